# Optimizing an MI355X kernel written in HIP

```python
import math
import jax
import jax.numpy as jnp
from jax import lax
import numpy as np

D_MODEL = 1024
BATCH = 32
SEQ = 2048
DEPTH = 2

GRID_W = 64
CTX_LEN = 256
EPS = 1e-6
F32 = jnp.float32

D_MIX = D_MODEL
GROUP_W = D_MIX // 4

GLA_HEADS = 4
GLA_DK = 32
GLA_DV = GROUP_W // GLA_HEADS
GLA_LOWRANK = 16
GLA_TAU = 16.0
GLA_CHUNK = 64

CONV_C = GROUP_W
CONV_K = 31

S5_C = GROUP_W
S5_GROUP = 16
S5_NG = S5_C // S5_GROUP
S5_P = 64

MLA_HEADS = 4
MLA_NOPE = 64
MLA_ROPE = 32
MLA_V = GROUP_W // MLA_HEADS
MLA_Q_LORA = 256
MLA_KV_LORA = 128
ROPE_AXIS = MLA_ROPE // 2
ROPE_BASE = 10000.0
Q_BLOCK = 128

N_EXPERTS = 64
TOP_K = 8
N_GROUPS = 8
TOPK_GROUPS = 4
EXPERT_FF = 256
SHARED_FF = 256
ROUTED_SCALE = 2.5
EXPERT_BLOCK = 256

IN_SPLITS = (GLA_HEADS * GLA_DK, GLA_HEADS * GLA_DK, GLA_HEADS * GLA_DV, GLA_HEADS * GLA_DV, GLA_LOWRANK, GLA_LOWRANK,
             2 * CONV_C, S5_C, MLA_Q_LORA, MLA_KV_LORA, MLA_ROPE)
D_IN = sum(IN_SPLITS)

kernel_name = "hybrid_dit_gla_conv_s5_mla_moe"


def rmsnorm(x, g):
    xf = x.astype(F32)
    return xf * lax.rsqrt(jnp.mean(xf * xf, axis=-1, keepdims=True) + EPS) * g.astype(F32)


def layernorm(x, g, b):
    xf = x.astype(F32)
    mu = jnp.mean(xf, axis=-1, keepdims=True)
    var = jnp.mean(jnp.square(xf - mu), axis=-1, keepdims=True)
    return (xf - mu) * lax.rsqrt(var + EPS) * g + b


def modulate(x, g, shift, scale):
    return rmsnorm(x, g) * (1.0 + scale) + shift


def swiglu(x, w_gate, w_up, w_down):
    return (jax.nn.silu(x @ w_gate) * (x @ w_up)) @ w_down


def gla_log_decay(a_low, w_a2, b_a):
    z = (a_low @ w_a2 + b_a).astype(F32)
    return (jax.nn.log_sigmoid(z) / GLA_TAU).reshape(z.shape[:-1] + (GLA_HEADS, GLA_DK))


def gla_chunked(q, k, v, log_a, s0):
    bsz, seq_len = q.shape[:2]
    n_chunks = seq_len // GLA_CHUNK
    chunk = lambda t: t.reshape((bsz, n_chunks, GLA_CHUNK) + t.shape[2:])
    q, k, v, log_a = chunk(q), chunk(k), chunk(v), chunk(log_a)
    b = jnp.cumsum(log_a, axis=2)
    b_end = b[:, :, -1:]
    q_dec = q * jnp.exp(b)
    k_inv = k * jnp.exp(-b)
    k_tail = k * jnp.exp(b_end - b)
    causal = jnp.tril(jnp.ones((GLA_CHUNK, GLA_CHUNK), dtype=bool))
    att = jnp.where(causal, jnp.einsum("bnihd,bnjhd->bnhij", q_dec, k_inv), 0.0)
    o_intra = jnp.einsum("bnhij,bnjhv->bnihv", att, v)
    u = jnp.einsum("bnjhd,bnjhv->bnhdv", k_tail, v)
    decay = jnp.exp(b_end[:, :, 0])

    def step(s, inp):
        dec, un = inp
        return dec[..., None] * s + un, s

    s_last, s_prev = lax.scan(step, s0, (jnp.moveaxis(decay, 1, 0), jnp.moveaxis(u, 1, 0)))
    o_inter = jnp.einsum("bnihd,nbhdv->bnihv", q_dec, s_prev)
    return (o_intra + o_inter).reshape(bsz, seq_len, GLA_HEADS, -1), s_last


def gla_mixer(seg, seg_c, w_a2, b_a, norm_g):
    def prep(s):
        q, k, v, r, a_f, a_b = [t.astype(F32) for t in s]
        heads = lambda t, d: t.reshape(t.shape[:-1] + (GLA_HEADS, d))
        return (heads(q, GLA_DK) * GLA_DK ** -0.5, heads(k, GLA_DK), heads(v, GLA_DV), r,
                gla_log_decay(a_f, w_a2[0], b_a[0]), gla_log_decay(a_b, w_a2[1], b_a[1]))

    q, k, v, r, la_f, la_b = prep(seg)
    qc, kc, vc, rc, lac_f, lac_b = prep(seg_c)
    s0 = jnp.zeros((q.shape[0], GLA_HEADS, GLA_DK, GLA_DV), F32)
    flip = lambda t: jnp.flip(t, axis=1)
    oc_f, sc_f = gla_chunked(qc, kc, vc, lac_f, s0)
    o_f, _ = gla_chunked(q, k, v, la_f, sc_f)
    oc_b, sc_b = gla_chunked(flip(qc), flip(kc), flip(vc), flip(lac_b), s0)
    o_b, _ = gla_chunked(flip(q), flip(k), flip(v), flip(la_b), sc_b)
    g = norm_g.reshape(GLA_HEADS, GLA_DV)

    def out(o, gate):
        o = rmsnorm(o, g)
        return o.reshape(o.shape[:2] + (GLA_HEADS * GLA_DV,)) * jax.nn.silu(gate)

    return out(o_f + flip(o_b), r), out(oc_f + flip(oc_b), rc)


def conformer_conv(u, dw_w, dw_b, ln_g, ln_b, pw_w, pw_b):
    a, gate = jnp.split(u.astype(F32), 2, axis=-1)
    h = a * jax.nn.sigmoid(gate)
    h = lax.conv_general_dilated(h, dw_w.astype(F32)[:, None, :], window_strides=(1,),
                                 padding=[(CONV_K // 2, CONV_K // 2)],
                                 dimension_numbers=("NWC", "WIO", "NWC"),
                                 feature_group_count=CONV_C) + dw_b
    h = jax.nn.silu(layernorm(h, ln_g, ln_b))
    return h @ pw_w + pw_b


def cplx_affine_combine(e1, e2):
    a1r, a1i, b1r, b1i = e1
    a2r, a2i, b2r, b2i = e2
    return (a2r * a1r - a2i * a1i, a2r * a1i + a2i * a1r,
            a2r * b1r - a2i * b1i + b2r, a2r * b1i + a2i * b1r + b2i)


def s5_discretize(lam_re, lam_im, log_dt, b_re, b_im):
    lam_re, lam_im, b_re, b_im = [t.astype(F32) for t in (lam_re, lam_im, b_re, b_im)]
    dt = jnp.exp(log_dt.astype(F32))[:, None]
    mag = jnp.exp(lam_re * dt)
    a_re, a_im = mag * jnp.cos(lam_im * dt), mag * jnp.sin(lam_im * dt)
    den = lam_re * lam_re + lam_im * lam_im
    f_re = ((a_re - 1.0) * lam_re + a_im * lam_im) / den
    f_im = (a_im * lam_re - (a_re - 1.0) * lam_im) / den
    bb_re = f_re[..., None] * b_re - f_im[..., None] * b_im
    bb_im = f_re[..., None] * b_im + f_im[..., None] * b_re
    return a_re, a_im, bb_re, bb_im


def s5_scan(a_re, a_im, bb_re, bb_im, u, h0_re, h0_im):
    seq_len = u.shape[1]
    bu_re = jnp.einsum("gph,blgh->blgp", bb_re, u)
    bu_im = jnp.einsum("gph,blgh->blgp", bb_im, u)
    shape = (1, seq_len) + a_re.shape
    ap_re, ap_im, h_re, h_im = lax.associative_scan(
        cplx_affine_combine,
        (jnp.broadcast_to(a_re, shape), jnp.broadcast_to(a_im, shape), bu_re, bu_im), axis=1)
    h_re = h_re + ap_re * h0_re[:, None] - ap_im * h0_im[:, None]
    h_im = h_im + ap_re * h0_im[:, None] + ap_im * h0_re[:, None]
    return h_re, h_im


def s5_mixer(u, uc, lam_re, lam_im, log_dt, b_re, b_im, c_re, c_im, d_skip, glu_w, glu_b):
    grp = lambda t: t.astype(F32).reshape(t.shape[:-1] + (S5_NG, S5_GROUP))
    ug, ucg = grp(u), grp(uc)
    flip = lambda t: jnp.flip(t, axis=1)
    zeros = jnp.zeros((u.shape[0], S5_NG, S5_P), F32)
    d = d_skip.astype(F32).reshape(S5_NG, S5_GROUP)
    y, yc = d * ug, d * ucg
    for direction in range(2):
        a_re, a_im, bb_re, bb_im = s5_discretize(lam_re[direction], lam_im[direction], log_dt[direction],
                                                 b_re[direction], b_im[direction])
        src, src_c = (ug, ucg) if direction == 0 else (flip(ug), flip(ucg))
        hc_re, hc_im = s5_scan(a_re, a_im, bb_re, bb_im, src_c, zeros, zeros)
        h_re, h_im = s5_scan(a_re, a_im, bb_re, bb_im, src, hc_re[:, -1], hc_im[:, -1])
        c_r, c_i = c_re[direction], c_im[direction]
        read = lambda hr, hi: (jnp.einsum("ghp,blgp->blgh", c_r, hr) - jnp.einsum("ghp,blgp->blgh", c_i, hi))
        y_dir, yc_dir = read(h_re, h_im), read(hc_re, hc_im)
        if direction == 1:
            y_dir, yc_dir = flip(y_dir), flip(yc_dir)
        y, yc = y + y_dir, yc + yc_dir

    def glu(t):
        z = t.reshape(t.shape[:2] + (S5_C,)) @ glu_w + glu_b
        return z[..., :S5_C] * jax.nn.sigmoid(z[..., S5_C:])

    return glu(y), glu(yc)


def rope_2d_tables(seq_len):
    rows = seq_len // GRID_W
    row = jnp.broadcast_to(jnp.arange(rows, dtype=F32)[:, None], (rows, GRID_W)).reshape(seq_len)
    col = jnp.broadcast_to(jnp.arange(GRID_W, dtype=F32)[None, :], (rows, GRID_W)).reshape(seq_len)
    inv_freq = ROPE_BASE ** (-jnp.arange(ROPE_AXIS // 2, dtype=F32) / (ROPE_AXIS // 2))
    ang = jnp.stack([row[:, None] * inv_freq, col[:, None] * inv_freq], axis=1)
    return jnp.cos(ang), jnp.sin(ang)


def apply_rope_2d(x, cos, sin):
    xs = x.reshape(x.shape[:-1] + (2, 2, ROPE_AXIS // 2))
    x1, x2 = xs[..., 0, :], xs[..., 1, :]
    return jnp.stack([x1 * cos - x2 * sin, x2 * cos + x1 * sin], axis=-2).reshape(x.shape)


def mla_attend(q_nope, q_rope, k_nope, k_rope, v):
    scores = (jnp.einsum("bqhd,bkhd->bhqk", q_nope, k_nope)
              + jnp.einsum("bqhr,bkr->bhqk", q_rope, k_rope)) * (MLA_NOPE + MLA_ROPE) ** -0.5
    p = jax.nn.softmax(scores.astype(F32), axis=-1)
    return jnp.einsum("bhqk,bkhd->bqhd", p, v)


def mla_mixer(cq, ckv, k_rope, cq_c, ckv_c, k_rope_c, qn_g, kvn_g, w_uq, w_ukv, with_ctx_out):
    bsz, seq_len = cq.shape[:2]

    def project(cq_, ckv_):
        q = (rmsnorm(cq_, qn_g) @ w_uq).reshape(cq_.shape[:2] + (MLA_HEADS, MLA_NOPE + MLA_ROPE))
        kv = (rmsnorm(ckv_, kvn_g) @ w_ukv).reshape(ckv_.shape[:2] + (MLA_HEADS, MLA_NOPE + MLA_V))
        return q[..., :MLA_NOPE], q[..., MLA_NOPE:], kv[..., :MLA_NOPE], kv[..., MLA_NOPE:]

    qn, qr, kn, v = project(cq, ckv)
    qn_c, qr_c, kn_c, v_c = project(cq_c, ckv_c)
    cos, sin = rope_2d_tables(seq_len)
    qr = apply_rope_2d(qr, cos[:, None], sin[:, None])
    kr = apply_rope_2d(k_rope.astype(F32), cos, sin)
    kr_c = k_rope_c.astype(F32)
    k_nope_all = jnp.concatenate([kn, kn_c], axis=1)
    k_rope_all = jnp.concatenate([kr, kr_c], axis=1)
    v_all = jnp.concatenate([v, v_c], axis=1)
    n_blocks = seq_len // Q_BLOCK
    blocks = lambda t: jnp.moveaxis(t.reshape((bsz, n_blocks, Q_BLOCK) + t.shape[2:]), 1, 0)
    o = lax.map(lambda qb: mla_attend(qb[0], qb[1], k_nope_all, k_rope_all, v_all), (blocks(qn), blocks(qr)))
    o = jnp.moveaxis(o, 0, 1).reshape(bsz, seq_len, MLA_HEADS * MLA_V)
    if not with_ctx_out:
        return o, None
    oc = mla_attend(qn_c, qr_c, kn_c, kr_c, v_c)
    return o, oc.reshape(oc.shape[:2] + (MLA_HEADS * MLA_V,))


def route(xf, router_w, router_b):
    n_tok = xf.shape[0]
    scores = jax.nn.sigmoid((xf @ router_w).astype(F32))
    biased = scores + router_b.astype(F32)
    grp_score = lax.top_k(biased.reshape(n_tok, N_GROUPS, N_EXPERTS // N_GROUPS), 2)[0].sum(-1)
    _, grp_idx = lax.top_k(grp_score, TOPK_GROUPS)
    grp_mask = jax.nn.one_hot(grp_idx, N_GROUPS, dtype=F32).sum(axis=1) > 0
    exp_mask = jnp.repeat(grp_mask, N_EXPERTS // N_GROUPS, axis=1)
    _, idx = lax.top_k(jnp.where(exp_mask, biased, -jnp.inf), TOP_K)
    w = jnp.take_along_axis(scores, idx, axis=1)
    return idx, w / jnp.sum(w, axis=-1, keepdims=True) * ROUTED_SCALE


def routed_experts(xf, idx, w, w_gate, w_up, w_down):
    n_tok, dm = xf.shape
    n_assign = n_tok * TOP_K
    e_flat = idx.reshape(n_assign)
    order = jnp.argsort(e_flat)
    e_sorted = e_flat[order]
    counts = jnp.bincount(e_flat, length=N_EXPERTS)
    padded = (counts + EXPERT_BLOCK - 1) // EXPERT_BLOCK * EXPERT_BLOCK
    pad_end = jnp.cumsum(padded)
    pad_start = pad_end - padded
    grp_start = jnp.cumsum(counts) - counts
    dest = pad_start[e_sorted] + jnp.arange(n_assign) - grp_start[e_sorted]
    n_blocks = -(-n_assign // EXPERT_BLOCK) + N_EXPERTS
    n_rows = n_blocks * EXPERT_BLOCK
    row_tok = jnp.zeros((n_rows,), jnp.int32).at[dest].set((order // TOP_K).astype(jnp.int32))
    row_w = jnp.zeros((n_rows,), F32).at[dest].set(w.reshape(n_assign)[order])
    blk_expert = jnp.minimum(jnp.searchsorted(pad_end, jnp.arange(n_blocks) * EXPERT_BLOCK, side="right"),
                             N_EXPERTS - 1)

    def body(acc, blk):
        tok, wt, e = blk
        yb = swiglu(xf[tok], w_gate[e], w_up[e], w_down[e]) * wt[:, None]
        return acc.at[tok].add(yb.astype(acc.dtype)), None

    y, _ = lax.scan(body, jnp.zeros((n_tok, dm), F32),
                    (row_tok.reshape(n_blocks, EXPERT_BLOCK), row_w.reshape(n_blocks, EXPERT_BLOCK), blk_expert))
    return y


def moe_ffn(xf, router_w, router_b, w_gate, w_up, w_down, sh_gate, sh_up, sh_down):
    idx, w = route(xf, router_w, router_b)
    return routed_experts(xf, idx, w, w_gate, w_up, w_down) + swiglu(xf, sh_gate, sh_up, sh_down)


def setup_inputs(seed: int = 0) -> dict:
    key = jax.random.key(seed)
    keys = iter(jax.random.split(key, 64))

    def nrm(shape, scale):
        return jax.random.normal(next(keys), shape, F32) * scale

    def gain(shape):
        return 1.0 + nrm(shape, 0.02)

    s5_shape = (DEPTH, 2, S5_NG, S5_P)
    return {
        "x": nrm((BATCH, SEQ, D_MODEL), 1.0),
        "c": nrm((BATCH, D_MODEL), 1.0),
        "ctx": nrm((BATCH, CTX_LEN, D_MODEL), 1.0),
        "c_ctx": nrm((D_MODEL,), 1.0),
        "ada_w": nrm((DEPTH, D_MODEL, 6 * D_MODEL), 0.5 * D_MODEL ** -0.5),
        "ada_b": nrm((DEPTH, 6 * D_MODEL), 0.02),
        "norm1_g": gain((DEPTH, D_MODEL)),
        "norm2_g": gain((DEPTH, D_MODEL)),
        "w_in": nrm((DEPTH, D_MODEL, D_IN), D_MODEL ** -0.5),
        "w_out": nrm((DEPTH, D_MIX, D_MODEL), D_MIX ** -0.5),
        "gla_w_a2": nrm((DEPTH, 2, GLA_LOWRANK, GLA_HEADS * GLA_DK), GLA_LOWRANK ** -0.5),
        "gla_b_a": nrm((DEPTH, 2, GLA_HEADS * GLA_DK), 0.1),
        "gla_norm_g": gain((DEPTH, GLA_HEADS * GLA_DV)),
        "conv_dw_w": nrm((DEPTH, CONV_K, CONV_C), CONV_K ** -0.5),
        "conv_dw_b": nrm((DEPTH, CONV_C), 0.02),
        "conv_ln_g": gain((DEPTH, CONV_C)),
        "conv_ln_b": nrm((DEPTH, CONV_C), 0.02),
        "conv_pw_w": nrm((DEPTH, CONV_C, CONV_C), CONV_C ** -0.5),
        "conv_pw_b": nrm((DEPTH, CONV_C), 0.02),
        "s5_lam_re": -0.5 + nrm(s5_shape, 0.01),
        "s5_lam_im": math.pi * jnp.arange(S5_P, dtype=F32) + nrm(s5_shape, 0.01),
        "s5_log_dt": jax.random.uniform(next(keys), (DEPTH, 2, S5_NG), F32, math.log(1e-3), math.log(1e-1)),
        "s5_b_re": nrm((DEPTH, 2, S5_NG, S5_P, S5_GROUP), (2 * S5_GROUP) ** -0.5),
        "s5_b_im": nrm((DEPTH, 2, S5_NG, S5_P, S5_GROUP), (2 * S5_GROUP) ** -0.5),
        "s5_c_re": nrm((DEPTH, 2, S5_NG, S5_GROUP, S5_P), S5_P ** -0.5),
        "s5_c_im": nrm((DEPTH, 2, S5_NG, S5_GROUP, S5_P), S5_P ** -0.5),
        "s5_d": nrm((DEPTH, S5_C), 1.0),
        "s5_glu_w": nrm((DEPTH, S5_C, 2 * S5_C), S5_C ** -0.5),
        "s5_glu_b": nrm((DEPTH, 2 * S5_C), 0.02),
        "mla_qn_g": gain((DEPTH, MLA_Q_LORA)),
        "mla_kvn_g": gain((DEPTH, MLA_KV_LORA)),
        "mla_w_uq": nrm((DEPTH, MLA_Q_LORA, MLA_HEADS * (MLA_NOPE + MLA_ROPE)), MLA_Q_LORA ** -0.5),
        "mla_w_ukv": nrm((DEPTH, MLA_KV_LORA, MLA_HEADS * (MLA_NOPE + MLA_V)), MLA_KV_LORA ** -0.5),
        "moe_router_w": nrm((DEPTH, D_MODEL, N_EXPERTS), D_MODEL ** -0.5),
        "moe_router_b": nrm((DEPTH, N_EXPERTS), 0.01),
        "moe_w_gate": nrm((DEPTH, N_EXPERTS, D_MODEL, EXPERT_FF), D_MODEL ** -0.5),
        "moe_w_up": nrm((DEPTH, N_EXPERTS, D_MODEL, EXPERT_FF), D_MODEL ** -0.5),
        "moe_w_down": nrm((DEPTH, N_EXPERTS, EXPERT_FF, D_MODEL), EXPERT_FF ** -0.5),
        "shared_w_gate": nrm((DEPTH, D_MODEL, SHARED_FF), D_MODEL ** -0.5),
        "shared_w_up": nrm((DEPTH, D_MODEL, SHARED_FF), D_MODEL ** -0.5),
        "shared_w_down": nrm((DEPTH, SHARED_FF, D_MODEL), SHARED_FF ** -0.5),
        "final_g": gain((D_MODEL,)),
    }


def reference(x, c, ctx, c_ctx, ada_w, ada_b, norm1_g, norm2_g, w_in, w_out,
              gla_w_a2, gla_b_a, gla_norm_g,
              conv_dw_w, conv_dw_b, conv_ln_g, conv_ln_b, conv_pw_w, conv_pw_b,
              s5_lam_re, s5_lam_im, s5_log_dt, s5_b_re, s5_b_im, s5_c_re, s5_c_im, s5_d, s5_glu_w, s5_glu_b,
              mla_qn_g, mla_kvn_g, mla_w_uq, mla_w_ukv,
              moe_router_w, moe_router_b, moe_w_gate, moe_w_up, moe_w_down,
              shared_w_gate, shared_w_up, shared_w_down, final_g):
    bsz, seq_len, dm = x.shape
    ctx_len = ctx.shape[1]
    split_at = np.cumsum(IN_SPLITS)[:-1].tolist()
    xc = ctx
    for l in range(DEPTH):
        last = l == DEPTH - 1
        mod = jax.nn.silu(c.astype(F32)) @ ada_w[l] + ada_b[l]
        mod_c = jax.nn.silu(c_ctx.astype(F32)) @ ada_w[l] + ada_b[l]
        sh1, sc1, g1, sh2, sc2, g2 = jnp.split(mod[:, None, :], 6, axis=-1)
        sh1c, sc1c, g1c, sh2c, sc2c, g2c = jnp.split(mod_c, 6)
        z = jnp.split(modulate(x, norm1_g[l], sh1, sc1) @ w_in[l], split_at, axis=-1)
        zc = jnp.split(modulate(xc, norm1_g[l], sh1c, sc1c) @ w_in[l], split_at, axis=-1)
        conv_p = (conv_dw_w[l], conv_dw_b[l], conv_ln_g[l], conv_ln_b[l], conv_pw_w[l], conv_pw_b[l])
        s5_p = (s5_lam_re[l], s5_lam_im[l], s5_log_dt[l], s5_b_re[l], s5_b_im[l], s5_c_re[l], s5_c_im[l],
                s5_d[l], s5_glu_w[l], s5_glu_b[l])
        moe_p = (moe_router_w[l], moe_router_b[l], moe_w_gate[l], moe_w_up[l], moe_w_down[l],
                 shared_w_gate[l], shared_w_up[l], shared_w_down[l])
        o_gla, oc_gla = gla_mixer(z[:6], zc[:6], gla_w_a2[l], gla_b_a[l], gla_norm_g[l])
        o_conv = conformer_conv(z[6], *conv_p)
        o_s5, oc_s5 = s5_mixer(z[7], zc[7], *s5_p)
        o_mla, oc_mla = mla_mixer(z[8], z[9], z[10], zc[8], zc[9], zc[10],
                                  mla_qn_g[l], mla_kvn_g[l], mla_w_uq[l], mla_w_ukv[l], not last)
        mix = jnp.concatenate([o_gla, o_conv, o_s5, o_mla], axis=-1) @ w_out[l]
        x = x + (g1 * mix).astype(x.dtype)
        h2 = modulate(x, norm2_g[l], sh2, sc2).reshape(bsz * seq_len, dm)
        if last:
            y = moe_ffn(h2, *moe_p)
        else:
            oc_conv = conformer_conv(zc[6], *conv_p)
            mix_c = jnp.concatenate([oc_gla, oc_conv, oc_s5, oc_mla], axis=-1) @ w_out[l]
            xc = xc + (g1c * mix_c).astype(xc.dtype)
            h2c = modulate(xc, norm2_g[l], sh2c, sc2c).reshape(bsz * ctx_len, dm)
            y_all = moe_ffn(jnp.concatenate([h2, h2c], axis=0), *moe_p)
            y = y_all[: bsz * seq_len]
            xc = xc + (g2c * y_all[bsz * seq_len:].reshape(bsz, ctx_len, dm)).astype(xc.dtype)
        x = x + (g2 * y.reshape(bsz, seq_len, dm)).astype(x.dtype)
    return rmsnorm(x, final_g).astype(x.dtype)
```

```cpp
#include <hip/hip_runtime.h>
#include <cstdio>
#include <cstdint>

#define LAS __attribute__((address_space(3)))
typedef unsigned short bf16;
typedef short bf16x8 __attribute__((ext_vector_type(8)));
typedef float f32x4 __attribute__((ext_vector_type(4)));
typedef float f32x2 __attribute__((ext_vector_type(2)));
typedef unsigned u32x4 __attribute__((ext_vector_type(4)));
typedef unsigned u32x2 __attribute__((ext_vector_type(2)));

constexpr int NB = 32, SEQ = 2048, CTXL = 256, DM = 1024;
constexpr int NLAT = NB * SEQ, NCTX = NB * CTXL, NTOK = NLAT + NCTX;
constexpr int ZW = 2048;
constexpr int ZQ = 0, ZK = 128, ZV = 256, ZR = 512, ZCA = 768, ZCG = 1024, ZS5 = 1280, ZCQ = 1536, ZCKV = 1792, ZKR = 1920, ZAF = 1952, ZAB = 1968;
constexpr int NE = 64, TOPK = 8;
constexpr int NCH = 4;
constexpr int RPCMAX = 18432 * 8 + 64 * 256;
constexpr float EPS = 1e-6f;
constexpr int NWAVES = 8, NTHR = 512;

constexpr size_t MiB = (size_t)1 << 20;
constexpr size_t WS_CTL = 0, CTL_BYTES = 1 * MiB;
constexpr size_t WS_MOD = 1 * MiB;
constexpr size_t WS_TAB = 3 * MiB;
constexpr size_t WS_WSM = 5 * MiB;
constexpr size_t WS_WIN = 8 * MiB;
constexpr size_t WS_WOUT = 16 * MiB;
constexpr size_t WS_WSH = 20 * MiB;
constexpr size_t WS_TB = 23 * MiB;
constexpr size_t WS_RT = 24 * MiB;
constexpr size_t WS_ROWL = 32 * MiB;
constexpr size_t WS_RS = 35 * MiB;
constexpr size_t WS_WMOE = 36 * MiB;
constexpr size_t WS_XC = 132 * MiB;
constexpr size_t WS_H = 164 * MiB;
constexpr size_t WS_Z = 308 * MiB;
constexpr size_t WS_MIX = 596 * MiB;
constexpr size_t WS_T1 = 740 * MiB;
constexpr size_t WS_CV = 884 * MiB;
constexpr size_t WS_Y5 = 920 * MiB;
constexpr size_t WS_END = 956 * MiB;
constexpr size_t WS_HB = WS_Z;
constexpr size_t WS_HBS = WS_Z + 80 * MiB;
constexpr size_t WS_OBS = WS_Z + 89 * MiB;
constexpr size_t WS_OB = WS_MIX;
static_assert(WS_OB + (size_t)RPCMAX * 2048 <= WS_END, "OB overlay");
constexpr int CW_BAR = 0;
constexpr int CW_CNT = 4096;
constexpr size_t WSM_L = 1 * MiB;
constexpr size_t WSM_PW = 0, WSM_GLU = 128 * 1024, WSM_UQ = 384 * 1024, WSM_UK = 640 * 1024, WSM_UV = 768 * 1024;
constexpr size_t TAB_ROPE = 0;
constexpr size_t TAB_S5 = 256 * 1024;
constexpr size_t RT_TKEP = 0, RT_TKW = 2400000, RT_SLOT = 4800000;

__device__ __forceinline__ float bf2f(bf16 v) { return __uint_as_float(((unsigned)v) << 16); }
__device__ __forceinline__ unsigned pk2(float lo, float hi) { unsigned r; asm("v_cvt_pk_bf16_f32 %0, %1, %2" : "=v"(r) : "v"(lo), "v"(hi)); return r; }
__device__ __forceinline__ bf16 f2bf(float f) { return (bf16)(pk2(f, 0.f) & 0xffffu); }
template <int O> __device__ __forceinline__ float shx(float v) {
    return __int_as_float(__builtin_amdgcn_ds_swizzle(__float_as_int(v), (O << 10) | 0x1f)); }
__device__ __forceinline__ float rdl(float v, int l) { return __int_as_float(__builtin_amdgcn_readlane(__float_as_int(v), l)); }
__device__ __forceinline__ int rdli(int v, int l) { return __builtin_amdgcn_readlane(v, l); }
__device__ __forceinline__ float wave_sum(float v) {
    v += shx<1>(v); v += shx<2>(v); v += shx<4>(v); v += shx<8>(v); v += shx<16>(v);
    const auto r = __builtin_amdgcn_permlane32_swap(__float_as_uint(v), __float_as_uint(v), false, false);
    return __uint_as_float(r[0]) + __uint_as_float(r[1]);
}
__device__ __forceinline__ float wave_max(float v) {
    v = fmaxf(v, shx<1>(v)); v = fmaxf(v, shx<2>(v)); v = fmaxf(v, shx<4>(v)); v = fmaxf(v, shx<8>(v)); v = fmaxf(v, shx<16>(v));
    const auto r = __builtin_amdgcn_permlane32_swap(__float_as_uint(v), __float_as_uint(v), false, false);
    return fmaxf(__uint_as_float(r[0]), __uint_as_float(r[1]));
}
__device__ __forceinline__ float sigmoidf_(float x) { return 1.0f / (1.0f + __expf(-x)); }
__device__ __forceinline__ float siluf_(float x) { return x / (1.0f + __expf(-x)); }
__device__ __forceinline__ void unpack8(const u32x4 w, float (&v)[8]) {
    v[0] = __uint_as_float(w.x << 16); v[1] = __uint_as_float(w.x & 0xffff0000u);
    v[2] = __uint_as_float(w.y << 16); v[3] = __uint_as_float(w.y & 0xffff0000u);
    v[4] = __uint_as_float(w.z << 16); v[5] = __uint_as_float(w.z & 0xffff0000u);
    v[6] = __uint_as_float(w.w << 16); v[7] = __uint_as_float(w.w & 0xffff0000u);
}
__device__ __forceinline__ void lds_wait() { asm volatile("s_waitcnt lgkmcnt(0)" ::: "memory"); }

#define XB_TMO      128
#define XB_XCNT(j)  (256  + 64 * (j))
#define XB_XSUB(j)  (1280 + 64 * (j))
#define XB_XGEN(j)  (2304 + 64 * (j))
#define XB_TOP      3328
#define XB_TOPGEN   3392
#define XCD_BAR_WORDS 3456
#define XB_SPIN_CAP (1u << 22)
__device__ __forceinline__ unsigned xb_ld(unsigned* p)              { return __hip_atomic_load(p, __ATOMIC_RELAXED, __HIP_MEMORY_SCOPE_AGENT); }
__device__ __forceinline__ unsigned xb_add(unsigned* p, unsigned v) { return __hip_atomic_fetch_add(p, v, __ATOMIC_RELAXED, __HIP_MEMORY_SCOPE_AGENT); }
__device__ __forceinline__ unsigned xb_xcc_id() { return (unsigned)__builtin_amdgcn_s_getreg((3 << 11) | 20) & 0xFu; }
#define XB_SPIN(cond, bar) do { unsigned _sp = 0; while (cond) { __builtin_amdgcn_s_sleep(1); \
    if ((++_sp & 255u) == 0u) { if (xb_ld(&(bar)[XB_TMO])) break; if (_sp > XB_SPIN_CAP) { atomicAdd(&(bar)[XB_TMO], 1u); break; } } } } while (0)
struct XcdBarrier { unsigned* bar; unsigned x; volatile LAS unsigned* st; };
__device__ __forceinline__ XcdBarrier xcd_barrier_post(unsigned* bar, volatile LAS unsigned* st) {
    XcdBarrier b; b.bar = bar; b.x = xb_xcc_id(); b.st = st;
    if (threadIdx.x == 0) (void)xb_add(&bar[XB_XCNT(b.x)], 1u);
    return b;
}
__device__ __forceinline__ void xcd_barrier_complete(unsigned* bar, unsigned x, unsigned& nloc, unsigned& nx) {
    const unsigned G = gridDim.x * gridDim.y * gridDim.z;
    unsigned sum, cnt, mine, sp = 0u;
    for (;;) {
        sum = 0u; cnt = 0u; mine = 0u;
#pragma unroll
        for (unsigned j = 0; j < 16; ++j) { const unsigned c = xb_ld(&bar[XB_XCNT(j)]); sum += c; cnt += (c > 0u) ? 1u : 0u; mine = (j == x) ? c : mine; }
        if (sum == G) break;
        __builtin_amdgcn_s_sleep(1);
        if ((++sp & 255u) == 0u) { if (xb_ld(&bar[XB_TMO])) break; if (sp > XB_SPIN_CAP) { atomicAdd(&bar[XB_TMO], 1u); break; } }
    }
    nloc = mine > 0u ? mine : 1u; nx = cnt > 0u ? cnt : 1u;
}
__device__ __forceinline__ void xcd_barrier(const XcdBarrier& b) {
    asm volatile("s_waitcnt vmcnt(0)" ::: "memory");
    __syncthreads();
    if (threadIdx.x == 0) {
        unsigned* bar = b.bar;
        __builtin_amdgcn_s_waitcnt(0);
        unsigned nloc = b.st[0], nx = b.st[1];
        if (nloc == 0u) { xcd_barrier_complete(bar, b.x, nloc, nx); b.st[0] = nloc; b.st[1] = nx; }
        const unsigned old = xb_add(&bar[XB_XSUB(b.x)], 1u);
        const unsigned gen = old / nloc;
        if (old + 1u == (gen + 1u) * nloc) {
            __builtin_amdgcn_fence(__ATOMIC_RELEASE, "agent");
            asm volatile("s_waitcnt vmcnt(0)" ::: "memory");
            const unsigned og = xb_add(&bar[XB_TOP], 1u);
            const unsigned tg = og / nx;
            if (og + 1u == (tg + 1u) * nx) xb_add(&bar[XB_TOPGEN], 1u);
            else XB_SPIN(xb_ld(&bar[XB_TOPGEN]) == tg, bar);
            __builtin_amdgcn_fence(__ATOMIC_ACQUIRE, "agent");
            xb_add(&bar[XB_XGEN(b.x)], 1u);
            asm volatile("s_waitcnt vmcnt(0)" ::: "memory");
        } else {
            XB_SPIN(xb_ld(&bar[XB_XGEN(b.x)]) == gen, bar);
            __builtin_amdgcn_fence(__ATOMIC_ACQUIRE, "agent");
            asm volatile("s_waitcnt vmcnt(0)" ::: "memory");
        }
    }
    __syncthreads();
}

namespace pg8 {
constexpr int BM = 256, BK = 64, HALF = 128, HTB = HALF * BK * 2, STAGE_BYTES = 8 * HTB, NXCD = 8, WGM = 8;
__device__ __forceinline__ int lds_byte(int r, int c) { const int st = (r >> 4) * 2 + (c >> 5), rr = r & 15, cc = c & 31, ob = rr * 64 + cc * 2; return st * 1024 + (ob ^ (((ob >> 9) & 1) << 5)); }
__device__ __forceinline__ void stage_rc(int b, int& R, int& C) { const int st = b / 1024, sb = b % 1024, swz = sb ^ (((sb >> 9) & 1) << 5); R = (st >> 1) * 16 + swz / 64; C = (st & 1) * 32 + (swz % 64) / 2; }
__device__ __forceinline__ int perm32(int rho) { const int n = rho >> 4, i = rho & 15; return 8 * (i >> 2) + 4 * n + (i & 3); }

struct Unit { int pm, pn, e; const char* B; };

struct DenseOrder {
    int nM, nN, nwg, G, c; const char* Bt; size_t btile;
    __device__ __forceinline__ void init(int nM_, int nN_, int G_, int c_, const bf16* Bt_, int K) { nM = nM_; nN = nN_; nwg = nM * nN; G = G_; c = c_; Bt = (const char*)Bt_; btile = (size_t)256 * K * 2; }
    __device__ __forceinline__ bool next(int i, Unit& u) const {
        const long L = (long)i * G + c; if (L >= nwg) return false;
        int wgid = (int)L; { const int q = nwg / NXCD, r = nwg % NXCD, xcd = wgid % NXCD, off = wgid / NXCD; wgid = (xcd < r ? xcd * (q + 1) : r * (q + 1) + (xcd - r) * q) + off; }
        const int nig = WGM * nN, gid = wgid / nig, fm = gid * WGM, gsz = (nM - fm) < WGM ? (nM - fm) : WGM;
        u.pm = fm + ((wgid % nig) % gsz); u.pn = (wgid % nig) / gsz; u.e = 0; u.B = Bt + (size_t)u.pn * btile; return true;
    }
};
struct RowsDense { unsigned ldab; __device__ __forceinline__ unsigned off(const Unit& u, int r) const { return (unsigned)(u.pm * 256 + r) * ldab; } };
struct RowsGather { const int* list; unsigned ldab; __device__ __forceinline__ unsigned off(const Unit& u, int r) const { return (unsigned)list[u.pm * 256 + r] * ldab; } };

template <class Epi, class Sched, class Rows>
__device__ __forceinline__ void gemm_phase(LAS unsigned char* lds, const char* Abase, const int K, const Sched& S, const Rows& RW, const Epi& E) {
    int tid_ = threadIdx.x; asm volatile("" : "+v"(tid_));
    const int tid = tid_, wid = __builtin_amdgcn_readfirstlane(tid >> 6), lane = tid & 63, wr = wid >> 2, wc = wid & 3, fr = lane & 15, fq = lane >> 4;
    const int nt = K / BK;
    int sR[2]; unsigned sC[2], voffB[2];
#pragma unroll
    for (int i = 0; i < 2; ++i) { int R, C; stage_rc(tid * 16 + i * 8192, R, C); sR[i] = R; sC[i] = (unsigned)C * 2u; const int Rb = (R & ~31) + perm32(R & 31); voffB[i] = (unsigned)(Rb * K + C) * 2u; }
    const size_t kstep = (size_t)(BK * 2);
    const size_t hstepB = (size_t)HALF * K * 2;
    const unsigned ldsw = (unsigned)wid * 1024u;
    const int aoff = lds_byte(wr * 64 + fr, fq * 8), boff = lds_byte(wc * 32 + fr, fq * 8);
#define PG8_SA(b, h) (((b) * 2 + (h)) * HTB)
#define PG8_SB(b, h) ((4 + (b) * 2 + (h)) * HTB)
#define PG8_STAGE(bufoff, gbase, voff) do { _Pragma("unroll") for (int _i = 0; _i < 2; ++_i) { unsigned _o = (voff)[_i]; asm volatile("" : "+v"(_o)); \
        __builtin_amdgcn_global_load_lds((const unsigned*)((const char*)(gbase) + _o), (LAS unsigned*)(lds + (bufoff) + ldsw + _i * 8192), 16, 0, 0); } } while (0)
#define PG8_LDA(dst, b, h) do { _Pragma("unroll") for (int m = 0; m < 4; ++m) _Pragma("unroll") for (int k = 0; k < 2; ++k) dst[m][k] = *(const LAS bf16x8*)(lds + PG8_SA(b, h) + aoff + m * 2048 + k * 1024); } while (0)
#define PG8_LDB(dst, b, h) do { _Pragma("unroll") for (int n = 0; n < 2; ++n) _Pragma("unroll") for (int k = 0; k < 2; ++k) dst[n][k] = *(const LAS bf16x8*)(lds + PG8_SB(b, h) + boff + n * 2048 + k * 1024); } while (0)
#define PG8_MMA(ai, bj, At, Bt) do { __builtin_amdgcn_s_setprio(1); _Pragma("unroll") for (int m = 0; m < 4; ++m) _Pragma("unroll") for (int n = 0; n < 2; ++n) _Pragma("unroll") for (int k = 0; k < 2; ++k) \
        acc[ai][bj][m][n] = __builtin_amdgcn_mfma_f32_16x16x32_bf16(Bt[n][k], At[m][k], acc[ai][bj][m][n], 0, 0, 0); __builtin_amdgcn_s_setprio(0); } while (0)
#define PG8_WAIT_V(n) asm volatile("s_waitcnt vmcnt(" #n ")" ::: "memory")
#define PG8_WAIT_L(n) asm volatile("s_waitcnt lgkmcnt(" #n ")" ::: "memory")
#define PG8_BAR __builtin_amdgcn_s_barrier()
#define PG8_SCHED __builtin_amdgcn_sched_barrier(0)
    Unit cur, nxt; int ui = 0;
    if (!S.next(0, cur)) return;
    f32x4 acc[2][2][4][2];
#pragma unroll
    for (int a = 0; a < 2; ++a)
#pragma unroll
        for (int b = 0; b < 2; ++b)
#pragma unroll
            for (int m = 0; m < 4; ++m)
#pragma unroll
                for (int n = 0; n < 2; ++n) acc[a][b][m][n] = (f32x4){0.f, 0.f, 0.f, 0.f};
    bf16x8 At[4][2], B0[2][2], B1[2][2];
    unsigned oA0[2], oA1[2];
#pragma unroll
    for (int i = 0; i < 2; ++i) { oA0[i] = RW.off(cur, sR[i]) + sC[i]; oA1[i] = RW.off(cur, HALF + sR[i]) + sC[i]; }
    const char* cB = cur.B;
    PG8_STAGE(PG8_SB(0, 0), cB, voffB); PG8_STAGE(PG8_SB(0, 1), cB + hstepB, voffB); PG8_STAGE(PG8_SA(0, 0), Abase, oA0); PG8_STAGE(PG8_SA(0, 1), Abase, oA1);
    if (wr == 1) PG8_BAR;
    PG8_WAIT_V(2); PG8_BAR;
    PG8_STAGE(PG8_SB(1, 0), cB + kstep, voffB); PG8_STAGE(PG8_SA(1, 0), Abase + kstep, oA0); PG8_STAGE(PG8_SB(1, 1), cB + hstepB + kstep, voffB);
    PG8_WAIT_V(6); PG8_BAR;
    for (;;) {
        const bool has_next = S.next(ui + 1, nxt);
#pragma unroll 1
        for (int t = 0; t < nt; t += 2) {
            const bool last = (t == nt - 2);
            const char* a1 = Abase + (size_t)(t + 1) * kstep;
            PG8_LDB(B0, 0, 0); PG8_LDB(B1, 0, 1); PG8_SCHED; PG8_LDA(At, 0, 0); PG8_STAGE(PG8_SA(1, 1), a1, oA1);
            PG8_WAIT_V(8); PG8_WAIT_L(0); PG8_BAR; PG8_MMA(0, 0, At, B0); PG8_MMA(0, 1, At, B1); PG8_BAR; PG8_SCHED;
            const char* a2; const char* b2;
            if (last) {
                if (has_next) {
                    int t2 = threadIdx.x; asm volatile("" : "+v"(t2));
#pragma unroll
                    for (int i = 0; i < 2; ++i) { int R, C; stage_rc(t2 * 16 + i * 8192, R, C); oA0[i] = RW.off(nxt, R) + (unsigned)C * 2u; oA1[i] = RW.off(nxt, HALF + R) + (unsigned)C * 2u; }
                    cB = nxt.B;
                }
                a2 = Abase; b2 = cB;
            } else { a2 = Abase + (size_t)(t + 2) * kstep; b2 = cB + (size_t)(t + 2) * kstep; }
            const char* a3 = a2 + kstep; const char* b3 = b2 + kstep;
            PG8_LDA(At, 0, 1); PG8_STAGE(PG8_SB(0, 0), b2, voffB); PG8_STAGE(PG8_SB(0, 1), b2 + hstepB, voffB); PG8_STAGE(PG8_SA(0, 0), a2, oA0);
            PG8_WAIT_V(8); PG8_WAIT_L(0); PG8_BAR; PG8_MMA(1, 0, At, B0); PG8_MMA(1, 1, At, B1); PG8_BAR; PG8_SCHED;
            PG8_LDB(B0, 1, 0); PG8_LDB(B1, 1, 1); PG8_SCHED; PG8_LDA(At, 1, 0); PG8_STAGE(PG8_SA(0, 1), a2, oA1);
            PG8_WAIT_V(8); PG8_WAIT_L(0); PG8_BAR; PG8_MMA(0, 0, At, B0); PG8_MMA(0, 1, At, B1); PG8_BAR; PG8_SCHED;
            PG8_LDA(At, 1, 1); PG8_STAGE(PG8_SB(1, 0), b3, voffB); PG8_STAGE(PG8_SB(1, 1), b3 + hstepB, voffB); PG8_STAGE(PG8_SA(1, 0), a3, oA0);
            PG8_WAIT_V(8); PG8_WAIT_L(0); PG8_BAR; PG8_MMA(1, 0, At, B0); PG8_MMA(1, 1, At, B1); PG8_BAR; PG8_SCHED;
        }
        if (wr == 0) PG8_BAR;
        { Unit eu = cur; asm volatile("" : "+s"(eu.pm), "+s"(eu.pn)); int t3 = threadIdx.x; asm volatile("" : "+v"(t3)); E(acc, eu, wr, wc, t3 & 15, (t3 & 63) >> 4); }
        if (!has_next) break;
#pragma unroll
        for (int a = 0; a < 2; ++a)
#pragma unroll
            for (int b = 0; b < 2; ++b)
#pragma unroll
                for (int m = 0; m < 4; ++m)
#pragma unroll
                    for (int n = 0; n < 2; ++n) acc[a][b][m][n] = (f32x4){0.f, 0.f, 0.f, 0.f};
        cur = nxt; ++ui;
        if (wr == 1) PG8_BAR;
    }
    PG8_WAIT_V(0);
    PG8_BAR;
#undef PG8_SA
#undef PG8_SB
#undef PG8_STAGE
#undef PG8_LDA
#undef PG8_LDB
#undef PG8_MMA
#undef PG8_WAIT_V
#undef PG8_WAIT_L
#undef PG8_BAR
#undef PG8_SCHED
}
}

struct Params { const float* in[42]; float* out; unsigned char* ws; int ph_lo, ph_hi; };
enum { I_X = 0, I_C, I_CTX, I_CCTX, I_ADAW, I_ADAB, I_N1G, I_N2G, I_WIN, I_WOUT, I_GLAW, I_GLAB, I_GLAG, I_CDW, I_CDB, I_CLG, I_CLB, I_CPW, I_CPB,
       I_S5LR, I_S5LI, I_S5DT, I_S5BR, I_S5BI, I_S5CR, I_S5CI, I_S5D, I_S5GW, I_S5GB, I_QNG, I_KVNG, I_WUQ, I_WUKV, I_RW, I_RB, I_MG, I_MU, I_MD, I_SG, I_SU, I_SD, I_FG };

typedef const __attribute__((address_space(4))) Params* KParams;
__device__ __forceinline__ KParams fresh_params() { KParams kp = (KParams)__builtin_amdgcn_kernarg_segment_ptr(); asm volatile("" : "+s"(kp)); return kp; }
struct Ctx {
    LAS unsigned char* lds;
    int tid, lane, wave, blk, G;
    unsigned char* ws;
};

__device__ __forceinline__ int mod_row(int r) { return r < NLAT ? (r >> 11) : 32; }

__device__ __forceinline__ void tr_item(const float* W, int ldw, int k0, int n0, bf16* dst, int ldk, const float* kscale, float sc, LAS float* scr, int lane) {
#pragma unroll 8
    for (int i = 0; i < 32; ++i) { const int kk = 2 * i + (lane >> 5); float v = W[(size_t)(k0 + kk) * ldw + n0 + (lane & 31)] * sc; if (kscale) v *= kscale[k0 + kk]; scr[kk * 33 + (lane & 31)] = v; }
    lds_wait();
    const int c = lane & 7;
#pragma unroll
    for (int j = 0; j < 4; ++j) { const int n = (lane >> 3) + 8 * j; const LAS float* s = scr + (8 * c) * 33 + n;
        u32x4 o; o.x = pk2(s[0 * 33], s[1 * 33]); o.y = pk2(s[2 * 33], s[3 * 33]); o.z = pk2(s[4 * 33], s[5 * 33]); o.w = pk2(s[6 * 33], s[7 * 33]);
        *(u32x4*)(dst + (size_t)n * ldk + k0 + 8 * c) = o; }
    lds_wait();
}
template <int KIND> __device__ __forceinline__ int tr_dst(int n0) {
    if (KIND == 0) return n0;
    if (KIND == 1) return n0 < 768 ? n0 : (n0 == 768 ? 1952 : n0 - 32);
    if (KIND == 2) { const int half = n0 >> 8, c = n0 & 255; return (c >> 7) * 256 + half * 128 + (c & 127); }
    if (KIND == 3) { const int head = n0 / 96, d0 = n0 % 96; return d0 < 64 ? head * 64 + d0 : 256 + head * 32; }
    if (KIND == 4) { const int head = n0 >> 7, d0 = n0 & 127; return d0 < 64 ? head * 64 + d0 : 256 + head * 64 + (d0 - 64); }
    if (KIND == 5) return (n0 >> 7) * 256 + (n0 & 127);
    if (KIND == 6) return (n0 >> 7) * 256 + 128 + (n0 & 127);
    return n0;
}
template <int KIND> __device__ __forceinline__ void tr_matrix(const Ctx& c, const float* W, int ldw, int K, int Nsrc, bf16* WT, int ldk, const float* kscale, float sc) {
    LAS float* scr = (LAS float*)(c.lds + c.wave * 8704);
    const int gw = c.blk * NWAVES + c.wave, NGW = c.G * NWAVES, ng = Nsrc / 32, items = (K / 64) * ng;
    for (int it = gw; it < items; it += NGW) { const int kb = it / ng, g = it % ng; tr_item(W, ldw, kb * 64, 32 * g, WT + (size_t)tr_dst<KIND>(32 * g) * ldk, ldk, kscale, sc, scr, c.lane); }
}
__device__ __forceinline__ void zero_fill16(const Ctx& c, void* p, size_t bytes) {
    u32x4* q = (u32x4*)p; const size_t n = bytes / 16;
    for (size_t i = (size_t)c.blk * NTHR + c.tid; i < n; i += (size_t)c.G * NTHR) q[i] = (u32x4){0u, 0u, 0u, 0u};
}
__device__ __forceinline__ void sincos_r(float x, float& s, float& co) {
    const float n = rintf(x * 0.15915494309189535f);
    float r = fmaf(n, -6.28125f, x); r = fmaf(n, -1.9353071795864769e-3f, r);
    s = __sinf(r); co = __cosf(r);
}

__device__ __forceinline__ void prologue_moe_weights(const Ctx& c, KParams p, int l) {
    bf16* WGU = (bf16*)(c.ws + WS_WMOE); bf16* WD = WGU + (size_t)NE * 512 * 1024;
    LAS float* scr = (LAS float*)(c.lds + c.wave * 8704);
    const int gw = c.blk * NWAVES + c.wave, NGW = c.G * NWAVES;
    for (int it = gw; it < NE * 384; it += NGW) {
        const int e = it / 384, r = it % 384;
        if (r < 256) { const int up = r >> 7, q = r & 127, kb = q >> 3, g = q & 7;
            const float* W = p->in[up ? I_MU : I_MG] + ((size_t)l * NE + e) * 1024 * 256;
            const int nd = up ? tr_dst<6>(32 * g) : tr_dst<5>(32 * g);
            tr_item(W, 256, kb * 64, 32 * g, WGU + (size_t)e * 512 * 1024 + (size_t)nd * 1024, 1024, nullptr, 1.f, scr, c.lane);
        } else { const int q = r - 256, kb = q >> 5, g = q & 31;
            const float* W = p->in[I_MD] + ((size_t)l * NE + e) * 256 * 1024;
            tr_item(W, 1024, kb * 64, 32 * g, WD + (size_t)e * 1024 * 256 + (size_t)(32 * g) * 256, 256, nullptr, 1.f, scr, c.lane);
        }
    }
}

__device__ __forceinline__ void prologue(const Ctx& c, KParams p) {
    float* MOD = (float*)(c.ws + WS_MOD);
    {
        const int u = c.G - 1 - c.blk;
        if (u < 24) {
            LAS float* sc = (LAS float*)(c.lds + 80 * 1024);
            const int l = u / 12, col = (u % 12) * 512 + c.tid;
            const float* W = p->in[I_ADAW] + (size_t)l * 1024 * 6144;
            float acc[33];
#pragma unroll
            for (int b = 0; b < 33; ++b) acc[b] = 0.f;
            for (int k0 = 0; k0 < 1024; k0 += 64) {
                __syncthreads();
                for (int i = c.tid; i < 33 * 64; i += NTHR) { const int b = i >> 6, kk = i & 63; const float v = b < 32 ? p->in[I_C][b * 1024 + k0 + kk] : p->in[I_CCTX][k0 + kk]; sc[i] = siluf_(v); }
                __syncthreads();
                for (int kk = 0; kk < 64; ++kk) { const float w = W[(size_t)(k0 + kk) * 6144 + col];
#pragma unroll
                    for (int b = 0; b < 33; ++b) acc[b] = fmaf(sc[b * 64 + kk], w, acc[b]); }
            }
            const float bias = p->in[I_ADAB][l * 6144 + col];
#pragma unroll
            for (int b = 0; b < 33; ++b) MOD[((size_t)l * 33 + b) * 6144 + col] = acc[b] + bias;
            __syncthreads();
        }
    }
    {
        float* ROPE = (float*)(c.ws + WS_TAB + TAB_ROPE);
        for (int i = c.blk * NTHR + c.tid; i < 2048 * 16; i += c.G * NTHR) { const int t = i >> 4, ax = (i >> 3) & 1, f = i & 7;
            const float pos = (float)(ax == 0 ? (t >> 6) : (t & 63)); const float inv = __expf(-(float)f * (9.210340371976184f / 8.0f));
            float s, co; sincos_r(pos * inv, s, co); ROPE[i * 2] = co; ROPE[i * 2 + 1] = s; }
        float* S5T = (float*)(c.ws + WS_TAB + TAB_S5);
        for (int i = c.blk * NTHR + c.tid; i < 2 * 2 * 16 * 64; i += c.G * NTHR) {
            const int pp = i & 63, g = (i >> 6) & 15, ld = i >> 10;
            const float lr = p->in[I_S5LR][i], li = p->in[I_S5LI][i], dt = __expf(p->in[I_S5DT][ld * 16 + g]);
            const float mag = __expf(lr * dt); float s, co; sincos_r(li * dt, s, co);
            const float are = mag * co, aim = mag * s, den = lr * lr + li * li;
            const float fre = ((are - 1.f) * lr + aim * li) / den, fim = (aim * lr - (are - 1.f) * li) / den;
            float* T = S5T + (size_t)i * 66; T[0] = are; T[1] = aim;
            for (int ch = 0; ch < 16; ++ch) { const float br = p->in[I_S5BR][(size_t)i * 16 + ch], bi = p->in[I_S5BI][(size_t)i * 16 + ch];
                T[2 + ch] = fre * br - fim * bi; T[18 + ch] = fre * bi + fim * br;
                T[34 + ch] = p->in[I_S5CR][((size_t)(ld * 16 + g) * 16 + ch) * 64 + pp]; T[50 + ch] = p->in[I_S5CI][((size_t)(ld * 16 + g) * 16 + ch) * 64 + pp]; }
        }
    }
    for (int l = 0; l < 2; ++l) {
        bf16* WIN = (bf16*)(c.ws + WS_WIN) + (size_t)l * 2048 * 1024;
        tr_matrix<1>(c, p->in[I_WIN] + (size_t)l * 1024 * 1984, 1984, 1024, 1984, WIN, 1024, nullptr, 1.f);
        zero_fill16(c, WIN + (size_t)1984 * 1024, (size_t)64 * 1024 * 2);
        tr_matrix<0>(c, p->in[I_WOUT] + (size_t)l * 1024 * 1024, 1024, 1024, 1024, (bf16*)(c.ws + WS_WOUT) + (size_t)l * 1024 * 1024, 1024, nullptr, 1.f);
        unsigned char* sm = c.ws + WS_WSM + (size_t)l * WSM_L;
        tr_matrix<0>(c, p->in[I_CPW] + (size_t)l * 256 * 256, 256, 256, 256, (bf16*)(sm + WSM_PW), 256, nullptr, 1.f);
        tr_matrix<2>(c, p->in[I_S5GW] + (size_t)l * 256 * 512, 512, 256, 512, (bf16*)(sm + WSM_GLU), 256, nullptr, 1.f);
        tr_matrix<3>(c, p->in[I_WUQ] + (size_t)l * 256 * 384, 384, 256, 384, (bf16*)(sm + WSM_UQ), 256, p->in[I_QNG] + l * 256, 0.10206207261596577f);
        zero_fill16(c, (bf16*)(sm + WSM_UQ) + (size_t)384 * 256, (size_t)128 * 256 * 2);
        zero_fill16(c, sm + WSM_UK, (size_t)512 * 256 * 2);
    }
    for (int l = 0; l < 2; ++l) {
        bf16* WSGU = (bf16*)(c.ws + WS_WSH) + (size_t)l * (512 * 1024 + 1024 * 256); bf16* WSD = WSGU + 512 * 1024;
        tr_matrix<5>(c, p->in[I_SG] + (size_t)l * 1024 * 256, 256, 1024, 256, WSGU, 1024, nullptr, 1.f);
        tr_matrix<6>(c, p->in[I_SU] + (size_t)l * 1024 * 256, 256, 1024, 256, WSGU, 1024, nullptr, 1.f);
        tr_matrix<0>(c, p->in[I_SD] + (size_t)l * 256 * 1024, 1024, 256, 1024, WSD, 256, nullptr, 1.f);
    }
    prologue_moe_weights(c, p, 0);
}
__device__ __forceinline__ void prologue2(const Ctx& c, KParams p) {
    for (int l = 0; l < 2; ++l) { unsigned char* sm = c.ws + WS_WSM + (size_t)l * WSM_L;
        tr_matrix<4>(c, p->in[I_WUKV] + (size_t)l * 128 * 512, 512, 128, 512, (bf16*)(sm + WSM_UK), 256, p->in[I_KVNG] + l * 128, 1.f); }
}

__device__ __forceinline__ void norm_row(const float* xrow, const float* gain, const float* sh, const float* sc, bf16* orow, int lane, f32x4 (&v)[4]) {
    float ss = 0.f;
#pragma unroll
    for (int j = 0; j < 4; ++j) { v[j] = *(const f32x4*)(xrow + 4 * lane + 256 * j); ss += (v[j].x * v[j].x + v[j].y * v[j].y) + (v[j].z * v[j].z + v[j].w * v[j].w); }
    const float rstd = rsqrtf(wave_sum(ss) * (1.f / 1024.f) + EPS);
#pragma unroll
    for (int j = 0; j < 4; ++j) { const int cc = 4 * lane + 256 * j; const f32x4 g = *(const f32x4*)(gain + cc), s1 = *(const f32x4*)(sc + cc), s0 = *(const f32x4*)(sh + cc);
        v[j] = v[j] * rstd * g * (s1 + 1.0f) + s0;
        u32x2 o; o.x = pk2(v[j].x, v[j].y); o.y = pk2(v[j].z, v[j].w); *(u32x2*)(orow + cc) = o; }
}
__device__ __forceinline__ void phase_norm1(const Ctx& c, KParams p, int l) {
    const float* MOD = (const float*)(c.ws + WS_MOD) + (size_t)l * 33 * 6144;
    const float* xl = l == 0 ? p->in[I_X] : p->out; const float* xc = l == 0 ? p->in[I_CTX] : (const float*)(c.ws + WS_XC);
    bf16* H = (bf16*)(c.ws + WS_H);
    const int gw = c.blk * NWAVES + c.wave, NGW = c.G * NWAVES;
    for (int r = gw; r < NTOK; r += NGW) { const float* xr = r < NLAT ? xl + (size_t)r * DM : xc + (size_t)(r - NLAT) * DM; const float* m = MOD + (size_t)mod_row(r) * 6144;
        f32x4 v[4]; norm_row(xr, p->in[I_N1G] + l * DM, m, m + 1024, H + (size_t)r * DM, c.lane, v); }
}

#define EPI_ARGS const f32x4 (&acc)[2][2][4][2], const pg8::Unit& u, int wr, int wc, int fr, int fq
#define EPI_ROWS for (int ai = 0; ai < 2; ++ai) _Pragma("unroll") for (int m = 0; m < 4; ++m)
struct EpiBf16 {
    bf16* O; int ldo;
    __device__ __forceinline__ void operator()(EPI_ARGS) const {
        const int r0 = u.pm * 256 + wr * 64 + fr, c0 = u.pn * 256 + wc * 32 + 8 * fq;
#pragma unroll
        EPI_ROWS { bf16* rp = O + (size_t)(r0 + ai * 128 + m * 16) * ldo + c0;
#pragma unroll
            for (int bj = 0; bj < 2; ++bj) { const f32x4 a = acc[ai][bj][m][0], b = acc[ai][bj][m][1]; u32x4 w; w.x = pk2(a.x, a.y); w.y = pk2(a.z, a.w); w.z = pk2(b.x, b.y); w.w = pk2(b.z, b.w); *(u32x4*)(rp + bj * 128) = w; } asm volatile("" ::: "memory"); }
    }
};
struct EpiBiasBf16 {
    bf16* O; int ldo; const float* bias;
    __device__ __forceinline__ void operator()(EPI_ARGS) const {
        const int r0 = u.pm * 256 + wr * 64 + fr, c0 = u.pn * 256 + wc * 32 + 8 * fq;
        f32x4 bv[2][2];
#pragma unroll
        for (int bj = 0; bj < 2; ++bj) { bv[bj][0] = *(const f32x4*)(bias + c0 + bj * 128); bv[bj][1] = *(const f32x4*)(bias + c0 + bj * 128 + 4); }
#pragma unroll
        EPI_ROWS { bf16* rp = O + (size_t)(r0 + ai * 128 + m * 16) * ldo + c0;
#pragma unroll
            for (int bj = 0; bj < 2; ++bj) { const f32x4 a = acc[ai][bj][m][0] + bv[bj][0], b = acc[ai][bj][m][1] + bv[bj][1]; u32x4 w; w.x = pk2(a.x, a.y); w.y = pk2(a.z, a.w); w.z = pk2(b.x, b.y); w.w = pk2(b.z, b.w); *(u32x4*)(rp + bj * 128) = w; } asm volatile("" ::: "memory"); }
    }
};
struct EpiGluSig {
    bf16* O; int ldo; const float* bias;
    __device__ __forceinline__ void operator()(EPI_ARGS) const {
        const int r0 = u.pm * 256 + wr * 64 + fr, c0 = u.pn * 128 + wc * 32 + 8 * fq;
        f32x4 b1[2], b2[2];
#pragma unroll
        for (int n = 0; n < 2; ++n) { b1[n] = *(const f32x4*)(bias + c0 + 4 * n); b2[n] = *(const f32x4*)(bias + 256 + c0 + 4 * n); }
#pragma unroll
        EPI_ROWS { bf16* rp = O + (size_t)(r0 + ai * 128 + m * 16) * ldo + c0; float o[8];
#pragma unroll
            for (int n = 0; n < 2; ++n)
#pragma unroll
                for (int i = 0; i < 4; ++i) o[4 * n + i] = (acc[ai][0][m][n][i] + b1[n][i]) * sigmoidf_(acc[ai][1][m][n][i] + b2[n][i]);
            u32x4 w; w.x = pk2(o[0], o[1]); w.y = pk2(o[2], o[3]); w.z = pk2(o[4], o[5]); w.w = pk2(o[6], o[7]); *(u32x4*)rp = w; asm volatile("" ::: "memory"); }
    }
};
struct EpiSwiglu {
    bf16* O; int ldo;
    __device__ __forceinline__ void operator()(EPI_ARGS) const {
        const int r0 = u.pm * 256 + wr * 64 + fr, c0 = u.pn * 128 + wc * 32 + 8 * fq;
#pragma unroll
        EPI_ROWS { bf16* rp = O + (size_t)(r0 + ai * 128 + m * 16) * ldo + c0; float o[8];
#pragma unroll
            for (int n = 0; n < 2; ++n)
#pragma unroll
                for (int i = 0; i < 4; ++i) o[4 * n + i] = siluf_(acc[ai][0][m][n][i]) * acc[ai][1][m][n][i];
            u32x4 w; w.x = pk2(o[0], o[1]); w.y = pk2(o[2], o[3]); w.z = pk2(o[4], o[5]); w.w = pk2(o[6], o[7]); *(u32x4*)rp = w; asm volatile("" ::: "memory"); }
    }
};
struct EpiQ {
    bf16* Q; const float* RS; const float* ROPE;
    __device__ __forceinline__ void operator()(EPI_ARGS) const {
        const int r0 = u.pm * 256 + wr * 64 + fr;
#pragma unroll
        EPI_ROWS { const int row = r0 + ai * 128 + m * 16; const float rq = RS[(size_t)row * 2]; bf16* rp = Q + (size_t)row * 384;
            if (u.pn == 0) {
#pragma unroll
                for (int bj = 0; bj < 2; ++bj) { const int head = 2 * bj + (wc >> 1), d = 32 * (wc & 1) + 8 * fq; const f32x4 a = acc[ai][bj][m][0] * rq, b = acc[ai][bj][m][1] * rq;
                    u32x4 w; w.x = pk2(a.x, a.y); w.y = pk2(a.z, a.w); w.z = pk2(b.x, b.y); w.w = pk2(b.z, b.w); *(u32x4*)(rp + head * 96 + d) = w; }
            } else {
                float o[8];
#pragma unroll
                for (int n = 0; n < 2; ++n)
#pragma unroll
                    for (int i = 0; i < 4; ++i) { const float v = acc[ai][0][m][n][i] * rq; const float pv = shx<16>(v); float res = v;
                        if (row < NLAT) { const int t = row & 2047; const f32x2 cs = *(const f32x2*)(ROPE + ((t * 2 + (fq >> 1)) * 8 + 4 * n + i) * 2); res = (fq & 1) ? fmaf(v, cs.x, pv * cs.y) : fmaf(v, cs.x, -pv * cs.y); }
                        o[4 * n + i] = res; }
                u32x4 w; w.x = pk2(o[0], o[1]); w.y = pk2(o[2], o[3]); w.z = pk2(o[4], o[5]); w.w = pk2(o[6], o[7]); *(u32x4*)(rp + wc * 96 + 64 + 8 * fq) = w;
            } asm volatile("" ::: "memory"); }
    }
};
struct EpiKV {
    bf16* Kb; bf16* Vb; const float* RS;
    __device__ __forceinline__ void operator()(EPI_ARGS) const {
        const int r0 = u.pm * 256 + wr * 64 + fr;
#pragma unroll
        EPI_ROWS { const int row = r0 + ai * 128 + m * 16; const float rk = RS[(size_t)row * 2 + 1];
#pragma unroll
            for (int bj = 0; bj < 2; ++bj) { const int head = 2 * bj + (wc >> 1), d = 32 * (wc & 1) + 8 * fq; const f32x4 a = acc[ai][bj][m][0] * rk, b = acc[ai][bj][m][1] * rk;
                u32x4 w; w.x = pk2(a.x, a.y); w.y = pk2(a.z, a.w); w.z = pk2(b.x, b.y); w.w = pk2(b.z, b.w);
                bf16* dst = u.pn == 0 ? Kb + (size_t)row * 384 + head * 96 + d : Vb + (size_t)row * 256 + head * 64 + d; *(u32x4*)dst = w; } asm volatile("" ::: "memory"); }
    }
};
struct EpiResid {
    const float* xl_in; const float* xc_in; float* xl_out; float* xc_out; const float* MODg;
    __device__ __forceinline__ void operator()(EPI_ARGS) const {
        const int rt = u.pm * 256; const bool lat = rt < NLAT;
        const float* g = MODg + (size_t)(lat ? (rt >> 11) : 32) * 6144;
        const float* xi = lat ? xl_in + (size_t)rt * DM : xc_in + (size_t)(rt - NLAT) * DM; float* xo = lat ? xl_out + (size_t)rt * DM : xc_out + (size_t)(rt - NLAT) * DM;
        const int r0 = wr * 64 + fr, c0 = u.pn * 256 + wc * 32 + 8 * fq;
        f32x4 gv[2][2];
#pragma unroll
        for (int bj = 0; bj < 2; ++bj) { gv[bj][0] = *(const f32x4*)(g + c0 + bj * 128); gv[bj][1] = *(const f32x4*)(g + c0 + bj * 128 + 4); }
#pragma unroll
        EPI_ROWS { const size_t o = (size_t)(r0 + ai * 128 + m * 16) * DM + c0;
#pragma unroll
            for (int bj = 0; bj < 2; ++bj)
#pragma unroll
                for (int n = 0; n < 2; ++n) { const f32x4 xv = *(const f32x4*)(xi + o + bj * 128 + 4 * n); *(f32x4*)(xo + o + bj * 128 + 4 * n) = xv + gv[bj][n] * acc[ai][bj][m][n]; } asm volatile("" ::: "memory"); }
    }
};

__device__ __forceinline__ int seq_row(int b, int dir, int pos) {
    if (pos < CTXL) return NLAT + b * CTXL + (dir ? CTXL - 1 - pos : pos);
    const int t = pos - CTXL; return b * SEQ + (dir ? SEQ - 1 - t : t);
}
__device__ __forceinline__ void phase_gla_scan(const Ctx& c, KParams p, int l) {
    if (c.wave != 0) return;
    const bf16* Z = (const bf16*)(c.ws + WS_Z); float* OG = (float*)(c.ws + WS_T1);
    LAS float* qs = (LAS float*)c.lds; LAS float* ks = qs + 2048; LAS float* as = ks + 2048;
    for (int u = c.blk; u < 256; u += c.G) {
        const int b = u >> 3, h = (u >> 1) & 3, dir = u & 1;
        const float* wa = p->in[I_GLAW] + ((size_t)(l * 2 + dir) * 16) * 128 + h * 32; const float* ba = p->in[I_GLAB] + (l * 2 + dir) * 128 + h * 32;
        float S[32];
#pragma unroll
        for (int d = 0; d < 32; ++d) S[d] = 0.f;
        for (int ci = 0; ci < 36; ++ci) {
            for (int idx = c.lane; idx < 2048; idx += 64) { const int i = idx >> 5, d = idx & 31; const bf16* zr = Z + (size_t)seq_row(b, dir, ci * 64 + i) * ZW;
                qs[idx] = bf2f(zr[ZQ + h * 32 + d]) * 0.17677669529663687f; ks[idx] = bf2f(zr[ZK + h * 32 + d]);
                float za = ba[d];
#pragma unroll
                for (int j = 0; j < 16; ++j) za = fmaf(bf2f(zr[ZAF + dir * 16 + j]), wa[j * 128 + d], za);
                const float ls = fminf(za, 0.f) - log1pf(__expf(-fabsf(za)));
                as[idx] = __expf(ls * 0.0625f); }
            lds_wait();
            for (int i = 0; i < 64; ++i) { const int r = seq_row(b, dir, ci * 64 + i); const float v = bf2f(Z[(size_t)r * ZW + ZV + h * 64 + c.lane]); float o = 0.f;
#pragma unroll
                for (int d4 = 0; d4 < 8; ++d4) { const f32x4 a4 = *(const LAS f32x4*)(as + i * 32 + 4 * d4), k4 = *(const LAS f32x4*)(ks + i * 32 + 4 * d4), q4 = *(const LAS f32x4*)(qs + i * 32 + 4 * d4);
#pragma unroll
                    for (int j = 0; j < 4; ++j) { S[4 * d4 + j] = fmaf(a4[j], S[4 * d4 + j], k4[j] * v); o = fmaf(q4[j], S[4 * d4 + j], o); } }
                OG[((size_t)dir * NTOK + r) * 256 + h * 64 + c.lane] = o; }
            lds_wait();
        }
    }
}
__device__ __forceinline__ void phase_gla_final(const Ctx& c, KParams p, int l, int nrows) {
    const bf16* Z = (const bf16*)(c.ws + WS_Z); const float* OG = (const float*)(c.ws + WS_T1); bf16* MIX = (bf16*)(c.ws + WS_MIX);
    const int gw = c.blk * NWAVES + c.wave, NGW = c.G * NWAVES; const f32x4 g = *(const f32x4*)(p->in[I_GLAG] + l * 256 + 4 * c.lane);
    for (int r = gw; r < nrows; r += NGW) {
        f32x4 o = *(const f32x4*)(OG + (size_t)r * 256 + 4 * c.lane) + *(const f32x4*)(OG + ((size_t)NTOK + r) * 256 + 4 * c.lane);
        float ss = (o.x * o.x + o.y * o.y) + (o.z * o.z + o.w * o.w);
        ss += shx<1>(ss); ss += shx<2>(ss); ss += shx<4>(ss); ss += shx<8>(ss);
        const float rstd = rsqrtf(ss * (1.f / 64.f) + EPS);
        const u32x2 rg = *(const u32x2*)(Z + (size_t)r * ZW + ZR + 4 * c.lane);
        const float g0 = __uint_as_float(rg.x << 16), g1 = __uint_as_float(rg.x & 0xffff0000u), g2 = __uint_as_float(rg.y << 16), g3 = __uint_as_float(rg.y & 0xffff0000u);
        u32x2 w; w.x = pk2(o.x * rstd * g.x * siluf_(g0), o.y * rstd * g.y * siluf_(g1)); w.y = pk2(o.z * rstd * g.z * siluf_(g2), o.w * rstd * g.w * siluf_(g3));
        *(u32x2*)(MIX + (size_t)r * DM + 4 * c.lane) = w;
    }
}

__device__ __forceinline__ void phase_conv1(const Ctx& c, KParams p, int l, bool with_ctx) {
    const bf16* Z = (const bf16*)(c.ws + WS_Z); bf16* CV = (bf16*)(c.ws + WS_CV);
    LAS float* glu = (LAS float*)c.lds;
    LAS float* dws = glu + 62 * 256;
    for (int i = c.tid; i < 31 * 256; i += NTHR) dws[i] = p->in[I_CDW][(size_t)l * 31 * 256 + i];
    const int ntiles = with_ctx ? 2048 + 256 : 2048;
    const f32x4 dwb = *(const f32x4*)(p->in[I_CDB] + l * 256 + 4 * c.lane), lg = *(const f32x4*)(p->in[I_CLG] + l * 256 + 4 * c.lane), lb = *(const f32x4*)(p->in[I_CLB] + l * 256 + 4 * c.lane);
    for (int tile = c.blk; tile < ntiles; tile += c.G) {
        int rowbase, t0, slen;
        if (tile < 2048) { const int b = tile >> 6; rowbase = b * SEQ; t0 = (tile & 63) * 32; slen = SEQ; } else { const int q = tile - 2048, b = q >> 3; rowbase = NLAT + b * CTXL; t0 = (q & 7) * 32; slen = CTXL; }
        __syncthreads();
        for (int idx = c.tid; idx < 62 * 64; idx += NTHR) { const int j = idx >> 6, c4 = (idx & 63) * 4, t = t0 - 15 + j; f32x4 v = (f32x4){0.f, 0.f, 0.f, 0.f};
            if (t >= 0 && t < slen) { const bf16* zr = Z + (size_t)(rowbase + t) * ZW; const u32x2 a = *(const u32x2*)(zr + ZCA + c4), g = *(const u32x2*)(zr + ZCG + c4);
                v.x = __uint_as_float(a.x << 16) * sigmoidf_(__uint_as_float(g.x << 16)); v.y = __uint_as_float(a.x & 0xffff0000u) * sigmoidf_(__uint_as_float(g.x & 0xffff0000u));
                v.z = __uint_as_float(a.y << 16) * sigmoidf_(__uint_as_float(g.y << 16)); v.w = __uint_as_float(a.y & 0xffff0000u) * sigmoidf_(__uint_as_float(g.y & 0xffff0000u)); }
            *(LAS f32x4*)(glu + j * 256 + c4) = v; }
        __syncthreads();
        for (int q = 0; q < 4; ++q) { const int i = c.wave * 4 + q; f32x4 a = dwb;
            for (int j = 0; j < 31; ++j) a += *(const LAS f32x4*)(glu + (i + j) * 256 + 4 * c.lane) * *(const LAS f32x4*)(dws + j * 256 + 4 * c.lane);
            const float mu = wave_sum((a.x + a.y) + (a.z + a.w)) * (1.f / 256.f); const f32x4 dlt = a - mu;
            const float var = wave_sum((dlt.x * dlt.x + dlt.y * dlt.y) + (dlt.z * dlt.z + dlt.w * dlt.w)) * (1.f / 256.f); const float rstd = rsqrtf(var + EPS);
            const f32x4 y = dlt * rstd * lg + lb;
            u32x2 w; w.x = pk2(siluf_(y.x), siluf_(y.y)); w.y = pk2(siluf_(y.z), siluf_(y.w));
            *(u32x2*)(CV + (size_t)(rowbase + t0 + i) * 256 + 4 * c.lane) = w; }
    }
    __syncthreads();
}

__device__ __forceinline__ void phase_s5_scan(const Ctx& c, KParams p, int l) {
    if (c.wave >= 4) return;
    const bf16* Z = (const bf16*)(c.ws + WS_Z); float* YT = (float*)(c.ws + WS_T1); const float* S5T = (const float*)(c.ws + WS_TAB + TAB_S5);
    LAS float* base = (LAS float*)(c.lds + c.wave * 24576);
    LAS float* us = base;
    LAS float* hre = base + 1024;
    LAS float* him = hre + 16 * 65;
    LAS float* cre = him + 16 * 65;
    LAS float* cim = cre + 1024;
    const int lane = c.lane;
    for (int u = c.wave * c.G + c.blk; u < 1024; u += 4 * c.G) {
        const int b = u >> 5, dir = (u >> 4) & 1, g = u & 15;
        const float* T = S5T + ((size_t)((l * 2 + dir) * 16 + g) * 64 + lane) * 66;
        const float are = T[0], aim = T[1]; float bre[16], bim[16];
#pragma unroll
        for (int ch = 0; ch < 16; ++ch) { bre[ch] = T[2 + ch]; bim[ch] = T[18 + ch]; cre[lane * 16 + ch] = T[34 + ch]; cim[lane * 16 + ch] = T[50 + ch]; }
        float hr = 0.f, hi = 0.f;
        for (int ci = 0; ci < 36; ++ci) {
            for (int idx = lane; idx < 1024; idx += 64) { const int i = idx >> 4, ch = idx & 15; us[idx] = bf2f(Z[(size_t)seq_row(b, dir, ci * 64 + i) * ZW + ZS5 + g * 16 + ch]); }
            lds_wait();
            for (int sc = 0; sc < 4; ++sc) {
                for (int i = 0; i < 16; ++i) { float br = 0.f, bi = 0.f;
#pragma unroll
                    for (int c4 = 0; c4 < 4; ++c4) { const f32x4 uv = *(const LAS f32x4*)(us + (sc * 16 + i) * 16 + 4 * c4);
#pragma unroll
                        for (int j = 0; j < 4; ++j) { br = fmaf(bre[4 * c4 + j], uv[j], br); bi = fmaf(bim[4 * c4 + j], uv[j], bi); } }
                    const float nr = are * hr - aim * hi + br, ni = are * hi + aim * hr + bi; hr = nr; hi = ni;
                    hre[i * 65 + lane] = hr; him[i * 65 + lane] = hi; }
                lds_wait();
                const int tt = lane >> 4, ch = lane & 15; float y[4] = {0.f, 0.f, 0.f, 0.f};
                for (int pp = 0; pp < 64; ++pp) { const float cr = cre[pp * 16 + ch], cm = cim[pp * 16 + ch];
#pragma unroll
                    for (int q = 0; q < 4; ++q) y[q] = fmaf(cr, hre[(tt * 4 + q) * 65 + pp], fmaf(-cm, him[(tt * 4 + q) * 65 + pp], y[q])); }
#pragma unroll
                for (int q = 0; q < 4; ++q) { const int r = seq_row(b, dir, ci * 64 + sc * 16 + tt * 4 + q); YT[((size_t)dir * NTOK + r) * 256 + g * 16 + ch] = y[q]; }
                lds_wait();
            }
        }
    }
}
__device__ __forceinline__ void phase_s5_final(const Ctx& c, KParams p, int l, int nrows) {
    const bf16* Z = (const bf16*)(c.ws + WS_Z); const float* YT = (const float*)(c.ws + WS_T1); bf16* Y5 = (bf16*)(c.ws + WS_Y5);
    const size_t n4 = (size_t)nrows * 64;
    for (size_t i = (size_t)c.blk * NTHR + c.tid; i < n4; i += (size_t)c.G * NTHR) { const size_t r = i >> 6; const int c4 = (int)(i & 63) * 4;
        const f32x4 d = *(const f32x4*)(p->in[I_S5D] + l * 256 + c4); const u32x2 uu = *(const u32x2*)(Z + r * ZW + ZS5 + c4);
        const f32x4 uv = (f32x4){__uint_as_float(uu.x << 16), __uint_as_float(uu.x & 0xffff0000u), __uint_as_float(uu.y << 16), __uint_as_float(uu.y & 0xffff0000u)};
        const f32x4 y = d * uv + *(const f32x4*)(YT + r * 256 + c4) + *(const f32x4*)(YT + ((size_t)NTOK + r) * 256 + c4);
        u32x2 w; w.x = pk2(y.x, y.y); w.y = pk2(y.z, y.w); *(u32x2*)(Y5 + r * 256 + c4) = w; }
}

__device__ __forceinline__ void phase_mla_prep(const Ctx& c, KParams p) {
    const bf16* Z = (const bf16*)(c.ws + WS_Z); float* RS = (float*)(c.ws + WS_RS); bf16* Kb = (bf16*)(c.ws + WS_H) + (size_t)NTOK * 384; const float* ROPE = (const float*)(c.ws + WS_TAB + TAB_ROPE);
    const int gw = c.blk * NWAVES + c.wave, NGW = c.G * NWAVES, lane = c.lane;
    for (int r = gw; r < NTOK; r += NGW) { const bf16* zr = Z + (size_t)r * ZW;
        const u32x2 q4 = *(const u32x2*)(zr + ZCQ + 4 * lane); const unsigned k2 = *(const unsigned*)(zr + ZCKV + 2 * lane);
        const float a0 = __uint_as_float(q4.x << 16), a1 = __uint_as_float(q4.x & 0xffff0000u), a2 = __uint_as_float(q4.y << 16), a3 = __uint_as_float(q4.y & 0xffff0000u);
        const float b0 = __uint_as_float(k2 << 16), b1 = __uint_as_float(k2 & 0xffff0000u);
        const float sq = wave_sum((a0 * a0 + a1 * a1) + (a2 * a2 + a3 * a3)), sk = wave_sum(b0 * b0 + b1 * b1);
        if (lane == 0) { RS[(size_t)r * 2] = rsqrtf(sq * (1.f / 256.f) + EPS); RS[(size_t)r * 2 + 1] = rsqrtf(sk * (1.f / 128.f) + EPS); }
        const int d = lane & 31; const float x = bf2f(zr[ZKR + d]); const float px = shx<8>(x); float o = x;
        if (r < NLAT) { const int t = r & 2047, ax = d >> 4, f = d & 7; const f32x2 cs = *(const f32x2*)(ROPE + ((t * 2 + ax) * 8 + f) * 2); o = (d & 8) ? fmaf(x, cs.x, px * cs.y) : fmaf(x, cs.x, -px * cs.y); }
        const bf16 ob = f2bf(o); bf16* kr = Kb + (size_t)r * 384 + 64 + d;
        if (lane < 32) { kr[0] = ob; kr[96] = ob; kr[192] = ob; kr[288] = ob; }
    }
}
__device__ __forceinline__ void phase_attn_naive(const Ctx& c, bool with_ctx) {
    const bf16* Qb = (const bf16*)(c.ws + WS_H); const bf16* Kb = Qb + (size_t)NTOK * 384; const bf16* Vb = Kb + (size_t)NTOK * 384; bf16* MIX = (bf16*)(c.ws + WS_MIX);
    LAS float* Ks = (LAS float*)c.lds;
    LAS float* Vs = Ks + 32 * 96;
    const int nunits = with_ctx ? 512 + 128 : 512;
    for (int u = c.blk; u < nunits; u += c.G) {
        int b, h, qrow, nkt; bool active = true;
        if (u < 512) { b = u >> 4; h = (u >> 2) & 3; qrow = b * SEQ + (u & 3) * 512 + c.tid; nkt = 72; }
        else { const int q = u - 512; b = q >> 2; h = q & 3; qrow = NLAT + b * CTXL + (c.tid & 255); nkt = 8; active = c.tid < 256; }
        float q[96], o[64];
#pragma unroll
        for (int d8 = 0; d8 < 12; ++d8) { const u32x4 w = *(const u32x4*)(Qb + (size_t)qrow * 384 + h * 96 + 8 * d8); float t8[8]; unpack8(w, t8);
#pragma unroll
            for (int j = 0; j < 8; ++j) q[8 * d8 + j] = t8[j]; }
#pragma unroll
        for (int d = 0; d < 64; ++d) o[d] = 0.f;
        float mx = -1e30f, lsum = 0.f;
        for (int kt = 0; kt < nkt; ++kt) {
            const int krow0 = (u < 512) ? (kt < 64 ? b * SEQ + kt * 32 : NLAT + b * CTXL + (kt - 64) * 32) : NLAT + b * CTXL + kt * 32;
            __syncthreads();
            for (int idx = c.tid; idx < 32 * 12; idx += NTHR) { const int j = idx / 12, d8 = idx % 12; const u32x4 w = *(const u32x4*)(Kb + (size_t)(krow0 + j) * 384 + h * 96 + 8 * d8); float t8[8]; unpack8(w, t8);
                *(LAS f32x4*)(Ks + j * 96 + 8 * d8) = (f32x4){t8[0], t8[1], t8[2], t8[3]}; *(LAS f32x4*)(Ks + j * 96 + 8 * d8 + 4) = (f32x4){t8[4], t8[5], t8[6], t8[7]}; }
            for (int idx = c.tid; idx < 32 * 8; idx += NTHR) { const int j = idx >> 3, d8 = idx & 7; const u32x4 w = *(const u32x4*)(Vb + (size_t)(krow0 + j) * 256 + h * 64 + 8 * d8); float t8[8]; unpack8(w, t8);
                *(LAS f32x4*)(Vs + j * 64 + 8 * d8) = (f32x4){t8[0], t8[1], t8[2], t8[3]}; *(LAS f32x4*)(Vs + j * 64 + 8 * d8 + 4) = (f32x4){t8[4], t8[5], t8[6], t8[7]}; }
            __syncthreads();
            for (int j = 0; j < 32; ++j) { float s = 0.f;
#pragma unroll
                for (int d4 = 0; d4 < 24; ++d4) { const f32x4 kv = *(const LAS f32x4*)(Ks + j * 96 + 4 * d4); s = fmaf(q[4 * d4], kv.x, s); s = fmaf(q[4 * d4 + 1], kv.y, s); s = fmaf(q[4 * d4 + 2], kv.z, s); s = fmaf(q[4 * d4 + 3], kv.w, s); }
                if (s > mx) { const float sc = __expf(mx - s); lsum *= sc;
#pragma unroll
                    for (int d = 0; d < 64; ++d) o[d] *= sc;
                    mx = s; }
                const float pr = __expf(s - mx); lsum += pr;
#pragma unroll
                for (int d4 = 0; d4 < 16; ++d4) { const f32x4 vv = *(const LAS f32x4*)(Vs + j * 64 + 4 * d4); o[4 * d4] = fmaf(pr, vv.x, o[4 * d4]); o[4 * d4 + 1] = fmaf(pr, vv.y, o[4 * d4 + 1]); o[4 * d4 + 2] = fmaf(pr, vv.z, o[4 * d4 + 2]); o[4 * d4 + 3] = fmaf(pr, vv.w, o[4 * d4 + 3]); }
            }
        }
        if (active) { const float inv = 1.f / lsum; bf16* dst = MIX + (size_t)qrow * DM + 768 + h * 64;
#pragma unroll
            for (int d8 = 0; d8 < 8; ++d8) { u32x4 w; w.x = pk2(o[8 * d8] * inv, o[8 * d8 + 1] * inv); w.y = pk2(o[8 * d8 + 2] * inv, o[8 * d8 + 3] * inv); w.z = pk2(o[8 * d8 + 4] * inv, o[8 * d8 + 5] * inv); w.w = pk2(o[8 * d8 + 6] * inv, o[8 * d8 + 7] * inv);
                *(u32x4*)(dst + 8 * d8) = w; } }
    }
    __syncthreads();
}

__device__ __forceinline__ void phase_norm2_route(const Ctx& c, KParams p, int l, int ntok) {
    const float* MOD = (const float*)(c.ws + WS_MOD) + (size_t)l * 33 * 6144;
    const float* xl = p->out; const float* xc = (const float*)(c.ws + WS_XC);
    bf16* H = (bf16*)(c.ws + WS_H);
    int* TKEP = (int*)(c.ws + WS_RT + RT_TKEP); float* TKW = (float*)(c.ws + WS_RT + RT_TKW); int* TB = (int*)(c.ws + WS_TB);
    int* CNT = (int*)(c.ws + WS_CTL) + CW_CNT + l * NCH * NE;
    LAS float* hs = (LAS float*)c.lds;
    LAS int* hist = (LAS int*)(c.lds + 131072);
    const float* RWt = p->in[I_RW] + (size_t)l * 1024 * 64; const float rbias = p->in[I_RB][l * 64 + c.lane];
    const int ntiles = ntok / 32, rpc = ntok / NCH, lane = c.lane;
    for (int tile = c.blk; tile < ntiles; tile += c.G) {
        __syncthreads();
        if (c.tid < 64) hist[c.tid] = 0;
        for (int q = 0; q < 4; ++q) { const int r = tile * 32 + c.wave * 4 + q; const float* xr = r < NLAT ? xl + (size_t)r * DM : xc + (size_t)(r - NLAT) * DM; const float* m = MOD + (size_t)mod_row(r) * 6144;
            f32x4 v[4]; norm_row(xr, p->in[I_N2G] + l * DM, m + 3072, m + 4096, H + (size_t)r * DM, lane, v);
#pragma unroll
            for (int j = 0; j < 4; ++j) *(LAS f32x4*)(hs + (c.wave * 4 + q) * 1024 + 4 * lane + 256 * j) = v[j]; }
        __syncthreads();
        float lg[4] = {0.f, 0.f, 0.f, 0.f};
        for (int k = 0; k < 1024; k += 4) { const float w0 = RWt[(k + 0) * 64 + lane], w1 = RWt[(k + 1) * 64 + lane], w2 = RWt[(k + 2) * 64 + lane], w3 = RWt[(k + 3) * 64 + lane];
#pragma unroll
            for (int q = 0; q < 4; ++q) { const f32x4 hv = *(const LAS f32x4*)(hs + (c.wave * 4 + q) * 1024 + k); lg[q] = fmaf(hv.x, w0, lg[q]); lg[q] = fmaf(hv.y, w1, lg[q]); lg[q] = fmaf(hv.z, w2, lg[q]); lg[q] = fmaf(hv.w, w3, lg[q]); } }
#pragma unroll
        for (int q = 0; q < 4; ++q) {
            const int r = tile * 32 + c.wave * 4 + q;
            const float s = sigmoidf_(lg[q]), bs = s + rbias;
            float m1 = bs; m1 = fmaxf(m1, shx<1>(m1)); m1 = fmaxf(m1, shx<2>(m1)); m1 = fmaxf(m1, shx<4>(m1));
            const unsigned long long eq = __ballot(bs == m1); const unsigned gm = (unsigned)(eq >> (lane & 56)) & 0xffu; const int first = __ffs(gm) - 1;
            float m2 = ((lane & 7) == first) ? -1e30f : bs; m2 = fmaxf(m2, shx<1>(m2)); m2 = fmaxf(m2, shx<2>(m2)); m2 = fmaxf(m2, shx<4>(m2));
            const float gs = m1 + m2; const int g = lane >> 3; int rank = 0;
#pragma unroll
            for (int j = 0; j < 8; ++j) { const float o = rdl(gs, 8 * j); rank += (o > gs || (o == gs && j < g)) ? 1 : 0; }
            float cand = rank < 4 ? bs : -1e30f; int my_e = 0; float my_w = 0.f, wsum = 0.f;
#pragma unroll
            for (int k = 0; k < 8; ++k) { const float mm = wave_max(cand); const unsigned long long e2 = __ballot(cand == mm); const int idx = __ffsll((long long)e2) - 1; const float wk = rdl(s, idx);
                if (lane == idx) cand = -1e30f; if (lane == k) { my_e = idx; my_w = wk; } wsum += wk; }
            if (lane < 8) { const int lp = atomicAdd((int*)&hist[my_e], 1); TKEP[(size_t)r * 8 + lane] = my_e | (lp << 8); TKW[(size_t)r * 8 + lane] = my_w / wsum * 2.5f; }
        }
        __syncthreads();
        if (c.tid < 64) { const int n = hist[c.tid]; int base = 0; if (n > 0) base = atomicAdd(&CNT[((tile * 32) / rpc) * NE + c.tid], n); TB[tile * 64 + c.tid] = base; }
    }
    __syncthreads();
}
__device__ __forceinline__ void phase_route_fill(const Ctx& c, int l, int ntok) {
    const int* TKEP = (const int*)(c.ws + WS_RT + RT_TKEP); int* SLOT = (int*)(c.ws + WS_RT + RT_SLOT); const int* TB = (const int*)(c.ws + WS_TB);
    const int* CNT = (const int*)(c.ws + WS_CTL) + CW_CNT + l * NCH * NE; int* ROWL = (int*)(c.ws + WS_ROWL);
    LAS int* est = (LAS int*)c.lds;
    const int rpc = ntok / NCH;
    __syncthreads();
    if (c.tid < NCH) { int s = 0; for (int e = 0; e < NE; ++e) { est[c.tid * 65 + e] = s; s += (CNT[c.tid * NE + e] + 255) & ~255; } est[c.tid * 65 + 64] = s; }
    __syncthreads();
    const size_t na = (size_t)ntok * 8;
    for (size_t a = (size_t)c.blk * NTHR + c.tid; a < na; a += (size_t)c.G * NTHR) { const int t = (int)(a >> 3), ch = t / rpc; const int ep = TKEP[a], e = ep & 255, lp = ep >> 8;
        const int slot = est[ch * 65 + e] + TB[(t >> 5) * 64 + e] + lp; SLOT[a] = slot; ROWL[(size_t)ch * RPCMAX + slot] = t; }
    for (int i = c.blk * NTHR + c.tid; i < NCH * NE * 256; i += c.G * NTHR) { const int ch = i >> 14, e = (i >> 8) & 63, j = i & 255; const int n = CNT[ch * NE + e]; const int pad = ((n + 255) & ~255) - n;
        if (j < pad) ROWL[(size_t)ch * RPCMAX + est[ch * 65 + e] + n + j] = ch * rpc; }
    __syncthreads();
}

struct MoeOrder {
    const LAS int* tst;
    int ntile, npn, G, c; const char* W; size_t wexp, wtile;
    __device__ __forceinline__ bool next(int i, pg8::Unit& u) const {
        const long L = (long)i * G + c; if (L >= (long)ntile * npn) return false;
        const int T = (int)(L / npn), pn = (int)(L % npn); int e = 0; while (tst[e + 1] <= T) ++e;
        u.pm = T; u.pn = pn; u.e = e; u.B = W + (size_t)e * wexp + (size_t)pn * wtile; return true;
    }
};
__device__ __forceinline__ void moe_tile_table(const Ctx& c, int l, int ch, LAS int* tst) {
    const int* CNT = (const int*)(c.ws + WS_CTL) + CW_CNT + l * NCH * NE + ch * NE;
    __syncthreads();
    if (c.tid == 0) { int s = 0; for (int e = 0; e < NE; ++e) { tst[e] = s; s += (CNT[e] + 255) >> 8; } tst[64] = s; }
    __syncthreads();
}
__device__ __forceinline__ void phase_combine(const Ctx& c, KParams p, int l, int ch, int rpc) {
    const float* MOD = (const float*)(c.ws + WS_MOD) + (size_t)l * 33 * 6144 + 5120;
    const int* SLOT = (const int*)(c.ws + WS_RT + RT_SLOT); const float* TKW = (const float*)(c.ws + WS_RT + RT_TKW);
    const bf16* OB = (const bf16*)(c.ws + WS_OB); const bf16* OBS = (const bf16*)(c.ws + WS_OBS);
    float* xl = p->out; float* xc = (float*)(c.ws + WS_XC);
    const int gw = c.blk * NWAVES + c.wave, NGW = c.G * NWAVES, lane = c.lane;
    for (int i = gw; i < rpc; i += NGW) { const int t = ch * rpc + i; float* xr = t < NLAT ? xl + (size_t)t * DM : xc + (size_t)(t - NLAT) * DM; const float* g2 = MOD + (size_t)mod_row(t) * 6144;
        int sl = 0; float w = 0.f; if (lane < 8) { sl = SLOT[(size_t)t * 8 + lane]; w = TKW[(size_t)t * 8 + lane]; }
#pragma unroll
        for (int j = 0; j < 2; ++j) { const int cc = 8 * lane + 512 * j; float a[8]; { const u32x4 s8 = *(const u32x4*)(OBS + (size_t)i * DM + cc); unpack8(s8, a); }
#pragma unroll
            for (int k = 0; k < 8; ++k) { const int sk = rdli(sl, k); const float wk = rdl(w, k); const u32x4 o8 = *(const u32x4*)(OB + (size_t)sk * DM + cc); float t8[8]; unpack8(o8, t8);
#pragma unroll
                for (int q = 0; q < 8; ++q) a[q] = fmaf(wk, t8[q], a[q]); }
            const f32x4 x0 = *(const f32x4*)(xr + cc), x1 = *(const f32x4*)(xr + cc + 4), g0 = *(const f32x4*)(g2 + cc), g1 = *(const f32x4*)(g2 + cc + 4);
            *(f32x4*)(xr + cc) = x0 + g0 * (f32x4){a[0], a[1], a[2], a[3]}; *(f32x4*)(xr + cc + 4) = x1 + g1 * (f32x4){a[4], a[5], a[6], a[7]}; }
    }
}
__device__ __forceinline__ void phase_final_norm(const Ctx& c, KParams p) {
    const int gw = c.blk * NWAVES + c.wave, NGW = c.G * NWAVES, lane = c.lane;
    for (int r = gw; r < NLAT; r += NGW) { float* xr = p->out + (size_t)r * DM; f32x4 v[4]; float ss = 0.f;
#pragma unroll
        for (int j = 0; j < 4; ++j) { v[j] = *(const f32x4*)(xr + 4 * lane + 256 * j); ss += (v[j].x * v[j].x + v[j].y * v[j].y) + (v[j].z * v[j].z + v[j].w * v[j].w); }
        const float rstd = rsqrtf(wave_sum(ss) * (1.f / 1024.f) + EPS);
#pragma unroll
        for (int j = 0; j < 4; ++j) *(f32x4*)(xr + 4 * lane + 256 * j) = v[j] * rstd * *(const f32x4*)(p->in[I_FG] + 4 * lane + 256 * j); }
}

constexpr int LDS_BYTES = 147456;
constexpr int LDS_TAB = 131072, LDS_XB = LDS_BYTES - 16;

__global__ void __launch_bounds__(NTHR, 2) fwd_kernel(Params pk) {
    extern __shared__ __attribute__((aligned(16))) unsigned char lds_raw[];
    LAS unsigned char* const lds0 = (LAS unsigned char*)lds_raw;
    if (threadIdx.x < 4) ((LAS unsigned*)(lds0 + LDS_XB))[threadIdx.x] = 0u;
    __syncthreads();
    (void)xcd_barrier_post((unsigned*)(pk.ws + WS_CTL) + CW_BAR, (volatile LAS unsigned*)(lds0 + LDS_XB));
    int ph = 0; const int ph_lo = pk.ph_lo, ph_hi = pk.ph_hi;
#define RUN (ph >= ph_lo && ph < ph_hi)
#define SEAM() do { if (RUN && ph + 1 < ph_hi) { KParams q_ = fresh_params(); XcdBarrier b_; b_.bar = (unsigned*)(q_->ws + WS_CTL) + CW_BAR; b_.x = xb_xcc_id(); b_.st = (volatile LAS unsigned*)(lds0 + LDS_XB); xcd_barrier(b_); } ++ph; } while (0)
#define PHB KParams p = fresh_params(); Ctx c; { int t_ = threadIdx.x; asm volatile("" : "+v"(t_)); c.lds = lds0; c.tid = t_; c.lane = t_ & 63; c.wave = __builtin_amdgcn_readfirstlane(t_ >> 6); c.blk = blockIdx.x; c.G = gridDim.x; c.ws = p->ws; } \
    LAS unsigned char* stage = c.lds; LAS int* tst = (LAS int*)(c.lds + LDS_TAB); (void)stage; (void)tst; \
    unsigned char* sm = c.ws + WS_WSM + (size_t)l_ * WSM_L; const float* MODl = (const float*)(c.ws + WS_MOD) + (size_t)l_ * 33 * 6144; (void)sm; (void)MODl;

    int l_ = 0;
    if (RUN) { PHB prologue(c, p); }
    SEAM();
    if (RUN) { PHB prologue2(c, p); }
    SEAM();
#pragma unroll 1
    for (int l = 0; l < 2; ++l) {
        l_ = l;
        const bool last = (l == 1);
        const int nrows = last ? NLAT : NTOK;
        if (RUN) { PHB { phase_norm1(c, p, l); if (last) prologue_moe_weights(c, p, 1); } }
        SEAM();
        if (RUN) { PHB { pg8::DenseOrder S; S.init(NTOK / 256, ZW / 256, c.G, c.blk, (const bf16*)(c.ws + WS_WIN) + (size_t)l * 2048 * 1024, 1024);
            pg8::RowsDense R{2048u}; EpiBf16 E{(bf16*)(c.ws + WS_Z), ZW};
            pg8::gemm_phase(stage, (const char*)(c.ws + WS_H), 1024, S, R, E); } }
        SEAM();
        if (RUN) { PHB { phase_gla_scan(c, p, l); __syncthreads(); phase_conv1(c, p, l, !last); phase_mla_prep(c, p); } }
        SEAM();
        if (RUN) { PHB {
            phase_gla_final(c, p, l, nrows);
            { pg8::DenseOrder S; S.init(nrows / 256, 1, c.G, c.blk, (const bf16*)(sm + WSM_PW), 256); pg8::RowsDense R{512u}; EpiBiasBf16 E{(bf16*)(c.ws + WS_MIX) + 256, DM, p->in[I_CPB] + l * 256};
              pg8::gemm_phase(stage, (const char*)(c.ws + WS_CV), 256, S, R, E); }
            { pg8::DenseOrder S; S.init(NTOK / 256, 2, c.G, c.blk, (const bf16*)(sm + WSM_UQ), 256); pg8::RowsDense R{(unsigned)ZW * 2u};
              EpiQ E{(bf16*)(c.ws + WS_H), (const float*)(c.ws + WS_RS), (const float*)(c.ws + WS_TAB + TAB_ROPE)};
              pg8::gemm_phase(stage, (const char*)(c.ws + WS_Z) + ZCQ * 2, 256, S, R, E); }
            { pg8::DenseOrder S; S.init(NTOK / 256, 2, c.G, c.blk, (const bf16*)(sm + WSM_UK), 256); pg8::RowsDense R{(unsigned)ZW * 2u};
              EpiKV E{(bf16*)(c.ws + WS_H) + (size_t)NTOK * 384, (bf16*)(c.ws + WS_H) + (size_t)NTOK * 768, (const float*)(c.ws + WS_RS)};
              pg8::gemm_phase(stage, (const char*)(c.ws + WS_Z) + ZCKV * 2, 256, S, R, E); }
        } }
        SEAM();
        if (RUN) { PHB { phase_s5_scan(c, p, l); __syncthreads(); phase_attn_naive(c, !last); } }
        SEAM();
        if (RUN) { PHB phase_s5_final(c, p, l, nrows); }
        SEAM();
        if (RUN) { PHB { pg8::DenseOrder S; S.init(nrows / 256, 2, c.G, c.blk, (const bf16*)(sm + WSM_GLU), 256); pg8::RowsDense R{512u}; EpiGluSig E{(bf16*)(c.ws + WS_MIX) + 512, DM, p->in[I_S5GB] + l * 512};
            pg8::gemm_phase(stage, (const char*)(c.ws + WS_Y5), 256, S, R, E); } }
        SEAM();
        if (RUN) { PHB { pg8::DenseOrder S; S.init(nrows / 256, 4, c.G, c.blk, (const bf16*)(c.ws + WS_WOUT) + (size_t)l * 1024 * 1024, 1024); pg8::RowsDense R{2048u};
            EpiResid E{l == 0 ? p->in[I_X] : p->out, l == 0 ? p->in[I_CTX] : (const float*)(c.ws + WS_XC), p->out, (float*)(c.ws + WS_XC), MODl + 2048};
            pg8::gemm_phase(stage, (const char*)(c.ws + WS_MIX), 1024, S, R, E); } }
        SEAM();
        if (RUN) { PHB phase_norm2_route(c, p, l, nrows); }
        SEAM();
        if (RUN) { PHB phase_route_fill(c, l, nrows); }
        SEAM();
        const int rpc = nrows / NCH;
#pragma unroll 1
        for (int ch = 0; ch < NCH; ++ch) {
            if (RUN) { PHB {
                moe_tile_table(c, l, ch, tst);
                { MoeOrder S{tst, tst[64], 2, c.G, c.blk, (const char*)(c.ws + WS_WMOE), (size_t)512 * 1024 * 2, (size_t)256 * 1024 * 2};
                  pg8::RowsGather R{(const int*)(c.ws + WS_ROWL) + (size_t)ch * RPCMAX, 2048u}; EpiSwiglu E{(bf16*)(c.ws + WS_HB), 256};
                  pg8::gemm_phase(stage, (const char*)(c.ws + WS_H), 1024, S, R, E); }
                { pg8::DenseOrder S; S.init(rpc / 256, 2, c.G, c.blk, (const bf16*)(c.ws + WS_WSH) + (size_t)l * (512 * 1024 + 1024 * 256), 1024); pg8::RowsDense R{2048u}; EpiSwiglu E{(bf16*)(c.ws + WS_HBS), 256};
                  pg8::gemm_phase(stage, (const char*)(c.ws + WS_H) + (size_t)ch * rpc * 2048, 1024, S, R, E); }
            } }
            SEAM();
            if (RUN) { PHB {
                { MoeOrder S{tst, tst[64], 4, c.G, c.blk, (const char*)(c.ws + WS_WMOE) + (size_t)NE * 512 * 1024 * 2, (size_t)1024 * 256 * 2, (size_t)256 * 256 * 2};
                  pg8::RowsDense R{512u}; EpiBf16 E{(bf16*)(c.ws + WS_OB), DM};
                  pg8::gemm_phase(stage, (const char*)(c.ws + WS_HB), 256, S, R, E); }
                { pg8::DenseOrder S; S.init(rpc / 256, 4, c.G, c.blk, (const bf16*)(c.ws + WS_WSH) + (size_t)l * (512 * 1024 + 1024 * 256) + 512 * 1024, 256); pg8::RowsDense R{512u}; EpiBf16 E{(bf16*)(c.ws + WS_OBS), DM};
                  pg8::gemm_phase(stage, (const char*)(c.ws + WS_HBS), 256, S, R, E); }
            } }
            SEAM();
            if (RUN) { PHB phase_combine(c, p, l, ch, rpc); }
            SEAM();
        }
    }
    if (RUN) { PHB phase_final_norm(c, p); }
#undef RUN
#undef SEAM
#undef PHB
}

extern "C" void kernel_launch(void* const* d_in, const int* in_sizes, int n_in, void* d_out, int out_size, void* d_ws, size_t ws_size, hipStream_t stream) {
    static int grid = 0;
    if (grid == 0) {
        if (n_in != 42 || out_size != NLAT * DM || ws_size < WS_END) { fprintf(stderr, "kernel_launch: unexpected shapes (n_in %d out %d ws %zu)\n", n_in, out_size, ws_size); grid = -1; return; }
        int dev = 0, cus = 0;
        if (hipGetDevice(&dev) != hipSuccess || hipDeviceGetAttribute(&cus, hipDeviceAttributeMultiprocessorCount, dev) != hipSuccess) { grid = -1; return; }
        if (hipFuncSetAttribute((const void*)fwd_kernel, hipFuncAttributeMaxDynamicSharedMemorySize, LDS_BYTES) != hipSuccess) { fprintf(stderr, "kernel_launch: hipFuncSetAttribute failed\n"); grid = -1; return; }
        int per_cu = 0;
        if (hipOccupancyMaxActiveBlocksPerMultiprocessor(&per_cu, (const void*)fwd_kernel, NTHR, LDS_BYTES) != hipSuccess || per_cu < 1) fprintf(stderr, "kernel_launch: occupancy query reports %d\n", per_cu);
        (void)hipGetLastError();
        grid = cus;
    }
    if (grid < 0) return;
    (void)hipMemsetAsync((char*)d_ws + WS_CTL, 0, CTL_BYTES, stream);
    Params p{};
    for (int i = 0; i < 42; ++i) p.in[i] = (const float*)d_in[i];
    p.out = (float*)d_out; p.ws = (unsigned char*)d_ws; p.ph_lo = 0; p.ph_hi = 1 << 20;
    hipLaunchKernelGGL(fwd_kernel, dim3(grid), dim3(NTHR), LDS_BYTES, stream, p);
}
```

```cpp
#include <hip/hip_runtime.h>
#include <cstdio>
#include <cstdint>

#define LAS __attribute__((address_space(3)))
typedef unsigned short bf16;
typedef short bf16x8 __attribute__((ext_vector_type(8)));
typedef float f32x4 __attribute__((ext_vector_type(4)));
typedef float f32x2 __attribute__((ext_vector_type(2)));
typedef float f32x16 __attribute__((ext_vector_type(16)));
typedef unsigned u32x4 __attribute__((ext_vector_type(4)));
typedef unsigned u32x2 __attribute__((ext_vector_type(2)));

constexpr int NB = 32, SEQ = 2048, CTXL = 256, DM = 1024;
constexpr int NLAT = NB * SEQ, NCTX = NB * CTXL, NTOK = NLAT + NCTX;
constexpr int ZW = 2048;
constexpr int ZQ = 0, ZK = 128, ZV = 256, ZR = 512, ZCA = 768, ZCG = 1024, ZS5 = 1280, ZCQ = 1536, ZCKV = 1792, ZKR = 1920, ZAF = 1952, ZAB = 1968;
constexpr int NE = 64, TOPK = 8;
constexpr int NCH = 2;
constexpr int RPCMAX = (NTOK / NCH) * 8 + 64 * 256;
constexpr float EPS = 1e-6f;
constexpr int NWAVES = 8, NTHR = 512;

constexpr size_t MiB = (size_t)1 << 20;
constexpr size_t WS_CTL = 0, CTL_BYTES = 1 * MiB;
constexpr size_t WS_MOD = 1 * MiB;
constexpr size_t WS_TAB = 3 * MiB;
constexpr size_t WS_WSM = 5 * MiB;
constexpr size_t WS_WIN = 8 * MiB;
constexpr size_t WS_WOUT = 16 * MiB;
constexpr size_t WS_WSH = 20 * MiB;
constexpr size_t WS_TB = 23 * MiB;
constexpr size_t WS_RT = 24 * MiB;
constexpr size_t WS_ROWL = 32 * MiB;
constexpr size_t WS_RS = 35 * MiB;
constexpr size_t WS_WMOE = 36 * MiB;
constexpr size_t WS_XC = 132 * MiB;
constexpr size_t WS_H = 164 * MiB;
constexpr size_t WS_Z = 308 * MiB;
constexpr size_t WS_MIX = 596 * MiB;
constexpr size_t WS_T1 = 740 * MiB;
constexpr size_t WS_UP = 812 * MiB;
constexpr size_t WS_CV = 884 * MiB;
constexpr size_t WS_Y5 = 920 * MiB;
constexpr size_t WS_S5W = 956 * MiB;
constexpr size_t WS_S5P = 968 * MiB;
constexpr size_t WS_GVT = 969 * MiB;
constexpr size_t WS_END = 1005 * MiB;
constexpr size_t WS_HB = WS_Z;
constexpr size_t WS_HBS = WS_Z + 152 * MiB;
constexpr size_t WS_OBS = WS_Z + 170 * MiB;
constexpr size_t WS_OB = WS_MIX;
static_assert((size_t)RPCMAX * 512 <= 152 * MiB && WS_OBS + (size_t)(NTOK / NCH) * 2048 <= WS_MIX && WS_OB + (size_t)RPCMAX * 1024 <= WS_S5W, "MoE overlays");
constexpr int CW_BAR = 0;
constexpr int CW_CNT = 4096;
constexpr size_t WSM_L = 1 * MiB;
constexpr size_t WSM_PW = 0, WSM_GLU = 128 * 1024, WSM_UQ = 384 * 1024, WSM_UK = 640 * 1024, WSM_UV = 768 * 1024;
constexpr size_t TAB_ROPE = 0;
constexpr size_t TAB_S5 = 256 * 1024;
constexpr size_t TAB_RWT = 1536 * 1024;
constexpr size_t RT_TKEP = 0, RT_TKW = 2400000, RT_SLOT = 4800000;

__device__ __forceinline__ float bf2f(bf16 v) { return __uint_as_float(((unsigned)v) << 16); }
typedef __bf16 bf16x2_t __attribute__((ext_vector_type(2)));
__device__ __forceinline__ unsigned pk2(float lo, float hi) { const f32x2 v = {lo, hi}; return __builtin_bit_cast(unsigned, __builtin_convertvector(v, bf16x2_t)); }
__device__ __forceinline__ bf16 f2bf(float f) { return __builtin_bit_cast(unsigned short, (__bf16)f); }
template <int O> __device__ __forceinline__ float shx(float v) {
    return __int_as_float(__builtin_amdgcn_ds_swizzle(__float_as_int(v), (O << 10) | 0x1f)); }
__device__ __forceinline__ float rdl(float v, int l) { return __int_as_float(__builtin_amdgcn_readlane(__float_as_int(v), l)); }
__device__ __forceinline__ int rdli(int v, int l) { return __builtin_amdgcn_readlane(v, l); }
__device__ __forceinline__ float wave_sum(float v) {
    v += shx<1>(v); v += shx<2>(v); v += shx<4>(v); v += shx<8>(v); v += shx<16>(v);
    const auto r = __builtin_amdgcn_permlane32_swap(__float_as_uint(v), __float_as_uint(v), false, false);
    return __uint_as_float(r[0]) + __uint_as_float(r[1]);
}
__device__ __forceinline__ float wave_max(float v) {
    v = fmaxf(v, shx<1>(v)); v = fmaxf(v, shx<2>(v)); v = fmaxf(v, shx<4>(v)); v = fmaxf(v, shx<8>(v)); v = fmaxf(v, shx<16>(v));
    const auto r = __builtin_amdgcn_permlane32_swap(__float_as_uint(v), __float_as_uint(v), false, false);
    return fmaxf(__uint_as_float(r[0]), __uint_as_float(r[1]));
}
__device__ __forceinline__ float sigmoidf_(float x) { return 1.0f / (1.0f + __expf(-x)); }
__device__ __forceinline__ float siluf_(float x) { return x / (1.0f + __expf(-x)); }
__device__ __forceinline__ void unpack8(const u32x4 w, float (&v)[8]) {
    v[0] = __uint_as_float(w.x << 16); v[1] = __uint_as_float(w.x & 0xffff0000u);
    v[2] = __uint_as_float(w.y << 16); v[3] = __uint_as_float(w.y & 0xffff0000u);
    v[4] = __uint_as_float(w.z << 16); v[5] = __uint_as_float(w.z & 0xffff0000u);
    v[6] = __uint_as_float(w.w << 16); v[7] = __uint_as_float(w.w & 0xffff0000u);
}
__device__ __forceinline__ void lds_wait() { asm volatile("s_waitcnt lgkmcnt(0)" ::: "memory"); }

#define XB_TMO      128
#define XB_XCNT(j)  (256  + 64 * (j))
#define XB_XSUB(j)  (1280 + 64 * (j))
#define XB_XGEN(j)  (2304 + 64 * (j))
#define XB_TOP      3328
#define XB_TOPGEN   3392
#define XCD_BAR_WORDS 3456
#define XB_SPIN_CAP (1u << 22)
__device__ __forceinline__ unsigned xb_ld(unsigned* p)              { return __hip_atomic_load(p, __ATOMIC_RELAXED, __HIP_MEMORY_SCOPE_AGENT); }
__device__ __forceinline__ unsigned xb_add(unsigned* p, unsigned v) { return __hip_atomic_fetch_add(p, v, __ATOMIC_RELAXED, __HIP_MEMORY_SCOPE_AGENT); }
__device__ __forceinline__ unsigned xb_xcc_id() { return (unsigned)__builtin_amdgcn_s_getreg((3 << 11) | 20) & 0xFu; }
#define XB_SPIN(cond, bar) do { unsigned _sp = 0; while (cond) { __builtin_amdgcn_s_sleep(1); \
    if ((++_sp & 255u) == 0u) { if (xb_ld(&(bar)[XB_TMO])) break; if (_sp > XB_SPIN_CAP) { atomicAdd(&(bar)[XB_TMO], 1u); break; } } } } while (0)
struct XcdBarrier { unsigned* bar; unsigned x; volatile LAS unsigned* st; };
__device__ __forceinline__ XcdBarrier xcd_barrier_post(unsigned* bar, volatile LAS unsigned* st) {
    XcdBarrier b; b.bar = bar; b.x = xb_xcc_id(); b.st = st;
    if (threadIdx.x == 0) (void)xb_add(&bar[XB_XCNT(b.x)], 1u);
    return b;
}
__device__ __forceinline__ void xcd_barrier_complete(unsigned* bar, unsigned x, unsigned& nloc, unsigned& nx) {
    const unsigned G = gridDim.x * gridDim.y * gridDim.z;
    unsigned sum, cnt, mine, sp = 0u;
    for (;;) {
        sum = 0u; cnt = 0u; mine = 0u;
#pragma unroll
        for (unsigned j = 0; j < 16; ++j) { const unsigned c = xb_ld(&bar[XB_XCNT(j)]); sum += c; cnt += (c > 0u) ? 1u : 0u; mine = (j == x) ? c : mine; }
        if (sum == G) break;
        __builtin_amdgcn_s_sleep(1);
        if ((++sp & 255u) == 0u) { if (xb_ld(&bar[XB_TMO])) break; if (sp > XB_SPIN_CAP) { atomicAdd(&bar[XB_TMO], 1u); break; } }
    }
    nloc = mine > 0u ? mine : 1u; nx = cnt > 0u ? cnt : 1u;
}
__device__ __forceinline__ void xcd_barrier(const XcdBarrier& b) {
    asm volatile("s_waitcnt vmcnt(0)" ::: "memory");
    __syncthreads();
    if (threadIdx.x == 0) {
        unsigned* bar = b.bar;
        __builtin_amdgcn_s_waitcnt(0);
        unsigned nloc = b.st[0], nx = b.st[1];
        if (nloc == 0u) { xcd_barrier_complete(bar, b.x, nloc, nx); b.st[0] = nloc; b.st[1] = nx; }
        const unsigned old = xb_add(&bar[XB_XSUB(b.x)], 1u);
        const unsigned gen = old / nloc;
        if (old + 1u == (gen + 1u) * nloc) {
            __builtin_amdgcn_fence(__ATOMIC_RELEASE, "agent");
            asm volatile("s_waitcnt vmcnt(0)" ::: "memory");
            const unsigned og = xb_add(&bar[XB_TOP], 1u);
            const unsigned tg = og / nx;
            if (og + 1u == (tg + 1u) * nx) xb_add(&bar[XB_TOPGEN], 1u);
            else XB_SPIN(xb_ld(&bar[XB_TOPGEN]) == tg, bar);
            __builtin_amdgcn_fence(__ATOMIC_ACQUIRE, "agent");
            xb_add(&bar[XB_XGEN(b.x)], 1u);
            asm volatile("s_waitcnt vmcnt(0)" ::: "memory");
        } else {
            XB_SPIN(xb_ld(&bar[XB_XGEN(b.x)]) == gen, bar);
            __builtin_amdgcn_fence(__ATOMIC_ACQUIRE, "agent");
            asm volatile("s_waitcnt vmcnt(0)" ::: "memory");
        }
    }
    __syncthreads();
}

namespace pg8 {
constexpr int BM = 256, BK = 64, HALF = 128, HTB = HALF * BK * 2, STAGE_BYTES = 8 * HTB, NXCD = 8, WGM = 8;
__device__ __forceinline__ int lds_byte(int r, int c) { const int st = (r >> 4) * 2 + (c >> 5), rr = r & 15, cc = c & 31, ob = rr * 64 + cc * 2; return st * 1024 + (ob ^ (((ob >> 9) & 1) << 5)); }
__device__ __forceinline__ void stage_rc(int b, int& R, int& C) { const int st = b / 1024, sb = b % 1024, swz = sb ^ (((sb >> 9) & 1) << 5); R = (st >> 1) * 16 + swz / 64; C = (st & 1) * 32 + (swz % 64) / 2; }
__device__ __forceinline__ int perm32(int rho) { const int n = rho >> 4, i = rho & 15; return 8 * (i >> 2) + 4 * n + (i & 3); }

struct Unit { int pm, pn, e; const char* B; };

struct DenseOrder {
    int nM, nN, nwg, G, c; const char* Bt; size_t btile;
    __device__ __forceinline__ void init(int nM_, int nN_, int G_, int c_, const bf16* Bt_, int K) { nM = nM_; nN = nN_; nwg = nM * nN; G = G_; c = c_; Bt = (const char*)Bt_; btile = (size_t)256 * K * 2; }
    __device__ __forceinline__ bool next(int i, Unit& u) const {
        const long L = (long)i * G + c; if (L >= nwg) return false;
        int wgid = (int)L; { const int q = nwg / NXCD, r = nwg % NXCD, xcd = wgid % NXCD, off = wgid / NXCD; wgid = (xcd < r ? xcd * (q + 1) : r * (q + 1) + (xcd - r) * q) + off; }
        const int nig = WGM * nN, gid = wgid / nig, fm = gid * WGM, gsz = (nM - fm) < WGM ? (nM - fm) : WGM;
        u.pm = fm + ((wgid % nig) % gsz); u.pn = (wgid % nig) / gsz; u.e = 0; u.B = Bt + (size_t)u.pn * btile; return true;
    }
};
struct RowsDense { unsigned ldab; __device__ __forceinline__ unsigned off(const Unit& u, int r) const { return (unsigned)(u.pm * 256 + r) * ldab; } };
struct RowsGather { const int* list; unsigned ldab; __device__ __forceinline__ unsigned off(const Unit& u, int r) const { return (unsigned)list[u.pm * 256 + r] * ldab; } };

template <class Epi, class Sched, class Rows>
__device__ __forceinline__ void gemm_phase(LAS unsigned char* lds, const char* Abase, const int K, const Sched& S, const Rows& RW, const Epi& E) {
    int tid_ = threadIdx.x; asm volatile("" : "+v"(tid_));
    const int tid = tid_, wid = __builtin_amdgcn_readfirstlane(tid >> 6), lane = tid & 63, wr = wid >> 2, wc = wid & 3, fr = lane & 15, fq = lane >> 4;
    const int nt = K / BK;
    int sR[2]; unsigned sC[2], voffB[2];
#pragma unroll
    for (int i = 0; i < 2; ++i) { int R, C; stage_rc(tid * 16 + i * 8192, R, C); sR[i] = R; sC[i] = (unsigned)C * 2u; const int Rb = (R & ~31) + perm32(R & 31); voffB[i] = (unsigned)(Rb * K + C) * 2u; }
    const size_t kstep = (size_t)(BK * 2);
    const size_t hstepB = (size_t)HALF * K * 2;
    const unsigned ldsw = (unsigned)wid * 1024u;
    const int aoff = lds_byte(wr * 64 + fr, fq * 8), boff = lds_byte(wc * 32 + fr, fq * 8);
#define PG8_SA(b, h) (((b) * 2 + (h)) * HTB)
#define PG8_SB(b, h) ((4 + (b) * 2 + (h)) * HTB)
#define PG8_STAGE(bufoff, gbase, voff) do { _Pragma("unroll") for (int _i = 0; _i < 2; ++_i) { unsigned _o = (voff)[_i]; asm volatile("" : "+v"(_o)); \
        __builtin_amdgcn_global_load_lds((const unsigned*)((const char*)(gbase) + _o), (LAS unsigned*)(lds + (bufoff) + ldsw + _i * 8192), 16, 0, 0); } } while (0)
#define PG8_LDA(dst, b, h) do { _Pragma("unroll") for (int m = 0; m < 4; ++m) _Pragma("unroll") for (int k = 0; k < 2; ++k) dst[m][k] = *(const LAS bf16x8*)(lds + PG8_SA(b, h) + aoff + m * 2048 + k * 1024); } while (0)
#define PG8_LDB(dst, b, h) do { _Pragma("unroll") for (int n = 0; n < 2; ++n) _Pragma("unroll") for (int k = 0; k < 2; ++k) dst[n][k] = *(const LAS bf16x8*)(lds + PG8_SB(b, h) + boff + n * 2048 + k * 1024); } while (0)
#define PG8_MMA(ai, bj, At, Bt) do { __builtin_amdgcn_s_setprio(1); _Pragma("unroll") for (int m = 0; m < 4; ++m) _Pragma("unroll") for (int n = 0; n < 2; ++n) _Pragma("unroll") for (int k = 0; k < 2; ++k) \
        acc[ai][bj][m][n] = __builtin_amdgcn_mfma_f32_16x16x32_bf16(Bt[n][k], At[m][k], acc[ai][bj][m][n], 0, 0, 0); __builtin_amdgcn_s_setprio(0); } while (0)
#define PG8_WAIT_V(n) asm volatile("s_waitcnt vmcnt(" #n ")" ::: "memory")
#define PG8_WAIT_L(n) asm volatile("s_waitcnt lgkmcnt(" #n ")" ::: "memory")
#define PG8_BAR __builtin_amdgcn_s_barrier()
#define PG8_SCHED __builtin_amdgcn_sched_barrier(0)
    Unit cur, nxt; int ui = 0;
    if (!S.next(0, cur)) return;
    f32x4 acc[2][2][4][2];
#pragma unroll
    for (int a = 0; a < 2; ++a)
#pragma unroll
        for (int b = 0; b < 2; ++b)
#pragma unroll
            for (int m = 0; m < 4; ++m)
#pragma unroll
                for (int n = 0; n < 2; ++n) acc[a][b][m][n] = (f32x4){0.f, 0.f, 0.f, 0.f};
    bf16x8 At[4][2], B0[2][2], B1[2][2];
    unsigned oA0[2], oA1[2];
#pragma unroll
    for (int i = 0; i < 2; ++i) { oA0[i] = RW.off(cur, sR[i]) + sC[i]; oA1[i] = RW.off(cur, HALF + sR[i]) + sC[i]; }
    const char* cB = cur.B;
    PG8_STAGE(PG8_SB(0, 0), cB, voffB); PG8_STAGE(PG8_SB(0, 1), cB + hstepB, voffB); PG8_STAGE(PG8_SA(0, 0), Abase, oA0); PG8_STAGE(PG8_SA(0, 1), Abase, oA1);
    if (wr == 1) PG8_BAR;
    PG8_WAIT_V(2); PG8_BAR;
    PG8_STAGE(PG8_SB(1, 0), cB + kstep, voffB); PG8_STAGE(PG8_SA(1, 0), Abase + kstep, oA0); PG8_STAGE(PG8_SB(1, 1), cB + hstepB + kstep, voffB);
    PG8_WAIT_V(6); PG8_BAR;
    for (;;) {
        const bool has_next = S.next(ui + 1, nxt);
#pragma unroll 1
        for (int t = 0; t < nt; t += 2) {
            const bool last = (t == nt - 2);
            const char* a1 = Abase + (size_t)(t + 1) * kstep;
            PG8_LDB(B0, 0, 0); PG8_LDB(B1, 0, 1); PG8_SCHED; PG8_LDA(At, 0, 0); PG8_STAGE(PG8_SA(1, 1), a1, oA1);
            PG8_WAIT_V(8); PG8_WAIT_L(0); PG8_BAR; PG8_MMA(0, 0, At, B0); PG8_MMA(0, 1, At, B1); PG8_BAR; PG8_SCHED;
            const char* a2; const char* b2;
            if (last) {
                if (has_next) {
                    int t2 = threadIdx.x; asm volatile("" : "+v"(t2));
#pragma unroll
                    for (int i = 0; i < 2; ++i) { int R, C; stage_rc(t2 * 16 + i * 8192, R, C); oA0[i] = RW.off(nxt, R) + (unsigned)C * 2u; oA1[i] = RW.off(nxt, HALF + R) + (unsigned)C * 2u; }
                    cB = nxt.B;
                }
                a2 = Abase; b2 = cB;
            } else { a2 = Abase + (size_t)(t + 2) * kstep; b2 = cB + (size_t)(t + 2) * kstep; }
            const char* a3 = a2 + kstep; const char* b3 = b2 + kstep;
            PG8_LDA(At, 0, 1); PG8_STAGE(PG8_SB(0, 0), b2, voffB); PG8_STAGE(PG8_SB(0, 1), b2 + hstepB, voffB); PG8_STAGE(PG8_SA(0, 0), a2, oA0);
            PG8_WAIT_V(8); PG8_WAIT_L(0); PG8_BAR; PG8_MMA(1, 0, At, B0); PG8_MMA(1, 1, At, B1); PG8_BAR; PG8_SCHED;
            PG8_LDB(B0, 1, 0); PG8_LDB(B1, 1, 1); PG8_SCHED; PG8_LDA(At, 1, 0); PG8_STAGE(PG8_SA(0, 1), a2, oA1);
            PG8_WAIT_V(8); PG8_WAIT_L(0); PG8_BAR; PG8_MMA(0, 0, At, B0); PG8_MMA(0, 1, At, B1); PG8_BAR; PG8_SCHED;
            PG8_LDA(At, 1, 1); PG8_STAGE(PG8_SB(1, 0), b3, voffB); PG8_STAGE(PG8_SB(1, 1), b3 + hstepB, voffB); PG8_STAGE(PG8_SA(1, 0), a3, oA0);
            PG8_WAIT_V(8); PG8_WAIT_L(0); PG8_BAR; PG8_MMA(1, 0, At, B0); PG8_MMA(1, 1, At, B1); PG8_BAR; PG8_SCHED;
        }
        if (wr == 0) PG8_BAR;
        { Unit eu = cur; asm volatile("" : "+s"(eu.pm), "+s"(eu.pn)); int t3 = threadIdx.x; asm volatile("" : "+v"(t3)); E(acc, eu, wr, wc, t3 & 15, (t3 & 63) >> 4); }
        if (!has_next) break;
#pragma unroll
        for (int a = 0; a < 2; ++a)
#pragma unroll
            for (int b = 0; b < 2; ++b)
#pragma unroll
                for (int m = 0; m < 4; ++m)
#pragma unroll
                    for (int n = 0; n < 2; ++n) acc[a][b][m][n] = (f32x4){0.f, 0.f, 0.f, 0.f};
        cur = nxt; ++ui;
        if (wr == 1) PG8_BAR;
    }
    PG8_WAIT_V(0);
    PG8_BAR;
#undef PG8_SA
#undef PG8_SB
#undef PG8_STAGE
#undef PG8_LDA
#undef PG8_LDB
#undef PG8_MMA
#undef PG8_WAIT_V
#undef PG8_WAIT_L
#undef PG8_BAR
#undef PG8_SCHED
}
}

struct Params { const float* in[42]; float* out; unsigned char* ws; int ph_lo, ph_hi; };
enum { I_X = 0, I_C, I_CTX, I_CCTX, I_ADAW, I_ADAB, I_N1G, I_N2G, I_WIN, I_WOUT, I_GLAW, I_GLAB, I_GLAG, I_CDW, I_CDB, I_CLG, I_CLB, I_CPW, I_CPB,
       I_S5LR, I_S5LI, I_S5DT, I_S5BR, I_S5BI, I_S5CR, I_S5CI, I_S5D, I_S5GW, I_S5GB, I_QNG, I_KVNG, I_WUQ, I_WUKV, I_RW, I_RB, I_MG, I_MU, I_MD, I_SG, I_SU, I_SD, I_FG };

typedef const __attribute__((address_space(4))) Params* KParams;
__device__ __forceinline__ KParams fresh_params() { KParams kp = (KParams)__builtin_amdgcn_kernarg_segment_ptr(); asm volatile("" : "+s"(kp)); return kp; }
struct Ctx {
    LAS unsigned char* lds;
    int tid, lane, wave, blk, G;
    unsigned char* ws;
};

__device__ __forceinline__ int mod_row(int r) { return r < NLAT ? (r >> 11) : 32; }

__device__ __forceinline__ void tr_item(const float* W, int ldw, int k0, int n0, bf16* dst, int ldk, const float* kscale, float sc, LAS float* scr, int lane) {
#pragma unroll 8
    for (int i = 0; i < 32; ++i) { const int kk = 2 * i + (lane >> 5); float v = W[(size_t)(k0 + kk) * ldw + n0 + (lane & 31)] * sc; if (kscale) v *= kscale[k0 + kk]; scr[kk * 33 + (lane & 31)] = v; }
    lds_wait();
    const int c = lane & 7;
#pragma unroll
    for (int j = 0; j < 4; ++j) { const int n = (lane >> 3) + 8 * j; const LAS float* s = scr + (8 * c) * 33 + n;
        u32x4 o; o.x = pk2(s[0 * 33], s[1 * 33]); o.y = pk2(s[2 * 33], s[3 * 33]); o.z = pk2(s[4 * 33], s[5 * 33]); o.w = pk2(s[6 * 33], s[7 * 33]);
        *(u32x4*)(dst + (size_t)n * ldk + k0 + 8 * c) = o; }
    lds_wait();
}
template <int KIND> __device__ __forceinline__ int tr_dst(int n0) {
    if (KIND == 0) return n0;
    if (KIND == 1) return n0 < 768 ? n0 : (n0 == 768 ? 1952 : n0 - 32);
    if (KIND == 2) { const int half = n0 >> 8, c = n0 & 255; return (c >> 7) * 256 + half * 128 + (c & 127); }
    if (KIND == 3) { const int head = n0 / 96, d0 = n0 % 96; return d0 < 64 ? head * 64 + d0 : 256 + head * 32; }
    if (KIND == 4) { const int head = n0 >> 7, d0 = n0 & 127; return d0 < 64 ? head * 64 + d0 : 256 + head * 64 + (d0 - 64); }
    if (KIND == 5) return (n0 >> 7) * 256 + (n0 & 127);
    if (KIND == 6) return (n0 >> 7) * 256 + 128 + (n0 & 127);
    return n0;
}
template <int KIND> __device__ __forceinline__ void tr_matrix(const Ctx& c, const float* W, int ldw, int K, int Nsrc, bf16* WT, int ldk, const float* kscale, float sc) {
    LAS float* scr = (LAS float*)(c.lds + c.wave * 8704);
    const int gw = c.blk * NWAVES + c.wave, NGW = c.G * NWAVES, ng = Nsrc / 32, items = (K / 64) * ng;
    for (int it = gw; it < items; it += NGW) { const int kb = it / ng, g = it % ng; tr_item(W, ldw, kb * 64, 32 * g, WT + (size_t)tr_dst<KIND>(32 * g) * ldk, ldk, kscale, sc, scr, c.lane); }
}
__device__ __forceinline__ void zero_fill16(const Ctx& c, void* p, size_t bytes) {
    u32x4* q = (u32x4*)p; const size_t n = bytes / 16;
    for (size_t i = (size_t)c.blk * NTHR + c.tid; i < n; i += (size_t)c.G * NTHR) q[i] = (u32x4){0u, 0u, 0u, 0u};
}
__device__ __forceinline__ void sincos_r(float x, float& s, float& co) {
    const float n = rintf(x * 0.15915494309189535f);
    float r = fmaf(n, -6.28125f, x); r = fmaf(n, -1.9353071795864769e-3f, r);
    s = __sinf(r); co = __cosf(r);
}

__device__ __forceinline__ void prologue_moe_weights(const Ctx& c, KParams p, int l) {
    bf16* WGU = (bf16*)(c.ws + WS_WMOE); bf16* WD = WGU + (size_t)NE * 512 * 1024;
    LAS float* scr = (LAS float*)(c.lds + c.wave * 8704);
    const int gw = c.blk * NWAVES + c.wave, NGW = c.G * NWAVES;
    for (int it = gw; it < NE * 384; it += NGW) {
        const int e = it / 384, r = it % 384;
        if (r < 256) { const int up = r >> 7, q = r & 127, kb = q >> 3, g = q & 7;
            const float* W = p->in[up ? I_MU : I_MG] + ((size_t)l * NE + e) * 1024 * 256;
            const int nd = up ? tr_dst<6>(32 * g) : tr_dst<5>(32 * g);
            tr_item(W, 256, kb * 64, 32 * g, WGU + (size_t)e * 512 * 1024 + (size_t)nd * 1024, 1024, nullptr, 1.f, scr, c.lane);
        } else { const int q = r - 256, kb = q >> 5, g = q & 31;
            const float* W = p->in[I_MD] + ((size_t)l * NE + e) * 256 * 1024;
            tr_item(W, 1024, kb * 64, 32 * g, WD + (size_t)e * 1024 * 256 + (size_t)(32 * g) * 256, 256, nullptr, 1.f, scr, c.lane);
        }
    }
}

__device__ __forceinline__ void prologue(const Ctx& c, KParams p) {
    float* MOD = (float*)(c.ws + WS_MOD);
    {
        const int u = c.G - 1 - c.blk;
        if (u < 24) {
            LAS float* sc = (LAS float*)(c.lds + 80 * 1024);
            const int l = u / 12, col = (u % 12) * 512 + c.tid;
            const float* W = p->in[I_ADAW] + (size_t)l * 1024 * 6144;
            float acc[33];
#pragma unroll
            for (int b = 0; b < 33; ++b) acc[b] = 0.f;
            for (int k0 = 0; k0 < 1024; k0 += 64) {
                __syncthreads();
                for (int i = c.tid; i < 33 * 64; i += NTHR) { const int b = i >> 6, kk = i & 63; const float v = b < 32 ? p->in[I_C][b * 1024 + k0 + kk] : p->in[I_CCTX][k0 + kk]; sc[i] = siluf_(v); }
                __syncthreads();
                for (int kk = 0; kk < 64; ++kk) { const float w = W[(size_t)(k0 + kk) * 6144 + col];
#pragma unroll
                    for (int b = 0; b < 33; ++b) acc[b] = fmaf(sc[b * 64 + kk], w, acc[b]); }
            }
            const float bias = p->in[I_ADAB][l * 6144 + col];
#pragma unroll
            for (int b = 0; b < 33; ++b) MOD[((size_t)l * 33 + b) * 6144 + col] = acc[b] + bias;
            __syncthreads();
        }
    }
    {
        float* ROPE = (float*)(c.ws + WS_TAB + TAB_ROPE);
        for (int i = c.blk * NTHR + c.tid; i < 2048 * 16; i += c.G * NTHR) { const int t = i >> 4, ax = (i >> 3) & 1, f = i & 7;
            const float pos = (float)(ax == 0 ? (t >> 6) : (t & 63)); const float inv = __expf(-(float)f * (9.210340371976184f / 8.0f));
            float s, co; sincos_r(pos * inv, s, co); ROPE[i * 2] = co; ROPE[i * 2 + 1] = s; }
        bf16* RWT = (bf16*)(c.ws + WS_TAB + TAB_RWT);
        for (int i = c.blk * NTHR + c.tid; i < 2 * 64 * 1024; i += c.G * NTHR) { const int l = i >> 16, n = (i >> 10) & 63, k = i & 1023; const float wv = p->in[I_RW][((size_t)l * 1024 + k) * 64 + n];
            const bf16 hi = f2bf(wv); RWT[(size_t)(l * 2) * 65536 + n * 1024 + k] = hi; RWT[(size_t)(l * 2 + 1) * 65536 + n * 1024 + k] = f2bf(wv - bf2f(hi)); }
        float* S5T = (float*)(c.ws + WS_TAB + TAB_S5);
        for (int i = c.blk * NTHR + c.tid; i < 2 * 2 * 16 * 64; i += c.G * NTHR) {
            const int pp = i & 63, g = (i >> 6) & 15, ld = i >> 10;
            const float lr = p->in[I_S5LR][i], li = p->in[I_S5LI][i], dt = __expf(p->in[I_S5DT][ld * 16 + g]);
            const float mag = __expf(lr * dt); float s, co; sincos_r(li * dt, s, co);
            const float are = mag * co, aim = mag * s, den = lr * lr + li * li;
            const float fre = ((are - 1.f) * lr + aim * li) / den, fim = (aim * lr - (are - 1.f) * li) / den;
            float* T = S5T + (size_t)i * 66; T[0] = are; T[1] = aim;
            { float* PW = (float*)(c.ws + WS_S5P) + (size_t)i * 34; float pr = 1.f, pi = 0.f;
              for (int e = 0; e <= 16; ++e) { PW[2 * e] = pr; PW[2 * e + 1] = pi; const float nr = pr * are - pi * aim, ni = pr * aim + pi * are; pr = nr; pi = ni; } }
            for (int ch = 0; ch < 16; ++ch) { const float br = p->in[I_S5BR][(size_t)i * 16 + ch], bi = p->in[I_S5BI][(size_t)i * 16 + ch];
                T[2 + ch] = fre * br - fim * bi; T[18 + ch] = fre * bi + fim * br;
                T[34 + ch] = p->in[I_S5CR][((size_t)(ld * 16 + g) * 16 + ch) * 64 + pp]; T[50 + ch] = p->in[I_S5CI][((size_t)(ld * 16 + g) * 16 + ch) * 64 + pp]; }
        }
    }
    for (int l = 0; l < 2; ++l) {
        bf16* WIN = (bf16*)(c.ws + WS_WIN) + (size_t)l * 2048 * 1024;
        tr_matrix<1>(c, p->in[I_WIN] + (size_t)l * 1024 * 1984, 1984, 1024, 1984, WIN, 1024, nullptr, 1.f);
        zero_fill16(c, WIN + (size_t)1984 * 1024, (size_t)64 * 1024 * 2);
        tr_matrix<0>(c, p->in[I_WOUT] + (size_t)l * 1024 * 1024, 1024, 1024, 1024, (bf16*)(c.ws + WS_WOUT) + (size_t)l * 1024 * 1024, 1024, nullptr, 1.f);
        unsigned char* sm = c.ws + WS_WSM + (size_t)l * WSM_L;
        tr_matrix<0>(c, p->in[I_CPW] + (size_t)l * 256 * 256, 256, 256, 256, (bf16*)(sm + WSM_PW), 256, nullptr, 1.f);
        tr_matrix<2>(c, p->in[I_S5GW] + (size_t)l * 256 * 512, 512, 256, 512, (bf16*)(sm + WSM_GLU), 256, nullptr, 1.f);
        tr_matrix<3>(c, p->in[I_WUQ] + (size_t)l * 256 * 384, 384, 256, 384, (bf16*)(sm + WSM_UQ), 256, p->in[I_QNG] + l * 256, 0.14724445f  );
        zero_fill16(c, (bf16*)(sm + WSM_UQ) + (size_t)384 * 256, (size_t)128 * 256 * 2);
        zero_fill16(c, sm + WSM_UK, (size_t)512 * 256 * 2);
    }
    for (int l = 0; l < 2; ++l) {
        bf16* WSGU = (bf16*)(c.ws + WS_WSH) + (size_t)l * (512 * 1024 + 1024 * 256); bf16* WSD = WSGU + 512 * 1024;
        tr_matrix<5>(c, p->in[I_SG] + (size_t)l * 1024 * 256, 256, 1024, 256, WSGU, 1024, nullptr, 1.f);
        tr_matrix<6>(c, p->in[I_SU] + (size_t)l * 1024 * 256, 256, 1024, 256, WSGU, 1024, nullptr, 1.f);
        tr_matrix<0>(c, p->in[I_SD] + (size_t)l * 256 * 1024, 1024, 256, 1024, WSD, 256, nullptr, 1.f);
    }
    prologue_moe_weights(c, p, 0);
}
__device__ __forceinline__ void prologue_s5_weights(const Ctx& c, KParams p) {
    const float* S5T = (const float*)(c.ws + WS_TAB + TAB_S5); const float* S5P = (const float*)(c.ws + WS_S5P);
    LAS float* pw = (LAS float*)c.lds;
    LAS float* bb = pw + 2 * 17 * 64 * 2;
    LAS float* cc = bb + 2 * 64 * 16 * 2;
    LAS float* kt = cc + 2 * 16 * 64 * 2;
    for (int u = c.blk; u < 32; u += c.G) {
        const int l = u >> 4, g = u & 15;
        __syncthreads();
        for (int i = c.tid; i < 2 * 64; i += NTHR) { const int dir = i >> 6, pp = i & 63; const size_t row = (size_t)((l * 2 + dir) * 16 + g) * 64 + pp; const float* T = S5T + row * 66; const float* PW = S5P + row * 34;
            for (int e = 0; e <= 16; ++e) { pw[((dir * 17 + e) * 64 + pp) * 2] = PW[2 * e]; pw[((dir * 17 + e) * 64 + pp) * 2 + 1] = PW[2 * e + 1]; }
            for (int ch = 0; ch < 16; ++ch) { bb[((dir * 64 + pp) * 16 + ch) * 2] = T[2 + ch]; bb[((dir * 64 + pp) * 16 + ch) * 2 + 1] = T[18 + ch]; cc[((dir * 16 + ch) * 64 + pp) * 2] = T[34 + ch]; cc[((dir * 16 + ch) * 64 + pp) * 2 + 1] = T[50 + ch]; } }
        __syncthreads();
        for (int i = c.tid; i < 2 * 16 * 256; i += NTHR) { const int dir = i >> 12, tau = (i >> 8) & 15, c1 = (i >> 4) & 15, c0 = i & 15; float s = 0.f;
            for (int pp = 0; pp < 64; ++pp) { const float cr = cc[((dir * 16 + c1) * 64 + pp) * 2], ci = cc[((dir * 16 + c1) * 64 + pp) * 2 + 1], pr = pw[((dir * 17 + tau) * 64 + pp) * 2], pi = pw[((dir * 17 + tau) * 64 + pp) * 2 + 1];
                const float wr_ = cr * pr - ci * pi, wi_ = cr * pi + ci * pr; s += wr_ * bb[((dir * 64 + pp) * 16 + c0) * 2] - wi_ * bb[((dir * 64 + pp) * 16 + c0) * 2 + 1]; }
            kt[i] = s; }
        __syncthreads();
        bf16* B1 = (bf16*)(c.ws + WS_S5W) + (size_t)(l * 16 + g) * 256 * 256;
        bf16* B2 = (bf16*)(c.ws + WS_S5W) + (size_t)32 * 256 * 256 + (size_t)(l * 16 + g) * 256 * 512;
        const float* dsk = p->in[I_S5D] + l * 256 + g * 16;
        for (int i = c.tid; i < 256 * 256; i += NTHR) { const int n = i >> 8, k = i & 255, dir = n >> 7, ri = (n >> 6) & 1, pp = n & 63, s = k >> 4, ch = k & 15, e = dir ? s : 15 - s;
            const float pr = pw[((dir * 17 + e) * 64 + pp) * 2], pi = pw[((dir * 17 + e) * 64 + pp) * 2 + 1], br = bb[((dir * 64 + pp) * 16 + ch) * 2], bi = bb[((dir * 64 + pp) * 16 + ch) * 2 + 1];
            B1[i] = f2bf(ri ? pr * bi + pi * br : pr * br - pi * bi); }
        for (int i = c.tid; i < 256 * 512; i += NTHR) { const int n = i >> 9, k = i & 511, t = n >> 4, c1 = n & 15; float v;
            if (k < 256) { const int s = k >> 4, c0 = k & 15; v = 0.f; if (s <= t) v += kt[((0 * 16 + (t - s)) * 16 + c1) * 16 + c0]; if (s >= t) v += kt[((1 * 16 + (s - t)) * 16 + c1) * 16 + c0]; if (s == t && c0 == c1) v += dsk[c0]; }
            else { const int q = k - 256, dir = q >> 7, ri = (q >> 6) & 1, pp = q & 63, e = dir ? 16 - t : t + 1;
                const float cr = cc[((dir * 16 + c1) * 64 + pp) * 2], ci = cc[((dir * 16 + c1) * 64 + pp) * 2 + 1], pr = pw[((dir * 17 + e) * 64 + pp) * 2], pi = pw[((dir * 17 + e) * 64 + pp) * 2 + 1];
                v = ri ? -(cr * pi + ci * pr) : (cr * pr - ci * pi); }
            B2[i] = f2bf(v); }
    }
    __syncthreads();
}
__device__ __forceinline__ void prologue2(const Ctx& c, KParams p) {
    prologue_s5_weights(c, p);
    for (int l = 0; l < 2; ++l) { unsigned char* sm = c.ws + WS_WSM + (size_t)l * WSM_L;
        tr_matrix<4>(c, p->in[I_WUKV] + (size_t)l * 128 * 512, 512, 128, 512, (bf16*)(sm + WSM_UK), 256, p->in[I_KVNG] + l * 128, 1.f); }
}

__device__ __forceinline__ void norm_row(const float* xrow, const float* gain, const float* sh, const float* sc, bf16* orow, int lane, f32x4 (&v)[4]) {
    float ss = 0.f;
#pragma unroll
    for (int j = 0; j < 4; ++j) { v[j] = *(const f32x4*)(xrow + 4 * lane + 256 * j); ss += (v[j].x * v[j].x + v[j].y * v[j].y) + (v[j].z * v[j].z + v[j].w * v[j].w); }
    const float rstd = rsqrtf(wave_sum(ss) * (1.f / 1024.f) + EPS);
#pragma unroll
    for (int j = 0; j < 4; ++j) { const int cc = 4 * lane + 256 * j; const f32x4 g = *(const f32x4*)(gain + cc), s1 = *(const f32x4*)(sc + cc), s0 = *(const f32x4*)(sh + cc);
        v[j] = v[j] * rstd * g * (s1 + 1.0f) + s0;
        u32x2 o; o.x = pk2(v[j].x, v[j].y); o.y = pk2(v[j].z, v[j].w); *(u32x2*)(orow + cc) = o; }
}
__device__ __forceinline__ void phase_norm1(const Ctx& c, KParams p, int l) {
    const float* MOD = (const float*)(c.ws + WS_MOD) + (size_t)l * 33 * 6144;
    const float* xl = l == 0 ? p->in[I_X] : p->out; const float* xc = l == 0 ? p->in[I_CTX] : (const float*)(c.ws + WS_XC);
    bf16* H = (bf16*)(c.ws + WS_H);
    const int gw = c.blk * NWAVES + c.wave, NGW = c.G * NWAVES;
    for (int r = gw; r < NTOK; r += NGW) { const float* xr = r < NLAT ? xl + (size_t)r * DM : xc + (size_t)(r - NLAT) * DM; const float* m = MOD + (size_t)mod_row(r) * 6144;
        f32x4 v[4]; norm_row(xr, p->in[I_N1G] + l * DM, m, m + 1024, H + (size_t)r * DM, c.lane, v); }
}

#define EPI_ARGS const f32x4 (&acc)[2][2][4][2], const pg8::Unit& u, int wr, int wc, int fr, int fq
#define EPI_ROWS for (int ai = 0; ai < 2; ++ai) _Pragma("unroll") for (int m = 0; m < 4; ++m)
struct EpiBf16 {
    bf16* O; int ldo;
    __device__ __forceinline__ void operator()(EPI_ARGS) const {
        const int r0 = u.pm * 256 + wr * 64 + fr, c0 = u.pn * 256 + wc * 32 + 8 * fq;
#pragma unroll
        EPI_ROWS { bf16* rp = O + (size_t)(r0 + ai * 128 + m * 16) * ldo + c0;
#pragma unroll
            for (int bj = 0; bj < 2; ++bj) { const f32x4 a = acc[ai][bj][m][0], b = acc[ai][bj][m][1]; u32x4 w; w.x = pk2(a.x, a.y); w.y = pk2(a.z, a.w); w.z = pk2(b.x, b.y); w.w = pk2(b.z, b.w); *(u32x4*)(rp + bj * 128) = w; } asm volatile("" ::: "memory"); }
    }
};
struct EpiInProj {
    bf16* O; bf16* UP; bf16* GVT;
    __device__ __forceinline__ void operator()(EPI_ARGS) const {
        const int r0 = u.pm * 256 + wr * 64 + fr, c0 = u.pn * 256 + wc * 32 + 8 * fq;
#pragma unroll
        EPI_ROWS { const int row = r0 + ai * 128 + m * 16; bf16* rp = O + (size_t)row * ZW + c0;
            const int crow = row < NLAT ? (row >> 11) * 144 + 16 + ((row & 2047) >> 4) : ((row - NLAT) >> 8) * 144 + (((row - NLAT) & 255) >> 4);
#pragma unroll
            for (int bj = 0; bj < 2; ++bj) { const f32x4 a = acc[ai][bj][m][0], b = acc[ai][bj][m][1]; u32x4 w; w.x = pk2(a.x, a.y); w.y = pk2(a.z, a.w); w.z = pk2(b.x, b.y); w.w = pk2(b.z, b.w); *(u32x4*)(rp + bj * 128) = w;
                if (u.pn == 5) { const int g = 8 * bj + 2 * wc + (fq >> 1); *(u32x4*)(UP + ((size_t)g * 4608 + crow) * 512 + fr * 16 + 8 * (fq & 1)) = w; }
                if (u.pn == 1) { const int col = 128 * bj + 32 * wc + 8 * fq, bb = row < NLAT ? (row >> 11) : ((row - NLAT) >> 8), kk = row < NLAT ? 256 + (row & 2047) : ((row - NLAT) & 255);
                    bf16* dst = GVT + ((size_t)(bb * 4 + (col >> 6)) * 64 + (col & 63)) * 2304 + (kk & ~15) + 8 * ((fr >> 2) & 1) + 4 * (fr >> 3) + (fr & 3);
#pragma unroll
                    for (int n = 0; n < 2; ++n)
#pragma unroll
                        for (int i = 0; i < 4; ++i) dst[(size_t)(4 * n + i) * 2304] = f2bf(acc[ai][bj][m][n][i]); } }
            asm volatile("" ::: "memory"); }
    }
};
struct EpiS5X {
    bf16* XE;
    __device__ __forceinline__ void operator()(EPI_ARGS) const {
        const int r0 = u.pm * 256 + wr * 64 + fr, c0 = wc * 32 + 8 * fq;
#pragma unroll
        EPI_ROWS { bf16* rp = XE + (size_t)(r0 + ai * 128 + m * 16) * 256 + c0;
#pragma unroll
            for (int bj = 0; bj < 2; ++bj) { const f32x4 a = acc[ai][bj][m][0], b = acc[ai][bj][m][1]; u32x4 w; w.x = pk2(a.x, a.y); w.y = pk2(a.z, a.w); w.z = pk2(b.x, b.y); w.w = pk2(b.z, b.w); *(u32x4*)(rp + bj * 128) = w; }
            asm volatile("" ::: "memory"); }
    }
};
struct EpiS5Y {
    bf16* Y;
    __device__ __forceinline__ void operator()(EPI_ARGS) const {
        const int r0 = u.pm * 256 + wr * 64 + fr;
#pragma unroll
        EPI_ROWS { const int grow = r0 + ai * 128 + m * 16; const int g = grow / 4608, rem = grow - g * 4608, b = rem / 144, ci = rem - b * 144;
            const int tok0 = ci < 16 ? NLAT + b * CTXL + ci * 16 : b * SEQ + (ci - 16) * 16;
#pragma unroll
            for (int bj = 0; bj < 2; ++bj) { const int t = 8 * bj + 2 * wc + (fq >> 1); const f32x4 a = acc[ai][bj][m][0], bq = acc[ai][bj][m][1]; u32x4 w; w.x = pk2(a.x, a.y); w.y = pk2(a.z, a.w); w.z = pk2(bq.x, bq.y); w.w = pk2(bq.z, bq.w);
                *(u32x4*)(Y + (size_t)(tok0 + t) * 256 + g * 16 + 8 * (fq & 1)) = w; }
            asm volatile("" ::: "memory"); }
    }
};
struct S5Order {
    int G, c; const char* W; size_t wstride;
    __device__ __forceinline__ bool next(int i, pg8::Unit& u) const { const int L = i * G + c; if (L >= 288) return false; u.pm = L; u.pn = 0; u.e = L / 18; u.B = W + (size_t)u.e * wstride; return true; }
};
struct EpiOB8 {
    unsigned char* OB;
    __device__ __forceinline__ void operator()(EPI_ARGS) const {
        const int r0 = u.pm * 256 + wr * 64 + fr;
#pragma unroll
        EPI_ROWS { unsigned char* rp = OB + (size_t)(r0 + ai * 128 + m * 16) * 1024 + u.pn * 256 + (wc * 4 + fq) * 16; u32x4 w;
#pragma unroll
            for (int bj = 0; bj < 2; ++bj)
#pragma unroll
                for (int n = 0; n < 2; ++n) { const f32x4 a = acc[ai][bj][m][n] * 16.0f; int pk = 0;
                    pk = __builtin_amdgcn_cvt_pk_fp8_f32(__builtin_amdgcn_fmed3f(a.x, -440.f, 440.f), __builtin_amdgcn_fmed3f(a.y, -440.f, 440.f), pk, false);
                    pk = __builtin_amdgcn_cvt_pk_fp8_f32(__builtin_amdgcn_fmed3f(a.z, -440.f, 440.f), __builtin_amdgcn_fmed3f(a.w, -440.f, 440.f), pk, true); w[2 * bj + n] = (unsigned)pk; }
            *(u32x4*)rp = w; asm volatile("" ::: "memory"); }
    }
};
struct EpiBiasBf16 {
    bf16* O; int ldo; const float* bias;
    __device__ __forceinline__ void operator()(EPI_ARGS) const {
        const int r0 = u.pm * 256 + wr * 64 + fr, c0 = u.pn * 256 + wc * 32 + 8 * fq;
        f32x4 bv[2][2];
#pragma unroll
        for (int bj = 0; bj < 2; ++bj) { bv[bj][0] = *(const f32x4*)(bias + c0 + bj * 128); bv[bj][1] = *(const f32x4*)(bias + c0 + bj * 128 + 4); }
#pragma unroll
        EPI_ROWS { bf16* rp = O + (size_t)(r0 + ai * 128 + m * 16) * ldo + c0;
#pragma unroll
            for (int bj = 0; bj < 2; ++bj) { const f32x4 a = acc[ai][bj][m][0] + bv[bj][0], b = acc[ai][bj][m][1] + bv[bj][1]; u32x4 w; w.x = pk2(a.x, a.y); w.y = pk2(a.z, a.w); w.z = pk2(b.x, b.y); w.w = pk2(b.z, b.w); *(u32x4*)(rp + bj * 128) = w; } asm volatile("" ::: "memory"); }
    }
};
struct EpiGluSig {
    bf16* O; int ldo; const float* bias;
    __device__ __forceinline__ void operator()(EPI_ARGS) const {
        const int r0 = u.pm * 256 + wr * 64 + fr, c0 = u.pn * 128 + wc * 32 + 8 * fq;
        f32x4 b1[2], b2[2];
#pragma unroll
        for (int n = 0; n < 2; ++n) { b1[n] = *(const f32x4*)(bias + c0 + 4 * n); b2[n] = *(const f32x4*)(bias + 256 + c0 + 4 * n); }
#pragma unroll
        EPI_ROWS { bf16* rp = O + (size_t)(r0 + ai * 128 + m * 16) * ldo + c0; float o[8];
#pragma unroll
            for (int n = 0; n < 2; ++n)
#pragma unroll
                for (int i = 0; i < 4; ++i) o[4 * n + i] = (acc[ai][0][m][n][i] + b1[n][i]) * sigmoidf_(acc[ai][1][m][n][i] + b2[n][i]);
            u32x4 w; w.x = pk2(o[0], o[1]); w.y = pk2(o[2], o[3]); w.z = pk2(o[4], o[5]); w.w = pk2(o[6], o[7]); *(u32x4*)rp = w; asm volatile("" ::: "memory"); }
    }
};
struct EpiSwiglu {
    bf16* O; int ldo;
    __device__ __forceinline__ void operator()(EPI_ARGS) const {
        const int r0 = u.pm * 256 + wr * 64 + fr, c0 = u.pn * 128 + wc * 32 + 8 * fq;
#pragma unroll
        EPI_ROWS { bf16* rp = O + (size_t)(r0 + ai * 128 + m * 16) * ldo + c0; float o[8];
#pragma unroll
            for (int n = 0; n < 2; ++n)
#pragma unroll
                for (int i = 0; i < 4; ++i) o[4 * n + i] = siluf_(acc[ai][0][m][n][i]) * acc[ai][1][m][n][i];
            u32x4 w; w.x = pk2(o[0], o[1]); w.y = pk2(o[2], o[3]); w.z = pk2(o[4], o[5]); w.w = pk2(o[6], o[7]); *(u32x4*)rp = w; asm volatile("" ::: "memory"); }
    }
};
struct EpiQ {
    bf16* Q; const float* RS; const float* ROPE;
    __device__ __forceinline__ void operator()(EPI_ARGS) const {
        const int r0 = u.pm * 256 + wr * 64 + fr;
#pragma unroll
        EPI_ROWS { const int row = r0 + ai * 128 + m * 16; const float rq = RS[(size_t)row * 2]; bf16* rp = Q + (size_t)row * 384;
            if (u.pn == 0) {
#pragma unroll
                for (int bj = 0; bj < 2; ++bj) { const int head = 2 * bj + (wc >> 1), d = 32 * (wc & 1) + 8 * fq; const f32x4 a = acc[ai][bj][m][0] * rq, b = acc[ai][bj][m][1] * rq;
                    u32x4 w; w.x = pk2(a.x, a.y); w.y = pk2(a.z, a.w); w.z = pk2(b.x, b.y); w.w = pk2(b.z, b.w); *(u32x4*)(rp + head * 96 + d) = w; }
            } else {
                float o[8];
#pragma unroll
                for (int n = 0; n < 2; ++n)
#pragma unroll
                    for (int i = 0; i < 4; ++i) { const float v = acc[ai][0][m][n][i] * rq; const float pv = shx<16>(v); float res = v;
                        if (row < NLAT) { const int t = row & 2047; const f32x2 cs = *(const f32x2*)(ROPE + ((t * 2 + (fq >> 1)) * 8 + 4 * n + i) * 2); res = (fq & 1) ? fmaf(v, cs.x, pv * cs.y) : fmaf(v, cs.x, -pv * cs.y); }
                        o[4 * n + i] = res; }
                u32x4 w; w.x = pk2(o[0], o[1]); w.y = pk2(o[2], o[3]); w.z = pk2(o[4], o[5]); w.w = pk2(o[6], o[7]); *(u32x4*)(rp + wc * 96 + 64 + 8 * fq) = w;
            } asm volatile("" ::: "memory"); }
    }
};
struct EpiKV {
    bf16* Kb; bf16* VT; const float* RS;
    __device__ __forceinline__ void operator()(EPI_ARGS) const {
        const int r0 = u.pm * 256 + wr * 64 + fr;
        const int p16 = 8 * ((fr >> 2) & 1) + 4 * (fr >> 3) + (fr & 3);
#pragma unroll
        EPI_ROWS { const int row = r0 + ai * 128 + m * 16; const float rk = RS[(size_t)row * 2 + 1];
            if (u.pn == 0) {
#pragma unroll
                for (int bj = 0; bj < 2; ++bj) { const int head = 2 * bj + (wc >> 1), d = 32 * (wc & 1) + 8 * fq; const f32x4 a = acc[ai][bj][m][0] * rk, b = acc[ai][bj][m][1] * rk;
                    u32x4 w; w.x = pk2(a.x, a.y); w.y = pk2(a.z, a.w); w.z = pk2(b.x, b.y); w.w = pk2(b.z, b.w);
                    *(u32x4*)(Kb + (size_t)row * 384 + head * 96 + d) = w; }
            } else {
                const int bb = row < NLAT ? (row >> 11) : ((row - NLAT) >> 8); const int kk = row < NLAT ? (row & 2047) : 2048 + ((row - NLAT) & 255);
                const int pos = (kk & ~15) + p16;
#pragma unroll
                for (int bj = 0; bj < 2; ++bj) { const int head = 2 * bj + (wc >> 1), d = 32 * (wc & 1) + 8 * fq; bf16* dst = VT + ((size_t)((bb * 4 + head) * 64 + d)) * 2304 + pos;
#pragma unroll
                    for (int n = 0; n < 2; ++n)
#pragma unroll
                        for (int i = 0; i < 4; ++i) dst[(size_t)(4 * n + i) * 2304] = f2bf(acc[ai][bj][m][n][i] * rk); }
            }
            asm volatile("" ::: "memory"); }
    }
};
struct EpiResid {
    const float* xl_in; const float* xc_in; float* xl_out; float* xc_out; const float* MODg;
    __device__ __forceinline__ void operator()(EPI_ARGS) const {
        const int rt = u.pm * 256; const bool lat = rt < NLAT;
        const float* g = MODg + (size_t)(lat ? (rt >> 11) : 32) * 6144;
        const float* xi = lat ? xl_in + (size_t)rt * DM : xc_in + (size_t)(rt - NLAT) * DM; float* xo = lat ? xl_out + (size_t)rt * DM : xc_out + (size_t)(rt - NLAT) * DM;
        const int r0 = wr * 64 + fr, c0 = u.pn * 256 + wc * 32 + 8 * fq;
        f32x4 gv[2][2];
#pragma unroll
        for (int bj = 0; bj < 2; ++bj) { gv[bj][0] = *(const f32x4*)(g + c0 + bj * 128); gv[bj][1] = *(const f32x4*)(g + c0 + bj * 128 + 4); }
#pragma unroll
        EPI_ROWS { const size_t o = (size_t)(r0 + ai * 128 + m * 16) * DM + c0;
#pragma unroll
            for (int bj = 0; bj < 2; ++bj)
#pragma unroll
                for (int n = 0; n < 2; ++n) { const f32x4 xv = *(const f32x4*)(xi + o + bj * 128 + 4 * n); *(f32x4*)(xo + o + bj * 128 + 4 * n) = xv + gv[bj][n] * acc[ai][bj][m][n]; } asm volatile("" ::: "memory"); }
    }
};

__device__ __forceinline__ int seq_row(int b, int dir, int pos) {
    if (pos < CTXL) return NLAT + b * CTXL + (dir ? CTXL - 1 - pos : pos);
    const int t = pos - CTXL; return b * SEQ + (dir ? SEQ - 1 - t : t);
}
__device__ __forceinline__ void phase_gla(const Ctx& c, KParams p, int l) {
    const bf16* Z = (const bf16*)(c.ws + WS_Z); const bf16* GVT = (const bf16*)(c.ws + WS_GVT); bf16* OG = (bf16*)(c.ws + WS_T1);
    const int w = c.wave, tid = c.tid;
    LAS float* wtab = (LAS float*)c.lds;
    LAS float* DD = (LAS float*)(c.lds + 4096);
    LAS unsigned char* RW = c.lds + 8192 + w * 13824;
    LAS float* LA = (LAS float*)RW;
    LAS unsigned char* KTT = RW + 9216;
    for (int u = c.blk; u < 256; u += c.G) {
        const int b = u >> 3, h = (u >> 1) & 3, dir = u & 1;
        __syncthreads();
        { const float* wa = p->in[I_GLAW] + ((size_t)(l * 2 + dir) * 16) * 128 + h * 32; wtab[tid] = wa[(tid >> 5) * 128 + (tid & 31)]; if (tid < 32) wtab[512 + tid] = p->in[I_GLAB][(l * 2 + dir) * 128 + h * 32 + tid]; }
        float Sst[4] = {0.f, 0.f, 0.f, 0.f};
        __syncthreads();
        for (int gi = 0; gi < 5; ++gi) {
            const int pc = gi * 8 + w; const bool active = pc < 36;
            int lane_ = c.lane; asm volatile("" : "+v"(lane_));
            const int r = lane_ & 31, hh = lane_ >> 5;
            const int p16 = 8 * ((r >> 2) & 1) + 4 * ((r & 15) >> 3) + (r & 3);
            const int pos0 = (r & 16) + p16, pos1 = 32 + pos0;
            bf16x8 qd[2][2]; f32x16 oacc[2][2]; int row0 = 0;
            if (active) {
                int kk0;
                if (dir == 0) { if (pc < 4) { row0 = NLAT + b * CTXL + pc * 64; kk0 = pc * 64; } else { row0 = b * SEQ + (pc - 4) * 64; kk0 = 256 + (pc - 4) * 64; } }
                else { if (pc < 4) { row0 = NLAT + b * CTXL + (3 - pc) * 64; kk0 = (3 - pc) * 64; } else { row0 = b * SEQ + (35 - pc) * 64; kk0 = 256 + (35 - pc) * 64; } }
#pragma unroll
                for (int ib = 0; ib < 2; ++ib) { const bf16* zr = Z + (size_t)(row0 + 32 * ib + r) * ZW; float al[16]; { const u32x4 a0 = *(const u32x4*)(zr + ZAF + dir * 16), a1 = *(const u32x4*)(zr + ZAF + dir * 16 + 8); float t8[8]; unpack8(a0, t8);
#pragma unroll
                        for (int j = 0; j < 8; ++j) al[j] = t8[j];
                        unpack8(a1, t8);
#pragma unroll
                        for (int j = 0; j < 8; ++j) al[8 + j] = t8[j]; }
#pragma unroll
                    for (int ks = 0; ks < 2; ++ks) { float za[8]; { const f32x4 b0 = *(const LAS f32x4*)(wtab + 512 + 16 * ks + 8 * hh), b1 = *(const LAS f32x4*)(wtab + 512 + 16 * ks + 8 * hh + 4);
                            za[0] = b0.x; za[1] = b0.y; za[2] = b0.z; za[3] = b0.w; za[4] = b1.x; za[5] = b1.y; za[6] = b1.z; za[7] = b1.w; }
#pragma unroll
                        for (int j = 0; j < 16; ++j) { const f32x4 w0 = *(const LAS f32x4*)(wtab + j * 32 + 16 * ks + 8 * hh), w1 = *(const LAS f32x4*)(wtab + j * 32 + 16 * ks + 8 * hh + 4);
                            za[0] = fmaf(al[j], w0.x, za[0]); za[1] = fmaf(al[j], w0.y, za[1]); za[2] = fmaf(al[j], w0.z, za[2]); za[3] = fmaf(al[j], w0.w, za[3]);
                            za[4] = fmaf(al[j], w1.x, za[4]); za[5] = fmaf(al[j], w1.y, za[5]); za[6] = fmaf(al[j], w1.z, za[6]); za[7] = fmaf(al[j], w1.w, za[7]); }
                        float la[8];
#pragma unroll
                        for (int e = 0; e < 8; ++e) la[e] = (fminf(za[e], 0.f) - __logf(1.f + __expf(-fabsf(za[e])))) * 0.0625f;
                        *(LAS f32x4*)(LA + (32 * ib + r) * 36 + 16 * ks + 8 * hh) = (f32x4){la[0], la[1], la[2], la[3]}; *(LAS f32x4*)(LA + (32 * ib + r) * 36 + 16 * ks + 8 * hh + 4) = (f32x4){la[4], la[5], la[6], la[7]}; } }
                lds_wait();
                { float bend; float v[32], s = 0.f;
#pragma unroll
                  for (int qq = 0; qq < 32; ++qq) { const int q = 32 * hh + qq, i = dir ? 63 - q : q; v[qq] = LA[i * 36 + r]; s += v[qq]; }
                  const auto sw = __builtin_amdgcn_permlane32_swap(__float_as_uint(s), __float_as_uint(s), false, false);
                  const float h0 = __uint_as_float(sw[0]), h1 = __uint_as_float(sw[1]); bend = h0 + h1;
                  float run = hh ? h0 : 0.f;
#pragma unroll
                  for (int qq = 0; qq < 32; ++qq) { const int q = 32 * hh + qq, i = dir ? 63 - q : q; run += v[qq]; LA[i * 36 + r] = run; }
                  if (hh == 0) DD[w * 32 + r] = __expf(bend); }
                lds_wait();
                bf16x8 ki[2][2];
#pragma unroll
                for (int ib = 0; ib < 2; ++ib) { const bf16* zr = Z + (size_t)(row0 + 32 * ib + r) * ZW;
#pragma unroll
                    for (int ks = 0; ks < 2; ++ks) { const int dk0 = 16 * ks + 8 * hh; float q8[8], k8[8], b8[8]; unpack8(*(const u32x4*)(zr + ZQ + h * 32 + dk0), q8); unpack8(*(const u32x4*)(zr + ZK + h * 32 + dk0), k8);
                        { const f32x4 x0 = *(const LAS f32x4*)(LA + (32 * ib + r) * 36 + dk0), x1 = *(const LAS f32x4*)(LA + (32 * ib + r) * 36 + dk0 + 4); b8[0] = x0.x; b8[1] = x0.y; b8[2] = x0.z; b8[3] = x0.w; b8[4] = x1.x; b8[5] = x1.y; b8[6] = x1.z; b8[7] = x1.w; }
                        float qo[8], ko[8];
#pragma unroll
                        for (int e = 0; e < 8; ++e) { const float eb = __expf(b8[e]), ieb = 1.f / eb; qo[e] = q8[e] * 0.17677669529663687f * eb; ko[e] = k8[e] * ieb;
                            *(LAS bf16*)(KTT + ((dk0 + e) * 72 + (ib ? pos1 : pos0)) * 2) = f2bf(ko[e] * DD[w * 32 + dk0 + e]); }
                        u32x4 wq, wk; wq.x = pk2(qo[0], qo[1]); wq.y = pk2(qo[2], qo[3]); wq.z = pk2(qo[4], qo[5]); wq.w = pk2(qo[6], qo[7]); wk.x = pk2(ko[0], ko[1]); wk.y = pk2(ko[2], ko[3]); wk.z = pk2(ko[4], ko[5]); wk.w = pk2(ko[6], ko[7]);
                        qd[ib][ks] = __builtin_bit_cast(bf16x8, wq); ki[ib][ks] = __builtin_bit_cast(bf16x8, wk); } }
                bf16x8 vt[2][4];
#pragma unroll
                for (int db = 0; db < 2; ++db)
#pragma unroll
                    for (int s4 = 0; s4 < 4; ++s4) vt[db][s4] = *(const bf16x8*)(GVT + ((size_t)(b * 4 + h) * 64 + 32 * db + r) * 2304 + kk0 + 16 * s4 + 8 * hh);
                f32x16 zero16;
#pragma unroll
                for (int i = 0; i < 16; ++i) zero16[i] = 0.f;
                f32x16 a00 = __builtin_amdgcn_mfma_f32_32x32x16_bf16(ki[0][0], qd[0][0], zero16, 0, 0, 0); a00 = __builtin_amdgcn_mfma_f32_32x32x16_bf16(ki[0][1], qd[0][1], a00, 0, 0, 0);
                f32x16 a11 = __builtin_amdgcn_mfma_f32_32x32x16_bf16(ki[1][0], qd[1][0], zero16, 0, 0, 0); a11 = __builtin_amdgcn_mfma_f32_32x32x16_bf16(ki[1][1], qd[1][1], a11, 0, 0, 0);
                f32x16 aof;
                if (dir == 0) { aof = __builtin_amdgcn_mfma_f32_32x32x16_bf16(ki[0][0], qd[1][0], zero16, 0, 0, 0); aof = __builtin_amdgcn_mfma_f32_32x32x16_bf16(ki[0][1], qd[1][1], aof, 0, 0, 0); }
                else { aof = __builtin_amdgcn_mfma_f32_32x32x16_bf16(ki[1][0], qd[0][0], zero16, 0, 0, 0); aof = __builtin_amdgcn_mfma_f32_32x32x16_bf16(ki[1][1], qd[0][1], aof, 0, 0, 0); }
#pragma unroll
                for (int i = 0; i < 16; ++i) { const int j = (i & 3) + 8 * (i >> 2) + 4 * hh; const bool keep = dir ? (j >= r) : (j <= r); a00[i] = keep ? a00[i] : 0.f; a11[i] = keep ? a11[i] : 0.f; }
#define GLA_P(X, s) ({ u32x4 w_; w_.x = pk2((X)[8 * (s)], (X)[8 * (s) + 1]); w_.y = pk2((X)[8 * (s) + 2], (X)[8 * (s) + 3]); w_.z = pk2((X)[8 * (s) + 4], (X)[8 * (s) + 5]); w_.w = pk2((X)[8 * (s) + 6], (X)[8 * (s) + 7]); __builtin_bit_cast(bf16x8, w_); })
                const bf16x8 p00a = GLA_P(a00, 0), p00b = GLA_P(a00, 1), p11a = GLA_P(a11, 0), p11b = GLA_P(a11, 1), pofa = GLA_P(aof, 0), pofb = GLA_P(aof, 1);
#pragma unroll
                for (int db = 0; db < 2; ++db) {
                    f32x16 o0 = __builtin_amdgcn_mfma_f32_32x32x16_bf16(vt[db][0], p00a, zero16, 0, 0, 0); o0 = __builtin_amdgcn_mfma_f32_32x32x16_bf16(vt[db][1], p00b, o0, 0, 0, 0);
                    f32x16 o1 = __builtin_amdgcn_mfma_f32_32x32x16_bf16(vt[db][2], p11a, zero16, 0, 0, 0); o1 = __builtin_amdgcn_mfma_f32_32x32x16_bf16(vt[db][3], p11b, o1, 0, 0, 0);
                    if (dir == 0) { o1 = __builtin_amdgcn_mfma_f32_32x32x16_bf16(vt[db][0], pofa, o1, 0, 0, 0); o1 = __builtin_amdgcn_mfma_f32_32x32x16_bf16(vt[db][1], pofb, o1, 0, 0, 0); }
                    else { o0 = __builtin_amdgcn_mfma_f32_32x32x16_bf16(vt[db][2], pofa, o0, 0, 0, 0); o0 = __builtin_amdgcn_mfma_f32_32x32x16_bf16(vt[db][3], pofb, o0, 0, 0, 0); }
                    oacc[db][0] = o0; oacc[db][1] = o1; }
#undef GLA_P
                lds_wait();
                bf16x8 kf[4];
#pragma unroll
                for (int s4 = 0; s4 < 4; ++s4) kf[s4] = *(const LAS bf16x8*)(KTT + (r * 72 + 16 * s4 + 8 * hh) * 2);
#pragma unroll
                for (int db = 0; db < 2; ++db) { f32x16 uu = __builtin_amdgcn_mfma_f32_32x32x16_bf16(vt[db][0], kf[0], zero16, 0, 0, 0);
#pragma unroll
                    for (int s4 = 1; s4 < 4; ++s4) uu = __builtin_amdgcn_mfma_f32_32x32x16_bf16(vt[db][s4], kf[s4], uu, 0, 0, 0);
#pragma unroll
                    for (int i = 0; i < 16; ++i) LA[(32 * db + (i & 3) + 8 * (i >> 2) + 4 * hh) * 32 + r] = uu[i]; }
            }
            __syncthreads();
            const int dv2 = tid >> 3, dk4 = (tid & 7) * 4;
            f32x4 ur[8], dr[8];
#pragma unroll
            for (int cc = 0; cc < 8; ++cc) { ur[cc] = *(const LAS f32x4*)((LAS float*)(c.lds + 8192 + cc * 13824) + dv2 * 32 + dk4); dr[cc] = *(const LAS f32x4*)(DD + cc * 32 + dk4); }
            __syncthreads();
#pragma unroll
            for (int cc = 0; cc < 8; ++cc) if (gi * 8 + cc < 36) { u32x2 sp; sp.x = pk2(Sst[0], Sst[1]); sp.y = pk2(Sst[2], Sst[3]); *(LAS u32x2*)(c.lds + 8192 + cc * 13824 + (dv2 * 40 + dk4) * 2) = sp;
                Sst[0] = fmaf(dr[cc].x, Sst[0], ur[cc].x); Sst[1] = fmaf(dr[cc].y, Sst[1], ur[cc].y); Sst[2] = fmaf(dr[cc].z, Sst[2], ur[cc].z); Sst[3] = fmaf(dr[cc].w, Sst[3], ur[cc].w); }
            __syncthreads();
            if (active) {
#pragma unroll
                for (int db = 0; db < 2; ++db) { const bf16x8 s0 = *(const LAS bf16x8*)(RW + ((32 * db + r) * 40 + 8 * hh) * 2), s1 = *(const LAS bf16x8*)(RW + ((32 * db + r) * 40 + 16 + 8 * hh) * 2);
#pragma unroll
                    for (int ib = 0; ib < 2; ++ib) { oacc[db][ib] = __builtin_amdgcn_mfma_f32_32x32x16_bf16(s0, qd[ib][0], oacc[db][ib], 0, 0, 0); oacc[db][ib] = __builtin_amdgcn_mfma_f32_32x32x16_bf16(s1, qd[ib][1], oacc[db][ib], 0, 0, 0); } }
#pragma unroll
                for (int ib = 0; ib < 2; ++ib) { bf16* orow = OG + ((size_t)dir * NTOK + row0 + 32 * ib + r) * 256 + h * 64 + 4 * hh;
#pragma unroll
                    for (int db = 0; db < 2; ++db)
#pragma unroll
                        for (int g4 = 0; g4 < 4; ++g4) { u32x2 wv; wv.x = pk2(oacc[db][ib][4 * g4], oacc[db][ib][4 * g4 + 1]); wv.y = pk2(oacc[db][ib][4 * g4 + 2], oacc[db][ib][4 * g4 + 3]); *(u32x2*)(orow + 32 * db + 8 * g4) = wv; } }
                lds_wait();
            }
        }
    }
    __syncthreads();
}
__device__ __forceinline__ void phase_gla_final(const Ctx& c, KParams p, int l, int nrows) {
    const bf16* Z = (const bf16*)(c.ws + WS_Z); const bf16* OG = (const bf16*)(c.ws + WS_T1); bf16* MIX = (bf16*)(c.ws + WS_MIX);
    const int gw = c.blk * NWAVES + c.wave, NGW = c.G * NWAVES; const f32x4 g = *(const f32x4*)(p->in[I_GLAG] + l * 256 + 4 * c.lane);
    for (int r = gw; r < nrows; r += NGW) {
        const u32x2 of = *(const u32x2*)(OG + (size_t)r * 256 + 4 * c.lane), ob = *(const u32x2*)(OG + ((size_t)NTOK + r) * 256 + 4 * c.lane);
        f32x4 o = (f32x4){__uint_as_float(of.x << 16) + __uint_as_float(ob.x << 16), __uint_as_float(of.x & 0xffff0000u) + __uint_as_float(ob.x & 0xffff0000u),
                          __uint_as_float(of.y << 16) + __uint_as_float(ob.y << 16), __uint_as_float(of.y & 0xffff0000u) + __uint_as_float(ob.y & 0xffff0000u)};
        float ss = (o.x * o.x + o.y * o.y) + (o.z * o.z + o.w * o.w);
        ss += shx<1>(ss); ss += shx<2>(ss); ss += shx<4>(ss); ss += shx<8>(ss);
        const float rstd = rsqrtf(ss * (1.f / 64.f) + EPS);
        const u32x2 rg = *(const u32x2*)(Z + (size_t)r * ZW + ZR + 4 * c.lane);
        const float g0 = __uint_as_float(rg.x << 16), g1 = __uint_as_float(rg.x & 0xffff0000u), g2 = __uint_as_float(rg.y << 16), g3 = __uint_as_float(rg.y & 0xffff0000u);
        u32x2 w; w.x = pk2(o.x * rstd * g.x * siluf_(g0), o.y * rstd * g.y * siluf_(g1)); w.y = pk2(o.z * rstd * g.z * siluf_(g2), o.w * rstd * g.w * siluf_(g3));
        *(u32x2*)(MIX + (size_t)r * DM + 4 * c.lane) = w;
    }
}

__device__ __forceinline__ void phase_conv1(const Ctx& c, KParams p, int l, bool with_ctx) {
    const bf16* Z = (const bf16*)(c.ws + WS_Z); bf16* CV = (bf16*)(c.ws + WS_CV);
    LAS float* glu = (LAS float*)c.lds;
    LAS float* dws = glu + 62 * 256;
    for (int i = c.tid; i < 31 * 256; i += NTHR) dws[i] = p->in[I_CDW][(size_t)l * 31 * 256 + i];
    const int ntiles = with_ctx ? 2048 + 256 : 2048;
    const f32x4 dwb = *(const f32x4*)(p->in[I_CDB] + l * 256 + 4 * c.lane), lg = *(const f32x4*)(p->in[I_CLG] + l * 256 + 4 * c.lane), lb = *(const f32x4*)(p->in[I_CLB] + l * 256 + 4 * c.lane);
    for (int tile = c.blk; tile < ntiles; tile += c.G) {
        int rowbase, t0, slen;
        if (tile < 2048) { const int b = tile >> 6; rowbase = b * SEQ; t0 = (tile & 63) * 32; slen = SEQ; } else { const int q = tile - 2048, b = q >> 3; rowbase = NLAT + b * CTXL; t0 = (q & 7) * 32; slen = CTXL; }
        __syncthreads();
        for (int idx = c.tid; idx < 62 * 64; idx += NTHR) { const int j = idx >> 6, c4 = (idx & 63) * 4, t = t0 - 15 + j; f32x4 v = (f32x4){0.f, 0.f, 0.f, 0.f};
            if (t >= 0 && t < slen) { const bf16* zr = Z + (size_t)(rowbase + t) * ZW; const u32x2 a = *(const u32x2*)(zr + ZCA + c4), g = *(const u32x2*)(zr + ZCG + c4);
                v.x = __uint_as_float(a.x << 16) * sigmoidf_(__uint_as_float(g.x << 16)); v.y = __uint_as_float(a.x & 0xffff0000u) * sigmoidf_(__uint_as_float(g.x & 0xffff0000u));
                v.z = __uint_as_float(a.y << 16) * sigmoidf_(__uint_as_float(g.y << 16)); v.w = __uint_as_float(a.y & 0xffff0000u) * sigmoidf_(__uint_as_float(g.y & 0xffff0000u)); }
            *(LAS f32x4*)(glu + j * 256 + c4) = v; }
        __syncthreads();
        for (int q = 0; q < 4; ++q) { const int i = c.wave * 4 + q; f32x4 a = dwb;
            for (int j = 0; j < 31; ++j) a += *(const LAS f32x4*)(glu + (i + j) * 256 + 4 * c.lane) * *(const LAS f32x4*)(dws + j * 256 + 4 * c.lane);
            const float mu = wave_sum((a.x + a.y) + (a.z + a.w)) * (1.f / 256.f); const f32x4 dlt = a - mu;
            const float var = wave_sum((dlt.x * dlt.x + dlt.y * dlt.y) + (dlt.z * dlt.z + dlt.w * dlt.w)) * (1.f / 256.f); const float rstd = rsqrtf(var + EPS);
            const f32x4 y = dlt * rstd * lg + lb;
            u32x2 w; w.x = pk2(siluf_(y.x), siluf_(y.y)); w.y = pk2(siluf_(y.z), siluf_(y.w));
            *(u32x2*)(CV + (size_t)(rowbase + t0 + i) * 256 + 4 * c.lane) = w; }
    }
    __syncthreads();
}

__device__ __forceinline__ void phase_s5_carry(const Ctx& c, int l) {
    const bf16* XE = (const bf16*)(c.ws + WS_Y5); bf16* UP = (bf16*)(c.ws + WS_UP); const float* S5P = (const float*)(c.ws + WS_S5P);
    for (int i = c.blk * NTHR + c.tid; i < NB * 2 * 16 * 64; i += c.G * NTHR) {
        const int pp = i & 63, g = (i >> 6) & 15, dir = (i >> 10) & 1, b = i >> 11;
        const float* PW = S5P + ((size_t)((l * 2 + dir) * 16 + g) * 64 + pp) * 34 + 32; const float ar = PW[0], ai = PW[1];
        const size_t rbase = (size_t)g * 4608 + (size_t)b * 144; float xr = 0.f, xi = 0.f;
        for (int s0 = 0; s0 < 144; s0 += 8) {
            float er[8], ei[8];
#pragma unroll
            for (int q = 0; q < 8; ++q) { const int s = s0 + q; const int ci = dir == 0 ? s : (s < 16 ? 15 - s : 159 - s); const bf16* xe = XE + (rbase + ci) * 256 + dir * 128 + pp; er[q] = bf2f(xe[0]); ei[q] = bf2f(xe[64]); }
#pragma unroll
            for (int q = 0; q < 8; ++q) { const int s = s0 + q; const int ci = dir == 0 ? s : (s < 16 ? 15 - s : 159 - s); bf16* up = UP + (rbase + ci) * 512 + 256 + dir * 128 + pp; up[0] = f2bf(xr); up[64] = f2bf(xi);
                const float nr = ar * xr - ai * xi + er[q], ni = ar * xi + ai * xr + ei[q]; xr = nr; xi = ni; }
        }
    }
}

__device__ __forceinline__ void phase_mla_prep(const Ctx& c, KParams p) {
    const bf16* Z = (const bf16*)(c.ws + WS_Z); float* RS = (float*)(c.ws + WS_RS); bf16* Kb = (bf16*)(c.ws + WS_H) + (size_t)NTOK * 384; const float* ROPE = (const float*)(c.ws + WS_TAB + TAB_ROPE);
    const int gw = c.blk * NWAVES + c.wave, NGW = c.G * NWAVES, lane = c.lane;
    for (int r = gw; r < NTOK; r += NGW) { const bf16* zr = Z + (size_t)r * ZW;
        const u32x2 q4 = *(const u32x2*)(zr + ZCQ + 4 * lane); const unsigned k2 = *(const unsigned*)(zr + ZCKV + 2 * lane);
        const float a0 = __uint_as_float(q4.x << 16), a1 = __uint_as_float(q4.x & 0xffff0000u), a2 = __uint_as_float(q4.y << 16), a3 = __uint_as_float(q4.y & 0xffff0000u);
        const float b0 = __uint_as_float(k2 << 16), b1 = __uint_as_float(k2 & 0xffff0000u);
        const float sq = wave_sum((a0 * a0 + a1 * a1) + (a2 * a2 + a3 * a3)), sk = wave_sum(b0 * b0 + b1 * b1);
        if (lane == 0) { RS[(size_t)r * 2] = rsqrtf(sq * (1.f / 256.f) + EPS); RS[(size_t)r * 2 + 1] = rsqrtf(sk * (1.f / 128.f) + EPS); }
        const int d = lane & 31; const float x = bf2f(zr[ZKR + d]); const float px = shx<8>(x); float o = x;
        if (r < NLAT) { const int t = r & 2047, ax = d >> 4, f = d & 7; const f32x2 cs = *(const f32x2*)(ROPE + ((t * 2 + ax) * 8 + f) * 2); o = (d & 8) ? fmaf(x, cs.x, px * cs.y) : fmaf(x, cs.x, -px * cs.y); }
        const bf16 ob = f2bf(o); bf16* kr = Kb + (size_t)r * 384 + 64 + d;
        if (lane < 32) { kr[0] = ob; kr[96] = ob; kr[192] = ob; kr[288] = ob; }
    }
}
__device__ __forceinline__ void phase_attn(const Ctx& c, bool with_ctx) {
    const bf16* Qb = (const bf16*)(c.ws + WS_H); const bf16* Kb = Qb + (size_t)NTOK * 384; const bf16* VT = Kb + (size_t)NTOK * 384; bf16* MIX = (bf16*)(c.ws + WS_MIX);
    constexpr int KROW = 208, VROW = 144, KBUF = 64 * KROW, VBUF = 64 * VROW;
    LAS unsigned char* Kt = c.lds; LAS unsigned char* Vt = c.lds + 2 * KBUF;
    const int lane = c.lane, ln = lane & 31, hh = lane >> 5, tid = c.tid;
    const int nunits = with_ctx ? 1152 : 1024;
    for (int L = c.blk; L < nunits; L += c.G) {
        int u = L;
        if (c.G == 256 && L < 1024) { const int r = L >> 8, x = L & 7, j = (L & 255) >> 3; u = ((r * 32 + x * 4 + (j >> 3)) << 3) | (j & 7); }
        int b, h, qrow0, kt0, nkt;
        if (u < 1024) { b = u >> 5; h = (u >> 3) & 3; qrow0 = b * SEQ + (u & 7) * 256; kt0 = 0; nkt = 36; } else { const int q = u - 1024; b = q >> 2; h = q & 3; qrow0 = NLAT + b * CTXL; kt0 = 32; nkt = 4; }
        const bf16* vtb = VT + (size_t)((b * 4 + h) * 64) * 2304;
        bf16x8 qf[6];
        { const bf16* qr = Qb + (size_t)(qrow0 + 32 * c.wave + ln) * 384 + h * 96 + 8 * hh;
#pragma unroll
          for (int ks = 0; ks < 6; ++ks) qf[ks] = *(const bf16x8*)(qr + 16 * ks); }
        f32x16 oacc[2];
#pragma unroll
        for (int i = 0; i < 16; ++i) { oacc[0][i] = 0.f; oacc[1][i] = 0.f; }
        float mrun = -1e30f, lsum = 0.f;
        const int k0key = tid / 12, k0pt = tid % 12, k1key = (512 + tid) / 12, k1pt = (512 + tid) % 12; const bool k1on = tid < 256;
        u32x4 sk0, sk1 = (u32x4){0u, 0u, 0u, 0u}, sv;
        auto key_row = [&](int kt, int j) -> int { const int kk = kt * 64 + j; return kk < 2048 ? b * SEQ + kk : NLAT + b * CTXL + (kk - 2048); };
#define ATT_LOAD(kt) do { sk0 = *(const u32x4*)(Kb + (size_t)key_row((kt), k0key) * 384 + h * 96 + k0pt * 8); if (k1on) sk1 = *(const u32x4*)(Kb + (size_t)key_row((kt), k1key) * 384 + h * 96 + k1pt * 8); \
        sv = *(const u32x4*)(vtb + (size_t)(tid >> 3) * 2304 + (kt) * 64 + (tid & 7) * 8); } while (0)
#define ATT_STORE(buf) do { *(LAS u32x4*)(Kt + (buf) * KBUF + k0key * KROW + k0pt * 16) = sk0; if (k1on) *(LAS u32x4*)(Kt + (buf) * KBUF + k1key * KROW + k1pt * 16) = sk1; \
        *(LAS u32x4*)(Vt + (buf) * VBUF + (tid >> 3) * VROW + (tid & 7) * 16) = sv; } while (0)
        __syncthreads();
        ATT_LOAD(kt0); ATT_STORE(0);
        __syncthreads();
        for (int it = 0; it < nkt; ++it) {
            const int cur = it & 1;
            if (it + 1 < nkt) ATT_LOAD(kt0 + it + 1);
            f32x16 sacc[2];
#pragma unroll
            for (int kb = 0; kb < 2; ++kb) {
#pragma unroll
                for (int i = 0; i < 16; ++i) sacc[kb][i] = 0.f;
#pragma unroll
                for (int ks = 0; ks < 6; ++ks) { const bf16x8 a = *(const LAS bf16x8*)(Kt + cur * KBUF + (32 * kb + ln) * KROW + ks * 32 + hh * 16);
                    sacc[kb] = __builtin_amdgcn_mfma_f32_32x32x16_bf16(a, qf[ks], sacc[kb], 0, 0, 0); } }
            float mx = sacc[0][0];
#pragma unroll
            for (int i = 1; i < 16; ++i) mx = fmaxf(mx, sacc[0][i]);
#pragma unroll
            for (int i = 0; i < 16; ++i) mx = fmaxf(mx, sacc[1][i]);
            { const auto r = __builtin_amdgcn_permlane32_swap(__float_as_uint(mx), __float_as_uint(mx), false, false); mx = fmaxf(__uint_as_float(r[0]), __uint_as_float(r[1])); }
            const float mnew = fmaxf(mrun, mx), alpha = __builtin_amdgcn_exp2f(mrun - mnew); mrun = mnew;
            float ps = 0.f;
#pragma unroll
            for (int kb = 0; kb < 2; ++kb)
#pragma unroll
                for (int i = 0; i < 16; ++i) { const float pv = __builtin_amdgcn_exp2f(sacc[kb][i] - mnew); sacc[kb][i] = pv; ps += pv; }
            lsum = lsum * alpha + ps;
#pragma unroll
            for (int i = 0; i < 16; ++i) { oacc[0][i] *= alpha; oacc[1][i] *= alpha; }
            bf16x8 pb[4];
#pragma unroll
            for (int s4 = 0; s4 < 4; ++s4) { const int kb = s4 >> 1, o8 = 8 * (s4 & 1); u32x4 w;
                w.x = pk2(sacc[kb][o8 + 0], sacc[kb][o8 + 1]); w.y = pk2(sacc[kb][o8 + 2], sacc[kb][o8 + 3]); w.z = pk2(sacc[kb][o8 + 4], sacc[kb][o8 + 5]); w.w = pk2(sacc[kb][o8 + 6], sacc[kb][o8 + 7]);
                pb[s4] = __builtin_bit_cast(bf16x8, w); }
#pragma unroll
            for (int db = 0; db < 2; ++db)
#pragma unroll
                for (int s4 = 0; s4 < 4; ++s4) { const bf16x8 a = *(const LAS bf16x8*)(Vt + cur * VBUF + (32 * db + ln) * VROW + s4 * 32 + hh * 16);
                    oacc[db] = __builtin_amdgcn_mfma_f32_32x32x16_bf16(a, pb[s4], oacc[db], 0, 0, 0); }
            if (it + 1 < nkt) ATT_STORE(cur ^ 1);
            __syncthreads();
        }
#undef ATT_LOAD
#undef ATT_STORE
        { const auto r = __builtin_amdgcn_permlane32_swap(__float_as_uint(lsum), __float_as_uint(lsum), false, false); lsum = __uint_as_float(r[0]) + __uint_as_float(r[1]); }
        const float inv = 1.f / lsum;
        bf16* dst = MIX + (size_t)(qrow0 + 32 * c.wave + ln) * DM + 768 + h * 64 + 4 * hh;
#pragma unroll
        for (int db = 0; db < 2; ++db)
#pragma unroll
            for (int g4 = 0; g4 < 4; ++g4) { u32x2 w; w.x = pk2(oacc[db][4 * g4] * inv, oacc[db][4 * g4 + 1] * inv); w.y = pk2(oacc[db][4 * g4 + 2] * inv, oacc[db][4 * g4 + 3] * inv);
                *(u32x2*)(dst + 32 * db + 8 * g4) = w; }
    }
    __syncthreads();
}

__device__ __forceinline__ void phase_norm2_route(const Ctx& c, KParams p, int l, int ntok) {
    const float* MOD = (const float*)(c.ws + WS_MOD) + (size_t)l * 33 * 6144;
    const float* xl = p->out; const float* xc = (const float*)(c.ws + WS_XC);
    bf16* H = (bf16*)(c.ws + WS_H);
    int* TKEP = (int*)(c.ws + WS_RT + RT_TKEP); float* TKW = (float*)(c.ws + WS_RT + RT_TKW); int* TB = (int*)(c.ws + WS_TB);
    int* CNT = (int*)(c.ws + WS_CTL) + CW_CNT + l * NCH * NE;
    constexpr int HROW = 1032;
    LAS bf16* hhi = (LAS bf16*)c.lds;
    LAS bf16* hlo = hhi + 32 * HROW;
    LAS float* lgs = (LAS float*)(c.lds + 132096);
    LAS int* hist = (LAS int*)(c.lds + 140288);
    const bf16* Whi = (const bf16*)(c.ws + WS_TAB + TAB_RWT) + (size_t)(l * 2) * 65536; const bf16* Wlo = Whi + 65536;
    const float rbias = p->in[I_RB][l * 64 + c.lane];
    const int ntiles = ntok / 32, rpc = ntok / NCH, lane = c.lane, mb = c.wave >> 2, nb = c.wave & 3;
    for (int tile = c.blk; tile < ntiles; tile += c.G) {
        __syncthreads();
        if (c.tid < 64) hist[c.tid] = 0;
        for (int q = 0; q < 4; ++q) { const int r = tile * 32 + c.wave * 4 + q; const float* xr = r < NLAT ? xl + (size_t)r * DM : xc + (size_t)(r - NLAT) * DM; const float* m = MOD + (size_t)mod_row(r) * 6144;
            f32x4 v[4]; norm_row(xr, p->in[I_N2G] + l * DM, m + 3072, m + 4096, H + (size_t)r * DM, lane, v);
#pragma unroll
            for (int j = 0; j < 4; ++j) { u32x2 hi; hi.x = pk2(v[j].x, v[j].y); hi.y = pk2(v[j].z, v[j].w);
                const float r0 = v[j].x - __uint_as_float(hi.x << 16), r1 = v[j].y - __uint_as_float(hi.x & 0xffff0000u), r2 = v[j].z - __uint_as_float(hi.y << 16), r3 = v[j].w - __uint_as_float(hi.y & 0xffff0000u);
                u32x2 lo; lo.x = pk2(r0, r1); lo.y = pk2(r2, r3);
                *(LAS u32x2*)(hhi + (c.wave * 4 + q) * HROW + 4 * lane + 256 * j) = hi; *(LAS u32x2*)(hlo + (c.wave * 4 + q) * HROW + 4 * lane + 256 * j) = lo; } }
        __syncthreads();
        { f32x4 acc = (f32x4){0.f, 0.f, 0.f, 0.f};
          const LAS bf16* ah = hhi + (mb * 16 + (lane & 15)) * HROW + 8 * (lane >> 4); const LAS bf16* al = hlo + (mb * 16 + (lane & 15)) * HROW + 8 * (lane >> 4);
          const bf16* bh = Whi + (size_t)(nb * 16 + (lane & 15)) * 1024 + 8 * (lane >> 4); const bf16* bl = Wlo + (size_t)(nb * 16 + (lane & 15)) * 1024 + 8 * (lane >> 4);
#pragma unroll 8
          for (int ks = 0; ks < 32; ++ks) { const bf16x8 a_h = *(const LAS bf16x8*)(ah + 32 * ks), a_l = *(const LAS bf16x8*)(al + 32 * ks), b_h = *(const bf16x8*)(bh + 32 * ks), b_l = *(const bf16x8*)(bl + 32 * ks);
              acc = __builtin_amdgcn_mfma_f32_16x16x32_bf16(a_h, b_h, acc, 0, 0, 0); acc = __builtin_amdgcn_mfma_f32_16x16x32_bf16(a_h, b_l, acc, 0, 0, 0); acc = __builtin_amdgcn_mfma_f32_16x16x32_bf16(a_l, b_h, acc, 0, 0, 0); }
#pragma unroll
          for (int i = 0; i < 4; ++i) lgs[(mb * 16 + 4 * (lane >> 4) + i) * 64 + nb * 16 + (lane & 15)] = acc[i]; }
        __syncthreads();
#pragma unroll
        for (int q = 0; q < 4; ++q) {
            const int r = tile * 32 + c.wave * 4 + q;
            const float s = sigmoidf_(lgs[(c.wave * 4 + q) * 64 + lane]), bs = s + rbias;
            float m1 = bs; m1 = fmaxf(m1, shx<1>(m1)); m1 = fmaxf(m1, shx<2>(m1)); m1 = fmaxf(m1, shx<4>(m1));
            const unsigned long long eq = __ballot(bs == m1); const unsigned gm = (unsigned)(eq >> (lane & 56)) & 0xffu; const int first = __ffs(gm) - 1;
            float m2 = ((lane & 7) == first) ? -1e30f : bs; m2 = fmaxf(m2, shx<1>(m2)); m2 = fmaxf(m2, shx<2>(m2)); m2 = fmaxf(m2, shx<4>(m2));
            const float gs = m1 + m2; const int g = lane >> 3; int rank = 0;
#pragma unroll
            for (int j = 0; j < 8; ++j) { const float o = rdl(gs, 8 * j); rank += (o > gs || (o == gs && j < g)) ? 1 : 0; }
            float cand = rank < 4 ? bs : -1e30f; int my_e = 0; float my_w = 0.f, wsum = 0.f;
#pragma unroll
            for (int k = 0; k < 8; ++k) { const float mm = wave_max(cand); const unsigned long long e2 = __ballot(cand == mm); const int idx = __ffsll((long long)e2) - 1; const float wk = rdl(s, idx);
                if (lane == idx) cand = -1e30f; if (lane == k) { my_e = idx; my_w = wk; } wsum += wk; }
            if (lane < 8) { const int lp = atomicAdd((int*)&hist[my_e], 1); TKEP[(size_t)r * 8 + lane] = my_e | (lp << 8); TKW[(size_t)r * 8 + lane] = my_w / wsum * 2.5f; }
        }
        __syncthreads();
        if (c.tid < 64) { const int n = hist[c.tid]; int base = 0; if (n > 0) base = atomicAdd(&CNT[((tile * 32) / rpc) * NE + c.tid], n); TB[tile * 64 + c.tid] = base; }
    }
    __syncthreads();
}
__device__ __forceinline__ void phase_route_fill(const Ctx& c, int l, int ntok) {
    const int* TKEP = (const int*)(c.ws + WS_RT + RT_TKEP); int* SLOT = (int*)(c.ws + WS_RT + RT_SLOT); const int* TB = (const int*)(c.ws + WS_TB);
    const int* CNT = (const int*)(c.ws + WS_CTL) + CW_CNT + l * NCH * NE; int* ROWL = (int*)(c.ws + WS_ROWL);
    LAS int* est = (LAS int*)c.lds;
    const int rpc = ntok / NCH;
    __syncthreads();
    if (c.tid < NCH) { int s = 0; for (int e = 0; e < NE; ++e) { est[c.tid * 65 + e] = s; s += (CNT[c.tid * NE + e] + 255) & ~255; } est[c.tid * 65 + 64] = s; }
    __syncthreads();
    const size_t na = (size_t)ntok * 8;
    for (size_t a = (size_t)c.blk * NTHR + c.tid; a < na; a += (size_t)c.G * NTHR) { const int t = (int)(a >> 3), ch = t / rpc; const int ep = TKEP[a], e = ep & 255, lp = ep >> 8;
        const int slot = est[ch * 65 + e] + TB[(t >> 5) * 64 + e] + lp; SLOT[a] = slot; ROWL[(size_t)ch * RPCMAX + slot] = t; }
    for (int i = c.blk * NTHR + c.tid; i < NCH * NE * 256; i += c.G * NTHR) { const int ch = i >> 14, e = (i >> 8) & 63, j = i & 255; const int n = CNT[ch * NE + e]; const int pad = ((n + 255) & ~255) - n;
        if (j < pad) ROWL[(size_t)ch * RPCMAX + est[ch * 65 + e] + n + j] = ch * rpc; }
    __syncthreads();
}

struct MoeOrder {
    const LAS unsigned char* texp;
    int ntile, npn, G, c; const char* W; size_t wexp, wtile;
    __device__ __forceinline__ bool next(int i, pg8::Unit& u) const {
        const int L = i * G + c; if (L >= ntile * npn) return false;
        const int T = npn == 2 ? (L >> 1) : (L >> 2), pn = L & (npn - 1); const int e = texp[T];
        u.pm = T; u.pn = pn; u.e = e; u.B = W + (size_t)e * wexp + (size_t)pn * wtile; return true;
    }
};
__device__ __forceinline__ void moe_tile_table(const Ctx& c, int l, int ch, LAS int* tst) {
    const int* CNT = (const int*)(c.ws + WS_CTL) + CW_CNT + l * NCH * NE + ch * NE;
    LAS unsigned char* texp = (LAS unsigned char*)(tst + 80);
    __syncthreads();
    if (c.tid == 0) { int s = 0; for (int e = 0; e < NE; ++e) { tst[e] = s; s += (CNT[e] + 255) >> 8; } tst[64] = s; }
    __syncthreads();
    if (c.tid < NE) { for (int t = tst[c.tid]; t < tst[c.tid + 1]; ++t) texp[t] = (unsigned char)c.tid; }
    __syncthreads();
}
__device__ __forceinline__ void phase_combine(const Ctx& c, KParams p, int l, int ch, int rpc) {
    const float* MOD = (const float*)(c.ws + WS_MOD) + (size_t)l * 33 * 6144 + 5120; const float* MODn = (const float*)(c.ws + WS_MOD) + (size_t)33 * 6144;
    const int* SLOT = (const int*)(c.ws + WS_RT + RT_SLOT); const float* TKW = (const float*)(c.ws + WS_RT + RT_TKW);
    const unsigned char* OB = (const unsigned char*)(c.ws + WS_OB); const bf16* OBS = (const bf16*)(c.ws + WS_OBS);
    float* xl = p->out; float* xc = (float*)(c.ws + WS_XC); bf16* H = (bf16*)(c.ws + WS_H);
    const int gw = c.blk * NWAVES + c.wave, NGW = c.G * NWAVES, lane = c.lane;
    const int col0 = (lane >> 4) * 256 + ((lane >> 2) & 3) * 32 + (lane & 3) * 8;
    f32x4 gn[4];
#pragma unroll
    for (int q = 0; q < 4; ++q) gn[q] = *(const f32x4*)((l == 0 ? p->in[I_N1G] + DM : p->in[I_FG]) + col0 + 128 * (q >> 1) + 4 * (q & 1));
    for (int i = gw; i < rpc; i += NGW) { const int t = ch * rpc + i; float* xr = t < NLAT ? xl + (size_t)t * DM : xc + (size_t)(t - NLAT) * DM; const int mr = mod_row(t); const float* g2 = MOD + (size_t)mr * 6144;
        int sl = 0; float w = 0.f; if (lane < 8) { sl = SLOT[(size_t)t * 8 + lane]; w = TKW[(size_t)t * 8 + lane] * 0.0625f; }
        float a[16];
        { float t8[8]; unpack8(*(const u32x4*)(OBS + (size_t)i * DM + col0), t8);
#pragma unroll
          for (int q = 0; q < 8; ++q) a[q] = t8[q];
          unpack8(*(const u32x4*)(OBS + (size_t)i * DM + col0 + 128), t8);
#pragma unroll
          for (int q = 0; q < 8; ++q) a[8 + q] = t8[q]; }
#pragma unroll
        for (int k = 0; k < 8; ++k) { const int sk = rdli(sl, k); const float wk = rdl(w, k); const u32x4 o = *(const u32x4*)(OB + (size_t)sk * 1024 + lane * 16);
#pragma unroll
            for (int q = 0; q < 4; ++q) { const f32x2 lo = __builtin_amdgcn_cvt_pk_f32_fp8((int)o[q], false), hi = __builtin_amdgcn_cvt_pk_f32_fp8((int)o[q], true);
                a[4 * q] = fmaf(wk, lo.x, a[4 * q]); a[4 * q + 1] = fmaf(wk, lo.y, a[4 * q + 1]); a[4 * q + 2] = fmaf(wk, hi.x, a[4 * q + 2]); a[4 * q + 3] = fmaf(wk, hi.y, a[4 * q + 3]); } }
        f32x4 xn[4]; float ss = 0.f;
#pragma unroll
        for (int q = 0; q < 4; ++q) { const int cc = col0 + 128 * (q >> 1) + 4 * (q & 1); const f32x4 xv = *(const f32x4*)(xr + cc), gv = *(const f32x4*)(g2 + cc);
            xn[q] = xv + gv * (f32x4){a[4 * q], a[4 * q + 1], a[4 * q + 2], a[4 * q + 3]}; ss += (xn[q].x * xn[q].x + xn[q].y * xn[q].y) + (xn[q].z * xn[q].z + xn[q].w * xn[q].w); }
        const float rstd = rsqrtf(wave_sum(ss) * (1.f / 1024.f) + EPS);
        if (l == 0) { const float* mn = MODn + (size_t)mr * 6144; bf16* hr = H + (size_t)t * DM;
#pragma unroll
            for (int q = 0; q < 4; ++q) { const int cc = col0 + 128 * (q >> 1) + 4 * (q & 1); *(f32x4*)(xr + cc) = xn[q];
                const f32x4 s0 = *(const f32x4*)(mn + cc), s1 = *(const f32x4*)(mn + 1024 + cc); const f32x4 hv = xn[q] * rstd * gn[q] * (s1 + 1.0f) + s0;
                u32x2 o; o.x = pk2(hv.x, hv.y); o.y = pk2(hv.z, hv.w); *(u32x2*)(hr + cc) = o; } }
        else {
#pragma unroll
            for (int q = 0; q < 4; ++q) { const int cc = col0 + 128 * (q >> 1) + 4 * (q & 1); *(f32x4*)(xr + cc) = xn[q] * rstd * gn[q]; } }
    }
}
constexpr int LDS_BYTES = 147456;
constexpr int LDS_TAB = 131072, LDS_XB = LDS_BYTES - 16;

__global__ void __launch_bounds__(NTHR, 2) fwd_kernel(Params pk) {
    extern __shared__ __attribute__((aligned(16))) unsigned char lds_raw[];
    LAS unsigned char* const lds0 = (LAS unsigned char*)lds_raw;
    if (threadIdx.x < 4) ((LAS unsigned*)(lds0 + LDS_XB))[threadIdx.x] = 0u;
    __syncthreads();
    (void)xcd_barrier_post((unsigned*)(pk.ws + WS_CTL) + CW_BAR, (volatile LAS unsigned*)(lds0 + LDS_XB));
    int ph = 0; const int ph_lo = pk.ph_lo, ph_hi = pk.ph_hi;
#define RUN (ph >= ph_lo && ph < ph_hi)
#ifndef PROBE_REP
#define PROBE_REP 0
#endif
#define SEAM() do { if (RUN && ph + 1 < ph_hi) { KParams q_ = fresh_params(); XcdBarrier b_; b_.bar = (unsigned*)(q_->ws + WS_CTL) + CW_BAR; b_.x = xb_xcc_id(); b_.st = (volatile LAS unsigned*)(lds0 + LDS_XB); xcd_barrier(b_); } ++ph; } while (0)
#define PHB KParams p = fresh_params(); Ctx c; { int t_ = threadIdx.x; asm volatile("" : "+v"(t_)); c.lds = lds0; c.tid = t_; c.lane = t_ & 63; c.wave = __builtin_amdgcn_readfirstlane(t_ >> 6); c.blk = blockIdx.x; c.G = gridDim.x; c.ws = p->ws; } \
    LAS unsigned char* stage = c.lds; LAS int* tst = (LAS int*)(c.lds + LDS_TAB); (void)stage; (void)tst; \
    unsigned char* sm = c.ws + WS_WSM + (size_t)l_ * WSM_L; const float* MODl = (const float*)(c.ws + WS_MOD) + (size_t)l_ * 33 * 6144; (void)sm; (void)MODl;

    int l_ = 0;
    if (RUN) for (int rep_ = 0; rep_ < 1 + ((PROBE_REP >> 0) & 1); ++rep_) { PHB prologue(c, p); }
    SEAM();
    if (RUN) for (int rep_ = 0; rep_ < 1 + ((PROBE_REP >> 1) & 1); ++rep_) { PHB prologue2(c, p); }
    SEAM();
#pragma unroll 1
    for (int l = 0; l < 2; ++l) {
        l_ = l;
        const bool last = (l == 1);
        const int nrows = last ? NLAT : NTOK;
        if (RUN) for (int rep_ = 0; rep_ < 1 + ((PROBE_REP >> 2) & 1); ++rep_) { PHB { if (last) prologue_moe_weights(c, p, 1); else phase_norm1(c, p, l); } }
        SEAM();
        if (RUN) for (int rep_ = 0; rep_ < 1 + ((PROBE_REP >> 3) & 1); ++rep_) { PHB { pg8::DenseOrder S; S.init(NTOK / 256, ZW / 256, c.G, c.blk, (const bf16*)(c.ws + WS_WIN) + (size_t)l * 2048 * 1024, 1024);
            pg8::RowsDense R{2048u}; EpiInProj E{(bf16*)(c.ws + WS_Z), (bf16*)(c.ws + WS_UP), (bf16*)(c.ws + WS_GVT)};
            pg8::gemm_phase(stage, (const char*)(c.ws + WS_H), 1024, S, R, E); } }
        SEAM();
        if (RUN) for (int rep_ = 0; rep_ < 1 + ((PROBE_REP >> 4) & 1); ++rep_) { PHB { phase_gla(c, p, l); phase_conv1(c, p, l, !last); phase_mla_prep(c, p);
            { S5Order S{c.G, c.blk, (const char*)(c.ws + WS_S5W) + (size_t)l * 16 * 256 * 256 * 2, (size_t)256 * 256 * 2}; pg8::RowsDense R{1024u}; EpiS5X E{(bf16*)(c.ws + WS_Y5)};
              pg8::gemm_phase(stage, (const char*)(c.ws + WS_UP), 256, S, R, E); } } }
        SEAM();
        if (RUN) for (int rep_ = 0; rep_ < 1 + ((PROBE_REP >> 5) & 1); ++rep_) { PHB {
            phase_gla_final(c, p, l, nrows);
            { pg8::DenseOrder S; S.init(nrows / 256, 1, c.G, c.blk, (const bf16*)(sm + WSM_PW), 256); pg8::RowsDense R{512u}; EpiBiasBf16 E{(bf16*)(c.ws + WS_MIX) + 256, DM, p->in[I_CPB] + l * 256};
              pg8::gemm_phase(stage, (const char*)(c.ws + WS_CV), 256, S, R, E); }
            { pg8::DenseOrder S; S.init(NTOK / 256, 2, c.G, c.blk, (const bf16*)(sm + WSM_UQ), 256); pg8::RowsDense R{(unsigned)ZW * 2u};
              EpiQ E{(bf16*)(c.ws + WS_H), (const float*)(c.ws + WS_RS), (const float*)(c.ws + WS_TAB + TAB_ROPE)};
              pg8::gemm_phase(stage, (const char*)(c.ws + WS_Z) + ZCQ * 2, 256, S, R, E); }
            { pg8::DenseOrder S; S.init(NTOK / 256, 2, c.G, c.blk, (const bf16*)(sm + WSM_UK), 256); pg8::RowsDense R{(unsigned)ZW * 2u};
              EpiKV E{(bf16*)(c.ws + WS_H) + (size_t)NTOK * 384, (bf16*)(c.ws + WS_H) + (size_t)NTOK * 768, (const float*)(c.ws + WS_RS)};
              pg8::gemm_phase(stage, (const char*)(c.ws + WS_Z) + ZCKV * 2, 256, S, R, E); }
            phase_s5_carry(c, l);
        } }
        SEAM();
        if (RUN) for (int rep_ = 0; rep_ < 1 + ((PROBE_REP >> 6) & 1); ++rep_) { PHB { phase_attn(c, !last);
            { S5Order S{c.G, c.blk, (const char*)(c.ws + WS_S5W) + (size_t)32 * 256 * 256 * 2 + (size_t)l * 16 * 256 * 512 * 2, (size_t)256 * 512 * 2}; pg8::RowsDense R{1024u}; EpiS5Y E{(bf16*)(c.ws + WS_Y5)};
              pg8::gemm_phase(stage, (const char*)(c.ws + WS_UP), 512, S, R, E); } } }
        SEAM();
        if (RUN) for (int rep_ = 0; rep_ < 1 + ((PROBE_REP >> 7) & 1); ++rep_) { PHB { pg8::DenseOrder S; S.init(nrows / 256, 2, c.G, c.blk, (const bf16*)(sm + WSM_GLU), 256); pg8::RowsDense R{512u}; EpiGluSig E{(bf16*)(c.ws + WS_MIX) + 512, DM, p->in[I_S5GB] + l * 512};
            pg8::gemm_phase(stage, (const char*)(c.ws + WS_Y5), 256, S, R, E); } }
        SEAM();
        if (RUN) for (int rep_ = 0; rep_ < 1 + ((PROBE_REP >> 8) & 1); ++rep_) { PHB { pg8::DenseOrder S; S.init(nrows / 256, 4, c.G, c.blk, (const bf16*)(c.ws + WS_WOUT) + (size_t)l * 1024 * 1024, 1024); pg8::RowsDense R{2048u};
            EpiResid E{l == 0 ? p->in[I_X] : p->out, l == 0 ? p->in[I_CTX] : (const float*)(c.ws + WS_XC), p->out, (float*)(c.ws + WS_XC), MODl + 2048};
            pg8::gemm_phase(stage, (const char*)(c.ws + WS_MIX), 1024, S, R, E); } }
        SEAM();
        if (RUN) for (int rep_ = 0; rep_ < 1 + ((PROBE_REP >> 9) & 1); ++rep_) { PHB phase_norm2_route(c, p, l, nrows); }
        SEAM();
        if (RUN) for (int rep_ = 0; rep_ < 1 + ((PROBE_REP >> 10) & 1); ++rep_) { PHB phase_route_fill(c, l, nrows); }
        SEAM();
        const int rpc = nrows / NCH;
#pragma unroll 1
        for (int ch = 0; ch < NCH; ++ch) {
            if (RUN) for (int rep_ = 0; rep_ < 1 + ((PROBE_REP >> 11) & 1); ++rep_) { PHB {
                moe_tile_table(c, l, ch, tst);
                { MoeOrder S{(const LAS unsigned char*)(tst + 80), tst[64], 2, c.G, c.blk, (const char*)(c.ws + WS_WMOE), (size_t)512 * 1024 * 2, (size_t)256 * 1024 * 2};
                  pg8::RowsGather R{(const int*)(c.ws + WS_ROWL) + (size_t)ch * RPCMAX, 2048u}; EpiSwiglu E{(bf16*)(c.ws + WS_HB), 256};
                  pg8::gemm_phase(stage, (const char*)(c.ws + WS_H), 1024, S, R, E); }
                { pg8::DenseOrder S; S.init(rpc / 256, 2, c.G, c.blk, (const bf16*)(c.ws + WS_WSH) + (size_t)l * (512 * 1024 + 1024 * 256), 1024); pg8::RowsDense R{2048u}; EpiSwiglu E{(bf16*)(c.ws + WS_HBS), 256};
                  pg8::gemm_phase(stage, (const char*)(c.ws + WS_H) + (size_t)ch * rpc * 2048, 1024, S, R, E); }
            } }
            SEAM();
            if (RUN) for (int rep_ = 0; rep_ < 1 + ((PROBE_REP >> 12) & 1); ++rep_) { PHB {
                { MoeOrder S{(const LAS unsigned char*)(tst + 80), tst[64], 4, c.G, c.blk, (const char*)(c.ws + WS_WMOE) + (size_t)NE * 512 * 1024 * 2, (size_t)1024 * 256 * 2, (size_t)256 * 256 * 2};
                  pg8::RowsDense R{512u}; EpiOB8 E{(unsigned char*)(c.ws + WS_OB)};
                  pg8::gemm_phase(stage, (const char*)(c.ws + WS_HB), 256, S, R, E); }
                { pg8::DenseOrder S; S.init(rpc / 256, 4, c.G, c.blk, (const bf16*)(c.ws + WS_WSH) + (size_t)l * (512 * 1024 + 1024 * 256) + 512 * 1024, 256); pg8::RowsDense R{512u}; EpiBf16 E{(bf16*)(c.ws + WS_OBS), DM};
                  pg8::gemm_phase(stage, (const char*)(c.ws + WS_HBS), 256, S, R, E); }
            } }
            SEAM();
            if (RUN) for (int rep_ = 0; rep_ < 1 + ((PROBE_REP >> 13) & 1); ++rep_) { PHB phase_combine(c, p, l, ch, rpc); }
            SEAM();
        }
    }
#undef RUN
#undef SEAM
#undef PHB
}

extern "C" void kernel_launch(void* const* d_in, const int* in_sizes, int n_in, void* d_out, int out_size, void* d_ws, size_t ws_size, hipStream_t stream) {
    static int grid = 0;
    if (grid == 0) {
        if (n_in != 42 || out_size != NLAT * DM || ws_size < WS_END) { fprintf(stderr, "kernel_launch: unexpected shapes (n_in %d out %d ws %zu)\n", n_in, out_size, ws_size); grid = -1; return; }
        int dev = 0, cus = 0;
        if (hipGetDevice(&dev) != hipSuccess || hipDeviceGetAttribute(&cus, hipDeviceAttributeMultiprocessorCount, dev) != hipSuccess) { grid = -1; return; }
        if (hipFuncSetAttribute((const void*)fwd_kernel, hipFuncAttributeMaxDynamicSharedMemorySize, LDS_BYTES) != hipSuccess) { fprintf(stderr, "kernel_launch: hipFuncSetAttribute failed\n"); grid = -1; return; }
        int per_cu = 0;
        if (hipOccupancyMaxActiveBlocksPerMultiprocessor(&per_cu, (const void*)fwd_kernel, NTHR, LDS_BYTES) != hipSuccess || per_cu < 1) fprintf(stderr, "kernel_launch: occupancy query reports %d\n", per_cu);
        (void)hipGetLastError();
        grid = cus;
    }
    if (grid < 0) return;
    (void)hipMemsetAsync((char*)d_ws + WS_CTL, 0, CTL_BYTES, stream);
    Params p{};
    for (int i = 0; i < 42; ++i) p.in[i] = (const float*)d_in[i];
    p.out = (float*)d_out; p.ws = (unsigned char*)d_ws; p.ph_lo = 0; p.ph_hi = 1 << 20;
    hipLaunchKernelGGL(fwd_kernel, dim3(grid), dim3(NTHR), LDS_BYTES, stream, p);
}
```

```cpp
#include <hip/hip_runtime.h>
#include <cstdio>
#include <cstdint>

#define LAS __attribute__((address_space(3)))
typedef unsigned short bf16;
typedef short bf16x8 __attribute__((ext_vector_type(8)));
typedef float f32x4 __attribute__((ext_vector_type(4)));
typedef float f32x2 __attribute__((ext_vector_type(2)));
typedef float f32x16 __attribute__((ext_vector_type(16)));
typedef unsigned u32x4 __attribute__((ext_vector_type(4)));
typedef unsigned u32x2 __attribute__((ext_vector_type(2)));

constexpr int NB = 32, SEQ = 2048, CTXL = 256, DM = 1024;
constexpr int NLAT = NB * SEQ, NCTX = NB * CTXL, NTOK = NLAT + NCTX;
constexpr int ZW = 2048;
constexpr int ZQ = 0, ZK = 128, ZV = 256, ZR = 512, ZCA = 768, ZCG = 1024, ZS5 = 1280, ZCQ = 1536, ZCKV = 1792, ZKR = 1920, ZAF = 1952, ZAB = 1968;
constexpr int NE = 64, TOPK = 8;
constexpr int NCH = 2;
constexpr int RPCMAX = (NTOK / NCH) * 8 + 64 * 256;
constexpr float EPS = 1e-6f;
constexpr int NWAVES = 8, NTHR = 512;

constexpr size_t MiB = (size_t)1 << 20;
constexpr size_t WS_CTL = 0, CTL_BYTES = 1 * MiB;
constexpr size_t WS_MOD = 1 * MiB;
constexpr size_t WS_TAB = 3 * MiB;
constexpr size_t WS_WSM = 5 * MiB;
constexpr size_t WS_WIN = 8 * MiB;
constexpr size_t WS_WOUT = 16 * MiB;
constexpr size_t WS_WSH = 20 * MiB;
constexpr size_t WS_TB = 23 * MiB;
constexpr size_t WS_RT = 24 * MiB;
constexpr size_t WS_ROWL = 32 * MiB;
constexpr size_t WS_RS = 35 * MiB;
constexpr size_t WS_WMOE = 36 * MiB;
constexpr size_t WS_XC = 132 * MiB;
constexpr size_t WS_H = 164 * MiB;
constexpr size_t WS_Z = 308 * MiB;
constexpr size_t WS_MIX = 596 * MiB;
constexpr size_t WS_T1 = 740 * MiB;
constexpr size_t WS_UP = 812 * MiB;
constexpr size_t WS_CV = 884 * MiB;
constexpr size_t WS_Y5 = 920 * MiB;
constexpr size_t WS_S5W = 956 * MiB;
constexpr size_t WS_S5P = 968 * MiB;
constexpr size_t WS_GVT = 969 * MiB;
constexpr size_t WS_END = 1005 * MiB;
constexpr size_t WS_HB = WS_Z;
constexpr size_t WS_HBS = WS_Z + 152 * MiB;
constexpr size_t WS_OBS = WS_Z + 170 * MiB;
constexpr size_t WS_OB = WS_MIX;
static_assert((size_t)RPCMAX * 512 <= 152 * MiB && WS_OBS + (size_t)(NTOK / NCH) * 2048 <= WS_MIX && WS_OB + (size_t)RPCMAX * 1024 <= WS_S5W, "MoE overlays");
constexpr int CW_BAR = 0;
constexpr int CW_CNT = 4096;
constexpr size_t WSM_L = 1 * MiB;
constexpr size_t WSM_PW = 0, WSM_GLU = 128 * 1024, WSM_UQ = 384 * 1024, WSM_UK = 640 * 1024, WSM_UV = 768 * 1024;
constexpr size_t TAB_ROPE = 0;
constexpr size_t TAB_S5 = 256 * 1024;
constexpr size_t TAB_RWT = 1536 * 1024;
constexpr size_t RT_TKEP = 0, RT_TKW = 2400000, RT_SLOT = 4800000;

__device__ __forceinline__ float bf2f(bf16 v) { return __uint_as_float(((unsigned)v) << 16); }
typedef __bf16 bf16x2_t __attribute__((ext_vector_type(2)));
__device__ __forceinline__ unsigned pk2(float lo, float hi) { const f32x2 v = {lo, hi}; return __builtin_bit_cast(unsigned, __builtin_convertvector(v, bf16x2_t)); }
__device__ __forceinline__ bf16 f2bf(float f) { return __builtin_bit_cast(unsigned short, (__bf16)f); }
template <int O> __device__ __forceinline__ float shx(float v) {
    return __int_as_float(__builtin_amdgcn_ds_swizzle(__float_as_int(v), (O << 10) | 0x1f)); }
__device__ __forceinline__ float rdl(float v, int l) { return __int_as_float(__builtin_amdgcn_readlane(__float_as_int(v), l)); }
__device__ __forceinline__ int rdli(int v, int l) { return __builtin_amdgcn_readlane(v, l); }
__device__ __forceinline__ float wave_sum(float v) {
    v += shx<1>(v); v += shx<2>(v); v += shx<4>(v); v += shx<8>(v); v += shx<16>(v);
    const auto r = __builtin_amdgcn_permlane32_swap(__float_as_uint(v), __float_as_uint(v), false, false);
    return __uint_as_float(r[0]) + __uint_as_float(r[1]);
}
__device__ __forceinline__ float wave_max(float v) {
    v = fmaxf(v, shx<1>(v)); v = fmaxf(v, shx<2>(v)); v = fmaxf(v, shx<4>(v)); v = fmaxf(v, shx<8>(v)); v = fmaxf(v, shx<16>(v));
    const auto r = __builtin_amdgcn_permlane32_swap(__float_as_uint(v), __float_as_uint(v), false, false);
    return fmaxf(__uint_as_float(r[0]), __uint_as_float(r[1]));
}
__device__ __forceinline__ float sigmoidf_(float x) { return 1.0f / (1.0f + __expf(-x)); }
__device__ __forceinline__ float siluf_(float x) { return x / (1.0f + __expf(-x)); }
__device__ __forceinline__ void unpack8(const u32x4 w, float (&v)[8]) {
    v[0] = __uint_as_float(w.x << 16); v[1] = __uint_as_float(w.x & 0xffff0000u);
    v[2] = __uint_as_float(w.y << 16); v[3] = __uint_as_float(w.y & 0xffff0000u);
    v[4] = __uint_as_float(w.z << 16); v[5] = __uint_as_float(w.z & 0xffff0000u);
    v[6] = __uint_as_float(w.w << 16); v[7] = __uint_as_float(w.w & 0xffff0000u);
}
__device__ __forceinline__ void lds_wait() { asm volatile("s_waitcnt lgkmcnt(0)" ::: "memory"); }

#define XB_TMO      128
#define XB_XCNT(j)  (256  + 64 * (j))
#define XB_XSUB(j)  (1280 + 64 * (j))
#define XB_XGEN(j)  (2304 + 64 * (j))
#define XB_TOP      3328
#define XB_TOPGEN   3392
#define XCD_BAR_WORDS 3456
#define XB_SPIN_CAP (1u << 22)
__device__ __forceinline__ unsigned xb_ld(unsigned* p)              { return __hip_atomic_load(p, __ATOMIC_RELAXED, __HIP_MEMORY_SCOPE_AGENT); }
__device__ __forceinline__ unsigned xb_add(unsigned* p, unsigned v) { return __hip_atomic_fetch_add(p, v, __ATOMIC_RELAXED, __HIP_MEMORY_SCOPE_AGENT); }
__device__ __forceinline__ unsigned xb_xcc_id() { return (unsigned)__builtin_amdgcn_s_getreg((3 << 11) | 20) & 0xFu; }
#define XB_SPIN(cond, bar) do { unsigned _sp = 0; while (cond) { __builtin_amdgcn_s_sleep(1); \
    if ((++_sp & 255u) == 0u) { if (xb_ld(&(bar)[XB_TMO])) break; if (_sp > XB_SPIN_CAP) { atomicAdd(&(bar)[XB_TMO], 1u); break; } } } } while (0)
struct XcdBarrier { unsigned* bar; unsigned x; volatile LAS unsigned* st; };
__device__ __forceinline__ XcdBarrier xcd_barrier_post(unsigned* bar, volatile LAS unsigned* st) {
    XcdBarrier b; b.bar = bar; b.x = xb_xcc_id(); b.st = st;
    if (threadIdx.x == 0) (void)xb_add(&bar[XB_XCNT(b.x)], 1u);
    return b;
}
__device__ __forceinline__ void xcd_barrier_complete(unsigned* bar, unsigned x, unsigned& nloc, unsigned& nx) {
    const unsigned G = gridDim.x * gridDim.y * gridDim.z;
    unsigned sum, cnt, mine, sp = 0u;
    for (;;) {
        sum = 0u; cnt = 0u; mine = 0u;
#pragma unroll
        for (unsigned j = 0; j < 16; ++j) { const unsigned c = xb_ld(&bar[XB_XCNT(j)]); sum += c; cnt += (c > 0u) ? 1u : 0u; mine = (j == x) ? c : mine; }
        if (sum == G) break;
        __builtin_amdgcn_s_sleep(1);
        if ((++sp & 255u) == 0u) { if (xb_ld(&bar[XB_TMO])) break; if (sp > XB_SPIN_CAP) { atomicAdd(&bar[XB_TMO], 1u); break; } }
    }
    nloc = mine > 0u ? mine : 1u; nx = cnt > 0u ? cnt : 1u;
}
__device__ __forceinline__ void xcd_barrier(const XcdBarrier& b) {
    asm volatile("s_waitcnt vmcnt(0)" ::: "memory");
    __syncthreads();
    if (threadIdx.x == 0) {
        unsigned* bar = b.bar;
        __builtin_amdgcn_s_waitcnt(0);
        unsigned nloc = b.st[0], nx = b.st[1];
        if (nloc == 0u) { xcd_barrier_complete(bar, b.x, nloc, nx); b.st[0] = nloc; b.st[1] = nx; }
        const unsigned old = xb_add(&bar[XB_XSUB(b.x)], 1u);
        const unsigned gen = old / nloc;
        if (old + 1u == (gen + 1u) * nloc) {
            __builtin_amdgcn_fence(__ATOMIC_RELEASE, "agent");
            asm volatile("s_waitcnt vmcnt(0)" ::: "memory");
            const unsigned og = xb_add(&bar[XB_TOP], 1u);
            const unsigned tg = og / nx;
            if (og + 1u == (tg + 1u) * nx) xb_add(&bar[XB_TOPGEN], 1u);
            else XB_SPIN(xb_ld(&bar[XB_TOPGEN]) == tg, bar);
            __builtin_amdgcn_fence(__ATOMIC_ACQUIRE, "agent");
            xb_add(&bar[XB_XGEN(b.x)], 1u);
            asm volatile("s_waitcnt vmcnt(0)" ::: "memory");
        } else {
            XB_SPIN(xb_ld(&bar[XB_XGEN(b.x)]) == gen, bar);
            __builtin_amdgcn_fence(__ATOMIC_ACQUIRE, "agent");
            asm volatile("s_waitcnt vmcnt(0)" ::: "memory");
        }
    }
    __syncthreads();
}

namespace pg8 {
constexpr int BM = 256, BK = 64, HALF = 128, HTB = HALF * BK * 2, STAGE_BYTES = 8 * HTB, NXCD = 8, WGM = 8;
__device__ __forceinline__ int lds_byte(int r, int c) { const int st = (r >> 4) * 2 + (c >> 5), rr = r & 15, cc = c & 31, ob = rr * 64 + cc * 2; return st * 1024 + (ob ^ (((ob >> 9) & 1) << 5)); }
__device__ __forceinline__ void stage_rc(int b, int& R, int& C) { const int st = b / 1024, sb = b % 1024, swz = sb ^ (((sb >> 9) & 1) << 5); R = (st >> 1) * 16 + swz / 64; C = (st & 1) * 32 + (swz % 64) / 2; }
__device__ __forceinline__ int perm32(int rho) { const int n = rho >> 4, i = rho & 15; return 8 * (i >> 2) + 4 * n + (i & 3); }

struct Unit { int pm, pn, e; const char* B; };

struct DenseOrder {
    int nM, nN, nwg, G, c; const char* Bt; size_t btile;
    __device__ __forceinline__ void init(int nM_, int nN_, int G_, int c_, const bf16* Bt_, int K) { nM = nM_; nN = nN_; nwg = nM * nN; G = G_; c = c_; Bt = (const char*)Bt_; btile = (size_t)256 * K * 2; }
    __device__ __forceinline__ bool next(int i, Unit& u) const {
        const long L = (long)i * G + c; if (L >= nwg) return false;
        int wgid = (int)L; { const int q = nwg / NXCD, r = nwg % NXCD, xcd = wgid % NXCD, off = wgid / NXCD; wgid = (xcd < r ? xcd * (q + 1) : r * (q + 1) + (xcd - r) * q) + off; }
        const int nig = WGM * nN, gid = wgid / nig, fm = gid * WGM, gsz = (nM - fm) < WGM ? (nM - fm) : WGM;
        u.pm = fm + ((wgid % nig) % gsz); u.pn = (wgid % nig) / gsz; u.e = 0; u.B = Bt + (size_t)u.pn * btile; return true;
    }
};
struct RowsDense { unsigned ldab; __device__ __forceinline__ unsigned off(const Unit& u, int r) const { return (unsigned)(u.pm * 256 + r) * ldab; } };
struct RowsGather { const int* list; unsigned ldab; __device__ __forceinline__ unsigned off(const Unit& u, int r) const { return (unsigned)list[u.pm * 256 + r] * ldab; } };

template <class Epi, class Sched, class Rows>
__device__ __forceinline__ void gemm_phase(LAS unsigned char* lds, const char* Abase, const int K, const Sched& S, const Rows& RW, const Epi& E) {
    int tid_ = threadIdx.x; asm volatile("" : "+v"(tid_));
    const int tid = tid_, wid = __builtin_amdgcn_readfirstlane(tid >> 6), lane = tid & 63, wr = wid >> 2, wc = wid & 3, fr = lane & 15, fq = lane >> 4;
    const int nt = K / BK;
    int sR[2]; unsigned sC[2], voffB[2];
#pragma unroll
    for (int i = 0; i < 2; ++i) { int R, C; stage_rc(tid * 16 + i * 8192, R, C); sR[i] = R; sC[i] = (unsigned)C * 2u; const int Rb = (R & ~31) + perm32(R & 31); voffB[i] = (unsigned)(Rb * K + C) * 2u; }
    const size_t kstep = (size_t)(BK * 2);
    const size_t hstepB = (size_t)HALF * K * 2;
    const unsigned ldsw = (unsigned)wid * 1024u;
    const int aoff = lds_byte(wr * 64 + fr, fq * 8), boff = lds_byte(wc * 32 + fr, fq * 8);
#define PG8_SA(b, h) (((b) * 2 + (h)) * HTB)
#define PG8_SB(b, h) ((4 + (b) * 2 + (h)) * HTB)
#define PG8_STAGE(bufoff, gbase, voff) do { const char* _gb = (const char*)(gbase); asm volatile("" : "+s"(_gb)); _Pragma("unroll") for (int _i = 0; _i < 2; ++_i) { unsigned _o = (voff)[_i]; asm volatile("" : "+v"(_o)); \
        __builtin_amdgcn_global_load_lds((const unsigned*)(_gb + _o), (LAS unsigned*)(lds + (bufoff) + ldsw + _i * 8192), 16, 0, 0); } } while (0)
#define PG8_LDA(dst, b, h) do { _Pragma("unroll") for (int m = 0; m < 4; ++m) _Pragma("unroll") for (int k = 0; k < 2; ++k) dst[m][k] = *(const LAS bf16x8*)(lds + PG8_SA(b, h) + aoff + m * 2048 + k * 1024); } while (0)
#define PG8_LDB(dst, b, h) do { _Pragma("unroll") for (int n = 0; n < 2; ++n) _Pragma("unroll") for (int k = 0; k < 2; ++k) dst[n][k] = *(const LAS bf16x8*)(lds + PG8_SB(b, h) + boff + n * 2048 + k * 1024); } while (0)
#define PG8_MMA(ai, bj, At, Bt) do { __builtin_amdgcn_s_setprio(1); _Pragma("unroll") for (int m = 0; m < 4; ++m) _Pragma("unroll") for (int n = 0; n < 2; ++n) _Pragma("unroll") for (int k = 0; k < 2; ++k) \
        acc[ai][bj][m][n] = __builtin_amdgcn_mfma_f32_16x16x32_bf16(Bt[n][k], At[m][k], acc[ai][bj][m][n], 0, 0, 0); __builtin_amdgcn_s_setprio(0); } while (0)
#define PG8_WAIT_V(n) asm volatile("s_waitcnt vmcnt(" #n ")" ::: "memory")
#define PG8_WAIT_L(n) asm volatile("s_waitcnt lgkmcnt(" #n ")" ::: "memory")
#define PG8_BAR __builtin_amdgcn_s_barrier()
#define PG8_SCHED __builtin_amdgcn_sched_barrier(0)
    Unit cur, nxt; int ui = 0;
    if (!S.next(0, cur)) return;
    f32x4 acc[2][2][4][2];
#pragma unroll
    for (int a = 0; a < 2; ++a)
#pragma unroll
        for (int b = 0; b < 2; ++b)
#pragma unroll
            for (int m = 0; m < 4; ++m)
#pragma unroll
                for (int n = 0; n < 2; ++n) acc[a][b][m][n] = (f32x4){0.f, 0.f, 0.f, 0.f};
    bf16x8 At[4][2], B0[2][2], B1[2][2];
    unsigned oA0[2], oA1[2];
#pragma unroll
    for (int i = 0; i < 2; ++i) { oA0[i] = RW.off(cur, sR[i]) + sC[i]; oA1[i] = RW.off(cur, HALF + sR[i]) + sC[i]; }
    const char* cB = cur.B;
    PG8_STAGE(PG8_SB(0, 0), cB, voffB); PG8_STAGE(PG8_SB(0, 1), cB + hstepB, voffB); PG8_STAGE(PG8_SA(0, 0), Abase, oA0); PG8_STAGE(PG8_SA(0, 1), Abase, oA1);
    if (wr == 1) PG8_BAR;
    PG8_WAIT_V(2); PG8_BAR;
    PG8_STAGE(PG8_SB(1, 0), cB + kstep, voffB); PG8_STAGE(PG8_SA(1, 0), Abase + kstep, oA0); PG8_STAGE(PG8_SB(1, 1), cB + hstepB + kstep, voffB);
    PG8_WAIT_V(6); PG8_BAR;
    for (;;) {
        const bool has_next = S.next(ui + 1, nxt);
        unsigned gi0 = 0u, gi1 = 0u, gi2 = 0u, gi3 = 0u;
        if (has_next && RW.list) {
            int t2 = threadIdx.x; asm volatile("" : "+v"(t2)); int R0, C0, R1, C1; stage_rc(t2 * 16, R0, C0); stage_rc(t2 * 16 + 8192, R1, C1);
            const int* lb = RW.list + (size_t)nxt.pm * 256; const unsigned o0 = (unsigned)R0 * 4u, o1 = (unsigned)R1 * 4u, o2 = (unsigned)(HALF + R0) * 4u, o3 = (unsigned)(HALF + R1) * 4u;
            asm volatile("global_load_dword %0, %4, %8\n\tglobal_load_dword %1, %5, %8\n\tglobal_load_dword %2, %6, %8\n\tglobal_load_dword %3, %7, %8"
                         : "=&v"(gi0), "=&v"(gi1), "=&v"(gi2), "=&v"(gi3) : "v"(o0), "v"(o1), "v"(o2), "v"(o3), "s"(lb));
        }
#pragma unroll 1
        for (int t = 0; t < nt; t += 2) {
            const bool last = (t == nt - 2);
            const char* a1 = Abase + (size_t)(t + 1) * kstep;
            PG8_LDB(B0, 0, 0); PG8_LDB(B1, 0, 1); PG8_SCHED; PG8_LDA(At, 0, 0); PG8_STAGE(PG8_SA(1, 1), a1, oA1);
            PG8_WAIT_V(8); PG8_WAIT_L(0); PG8_BAR; PG8_MMA(0, 0, At, B0); PG8_MMA(0, 1, At, B1); PG8_BAR; PG8_SCHED;
            const char* a2; const char* b2;
            if (last) {
                if (has_next) {
                    int t2 = threadIdx.x; asm volatile("" : "+v"(t2));
#pragma unroll
                    for (int i = 0; i < 2; ++i) { int R, C; stage_rc(t2 * 16 + i * 8192, R, C);
                        if (RW.list) { asm volatile("" : "+v"(gi0), "+v"(gi1), "+v"(gi2), "+v"(gi3)); oA0[i] = (i ? gi1 : gi0) * RW.ldab + (unsigned)C * 2u; oA1[i] = (i ? gi3 : gi2) * RW.ldab + (unsigned)C * 2u; }
                        else { oA0[i] = (unsigned)(nxt.pm * 256 + R) * RW.ldab + (unsigned)C * 2u; oA1[i] = (unsigned)(nxt.pm * 256 + HALF + R) * RW.ldab + (unsigned)C * 2u; } }
                    cB = nxt.B;
                }
                a2 = Abase; b2 = cB;
            } else { a2 = Abase + (size_t)(t + 2) * kstep; b2 = cB + (size_t)(t + 2) * kstep; }
            const char* a3 = a2 + kstep; const char* b3 = b2 + kstep;
            PG8_LDA(At, 0, 1); PG8_STAGE(PG8_SB(0, 0), b2, voffB); PG8_STAGE(PG8_SB(0, 1), b2 + hstepB, voffB); PG8_STAGE(PG8_SA(0, 0), a2, oA0);
            PG8_WAIT_V(8); PG8_WAIT_L(0); PG8_BAR; PG8_MMA(1, 0, At, B0); PG8_MMA(1, 1, At, B1); PG8_BAR; PG8_SCHED;
            PG8_LDB(B0, 1, 0); PG8_LDB(B1, 1, 1); PG8_SCHED; PG8_LDA(At, 1, 0); PG8_STAGE(PG8_SA(0, 1), a2, oA1);
            PG8_WAIT_V(8); PG8_WAIT_L(0); PG8_BAR; PG8_MMA(0, 0, At, B0); PG8_MMA(0, 1, At, B1); PG8_BAR; PG8_SCHED;
            PG8_LDA(At, 1, 1); PG8_STAGE(PG8_SB(1, 0), b3, voffB); PG8_STAGE(PG8_SB(1, 1), b3 + hstepB, voffB); PG8_STAGE(PG8_SA(1, 0), a3, oA0);
            PG8_WAIT_V(8); PG8_WAIT_L(0); PG8_BAR; PG8_MMA(1, 0, At, B0); PG8_MMA(1, 1, At, B1); PG8_BAR; PG8_SCHED;
        }
        if (wr == 0) PG8_BAR;
        { Unit eu = cur; asm volatile("" : "+s"(eu.pm), "+s"(eu.pn)); int t3 = threadIdx.x; asm volatile("" : "+v"(t3)); E(acc, eu, wr, wc, t3 & 15, (t3 & 63) >> 4); }
        if (!has_next) break;
#pragma unroll
        for (int a = 0; a < 2; ++a)
#pragma unroll
            for (int b = 0; b < 2; ++b)
#pragma unroll
                for (int m = 0; m < 4; ++m)
#pragma unroll
                    for (int n = 0; n < 2; ++n) acc[a][b][m][n] = (f32x4){0.f, 0.f, 0.f, 0.f};
        cur = nxt; ++ui;
        if (wr == 1) PG8_BAR;
    }
    PG8_WAIT_V(0);
    PG8_BAR;
#undef PG8_SA
#undef PG8_SB
#undef PG8_STAGE
#undef PG8_LDA
#undef PG8_LDB
#undef PG8_MMA
#undef PG8_WAIT_V
#undef PG8_WAIT_L
#undef PG8_BAR
#undef PG8_SCHED
}
}

struct Params { const float* in[42]; float* out; unsigned char* ws; int ph_lo, ph_hi; };
enum { I_X = 0, I_C, I_CTX, I_CCTX, I_ADAW, I_ADAB, I_N1G, I_N2G, I_WIN, I_WOUT, I_GLAW, I_GLAB, I_GLAG, I_CDW, I_CDB, I_CLG, I_CLB, I_CPW, I_CPB,
       I_S5LR, I_S5LI, I_S5DT, I_S5BR, I_S5BI, I_S5CR, I_S5CI, I_S5D, I_S5GW, I_S5GB, I_QNG, I_KVNG, I_WUQ, I_WUKV, I_RW, I_RB, I_MG, I_MU, I_MD, I_SG, I_SU, I_SD, I_FG };

typedef const __attribute__((address_space(4))) Params* KParams;
__device__ __forceinline__ KParams fresh_params() { KParams kp = (KParams)__builtin_amdgcn_kernarg_segment_ptr(); asm volatile("" : "+s"(kp)); return kp; }
struct Ctx {
    LAS unsigned char* lds;
    int tid, lane, wave, blk, G;
    unsigned char* ws;
};

__device__ __forceinline__ int mod_row(int r) { return r < NLAT ? (r >> 11) : 32; }

__device__ __forceinline__ void tr_item(const float* W, int ldw, int k0, int n0, bf16* dst, int ldk, const float* kscale, float sc, LAS float* scr, int lane) {
    float tv[32];
#pragma unroll
    for (int i = 0; i < 32; ++i) tv[i] = W[(size_t)(k0 + 2 * i + (lane >> 5)) * ldw + n0 + (lane & 31)];
#pragma unroll
    for (int i = 0; i < 32; ++i) { const int kk = 2 * i + (lane >> 5); float v = tv[i] * sc; if (kscale) v *= kscale[k0 + kk]; scr[kk * 33 + (lane & 31)] = v; }
    lds_wait();
    const int c = lane & 7;
#pragma unroll
    for (int j = 0; j < 4; ++j) { const int n = (lane >> 3) + 8 * j; const LAS float* s = scr + (8 * c) * 33 + n;
        u32x4 o; o.x = pk2(s[0 * 33], s[1 * 33]); o.y = pk2(s[2 * 33], s[3 * 33]); o.z = pk2(s[4 * 33], s[5 * 33]); o.w = pk2(s[6 * 33], s[7 * 33]);
        *(u32x4*)(dst + (size_t)n * ldk + k0 + 8 * c) = o; }
    lds_wait();
}
template <int KIND> __device__ __forceinline__ int tr_dst(int n0) {
    if (KIND == 0) return n0;
    if (KIND == 1) return n0 < 768 ? n0 : (n0 == 768 ? 1952 : n0 - 32);
    if (KIND == 2) { const int half = n0 >> 8, c = n0 & 255; return (c >> 7) * 256 + half * 128 + (c & 127); }
    if (KIND == 3) { const int head = n0 / 96, d0 = n0 % 96; return d0 < 64 ? head * 64 + d0 : 256 + head * 32; }
    if (KIND == 4) { const int head = n0 >> 7, d0 = n0 & 127; return d0 < 64 ? head * 64 + d0 : 256 + head * 64 + (d0 - 64); }
    if (KIND == 5) return (n0 >> 7) * 256 + (n0 & 127);
    if (KIND == 6) return (n0 >> 7) * 256 + 128 + (n0 & 127);
    return n0;
}
template <int KIND> __device__ __forceinline__ void tr_matrix(const Ctx& c, const float* W, int ldw, int K, int Nsrc, bf16* WT, int ldk, const float* kscale, float sc) {
    LAS float* scr = (LAS float*)(c.lds + c.wave * 8704);
    const int gw = c.blk * NWAVES + c.wave, NGW = c.G * NWAVES, ng = Nsrc / 32, items = (K / 64) * ng;
    for (int it = gw; it < items; it += NGW) { const int kb = it / ng, g = it % ng; tr_item(W, ldw, kb * 64, 32 * g, WT + (size_t)tr_dst<KIND>(32 * g) * ldk, ldk, kscale, sc, scr, c.lane); }
}
__device__ __forceinline__ void zero_fill16(const Ctx& c, void* p, size_t bytes) {
    u32x4* q = (u32x4*)p; const size_t n = bytes / 16;
    for (size_t i = (size_t)c.blk * NTHR + c.tid; i < n; i += (size_t)c.G * NTHR) q[i] = (u32x4){0u, 0u, 0u, 0u};
}
__device__ __forceinline__ void sincos_r(float x, float& s, float& co) {
    const float n = rintf(x * 0.15915494309189535f);
    float r = fmaf(n, -6.28125f, x); r = fmaf(n, -1.9353071795864769e-3f, r);
    s = __sinf(r); co = __cosf(r);
}

__device__ __forceinline__ void prologue_moe_weights(const Ctx& c, KParams p, int l) {
    bf16* WGU = (bf16*)(c.ws + WS_WMOE); bf16* WD = WGU + (size_t)NE * 512 * 1024;
    LAS float* scr = (LAS float*)(c.lds + c.wave * 8704);
    const int gw = c.blk * NWAVES + c.wave, NGW = c.G * NWAVES;
    for (int it = gw; it < NE * 384; it += NGW) {
        const int e = it / 384, r = it % 384;
        if (r < 256) { const int up = r >> 7, q = r & 127, kb = q >> 3, g = q & 7;
            const float* W = p->in[up ? I_MU : I_MG] + ((size_t)l * NE + e) * 1024 * 256;
            const int nd = up ? tr_dst<6>(32 * g) : tr_dst<5>(32 * g);
            tr_item(W, 256, kb * 64, 32 * g, WGU + (size_t)e * 512 * 1024 + (size_t)nd * 1024, 1024, nullptr, 1.f, scr, c.lane);
        } else { const int q = r - 256, kb = q >> 5, g = q & 31;
            const float* W = p->in[I_MD] + ((size_t)l * NE + e) * 256 * 1024;
            tr_item(W, 1024, kb * 64, 32 * g, WD + (size_t)e * 1024 * 256 + (size_t)(32 * g) * 256, 256, nullptr, 1.f, scr, c.lane);
        }
    }
}

__device__ __forceinline__ void prologue(const Ctx& c, KParams p) {
    float* MOD = (float*)(c.ws + WS_MOD);
    {
        const int u = c.G - 1 - c.blk;
        if (u < 96) {
            LAS float* sc = (LAS float*)(c.lds + 72 * 1024);
            LAS float* part = (LAS float*)c.lds;
            const int l = u / 48, kq = c.tid >> 7, cj = c.tid & 127, col = (u % 48) * 128 + cj;
            const float* W = p->in[I_ADAW] + (size_t)l * 1024 * 6144;
            float acc[33];
#pragma unroll
            for (int b = 0; b < 33; ++b) acc[b] = 0.f;
            for (int j = 0; j < 4; ++j) {
                __syncthreads();
                for (int i = c.tid; i < 4 * 33 * 64; i += NTHR) { const int q = i / (33 * 64), r = i % (33 * 64), b = r >> 6, kk = r & 63, k = 256 * q + 64 * j + kk; const float v = b < 32 ? p->in[I_C][b * 1024 + k] : p->in[I_CCTX][k]; sc[i] = siluf_(v); }
                __syncthreads();
                const float* wp = W + (size_t)(256 * kq + 64 * j) * 6144 + col; const LAS float* sq = sc + kq * 33 * 64;
#pragma unroll 8
                for (int kk = 0; kk < 64; ++kk) { const float w = wp[(size_t)kk * 6144];
#pragma unroll
                    for (int b = 0; b < 33; ++b) acc[b] = fmaf(sq[b * 64 + kk], w, acc[b]); }
            }
#pragma unroll
            for (int b = 0; b < 33; ++b) part[(kq * 33 + b) * 128 + cj] = acc[b];
            __syncthreads();
            for (int i = c.tid; i < 33 * 128; i += NTHR) { const int b = i >> 7, cc = i & 127, gc = (u % 48) * 128 + cc;
                MOD[((size_t)l * 33 + b) * 6144 + gc] = (part[(0 * 33 + b) * 128 + cc] + part[(1 * 33 + b) * 128 + cc]) + (part[(2 * 33 + b) * 128 + cc] + part[(3 * 33 + b) * 128 + cc]) + p->in[I_ADAB][l * 6144 + gc]; }
            __syncthreads();
        }
    }
    {
        float* ROPE = (float*)(c.ws + WS_TAB + TAB_ROPE);
        for (int i = c.blk * NTHR + c.tid; i < 2048 * 16; i += c.G * NTHR) { const int t = i >> 4, ax = (i >> 3) & 1, f = i & 7;
            const float pos = (float)(ax == 0 ? (t >> 6) : (t & 63)); const float inv = __expf(-(float)f * (9.210340371976184f / 8.0f));
            float s, co; sincos_r(pos * inv, s, co); ROPE[i * 2] = co; ROPE[i * 2 + 1] = s; }
        bf16* RWT = (bf16*)(c.ws + WS_TAB + TAB_RWT);
        for (int i = c.blk * NTHR + c.tid; i < 2 * 64 * 1024; i += c.G * NTHR) { const int l = i >> 16, n = (i >> 10) & 63, k = i & 1023; const float wv = p->in[I_RW][((size_t)l * 1024 + k) * 64 + n];
            const bf16 hi = f2bf(wv); RWT[(size_t)(l * 2) * 65536 + n * 1024 + k] = hi; RWT[(size_t)(l * 2 + 1) * 65536 + n * 1024 + k] = f2bf(wv - bf2f(hi)); }
        float* S5T = (float*)(c.ws + WS_TAB + TAB_S5);
        for (int i = c.blk * NTHR + c.tid; i < 2 * 2 * 16 * 64; i += c.G * NTHR) {
            const int pp = i & 63, g = (i >> 6) & 15, ld = i >> 10;
            const float lr = p->in[I_S5LR][i], li = p->in[I_S5LI][i], dt = __expf(p->in[I_S5DT][ld * 16 + g]);
            const float mag = __expf(lr * dt); float s, co; sincos_r(li * dt, s, co);
            const float are = mag * co, aim = mag * s, den = lr * lr + li * li;
            const float fre = ((are - 1.f) * lr + aim * li) / den, fim = (aim * lr - (are - 1.f) * li) / den;
            float* T = S5T + (size_t)i * 66; T[0] = are; T[1] = aim;
            { float* PW = (float*)(c.ws + WS_S5P) + (size_t)i * 34; float pr = 1.f, pi = 0.f;
              for (int e = 0; e <= 16; ++e) { PW[2 * e] = pr; PW[2 * e + 1] = pi; const float nr = pr * are - pi * aim, ni = pr * aim + pi * are; pr = nr; pi = ni; } }
            for (int ch = 0; ch < 16; ++ch) { const float br = p->in[I_S5BR][(size_t)i * 16 + ch], bi = p->in[I_S5BI][(size_t)i * 16 + ch];
                T[2 + ch] = fre * br - fim * bi; T[18 + ch] = fre * bi + fim * br;
                T[34 + ch] = p->in[I_S5CR][((size_t)(ld * 16 + g) * 16 + ch) * 64 + pp]; T[50 + ch] = p->in[I_S5CI][((size_t)(ld * 16 + g) * 16 + ch) * 64 + pp]; }
        }
    }
    for (int l = 0; l < 2; ++l) {
        bf16* WIN = (bf16*)(c.ws + WS_WIN) + (size_t)l * 2048 * 1024;
        tr_matrix<1>(c, p->in[I_WIN] + (size_t)l * 1024 * 1984, 1984, 1024, 1984, WIN, 1024, nullptr, 1.f);
        zero_fill16(c, WIN + (size_t)1984 * 1024, (size_t)64 * 1024 * 2);
        tr_matrix<0>(c, p->in[I_WOUT] + (size_t)l * 1024 * 1024, 1024, 1024, 1024, (bf16*)(c.ws + WS_WOUT) + (size_t)l * 1024 * 1024, 1024, nullptr, 1.f);
        unsigned char* sm = c.ws + WS_WSM + (size_t)l * WSM_L;
        tr_matrix<0>(c, p->in[I_CPW] + (size_t)l * 256 * 256, 256, 256, 256, (bf16*)(sm + WSM_PW), 256, nullptr, 1.f);
        tr_matrix<2>(c, p->in[I_S5GW] + (size_t)l * 256 * 512, 512, 256, 512, (bf16*)(sm + WSM_GLU), 256, nullptr, 1.f);
        tr_matrix<3>(c, p->in[I_WUQ] + (size_t)l * 256 * 384, 384, 256, 384, (bf16*)(sm + WSM_UQ), 256, p->in[I_QNG] + l * 256, 0.14724445f  );
        zero_fill16(c, (bf16*)(sm + WSM_UQ) + (size_t)384 * 256, (size_t)128 * 256 * 2);
        zero_fill16(c, sm + WSM_UK, (size_t)512 * 256 * 2);
    }
    for (int l = 0; l < 2; ++l) {
        bf16* WSGU = (bf16*)(c.ws + WS_WSH) + (size_t)l * (512 * 1024 + 1024 * 256); bf16* WSD = WSGU + 512 * 1024;
        tr_matrix<5>(c, p->in[I_SG] + (size_t)l * 1024 * 256, 256, 1024, 256, WSGU, 1024, nullptr, 1.f);
        tr_matrix<6>(c, p->in[I_SU] + (size_t)l * 1024 * 256, 256, 1024, 256, WSGU, 1024, nullptr, 1.f);
        tr_matrix<0>(c, p->in[I_SD] + (size_t)l * 256 * 1024, 1024, 256, 1024, WSD, 256, nullptr, 1.f);
    }
    prologue_moe_weights(c, p, 0);
}
__device__ __forceinline__ void prologue_s5_weights(const Ctx& c, KParams p) {
    const float* S5T = (const float*)(c.ws + WS_TAB + TAB_S5); const float* S5P = (const float*)(c.ws + WS_S5P);
    LAS float* pw = (LAS float*)c.lds;
    LAS float* bb = pw + 2 * 17 * 64 * 2;
    LAS float* cc = bb + 2 * 64 * 16 * 2;
    LAS float* kt = cc + 2 * 16 * 64 * 2;
    for (int u = c.blk; u < 32; u += c.G) {
        const int l = u >> 4, g = u & 15;
        __syncthreads();
        for (int i = c.tid; i < 2 * 64; i += NTHR) { const int dir = i >> 6, pp = i & 63; const size_t row = (size_t)((l * 2 + dir) * 16 + g) * 64 + pp; const float* T = S5T + row * 66; const float* PW = S5P + row * 34;
            for (int e = 0; e <= 16; ++e) { pw[((dir * 17 + e) * 64 + pp) * 2] = PW[2 * e]; pw[((dir * 17 + e) * 64 + pp) * 2 + 1] = PW[2 * e + 1]; }
            for (int ch = 0; ch < 16; ++ch) { bb[((dir * 64 + pp) * 16 + ch) * 2] = T[2 + ch]; bb[((dir * 64 + pp) * 16 + ch) * 2 + 1] = T[18 + ch]; cc[((dir * 16 + ch) * 64 + pp) * 2] = T[34 + ch]; cc[((dir * 16 + ch) * 64 + pp) * 2 + 1] = T[50 + ch]; } }
        __syncthreads();
        for (int i = c.tid; i < 2 * 16 * 256; i += NTHR) { const int dir = i >> 12, tau = (i >> 8) & 15, c1 = (i >> 4) & 15, c0 = i & 15; float s = 0.f;
            for (int pp = 0; pp < 64; ++pp) { const float cr = cc[((dir * 16 + c1) * 64 + pp) * 2], ci = cc[((dir * 16 + c1) * 64 + pp) * 2 + 1], pr = pw[((dir * 17 + tau) * 64 + pp) * 2], pi = pw[((dir * 17 + tau) * 64 + pp) * 2 + 1];
                const float wr_ = cr * pr - ci * pi, wi_ = cr * pi + ci * pr; s += wr_ * bb[((dir * 64 + pp) * 16 + c0) * 2] - wi_ * bb[((dir * 64 + pp) * 16 + c0) * 2 + 1]; }
            kt[i] = s; }
        __syncthreads();
        bf16* B1 = (bf16*)(c.ws + WS_S5W) + (size_t)(l * 16 + g) * 256 * 256;
        bf16* B2 = (bf16*)(c.ws + WS_S5W) + (size_t)32 * 256 * 256 + (size_t)(l * 16 + g) * 256 * 512;
        const float* dsk = p->in[I_S5D] + l * 256 + g * 16;
        for (int i = c.tid; i < 256 * 256; i += NTHR) { const int n = i >> 8, k = i & 255, dir = n >> 7, ri = (n >> 6) & 1, pp = n & 63, s = k >> 4, ch = k & 15, e = dir ? s : 15 - s;
            const float pr = pw[((dir * 17 + e) * 64 + pp) * 2], pi = pw[((dir * 17 + e) * 64 + pp) * 2 + 1], br = bb[((dir * 64 + pp) * 16 + ch) * 2], bi = bb[((dir * 64 + pp) * 16 + ch) * 2 + 1];
            B1[i] = f2bf(ri ? pr * bi + pi * br : pr * br - pi * bi); }
        for (int i = c.tid; i < 256 * 512; i += NTHR) { const int n = i >> 9, k = i & 511, t = n >> 4, c1 = n & 15; float v;
            if (k < 256) { const int s = k >> 4, c0 = k & 15; v = 0.f; if (s <= t) v += kt[((0 * 16 + (t - s)) * 16 + c1) * 16 + c0]; if (s >= t) v += kt[((1 * 16 + (s - t)) * 16 + c1) * 16 + c0]; if (s == t && c0 == c1) v += dsk[c0]; }
            else { const int q = k - 256, dir = q >> 7, ri = (q >> 6) & 1, pp = q & 63, e = dir ? 16 - t : t + 1;
                const float cr = cc[((dir * 16 + c1) * 64 + pp) * 2], ci = cc[((dir * 16 + c1) * 64 + pp) * 2 + 1], pr = pw[((dir * 17 + e) * 64 + pp) * 2], pi = pw[((dir * 17 + e) * 64 + pp) * 2 + 1];
                v = ri ? -(cr * pi + ci * pr) : (cr * pr - ci * pi); }
            B2[i] = f2bf(v); }
    }
    __syncthreads();
}
__device__ __forceinline__ void prologue2(const Ctx& c, KParams p) {
    prologue_s5_weights(c, p);
    for (int l = 0; l < 2; ++l) { unsigned char* sm = c.ws + WS_WSM + (size_t)l * WSM_L;
        tr_matrix<4>(c, p->in[I_WUKV] + (size_t)l * 128 * 512, 512, 128, 512, (bf16*)(sm + WSM_UK), 256, p->in[I_KVNG] + l * 128, 1.f); }
}

__device__ __forceinline__ void norm_row(const float* xrow, const float* gain, const float* sh, const float* sc, bf16* orow, int lane, f32x4 (&v)[4]) {
    float ss = 0.f;
#pragma unroll
    for (int j = 0; j < 4; ++j) { v[j] = *(const f32x4*)(xrow + 4 * lane + 256 * j); ss += (v[j].x * v[j].x + v[j].y * v[j].y) + (v[j].z * v[j].z + v[j].w * v[j].w); }
    const float rstd = rsqrtf(wave_sum(ss) * (1.f / 1024.f) + EPS);
#pragma unroll
    for (int j = 0; j < 4; ++j) { const int cc = 4 * lane + 256 * j; const f32x4 g = *(const f32x4*)(gain + cc), s1 = *(const f32x4*)(sc + cc), s0 = *(const f32x4*)(sh + cc);
        v[j] = v[j] * rstd * g * (s1 + 1.0f) + s0;
        u32x2 o; o.x = pk2(v[j].x, v[j].y); o.y = pk2(v[j].z, v[j].w); *(u32x2*)(orow + cc) = o; }
}
__device__ __forceinline__ void norm_row_add(const float* xrow, const bf16* drow, float* xout, const float* gain, const float* sh, const float* sc, bf16* orow, int lane, f32x4 (&v)[4]) {
    float ss = 0.f; u32x2 dl[4];
#pragma unroll
    for (int j = 0; j < 4; ++j) { v[j] = *(const f32x4*)(xrow + 4 * lane + 256 * j); dl[j] = *(const u32x2*)(drow + 4 * lane + 256 * j); }
#pragma unroll
    for (int j = 0; j < 4; ++j) { v[j] += (f32x4){__uint_as_float(dl[j].x << 16), __uint_as_float(dl[j].x & 0xffff0000u), __uint_as_float(dl[j].y << 16), __uint_as_float(dl[j].y & 0xffff0000u)};
        *(f32x4*)(xout + 4 * lane + 256 * j) = v[j]; ss += (v[j].x * v[j].x + v[j].y * v[j].y) + (v[j].z * v[j].z + v[j].w * v[j].w); }
    const float rstd = rsqrtf(wave_sum(ss) * (1.f / 1024.f) + EPS);
#pragma unroll
    for (int j = 0; j < 4; ++j) { const int cc = 4 * lane + 256 * j; const f32x4 g = *(const f32x4*)(gain + cc), s1 = *(const f32x4*)(sc + cc), s0 = *(const f32x4*)(sh + cc);
        v[j] = v[j] * rstd * g * (s1 + 1.0f) + s0;
        u32x2 o; o.x = pk2(v[j].x, v[j].y); o.y = pk2(v[j].z, v[j].w); *(u32x2*)(orow + cc) = o; }
}
__device__ __forceinline__ void phase_norm1(const Ctx& c, KParams p, int l) {
    const float* MOD = (const float*)(c.ws + WS_MOD) + (size_t)l * 33 * 6144;
    const float* xl = l == 0 ? p->in[I_X] : p->out; const float* xc = l == 0 ? p->in[I_CTX] : (const float*)(c.ws + WS_XC);
    bf16* H = (bf16*)(c.ws + WS_H); const float* gain = p->in[I_N1G] + l * DM;
    const int gw = c.blk * NWAVES + c.wave, NGW = c.G * NWAVES, lane = c.lane;
    for (int r0 = gw; r0 < NTOK; r0 += 2 * NGW) {
        f32x4 v[2][4]; float ss[2];
#pragma unroll
        for (int k = 0; k < 2; ++k) { const int r = r0 + k * NGW < NTOK ? r0 + k * NGW : r0; const float* xr = r < NLAT ? xl + (size_t)r * DM : xc + (size_t)(r - NLAT) * DM;
#pragma unroll
            for (int j = 0; j < 4; ++j) v[k][j] = *(const f32x4*)(xr + 4 * lane + 256 * j); }
#pragma unroll
        for (int k = 0; k < 2; ++k) { ss[k] = 0.f;
#pragma unroll
            for (int j = 0; j < 4; ++j) ss[k] += (v[k][j].x * v[k][j].x + v[k][j].y * v[k][j].y) + (v[k][j].z * v[k][j].z + v[k][j].w * v[k][j].w); }
#pragma unroll
        for (int k = 0; k < 2; ++k) { const int r = r0 + k * NGW; if (r < NTOK) { const float rstd = rsqrtf(wave_sum(ss[k]) * (1.f / 1024.f) + EPS); const float* m = MOD + (size_t)mod_row(r) * 6144; bf16* orow = H + (size_t)r * DM;
#pragma unroll
            for (int j = 0; j < 4; ++j) { const int cc = 4 * lane + 256 * j; const f32x4 g = *(const f32x4*)(gain + cc), s1 = *(const f32x4*)(m + 1024 + cc), s0 = *(const f32x4*)(m + cc);
                const f32x4 y = v[k][j] * rstd * g * (s1 + 1.0f) + s0; u32x2 o; o.x = pk2(y.x, y.y); o.y = pk2(y.z, y.w); *(u32x2*)(orow + cc) = o; } } }
    }
}

#define EPI_ARGS const f32x4 (&acc)[2][2][4][2], const pg8::Unit& u, int wr, int wc, int fr, int fq
#define EPI_ROWS for (int ai = 0; ai < 2; ++ai) _Pragma("unroll") for (int m = 0; m < 4; ++m)
struct EpiBf16 {
    bf16* O; int ldo;
    __device__ __forceinline__ void operator()(EPI_ARGS) const {
        const int r0 = u.pm * 256 + wr * 64 + fr, c0 = u.pn * 256 + wc * 32 + 8 * fq;
#pragma unroll
        EPI_ROWS { bf16* rp = O + (size_t)(r0 + ai * 128 + m * 16) * ldo + c0;
#pragma unroll
            for (int bj = 0; bj < 2; ++bj) { const f32x4 a = acc[ai][bj][m][0], b = acc[ai][bj][m][1]; u32x4 w; w.x = pk2(a.x, a.y); w.y = pk2(a.z, a.w); w.z = pk2(b.x, b.y); w.w = pk2(b.z, b.w); *(u32x4*)(rp + bj * 128) = w; } asm volatile("" ::: "memory"); }
    }
};
struct EpiInProj {
    bf16* O; bf16* UP; bf16* GVT;
    __device__ __forceinline__ void operator()(EPI_ARGS) const {
        const int r0 = u.pm * 256 + wr * 64 + fr, c0 = u.pn * 256 + wc * 32 + 8 * fq;
#pragma unroll
        EPI_ROWS { const int row = r0 + ai * 128 + m * 16; bf16* rp = O + (size_t)row * ZW + c0;
            const int crow = row < NLAT ? (row >> 11) * 144 + 16 + ((row & 2047) >> 4) : ((row - NLAT) >> 8) * 144 + (((row - NLAT) & 255) >> 4);
#pragma unroll
            for (int bj = 0; bj < 2; ++bj) { const f32x4 a = acc[ai][bj][m][0], b = acc[ai][bj][m][1]; u32x4 w; w.x = pk2(a.x, a.y); w.y = pk2(a.z, a.w); w.z = pk2(b.x, b.y); w.w = pk2(b.z, b.w); *(u32x4*)(rp + bj * 128) = w;
                if (u.pn == 5) { const int g = 8 * bj + 2 * wc + (fq >> 1); *(u32x4*)(UP + ((size_t)g * 4608 + crow) * 512 + fr * 16 + 8 * (fq & 1)) = w; }
                if (u.pn == 1) { const int col = 128 * bj + 32 * wc + 8 * fq, bb = row < NLAT ? (row >> 11) : ((row - NLAT) >> 8), kk = row < NLAT ? 256 + (row & 2047) : ((row - NLAT) & 255);
                    bf16* dst = GVT + ((size_t)(bb * 4 + (col >> 6)) * 64 + (col & 63)) * 2304 + (kk & ~15) + 8 * ((fr >> 2) & 1) + 4 * (fr >> 3) + (fr & 3);
#pragma unroll
                    for (int n = 0; n < 2; ++n)
#pragma unroll
                        for (int i = 0; i < 4; ++i) dst[(size_t)(4 * n + i) * 2304] = f2bf(acc[ai][bj][m][n][i]); } }
            asm volatile("" ::: "memory"); }
    }
};
struct EpiS5X {
    bf16* XE;
    __device__ __forceinline__ void operator()(EPI_ARGS) const {
        const int r0 = u.pm * 256 + wr * 64 + fr, c0 = wc * 32 + 8 * fq;
#pragma unroll
        EPI_ROWS { bf16* rp = XE + (size_t)(r0 + ai * 128 + m * 16) * 256 + c0;
#pragma unroll
            for (int bj = 0; bj < 2; ++bj) { const f32x4 a = acc[ai][bj][m][0], b = acc[ai][bj][m][1]; u32x4 w; w.x = pk2(a.x, a.y); w.y = pk2(a.z, a.w); w.z = pk2(b.x, b.y); w.w = pk2(b.z, b.w); *(u32x4*)(rp + bj * 128) = w; }
            asm volatile("" ::: "memory"); }
    }
};
struct EpiS5Y {
    bf16* Y;
    __device__ __forceinline__ void operator()(EPI_ARGS) const {
        const int r0 = u.pm * 256 + wr * 64 + fr;
#pragma unroll
        EPI_ROWS { const int grow = r0 + ai * 128 + m * 16; const int g = grow / 4608, rem = grow - g * 4608, b = rem / 144, ci = rem - b * 144;
            const int tok0 = ci < 16 ? NLAT + b * CTXL + ci * 16 : b * SEQ + (ci - 16) * 16;
#pragma unroll
            for (int bj = 0; bj < 2; ++bj) { const int t = 8 * bj + 2 * wc + (fq >> 1); const f32x4 a = acc[ai][bj][m][0], bq = acc[ai][bj][m][1]; u32x4 w; w.x = pk2(a.x, a.y); w.y = pk2(a.z, a.w); w.z = pk2(bq.x, bq.y); w.w = pk2(bq.z, bq.w);
                *(u32x4*)(Y + (size_t)(tok0 + t) * 256 + g * 16 + 8 * (fq & 1)) = w; }
            asm volatile("" ::: "memory"); }
    }
};
struct EpiOB8 {
    unsigned char* OB;
    __device__ __forceinline__ void operator()(EPI_ARGS) const {
        const int r0 = u.pm * 256 + wr * 64 + fr;
#pragma unroll
        EPI_ROWS { unsigned char* rp = OB + (size_t)(r0 + ai * 128 + m * 16) * 1024 + u.pn * 256 + (wc * 4 + fq) * 16; u32x4 w;
#pragma unroll
            for (int bj = 0; bj < 2; ++bj)
#pragma unroll
                for (int n = 0; n < 2; ++n) { const f32x4 a = acc[ai][bj][m][n] * 16.0f; int pk = 0;
                    pk = __builtin_amdgcn_cvt_pk_fp8_f32(__builtin_amdgcn_fmed3f(a.x, -440.f, 440.f), __builtin_amdgcn_fmed3f(a.y, -440.f, 440.f), pk, false);
                    pk = __builtin_amdgcn_cvt_pk_fp8_f32(__builtin_amdgcn_fmed3f(a.z, -440.f, 440.f), __builtin_amdgcn_fmed3f(a.w, -440.f, 440.f), pk, true); w[2 * bj + n] = (unsigned)pk; }
            *(u32x4*)rp = w; asm volatile("" ::: "memory"); }
    }
};
struct EpiBiasBf16 {
    bf16* O; int ldo; const float* bias;
    __device__ __forceinline__ void operator()(EPI_ARGS) const {
        const int r0 = u.pm * 256 + wr * 64 + fr, c0 = u.pn * 256 + wc * 32 + 8 * fq;
        f32x4 bv[2][2];
#pragma unroll
        for (int bj = 0; bj < 2; ++bj) { bv[bj][0] = *(const f32x4*)(bias + c0 + bj * 128); bv[bj][1] = *(const f32x4*)(bias + c0 + bj * 128 + 4); }
        __builtin_amdgcn_s_waitcnt(0x0F70);
#pragma unroll
        EPI_ROWS { bf16* rp = O + (size_t)(r0 + ai * 128 + m * 16) * ldo + c0;
#pragma unroll
            for (int bj = 0; bj < 2; ++bj) { const f32x4 a = acc[ai][bj][m][0] + bv[bj][0], b = acc[ai][bj][m][1] + bv[bj][1]; u32x4 w; w.x = pk2(a.x, a.y); w.y = pk2(a.z, a.w); w.z = pk2(b.x, b.y); w.w = pk2(b.z, b.w); *(u32x4*)(rp + bj * 128) = w; } asm volatile("" ::: "memory"); }
    }
};
struct EpiGluSig {
    bf16* O; int ldo; const float* bias;
    __device__ __forceinline__ void operator()(EPI_ARGS) const {
        const int r0 = u.pm * 256 + wr * 64 + fr, c0 = u.pn * 128 + wc * 32 + 8 * fq;
        f32x4 b1[2], b2[2];
#pragma unroll
        for (int n = 0; n < 2; ++n) { b1[n] = *(const f32x4*)(bias + c0 + 4 * n); b2[n] = *(const f32x4*)(bias + 256 + c0 + 4 * n); }
        __builtin_amdgcn_s_waitcnt(0x0F70);
#pragma unroll
        EPI_ROWS { bf16* rp = O + (size_t)(r0 + ai * 128 + m * 16) * ldo + c0; float o[8];
#pragma unroll
            for (int n = 0; n < 2; ++n)
#pragma unroll
                for (int i = 0; i < 4; ++i) o[4 * n + i] = (acc[ai][0][m][n][i] + b1[n][i]) * sigmoidf_(acc[ai][1][m][n][i] + b2[n][i]);
            u32x4 w; w.x = pk2(o[0], o[1]); w.y = pk2(o[2], o[3]); w.z = pk2(o[4], o[5]); w.w = pk2(o[6], o[7]); *(u32x4*)rp = w; asm volatile("" ::: "memory"); }
    }
};
struct EpiSwiglu {
    bf16* O; int ldo;
    __device__ __forceinline__ void operator()(EPI_ARGS) const {
        const int r0 = u.pm * 256 + wr * 64 + fr, c0 = u.pn * 128 + wc * 32 + 8 * fq;
#pragma unroll
        EPI_ROWS { bf16* rp = O + (size_t)(r0 + ai * 128 + m * 16) * ldo + c0; float o[8];
#pragma unroll
            for (int n = 0; n < 2; ++n)
#pragma unroll
                for (int i = 0; i < 4; ++i) o[4 * n + i] = siluf_(acc[ai][0][m][n][i]) * acc[ai][1][m][n][i];
            u32x4 w; w.x = pk2(o[0], o[1]); w.y = pk2(o[2], o[3]); w.z = pk2(o[4], o[5]); w.w = pk2(o[6], o[7]); *(u32x4*)rp = w; asm volatile("" ::: "memory"); }
    }
};
struct EpiQ {
    bf16* Q; const float* RS;
    __device__ __forceinline__ void operator()(EPI_ARGS) const {
        const int r0 = u.pm * 256 + wr * 64 + fr; float rq[8];
#pragma unroll
        for (int g = 0; g < 8; ++g) rq[g] = RS[(size_t)(r0 + (g >> 2) * 128 + (g & 3) * 16) * 2];
        __builtin_amdgcn_s_waitcnt(0x0F70);
#pragma unroll
        EPI_ROWS { const int row = r0 + ai * 128 + m * 16; const float rs = rq[ai * 4 + m]; bf16* rp = Q + (size_t)row * 384;
            if (u.pn == 0) {
#pragma unroll
                for (int bj = 0; bj < 2; ++bj) { const int head = 2 * bj + (wc >> 1), d = 32 * (wc & 1) + 8 * fq; const f32x4 a = acc[ai][bj][m][0] * rs, b = acc[ai][bj][m][1] * rs;
                    u32x4 w; w.x = pk2(a.x, a.y); w.y = pk2(a.z, a.w); w.z = pk2(b.x, b.y); w.w = pk2(b.z, b.w); *(u32x4*)(rp + head * 96 + d) = w; }
            } else { const f32x4 a = acc[ai][0][m][0] * rs, b = acc[ai][0][m][1] * rs;
                u32x4 w; w.x = pk2(a.x, a.y); w.y = pk2(a.z, a.w); w.z = pk2(b.x, b.y); w.w = pk2(b.z, b.w); *(u32x4*)(rp + wc * 96 + 64 + 8 * fq) = w; }
            asm volatile("" ::: "memory"); }
    }
};
struct EpiKV {
    bf16* Kb; bf16* VT; const float* RS;
    __device__ __forceinline__ void operator()(EPI_ARGS) const {
        const int r0 = u.pm * 256 + wr * 64 + fr;
        const int p16 = 8 * ((fr >> 2) & 1) + 4 * (fr >> 3) + (fr & 3); float rkv[8];
#pragma unroll
        for (int g = 0; g < 8; ++g) rkv[g] = RS[(size_t)(r0 + (g >> 2) * 128 + (g & 3) * 16) * 2 + 1];
        __builtin_amdgcn_s_waitcnt(0x0F70);
#pragma unroll
        EPI_ROWS { const int row = r0 + ai * 128 + m * 16; const float rk = rkv[ai * 4 + m];
            if (u.pn == 0) {
#pragma unroll
                for (int bj = 0; bj < 2; ++bj) { const int head = 2 * bj + (wc >> 1), d = 32 * (wc & 1) + 8 * fq; const f32x4 a = acc[ai][bj][m][0] * rk, b = acc[ai][bj][m][1] * rk;
                    u32x4 w; w.x = pk2(a.x, a.y); w.y = pk2(a.z, a.w); w.z = pk2(b.x, b.y); w.w = pk2(b.z, b.w);
                    *(u32x4*)(Kb + (size_t)row * 384 + head * 96 + d) = w; }
            } else {
                const int bb = row < NLAT ? (row >> 11) : ((row - NLAT) >> 8); const int kk = row < NLAT ? (row & 2047) : 2048 + ((row - NLAT) & 255);
                const int pos = (kk & ~15) + p16;
#pragma unroll
                for (int bj = 0; bj < 2; ++bj) { const int head = 2 * bj + (wc >> 1), d = 32 * (wc & 1) + 8 * fq; bf16* dst = VT + ((size_t)((bb * 4 + head) * 64 + d)) * 2304 + pos;
#pragma unroll
                    for (int n = 0; n < 2; ++n)
#pragma unroll
                        for (int i = 0; i < 4; ++i) dst[(size_t)(4 * n + i) * 2304] = f2bf(acc[ai][bj][m][n][i] * rk); }
            }
            asm volatile("" ::: "memory"); }
    }
};
struct EpiDelta {
    bf16* D; const float* MODg;
    __device__ __forceinline__ void operator()(EPI_ARGS) const {
        const int rt = u.pm * 256; const float* g = MODg + (size_t)(rt < NLAT ? (rt >> 11) : 32) * 6144;
        const int r0 = rt + wr * 64 + fr, c0 = u.pn * 256 + wc * 32 + 8 * fq;
        f32x4 gv[2][2];
#pragma unroll
        for (int bj = 0; bj < 2; ++bj) { gv[bj][0] = *(const f32x4*)(g + c0 + bj * 128); gv[bj][1] = *(const f32x4*)(g + c0 + bj * 128 + 4); }
        __builtin_amdgcn_s_waitcnt(0x0F70);
#pragma unroll
        EPI_ROWS { bf16* rp = D + (size_t)(r0 + ai * 128 + m * 16) * DM + c0;
#pragma unroll
            for (int bj = 0; bj < 2; ++bj) { const f32x4 a = gv[bj][0] * acc[ai][bj][m][0], b = gv[bj][1] * acc[ai][bj][m][1]; u32x4 w; w.x = pk2(a.x, a.y); w.y = pk2(a.z, a.w); w.z = pk2(b.x, b.y); w.w = pk2(b.z, b.w); *(u32x4*)(rp + bj * 128) = w; }
            asm volatile("" ::: "memory"); }
    }
};

__device__ __forceinline__ int seq_row(int b, int dir, int pos) {
    if (pos < CTXL) return NLAT + b * CTXL + (dir ? CTXL - 1 - pos : pos);
    const int t = pos - CTXL; return b * SEQ + (dir ? SEQ - 1 - t : t);
}
__device__ __forceinline__ void phase_gla(const Ctx& c, KParams p, int l) {
    const bf16* Z = (const bf16*)(c.ws + WS_Z); const bf16* GVT = (const bf16*)(c.ws + WS_GVT); bf16* OG = (bf16*)(c.ws + WS_T1);
    const int w = c.wave, tid = c.tid;
    LAS float* wtab = (LAS float*)c.lds;
    LAS float* DD = (LAS float*)(c.lds + 4096);
    LAS unsigned char* RW = c.lds + 8192 + w * 13824;
    LAS float* LA = (LAS float*)RW;
    LAS unsigned char* KTT = RW + 9216;
    for (int u = c.blk; u < 256; u += c.G) {
        const int b = u >> 3, h = (u >> 1) & 3, dir = u & 1;
        __syncthreads();
        { const float* wa = p->in[I_GLAW] + ((size_t)(l * 2 + dir) * 16) * 128 + h * 32; wtab[tid] = wa[(tid >> 5) * 128 + (tid & 31)]; if (tid < 32) wtab[512 + tid] = p->in[I_GLAB][(l * 2 + dir) * 128 + h * 32 + tid]; }
        float Sst[4] = {0.f, 0.f, 0.f, 0.f};
        __syncthreads();
        for (int gi = 0; gi < 5; ++gi) {
            const int pc = gi * 8 + w; const bool active = pc < 36;
            int lane_ = c.lane; asm volatile("" : "+v"(lane_));
            const int r = lane_ & 31, hh = lane_ >> 5;
            const int p16 = 8 * ((r >> 2) & 1) + 4 * ((r & 15) >> 3) + (r & 3);
            const int pos0 = (r & 16) + p16, pos1 = 32 + pos0;
            bf16x8 qd[2][2]; f32x16 oacc[2][2]; int row0 = 0;
            if (active) {
                int kk0;
                if (dir == 0) { if (pc < 4) { row0 = NLAT + b * CTXL + pc * 64; kk0 = pc * 64; } else { row0 = b * SEQ + (pc - 4) * 64; kk0 = 256 + (pc - 4) * 64; } }
                else { if (pc < 4) { row0 = NLAT + b * CTXL + (3 - pc) * 64; kk0 = (3 - pc) * 64; } else { row0 = b * SEQ + (35 - pc) * 64; kk0 = 256 + (35 - pc) * 64; } }
#pragma unroll
                for (int ib = 0; ib < 2; ++ib) { const bf16* zr = Z + (size_t)(row0 + 32 * ib + r) * ZW; float al[16]; { const u32x4 a0 = *(const u32x4*)(zr + ZAF + dir * 16), a1 = *(const u32x4*)(zr + ZAF + dir * 16 + 8); float t8[8]; unpack8(a0, t8);
#pragma unroll
                        for (int j = 0; j < 8; ++j) al[j] = t8[j];
                        unpack8(a1, t8);
#pragma unroll
                        for (int j = 0; j < 8; ++j) al[8 + j] = t8[j]; }
#pragma unroll
                    for (int ks = 0; ks < 2; ++ks) { float za[8]; { const f32x4 b0 = *(const LAS f32x4*)(wtab + 512 + 16 * ks + 8 * hh), b1 = *(const LAS f32x4*)(wtab + 512 + 16 * ks + 8 * hh + 4);
                            za[0] = b0.x; za[1] = b0.y; za[2] = b0.z; za[3] = b0.w; za[4] = b1.x; za[5] = b1.y; za[6] = b1.z; za[7] = b1.w; }
#pragma unroll
                        for (int j = 0; j < 16; ++j) { const f32x4 w0 = *(const LAS f32x4*)(wtab + j * 32 + 16 * ks + 8 * hh), w1 = *(const LAS f32x4*)(wtab + j * 32 + 16 * ks + 8 * hh + 4);
                            za[0] = fmaf(al[j], w0.x, za[0]); za[1] = fmaf(al[j], w0.y, za[1]); za[2] = fmaf(al[j], w0.z, za[2]); za[3] = fmaf(al[j], w0.w, za[3]);
                            za[4] = fmaf(al[j], w1.x, za[4]); za[5] = fmaf(al[j], w1.y, za[5]); za[6] = fmaf(al[j], w1.z, za[6]); za[7] = fmaf(al[j], w1.w, za[7]); }
                        float la[8];
#pragma unroll
                        for (int e = 0; e < 8; ++e) la[e] = (fminf(za[e], 0.f) - __logf(1.f + __expf(-fabsf(za[e])))) * 0.0625f;
                        *(LAS f32x4*)(LA + (32 * ib + r) * 36 + 16 * ks + 8 * hh) = (f32x4){la[0], la[1], la[2], la[3]}; *(LAS f32x4*)(LA + (32 * ib + r) * 36 + 16 * ks + 8 * hh + 4) = (f32x4){la[4], la[5], la[6], la[7]}; } }
                lds_wait();
                { float bend; float v[32], s = 0.f;
#pragma unroll
                  for (int qq = 0; qq < 32; ++qq) { const int q = 32 * hh + qq, i = dir ? 63 - q : q; v[qq] = LA[i * 36 + r]; s += v[qq]; }
                  const auto sw = __builtin_amdgcn_permlane32_swap(__float_as_uint(s), __float_as_uint(s), false, false);
                  const float h0 = __uint_as_float(sw[0]), h1 = __uint_as_float(sw[1]); bend = h0 + h1;
                  float run = hh ? h0 : 0.f;
#pragma unroll
                  for (int qq = 0; qq < 32; ++qq) { const int q = 32 * hh + qq, i = dir ? 63 - q : q; run += v[qq]; LA[i * 36 + r] = run; }
                  if (hh == 0) DD[w * 32 + r] = __expf(bend); }
                lds_wait();
                bf16x8 ki[2][2];
#pragma unroll
                for (int ib = 0; ib < 2; ++ib) { const bf16* zr = Z + (size_t)(row0 + 32 * ib + r) * ZW;
#pragma unroll
                    for (int ks = 0; ks < 2; ++ks) { const int dk0 = 16 * ks + 8 * hh; float q8[8], k8[8], b8[8]; unpack8(*(const u32x4*)(zr + ZQ + h * 32 + dk0), q8); unpack8(*(const u32x4*)(zr + ZK + h * 32 + dk0), k8);
                        { const f32x4 x0 = *(const LAS f32x4*)(LA + (32 * ib + r) * 36 + dk0), x1 = *(const LAS f32x4*)(LA + (32 * ib + r) * 36 + dk0 + 4); b8[0] = x0.x; b8[1] = x0.y; b8[2] = x0.z; b8[3] = x0.w; b8[4] = x1.x; b8[5] = x1.y; b8[6] = x1.z; b8[7] = x1.w; }
                        float qo[8], ko[8];
#pragma unroll
                        for (int e = 0; e < 8; ++e) { const float eb = __expf(b8[e]), ieb = 1.f / eb; qo[e] = q8[e] * 0.17677669529663687f * eb; ko[e] = k8[e] * ieb;
                            *(LAS bf16*)(KTT + ((dk0 + e) * 72 + (ib ? pos1 : pos0)) * 2) = f2bf(ko[e] * DD[w * 32 + dk0 + e]); }
                        u32x4 wq, wk; wq.x = pk2(qo[0], qo[1]); wq.y = pk2(qo[2], qo[3]); wq.z = pk2(qo[4], qo[5]); wq.w = pk2(qo[6], qo[7]); wk.x = pk2(ko[0], ko[1]); wk.y = pk2(ko[2], ko[3]); wk.z = pk2(ko[4], ko[5]); wk.w = pk2(ko[6], ko[7]);
                        qd[ib][ks] = __builtin_bit_cast(bf16x8, wq); ki[ib][ks] = __builtin_bit_cast(bf16x8, wk); } }
                bf16x8 vt[2][4];
#pragma unroll
                for (int db = 0; db < 2; ++db)
#pragma unroll
                    for (int s4 = 0; s4 < 4; ++s4) vt[db][s4] = *(const bf16x8*)(GVT + ((size_t)(b * 4 + h) * 64 + 32 * db + r) * 2304 + kk0 + 16 * s4 + 8 * hh);
                f32x16 zero16;
#pragma unroll
                for (int i = 0; i < 16; ++i) zero16[i] = 0.f;
                f32x16 a00 = __builtin_amdgcn_mfma_f32_32x32x16_bf16(ki[0][0], qd[0][0], zero16, 0, 0, 0); a00 = __builtin_amdgcn_mfma_f32_32x32x16_bf16(ki[0][1], qd[0][1], a00, 0, 0, 0);
                f32x16 a11 = __builtin_amdgcn_mfma_f32_32x32x16_bf16(ki[1][0], qd[1][0], zero16, 0, 0, 0); a11 = __builtin_amdgcn_mfma_f32_32x32x16_bf16(ki[1][1], qd[1][1], a11, 0, 0, 0);
                f32x16 aof;
                if (dir == 0) { aof = __builtin_amdgcn_mfma_f32_32x32x16_bf16(ki[0][0], qd[1][0], zero16, 0, 0, 0); aof = __builtin_amdgcn_mfma_f32_32x32x16_bf16(ki[0][1], qd[1][1], aof, 0, 0, 0); }
                else { aof = __builtin_amdgcn_mfma_f32_32x32x16_bf16(ki[1][0], qd[0][0], zero16, 0, 0, 0); aof = __builtin_amdgcn_mfma_f32_32x32x16_bf16(ki[1][1], qd[0][1], aof, 0, 0, 0); }
#pragma unroll
                for (int i = 0; i < 16; ++i) { const int j = (i & 3) + 8 * (i >> 2) + 4 * hh; const bool keep = dir ? (j >= r) : (j <= r); a00[i] = keep ? a00[i] : 0.f; a11[i] = keep ? a11[i] : 0.f; }
#define GLA_P(X, s) ({ u32x4 w_; w_.x = pk2((X)[8 * (s)], (X)[8 * (s) + 1]); w_.y = pk2((X)[8 * (s) + 2], (X)[8 * (s) + 3]); w_.z = pk2((X)[8 * (s) + 4], (X)[8 * (s) + 5]); w_.w = pk2((X)[8 * (s) + 6], (X)[8 * (s) + 7]); __builtin_bit_cast(bf16x8, w_); })
                const bf16x8 p00a = GLA_P(a00, 0), p00b = GLA_P(a00, 1), p11a = GLA_P(a11, 0), p11b = GLA_P(a11, 1), pofa = GLA_P(aof, 0), pofb = GLA_P(aof, 1);
#pragma unroll
                for (int db = 0; db < 2; ++db) {
                    f32x16 o0 = __builtin_amdgcn_mfma_f32_32x32x16_bf16(vt[db][0], p00a, zero16, 0, 0, 0); o0 = __builtin_amdgcn_mfma_f32_32x32x16_bf16(vt[db][1], p00b, o0, 0, 0, 0);
                    f32x16 o1 = __builtin_amdgcn_mfma_f32_32x32x16_bf16(vt[db][2], p11a, zero16, 0, 0, 0); o1 = __builtin_amdgcn_mfma_f32_32x32x16_bf16(vt[db][3], p11b, o1, 0, 0, 0);
                    if (dir == 0) { o1 = __builtin_amdgcn_mfma_f32_32x32x16_bf16(vt[db][0], pofa, o1, 0, 0, 0); o1 = __builtin_amdgcn_mfma_f32_32x32x16_bf16(vt[db][1], pofb, o1, 0, 0, 0); }
                    else { o0 = __builtin_amdgcn_mfma_f32_32x32x16_bf16(vt[db][2], pofa, o0, 0, 0, 0); o0 = __builtin_amdgcn_mfma_f32_32x32x16_bf16(vt[db][3], pofb, o0, 0, 0, 0); }
                    oacc[db][0] = o0; oacc[db][1] = o1; }
#undef GLA_P
                lds_wait();
                bf16x8 kf[4];
#pragma unroll
                for (int s4 = 0; s4 < 4; ++s4) kf[s4] = *(const LAS bf16x8*)(KTT + (r * 72 + 16 * s4 + 8 * hh) * 2);
#pragma unroll
                for (int db = 0; db < 2; ++db) { f32x16 uu = __builtin_amdgcn_mfma_f32_32x32x16_bf16(vt[db][0], kf[0], zero16, 0, 0, 0);
#pragma unroll
                    for (int s4 = 1; s4 < 4; ++s4) uu = __builtin_amdgcn_mfma_f32_32x32x16_bf16(vt[db][s4], kf[s4], uu, 0, 0, 0);
#pragma unroll
                    for (int i = 0; i < 16; ++i) LA[(32 * db + (i & 3) + 8 * (i >> 2) + 4 * hh) * 32 + r] = uu[i]; }
            }
            __syncthreads();
            const int dv2 = tid >> 3, dk4 = (tid & 7) * 4;
            f32x4 ur[8], dr[8];
#pragma unroll
            for (int cc = 0; cc < 8; ++cc) { ur[cc] = *(const LAS f32x4*)((LAS float*)(c.lds + 8192 + cc * 13824) + dv2 * 32 + dk4); dr[cc] = *(const LAS f32x4*)(DD + cc * 32 + dk4); }
            __syncthreads();
#pragma unroll
            for (int cc = 0; cc < 8; ++cc) if (gi * 8 + cc < 36) { u32x2 sp; sp.x = pk2(Sst[0], Sst[1]); sp.y = pk2(Sst[2], Sst[3]); *(LAS u32x2*)(c.lds + 8192 + cc * 13824 + (dv2 * 40 + dk4) * 2) = sp;
                Sst[0] = fmaf(dr[cc].x, Sst[0], ur[cc].x); Sst[1] = fmaf(dr[cc].y, Sst[1], ur[cc].y); Sst[2] = fmaf(dr[cc].z, Sst[2], ur[cc].z); Sst[3] = fmaf(dr[cc].w, Sst[3], ur[cc].w); }
            __syncthreads();
            if (active) {
#pragma unroll
                for (int db = 0; db < 2; ++db) { const bf16x8 s0 = *(const LAS bf16x8*)(RW + ((32 * db + r) * 40 + 8 * hh) * 2), s1 = *(const LAS bf16x8*)(RW + ((32 * db + r) * 40 + 16 + 8 * hh) * 2);
#pragma unroll
                    for (int ib = 0; ib < 2; ++ib) { oacc[db][ib] = __builtin_amdgcn_mfma_f32_32x32x16_bf16(s0, qd[ib][0], oacc[db][ib], 0, 0, 0); oacc[db][ib] = __builtin_amdgcn_mfma_f32_32x32x16_bf16(s1, qd[ib][1], oacc[db][ib], 0, 0, 0); } }
#pragma unroll
                for (int ib = 0; ib < 2; ++ib) { bf16* orow = OG + ((size_t)dir * NTOK + row0 + 32 * ib + r) * 256 + h * 64 + 4 * hh;
#pragma unroll
                    for (int db = 0; db < 2; ++db)
#pragma unroll
                        for (int g4 = 0; g4 < 4; ++g4) { u32x2 wv; wv.x = pk2(oacc[db][ib][4 * g4], oacc[db][ib][4 * g4 + 1]); wv.y = pk2(oacc[db][ib][4 * g4 + 2], oacc[db][ib][4 * g4 + 3]); *(u32x2*)(orow + 32 * db + 8 * g4) = wv; } }
                lds_wait();
            }
        }
    }
    __syncthreads();
}
__device__ __forceinline__ void phase_gla_final(const Ctx& c, KParams p, int l, int nrows) {
    const bf16* Z = (const bf16*)(c.ws + WS_Z); const bf16* OG = (const bf16*)(c.ws + WS_T1); bf16* MIX = (bf16*)(c.ws + WS_MIX);
    const int gw = c.blk * NWAVES + c.wave, NGW = c.G * NWAVES; const f32x4 g = *(const f32x4*)(p->in[I_GLAG] + l * 256 + 4 * c.lane);
    for (int r0 = gw; r0 < nrows; r0 += 4 * NGW) {
        u32x2 of[4], ob[4], rg[4];
#pragma unroll
        for (int k = 0; k < 4; ++k) { const int r = r0 + k * NGW; of[k] = ob[k] = rg[k] = (u32x2){0u, 0u};
            if (r < nrows) { of[k] = *(const u32x2*)(OG + (size_t)r * 256 + 4 * c.lane); ob[k] = *(const u32x2*)(OG + ((size_t)NTOK + r) * 256 + 4 * c.lane); rg[k] = *(const u32x2*)(Z + (size_t)r * ZW + ZR + 4 * c.lane); } }
#pragma unroll
        for (int k = 0; k < 4; ++k) { const int r = r0 + k * NGW;
            f32x4 o = (f32x4){__uint_as_float(of[k].x << 16) + __uint_as_float(ob[k].x << 16), __uint_as_float(of[k].x & 0xffff0000u) + __uint_as_float(ob[k].x & 0xffff0000u),
                              __uint_as_float(of[k].y << 16) + __uint_as_float(ob[k].y << 16), __uint_as_float(of[k].y & 0xffff0000u) + __uint_as_float(ob[k].y & 0xffff0000u)};
            float ss = (o.x * o.x + o.y * o.y) + (o.z * o.z + o.w * o.w);
            ss += shx<1>(ss); ss += shx<2>(ss); ss += shx<4>(ss); ss += shx<8>(ss);
            const float rstd = rsqrtf(ss * (1.f / 64.f) + EPS);
            const float g0 = __uint_as_float(rg[k].x << 16), g1 = __uint_as_float(rg[k].x & 0xffff0000u), g2 = __uint_as_float(rg[k].y << 16), g3 = __uint_as_float(rg[k].y & 0xffff0000u);
            u32x2 w; w.x = pk2(o.x * rstd * g.x * siluf_(g0), o.y * rstd * g.y * siluf_(g1)); w.y = pk2(o.z * rstd * g.z * siluf_(g2), o.w * rstd * g.w * siluf_(g3));
            if (r < nrows) *(u32x2*)(MIX + (size_t)r * DM + 4 * c.lane) = w; }
    }
}

__device__ __forceinline__ void phase_conv1(const Ctx& c, KParams p, int l, bool with_ctx) {
    const bf16* Z = (const bf16*)(c.ws + WS_Z); bf16* CV = (bf16*)(c.ws + WS_CV);
    constexpr int TT = 64, HR = TT + 30;
    LAS float* glu = (LAS float*)c.lds;
    LAS float* dws = glu + HR * 256;
    for (int i = c.tid; i < 31 * 256; i += NTHR) dws[i] = p->in[I_CDW][(size_t)l * 31 * 256 + i];
    const int ntiles = with_ctx ? 1024 + 128 : 1024;
    const f32x4 dwb = *(const f32x4*)(p->in[I_CDB] + l * 256 + 4 * c.lane), lg = *(const f32x4*)(p->in[I_CLG] + l * 256 + 4 * c.lane), lb = *(const f32x4*)(p->in[I_CLB] + l * 256 + 4 * c.lane);
    for (int tile = c.blk; tile < ntiles; tile += c.G) {
        int rowbase, t0, slen;
        if (tile < 1024) { const int b = tile >> 5; rowbase = b * SEQ; t0 = (tile & 31) * TT; slen = SEQ; } else { const int q = tile - 1024, b = q >> 2; rowbase = NLAT + b * CTXL; t0 = (q & 3) * TT; slen = CTXL; }
        __syncthreads();
        u32x2 ra[12], rg[12];
#pragma unroll
        for (int k = 0; k < 12; ++k) { const int idx = c.tid + k * NTHR, j = idx >> 6, c4 = (idx & 63) * 4, t = t0 - 15 + j; ra[k] = (u32x2){0u, 0u}; rg[k] = (u32x2){0u, 0u};
            if (idx < HR * 64 && t >= 0 && t < slen) { const bf16* zr = Z + (size_t)(rowbase + t) * ZW; ra[k] = *(const u32x2*)(zr + ZCA + c4); rg[k] = *(const u32x2*)(zr + ZCG + c4); } }
#pragma unroll
        for (int k = 0; k < 12; ++k) { const int idx = c.tid + k * NTHR, j = idx >> 6, c4 = (idx & 63) * 4; f32x4 v;
            v.x = __uint_as_float(ra[k].x << 16) * sigmoidf_(__uint_as_float(rg[k].x << 16)); v.y = __uint_as_float(ra[k].x & 0xffff0000u) * sigmoidf_(__uint_as_float(rg[k].x & 0xffff0000u));
            v.z = __uint_as_float(ra[k].y << 16) * sigmoidf_(__uint_as_float(rg[k].y << 16)); v.w = __uint_as_float(ra[k].y & 0xffff0000u) * sigmoidf_(__uint_as_float(rg[k].y & 0xffff0000u));
            if (idx < HR * 64) *(LAS f32x4*)(glu + j * 256 + c4) = v; }
        __syncthreads();
        for (int q = 0; q < 8; ++q) { const int i = c.wave * 8 + q; f32x4 a = dwb;
#pragma unroll
            for (int j = 0; j < 31; ++j) a += *(const LAS f32x4*)(glu + (i + j) * 256 + 4 * c.lane) * *(const LAS f32x4*)(dws + j * 256 + 4 * c.lane);
            const float mu = wave_sum((a.x + a.y) + (a.z + a.w)) * (1.f / 256.f); const f32x4 dlt = a - mu;
            const float var = wave_sum((dlt.x * dlt.x + dlt.y * dlt.y) + (dlt.z * dlt.z + dlt.w * dlt.w)) * (1.f / 256.f); const float rstd = rsqrtf(var + EPS);
            const f32x4 y = dlt * rstd * lg + lb;
            u32x2 w; w.x = pk2(siluf_(y.x), siluf_(y.y)); w.y = pk2(siluf_(y.z), siluf_(y.w));
            *(u32x2*)(CV + (size_t)(rowbase + t0 + i) * 256 + 4 * c.lane) = w; }
    }
    __syncthreads();
}

__device__ __forceinline__ void phase_s5_carry(const Ctx& c, int l) {
    const bf16* XE = (const bf16*)(c.ws + WS_Y5); bf16* UP = (bf16*)(c.ws + WS_UP); const float* S5P = (const float*)(c.ws + WS_S5P);
    for (int i = c.blk * NTHR + c.tid; i < NB * 2 * 16 * 64; i += c.G * NTHR) {
        const int pp = i & 63, g = (i >> 6) & 15, dir = (i >> 10) & 1, b = i >> 11;
        const float* PW = S5P + ((size_t)((l * 2 + dir) * 16 + g) * 64 + pp) * 34 + 32; const float ar = PW[0], ai = PW[1];
        const size_t rbase = (size_t)g * 4608 + (size_t)b * 144; float xr = 0.f, xi = 0.f;
        for (int s0 = 0; s0 < 144; s0 += 8) {
            float er[8], ei[8];
#pragma unroll
            for (int q = 0; q < 8; ++q) { const int s = s0 + q; const int ci = dir == 0 ? s : (s < 16 ? 15 - s : 159 - s); const bf16* xe = XE + (rbase + ci) * 256 + dir * 128 + pp; er[q] = bf2f(xe[0]); ei[q] = bf2f(xe[64]); }
#pragma unroll
            for (int q = 0; q < 8; ++q) { const int s = s0 + q; const int ci = dir == 0 ? s : (s < 16 ? 15 - s : 159 - s); bf16* up = UP + (rbase + ci) * 512 + 256 + dir * 128 + pp; up[0] = f2bf(xr); up[64] = f2bf(xi);
                const float nr = ar * xr - ai * xi + er[q], ni = ar * xi + ai * xr + ei[q]; xr = nr; xi = ni; }
        }
    }
}

__device__ __forceinline__ void phase_mla_prep(const Ctx& c, KParams p) {
    const bf16* Z = (const bf16*)(c.ws + WS_Z); float* RS = (float*)(c.ws + WS_RS); bf16* Kb = (bf16*)(c.ws + WS_H) + (size_t)NTOK * 384; const float* ROPE = (const float*)(c.ws + WS_TAB + TAB_ROPE);
    const int gw = c.blk * NWAVES + c.wave, NGW = c.G * NWAVES, lane = c.lane, d = lane & 31;
    for (int r0 = gw; r0 < NTOK; r0 += 4 * NGW) {
        u32x2 q4[4]; unsigned k2[4]; bf16 xr[4]; f32x2 cs[4];
#pragma unroll
        for (int k = 0; k < 4; ++k) { const int r = r0 + k * NGW; q4[k] = (u32x2){0u, 0u}; k2[k] = 0u; xr[k] = 0; cs[k] = (f32x2){1.f, 0.f};
            if (r < NTOK) { const bf16* zr = Z + (size_t)r * ZW; q4[k] = *(const u32x2*)(zr + ZCQ + 4 * lane); k2[k] = *(const unsigned*)(zr + ZCKV + 2 * lane); xr[k] = zr[ZKR + d];
                if (r < NLAT) cs[k] = *(const f32x2*)(ROPE + (((r & 2047) * 2 + (d >> 4)) * 8 + (d & 7)) * 2); } }
#pragma unroll
        for (int k = 0; k < 4; ++k) { const int r = r0 + k * NGW;
            const float a0 = __uint_as_float(q4[k].x << 16), a1 = __uint_as_float(q4[k].x & 0xffff0000u), a2 = __uint_as_float(q4[k].y << 16), a3 = __uint_as_float(q4[k].y & 0xffff0000u);
            const float b0 = __uint_as_float(k2[k] << 16), b1 = __uint_as_float(k2[k] & 0xffff0000u);
            const float sq = wave_sum((a0 * a0 + a1 * a1) + (a2 * a2 + a3 * a3)), sk = wave_sum(b0 * b0 + b1 * b1);
            const float x = bf2f(xr[k]); const float px = shx<8>(x);
            const float o = (d & 8) ? fmaf(x, cs[k].x, px * cs[k].y) : fmaf(x, cs[k].x, -px * cs[k].y);
            if (r < NTOK) { if (lane == 0) { RS[(size_t)r * 2] = rsqrtf(sq * (1.f / 256.f) + EPS); RS[(size_t)r * 2 + 1] = rsqrtf(sk * (1.f / 128.f) + EPS); }
                const bf16 ob = f2bf(o); bf16* kr = Kb + (size_t)r * 384 + 64 + d; if (lane < 32) { kr[0] = ob; kr[96] = ob; kr[192] = ob; kr[288] = ob; } } }
    }
}
__device__ __forceinline__ void phase_attn(const Ctx& c, bool with_ctx) {
    const bf16* Qb = (const bf16*)(c.ws + WS_H); const bf16* Kb = Qb + (size_t)NTOK * 384; const bf16* VT = Kb + (size_t)NTOK * 384; bf16* MIX = (bf16*)(c.ws + WS_MIX);
    constexpr int KROW = 208, VROW = 144, KBUF = 64 * KROW, VBUF = 64 * VROW;
    LAS unsigned char* Kt = c.lds; LAS unsigned char* Vt = c.lds + 2 * KBUF;
    const int lane = c.lane, ln = lane & 31, hh = lane >> 5, tid = c.tid;
    const int nunits = with_ctx ? 1152 : 1024;
    for (int L = c.blk; L < nunits; L += c.G) {
        int u = L;
        if (c.G == 256 && L < 1024) { const int r = L >> 8, x = L & 7, j = (L & 255) >> 3; u = ((r * 32 + x * 4 + (j >> 3)) << 3) | (j & 7); }
        int b, h, qrow0, kt0, nkt;
        if (u < 1024) { b = u >> 5; h = (u >> 3) & 3; qrow0 = b * SEQ + (u & 7) * 256; kt0 = 0; nkt = 36; } else { const int q = u - 1024; b = q >> 2; h = q & 3; qrow0 = NLAT + b * CTXL; kt0 = 32; nkt = 4; }
        const bf16* vtb = VT + (size_t)((b * 4 + h) * 64) * 2304;
        bf16x8 qf[6];
        { const bf16* qr = Qb + (size_t)(qrow0 + 32 * c.wave + ln) * 384 + h * 96 + 8 * hh;
#pragma unroll
          for (int ks = 0; ks < 6; ++ks) qf[ks] = *(const bf16x8*)(qr + 16 * ks); }
        if (u < 1024) {
            const float* ROPE = (const float*)(c.ws + WS_TAB + TAB_ROPE) + (size_t)((qrow0 + 32 * c.wave + ln) & 2047) * 32;
#pragma unroll
            for (int ax = 0; ax < 2; ++ax) { const u32x4 own = __builtin_bit_cast(u32x4, qf[4 + ax]); u32x4 oth, res;
#pragma unroll
                for (int i = 0; i < 4; ++i) { const auto sw = __builtin_amdgcn_permlane32_swap(own[i], own[i], false, false); oth[i] = hh ? sw[0] : sw[1]; }
#pragma unroll
                for (int i = 0; i < 4; ++i) { const f32x4 cs = *(const f32x4*)(ROPE + ax * 16 + 4 * i);
                    const float v0 = __uint_as_float(own[i] << 16), v1 = __uint_as_float(own[i] & 0xffff0000u), p0 = __uint_as_float(oth[i] << 16), p1 = __uint_as_float(oth[i] & 0xffff0000u);
                    const float sg = hh ? 1.f : -1.f; res[i] = pk2(fmaf(v0, cs.x, sg * p0 * cs.y), fmaf(v1, cs.z, sg * p1 * cs.w)); }
                qf[4 + ax] = __builtin_bit_cast(bf16x8, res); } }
        f32x16 oacc[2];
#pragma unroll
        for (int i = 0; i < 16; ++i) { oacc[0][i] = 0.f; oacc[1][i] = 0.f; }
        float mrun = 0.f, lsum = 0.f;
        const int k0key = tid / 12, k0pt = tid % 12, k1key = (512 + tid) / 12, k1pt = (512 + tid) % 12; const bool k1on = tid < 256;
        u32x4 sk0, sk1 = (u32x4){0u, 0u, 0u, 0u}, sv;
        auto key_row = [&](int kt, int j) -> int { const int kk = kt * 64 + j; return kk < 2048 ? b * SEQ + kk : NLAT + b * CTXL + (kk - 2048); };
#define ATT_LOAD(kt) do { sk0 = *(const u32x4*)(Kb + (size_t)key_row((kt), k0key) * 384 + h * 96 + k0pt * 8); if (k1on) sk1 = *(const u32x4*)(Kb + (size_t)key_row((kt), k1key) * 384 + h * 96 + k1pt * 8); \
        sv = *(const u32x4*)(vtb + (size_t)(tid >> 3) * 2304 + (kt) * 64 + (tid & 7) * 8); } while (0)
#define ATT_STORE(buf) do { *(LAS u32x4*)(Kt + (buf) * KBUF + k0key * KROW + k0pt * 16) = sk0; if (k1on) *(LAS u32x4*)(Kt + (buf) * KBUF + k1key * KROW + k1pt * 16) = sk1; \
        *(LAS u32x4*)(Vt + (buf) * VBUF + (tid >> 3) * VROW + (tid & 7) * 16) = sv; } while (0)
        __syncthreads();
        ATT_LOAD(kt0); ATT_STORE(0);
        __syncthreads();
        for (int it = 0; it < nkt; ++it) {
            const int cur = it & 1;
            if (it + 1 < nkt) ATT_LOAD(kt0 + it + 1);
            f32x16 sacc[2];
            const float nm = -mrun;
#pragma unroll
            for (int kb = 0; kb < 2; ++kb) {
#pragma unroll
                for (int i = 0; i < 16; ++i) sacc[kb][i] = nm;
#pragma unroll
                for (int ks = 0; ks < 6; ++ks) { const bf16x8 a = *(const LAS bf16x8*)(Kt + cur * KBUF + (32 * kb + ln) * KROW + ks * 32 + hh * 16);
                    sacc[kb] = __builtin_amdgcn_mfma_f32_32x32x16_bf16(a, qf[ks], sacc[kb], 0, 0, 0); } }
            float mx = fmaxf(fmaxf(sacc[0][0], sacc[0][1]), sacc[0][2]);
#pragma unroll
            for (int i = 3; i < 15; i += 2) mx = fmaxf(fmaxf(mx, sacc[0][i]), sacc[0][i + 1]);
            mx = fmaxf(mx, sacc[0][15]);
#pragma unroll
            for (int i = 0; i < 16; i += 2) mx = fmaxf(fmaxf(mx, sacc[1][i]), sacc[1][i + 1]);
            { const auto r = __builtin_amdgcn_permlane32_swap(__float_as_uint(mx), __float_as_uint(mx), false, false); mx = fmaxf(__uint_as_float(r[0]), __uint_as_float(r[1])); }
            if (it == 0 || __builtin_amdgcn_ballot_w64(mx > 8.0f) != 0ull) {
                const float up = it == 0 ? mx : fmaxf(mx, 0.f), alpha = __builtin_amdgcn_exp2f(-up); mrun += up; lsum *= alpha;
#pragma unroll
                for (int i = 0; i < 16; ++i) { oacc[0][i] *= alpha; oacc[1][i] *= alpha; sacc[0][i] -= up; sacc[1][i] -= up; }
            }
            float ps = 0.f;
#pragma unroll
            for (int kb = 0; kb < 2; ++kb)
#pragma unroll
                for (int i = 0; i < 16; ++i) { const float pv = __builtin_amdgcn_exp2f(sacc[kb][i]); sacc[kb][i] = pv; ps += pv; }
            lsum += ps;
            bf16x8 pb[4];
#pragma unroll
            for (int s4 = 0; s4 < 4; ++s4) { const int kb = s4 >> 1, o8 = 8 * (s4 & 1); u32x4 w;
                w.x = pk2(sacc[kb][o8 + 0], sacc[kb][o8 + 1]); w.y = pk2(sacc[kb][o8 + 2], sacc[kb][o8 + 3]); w.z = pk2(sacc[kb][o8 + 4], sacc[kb][o8 + 5]); w.w = pk2(sacc[kb][o8 + 6], sacc[kb][o8 + 7]);
                pb[s4] = __builtin_bit_cast(bf16x8, w); }
#pragma unroll
            for (int db = 0; db < 2; ++db)
#pragma unroll
                for (int s4 = 0; s4 < 4; ++s4) { const bf16x8 a = *(const LAS bf16x8*)(Vt + cur * VBUF + (32 * db + ln) * VROW + s4 * 32 + hh * 16);
                    oacc[db] = __builtin_amdgcn_mfma_f32_32x32x16_bf16(a, pb[s4], oacc[db], 0, 0, 0); }
            if (it + 1 < nkt) ATT_STORE(cur ^ 1);
            __syncthreads();
        }
#undef ATT_LOAD
#undef ATT_STORE
        { const auto r = __builtin_amdgcn_permlane32_swap(__float_as_uint(lsum), __float_as_uint(lsum), false, false); lsum = __uint_as_float(r[0]) + __uint_as_float(r[1]); }
        const float inv = 1.f / lsum;
        bf16* dst = MIX + (size_t)(qrow0 + 32 * c.wave + ln) * DM + 768 + h * 64 + 4 * hh;
#pragma unroll
        for (int db = 0; db < 2; ++db)
#pragma unroll
            for (int g4 = 0; g4 < 4; ++g4) { u32x2 w; w.x = pk2(oacc[db][4 * g4] * inv, oacc[db][4 * g4 + 1] * inv); w.y = pk2(oacc[db][4 * g4 + 2] * inv, oacc[db][4 * g4 + 3] * inv);
                *(u32x2*)(dst + 32 * db + 8 * g4) = w; }
    }
    __syncthreads();
}

__device__ __forceinline__ void phase_norm2_route(const Ctx& c, KParams p, int l, int ntok) {
    const float* MOD = (const float*)(c.ws + WS_MOD) + (size_t)l * 33 * 6144;
    const float* xl = l == 0 ? p->in[I_X] : p->out; const float* xc = l == 0 ? p->in[I_CTX] : (const float*)(c.ws + WS_XC);
    bf16* H = (bf16*)(c.ws + WS_H);
    int* TKEP = (int*)(c.ws + WS_RT + RT_TKEP); float* TKW = (float*)(c.ws + WS_RT + RT_TKW); int* TB = (int*)(c.ws + WS_TB);
    int* CNT = (int*)(c.ws + WS_CTL) + CW_CNT + l * NCH * NE;
    constexpr int HROW = 1032;
    LAS bf16* hhi = (LAS bf16*)c.lds;
    LAS bf16* hlo = hhi + 32 * HROW;
    LAS float* lgs = (LAS float*)(c.lds + 132096);
    LAS int* hist = (LAS int*)(c.lds + 140288);
    const bf16* Whi = (const bf16*)(c.ws + WS_TAB + TAB_RWT) + (size_t)(l * 2) * 65536; const bf16* Wlo = Whi + 65536;
    const float rbias = p->in[I_RB][l * 64 + c.lane];
    const int ntiles = ntok / 32, rpc = ntok / NCH, lane = c.lane, mb = c.wave >> 2, nb = c.wave & 3;
    for (int tile = c.blk; tile < ntiles; tile += c.G) {
        __syncthreads();
        if (c.tid < 64) hist[c.tid] = 0;
        for (int q = 0; q < 4; ++q) { const int r = tile * 32 + c.wave * 4 + q; const float* xr = r < NLAT ? xl + (size_t)r * DM : xc + (size_t)(r - NLAT) * DM; const float* m = MOD + (size_t)mod_row(r) * 6144;
            float* xo = r < NLAT ? p->out + (size_t)r * DM : (float*)(c.ws + WS_XC) + (size_t)(r - NLAT) * DM;
            f32x4 v[4]; norm_row_add(xr, H + (size_t)r * DM, xo, p->in[I_N2G] + l * DM, m + 3072, m + 4096, H + (size_t)r * DM, lane, v);
#pragma unroll
            for (int j = 0; j < 4; ++j) { u32x2 hi; hi.x = pk2(v[j].x, v[j].y); hi.y = pk2(v[j].z, v[j].w);
                const float r0 = v[j].x - __uint_as_float(hi.x << 16), r1 = v[j].y - __uint_as_float(hi.x & 0xffff0000u), r2 = v[j].z - __uint_as_float(hi.y << 16), r3 = v[j].w - __uint_as_float(hi.y & 0xffff0000u);
                u32x2 lo; lo.x = pk2(r0, r1); lo.y = pk2(r2, r3);
                *(LAS u32x2*)(hhi + (c.wave * 4 + q) * HROW + 4 * lane + 256 * j) = hi; *(LAS u32x2*)(hlo + (c.wave * 4 + q) * HROW + 4 * lane + 256 * j) = lo; } }
        __syncthreads();
        { f32x4 acc = (f32x4){0.f, 0.f, 0.f, 0.f};
          const LAS bf16* ah = hhi + (mb * 16 + (lane & 15)) * HROW + 8 * (lane >> 4); const LAS bf16* al = hlo + (mb * 16 + (lane & 15)) * HROW + 8 * (lane >> 4);
          const bf16* bh = Whi + (size_t)(nb * 16 + (lane & 15)) * 1024 + 8 * (lane >> 4); const bf16* bl = Wlo + (size_t)(nb * 16 + (lane & 15)) * 1024 + 8 * (lane >> 4);
#pragma unroll 8
          for (int ks = 0; ks < 32; ++ks) { const bf16x8 a_h = *(const LAS bf16x8*)(ah + 32 * ks), a_l = *(const LAS bf16x8*)(al + 32 * ks), b_h = *(const bf16x8*)(bh + 32 * ks), b_l = *(const bf16x8*)(bl + 32 * ks);
              acc = __builtin_amdgcn_mfma_f32_16x16x32_bf16(a_h, b_h, acc, 0, 0, 0); acc = __builtin_amdgcn_mfma_f32_16x16x32_bf16(a_h, b_l, acc, 0, 0, 0); acc = __builtin_amdgcn_mfma_f32_16x16x32_bf16(a_l, b_h, acc, 0, 0, 0); }
#pragma unroll
          for (int i = 0; i < 4; ++i) lgs[(mb * 16 + 4 * (lane >> 4) + i) * 64 + nb * 16 + (lane & 15)] = acc[i]; }
        __syncthreads();
#pragma unroll
        for (int q = 0; q < 4; ++q) {
            const int r = tile * 32 + c.wave * 4 + q;
            const float s = sigmoidf_(lgs[(c.wave * 4 + q) * 64 + lane]), bs = s + rbias;
            float m1 = bs; m1 = fmaxf(m1, shx<1>(m1)); m1 = fmaxf(m1, shx<2>(m1)); m1 = fmaxf(m1, shx<4>(m1));
            const unsigned long long eq = __ballot(bs == m1); const unsigned gm = (unsigned)(eq >> (lane & 56)) & 0xffu; const int first = __ffs(gm) - 1;
            float m2 = ((lane & 7) == first) ? -1e30f : bs; m2 = fmaxf(m2, shx<1>(m2)); m2 = fmaxf(m2, shx<2>(m2)); m2 = fmaxf(m2, shx<4>(m2));
            const float gs = m1 + m2; const int g = lane >> 3; int rank = 0;
#pragma unroll
            for (int j = 0; j < 8; ++j) { const float o = rdl(gs, 8 * j); rank += (o > gs || (o == gs && j < g)) ? 1 : 0; }
            float cand = rank < 4 ? bs : -1e30f; int my_e = 0; float my_w = 0.f, wsum = 0.f;
#pragma unroll
            for (int k = 0; k < 8; ++k) { const float mm = wave_max(cand); const unsigned long long e2 = __ballot(cand == mm); const int idx = __ffsll((long long)e2) - 1; const float wk = rdl(s, idx);
                if (lane == idx) cand = -1e30f; if (lane == k) { my_e = idx; my_w = wk; } wsum += wk; }
            if (lane < 8) { const int lp = atomicAdd((int*)&hist[my_e], 1); TKEP[(size_t)r * 8 + lane] = my_e | (lp << 8); TKW[(size_t)r * 8 + lane] = my_w / wsum * 2.5f; }
        }
        __syncthreads();
        if (c.tid < 64) { const int n = hist[c.tid]; int base = 0; if (n > 0) base = atomicAdd(&CNT[((tile * 32) / rpc) * NE + c.tid], n); TB[tile * 64 + c.tid] = base; }
    }
    __syncthreads();
}
__device__ __forceinline__ void phase_route_fill(const Ctx& c, int l, int ntok) {
    const int* TKEP = (const int*)(c.ws + WS_RT + RT_TKEP); int* SLOT = (int*)(c.ws + WS_RT + RT_SLOT); const int* TB = (const int*)(c.ws + WS_TB);
    const int* CNT = (const int*)(c.ws + WS_CTL) + CW_CNT + l * NCH * NE; int* ROWL = (int*)(c.ws + WS_ROWL);
    LAS int* est = (LAS int*)c.lds;
    const int rpc = ntok / NCH;
    __syncthreads();
    if (c.tid < NCH) { int s = 0; for (int e = 0; e < NE; ++e) { est[c.tid * 65 + e] = s; s += (CNT[c.tid * NE + e] + 255) & ~255; } est[c.tid * 65 + 64] = s; }
    __syncthreads();
    const size_t na = (size_t)ntok * 8;
    for (size_t a = (size_t)c.blk * NTHR + c.tid; a < na; a += (size_t)c.G * NTHR) { const int t = (int)(a >> 3), ch = t / rpc; const int ep = TKEP[a], e = ep & 255, lp = ep >> 8;
        const int slot = est[ch * 65 + e] + TB[(t >> 5) * 64 + e] + lp; SLOT[a] = slot; ROWL[(size_t)ch * RPCMAX + slot] = t; }
    for (int i = c.blk * NTHR + c.tid; i < NCH * NE * 256; i += c.G * NTHR) { const int ch = i >> 14, e = (i >> 8) & 63, j = i & 255; const int n = CNT[ch * NE + e]; const int pad = ((n + 255) & ~255) - n;
        if (j < pad) ROWL[(size_t)ch * RPCMAX + est[ch * 65 + e] + n + j] = ch * rpc; }
    __syncthreads();
}

__device__ __forceinline__ void moe_tile_table(const Ctx& c, int l, int ch, LAS int* tst) {
    const int* CNT = (const int*)(c.ws + WS_CTL) + CW_CNT + l * NCH * NE + ch * NE;
    LAS unsigned char* texp = (LAS unsigned char*)(tst + 80);
    __syncthreads();
    if (c.tid == 0) { int s = 0; for (int e = 0; e < NE; ++e) { tst[e] = s; s += (CNT[e] + 255) >> 8; } tst[64] = s; }
    __syncthreads();
    if (c.tid < NE) { for (int t = tst[c.tid]; t < tst[c.tid + 1]; ++t) texp[t] = (unsigned char)c.tid; }
    __syncthreads();
}
__device__ __forceinline__ void phase_combine(const Ctx& c, KParams p, int l, int ch, int rpc) {
    const float* MOD = (const float*)(c.ws + WS_MOD) + (size_t)l * 33 * 6144 + 5120; const float* MODn = (const float*)(c.ws + WS_MOD) + (size_t)33 * 6144;
    const int* SLOT = (const int*)(c.ws + WS_RT + RT_SLOT); const float* TKW = (const float*)(c.ws + WS_RT + RT_TKW);
    const unsigned char* OB = (const unsigned char*)(c.ws + WS_OB); const bf16* OBS = (const bf16*)(c.ws + WS_OBS);
    float* xl = p->out; float* xc = (float*)(c.ws + WS_XC); bf16* H = (bf16*)(c.ws + WS_H);
    const int gw = c.blk * NWAVES + c.wave, NGW = c.G * NWAVES, lane = c.lane;
    const int col0 = (lane >> 4) * 256 + ((lane >> 2) & 3) * 32 + (lane & 3) * 8;
    f32x4 gn[4];
#pragma unroll
    for (int q = 0; q < 4; ++q) gn[q] = *(const f32x4*)((l == 0 ? p->in[I_N1G] + DM : p->in[I_FG]) + col0 + 128 * (q >> 1) + 4 * (q & 1));
    int sl_n = 0; float w_n = 0.f;
    if (gw < rpc && lane < 8) { sl_n = SLOT[(size_t)(ch * rpc + gw) * 8 + lane]; w_n = TKW[(size_t)(ch * rpc + gw) * 8 + lane] * 0.0625f; }
    for (int i = gw; i < rpc; i += NGW) {
        const int t = ch * rpc + i; float* xr = t < NLAT ? xl + (size_t)t * DM : xc + (size_t)(t - NLAT) * DM; const int mr = mod_row(t); const float* g2 = MOD + (size_t)mr * 6144;
        const int sl = sl_n; const float w = w_n;
        u32x4 ob[8], os0, os1; f32x4 xv[4];
#pragma unroll
        for (int e = 0; e < 8; ++e) ob[e] = *(const u32x4*)(OB + (size_t)rdli(sl, e) * 1024 + lane * 16);
        os0 = *(const u32x4*)(OBS + (size_t)i * DM + col0); os1 = *(const u32x4*)(OBS + (size_t)i * DM + col0 + 128);
#pragma unroll
        for (int q = 0; q < 4; ++q) xv[q] = *(const f32x4*)(xr + col0 + 128 * (q >> 1) + 4 * (q & 1));
        if (i + NGW < rpc && lane < 8) { sl_n = SLOT[(size_t)(t + NGW) * 8 + lane]; w_n = TKW[(size_t)(t + NGW) * 8 + lane] * 0.0625f; }
        float a[16]; { float t8[8]; unpack8(os0, t8);
#pragma unroll
            for (int q = 0; q < 8; ++q) a[q] = t8[q];
            unpack8(os1, t8);
#pragma unroll
            for (int q = 0; q < 8; ++q) a[8 + q] = t8[q]; }
#pragma unroll
        for (int e = 0; e < 8; ++e) { const float wk = rdl(w, e);
#pragma unroll
            for (int q = 0; q < 4; ++q) { const f32x2 lo = __builtin_amdgcn_cvt_pk_f32_fp8((int)ob[e][q], false), hi = __builtin_amdgcn_cvt_pk_f32_fp8((int)ob[e][q], true);
                a[4 * q] = fmaf(wk, lo.x, a[4 * q]); a[4 * q + 1] = fmaf(wk, lo.y, a[4 * q + 1]); a[4 * q + 2] = fmaf(wk, hi.x, a[4 * q + 2]); a[4 * q + 3] = fmaf(wk, hi.y, a[4 * q + 3]); } }
        f32x4 xn[4]; float ss = 0.f;
#pragma unroll
        for (int q = 0; q < 4; ++q) { const int cc = col0 + 128 * (q >> 1) + 4 * (q & 1); const f32x4 gv = *(const f32x4*)(g2 + cc);
            xn[q] = xv[q] + gv * (f32x4){a[4 * q], a[4 * q + 1], a[4 * q + 2], a[4 * q + 3]}; ss += (xn[q].x * xn[q].x + xn[q].y * xn[q].y) + (xn[q].z * xn[q].z + xn[q].w * xn[q].w); }
        const float rstd = rsqrtf(wave_sum(ss) * (1.f / 1024.f) + EPS);
        if (l == 0) { const float* mn = MODn + (size_t)mr * 6144; bf16* hr = H + (size_t)t * DM;
#pragma unroll
            for (int q = 0; q < 4; ++q) { const int cc = col0 + 128 * (q >> 1) + 4 * (q & 1); *(f32x4*)(xr + cc) = xn[q];
                const f32x4 s0 = *(const f32x4*)(mn + cc), s1 = *(const f32x4*)(mn + 1024 + cc); const f32x4 hv = xn[q] * rstd * gn[q] * (s1 + 1.0f) + s0;
                u32x2 o; o.x = pk2(hv.x, hv.y); o.y = pk2(hv.z, hv.w); *(u32x2*)(hr + cc) = o; } }
        else {
#pragma unroll
            for (int q = 0; q < 4; ++q) { const int cc = col0 + 128 * (q >> 1) + 4 * (q & 1); *(f32x4*)(xr + cc) = xn[q] * rstd * gn[q]; } }
    }
}
constexpr int LDS_BYTES = 147456;
constexpr int LDS_TAB = 131072, LDS_XB = LDS_BYTES - 16;
enum { J_INPROJ = 0, J_S5G1, J_PW, J_Q, J_KV, J_S5G2, J_GLU, J_OUT, J_GU, J_GUS, J_DN, J_DNS };
enum { SK_DENSE = 0, SK_S5, SK_MOE };
enum { EK_INPROJ = 0, EK_S5X, EK_S5Y, EK_BIAS, EK_GLU, EK_Q, EK_KV, EK_RESID, EK_SWIGLU, EK_OB8, EK_BF16 };
struct JSched {
    int sk, G, c; pg8::DenseOrder d; const char* W; size_t wexp, wtile; const LAS unsigned char* texp; int ntile, npn;
    __device__ __forceinline__ bool next(int i, pg8::Unit& u) const {
        if (sk == SK_DENSE) return d.next(i, u);
        const int L = i * G + c;
        if (sk == SK_S5) { if (L >= 288) return false; u.pm = L; u.pn = 0; u.e = L / 18; u.B = W + (size_t)u.e * wexp; return true; }
        if (L >= ntile * npn) return false;
        const int T = npn == 2 ? (L >> 1) : (L >> 2), pn = L & (npn - 1); const int e = __builtin_amdgcn_readfirstlane((int)texp[T]);
        u.pm = T; u.pn = pn; u.e = e; u.B = W + (size_t)e * wexp + (size_t)pn * wtile; return true;
    }
};
struct JRows { const int* list; unsigned ldab;
    __device__ __forceinline__ unsigned off(const pg8::Unit& u, int r) const { const int row = u.pm * 256 + r; return (unsigned)(list ? list[row] : row) * ldab; } };
struct JEpi {
    int ek; void* p0; void* p1; void* p2; const void* q0; const void* q1; const void* q2; int i0;
    __device__ __forceinline__ void operator()(EPI_ARGS) const {
        switch (ek) {
        case EK_INPROJ: EpiInProj{(bf16*)p0, (bf16*)p1, (bf16*)p2}(acc, u, wr, wc, fr, fq); break;
        case EK_S5X:    EpiS5X{(bf16*)p0}(acc, u, wr, wc, fr, fq); break;
        case EK_S5Y:    EpiS5Y{(bf16*)p0}(acc, u, wr, wc, fr, fq); break;
        case EK_BIAS:   EpiBiasBf16{(bf16*)p0, i0, (const float*)q0}(acc, u, wr, wc, fr, fq); break;
        case EK_GLU:    EpiGluSig{(bf16*)p0, i0, (const float*)q0}(acc, u, wr, wc, fr, fq); break;
        case EK_Q:      EpiQ{(bf16*)p0, (const float*)q0}(acc, u, wr, wc, fr, fq); break;
        case EK_KV:     EpiKV{(bf16*)p0, (bf16*)p1, (const float*)q0}(acc, u, wr, wc, fr, fq); break;
        case EK_RESID:  EpiDelta{(bf16*)p0, (const float*)q0}(acc, u, wr, wc, fr, fq); break;
        case EK_SWIGLU: EpiSwiglu{(bf16*)p0, i0}(acc, u, wr, wc, fr, fq); break;
        case EK_OB8:    EpiOB8{(unsigned char*)p0}(acc, u, wr, wc, fr, fq); break;
        default:        EpiBf16{(bf16*)p0, i0}(acc, u, wr, wc, fr, fq); break;
        }
    }
};
__device__ __forceinline__ void gemm_job(KParams p, LAS unsigned char* lds, int job, int l, int ch) {
    unsigned char* ws = p->ws;
    const int G = gridDim.x, blk = blockIdx.x;
    const bool last = (l == 1); const int nrows = last ? NLAT : NTOK, rpc = nrows / NCH;
    unsigned char* sm = ws + WS_WSM + (size_t)l * WSM_L;
    const LAS int* tst = (const LAS int*)(lds + LDS_TAB);
    const char* A = nullptr; int K = 256; JSched S; JRows R; JEpi E;
    S.sk = SK_DENSE; S.G = G; S.c = blk; S.W = nullptr; S.wexp = 0; S.wtile = 0; S.texp = (const LAS unsigned char*)(tst + 80); S.ntile = 0; S.npn = 2; S.d.init(1, 1, G, blk, nullptr, 256);
    R.list = nullptr; R.ldab = 512u; E.ek = EK_BF16; E.p0 = E.p1 = E.p2 = nullptr; E.q0 = E.q1 = E.q2 = nullptr; E.i0 = 0;
    switch (job) {
    case J_INPROJ: A = (const char*)(ws + WS_H); K = 1024; R.ldab = 2048u; S.d.init(NTOK / 256, ZW / 256, G, blk, (const bf16*)(ws + WS_WIN) + (size_t)l * 2048 * 1024, 1024);
        E.ek = EK_INPROJ; E.p0 = ws + WS_Z; E.p1 = ws + WS_UP; E.p2 = ws + WS_GVT; break;
    case J_S5G1: A = (const char*)(ws + WS_UP); K = 256; R.ldab = 1024u; S.sk = SK_S5; S.W = (const char*)(ws + WS_S5W) + (size_t)l * 16 * 256 * 256 * 2; S.wexp = (size_t)256 * 256 * 2; E.ek = EK_S5X; E.p0 = ws + WS_Y5; break;
    case J_PW: A = (const char*)(ws + WS_CV); K = 256; R.ldab = 512u; S.d.init(nrows / 256, 1, G, blk, (const bf16*)(sm + WSM_PW), 256); E.ek = EK_BIAS; E.p0 = (bf16*)(ws + WS_MIX) + 256; E.i0 = DM; E.q0 = p->in[I_CPB] + l * 256; break;
    case J_Q: A = (const char*)(ws + WS_Z) + ZCQ * 2; K = 256; R.ldab = (unsigned)ZW * 2u; S.d.init(NTOK / 256, 2, G, blk, (const bf16*)(sm + WSM_UQ), 256);
        E.ek = EK_Q; E.p0 = ws + WS_H; E.q0 = ws + WS_RS; break;
    case J_KV: A = (const char*)(ws + WS_Z) + ZCKV * 2; K = 256; R.ldab = (unsigned)ZW * 2u; S.d.init(NTOK / 256, 2, G, blk, (const bf16*)(sm + WSM_UK), 256);
        E.ek = EK_KV; E.p0 = (bf16*)(ws + WS_H) + (size_t)NTOK * 384; E.p1 = (bf16*)(ws + WS_H) + (size_t)NTOK * 768; E.q0 = ws + WS_RS; break;
    case J_S5G2: A = (const char*)(ws + WS_UP); K = 512; R.ldab = 1024u; S.sk = SK_S5; S.W = (const char*)(ws + WS_S5W) + (size_t)32 * 256 * 256 * 2 + (size_t)l * 16 * 256 * 512 * 2; S.wexp = (size_t)256 * 512 * 2; E.ek = EK_S5Y; E.p0 = ws + WS_Y5; break;
    case J_GLU: A = (const char*)(ws + WS_Y5); K = 256; R.ldab = 512u; S.d.init(nrows / 256, 2, G, blk, (const bf16*)(sm + WSM_GLU), 256); E.ek = EK_GLU; E.p0 = (bf16*)(ws + WS_MIX) + 512; E.i0 = DM; E.q0 = p->in[I_S5GB] + l * 512; break;
    case J_OUT: A = (const char*)(ws + WS_MIX); K = 1024; R.ldab = 2048u; S.d.init(nrows / 256, 4, G, blk, (const bf16*)(ws + WS_WOUT) + (size_t)l * 1024 * 1024, 1024);
        E.ek = EK_RESID; E.p0 = ws + WS_H; E.q0 = (const float*)(ws + WS_MOD) + (size_t)l * 33 * 6144 + 2048; break;
    case J_GU: A = (const char*)(ws + WS_H); K = 1024; R.list = (const int*)(ws + WS_ROWL) + (size_t)ch * RPCMAX; R.ldab = 2048u; S.sk = SK_MOE; S.ntile = __builtin_amdgcn_readfirstlane(tst[64]); S.npn = 2; S.W = (const char*)(ws + WS_WMOE); S.wexp = (size_t)512 * 1024 * 2; S.wtile = (size_t)256 * 1024 * 2;
        E.ek = EK_SWIGLU; E.p0 = ws + WS_HB; E.i0 = 256; break;
    case J_GUS: A = (const char*)(ws + WS_H) + (size_t)ch * rpc * 2048; K = 1024; R.ldab = 2048u; S.d.init(rpc / 256, 2, G, blk, (const bf16*)(ws + WS_WSH) + (size_t)l * (512 * 1024 + 1024 * 256), 1024); E.ek = EK_SWIGLU; E.p0 = ws + WS_HBS; E.i0 = 256; break;
    case J_DN: A = (const char*)(ws + WS_HB); K = 256; R.ldab = 512u; S.sk = SK_MOE; S.ntile = __builtin_amdgcn_readfirstlane(tst[64]); S.npn = 4; S.W = (const char*)(ws + WS_WMOE) + (size_t)NE * 512 * 1024 * 2; S.wexp = (size_t)1024 * 256 * 2; S.wtile = (size_t)256 * 256 * 2;
        E.ek = EK_OB8; E.p0 = ws + WS_OB; break;
    default: A = (const char*)(ws + WS_HBS); K = 256; R.ldab = 512u; S.d.init(rpc / 256, 4, G, blk, (const bf16*)(ws + WS_WSH) + (size_t)l * (512 * 1024 + 1024 * 256) + 512 * 1024, 256); E.ek = EK_BF16; E.p0 = ws + WS_OBS; E.i0 = DM; break;
    }
    __builtin_amdgcn_s_waitcnt(0x0F70);
    pg8::gemm_phase(lds, A, K, S, R, E);
}


__global__ void __launch_bounds__(NTHR, 2) fwd_kernel(Params pk) {
    extern __shared__ __attribute__((aligned(16))) unsigned char lds_raw[];
    LAS unsigned char* const lds0 = (LAS unsigned char*)lds_raw;
    if (threadIdx.x < 4) ((LAS unsigned*)(lds0 + LDS_XB))[threadIdx.x] = 0u;
    __syncthreads();
    (void)xcd_barrier_post((unsigned*)(pk.ws + WS_CTL) + CW_BAR, (volatile LAS unsigned*)(lds0 + LDS_XB));
    constexpr int NSTEP = 15 + 6 * NCH;
#ifndef PROBE_DUP
#define PROBE_DUP (-9)
#endif
#pragma unroll 1
    for (int it_ = -2; it_ < 2 * NSTEP + (PROBE_DUP >= 0 ? 2 : 0); ++it_) {
        int gs = it_; if (PROBE_DUP >= 0) { if (it_ > PROBE_DUP) gs -= 1; if (it_ > NSTEP + PROBE_DUP + 1) gs -= 1; }
        KParams p = fresh_params(); Ctx c; { int t_ = threadIdx.x; asm volatile("" : "+v"(t_)); c.lds = lds0; c.tid = t_; c.lane = t_ & 63; c.wave = __builtin_amdgcn_readfirstlane(t_ >> 6); c.blk = blockIdx.x; c.G = gridDim.x; c.ws = p->ws; }
        LAS int* tst = (LAS int*)(c.lds + LDS_TAB);
        int l = 0, s = gs, ch = 0, job = -1; bool seam = true;
        if (gs >= 0) { l = gs >= NSTEP ? 1 : 0; s = gs - l * NSTEP; if (s >= 15) { ch = (s - 15) / 6; s = 15 + (s - 15) % 6; } }
        const bool last = (l == 1); const int nrows = last ? NLAT : NTOK, rpc = nrows / NCH;
        switch (s) {
        case -2: prologue(c, p); break;
        case -1: prologue2(c, p); break;
        case 0: if (last) prologue_moe_weights(c, p, 1); else phase_norm1(c, p, l); break;
        case 1: job = J_INPROJ; break;
        case 2: phase_gla(c, p, l); phase_conv1(c, p, l, !last); phase_mla_prep(c, p); seam = false; break;
        case 3: job = J_S5G1; break;
        case 4: phase_gla_final(c, p, l, nrows); seam = false; break;
        case 5: job = J_PW; seam = false; break;
        case 6: job = J_Q; seam = false; break;
        case 7: job = J_KV; seam = false; break;
        case 8: phase_s5_carry(c, l); break;
        case 9: phase_attn(c, !last); seam = false; break;
        case 10: job = J_S5G2; break;
        case 11: job = J_GLU; break;
        case 12: job = J_OUT; break;
        case 13: phase_norm2_route(c, p, l, nrows); break;
        case 14: phase_route_fill(c, l, nrows); break;
        case 15: moe_tile_table(c, l, ch, tst); job = J_GU; seam = false; break;
        case 16: job = J_GUS; break;
        case 17: job = J_DN; seam = false; break;
        case 18: job = J_DNS; break;
        case 19: phase_combine(c, p, l, ch, rpc); break;
        default: seam = false; break;
        }
        if (job >= 0) gemm_job(p, c.lds, job, l, ch);
        if (seam && gs + 1 < 2 * NSTEP) { XcdBarrier b_; b_.bar = (unsigned*)(p->ws + WS_CTL) + CW_BAR; b_.x = xb_xcc_id(); b_.st = (volatile LAS unsigned*)(lds0 + LDS_XB); xcd_barrier(b_); }
    }
}

extern "C" void kernel_launch(void* const* d_in, const int* in_sizes, int n_in, void* d_out, int out_size, void* d_ws, size_t ws_size, hipStream_t stream) {
    static int grid = 0;
    if (grid == 0) {
        if (n_in != 42 || out_size != NLAT * DM || ws_size < WS_END) { fprintf(stderr, "kernel_launch: unexpected shapes (n_in %d out %d ws %zu)\n", n_in, out_size, ws_size); grid = -1; return; }
        int dev = 0, cus = 0;
        if (hipGetDevice(&dev) != hipSuccess || hipDeviceGetAttribute(&cus, hipDeviceAttributeMultiprocessorCount, dev) != hipSuccess) { grid = -1; return; }
        if (hipFuncSetAttribute((const void*)fwd_kernel, hipFuncAttributeMaxDynamicSharedMemorySize, LDS_BYTES) != hipSuccess) { fprintf(stderr, "kernel_launch: hipFuncSetAttribute failed\n"); grid = -1; return; }
        int per_cu = 0;
        if (hipOccupancyMaxActiveBlocksPerMultiprocessor(&per_cu, (const void*)fwd_kernel, NTHR, LDS_BYTES) != hipSuccess || per_cu < 1) fprintf(stderr, "kernel_launch: occupancy query reports %d\n", per_cu);
        (void)hipGetLastError();
        grid = cus;
    }
    if (grid < 0) return;
    (void)hipMemsetAsync((char*)d_ws + WS_CTL, 0, CTL_BYTES, stream);
    Params p{};
    for (int i = 0; i < 42; ++i) p.in[i] = (const float*)d_in[i];
    p.out = (float*)d_out; p.ws = (unsigned char*)d_ws; p.ph_lo = 0; p.ph_hi = 1 << 20;
    hipLaunchKernelGGL(fwd_kernel, dim3(grid), dim3(NTHR), LDS_BYTES, stream, p);
}
```

```cpp
#include <hip/hip_runtime.h>
#include <cstdio>
#include <cstdint>

#define LAS __attribute__((address_space(3)))
typedef unsigned short bf16;
typedef short bf16x8 __attribute__((ext_vector_type(8)));
typedef float f32x4 __attribute__((ext_vector_type(4)));
typedef float f32x2 __attribute__((ext_vector_type(2)));
typedef float f32x16 __attribute__((ext_vector_type(16)));
typedef unsigned u32x4 __attribute__((ext_vector_type(4)));
typedef unsigned u32x2 __attribute__((ext_vector_type(2)));
typedef int i32x4 __attribute__((ext_vector_type(4)));
typedef int i32x8 __attribute__((ext_vector_type(8)));

constexpr int NB = 32, SEQ = 2048, CTXL = 256, DM = 1024;
constexpr int NLAT = NB * SEQ, NCTX = NB * CTXL, NTOK = NLAT + NCTX;
constexpr int ZW = 2048;
constexpr int ZQ = 0, ZK = 128, ZV = 256, ZR = 512, ZCA = 768, ZCG = 1024, ZS5 = 1280, ZCQ = 1536, ZCKV = 1792, ZKR = 1920, ZAF = 1952, ZAB = 1968;
constexpr int NE = 64, TOPK = 8;
constexpr int NCH = 2;
constexpr int RPCMAX = (NTOK / NCH) * 8 + 64 * 256;
constexpr float EPS = 1e-6f;
constexpr int NWAVES = 8, NTHR = 512;

constexpr size_t MiB = (size_t)1 << 20;
constexpr size_t WS_CTL = 0, CTL_BYTES = 1 * MiB;
constexpr size_t WS_MOD = 1 * MiB;
constexpr size_t WS_TAB = 3 * MiB;
constexpr size_t WS_WSM = 5 * MiB;
constexpr size_t WS_WIN = 8 * MiB;
constexpr size_t WS_WOUT = 16 * MiB;
constexpr size_t WS_WSH = 20 * MiB;
constexpr size_t WS_TB = 23 * MiB;
constexpr size_t WS_RT = 24 * MiB;
constexpr size_t WS_ROWL = 32 * MiB;
constexpr size_t WS_RS = 35 * MiB;
constexpr size_t WS_WMOE = 36 * MiB;
constexpr size_t WS_XC = 132 * MiB;
constexpr size_t WS_H = 164 * MiB;
constexpr size_t WS_H8 = WS_H + 72 * MiB;
constexpr size_t WS_Z = 308 * MiB;
constexpr size_t WS_MIX = 596 * MiB;
constexpr size_t WS_T1 = 740 * MiB;
constexpr size_t WS_UP = 812 * MiB;
constexpr size_t WS_CV = 884 * MiB;
constexpr size_t WS_Y5 = 920 * MiB;
constexpr size_t WS_S5W = 956 * MiB;
constexpr size_t WS_S5P = 968 * MiB;
constexpr size_t WS_GVT = 969 * MiB;
constexpr size_t WS_END = 1005 * MiB;
constexpr size_t WS_HB = WS_Z;
constexpr size_t WS_HBS = WS_Z + 152 * MiB;
constexpr size_t WS_OBS = WS_Z + 170 * MiB;
constexpr size_t WS_OB = WS_MIX;
static_assert((size_t)RPCMAX * 512 <= 152 * MiB && WS_OBS + (size_t)(NTOK / NCH) * 2048 <= WS_MIX && WS_OB + (size_t)RPCMAX * 1024 <= WS_S5W, "MoE overlays");
constexpr int CW_BAR = 0;
constexpr int CW_CNT = 4096;
constexpr size_t WSM_L = 1 * MiB;
constexpr size_t WSM_PW = 0, WSM_GLU = 128 * 1024, WSM_UQ = 384 * 1024, WSM_UK = 640 * 1024, WSM_UV = 768 * 1024;
constexpr size_t TAB_ROPE = 0;
constexpr size_t TAB_S5 = 256 * 1024;
constexpr size_t TAB_RWT = 1536 * 1024;
constexpr size_t RT_TKEP = 0, RT_TKW = 2400000, RT_SLOT = 4800000;

__device__ __forceinline__ float bf2f(bf16 v) { return __uint_as_float(((unsigned)v) << 16); }
typedef __bf16 bf16x2_t __attribute__((ext_vector_type(2)));
__device__ __forceinline__ unsigned pk2(float lo, float hi) { const f32x2 v = {lo, hi}; return __builtin_bit_cast(unsigned, __builtin_convertvector(v, bf16x2_t)); }
__device__ __forceinline__ bf16 f2bf(float f) { return __builtin_bit_cast(unsigned short, (__bf16)f); }
template <int O> __device__ __forceinline__ float shx(float v) {
    return __int_as_float(__builtin_amdgcn_ds_swizzle(__float_as_int(v), (O << 10) | 0x1f)); }
__device__ __forceinline__ float rdl(float v, int l) { return __int_as_float(__builtin_amdgcn_readlane(__float_as_int(v), l)); }
__device__ __forceinline__ int rdli(int v, int l) { return __builtin_amdgcn_readlane(v, l); }
__device__ __forceinline__ float wave_sum(float v) {
    v += shx<1>(v); v += shx<2>(v); v += shx<4>(v); v += shx<8>(v); v += shx<16>(v);
    const auto r = __builtin_amdgcn_permlane32_swap(__float_as_uint(v), __float_as_uint(v), false, false);
    return __uint_as_float(r[0]) + __uint_as_float(r[1]);
}
__device__ __forceinline__ float wave_max(float v) {
    v = fmaxf(v, shx<1>(v)); v = fmaxf(v, shx<2>(v)); v = fmaxf(v, shx<4>(v)); v = fmaxf(v, shx<8>(v)); v = fmaxf(v, shx<16>(v));
    const auto r = __builtin_amdgcn_permlane32_swap(__float_as_uint(v), __float_as_uint(v), false, false);
    return fmaxf(__uint_as_float(r[0]), __uint_as_float(r[1]));
}
__device__ __forceinline__ float sigmoidf_(float x) { return 1.0f / (1.0f + __expf(-x)); }
__device__ __forceinline__ float siluf_(float x) { return x / (1.0f + __expf(-x)); }
__device__ __forceinline__ void unpack8(const u32x4 w, float (&v)[8]) {
    v[0] = __uint_as_float(w.x << 16); v[1] = __uint_as_float(w.x & 0xffff0000u);
    v[2] = __uint_as_float(w.y << 16); v[3] = __uint_as_float(w.y & 0xffff0000u);
    v[4] = __uint_as_float(w.z << 16); v[5] = __uint_as_float(w.z & 0xffff0000u);
    v[6] = __uint_as_float(w.w << 16); v[7] = __uint_as_float(w.w & 0xffff0000u);
}
__device__ __forceinline__ void lds_wait() { asm volatile("s_waitcnt lgkmcnt(0)" ::: "memory"); }

#define XB_TMO      128
#define XB_XCNT(j)  (256  + 64 * (j))
#define XB_XSUB(j)  (1280 + 64 * (j))
#define XB_XGEN(j)  (2304 + 64 * (j))
#define XB_TOP      3328
#define XB_TOPGEN   3392
#define XCD_BAR_WORDS 3456
#define XB_SPIN_CAP (1u << 22)
__device__ __forceinline__ unsigned xb_ld(unsigned* p)              { return __hip_atomic_load(p, __ATOMIC_RELAXED, __HIP_MEMORY_SCOPE_AGENT); }
__device__ __forceinline__ unsigned xb_add(unsigned* p, unsigned v) { return __hip_atomic_fetch_add(p, v, __ATOMIC_RELAXED, __HIP_MEMORY_SCOPE_AGENT); }
__device__ __forceinline__ unsigned xb_xcc_id() { return (unsigned)__builtin_amdgcn_s_getreg((3 << 11) | 20) & 0xFu; }
#define XB_SPIN(cond, bar) do { unsigned _sp = 0; while (cond) { __builtin_amdgcn_s_sleep(1); \
    if ((++_sp & 255u) == 0u) { if (xb_ld(&(bar)[XB_TMO])) break; if (_sp > XB_SPIN_CAP) { atomicAdd(&(bar)[XB_TMO], 1u); break; } } } } while (0)
struct XcdBarrier { unsigned* bar; unsigned x; volatile LAS unsigned* st; };
__device__ __forceinline__ XcdBarrier xcd_barrier_post(unsigned* bar, volatile LAS unsigned* st) {
    XcdBarrier b; b.bar = bar; b.x = xb_xcc_id(); b.st = st;
    if (threadIdx.x == 0) (void)xb_add(&bar[XB_XCNT(b.x)], 1u);
    return b;
}
__device__ __forceinline__ void xcd_barrier_complete(unsigned* bar, unsigned x, unsigned& nloc, unsigned& nx) {
    const unsigned G = gridDim.x * gridDim.y * gridDim.z;
    unsigned sum, cnt, mine, sp = 0u;
    for (;;) {
        sum = 0u; cnt = 0u; mine = 0u;
#pragma unroll
        for (unsigned j = 0; j < 16; ++j) { const unsigned c = xb_ld(&bar[XB_XCNT(j)]); sum += c; cnt += (c > 0u) ? 1u : 0u; mine = (j == x) ? c : mine; }
        if (sum == G) break;
        __builtin_amdgcn_s_sleep(1);
        if ((++sp & 255u) == 0u) { if (xb_ld(&bar[XB_TMO])) break; if (sp > XB_SPIN_CAP) { atomicAdd(&bar[XB_TMO], 1u); break; } }
    }
    nloc = mine > 0u ? mine : 1u; nx = cnt > 0u ? cnt : 1u;
}
__device__ __forceinline__ void xcd_barrier(const XcdBarrier& b) {
    asm volatile("s_waitcnt vmcnt(0)" ::: "memory");
    __syncthreads();
    if (threadIdx.x == 0) {
        unsigned* bar = b.bar;
        __builtin_amdgcn_s_waitcnt(0);
        unsigned nloc = b.st[0], nx = b.st[1];
        if (nloc == 0u) { xcd_barrier_complete(bar, b.x, nloc, nx); b.st[0] = nloc; b.st[1] = nx; }
        const unsigned old = xb_add(&bar[XB_XSUB(b.x)], 1u);
        const unsigned gen = old / nloc;
        if (old + 1u == (gen + 1u) * nloc) {
            __builtin_amdgcn_fence(__ATOMIC_RELEASE, "agent");
            asm volatile("s_waitcnt vmcnt(0)" ::: "memory");
            const unsigned og = xb_add(&bar[XB_TOP], 1u);
            const unsigned tg = og / nx;
            if (og + 1u == (tg + 1u) * nx) xb_add(&bar[XB_TOPGEN], 1u);
            else XB_SPIN(xb_ld(&bar[XB_TOPGEN]) == tg, bar);
            __builtin_amdgcn_fence(__ATOMIC_ACQUIRE, "agent");
            xb_add(&bar[XB_XGEN(b.x)], 1u);
            asm volatile("s_waitcnt vmcnt(0)" ::: "memory");
        } else {
            XB_SPIN(xb_ld(&bar[XB_XGEN(b.x)]) == gen, bar);
            __builtin_amdgcn_fence(__ATOMIC_ACQUIRE, "agent");
            asm volatile("s_waitcnt vmcnt(0)" ::: "memory");
        }
    }
    __syncthreads();
}

namespace pg8 {
constexpr int BM = 256, BK = 64, HALF = 128, HTB = HALF * BK * 2, STAGE_BYTES = 8 * HTB, NXCD = 8, WGM = 8;
__device__ __forceinline__ int lds_byte(int r, int c) { const int st = (r >> 4) * 2 + (c >> 5), rr = r & 15, cc = c & 31, ob = rr * 64 + cc * 2; return st * 1024 + (ob ^ (((ob >> 9) & 1) << 5)); }
__device__ __forceinline__ void stage_rc(int b, int& R, int& C) { const int st = b / 1024, sb = b % 1024, swz = sb ^ (((sb >> 9) & 1) << 5); R = (st >> 1) * 16 + swz / 64; C = (st & 1) * 32 + (swz % 64) / 2; }
__device__ __forceinline__ int perm32(int rho) { const int n = rho >> 4, i = rho & 15; return 8 * (i >> 2) + 4 * n + (i & 3); }

struct Unit { int pm, pn, e; const char* B; };

struct DenseOrder {
    int nM, nN, nwg, G, c; const char* Bt; size_t btile;
    __device__ __forceinline__ void init(int nM_, int nN_, int G_, int c_, const bf16* Bt_, int K) { nM = nM_; nN = nN_; nwg = nM * nN; G = G_; c = c_; Bt = (const char*)Bt_; btile = (size_t)256 * K * 2; }
    __device__ __forceinline__ bool next(int i, Unit& u) const {
        const long L = (long)i * G + c; if (L >= nwg) return false;
        int wgid = (int)L; { const int q = nwg / NXCD, r = nwg % NXCD, xcd = wgid % NXCD, off = wgid / NXCD; wgid = (xcd < r ? xcd * (q + 1) : r * (q + 1) + (xcd - r) * q) + off; }
        const int nig = WGM * nN, gid = wgid / nig, fm = gid * WGM, gsz = (nM - fm) < WGM ? (nM - fm) : WGM;
        u.pm = fm + ((wgid % nig) % gsz); u.pn = (wgid % nig) / gsz; u.e = 0; u.B = Bt + (size_t)u.pn * btile; return true;
    }
};
struct RowsDense { unsigned ldab; __device__ __forceinline__ unsigned off(const Unit& u, int r) const { return (unsigned)(u.pm * 256 + r) * ldab; } };
struct RowsGather { const int* list; unsigned ldab; __device__ __forceinline__ unsigned off(const Unit& u, int r) const { return (unsigned)list[u.pm * 256 + r] * ldab; } };

template <bool FP8, class Epi, class Sched, class Rows>
__device__ __forceinline__ void gemm_phase(LAS unsigned char* lds, const char* Abase, const int K, const Sched& S, const Rows& RW, const Epi& E) {
    int tid_ = threadIdx.x; asm volatile("" : "+v"(tid_));
    const int tid = tid_, wid = __builtin_amdgcn_readfirstlane(tid >> 6), lane = tid & 63, wr = wid >> 2, wc = wid & 3, fr = lane & 15, fq = lane >> 4;
    const int nt = K / BK;
    int sR[2]; unsigned sC[2], voffB[2];
#pragma unroll
    for (int i = 0; i < 2; ++i) { int R, C; stage_rc(tid * 16 + i * 8192, R, C); sR[i] = R; sC[i] = (unsigned)C * 2u; const int Rb = (R & ~31) + perm32(R & 31); voffB[i] = (unsigned)(Rb * K + C) * 2u; }
    const size_t kstep = (size_t)(BK * 2);
    const size_t hstepB = (size_t)HALF * K * 2;
    const unsigned ldsw = (unsigned)wid * 1024u;
    const int aoff = lds_byte(wr * 64 + fr, fq * 8), boff = lds_byte(wc * 32 + fr, fq * 8);
#define PG8_SA(b, h) (((b) * 2 + (h)) * HTB)
#define PG8_SB(b, h) ((4 + (b) * 2 + (h)) * HTB)
#define PG8_STAGE(bufoff, gbase, voff) do { const char* _gb = (const char*)(gbase); asm volatile("" : "+s"(_gb)); _Pragma("unroll") for (int _i = 0; _i < 2; ++_i) { unsigned _o = (voff)[_i]; asm volatile("" : "+v"(_o)); \
        __builtin_amdgcn_global_load_lds((const unsigned*)(_gb + _o), (LAS unsigned*)(lds + (bufoff) + ldsw + _i * 8192), 16, 0, 0); } } while (0)
#define PG8_LDA(dst, b, h) do { _Pragma("unroll") for (int m = 0; m < 4; ++m) dst[m] = PG8_CAT(*(const LAS i32x4*)(lds + PG8_SA(b, h) + aoff + m * 2048), *(const LAS i32x4*)(lds + PG8_SA(b, h) + aoff + m * 2048 + 1024)); } while (0)
#define PG8_LDB(dst, b, h) do { _Pragma("unroll") for (int n = 0; n < 2; ++n) dst[n] = PG8_CAT(*(const LAS i32x4*)(lds + PG8_SB(b, h) + boff + n * 2048), *(const LAS i32x4*)(lds + PG8_SB(b, h) + boff + n * 2048 + 1024)); } while (0)
#define PG8_CAT(x0, x1) __builtin_shufflevector((x0), (x1), 0, 1, 2, 3, 4, 5, 6, 7)
#define PG8_LO(x) __builtin_bit_cast(bf16x8, __builtin_shufflevector((x), (x), 0, 1, 2, 3))
#define PG8_HI(x) __builtin_bit_cast(bf16x8, __builtin_shufflevector((x), (x), 4, 5, 6, 7))
#define PG8_MMA(ai, bj, At, Bt) do { __builtin_amdgcn_s_setprio(1); \
        if (FP8) { _Pragma("unroll") for (int m = 0; m < 4; ++m) _Pragma("unroll") for (int n = 0; n < 2; ++n) \
            acc[ai][bj][m][n] = __builtin_amdgcn_mfma_scale_f32_16x16x128_f8f6f4(Bt[n], At[m], acc[ai][bj][m][n], 0, 0, 0, 0x7f7f7f7f, 0, 0x7f7f7f7f); } \
        else { _Pragma("unroll") for (int m = 0; m < 4; ++m) _Pragma("unroll") for (int n = 0; n < 2; ++n) { \
            acc[ai][bj][m][n] = __builtin_amdgcn_mfma_f32_16x16x32_bf16(PG8_LO(Bt[n]), PG8_LO(At[m]), acc[ai][bj][m][n], 0, 0, 0); \
            acc[ai][bj][m][n] = __builtin_amdgcn_mfma_f32_16x16x32_bf16(PG8_HI(Bt[n]), PG8_HI(At[m]), acc[ai][bj][m][n], 0, 0, 0); } } \
        __builtin_amdgcn_s_setprio(0); } while (0)
#define PG8_WAIT_V(n) asm volatile("s_waitcnt vmcnt(" #n ")" ::: "memory")
#define PG8_WAIT_L(n) asm volatile("s_waitcnt lgkmcnt(" #n ")" ::: "memory")
#define PG8_BAR __builtin_amdgcn_s_barrier()
#define PG8_SCHED __builtin_amdgcn_sched_barrier(0)
    Unit cur, nxt; int ui = 0;
    if (!S.next(0, cur)) return;
    f32x4 acc[2][2][4][2];
#pragma unroll
    for (int a = 0; a < 2; ++a)
#pragma unroll
        for (int b = 0; b < 2; ++b)
#pragma unroll
            for (int m = 0; m < 4; ++m)
#pragma unroll
                for (int n = 0; n < 2; ++n) acc[a][b][m][n] = (f32x4){0.f, 0.f, 0.f, 0.f};
    i32x8 At[4], B0[2], B1[2];
    unsigned oA0[2], oA1[2];
#pragma unroll
    for (int i = 0; i < 2; ++i) { oA0[i] = RW.off(cur, sR[i]) + sC[i]; oA1[i] = RW.off(cur, HALF + sR[i]) + sC[i]; }
    const char* cB = cur.B;
    PG8_STAGE(PG8_SB(0, 0), cB, voffB); PG8_STAGE(PG8_SB(0, 1), cB + hstepB, voffB); PG8_STAGE(PG8_SA(0, 0), Abase, oA0); PG8_STAGE(PG8_SA(0, 1), Abase, oA1);
    if (wr == 1) PG8_BAR;
    PG8_WAIT_V(2); PG8_BAR;
    PG8_STAGE(PG8_SB(1, 0), cB + kstep, voffB); PG8_STAGE(PG8_SA(1, 0), Abase + kstep, oA0); PG8_STAGE(PG8_SB(1, 1), cB + hstepB + kstep, voffB);
    PG8_WAIT_V(6); PG8_BAR;
    for (;;) {
        const bool has_next = S.next(ui + 1, nxt);
        unsigned gi0 = 0u, gi1 = 0u, gi2 = 0u, gi3 = 0u;
        if (has_next && RW.list) {
            int t2 = threadIdx.x; asm volatile("" : "+v"(t2)); int R0, C0, R1, C1; stage_rc(t2 * 16, R0, C0); stage_rc(t2 * 16 + 8192, R1, C1);
            const int* lb = RW.list + (size_t)nxt.pm * 256; const unsigned o0 = (unsigned)R0 * 4u, o1 = (unsigned)R1 * 4u, o2 = (unsigned)(HALF + R0) * 4u, o3 = (unsigned)(HALF + R1) * 4u;
            asm volatile("global_load_dword %0, %4, %8\n\tglobal_load_dword %1, %5, %8\n\tglobal_load_dword %2, %6, %8\n\tglobal_load_dword %3, %7, %8"
                         : "=&v"(gi0), "=&v"(gi1), "=&v"(gi2), "=&v"(gi3) : "v"(o0), "v"(o1), "v"(o2), "v"(o3), "s"(lb));
        }
#pragma unroll 1
        for (int t = 0; t < nt; t += 2) {
            const bool last = (t == nt - 2);
            const char* a1 = Abase + (size_t)(t + 1) * kstep;
            PG8_LDB(B0, 0, 0); PG8_LDB(B1, 0, 1); PG8_SCHED; PG8_LDA(At, 0, 0); PG8_STAGE(PG8_SA(1, 1), a1, oA1);
            PG8_WAIT_V(8); PG8_WAIT_L(0); PG8_BAR; PG8_MMA(0, 0, At, B0); PG8_MMA(0, 1, At, B1); PG8_BAR; PG8_SCHED;
            const char* a2; const char* b2;
            if (last) {
                if (has_next) {
                    int t2 = threadIdx.x; asm volatile("" : "+v"(t2));
#pragma unroll
                    for (int i = 0; i < 2; ++i) { int R, C; stage_rc(t2 * 16 + i * 8192, R, C);
                        if (RW.list) { asm volatile("" : "+v"(gi0), "+v"(gi1), "+v"(gi2), "+v"(gi3)); oA0[i] = (i ? gi1 : gi0) * RW.ldab + (unsigned)C * 2u; oA1[i] = (i ? gi3 : gi2) * RW.ldab + (unsigned)C * 2u; }
                        else { oA0[i] = (unsigned)(nxt.pm * 256 + R) * RW.ldab + (unsigned)C * 2u; oA1[i] = (unsigned)(nxt.pm * 256 + HALF + R) * RW.ldab + (unsigned)C * 2u; } }
                    cB = nxt.B;
                }
                a2 = Abase; b2 = cB;
            } else { a2 = Abase + (size_t)(t + 2) * kstep; b2 = cB + (size_t)(t + 2) * kstep; }
            const char* a3 = a2 + kstep; const char* b3 = b2 + kstep;
            PG8_LDA(At, 0, 1); PG8_STAGE(PG8_SB(0, 0), b2, voffB); PG8_STAGE(PG8_SB(0, 1), b2 + hstepB, voffB); PG8_STAGE(PG8_SA(0, 0), a2, oA0);
            PG8_WAIT_V(8); PG8_WAIT_L(0); PG8_BAR; PG8_MMA(1, 0, At, B0); PG8_MMA(1, 1, At, B1); PG8_BAR; PG8_SCHED;
            PG8_LDB(B0, 1, 0); PG8_LDB(B1, 1, 1); PG8_SCHED; PG8_LDA(At, 1, 0); PG8_STAGE(PG8_SA(0, 1), a2, oA1);
            PG8_WAIT_V(8); PG8_WAIT_L(0); PG8_BAR; PG8_MMA(0, 0, At, B0); PG8_MMA(0, 1, At, B1); PG8_BAR; PG8_SCHED;
            PG8_LDA(At, 1, 1); PG8_STAGE(PG8_SB(1, 0), b3, voffB); PG8_STAGE(PG8_SB(1, 1), b3 + hstepB, voffB); PG8_STAGE(PG8_SA(1, 0), a3, oA0);
            PG8_WAIT_V(8); PG8_WAIT_L(0); PG8_BAR; PG8_MMA(1, 0, At, B0); PG8_MMA(1, 1, At, B1); PG8_BAR; PG8_SCHED;
        }
        if (wr == 0) PG8_BAR;
        { Unit eu = cur; asm volatile("" : "+s"(eu.pm), "+s"(eu.pn)); int t3 = threadIdx.x; asm volatile("" : "+v"(t3)); E(acc, eu, wr, wc, t3 & 15, (t3 & 63) >> 4); }
        if (!has_next) break;
#pragma unroll
        for (int a = 0; a < 2; ++a)
#pragma unroll
            for (int b = 0; b < 2; ++b)
#pragma unroll
                for (int m = 0; m < 4; ++m)
#pragma unroll
                    for (int n = 0; n < 2; ++n) acc[a][b][m][n] = (f32x4){0.f, 0.f, 0.f, 0.f};
        cur = nxt; ++ui;
        if (wr == 1) PG8_BAR;
    }
    PG8_WAIT_V(0);
    PG8_BAR;
#undef PG8_SA
#undef PG8_SB
#undef PG8_STAGE
#undef PG8_LDA
#undef PG8_LDB
#undef PG8_MMA
#undef PG8_CAT
#undef PG8_LO
#undef PG8_HI
#undef PG8_WAIT_V
#undef PG8_WAIT_L
#undef PG8_BAR
#undef PG8_SCHED
}
}

struct Params { const float* in[42]; float* out; unsigned char* ws; int ph_lo, ph_hi; };
enum { I_X = 0, I_C, I_CTX, I_CCTX, I_ADAW, I_ADAB, I_N1G, I_N2G, I_WIN, I_WOUT, I_GLAW, I_GLAB, I_GLAG, I_CDW, I_CDB, I_CLG, I_CLB, I_CPW, I_CPB,
       I_S5LR, I_S5LI, I_S5DT, I_S5BR, I_S5BI, I_S5CR, I_S5CI, I_S5D, I_S5GW, I_S5GB, I_QNG, I_KVNG, I_WUQ, I_WUKV, I_RW, I_RB, I_MG, I_MU, I_MD, I_SG, I_SU, I_SD, I_FG };

typedef const __attribute__((address_space(4))) Params* KParams;
__device__ __forceinline__ KParams fresh_params() { KParams kp = (KParams)__builtin_amdgcn_kernarg_segment_ptr(); asm volatile("" : "+s"(kp)); return kp; }
struct Ctx {
    LAS unsigned char* lds;
    int tid, lane, wave, blk, G;
    unsigned char* ws;
};

__device__ __forceinline__ int mod_row(int r) { return r < NLAT ? (r >> 11) : 32; }

__device__ __forceinline__ unsigned pk4_fp8(float a, float b, float c2, float d) {
    int pk = __builtin_amdgcn_cvt_pk_fp8_f32(__builtin_amdgcn_fmed3f(a, -440.f, 440.f), __builtin_amdgcn_fmed3f(b, -440.f, 440.f), 0, false);
    pk = __builtin_amdgcn_cvt_pk_fp8_f32(__builtin_amdgcn_fmed3f(c2, -440.f, 440.f), __builtin_amdgcn_fmed3f(d, -440.f, 440.f), pk, true); return (unsigned)pk; }
template <bool F8 = false>
__device__ __forceinline__ void tr_item(const float* W, int ldw, int k0, int n0, bf16* dst, int ldk, const float* kscale, float sc, LAS float* scr, int lane) {
    float tv[32];
#pragma unroll
    for (int i = 0; i < 32; ++i) tv[i] = W[(size_t)(k0 + 2 * i + (lane >> 5)) * ldw + n0 + (lane & 31)];
#pragma unroll
    for (int i = 0; i < 32; ++i) { const int kk = 2 * i + (lane >> 5); float v = tv[i] * sc; if (kscale) v *= kscale[k0 + kk]; scr[kk * 33 + (lane & 31)] = v; }
    lds_wait();
    const int c = lane & 7;
#pragma unroll
    for (int j = 0; j < 4; ++j) { const int n = (lane >> 3) + 8 * j; const LAS float* s = scr + (8 * c) * 33 + n;
        if (F8) { u32x2 o; o.x = pk4_fp8(s[0 * 33], s[1 * 33], s[2 * 33], s[3 * 33]); o.y = pk4_fp8(s[4 * 33], s[5 * 33], s[6 * 33], s[7 * 33]); *(u32x2*)((unsigned char*)dst + (size_t)n * ldk + k0 + 8 * c) = o; }
        else { u32x4 o; o.x = pk2(s[0 * 33], s[1 * 33]); o.y = pk2(s[2 * 33], s[3 * 33]); o.z = pk2(s[4 * 33], s[5 * 33]); o.w = pk2(s[6 * 33], s[7 * 33]);
            *(u32x4*)(dst + (size_t)n * ldk + k0 + 8 * c) = o; } }
    lds_wait();
}
template <int KIND> __device__ __forceinline__ int tr_dst(int n0) {
    if (KIND == 0) return n0;
    if (KIND == 1) return n0 < 768 ? n0 : (n0 == 768 ? 1952 : n0 - 32);
    if (KIND == 2) { const int half = n0 >> 8, c = n0 & 255; return (c >> 7) * 256 + half * 128 + (c & 127); }
    if (KIND == 3) { const int head = n0 / 96, d0 = n0 % 96; return d0 < 64 ? head * 64 + d0 : 256 + head * 32; }
    if (KIND == 4) { const int head = n0 >> 7, d0 = n0 & 127; return d0 < 64 ? head * 64 + d0 : 256 + head * 64 + (d0 - 64); }
    if (KIND == 5) return (n0 >> 7) * 256 + (n0 & 127);
    if (KIND == 6) return (n0 >> 7) * 256 + 128 + (n0 & 127);
    return n0;
}
template <int KIND, bool F8 = false> __device__ __forceinline__ void tr_matrix(const Ctx& c, const float* W, int ldw, int K, int Nsrc, bf16* WT, int ldk, const float* kscale, float sc) {
    LAS float* scr = (LAS float*)(c.lds + c.wave * 8704);
    const int gw = c.blk * NWAVES + c.wave, NGW = c.G * NWAVES, ng = Nsrc / 32, items = (K / 64) * ng;
    for (int it = gw; it < items; it += NGW) { const int kb = it / ng, g = it % ng; tr_item<F8>(W, ldw, kb * 64, 32 * g, F8 ? (bf16*)((unsigned char*)WT + (size_t)tr_dst<KIND>(32 * g) * ldk) : WT + (size_t)tr_dst<KIND>(32 * g) * ldk, ldk, kscale, sc, scr, c.lane); }
}
__device__ __forceinline__ void zero_fill16(const Ctx& c, void* p, size_t bytes) {
    u32x4* q = (u32x4*)p; const size_t n = bytes / 16;
    for (size_t i = (size_t)c.blk * NTHR + c.tid; i < n; i += (size_t)c.G * NTHR) q[i] = (u32x4){0u, 0u, 0u, 0u};
}
__device__ __forceinline__ void sincos_r(float x, float& s, float& co) {
    const float n = rintf(x * 0.15915494309189535f);
    float r = fmaf(n, -6.28125f, x); r = fmaf(n, -1.9353071795864769e-3f, r);
    s = __sinf(r); co = __cosf(r);
}

__device__ __forceinline__ void prologue_moe_weights(const Ctx& c, KParams p, int l) {
    unsigned char* WGU8 = c.ws + WS_WMOE;
    bf16* WD = (bf16*)(c.ws + WS_WMOE + (size_t)NE * 512 * 1024);
    LAS float* scr = (LAS float*)(c.lds + c.wave * 8704);
    const int gw = c.blk * NWAVES + c.wave, NGW = c.G * NWAVES;
    for (int it = gw; it < NE * 384; it += NGW) {
        const int e = it / 384, r = it % 384;
        if (r < 256) { const int up = r >> 7, q = r & 127, kb = q >> 3, g = q & 7;
            const float* W = p->in[up ? I_MU : I_MG] + ((size_t)l * NE + e) * 1024 * 256;
            const int nd = up ? tr_dst<6>(32 * g) : tr_dst<5>(32 * g);
            tr_item<true>(W, 256, kb * 64, 32 * g, (bf16*)(WGU8 + (size_t)e * 512 * 1024 + (size_t)nd * 1024), 1024, nullptr, 64.f, scr, c.lane);
        } else { const int q = r - 256, kb = q >> 5, g = q & 31;
            const float* W = p->in[I_MD] + ((size_t)l * NE + e) * 256 * 1024;
            tr_item<false>(W, 1024, kb * 64, 32 * g, WD + (size_t)e * 1024 * 256 + (size_t)(32 * g) * 256, 256, nullptr, 1.f, scr, c.lane);
        }
    }
}

__device__ __forceinline__ void prologue(const Ctx& c, KParams p) {
    float* MOD = (float*)(c.ws + WS_MOD);
    {
        const int u = c.G - 1 - c.blk;
        if (u < 96) {
            LAS float* sc = (LAS float*)(c.lds + 72 * 1024);
            LAS float* part = (LAS float*)c.lds;
            const int l = u / 48, kq = c.tid >> 7, cj = c.tid & 127, col = (u % 48) * 128 + cj;
            const float* W = p->in[I_ADAW] + (size_t)l * 1024 * 6144;
            float acc[33];
#pragma unroll
            for (int b = 0; b < 33; ++b) acc[b] = 0.f;
            for (int j = 0; j < 4; ++j) {
                __syncthreads();
                for (int i = c.tid; i < 4 * 33 * 64; i += NTHR) { const int q = i / (33 * 64), r = i % (33 * 64), b = r >> 6, kk = r & 63, k = 256 * q + 64 * j + kk; const float v = b < 32 ? p->in[I_C][b * 1024 + k] : p->in[I_CCTX][k]; sc[i] = siluf_(v); }
                __syncthreads();
                const float* wp = W + (size_t)(256 * kq + 64 * j) * 6144 + col; const LAS float* sq = sc + kq * 33 * 64;
#pragma unroll 8
                for (int kk = 0; kk < 64; ++kk) { const float w = wp[(size_t)kk * 6144];
#pragma unroll
                    for (int b = 0; b < 33; ++b) acc[b] = fmaf(sq[b * 64 + kk], w, acc[b]); }
            }
#pragma unroll
            for (int b = 0; b < 33; ++b) part[(kq * 33 + b) * 128 + cj] = acc[b];
            __syncthreads();
            for (int i = c.tid; i < 33 * 128; i += NTHR) { const int b = i >> 7, cc = i & 127, gc = (u % 48) * 128 + cc;
                MOD[((size_t)l * 33 + b) * 6144 + gc] = (part[(0 * 33 + b) * 128 + cc] + part[(1 * 33 + b) * 128 + cc]) + (part[(2 * 33 + b) * 128 + cc] + part[(3 * 33 + b) * 128 + cc]) + p->in[I_ADAB][l * 6144 + gc]; }
            __syncthreads();
        }
    }
    {
        float* ROPE = (float*)(c.ws + WS_TAB + TAB_ROPE);
        for (int i = c.blk * NTHR + c.tid; i < 2048 * 16; i += c.G * NTHR) { const int t = i >> 4, ax = (i >> 3) & 1, f = i & 7;
            const float pos = (float)(ax == 0 ? (t >> 6) : (t & 63)); const float inv = __expf(-(float)f * (9.210340371976184f / 8.0f));
            float s, co; sincos_r(pos * inv, s, co); ROPE[i * 2] = co; ROPE[i * 2 + 1] = s; }
        bf16* RWT = (bf16*)(c.ws + WS_TAB + TAB_RWT);
        for (int i = c.blk * NTHR + c.tid; i < 2 * 64 * 1024; i += c.G * NTHR) { const int l = i >> 16, n = (i >> 10) & 63, k = i & 1023; const float wv = p->in[I_RW][((size_t)l * 1024 + k) * 64 + n];
            const bf16 hi = f2bf(wv); RWT[(size_t)(l * 2) * 65536 + n * 1024 + k] = hi; RWT[(size_t)(l * 2 + 1) * 65536 + n * 1024 + k] = f2bf(wv - bf2f(hi)); }
        float* S5T = (float*)(c.ws + WS_TAB + TAB_S5);
        for (int i = c.blk * NTHR + c.tid; i < 2 * 2 * 16 * 64; i += c.G * NTHR) {
            const int pp = i & 63, g = (i >> 6) & 15, ld = i >> 10;
            const float lr = p->in[I_S5LR][i], li = p->in[I_S5LI][i], dt = __expf(p->in[I_S5DT][ld * 16 + g]);
            const float mag = __expf(lr * dt); float s, co; sincos_r(li * dt, s, co);
            const float are = mag * co, aim = mag * s, den = lr * lr + li * li;
            const float fre = ((are - 1.f) * lr + aim * li) / den, fim = (aim * lr - (are - 1.f) * li) / den;
            float* T = S5T + (size_t)i * 66; T[0] = are; T[1] = aim;
            { float* PW = (float*)(c.ws + WS_S5P) + (size_t)i * 34; float pr = 1.f, pi = 0.f;
              for (int e = 0; e <= 16; ++e) { PW[2 * e] = pr; PW[2 * e + 1] = pi; const float nr = pr * are - pi * aim, ni = pr * aim + pi * are; pr = nr; pi = ni; } }
            for (int ch = 0; ch < 16; ++ch) { const float br = p->in[I_S5BR][(size_t)i * 16 + ch], bi = p->in[I_S5BI][(size_t)i * 16 + ch];
                T[2 + ch] = fre * br - fim * bi; T[18 + ch] = fre * bi + fim * br;
                T[34 + ch] = p->in[I_S5CR][((size_t)(ld * 16 + g) * 16 + ch) * 64 + pp]; T[50 + ch] = p->in[I_S5CI][((size_t)(ld * 16 + g) * 16 + ch) * 64 + pp]; }
        }
    }
    for (int l = 0; l < 2; ++l) {
        bf16* WIN = (bf16*)(c.ws + WS_WIN) + (size_t)l * 2048 * 1024;
        tr_matrix<1>(c, p->in[I_WIN] + (size_t)l * 1024 * 1984, 1984, 1024, 1984, WIN, 1024, nullptr, 1.f);
        zero_fill16(c, WIN + (size_t)1984 * 1024, (size_t)64 * 1024 * 2);
        tr_matrix<0>(c, p->in[I_WOUT] + (size_t)l * 1024 * 1024, 1024, 1024, 1024, (bf16*)(c.ws + WS_WOUT) + (size_t)l * 1024 * 1024, 1024, nullptr, 1.f);
        unsigned char* sm = c.ws + WS_WSM + (size_t)l * WSM_L;
        tr_matrix<0>(c, p->in[I_CPW] + (size_t)l * 256 * 256, 256, 256, 256, (bf16*)(sm + WSM_PW), 256, nullptr, 1.f);
        tr_matrix<2>(c, p->in[I_S5GW] + (size_t)l * 256 * 512, 512, 256, 512, (bf16*)(sm + WSM_GLU), 256, nullptr, 1.f);
        tr_matrix<3>(c, p->in[I_WUQ] + (size_t)l * 256 * 384, 384, 256, 384, (bf16*)(sm + WSM_UQ), 256, p->in[I_QNG] + l * 256, 0.14724445f  );
        zero_fill16(c, (bf16*)(sm + WSM_UQ) + (size_t)384 * 256, (size_t)128 * 256 * 2);
        zero_fill16(c, sm + WSM_UK, (size_t)512 * 256 * 2);
    }
    for (int l = 0; l < 2; ++l) {
        bf16* WSGU = (bf16*)(c.ws + WS_WSH) + (size_t)l * (512 * 1024 + 1024 * 256); bf16* WSD = WSGU + 512 * 1024;
        tr_matrix<5, true>(c, p->in[I_SG] + (size_t)l * 1024 * 256, 256, 1024, 256, WSGU, 1024, nullptr, 64.f);
        tr_matrix<6, true>(c, p->in[I_SU] + (size_t)l * 1024 * 256, 256, 1024, 256, WSGU, 1024, nullptr, 64.f);
        tr_matrix<0>(c, p->in[I_SD] + (size_t)l * 256 * 1024, 1024, 256, 1024, WSD, 256, nullptr, 1.f);
    }
    prologue_moe_weights(c, p, 0);
}
__device__ __forceinline__ void prologue_s5_weights(const Ctx& c, KParams p) {
    const float* S5T = (const float*)(c.ws + WS_TAB + TAB_S5); const float* S5P = (const float*)(c.ws + WS_S5P);
    LAS float* pw = (LAS float*)c.lds;
    LAS float* bb = pw + 2 * 17 * 64 * 2;
    LAS float* cc = bb + 2 * 64 * 16 * 2;
    LAS float* kt = cc + 2 * 16 * 64 * 2;
    for (int u = c.blk; u < 32; u += c.G) {
        const int l = u >> 4, g = u & 15;
        __syncthreads();
        for (int i = c.tid; i < 2 * 64; i += NTHR) { const int dir = i >> 6, pp = i & 63; const size_t row = (size_t)((l * 2 + dir) * 16 + g) * 64 + pp; const float* T = S5T + row * 66; const float* PW = S5P + row * 34;
            for (int e = 0; e <= 16; ++e) { pw[((dir * 17 + e) * 64 + pp) * 2] = PW[2 * e]; pw[((dir * 17 + e) * 64 + pp) * 2 + 1] = PW[2 * e + 1]; }
            for (int ch = 0; ch < 16; ++ch) { bb[((dir * 64 + pp) * 16 + ch) * 2] = T[2 + ch]; bb[((dir * 64 + pp) * 16 + ch) * 2 + 1] = T[18 + ch]; cc[((dir * 16 + ch) * 64 + pp) * 2] = T[34 + ch]; cc[((dir * 16 + ch) * 64 + pp) * 2 + 1] = T[50 + ch]; } }
        __syncthreads();
        for (int i = c.tid; i < 2 * 16 * 256; i += NTHR) { const int dir = i >> 12, tau = (i >> 8) & 15, c1 = (i >> 4) & 15, c0 = i & 15; float s = 0.f;
            for (int pp = 0; pp < 64; ++pp) { const float cr = cc[((dir * 16 + c1) * 64 + pp) * 2], ci = cc[((dir * 16 + c1) * 64 + pp) * 2 + 1], pr = pw[((dir * 17 + tau) * 64 + pp) * 2], pi = pw[((dir * 17 + tau) * 64 + pp) * 2 + 1];
                const float wr_ = cr * pr - ci * pi, wi_ = cr * pi + ci * pr; s += wr_ * bb[((dir * 64 + pp) * 16 + c0) * 2] - wi_ * bb[((dir * 64 + pp) * 16 + c0) * 2 + 1]; }
            kt[i] = s; }
        __syncthreads();
        bf16* B1 = (bf16*)(c.ws + WS_S5W) + (size_t)(l * 16 + g) * 256 * 256;
        bf16* B2 = (bf16*)(c.ws + WS_S5W) + (size_t)32 * 256 * 256 + (size_t)(l * 16 + g) * 256 * 512;
        const float* dsk = p->in[I_S5D] + l * 256 + g * 16;
        for (int i = c.tid; i < 256 * 256; i += NTHR) { const int n = i >> 8, k = i & 255, dir = n >> 7, ri = (n >> 6) & 1, pp = n & 63, s = k >> 4, ch = k & 15, e = dir ? s : 15 - s;
            const float pr = pw[((dir * 17 + e) * 64 + pp) * 2], pi = pw[((dir * 17 + e) * 64 + pp) * 2 + 1], br = bb[((dir * 64 + pp) * 16 + ch) * 2], bi = bb[((dir * 64 + pp) * 16 + ch) * 2 + 1];
            B1[i] = f2bf(ri ? pr * bi + pi * br : pr * br - pi * bi); }
        for (int i = c.tid; i < 256 * 512; i += NTHR) { const int n = i >> 9, k = i & 511, t = n >> 4, c1 = n & 15; float v;
            if (k < 256) { const int s = k >> 4, c0 = k & 15; v = 0.f; if (s <= t) v += kt[((0 * 16 + (t - s)) * 16 + c1) * 16 + c0]; if (s >= t) v += kt[((1 * 16 + (s - t)) * 16 + c1) * 16 + c0]; if (s == t && c0 == c1) v += dsk[c0]; }
            else { const int q = k - 256, dir = q >> 7, ri = (q >> 6) & 1, pp = q & 63, e = dir ? 16 - t : t + 1;
                const float cr = cc[((dir * 16 + c1) * 64 + pp) * 2], ci = cc[((dir * 16 + c1) * 64 + pp) * 2 + 1], pr = pw[((dir * 17 + e) * 64 + pp) * 2], pi = pw[((dir * 17 + e) * 64 + pp) * 2 + 1];
                v = ri ? -(cr * pi + ci * pr) : (cr * pr - ci * pi); }
            B2[i] = f2bf(v); }
    }
    __syncthreads();
}
__device__ __forceinline__ void prologue2(const Ctx& c, KParams p) {
    prologue_s5_weights(c, p);
    for (int l = 0; l < 2; ++l) { unsigned char* sm = c.ws + WS_WSM + (size_t)l * WSM_L;
        tr_matrix<4>(c, p->in[I_WUKV] + (size_t)l * 128 * 512, 512, 128, 512, (bf16*)(sm + WSM_UK), 256, p->in[I_KVNG] + l * 128, 1.f); }
}

__device__ __forceinline__ void norm_row(const float* xrow, const float* gain, const float* sh, const float* sc, bf16* orow, int lane, f32x4 (&v)[4]) {
    float ss = 0.f;
#pragma unroll
    for (int j = 0; j < 4; ++j) { v[j] = *(const f32x4*)(xrow + 4 * lane + 256 * j); ss += (v[j].x * v[j].x + v[j].y * v[j].y) + (v[j].z * v[j].z + v[j].w * v[j].w); }
    const float rstd = rsqrtf(wave_sum(ss) * (1.f / 1024.f) + EPS);
#pragma unroll
    for (int j = 0; j < 4; ++j) { const int cc = 4 * lane + 256 * j; const f32x4 g = *(const f32x4*)(gain + cc), s1 = *(const f32x4*)(sc + cc), s0 = *(const f32x4*)(sh + cc);
        v[j] = v[j] * rstd * g * (s1 + 1.0f) + s0;
        u32x2 o; o.x = pk2(v[j].x, v[j].y); o.y = pk2(v[j].z, v[j].w); *(u32x2*)(orow + cc) = o; }
}
__device__ __forceinline__ void norm_row_add(const float* xrow, const bf16* drow, float* xout, const float* gain, const float* sh, const float* sc, unsigned char* orow8, int lane, f32x4 (&v)[4]) {
    float ss = 0.f; u32x2 dl[4];
#pragma unroll
    for (int j = 0; j < 4; ++j) { v[j] = *(const f32x4*)(xrow + 4 * lane + 256 * j); dl[j] = *(const u32x2*)(drow + 4 * lane + 256 * j); }
#pragma unroll
    for (int j = 0; j < 4; ++j) { v[j] += (f32x4){__uint_as_float(dl[j].x << 16), __uint_as_float(dl[j].x & 0xffff0000u), __uint_as_float(dl[j].y << 16), __uint_as_float(dl[j].y & 0xffff0000u)};
        *(f32x4*)(xout + 4 * lane + 256 * j) = v[j]; ss += (v[j].x * v[j].x + v[j].y * v[j].y) + (v[j].z * v[j].z + v[j].w * v[j].w); }
    const float rstd = rsqrtf(wave_sum(ss) * (1.f / 1024.f) + EPS);
#pragma unroll
    for (int j = 0; j < 4; ++j) { const int cc = 4 * lane + 256 * j; const f32x4 g = *(const f32x4*)(gain + cc), s1 = *(const f32x4*)(sc + cc), s0 = *(const f32x4*)(sh + cc);
        v[j] = v[j] * rstd * g * (s1 + 1.0f) + s0;
        *(unsigned*)(orow8 + cc) = pk4_fp8(v[j].x * 4.f, v[j].y * 4.f, v[j].z * 4.f, v[j].w * 4.f); }
}
__device__ __forceinline__ void phase_norm1(const Ctx& c, KParams p, int l) {
    const float* MOD = (const float*)(c.ws + WS_MOD) + (size_t)l * 33 * 6144;
    const float* xl = l == 0 ? p->in[I_X] : p->out; const float* xc = l == 0 ? p->in[I_CTX] : (const float*)(c.ws + WS_XC);
    bf16* H = (bf16*)(c.ws + WS_H); const float* gain = p->in[I_N1G] + l * DM;
    const int gw = c.blk * NWAVES + c.wave, NGW = c.G * NWAVES, lane = c.lane;
    for (int r0 = gw; r0 < NTOK; r0 += 2 * NGW) {
        f32x4 v[2][4]; float ss[2];
#pragma unroll
        for (int k = 0; k < 2; ++k) { const int r = r0 + k * NGW < NTOK ? r0 + k * NGW : r0; const float* xr = r < NLAT ? xl + (size_t)r * DM : xc + (size_t)(r - NLAT) * DM;
#pragma unroll
            for (int j = 0; j < 4; ++j) v[k][j] = *(const f32x4*)(xr + 4 * lane + 256 * j); }
#pragma unroll
        for (int k = 0; k < 2; ++k) { ss[k] = 0.f;
#pragma unroll
            for (int j = 0; j < 4; ++j) ss[k] += (v[k][j].x * v[k][j].x + v[k][j].y * v[k][j].y) + (v[k][j].z * v[k][j].z + v[k][j].w * v[k][j].w); }
#pragma unroll
        for (int k = 0; k < 2; ++k) { const int r = r0 + k * NGW; if (r < NTOK) { const float rstd = rsqrtf(wave_sum(ss[k]) * (1.f / 1024.f) + EPS); const float* m = MOD + (size_t)mod_row(r) * 6144; bf16* orow = H + (size_t)r * DM;
#pragma unroll
            for (int j = 0; j < 4; ++j) { const int cc = 4 * lane + 256 * j; const f32x4 g = *(const f32x4*)(gain + cc), s1 = *(const f32x4*)(m + 1024 + cc), s0 = *(const f32x4*)(m + cc);
                const f32x4 y = v[k][j] * rstd * g * (s1 + 1.0f) + s0; u32x2 o; o.x = pk2(y.x, y.y); o.y = pk2(y.z, y.w); *(u32x2*)(orow + cc) = o; } } }
    }
}

#define EPI_ARGS const f32x4 (&acc)[2][2][4][2], const pg8::Unit& u, int wr, int wc, int fr, int fq
#define EPI_ROWS for (int ai = 0; ai < 2; ++ai) _Pragma("unroll") for (int m = 0; m < 4; ++m)
struct EpiBf16 {
    bf16* O; int ldo;
    __device__ __forceinline__ void operator()(EPI_ARGS) const {
        const int r0 = u.pm * 256 + wr * 64 + fr, c0 = u.pn * 256 + wc * 32 + 8 * fq;
#pragma unroll
        EPI_ROWS { bf16* rp = O + (size_t)(r0 + ai * 128 + m * 16) * ldo + c0;
#pragma unroll
            for (int bj = 0; bj < 2; ++bj) { const f32x4 a = acc[ai][bj][m][0], b = acc[ai][bj][m][1]; u32x4 w; w.x = pk2(a.x, a.y); w.y = pk2(a.z, a.w); w.z = pk2(b.x, b.y); w.w = pk2(b.z, b.w); *(u32x4*)(rp + bj * 128) = w; } asm volatile("" ::: "memory"); }
    }
};
struct EpiInProj {
    bf16* O; bf16* UP; bf16* GVT;
    __device__ __forceinline__ void operator()(EPI_ARGS) const {
        const int r0 = u.pm * 256 + wr * 64 + fr, c0 = u.pn * 256 + wc * 32 + 8 * fq;
#pragma unroll
        EPI_ROWS { const int row = r0 + ai * 128 + m * 16; bf16* rp = O + (size_t)row * ZW + c0;
            const int crow = row < NLAT ? (row >> 11) * 144 + 16 + ((row & 2047) >> 4) : ((row - NLAT) >> 8) * 144 + (((row - NLAT) & 255) >> 4);
#pragma unroll
            for (int bj = 0; bj < 2; ++bj) { const f32x4 a = acc[ai][bj][m][0], b = acc[ai][bj][m][1]; u32x4 w; w.x = pk2(a.x, a.y); w.y = pk2(a.z, a.w); w.z = pk2(b.x, b.y); w.w = pk2(b.z, b.w); *(u32x4*)(rp + bj * 128) = w;
                if (u.pn == 5) { const int g = 8 * bj + 2 * wc + (fq >> 1); *(u32x4*)(UP + ((size_t)g * 4608 + crow) * 512 + fr * 16 + 8 * (fq & 1)) = w; }
                if (u.pn == 1) { const int col = 128 * bj + 32 * wc + 8 * fq, bb = row < NLAT ? (row >> 11) : ((row - NLAT) >> 8), kk = row < NLAT ? 256 + (row & 2047) : ((row - NLAT) & 255);
                    bf16* dst = GVT + ((size_t)(bb * 4 + (col >> 6)) * 64 + (col & 63)) * 2304 + (kk & ~15) + 8 * ((fr >> 2) & 1) + 4 * (fr >> 3) + (fr & 3);
#pragma unroll
                    for (int n = 0; n < 2; ++n)
#pragma unroll
                        for (int i = 0; i < 4; ++i) dst[(size_t)(4 * n + i) * 2304] = f2bf(acc[ai][bj][m][n][i]); } }
            asm volatile("" ::: "memory"); }
    }
};
struct EpiS5X {
    bf16* XE;
    __device__ __forceinline__ void operator()(EPI_ARGS) const {
        const int r0 = u.pm * 256 + wr * 64 + fr, c0 = wc * 32 + 8 * fq;
#pragma unroll
        EPI_ROWS { bf16* rp = XE + (size_t)(r0 + ai * 128 + m * 16) * 256 + c0;
#pragma unroll
            for (int bj = 0; bj < 2; ++bj) { const f32x4 a = acc[ai][bj][m][0], b = acc[ai][bj][m][1]; u32x4 w; w.x = pk2(a.x, a.y); w.y = pk2(a.z, a.w); w.z = pk2(b.x, b.y); w.w = pk2(b.z, b.w); *(u32x4*)(rp + bj * 128) = w; }
            asm volatile("" ::: "memory"); }
    }
};
struct EpiS5Y {
    bf16* Y;
    __device__ __forceinline__ void operator()(EPI_ARGS) const {
        const int r0 = u.pm * 256 + wr * 64 + fr;
#pragma unroll
        EPI_ROWS { const int grow = r0 + ai * 128 + m * 16; const int g = grow / 4608, rem = grow - g * 4608, b = rem / 144, ci = rem - b * 144;
            const int tok0 = ci < 16 ? NLAT + b * CTXL + ci * 16 : b * SEQ + (ci - 16) * 16;
#pragma unroll
            for (int bj = 0; bj < 2; ++bj) { const int t = 8 * bj + 2 * wc + (fq >> 1); const f32x4 a = acc[ai][bj][m][0], bq = acc[ai][bj][m][1]; u32x4 w; w.x = pk2(a.x, a.y); w.y = pk2(a.z, a.w); w.z = pk2(bq.x, bq.y); w.w = pk2(bq.z, bq.w);
                *(u32x4*)(Y + (size_t)(tok0 + t) * 256 + g * 16 + 8 * (fq & 1)) = w; }
            asm volatile("" ::: "memory"); }
    }
};
struct EpiOB8 {
    unsigned char* OB;
    __device__ __forceinline__ void operator()(EPI_ARGS) const {
        const int r0 = u.pm * 256 + wr * 64 + fr;
#pragma unroll
        EPI_ROWS { unsigned char* rp = OB + (size_t)(r0 + ai * 128 + m * 16) * 1024 + u.pn * 256 + (wc * 4 + fq) * 16; u32x4 w;
#pragma unroll
            for (int bj = 0; bj < 2; ++bj)
#pragma unroll
                for (int n = 0; n < 2; ++n) { const f32x4 a = acc[ai][bj][m][n] * 16.0f; int pk = 0;
                    pk = __builtin_amdgcn_cvt_pk_fp8_f32(__builtin_amdgcn_fmed3f(a.x, -440.f, 440.f), __builtin_amdgcn_fmed3f(a.y, -440.f, 440.f), pk, false);
                    pk = __builtin_amdgcn_cvt_pk_fp8_f32(__builtin_amdgcn_fmed3f(a.z, -440.f, 440.f), __builtin_amdgcn_fmed3f(a.w, -440.f, 440.f), pk, true); w[2 * bj + n] = (unsigned)pk; }
            *(u32x4*)rp = w; asm volatile("" ::: "memory"); }
    }
};
struct EpiBiasBf16 {
    bf16* O; int ldo; const float* bias;
    __device__ __forceinline__ void operator()(EPI_ARGS) const {
        const int r0 = u.pm * 256 + wr * 64 + fr, c0 = u.pn * 256 + wc * 32 + 8 * fq;
        f32x4 bv[2][2];
#pragma unroll
        for (int bj = 0; bj < 2; ++bj) { bv[bj][0] = *(const f32x4*)(bias + c0 + bj * 128); bv[bj][1] = *(const f32x4*)(bias + c0 + bj * 128 + 4); }
        __builtin_amdgcn_s_waitcnt(0x0F70);
#pragma unroll
        EPI_ROWS { bf16* rp = O + (size_t)(r0 + ai * 128 + m * 16) * ldo + c0;
#pragma unroll
            for (int bj = 0; bj < 2; ++bj) { const f32x4 a = acc[ai][bj][m][0] + bv[bj][0], b = acc[ai][bj][m][1] + bv[bj][1]; u32x4 w; w.x = pk2(a.x, a.y); w.y = pk2(a.z, a.w); w.z = pk2(b.x, b.y); w.w = pk2(b.z, b.w); *(u32x4*)(rp + bj * 128) = w; } asm volatile("" ::: "memory"); }
    }
};
struct EpiGluSig {
    bf16* O; int ldo; const float* bias;
    __device__ __forceinline__ void operator()(EPI_ARGS) const {
        const int r0 = u.pm * 256 + wr * 64 + fr, c0 = u.pn * 128 + wc * 32 + 8 * fq;
        f32x4 b1[2], b2[2];
#pragma unroll
        for (int n = 0; n < 2; ++n) { b1[n] = *(const f32x4*)(bias + c0 + 4 * n); b2[n] = *(const f32x4*)(bias + 256 + c0 + 4 * n); }
        __builtin_amdgcn_s_waitcnt(0x0F70);
#pragma unroll
        EPI_ROWS { bf16* rp = O + (size_t)(r0 + ai * 128 + m * 16) * ldo + c0; float o[8];
#pragma unroll
            for (int n = 0; n < 2; ++n)
#pragma unroll
                for (int i = 0; i < 4; ++i) o[4 * n + i] = (acc[ai][0][m][n][i] + b1[n][i]) * sigmoidf_(acc[ai][1][m][n][i] + b2[n][i]);
            u32x4 w; w.x = pk2(o[0], o[1]); w.y = pk2(o[2], o[3]); w.z = pk2(o[4], o[5]); w.w = pk2(o[6], o[7]); *(u32x4*)rp = w; asm volatile("" ::: "memory"); }
    }
};
struct EpiSwiglu {
    bf16* O; int ldo; float sc;
    __device__ __forceinline__ void operator()(EPI_ARGS) const {
        const int r0 = u.pm * 256 + wr * 64 + fr, c0 = u.pn * 128 + wc * 32 + 8 * fq;
#pragma unroll
        EPI_ROWS { bf16* rp = O + (size_t)(r0 + ai * 128 + m * 16) * ldo + c0; float o[8];
#pragma unroll
            for (int n = 0; n < 2; ++n)
#pragma unroll
                for (int i = 0; i < 4; ++i) o[4 * n + i] = siluf_(acc[ai][0][m][n][i] * sc) * (acc[ai][1][m][n][i] * sc);
            u32x4 w; w.x = pk2(o[0], o[1]); w.y = pk2(o[2], o[3]); w.z = pk2(o[4], o[5]); w.w = pk2(o[6], o[7]); *(u32x4*)rp = w; asm volatile("" ::: "memory"); }
    }
};
struct EpiQ {
    bf16* Q; const float* RS;
    __device__ __forceinline__ void operator()(EPI_ARGS) const {
        const int r0 = u.pm * 256 + wr * 64 + fr; float rq[8];
#pragma unroll
        for (int g = 0; g < 8; ++g) rq[g] = RS[(size_t)(r0 + (g >> 2) * 128 + (g & 3) * 16) * 2];
        __builtin_amdgcn_s_waitcnt(0x0F70);
#pragma unroll
        EPI_ROWS { const int row = r0 + ai * 128 + m * 16; const float rs = rq[ai * 4 + m]; bf16* rp = Q + (size_t)row * 384;
            if (u.pn == 0) {
#pragma unroll
                for (int bj = 0; bj < 2; ++bj) { const int head = 2 * bj + (wc >> 1), d = 32 * (wc & 1) + 8 * fq; const f32x4 a = acc[ai][bj][m][0] * rs, b = acc[ai][bj][m][1] * rs;
                    u32x4 w; w.x = pk2(a.x, a.y); w.y = pk2(a.z, a.w); w.z = pk2(b.x, b.y); w.w = pk2(b.z, b.w); *(u32x4*)(rp + head * 96 + d) = w; }
            } else { const f32x4 a = acc[ai][0][m][0] * rs, b = acc[ai][0][m][1] * rs;
                u32x4 w; w.x = pk2(a.x, a.y); w.y = pk2(a.z, a.w); w.z = pk2(b.x, b.y); w.w = pk2(b.z, b.w); *(u32x4*)(rp + wc * 96 + 64 + 8 * fq) = w; }
            asm volatile("" ::: "memory"); }
    }
};
struct EpiKV {
    bf16* Kb; bf16* VT; const float* RS;
    __device__ __forceinline__ void operator()(EPI_ARGS) const {
        const int r0 = u.pm * 256 + wr * 64 + fr;
        const int p16 = 8 * ((fr >> 2) & 1) + 4 * (fr >> 3) + (fr & 3); float rkv[8];
#pragma unroll
        for (int g = 0; g < 8; ++g) rkv[g] = RS[(size_t)(r0 + (g >> 2) * 128 + (g & 3) * 16) * 2 + 1];
        __builtin_amdgcn_s_waitcnt(0x0F70);
#pragma unroll
        EPI_ROWS { const int row = r0 + ai * 128 + m * 16; const float rk = rkv[ai * 4 + m];
            if (u.pn == 0) {
#pragma unroll
                for (int bj = 0; bj < 2; ++bj) { const int head = 2 * bj + (wc >> 1), d = 32 * (wc & 1) + 8 * fq; const f32x4 a = acc[ai][bj][m][0] * rk, b = acc[ai][bj][m][1] * rk;
                    u32x4 w; w.x = pk2(a.x, a.y); w.y = pk2(a.z, a.w); w.z = pk2(b.x, b.y); w.w = pk2(b.z, b.w);
                    *(u32x4*)(Kb + (size_t)row * 384 + head * 96 + d) = w; }
            } else {
                const int bb = row < NLAT ? (row >> 11) : ((row - NLAT) >> 8); const int kk = row < NLAT ? (row & 2047) : 2048 + ((row - NLAT) & 255);
                const int pos = (kk & ~15) + p16;
#pragma unroll
                for (int bj = 0; bj < 2; ++bj) { const int head = 2 * bj + (wc >> 1), d = 32 * (wc & 1) + 8 * fq; bf16* dst = VT + ((size_t)((bb * 4 + head) * 64 + d)) * 2304 + pos;
#pragma unroll
                    for (int n = 0; n < 2; ++n)
#pragma unroll
                        for (int i = 0; i < 4; ++i) dst[(size_t)(4 * n + i) * 2304] = f2bf(acc[ai][bj][m][n][i] * rk); }
            }
            asm volatile("" ::: "memory"); }
    }
};
struct EpiDelta {
    bf16* D; const float* MODg;
    __device__ __forceinline__ void operator()(EPI_ARGS) const {
        const int rt = u.pm * 256; const float* g = MODg + (size_t)(rt < NLAT ? (rt >> 11) : 32) * 6144;
        const int r0 = rt + wr * 64 + fr, c0 = u.pn * 256 + wc * 32 + 8 * fq;
        f32x4 gv[2][2];
#pragma unroll
        for (int bj = 0; bj < 2; ++bj) { gv[bj][0] = *(const f32x4*)(g + c0 + bj * 128); gv[bj][1] = *(const f32x4*)(g + c0 + bj * 128 + 4); }
        __builtin_amdgcn_s_waitcnt(0x0F70);
#pragma unroll
        EPI_ROWS { bf16* rp = D + (size_t)(r0 + ai * 128 + m * 16) * DM + c0;
#pragma unroll
            for (int bj = 0; bj < 2; ++bj) { const f32x4 a = gv[bj][0] * acc[ai][bj][m][0], b = gv[bj][1] * acc[ai][bj][m][1]; u32x4 w; w.x = pk2(a.x, a.y); w.y = pk2(a.z, a.w); w.z = pk2(b.x, b.y); w.w = pk2(b.z, b.w); *(u32x4*)(rp + bj * 128) = w; }
            asm volatile("" ::: "memory"); }
    }
};

__device__ __forceinline__ int seq_row(int b, int dir, int pos) {
    if (pos < CTXL) return NLAT + b * CTXL + (dir ? CTXL - 1 - pos : pos);
    const int t = pos - CTXL; return b * SEQ + (dir ? SEQ - 1 - t : t);
}
__device__ __forceinline__ void phase_gla(const Ctx& c, KParams p, int l) {
    const bf16* Z = (const bf16*)(c.ws + WS_Z); const bf16* GVT = (const bf16*)(c.ws + WS_GVT); bf16* OG = (bf16*)(c.ws + WS_T1);
    const int w = c.wave, tid = c.tid;
    LAS float* wtab = (LAS float*)c.lds;
    LAS float* DD = (LAS float*)(c.lds + 4096);
    LAS unsigned char* RW = c.lds + 8192 + w * 13824;
    LAS float* LA = (LAS float*)RW;
    LAS unsigned char* KTT = RW + 9216;
    for (int u = c.blk; u < 256; u += c.G) {
        const int b = u >> 3, h = (u >> 1) & 3, dir = u & 1;
        __syncthreads();
        { const float* wa = p->in[I_GLAW] + ((size_t)(l * 2 + dir) * 16) * 128 + h * 32; wtab[tid] = wa[(tid >> 5) * 128 + (tid & 31)]; if (tid < 32) wtab[512 + tid] = p->in[I_GLAB][(l * 2 + dir) * 128 + h * 32 + tid]; }
        float Sst[4] = {0.f, 0.f, 0.f, 0.f};
        __syncthreads();
        for (int gi = 0; gi < 5; ++gi) {
            const int pc = gi * 8 + w; const bool active = pc < 36;
            int lane_ = c.lane; asm volatile("" : "+v"(lane_));
            const int r = lane_ & 31, hh = lane_ >> 5;
            const int p16 = 8 * ((r >> 2) & 1) + 4 * ((r & 15) >> 3) + (r & 3);
            const int pos0 = (r & 16) + p16, pos1 = 32 + pos0;
            bf16x8 qd[2][2]; f32x16 oacc[2][2]; int row0 = 0;
            if (active) {
                int kk0;
                if (dir == 0) { if (pc < 4) { row0 = NLAT + b * CTXL + pc * 64; kk0 = pc * 64; } else { row0 = b * SEQ + (pc - 4) * 64; kk0 = 256 + (pc - 4) * 64; } }
                else { if (pc < 4) { row0 = NLAT + b * CTXL + (3 - pc) * 64; kk0 = (3 - pc) * 64; } else { row0 = b * SEQ + (35 - pc) * 64; kk0 = 256 + (35 - pc) * 64; } }
#pragma unroll
                for (int ib = 0; ib < 2; ++ib) { const bf16* zr = Z + (size_t)(row0 + 32 * ib + r) * ZW; float al[16]; { const u32x4 a0 = *(const u32x4*)(zr + ZAF + dir * 16), a1 = *(const u32x4*)(zr + ZAF + dir * 16 + 8); float t8[8]; unpack8(a0, t8);
#pragma unroll
                        for (int j = 0; j < 8; ++j) al[j] = t8[j];
                        unpack8(a1, t8);
#pragma unroll
                        for (int j = 0; j < 8; ++j) al[8 + j] = t8[j]; }
#pragma unroll
                    for (int ks = 0; ks < 2; ++ks) { float za[8]; { const f32x4 b0 = *(const LAS f32x4*)(wtab + 512 + 16 * ks + 8 * hh), b1 = *(const LAS f32x4*)(wtab + 512 + 16 * ks + 8 * hh + 4);
                            za[0] = b0.x; za[1] = b0.y; za[2] = b0.z; za[3] = b0.w; za[4] = b1.x; za[5] = b1.y; za[6] = b1.z; za[7] = b1.w; }
#pragma unroll
                        for (int j = 0; j < 16; ++j) { const f32x4 w0 = *(const LAS f32x4*)(wtab + j * 32 + 16 * ks + 8 * hh), w1 = *(const LAS f32x4*)(wtab + j * 32 + 16 * ks + 8 * hh + 4);
                            za[0] = fmaf(al[j], w0.x, za[0]); za[1] = fmaf(al[j], w0.y, za[1]); za[2] = fmaf(al[j], w0.z, za[2]); za[3] = fmaf(al[j], w0.w, za[3]);
                            za[4] = fmaf(al[j], w1.x, za[4]); za[5] = fmaf(al[j], w1.y, za[5]); za[6] = fmaf(al[j], w1.z, za[6]); za[7] = fmaf(al[j], w1.w, za[7]); }
                        float la[8];
#pragma unroll
                        for (int e = 0; e < 8; ++e) la[e] = (fminf(za[e], 0.f) - __logf(1.f + __expf(-fabsf(za[e])))) * 0.0625f;
                        *(LAS f32x4*)(LA + (32 * ib + r) * 36 + 16 * ks + 8 * hh) = (f32x4){la[0], la[1], la[2], la[3]}; *(LAS f32x4*)(LA + (32 * ib + r) * 36 + 16 * ks + 8 * hh + 4) = (f32x4){la[4], la[5], la[6], la[7]}; } }
                lds_wait();
                { float bend; float v[32], s = 0.f;
#pragma unroll
                  for (int qq = 0; qq < 32; ++qq) { const int q = 32 * hh + qq, i = dir ? 63 - q : q; v[qq] = LA[i * 36 + r]; s += v[qq]; }
                  const auto sw = __builtin_amdgcn_permlane32_swap(__float_as_uint(s), __float_as_uint(s), false, false);
                  const float h0 = __uint_as_float(sw[0]), h1 = __uint_as_float(sw[1]); bend = h0 + h1;
                  float run = hh ? h0 : 0.f;
#pragma unroll
                  for (int qq = 0; qq < 32; ++qq) { const int q = 32 * hh + qq, i = dir ? 63 - q : q; run += v[qq]; LA[i * 36 + r] = run; }
                  if (hh == 0) DD[w * 32 + r] = __expf(bend); }
                lds_wait();
                bf16x8 ki[2][2];
#pragma unroll
                for (int ib = 0; ib < 2; ++ib) { const bf16* zr = Z + (size_t)(row0 + 32 * ib + r) * ZW;
#pragma unroll
                    for (int ks = 0; ks < 2; ++ks) { const int dk0 = 16 * ks + 8 * hh; float q8[8], k8[8], b8[8]; unpack8(*(const u32x4*)(zr + ZQ + h * 32 + dk0), q8); unpack8(*(const u32x4*)(zr + ZK + h * 32 + dk0), k8);
                        { const f32x4 x0 = *(const LAS f32x4*)(LA + (32 * ib + r) * 36 + dk0), x1 = *(const LAS f32x4*)(LA + (32 * ib + r) * 36 + dk0 + 4); b8[0] = x0.x; b8[1] = x0.y; b8[2] = x0.z; b8[3] = x0.w; b8[4] = x1.x; b8[5] = x1.y; b8[6] = x1.z; b8[7] = x1.w; }
                        float qo[8], ko[8];
#pragma unroll
                        for (int e = 0; e < 8; ++e) { const float eb = __expf(b8[e]), ieb = 1.f / eb; qo[e] = q8[e] * 0.17677669529663687f * eb; ko[e] = k8[e] * ieb;
                            *(LAS bf16*)(KTT + ((dk0 + e) * 72 + (ib ? pos1 : pos0)) * 2) = f2bf(ko[e] * DD[w * 32 + dk0 + e]); }
                        u32x4 wq, wk; wq.x = pk2(qo[0], qo[1]); wq.y = pk2(qo[2], qo[3]); wq.z = pk2(qo[4], qo[5]); wq.w = pk2(qo[6], qo[7]); wk.x = pk2(ko[0], ko[1]); wk.y = pk2(ko[2], ko[3]); wk.z = pk2(ko[4], ko[5]); wk.w = pk2(ko[6], ko[7]);
                        qd[ib][ks] = __builtin_bit_cast(bf16x8, wq); ki[ib][ks] = __builtin_bit_cast(bf16x8, wk); } }
                bf16x8 vt[2][4];
#pragma unroll
                for (int db = 0; db < 2; ++db)
#pragma unroll
                    for (int s4 = 0; s4 < 4; ++s4) vt[db][s4] = *(const bf16x8*)(GVT + ((size_t)(b * 4 + h) * 64 + 32 * db + r) * 2304 + kk0 + 16 * s4 + 8 * hh);
                f32x16 zero16;
#pragma unroll
                for (int i = 0; i < 16; ++i) zero16[i] = 0.f;
                f32x16 a00 = __builtin_amdgcn_mfma_f32_32x32x16_bf16(ki[0][0], qd[0][0], zero16, 0, 0, 0); a00 = __builtin_amdgcn_mfma_f32_32x32x16_bf16(ki[0][1], qd[0][1], a00, 0, 0, 0);
                f32x16 a11 = __builtin_amdgcn_mfma_f32_32x32x16_bf16(ki[1][0], qd[1][0], zero16, 0, 0, 0); a11 = __builtin_amdgcn_mfma_f32_32x32x16_bf16(ki[1][1], qd[1][1], a11, 0, 0, 0);
                f32x16 aof;
                if (dir == 0) { aof = __builtin_amdgcn_mfma_f32_32x32x16_bf16(ki[0][0], qd[1][0], zero16, 0, 0, 0); aof = __builtin_amdgcn_mfma_f32_32x32x16_bf16(ki[0][1], qd[1][1], aof, 0, 0, 0); }
                else { aof = __builtin_amdgcn_mfma_f32_32x32x16_bf16(ki[1][0], qd[0][0], zero16, 0, 0, 0); aof = __builtin_amdgcn_mfma_f32_32x32x16_bf16(ki[1][1], qd[0][1], aof, 0, 0, 0); }
#pragma unroll
                for (int i = 0; i < 16; ++i) { const int j = (i & 3) + 8 * (i >> 2) + 4 * hh; const bool keep = dir ? (j >= r) : (j <= r); a00[i] = keep ? a00[i] : 0.f; a11[i] = keep ? a11[i] : 0.f; }
#define GLA_P(X, s) ({ u32x4 w_; w_.x = pk2((X)[8 * (s)], (X)[8 * (s) + 1]); w_.y = pk2((X)[8 * (s) + 2], (X)[8 * (s) + 3]); w_.z = pk2((X)[8 * (s) + 4], (X)[8 * (s) + 5]); w_.w = pk2((X)[8 * (s) + 6], (X)[8 * (s) + 7]); __builtin_bit_cast(bf16x8, w_); })
                const bf16x8 p00a = GLA_P(a00, 0), p00b = GLA_P(a00, 1), p11a = GLA_P(a11, 0), p11b = GLA_P(a11, 1), pofa = GLA_P(aof, 0), pofb = GLA_P(aof, 1);
#pragma unroll
                for (int db = 0; db < 2; ++db) {
                    f32x16 o0 = __builtin_amdgcn_mfma_f32_32x32x16_bf16(vt[db][0], p00a, zero16, 0, 0, 0); o0 = __builtin_amdgcn_mfma_f32_32x32x16_bf16(vt[db][1], p00b, o0, 0, 0, 0);
                    f32x16 o1 = __builtin_amdgcn_mfma_f32_32x32x16_bf16(vt[db][2], p11a, zero16, 0, 0, 0); o1 = __builtin_amdgcn_mfma_f32_32x32x16_bf16(vt[db][3], p11b, o1, 0, 0, 0);
                    if (dir == 0) { o1 = __builtin_amdgcn_mfma_f32_32x32x16_bf16(vt[db][0], pofa, o1, 0, 0, 0); o1 = __builtin_amdgcn_mfma_f32_32x32x16_bf16(vt[db][1], pofb, o1, 0, 0, 0); }
                    else { o0 = __builtin_amdgcn_mfma_f32_32x32x16_bf16(vt[db][2], pofa, o0, 0, 0, 0); o0 = __builtin_amdgcn_mfma_f32_32x32x16_bf16(vt[db][3], pofb, o0, 0, 0, 0); }
                    oacc[db][0] = o0; oacc[db][1] = o1; }
#undef GLA_P
                lds_wait();
                bf16x8 kf[4];
#pragma unroll
                for (int s4 = 0; s4 < 4; ++s4) kf[s4] = *(const LAS bf16x8*)(KTT + (r * 72 + 16 * s4 + 8 * hh) * 2);
#pragma unroll
                for (int db = 0; db < 2; ++db) { f32x16 uu = __builtin_amdgcn_mfma_f32_32x32x16_bf16(vt[db][0], kf[0], zero16, 0, 0, 0);
#pragma unroll
                    for (int s4 = 1; s4 < 4; ++s4) uu = __builtin_amdgcn_mfma_f32_32x32x16_bf16(vt[db][s4], kf[s4], uu, 0, 0, 0);
#pragma unroll
                    for (int i = 0; i < 16; ++i) LA[(32 * db + (i & 3) + 8 * (i >> 2) + 4 * hh) * 32 + r] = uu[i]; }
            }
            __syncthreads();
            const int dv2 = tid >> 3, dk4 = (tid & 7) * 4;
            f32x4 ur[8], dr[8];
#pragma unroll
            for (int cc = 0; cc < 8; ++cc) { ur[cc] = *(const LAS f32x4*)((LAS float*)(c.lds + 8192 + cc * 13824) + dv2 * 32 + dk4); dr[cc] = *(const LAS f32x4*)(DD + cc * 32 + dk4); }
            __syncthreads();
#pragma unroll
            for (int cc = 0; cc < 8; ++cc) if (gi * 8 + cc < 36) { u32x2 sp; sp.x = pk2(Sst[0], Sst[1]); sp.y = pk2(Sst[2], Sst[3]); *(LAS u32x2*)(c.lds + 8192 + cc * 13824 + (dv2 * 40 + dk4) * 2) = sp;
                Sst[0] = fmaf(dr[cc].x, Sst[0], ur[cc].x); Sst[1] = fmaf(dr[cc].y, Sst[1], ur[cc].y); Sst[2] = fmaf(dr[cc].z, Sst[2], ur[cc].z); Sst[3] = fmaf(dr[cc].w, Sst[3], ur[cc].w); }
            __syncthreads();
            if (active) {
#pragma unroll
                for (int db = 0; db < 2; ++db) { const bf16x8 s0 = *(const LAS bf16x8*)(RW + ((32 * db + r) * 40 + 8 * hh) * 2), s1 = *(const LAS bf16x8*)(RW + ((32 * db + r) * 40 + 16 + 8 * hh) * 2);
#pragma unroll
                    for (int ib = 0; ib < 2; ++ib) { oacc[db][ib] = __builtin_amdgcn_mfma_f32_32x32x16_bf16(s0, qd[ib][0], oacc[db][ib], 0, 0, 0); oacc[db][ib] = __builtin_amdgcn_mfma_f32_32x32x16_bf16(s1, qd[ib][1], oacc[db][ib], 0, 0, 0); } }
#pragma unroll
                for (int ib = 0; ib < 2; ++ib) { bf16* orow = OG + ((size_t)dir * NTOK + row0 + 32 * ib + r) * 256 + h * 64 + 4 * hh;
#pragma unroll
                    for (int db = 0; db < 2; ++db)
#pragma unroll
                        for (int g4 = 0; g4 < 4; ++g4) { u32x2 wv; wv.x = pk2(oacc[db][ib][4 * g4], oacc[db][ib][4 * g4 + 1]); wv.y = pk2(oacc[db][ib][4 * g4 + 2], oacc[db][ib][4 * g4 + 3]); *(u32x2*)(orow + 32 * db + 8 * g4) = wv; } }
                lds_wait();
            }
        }
    }
    __syncthreads();
}
__device__ __forceinline__ void phase_gla_final(const Ctx& c, KParams p, int l, int nrows) {
    const bf16* Z = (const bf16*)(c.ws + WS_Z); const bf16* OG = (const bf16*)(c.ws + WS_T1); bf16* MIX = (bf16*)(c.ws + WS_MIX);
    const int gw = c.blk * NWAVES + c.wave, NGW = c.G * NWAVES; const f32x4 g = *(const f32x4*)(p->in[I_GLAG] + l * 256 + 4 * c.lane);
    for (int r0 = gw; r0 < nrows; r0 += 4 * NGW) {
        u32x2 of[4], ob[4], rg[4];
#pragma unroll
        for (int k = 0; k < 4; ++k) { const int r = r0 + k * NGW; of[k] = ob[k] = rg[k] = (u32x2){0u, 0u};
            if (r < nrows) { of[k] = *(const u32x2*)(OG + (size_t)r * 256 + 4 * c.lane); ob[k] = *(const u32x2*)(OG + ((size_t)NTOK + r) * 256 + 4 * c.lane); rg[k] = *(const u32x2*)(Z + (size_t)r * ZW + ZR + 4 * c.lane); } }
#pragma unroll
        for (int k = 0; k < 4; ++k) { const int r = r0 + k * NGW;
            f32x4 o = (f32x4){__uint_as_float(of[k].x << 16) + __uint_as_float(ob[k].x << 16), __uint_as_float(of[k].x & 0xffff0000u) + __uint_as_float(ob[k].x & 0xffff0000u),
                              __uint_as_float(of[k].y << 16) + __uint_as_float(ob[k].y << 16), __uint_as_float(of[k].y & 0xffff0000u) + __uint_as_float(ob[k].y & 0xffff0000u)};
            float ss = (o.x * o.x + o.y * o.y) + (o.z * o.z + o.w * o.w);
            ss += shx<1>(ss); ss += shx<2>(ss); ss += shx<4>(ss); ss += shx<8>(ss);
            const float rstd = rsqrtf(ss * (1.f / 64.f) + EPS);
            const float g0 = __uint_as_float(rg[k].x << 16), g1 = __uint_as_float(rg[k].x & 0xffff0000u), g2 = __uint_as_float(rg[k].y << 16), g3 = __uint_as_float(rg[k].y & 0xffff0000u);
            u32x2 w; w.x = pk2(o.x * rstd * g.x * siluf_(g0), o.y * rstd * g.y * siluf_(g1)); w.y = pk2(o.z * rstd * g.z * siluf_(g2), o.w * rstd * g.w * siluf_(g3));
            if (r < nrows) *(u32x2*)(MIX + (size_t)r * DM + 4 * c.lane) = w; }
    }
}

__device__ __forceinline__ void phase_conv1(const Ctx& c, KParams p, int l, bool with_ctx) {
    const bf16* Z = (const bf16*)(c.ws + WS_Z); bf16* CV = (bf16*)(c.ws + WS_CV);
    constexpr int TT = 64, HR = TT + 30;
    LAS float* glu = (LAS float*)c.lds;
    LAS float* dws = glu + HR * 256;
    for (int i = c.tid; i < 31 * 256; i += NTHR) dws[i] = p->in[I_CDW][(size_t)l * 31 * 256 + i];
    const int ntiles = with_ctx ? 1024 + 128 : 1024;
    const f32x4 dwb = *(const f32x4*)(p->in[I_CDB] + l * 256 + 4 * c.lane), lg = *(const f32x4*)(p->in[I_CLG] + l * 256 + 4 * c.lane), lb = *(const f32x4*)(p->in[I_CLB] + l * 256 + 4 * c.lane);
    for (int tile = c.blk; tile < ntiles; tile += c.G) {
        int rowbase, t0, slen;
        if (tile < 1024) { const int b = tile >> 5; rowbase = b * SEQ; t0 = (tile & 31) * TT; slen = SEQ; } else { const int q = tile - 1024, b = q >> 2; rowbase = NLAT + b * CTXL; t0 = (q & 3) * TT; slen = CTXL; }
        __syncthreads();
        u32x2 ra[12], rg[12];
#pragma unroll
        for (int k = 0; k < 12; ++k) { const int idx = c.tid + k * NTHR, j = idx >> 6, c4 = (idx & 63) * 4, t = t0 - 15 + j; ra[k] = (u32x2){0u, 0u}; rg[k] = (u32x2){0u, 0u};
            if (idx < HR * 64 && t >= 0 && t < slen) { const bf16* zr = Z + (size_t)(rowbase + t) * ZW; ra[k] = *(const u32x2*)(zr + ZCA + c4); rg[k] = *(const u32x2*)(zr + ZCG + c4); } }
#pragma unroll
        for (int k = 0; k < 12; ++k) { const int idx = c.tid + k * NTHR, j = idx >> 6, c4 = (idx & 63) * 4; f32x4 v;
            v.x = __uint_as_float(ra[k].x << 16) * sigmoidf_(__uint_as_float(rg[k].x << 16)); v.y = __uint_as_float(ra[k].x & 0xffff0000u) * sigmoidf_(__uint_as_float(rg[k].x & 0xffff0000u));
            v.z = __uint_as_float(ra[k].y << 16) * sigmoidf_(__uint_as_float(rg[k].y << 16)); v.w = __uint_as_float(ra[k].y & 0xffff0000u) * sigmoidf_(__uint_as_float(rg[k].y & 0xffff0000u));
            if (idx < HR * 64) *(LAS f32x4*)(glu + j * 256 + c4) = v; }
        __syncthreads();
        for (int q = 0; q < 8; ++q) { const int i = c.wave * 8 + q; f32x4 a = dwb;
#pragma unroll
            for (int j = 0; j < 31; ++j) a += *(const LAS f32x4*)(glu + (i + j) * 256 + 4 * c.lane) * *(const LAS f32x4*)(dws + j * 256 + 4 * c.lane);
            const float mu = wave_sum((a.x + a.y) + (a.z + a.w)) * (1.f / 256.f); const f32x4 dlt = a - mu;
            const float var = wave_sum((dlt.x * dlt.x + dlt.y * dlt.y) + (dlt.z * dlt.z + dlt.w * dlt.w)) * (1.f / 256.f); const float rstd = rsqrtf(var + EPS);
            const f32x4 y = dlt * rstd * lg + lb;
            u32x2 w; w.x = pk2(siluf_(y.x), siluf_(y.y)); w.y = pk2(siluf_(y.z), siluf_(y.w));
            *(u32x2*)(CV + (size_t)(rowbase + t0 + i) * 256 + 4 * c.lane) = w; }
    }
    __syncthreads();
}

__device__ __forceinline__ void phase_s5_carry(const Ctx& c, int l) {
    const bf16* XE = (const bf16*)(c.ws + WS_Y5); bf16* UP = (bf16*)(c.ws + WS_UP); const float* S5P = (const float*)(c.ws + WS_S5P);
    for (int i = c.blk * NTHR + c.tid; i < NB * 2 * 16 * 64; i += c.G * NTHR) {
        const int pp = i & 63, g = (i >> 6) & 15, dir = (i >> 10) & 1, b = i >> 11;
        const float* PW = S5P + ((size_t)((l * 2 + dir) * 16 + g) * 64 + pp) * 34 + 32; const float ar = PW[0], ai = PW[1];
        const size_t rbase = (size_t)g * 4608 + (size_t)b * 144; float xr = 0.f, xi = 0.f;
        for (int s0 = 0; s0 < 144; s0 += 8) {
            float er[8], ei[8];
#pragma unroll
            for (int q = 0; q < 8; ++q) { const int s = s0 + q; const int ci = dir == 0 ? s : (s < 16 ? 15 - s : 159 - s); const bf16* xe = XE + (rbase + ci) * 256 + dir * 128 + pp; er[q] = bf2f(xe[0]); ei[q] = bf2f(xe[64]); }
#pragma unroll
            for (int q = 0; q < 8; ++q) { const int s = s0 + q; const int ci = dir == 0 ? s : (s < 16 ? 15 - s : 159 - s); bf16* up = UP + (rbase + ci) * 512 + 256 + dir * 128 + pp; up[0] = f2bf(xr); up[64] = f2bf(xi);
                const float nr = ar * xr - ai * xi + er[q], ni = ar * xi + ai * xr + ei[q]; xr = nr; xi = ni; }
        }
    }
}

__device__ __forceinline__ void phase_mla_prep(const Ctx& c, KParams p) {
    const bf16* Z = (const bf16*)(c.ws + WS_Z); float* RS = (float*)(c.ws + WS_RS); bf16* Kb = (bf16*)(c.ws + WS_H) + (size_t)NTOK * 384; const float* ROPE = (const float*)(c.ws + WS_TAB + TAB_ROPE);
    const int gw = c.blk * NWAVES + c.wave, NGW = c.G * NWAVES, lane = c.lane, d = lane & 31;
    for (int r0 = gw; r0 < NTOK; r0 += 4 * NGW) {
        u32x2 q4[4]; unsigned k2[4]; bf16 xr[4]; f32x2 cs[4];
#pragma unroll
        for (int k = 0; k < 4; ++k) { const int r = r0 + k * NGW; q4[k] = (u32x2){0u, 0u}; k2[k] = 0u; xr[k] = 0; cs[k] = (f32x2){1.f, 0.f};
            if (r < NTOK) { const bf16* zr = Z + (size_t)r * ZW; q4[k] = *(const u32x2*)(zr + ZCQ + 4 * lane); k2[k] = *(const unsigned*)(zr + ZCKV + 2 * lane); xr[k] = zr[ZKR + d];
                if (r < NLAT) cs[k] = *(const f32x2*)(ROPE + (((r & 2047) * 2 + (d >> 4)) * 8 + (d & 7)) * 2); } }
#pragma unroll
        for (int k = 0; k < 4; ++k) { const int r = r0 + k * NGW;
            const float a0 = __uint_as_float(q4[k].x << 16), a1 = __uint_as_float(q4[k].x & 0xffff0000u), a2 = __uint_as_float(q4[k].y << 16), a3 = __uint_as_float(q4[k].y & 0xffff0000u);
            const float b0 = __uint_as_float(k2[k] << 16), b1 = __uint_as_float(k2[k] & 0xffff0000u);
            const float sq = wave_sum((a0 * a0 + a1 * a1) + (a2 * a2 + a3 * a3)), sk = wave_sum(b0 * b0 + b1 * b1);
            const float x = bf2f(xr[k]); const float px = shx<8>(x);
            const float o = (d & 8) ? fmaf(x, cs[k].x, px * cs[k].y) : fmaf(x, cs[k].x, -px * cs[k].y);
            if (r < NTOK) { if (lane == 0) { RS[(size_t)r * 2] = rsqrtf(sq * (1.f / 256.f) + EPS); RS[(size_t)r * 2 + 1] = rsqrtf(sk * (1.f / 128.f) + EPS); }
                const bf16 ob = f2bf(o); bf16* kr = Kb + (size_t)r * 384 + 64 + d; if (lane < 32) { kr[0] = ob; kr[96] = ob; kr[192] = ob; kr[288] = ob; } } }
    }
}
__device__ __forceinline__ void phase_attn(const Ctx& c, bool with_ctx) {
    const bf16* Qb = (const bf16*)(c.ws + WS_H); const bf16* Kb = Qb + (size_t)NTOK * 384; const bf16* VT = Kb + (size_t)NTOK * 384; bf16* MIX = (bf16*)(c.ws + WS_MIX);
    constexpr int KROW = 208, VROW = 144, KBUF = 64 * KROW, VBUF = 64 * VROW;
    LAS unsigned char* Kt = c.lds; LAS unsigned char* Vt = c.lds + 2 * KBUF;
    const int lane = c.lane, ln = lane & 31, hh = lane >> 5, tid = c.tid;
    const int nunits = with_ctx ? 1152 : 1024;
    for (int L = c.blk; L < nunits; L += c.G) {
        int u = L;
        if (c.G == 256 && L < 1024) { const int r = L >> 8, x = L & 7, j = (L & 255) >> 3; u = ((r * 32 + x * 4 + (j >> 3)) << 3) | (j & 7); }
        int b, h, qrow0, kt0, nkt;
        if (u < 1024) { b = u >> 5; h = (u >> 3) & 3; qrow0 = b * SEQ + (u & 7) * 256; kt0 = 0; nkt = 36; } else { const int q = u - 1024; b = q >> 2; h = q & 3; qrow0 = NLAT + b * CTXL; kt0 = 32; nkt = 4; }
        const bf16* vtb = VT + (size_t)((b * 4 + h) * 64) * 2304;
        bf16x8 qf[6];
        { const bf16* qr = Qb + (size_t)(qrow0 + 32 * c.wave + ln) * 384 + h * 96 + 8 * hh;
#pragma unroll
          for (int ks = 0; ks < 6; ++ks) qf[ks] = *(const bf16x8*)(qr + 16 * ks); }
        if (u < 1024) {
            const float* ROPE = (const float*)(c.ws + WS_TAB + TAB_ROPE) + (size_t)((qrow0 + 32 * c.wave + ln) & 2047) * 32;
#pragma unroll
            for (int ax = 0; ax < 2; ++ax) { const u32x4 own = __builtin_bit_cast(u32x4, qf[4 + ax]); u32x4 oth, res;
#pragma unroll
                for (int i = 0; i < 4; ++i) { const auto sw = __builtin_amdgcn_permlane32_swap(own[i], own[i], false, false); oth[i] = hh ? sw[0] : sw[1]; }
#pragma unroll
                for (int i = 0; i < 4; ++i) { const f32x4 cs = *(const f32x4*)(ROPE + ax * 16 + 4 * i);
                    const float v0 = __uint_as_float(own[i] << 16), v1 = __uint_as_float(own[i] & 0xffff0000u), p0 = __uint_as_float(oth[i] << 16), p1 = __uint_as_float(oth[i] & 0xffff0000u);
                    const float sg = hh ? 1.f : -1.f; res[i] = pk2(fmaf(v0, cs.x, sg * p0 * cs.y), fmaf(v1, cs.z, sg * p1 * cs.w)); }
                qf[4 + ax] = __builtin_bit_cast(bf16x8, res); } }
        f32x16 oacc[2];
#pragma unroll
        for (int i = 0; i < 16; ++i) { oacc[0][i] = 0.f; oacc[1][i] = 0.f; }
        float mrun = 0.f, lsum = 0.f;
        const int k0key = tid / 12, k0pt = tid % 12, k1key = (512 + tid) / 12, k1pt = (512 + tid) % 12; const bool k1on = tid < 256;
        u32x4 sk0, sk1 = (u32x4){0u, 0u, 0u, 0u}, sv;
        auto key_row = [&](int kt, int j) -> int { const int kk = kt * 64 + j; return kk < 2048 ? b * SEQ + kk : NLAT + b * CTXL + (kk - 2048); };
#define ATT_LOAD(kt) do { sk0 = *(const u32x4*)(Kb + (size_t)key_row((kt), k0key) * 384 + h * 96 + k0pt * 8); if (k1on) sk1 = *(const u32x4*)(Kb + (size_t)key_row((kt), k1key) * 384 + h * 96 + k1pt * 8); \
        sv = *(const u32x4*)(vtb + (size_t)(tid >> 3) * 2304 + (kt) * 64 + (tid & 7) * 8); } while (0)
#define ATT_STORE(buf) do { *(LAS u32x4*)(Kt + (buf) * KBUF + k0key * KROW + k0pt * 16) = sk0; if (k1on) *(LAS u32x4*)(Kt + (buf) * KBUF + k1key * KROW + k1pt * 16) = sk1; \
        *(LAS u32x4*)(Vt + (buf) * VBUF + (tid >> 3) * VROW + (tid & 7) * 16) = sv; } while (0)
        __syncthreads();
        ATT_LOAD(kt0); ATT_STORE(0);
        __syncthreads();
        for (int it = 0; it < nkt; ++it) {
            const int cur = it & 1;
            if (it + 1 < nkt) ATT_LOAD(kt0 + it + 1);
            f32x16 sacc[2];
            const float nm = -mrun;
#pragma unroll
            for (int kb = 0; kb < 2; ++kb) {
#pragma unroll
                for (int i = 0; i < 16; ++i) sacc[kb][i] = nm;
#pragma unroll
                for (int ks = 0; ks < 6; ++ks) { const bf16x8 a = *(const LAS bf16x8*)(Kt + cur * KBUF + (32 * kb + ln) * KROW + ks * 32 + hh * 16);
                    sacc[kb] = __builtin_amdgcn_mfma_f32_32x32x16_bf16(a, qf[ks], sacc[kb], 0, 0, 0); } }
            float mx = fmaxf(fmaxf(sacc[0][0], sacc[0][1]), sacc[0][2]);
#pragma unroll
            for (int i = 3; i < 15; i += 2) mx = fmaxf(fmaxf(mx, sacc[0][i]), sacc[0][i + 1]);
            mx = fmaxf(mx, sacc[0][15]);
#pragma unroll
            for (int i = 0; i < 16; i += 2) mx = fmaxf(fmaxf(mx, sacc[1][i]), sacc[1][i + 1]);
            { const auto r = __builtin_amdgcn_permlane32_swap(__float_as_uint(mx), __float_as_uint(mx), false, false); mx = fmaxf(__uint_as_float(r[0]), __uint_as_float(r[1])); }
            if (it == 0 || __builtin_amdgcn_ballot_w64(mx > 8.0f) != 0ull) {
                const float up = it == 0 ? mx : fmaxf(mx, 0.f), alpha = __builtin_amdgcn_exp2f(-up); mrun += up; lsum *= alpha;
#pragma unroll
                for (int i = 0; i < 16; ++i) { oacc[0][i] *= alpha; oacc[1][i] *= alpha; sacc[0][i] -= up; sacc[1][i] -= up; }
            }
            float ps = 0.f;
#pragma unroll
            for (int kb = 0; kb < 2; ++kb)
#pragma unroll
                for (int i = 0; i < 16; ++i) { const float pv = __builtin_amdgcn_exp2f(sacc[kb][i]); sacc[kb][i] = pv; ps += pv; }
            lsum += ps;
            bf16x8 pb[4];
#pragma unroll
            for (int s4 = 0; s4 < 4; ++s4) { const int kb = s4 >> 1, o8 = 8 * (s4 & 1); u32x4 w;
                w.x = pk2(sacc[kb][o8 + 0], sacc[kb][o8 + 1]); w.y = pk2(sacc[kb][o8 + 2], sacc[kb][o8 + 3]); w.z = pk2(sacc[kb][o8 + 4], sacc[kb][o8 + 5]); w.w = pk2(sacc[kb][o8 + 6], sacc[kb][o8 + 7]);
                pb[s4] = __builtin_bit_cast(bf16x8, w); }
#pragma unroll
            for (int db = 0; db < 2; ++db)
#pragma unroll
                for (int s4 = 0; s4 < 4; ++s4) { const bf16x8 a = *(const LAS bf16x8*)(Vt + cur * VBUF + (32 * db + ln) * VROW + s4 * 32 + hh * 16);
                    oacc[db] = __builtin_amdgcn_mfma_f32_32x32x16_bf16(a, pb[s4], oacc[db], 0, 0, 0); }
            if (it + 1 < nkt) ATT_STORE(cur ^ 1);
            __syncthreads();
        }
#undef ATT_LOAD
#undef ATT_STORE
        { const auto r = __builtin_amdgcn_permlane32_swap(__float_as_uint(lsum), __float_as_uint(lsum), false, false); lsum = __uint_as_float(r[0]) + __uint_as_float(r[1]); }
        const float inv = 1.f / lsum;
        bf16* dst = MIX + (size_t)(qrow0 + 32 * c.wave + ln) * DM + 768 + h * 64 + 4 * hh;
#pragma unroll
        for (int db = 0; db < 2; ++db)
#pragma unroll
            for (int g4 = 0; g4 < 4; ++g4) { u32x2 w; w.x = pk2(oacc[db][4 * g4] * inv, oacc[db][4 * g4 + 1] * inv); w.y = pk2(oacc[db][4 * g4 + 2] * inv, oacc[db][4 * g4 + 3] * inv);
                *(u32x2*)(dst + 32 * db + 8 * g4) = w; }
    }
    __syncthreads();
}

__device__ __forceinline__ void phase_norm2_route(const Ctx& c, KParams p, int l, int ntok) {
    const float* MOD = (const float*)(c.ws + WS_MOD) + (size_t)l * 33 * 6144;
    const float* xl = l == 0 ? p->in[I_X] : p->out; const float* xc = l == 0 ? p->in[I_CTX] : (const float*)(c.ws + WS_XC);
    bf16* H = (bf16*)(c.ws + WS_H);
    int* TKEP = (int*)(c.ws + WS_RT + RT_TKEP); float* TKW = (float*)(c.ws + WS_RT + RT_TKW); int* TB = (int*)(c.ws + WS_TB);
    int* CNT = (int*)(c.ws + WS_CTL) + CW_CNT + l * NCH * NE;
    constexpr int HROW = 1032;
    LAS bf16* hhi = (LAS bf16*)c.lds;
    LAS bf16* hlo = hhi + 32 * HROW;
    LAS float* lgs = (LAS float*)(c.lds + 132096);
    LAS int* hist = (LAS int*)(c.lds + 140288);
    const bf16* Whi = (const bf16*)(c.ws + WS_TAB + TAB_RWT) + (size_t)(l * 2) * 65536; const bf16* Wlo = Whi + 65536;
    const float rbias = p->in[I_RB][l * 64 + c.lane];
    const int ntiles = ntok / 32, rpc = ntok / NCH, lane = c.lane, mb = c.wave >> 2, nb = c.wave & 3;
    for (int tile = c.blk; tile < ntiles; tile += c.G) {
        __syncthreads();
        if (c.tid < 64) hist[c.tid] = 0;
        for (int q = 0; q < 4; ++q) { const int r = tile * 32 + c.wave * 4 + q; const float* xr = r < NLAT ? xl + (size_t)r * DM : xc + (size_t)(r - NLAT) * DM; const float* m = MOD + (size_t)mod_row(r) * 6144;
            float* xo = r < NLAT ? p->out + (size_t)r * DM : (float*)(c.ws + WS_XC) + (size_t)(r - NLAT) * DM;
            f32x4 v[4]; norm_row_add(xr, (const bf16*)(c.ws + WS_Z) + (size_t)r * DM, xo, p->in[I_N2G] + l * DM, m + 3072, m + 4096, c.ws + WS_H8 + (size_t)r * DM, lane, v);
#pragma unroll
            for (int j = 0; j < 4; ++j) { u32x2 hi; hi.x = pk2(v[j].x, v[j].y); hi.y = pk2(v[j].z, v[j].w);
                const float r0 = v[j].x - __uint_as_float(hi.x << 16), r1 = v[j].y - __uint_as_float(hi.x & 0xffff0000u), r2 = v[j].z - __uint_as_float(hi.y << 16), r3 = v[j].w - __uint_as_float(hi.y & 0xffff0000u);
                u32x2 lo; lo.x = pk2(r0, r1); lo.y = pk2(r2, r3);
                *(LAS u32x2*)(hhi + (c.wave * 4 + q) * HROW + 4 * lane + 256 * j) = hi; *(LAS u32x2*)(hlo + (c.wave * 4 + q) * HROW + 4 * lane + 256 * j) = lo; } }
        __syncthreads();
        { f32x4 acc = (f32x4){0.f, 0.f, 0.f, 0.f};
          const LAS bf16* ah = hhi + (mb * 16 + (lane & 15)) * HROW + 8 * (lane >> 4); const LAS bf16* al = hlo + (mb * 16 + (lane & 15)) * HROW + 8 * (lane >> 4);
          const bf16* bh = Whi + (size_t)(nb * 16 + (lane & 15)) * 1024 + 8 * (lane >> 4); const bf16* bl = Wlo + (size_t)(nb * 16 + (lane & 15)) * 1024 + 8 * (lane >> 4);
#pragma unroll 8
          for (int ks = 0; ks < 32; ++ks) { const bf16x8 a_h = *(const LAS bf16x8*)(ah + 32 * ks), a_l = *(const LAS bf16x8*)(al + 32 * ks), b_h = *(const bf16x8*)(bh + 32 * ks), b_l = *(const bf16x8*)(bl + 32 * ks);
              acc = __builtin_amdgcn_mfma_f32_16x16x32_bf16(a_h, b_h, acc, 0, 0, 0); acc = __builtin_amdgcn_mfma_f32_16x16x32_bf16(a_h, b_l, acc, 0, 0, 0); acc = __builtin_amdgcn_mfma_f32_16x16x32_bf16(a_l, b_h, acc, 0, 0, 0); }
#pragma unroll
          for (int i = 0; i < 4; ++i) lgs[(mb * 16 + 4 * (lane >> 4) + i) * 64 + nb * 16 + (lane & 15)] = acc[i]; }
        __syncthreads();
#pragma unroll
        for (int q = 0; q < 4; ++q) {
            const int r = tile * 32 + c.wave * 4 + q;
            const float s = sigmoidf_(lgs[(c.wave * 4 + q) * 64 + lane]), bs = s + rbias;
            float m1 = bs; m1 = fmaxf(m1, shx<1>(m1)); m1 = fmaxf(m1, shx<2>(m1)); m1 = fmaxf(m1, shx<4>(m1));
            const unsigned long long eq = __ballot(bs == m1); const unsigned gm = (unsigned)(eq >> (lane & 56)) & 0xffu; const int first = __ffs(gm) - 1;
            float m2 = ((lane & 7) == first) ? -1e30f : bs; m2 = fmaxf(m2, shx<1>(m2)); m2 = fmaxf(m2, shx<2>(m2)); m2 = fmaxf(m2, shx<4>(m2));
            const float gs = m1 + m2; const int g = lane >> 3; int rank = 0;
#pragma unroll
            for (int j = 0; j < 8; ++j) { const float o = rdl(gs, 8 * j); rank += (o > gs || (o == gs && j < g)) ? 1 : 0; }
            float cand = rank < 4 ? bs : -1e30f; int my_e = 0; float my_w = 0.f, wsum = 0.f;
#pragma unroll
            for (int k = 0; k < 8; ++k) { const float mm = wave_max(cand); const unsigned long long e2 = __ballot(cand == mm); const int idx = __ffsll((long long)e2) - 1; const float wk = rdl(s, idx);
                if (lane == idx) cand = -1e30f; if (lane == k) { my_e = idx; my_w = wk; } wsum += wk; }
            if (lane < 8) { const int lp = atomicAdd((int*)&hist[my_e], 1); TKEP[(size_t)r * 8 + lane] = my_e | (lp << 8); TKW[(size_t)r * 8 + lane] = my_w / wsum * 2.5f; }
        }
        __syncthreads();
        if (c.tid < 64) { const int n = hist[c.tid]; int base = 0; if (n > 0) base = atomicAdd(&CNT[((tile * 32) / rpc) * NE + c.tid], n); TB[tile * 64 + c.tid] = base; }
    }
    __syncthreads();
}
__device__ __forceinline__ void phase_route_fill(const Ctx& c, int l, int ntok) {
    const int* TKEP = (const int*)(c.ws + WS_RT + RT_TKEP); int* SLOT = (int*)(c.ws + WS_RT + RT_SLOT); const int* TB = (const int*)(c.ws + WS_TB);
    const int* CNT = (const int*)(c.ws + WS_CTL) + CW_CNT + l * NCH * NE; int* ROWL = (int*)(c.ws + WS_ROWL);
    LAS int* est = (LAS int*)c.lds;
    const int rpc = ntok / NCH;
    __syncthreads();
    if (c.tid < NCH) { int s = 0; for (int e = 0; e < NE; ++e) { est[c.tid * 65 + e] = s; s += (CNT[c.tid * NE + e] + 255) & ~255; } est[c.tid * 65 + 64] = s; }
    __syncthreads();
    const size_t na = (size_t)ntok * 8;
    for (size_t a = (size_t)c.blk * NTHR + c.tid; a < na; a += (size_t)c.G * NTHR) { const int t = (int)(a >> 3), ch = t / rpc; const int ep = TKEP[a], e = ep & 255, lp = ep >> 8;
        const int slot = est[ch * 65 + e] + TB[(t >> 5) * 64 + e] + lp; SLOT[a] = slot; ROWL[(size_t)ch * RPCMAX + slot] = t; }
    for (int i = c.blk * NTHR + c.tid; i < NCH * NE * 256; i += c.G * NTHR) { const int ch = i >> 14, e = (i >> 8) & 63, j = i & 255; const int n = CNT[ch * NE + e]; const int pad = ((n + 255) & ~255) - n;
        if (j < pad) ROWL[(size_t)ch * RPCMAX + est[ch * 65 + e] + n + j] = ch * rpc; }
    __syncthreads();
}

__device__ __forceinline__ void moe_tile_table(const Ctx& c, int l, int ch, LAS int* tst) {
    const int* CNT = (const int*)(c.ws + WS_CTL) + CW_CNT + l * NCH * NE + ch * NE;
    LAS unsigned char* texp = (LAS unsigned char*)(tst + 80);
    __syncthreads();
    if (c.tid == 0) { int s = 0; for (int e = 0; e < NE; ++e) { tst[e] = s; s += (CNT[e] + 255) >> 8; } tst[64] = s; }
    __syncthreads();
    if (c.tid < NE) { for (int t = tst[c.tid]; t < tst[c.tid + 1]; ++t) texp[t] = (unsigned char)c.tid; }
    __syncthreads();
}
__device__ __forceinline__ void phase_combine(const Ctx& c, KParams p, int l, int ch, int rpc) {
    const float* MOD = (const float*)(c.ws + WS_MOD) + (size_t)l * 33 * 6144 + 5120; const float* MODn = (const float*)(c.ws + WS_MOD) + (size_t)33 * 6144;
    const int* SLOT = (const int*)(c.ws + WS_RT + RT_SLOT); const float* TKW = (const float*)(c.ws + WS_RT + RT_TKW);
    const unsigned char* OB = (const unsigned char*)(c.ws + WS_OB); const bf16* OBS = (const bf16*)(c.ws + WS_OBS);
    float* xl = p->out; float* xc = (float*)(c.ws + WS_XC); bf16* H = (bf16*)(c.ws + WS_H);
    const int gw = c.blk * NWAVES + c.wave, NGW = c.G * NWAVES, lane = c.lane;
    const int col0 = (lane >> 4) * 256 + ((lane >> 2) & 3) * 32 + (lane & 3) * 8;
    f32x4 gn[4];
#pragma unroll
    for (int q = 0; q < 4; ++q) gn[q] = *(const f32x4*)((l == 0 ? p->in[I_N1G] + DM : p->in[I_FG]) + col0 + 128 * (q >> 1) + 4 * (q & 1));
    int sl_n = 0; float w_n = 0.f;
    if (gw < rpc && lane < 8) { sl_n = SLOT[(size_t)(ch * rpc + gw) * 8 + lane]; w_n = TKW[(size_t)(ch * rpc + gw) * 8 + lane] * 0.0625f; }
    for (int i = gw; i < rpc; i += NGW) {
        const int t = ch * rpc + i; float* xr = t < NLAT ? xl + (size_t)t * DM : xc + (size_t)(t - NLAT) * DM; const int mr = mod_row(t); const float* g2 = MOD + (size_t)mr * 6144;
        const int sl = sl_n; const float w = w_n;
        u32x4 ob[8], os0, os1; f32x4 xv[4];
#pragma unroll
        for (int e = 0; e < 8; ++e) ob[e] = *(const u32x4*)(OB + (size_t)rdli(sl, e) * 1024 + lane * 16);
        os0 = *(const u32x4*)(OBS + (size_t)i * DM + col0); os1 = *(const u32x4*)(OBS + (size_t)i * DM + col0 + 128);
#pragma unroll
        for (int q = 0; q < 4; ++q) xv[q] = *(const f32x4*)(xr + col0 + 128 * (q >> 1) + 4 * (q & 1));
        if (i + NGW < rpc && lane < 8) { sl_n = SLOT[(size_t)(t + NGW) * 8 + lane]; w_n = TKW[(size_t)(t + NGW) * 8 + lane] * 0.0625f; }
        float a[16]; { float t8[8]; unpack8(os0, t8);
#pragma unroll
            for (int q = 0; q < 8; ++q) a[q] = t8[q];
            unpack8(os1, t8);
#pragma unroll
            for (int q = 0; q < 8; ++q) a[8 + q] = t8[q]; }
#pragma unroll
        for (int e = 0; e < 8; ++e) { const float wk = rdl(w, e);
#pragma unroll
            for (int q = 0; q < 4; ++q) { const f32x2 lo = __builtin_amdgcn_cvt_pk_f32_fp8((int)ob[e][q], false), hi = __builtin_amdgcn_cvt_pk_f32_fp8((int)ob[e][q], true);
                a[4 * q] = fmaf(wk, lo.x, a[4 * q]); a[4 * q + 1] = fmaf(wk, lo.y, a[4 * q + 1]); a[4 * q + 2] = fmaf(wk, hi.x, a[4 * q + 2]); a[4 * q + 3] = fmaf(wk, hi.y, a[4 * q + 3]); } }
        f32x4 xn[4]; float ss = 0.f;
#pragma unroll
        for (int q = 0; q < 4; ++q) { const int cc = col0 + 128 * (q >> 1) + 4 * (q & 1); const f32x4 gv = *(const f32x4*)(g2 + cc);
            xn[q] = xv[q] + gv * (f32x4){a[4 * q], a[4 * q + 1], a[4 * q + 2], a[4 * q + 3]}; ss += (xn[q].x * xn[q].x + xn[q].y * xn[q].y) + (xn[q].z * xn[q].z + xn[q].w * xn[q].w); }
        const float rstd = rsqrtf(wave_sum(ss) * (1.f / 1024.f) + EPS);
        if (l == 0) { const float* mn = MODn + (size_t)mr * 6144; bf16* hr = H + (size_t)t * DM;
#pragma unroll
            for (int q = 0; q < 4; ++q) { const int cc = col0 + 128 * (q >> 1) + 4 * (q & 1); *(f32x4*)(xr + cc) = xn[q];
                const f32x4 s0 = *(const f32x4*)(mn + cc), s1 = *(const f32x4*)(mn + 1024 + cc); const f32x4 hv = xn[q] * rstd * gn[q] * (s1 + 1.0f) + s0;
                u32x2 o; o.x = pk2(hv.x, hv.y); o.y = pk2(hv.z, hv.w); *(u32x2*)(hr + cc) = o; } }
        else {
#pragma unroll
            for (int q = 0; q < 4; ++q) { const int cc = col0 + 128 * (q >> 1) + 4 * (q & 1); *(f32x4*)(xr + cc) = xn[q] * rstd * gn[q]; } }
    }
}
constexpr int LDS_BYTES = 147456;
constexpr int LDS_TAB = 131072, LDS_XB = LDS_BYTES - 16;
enum { J_INPROJ = 0, J_S5G1, J_PW, J_Q, J_KV, J_S5G2, J_GLU, J_OUT, J_GU, J_GUS, J_DN, J_DNS };
enum { SK_DENSE = 0, SK_S5, SK_MOE };
enum { EK_INPROJ = 0, EK_S5X, EK_S5Y, EK_BIAS, EK_GLU, EK_Q, EK_KV, EK_RESID, EK_SWIGLU, EK_OB8, EK_BF16 };
struct JSched {
    int sk, G, c; pg8::DenseOrder d; const char* W; size_t wexp, wtile; const LAS unsigned char* texp; int ntile, npn;
    __device__ __forceinline__ bool next(int i, pg8::Unit& u) const {
        if (sk == SK_DENSE) return d.next(i, u);
        const int L = i * G + c;
        if (sk == SK_S5) { if (L >= 288) return false; u.pm = L; u.pn = 0; u.e = L / 18; u.B = W + (size_t)u.e * wexp; return true; }
        if (L >= ntile * npn) return false;
        const int T = npn == 2 ? (L >> 1) : (L >> 2), pn = L & (npn - 1); const int e = __builtin_amdgcn_readfirstlane((int)texp[T]);
        u.pm = T; u.pn = pn; u.e = e; u.B = W + (size_t)e * wexp + (size_t)pn * wtile; return true;
    }
};
struct JRows { const int* list; unsigned ldab;
    __device__ __forceinline__ unsigned off(const pg8::Unit& u, int r) const { const int row = u.pm * 256 + r; return (unsigned)(list ? list[row] : row) * ldab; } };
struct JEpi {
    int ek; void* p0; void* p1; void* p2; const void* q0; const void* q1; const void* q2; int i0;
    __device__ __forceinline__ void operator()(EPI_ARGS) const {
        switch (ek) {
        case EK_INPROJ: EpiInProj{(bf16*)p0, (bf16*)p1, (bf16*)p2}(acc, u, wr, wc, fr, fq); break;
        case EK_S5X:    EpiS5X{(bf16*)p0}(acc, u, wr, wc, fr, fq); break;
        case EK_S5Y:    EpiS5Y{(bf16*)p0}(acc, u, wr, wc, fr, fq); break;
        case EK_BIAS:   EpiBiasBf16{(bf16*)p0, i0, (const float*)q0}(acc, u, wr, wc, fr, fq); break;
        case EK_GLU:    EpiGluSig{(bf16*)p0, i0, (const float*)q0}(acc, u, wr, wc, fr, fq); break;
        case EK_Q:      EpiQ{(bf16*)p0, (const float*)q0}(acc, u, wr, wc, fr, fq); break;
        case EK_KV:     EpiKV{(bf16*)p0, (bf16*)p1, (const float*)q0}(acc, u, wr, wc, fr, fq); break;
        case EK_RESID:  EpiDelta{(bf16*)p0, (const float*)q0}(acc, u, wr, wc, fr, fq); break;
        case EK_SWIGLU: EpiSwiglu{(bf16*)p0, i0, 1.0f / 256.0f}(acc, u, wr, wc, fr, fq); break;
        case EK_OB8:    EpiOB8{(unsigned char*)p0}(acc, u, wr, wc, fr, fq); break;
        default:        EpiBf16{(bf16*)p0, i0}(acc, u, wr, wc, fr, fq); break;
        }
    }
};
__device__ __forceinline__ void gemm_job(KParams p, LAS unsigned char* lds, int job, int l, int ch) {
    unsigned char* ws = p->ws;
    const int G = gridDim.x, blk = blockIdx.x;
    const bool last = (l == 1); const int nrows = last ? NLAT : NTOK, rpc = nrows / NCH;
    unsigned char* sm = ws + WS_WSM + (size_t)l * WSM_L;
    const LAS int* tst = (const LAS int*)(lds + LDS_TAB);
    const char* A = nullptr; int K = 256; bool fp8 = false; JSched S; JRows R; JEpi E;
    S.sk = SK_DENSE; S.G = G; S.c = blk; S.W = nullptr; S.wexp = 0; S.wtile = 0; S.texp = (const LAS unsigned char*)(tst + 80); S.ntile = 0; S.npn = 2; S.d.init(1, 1, G, blk, nullptr, 256);
    R.list = nullptr; R.ldab = 512u; E.ek = EK_BF16; E.p0 = E.p1 = E.p2 = nullptr; E.q0 = E.q1 = E.q2 = nullptr; E.i0 = 0;
    switch (job) {
    case J_INPROJ: A = (const char*)(ws + WS_H); K = 1024; R.ldab = 2048u; S.d.init(NTOK / 256, ZW / 256, G, blk, (const bf16*)(ws + WS_WIN) + (size_t)l * 2048 * 1024, 1024);
        E.ek = EK_INPROJ; E.p0 = ws + WS_Z; E.p1 = ws + WS_UP; E.p2 = ws + WS_GVT; break;
    case J_S5G1: A = (const char*)(ws + WS_UP); K = 256; R.ldab = 1024u; S.sk = SK_S5; S.W = (const char*)(ws + WS_S5W) + (size_t)l * 16 * 256 * 256 * 2; S.wexp = (size_t)256 * 256 * 2; E.ek = EK_S5X; E.p0 = ws + WS_Y5; break;
    case J_PW: A = (const char*)(ws + WS_CV); K = 256; R.ldab = 512u; S.d.init(nrows / 256, 1, G, blk, (const bf16*)(sm + WSM_PW), 256); E.ek = EK_BIAS; E.p0 = (bf16*)(ws + WS_MIX) + 256; E.i0 = DM; E.q0 = p->in[I_CPB] + l * 256; break;
    case J_Q: A = (const char*)(ws + WS_Z) + ZCQ * 2; K = 256; R.ldab = (unsigned)ZW * 2u; S.d.init(NTOK / 256, 2, G, blk, (const bf16*)(sm + WSM_UQ), 256);
        E.ek = EK_Q; E.p0 = ws + WS_H; E.q0 = ws + WS_RS; break;
    case J_KV: A = (const char*)(ws + WS_Z) + ZCKV * 2; K = 256; R.ldab = (unsigned)ZW * 2u; S.d.init(NTOK / 256, 2, G, blk, (const bf16*)(sm + WSM_UK), 256);
        E.ek = EK_KV; E.p0 = (bf16*)(ws + WS_H) + (size_t)NTOK * 384; E.p1 = (bf16*)(ws + WS_H) + (size_t)NTOK * 768; E.q0 = ws + WS_RS; break;
    case J_S5G2: A = (const char*)(ws + WS_UP); K = 512; R.ldab = 1024u; S.sk = SK_S5; S.W = (const char*)(ws + WS_S5W) + (size_t)32 * 256 * 256 * 2 + (size_t)l * 16 * 256 * 512 * 2; S.wexp = (size_t)256 * 512 * 2; E.ek = EK_S5Y; E.p0 = ws + WS_Y5; break;
    case J_GLU: A = (const char*)(ws + WS_Y5); K = 256; R.ldab = 512u; S.d.init(nrows / 256, 2, G, blk, (const bf16*)(sm + WSM_GLU), 256); E.ek = EK_GLU; E.p0 = (bf16*)(ws + WS_MIX) + 512; E.i0 = DM; E.q0 = p->in[I_S5GB] + l * 512; break;
    case J_OUT: A = (const char*)(ws + WS_MIX); K = 1024; R.ldab = 2048u; S.d.init(nrows / 256, 4, G, blk, (const bf16*)(ws + WS_WOUT) + (size_t)l * 1024 * 1024, 1024);
        E.ek = EK_RESID; E.p0 = ws + WS_Z; E.q0 = (const float*)(ws + WS_MOD) + (size_t)l * 33 * 6144 + 2048; break;
    case J_GU: A = (const char*)(ws + WS_H8); K = 512; fp8 = true; R.list = (const int*)(ws + WS_ROWL) + (size_t)ch * RPCMAX; R.ldab = 1024u; S.sk = SK_MOE; S.ntile = __builtin_amdgcn_readfirstlane(tst[64]); S.npn = 2; S.W = (const char*)(ws + WS_WMOE); S.wexp = (size_t)512 * 1024; S.wtile = (size_t)256 * 1024;
        E.ek = EK_SWIGLU; E.p0 = ws + WS_HB; E.i0 = 256; break;
    case J_GUS: A = (const char*)(ws + WS_H8) + (size_t)ch * rpc * 1024; K = 512; fp8 = true; R.ldab = 1024u; S.d.init(rpc / 256, 2, G, blk, (const bf16*)(ws + WS_WSH) + (size_t)l * (512 * 1024 + 1024 * 256), 512); E.ek = EK_SWIGLU; E.p0 = ws + WS_HBS; E.i0 = 256; break;
    case J_DN: A = (const char*)(ws + WS_HB); K = 256; R.ldab = 512u; S.sk = SK_MOE; S.ntile = __builtin_amdgcn_readfirstlane(tst[64]); S.npn = 4; S.W = (const char*)(ws + WS_WMOE) + (size_t)NE * 512 * 1024; S.wexp = (size_t)1024 * 256 * 2; S.wtile = (size_t)256 * 256 * 2;
        E.ek = EK_OB8; E.p0 = ws + WS_OB; break;
    default: A = (const char*)(ws + WS_HBS); K = 256; R.ldab = 512u; S.d.init(rpc / 256, 4, G, blk, (const bf16*)(ws + WS_WSH) + (size_t)l * (512 * 1024 + 1024 * 256) + 512 * 1024, 256); E.ek = EK_BF16; E.p0 = ws + WS_OBS; E.i0 = DM; break;
    }
    __builtin_amdgcn_s_waitcnt(0x0F70);
    if (fp8) pg8::gemm_phase<true>(lds, A, K, S, R, EpiSwiglu{(bf16*)E.p0, E.i0, 1.0f / 256.0f});
    else pg8::gemm_phase<false>(lds, A, K, S, R, E);
}


__global__ void __launch_bounds__(NTHR, 2) fwd_kernel(Params pk) {
    extern __shared__ __attribute__((aligned(16))) unsigned char lds_raw[];
    LAS unsigned char* const lds0 = (LAS unsigned char*)lds_raw;
    if (threadIdx.x < 4) ((LAS unsigned*)(lds0 + LDS_XB))[threadIdx.x] = 0u;
    __syncthreads();
    (void)xcd_barrier_post((unsigned*)(pk.ws + WS_CTL) + CW_BAR, (volatile LAS unsigned*)(lds0 + LDS_XB));
    constexpr int NSTEP = 15 + 6 * NCH;
#ifndef PROBE_DUP
#define PROBE_DUP (-9)
#endif
#pragma unroll 1
    for (int it_ = -2; it_ < 2 * NSTEP + (PROBE_DUP >= 0 ? 2 : 0); ++it_) {
        int gs = it_; if (PROBE_DUP >= 0) { if (it_ > PROBE_DUP) gs -= 1; if (it_ > NSTEP + PROBE_DUP + 1) gs -= 1; }
        KParams p = fresh_params(); Ctx c; { int t_ = threadIdx.x; asm volatile("" : "+v"(t_)); c.lds = lds0; c.tid = t_; c.lane = t_ & 63; c.wave = __builtin_amdgcn_readfirstlane(t_ >> 6); c.blk = blockIdx.x; c.G = gridDim.x; c.ws = p->ws; }
        LAS int* tst = (LAS int*)(c.lds + LDS_TAB);
        int l = 0, s = gs, ch = 0, job = -1; bool seam = true;
        if (gs >= 0) { l = gs >= NSTEP ? 1 : 0; s = gs - l * NSTEP; if (s >= 15) { ch = (s - 15) / 6; s = 15 + (s - 15) % 6; } }
        const bool last = (l == 1); const int nrows = last ? NLAT : NTOK, rpc = nrows / NCH;
        switch (s) {
        case -2: prologue(c, p); break;
        case -1: prologue2(c, p); break;
        case 0: if (last) prologue_moe_weights(c, p, 1); else phase_norm1(c, p, l); break;
        case 1: job = J_INPROJ; break;
        case 2: phase_gla(c, p, l); phase_conv1(c, p, l, !last); phase_mla_prep(c, p); seam = false; break;
        case 3: job = J_S5G1; break;
        case 4: phase_gla_final(c, p, l, nrows); seam = false; break;
        case 5: job = J_PW; seam = false; break;
        case 6: job = J_Q; seam = false; break;
        case 7: job = J_KV; seam = false; break;
        case 8: phase_s5_carry(c, l); break;
        case 9: phase_attn(c, !last); seam = false; break;
        case 10: job = J_S5G2; break;
        case 11: job = J_GLU; break;
        case 12: job = J_OUT; break;
        case 13: phase_norm2_route(c, p, l, nrows); break;
        case 14: phase_route_fill(c, l, nrows); break;
        case 15: moe_tile_table(c, l, ch, tst); job = J_GU; seam = false; break;
        case 16: job = J_GUS; break;
        case 17: job = J_DN; seam = false; break;
        case 18: job = J_DNS; break;
        case 19: phase_combine(c, p, l, ch, rpc); break;
        default: seam = false; break;
        }
        if (job >= 0) gemm_job(p, c.lds, job, l, ch);
        if (seam && gs + 1 < 2 * NSTEP) { XcdBarrier b_; b_.bar = (unsigned*)(p->ws + WS_CTL) + CW_BAR; b_.x = xb_xcc_id(); b_.st = (volatile LAS unsigned*)(lds0 + LDS_XB); xcd_barrier(b_); }
    }
}

extern "C" void kernel_launch(void* const* d_in, const int* in_sizes, int n_in, void* d_out, int out_size, void* d_ws, size_t ws_size, hipStream_t stream) {
    static int grid = 0;
    if (grid == 0) {
        if (n_in != 42 || out_size != NLAT * DM || ws_size < WS_END) { fprintf(stderr, "kernel_launch: unexpected shapes (n_in %d out %d ws %zu)\n", n_in, out_size, ws_size); grid = -1; return; }
        int dev = 0, cus = 0;
        if (hipGetDevice(&dev) != hipSuccess || hipDeviceGetAttribute(&cus, hipDeviceAttributeMultiprocessorCount, dev) != hipSuccess) { grid = -1; return; }
        if (hipFuncSetAttribute((const void*)fwd_kernel, hipFuncAttributeMaxDynamicSharedMemorySize, LDS_BYTES) != hipSuccess) { fprintf(stderr, "kernel_launch: hipFuncSetAttribute failed\n"); grid = -1; return; }
        int per_cu = 0;
        if (hipOccupancyMaxActiveBlocksPerMultiprocessor(&per_cu, (const void*)fwd_kernel, NTHR, LDS_BYTES) != hipSuccess || per_cu < 1) fprintf(stderr, "kernel_launch: occupancy query reports %d\n", per_cu);
        (void)hipGetLastError();
        grid = cus;
    }
    if (grid < 0) return;
    (void)hipMemsetAsync((char*)d_ws + WS_CTL, 0, CTL_BYTES, stream);
    Params p{};
    for (int i = 0; i < 42; ++i) p.in[i] = (const float*)d_in[i];
    p.out = (float*)d_out; p.ws = (unsigned char*)d_ws; p.ph_lo = 0; p.ph_hi = 1 << 20;
    hipLaunchKernelGGL(fwd_kernel, dim3(grid), dim3(NTHR), LDS_BYTES, stream, p);
}
```

```cpp
#include <hip/hip_runtime.h>
#include <cstdio>
#include <cstdint>

#define LAS __attribute__((address_space(3)))
typedef unsigned short bf16;
typedef short bf16x8 __attribute__((ext_vector_type(8)));
typedef float f32x4 __attribute__((ext_vector_type(4)));
typedef float f32x2 __attribute__((ext_vector_type(2)));
typedef float f32x16 __attribute__((ext_vector_type(16)));
typedef unsigned u32x4 __attribute__((ext_vector_type(4)));
typedef unsigned u32x2 __attribute__((ext_vector_type(2)));
typedef int i32x4 __attribute__((ext_vector_type(4)));
typedef int i32x8 __attribute__((ext_vector_type(8)));

constexpr int NB = 32, SEQ = 2048, CTXL = 256, DM = 1024;
constexpr int NLAT = NB * SEQ, NCTX = NB * CTXL, NTOK = NLAT + NCTX;
constexpr int ZW = 2048;
constexpr int ZQ = 0, ZK = 128, ZV = 256, ZR = 512, ZCA = 768, ZCG = 1024, ZS5 = 1280, ZCQ = 1536, ZCKV = 1792, ZKR = 1920, ZAF = 1952, ZAB = 1968;
constexpr int NE = 64, TOPK = 8;
constexpr int NCH = 2;
constexpr int RPCMAX = (NTOK / NCH) * 8 + 64 * 256;
constexpr float EPS = 1e-6f;
constexpr int NWAVES = 8, NTHR = 512;

constexpr size_t MiB = (size_t)1 << 20;
constexpr size_t WS_CTL = 0, CTL_BYTES = 1 * MiB;
constexpr size_t WS_MOD = 1 * MiB;
constexpr size_t WS_TAB = 3 * MiB;
constexpr size_t WS_WSM = 5 * MiB;
constexpr size_t WS_WIN = 8 * MiB;
constexpr size_t WS_WOUT = 16 * MiB;
constexpr size_t WS_WSH = 20 * MiB;
constexpr size_t WS_TB = 23 * MiB;
constexpr size_t WS_RT = 24 * MiB;
constexpr size_t WS_ROWL = 32 * MiB;
constexpr size_t WS_RS = 35 * MiB;
constexpr size_t WS_WMOE = 36 * MiB;
constexpr size_t WS_XC = 132 * MiB;
constexpr size_t WS_H = 164 * MiB;
constexpr size_t WS_H8 = WS_H + 72 * MiB;
constexpr size_t WS_Z = 308 * MiB;
constexpr size_t WS_MIX = 596 * MiB;
constexpr size_t WS_T1 = 740 * MiB;
constexpr size_t WS_UP = 812 * MiB;
constexpr size_t WS_CV = 884 * MiB;
constexpr size_t WS_Y5 = 920 * MiB;
constexpr size_t WS_S5W = 956 * MiB;
constexpr size_t WS_S5P = 968 * MiB;
constexpr size_t WS_GVT = 969 * MiB;
constexpr size_t WS_END = 1005 * MiB;
constexpr size_t WS_HB = WS_Z;
constexpr size_t WS_HBS = WS_Z + 152 * MiB;
constexpr size_t WS_OBS = WS_Z + 170 * MiB;
constexpr size_t WS_OB = WS_MIX;
static_assert((size_t)RPCMAX * 512 <= 152 * MiB && WS_OBS + (size_t)(NTOK / NCH) * 2048 <= WS_MIX && WS_OB + (size_t)RPCMAX * 1024 <= WS_S5W, "MoE overlays");
constexpr int CW_BAR = 0;
constexpr int CW_CNT = 4096;
constexpr size_t WSM_L = 1 * MiB;
constexpr size_t WSM_PW = 0, WSM_GLU = 128 * 1024, WSM_UQ = 384 * 1024, WSM_UK = 640 * 1024, WSM_UV = 768 * 1024;
constexpr size_t TAB_ROPE = 0;
constexpr size_t TAB_S5 = 256 * 1024;
constexpr size_t TAB_RWT = 1536 * 1024;
constexpr size_t RT_TKEP = 0, RT_TKW = 2400000, RT_SLOT = 4800000;

__device__ __forceinline__ float bf2f(bf16 v) { return __uint_as_float(((unsigned)v) << 16); }
typedef __bf16 bf16x2_t __attribute__((ext_vector_type(2)));
__device__ __forceinline__ unsigned pk2(float lo, float hi) { const f32x2 v = {lo, hi}; return __builtin_bit_cast(unsigned, __builtin_convertvector(v, bf16x2_t)); }
__device__ __forceinline__ bf16 f2bf(float f) { return __builtin_bit_cast(unsigned short, (__bf16)f); }
template <int O> __device__ __forceinline__ float shx(float v) {
    return __int_as_float(__builtin_amdgcn_ds_swizzle(__float_as_int(v), (O << 10) | 0x1f)); }
__device__ __forceinline__ float rdl(float v, int l) { return __int_as_float(__builtin_amdgcn_readlane(__float_as_int(v), l)); }
__device__ __forceinline__ int rdli(int v, int l) { return __builtin_amdgcn_readlane(v, l); }
__device__ __forceinline__ float wave_sum(float v) {
    v += shx<1>(v); v += shx<2>(v); v += shx<4>(v); v += shx<8>(v); v += shx<16>(v);
    const auto r = __builtin_amdgcn_permlane32_swap(__float_as_uint(v), __float_as_uint(v), false, false);
    return __uint_as_float(r[0]) + __uint_as_float(r[1]);
}
__device__ __forceinline__ float wave_max(float v) {
    v = fmaxf(v, shx<1>(v)); v = fmaxf(v, shx<2>(v)); v = fmaxf(v, shx<4>(v)); v = fmaxf(v, shx<8>(v)); v = fmaxf(v, shx<16>(v));
    const auto r = __builtin_amdgcn_permlane32_swap(__float_as_uint(v), __float_as_uint(v), false, false);
    return fmaxf(__uint_as_float(r[0]), __uint_as_float(r[1]));
}
__device__ __forceinline__ float sigmoidf_(float x) { return 1.0f / (1.0f + __expf(-x)); }
__device__ __forceinline__ float siluf_(float x) { return x / (1.0f + __expf(-x)); }
__device__ __forceinline__ void unpack8(const u32x4 w, float (&v)[8]) {
    v[0] = __uint_as_float(w.x << 16); v[1] = __uint_as_float(w.x & 0xffff0000u);
    v[2] = __uint_as_float(w.y << 16); v[3] = __uint_as_float(w.y & 0xffff0000u);
    v[4] = __uint_as_float(w.z << 16); v[5] = __uint_as_float(w.z & 0xffff0000u);
    v[6] = __uint_as_float(w.w << 16); v[7] = __uint_as_float(w.w & 0xffff0000u);
}
__device__ __forceinline__ void lds_wait() { asm volatile("s_waitcnt lgkmcnt(0)" ::: "memory"); }

#define XB_TMO      128
#define XB_XCNT(j)  (256  + 64 * (j))
#define XB_XSUB(j)  (1280 + 64 * (j))
#define XB_XGEN(j)  (2304 + 64 * (j))
#define XB_TOP      3328
#define XB_TOPGEN   3392
#define XCD_BAR_WORDS 3456
#define XB_SPIN_CAP (1u << 22)
__device__ __forceinline__ unsigned xb_ld(unsigned* p)              { return __hip_atomic_load(p, __ATOMIC_RELAXED, __HIP_MEMORY_SCOPE_AGENT); }
__device__ __forceinline__ unsigned xb_add(unsigned* p, unsigned v) { return __hip_atomic_fetch_add(p, v, __ATOMIC_RELAXED, __HIP_MEMORY_SCOPE_AGENT); }
__device__ __forceinline__ unsigned xb_xcc_id() { return (unsigned)__builtin_amdgcn_s_getreg((3 << 11) | 20) & 0xFu; }
#define XB_SPIN(cond, bar) do { unsigned _sp = 0; while (cond) { __builtin_amdgcn_s_sleep(1); \
    if ((++_sp & 255u) == 0u) { if (xb_ld(&(bar)[XB_TMO])) break; if (_sp > XB_SPIN_CAP) { atomicAdd(&(bar)[XB_TMO], 1u); break; } } } } while (0)
struct XcdBarrier { unsigned* bar; unsigned x; volatile LAS unsigned* st; };
__device__ __forceinline__ XcdBarrier xcd_barrier_post(unsigned* bar, volatile LAS unsigned* st) {
    XcdBarrier b; b.bar = bar; b.x = xb_xcc_id(); b.st = st;
    if (threadIdx.x == 0) (void)xb_add(&bar[XB_XCNT(b.x)], 1u);
    return b;
}
__device__ __forceinline__ void xcd_barrier_complete(unsigned* bar, unsigned x, unsigned& nloc, unsigned& nx) {
    const unsigned G = gridDim.x * gridDim.y * gridDim.z;
    unsigned sum, cnt, mine, sp = 0u;
    for (;;) {
        sum = 0u; cnt = 0u; mine = 0u;
#pragma unroll
        for (unsigned j = 0; j < 16; ++j) { const unsigned c = xb_ld(&bar[XB_XCNT(j)]); sum += c; cnt += (c > 0u) ? 1u : 0u; mine = (j == x) ? c : mine; }
        if (sum == G) break;
        __builtin_amdgcn_s_sleep(1);
        if ((++sp & 255u) == 0u) { if (xb_ld(&bar[XB_TMO])) break; if (sp > XB_SPIN_CAP) { atomicAdd(&bar[XB_TMO], 1u); break; } }
    }
    nloc = mine > 0u ? mine : 1u; nx = cnt > 0u ? cnt : 1u;
}
__device__ __forceinline__ void xcd_barrier(const XcdBarrier& b) {
    asm volatile("s_waitcnt vmcnt(0)" ::: "memory");
    __syncthreads();
    if (threadIdx.x == 0) {
        unsigned* bar = b.bar;
        __builtin_amdgcn_s_waitcnt(0);
        unsigned nloc = b.st[0], nx = b.st[1];
        if (nloc == 0u) { xcd_barrier_complete(bar, b.x, nloc, nx); b.st[0] = nloc; b.st[1] = nx; }
        const unsigned old = xb_add(&bar[XB_XSUB(b.x)], 1u);
        const unsigned gen = old / nloc;
        if (old + 1u == (gen + 1u) * nloc) {
            __builtin_amdgcn_fence(__ATOMIC_RELEASE, "agent");
            asm volatile("s_waitcnt vmcnt(0)" ::: "memory");
            const unsigned og = xb_add(&bar[XB_TOP], 1u);
            const unsigned tg = og / nx;
            if (og + 1u == (tg + 1u) * nx) xb_add(&bar[XB_TOPGEN], 1u);
            else XB_SPIN(xb_ld(&bar[XB_TOPGEN]) == tg, bar);
            __builtin_amdgcn_fence(__ATOMIC_ACQUIRE, "agent");
            xb_add(&bar[XB_XGEN(b.x)], 1u);
            asm volatile("s_waitcnt vmcnt(0)" ::: "memory");
        } else {
            XB_SPIN(xb_ld(&bar[XB_XGEN(b.x)]) == gen, bar);
            __builtin_amdgcn_fence(__ATOMIC_ACQUIRE, "agent");
            asm volatile("s_waitcnt vmcnt(0)" ::: "memory");
        }
    }
    __syncthreads();
}

namespace pg8 {
constexpr int BM = 256, BK = 64, HALF = 128, HTB = HALF * BK * 2, STAGE_BYTES = 8 * HTB, NXCD = 8, WGM = 8;
__device__ __forceinline__ int lds_byte(int r, int c) { const int st = (r >> 4) * 2 + (c >> 5), rr = r & 15, cc = c & 31, ob = rr * 64 + cc * 2; return st * 1024 + (ob ^ (((ob >> 9) & 1) << 5)); }
__device__ __forceinline__ void stage_rc(int b, int& R, int& C) { const int st = b / 1024, sb = b % 1024, swz = sb ^ (((sb >> 9) & 1) << 5); R = (st >> 1) * 16 + swz / 64; C = (st & 1) * 32 + (swz % 64) / 2; }
__device__ __forceinline__ int perm32(int rho) { const int n = rho >> 4, i = rho & 15; return 8 * (i >> 2) + 4 * n + (i & 3); }

struct Unit { int pm, pn, e; const char* B; };

struct DenseOrder {
    int nM, nN, nwg, G, c; const char* Bt; size_t btile;
    __device__ __forceinline__ void init(int nM_, int nN_, int G_, int c_, const bf16* Bt_, int K) { nM = nM_; nN = nN_; nwg = nM * nN; G = G_; c = c_; Bt = (const char*)Bt_; btile = (size_t)256 * K * 2; }
    __device__ __forceinline__ bool next(int i, Unit& u) const {
        const long L = (long)i * G + c; if (L >= nwg) return false;
        int wgid = (int)L; { const int q = nwg / NXCD, r = nwg % NXCD, xcd = wgid % NXCD, off = wgid / NXCD; wgid = (xcd < r ? xcd * (q + 1) : r * (q + 1) + (xcd - r) * q) + off; }
        const int nig = WGM * nN, gid = wgid / nig, fm = gid * WGM, gsz = (nM - fm) < WGM ? (nM - fm) : WGM;
        u.pm = fm + ((wgid % nig) % gsz); u.pn = (wgid % nig) / gsz; u.e = 0; u.B = Bt + (size_t)u.pn * btile; return true;
    }
};
struct RowsDense { unsigned ldab; __device__ __forceinline__ unsigned off(const Unit& u, int r) const { return (unsigned)(u.pm * 256 + r) * ldab; } };
struct RowsGather { const int* list; unsigned ldab; __device__ __forceinline__ unsigned off(const Unit& u, int r) const { return (unsigned)list[u.pm * 256 + r] * ldab; } };

template <bool FP8, class Epi, class Sched, class Rows>
__device__ __forceinline__ void gemm_phase(LAS unsigned char* lds, const char* Abase, const int K, const Sched& S, const Rows& RW, const Epi& E) {
    int tid_ = threadIdx.x; asm volatile("" : "+v"(tid_));
    const int tid = tid_, wid = __builtin_amdgcn_readfirstlane(tid >> 6), lane = tid & 63, wr = wid >> 2, wc = wid & 3, fr = lane & 15, fq = lane >> 4;
    const int nt = K / BK;
    int sR[2]; unsigned sC[2], voffB[2];
#pragma unroll
    for (int i = 0; i < 2; ++i) { int R, C; stage_rc(tid * 16 + i * 8192, R, C); sR[i] = R; sC[i] = (unsigned)C * 2u; const int Rb = (R & ~31) + perm32(R & 31); voffB[i] = (unsigned)(Rb * K + C) * 2u; }
    const size_t kstep = (size_t)(BK * 2);
    const size_t hstepB = (size_t)HALF * K * 2;
    const unsigned ldsw = (unsigned)wid * 1024u;
    const int aoff = lds_byte(wr * 64 + fr, fq * 8), boff = lds_byte(wc * 32 + fr, fq * 8);
#define PG8_SA(b, h) (((b) * 2 + (h)) * HTB)
#define PG8_SB(b, h) ((4 + (b) * 2 + (h)) * HTB)
#define PG8_STAGE(bufoff, gbase, voff) do { const char* _gb = (const char*)(gbase); asm volatile("" : "+s"(_gb)); _Pragma("unroll") for (int _i = 0; _i < 2; ++_i) { unsigned _o = (voff)[_i]; asm volatile("" : "+v"(_o)); \
        __builtin_amdgcn_global_load_lds((const unsigned*)(_gb + _o), (LAS unsigned*)(lds + (bufoff) + ldsw + _i * 8192), 16, 0, 0); } } while (0)
#define PG8_LDA(dst, b, h) do { _Pragma("unroll") for (int m = 0; m < 4; ++m) dst[m] = PG8_CAT(*(const LAS i32x4*)(lds + PG8_SA(b, h) + aoff + m * 2048), *(const LAS i32x4*)(lds + PG8_SA(b, h) + aoff + m * 2048 + 1024)); } while (0)
#define PG8_LDB(dst, b, h) do { _Pragma("unroll") for (int n = 0; n < 2; ++n) dst[n] = PG8_CAT(*(const LAS i32x4*)(lds + PG8_SB(b, h) + boff + n * 2048), *(const LAS i32x4*)(lds + PG8_SB(b, h) + boff + n * 2048 + 1024)); } while (0)
#define PG8_CAT(x0, x1) __builtin_shufflevector((x0), (x1), 0, 1, 2, 3, 4, 5, 6, 7)
#define PG8_LO(x) __builtin_bit_cast(bf16x8, __builtin_shufflevector((x), (x), 0, 1, 2, 3))
#define PG8_HI(x) __builtin_bit_cast(bf16x8, __builtin_shufflevector((x), (x), 4, 5, 6, 7))
#define PG8_MMA(ai, bj, At, Bt) do { __builtin_amdgcn_s_setprio(1); \
        if (FP8) { _Pragma("unroll") for (int m = 0; m < 4; ++m) _Pragma("unroll") for (int n = 0; n < 2; ++n) \
            acc[ai][bj][m][n] = __builtin_amdgcn_mfma_scale_f32_16x16x128_f8f6f4(Bt[n], At[m], acc[ai][bj][m][n], 0, 0, 0, 0x7f7f7f7f, 0, 0x7f7f7f7f); } \
        else { _Pragma("unroll") for (int m = 0; m < 4; ++m) _Pragma("unroll") for (int n = 0; n < 2; ++n) { \
            acc[ai][bj][m][n] = __builtin_amdgcn_mfma_f32_16x16x32_bf16(PG8_LO(Bt[n]), PG8_LO(At[m]), acc[ai][bj][m][n], 0, 0, 0); \
            acc[ai][bj][m][n] = __builtin_amdgcn_mfma_f32_16x16x32_bf16(PG8_HI(Bt[n]), PG8_HI(At[m]), acc[ai][bj][m][n], 0, 0, 0); } } \
        __builtin_amdgcn_s_setprio(0); } while (0)
#define PG8_WAIT_V(n) asm volatile("s_waitcnt vmcnt(" #n ")" ::: "memory")
#define PG8_WAIT_L(n) asm volatile("s_waitcnt lgkmcnt(" #n ")" ::: "memory")
#define PG8_BAR __builtin_amdgcn_s_barrier()
#define PG8_SCHED __builtin_amdgcn_sched_barrier(0)
    Unit cur, nxt; int ui = 0;
    if (!S.next(0, cur)) return;
    f32x4 acc[2][2][4][2];
#pragma unroll
    for (int a = 0; a < 2; ++a)
#pragma unroll
        for (int b = 0; b < 2; ++b)
#pragma unroll
            for (int m = 0; m < 4; ++m)
#pragma unroll
                for (int n = 0; n < 2; ++n) acc[a][b][m][n] = (f32x4){0.f, 0.f, 0.f, 0.f};
    i32x8 At[4], B0[2], B1[2];
    unsigned oA0[2], oA1[2];
#pragma unroll
    for (int i = 0; i < 2; ++i) { oA0[i] = RW.off(cur, sR[i]) + sC[i]; oA1[i] = RW.off(cur, HALF + sR[i]) + sC[i]; }
    const char* cB = cur.B;
    PG8_STAGE(PG8_SB(0, 0), cB, voffB); PG8_STAGE(PG8_SB(0, 1), cB + hstepB, voffB); PG8_STAGE(PG8_SA(0, 0), Abase, oA0); PG8_STAGE(PG8_SA(0, 1), Abase, oA1);
    if (wr == 1) PG8_BAR;
    PG8_WAIT_V(2); PG8_BAR;
    PG8_STAGE(PG8_SB(1, 0), cB + kstep, voffB); PG8_STAGE(PG8_SA(1, 0), Abase + kstep, oA0); PG8_STAGE(PG8_SB(1, 1), cB + hstepB + kstep, voffB);
    PG8_WAIT_V(6); PG8_BAR;
    for (;;) {
        const bool has_next = S.next(ui + 1, nxt);
        unsigned gi0 = 0u, gi1 = 0u, gi2 = 0u, gi3 = 0u;
        if (has_next && RW.list) {
            int t2 = threadIdx.x; asm volatile("" : "+v"(t2)); int R0, C0, R1, C1; stage_rc(t2 * 16, R0, C0); stage_rc(t2 * 16 + 8192, R1, C1);
            const int* lb = RW.list + (size_t)nxt.pm * 256; const unsigned o0 = (unsigned)R0 * 4u, o1 = (unsigned)R1 * 4u, o2 = (unsigned)(HALF + R0) * 4u, o3 = (unsigned)(HALF + R1) * 4u;
            asm volatile("global_load_dword %0, %4, %8\n\tglobal_load_dword %1, %5, %8\n\tglobal_load_dword %2, %6, %8\n\tglobal_load_dword %3, %7, %8"
                         : "=&v"(gi0), "=&v"(gi1), "=&v"(gi2), "=&v"(gi3) : "v"(o0), "v"(o1), "v"(o2), "v"(o3), "s"(lb));
        }
#pragma unroll 1
        for (int t = 0; t < nt; t += 2) {
            const bool last = (t == nt - 2);
            const char* a1 = Abase + (size_t)(t + 1) * kstep;
            PG8_LDB(B0, 0, 0); PG8_LDB(B1, 0, 1); PG8_SCHED; PG8_LDA(At, 0, 0); PG8_STAGE(PG8_SA(1, 1), a1, oA1);
            PG8_WAIT_V(8); PG8_WAIT_L(0); PG8_BAR; PG8_MMA(0, 0, At, B0); PG8_MMA(0, 1, At, B1); PG8_BAR; PG8_SCHED;
            const char* a2; const char* b2;
            if (last) {
                if (has_next) {
                    int t2 = threadIdx.x; asm volatile("" : "+v"(t2));
#pragma unroll
                    for (int i = 0; i < 2; ++i) { int R, C; stage_rc(t2 * 16 + i * 8192, R, C);
                        if (RW.list) { asm volatile("" : "+v"(gi0), "+v"(gi1), "+v"(gi2), "+v"(gi3)); oA0[i] = (i ? gi1 : gi0) * RW.ldab + (unsigned)C * 2u; oA1[i] = (i ? gi3 : gi2) * RW.ldab + (unsigned)C * 2u; }
                        else { oA0[i] = (unsigned)(nxt.pm * 256 + R) * RW.ldab + (unsigned)C * 2u; oA1[i] = (unsigned)(nxt.pm * 256 + HALF + R) * RW.ldab + (unsigned)C * 2u; } }
                    cB = nxt.B;
                }
                a2 = Abase; b2 = cB;
            } else { a2 = Abase + (size_t)(t + 2) * kstep; b2 = cB + (size_t)(t + 2) * kstep; }
            const char* a3 = a2 + kstep; const char* b3 = b2 + kstep;
            PG8_LDA(At, 0, 1); PG8_STAGE(PG8_SB(0, 0), b2, voffB); PG8_STAGE(PG8_SB(0, 1), b2 + hstepB, voffB); PG8_STAGE(PG8_SA(0, 0), a2, oA0);
            PG8_WAIT_V(8); PG8_WAIT_L(0); PG8_BAR; PG8_MMA(1, 0, At, B0); PG8_MMA(1, 1, At, B1); PG8_BAR; PG8_SCHED;
            PG8_LDB(B0, 1, 0); PG8_LDB(B1, 1, 1); PG8_SCHED; PG8_LDA(At, 1, 0); PG8_STAGE(PG8_SA(0, 1), a2, oA1);
            PG8_WAIT_V(8); PG8_WAIT_L(0); PG8_BAR; PG8_MMA(0, 0, At, B0); PG8_MMA(0, 1, At, B1); PG8_BAR; PG8_SCHED;
            PG8_LDA(At, 1, 1); PG8_STAGE(PG8_SB(1, 0), b3, voffB); PG8_STAGE(PG8_SB(1, 1), b3 + hstepB, voffB); PG8_STAGE(PG8_SA(1, 0), a3, oA0);
            PG8_WAIT_V(8); PG8_WAIT_L(0); PG8_BAR; PG8_MMA(1, 0, At, B0); PG8_MMA(1, 1, At, B1); PG8_BAR; PG8_SCHED;
        }
        if (wr == 0) PG8_BAR;
        { Unit eu = cur; asm volatile("" : "+s"(eu.pm), "+s"(eu.pn)); int t3 = threadIdx.x; asm volatile("" : "+v"(t3)); E(acc, eu, wr, wc, t3 & 15, (t3 & 63) >> 4); }
        if (!has_next) break;
#pragma unroll
        for (int a = 0; a < 2; ++a)
#pragma unroll
            for (int b = 0; b < 2; ++b)
#pragma unroll
                for (int m = 0; m < 4; ++m)
#pragma unroll
                    for (int n = 0; n < 2; ++n) acc[a][b][m][n] = (f32x4){0.f, 0.f, 0.f, 0.f};
        cur = nxt; ++ui;
        if (wr == 1) PG8_BAR;
    }
    PG8_WAIT_V(0);
    PG8_BAR;
#undef PG8_SA
#undef PG8_SB
#undef PG8_STAGE
#undef PG8_LDA
#undef PG8_LDB
#undef PG8_MMA
#undef PG8_CAT
#undef PG8_LO
#undef PG8_HI
#undef PG8_WAIT_V
#undef PG8_WAIT_L
#undef PG8_BAR
#undef PG8_SCHED
}
}

struct Params { const float* in[42]; float* out; unsigned char* ws; int ph_lo, ph_hi; };
enum { I_X = 0, I_C, I_CTX, I_CCTX, I_ADAW, I_ADAB, I_N1G, I_N2G, I_WIN, I_WOUT, I_GLAW, I_GLAB, I_GLAG, I_CDW, I_CDB, I_CLG, I_CLB, I_CPW, I_CPB,
       I_S5LR, I_S5LI, I_S5DT, I_S5BR, I_S5BI, I_S5CR, I_S5CI, I_S5D, I_S5GW, I_S5GB, I_QNG, I_KVNG, I_WUQ, I_WUKV, I_RW, I_RB, I_MG, I_MU, I_MD, I_SG, I_SU, I_SD, I_FG };

typedef const __attribute__((address_space(4))) Params* KParams;
__device__ __forceinline__ KParams fresh_params() { KParams kp = (KParams)__builtin_amdgcn_kernarg_segment_ptr(); asm volatile("" : "+s"(kp)); return kp; }
struct Ctx {
    LAS unsigned char* lds;
    int tid, lane, wave, blk, G;
    unsigned char* ws;
};

__device__ __forceinline__ int mod_row(int r) { return r < NLAT ? (r >> 11) : 32; }

__device__ __forceinline__ unsigned pk4_fp8(float a, float b, float c2, float d) {
    int pk = __builtin_amdgcn_cvt_pk_fp8_f32(__builtin_amdgcn_fmed3f(a, -440.f, 440.f), __builtin_amdgcn_fmed3f(b, -440.f, 440.f), 0, false);
    pk = __builtin_amdgcn_cvt_pk_fp8_f32(__builtin_amdgcn_fmed3f(c2, -440.f, 440.f), __builtin_amdgcn_fmed3f(d, -440.f, 440.f), pk, true); return (unsigned)pk; }
template <bool F8 = false>
__device__ __forceinline__ void tr_item(const float* W, int ldw, int k0, int n0, bf16* dst, int ldk, const float* kscale, float sc, LAS float* scr, int lane) {
    float tv[32];
#pragma unroll
    for (int i = 0; i < 32; ++i) tv[i] = W[(size_t)(k0 + 2 * i + (lane >> 5)) * ldw + n0 + (lane & 31)];
#pragma unroll
    for (int i = 0; i < 32; ++i) { const int kk = 2 * i + (lane >> 5); float v = tv[i] * sc; if (kscale) v *= kscale[k0 + kk]; scr[kk * 33 + (lane & 31)] = v; }
    lds_wait();
    const int c = lane & 7;
#pragma unroll
    for (int j = 0; j < 4; ++j) { const int n = (lane >> 3) + 8 * j; const LAS float* s = scr + (8 * c) * 33 + n;
        if (F8) { u32x2 o; o.x = pk4_fp8(s[0 * 33], s[1 * 33], s[2 * 33], s[3 * 33]); o.y = pk4_fp8(s[4 * 33], s[5 * 33], s[6 * 33], s[7 * 33]); *(u32x2*)((unsigned char*)dst + (size_t)n * ldk + k0 + 8 * c) = o; }
        else { u32x4 o; o.x = pk2(s[0 * 33], s[1 * 33]); o.y = pk2(s[2 * 33], s[3 * 33]); o.z = pk2(s[4 * 33], s[5 * 33]); o.w = pk2(s[6 * 33], s[7 * 33]);
            *(u32x4*)(dst + (size_t)n * ldk + k0 + 8 * c) = o; } }
    lds_wait();
}
template <int KIND> __device__ __forceinline__ int tr_dst(int n0) {
    if (KIND == 0) return n0;
    if (KIND == 1) return n0 < 768 ? n0 : (n0 == 768 ? 1952 : n0 - 32);
    if (KIND == 2) { const int half = n0 >> 8, c = n0 & 255; return (c >> 7) * 256 + half * 128 + (c & 127); }
    if (KIND == 3) { const int head = n0 / 96, d0 = n0 % 96; return d0 < 64 ? head * 64 + d0 : 256 + head * 32; }
    if (KIND == 4) { const int head = n0 >> 7, d0 = n0 & 127; return d0 < 64 ? head * 64 + d0 : 256 + head * 64 + (d0 - 64); }
    if (KIND == 5) return (n0 >> 7) * 256 + (n0 & 127);
    if (KIND == 6) return (n0 >> 7) * 256 + 128 + (n0 & 127);
    return n0;
}
template <int KIND, bool F8 = false> __device__ __forceinline__ void tr_matrix(const Ctx& c, const float* W, int ldw, int K, int Nsrc, bf16* WT, int ldk, const float* kscale, float sc) {
    LAS float* scr = (LAS float*)(c.lds + c.wave * 8704);
    const int gw = c.blk * NWAVES + c.wave, NGW = c.G * NWAVES, ng = Nsrc / 32, items = (K / 64) * ng;
    for (int it = gw; it < items; it += NGW) { const int kb = it / ng, g = it % ng; tr_item<F8>(W, ldw, kb * 64, 32 * g, F8 ? (bf16*)((unsigned char*)WT + (size_t)tr_dst<KIND>(32 * g) * ldk) : WT + (size_t)tr_dst<KIND>(32 * g) * ldk, ldk, kscale, sc, scr, c.lane); }
}
__device__ __forceinline__ void zero_fill16(const Ctx& c, void* p, size_t bytes) {
    u32x4* q = (u32x4*)p; const size_t n = bytes / 16;
    for (size_t i = (size_t)c.blk * NTHR + c.tid; i < n; i += (size_t)c.G * NTHR) q[i] = (u32x4){0u, 0u, 0u, 0u};
}
__device__ __forceinline__ void sincos_r(float x, float& s, float& co) {
    const float n = rintf(x * 0.15915494309189535f);
    float r = fmaf(n, -6.28125f, x); r = fmaf(n, -1.9353071795864769e-3f, r);
    s = __sinf(r); co = __cosf(r);
}

__device__ __forceinline__ void prologue_moe_weights(const Ctx& c, KParams p, int l) {
    unsigned char* WGU8 = c.ws + WS_WMOE;
    unsigned char* WD8 = c.ws + WS_WMOE + (size_t)NE * 512 * 1024;
    LAS float* scr = (LAS float*)(c.lds + c.wave * 8704);
    const int gw = c.blk * NWAVES + c.wave, NGW = c.G * NWAVES;
    for (int it = gw; it < NE * 384; it += NGW) {
        const int e = it / 384, r = it % 384;
        if (r < 256) { const int up = r >> 7, q = r & 127, kb = q >> 3, g = q & 7;
            const float* W = p->in[up ? I_MU : I_MG] + ((size_t)l * NE + e) * 1024 * 256;
            const int nd = up ? tr_dst<6>(32 * g) : tr_dst<5>(32 * g);
            tr_item<true>(W, 256, kb * 64, 32 * g, (bf16*)(WGU8 + (size_t)e * 512 * 1024 + (size_t)nd * 1024), 1024, nullptr, 64.f, scr, c.lane);
        } else { const int q = r - 256, kb = q >> 5, g = q & 31;
            const float* W = p->in[I_MD] + ((size_t)l * NE + e) * 256 * 1024;
            tr_item<true>(W, 1024, kb * 64, 32 * g, (bf16*)(WD8 + (size_t)e * 1024 * 256 + (size_t)(32 * g) * 256), 256, nullptr, 64.f, scr, c.lane);
        }
    }
}

__device__ __forceinline__ void prologue(const Ctx& c, KParams p) {
    float* MOD = (float*)(c.ws + WS_MOD);
    {
        const int u = c.G - 1 - c.blk;
        if (u < 96) {
            LAS float* sc = (LAS float*)(c.lds + 72 * 1024);
            LAS float* part = (LAS float*)c.lds;
            const int l = u / 48, kq = c.tid >> 7, cj = c.tid & 127, col = (u % 48) * 128 + cj;
            const float* W = p->in[I_ADAW] + (size_t)l * 1024 * 6144;
            float acc[33];
#pragma unroll
            for (int b = 0; b < 33; ++b) acc[b] = 0.f;
            for (int j = 0; j < 4; ++j) {
                __syncthreads();
                for (int i = c.tid; i < 4 * 33 * 64; i += NTHR) { const int q = i / (33 * 64), r = i % (33 * 64), b = r >> 6, kk = r & 63, k = 256 * q + 64 * j + kk; const float v = b < 32 ? p->in[I_C][b * 1024 + k] : p->in[I_CCTX][k]; sc[i] = siluf_(v); }
                __syncthreads();
                const float* wp = W + (size_t)(256 * kq + 64 * j) * 6144 + col; const LAS float* sq = sc + kq * 33 * 64;
#pragma unroll 8
                for (int kk = 0; kk < 64; ++kk) { const float w = wp[(size_t)kk * 6144];
#pragma unroll
                    for (int b = 0; b < 33; ++b) acc[b] = fmaf(sq[b * 64 + kk], w, acc[b]); }
            }
#pragma unroll
            for (int b = 0; b < 33; ++b) part[(kq * 33 + b) * 128 + cj] = acc[b];
            __syncthreads();
            for (int i = c.tid; i < 33 * 128; i += NTHR) { const int b = i >> 7, cc = i & 127, gc = (u % 48) * 128 + cc;
                MOD[((size_t)l * 33 + b) * 6144 + gc] = (part[(0 * 33 + b) * 128 + cc] + part[(1 * 33 + b) * 128 + cc]) + (part[(2 * 33 + b) * 128 + cc] + part[(3 * 33 + b) * 128 + cc]) + p->in[I_ADAB][l * 6144 + gc]; }
            __syncthreads();
        }
    }
    {
        float* ROPE = (float*)(c.ws + WS_TAB + TAB_ROPE);
        for (int i = c.blk * NTHR + c.tid; i < 2048 * 16; i += c.G * NTHR) { const int t = i >> 4, ax = (i >> 3) & 1, f = i & 7;
            const float pos = (float)(ax == 0 ? (t >> 6) : (t & 63)); const float inv = __expf(-(float)f * (9.210340371976184f / 8.0f));
            float s, co; sincos_r(pos * inv, s, co); ROPE[i * 2] = co; ROPE[i * 2 + 1] = s; }
        bf16* RWT = (bf16*)(c.ws + WS_TAB + TAB_RWT);
        for (int i = c.blk * NTHR + c.tid; i < 2 * 64 * 1024; i += c.G * NTHR) { const int l = i >> 16, n = (i >> 10) & 63, k = i & 1023; const float wv = p->in[I_RW][((size_t)l * 1024 + k) * 64 + n];
            const bf16 hi = f2bf(wv); RWT[(size_t)(l * 2) * 65536 + n * 1024 + k] = hi; RWT[(size_t)(l * 2 + 1) * 65536 + n * 1024 + k] = f2bf(wv - bf2f(hi)); }
        float* S5T = (float*)(c.ws + WS_TAB + TAB_S5);
        for (int i = c.blk * NTHR + c.tid; i < 2 * 2 * 16 * 64; i += c.G * NTHR) {
            const int pp = i & 63, g = (i >> 6) & 15, ld = i >> 10;
            const float lr = p->in[I_S5LR][i], li = p->in[I_S5LI][i], dt = __expf(p->in[I_S5DT][ld * 16 + g]);
            const float mag = __expf(lr * dt); float s, co; sincos_r(li * dt, s, co);
            const float are = mag * co, aim = mag * s, den = lr * lr + li * li;
            const float fre = ((are - 1.f) * lr + aim * li) / den, fim = (aim * lr - (are - 1.f) * li) / den;
            float* T = S5T + (size_t)i * 66; T[0] = are; T[1] = aim;
            { float* PW = (float*)(c.ws + WS_S5P) + (size_t)i * 34; float pr = 1.f, pi = 0.f;
              for (int e = 0; e <= 16; ++e) { PW[2 * e] = pr; PW[2 * e + 1] = pi; const float nr = pr * are - pi * aim, ni = pr * aim + pi * are; pr = nr; pi = ni; } }
            for (int ch = 0; ch < 16; ++ch) { const float br = p->in[I_S5BR][(size_t)i * 16 + ch], bi = p->in[I_S5BI][(size_t)i * 16 + ch];
                T[2 + ch] = fre * br - fim * bi; T[18 + ch] = fre * bi + fim * br;
                T[34 + ch] = p->in[I_S5CR][((size_t)(ld * 16 + g) * 16 + ch) * 64 + pp]; T[50 + ch] = p->in[I_S5CI][((size_t)(ld * 16 + g) * 16 + ch) * 64 + pp]; }
        }
    }
    for (int l = 0; l < 2; ++l) {
        bf16* WIN = (bf16*)(c.ws + WS_WIN) + (size_t)l * 2048 * 1024;
        tr_matrix<1>(c, p->in[I_WIN] + (size_t)l * 1024 * 1984, 1984, 1024, 1984, WIN, 1024, nullptr, 1.f);
        zero_fill16(c, WIN + (size_t)1984 * 1024, (size_t)64 * 1024 * 2);
        tr_matrix<0>(c, p->in[I_WOUT] + (size_t)l * 1024 * 1024, 1024, 1024, 1024, (bf16*)(c.ws + WS_WOUT) + (size_t)l * 1024 * 1024, 1024, nullptr, 1.f);
        unsigned char* sm = c.ws + WS_WSM + (size_t)l * WSM_L;
        tr_matrix<0>(c, p->in[I_CPW] + (size_t)l * 256 * 256, 256, 256, 256, (bf16*)(sm + WSM_PW), 256, nullptr, 1.f);
        tr_matrix<2>(c, p->in[I_S5GW] + (size_t)l * 256 * 512, 512, 256, 512, (bf16*)(sm + WSM_GLU), 256, nullptr, 1.f);
        tr_matrix<3>(c, p->in[I_WUQ] + (size_t)l * 256 * 384, 384, 256, 384, (bf16*)(sm + WSM_UQ), 256, p->in[I_QNG] + l * 256, 0.14724445f  );
        zero_fill16(c, (bf16*)(sm + WSM_UQ) + (size_t)384 * 256, (size_t)128 * 256 * 2);
        zero_fill16(c, sm + WSM_UK, (size_t)512 * 256 * 2);
    }
    for (int l = 0; l < 2; ++l) {
        bf16* WSGU = (bf16*)(c.ws + WS_WSH) + (size_t)l * (512 * 1024 + 1024 * 256); bf16* WSD = WSGU + 512 * 1024;
        tr_matrix<5, true>(c, p->in[I_SG] + (size_t)l * 1024 * 256, 256, 1024, 256, WSGU, 1024, nullptr, 64.f);
        tr_matrix<6, true>(c, p->in[I_SU] + (size_t)l * 1024 * 256, 256, 1024, 256, WSGU, 1024, nullptr, 64.f);
        tr_matrix<0, true>(c, p->in[I_SD] + (size_t)l * 256 * 1024, 1024, 256, 1024, (bf16*)((unsigned char*)WSGU + 512 * 1024), 256, nullptr, 64.f);
    }
    prologue_moe_weights(c, p, 0);
}
__device__ __forceinline__ void prologue_s5_weights(const Ctx& c, KParams p) {
    const float* S5T = (const float*)(c.ws + WS_TAB + TAB_S5); const float* S5P = (const float*)(c.ws + WS_S5P);
    LAS float* pw = (LAS float*)c.lds;
    LAS float* bb = pw + 2 * 17 * 64 * 2;
    LAS float* cc = bb + 2 * 64 * 16 * 2;
    LAS float* kt = cc + 2 * 16 * 64 * 2;
    for (int u = c.blk; u < 32; u += c.G) {
        const int l = u >> 4, g = u & 15;
        __syncthreads();
        for (int i = c.tid; i < 2 * 64; i += NTHR) { const int dir = i >> 6, pp = i & 63; const size_t row = (size_t)((l * 2 + dir) * 16 + g) * 64 + pp; const float* T = S5T + row * 66; const float* PW = S5P + row * 34;
            for (int e = 0; e <= 16; ++e) { pw[((dir * 17 + e) * 64 + pp) * 2] = PW[2 * e]; pw[((dir * 17 + e) * 64 + pp) * 2 + 1] = PW[2 * e + 1]; }
            for (int ch = 0; ch < 16; ++ch) { bb[((dir * 64 + pp) * 16 + ch) * 2] = T[2 + ch]; bb[((dir * 64 + pp) * 16 + ch) * 2 + 1] = T[18 + ch]; cc[((dir * 16 + ch) * 64 + pp) * 2] = T[34 + ch]; cc[((dir * 16 + ch) * 64 + pp) * 2 + 1] = T[50 + ch]; } }
        __syncthreads();
        for (int i = c.tid; i < 2 * 16 * 256; i += NTHR) { const int dir = i >> 12, tau = (i >> 8) & 15, c1 = (i >> 4) & 15, c0 = i & 15; float s = 0.f;
            for (int pp = 0; pp < 64; ++pp) { const float cr = cc[((dir * 16 + c1) * 64 + pp) * 2], ci = cc[((dir * 16 + c1) * 64 + pp) * 2 + 1], pr = pw[((dir * 17 + tau) * 64 + pp) * 2], pi = pw[((dir * 17 + tau) * 64 + pp) * 2 + 1];
                const float wr_ = cr * pr - ci * pi, wi_ = cr * pi + ci * pr; s += wr_ * bb[((dir * 64 + pp) * 16 + c0) * 2] - wi_ * bb[((dir * 64 + pp) * 16 + c0) * 2 + 1]; }
            kt[i] = s; }
        __syncthreads();
        bf16* B1 = (bf16*)(c.ws + WS_S5W) + (size_t)(l * 16 + g) * 256 * 256;
        bf16* B2 = (bf16*)(c.ws + WS_S5W) + (size_t)32 * 256 * 256 + (size_t)(l * 16 + g) * 256 * 512;
        const float* dsk = p->in[I_S5D] + l * 256 + g * 16;
        for (int i = c.tid; i < 256 * 256; i += NTHR) { const int n = i >> 8, k = i & 255, dir = n >> 7, ri = (n >> 6) & 1, pp = n & 63, s = k >> 4, ch = k & 15, e = dir ? s : 15 - s;
            const float pr = pw[((dir * 17 + e) * 64 + pp) * 2], pi = pw[((dir * 17 + e) * 64 + pp) * 2 + 1], br = bb[((dir * 64 + pp) * 16 + ch) * 2], bi = bb[((dir * 64 + pp) * 16 + ch) * 2 + 1];
            B1[i] = f2bf(ri ? pr * bi + pi * br : pr * br - pi * bi); }
        for (int i = c.tid; i < 256 * 512; i += NTHR) { const int n = i >> 9, k = i & 511, t = n >> 4, c1 = n & 15; float v;
            if (k < 256) { const int s = k >> 4, c0 = k & 15; v = 0.f; if (s <= t) v += kt[((0 * 16 + (t - s)) * 16 + c1) * 16 + c0]; if (s >= t) v += kt[((1 * 16 + (s - t)) * 16 + c1) * 16 + c0]; if (s == t && c0 == c1) v += dsk[c0]; }
            else { const int q = k - 256, dir = q >> 7, ri = (q >> 6) & 1, pp = q & 63, e = dir ? 16 - t : t + 1;
                const float cr = cc[((dir * 16 + c1) * 64 + pp) * 2], ci = cc[((dir * 16 + c1) * 64 + pp) * 2 + 1], pr = pw[((dir * 17 + e) * 64 + pp) * 2], pi = pw[((dir * 17 + e) * 64 + pp) * 2 + 1];
                v = ri ? -(cr * pi + ci * pr) : (cr * pr - ci * pi); }
            B2[i] = f2bf(v); }
    }
    __syncthreads();
}
__device__ __forceinline__ void prologue2(const Ctx& c, KParams p) {
    prologue_s5_weights(c, p);
    for (int l = 0; l < 2; ++l) { unsigned char* sm = c.ws + WS_WSM + (size_t)l * WSM_L;
        tr_matrix<4>(c, p->in[I_WUKV] + (size_t)l * 128 * 512, 512, 128, 512, (bf16*)(sm + WSM_UK), 256, p->in[I_KVNG] + l * 128, 1.f); }
}

__device__ __forceinline__ void norm_row(const float* xrow, const float* gain, const float* sh, const float* sc, bf16* orow, int lane, f32x4 (&v)[4]) {
    float ss = 0.f;
#pragma unroll
    for (int j = 0; j < 4; ++j) { v[j] = *(const f32x4*)(xrow + 4 * lane + 256 * j); ss += (v[j].x * v[j].x + v[j].y * v[j].y) + (v[j].z * v[j].z + v[j].w * v[j].w); }
    const float rstd = rsqrtf(wave_sum(ss) * (1.f / 1024.f) + EPS);
#pragma unroll
    for (int j = 0; j < 4; ++j) { const int cc = 4 * lane + 256 * j; const f32x4 g = *(const f32x4*)(gain + cc), s1 = *(const f32x4*)(sc + cc), s0 = *(const f32x4*)(sh + cc);
        v[j] = v[j] * rstd * g * (s1 + 1.0f) + s0;
        u32x2 o; o.x = pk2(v[j].x, v[j].y); o.y = pk2(v[j].z, v[j].w); *(u32x2*)(orow + cc) = o; }
}
__device__ __forceinline__ void norm_row_add(const float* xrow, const bf16* drow, float* xout, const float* gain, const float* sh, const float* sc, unsigned char* orow8, int lane, f32x4 (&v)[4]) {
    float ss = 0.f; u32x2 dl[4];
#pragma unroll
    for (int j = 0; j < 4; ++j) { v[j] = *(const f32x4*)(xrow + 4 * lane + 256 * j); dl[j] = *(const u32x2*)(drow + 4 * lane + 256 * j); }
#pragma unroll
    for (int j = 0; j < 4; ++j) { v[j] += (f32x4){__uint_as_float(dl[j].x << 16), __uint_as_float(dl[j].x & 0xffff0000u), __uint_as_float(dl[j].y << 16), __uint_as_float(dl[j].y & 0xffff0000u)};
        *(f32x4*)(xout + 4 * lane + 256 * j) = v[j]; ss += (v[j].x * v[j].x + v[j].y * v[j].y) + (v[j].z * v[j].z + v[j].w * v[j].w); }
    const float rstd = rsqrtf(wave_sum(ss) * (1.f / 1024.f) + EPS);
#pragma unroll
    for (int j = 0; j < 4; ++j) { const int cc = 4 * lane + 256 * j; const f32x4 g = *(const f32x4*)(gain + cc), s1 = *(const f32x4*)(sc + cc), s0 = *(const f32x4*)(sh + cc);
        v[j] = v[j] * rstd * g * (s1 + 1.0f) + s0;
        *(unsigned*)(orow8 + cc) = pk4_fp8(v[j].x * 4.f, v[j].y * 4.f, v[j].z * 4.f, v[j].w * 4.f); }
}
__device__ __forceinline__ void phase_norm1(const Ctx& c, KParams p, int l) {
    const float* MOD = (const float*)(c.ws + WS_MOD) + (size_t)l * 33 * 6144;
    const float* xl = l == 0 ? p->in[I_X] : p->out; const float* xc = l == 0 ? p->in[I_CTX] : (const float*)(c.ws + WS_XC);
    bf16* H = (bf16*)(c.ws + WS_H); const float* gain = p->in[I_N1G] + l * DM;
    const int gw = c.blk * NWAVES + c.wave, NGW = c.G * NWAVES, lane = c.lane;
    for (int r0 = gw; r0 < NTOK; r0 += 2 * NGW) {
        f32x4 v[2][4]; float ss[2];
#pragma unroll
        for (int k = 0; k < 2; ++k) { const int r = r0 + k * NGW < NTOK ? r0 + k * NGW : r0; const float* xr = r < NLAT ? xl + (size_t)r * DM : xc + (size_t)(r - NLAT) * DM;
#pragma unroll
            for (int j = 0; j < 4; ++j) v[k][j] = *(const f32x4*)(xr + 4 * lane + 256 * j); }
#pragma unroll
        for (int k = 0; k < 2; ++k) { ss[k] = 0.f;
#pragma unroll
            for (int j = 0; j < 4; ++j) ss[k] += (v[k][j].x * v[k][j].x + v[k][j].y * v[k][j].y) + (v[k][j].z * v[k][j].z + v[k][j].w * v[k][j].w); }
#pragma unroll
        for (int k = 0; k < 2; ++k) { const int r = r0 + k * NGW; if (r < NTOK) { const float rstd = rsqrtf(wave_sum(ss[k]) * (1.f / 1024.f) + EPS); const float* m = MOD + (size_t)mod_row(r) * 6144; bf16* orow = H + (size_t)r * DM;
#pragma unroll
            for (int j = 0; j < 4; ++j) { const int cc = 4 * lane + 256 * j; const f32x4 g = *(const f32x4*)(gain + cc), s1 = *(const f32x4*)(m + 1024 + cc), s0 = *(const f32x4*)(m + cc);
                const f32x4 y = v[k][j] * rstd * g * (s1 + 1.0f) + s0; u32x2 o; o.x = pk2(y.x, y.y); o.y = pk2(y.z, y.w); *(u32x2*)(orow + cc) = o; } } }
    }
}

#define EPI_ARGS const f32x4 (&acc)[2][2][4][2], const pg8::Unit& u, int wr, int wc, int fr, int fq
#define EPI_ROWS for (int ai = 0; ai < 2; ++ai) _Pragma("unroll") for (int m = 0; m < 4; ++m)
struct EpiBf16 {
    bf16* O; int ldo;
    __device__ __forceinline__ void operator()(EPI_ARGS) const {
        const int r0 = u.pm * 256 + wr * 64 + fr, c0 = u.pn * 256 + wc * 32 + 8 * fq;
#pragma unroll
        EPI_ROWS { bf16* rp = O + (size_t)(r0 + ai * 128 + m * 16) * ldo + c0;
#pragma unroll
            for (int bj = 0; bj < 2; ++bj) { const f32x4 a = acc[ai][bj][m][0], b = acc[ai][bj][m][1]; u32x4 w; w.x = pk2(a.x, a.y); w.y = pk2(a.z, a.w); w.z = pk2(b.x, b.y); w.w = pk2(b.z, b.w); *(u32x4*)(rp + bj * 128) = w; } asm volatile("" ::: "memory"); }
    }
};
struct EpiInProj {
    bf16* O; bf16* UP; bf16* GVT;
    __device__ __forceinline__ void operator()(EPI_ARGS) const {
        const int r0 = u.pm * 256 + wr * 64 + fr, c0 = u.pn * 256 + wc * 32 + 8 * fq;
#pragma unroll
        EPI_ROWS { const int row = r0 + ai * 128 + m * 16; bf16* rp = O + (size_t)row * ZW + c0;
            const int crow = row < NLAT ? (row >> 11) * 144 + 16 + ((row & 2047) >> 4) : ((row - NLAT) >> 8) * 144 + (((row - NLAT) & 255) >> 4);
#pragma unroll
            for (int bj = 0; bj < 2; ++bj) { const f32x4 a = acc[ai][bj][m][0], b = acc[ai][bj][m][1]; u32x4 w; w.x = pk2(a.x, a.y); w.y = pk2(a.z, a.w); w.z = pk2(b.x, b.y); w.w = pk2(b.z, b.w); *(u32x4*)(rp + bj * 128) = w;
                if (u.pn == 5) { const int g = 8 * bj + 2 * wc + (fq >> 1); *(u32x4*)(UP + ((size_t)g * 4608 + crow) * 512 + fr * 16 + 8 * (fq & 1)) = w; }
                if (u.pn == 1) { const int col = 128 * bj + 32 * wc + 8 * fq, bb = row < NLAT ? (row >> 11) : ((row - NLAT) >> 8), kk = row < NLAT ? 256 + (row & 2047) : ((row - NLAT) & 255);
                    bf16* dst = GVT + ((size_t)(bb * 4 + (col >> 6)) * 64 + (col & 63)) * 2304 + (kk & ~15) + 8 * ((fr >> 2) & 1) + 4 * (fr >> 3) + (fr & 3);
#pragma unroll
                    for (int n = 0; n < 2; ++n)
#pragma unroll
                        for (int i = 0; i < 4; ++i) dst[(size_t)(4 * n + i) * 2304] = f2bf(acc[ai][bj][m][n][i]); } }
            asm volatile("" ::: "memory"); }
    }
};
struct EpiS5X {
    bf16* XE;
    __device__ __forceinline__ void operator()(EPI_ARGS) const {
        const int r0 = u.pm * 256 + wr * 64 + fr, c0 = wc * 32 + 8 * fq;
#pragma unroll
        EPI_ROWS { bf16* rp = XE + (size_t)(r0 + ai * 128 + m * 16) * 256 + c0;
#pragma unroll
            for (int bj = 0; bj < 2; ++bj) { const f32x4 a = acc[ai][bj][m][0], b = acc[ai][bj][m][1]; u32x4 w; w.x = pk2(a.x, a.y); w.y = pk2(a.z, a.w); w.z = pk2(b.x, b.y); w.w = pk2(b.z, b.w); *(u32x4*)(rp + bj * 128) = w; }
            asm volatile("" ::: "memory"); }
    }
};
struct EpiS5Y {
    bf16* Y;
    __device__ __forceinline__ void operator()(EPI_ARGS) const {
        const int r0 = u.pm * 256 + wr * 64 + fr;
#pragma unroll
        EPI_ROWS { const int grow = r0 + ai * 128 + m * 16; const int g = grow / 4608, rem = grow - g * 4608, b = rem / 144, ci = rem - b * 144;
            const int tok0 = ci < 16 ? NLAT + b * CTXL + ci * 16 : b * SEQ + (ci - 16) * 16;
#pragma unroll
            for (int bj = 0; bj < 2; ++bj) { const int t = 8 * bj + 2 * wc + (fq >> 1); const f32x4 a = acc[ai][bj][m][0], bq = acc[ai][bj][m][1]; u32x4 w; w.x = pk2(a.x, a.y); w.y = pk2(a.z, a.w); w.z = pk2(bq.x, bq.y); w.w = pk2(bq.z, bq.w);
                *(u32x4*)(Y + (size_t)(tok0 + t) * 256 + g * 16 + 8 * (fq & 1)) = w; }
            asm volatile("" ::: "memory"); }
    }
};
struct EpiOB8 {
    unsigned char* OB; float sc;
    __device__ __forceinline__ void operator()(EPI_ARGS) const {
        const int r0 = u.pm * 256 + wr * 64 + fr;
#pragma unroll
        EPI_ROWS { unsigned char* rp = OB + (size_t)(r0 + ai * 128 + m * 16) * 1024 + u.pn * 256 + (wc * 4 + fq) * 16; u32x4 w;
#pragma unroll
            for (int bj = 0; bj < 2; ++bj)
#pragma unroll
                for (int n = 0; n < 2; ++n) { const f32x4 a = acc[ai][bj][m][n] * sc; int pk = 0;
                    pk = __builtin_amdgcn_cvt_pk_fp8_f32(__builtin_amdgcn_fmed3f(a.x, -440.f, 440.f), __builtin_amdgcn_fmed3f(a.y, -440.f, 440.f), pk, false);
                    pk = __builtin_amdgcn_cvt_pk_fp8_f32(__builtin_amdgcn_fmed3f(a.z, -440.f, 440.f), __builtin_amdgcn_fmed3f(a.w, -440.f, 440.f), pk, true); w[2 * bj + n] = (unsigned)pk; }
            *(u32x4*)rp = w; asm volatile("" ::: "memory"); }
    }
};
struct EpiBf16S {
    bf16* O; int ldo; float sc;
    __device__ __forceinline__ void operator()(EPI_ARGS) const {
        const int r0 = u.pm * 256 + wr * 64 + fr, c0 = u.pn * 256 + wc * 32 + 8 * fq;
#pragma unroll
        EPI_ROWS { bf16* rp = O + (size_t)(r0 + ai * 128 + m * 16) * ldo + c0;
#pragma unroll
            for (int bj = 0; bj < 2; ++bj) { const f32x4 a = acc[ai][bj][m][0] * sc, b = acc[ai][bj][m][1] * sc; u32x4 w; w.x = pk2(a.x, a.y); w.y = pk2(a.z, a.w); w.z = pk2(b.x, b.y); w.w = pk2(b.z, b.w); *(u32x4*)(rp + bj * 128) = w; }
            asm volatile("" ::: "memory"); }
    }
};
struct EpiBiasBf16 {
    bf16* O; int ldo; const float* bias;
    __device__ __forceinline__ void operator()(EPI_ARGS) const {
        const int r0 = u.pm * 256 + wr * 64 + fr, c0 = u.pn * 256 + wc * 32 + 8 * fq;
        f32x4 bv[2][2];
#pragma unroll
        for (int bj = 0; bj < 2; ++bj) { bv[bj][0] = *(const f32x4*)(bias + c0 + bj * 128); bv[bj][1] = *(const f32x4*)(bias + c0 + bj * 128 + 4); }
        __builtin_amdgcn_s_waitcnt(0x0F70);
#pragma unroll
        EPI_ROWS { bf16* rp = O + (size_t)(r0 + ai * 128 + m * 16) * ldo + c0;
#pragma unroll
            for (int bj = 0; bj < 2; ++bj) { const f32x4 a = acc[ai][bj][m][0] + bv[bj][0], b = acc[ai][bj][m][1] + bv[bj][1]; u32x4 w; w.x = pk2(a.x, a.y); w.y = pk2(a.z, a.w); w.z = pk2(b.x, b.y); w.w = pk2(b.z, b.w); *(u32x4*)(rp + bj * 128) = w; } asm volatile("" ::: "memory"); }
    }
};
struct EpiGluSig {
    bf16* O; int ldo; const float* bias;
    __device__ __forceinline__ void operator()(EPI_ARGS) const {
        const int r0 = u.pm * 256 + wr * 64 + fr, c0 = u.pn * 128 + wc * 32 + 8 * fq;
        f32x4 b1[2], b2[2];
#pragma unroll
        for (int n = 0; n < 2; ++n) { b1[n] = *(const f32x4*)(bias + c0 + 4 * n); b2[n] = *(const f32x4*)(bias + 256 + c0 + 4 * n); }
        __builtin_amdgcn_s_waitcnt(0x0F70);
#pragma unroll
        EPI_ROWS { bf16* rp = O + (size_t)(r0 + ai * 128 + m * 16) * ldo + c0; float o[8];
#pragma unroll
            for (int n = 0; n < 2; ++n)
#pragma unroll
                for (int i = 0; i < 4; ++i) o[4 * n + i] = (acc[ai][0][m][n][i] + b1[n][i]) * sigmoidf_(acc[ai][1][m][n][i] + b2[n][i]);
            u32x4 w; w.x = pk2(o[0], o[1]); w.y = pk2(o[2], o[3]); w.z = pk2(o[4], o[5]); w.w = pk2(o[6], o[7]); *(u32x4*)rp = w; asm volatile("" ::: "memory"); }
    }
};
struct EpiSwiglu {
    unsigned char* O; int ldo; float sc;
    __device__ __forceinline__ void operator()(EPI_ARGS) const {
        const int r0 = u.pm * 256 + wr * 64 + fr, c0 = u.pn * 128 + wc * 32 + 8 * fq;
#pragma unroll
        EPI_ROWS { unsigned char* rp = O + (size_t)(r0 + ai * 128 + m * 16) * ldo + c0; float o[8];
#pragma unroll
            for (int n = 0; n < 2; ++n)
#pragma unroll
                for (int i = 0; i < 4; ++i) o[4 * n + i] = siluf_(acc[ai][0][m][n][i] * sc) * (acc[ai][1][m][n][i] * (sc * 16.0f));
            u32x2 w; w.x = pk4_fp8(o[0], o[1], o[2], o[3]); w.y = pk4_fp8(o[4], o[5], o[6], o[7]); *(u32x2*)rp = w; asm volatile("" ::: "memory"); }
    }
};
struct EpiQ {
    bf16* Q; const float* RS;
    __device__ __forceinline__ void operator()(EPI_ARGS) const {
        const int r0 = u.pm * 256 + wr * 64 + fr; float rq[8];
#pragma unroll
        for (int g = 0; g < 8; ++g) rq[g] = RS[(size_t)(r0 + (g >> 2) * 128 + (g & 3) * 16) * 2];
        __builtin_amdgcn_s_waitcnt(0x0F70);
#pragma unroll
        EPI_ROWS { const int row = r0 + ai * 128 + m * 16; const float rs = rq[ai * 4 + m]; bf16* rp = Q + (size_t)row * 384;
            if (u.pn == 0) {
#pragma unroll
                for (int bj = 0; bj < 2; ++bj) { const int head = 2 * bj + (wc >> 1), d = 32 * (wc & 1) + 8 * fq; const f32x4 a = acc[ai][bj][m][0] * rs, b = acc[ai][bj][m][1] * rs;
                    u32x4 w; w.x = pk2(a.x, a.y); w.y = pk2(a.z, a.w); w.z = pk2(b.x, b.y); w.w = pk2(b.z, b.w); *(u32x4*)(rp + head * 96 + d) = w; }
            } else { const f32x4 a = acc[ai][0][m][0] * rs, b = acc[ai][0][m][1] * rs;
                u32x4 w; w.x = pk2(a.x, a.y); w.y = pk2(a.z, a.w); w.z = pk2(b.x, b.y); w.w = pk2(b.z, b.w); *(u32x4*)(rp + wc * 96 + 64 + 8 * fq) = w; }
            asm volatile("" ::: "memory"); }
    }
};
struct EpiKV {
    bf16* Kb; bf16* VT; const float* RS;
    __device__ __forceinline__ void operator()(EPI_ARGS) const {
        const int r0 = u.pm * 256 + wr * 64 + fr;
        const int p16 = 8 * ((fr >> 2) & 1) + 4 * (fr >> 3) + (fr & 3); float rkv[8];
#pragma unroll
        for (int g = 0; g < 8; ++g) rkv[g] = RS[(size_t)(r0 + (g >> 2) * 128 + (g & 3) * 16) * 2 + 1];
        __builtin_amdgcn_s_waitcnt(0x0F70);
#pragma unroll
        EPI_ROWS { const int row = r0 + ai * 128 + m * 16; const float rk = rkv[ai * 4 + m];
            if (u.pn == 0) {
#pragma unroll
                for (int bj = 0; bj < 2; ++bj) { const int head = 2 * bj + (wc >> 1), d = 32 * (wc & 1) + 8 * fq; const f32x4 a = acc[ai][bj][m][0] * rk, b = acc[ai][bj][m][1] * rk;
                    u32x4 w; w.x = pk2(a.x, a.y); w.y = pk2(a.z, a.w); w.z = pk2(b.x, b.y); w.w = pk2(b.z, b.w);
                    *(u32x4*)(Kb + (size_t)row * 384 + head * 96 + d) = w; }
            } else {
                const int bb = row < NLAT ? (row >> 11) : ((row - NLAT) >> 8); const int kk = row < NLAT ? (row & 2047) : 2048 + ((row - NLAT) & 255);
                const int pos = (kk & ~15) + p16;
#pragma unroll
                for (int bj = 0; bj < 2; ++bj) { const int head = 2 * bj + (wc >> 1), d = 32 * (wc & 1) + 8 * fq; bf16* dst = VT + ((size_t)((bb * 4 + head) * 64 + d)) * 2304 + pos;
#pragma unroll
                    for (int n = 0; n < 2; ++n)
#pragma unroll
                        for (int i = 0; i < 4; ++i) dst[(size_t)(4 * n + i) * 2304] = f2bf(acc[ai][bj][m][n][i] * rk); }
            }
            asm volatile("" ::: "memory"); }
    }
};
struct EpiDelta {
    bf16* D; const float* MODg;
    __device__ __forceinline__ void operator()(EPI_ARGS) const {
        const int rt = u.pm * 256; const float* g = MODg + (size_t)(rt < NLAT ? (rt >> 11) : 32) * 6144;
        const int r0 = rt + wr * 64 + fr, c0 = u.pn * 256 + wc * 32 + 8 * fq;
        f32x4 gv[2][2];
#pragma unroll
        for (int bj = 0; bj < 2; ++bj) { gv[bj][0] = *(const f32x4*)(g + c0 + bj * 128); gv[bj][1] = *(const f32x4*)(g + c0 + bj * 128 + 4); }
        __builtin_amdgcn_s_waitcnt(0x0F70);
#pragma unroll
        EPI_ROWS { bf16* rp = D + (size_t)(r0 + ai * 128 + m * 16) * DM + c0;
#pragma unroll
            for (int bj = 0; bj < 2; ++bj) { const f32x4 a = gv[bj][0] * acc[ai][bj][m][0], b = gv[bj][1] * acc[ai][bj][m][1]; u32x4 w; w.x = pk2(a.x, a.y); w.y = pk2(a.z, a.w); w.z = pk2(b.x, b.y); w.w = pk2(b.z, b.w); *(u32x4*)(rp + bj * 128) = w; }
            asm volatile("" ::: "memory"); }
    }
};

__device__ __forceinline__ int seq_row(int b, int dir, int pos) {
    if (pos < CTXL) return NLAT + b * CTXL + (dir ? CTXL - 1 - pos : pos);
    const int t = pos - CTXL; return b * SEQ + (dir ? SEQ - 1 - t : t);
}
__device__ __forceinline__ void phase_gla(const Ctx& c, KParams p, int l) {
    const bf16* Z = (const bf16*)(c.ws + WS_Z); const bf16* GVT = (const bf16*)(c.ws + WS_GVT); bf16* OG = (bf16*)(c.ws + WS_T1);
    const int w = c.wave, tid = c.tid;
    LAS float* wtab = (LAS float*)c.lds;
    LAS float* DD = (LAS float*)(c.lds + 4096);
    LAS unsigned char* RW = c.lds + 8192 + w * 13824;
    LAS float* LA = (LAS float*)RW;
    LAS unsigned char* KTT = RW + 9216;
    for (int u = c.blk; u < 256; u += c.G) {
        const int b = u >> 3, h = (u >> 1) & 3, dir = u & 1;
        __syncthreads();
        { const float* wa = p->in[I_GLAW] + ((size_t)(l * 2 + dir) * 16) * 128 + h * 32; wtab[tid] = wa[(tid >> 5) * 128 + (tid & 31)]; if (tid < 32) wtab[512 + tid] = p->in[I_GLAB][(l * 2 + dir) * 128 + h * 32 + tid]; }
        float Sst[4] = {0.f, 0.f, 0.f, 0.f};
        __syncthreads();
        for (int gi = 0; gi < 5; ++gi) {
            const int pc = gi * 8 + w; const bool active = pc < 36;
            int lane_ = c.lane; asm volatile("" : "+v"(lane_));
            const int r = lane_ & 31, hh = lane_ >> 5;
            const int p16 = 8 * ((r >> 2) & 1) + 4 * ((r & 15) >> 3) + (r & 3);
            const int pos0 = (r & 16) + p16, pos1 = 32 + pos0;
            bf16x8 qd[2][2]; f32x16 oacc[2][2]; int row0 = 0;
            if (active) {
                int kk0;
                if (dir == 0) { if (pc < 4) { row0 = NLAT + b * CTXL + pc * 64; kk0 = pc * 64; } else { row0 = b * SEQ + (pc - 4) * 64; kk0 = 256 + (pc - 4) * 64; } }
                else { if (pc < 4) { row0 = NLAT + b * CTXL + (3 - pc) * 64; kk0 = (3 - pc) * 64; } else { row0 = b * SEQ + (35 - pc) * 64; kk0 = 256 + (35 - pc) * 64; } }
#pragma unroll
                for (int ib = 0; ib < 2; ++ib) { const bf16* zr = Z + (size_t)(row0 + 32 * ib + r) * ZW; float al[16]; { const u32x4 a0 = *(const u32x4*)(zr + ZAF + dir * 16), a1 = *(const u32x4*)(zr + ZAF + dir * 16 + 8); float t8[8]; unpack8(a0, t8);
#pragma unroll
                        for (int j = 0; j < 8; ++j) al[j] = t8[j];
                        unpack8(a1, t8);
#pragma unroll
                        for (int j = 0; j < 8; ++j) al[8 + j] = t8[j]; }
#pragma unroll
                    for (int ks = 0; ks < 2; ++ks) { float za[8]; { const f32x4 b0 = *(const LAS f32x4*)(wtab + 512 + 16 * ks + 8 * hh), b1 = *(const LAS f32x4*)(wtab + 512 + 16 * ks + 8 * hh + 4);
                            za[0] = b0.x; za[1] = b0.y; za[2] = b0.z; za[3] = b0.w; za[4] = b1.x; za[5] = b1.y; za[6] = b1.z; za[7] = b1.w; }
#pragma unroll
                        for (int j = 0; j < 16; ++j) { const f32x4 w0 = *(const LAS f32x4*)(wtab + j * 32 + 16 * ks + 8 * hh), w1 = *(const LAS f32x4*)(wtab + j * 32 + 16 * ks + 8 * hh + 4);
                            za[0] = fmaf(al[j], w0.x, za[0]); za[1] = fmaf(al[j], w0.y, za[1]); za[2] = fmaf(al[j], w0.z, za[2]); za[3] = fmaf(al[j], w0.w, za[3]);
                            za[4] = fmaf(al[j], w1.x, za[4]); za[5] = fmaf(al[j], w1.y, za[5]); za[6] = fmaf(al[j], w1.z, za[6]); za[7] = fmaf(al[j], w1.w, za[7]); }
                        float la[8];
#pragma unroll
                        for (int e = 0; e < 8; ++e) la[e] = (fminf(za[e], 0.f) - __logf(1.f + __expf(-fabsf(za[e])))) * 0.0625f;
                        *(LAS f32x4*)(LA + (32 * ib + r) * 36 + 16 * ks + 8 * hh) = (f32x4){la[0], la[1], la[2], la[3]}; *(LAS f32x4*)(LA + (32 * ib + r) * 36 + 16 * ks + 8 * hh + 4) = (f32x4){la[4], la[5], la[6], la[7]}; } }
                lds_wait();
                { float bend; float v[32], s = 0.f;
#pragma unroll
                  for (int qq = 0; qq < 32; ++qq) { const int q = 32 * hh + qq, i = dir ? 63 - q : q; v[qq] = LA[i * 36 + r]; s += v[qq]; }
                  const auto sw = __builtin_amdgcn_permlane32_swap(__float_as_uint(s), __float_as_uint(s), false, false);
                  const float h0 = __uint_as_float(sw[0]), h1 = __uint_as_float(sw[1]); bend = h0 + h1;
                  float run = hh ? h0 : 0.f;
#pragma unroll
                  for (int qq = 0; qq < 32; ++qq) { const int q = 32 * hh + qq, i = dir ? 63 - q : q; run += v[qq]; LA[i * 36 + r] = run; }
                  if (hh == 0) DD[w * 32 + r] = __expf(bend); }
                lds_wait();
                bf16x8 ki[2][2];
#pragma unroll
                for (int ib = 0; ib < 2; ++ib) { const bf16* zr = Z + (size_t)(row0 + 32 * ib + r) * ZW;
#pragma unroll
                    for (int ks = 0; ks < 2; ++ks) { const int dk0 = 16 * ks + 8 * hh; float q8[8], k8[8], b8[8]; unpack8(*(const u32x4*)(zr + ZQ + h * 32 + dk0), q8); unpack8(*(const u32x4*)(zr + ZK + h * 32 + dk0), k8);
                        { const f32x4 x0 = *(const LAS f32x4*)(LA + (32 * ib + r) * 36 + dk0), x1 = *(const LAS f32x4*)(LA + (32 * ib + r) * 36 + dk0 + 4); b8[0] = x0.x; b8[1] = x0.y; b8[2] = x0.z; b8[3] = x0.w; b8[4] = x1.x; b8[5] = x1.y; b8[6] = x1.z; b8[7] = x1.w; }
                        float qo[8], ko[8];
#pragma unroll
                        for (int e = 0; e < 8; ++e) { const float eb = __expf(b8[e]), ieb = 1.f / eb; qo[e] = q8[e] * 0.17677669529663687f * eb; ko[e] = k8[e] * ieb;
                            *(LAS bf16*)(KTT + ((dk0 + e) * 72 + (ib ? pos1 : pos0)) * 2) = f2bf(ko[e] * DD[w * 32 + dk0 + e]); }
                        u32x4 wq, wk; wq.x = pk2(qo[0], qo[1]); wq.y = pk2(qo[2], qo[3]); wq.z = pk2(qo[4], qo[5]); wq.w = pk2(qo[6], qo[7]); wk.x = pk2(ko[0], ko[1]); wk.y = pk2(ko[2], ko[3]); wk.z = pk2(ko[4], ko[5]); wk.w = pk2(ko[6], ko[7]);
                        qd[ib][ks] = __builtin_bit_cast(bf16x8, wq); ki[ib][ks] = __builtin_bit_cast(bf16x8, wk); } }
                bf16x8 vt[2][4];
#pragma unroll
                for (int db = 0; db < 2; ++db)
#pragma unroll
                    for (int s4 = 0; s4 < 4; ++s4) vt[db][s4] = *(const bf16x8*)(GVT + ((size_t)(b * 4 + h) * 64 + 32 * db + r) * 2304 + kk0 + 16 * s4 + 8 * hh);
                f32x16 zero16;
#pragma unroll
                for (int i = 0; i < 16; ++i) zero16[i] = 0.f;
                f32x16 a00 = __builtin_amdgcn_mfma_f32_32x32x16_bf16(ki[0][0], qd[0][0], zero16, 0, 0, 0); a00 = __builtin_amdgcn_mfma_f32_32x32x16_bf16(ki[0][1], qd[0][1], a00, 0, 0, 0);
                f32x16 a11 = __builtin_amdgcn_mfma_f32_32x32x16_bf16(ki[1][0], qd[1][0], zero16, 0, 0, 0); a11 = __builtin_amdgcn_mfma_f32_32x32x16_bf16(ki[1][1], qd[1][1], a11, 0, 0, 0);
                f32x16 aof;
                if (dir == 0) { aof = __builtin_amdgcn_mfma_f32_32x32x16_bf16(ki[0][0], qd[1][0], zero16, 0, 0, 0); aof = __builtin_amdgcn_mfma_f32_32x32x16_bf16(ki[0][1], qd[1][1], aof, 0, 0, 0); }
                else { aof = __builtin_amdgcn_mfma_f32_32x32x16_bf16(ki[1][0], qd[0][0], zero16, 0, 0, 0); aof = __builtin_amdgcn_mfma_f32_32x32x16_bf16(ki[1][1], qd[0][1], aof, 0, 0, 0); }
#pragma unroll
                for (int i = 0; i < 16; ++i) { const int j = (i & 3) + 8 * (i >> 2) + 4 * hh; const bool keep = dir ? (j >= r) : (j <= r); a00[i] = keep ? a00[i] : 0.f; a11[i] = keep ? a11[i] : 0.f; }
#define GLA_P(X, s) ({ u32x4 w_; w_.x = pk2((X)[8 * (s)], (X)[8 * (s) + 1]); w_.y = pk2((X)[8 * (s) + 2], (X)[8 * (s) + 3]); w_.z = pk2((X)[8 * (s) + 4], (X)[8 * (s) + 5]); w_.w = pk2((X)[8 * (s) + 6], (X)[8 * (s) + 7]); __builtin_bit_cast(bf16x8, w_); })
                const bf16x8 p00a = GLA_P(a00, 0), p00b = GLA_P(a00, 1), p11a = GLA_P(a11, 0), p11b = GLA_P(a11, 1), pofa = GLA_P(aof, 0), pofb = GLA_P(aof, 1);
#pragma unroll
                for (int db = 0; db < 2; ++db) {
                    f32x16 o0 = __builtin_amdgcn_mfma_f32_32x32x16_bf16(vt[db][0], p00a, zero16, 0, 0, 0); o0 = __builtin_amdgcn_mfma_f32_32x32x16_bf16(vt[db][1], p00b, o0, 0, 0, 0);
                    f32x16 o1 = __builtin_amdgcn_mfma_f32_32x32x16_bf16(vt[db][2], p11a, zero16, 0, 0, 0); o1 = __builtin_amdgcn_mfma_f32_32x32x16_bf16(vt[db][3], p11b, o1, 0, 0, 0);
                    if (dir == 0) { o1 = __builtin_amdgcn_mfma_f32_32x32x16_bf16(vt[db][0], pofa, o1, 0, 0, 0); o1 = __builtin_amdgcn_mfma_f32_32x32x16_bf16(vt[db][1], pofb, o1, 0, 0, 0); }
                    else { o0 = __builtin_amdgcn_mfma_f32_32x32x16_bf16(vt[db][2], pofa, o0, 0, 0, 0); o0 = __builtin_amdgcn_mfma_f32_32x32x16_bf16(vt[db][3], pofb, o0, 0, 0, 0); }
                    oacc[db][0] = o0; oacc[db][1] = o1; }
#undef GLA_P
                lds_wait();
                bf16x8 kf[4];
#pragma unroll
                for (int s4 = 0; s4 < 4; ++s4) kf[s4] = *(const LAS bf16x8*)(KTT + (r * 72 + 16 * s4 + 8 * hh) * 2);
#pragma unroll
                for (int db = 0; db < 2; ++db) { f32x16 uu = __builtin_amdgcn_mfma_f32_32x32x16_bf16(vt[db][0], kf[0], zero16, 0, 0, 0);
#pragma unroll
                    for (int s4 = 1; s4 < 4; ++s4) uu = __builtin_amdgcn_mfma_f32_32x32x16_bf16(vt[db][s4], kf[s4], uu, 0, 0, 0);
#pragma unroll
                    for (int i = 0; i < 16; ++i) LA[(32 * db + (i & 3) + 8 * (i >> 2) + 4 * hh) * 32 + r] = uu[i]; }
            }
            __syncthreads();
            const int dv2 = tid >> 3, dk4 = (tid & 7) * 4;
            f32x4 ur[8], dr[8];
#pragma unroll
            for (int cc = 0; cc < 8; ++cc) { ur[cc] = *(const LAS f32x4*)((LAS float*)(c.lds + 8192 + cc * 13824) + dv2 * 32 + dk4); dr[cc] = *(const LAS f32x4*)(DD + cc * 32 + dk4); }
            __syncthreads();
#pragma unroll
            for (int cc = 0; cc < 8; ++cc) if (gi * 8 + cc < 36) { u32x2 sp; sp.x = pk2(Sst[0], Sst[1]); sp.y = pk2(Sst[2], Sst[3]); *(LAS u32x2*)(c.lds + 8192 + cc * 13824 + (dv2 * 40 + dk4) * 2) = sp;
                Sst[0] = fmaf(dr[cc].x, Sst[0], ur[cc].x); Sst[1] = fmaf(dr[cc].y, Sst[1], ur[cc].y); Sst[2] = fmaf(dr[cc].z, Sst[2], ur[cc].z); Sst[3] = fmaf(dr[cc].w, Sst[3], ur[cc].w); }
            __syncthreads();
            if (active) {
#pragma unroll
                for (int db = 0; db < 2; ++db) { const bf16x8 s0 = *(const LAS bf16x8*)(RW + ((32 * db + r) * 40 + 8 * hh) * 2), s1 = *(const LAS bf16x8*)(RW + ((32 * db + r) * 40 + 16 + 8 * hh) * 2);
#pragma unroll
                    for (int ib = 0; ib < 2; ++ib) { oacc[db][ib] = __builtin_amdgcn_mfma_f32_32x32x16_bf16(s0, qd[ib][0], oacc[db][ib], 0, 0, 0); oacc[db][ib] = __builtin_amdgcn_mfma_f32_32x32x16_bf16(s1, qd[ib][1], oacc[db][ib], 0, 0, 0); } }
#pragma unroll
                for (int ib = 0; ib < 2; ++ib) { bf16* orow = OG + ((size_t)dir * NTOK + row0 + 32 * ib + r) * 256 + h * 64 + 4 * hh;
#pragma unroll
                    for (int db = 0; db < 2; ++db)
#pragma unroll
                        for (int g4 = 0; g4 < 4; ++g4) { u32x2 wv; wv.x = pk2(oacc[db][ib][4 * g4], oacc[db][ib][4 * g4 + 1]); wv.y = pk2(oacc[db][ib][4 * g4 + 2], oacc[db][ib][4 * g4 + 3]); *(u32x2*)(orow + 32 * db + 8 * g4) = wv; } }
                lds_wait();
            }
        }
    }
    __syncthreads();
}
__device__ __forceinline__ void phase_gla_final(const Ctx& c, KParams p, int l, int nrows) {
    const bf16* Z = (const bf16*)(c.ws + WS_Z); const bf16* OG = (const bf16*)(c.ws + WS_T1); bf16* MIX = (bf16*)(c.ws + WS_MIX);
    const int gw = c.blk * NWAVES + c.wave, NGW = c.G * NWAVES; const f32x4 g = *(const f32x4*)(p->in[I_GLAG] + l * 256 + 4 * c.lane);
    for (int r0 = gw; r0 < nrows; r0 += 4 * NGW) {
        u32x2 of[4], ob[4], rg[4];
#pragma unroll
        for (int k = 0; k < 4; ++k) { const int r = r0 + k * NGW; of[k] = ob[k] = rg[k] = (u32x2){0u, 0u};
            if (r < nrows) { of[k] = *(const u32x2*)(OG + (size_t)r * 256 + 4 * c.lane); ob[k] = *(const u32x2*)(OG + ((size_t)NTOK + r) * 256 + 4 * c.lane); rg[k] = *(const u32x2*)(Z + (size_t)r * ZW + ZR + 4 * c.lane); } }
#pragma unroll
        for (int k = 0; k < 4; ++k) { const int r = r0 + k * NGW;
            f32x4 o = (f32x4){__uint_as_float(of[k].x << 16) + __uint_as_float(ob[k].x << 16), __uint_as_float(of[k].x & 0xffff0000u) + __uint_as_float(ob[k].x & 0xffff0000u),
                              __uint_as_float(of[k].y << 16) + __uint_as_float(ob[k].y << 16), __uint_as_float(of[k].y & 0xffff0000u) + __uint_as_float(ob[k].y & 0xffff0000u)};
            float ss = (o.x * o.x + o.y * o.y) + (o.z * o.z + o.w * o.w);
            ss += shx<1>(ss); ss += shx<2>(ss); ss += shx<4>(ss); ss += shx<8>(ss);
            const float rstd = rsqrtf(ss * (1.f / 64.f) + EPS);
            const float g0 = __uint_as_float(rg[k].x << 16), g1 = __uint_as_float(rg[k].x & 0xffff0000u), g2 = __uint_as_float(rg[k].y << 16), g3 = __uint_as_float(rg[k].y & 0xffff0000u);
            u32x2 w; w.x = pk2(o.x * rstd * g.x * siluf_(g0), o.y * rstd * g.y * siluf_(g1)); w.y = pk2(o.z * rstd * g.z * siluf_(g2), o.w * rstd * g.w * siluf_(g3));
            if (r < nrows) *(u32x2*)(MIX + (size_t)r * DM + 4 * c.lane) = w; }
    }
}

__device__ __forceinline__ void phase_conv1(const Ctx& c, KParams p, int l, bool with_ctx) {
    const bf16* Z = (const bf16*)(c.ws + WS_Z); bf16* CV = (bf16*)(c.ws + WS_CV);
    constexpr int TT = 64, HR = TT + 30;
    LAS float* glu = (LAS float*)c.lds;
    LAS float* dws = glu + HR * 256;
    for (int i = c.tid; i < 31 * 256; i += NTHR) dws[i] = p->in[I_CDW][(size_t)l * 31 * 256 + i];
    const int ntiles = with_ctx ? 1024 + 128 : 1024;
    const f32x4 dwb = *(const f32x4*)(p->in[I_CDB] + l * 256 + 4 * c.lane), lg = *(const f32x4*)(p->in[I_CLG] + l * 256 + 4 * c.lane), lb = *(const f32x4*)(p->in[I_CLB] + l * 256 + 4 * c.lane);
    for (int tile = c.blk; tile < ntiles; tile += c.G) {
        int rowbase, t0, slen;
        if (tile < 1024) { const int b = tile >> 5; rowbase = b * SEQ; t0 = (tile & 31) * TT; slen = SEQ; } else { const int q = tile - 1024, b = q >> 2; rowbase = NLAT + b * CTXL; t0 = (q & 3) * TT; slen = CTXL; }
        __syncthreads();
        u32x2 ra[12], rg[12];
#pragma unroll
        for (int k = 0; k < 12; ++k) { const int idx = c.tid + k * NTHR, j = idx >> 6, c4 = (idx & 63) * 4, t = t0 - 15 + j; ra[k] = (u32x2){0u, 0u}; rg[k] = (u32x2){0u, 0u};
            if (idx < HR * 64 && t >= 0 && t < slen) { const bf16* zr = Z + (size_t)(rowbase + t) * ZW; ra[k] = *(const u32x2*)(zr + ZCA + c4); rg[k] = *(const u32x2*)(zr + ZCG + c4); } }
#pragma unroll
        for (int k = 0; k < 12; ++k) { const int idx = c.tid + k * NTHR, j = idx >> 6, c4 = (idx & 63) * 4; f32x4 v;
            v.x = __uint_as_float(ra[k].x << 16) * sigmoidf_(__uint_as_float(rg[k].x << 16)); v.y = __uint_as_float(ra[k].x & 0xffff0000u) * sigmoidf_(__uint_as_float(rg[k].x & 0xffff0000u));
            v.z = __uint_as_float(ra[k].y << 16) * sigmoidf_(__uint_as_float(rg[k].y << 16)); v.w = __uint_as_float(ra[k].y & 0xffff0000u) * sigmoidf_(__uint_as_float(rg[k].y & 0xffff0000u));
            if (idx < HR * 64) *(LAS f32x4*)(glu + j * 256 + c4) = v; }
        __syncthreads();
        for (int q = 0; q < 8; ++q) { const int i = c.wave * 8 + q; f32x4 a = dwb;
#pragma unroll
            for (int j = 0; j < 31; ++j) a += *(const LAS f32x4*)(glu + (i + j) * 256 + 4 * c.lane) * *(const LAS f32x4*)(dws + j * 256 + 4 * c.lane);
            const float mu = wave_sum((a.x + a.y) + (a.z + a.w)) * (1.f / 256.f); const f32x4 dlt = a - mu;
            const float var = wave_sum((dlt.x * dlt.x + dlt.y * dlt.y) + (dlt.z * dlt.z + dlt.w * dlt.w)) * (1.f / 256.f); const float rstd = rsqrtf(var + EPS);
            const f32x4 y = dlt * rstd * lg + lb;
            u32x2 w; w.x = pk2(siluf_(y.x), siluf_(y.y)); w.y = pk2(siluf_(y.z), siluf_(y.w));
            *(u32x2*)(CV + (size_t)(rowbase + t0 + i) * 256 + 4 * c.lane) = w; }
    }
    __syncthreads();
}

__device__ __forceinline__ void phase_s5_carry(const Ctx& c, int l) {
    const bf16* XE = (const bf16*)(c.ws + WS_Y5); bf16* UP = (bf16*)(c.ws + WS_UP); const float* S5P = (const float*)(c.ws + WS_S5P);
    for (int i = c.blk * NTHR + c.tid; i < NB * 2 * 16 * 64; i += c.G * NTHR) {
        const int pp = i & 63, g = (i >> 6) & 15, dir = (i >> 10) & 1, b = i >> 11;
        const float* PW = S5P + ((size_t)((l * 2 + dir) * 16 + g) * 64 + pp) * 34 + 32; const float ar = PW[0], ai = PW[1];
        const size_t rbase = (size_t)g * 4608 + (size_t)b * 144; float xr = 0.f, xi = 0.f;
        for (int s0 = 0; s0 < 144; s0 += 8) {
            float er[8], ei[8];
#pragma unroll
            for (int q = 0; q < 8; ++q) { const int s = s0 + q; const int ci = dir == 0 ? s : (s < 16 ? 15 - s : 159 - s); const bf16* xe = XE + (rbase + ci) * 256 + dir * 128 + pp; er[q] = bf2f(xe[0]); ei[q] = bf2f(xe[64]); }
#pragma unroll
            for (int q = 0; q < 8; ++q) { const int s = s0 + q; const int ci = dir == 0 ? s : (s < 16 ? 15 - s : 159 - s); bf16* up = UP + (rbase + ci) * 512 + 256 + dir * 128 + pp; up[0] = f2bf(xr); up[64] = f2bf(xi);
                const float nr = ar * xr - ai * xi + er[q], ni = ar * xi + ai * xr + ei[q]; xr = nr; xi = ni; }
        }
    }
}

__device__ __forceinline__ void phase_mla_prep(const Ctx& c, KParams p) {
    const bf16* Z = (const bf16*)(c.ws + WS_Z); float* RS = (float*)(c.ws + WS_RS); bf16* Kb = (bf16*)(c.ws + WS_H) + (size_t)NTOK * 384; const float* ROPE = (const float*)(c.ws + WS_TAB + TAB_ROPE);
    const int gw = c.blk * NWAVES + c.wave, NGW = c.G * NWAVES, lane = c.lane, d = lane & 31;
    for (int r0 = gw; r0 < NTOK; r0 += 4 * NGW) {
        u32x2 q4[4]; unsigned k2[4]; bf16 xr[4]; f32x2 cs[4];
#pragma unroll
        for (int k = 0; k < 4; ++k) { const int r = r0 + k * NGW; q4[k] = (u32x2){0u, 0u}; k2[k] = 0u; xr[k] = 0; cs[k] = (f32x2){1.f, 0.f};
            if (r < NTOK) { const bf16* zr = Z + (size_t)r * ZW; q4[k] = *(const u32x2*)(zr + ZCQ + 4 * lane); k2[k] = *(const unsigned*)(zr + ZCKV + 2 * lane); xr[k] = zr[ZKR + d];
                if (r < NLAT) cs[k] = *(const f32x2*)(ROPE + (((r & 2047) * 2 + (d >> 4)) * 8 + (d & 7)) * 2); } }
#pragma unroll
        for (int k = 0; k < 4; ++k) { const int r = r0 + k * NGW;
            const float a0 = __uint_as_float(q4[k].x << 16), a1 = __uint_as_float(q4[k].x & 0xffff0000u), a2 = __uint_as_float(q4[k].y << 16), a3 = __uint_as_float(q4[k].y & 0xffff0000u);
            const float b0 = __uint_as_float(k2[k] << 16), b1 = __uint_as_float(k2[k] & 0xffff0000u);
            const float sq = wave_sum((a0 * a0 + a1 * a1) + (a2 * a2 + a3 * a3)), sk = wave_sum(b0 * b0 + b1 * b1);
            const float x = bf2f(xr[k]); const float px = shx<8>(x);
            const float o = (d & 8) ? fmaf(x, cs[k].x, px * cs[k].y) : fmaf(x, cs[k].x, -px * cs[k].y);
            if (r < NTOK) { if (lane == 0) { RS[(size_t)r * 2] = rsqrtf(sq * (1.f / 256.f) + EPS); RS[(size_t)r * 2 + 1] = rsqrtf(sk * (1.f / 128.f) + EPS); }
                const bf16 ob = f2bf(o); bf16* kr = Kb + (size_t)r * 384 + 64 + d; if (lane < 32) { kr[0] = ob; kr[96] = ob; kr[192] = ob; kr[288] = ob; } } }
    }
}
__device__ __forceinline__ void phase_attn(const Ctx& c, bool with_ctx) {
    const bf16* Qb = (const bf16*)(c.ws + WS_H); const bf16* Kb = Qb + (size_t)NTOK * 384; const bf16* VT = Kb + (size_t)NTOK * 384; bf16* MIX = (bf16*)(c.ws + WS_MIX);
    constexpr int KROW = 208, VROW = 144, KBUF = 64 * KROW, VBUF = 64 * VROW;
    LAS unsigned char* Kt = c.lds; LAS unsigned char* Vt = c.lds + 2 * KBUF;
    const int lane = c.lane, ln = lane & 31, hh = lane >> 5, tid = c.tid;
    const int nunits = with_ctx ? 1152 : 1024;
    for (int L = c.blk; L < nunits; L += c.G) {
        int u = L;
        if (c.G == 256 && L < 1024) { const int r = L >> 8, x = L & 7, j = (L & 255) >> 3; u = ((r * 32 + x * 4 + (j >> 3)) << 3) | (j & 7); }
        int b, h, qrow0, kt0, nkt;
        if (u < 1024) { b = u >> 5; h = (u >> 3) & 3; qrow0 = b * SEQ + (u & 7) * 256; kt0 = 0; nkt = 36; } else { const int q = u - 1024; b = q >> 2; h = q & 3; qrow0 = NLAT + b * CTXL; kt0 = 32; nkt = 4; }
        const bf16* vtb = VT + (size_t)((b * 4 + h) * 64) * 2304;
        bf16x8 qf[6];
        { const bf16* qr = Qb + (size_t)(qrow0 + 32 * c.wave + ln) * 384 + h * 96 + 8 * hh;
#pragma unroll
          for (int ks = 0; ks < 6; ++ks) qf[ks] = *(const bf16x8*)(qr + 16 * ks); }
        if (u < 1024) {
            const float* ROPE = (const float*)(c.ws + WS_TAB + TAB_ROPE) + (size_t)((qrow0 + 32 * c.wave + ln) & 2047) * 32;
#pragma unroll
            for (int ax = 0; ax < 2; ++ax) { const u32x4 own = __builtin_bit_cast(u32x4, qf[4 + ax]); u32x4 oth, res;
#pragma unroll
                for (int i = 0; i < 4; ++i) { const auto sw = __builtin_amdgcn_permlane32_swap(own[i], own[i], false, false); oth[i] = hh ? sw[0] : sw[1]; }
#pragma unroll
                for (int i = 0; i < 4; ++i) { const f32x4 cs = *(const f32x4*)(ROPE + ax * 16 + 4 * i);
                    const float v0 = __uint_as_float(own[i] << 16), v1 = __uint_as_float(own[i] & 0xffff0000u), p0 = __uint_as_float(oth[i] << 16), p1 = __uint_as_float(oth[i] & 0xffff0000u);
                    const float sg = hh ? 1.f : -1.f; res[i] = pk2(fmaf(v0, cs.x, sg * p0 * cs.y), fmaf(v1, cs.z, sg * p1 * cs.w)); }
                qf[4 + ax] = __builtin_bit_cast(bf16x8, res); } }
        f32x16 oacc[2];
#pragma unroll
        for (int i = 0; i < 16; ++i) { oacc[0][i] = 0.f; oacc[1][i] = 0.f; }
        float mrun = 0.f, lsum = 0.f;
        const int k0key = tid / 12, k0pt = tid % 12, k1key = (512 + tid) / 12, k1pt = (512 + tid) % 12; const bool k1on = tid < 256;
        u32x4 sk0, sk1 = (u32x4){0u, 0u, 0u, 0u}, sv;
        auto key_row = [&](int kt, int j) -> int { const int kk = kt * 64 + j; return kk < 2048 ? b * SEQ + kk : NLAT + b * CTXL + (kk - 2048); };
#define ATT_LOAD(kt) do { sk0 = *(const u32x4*)(Kb + (size_t)key_row((kt), k0key) * 384 + h * 96 + k0pt * 8); if (k1on) sk1 = *(const u32x4*)(Kb + (size_t)key_row((kt), k1key) * 384 + h * 96 + k1pt * 8); \
        sv = *(const u32x4*)(vtb + (size_t)(tid >> 3) * 2304 + (kt) * 64 + (tid & 7) * 8); } while (0)
#define ATT_STORE(buf) do { *(LAS u32x4*)(Kt + (buf) * KBUF + k0key * KROW + k0pt * 16) = sk0; if (k1on) *(LAS u32x4*)(Kt + (buf) * KBUF + k1key * KROW + k1pt * 16) = sk1; \
        *(LAS u32x4*)(Vt + (buf) * VBUF + (tid >> 3) * VROW + (tid & 7) * 16) = sv; } while (0)
        __syncthreads();
        ATT_LOAD(kt0); ATT_STORE(0);
        __syncthreads();
        for (int it = 0; it < nkt; ++it) {
            const int cur = it & 1;
            if (it + 1 < nkt) ATT_LOAD(kt0 + it + 1);
            f32x16 sacc[2];
            const float nm = -mrun;
#pragma unroll
            for (int kb = 0; kb < 2; ++kb) {
#pragma unroll
                for (int i = 0; i < 16; ++i) sacc[kb][i] = nm;
#pragma unroll
                for (int ks = 0; ks < 6; ++ks) { const bf16x8 a = *(const LAS bf16x8*)(Kt + cur * KBUF + (32 * kb + ln) * KROW + ks * 32 + hh * 16);
                    sacc[kb] = __builtin_amdgcn_mfma_f32_32x32x16_bf16(a, qf[ks], sacc[kb], 0, 0, 0); } }
            float mx = fmaxf(fmaxf(sacc[0][0], sacc[0][1]), sacc[0][2]);
#pragma unroll
            for (int i = 3; i < 15; i += 2) mx = fmaxf(fmaxf(mx, sacc[0][i]), sacc[0][i + 1]);
            mx = fmaxf(mx, sacc[0][15]);
#pragma unroll
            for (int i = 0; i < 16; i += 2) mx = fmaxf(fmaxf(mx, sacc[1][i]), sacc[1][i + 1]);
            { const auto r = __builtin_amdgcn_permlane32_swap(__float_as_uint(mx), __float_as_uint(mx), false, false); mx = fmaxf(__uint_as_float(r[0]), __uint_as_float(r[1])); }
            if (it == 0 || __builtin_amdgcn_ballot_w64(mx > 8.0f) != 0ull) {
                const float up = it == 0 ? mx : fmaxf(mx, 0.f), alpha = __builtin_amdgcn_exp2f(-up); mrun += up; lsum *= alpha;
#pragma unroll
                for (int i = 0; i < 16; ++i) { oacc[0][i] *= alpha; oacc[1][i] *= alpha; sacc[0][i] -= up; sacc[1][i] -= up; }
            }
            float ps = 0.f;
#pragma unroll
            for (int kb = 0; kb < 2; ++kb)
#pragma unroll
                for (int i = 0; i < 16; ++i) { const float pv = __builtin_amdgcn_exp2f(sacc[kb][i]); sacc[kb][i] = pv; ps += pv; }
            lsum += ps;
            bf16x8 pb[4];
#pragma unroll
            for (int s4 = 0; s4 < 4; ++s4) { const int kb = s4 >> 1, o8 = 8 * (s4 & 1); u32x4 w;
                w.x = pk2(sacc[kb][o8 + 0], sacc[kb][o8 + 1]); w.y = pk2(sacc[kb][o8 + 2], sacc[kb][o8 + 3]); w.z = pk2(sacc[kb][o8 + 4], sacc[kb][o8 + 5]); w.w = pk2(sacc[kb][o8 + 6], sacc[kb][o8 + 7]);
                pb[s4] = __builtin_bit_cast(bf16x8, w); }
#pragma unroll
            for (int db = 0; db < 2; ++db)
#pragma unroll
                for (int s4 = 0; s4 < 4; ++s4) { const bf16x8 a = *(const LAS bf16x8*)(Vt + cur * VBUF + (32 * db + ln) * VROW + s4 * 32 + hh * 16);
                    oacc[db] = __builtin_amdgcn_mfma_f32_32x32x16_bf16(a, pb[s4], oacc[db], 0, 0, 0); }
            if (it + 1 < nkt) ATT_STORE(cur ^ 1);
            __syncthreads();
        }
#undef ATT_LOAD
#undef ATT_STORE
        { const auto r = __builtin_amdgcn_permlane32_swap(__float_as_uint(lsum), __float_as_uint(lsum), false, false); lsum = __uint_as_float(r[0]) + __uint_as_float(r[1]); }
        const float inv = 1.f / lsum;
        bf16* dst = MIX + (size_t)(qrow0 + 32 * c.wave + ln) * DM + 768 + h * 64 + 4 * hh;
#pragma unroll
        for (int db = 0; db < 2; ++db)
#pragma unroll
            for (int g4 = 0; g4 < 4; ++g4) { u32x2 w; w.x = pk2(oacc[db][4 * g4] * inv, oacc[db][4 * g4 + 1] * inv); w.y = pk2(oacc[db][4 * g4 + 2] * inv, oacc[db][4 * g4 + 3] * inv);
                *(u32x2*)(dst + 32 * db + 8 * g4) = w; }
    }
    __syncthreads();
}

__device__ __forceinline__ void phase_norm2_route(const Ctx& c, KParams p, int l, int ntok) {
    const float* MOD = (const float*)(c.ws + WS_MOD) + (size_t)l * 33 * 6144;
    const float* xl = l == 0 ? p->in[I_X] : p->out; const float* xc = l == 0 ? p->in[I_CTX] : (const float*)(c.ws + WS_XC);
    bf16* H = (bf16*)(c.ws + WS_H);
    int* TKEP = (int*)(c.ws + WS_RT + RT_TKEP); float* TKW = (float*)(c.ws + WS_RT + RT_TKW); int* TB = (int*)(c.ws + WS_TB);
    int* CNT = (int*)(c.ws + WS_CTL) + CW_CNT + l * NCH * NE;
    constexpr int HROW = 1032;
    LAS bf16* hhi = (LAS bf16*)c.lds;
    LAS bf16* hlo = hhi + 32 * HROW;
    LAS float* lgs = (LAS float*)(c.lds + 132096);
    LAS int* hist = (LAS int*)(c.lds + 140288);
    const bf16* Whi = (const bf16*)(c.ws + WS_TAB + TAB_RWT) + (size_t)(l * 2) * 65536; const bf16* Wlo = Whi + 65536;
    const float rbias = p->in[I_RB][l * 64 + c.lane];
    const int ntiles = ntok / 32, rpc = ntok / NCH, lane = c.lane, mb = c.wave >> 2, nb = c.wave & 3;
    for (int tile = c.blk; tile < ntiles; tile += c.G) {
        __syncthreads();
        if (c.tid < 64) hist[c.tid] = 0;
        for (int q = 0; q < 4; ++q) { const int r = tile * 32 + c.wave * 4 + q; const float* xr = r < NLAT ? xl + (size_t)r * DM : xc + (size_t)(r - NLAT) * DM; const float* m = MOD + (size_t)mod_row(r) * 6144;
            float* xo = r < NLAT ? p->out + (size_t)r * DM : (float*)(c.ws + WS_XC) + (size_t)(r - NLAT) * DM;
            f32x4 v[4]; norm_row_add(xr, (const bf16*)(c.ws + WS_Z) + (size_t)r * DM, xo, p->in[I_N2G] + l * DM, m + 3072, m + 4096, c.ws + WS_H8 + (size_t)r * DM, lane, v);
#pragma unroll
            for (int j = 0; j < 4; ++j) { u32x2 hi; hi.x = pk2(v[j].x, v[j].y); hi.y = pk2(v[j].z, v[j].w);
                const float r0 = v[j].x - __uint_as_float(hi.x << 16), r1 = v[j].y - __uint_as_float(hi.x & 0xffff0000u), r2 = v[j].z - __uint_as_float(hi.y << 16), r3 = v[j].w - __uint_as_float(hi.y & 0xffff0000u);
                u32x2 lo; lo.x = pk2(r0, r1); lo.y = pk2(r2, r3);
                *(LAS u32x2*)(hhi + (c.wave * 4 + q) * HROW + 4 * lane + 256 * j) = hi; *(LAS u32x2*)(hlo + (c.wave * 4 + q) * HROW + 4 * lane + 256 * j) = lo; } }
        __syncthreads();
        { f32x4 acc = (f32x4){0.f, 0.f, 0.f, 0.f};
          const LAS bf16* ah = hhi + (mb * 16 + (lane & 15)) * HROW + 8 * (lane >> 4); const LAS bf16* al = hlo + (mb * 16 + (lane & 15)) * HROW + 8 * (lane >> 4);
          const bf16* bh = Whi + (size_t)(nb * 16 + (lane & 15)) * 1024 + 8 * (lane >> 4); const bf16* bl = Wlo + (size_t)(nb * 16 + (lane & 15)) * 1024 + 8 * (lane >> 4);
#pragma unroll 8
          for (int ks = 0; ks < 32; ++ks) { const bf16x8 a_h = *(const LAS bf16x8*)(ah + 32 * ks), a_l = *(const LAS bf16x8*)(al + 32 * ks), b_h = *(const bf16x8*)(bh + 32 * ks), b_l = *(const bf16x8*)(bl + 32 * ks);
              acc = __builtin_amdgcn_mfma_f32_16x16x32_bf16(a_h, b_h, acc, 0, 0, 0); acc = __builtin_amdgcn_mfma_f32_16x16x32_bf16(a_h, b_l, acc, 0, 0, 0); acc = __builtin_amdgcn_mfma_f32_16x16x32_bf16(a_l, b_h, acc, 0, 0, 0); }
#pragma unroll
          for (int i = 0; i < 4; ++i) lgs[(mb * 16 + 4 * (lane >> 4) + i) * 64 + nb * 16 + (lane & 15)] = acc[i]; }
        __syncthreads();
#pragma unroll
        for (int q = 0; q < 4; ++q) {
            const int r = tile * 32 + c.wave * 4 + q;
            const float s = sigmoidf_(lgs[(c.wave * 4 + q) * 64 + lane]), bs = s + rbias;
            float m1 = bs; m1 = fmaxf(m1, shx<1>(m1)); m1 = fmaxf(m1, shx<2>(m1)); m1 = fmaxf(m1, shx<4>(m1));
            const unsigned long long eq = __ballot(bs == m1); const unsigned gm = (unsigned)(eq >> (lane & 56)) & 0xffu; const int first = __ffs(gm) - 1;
            float m2 = ((lane & 7) == first) ? -1e30f : bs; m2 = fmaxf(m2, shx<1>(m2)); m2 = fmaxf(m2, shx<2>(m2)); m2 = fmaxf(m2, shx<4>(m2));
            const float gs = m1 + m2; const int g = lane >> 3; int rank = 0;
#pragma unroll
            for (int j = 0; j < 8; ++j) { const float o = rdl(gs, 8 * j); rank += (o > gs || (o == gs && j < g)) ? 1 : 0; }
            float cand = rank < 4 ? bs : -1e30f; int my_e = 0; float my_w = 0.f, wsum = 0.f;
#pragma unroll
            for (int k = 0; k < 8; ++k) { const float mm = wave_max(cand); const unsigned long long e2 = __ballot(cand == mm); const int idx = __ffsll((long long)e2) - 1; const float wk = rdl(s, idx);
                if (lane == idx) cand = -1e30f; if (lane == k) { my_e = idx; my_w = wk; } wsum += wk; }
            if (lane < 8) { const int lp = atomicAdd((int*)&hist[my_e], 1); TKEP[(size_t)r * 8 + lane] = my_e | (lp << 8); TKW[(size_t)r * 8 + lane] = my_w / wsum * 2.5f; }
        }
        __syncthreads();
        if (c.tid < 64) { const int n = hist[c.tid]; int base = 0; if (n > 0) base = atomicAdd(&CNT[((tile * 32) / rpc) * NE + c.tid], n); TB[tile * 64 + c.tid] = base; }
    }
    __syncthreads();
}
__device__ __forceinline__ void phase_route_fill(const Ctx& c, int l, int ntok) {
    const int* TKEP = (const int*)(c.ws + WS_RT + RT_TKEP); int* SLOT = (int*)(c.ws + WS_RT + RT_SLOT); const int* TB = (const int*)(c.ws + WS_TB);
    const int* CNT = (const int*)(c.ws + WS_CTL) + CW_CNT + l * NCH * NE; int* ROWL = (int*)(c.ws + WS_ROWL);
    LAS int* est = (LAS int*)c.lds;
    const int rpc = ntok / NCH;
    __syncthreads();
    if (c.tid < NCH) { int s = 0; for (int e = 0; e < NE; ++e) { est[c.tid * 65 + e] = s; s += (CNT[c.tid * NE + e] + 255) & ~255; } est[c.tid * 65 + 64] = s; }
    __syncthreads();
    const size_t na = (size_t)ntok * 8;
    for (size_t a = (size_t)c.blk * NTHR + c.tid; a < na; a += (size_t)c.G * NTHR) { const int t = (int)(a >> 3), ch = t / rpc; const int ep = TKEP[a], e = ep & 255, lp = ep >> 8;
        const int slot = est[ch * 65 + e] + TB[(t >> 5) * 64 + e] + lp; SLOT[a] = slot; ROWL[(size_t)ch * RPCMAX + slot] = t; }
    for (int i = c.blk * NTHR + c.tid; i < NCH * NE * 256; i += c.G * NTHR) { const int ch = i >> 14, e = (i >> 8) & 63, j = i & 255; const int n = CNT[ch * NE + e]; const int pad = ((n + 255) & ~255) - n;
        if (j < pad) ROWL[(size_t)ch * RPCMAX + est[ch * 65 + e] + n + j] = ch * rpc; }
    __syncthreads();
}

__device__ __forceinline__ void moe_tile_table(const Ctx& c, int l, int ch, LAS int* tst) {
    const int* CNT = (const int*)(c.ws + WS_CTL) + CW_CNT + l * NCH * NE + ch * NE;
    LAS unsigned char* texp = (LAS unsigned char*)(tst + 80);
    __syncthreads();
    if (c.tid == 0) { int s = 0; for (int e = 0; e < NE; ++e) { tst[e] = s; s += (CNT[e] + 255) >> 8; } tst[64] = s; }
    __syncthreads();
    if (c.tid < NE) { for (int t = tst[c.tid]; t < tst[c.tid + 1]; ++t) texp[t] = (unsigned char)c.tid; }
    __syncthreads();
}
__device__ __forceinline__ void phase_combine(const Ctx& c, KParams p, int l, int ch, int rpc) {
    const float* MOD = (const float*)(c.ws + WS_MOD) + (size_t)l * 33 * 6144 + 5120; const float* MODn = (const float*)(c.ws + WS_MOD) + (size_t)33 * 6144;
    const int* SLOT = (const int*)(c.ws + WS_RT + RT_SLOT); const float* TKW = (const float*)(c.ws + WS_RT + RT_TKW);
    const unsigned char* OB = (const unsigned char*)(c.ws + WS_OB); const bf16* OBS = (const bf16*)(c.ws + WS_OBS);
    float* xl = p->out; float* xc = (float*)(c.ws + WS_XC); bf16* H = (bf16*)(c.ws + WS_H);
    const int gw = c.blk * NWAVES + c.wave, NGW = c.G * NWAVES, lane = c.lane;
    const int col0 = (lane >> 4) * 256 + ((lane >> 2) & 3) * 32 + (lane & 3) * 8;
    f32x4 gn[4];
#pragma unroll
    for (int q = 0; q < 4; ++q) gn[q] = *(const f32x4*)((l == 0 ? p->in[I_N1G] + DM : p->in[I_FG]) + col0 + 128 * (q >> 1) + 4 * (q & 1));
    int sl_n = 0; float w_n = 0.f;
    if (gw < rpc && lane < 8) { sl_n = SLOT[(size_t)(ch * rpc + gw) * 8 + lane]; w_n = TKW[(size_t)(ch * rpc + gw) * 8 + lane] * 0.0625f; }
    for (int i = gw; i < rpc; i += NGW) {
        const int t = ch * rpc + i; float* xr = t < NLAT ? xl + (size_t)t * DM : xc + (size_t)(t - NLAT) * DM; const int mr = mod_row(t); const float* g2 = MOD + (size_t)mr * 6144;
        const int sl = sl_n; const float w = w_n;
        u32x4 ob[8], os0, os1; f32x4 xv[4];
#pragma unroll
        for (int e = 0; e < 8; ++e) ob[e] = *(const u32x4*)(OB + (size_t)rdli(sl, e) * 1024 + lane * 16);
        os0 = *(const u32x4*)(OBS + (size_t)i * DM + col0); os1 = *(const u32x4*)(OBS + (size_t)i * DM + col0 + 128);
#pragma unroll
        for (int q = 0; q < 4; ++q) xv[q] = *(const f32x4*)(xr + col0 + 128 * (q >> 1) + 4 * (q & 1));
        if (i + NGW < rpc && lane < 8) { sl_n = SLOT[(size_t)(t + NGW) * 8 + lane]; w_n = TKW[(size_t)(t + NGW) * 8 + lane] * 0.0625f; }
        float a[16]; { float t8[8]; unpack8(os0, t8);
#pragma unroll
            for (int q = 0; q < 8; ++q) a[q] = t8[q];
            unpack8(os1, t8);
#pragma unroll
            for (int q = 0; q < 8; ++q) a[8 + q] = t8[q]; }
#pragma unroll
        for (int e = 0; e < 8; ++e) { const float wk = rdl(w, e);
#pragma unroll
            for (int q = 0; q < 4; ++q) { const f32x2 lo = __builtin_amdgcn_cvt_pk_f32_fp8((int)ob[e][q], false), hi = __builtin_amdgcn_cvt_pk_f32_fp8((int)ob[e][q], true);
                a[4 * q] = fmaf(wk, lo.x, a[4 * q]); a[4 * q + 1] = fmaf(wk, lo.y, a[4 * q + 1]); a[4 * q + 2] = fmaf(wk, hi.x, a[4 * q + 2]); a[4 * q + 3] = fmaf(wk, hi.y, a[4 * q + 3]); } }
        f32x4 xn[4]; float ss = 0.f;
#pragma unroll
        for (int q = 0; q < 4; ++q) { const int cc = col0 + 128 * (q >> 1) + 4 * (q & 1); const f32x4 gv = *(const f32x4*)(g2 + cc);
            xn[q] = xv[q] + gv * (f32x4){a[4 * q], a[4 * q + 1], a[4 * q + 2], a[4 * q + 3]}; ss += (xn[q].x * xn[q].x + xn[q].y * xn[q].y) + (xn[q].z * xn[q].z + xn[q].w * xn[q].w); }
        const float rstd = rsqrtf(wave_sum(ss) * (1.f / 1024.f) + EPS);
        if (l == 0) { const float* mn = MODn + (size_t)mr * 6144; bf16* hr = H + (size_t)t * DM;
#pragma unroll
            for (int q = 0; q < 4; ++q) { const int cc = col0 + 128 * (q >> 1) + 4 * (q & 1); *(f32x4*)(xr + cc) = xn[q];
                const f32x4 s0 = *(const f32x4*)(mn + cc), s1 = *(const f32x4*)(mn + 1024 + cc); const f32x4 hv = xn[q] * rstd * gn[q] * (s1 + 1.0f) + s0;
                u32x2 o; o.x = pk2(hv.x, hv.y); o.y = pk2(hv.z, hv.w); *(u32x2*)(hr + cc) = o; } }
        else {
#pragma unroll
            for (int q = 0; q < 4; ++q) { const int cc = col0 + 128 * (q >> 1) + 4 * (q & 1); *(f32x4*)(xr + cc) = xn[q] * rstd * gn[q]; } }
    }
}
constexpr int LDS_BYTES = 147456;
constexpr int LDS_TAB = 131072, LDS_XB = LDS_BYTES - 16;
enum { J_INPROJ = 0, J_S5G1, J_PW, J_Q, J_KV, J_S5G2, J_GLU, J_OUT, J_GU, J_GUS, J_DN, J_DNS };
enum { SK_DENSE = 0, SK_S5, SK_MOE };
enum { EK_INPROJ = 0, EK_S5X, EK_S5Y, EK_BIAS, EK_GLU, EK_Q, EK_KV, EK_RESID, EK_SWIGLU, EK_OB8, EK_BF16 };
struct JSched {
    int sk, G, c; pg8::DenseOrder d; const char* W; size_t wexp, wtile; const LAS unsigned char* texp; int ntile, npn;
    __device__ __forceinline__ bool next(int i, pg8::Unit& u) const {
        if (sk == SK_DENSE) return d.next(i, u);
        const int L = i * G + c;
        if (sk == SK_S5) { if (L >= 288) return false; u.pm = L; u.pn = 0; u.e = L / 18; u.B = W + (size_t)u.e * wexp; return true; }
        if (L >= ntile * npn) return false;
        const int T = npn == 2 ? (L >> 1) : (L >> 2), pn = L & (npn - 1); const int e = __builtin_amdgcn_readfirstlane((int)texp[T]);
        u.pm = T; u.pn = pn; u.e = e; u.B = W + (size_t)e * wexp + (size_t)pn * wtile; return true;
    }
};
struct JRows { const int* list; unsigned ldab;
    __device__ __forceinline__ unsigned off(const pg8::Unit& u, int r) const { const int row = u.pm * 256 + r; return (unsigned)(list ? list[row] : row) * ldab; } };
struct JEpi {
    int ek; void* p0; void* p1; void* p2; const void* q0; const void* q1; const void* q2; int i0;
    __device__ __forceinline__ void operator()(EPI_ARGS) const {
        switch (ek) {
        case EK_INPROJ: EpiInProj{(bf16*)p0, (bf16*)p1, (bf16*)p2}(acc, u, wr, wc, fr, fq); break;
        case EK_S5X:    EpiS5X{(bf16*)p0}(acc, u, wr, wc, fr, fq); break;
        case EK_S5Y:    EpiS5Y{(bf16*)p0}(acc, u, wr, wc, fr, fq); break;
        case EK_BIAS:   EpiBiasBf16{(bf16*)p0, i0, (const float*)q0}(acc, u, wr, wc, fr, fq); break;
        case EK_GLU:    EpiGluSig{(bf16*)p0, i0, (const float*)q0}(acc, u, wr, wc, fr, fq); break;
        case EK_Q:      EpiQ{(bf16*)p0, (const float*)q0}(acc, u, wr, wc, fr, fq); break;
        case EK_KV:     EpiKV{(bf16*)p0, (bf16*)p1, (const float*)q0}(acc, u, wr, wc, fr, fq); break;
        case EK_RESID:  EpiDelta{(bf16*)p0, (const float*)q0}(acc, u, wr, wc, fr, fq); break;
        default:        EpiBf16{(bf16*)p0, i0}(acc, u, wr, wc, fr, fq); break;
        }
    }
};
struct JEpi8 {
    int ek; void* p0; int i0;
    __device__ __forceinline__ void operator()(EPI_ARGS) const {
        if (ek == EK_SWIGLU) EpiSwiglu{(unsigned char*)p0, i0, 1.0f / 256.0f}(acc, u, wr, wc, fr, fq);
        else if (ek == EK_OB8) EpiOB8{(unsigned char*)p0, 16.0f / 1024.0f}(acc, u, wr, wc, fr, fq);
        else EpiBf16S{(bf16*)p0, i0, 1.0f / 1024.0f}(acc, u, wr, wc, fr, fq);
    }
};
__device__ __forceinline__ void gemm_job(KParams p, LAS unsigned char* lds, int job, int l, int ch) {
    unsigned char* ws = p->ws;
    const int G = gridDim.x, blk = blockIdx.x;
    const bool last = (l == 1); const int nrows = last ? NLAT : NTOK, rpc = nrows / NCH;
    unsigned char* sm = ws + WS_WSM + (size_t)l * WSM_L;
    const LAS int* tst = (const LAS int*)(lds + LDS_TAB);
    const char* A = nullptr; int K = 256; bool fp8 = false; JSched S; JRows R; JEpi E;
    S.sk = SK_DENSE; S.G = G; S.c = blk; S.W = nullptr; S.wexp = 0; S.wtile = 0; S.texp = (const LAS unsigned char*)(tst + 80); S.ntile = 0; S.npn = 2; S.d.init(1, 1, G, blk, nullptr, 256);
    R.list = nullptr; R.ldab = 512u; E.ek = EK_BF16; E.p0 = E.p1 = E.p2 = nullptr; E.q0 = E.q1 = E.q2 = nullptr; E.i0 = 0;
    switch (job) {
    case J_INPROJ: A = (const char*)(ws + WS_H); K = 1024; R.ldab = 2048u; S.d.init(NTOK / 256, ZW / 256, G, blk, (const bf16*)(ws + WS_WIN) + (size_t)l * 2048 * 1024, 1024);
        E.ek = EK_INPROJ; E.p0 = ws + WS_Z; E.p1 = ws + WS_UP; E.p2 = ws + WS_GVT; break;
    case J_S5G1: A = (const char*)(ws + WS_UP); K = 256; R.ldab = 1024u; S.sk = SK_S5; S.W = (const char*)(ws + WS_S5W) + (size_t)l * 16 * 256 * 256 * 2; S.wexp = (size_t)256 * 256 * 2; E.ek = EK_S5X; E.p0 = ws + WS_Y5; break;
    case J_PW: A = (const char*)(ws + WS_CV); K = 256; R.ldab = 512u; S.d.init(nrows / 256, 1, G, blk, (const bf16*)(sm + WSM_PW), 256); E.ek = EK_BIAS; E.p0 = (bf16*)(ws + WS_MIX) + 256; E.i0 = DM; E.q0 = p->in[I_CPB] + l * 256; break;
    case J_Q: A = (const char*)(ws + WS_Z) + ZCQ * 2; K = 256; R.ldab = (unsigned)ZW * 2u; S.d.init(NTOK / 256, 2, G, blk, (const bf16*)(sm + WSM_UQ), 256);
        E.ek = EK_Q; E.p0 = ws + WS_H; E.q0 = ws + WS_RS; break;
    case J_KV: A = (const char*)(ws + WS_Z) + ZCKV * 2; K = 256; R.ldab = (unsigned)ZW * 2u; S.d.init(NTOK / 256, 2, G, blk, (const bf16*)(sm + WSM_UK), 256);
        E.ek = EK_KV; E.p0 = (bf16*)(ws + WS_H) + (size_t)NTOK * 384; E.p1 = (bf16*)(ws + WS_H) + (size_t)NTOK * 768; E.q0 = ws + WS_RS; break;
    case J_S5G2: A = (const char*)(ws + WS_UP); K = 512; R.ldab = 1024u; S.sk = SK_S5; S.W = (const char*)(ws + WS_S5W) + (size_t)32 * 256 * 256 * 2 + (size_t)l * 16 * 256 * 512 * 2; S.wexp = (size_t)256 * 512 * 2; E.ek = EK_S5Y; E.p0 = ws + WS_Y5; break;
    case J_GLU: A = (const char*)(ws + WS_Y5); K = 256; R.ldab = 512u; S.d.init(nrows / 256, 2, G, blk, (const bf16*)(sm + WSM_GLU), 256); E.ek = EK_GLU; E.p0 = (bf16*)(ws + WS_MIX) + 512; E.i0 = DM; E.q0 = p->in[I_S5GB] + l * 512; break;
    case J_OUT: A = (const char*)(ws + WS_MIX); K = 1024; R.ldab = 2048u; S.d.init(nrows / 256, 4, G, blk, (const bf16*)(ws + WS_WOUT) + (size_t)l * 1024 * 1024, 1024);
        E.ek = EK_RESID; E.p0 = ws + WS_Z; E.q0 = (const float*)(ws + WS_MOD) + (size_t)l * 33 * 6144 + 2048; break;
    case J_GU: A = (const char*)(ws + WS_H8); K = 512; fp8 = true; R.list = (const int*)(ws + WS_ROWL) + (size_t)ch * RPCMAX; R.ldab = 1024u; S.sk = SK_MOE; S.ntile = __builtin_amdgcn_readfirstlane(tst[64]); S.npn = 2; S.W = (const char*)(ws + WS_WMOE); S.wexp = (size_t)512 * 1024; S.wtile = (size_t)256 * 1024;
        E.ek = EK_SWIGLU; E.p0 = ws + WS_HB; E.i0 = 256; break;
    case J_GUS: A = (const char*)(ws + WS_H8) + (size_t)ch * rpc * 1024; K = 512; fp8 = true; R.ldab = 1024u; S.d.init(rpc / 256, 2, G, blk, (const bf16*)((const unsigned char*)(ws + WS_WSH) + (size_t)l * (512 * 1024 + 1024 * 256) * 2), 512); E.ek = EK_SWIGLU; E.p0 = ws + WS_HBS; E.i0 = 256; break;
    case J_DN: A = (const char*)(ws + WS_HB); K = 128; fp8 = true; R.ldab = 256u; S.sk = SK_MOE; S.ntile = __builtin_amdgcn_readfirstlane(tst[64]); S.npn = 4; S.W = (const char*)(ws + WS_WMOE) + (size_t)NE * 512 * 1024; S.wexp = (size_t)1024 * 256; S.wtile = (size_t)256 * 256;
        E.ek = EK_OB8; E.p0 = ws + WS_OB; break;
    default: A = (const char*)(ws + WS_HBS); K = 128; fp8 = true; R.ldab = 256u; S.d.init(rpc / 256, 4, G, blk, (const bf16*)((const unsigned char*)(ws + WS_WSH) + (size_t)l * (512 * 1024 + 1024 * 256) * 2 + 512 * 1024), 128); E.ek = EK_BF16; E.p0 = ws + WS_OBS; E.i0 = DM; break;
    }
    __builtin_amdgcn_s_waitcnt(0x0F70);
    if (fp8) pg8::gemm_phase<true>(lds, A, K, S, R, JEpi8{E.ek, E.p0, E.i0});
    else pg8::gemm_phase<false>(lds, A, K, S, R, E);
}


__global__ void __launch_bounds__(NTHR, 2) fwd_kernel(Params pk) {
    extern __shared__ __attribute__((aligned(16))) unsigned char lds_raw[];
    LAS unsigned char* const lds0 = (LAS unsigned char*)lds_raw;
    if (threadIdx.x < 4) ((LAS unsigned*)(lds0 + LDS_XB))[threadIdx.x] = 0u;
    __syncthreads();
    (void)xcd_barrier_post((unsigned*)(pk.ws + WS_CTL) + CW_BAR, (volatile LAS unsigned*)(lds0 + LDS_XB));
    constexpr int NSTEP = 15 + 6 * NCH;
#ifndef PROBE_DUP
#define PROBE_DUP (-9)
#endif
#pragma unroll 1
    for (int it_ = -2; it_ < 2 * NSTEP + (PROBE_DUP >= 0 ? 2 : 0); ++it_) {
        int gs = it_; if (PROBE_DUP >= 0) { if (it_ > PROBE_DUP) gs -= 1; if (it_ > NSTEP + PROBE_DUP + 1) gs -= 1; }
        KParams p = fresh_params(); Ctx c; { int t_ = threadIdx.x; asm volatile("" : "+v"(t_)); c.lds = lds0; c.tid = t_; c.lane = t_ & 63; c.wave = __builtin_amdgcn_readfirstlane(t_ >> 6); c.blk = blockIdx.x; c.G = gridDim.x; c.ws = p->ws; }
        LAS int* tst = (LAS int*)(c.lds + LDS_TAB);
        int l = 0, s = gs, ch = 0, job = -1; bool seam = true;
        if (gs >= 0) { l = gs >= NSTEP ? 1 : 0; s = gs - l * NSTEP; if (s >= 15) { ch = (s - 15) / 6; s = 15 + (s - 15) % 6; } }
        const bool last = (l == 1); const int nrows = last ? NLAT : NTOK, rpc = nrows / NCH;
        switch (s) {
        case -2: prologue(c, p); break;
        case -1: prologue2(c, p); break;
        case 0: if (last) prologue_moe_weights(c, p, 1); else phase_norm1(c, p, l); break;
        case 1: job = J_INPROJ; break;
        case 2: phase_gla(c, p, l); phase_conv1(c, p, l, !last); phase_mla_prep(c, p); seam = false; break;
        case 3: job = J_S5G1; break;
        case 4: phase_gla_final(c, p, l, nrows); seam = false; break;
        case 5: job = J_PW; seam = false; break;
        case 6: job = J_Q; seam = false; break;
        case 7: job = J_KV; seam = false; break;
        case 8: phase_s5_carry(c, l); break;
        case 9: phase_attn(c, !last); seam = false; break;
        case 10: job = J_S5G2; break;
        case 11: job = J_GLU; break;
        case 12: job = J_OUT; break;
        case 13: phase_norm2_route(c, p, l, nrows); break;
        case 14: phase_route_fill(c, l, nrows); break;
        case 15: moe_tile_table(c, l, ch, tst); job = J_GU; seam = false; break;
        case 16: job = J_GUS; break;
        case 17: job = J_DN; seam = false; break;
        case 18: job = J_DNS; break;
        case 19: phase_combine(c, p, l, ch, rpc); break;
        default: seam = false; break;
        }
        if (job >= 0) gemm_job(p, c.lds, job, l, ch);
        if (seam && gs + 1 < 2 * NSTEP) { XcdBarrier b_; b_.bar = (unsigned*)(p->ws + WS_CTL) + CW_BAR; b_.x = xb_xcc_id(); b_.st = (volatile LAS unsigned*)(lds0 + LDS_XB); xcd_barrier(b_); }
    }
}

extern "C" void kernel_launch(void* const* d_in, const int* in_sizes, int n_in, void* d_out, int out_size, void* d_ws, size_t ws_size, hipStream_t stream) {
    static int grid = 0;
    if (grid == 0) {
        if (n_in != 42 || out_size != NLAT * DM || ws_size < WS_END) { fprintf(stderr, "kernel_launch: unexpected shapes (n_in %d out %d ws %zu)\n", n_in, out_size, ws_size); grid = -1; return; }
        int dev = 0, cus = 0;
        if (hipGetDevice(&dev) != hipSuccess || hipDeviceGetAttribute(&cus, hipDeviceAttributeMultiprocessorCount, dev) != hipSuccess) { grid = -1; return; }
        if (hipFuncSetAttribute((const void*)fwd_kernel, hipFuncAttributeMaxDynamicSharedMemorySize, LDS_BYTES) != hipSuccess) { fprintf(stderr, "kernel_launch: hipFuncSetAttribute failed\n"); grid = -1; return; }
        int per_cu = 0;
        if (hipOccupancyMaxActiveBlocksPerMultiprocessor(&per_cu, (const void*)fwd_kernel, NTHR, LDS_BYTES) != hipSuccess || per_cu < 1) fprintf(stderr, "kernel_launch: occupancy query reports %d\n", per_cu);
        (void)hipGetLastError();
        grid = cus;
    }
    if (grid < 0) return;
    (void)hipMemsetAsync((char*)d_ws + WS_CTL, 0, CTL_BYTES, stream);
    Params p{};
    for (int i = 0; i < 42; ++i) p.in[i] = (const float*)d_in[i];
    p.out = (float*)d_out; p.ws = (unsigned char*)d_ws; p.ph_lo = 0; p.ph_hi = 1 << 20;
    hipLaunchKernelGGL(fwd_kernel, dim3(grid), dim3(NTHR), LDS_BYTES, stream, p);
}
```

```cpp
#include <hip/hip_runtime.h>
#include <cstdio>
#include <cstdint>

#define LAS __attribute__((address_space(3)))
typedef unsigned short bf16;
typedef short bf16x8 __attribute__((ext_vector_type(8)));
typedef float f32x4 __attribute__((ext_vector_type(4)));
typedef float f32x2 __attribute__((ext_vector_type(2)));
typedef float f32x16 __attribute__((ext_vector_type(16)));
typedef unsigned u32x4 __attribute__((ext_vector_type(4)));
typedef unsigned u32x2 __attribute__((ext_vector_type(2)));
typedef int i32x4 __attribute__((ext_vector_type(4)));
typedef int i32x8 __attribute__((ext_vector_type(8)));

constexpr int NB = 32, SEQ = 2048, CTXL = 256, DM = 1024;
constexpr int NLAT = NB * SEQ, NCTX = NB * CTXL, NTOK = NLAT + NCTX;
constexpr int ZW = 2048;
constexpr int ZQ = 0, ZK = 128, ZV = 256, ZR = 512, ZCA = 768, ZCG = 1024, ZS5 = 1280, ZCQ = 1536, ZCKV = 1792, ZKR = 1920, ZAF = 1952, ZAB = 1968;
constexpr int NE = 64, TOPK = 8;
constexpr int NCH = 2;
constexpr int RPCMAX = (NTOK / NCH) * 8 + 64 * 256;
constexpr float EPS = 1e-6f;
constexpr int NWAVES = 8, NTHR = 512;

constexpr size_t MiB = (size_t)1 << 20;
constexpr size_t WS_CTL = 0, CTL_BYTES = 1 * MiB;
constexpr size_t WS_MOD = 1 * MiB;
constexpr size_t WS_TAB = 3 * MiB;
constexpr size_t WS_WSM = 5 * MiB;
constexpr size_t WS_WIN = 8 * MiB;
constexpr size_t WS_WOUT = 16 * MiB;
constexpr size_t WS_WSH = 20 * MiB;
constexpr size_t WS_TB = 23 * MiB;
constexpr size_t WS_RT = 24 * MiB;
constexpr size_t WS_ROWL = 32 * MiB;
constexpr size_t WS_RS = 35 * MiB;
constexpr size_t WS_WMOE = 36 * MiB;
constexpr size_t WS_XC = 132 * MiB;
constexpr size_t WS_H = 164 * MiB;
constexpr size_t WS_H8 = WS_H + 72 * MiB;
constexpr size_t WS_Z = 308 * MiB;
constexpr size_t WS_MIX = 596 * MiB;
constexpr size_t WS_T1 = 740 * MiB;
constexpr size_t WS_UP = 812 * MiB;
constexpr size_t WS_CV = 884 * MiB;
constexpr size_t WS_Y5 = 920 * MiB;
constexpr size_t WS_S5W = 956 * MiB;
constexpr size_t WS_S5P = 968 * MiB;
constexpr size_t WS_GVT = 969 * MiB;
constexpr size_t WS_END = 1005 * MiB;
constexpr size_t WS_HB = WS_Z;
constexpr size_t WS_HBS = WS_Z + 152 * MiB;
constexpr size_t WS_OBS = WS_Z + 170 * MiB;
constexpr size_t WS_OB = WS_MIX;
static_assert((size_t)RPCMAX * 512 <= 152 * MiB && WS_OBS + (size_t)(NTOK / NCH) * 2048 <= WS_MIX && WS_OB + (size_t)RPCMAX * 1024 <= WS_S5W, "MoE overlays");
constexpr int CW_BAR = 0;
constexpr int CW_CNT = 4096;
constexpr size_t WSM_L = 1 * MiB;
constexpr size_t WSM_PW = 0, WSM_GLU = 128 * 1024, WSM_UQ = 384 * 1024, WSM_UK = 640 * 1024, WSM_UV = 768 * 1024;
constexpr size_t TAB_ROPE = 0;
constexpr size_t TAB_S5 = 256 * 1024;
constexpr size_t TAB_RWT = 1536 * 1024;
constexpr size_t RT_TKEP = 0, RT_TKW = 2400000, RT_SLOT = 4800000;

__device__ __forceinline__ float bf2f(bf16 v) { return __uint_as_float(((unsigned)v) << 16); }
typedef __bf16 bf16x2_t __attribute__((ext_vector_type(2)));
__device__ __forceinline__ unsigned pk2(float lo, float hi) { const f32x2 v = {lo, hi}; return __builtin_bit_cast(unsigned, __builtin_convertvector(v, bf16x2_t)); }
__device__ __forceinline__ bf16 f2bf(float f) { return __builtin_bit_cast(unsigned short, (__bf16)f); }
template <int O> __device__ __forceinline__ float shx(float v) {
    return __int_as_float(__builtin_amdgcn_ds_swizzle(__float_as_int(v), (O << 10) | 0x1f)); }
__device__ __forceinline__ float rdl(float v, int l) { return __int_as_float(__builtin_amdgcn_readlane(__float_as_int(v), l)); }
__device__ __forceinline__ int rdli(int v, int l) { return __builtin_amdgcn_readlane(v, l); }
__device__ __forceinline__ float wave_sum(float v) {
    v += shx<1>(v); v += shx<2>(v); v += shx<4>(v); v += shx<8>(v); v += shx<16>(v);
    const auto r = __builtin_amdgcn_permlane32_swap(__float_as_uint(v), __float_as_uint(v), false, false);
    return __uint_as_float(r[0]) + __uint_as_float(r[1]);
}
__device__ __forceinline__ float wave_max(float v) {
    v = fmaxf(v, shx<1>(v)); v = fmaxf(v, shx<2>(v)); v = fmaxf(v, shx<4>(v)); v = fmaxf(v, shx<8>(v)); v = fmaxf(v, shx<16>(v));
    const auto r = __builtin_amdgcn_permlane32_swap(__float_as_uint(v), __float_as_uint(v), false, false);
    return fmaxf(__uint_as_float(r[0]), __uint_as_float(r[1]));
}
__device__ __forceinline__ float sigmoidf_(float x) { return 1.0f / (1.0f + __expf(-x)); }
__device__ __forceinline__ float siluf_(float x) { return x / (1.0f + __expf(-x)); }
__device__ __forceinline__ void unpack8(const u32x4 w, float (&v)[8]) {
    v[0] = __uint_as_float(w.x << 16); v[1] = __uint_as_float(w.x & 0xffff0000u);
    v[2] = __uint_as_float(w.y << 16); v[3] = __uint_as_float(w.y & 0xffff0000u);
    v[4] = __uint_as_float(w.z << 16); v[5] = __uint_as_float(w.z & 0xffff0000u);
    v[6] = __uint_as_float(w.w << 16); v[7] = __uint_as_float(w.w & 0xffff0000u);
}
__device__ __forceinline__ void lds_wait() { asm volatile("s_waitcnt lgkmcnt(0)" ::: "memory"); }

#define XB_TMO      128
#define XB_XCNT(j)  (256  + 64 * (j))
#define XB_XSUB(j)  (1280 + 64 * (j))
#define XB_XGEN(j)  (2304 + 64 * (j))
#define XB_TOP      3328
#define XB_TOPGEN   3392
#define XCD_BAR_WORDS 3456
#define XB_SPIN_CAP (1u << 22)
__device__ __forceinline__ unsigned xb_ld(unsigned* p)              { return __hip_atomic_load(p, __ATOMIC_RELAXED, __HIP_MEMORY_SCOPE_AGENT); }
__device__ __forceinline__ unsigned xb_add(unsigned* p, unsigned v) { return __hip_atomic_fetch_add(p, v, __ATOMIC_RELAXED, __HIP_MEMORY_SCOPE_AGENT); }
__device__ __forceinline__ unsigned xb_xcc_id() { return (unsigned)__builtin_amdgcn_s_getreg((3 << 11) | 20) & 0xFu; }
#define XB_SPIN(cond, bar) do { unsigned _sp = 0; while (cond) { __builtin_amdgcn_s_sleep(1); \
    if ((++_sp & 255u) == 0u) { if (xb_ld(&(bar)[XB_TMO])) break; if (_sp > XB_SPIN_CAP) { atomicAdd(&(bar)[XB_TMO], 1u); break; } } } } while (0)
struct XcdBarrier { unsigned* bar; unsigned x; volatile LAS unsigned* st; };
__device__ __forceinline__ XcdBarrier xcd_barrier_post(unsigned* bar, volatile LAS unsigned* st) {
    XcdBarrier b; b.bar = bar; b.x = xb_xcc_id(); b.st = st;
    if (threadIdx.x == 0) (void)xb_add(&bar[XB_XCNT(b.x)], 1u);
    return b;
}
__device__ __forceinline__ void xcd_barrier_complete(unsigned* bar, unsigned x, unsigned& nloc, unsigned& nx) {
    const unsigned G = gridDim.x * gridDim.y * gridDim.z;
    unsigned sum, cnt, mine, sp = 0u;
    for (;;) {
        sum = 0u; cnt = 0u; mine = 0u;
#pragma unroll
        for (unsigned j = 0; j < 16; ++j) { const unsigned c = xb_ld(&bar[XB_XCNT(j)]); sum += c; cnt += (c > 0u) ? 1u : 0u; mine = (j == x) ? c : mine; }
        if (sum == G) break;
        __builtin_amdgcn_s_sleep(1);
        if ((++sp & 255u) == 0u) { if (xb_ld(&bar[XB_TMO])) break; if (sp > XB_SPIN_CAP) { atomicAdd(&bar[XB_TMO], 1u); break; } }
    }
    nloc = mine > 0u ? mine : 1u; nx = cnt > 0u ? cnt : 1u;
}
__device__ __forceinline__ void xcd_barrier(const XcdBarrier& b) {
    asm volatile("s_waitcnt vmcnt(0)" ::: "memory");
    __syncthreads();
    if (threadIdx.x == 0) {
        unsigned* bar = b.bar;
        __builtin_amdgcn_s_waitcnt(0);
        unsigned nloc = b.st[0], nx = b.st[1];
        if (nloc == 0u) { xcd_barrier_complete(bar, b.x, nloc, nx); b.st[0] = nloc; b.st[1] = nx; }
        const unsigned old = xb_add(&bar[XB_XSUB(b.x)], 1u);
        const unsigned gen = old / nloc;
        if (old + 1u == (gen + 1u) * nloc) {
            __builtin_amdgcn_fence(__ATOMIC_RELEASE, "agent");
            asm volatile("s_waitcnt vmcnt(0)" ::: "memory");
            const unsigned og = xb_add(&bar[XB_TOP], 1u);
            const unsigned tg = og / nx;
            if (og + 1u == (tg + 1u) * nx) xb_add(&bar[XB_TOPGEN], 1u);
            else XB_SPIN(xb_ld(&bar[XB_TOPGEN]) == tg, bar);
            __builtin_amdgcn_fence(__ATOMIC_ACQUIRE, "agent");
            xb_add(&bar[XB_XGEN(b.x)], 1u);
            asm volatile("s_waitcnt vmcnt(0)" ::: "memory");
        } else {
            XB_SPIN(xb_ld(&bar[XB_XGEN(b.x)]) == gen, bar);
            __builtin_amdgcn_fence(__ATOMIC_ACQUIRE, "agent");
            asm volatile("s_waitcnt vmcnt(0)" ::: "memory");
        }
    }
    __syncthreads();
}

namespace pg8 {
constexpr int BM = 256, BK = 64, HALF = 128, HTB = HALF * BK * 2, STAGE_BYTES = 8 * HTB, NXCD = 8, WGM = 8;
__device__ __forceinline__ int lds_byte(int r, int c) { const int st = (r >> 4) * 2 + (c >> 5), rr = r & 15, cc = c & 31, ob = rr * 64 + cc * 2; return st * 1024 + (ob ^ (((ob >> 9) & 1) << 5)); }
__device__ __forceinline__ void stage_rc(int b, int& R, int& C) { const int st = b / 1024, sb = b % 1024, swz = sb ^ (((sb >> 9) & 1) << 5); R = (st >> 1) * 16 + swz / 64; C = (st & 1) * 32 + (swz % 64) / 2; }
__device__ __forceinline__ int perm32(int rho) { const int n = rho >> 4, i = rho & 15; return 8 * (i >> 2) + 4 * n + (i & 3); }

struct Unit { int pm, pn, e; const char* B; };

struct DenseOrder {
    int nM, nN, nwg, G, c; const char* Bt; size_t btile;
    __device__ __forceinline__ void init(int nM_, int nN_, int G_, int c_, const bf16* Bt_, int K) { nM = nM_; nN = nN_; nwg = nM * nN; G = G_; c = c_; Bt = (const char*)Bt_; btile = (size_t)256 * K * 2; }
    __device__ __forceinline__ bool next(int i, Unit& u) const {
        const long L = (long)i * G + c; if (L >= nwg) return false;
        int wgid = (int)L; { const int q = nwg / NXCD, r = nwg % NXCD, xcd = wgid % NXCD, off = wgid / NXCD; wgid = (xcd < r ? xcd * (q + 1) : r * (q + 1) + (xcd - r) * q) + off; }
        const int nig = WGM * nN, gid = wgid / nig, fm = gid * WGM, gsz = (nM - fm) < WGM ? (nM - fm) : WGM;
        u.pm = fm + ((wgid % nig) % gsz); u.pn = (wgid % nig) / gsz; u.e = 0; u.B = Bt + (size_t)u.pn * btile; return true;
    }
};
struct RowsDense { unsigned ldab; __device__ __forceinline__ unsigned off(const Unit& u, int r) const { return (unsigned)(u.pm * 256 + r) * ldab; } };
struct RowsGather { const int* list; unsigned ldab; __device__ __forceinline__ unsigned off(const Unit& u, int r) const { return (unsigned)list[u.pm * 256 + r] * ldab; } };

template <bool FP8, class Epi, class Sched, class Rows>
__device__ __forceinline__ void gemm_phase(LAS unsigned char* lds, const char* Abase, const int K, const Sched& S, const Rows& RW, const Epi& E) {
    int tid_ = threadIdx.x; asm volatile("" : "+v"(tid_));
    const int tid = tid_, wid = __builtin_amdgcn_readfirstlane(tid >> 6), lane = tid & 63, wr = wid >> 2, wc = wid & 3, fr = lane & 15, fq = lane >> 4;
    const int nt = K / BK;
    int sR[2]; unsigned sC[2], voffB[2];
#pragma unroll
    for (int i = 0; i < 2; ++i) { int R, C; stage_rc(tid * 16 + i * 8192, R, C); sR[i] = R; sC[i] = (unsigned)C * 2u; const int Rb = (R & ~31) + perm32(R & 31); voffB[i] = (unsigned)(Rb * K + C) * 2u; }
    const size_t kstep = (size_t)(BK * 2);
    const size_t hstepB = (size_t)HALF * K * 2;
    const unsigned ldsw = (unsigned)wid * 1024u;
    const int aoff = lds_byte(wr * 64 + fr, fq * 8), boff = lds_byte(wc * 32 + fr, fq * 8);
#define PG8_SA(b, h) (((b) * 2 + (h)) * HTB)
#define PG8_SB(b, h) ((4 + (b) * 2 + (h)) * HTB)
#define PG8_STAGE(bufoff, gbase, voff) do { const char* _gb = (const char*)(gbase); asm volatile("" : "+s"(_gb)); _Pragma("unroll") for (int _i = 0; _i < 2; ++_i) { unsigned _o = (voff)[_i]; asm volatile("" : "+v"(_o)); \
        __builtin_amdgcn_global_load_lds((const unsigned*)(_gb + _o), (LAS unsigned*)(lds + (bufoff) + ldsw + _i * 8192), 16, 0, 0); } } while (0)
#define PG8_LDA(dst, b, h) do { _Pragma("unroll") for (int m = 0; m < 4; ++m) dst[m] = PG8_CAT(*(const LAS i32x4*)(lds + PG8_SA(b, h) + aoff + m * 2048), *(const LAS i32x4*)(lds + PG8_SA(b, h) + aoff + m * 2048 + 1024)); } while (0)
#define PG8_LDB(dst, b, h) do { _Pragma("unroll") for (int n = 0; n < 2; ++n) dst[n] = PG8_CAT(*(const LAS i32x4*)(lds + PG8_SB(b, h) + boff + n * 2048), *(const LAS i32x4*)(lds + PG8_SB(b, h) + boff + n * 2048 + 1024)); } while (0)
#define PG8_CAT(x0, x1) __builtin_shufflevector((x0), (x1), 0, 1, 2, 3, 4, 5, 6, 7)
#define PG8_LO(x) __builtin_bit_cast(bf16x8, __builtin_shufflevector((x), (x), 0, 1, 2, 3))
#define PG8_HI(x) __builtin_bit_cast(bf16x8, __builtin_shufflevector((x), (x), 4, 5, 6, 7))
#define PG8_MMA(ai, bj, At, Bt) do { __builtin_amdgcn_s_setprio(1); \
        if (FP8) { _Pragma("unroll") for (int m = 0; m < 4; ++m) _Pragma("unroll") for (int n = 0; n < 2; ++n) \
            acc[ai][bj][m][n] = __builtin_amdgcn_mfma_scale_f32_16x16x128_f8f6f4(Bt[n], At[m], acc[ai][bj][m][n], 0, 0, 0, 0x7f7f7f7f, 0, 0x7f7f7f7f); } \
        else { _Pragma("unroll") for (int m = 0; m < 4; ++m) _Pragma("unroll") for (int n = 0; n < 2; ++n) { \
            acc[ai][bj][m][n] = __builtin_amdgcn_mfma_f32_16x16x32_bf16(PG8_LO(Bt[n]), PG8_LO(At[m]), acc[ai][bj][m][n], 0, 0, 0); \
            acc[ai][bj][m][n] = __builtin_amdgcn_mfma_f32_16x16x32_bf16(PG8_HI(Bt[n]), PG8_HI(At[m]), acc[ai][bj][m][n], 0, 0, 0); } } \
        __builtin_amdgcn_s_setprio(0); } while (0)
#define PG8_WAIT_V(n) asm volatile("s_waitcnt vmcnt(" #n ")" ::: "memory")
#define PG8_WAIT_L(n) asm volatile("s_waitcnt lgkmcnt(" #n ")" ::: "memory")
#define PG8_BAR __builtin_amdgcn_s_barrier()
#define PG8_SCHED __builtin_amdgcn_sched_barrier(0)
    Unit cur, nxt; int ui = 0;
    if (!S.next(0, cur)) return;
    f32x4 acc[2][2][4][2];
#pragma unroll
    for (int a = 0; a < 2; ++a)
#pragma unroll
        for (int b = 0; b < 2; ++b)
#pragma unroll
            for (int m = 0; m < 4; ++m)
#pragma unroll
                for (int n = 0; n < 2; ++n) acc[a][b][m][n] = (f32x4){0.f, 0.f, 0.f, 0.f};
    i32x8 At[4], B0[2], B1[2];
    unsigned oA0[2], oA1[2];
#pragma unroll
    for (int i = 0; i < 2; ++i) { oA0[i] = RW.off(cur, sR[i]) + sC[i]; oA1[i] = RW.off(cur, HALF + sR[i]) + sC[i]; }
    const char* cB = cur.B;
    PG8_STAGE(PG8_SB(0, 0), cB, voffB); PG8_STAGE(PG8_SB(0, 1), cB + hstepB, voffB); PG8_STAGE(PG8_SA(0, 0), Abase, oA0); PG8_STAGE(PG8_SA(0, 1), Abase, oA1);
    if (wr == 1) PG8_BAR;
    PG8_WAIT_V(2); PG8_BAR;
    PG8_STAGE(PG8_SB(1, 0), cB + kstep, voffB); PG8_STAGE(PG8_SA(1, 0), Abase + kstep, oA0); PG8_STAGE(PG8_SB(1, 1), cB + hstepB + kstep, voffB);
    PG8_WAIT_V(6); PG8_BAR;
    for (;;) {
        const bool has_next = S.next(ui + 1, nxt);
        unsigned gi0 = 0u, gi1 = 0u, gi2 = 0u, gi3 = 0u;
        if (has_next && RW.list) {
            int t2 = threadIdx.x; asm volatile("" : "+v"(t2)); int R0, C0, R1, C1; stage_rc(t2 * 16, R0, C0); stage_rc(t2 * 16 + 8192, R1, C1);
            const int* lb = RW.list + (size_t)nxt.pm * 256; const unsigned o0 = (unsigned)R0 * 4u, o1 = (unsigned)R1 * 4u, o2 = (unsigned)(HALF + R0) * 4u, o3 = (unsigned)(HALF + R1) * 4u;
            asm volatile("global_load_dword %0, %4, %8\n\tglobal_load_dword %1, %5, %8\n\tglobal_load_dword %2, %6, %8\n\tglobal_load_dword %3, %7, %8"
                         : "=&v"(gi0), "=&v"(gi1), "=&v"(gi2), "=&v"(gi3) : "v"(o0), "v"(o1), "v"(o2), "v"(o3), "s"(lb));
        }
#pragma unroll 1
        for (int t = 0; t < nt; t += 2) {
            const bool last = (t == nt - 2);
            const char* a1 = Abase + (size_t)(t + 1) * kstep;
            PG8_LDB(B0, 0, 0); PG8_LDB(B1, 0, 1); PG8_SCHED; PG8_LDA(At, 0, 0); PG8_STAGE(PG8_SA(1, 1), a1, oA1);
            PG8_WAIT_V(8); PG8_WAIT_L(0); PG8_BAR; PG8_MMA(0, 0, At, B0); PG8_MMA(0, 1, At, B1); PG8_BAR; PG8_SCHED;
            const char* a2; const char* b2;
            if (last) {
                if (has_next) {
                    int t2 = threadIdx.x; asm volatile("" : "+v"(t2));
#pragma unroll
                    for (int i = 0; i < 2; ++i) { int R, C; stage_rc(t2 * 16 + i * 8192, R, C);
                        if (RW.list) { asm volatile("" : "+v"(gi0), "+v"(gi1), "+v"(gi2), "+v"(gi3)); oA0[i] = (i ? gi1 : gi0) * RW.ldab + (unsigned)C * 2u; oA1[i] = (i ? gi3 : gi2) * RW.ldab + (unsigned)C * 2u; }
                        else { oA0[i] = (unsigned)(nxt.pm * 256 + R) * RW.ldab + (unsigned)C * 2u; oA1[i] = (unsigned)(nxt.pm * 256 + HALF + R) * RW.ldab + (unsigned)C * 2u; } }
                    cB = nxt.B;
                }
                a2 = Abase; b2 = cB;
            } else { a2 = Abase + (size_t)(t + 2) * kstep; b2 = cB + (size_t)(t + 2) * kstep; }
            const char* a3 = a2 + kstep; const char* b3 = b2 + kstep;
            PG8_LDA(At, 0, 1); PG8_STAGE(PG8_SB(0, 0), b2, voffB); PG8_STAGE(PG8_SB(0, 1), b2 + hstepB, voffB); PG8_STAGE(PG8_SA(0, 0), a2, oA0);
            PG8_WAIT_V(8); PG8_WAIT_L(0); PG8_BAR; PG8_MMA(1, 0, At, B0); PG8_MMA(1, 1, At, B1); PG8_BAR; PG8_SCHED;
            PG8_LDB(B0, 1, 0); PG8_LDB(B1, 1, 1); PG8_SCHED; PG8_LDA(At, 1, 0); PG8_STAGE(PG8_SA(0, 1), a2, oA1);
            PG8_WAIT_V(8); PG8_WAIT_L(0); PG8_BAR; PG8_MMA(0, 0, At, B0); PG8_MMA(0, 1, At, B1); PG8_BAR; PG8_SCHED;
            PG8_LDA(At, 1, 1); PG8_STAGE(PG8_SB(1, 0), b3, voffB); PG8_STAGE(PG8_SB(1, 1), b3 + hstepB, voffB); PG8_STAGE(PG8_SA(1, 0), a3, oA0);
            PG8_WAIT_V(8); PG8_WAIT_L(0); PG8_BAR; PG8_MMA(1, 0, At, B0); PG8_MMA(1, 1, At, B1); PG8_BAR; PG8_SCHED;
        }
        if (wr == 0) PG8_BAR;
        { Unit eu = cur; asm volatile("" : "+s"(eu.pm), "+s"(eu.pn)); int t3 = threadIdx.x; asm volatile("" : "+v"(t3)); E(acc, eu, wr, wc, t3 & 15, (t3 & 63) >> 4); }
        if (!has_next) break;
#pragma unroll
        for (int a = 0; a < 2; ++a)
#pragma unroll
            for (int b = 0; b < 2; ++b)
#pragma unroll
                for (int m = 0; m < 4; ++m)
#pragma unroll
                    for (int n = 0; n < 2; ++n) acc[a][b][m][n] = (f32x4){0.f, 0.f, 0.f, 0.f};
        cur = nxt; ++ui;
        if (wr == 1) PG8_BAR;
    }
    PG8_WAIT_V(0);
    PG8_BAR;
#undef PG8_SA
#undef PG8_SB
#undef PG8_STAGE
#undef PG8_LDA
#undef PG8_LDB
#undef PG8_MMA
#undef PG8_CAT
#undef PG8_LO
#undef PG8_HI
#undef PG8_WAIT_V
#undef PG8_WAIT_L
#undef PG8_BAR
#undef PG8_SCHED
}
}

struct Params { const float* in[42]; float* out; unsigned char* ws; int ph_lo, ph_hi; };
enum { I_X = 0, I_C, I_CTX, I_CCTX, I_ADAW, I_ADAB, I_N1G, I_N2G, I_WIN, I_WOUT, I_GLAW, I_GLAB, I_GLAG, I_CDW, I_CDB, I_CLG, I_CLB, I_CPW, I_CPB,
       I_S5LR, I_S5LI, I_S5DT, I_S5BR, I_S5BI, I_S5CR, I_S5CI, I_S5D, I_S5GW, I_S5GB, I_QNG, I_KVNG, I_WUQ, I_WUKV, I_RW, I_RB, I_MG, I_MU, I_MD, I_SG, I_SU, I_SD, I_FG };

typedef const __attribute__((address_space(4))) Params* KParams;
__device__ __forceinline__ KParams fresh_params() { KParams kp = (KParams)__builtin_amdgcn_kernarg_segment_ptr(); asm volatile("" : "+s"(kp)); return kp; }
struct Ctx {
    LAS unsigned char* lds;
    int tid, lane, wave, blk, G;
    unsigned char* ws;
};

__device__ __forceinline__ int mod_row(int r) { return r < NLAT ? (r >> 11) : 32; }

__device__ __forceinline__ unsigned pk4_fp8(float a, float b, float c2, float d) {
    int pk = __builtin_amdgcn_cvt_pk_fp8_f32(__builtin_amdgcn_fmed3f(a, -440.f, 440.f), __builtin_amdgcn_fmed3f(b, -440.f, 440.f), 0, false);
    pk = __builtin_amdgcn_cvt_pk_fp8_f32(__builtin_amdgcn_fmed3f(c2, -440.f, 440.f), __builtin_amdgcn_fmed3f(d, -440.f, 440.f), pk, true); return (unsigned)pk; }
template <bool F8 = false>
__device__ __forceinline__ void tr_item(const float* W, int ldw, int k0, int n0, bf16* dst, int ldk, const float* kscale, float sc, LAS float* scr, int lane) {
    float tv[32];
#pragma unroll
    for (int i = 0; i < 32; ++i) tv[i] = W[(size_t)(k0 + 2 * i + (lane >> 5)) * ldw + n0 + (lane & 31)];
#pragma unroll
    for (int i = 0; i < 32; ++i) { const int kk = 2 * i + (lane >> 5); float v = tv[i] * sc; if (kscale) v *= kscale[k0 + kk]; scr[kk * 33 + (lane & 31)] = v; }
    lds_wait();
    const int c = lane & 7;
#pragma unroll
    for (int j = 0; j < 4; ++j) { const int n = (lane >> 3) + 8 * j; const LAS float* s = scr + (8 * c) * 33 + n;
        if (F8) { u32x2 o; o.x = pk4_fp8(s[0 * 33], s[1 * 33], s[2 * 33], s[3 * 33]); o.y = pk4_fp8(s[4 * 33], s[5 * 33], s[6 * 33], s[7 * 33]); *(u32x2*)((unsigned char*)dst + (size_t)n * ldk + k0 + 8 * c) = o; }
        else { u32x4 o; o.x = pk2(s[0 * 33], s[1 * 33]); o.y = pk2(s[2 * 33], s[3 * 33]); o.z = pk2(s[4 * 33], s[5 * 33]); o.w = pk2(s[6 * 33], s[7 * 33]);
            *(u32x4*)(dst + (size_t)n * ldk + k0 + 8 * c) = o; } }
    lds_wait();
}
template <int KIND> __device__ __forceinline__ int tr_dst(int n0) {
    if (KIND == 0) return n0;
    if (KIND == 1) return n0 < 768 ? n0 : (n0 == 768 ? 1952 : n0 - 32);
    if (KIND == 2) { const int half = n0 >> 8, c = n0 & 255; return (c >> 7) * 256 + half * 128 + (c & 127); }
    if (KIND == 3) { const int head = n0 / 96, d0 = n0 % 96; return d0 < 64 ? head * 64 + d0 : 256 + head * 32; }
    if (KIND == 4) { const int head = n0 >> 7, d0 = n0 & 127; return d0 < 64 ? head * 64 + d0 : 256 + head * 64 + (d0 - 64); }
    if (KIND == 5) return (n0 >> 7) * 256 + (n0 & 127);
    if (KIND == 6) return (n0 >> 7) * 256 + 128 + (n0 & 127);
    return n0;
}
template <int KIND, bool F8 = false> __device__ __forceinline__ void tr_matrix(const Ctx& c, const float* W, int ldw, int K, int Nsrc, bf16* WT, int ldk, const float* kscale, float sc) {
    LAS float* scr = (LAS float*)(c.lds + c.wave * 8704);
    const int gw = c.blk * NWAVES + c.wave, NGW = c.G * NWAVES, ng = Nsrc / 32, items = (K / 64) * ng;
    for (int it = gw; it < items; it += NGW) { const int kb = it / ng, g = it % ng; tr_item<F8>(W, ldw, kb * 64, 32 * g, F8 ? (bf16*)((unsigned char*)WT + (size_t)tr_dst<KIND>(32 * g) * ldk) : WT + (size_t)tr_dst<KIND>(32 * g) * ldk, ldk, kscale, sc, scr, c.lane); }
}
__device__ __forceinline__ void zero_fill16(const Ctx& c, void* p, size_t bytes) {
    u32x4* q = (u32x4*)p; const size_t n = bytes / 16;
    for (size_t i = (size_t)c.blk * NTHR + c.tid; i < n; i += (size_t)c.G * NTHR) q[i] = (u32x4){0u, 0u, 0u, 0u};
}
__device__ __forceinline__ void sincos_r(float x, float& s, float& co) {
    const float n = rintf(x * 0.15915494309189535f);
    float r = fmaf(n, -6.28125f, x); r = fmaf(n, -1.9353071795864769e-3f, r);
    s = __sinf(r); co = __cosf(r);
}

__device__ __forceinline__ void prologue_moe_weights(const Ctx& c, KParams p, int l) {
    unsigned char* WGU8 = c.ws + WS_WMOE + (size_t)l * 48 * MiB;
    unsigned char* WD8 = WGU8 + (size_t)NE * 512 * 1024;
    LAS float* scr = (LAS float*)(c.lds + c.wave * 8704);
    const int gw = c.blk * NWAVES + c.wave, NGW = c.G * NWAVES;
    for (int it = gw; it < NE * 384; it += NGW) {
        const int e = it / 384, r = it % 384;
        if (r < 256) { const int up = r >> 7, q = r & 127, kb = q >> 3, g = q & 7;
            const float* W = p->in[up ? I_MU : I_MG] + ((size_t)l * NE + e) * 1024 * 256;
            const int nd = up ? tr_dst<6>(32 * g) : tr_dst<5>(32 * g);
            tr_item<true>(W, 256, kb * 64, 32 * g, (bf16*)(WGU8 + (size_t)e * 512 * 1024 + (size_t)nd * 1024), 1024, nullptr, 64.f, scr, c.lane);
        } else { const int q = r - 256, kb = q >> 5, g = q & 31;
            const float* W = p->in[I_MD] + ((size_t)l * NE + e) * 256 * 1024;
            tr_item<true>(W, 1024, kb * 64, 32 * g, (bf16*)(WD8 + (size_t)e * 1024 * 256 + (size_t)(32 * g) * 256), 256, nullptr, 64.f, scr, c.lane);
        }
    }
}

__device__ __forceinline__ void prologue(const Ctx& c, KParams p) {
    float* MOD = (float*)(c.ws + WS_MOD);
    {
        const int u = c.G - 1 - c.blk;
        if (u < 96) {
            LAS float* sc = (LAS float*)(c.lds + 72 * 1024);
            LAS float* part = (LAS float*)c.lds;
            const int l = u / 48, kq = c.tid >> 7, cj = c.tid & 127, col = (u % 48) * 128 + cj;
            const float* W = p->in[I_ADAW] + (size_t)l * 1024 * 6144;
            float acc[33];
#pragma unroll
            for (int b = 0; b < 33; ++b) acc[b] = 0.f;
            for (int j = 0; j < 4; ++j) {
                __syncthreads();
                for (int i = c.tid; i < 4 * 33 * 64; i += NTHR) { const int q = i / (33 * 64), r = i % (33 * 64), b = r >> 6, kk = r & 63, k = 256 * q + 64 * j + kk; const float v = b < 32 ? p->in[I_C][b * 1024 + k] : p->in[I_CCTX][k]; sc[i] = siluf_(v); }
                __syncthreads();
                const float* wp = W + (size_t)(256 * kq + 64 * j) * 6144 + col; const LAS float* sq = sc + kq * 33 * 64;
#pragma unroll 8
                for (int kk = 0; kk < 64; ++kk) { const float w = wp[(size_t)kk * 6144];
#pragma unroll
                    for (int b = 0; b < 33; ++b) acc[b] = fmaf(sq[b * 64 + kk], w, acc[b]); }
            }
#pragma unroll
            for (int b = 0; b < 33; ++b) part[(kq * 33 + b) * 128 + cj] = acc[b];
            __syncthreads();
            for (int i = c.tid; i < 33 * 128; i += NTHR) { const int b = i >> 7, cc = i & 127, gc = (u % 48) * 128 + cc;
                MOD[((size_t)l * 33 + b) * 6144 + gc] = (part[(0 * 33 + b) * 128 + cc] + part[(1 * 33 + b) * 128 + cc]) + (part[(2 * 33 + b) * 128 + cc] + part[(3 * 33 + b) * 128 + cc]) + p->in[I_ADAB][l * 6144 + gc]; }
            __syncthreads();
        }
    }
    {
        float* ROPE = (float*)(c.ws + WS_TAB + TAB_ROPE);
        for (int i = c.blk * NTHR + c.tid; i < 2048 * 16; i += c.G * NTHR) { const int t = i >> 4, ax = (i >> 3) & 1, f = i & 7;
            const float pos = (float)(ax == 0 ? (t >> 6) : (t & 63)); const float inv = __expf(-(float)f * (9.210340371976184f / 8.0f));
            float s, co; sincos_r(pos * inv, s, co); ROPE[i * 2] = co; ROPE[i * 2 + 1] = s; }
        bf16* RWT = (bf16*)(c.ws + WS_TAB + TAB_RWT);
        for (int i = c.blk * NTHR + c.tid; i < 2 * 64 * 1024; i += c.G * NTHR) { const int l = i >> 16, n = (i >> 10) & 63, k = i & 1023; const float wv = p->in[I_RW][((size_t)l * 1024 + k) * 64 + n];
            const bf16 hi = f2bf(wv); RWT[(size_t)(l * 2) * 65536 + n * 1024 + k] = hi; RWT[(size_t)(l * 2 + 1) * 65536 + n * 1024 + k] = f2bf(wv - bf2f(hi)); }
        float* S5T = (float*)(c.ws + WS_TAB + TAB_S5);
        for (int i = c.blk * NTHR + c.tid; i < 2 * 2 * 16 * 64; i += c.G * NTHR) {
            const int pp = i & 63, g = (i >> 6) & 15, ld = i >> 10;
            const float lr = p->in[I_S5LR][i], li = p->in[I_S5LI][i], dt = __expf(p->in[I_S5DT][ld * 16 + g]);
            const float mag = __expf(lr * dt); float s, co; sincos_r(li * dt, s, co);
            const float are = mag * co, aim = mag * s, den = lr * lr + li * li;
            const float fre = ((are - 1.f) * lr + aim * li) / den, fim = (aim * lr - (are - 1.f) * li) / den;
            float* T = S5T + (size_t)i * 66; T[0] = are; T[1] = aim;
            { float* PW = (float*)(c.ws + WS_S5P) + (size_t)i * 34; float pr = 1.f, pi = 0.f;
              for (int e = 0; e <= 16; ++e) { PW[2 * e] = pr; PW[2 * e + 1] = pi; const float nr = pr * are - pi * aim, ni = pr * aim + pi * are; pr = nr; pi = ni; } }
            for (int ch = 0; ch < 16; ++ch) { const float br = p->in[I_S5BR][(size_t)i * 16 + ch], bi = p->in[I_S5BI][(size_t)i * 16 + ch];
                T[2 + ch] = fre * br - fim * bi; T[18 + ch] = fre * bi + fim * br;
                T[34 + ch] = p->in[I_S5CR][((size_t)(ld * 16 + g) * 16 + ch) * 64 + pp]; T[50 + ch] = p->in[I_S5CI][((size_t)(ld * 16 + g) * 16 + ch) * 64 + pp]; }
        }
    }
    for (int l = 0; l < 2; ++l) {
        bf16* WIN = (bf16*)(c.ws + WS_WIN) + (size_t)l * 2048 * 1024;
        tr_matrix<1>(c, p->in[I_WIN] + (size_t)l * 1024 * 1984, 1984, 1024, 1984, WIN, 1024, nullptr, 1.f);
        zero_fill16(c, WIN + (size_t)1984 * 1024, (size_t)64 * 1024 * 2);
        tr_matrix<0>(c, p->in[I_WOUT] + (size_t)l * 1024 * 1024, 1024, 1024, 1024, (bf16*)(c.ws + WS_WOUT) + (size_t)l * 1024 * 1024, 1024, nullptr, 1.f);
        unsigned char* sm = c.ws + WS_WSM + (size_t)l * WSM_L;
        tr_matrix<0>(c, p->in[I_CPW] + (size_t)l * 256 * 256, 256, 256, 256, (bf16*)(sm + WSM_PW), 256, nullptr, 1.f);
        tr_matrix<2>(c, p->in[I_S5GW] + (size_t)l * 256 * 512, 512, 256, 512, (bf16*)(sm + WSM_GLU), 256, nullptr, 1.f);
        tr_matrix<3>(c, p->in[I_WUQ] + (size_t)l * 256 * 384, 384, 256, 384, (bf16*)(sm + WSM_UQ), 256, p->in[I_QNG] + l * 256, 0.14724445f  );
        zero_fill16(c, (bf16*)(sm + WSM_UQ) + (size_t)384 * 256, (size_t)128 * 256 * 2);
        zero_fill16(c, sm + WSM_UK, (size_t)512 * 256 * 2);
    }
    for (int l = 0; l < 2; ++l) {
        bf16* WSGU = (bf16*)(c.ws + WS_WSH) + (size_t)l * (512 * 1024 + 1024 * 256); bf16* WSD = WSGU + 512 * 1024;
        tr_matrix<5, true>(c, p->in[I_SG] + (size_t)l * 1024 * 256, 256, 1024, 256, WSGU, 1024, nullptr, 64.f);
        tr_matrix<6, true>(c, p->in[I_SU] + (size_t)l * 1024 * 256, 256, 1024, 256, WSGU, 1024, nullptr, 64.f);
        tr_matrix<0, true>(c, p->in[I_SD] + (size_t)l * 256 * 1024, 1024, 256, 1024, (bf16*)((unsigned char*)WSGU + 512 * 1024), 256, nullptr, 64.f);
    }
    prologue_moe_weights(c, p, 0);
    prologue_moe_weights(c, p, 1);
}
__device__ __forceinline__ void prologue_s5_weights(const Ctx& c, KParams p) {
    const float* S5T = (const float*)(c.ws + WS_TAB + TAB_S5); const float* S5P = (const float*)(c.ws + WS_S5P);
    LAS float* pw = (LAS float*)c.lds;
    LAS float* bb = pw + 2 * 17 * 64 * 2;
    LAS float* cc = bb + 2 * 64 * 16 * 2;
    LAS float* kt = cc + 2 * 16 * 64 * 2;
    for (int u = c.blk; u < 32; u += c.G) {
        const int l = u >> 4, g = u & 15;
        __syncthreads();
        for (int i = c.tid; i < 2 * 64; i += NTHR) { const int dir = i >> 6, pp = i & 63; const size_t row = (size_t)((l * 2 + dir) * 16 + g) * 64 + pp; const float* T = S5T + row * 66; const float* PW = S5P + row * 34;
            for (int e = 0; e <= 16; ++e) { pw[((dir * 17 + e) * 64 + pp) * 2] = PW[2 * e]; pw[((dir * 17 + e) * 64 + pp) * 2 + 1] = PW[2 * e + 1]; }
            for (int ch = 0; ch < 16; ++ch) { bb[((dir * 64 + pp) * 16 + ch) * 2] = T[2 + ch]; bb[((dir * 64 + pp) * 16 + ch) * 2 + 1] = T[18 + ch]; cc[((dir * 16 + ch) * 64 + pp) * 2] = T[34 + ch]; cc[((dir * 16 + ch) * 64 + pp) * 2 + 1] = T[50 + ch]; } }
        __syncthreads();
        for (int i = c.tid; i < 2 * 16 * 256; i += NTHR) { const int dir = i >> 12, tau = (i >> 8) & 15, c1 = (i >> 4) & 15, c0 = i & 15; float s = 0.f;
            for (int pp = 0; pp < 64; ++pp) { const float cr = cc[((dir * 16 + c1) * 64 + pp) * 2], ci = cc[((dir * 16 + c1) * 64 + pp) * 2 + 1], pr = pw[((dir * 17 + tau) * 64 + pp) * 2], pi = pw[((dir * 17 + tau) * 64 + pp) * 2 + 1];
                const float wr_ = cr * pr - ci * pi, wi_ = cr * pi + ci * pr; s += wr_ * bb[((dir * 64 + pp) * 16 + c0) * 2] - wi_ * bb[((dir * 64 + pp) * 16 + c0) * 2 + 1]; }
            kt[i] = s; }
        __syncthreads();
        bf16* B1 = (bf16*)(c.ws + WS_S5W) + (size_t)(l * 16 + g) * 256 * 256;
        bf16* B2 = (bf16*)(c.ws + WS_S5W) + (size_t)32 * 256 * 256 + (size_t)(l * 16 + g) * 256 * 512;
        const float* dsk = p->in[I_S5D] + l * 256 + g * 16;
        for (int i = c.tid; i < 256 * 256; i += NTHR) { const int n = i >> 8, k = i & 255, dir = n >> 7, ri = (n >> 6) & 1, pp = n & 63, s = k >> 4, ch = k & 15, e = dir ? s : 15 - s;
            const float pr = pw[((dir * 17 + e) * 64 + pp) * 2], pi = pw[((dir * 17 + e) * 64 + pp) * 2 + 1], br = bb[((dir * 64 + pp) * 16 + ch) * 2], bi = bb[((dir * 64 + pp) * 16 + ch) * 2 + 1];
            B1[i] = f2bf(ri ? pr * bi + pi * br : pr * br - pi * bi); }
        for (int i = c.tid; i < 256 * 512; i += NTHR) { const int n = i >> 9, k = i & 511, t = n >> 4, c1 = n & 15; float v;
            if (k < 256) { const int s = k >> 4, c0 = k & 15; v = 0.f; if (s <= t) v += kt[((0 * 16 + (t - s)) * 16 + c1) * 16 + c0]; if (s >= t) v += kt[((1 * 16 + (s - t)) * 16 + c1) * 16 + c0]; if (s == t && c0 == c1) v += dsk[c0]; }
            else { const int q = k - 256, dir = q >> 7, ri = (q >> 6) & 1, pp = q & 63, e = dir ? 16 - t : t + 1;
                const float cr = cc[((dir * 16 + c1) * 64 + pp) * 2], ci = cc[((dir * 16 + c1) * 64 + pp) * 2 + 1], pr = pw[((dir * 17 + e) * 64 + pp) * 2], pi = pw[((dir * 17 + e) * 64 + pp) * 2 + 1];
                v = ri ? -(cr * pi + ci * pr) : (cr * pr - ci * pi); }
            B2[i] = f2bf(v); }
    }
    __syncthreads();
}
__device__ __forceinline__ void prologue2(const Ctx& c, KParams p) {
    prologue_s5_weights(c, p);
    for (int l = 0; l < 2; ++l) { unsigned char* sm = c.ws + WS_WSM + (size_t)l * WSM_L;
        tr_matrix<4>(c, p->in[I_WUKV] + (size_t)l * 128 * 512, 512, 128, 512, (bf16*)(sm + WSM_UK), 256, p->in[I_KVNG] + l * 128, 1.f); }
}

__device__ __forceinline__ void norm_row(const float* xrow, const float* gain, const float* sh, const float* sc, bf16* orow, int lane, f32x4 (&v)[4]) {
    float ss = 0.f;
#pragma unroll
    for (int j = 0; j < 4; ++j) { v[j] = *(const f32x4*)(xrow + 4 * lane + 256 * j); ss += (v[j].x * v[j].x + v[j].y * v[j].y) + (v[j].z * v[j].z + v[j].w * v[j].w); }
    const float rstd = rsqrtf(wave_sum(ss) * (1.f / 1024.f) + EPS);
#pragma unroll
    for (int j = 0; j < 4; ++j) { const int cc = 4 * lane + 256 * j; const f32x4 g = *(const f32x4*)(gain + cc), s1 = *(const f32x4*)(sc + cc), s0 = *(const f32x4*)(sh + cc);
        v[j] = v[j] * rstd * g * (s1 + 1.0f) + s0;
        u32x2 o; o.x = pk2(v[j].x, v[j].y); o.y = pk2(v[j].z, v[j].w); *(u32x2*)(orow + cc) = o; }
}
__device__ __forceinline__ void norm_row_add(const float* xrow, const bf16* drow, float* xout, const float* gain, const float* sh, const float* sc, unsigned char* orow8, int lane, f32x4 (&v)[4]) {
    float ss = 0.f; u32x2 dl[4];
#pragma unroll
    for (int j = 0; j < 4; ++j) { v[j] = *(const f32x4*)(xrow + 4 * lane + 256 * j); dl[j] = *(const u32x2*)(drow + 4 * lane + 256 * j); }
#pragma unroll
    for (int j = 0; j < 4; ++j) { v[j] += (f32x4){__uint_as_float(dl[j].x << 16), __uint_as_float(dl[j].x & 0xffff0000u), __uint_as_float(dl[j].y << 16), __uint_as_float(dl[j].y & 0xffff0000u)};
        *(f32x4*)(xout + 4 * lane + 256 * j) = v[j]; ss += (v[j].x * v[j].x + v[j].y * v[j].y) + (v[j].z * v[j].z + v[j].w * v[j].w); }
    const float rstd = rsqrtf(wave_sum(ss) * (1.f / 1024.f) + EPS);
#pragma unroll
    for (int j = 0; j < 4; ++j) { const int cc = 4 * lane + 256 * j; const f32x4 g = *(const f32x4*)(gain + cc), s1 = *(const f32x4*)(sc + cc), s0 = *(const f32x4*)(sh + cc);
        v[j] = v[j] * rstd * g * (s1 + 1.0f) + s0;
        *(unsigned*)(orow8 + cc) = pk4_fp8(v[j].x * 4.f, v[j].y * 4.f, v[j].z * 4.f, v[j].w * 4.f); }
}
__device__ __forceinline__ void phase_norm1(const Ctx& c, KParams p, int l) {
    const float* MOD = (const float*)(c.ws + WS_MOD) + (size_t)l * 33 * 6144;
    const float* xl = l == 0 ? p->in[I_X] : p->out; const float* xc = l == 0 ? p->in[I_CTX] : (const float*)(c.ws + WS_XC);
    bf16* H = (bf16*)(c.ws + WS_H); const float* gain = p->in[I_N1G] + l * DM;
    const int gw = c.blk * NWAVES + c.wave, NGW = c.G * NWAVES, lane = c.lane;
    for (int r0 = gw; r0 < NTOK; r0 += 2 * NGW) {
        f32x4 v[2][4]; float ss[2];
#pragma unroll
        for (int k = 0; k < 2; ++k) { const int r = r0 + k * NGW < NTOK ? r0 + k * NGW : r0; const float* xr = r < NLAT ? xl + (size_t)r * DM : xc + (size_t)(r - NLAT) * DM;
#pragma unroll
            for (int j = 0; j < 4; ++j) v[k][j] = *(const f32x4*)(xr + 4 * lane + 256 * j); }
#pragma unroll
        for (int k = 0; k < 2; ++k) { ss[k] = 0.f;
#pragma unroll
            for (int j = 0; j < 4; ++j) ss[k] += (v[k][j].x * v[k][j].x + v[k][j].y * v[k][j].y) + (v[k][j].z * v[k][j].z + v[k][j].w * v[k][j].w); }
#pragma unroll
        for (int k = 0; k < 2; ++k) { const int r = r0 + k * NGW; if (r < NTOK) { const float rstd = rsqrtf(wave_sum(ss[k]) * (1.f / 1024.f) + EPS); const float* m = MOD + (size_t)mod_row(r) * 6144; bf16* orow = H + (size_t)r * DM;
#pragma unroll
            for (int j = 0; j < 4; ++j) { const int cc = 4 * lane + 256 * j; const f32x4 g = *(const f32x4*)(gain + cc), s1 = *(const f32x4*)(m + 1024 + cc), s0 = *(const f32x4*)(m + cc);
                const f32x4 y = v[k][j] * rstd * g * (s1 + 1.0f) + s0; u32x2 o; o.x = pk2(y.x, y.y); o.y = pk2(y.z, y.w); *(u32x2*)(orow + cc) = o; } } }
    }
}

#define EPI_ARGS const f32x4 (&acc)[2][2][4][2], const pg8::Unit& u, int wr, int wc, int fr, int fq
#define EPI_ROWS for (int ai = 0; ai < 2; ++ai) _Pragma("unroll") for (int m = 0; m < 4; ++m)
struct EpiBf16 {
    bf16* O; int ldo;
    __device__ __forceinline__ void operator()(EPI_ARGS) const {
        const int r0 = u.pm * 256 + wr * 64 + fr, c0 = u.pn * 256 + wc * 32 + 8 * fq;
#pragma unroll
        EPI_ROWS { bf16* rp = O + (size_t)(r0 + ai * 128 + m * 16) * ldo + c0;
#pragma unroll
            for (int bj = 0; bj < 2; ++bj) { const f32x4 a = acc[ai][bj][m][0], b = acc[ai][bj][m][1]; u32x4 w; w.x = pk2(a.x, a.y); w.y = pk2(a.z, a.w); w.z = pk2(b.x, b.y); w.w = pk2(b.z, b.w); *(u32x4*)(rp + bj * 128) = w; } asm volatile("" ::: "memory"); }
    }
};
struct EpiInProj {
    bf16* O; bf16* UP; bf16* GVT;
    __device__ __forceinline__ void operator()(EPI_ARGS) const {
        const int r0 = u.pm * 256 + wr * 64 + fr, c0 = u.pn * 256 + wc * 32 + 8 * fq;
#pragma unroll
        EPI_ROWS { const int row = r0 + ai * 128 + m * 16; bf16* rp = O + (size_t)row * ZW + c0;
            const int crow = row < NLAT ? (row >> 11) * 144 + 16 + ((row & 2047) >> 4) : ((row - NLAT) >> 8) * 144 + (((row - NLAT) & 255) >> 4);
#pragma unroll
            for (int bj = 0; bj < 2; ++bj) { const f32x4 a = acc[ai][bj][m][0], b = acc[ai][bj][m][1]; u32x4 w; w.x = pk2(a.x, a.y); w.y = pk2(a.z, a.w); w.z = pk2(b.x, b.y); w.w = pk2(b.z, b.w);
                if (u.pn != 1 && u.pn != 5) *(u32x4*)(rp + bj * 128) = w;
                if (u.pn == 5) { const int g = 8 * bj + 2 * wc + (fq >> 1); *(u32x4*)(UP + ((size_t)g * 4608 + crow) * 512 + fr * 16 + 8 * (fq & 1)) = w; }
                if (u.pn == 1) { const int col = 128 * bj + 32 * wc + 8 * fq, bb = row < NLAT ? (row >> 11) : ((row - NLAT) >> 8), kk = row < NLAT ? 256 + (row & 2047) : ((row - NLAT) & 255);
                    bf16* dst = GVT + ((size_t)(bb * 4 + (col >> 6)) * 64 + (col & 63)) * 2304 + (kk & ~15) + 8 * ((fr >> 2) & 1) + 4 * (fr >> 3) + (fr & 3);
#pragma unroll
                    for (int n = 0; n < 2; ++n)
#pragma unroll
                        for (int i = 0; i < 4; ++i) dst[(size_t)(4 * n + i) * 2304] = f2bf(acc[ai][bj][m][n][i]); } }
            asm volatile("" ::: "memory"); }
    }
};
struct EpiS5X {
    bf16* XE;
    __device__ __forceinline__ void operator()(EPI_ARGS) const {
        const int r0 = u.pm * 256 + wr * 64 + fr, c0 = wc * 32 + 8 * fq;
#pragma unroll
        EPI_ROWS { bf16* rp = XE + (size_t)(r0 + ai * 128 + m * 16) * 256 + c0;
#pragma unroll
            for (int bj = 0; bj < 2; ++bj) { const f32x4 a = acc[ai][bj][m][0], b = acc[ai][bj][m][1]; u32x4 w; w.x = pk2(a.x, a.y); w.y = pk2(a.z, a.w); w.z = pk2(b.x, b.y); w.w = pk2(b.z, b.w); *(u32x4*)(rp + bj * 128) = w; }
            asm volatile("" ::: "memory"); }
    }
};
struct EpiS5Y {
    bf16* Y;
    __device__ __forceinline__ void operator()(EPI_ARGS) const {
        const int r0 = u.pm * 256 + wr * 64 + fr;
#pragma unroll
        EPI_ROWS { const int grow = r0 + ai * 128 + m * 16; const int g = grow / 4608, rem = grow - g * 4608, b = rem / 144, ci = rem - b * 144;
            const int tok0 = ci < 16 ? NLAT + b * CTXL + ci * 16 : b * SEQ + (ci - 16) * 16;
#pragma unroll
            for (int bj = 0; bj < 2; ++bj) { const int t = 8 * bj + 2 * wc + (fq >> 1); const f32x4 a = acc[ai][bj][m][0], bq = acc[ai][bj][m][1]; u32x4 w; w.x = pk2(a.x, a.y); w.y = pk2(a.z, a.w); w.z = pk2(bq.x, bq.y); w.w = pk2(bq.z, bq.w);
                *(u32x4*)(Y + (size_t)(tok0 + t) * 256 + g * 16 + 8 * (fq & 1)) = w; }
            asm volatile("" ::: "memory"); }
    }
};
struct EpiOB8 {
    unsigned char* OB; float sc;
    __device__ __forceinline__ void operator()(EPI_ARGS) const {
        const int r0 = u.pm * 256 + wr * 64 + fr;
#pragma unroll
        EPI_ROWS { unsigned char* rp = OB + (size_t)(r0 + ai * 128 + m * 16) * 1024 + u.pn * 256 + (wc * 4 + fq) * 16; u32x4 w;
#pragma unroll
            for (int bj = 0; bj < 2; ++bj)
#pragma unroll
                for (int n = 0; n < 2; ++n) { const f32x4 a = acc[ai][bj][m][n] * sc; int pk = 0;
                    pk = __builtin_amdgcn_cvt_pk_fp8_f32(__builtin_amdgcn_fmed3f(a.x, -440.f, 440.f), __builtin_amdgcn_fmed3f(a.y, -440.f, 440.f), pk, false);
                    pk = __builtin_amdgcn_cvt_pk_fp8_f32(__builtin_amdgcn_fmed3f(a.z, -440.f, 440.f), __builtin_amdgcn_fmed3f(a.w, -440.f, 440.f), pk, true); w[2 * bj + n] = (unsigned)pk; }
            *(u32x4*)rp = w; asm volatile("" ::: "memory"); }
    }
};
struct EpiBf16S {
    bf16* O; int ldo; float sc;
    __device__ __forceinline__ void operator()(EPI_ARGS) const {
        const int r0 = u.pm * 256 + wr * 64 + fr, c0 = u.pn * 256 + wc * 32 + 8 * fq;
#pragma unroll
        EPI_ROWS { bf16* rp = O + (size_t)(r0 + ai * 128 + m * 16) * ldo + c0;
#pragma unroll
            for (int bj = 0; bj < 2; ++bj) { const f32x4 a = acc[ai][bj][m][0] * sc, b = acc[ai][bj][m][1] * sc; u32x4 w; w.x = pk2(a.x, a.y); w.y = pk2(a.z, a.w); w.z = pk2(b.x, b.y); w.w = pk2(b.z, b.w); *(u32x4*)(rp + bj * 128) = w; }
            asm volatile("" ::: "memory"); }
    }
};
struct EpiBiasBf16 {
    bf16* O; int ldo; const float* bias;
    __device__ __forceinline__ void operator()(EPI_ARGS) const {
        const int r0 = u.pm * 256 + wr * 64 + fr, c0 = u.pn * 256 + wc * 32 + 8 * fq;
        f32x4 bv[2][2];
#pragma unroll
        for (int bj = 0; bj < 2; ++bj) { bv[bj][0] = *(const f32x4*)(bias + c0 + bj * 128); bv[bj][1] = *(const f32x4*)(bias + c0 + bj * 128 + 4); }
        __builtin_amdgcn_s_waitcnt(0x0F70);
#pragma unroll
        EPI_ROWS { bf16* rp = O + (size_t)(r0 + ai * 128 + m * 16) * ldo + c0;
#pragma unroll
            for (int bj = 0; bj < 2; ++bj) { const f32x4 a = acc[ai][bj][m][0] + bv[bj][0], b = acc[ai][bj][m][1] + bv[bj][1]; u32x4 w; w.x = pk2(a.x, a.y); w.y = pk2(a.z, a.w); w.z = pk2(b.x, b.y); w.w = pk2(b.z, b.w); *(u32x4*)(rp + bj * 128) = w; } asm volatile("" ::: "memory"); }
    }
};
struct EpiGluSig {
    bf16* O; int ldo; const float* bias;
    __device__ __forceinline__ void operator()(EPI_ARGS) const {
        const int r0 = u.pm * 256 + wr * 64 + fr, c0 = u.pn * 128 + wc * 32 + 8 * fq;
        f32x4 b1[2], b2[2];
#pragma unroll
        for (int n = 0; n < 2; ++n) { b1[n] = *(const f32x4*)(bias + c0 + 4 * n); b2[n] = *(const f32x4*)(bias + 256 + c0 + 4 * n); }
        __builtin_amdgcn_s_waitcnt(0x0F70);
#pragma unroll
        EPI_ROWS { bf16* rp = O + (size_t)(r0 + ai * 128 + m * 16) * ldo + c0; float o[8];
#pragma unroll
            for (int n = 0; n < 2; ++n)
#pragma unroll
                for (int i = 0; i < 4; ++i) o[4 * n + i] = (acc[ai][0][m][n][i] + b1[n][i]) * sigmoidf_(acc[ai][1][m][n][i] + b2[n][i]);
            u32x4 w; w.x = pk2(o[0], o[1]); w.y = pk2(o[2], o[3]); w.z = pk2(o[4], o[5]); w.w = pk2(o[6], o[7]); *(u32x4*)rp = w; asm volatile("" ::: "memory"); }
    }
};
struct EpiSwiglu {
    unsigned char* O; int ldo; float sc;
    __device__ __forceinline__ void operator()(EPI_ARGS) const {
        const int r0 = u.pm * 256 + wr * 64 + fr, c0 = u.pn * 128 + wc * 32 + 8 * fq;
#pragma unroll
        EPI_ROWS { unsigned char* rp = O + (size_t)(r0 + ai * 128 + m * 16) * ldo + c0; float o[8];
#pragma unroll
            for (int n = 0; n < 2; ++n)
#pragma unroll
                for (int i = 0; i < 4; ++i) o[4 * n + i] = siluf_(acc[ai][0][m][n][i] * sc) * (acc[ai][1][m][n][i] * (sc * 16.0f));
            u32x2 w; w.x = pk4_fp8(o[0], o[1], o[2], o[3]); w.y = pk4_fp8(o[4], o[5], o[6], o[7]); *(u32x2*)rp = w; asm volatile("" ::: "memory"); }
    }
};
struct EpiQ {
    bf16* Q; const float* RS;
    __device__ __forceinline__ void operator()(EPI_ARGS) const {
        const int r0 = u.pm * 256 + wr * 64 + fr; float rq[8];
#pragma unroll
        for (int g = 0; g < 8; ++g) rq[g] = RS[(size_t)(r0 + (g >> 2) * 128 + (g & 3) * 16) * 2];
        __builtin_amdgcn_s_waitcnt(0x0F70);
#pragma unroll
        EPI_ROWS { const int row = r0 + ai * 128 + m * 16; const float rs = rq[ai * 4 + m]; bf16* rp = Q + (size_t)row * 384;
            if (u.pn == 0) {
#pragma unroll
                for (int bj = 0; bj < 2; ++bj) { const int head = 2 * bj + (wc >> 1), d = 32 * (wc & 1) + 8 * fq; const f32x4 a = acc[ai][bj][m][0] * rs, b = acc[ai][bj][m][1] * rs;
                    u32x4 w; w.x = pk2(a.x, a.y); w.y = pk2(a.z, a.w); w.z = pk2(b.x, b.y); w.w = pk2(b.z, b.w); *(u32x4*)(rp + head * 96 + d) = w; }
            } else { const f32x4 a = acc[ai][0][m][0] * rs, b = acc[ai][0][m][1] * rs;
                u32x4 w; w.x = pk2(a.x, a.y); w.y = pk2(a.z, a.w); w.z = pk2(b.x, b.y); w.w = pk2(b.z, b.w); *(u32x4*)(rp + wc * 96 + 64 + 8 * fq) = w; }
            asm volatile("" ::: "memory"); }
    }
};
struct EpiKV {
    bf16* Kb; bf16* VT; const float* RS;
    __device__ __forceinline__ void operator()(EPI_ARGS) const {
        const int r0 = u.pm * 256 + wr * 64 + fr;
        const int p16 = 8 * ((fr >> 2) & 1) + 4 * (fr >> 3) + (fr & 3); float rkv[8];
#pragma unroll
        for (int g = 0; g < 8; ++g) rkv[g] = RS[(size_t)(r0 + (g >> 2) * 128 + (g & 3) * 16) * 2 + 1];
        __builtin_amdgcn_s_waitcnt(0x0F70);
#pragma unroll
        EPI_ROWS { const int row = r0 + ai * 128 + m * 16; const float rk = rkv[ai * 4 + m];
            if (u.pn == 0) {
#pragma unroll
                for (int bj = 0; bj < 2; ++bj) { const int head = 2 * bj + (wc >> 1), d = 32 * (wc & 1) + 8 * fq; const f32x4 a = acc[ai][bj][m][0] * rk, b = acc[ai][bj][m][1] * rk;
                    u32x4 w; w.x = pk2(a.x, a.y); w.y = pk2(a.z, a.w); w.z = pk2(b.x, b.y); w.w = pk2(b.z, b.w);
                    *(u32x4*)(Kb + (size_t)row * 384 + head * 96 + d) = w; }
            } else {
                const int bb = row < NLAT ? (row >> 11) : ((row - NLAT) >> 8); const int kk = row < NLAT ? (row & 2047) : 2048 + ((row - NLAT) & 255);
                const int pos = (kk & ~15) + p16;
#pragma unroll
                for (int bj = 0; bj < 2; ++bj) { const int head = 2 * bj + (wc >> 1), d = 32 * (wc & 1) + 8 * fq; bf16* dst = VT + ((size_t)((bb * 4 + head) * 64 + d)) * 2304 + pos;
#pragma unroll
                    for (int n = 0; n < 2; ++n)
#pragma unroll
                        for (int i = 0; i < 4; ++i) dst[(size_t)(4 * n + i) * 2304] = f2bf(acc[ai][bj][m][n][i] * rk); }
            }
            asm volatile("" ::: "memory"); }
    }
};
struct EpiDelta {
    bf16* D; const float* MODg;
    __device__ __forceinline__ void operator()(EPI_ARGS) const {
        const int rt = u.pm * 256; const float* g = MODg + (size_t)(rt < NLAT ? (rt >> 11) : 32) * 6144;
        const int r0 = rt + wr * 64 + fr, c0 = u.pn * 256 + wc * 32 + 8 * fq;
        f32x4 gv[2][2];
#pragma unroll
        for (int bj = 0; bj < 2; ++bj) { gv[bj][0] = *(const f32x4*)(g + c0 + bj * 128); gv[bj][1] = *(const f32x4*)(g + c0 + bj * 128 + 4); }
        __builtin_amdgcn_s_waitcnt(0x0F70);
#pragma unroll
        EPI_ROWS { bf16* rp = D + (size_t)(r0 + ai * 128 + m * 16) * DM + c0;
#pragma unroll
            for (int bj = 0; bj < 2; ++bj) { const f32x4 a = gv[bj][0] * acc[ai][bj][m][0], b = gv[bj][1] * acc[ai][bj][m][1]; u32x4 w; w.x = pk2(a.x, a.y); w.y = pk2(a.z, a.w); w.z = pk2(b.x, b.y); w.w = pk2(b.z, b.w); *(u32x4*)(rp + bj * 128) = w; }
            asm volatile("" ::: "memory"); }
    }
};

__device__ __forceinline__ int seq_row(int b, int dir, int pos) {
    if (pos < CTXL) return NLAT + b * CTXL + (dir ? CTXL - 1 - pos : pos);
    const int t = pos - CTXL; return b * SEQ + (dir ? SEQ - 1 - t : t);
}
__device__ __forceinline__ void phase_gla(const Ctx& c, KParams p, int l) {
    const bf16* Z = (const bf16*)(c.ws + WS_Z); const bf16* GVT = (const bf16*)(c.ws + WS_GVT); bf16* OG = (bf16*)(c.ws + WS_T1);
    const int w = c.wave, tid = c.tid;
    LAS float* wtab = (LAS float*)c.lds;
    LAS float* DD = (LAS float*)(c.lds + 4096);
    LAS unsigned char* RW = c.lds + 8192 + w * 13824;
    LAS float* LA = (LAS float*)RW;
    LAS unsigned char* KTT = RW + 9216;
    for (int u = c.blk; u < 256; u += c.G) {
        const int b = u >> 3, h = (u >> 1) & 3, dir = u & 1;
        __syncthreads();
        { const float* wa = p->in[I_GLAW] + ((size_t)(l * 2 + dir) * 16) * 128 + h * 32; wtab[tid] = wa[(tid >> 5) * 128 + (tid & 31)]; if (tid < 32) wtab[512 + tid] = p->in[I_GLAB][(l * 2 + dir) * 128 + h * 32 + tid]; }
        float Sst[4] = {0.f, 0.f, 0.f, 0.f};
        __syncthreads();
        for (int gi = 0; gi < 5; ++gi) {
            const int pc = gi * 8 + w; const bool active = pc < 36;
            int lane_ = c.lane; asm volatile("" : "+v"(lane_));
            const int r = lane_ & 31, hh = lane_ >> 5;
            const int p16 = 8 * ((r >> 2) & 1) + 4 * ((r & 15) >> 3) + (r & 3);
            const int pos0 = (r & 16) + p16, pos1 = 32 + pos0;
            bf16x8 qd[2][2]; f32x16 oacc[2][2]; int row0 = 0;
            if (active) {
                int kk0;
                if (dir == 0) { if (pc < 4) { row0 = NLAT + b * CTXL + pc * 64; kk0 = pc * 64; } else { row0 = b * SEQ + (pc - 4) * 64; kk0 = 256 + (pc - 4) * 64; } }
                else { if (pc < 4) { row0 = NLAT + b * CTXL + (3 - pc) * 64; kk0 = (3 - pc) * 64; } else { row0 = b * SEQ + (35 - pc) * 64; kk0 = 256 + (35 - pc) * 64; } }
#pragma unroll
                for (int ib = 0; ib < 2; ++ib) { const bf16* zr = Z + (size_t)(row0 + 32 * ib + r) * ZW; float al[16]; { const u32x4 a0 = *(const u32x4*)(zr + ZAF + dir * 16), a1 = *(const u32x4*)(zr + ZAF + dir * 16 + 8); float t8[8]; unpack8(a0, t8);
#pragma unroll
                        for (int j = 0; j < 8; ++j) al[j] = t8[j];
                        unpack8(a1, t8);
#pragma unroll
                        for (int j = 0; j < 8; ++j) al[8 + j] = t8[j]; }
#pragma unroll
                    for (int ks = 0; ks < 2; ++ks) { float za[8]; { const f32x4 b0 = *(const LAS f32x4*)(wtab + 512 + 16 * ks + 8 * hh), b1 = *(const LAS f32x4*)(wtab + 512 + 16 * ks + 8 * hh + 4);
                            za[0] = b0.x; za[1] = b0.y; za[2] = b0.z; za[3] = b0.w; za[4] = b1.x; za[5] = b1.y; za[6] = b1.z; za[7] = b1.w; }
#pragma unroll
                        for (int j = 0; j < 16; ++j) { const f32x4 w0 = *(const LAS f32x4*)(wtab + j * 32 + 16 * ks + 8 * hh), w1 = *(const LAS f32x4*)(wtab + j * 32 + 16 * ks + 8 * hh + 4);
                            za[0] = fmaf(al[j], w0.x, za[0]); za[1] = fmaf(al[j], w0.y, za[1]); za[2] = fmaf(al[j], w0.z, za[2]); za[3] = fmaf(al[j], w0.w, za[3]);
                            za[4] = fmaf(al[j], w1.x, za[4]); za[5] = fmaf(al[j], w1.y, za[5]); za[6] = fmaf(al[j], w1.z, za[6]); za[7] = fmaf(al[j], w1.w, za[7]); }
                        float la[8];
#pragma unroll
                        for (int e = 0; e < 8; ++e) la[e] = (fminf(za[e], 0.f) - __logf(1.f + __expf(-fabsf(za[e])))) * 0.0625f;
                        *(LAS f32x4*)(LA + (32 * ib + r) * 36 + 16 * ks + 8 * hh) = (f32x4){la[0], la[1], la[2], la[3]}; *(LAS f32x4*)(LA + (32 * ib + r) * 36 + 16 * ks + 8 * hh + 4) = (f32x4){la[4], la[5], la[6], la[7]}; } }
                lds_wait();
                u32x4 qraw[2][2], kraw[2][2];
#pragma unroll
                for (int ib = 0; ib < 2; ++ib) { const bf16* zr = Z + (size_t)(row0 + 32 * ib + r) * ZW;
#pragma unroll
                    for (int ks = 0; ks < 2; ++ks) { qraw[ib][ks] = *(const u32x4*)(zr + ZQ + h * 32 + 16 * ks + 8 * hh); kraw[ib][ks] = *(const u32x4*)(zr + ZK + h * 32 + 16 * ks + 8 * hh); } }
                { float bend; float v[32], s = 0.f;
#pragma unroll
                  for (int qq = 0; qq < 32; ++qq) { const int q = 32 * hh + qq, i = dir ? 63 - q : q; v[qq] = LA[i * 36 + r]; s += v[qq]; }
                  const auto sw = __builtin_amdgcn_permlane32_swap(__float_as_uint(s), __float_as_uint(s), false, false);
                  const float h0 = __uint_as_float(sw[0]), h1 = __uint_as_float(sw[1]); bend = h0 + h1;
                  float run = hh ? h0 : 0.f;
#pragma unroll
                  for (int qq = 0; qq < 32; ++qq) { const int q = 32 * hh + qq, i = dir ? 63 - q : q; run += v[qq]; LA[i * 36 + r] = run; }
                  if (hh == 0) DD[w * 32 + r] = __expf(bend); }
                lds_wait();
                bf16x8 vt[2][4];
#pragma unroll
                for (int db = 0; db < 2; ++db)
#pragma unroll
                    for (int s4 = 0; s4 < 4; ++s4) vt[db][s4] = *(const bf16x8*)(GVT + ((size_t)(b * 4 + h) * 64 + 32 * db + r) * 2304 + kk0 + 16 * s4 + 8 * hh);
                bf16x8 ki[2][2];
#pragma unroll
                for (int ib = 0; ib < 2; ++ib) {
#pragma unroll
                    for (int ks = 0; ks < 2; ++ks) { const int dk0 = 16 * ks + 8 * hh; float q8[8], k8[8], b8[8]; unpack8(qraw[ib][ks], q8); unpack8(kraw[ib][ks], k8);
                        { const f32x4 x0 = *(const LAS f32x4*)(LA + (32 * ib + r) * 36 + dk0), x1 = *(const LAS f32x4*)(LA + (32 * ib + r) * 36 + dk0 + 4); b8[0] = x0.x; b8[1] = x0.y; b8[2] = x0.z; b8[3] = x0.w; b8[4] = x1.x; b8[5] = x1.y; b8[6] = x1.z; b8[7] = x1.w; }
                        float qo[8], ko[8];
#pragma unroll
                        for (int e = 0; e < 8; ++e) { const float eb = __expf(b8[e]), ieb = 1.f / eb; qo[e] = q8[e] * 0.17677669529663687f * eb; ko[e] = k8[e] * ieb;
                            *(LAS bf16*)(KTT + ((dk0 + e) * 72 + (ib ? pos1 : pos0)) * 2) = f2bf(ko[e] * DD[w * 32 + dk0 + e]); }
                        u32x4 wq, wk; wq.x = pk2(qo[0], qo[1]); wq.y = pk2(qo[2], qo[3]); wq.z = pk2(qo[4], qo[5]); wq.w = pk2(qo[6], qo[7]); wk.x = pk2(ko[0], ko[1]); wk.y = pk2(ko[2], ko[3]); wk.z = pk2(ko[4], ko[5]); wk.w = pk2(ko[6], ko[7]);
                        qd[ib][ks] = __builtin_bit_cast(bf16x8, wq); ki[ib][ks] = __builtin_bit_cast(bf16x8, wk); } }
                f32x16 zero16;
#pragma unroll
                for (int i = 0; i < 16; ++i) zero16[i] = 0.f;
                f32x16 a00 = __builtin_amdgcn_mfma_f32_32x32x16_bf16(ki[0][0], qd[0][0], zero16, 0, 0, 0); a00 = __builtin_amdgcn_mfma_f32_32x32x16_bf16(ki[0][1], qd[0][1], a00, 0, 0, 0);
                f32x16 a11 = __builtin_amdgcn_mfma_f32_32x32x16_bf16(ki[1][0], qd[1][0], zero16, 0, 0, 0); a11 = __builtin_amdgcn_mfma_f32_32x32x16_bf16(ki[1][1], qd[1][1], a11, 0, 0, 0);
                f32x16 aof;
                if (dir == 0) { aof = __builtin_amdgcn_mfma_f32_32x32x16_bf16(ki[0][0], qd[1][0], zero16, 0, 0, 0); aof = __builtin_amdgcn_mfma_f32_32x32x16_bf16(ki[0][1], qd[1][1], aof, 0, 0, 0); }
                else { aof = __builtin_amdgcn_mfma_f32_32x32x16_bf16(ki[1][0], qd[0][0], zero16, 0, 0, 0); aof = __builtin_amdgcn_mfma_f32_32x32x16_bf16(ki[1][1], qd[0][1], aof, 0, 0, 0); }
#pragma unroll
                for (int i = 0; i < 16; ++i) { const int j = (i & 3) + 8 * (i >> 2) + 4 * hh; const bool keep = dir ? (j >= r) : (j <= r); a00[i] = keep ? a00[i] : 0.f; a11[i] = keep ? a11[i] : 0.f; }
#define GLA_P(X, s) ({ u32x4 w_; w_.x = pk2((X)[8 * (s)], (X)[8 * (s) + 1]); w_.y = pk2((X)[8 * (s) + 2], (X)[8 * (s) + 3]); w_.z = pk2((X)[8 * (s) + 4], (X)[8 * (s) + 5]); w_.w = pk2((X)[8 * (s) + 6], (X)[8 * (s) + 7]); __builtin_bit_cast(bf16x8, w_); })
                const bf16x8 p00a = GLA_P(a00, 0), p00b = GLA_P(a00, 1), p11a = GLA_P(a11, 0), p11b = GLA_P(a11, 1), pofa = GLA_P(aof, 0), pofb = GLA_P(aof, 1);
#pragma unroll
                for (int db = 0; db < 2; ++db) {
                    f32x16 o0 = __builtin_amdgcn_mfma_f32_32x32x16_bf16(vt[db][0], p00a, zero16, 0, 0, 0); o0 = __builtin_amdgcn_mfma_f32_32x32x16_bf16(vt[db][1], p00b, o0, 0, 0, 0);
                    f32x16 o1 = __builtin_amdgcn_mfma_f32_32x32x16_bf16(vt[db][2], p11a, zero16, 0, 0, 0); o1 = __builtin_amdgcn_mfma_f32_32x32x16_bf16(vt[db][3], p11b, o1, 0, 0, 0);
                    if (dir == 0) { o1 = __builtin_amdgcn_mfma_f32_32x32x16_bf16(vt[db][0], pofa, o1, 0, 0, 0); o1 = __builtin_amdgcn_mfma_f32_32x32x16_bf16(vt[db][1], pofb, o1, 0, 0, 0); }
                    else { o0 = __builtin_amdgcn_mfma_f32_32x32x16_bf16(vt[db][2], pofa, o0, 0, 0, 0); o0 = __builtin_amdgcn_mfma_f32_32x32x16_bf16(vt[db][3], pofb, o0, 0, 0, 0); }
                    oacc[db][0] = o0; oacc[db][1] = o1; }
#undef GLA_P
                lds_wait();
                bf16x8 kf[4];
#pragma unroll
                for (int s4 = 0; s4 < 4; ++s4) kf[s4] = *(const LAS bf16x8*)(KTT + (r * 72 + 16 * s4 + 8 * hh) * 2);
#pragma unroll
                for (int db = 0; db < 2; ++db) { f32x16 uu = __builtin_amdgcn_mfma_f32_32x32x16_bf16(vt[db][0], kf[0], zero16, 0, 0, 0);
#pragma unroll
                    for (int s4 = 1; s4 < 4; ++s4) uu = __builtin_amdgcn_mfma_f32_32x32x16_bf16(vt[db][s4], kf[s4], uu, 0, 0, 0);
#pragma unroll
                    for (int i = 0; i < 16; ++i) LA[(32 * db + (i & 3) + 8 * (i >> 2) + 4 * hh) * 32 + r] = uu[i]; }
            }
            __syncthreads();
            const int dv2 = tid >> 3, dk4 = (tid & 7) * 4;
            f32x4 ur[8], dr[8];
#pragma unroll
            for (int cc = 0; cc < 8; ++cc) { ur[cc] = *(const LAS f32x4*)((LAS float*)(c.lds + 8192 + cc * 13824) + dv2 * 32 + dk4); dr[cc] = *(const LAS f32x4*)(DD + cc * 32 + dk4); }
            __syncthreads();
#pragma unroll
            for (int cc = 0; cc < 8; ++cc) if (gi * 8 + cc < 36) { u32x2 sp; sp.x = pk2(Sst[0], Sst[1]); sp.y = pk2(Sst[2], Sst[3]); *(LAS u32x2*)(c.lds + 8192 + cc * 13824 + (dv2 * 40 + dk4) * 2) = sp;
                Sst[0] = fmaf(dr[cc].x, Sst[0], ur[cc].x); Sst[1] = fmaf(dr[cc].y, Sst[1], ur[cc].y); Sst[2] = fmaf(dr[cc].z, Sst[2], ur[cc].z); Sst[3] = fmaf(dr[cc].w, Sst[3], ur[cc].w); }
            __syncthreads();
            if (active) {
#pragma unroll
                for (int db = 0; db < 2; ++db) { const bf16x8 s0 = *(const LAS bf16x8*)(RW + ((32 * db + r) * 40 + 8 * hh) * 2), s1 = *(const LAS bf16x8*)(RW + ((32 * db + r) * 40 + 16 + 8 * hh) * 2);
#pragma unroll
                    for (int ib = 0; ib < 2; ++ib) { oacc[db][ib] = __builtin_amdgcn_mfma_f32_32x32x16_bf16(s0, qd[ib][0], oacc[db][ib], 0, 0, 0); oacc[db][ib] = __builtin_amdgcn_mfma_f32_32x32x16_bf16(s1, qd[ib][1], oacc[db][ib], 0, 0, 0); } }
#pragma unroll
                for (int ib = 0; ib < 2; ++ib) { bf16* orow = OG + ((size_t)dir * NTOK + row0 + 32 * ib + r) * 256 + h * 64 + 4 * hh;
#pragma unroll
                    for (int db = 0; db < 2; ++db)
#pragma unroll
                        for (int g4 = 0; g4 < 4; ++g4) { u32x2 wv; wv.x = pk2(oacc[db][ib][4 * g4], oacc[db][ib][4 * g4 + 1]); wv.y = pk2(oacc[db][ib][4 * g4 + 2], oacc[db][ib][4 * g4 + 3]); *(u32x2*)(orow + 32 * db + 8 * g4) = wv; } }
                lds_wait();
            }
        }
    }
    __syncthreads();
}
__device__ __forceinline__ void phase_gla_final(const Ctx& c, KParams p, int l, int nrows) {
    const bf16* Z = (const bf16*)(c.ws + WS_Z); const bf16* OG = (const bf16*)(c.ws + WS_T1); bf16* MIX = (bf16*)(c.ws + WS_MIX);
    const int gw = c.blk * NWAVES + c.wave, NGW = c.G * NWAVES; const f32x4 g = *(const f32x4*)(p->in[I_GLAG] + l * 256 + 4 * c.lane);
    for (int r0 = gw; r0 < nrows; r0 += 4 * NGW) {
        u32x2 of[4], ob[4], rg[4];
#pragma unroll
        for (int k = 0; k < 4; ++k) { const int r = r0 + k * NGW; of[k] = ob[k] = rg[k] = (u32x2){0u, 0u};
            if (r < nrows) { of[k] = *(const u32x2*)(OG + (size_t)r * 256 + 4 * c.lane); ob[k] = *(const u32x2*)(OG + ((size_t)NTOK + r) * 256 + 4 * c.lane); rg[k] = *(const u32x2*)(Z + (size_t)r * ZW + ZR + 4 * c.lane); } }
#pragma unroll
        for (int k = 0; k < 4; ++k) { const int r = r0 + k * NGW;
            f32x4 o = (f32x4){__uint_as_float(of[k].x << 16) + __uint_as_float(ob[k].x << 16), __uint_as_float(of[k].x & 0xffff0000u) + __uint_as_float(ob[k].x & 0xffff0000u),
                              __uint_as_float(of[k].y << 16) + __uint_as_float(ob[k].y << 16), __uint_as_float(of[k].y & 0xffff0000u) + __uint_as_float(ob[k].y & 0xffff0000u)};
            float ss = (o.x * o.x + o.y * o.y) + (o.z * o.z + o.w * o.w);
            ss += shx<1>(ss); ss += shx<2>(ss); ss += shx<4>(ss); ss += shx<8>(ss);
            const float rstd = rsqrtf(ss * (1.f / 64.f) + EPS);
            const float g0 = __uint_as_float(rg[k].x << 16), g1 = __uint_as_float(rg[k].x & 0xffff0000u), g2 = __uint_as_float(rg[k].y << 16), g3 = __uint_as_float(rg[k].y & 0xffff0000u);
            u32x2 w; w.x = pk2(o.x * rstd * g.x * siluf_(g0), o.y * rstd * g.y * siluf_(g1)); w.y = pk2(o.z * rstd * g.z * siluf_(g2), o.w * rstd * g.w * siluf_(g3));
            if (r < nrows) *(u32x2*)(MIX + (size_t)r * DM + 4 * c.lane) = w; }
    }
}

__device__ __forceinline__ void phase_conv1(const Ctx& c, KParams p, int l, bool with_ctx) {
    const bf16* Z = (const bf16*)(c.ws + WS_Z); bf16* CV = (bf16*)(c.ws + WS_CV);
    constexpr int TT = 64, HR = TT + 30;
    LAS float* glu = (LAS float*)c.lds;
    LAS float* dws = glu + HR * 256;
    for (int i = c.tid; i < 31 * 256; i += NTHR) dws[i] = p->in[I_CDW][(size_t)l * 31 * 256 + i];
    const int ntiles = with_ctx ? 1024 + 128 : 1024;
    const f32x4 dwb = *(const f32x4*)(p->in[I_CDB] + l * 256 + 4 * c.lane), lg = *(const f32x4*)(p->in[I_CLG] + l * 256 + 4 * c.lane), lb = *(const f32x4*)(p->in[I_CLB] + l * 256 + 4 * c.lane);
    for (int tile = c.blk; tile < ntiles; tile += c.G) {
        int rowbase, t0, slen;
        if (tile < 1024) { const int b = tile >> 5; rowbase = b * SEQ; t0 = (tile & 31) * TT; slen = SEQ; } else { const int q = tile - 1024, b = q >> 2; rowbase = NLAT + b * CTXL; t0 = (q & 3) * TT; slen = CTXL; }
        __syncthreads();
        u32x2 ra[12], rg[12];
#pragma unroll
        for (int k = 0; k < 12; ++k) { const int idx = c.tid + k * NTHR, j = idx >> 6, c4 = (idx & 63) * 4, t = t0 - 15 + j; ra[k] = (u32x2){0u, 0u}; rg[k] = (u32x2){0u, 0u};
            if (idx < HR * 64 && t >= 0 && t < slen) { const bf16* zr = Z + (size_t)(rowbase + t) * ZW; ra[k] = *(const u32x2*)(zr + ZCA + c4); rg[k] = *(const u32x2*)(zr + ZCG + c4); } }
#pragma unroll
        for (int k = 0; k < 12; ++k) { const int idx = c.tid + k * NTHR, j = idx >> 6, c4 = (idx & 63) * 4; f32x4 v;
            v.x = __uint_as_float(ra[k].x << 16) * sigmoidf_(__uint_as_float(rg[k].x << 16)); v.y = __uint_as_float(ra[k].x & 0xffff0000u) * sigmoidf_(__uint_as_float(rg[k].x & 0xffff0000u));
            v.z = __uint_as_float(ra[k].y << 16) * sigmoidf_(__uint_as_float(rg[k].y << 16)); v.w = __uint_as_float(ra[k].y & 0xffff0000u) * sigmoidf_(__uint_as_float(rg[k].y & 0xffff0000u));
            if (idx < HR * 64) *(LAS f32x4*)(glu + j * 256 + c4) = v; }
        __syncthreads();
        for (int q = 0; q < 8; ++q) { const int i = c.wave * 8 + q; f32x4 a = dwb;
#pragma unroll
            for (int j = 0; j < 31; ++j) a += *(const LAS f32x4*)(glu + (i + j) * 256 + 4 * c.lane) * *(const LAS f32x4*)(dws + j * 256 + 4 * c.lane);
            const float mu = wave_sum((a.x + a.y) + (a.z + a.w)) * (1.f / 256.f); const f32x4 dlt = a - mu;
            const float var = wave_sum((dlt.x * dlt.x + dlt.y * dlt.y) + (dlt.z * dlt.z + dlt.w * dlt.w)) * (1.f / 256.f); const float rstd = rsqrtf(var + EPS);
            const f32x4 y = dlt * rstd * lg + lb;
            u32x2 w; w.x = pk2(siluf_(y.x), siluf_(y.y)); w.y = pk2(siluf_(y.z), siluf_(y.w));
            *(u32x2*)(CV + (size_t)(rowbase + t0 + i) * 256 + 4 * c.lane) = w; }
    }
    __syncthreads();
}

__device__ __forceinline__ void phase_s5_carry(const Ctx& c, int l) {
    const bf16* XE = (const bf16*)(c.ws + WS_Y5); bf16* UP = (bf16*)(c.ws + WS_UP); const float* S5P = (const float*)(c.ws + WS_S5P);
    for (int i = c.blk * NTHR + c.tid; i < NB * 2 * 16 * 64; i += c.G * NTHR) {
        const int pp = i & 63, g = (i >> 6) & 15, dir = (i >> 10) & 1, b = i >> 11;
        const float* PW = S5P + ((size_t)((l * 2 + dir) * 16 + g) * 64 + pp) * 34 + 32; const float ar = PW[0], ai = PW[1];
        const size_t rbase = (size_t)g * 4608 + (size_t)b * 144; float xr = 0.f, xi = 0.f;
        for (int s0 = 0; s0 < 144; s0 += 8) {
            float er[8], ei[8];
#pragma unroll
            for (int q = 0; q < 8; ++q) { const int s = s0 + q; const int ci = dir == 0 ? s : (s < 16 ? 15 - s : 159 - s); const bf16* xe = XE + (rbase + ci) * 256 + dir * 128 + pp; er[q] = bf2f(xe[0]); ei[q] = bf2f(xe[64]); }
#pragma unroll
            for (int q = 0; q < 8; ++q) { const int s = s0 + q; const int ci = dir == 0 ? s : (s < 16 ? 15 - s : 159 - s); bf16* up = UP + (rbase + ci) * 512 + 256 + dir * 128 + pp; up[0] = f2bf(xr); up[64] = f2bf(xi);
                const float nr = ar * xr - ai * xi + er[q], ni = ar * xi + ai * xr + ei[q]; xr = nr; xi = ni; }
        }
    }
}

__device__ __forceinline__ void phase_mla_prep(const Ctx& c, KParams p) {
    const bf16* Z = (const bf16*)(c.ws + WS_Z); float* RS = (float*)(c.ws + WS_RS); bf16* Kb = (bf16*)(c.ws + WS_H) + (size_t)NTOK * 384; const float* ROPE = (const float*)(c.ws + WS_TAB + TAB_ROPE);
    const int gw = c.blk * NWAVES + c.wave, NGW = c.G * NWAVES, lane = c.lane, d = lane & 31;
    for (int r0 = gw; r0 < NTOK; r0 += 4 * NGW) {
        u32x2 q4[4]; unsigned k2[4]; bf16 xr[4]; f32x2 cs[4];
#pragma unroll
        for (int k = 0; k < 4; ++k) { const int r = r0 + k * NGW; q4[k] = (u32x2){0u, 0u}; k2[k] = 0u; xr[k] = 0; cs[k] = (f32x2){1.f, 0.f};
            if (r < NTOK) { const bf16* zr = Z + (size_t)r * ZW; q4[k] = *(const u32x2*)(zr + ZCQ + 4 * lane); k2[k] = *(const unsigned*)(zr + ZCKV + 2 * lane); xr[k] = zr[ZKR + d];
                if (r < NLAT) cs[k] = *(const f32x2*)(ROPE + (((r & 2047) * 2 + (d >> 4)) * 8 + (d & 7)) * 2); } }
#pragma unroll
        for (int k = 0; k < 4; ++k) { const int r = r0 + k * NGW;
            const float a0 = __uint_as_float(q4[k].x << 16), a1 = __uint_as_float(q4[k].x & 0xffff0000u), a2 = __uint_as_float(q4[k].y << 16), a3 = __uint_as_float(q4[k].y & 0xffff0000u);
            const float b0 = __uint_as_float(k2[k] << 16), b1 = __uint_as_float(k2[k] & 0xffff0000u);
            const float sq = wave_sum((a0 * a0 + a1 * a1) + (a2 * a2 + a3 * a3)), sk = wave_sum(b0 * b0 + b1 * b1);
            const float x = bf2f(xr[k]); const float px = shx<8>(x);
            const float o = (d & 8) ? fmaf(x, cs[k].x, px * cs[k].y) : fmaf(x, cs[k].x, -px * cs[k].y);
            if (r < NTOK) { if (lane == 0) { RS[(size_t)r * 2] = rsqrtf(sq * (1.f / 256.f) + EPS); RS[(size_t)r * 2 + 1] = rsqrtf(sk * (1.f / 128.f) + EPS); }
                const bf16 ob = f2bf(o); bf16* kr = Kb + (size_t)r * 384 + 64 + d; if (lane < 32) { kr[0] = ob; kr[96] = ob; kr[192] = ob; kr[288] = ob; } } }
    }
}
__device__ __forceinline__ void phase_attn(const Ctx& c, bool with_ctx) {
    const bf16* Qb = (const bf16*)(c.ws + WS_H); const bf16* Kb = Qb + (size_t)NTOK * 384; const bf16* VT = Kb + (size_t)NTOK * 384; bf16* MIX = (bf16*)(c.ws + WS_MIX);
    constexpr int KROW = 208, VROW = 144, KBUF = 64 * KROW, VBUF = 64 * VROW;
    LAS unsigned char* Kt = c.lds; LAS unsigned char* Vt = c.lds + 2 * KBUF;
    const int lane = c.lane, ln = lane & 31, hh = lane >> 5, tid = c.tid;
    const int nunits = with_ctx ? 1152 : 1024;
    for (int L = c.blk; L < nunits; L += c.G) {
        int u = L;
        if (c.G == 256 && L < 1024) { const int r = L >> 8, x = L & 7, j = (L & 255) >> 3; u = ((r * 32 + x * 4 + (j >> 3)) << 3) | (j & 7); }
        int b, h, qrow0, kt0, nkt;
        if (u < 1024) { b = u >> 5; h = (u >> 3) & 3; qrow0 = b * SEQ + (u & 7) * 256; kt0 = 0; nkt = 36; } else { const int q = u - 1024; b = q >> 2; h = q & 3; qrow0 = NLAT + b * CTXL; kt0 = 32; nkt = 4; }
        const bf16* vtb = VT + (size_t)((b * 4 + h) * 64) * 2304;
        bf16x8 qf[6];
        { const bf16* qr = Qb + (size_t)(qrow0 + 32 * c.wave + ln) * 384 + h * 96 + 8 * hh;
#pragma unroll
          for (int ks = 0; ks < 6; ++ks) qf[ks] = *(const bf16x8*)(qr + 16 * ks); }
        if (u < 1024) {
            const float* ROPE = (const float*)(c.ws + WS_TAB + TAB_ROPE) + (size_t)((qrow0 + 32 * c.wave + ln) & 2047) * 32;
#pragma unroll
            for (int ax = 0; ax < 2; ++ax) { const u32x4 own = __builtin_bit_cast(u32x4, qf[4 + ax]); u32x4 oth, res;
#pragma unroll
                for (int i = 0; i < 4; ++i) { const auto sw = __builtin_amdgcn_permlane32_swap(own[i], own[i], false, false); oth[i] = hh ? sw[0] : sw[1]; }
#pragma unroll
                for (int i = 0; i < 4; ++i) { const f32x4 cs = *(const f32x4*)(ROPE + ax * 16 + 4 * i);
                    const float v0 = __uint_as_float(own[i] << 16), v1 = __uint_as_float(own[i] & 0xffff0000u), p0 = __uint_as_float(oth[i] << 16), p1 = __uint_as_float(oth[i] & 0xffff0000u);
                    const float sg = hh ? 1.f : -1.f; res[i] = pk2(fmaf(v0, cs.x, sg * p0 * cs.y), fmaf(v1, cs.z, sg * p1 * cs.w)); }
                qf[4 + ax] = __builtin_bit_cast(bf16x8, res); } }
        f32x16 oacc[2];
#pragma unroll
        for (int i = 0; i < 16; ++i) { oacc[0][i] = 0.f; oacc[1][i] = 0.f; }
        float mrun = 0.f, lsum = 0.f;
        const int k0key = tid / 12, k0pt = tid % 12, k1key = (512 + tid) / 12, k1pt = (512 + tid) % 12; const bool k1on = tid < 256;
        u32x4 sk0, sk1 = (u32x4){0u, 0u, 0u, 0u}, sv;
        auto key_row = [&](int kt, int j) -> int { const int kk = kt * 64 + j; return kk < 2048 ? b * SEQ + kk : NLAT + b * CTXL + (kk - 2048); };
#define ATT_LOAD(kt) do { sk0 = *(const u32x4*)(Kb + (size_t)key_row((kt), k0key) * 384 + h * 96 + k0pt * 8); if (k1on) sk1 = *(const u32x4*)(Kb + (size_t)key_row((kt), k1key) * 384 + h * 96 + k1pt * 8); \
        sv = *(const u32x4*)(vtb + (size_t)(tid >> 3) * 2304 + (kt) * 64 + (tid & 7) * 8); } while (0)
#define ATT_STORE(buf) do { *(LAS u32x4*)(Kt + (buf) * KBUF + k0key * KROW + k0pt * 16) = sk0; if (k1on) *(LAS u32x4*)(Kt + (buf) * KBUF + k1key * KROW + k1pt * 16) = sk1; \
        *(LAS u32x4*)(Vt + (buf) * VBUF + (tid >> 3) * VROW + (tid & 7) * 16) = sv; } while (0)
        __syncthreads();
        ATT_LOAD(kt0); ATT_STORE(0);
        __syncthreads();
        for (int it = 0; it < nkt; ++it) {
            const int cur = it & 1;
            if (it + 1 < nkt) ATT_LOAD(kt0 + it + 1);
            f32x16 sacc[2];
            const float nm = -mrun;
#pragma unroll
            for (int kb = 0; kb < 2; ++kb) {
#pragma unroll
                for (int i = 0; i < 16; ++i) sacc[kb][i] = nm;
#pragma unroll
                for (int ks = 0; ks < 6; ++ks) { const bf16x8 a = *(const LAS bf16x8*)(Kt + cur * KBUF + (32 * kb + ln) * KROW + ks * 32 + hh * 16);
                    sacc[kb] = __builtin_amdgcn_mfma_f32_32x32x16_bf16(a, qf[ks], sacc[kb], 0, 0, 0); } }
            float mx = fmaxf(fmaxf(sacc[0][0], sacc[0][1]), sacc[0][2]);
#pragma unroll
            for (int i = 3; i < 15; i += 2) mx = fmaxf(fmaxf(mx, sacc[0][i]), sacc[0][i + 1]);
            mx = fmaxf(mx, sacc[0][15]);
#pragma unroll
            for (int i = 0; i < 16; i += 2) mx = fmaxf(fmaxf(mx, sacc[1][i]), sacc[1][i + 1]);
            { const auto r = __builtin_amdgcn_permlane32_swap(__float_as_uint(mx), __float_as_uint(mx), false, false); mx = fmaxf(__uint_as_float(r[0]), __uint_as_float(r[1])); }
            if (it == 0 || __builtin_amdgcn_ballot_w64(mx > 8.0f) != 0ull) {
                const float up = it == 0 ? mx : fmaxf(mx, 0.f), alpha = __builtin_amdgcn_exp2f(-up); mrun += up; lsum *= alpha;
#pragma unroll
                for (int i = 0; i < 16; ++i) { oacc[0][i] *= alpha; oacc[1][i] *= alpha; sacc[0][i] -= up; sacc[1][i] -= up; }
            }
            float ps = 0.f;
#pragma unroll
            for (int kb = 0; kb < 2; ++kb)
#pragma unroll
                for (int i = 0; i < 16; ++i) { const float pv = __builtin_amdgcn_exp2f(sacc[kb][i]); sacc[kb][i] = pv; ps += pv; }
            lsum += ps;
            bf16x8 pb[4];
#pragma unroll
            for (int s4 = 0; s4 < 4; ++s4) { const int kb = s4 >> 1, o8 = 8 * (s4 & 1); u32x4 w;
                w.x = pk2(sacc[kb][o8 + 0], sacc[kb][o8 + 1]); w.y = pk2(sacc[kb][o8 + 2], sacc[kb][o8 + 3]); w.z = pk2(sacc[kb][o8 + 4], sacc[kb][o8 + 5]); w.w = pk2(sacc[kb][o8 + 6], sacc[kb][o8 + 7]);
                pb[s4] = __builtin_bit_cast(bf16x8, w); }
#pragma unroll
            for (int db = 0; db < 2; ++db)
#pragma unroll
                for (int s4 = 0; s4 < 4; ++s4) { const bf16x8 a = *(const LAS bf16x8*)(Vt + cur * VBUF + (32 * db + ln) * VROW + s4 * 32 + hh * 16);
                    oacc[db] = __builtin_amdgcn_mfma_f32_32x32x16_bf16(a, pb[s4], oacc[db], 0, 0, 0); }
            if (it + 1 < nkt) ATT_STORE(cur ^ 1);
            __syncthreads();
        }
#undef ATT_LOAD
#undef ATT_STORE
        { const auto r = __builtin_amdgcn_permlane32_swap(__float_as_uint(lsum), __float_as_uint(lsum), false, false); lsum = __uint_as_float(r[0]) + __uint_as_float(r[1]); }
        const float inv = 1.f / lsum;
        bf16* dst = MIX + (size_t)(qrow0 + 32 * c.wave + ln) * DM + 768 + h * 64 + 4 * hh;
#pragma unroll
        for (int db = 0; db < 2; ++db)
#pragma unroll
            for (int g4 = 0; g4 < 4; ++g4) { u32x2 w; w.x = pk2(oacc[db][4 * g4] * inv, oacc[db][4 * g4 + 1] * inv); w.y = pk2(oacc[db][4 * g4 + 2] * inv, oacc[db][4 * g4 + 3] * inv);
                *(u32x2*)(dst + 32 * db + 8 * g4) = w; }
    }
    __syncthreads();
}

__device__ __forceinline__ void phase_norm2_route(const Ctx& c, KParams p, int l, int ntok) {
    const float* MOD = (const float*)(c.ws + WS_MOD) + (size_t)l * 33 * 6144;
    const float* xl = l == 0 ? p->in[I_X] : p->out; const float* xc = l == 0 ? p->in[I_CTX] : (const float*)(c.ws + WS_XC);
    bf16* H = (bf16*)(c.ws + WS_H);
    int* TKEP = (int*)(c.ws + WS_RT + RT_TKEP); float* TKW = (float*)(c.ws + WS_RT + RT_TKW); int* TB = (int*)(c.ws + WS_TB);
    int* CNT = (int*)(c.ws + WS_CTL) + CW_CNT + l * NCH * NE;
    constexpr int HROW = 1032;
    LAS bf16* hhi = (LAS bf16*)c.lds;
    LAS bf16* hlo = hhi + 32 * HROW;
    LAS float* lgs = (LAS float*)(c.lds + 132096);
    LAS int* hist = (LAS int*)(c.lds + 140288);
    const bf16* Whi = (const bf16*)(c.ws + WS_TAB + TAB_RWT) + (size_t)(l * 2) * 65536; const bf16* Wlo = Whi + 65536;
    const float rbias = p->in[I_RB][l * 64 + c.lane];
    const int ntiles = ntok / 32, rpc = ntok / NCH, lane = c.lane, mb = c.wave >> 2, nb = c.wave & 3;
    for (int tile = c.blk; tile < ntiles; tile += c.G) {
        __syncthreads();
        if (c.tid < 64) hist[c.tid] = 0;
        for (int q = 0; q < 4; ++q) { const int r = tile * 32 + c.wave * 4 + q; const float* xr = r < NLAT ? xl + (size_t)r * DM : xc + (size_t)(r - NLAT) * DM; const float* m = MOD + (size_t)mod_row(r) * 6144;
            float* xo = r < NLAT ? p->out + (size_t)r * DM : (float*)(c.ws + WS_XC) + (size_t)(r - NLAT) * DM;
            f32x4 v[4]; norm_row_add(xr, (const bf16*)(c.ws + WS_Z) + (size_t)r * DM, xo, p->in[I_N2G] + l * DM, m + 3072, m + 4096, c.ws + WS_H8 + (size_t)r * DM, lane, v);
#pragma unroll
            for (int j = 0; j < 4; ++j) { u32x2 hi; hi.x = pk2(v[j].x, v[j].y); hi.y = pk2(v[j].z, v[j].w);
                const float r0 = v[j].x - __uint_as_float(hi.x << 16), r1 = v[j].y - __uint_as_float(hi.x & 0xffff0000u), r2 = v[j].z - __uint_as_float(hi.y << 16), r3 = v[j].w - __uint_as_float(hi.y & 0xffff0000u);
                u32x2 lo; lo.x = pk2(r0, r1); lo.y = pk2(r2, r3);
                *(LAS u32x2*)(hhi + (c.wave * 4 + q) * HROW + 4 * lane + 256 * j) = hi; *(LAS u32x2*)(hlo + (c.wave * 4 + q) * HROW + 4 * lane + 256 * j) = lo; } }
        __syncthreads();
        { f32x4 acc = (f32x4){0.f, 0.f, 0.f, 0.f};
          const LAS bf16* ah = hhi + (mb * 16 + (lane & 15)) * HROW + 8 * (lane >> 4); const LAS bf16* al = hlo + (mb * 16 + (lane & 15)) * HROW + 8 * (lane >> 4);
          const bf16* bh = Whi + (size_t)(nb * 16 + (lane & 15)) * 1024 + 8 * (lane >> 4); const bf16* bl = Wlo + (size_t)(nb * 16 + (lane & 15)) * 1024 + 8 * (lane >> 4);
#pragma unroll 8
          for (int ks = 0; ks < 32; ++ks) { const bf16x8 a_h = *(const LAS bf16x8*)(ah + 32 * ks), a_l = *(const LAS bf16x8*)(al + 32 * ks), b_h = *(const bf16x8*)(bh + 32 * ks), b_l = *(const bf16x8*)(bl + 32 * ks);
              acc = __builtin_amdgcn_mfma_f32_16x16x32_bf16(a_h, b_h, acc, 0, 0, 0); acc = __builtin_amdgcn_mfma_f32_16x16x32_bf16(a_h, b_l, acc, 0, 0, 0); acc = __builtin_amdgcn_mfma_f32_16x16x32_bf16(a_l, b_h, acc, 0, 0, 0); }
#pragma unroll
          for (int i = 0; i < 4; ++i) lgs[(mb * 16 + 4 * (lane >> 4) + i) * 64 + nb * 16 + (lane & 15)] = acc[i]; }
        __syncthreads();
#pragma unroll
        for (int q = 0; q < 4; ++q) {
            const int r = tile * 32 + c.wave * 4 + q;
            const float s = sigmoidf_(lgs[(c.wave * 4 + q) * 64 + lane]), bs = s + rbias;
            float m1 = bs; m1 = fmaxf(m1, shx<1>(m1)); m1 = fmaxf(m1, shx<2>(m1)); m1 = fmaxf(m1, shx<4>(m1));
            const unsigned long long eq = __ballot(bs == m1); const unsigned gm = (unsigned)(eq >> (lane & 56)) & 0xffu; const int first = __ffs(gm) - 1;
            float m2 = ((lane & 7) == first) ? -1e30f : bs; m2 = fmaxf(m2, shx<1>(m2)); m2 = fmaxf(m2, shx<2>(m2)); m2 = fmaxf(m2, shx<4>(m2));
            const float gs = m1 + m2; const int g = lane >> 3; int rank = 0;
#pragma unroll
            for (int j = 0; j < 8; ++j) { const float o = rdl(gs, 8 * j); rank += (o > gs || (o == gs && j < g)) ? 1 : 0; }
            float cand = rank < 4 ? bs : -1e30f; int my_e = 0; float my_w = 0.f, wsum = 0.f;
#pragma unroll
            for (int k = 0; k < 8; ++k) { const float mm = wave_max(cand); const unsigned long long e2 = __ballot(cand == mm); const int idx = __ffsll((long long)e2) - 1; const float wk = rdl(s, idx);
                if (lane == idx) cand = -1e30f; if (lane == k) { my_e = idx; my_w = wk; } wsum += wk; }
            if (lane < 8) { const int lp = atomicAdd((int*)&hist[my_e], 1); TKEP[(size_t)r * 8 + lane] = my_e | (lp << 8); TKW[(size_t)r * 8 + lane] = my_w / wsum * 2.5f; }
        }
        __syncthreads();
        if (c.tid < 64) { const int n = hist[c.tid]; int base = 0; if (n > 0) base = atomicAdd(&CNT[((tile * 32) / rpc) * NE + c.tid], n); TB[tile * 64 + c.tid] = base; }
    }
    __syncthreads();
}
__device__ __forceinline__ void phase_route_fill(const Ctx& c, int l, int ntok) {
    const int* TKEP = (const int*)(c.ws + WS_RT + RT_TKEP); int* SLOT = (int*)(c.ws + WS_RT + RT_SLOT); const int* TB = (const int*)(c.ws + WS_TB);
    const int* CNT = (const int*)(c.ws + WS_CTL) + CW_CNT + l * NCH * NE; int* ROWL = (int*)(c.ws + WS_ROWL);
    LAS int* est = (LAS int*)c.lds;
    const int rpc = ntok / NCH;
    __syncthreads();
    if (c.tid < NCH) { int s = 0; for (int e = 0; e < NE; ++e) { est[c.tid * 65 + e] = s; s += (CNT[c.tid * NE + e] + 255) & ~255; } est[c.tid * 65 + 64] = s; }
    __syncthreads();
    const size_t na = (size_t)ntok * 8;
    for (size_t a = (size_t)c.blk * NTHR + c.tid; a < na; a += (size_t)c.G * NTHR) { const int t = (int)(a >> 3), ch = t / rpc; const int ep = TKEP[a], e = ep & 255, lp = ep >> 8;
        const int slot = est[ch * 65 + e] + TB[(t >> 5) * 64 + e] + lp; SLOT[a] = slot; ROWL[(size_t)ch * RPCMAX + slot] = t; }
    for (int i = c.blk * NTHR + c.tid; i < NCH * NE * 256; i += c.G * NTHR) { const int ch = i >> 14, e = (i >> 8) & 63, j = i & 255; const int n = CNT[ch * NE + e]; const int pad = ((n + 255) & ~255) - n;
        if (j < pad) ROWL[(size_t)ch * RPCMAX + est[ch * 65 + e] + n + j] = ch * rpc; }
    __syncthreads();
}

__device__ __forceinline__ void moe_tile_table(const Ctx& c, int l, int ch, LAS int* tst) {
    const int* CNT = (const int*)(c.ws + WS_CTL) + CW_CNT + l * NCH * NE + ch * NE;
    LAS unsigned char* texp = (LAS unsigned char*)(tst + 80);
    __syncthreads();
    if (c.tid == 0) { int s = 0; for (int e = 0; e < NE; ++e) { tst[e] = s; s += (CNT[e] + 255) >> 8; } tst[64] = s; }
    __syncthreads();
    if (c.tid < NE) { for (int t = tst[c.tid]; t < tst[c.tid + 1]; ++t) texp[t] = (unsigned char)c.tid; }
    __syncthreads();
}
__device__ __forceinline__ void phase_combine(const Ctx& c, KParams p, int l, int ch, int rpc) {
    const float* MOD = (const float*)(c.ws + WS_MOD) + (size_t)l * 33 * 6144 + 5120; const float* MODn = (const float*)(c.ws + WS_MOD) + (size_t)33 * 6144;
    const int* SLOT = (const int*)(c.ws + WS_RT + RT_SLOT); const float* TKW = (const float*)(c.ws + WS_RT + RT_TKW);
    const unsigned char* OB = (const unsigned char*)(c.ws + WS_OB); const bf16* OBS = (const bf16*)(c.ws + WS_OBS);
    float* xl = p->out; float* xc = (float*)(c.ws + WS_XC); bf16* H = (bf16*)(c.ws + WS_H);
    const int gw = c.blk * NWAVES + c.wave, NGW = c.G * NWAVES, lane = c.lane;
    const int col0 = (lane >> 4) * 256 + ((lane >> 2) & 3) * 32 + (lane & 3) * 8;
    f32x4 gn[4];
#pragma unroll
    for (int q = 0; q < 4; ++q) gn[q] = *(const f32x4*)((l == 0 ? p->in[I_N1G] + DM : p->in[I_FG]) + col0 + 128 * (q >> 1) + 4 * (q & 1));
    int sl_n = 0; float w_n = 0.f;
    if (gw < rpc && lane < 8) { sl_n = SLOT[(size_t)(ch * rpc + gw) * 8 + lane]; w_n = TKW[(size_t)(ch * rpc + gw) * 8 + lane] * 0.0625f; }
    for (int i = gw; i < rpc; i += NGW) {
        const int t = ch * rpc + i; float* xr = t < NLAT ? xl + (size_t)t * DM : xc + (size_t)(t - NLAT) * DM; const int mr = mod_row(t); const float* g2 = MOD + (size_t)mr * 6144;
        const int sl = sl_n; const float w = w_n;
        u32x4 ob[8], os0, os1; f32x4 xv[4];
#pragma unroll
        for (int e = 0; e < 8; ++e) ob[e] = *(const u32x4*)(OB + (size_t)rdli(sl, e) * 1024 + lane * 16);
        os0 = *(const u32x4*)(OBS + (size_t)i * DM + col0); os1 = *(const u32x4*)(OBS + (size_t)i * DM + col0 + 128);
#pragma unroll
        for (int q = 0; q < 4; ++q) xv[q] = *(const f32x4*)(xr + col0 + 128 * (q >> 1) + 4 * (q & 1));
        if (i + NGW < rpc && lane < 8) { sl_n = SLOT[(size_t)(t + NGW) * 8 + lane]; w_n = TKW[(size_t)(t + NGW) * 8 + lane] * 0.0625f; }
        float a[16]; { float t8[8]; unpack8(os0, t8);
#pragma unroll
            for (int q = 0; q < 8; ++q) a[q] = t8[q];
            unpack8(os1, t8);
#pragma unroll
            for (int q = 0; q < 8; ++q) a[8 + q] = t8[q]; }
#pragma unroll
        for (int e = 0; e < 8; ++e) { const float wk = rdl(w, e);
#pragma unroll
            for (int q = 0; q < 4; ++q) { const f32x2 lo = __builtin_amdgcn_cvt_pk_f32_fp8((int)ob[e][q], false), hi = __builtin_amdgcn_cvt_pk_f32_fp8((int)ob[e][q], true);
                a[4 * q] = fmaf(wk, lo.x, a[4 * q]); a[4 * q + 1] = fmaf(wk, lo.y, a[4 * q + 1]); a[4 * q + 2] = fmaf(wk, hi.x, a[4 * q + 2]); a[4 * q + 3] = fmaf(wk, hi.y, a[4 * q + 3]); } }
        f32x4 xn[4]; float ss = 0.f;
#pragma unroll
        for (int q = 0; q < 4; ++q) { const int cc = col0 + 128 * (q >> 1) + 4 * (q & 1); const f32x4 gv = *(const f32x4*)(g2 + cc);
            xn[q] = xv[q] + gv * (f32x4){a[4 * q], a[4 * q + 1], a[4 * q + 2], a[4 * q + 3]}; ss += (xn[q].x * xn[q].x + xn[q].y * xn[q].y) + (xn[q].z * xn[q].z + xn[q].w * xn[q].w); }
        const float rstd = rsqrtf(wave_sum(ss) * (1.f / 1024.f) + EPS);
        if (l == 0) { const float* mn = MODn + (size_t)mr * 6144; bf16* hr = H + (size_t)t * DM;
#pragma unroll
            for (int q = 0; q < 4; ++q) { const int cc = col0 + 128 * (q >> 1) + 4 * (q & 1); *(f32x4*)(xr + cc) = xn[q];
                const f32x4 s0 = *(const f32x4*)(mn + cc), s1 = *(const f32x4*)(mn + 1024 + cc); const f32x4 hv = xn[q] * rstd * gn[q] * (s1 + 1.0f) + s0;
                u32x2 o; o.x = pk2(hv.x, hv.y); o.y = pk2(hv.z, hv.w); *(u32x2*)(hr + cc) = o; } }
        else {
#pragma unroll
            for (int q = 0; q < 4; ++q) { const int cc = col0 + 128 * (q >> 1) + 4 * (q & 1); *(f32x4*)(xr + cc) = xn[q] * rstd * gn[q]; } }
    }
}
constexpr int LDS_BYTES = 147456;
constexpr int LDS_TAB = 131072, LDS_XB = LDS_BYTES - 16;
enum { J_INPROJ = 0, J_S5G1, J_PW, J_Q, J_KV, J_S5G2, J_GLU, J_OUT, J_GU, J_GUS, J_DN, J_DNS };
enum { SK_DENSE = 0, SK_S5, SK_MOE };
enum { EK_INPROJ = 0, EK_S5X, EK_S5Y, EK_BIAS, EK_GLU, EK_Q, EK_KV, EK_RESID, EK_SWIGLU, EK_OB8, EK_BF16 };
struct JSched {
    int sk, G, c; pg8::DenseOrder d; const char* W; size_t wexp, wtile; const LAS unsigned char* texp; int ntile, npn;
    __device__ __forceinline__ bool next(int i, pg8::Unit& u) const {
        if (sk == SK_DENSE) return d.next(i, u);
        const int L = i * G + c;
        if (sk == SK_S5) { if (L >= 288) return false; u.pm = L; u.pn = 0; u.e = L / 18; u.B = W + (size_t)u.e * wexp; return true; }
        if (L >= ntile * npn) return false;
        const int T = npn == 2 ? (L >> 1) : (L >> 2), pn = L & (npn - 1); const int e = __builtin_amdgcn_readfirstlane((int)texp[T]);
        u.pm = T; u.pn = pn; u.e = e; u.B = W + (size_t)e * wexp + (size_t)pn * wtile; return true;
    }
};
struct JRows { const int* list; unsigned ldab;
    __device__ __forceinline__ unsigned off(const pg8::Unit& u, int r) const { const int row = u.pm * 256 + r; return (unsigned)(list ? list[row] : row) * ldab; } };
struct JEpi {
    int ek; void* p0; void* p1; void* p2; const void* q0; const void* q1; const void* q2; int i0;
    __device__ __forceinline__ void operator()(EPI_ARGS) const {
        switch (ek) {
        case EK_INPROJ: EpiInProj{(bf16*)p0, (bf16*)p1, (bf16*)p2}(acc, u, wr, wc, fr, fq); break;
        case EK_S5X:    EpiS5X{(bf16*)p0}(acc, u, wr, wc, fr, fq); break;
        case EK_S5Y:    EpiS5Y{(bf16*)p0}(acc, u, wr, wc, fr, fq); break;
        case EK_BIAS:   EpiBiasBf16{(bf16*)p0, i0, (const float*)q0}(acc, u, wr, wc, fr, fq); break;
        case EK_GLU:    EpiGluSig{(bf16*)p0, i0, (const float*)q0}(acc, u, wr, wc, fr, fq); break;
        case EK_Q:      EpiQ{(bf16*)p0, (const float*)q0}(acc, u, wr, wc, fr, fq); break;
        case EK_KV:     EpiKV{(bf16*)p0, (bf16*)p1, (const float*)q0}(acc, u, wr, wc, fr, fq); break;
        case EK_RESID:  EpiDelta{(bf16*)p0, (const float*)q0}(acc, u, wr, wc, fr, fq); break;
        default:        EpiBf16{(bf16*)p0, i0}(acc, u, wr, wc, fr, fq); break;
        }
    }
};
struct JEpi8 {
    int ek; void* p0; int i0;
    __device__ __forceinline__ void operator()(EPI_ARGS) const {
        if (ek == EK_SWIGLU) EpiSwiglu{(unsigned char*)p0, i0, 1.0f / 256.0f}(acc, u, wr, wc, fr, fq);
        else if (ek == EK_OB8) EpiOB8{(unsigned char*)p0, 16.0f / 1024.0f}(acc, u, wr, wc, fr, fq);
        else EpiBf16S{(bf16*)p0, i0, 1.0f / 1024.0f}(acc, u, wr, wc, fr, fq);
    }
};
__device__ __forceinline__ void gemm_job(KParams p, LAS unsigned char* lds, int job, int l, int ch) {
    unsigned char* ws = p->ws;
    const int G = gridDim.x, blk = blockIdx.x;
    const bool last = (l == 1); const int nrows = last ? NLAT : NTOK, rpc = nrows / NCH;
    unsigned char* sm = ws + WS_WSM + (size_t)l * WSM_L;
    const LAS int* tst = (const LAS int*)(lds + LDS_TAB);
    const char* A = nullptr; int K = 256; bool fp8 = false; JSched S; JRows R; JEpi E;
    S.sk = SK_DENSE; S.G = G; S.c = blk; S.W = nullptr; S.wexp = 0; S.wtile = 0; S.texp = (const LAS unsigned char*)(tst + 80); S.ntile = 0; S.npn = 2; S.d.init(1, 1, G, blk, nullptr, 256);
    R.list = nullptr; R.ldab = 512u; E.ek = EK_BF16; E.p0 = E.p1 = E.p2 = nullptr; E.q0 = E.q1 = E.q2 = nullptr; E.i0 = 0;
    switch (job) {
    case J_INPROJ: A = (const char*)(ws + WS_H); K = 1024; R.ldab = 2048u; S.d.init(NTOK / 256, ZW / 256, G, blk, (const bf16*)(ws + WS_WIN) + (size_t)l * 2048 * 1024, 1024);
        E.ek = EK_INPROJ; E.p0 = ws + WS_Z; E.p1 = ws + WS_UP; E.p2 = ws + WS_GVT; break;
    case J_S5G1: A = (const char*)(ws + WS_UP); K = 256; R.ldab = 1024u; S.sk = SK_S5; S.W = (const char*)(ws + WS_S5W) + (size_t)l * 16 * 256 * 256 * 2; S.wexp = (size_t)256 * 256 * 2; E.ek = EK_S5X; E.p0 = ws + WS_Y5; break;
    case J_PW: A = (const char*)(ws + WS_CV); K = 256; R.ldab = 512u; S.d.init(nrows / 256, 1, G, blk, (const bf16*)(sm + WSM_PW), 256); E.ek = EK_BIAS; E.p0 = (bf16*)(ws + WS_MIX) + 256; E.i0 = DM; E.q0 = p->in[I_CPB] + l * 256; break;
    case J_Q: A = (const char*)(ws + WS_Z) + ZCQ * 2; K = 256; R.ldab = (unsigned)ZW * 2u; S.d.init(NTOK / 256, 2, G, blk, (const bf16*)(sm + WSM_UQ), 256);
        E.ek = EK_Q; E.p0 = ws + WS_H; E.q0 = ws + WS_RS; break;
    case J_KV: A = (const char*)(ws + WS_Z) + ZCKV * 2; K = 256; R.ldab = (unsigned)ZW * 2u; S.d.init(NTOK / 256, 2, G, blk, (const bf16*)(sm + WSM_UK), 256);
        E.ek = EK_KV; E.p0 = (bf16*)(ws + WS_H) + (size_t)NTOK * 384; E.p1 = (bf16*)(ws + WS_H) + (size_t)NTOK * 768; E.q0 = ws + WS_RS; break;
    case J_S5G2: A = (const char*)(ws + WS_UP); K = 512; R.ldab = 1024u; S.sk = SK_S5; S.W = (const char*)(ws + WS_S5W) + (size_t)32 * 256 * 256 * 2 + (size_t)l * 16 * 256 * 512 * 2; S.wexp = (size_t)256 * 512 * 2; E.ek = EK_S5Y; E.p0 = ws + WS_Y5; break;
    case J_GLU: A = (const char*)(ws + WS_Y5); K = 256; R.ldab = 512u; S.d.init(nrows / 256, 2, G, blk, (const bf16*)(sm + WSM_GLU), 256); E.ek = EK_GLU; E.p0 = (bf16*)(ws + WS_MIX) + 512; E.i0 = DM; E.q0 = p->in[I_S5GB] + l * 512; break;
    case J_OUT: A = (const char*)(ws + WS_MIX); K = 1024; R.ldab = 2048u; S.d.init(nrows / 256, 4, G, blk, (const bf16*)(ws + WS_WOUT) + (size_t)l * 1024 * 1024, 1024);
        E.ek = EK_RESID; E.p0 = ws + WS_Z; E.q0 = (const float*)(ws + WS_MOD) + (size_t)l * 33 * 6144 + 2048; break;
    case J_GU: A = (const char*)(ws + WS_H8); K = 512; fp8 = true; R.list = (const int*)(ws + WS_ROWL) + (size_t)ch * RPCMAX; R.ldab = 1024u; S.sk = SK_MOE; S.ntile = __builtin_amdgcn_readfirstlane(tst[64]); S.npn = 2; S.W = (const char*)(ws + WS_WMOE) + (size_t)l * 48 * MiB; S.wexp = (size_t)512 * 1024; S.wtile = (size_t)256 * 1024;
        E.ek = EK_SWIGLU; E.p0 = ws + WS_HB; E.i0 = 256; break;
    case J_GUS: A = (const char*)(ws + WS_H8) + (size_t)ch * rpc * 1024; K = 512; fp8 = true; R.ldab = 1024u; S.d.init(rpc / 256, 2, G, blk, (const bf16*)((const unsigned char*)(ws + WS_WSH) + (size_t)l * (512 * 1024 + 1024 * 256) * 2), 512); E.ek = EK_SWIGLU; E.p0 = ws + WS_HBS; E.i0 = 256; break;
    case J_DN: A = (const char*)(ws + WS_HB); K = 128; fp8 = true; R.ldab = 256u; S.sk = SK_MOE; S.ntile = __builtin_amdgcn_readfirstlane(tst[64]); S.npn = 4; S.W = (const char*)(ws + WS_WMOE) + (size_t)l * 48 * MiB + (size_t)NE * 512 * 1024; S.wexp = (size_t)1024 * 256; S.wtile = (size_t)256 * 256;
        E.ek = EK_OB8; E.p0 = ws + WS_OB; break;
    default: A = (const char*)(ws + WS_HBS); K = 128; fp8 = true; R.ldab = 256u; S.d.init(rpc / 256, 4, G, blk, (const bf16*)((const unsigned char*)(ws + WS_WSH) + (size_t)l * (512 * 1024 + 1024 * 256) * 2 + 512 * 1024), 128); E.ek = EK_BF16; E.p0 = ws + WS_OBS; E.i0 = DM; break;
    }
    __builtin_amdgcn_s_waitcnt(0x0F70);
    if (fp8) pg8::gemm_phase<true>(lds, A, K, S, R, JEpi8{E.ek, E.p0, E.i0});
    else pg8::gemm_phase<false>(lds, A, K, S, R, E);
}


__global__ void __launch_bounds__(NTHR, 2) fwd_kernel(Params pk) {
    extern __shared__ __attribute__((aligned(16))) unsigned char lds_raw[];
    LAS unsigned char* const lds0 = (LAS unsigned char*)lds_raw;
    if (threadIdx.x < 4) ((LAS unsigned*)(lds0 + LDS_XB))[threadIdx.x] = 0u;
    __syncthreads();
    (void)xcd_barrier_post((unsigned*)(pk.ws + WS_CTL) + CW_BAR, (volatile LAS unsigned*)(lds0 + LDS_XB));
    constexpr int NSTEP = 15 + 6 * NCH;
#ifndef PROBE_DUP
#define PROBE_DUP (-9)
#endif
#pragma unroll 1
    for (int it_ = -2; it_ < 2 * NSTEP + (PROBE_DUP >= 0 ? 2 : 0); ++it_) {
        int gs = it_; if (PROBE_DUP >= 0) { if (it_ > PROBE_DUP) gs -= 1; if (it_ > NSTEP + PROBE_DUP + 1) gs -= 1; }
        KParams p = fresh_params(); Ctx c; { int t_ = threadIdx.x; asm volatile("" : "+v"(t_)); c.lds = lds0; c.tid = t_; c.lane = t_ & 63; c.wave = __builtin_amdgcn_readfirstlane(t_ >> 6); c.blk = blockIdx.x; c.G = gridDim.x; c.ws = p->ws; }
        LAS int* tst = (LAS int*)(c.lds + LDS_TAB);
        int l = 0, s = gs, ch = 0, job = -1; bool seam = true;
        if (gs >= 0) { l = gs >= NSTEP ? 1 : 0; s = gs - l * NSTEP; if (s >= 15) { ch = (s - 15) / 6; s = 15 + (s - 15) % 6; } }
        const bool last = (l == 1); const int nrows = last ? NLAT : NTOK, rpc = nrows / NCH;
        switch (s) {
        case -2: prologue(c, p); break;
        case -1: prologue2(c, p); phase_norm1(c, p, 0); break;
        case 0: seam = false; break;
        case 1: job = J_INPROJ; break;
        case 2: phase_gla(c, p, l); phase_conv1(c, p, l, !last); phase_mla_prep(c, p); seam = false; break;
        case 3: job = J_S5G1; break;
        case 4: phase_gla_final(c, p, l, nrows); seam = false; break;
        case 5: job = J_PW; seam = false; break;
        case 6: job = J_Q; seam = false; break;
        case 7: job = J_KV; seam = false; break;
        case 8: phase_s5_carry(c, l); break;
        case 9: phase_attn(c, !last); seam = false; break;
        case 10: job = J_S5G2; break;
        case 11: job = J_GLU; break;
        case 12: job = J_OUT; break;
        case 13: phase_norm2_route(c, p, l, nrows); break;
        case 14: phase_route_fill(c, l, nrows); break;
        case 15: moe_tile_table(c, l, ch, tst); job = J_GU; seam = false; break;
        case 16: job = J_GUS; break;
        case 17: job = J_DN; seam = false; break;
        case 18: job = J_DNS; break;
        case 19: phase_combine(c, p, l, ch, rpc); break;
        default: seam = false; break;
        }
        if (job >= 0) gemm_job(p, c.lds, job, l, ch);
        if (seam && gs + 1 < 2 * NSTEP) { XcdBarrier b_; b_.bar = (unsigned*)(p->ws + WS_CTL) + CW_BAR; b_.x = xb_xcc_id(); b_.st = (volatile LAS unsigned*)(lds0 + LDS_XB); xcd_barrier(b_); }
    }
}

extern "C" void kernel_launch(void* const* d_in, const int* in_sizes, int n_in, void* d_out, int out_size, void* d_ws, size_t ws_size, hipStream_t stream) {
    static int grid = 0;
    if (grid == 0) {
        if (n_in != 42 || out_size != NLAT * DM || ws_size < WS_END) { fprintf(stderr, "kernel_launch: unexpected shapes (n_in %d out %d ws %zu)\n", n_in, out_size, ws_size); grid = -1; return; }
        int dev = 0, cus = 0;
        if (hipGetDevice(&dev) != hipSuccess || hipDeviceGetAttribute(&cus, hipDeviceAttributeMultiprocessorCount, dev) != hipSuccess) { grid = -1; return; }
        if (hipFuncSetAttribute((const void*)fwd_kernel, hipFuncAttributeMaxDynamicSharedMemorySize, LDS_BYTES) != hipSuccess) { fprintf(stderr, "kernel_launch: hipFuncSetAttribute failed\n"); grid = -1; return; }
        int per_cu = 0;
        if (hipOccupancyMaxActiveBlocksPerMultiprocessor(&per_cu, (const void*)fwd_kernel, NTHR, LDS_BYTES) != hipSuccess || per_cu < 1) fprintf(stderr, "kernel_launch: occupancy query reports %d\n", per_cu);
        (void)hipGetLastError();
        grid = cus;
    }
    if (grid < 0) return;
    (void)hipMemsetAsync((char*)d_ws + WS_CTL, 0, CTL_BYTES, stream);
    Params p{};
    for (int i = 0; i < 42; ++i) p.in[i] = (const float*)d_in[i];
    p.out = (float*)d_out; p.ws = (unsigned char*)d_ws; p.ph_lo = 0; p.ph_hi = 1 << 20;
    hipLaunchKernelGGL(fwd_kernel, dim3(grid), dim3(NTHR), LDS_BYTES, stream, p);
}
```

```cpp
#include <hip/hip_runtime.h>
#include <cstdio>
#include <cstdint>

#define LAS __attribute__((address_space(3)))
typedef unsigned short bf16;
typedef short bf16x8 __attribute__((ext_vector_type(8)));
typedef float f32x4 __attribute__((ext_vector_type(4)));
typedef float f32x2 __attribute__((ext_vector_type(2)));
typedef float f32x16 __attribute__((ext_vector_type(16)));
typedef unsigned u32x4 __attribute__((ext_vector_type(4)));
typedef unsigned u32x2 __attribute__((ext_vector_type(2)));
typedef int i32x4 __attribute__((ext_vector_type(4)));
typedef int i32x8 __attribute__((ext_vector_type(8)));

constexpr int NB = 32, SEQ = 2048, CTXL = 256, DM = 1024;
constexpr int NLAT = NB * SEQ, NCTX = NB * CTXL, NTOK = NLAT + NCTX;
constexpr int ZW = 2048;
constexpr int ZQ = 0, ZK = 128, ZV = 256, ZR = 512, ZCA = 768, ZCG = 1024, ZS5 = 1280, ZCQ = 1536, ZCKV = 1792, ZKR = 1920, ZAF = 1952, ZAB = 1968;
constexpr int NE = 64, TOPK = 8;
constexpr int NCH = 2;
constexpr int RPCMAX = (NTOK / NCH) * 8 + 64 * 256;
constexpr float EPS = 1e-6f;
constexpr int NWAVES = 8, NTHR = 512;

constexpr size_t MiB = (size_t)1 << 20;
constexpr size_t WS_CTL = 0, CTL_BYTES = 1 * MiB;
constexpr size_t WS_MOD = 1 * MiB;
constexpr size_t WS_TAB = 3 * MiB;
constexpr size_t WS_WSM = 5 * MiB;
constexpr size_t WS_WIN = 8 * MiB;
constexpr size_t WS_WOUT = 16 * MiB;
constexpr size_t WS_WSH = 20 * MiB;
constexpr size_t WS_TB = 23 * MiB;
constexpr size_t WS_RT = 24 * MiB;
constexpr size_t WS_ROWL = 32 * MiB;
constexpr size_t WS_RS = 35 * MiB;
constexpr size_t WS_WMOE = 36 * MiB;
constexpr size_t WS_XC = 132 * MiB;
constexpr size_t WS_H = 164 * MiB;
constexpr size_t WS_H8 = WS_H + 72 * MiB;
constexpr size_t WS_Z = 308 * MiB;
constexpr size_t WS_MIX = 596 * MiB;
constexpr size_t WS_T1 = 740 * MiB;
constexpr size_t WS_UP = 812 * MiB;
constexpr size_t WS_CV = 884 * MiB;
constexpr size_t WS_Y5 = 920 * MiB;
constexpr size_t WS_S5W = 956 * MiB;
constexpr size_t WS_S5P = 968 * MiB;
constexpr size_t WS_GVT = 969 * MiB;
constexpr size_t WS_END = 1005 * MiB;
constexpr size_t WS_HB = WS_Z;
constexpr size_t WS_HBS = WS_Z + 152 * MiB;
constexpr size_t WS_OBS = WS_Z + 170 * MiB;
constexpr size_t WS_OB = WS_MIX;
static_assert((size_t)RPCMAX * 512 <= 152 * MiB && WS_OBS + (size_t)(NTOK / NCH) * 2048 <= WS_MIX && WS_OB + (size_t)RPCMAX * 1024 <= WS_S5W, "MoE overlays");
constexpr int CW_BAR = 0;
constexpr int CW_CNT = 4096;
constexpr size_t WSM_L = 1 * MiB;
constexpr size_t WSM_PW = 0, WSM_GLU = 128 * 1024, WSM_UQ = 384 * 1024, WSM_UK = 640 * 1024, WSM_UV = 768 * 1024;
constexpr size_t TAB_ROPE = 0;
constexpr size_t TAB_S5 = 256 * 1024;
constexpr size_t TAB_RWT = 1536 * 1024;
constexpr size_t RT_TKEP = 0, RT_TKW = 2400000, RT_SLOT = 4800000;

__device__ __forceinline__ float bf2f(bf16 v) { return __uint_as_float(((unsigned)v) << 16); }
typedef __bf16 bf16x2_t __attribute__((ext_vector_type(2)));
__device__ __forceinline__ unsigned pk2(float lo, float hi) { const f32x2 v = {lo, hi}; return __builtin_bit_cast(unsigned, __builtin_convertvector(v, bf16x2_t)); }
__device__ __forceinline__ bf16 f2bf(float f) { return __builtin_bit_cast(unsigned short, (__bf16)f); }
template <int O> __device__ __forceinline__ float shx(float v) {
    return __int_as_float(__builtin_amdgcn_ds_swizzle(__float_as_int(v), (O << 10) | 0x1f)); }
__device__ __forceinline__ float rdl(float v, int l) { return __int_as_float(__builtin_amdgcn_readlane(__float_as_int(v), l)); }
__device__ __forceinline__ int rdli(int v, int l) { return __builtin_amdgcn_readlane(v, l); }
__device__ __forceinline__ float wave_sum(float v) {
    v += shx<1>(v); v += shx<2>(v); v += shx<4>(v); v += shx<8>(v); v += shx<16>(v);
    const auto r = __builtin_amdgcn_permlane32_swap(__float_as_uint(v), __float_as_uint(v), false, false);
    return __uint_as_float(r[0]) + __uint_as_float(r[1]);
}
__device__ __forceinline__ float wave_max(float v) {
    v = fmaxf(v, shx<1>(v)); v = fmaxf(v, shx<2>(v)); v = fmaxf(v, shx<4>(v)); v = fmaxf(v, shx<8>(v)); v = fmaxf(v, shx<16>(v));
    const auto r = __builtin_amdgcn_permlane32_swap(__float_as_uint(v), __float_as_uint(v), false, false);
    return fmaxf(__uint_as_float(r[0]), __uint_as_float(r[1]));
}
__device__ __forceinline__ float sigmoidf_(float x) { return 1.0f / (1.0f + __expf(-x)); }
__device__ __forceinline__ float siluf_(float x) { return x / (1.0f + __expf(-x)); }
__device__ __forceinline__ void unpack8(const u32x4 w, float (&v)[8]) {
    v[0] = __uint_as_float(w.x << 16); v[1] = __uint_as_float(w.x & 0xffff0000u);
    v[2] = __uint_as_float(w.y << 16); v[3] = __uint_as_float(w.y & 0xffff0000u);
    v[4] = __uint_as_float(w.z << 16); v[5] = __uint_as_float(w.z & 0xffff0000u);
    v[6] = __uint_as_float(w.w << 16); v[7] = __uint_as_float(w.w & 0xffff0000u);
}
__device__ __forceinline__ void lds_wait() { asm volatile("s_waitcnt lgkmcnt(0)" ::: "memory"); }

#define XB_TMO      128
#define XB_XCNT(j)  (256  + 64 * (j))
#define XB_XSUB(j)  (1280 + 64 * (j))
#define XB_XGEN(j)  (2304 + 64 * (j))
#define XB_TOP      3328
#define XB_TOPGEN   3392
#define XCD_BAR_WORDS 3456
#define XB_SPIN_CAP (1u << 22)
__device__ __forceinline__ unsigned xb_ld(unsigned* p)              { return __hip_atomic_load(p, __ATOMIC_RELAXED, __HIP_MEMORY_SCOPE_AGENT); }
__device__ __forceinline__ unsigned xb_add(unsigned* p, unsigned v) { return __hip_atomic_fetch_add(p, v, __ATOMIC_RELAXED, __HIP_MEMORY_SCOPE_AGENT); }
__device__ __forceinline__ unsigned xb_xcc_id() { return (unsigned)__builtin_amdgcn_s_getreg((3 << 11) | 20) & 0xFu; }
#define XB_SPIN(cond, bar) do { unsigned _sp = 0; while (cond) { __builtin_amdgcn_s_sleep(1); \
    if ((++_sp & 255u) == 0u) { if (xb_ld(&(bar)[XB_TMO])) break; if (_sp > XB_SPIN_CAP) { atomicAdd(&(bar)[XB_TMO], 1u); break; } } } } while (0)
struct XcdBarrier { unsigned* bar; unsigned x; volatile LAS unsigned* st; };
__device__ __forceinline__ XcdBarrier xcd_barrier_post(unsigned* bar, volatile LAS unsigned* st) {
    XcdBarrier b; b.bar = bar; b.x = xb_xcc_id(); b.st = st;
    if (threadIdx.x == 0) (void)xb_add(&bar[XB_XCNT(b.x)], 1u);
    return b;
}
__device__ __forceinline__ void xcd_barrier_complete(unsigned* bar, unsigned x, unsigned& nloc, unsigned& nx) {
    const unsigned G = gridDim.x * gridDim.y * gridDim.z;
    unsigned sum, cnt, mine, sp = 0u;
    for (;;) {
        sum = 0u; cnt = 0u; mine = 0u;
#pragma unroll
        for (unsigned j = 0; j < 16; ++j) { const unsigned c = xb_ld(&bar[XB_XCNT(j)]); sum += c; cnt += (c > 0u) ? 1u : 0u; mine = (j == x) ? c : mine; }
        if (sum == G) break;
        __builtin_amdgcn_s_sleep(1);
        if ((++sp & 255u) == 0u) { if (xb_ld(&bar[XB_TMO])) break; if (sp > XB_SPIN_CAP) { atomicAdd(&bar[XB_TMO], 1u); break; } }
    }
    nloc = mine > 0u ? mine : 1u; nx = cnt > 0u ? cnt : 1u;
}
__device__ __forceinline__ void xcd_barrier(const XcdBarrier& b) {
    asm volatile("s_waitcnt vmcnt(0)" ::: "memory");
    __syncthreads();
    if (threadIdx.x == 0) {
        unsigned* bar = b.bar;
        __builtin_amdgcn_s_waitcnt(0);
        unsigned nloc = b.st[0], nx = b.st[1];
        if (nloc == 0u) { xcd_barrier_complete(bar, b.x, nloc, nx); b.st[0] = nloc; b.st[1] = nx; }
        const unsigned old = xb_add(&bar[XB_XSUB(b.x)], 1u);
        const unsigned gen = old / nloc;
        if (old + 1u == (gen + 1u) * nloc) {
            __builtin_amdgcn_fence(__ATOMIC_RELEASE, "agent");
            asm volatile("s_waitcnt vmcnt(0)" ::: "memory");
            const unsigned og = xb_add(&bar[XB_TOP], 1u);
            const unsigned tg = og / nx;
            if (og + 1u == (tg + 1u) * nx) xb_add(&bar[XB_TOPGEN], 1u);
            else XB_SPIN(xb_ld(&bar[XB_TOPGEN]) == tg, bar);
            __builtin_amdgcn_fence(__ATOMIC_ACQUIRE, "agent");
            xb_add(&bar[XB_XGEN(b.x)], 1u);
            asm volatile("s_waitcnt vmcnt(0)" ::: "memory");
        } else {
            XB_SPIN(xb_ld(&bar[XB_XGEN(b.x)]) == gen, bar);
            __builtin_amdgcn_fence(__ATOMIC_ACQUIRE, "agent");
            asm volatile("s_waitcnt vmcnt(0)" ::: "memory");
        }
    }
    __syncthreads();
}

namespace pg8 {
constexpr int BM = 256, BK = 64, HALF = 128, HTB = HALF * BK * 2, STAGE_BYTES = 8 * HTB, NXCD = 8, WGM = 8;
__device__ __forceinline__ int lds_byte(int r, int c) { const int st = (r >> 4) * 2 + (c >> 5), rr = r & 15, cc = c & 31, ob = rr * 64 + cc * 2; return st * 1024 + (ob ^ (((ob >> 9) & 1) << 5)); }
__device__ __forceinline__ void stage_rc(int b, int& R, int& C) { const int st = b / 1024, sb = b % 1024, swz = sb ^ (((sb >> 9) & 1) << 5); R = (st >> 1) * 16 + swz / 64; C = (st & 1) * 32 + (swz % 64) / 2; }
__device__ __forceinline__ int perm32(int rho) { const int n = rho >> 4, i = rho & 15; return 8 * (i >> 2) + 4 * n + (i & 3); }

struct Unit { int pm, pn, e; const char* B; };

struct DenseOrder {
    int nM, nN, nwg, G, c; const char* Bt; size_t btile;
    __device__ __forceinline__ void init(int nM_, int nN_, int G_, int c_, const bf16* Bt_, int K) { nM = nM_; nN = nN_; nwg = nM * nN; G = G_; c = c_; Bt = (const char*)Bt_; btile = (size_t)256 * K * 2; }
    __device__ __forceinline__ bool next(int i, Unit& u) const {
        const long L = (long)i * G + c; if (L >= nwg) return false;
        int wgid = (int)L; { const int q = nwg / NXCD, r = nwg % NXCD, xcd = wgid % NXCD, off = wgid / NXCD; wgid = (xcd < r ? xcd * (q + 1) : r * (q + 1) + (xcd - r) * q) + off; }
        const int nig = WGM * nN, gid = wgid / nig, fm = gid * WGM, gsz = (nM - fm) < WGM ? (nM - fm) : WGM;
        u.pm = fm + ((wgid % nig) % gsz); u.pn = (wgid % nig) / gsz; u.e = 0; u.B = Bt + (size_t)u.pn * btile; return true;
    }
};
struct RowsDense { unsigned ldab; __device__ __forceinline__ unsigned off(const Unit& u, int r) const { return (unsigned)(u.pm * 256 + r) * ldab; } };
struct RowsGather { const int* list; unsigned ldab; __device__ __forceinline__ unsigned off(const Unit& u, int r) const { return (unsigned)list[u.pm * 256 + r] * ldab; } };

template <bool FP8, class Epi, class Sched, class Rows>
__device__ __forceinline__ void gemm_phase(LAS unsigned char* lds, const char* Abase, const int K, const Sched& S, const Rows& RW, const Epi& E) {
    int tid_ = threadIdx.x; asm volatile("" : "+v"(tid_));
    const int tid = tid_, wid = __builtin_amdgcn_readfirstlane(tid >> 6), lane = tid & 63, wr = wid >> 2, wc = wid & 3, fr = lane & 15, fq = lane >> 4;
    const int nt = K / BK;
    int sR[2]; unsigned sC[2], voffB[2];
#pragma unroll
    for (int i = 0; i < 2; ++i) { int R, C; stage_rc(tid * 16 + i * 8192, R, C); sR[i] = R; sC[i] = (unsigned)C * 2u; const int Rb = (R & ~31) + perm32(R & 31); voffB[i] = (unsigned)(Rb * K + C) * 2u; }
    const size_t kstep = (size_t)(BK * 2);
    const size_t hstepB = (size_t)HALF * K * 2;
    const unsigned ldsw = (unsigned)wid * 1024u;
    const int aoff = lds_byte(wr * 64 + fr, fq * 8), boff = lds_byte(wc * 32 + fr, fq * 8);
#define PG8_SA(b, h) (((b) * 2 + (h)) * HTB)
#define PG8_SB(b, h) ((4 + (b) * 2 + (h)) * HTB)
#define PG8_STAGE(bufoff, gbase, voff) do { const char* _gb = (const char*)(gbase); asm volatile("" : "+s"(_gb)); _Pragma("unroll") for (int _i = 0; _i < 2; ++_i) { unsigned _o = (voff)[_i]; asm volatile("" : "+v"(_o)); \
        __builtin_amdgcn_global_load_lds((const unsigned*)(_gb + _o), (LAS unsigned*)(lds + (bufoff) + ldsw + _i * 8192), 16, 0, 0); } } while (0)
#define PG8_LDA(dst, b, h) do { _Pragma("unroll") for (int m = 0; m < 4; ++m) dst[m] = PG8_CAT(*(const LAS i32x4*)(lds + PG8_SA(b, h) + aoff + m * 2048), *(const LAS i32x4*)(lds + PG8_SA(b, h) + aoff + m * 2048 + 1024)); } while (0)
#define PG8_LDB(dst, b, h) do { _Pragma("unroll") for (int n = 0; n < 2; ++n) dst[n] = PG8_CAT(*(const LAS i32x4*)(lds + PG8_SB(b, h) + boff + n * 2048), *(const LAS i32x4*)(lds + PG8_SB(b, h) + boff + n * 2048 + 1024)); } while (0)
#define PG8_CAT(x0, x1) __builtin_shufflevector((x0), (x1), 0, 1, 2, 3, 4, 5, 6, 7)
#define PG8_LO(x) __builtin_bit_cast(bf16x8, __builtin_shufflevector((x), (x), 0, 1, 2, 3))
#define PG8_HI(x) __builtin_bit_cast(bf16x8, __builtin_shufflevector((x), (x), 4, 5, 6, 7))
#define PG8_MMA(ai, bj, At, Bt) do { __builtin_amdgcn_s_setprio(1); \
        if (FP8) { _Pragma("unroll") for (int m = 0; m < 4; ++m) _Pragma("unroll") for (int n = 0; n < 2; ++n) \
            acc[ai][bj][m][n] = __builtin_amdgcn_mfma_scale_f32_16x16x128_f8f6f4(Bt[n], At[m], acc[ai][bj][m][n], 0, 0, 0, 0x7f7f7f7f, 0, 0x7f7f7f7f); } \
        else { _Pragma("unroll") for (int m = 0; m < 4; ++m) _Pragma("unroll") for (int n = 0; n < 2; ++n) { \
            acc[ai][bj][m][n] = __builtin_amdgcn_mfma_f32_16x16x32_bf16(PG8_LO(Bt[n]), PG8_LO(At[m]), acc[ai][bj][m][n], 0, 0, 0); \
            acc[ai][bj][m][n] = __builtin_amdgcn_mfma_f32_16x16x32_bf16(PG8_HI(Bt[n]), PG8_HI(At[m]), acc[ai][bj][m][n], 0, 0, 0); } } \
        __builtin_amdgcn_s_setprio(0); } while (0)
#define PG8_WAIT_V(n) asm volatile("s_waitcnt vmcnt(" #n ")" ::: "memory")
#define PG8_WAIT_L(n) asm volatile("s_waitcnt lgkmcnt(" #n ")" ::: "memory")
#define PG8_BAR __builtin_amdgcn_s_barrier()
#define PG8_SCHED __builtin_amdgcn_sched_barrier(0)
    Unit cur, nxt; int ui = 0;
    if (!S.next(0, cur)) return;
    f32x4 acc[2][2][4][2];
#pragma unroll
    for (int a = 0; a < 2; ++a)
#pragma unroll
        for (int b = 0; b < 2; ++b)
#pragma unroll
            for (int m = 0; m < 4; ++m)
#pragma unroll
                for (int n = 0; n < 2; ++n) acc[a][b][m][n] = (f32x4){0.f, 0.f, 0.f, 0.f};
    i32x8 At[4], B0[2], B1[2];
    unsigned oA0[2], oA1[2];
#pragma unroll
    for (int i = 0; i < 2; ++i) { oA0[i] = RW.off(cur, sR[i]) + sC[i]; oA1[i] = RW.off(cur, HALF + sR[i]) + sC[i]; }
    const char* cB = cur.B;
    PG8_STAGE(PG8_SB(0, 0), cB, voffB); PG8_STAGE(PG8_SB(0, 1), cB + hstepB, voffB); PG8_STAGE(PG8_SA(0, 0), Abase, oA0); PG8_STAGE(PG8_SA(0, 1), Abase, oA1);
    if (wr == 1) PG8_BAR;
    PG8_WAIT_V(2); PG8_BAR;
    PG8_STAGE(PG8_SB(1, 0), cB + kstep, voffB); PG8_STAGE(PG8_SA(1, 0), Abase + kstep, oA0); PG8_STAGE(PG8_SB(1, 1), cB + hstepB + kstep, voffB);
    PG8_WAIT_V(6); PG8_BAR;
    for (;;) {
        const bool has_next = S.next(ui + 1, nxt);
        unsigned gi0 = 0u, gi1 = 0u, gi2 = 0u, gi3 = 0u;
        if (has_next && RW.list) {
            int t2 = threadIdx.x; asm volatile("" : "+v"(t2)); int R0, C0, R1, C1; stage_rc(t2 * 16, R0, C0); stage_rc(t2 * 16 + 8192, R1, C1);
            const int* lb = RW.list + (size_t)nxt.pm * 256; const unsigned o0 = (unsigned)R0 * 4u, o1 = (unsigned)R1 * 4u, o2 = (unsigned)(HALF + R0) * 4u, o3 = (unsigned)(HALF + R1) * 4u;
            asm volatile("global_load_dword %0, %4, %8\n\tglobal_load_dword %1, %5, %8\n\tglobal_load_dword %2, %6, %8\n\tglobal_load_dword %3, %7, %8"
                         : "=&v"(gi0), "=&v"(gi1), "=&v"(gi2), "=&v"(gi3) : "v"(o0), "v"(o1), "v"(o2), "v"(o3), "s"(lb));
        }
#pragma unroll 1
        for (int t = 0; t < nt; t += 2) {
            const bool last = (t == nt - 2);
            const char* a1 = Abase + (size_t)(t + 1) * kstep;
            PG8_LDB(B0, 0, 0); PG8_LDB(B1, 0, 1); PG8_SCHED; PG8_LDA(At, 0, 0); PG8_STAGE(PG8_SA(1, 1), a1, oA1);
            PG8_WAIT_V(8); PG8_WAIT_L(0); PG8_BAR; PG8_MMA(0, 0, At, B0); PG8_MMA(0, 1, At, B1); PG8_BAR; PG8_SCHED;
            const char* a2; const char* b2;
            if (last) {
                if (has_next) {
                    int t2 = threadIdx.x; asm volatile("" : "+v"(t2));
#pragma unroll
                    for (int i = 0; i < 2; ++i) { int R, C; stage_rc(t2 * 16 + i * 8192, R, C);
                        if (RW.list) { asm volatile("" : "+v"(gi0), "+v"(gi1), "+v"(gi2), "+v"(gi3)); oA0[i] = (i ? gi1 : gi0) * RW.ldab + (unsigned)C * 2u; oA1[i] = (i ? gi3 : gi2) * RW.ldab + (unsigned)C * 2u; }
                        else { oA0[i] = (unsigned)(nxt.pm * 256 + R) * RW.ldab + (unsigned)C * 2u; oA1[i] = (unsigned)(nxt.pm * 256 + HALF + R) * RW.ldab + (unsigned)C * 2u; } }
                    cB = nxt.B;
                }
                a2 = Abase; b2 = cB;
            } else { a2 = Abase + (size_t)(t + 2) * kstep; b2 = cB + (size_t)(t + 2) * kstep; }
            const char* a3 = a2 + kstep; const char* b3 = b2 + kstep;
            PG8_LDA(At, 0, 1); PG8_STAGE(PG8_SB(0, 0), b2, voffB); PG8_STAGE(PG8_SB(0, 1), b2 + hstepB, voffB); PG8_STAGE(PG8_SA(0, 0), a2, oA0);
            PG8_WAIT_V(8); PG8_WAIT_L(0); PG8_BAR; PG8_MMA(1, 0, At, B0); PG8_MMA(1, 1, At, B1); PG8_BAR; PG8_SCHED;
            PG8_LDB(B0, 1, 0); PG8_LDB(B1, 1, 1); PG8_SCHED; PG8_LDA(At, 1, 0); PG8_STAGE(PG8_SA(0, 1), a2, oA1);
            PG8_WAIT_V(8); PG8_WAIT_L(0); PG8_BAR; PG8_MMA(0, 0, At, B0); PG8_MMA(0, 1, At, B1); PG8_BAR; PG8_SCHED;
            PG8_LDA(At, 1, 1); PG8_STAGE(PG8_SB(1, 0), b3, voffB); PG8_STAGE(PG8_SB(1, 1), b3 + hstepB, voffB); PG8_STAGE(PG8_SA(1, 0), a3, oA0);
            PG8_WAIT_V(8); PG8_WAIT_L(0); PG8_BAR; PG8_MMA(1, 0, At, B0); PG8_MMA(1, 1, At, B1); PG8_BAR; PG8_SCHED;
        }
        if (wr == 0) PG8_BAR;
        { Unit eu = cur; asm volatile("" : "+s"(eu.pm), "+s"(eu.pn)); int t3 = threadIdx.x; asm volatile("" : "+v"(t3)); E(acc, eu, wr, wc, t3 & 15, (t3 & 63) >> 4); }
        if (!has_next) break;
#pragma unroll
        for (int a = 0; a < 2; ++a)
#pragma unroll
            for (int b = 0; b < 2; ++b)
#pragma unroll
                for (int m = 0; m < 4; ++m)
#pragma unroll
                    for (int n = 0; n < 2; ++n) acc[a][b][m][n] = (f32x4){0.f, 0.f, 0.f, 0.f};
        cur = nxt; ++ui;
        if (wr == 1) PG8_BAR;
    }
    PG8_WAIT_V(0);
    PG8_BAR;
#undef PG8_SA
#undef PG8_SB
#undef PG8_STAGE
#undef PG8_LDA
#undef PG8_LDB
#undef PG8_MMA
#undef PG8_CAT
#undef PG8_LO
#undef PG8_HI
#undef PG8_WAIT_V
#undef PG8_WAIT_L
#undef PG8_BAR
#undef PG8_SCHED
}
}

struct Params { const float* in[42]; float* out; unsigned char* ws; int ph_lo, ph_hi; };
enum { I_X = 0, I_C, I_CTX, I_CCTX, I_ADAW, I_ADAB, I_N1G, I_N2G, I_WIN, I_WOUT, I_GLAW, I_GLAB, I_GLAG, I_CDW, I_CDB, I_CLG, I_CLB, I_CPW, I_CPB,
       I_S5LR, I_S5LI, I_S5DT, I_S5BR, I_S5BI, I_S5CR, I_S5CI, I_S5D, I_S5GW, I_S5GB, I_QNG, I_KVNG, I_WUQ, I_WUKV, I_RW, I_RB, I_MG, I_MU, I_MD, I_SG, I_SU, I_SD, I_FG };

typedef const __attribute__((address_space(4))) Params* KParams;
__device__ __forceinline__ KParams fresh_params() { KParams kp = (KParams)__builtin_amdgcn_kernarg_segment_ptr(); asm volatile("" : "+s"(kp)); return kp; }
struct Ctx {
    LAS unsigned char* lds;
    int tid, lane, wave, blk, G;
    unsigned char* ws;
};

__device__ __forceinline__ int mod_row(int r) { return r < NLAT ? (r >> 11) : 32; }

__device__ __forceinline__ unsigned pk4_fp8(float a, float b, float c2, float d) {
    int pk = __builtin_amdgcn_cvt_pk_fp8_f32(__builtin_amdgcn_fmed3f(a, -440.f, 440.f), __builtin_amdgcn_fmed3f(b, -440.f, 440.f), 0, false);
    pk = __builtin_amdgcn_cvt_pk_fp8_f32(__builtin_amdgcn_fmed3f(c2, -440.f, 440.f), __builtin_amdgcn_fmed3f(d, -440.f, 440.f), pk, true); return (unsigned)pk; }
template <bool F8 = false>
__device__ __forceinline__ void tr_item(const float* W, int ldw, int k0, int n0, bf16* dst, int ldk, const float* kscale, float sc, LAS float* scr, int lane) {
    float tv[32];
#pragma unroll
    for (int i = 0; i < 32; ++i) tv[i] = W[(size_t)(k0 + 2 * i + (lane >> 5)) * ldw + n0 + (lane & 31)];
#pragma unroll
    for (int i = 0; i < 32; ++i) { const int kk = 2 * i + (lane >> 5); float v = tv[i] * sc; if (kscale) v *= kscale[k0 + kk]; scr[kk * 33 + (lane & 31)] = v; }
    lds_wait();
    const int c = lane & 7;
#pragma unroll
    for (int j = 0; j < 4; ++j) { const int n = (lane >> 3) + 8 * j; const LAS float* s = scr + (8 * c) * 33 + n;
        if (F8) { u32x2 o; o.x = pk4_fp8(s[0 * 33], s[1 * 33], s[2 * 33], s[3 * 33]); o.y = pk4_fp8(s[4 * 33], s[5 * 33], s[6 * 33], s[7 * 33]); *(u32x2*)((unsigned char*)dst + (size_t)n * ldk + k0 + 8 * c) = o; }
        else { u32x4 o; o.x = pk2(s[0 * 33], s[1 * 33]); o.y = pk2(s[2 * 33], s[3 * 33]); o.z = pk2(s[4 * 33], s[5 * 33]); o.w = pk2(s[6 * 33], s[7 * 33]);
            *(u32x4*)(dst + (size_t)n * ldk + k0 + 8 * c) = o; } }
    lds_wait();
}
template <int KIND> __device__ __forceinline__ int tr_dst(int n0) {
    if (KIND == 0) return n0;
    if (KIND == 1) return n0 < 768 ? n0 : (n0 == 768 ? 1952 : n0 - 32);
    if (KIND == 2) { const int half = n0 >> 8, c = n0 & 255; return (c >> 7) * 256 + half * 128 + (c & 127); }
    if (KIND == 3) { const int head = n0 / 96, d0 = n0 % 96; return d0 < 64 ? head * 64 + d0 : 256 + head * 32; }
    if (KIND == 4) { const int head = n0 >> 7, d0 = n0 & 127; return d0 < 64 ? head * 64 + d0 : 256 + head * 64 + (d0 - 64); }
    if (KIND == 5) return (n0 >> 7) * 256 + (n0 & 127);
    if (KIND == 6) return (n0 >> 7) * 256 + 128 + (n0 & 127);
    return n0;
}
template <int KIND, bool F8 = false> __device__ __forceinline__ void tr_matrix(const Ctx& c, const float* W, int ldw, int K, int Nsrc, bf16* WT, int ldk, const float* kscale, float sc) {
    LAS float* scr = (LAS float*)(c.lds + c.wave * 8704);
    const int gw = c.blk * NWAVES + c.wave, NGW = c.G * NWAVES, ng = Nsrc / 32, items = (K / 64) * ng;
    for (int it = gw; it < items; it += NGW) { const int kb = it / ng, g = it % ng; tr_item<F8>(W, ldw, kb * 64, 32 * g, F8 ? (bf16*)((unsigned char*)WT + (size_t)tr_dst<KIND>(32 * g) * ldk) : WT + (size_t)tr_dst<KIND>(32 * g) * ldk, ldk, kscale, sc, scr, c.lane); }
}
__device__ __forceinline__ void zero_fill16(const Ctx& c, void* p, size_t bytes) {
    u32x4* q = (u32x4*)p; const size_t n = bytes / 16;
    for (size_t i = (size_t)c.blk * NTHR + c.tid; i < n; i += (size_t)c.G * NTHR) q[i] = (u32x4){0u, 0u, 0u, 0u};
}
__device__ __forceinline__ void sincos_r(float x, float& s, float& co) {
    const float n = rintf(x * 0.15915494309189535f);
    float r = fmaf(n, -6.28125f, x); r = fmaf(n, -1.9353071795864769e-3f, r);
    s = __sinf(r); co = __cosf(r);
}

__device__ __forceinline__ void prologue_moe_weights(const Ctx& c, KParams p, int l) {
    unsigned char* WGU8 = c.ws + WS_WMOE + (size_t)l * 48 * MiB;
    unsigned char* WD8 = WGU8 + (size_t)NE * 512 * 1024;
    LAS float* scr = (LAS float*)(c.lds + c.wave * 8704);
    const int gw = c.blk * NWAVES + c.wave, NGW = c.G * NWAVES;
    for (int it = gw; it < NE * 384; it += NGW) {
        const int e = it / 384, r = it % 384;
        if (r < 256) { const int up = r >> 7, q = r & 127, kb = q >> 3, g = q & 7;
            const float* W = p->in[up ? I_MU : I_MG] + ((size_t)l * NE + e) * 1024 * 256;
            const int nd = up ? tr_dst<6>(32 * g) : tr_dst<5>(32 * g);
            tr_item<true>(W, 256, kb * 64, 32 * g, (bf16*)(WGU8 + (size_t)e * 512 * 1024 + (size_t)nd * 1024), 1024, nullptr, 64.f, scr, c.lane);
        } else { const int q = r - 256, kb = q >> 5, g = q & 31;
            const float* W = p->in[I_MD] + ((size_t)l * NE + e) * 256 * 1024;
            tr_item<true>(W, 1024, kb * 64, 32 * g, (bf16*)(WD8 + (size_t)e * 1024 * 256 + (size_t)(32 * g) * 256), 256, nullptr, 64.f, scr, c.lane);
        }
    }
}

__device__ __forceinline__ void prologue(const Ctx& c, KParams p) {
    float* MOD = (float*)(c.ws + WS_MOD);
    {
        const int u = c.G - 1 - c.blk;
        if (u < 96) {
            LAS float* sc = (LAS float*)(c.lds + 72 * 1024);
            LAS float* part = (LAS float*)c.lds;
            const int l = u / 48, kq = c.tid >> 7, cj = c.tid & 127, col = (u % 48) * 128 + cj;
            const float* W = p->in[I_ADAW] + (size_t)l * 1024 * 6144;
            float acc[33];
#pragma unroll
            for (int b = 0; b < 33; ++b) acc[b] = 0.f;
            for (int j = 0; j < 4; ++j) {
                __syncthreads();
                for (int i = c.tid; i < 4 * 33 * 64; i += NTHR) { const int q = i / (33 * 64), r = i % (33 * 64), b = r >> 6, kk = r & 63, k = 256 * q + 64 * j + kk; const float v = b < 32 ? p->in[I_C][b * 1024 + k] : p->in[I_CCTX][k]; sc[i] = siluf_(v); }
                __syncthreads();
                const float* wp = W + (size_t)(256 * kq + 64 * j) * 6144 + col; const LAS float* sq = sc + kq * 33 * 64;
#pragma unroll 8
                for (int kk = 0; kk < 64; ++kk) { const float w = wp[(size_t)kk * 6144];
#pragma unroll
                    for (int b = 0; b < 33; ++b) acc[b] = fmaf(sq[b * 64 + kk], w, acc[b]); }
            }
#pragma unroll
            for (int b = 0; b < 33; ++b) part[(kq * 33 + b) * 128 + cj] = acc[b];
            __syncthreads();
            for (int i = c.tid; i < 33 * 128; i += NTHR) { const int b = i >> 7, cc = i & 127, gc = (u % 48) * 128 + cc;
                MOD[((size_t)l * 33 + b) * 6144 + gc] = (part[(0 * 33 + b) * 128 + cc] + part[(1 * 33 + b) * 128 + cc]) + (part[(2 * 33 + b) * 128 + cc] + part[(3 * 33 + b) * 128 + cc]) + p->in[I_ADAB][l * 6144 + gc]; }
            __syncthreads();
        }
    }
    {
        float* ROPE = (float*)(c.ws + WS_TAB + TAB_ROPE);
        for (int i = c.blk * NTHR + c.tid; i < 2048 * 16; i += c.G * NTHR) { const int t = i >> 4, ax = (i >> 3) & 1, f = i & 7;
            const float pos = (float)(ax == 0 ? (t >> 6) : (t & 63)); const float inv = __expf(-(float)f * (9.210340371976184f / 8.0f));
            float s, co; sincos_r(pos * inv, s, co); ROPE[i * 2] = co; ROPE[i * 2 + 1] = s; }
        bf16* RWT = (bf16*)(c.ws + WS_TAB + TAB_RWT);
        for (int i = c.blk * NTHR + c.tid; i < 2 * 64 * 1024; i += c.G * NTHR) { const int l = i >> 16, n = (i >> 10) & 63, k = i & 1023; const float wv = p->in[I_RW][((size_t)l * 1024 + k) * 64 + n];
            const bf16 hi = f2bf(wv); RWT[(size_t)(l * 2) * 65536 + n * 1024 + k] = hi; RWT[(size_t)(l * 2 + 1) * 65536 + n * 1024 + k] = f2bf(wv - bf2f(hi)); }
        float* S5T = (float*)(c.ws + WS_TAB + TAB_S5);
        for (int i = c.blk * NTHR + c.tid; i < 2 * 2 * 16 * 64; i += c.G * NTHR) {
            const int pp = i & 63, g = (i >> 6) & 15, ld = i >> 10;
            const float lr = p->in[I_S5LR][i], li = p->in[I_S5LI][i], dt = __expf(p->in[I_S5DT][ld * 16 + g]);
            const float mag = __expf(lr * dt); float s, co; sincos_r(li * dt, s, co);
            const float are = mag * co, aim = mag * s, den = lr * lr + li * li;
            const float fre = ((are - 1.f) * lr + aim * li) / den, fim = (aim * lr - (are - 1.f) * li) / den;
            float* T = S5T + (size_t)i * 66; T[0] = are; T[1] = aim;
            { float* PW = (float*)(c.ws + WS_S5P) + (size_t)i * 34; float pr = 1.f, pi = 0.f;
              for (int e = 0; e <= 16; ++e) { PW[2 * e] = pr; PW[2 * e + 1] = pi; const float nr = pr * are - pi * aim, ni = pr * aim + pi * are; pr = nr; pi = ni; } }
            for (int ch = 0; ch < 16; ++ch) { const float br = p->in[I_S5BR][(size_t)i * 16 + ch], bi = p->in[I_S5BI][(size_t)i * 16 + ch];
                T[2 + ch] = fre * br - fim * bi; T[18 + ch] = fre * bi + fim * br;
                T[34 + ch] = p->in[I_S5CR][((size_t)(ld * 16 + g) * 16 + ch) * 64 + pp]; T[50 + ch] = p->in[I_S5CI][((size_t)(ld * 16 + g) * 16 + ch) * 64 + pp]; }
        }
    }
    for (int l = 0; l < 2; ++l) {
        bf16* WIN = (bf16*)(c.ws + WS_WIN) + (size_t)l * 2048 * 1024;
        tr_matrix<1>(c, p->in[I_WIN] + (size_t)l * 1024 * 1984, 1984, 1024, 1984, WIN, 1024, nullptr, 1.f);
        zero_fill16(c, WIN + (size_t)1984 * 1024, (size_t)64 * 1024 * 2);
        tr_matrix<0>(c, p->in[I_WOUT] + (size_t)l * 1024 * 1024, 1024, 1024, 1024, (bf16*)(c.ws + WS_WOUT) + (size_t)l * 1024 * 1024, 1024, nullptr, 1.f);
        unsigned char* sm = c.ws + WS_WSM + (size_t)l * WSM_L;
        tr_matrix<0>(c, p->in[I_CPW] + (size_t)l * 256 * 256, 256, 256, 256, (bf16*)(sm + WSM_PW), 256, nullptr, 1.f);
        tr_matrix<2>(c, p->in[I_S5GW] + (size_t)l * 256 * 512, 512, 256, 512, (bf16*)(sm + WSM_GLU), 256, nullptr, 1.f);
        tr_matrix<3>(c, p->in[I_WUQ] + (size_t)l * 256 * 384, 384, 256, 384, (bf16*)(sm + WSM_UQ), 256, p->in[I_QNG] + l * 256, 0.14724445f  );
        zero_fill16(c, (bf16*)(sm + WSM_UQ) + (size_t)384 * 256, (size_t)128 * 256 * 2);
        zero_fill16(c, sm + WSM_UK, (size_t)512 * 256 * 2);
    }
    for (int l = 0; l < 2; ++l) {
        bf16* WSGU = (bf16*)(c.ws + WS_WSH) + (size_t)l * (512 * 1024 + 1024 * 256); bf16* WSD = WSGU + 512 * 1024;
        tr_matrix<5, true>(c, p->in[I_SG] + (size_t)l * 1024 * 256, 256, 1024, 256, WSGU, 1024, nullptr, 64.f);
        tr_matrix<6, true>(c, p->in[I_SU] + (size_t)l * 1024 * 256, 256, 1024, 256, WSGU, 1024, nullptr, 64.f);
        tr_matrix<0, true>(c, p->in[I_SD] + (size_t)l * 256 * 1024, 1024, 256, 1024, (bf16*)((unsigned char*)WSGU + 512 * 1024), 256, nullptr, 64.f);
    }
    prologue_moe_weights(c, p, 0);
    prologue_moe_weights(c, p, 1);
}
__device__ __forceinline__ void prologue_s5_weights(const Ctx& c, KParams p) {
    const float* S5T = (const float*)(c.ws + WS_TAB + TAB_S5); const float* S5P = (const float*)(c.ws + WS_S5P);
    LAS float* pw = (LAS float*)c.lds;
    LAS float* bb = pw + 2 * 17 * 64 * 2;
    LAS float* cc = bb + 2 * 64 * 16 * 2;
    LAS float* kt = cc + 2 * 16 * 64 * 2;
    for (int u = c.blk; u < 32; u += c.G) {
        const int l = u >> 4, g = u & 15;
        __syncthreads();
        for (int i = c.tid; i < 2 * 64; i += NTHR) { const int dir = i >> 6, pp = i & 63; const size_t row = (size_t)((l * 2 + dir) * 16 + g) * 64 + pp; const float* T = S5T + row * 66; const float* PW = S5P + row * 34;
            for (int e = 0; e <= 16; ++e) { pw[((dir * 17 + e) * 64 + pp) * 2] = PW[2 * e]; pw[((dir * 17 + e) * 64 + pp) * 2 + 1] = PW[2 * e + 1]; }
            for (int ch = 0; ch < 16; ++ch) { bb[((dir * 64 + pp) * 16 + ch) * 2] = T[2 + ch]; bb[((dir * 64 + pp) * 16 + ch) * 2 + 1] = T[18 + ch]; cc[((dir * 16 + ch) * 64 + pp) * 2] = T[34 + ch]; cc[((dir * 16 + ch) * 64 + pp) * 2 + 1] = T[50 + ch]; } }
        __syncthreads();
        for (int i = c.tid; i < 2 * 16 * 256; i += NTHR) { const int dir = i >> 12, tau = (i >> 8) & 15, c1 = (i >> 4) & 15, c0 = i & 15; float s = 0.f;
            for (int pp = 0; pp < 64; ++pp) { const float cr = cc[((dir * 16 + c1) * 64 + pp) * 2], ci = cc[((dir * 16 + c1) * 64 + pp) * 2 + 1], pr = pw[((dir * 17 + tau) * 64 + pp) * 2], pi = pw[((dir * 17 + tau) * 64 + pp) * 2 + 1];
                const float wr_ = cr * pr - ci * pi, wi_ = cr * pi + ci * pr; s += wr_ * bb[((dir * 64 + pp) * 16 + c0) * 2] - wi_ * bb[((dir * 64 + pp) * 16 + c0) * 2 + 1]; }
            kt[i] = s; }
        __syncthreads();
        bf16* B1 = (bf16*)(c.ws + WS_S5W) + (size_t)(l * 16 + g) * 256 * 256;
        bf16* B2 = (bf16*)(c.ws + WS_S5W) + (size_t)32 * 256 * 256 + (size_t)(l * 16 + g) * 256 * 512;
        const float* dsk = p->in[I_S5D] + l * 256 + g * 16;
        for (int i = c.tid; i < 256 * 256; i += NTHR) { const int n = i >> 8, k = i & 255, dir = n >> 7, ri = (n >> 6) & 1, pp = n & 63, s = k >> 4, ch = k & 15, e = dir ? s : 15 - s;
            const float pr = pw[((dir * 17 + e) * 64 + pp) * 2], pi = pw[((dir * 17 + e) * 64 + pp) * 2 + 1], br = bb[((dir * 64 + pp) * 16 + ch) * 2], bi = bb[((dir * 64 + pp) * 16 + ch) * 2 + 1];
            B1[i] = f2bf(ri ? pr * bi + pi * br : pr * br - pi * bi); }
        for (int i = c.tid; i < 256 * 512; i += NTHR) { const int n = i >> 9, k = i & 511, t = n >> 4, c1 = n & 15; float v;
            if (k < 256) { const int s = k >> 4, c0 = k & 15; v = 0.f; if (s <= t) v += kt[((0 * 16 + (t - s)) * 16 + c1) * 16 + c0]; if (s >= t) v += kt[((1 * 16 + (s - t)) * 16 + c1) * 16 + c0]; if (s == t && c0 == c1) v += dsk[c0]; }
            else { const int q = k - 256, dir = q >> 7, ri = (q >> 6) & 1, pp = q & 63, e = dir ? 16 - t : t + 1;
                const float cr = cc[((dir * 16 + c1) * 64 + pp) * 2], ci = cc[((dir * 16 + c1) * 64 + pp) * 2 + 1], pr = pw[((dir * 17 + e) * 64 + pp) * 2], pi = pw[((dir * 17 + e) * 64 + pp) * 2 + 1];
                v = ri ? -(cr * pi + ci * pr) : (cr * pr - ci * pi); }
            B2[i] = f2bf(v); }
    }
    __syncthreads();
}
__device__ __forceinline__ void prologue2(const Ctx& c, KParams p) {
    prologue_s5_weights(c, p);
    for (int l = 0; l < 2; ++l) { unsigned char* sm = c.ws + WS_WSM + (size_t)l * WSM_L;
        tr_matrix<4>(c, p->in[I_WUKV] + (size_t)l * 128 * 512, 512, 128, 512, (bf16*)(sm + WSM_UK), 256, p->in[I_KVNG] + l * 128, 1.f); }
}

__device__ __forceinline__ void norm_row(const float* xrow, const float* gain, const float* sh, const float* sc, bf16* orow, int lane, f32x4 (&v)[4]) {
    float ss = 0.f;
#pragma unroll
    for (int j = 0; j < 4; ++j) { v[j] = *(const f32x4*)(xrow + 4 * lane + 256 * j); ss += (v[j].x * v[j].x + v[j].y * v[j].y) + (v[j].z * v[j].z + v[j].w * v[j].w); }
    const float rstd = rsqrtf(wave_sum(ss) * (1.f / 1024.f) + EPS);
#pragma unroll
    for (int j = 0; j < 4; ++j) { const int cc = 4 * lane + 256 * j; const f32x4 g = *(const f32x4*)(gain + cc), s1 = *(const f32x4*)(sc + cc), s0 = *(const f32x4*)(sh + cc);
        v[j] = v[j] * rstd * g * (s1 + 1.0f) + s0;
        u32x2 o; o.x = pk2(v[j].x, v[j].y); o.y = pk2(v[j].z, v[j].w); *(u32x2*)(orow + cc) = o; }
}
__device__ __forceinline__ void norm_row_add(const float* xrow, const bf16* drow, float* xout, const float* gain, const float* sh, const float* sc, unsigned char* orow8, int lane, f32x4 (&v)[4]) {
    float ss = 0.f; u32x2 dl[4];
#pragma unroll
    for (int j = 0; j < 4; ++j) { v[j] = *(const f32x4*)(xrow + 4 * lane + 256 * j); dl[j] = *(const u32x2*)(drow + 4 * lane + 256 * j); }
#pragma unroll
    for (int j = 0; j < 4; ++j) { v[j] += (f32x4){__uint_as_float(dl[j].x << 16), __uint_as_float(dl[j].x & 0xffff0000u), __uint_as_float(dl[j].y << 16), __uint_as_float(dl[j].y & 0xffff0000u)};
        *(f32x4*)(xout + 4 * lane + 256 * j) = v[j]; ss += (v[j].x * v[j].x + v[j].y * v[j].y) + (v[j].z * v[j].z + v[j].w * v[j].w); }
    const float rstd = rsqrtf(wave_sum(ss) * (1.f / 1024.f) + EPS);
#pragma unroll
    for (int j = 0; j < 4; ++j) { const int cc = 4 * lane + 256 * j; const f32x4 g = *(const f32x4*)(gain + cc), s1 = *(const f32x4*)(sc + cc), s0 = *(const f32x4*)(sh + cc);
        v[j] = v[j] * rstd * g * (s1 + 1.0f) + s0;
        *(unsigned*)(orow8 + cc) = pk4_fp8(v[j].x * 4.f, v[j].y * 4.f, v[j].z * 4.f, v[j].w * 4.f); }
}
__device__ __forceinline__ void phase_norm1(const Ctx& c, KParams p, int l) {
    const float* MOD = (const float*)(c.ws + WS_MOD) + (size_t)l * 33 * 6144;
    const float* xl = l == 0 ? p->in[I_X] : p->out; const float* xc = l == 0 ? p->in[I_CTX] : (const float*)(c.ws + WS_XC);
    bf16* H = (bf16*)(c.ws + WS_H); const float* gain = p->in[I_N1G] + l * DM;
    const int gw = c.blk * NWAVES + c.wave, NGW = c.G * NWAVES, lane = c.lane;
    for (int r0 = gw; r0 < NTOK; r0 += 2 * NGW) {
        f32x4 v[2][4]; float ss[2];
#pragma unroll
        for (int k = 0; k < 2; ++k) { const int r = r0 + k * NGW < NTOK ? r0 + k * NGW : r0; const float* xr = r < NLAT ? xl + (size_t)r * DM : xc + (size_t)(r - NLAT) * DM;
#pragma unroll
            for (int j = 0; j < 4; ++j) v[k][j] = *(const f32x4*)(xr + 4 * lane + 256 * j); }
#pragma unroll
        for (int k = 0; k < 2; ++k) { ss[k] = 0.f;
#pragma unroll
            for (int j = 0; j < 4; ++j) ss[k] += (v[k][j].x * v[k][j].x + v[k][j].y * v[k][j].y) + (v[k][j].z * v[k][j].z + v[k][j].w * v[k][j].w); }
#pragma unroll
        for (int k = 0; k < 2; ++k) { const int r = r0 + k * NGW; if (r < NTOK) { const float rstd = rsqrtf(wave_sum(ss[k]) * (1.f / 1024.f) + EPS); const float* m = MOD + (size_t)mod_row(r) * 6144; bf16* orow = H + (size_t)r * DM;
#pragma unroll
            for (int j = 0; j < 4; ++j) { const int cc = 4 * lane + 256 * j; const f32x4 g = *(const f32x4*)(gain + cc), s1 = *(const f32x4*)(m + 1024 + cc), s0 = *(const f32x4*)(m + cc);
                const f32x4 y = v[k][j] * rstd * g * (s1 + 1.0f) + s0; u32x2 o; o.x = pk2(y.x, y.y); o.y = pk2(y.z, y.w); *(u32x2*)(orow + cc) = o; } } }
    }
}

#define EPI_ARGS const f32x4 (&acc)[2][2][4][2], const pg8::Unit& u, int wr, int wc, int fr, int fq
#define EPI_ROWS for (int ai = 0; ai < 2; ++ai) _Pragma("unroll") for (int m = 0; m < 4; ++m)
struct EpiBf16 {
    bf16* O; int ldo;
    __device__ __forceinline__ void operator()(EPI_ARGS) const {
        const int r0 = u.pm * 256 + wr * 64 + fr, c0 = u.pn * 256 + wc * 32 + 8 * fq;
#pragma unroll
        EPI_ROWS { bf16* rp = O + (size_t)(r0 + ai * 128 + m * 16) * ldo + c0;
#pragma unroll
            for (int bj = 0; bj < 2; ++bj) { const f32x4 a = acc[ai][bj][m][0], b = acc[ai][bj][m][1]; u32x4 w; w.x = pk2(a.x, a.y); w.y = pk2(a.z, a.w); w.z = pk2(b.x, b.y); w.w = pk2(b.z, b.w); *(u32x4*)(rp + bj * 128) = w; } asm volatile("" ::: "memory"); }
    }
};
struct EpiInProj {
    bf16* O; bf16* UP; bf16* GVT;
    __device__ __forceinline__ void operator()(EPI_ARGS) const {
        const int r0 = u.pm * 256 + wr * 64 + fr, c0 = u.pn * 256 + wc * 32 + 8 * fq;
#pragma unroll
        EPI_ROWS { const int row = r0 + ai * 128 + m * 16; bf16* rp = O + (size_t)row * ZW + c0;
            const int crow = row < NLAT ? (row >> 11) * 144 + 16 + ((row & 2047) >> 4) : ((row - NLAT) >> 8) * 144 + (((row - NLAT) & 255) >> 4);
#pragma unroll
            for (int bj = 0; bj < 2; ++bj) { const f32x4 a = acc[ai][bj][m][0], b = acc[ai][bj][m][1]; u32x4 w; w.x = pk2(a.x, a.y); w.y = pk2(a.z, a.w); w.z = pk2(b.x, b.y); w.w = pk2(b.z, b.w);
                if (u.pn != 1 && u.pn != 5) *(u32x4*)(rp + bj * 128) = w;
                if (u.pn == 5) { const int g = 8 * bj + 2 * wc + (fq >> 1); *(u32x4*)(UP + ((size_t)g * 4608 + crow) * 512 + fr * 16 + 8 * (fq & 1)) = w; }
                if (u.pn == 1) { const int col = 128 * bj + 32 * wc + 8 * fq, bb = row < NLAT ? (row >> 11) : ((row - NLAT) >> 8), kk = row < NLAT ? 256 + (row & 2047) : ((row - NLAT) & 255);
                    bf16* dst = GVT + ((size_t)(bb * 4 + (col >> 6)) * 64 + (col & 63)) * 2304 + (kk & ~15) + 8 * ((fr >> 2) & 1) + 4 * (fr >> 3) + (fr & 3);
#pragma unroll
                    for (int n = 0; n < 2; ++n)
#pragma unroll
                        for (int i = 0; i < 4; ++i) dst[(size_t)(4 * n + i) * 2304] = f2bf(acc[ai][bj][m][n][i]); } }
            asm volatile("" ::: "memory"); }
    }
};
struct EpiS5X {
    bf16* XE;
    __device__ __forceinline__ void operator()(EPI_ARGS) const {
        const int r0 = u.pm * 256 + wr * 64 + fr, c0 = wc * 32 + 8 * fq;
#pragma unroll
        EPI_ROWS { bf16* rp = XE + (size_t)(r0 + ai * 128 + m * 16) * 256 + c0;
#pragma unroll
            for (int bj = 0; bj < 2; ++bj) { const f32x4 a = acc[ai][bj][m][0], b = acc[ai][bj][m][1]; u32x4 w; w.x = pk2(a.x, a.y); w.y = pk2(a.z, a.w); w.z = pk2(b.x, b.y); w.w = pk2(b.z, b.w); *(u32x4*)(rp + bj * 128) = w; }
            asm volatile("" ::: "memory"); }
    }
};
struct EpiS5Y {
    bf16* Y;
    __device__ __forceinline__ void operator()(EPI_ARGS) const {
        const int r0 = u.pm * 256 + wr * 64 + fr;
#pragma unroll
        EPI_ROWS { const int grow = r0 + ai * 128 + m * 16; const int g = grow / 4608, rem = grow - g * 4608, b = rem / 144, ci = rem - b * 144;
            const int tok0 = ci < 16 ? NLAT + b * CTXL + ci * 16 : b * SEQ + (ci - 16) * 16;
#pragma unroll
            for (int bj = 0; bj < 2; ++bj) { const int t = 8 * bj + 2 * wc + (fq >> 1); const f32x4 a = acc[ai][bj][m][0], bq = acc[ai][bj][m][1]; u32x4 w; w.x = pk2(a.x, a.y); w.y = pk2(a.z, a.w); w.z = pk2(bq.x, bq.y); w.w = pk2(bq.z, bq.w);
                *(u32x4*)(Y + (size_t)(tok0 + t) * 256 + g * 16 + 8 * (fq & 1)) = w; }
            asm volatile("" ::: "memory"); }
    }
};
struct EpiOB8 {
    unsigned char* OB; float sc;
    __device__ __forceinline__ void operator()(EPI_ARGS) const {
        const int r0 = u.pm * 256 + wr * 64 + fr;
#pragma unroll
        EPI_ROWS { unsigned char* rp = OB + (size_t)(r0 + ai * 128 + m * 16) * 1024 + u.pn * 256 + (wc * 4 + fq) * 16; u32x4 w;
#pragma unroll
            for (int bj = 0; bj < 2; ++bj)
#pragma unroll
                for (int n = 0; n < 2; ++n) { const f32x4 a = acc[ai][bj][m][n] * sc; int pk = 0;
                    pk = __builtin_amdgcn_cvt_pk_fp8_f32(__builtin_amdgcn_fmed3f(a.x, -440.f, 440.f), __builtin_amdgcn_fmed3f(a.y, -440.f, 440.f), pk, false);
                    pk = __builtin_amdgcn_cvt_pk_fp8_f32(__builtin_amdgcn_fmed3f(a.z, -440.f, 440.f), __builtin_amdgcn_fmed3f(a.w, -440.f, 440.f), pk, true); w[2 * bj + n] = (unsigned)pk; }
            *(u32x4*)rp = w; asm volatile("" ::: "memory"); }
    }
};
struct EpiBf16S {
    bf16* O; int ldo; float sc;
    __device__ __forceinline__ void operator()(EPI_ARGS) const {
        const int r0 = u.pm * 256 + wr * 64 + fr, c0 = u.pn * 256 + wc * 32 + 8 * fq;
#pragma unroll
        EPI_ROWS { bf16* rp = O + (size_t)(r0 + ai * 128 + m * 16) * ldo + c0;
#pragma unroll
            for (int bj = 0; bj < 2; ++bj) { const f32x4 a = acc[ai][bj][m][0] * sc, b = acc[ai][bj][m][1] * sc; u32x4 w; w.x = pk2(a.x, a.y); w.y = pk2(a.z, a.w); w.z = pk2(b.x, b.y); w.w = pk2(b.z, b.w); *(u32x4*)(rp + bj * 128) = w; }
            asm volatile("" ::: "memory"); }
    }
};
struct EpiBiasBf16 {
    bf16* O; int ldo; const float* bias;
    __device__ __forceinline__ void operator()(EPI_ARGS) const {
        const int r0 = u.pm * 256 + wr * 64 + fr, c0 = u.pn * 256 + wc * 32 + 8 * fq;
        f32x4 bv[2][2];
#pragma unroll
        for (int bj = 0; bj < 2; ++bj) { bv[bj][0] = *(const f32x4*)(bias + c0 + bj * 128); bv[bj][1] = *(const f32x4*)(bias + c0 + bj * 128 + 4); }
        __builtin_amdgcn_s_waitcnt(0x0F70);
#pragma unroll
        EPI_ROWS { bf16* rp = O + (size_t)(r0 + ai * 128 + m * 16) * ldo + c0;
#pragma unroll
            for (int bj = 0; bj < 2; ++bj) { const f32x4 a = acc[ai][bj][m][0] + bv[bj][0], b = acc[ai][bj][m][1] + bv[bj][1]; u32x4 w; w.x = pk2(a.x, a.y); w.y = pk2(a.z, a.w); w.z = pk2(b.x, b.y); w.w = pk2(b.z, b.w); *(u32x4*)(rp + bj * 128) = w; } asm volatile("" ::: "memory"); }
    }
};
struct EpiGluSig {
    bf16* O; int ldo; const float* bias;
    __device__ __forceinline__ void operator()(EPI_ARGS) const {
        const int r0 = u.pm * 256 + wr * 64 + fr, c0 = u.pn * 128 + wc * 32 + 8 * fq;
        f32x4 b1[2], b2[2];
#pragma unroll
        for (int n = 0; n < 2; ++n) { b1[n] = *(const f32x4*)(bias + c0 + 4 * n); b2[n] = *(const f32x4*)(bias + 256 + c0 + 4 * n); }
        __builtin_amdgcn_s_waitcnt(0x0F70);
#pragma unroll
        EPI_ROWS { bf16* rp = O + (size_t)(r0 + ai * 128 + m * 16) * ldo + c0; float o[8];
#pragma unroll
            for (int n = 0; n < 2; ++n)
#pragma unroll
                for (int i = 0; i < 4; ++i) o[4 * n + i] = (acc[ai][0][m][n][i] + b1[n][i]) * sigmoidf_(acc[ai][1][m][n][i] + b2[n][i]);
            u32x4 w; w.x = pk2(o[0], o[1]); w.y = pk2(o[2], o[3]); w.z = pk2(o[4], o[5]); w.w = pk2(o[6], o[7]); *(u32x4*)rp = w; asm volatile("" ::: "memory"); }
    }
};
struct EpiSwiglu {
    unsigned char* O; int ldo; float sc;
    __device__ __forceinline__ void operator()(EPI_ARGS) const {
        const int r0 = u.pm * 256 + wr * 64 + fr, c0 = u.pn * 128 + wc * 32 + 8 * fq;
#pragma unroll
        EPI_ROWS { unsigned char* rp = O + (size_t)(r0 + ai * 128 + m * 16) * ldo + c0; float o[8];
#pragma unroll
            for (int n = 0; n < 2; ++n)
#pragma unroll
                for (int i = 0; i < 4; ++i) o[4 * n + i] = siluf_(acc[ai][0][m][n][i] * sc) * (acc[ai][1][m][n][i] * (sc * 16.0f));
            u32x2 w; w.x = pk4_fp8(o[0], o[1], o[2], o[3]); w.y = pk4_fp8(o[4], o[5], o[6], o[7]); *(u32x2*)rp = w; asm volatile("" ::: "memory"); }
    }
};
struct EpiQ {
    bf16* Q; const float* RS;
    __device__ __forceinline__ void operator()(EPI_ARGS) const {
        const int r0 = u.pm * 256 + wr * 64 + fr; float rq[8];
#pragma unroll
        for (int g = 0; g < 8; ++g) rq[g] = RS[(size_t)(r0 + (g >> 2) * 128 + (g & 3) * 16) * 2];
        __builtin_amdgcn_s_waitcnt(0x0F70);
#pragma unroll
        EPI_ROWS { const int row = r0 + ai * 128 + m * 16; const float rs = rq[ai * 4 + m]; bf16* rp = Q + (size_t)row * 384;
            if (u.pn == 0) {
#pragma unroll
                for (int bj = 0; bj < 2; ++bj) { const int head = 2 * bj + (wc >> 1), d = 32 * (wc & 1) + 8 * fq; const f32x4 a = acc[ai][bj][m][0] * rs, b = acc[ai][bj][m][1] * rs;
                    u32x4 w; w.x = pk2(a.x, a.y); w.y = pk2(a.z, a.w); w.z = pk2(b.x, b.y); w.w = pk2(b.z, b.w); *(u32x4*)(rp + head * 96 + d) = w; }
            } else { const f32x4 a = acc[ai][0][m][0] * rs, b = acc[ai][0][m][1] * rs;
                u32x4 w; w.x = pk2(a.x, a.y); w.y = pk2(a.z, a.w); w.z = pk2(b.x, b.y); w.w = pk2(b.z, b.w); *(u32x4*)(rp + wc * 96 + 64 + 8 * fq) = w; }
            asm volatile("" ::: "memory"); }
    }
};
struct EpiKV {
    bf16* Kb; bf16* VT; const float* RS;
    __device__ __forceinline__ void operator()(EPI_ARGS) const {
        const int r0 = u.pm * 256 + wr * 64 + fr;
        const int p16 = 8 * ((fr >> 2) & 1) + 4 * (fr >> 3) + (fr & 3); float rkv[8];
#pragma unroll
        for (int g = 0; g < 8; ++g) rkv[g] = RS[(size_t)(r0 + (g >> 2) * 128 + (g & 3) * 16) * 2 + 1];
        __builtin_amdgcn_s_waitcnt(0x0F70);
#pragma unroll
        EPI_ROWS { const int row = r0 + ai * 128 + m * 16; const float rk = rkv[ai * 4 + m];
            if (u.pn == 0) {
#pragma unroll
                for (int bj = 0; bj < 2; ++bj) { const int head = 2 * bj + (wc >> 1), d = 32 * (wc & 1) + 8 * fq; const f32x4 a = acc[ai][bj][m][0] * rk, b = acc[ai][bj][m][1] * rk;
                    u32x4 w; w.x = pk2(a.x, a.y); w.y = pk2(a.z, a.w); w.z = pk2(b.x, b.y); w.w = pk2(b.z, b.w);
                    *(u32x4*)(Kb + (size_t)row * 384 + head * 96 + d) = w; }
            } else {
                const int bb = row < NLAT ? (row >> 11) : ((row - NLAT) >> 8); const int kk = row < NLAT ? (row & 2047) : 2048 + ((row - NLAT) & 255);
                const int pos = (kk & ~15) + p16;
#pragma unroll
                for (int bj = 0; bj < 2; ++bj) { const int head = 2 * bj + (wc >> 1), d = 32 * (wc & 1) + 8 * fq; bf16* dst = VT + ((size_t)((bb * 4 + head) * 64 + d)) * 2304 + pos;
#pragma unroll
                    for (int n = 0; n < 2; ++n)
#pragma unroll
                        for (int i = 0; i < 4; ++i) dst[(size_t)(4 * n + i) * 2304] = f2bf(acc[ai][bj][m][n][i] * rk); }
            }
            asm volatile("" ::: "memory"); }
    }
};
struct EpiDelta {
    bf16* D; const float* MODg;
    __device__ __forceinline__ void operator()(EPI_ARGS) const {
        const int rt = u.pm * 256; const float* g = MODg + (size_t)(rt < NLAT ? (rt >> 11) : 32) * 6144;
        const int r0 = rt + wr * 64 + fr, c0 = u.pn * 256 + wc * 32 + 8 * fq;
        f32x4 gv[2][2];
#pragma unroll
        for (int bj = 0; bj < 2; ++bj) { gv[bj][0] = *(const f32x4*)(g + c0 + bj * 128); gv[bj][1] = *(const f32x4*)(g + c0 + bj * 128 + 4); }
        __builtin_amdgcn_s_waitcnt(0x0F70);
#pragma unroll
        EPI_ROWS { bf16* rp = D + (size_t)(r0 + ai * 128 + m * 16) * DM + c0;
#pragma unroll
            for (int bj = 0; bj < 2; ++bj) { const f32x4 a = gv[bj][0] * acc[ai][bj][m][0], b = gv[bj][1] * acc[ai][bj][m][1]; u32x4 w; w.x = pk2(a.x, a.y); w.y = pk2(a.z, a.w); w.z = pk2(b.x, b.y); w.w = pk2(b.z, b.w); *(u32x4*)(rp + bj * 128) = w; }
            asm volatile("" ::: "memory"); }
    }
};

__device__ __forceinline__ int seq_row(int b, int dir, int pos) {
    if (pos < CTXL) return NLAT + b * CTXL + (dir ? CTXL - 1 - pos : pos);
    const int t = pos - CTXL; return b * SEQ + (dir ? SEQ - 1 - t : t);
}
__device__ __forceinline__ void phase_gla(const Ctx& c, KParams p, int l) {
    const bf16* Z = (const bf16*)(c.ws + WS_Z); const bf16* GVT = (const bf16*)(c.ws + WS_GVT); bf16* OG = (bf16*)(c.ws + WS_T1);
    const int w = c.wave, tid = c.tid;
    LAS float* wtab = (LAS float*)c.lds;
    LAS float* DD = (LAS float*)(c.lds + 4096);
    LAS unsigned char* RW = c.lds + 8192 + w * 13824;
    LAS float* LA = (LAS float*)RW;
    LAS unsigned char* KTT = RW + 9216;
    for (int u = c.blk; u < 256; u += c.G) {
        const int b = u >> 3, h = (u >> 1) & 3, dir = u & 1;
        __syncthreads();
        { const float* wa = p->in[I_GLAW] + ((size_t)(l * 2 + dir) * 16) * 128 + h * 32; wtab[tid] = wa[(tid >> 5) * 128 + (tid & 31)]; if (tid < 32) wtab[512 + tid] = p->in[I_GLAB][(l * 2 + dir) * 128 + h * 32 + tid]; }
        float Sst[4] = {0.f, 0.f, 0.f, 0.f};
        __syncthreads();
        for (int gi = 0; gi < 5; ++gi) {
            const int pc = gi * 8 + w; const bool active = pc < 36;
            int lane_ = c.lane; asm volatile("" : "+v"(lane_));
            const int r = lane_ & 31, hh = lane_ >> 5;
            const int p16 = 8 * ((r >> 2) & 1) + 4 * ((r & 15) >> 3) + (r & 3);
            const int pos0 = (r & 16) + p16, pos1 = 32 + pos0;
            bf16x8 qd[2][2]; f32x16 oacc[2][2]; int row0 = 0;
            if (active) {
                int kk0;
                if (dir == 0) { if (pc < 4) { row0 = NLAT + b * CTXL + pc * 64; kk0 = pc * 64; } else { row0 = b * SEQ + (pc - 4) * 64; kk0 = 256 + (pc - 4) * 64; } }
                else { if (pc < 4) { row0 = NLAT + b * CTXL + (3 - pc) * 64; kk0 = (3 - pc) * 64; } else { row0 = b * SEQ + (35 - pc) * 64; kk0 = 256 + (35 - pc) * 64; } }
#pragma unroll
                for (int ib = 0; ib < 2; ++ib) { const bf16* zr = Z + (size_t)(row0 + 32 * ib + r) * ZW; float al[16]; { const u32x4 a0 = *(const u32x4*)(zr + ZAF + dir * 16), a1 = *(const u32x4*)(zr + ZAF + dir * 16 + 8); float t8[8]; unpack8(a0, t8);
#pragma unroll
                        for (int j = 0; j < 8; ++j) al[j] = t8[j];
                        unpack8(a1, t8);
#pragma unroll
                        for (int j = 0; j < 8; ++j) al[8 + j] = t8[j]; }
#pragma unroll
                    for (int ks = 0; ks < 2; ++ks) { float za[8]; { const f32x4 b0 = *(const LAS f32x4*)(wtab + 512 + 16 * ks + 8 * hh), b1 = *(const LAS f32x4*)(wtab + 512 + 16 * ks + 8 * hh + 4);
                            za[0] = b0.x; za[1] = b0.y; za[2] = b0.z; za[3] = b0.w; za[4] = b1.x; za[5] = b1.y; za[6] = b1.z; za[7] = b1.w; }
#pragma unroll
                        for (int j = 0; j < 16; ++j) { const f32x4 w0 = *(const LAS f32x4*)(wtab + j * 32 + 16 * ks + 8 * hh), w1 = *(const LAS f32x4*)(wtab + j * 32 + 16 * ks + 8 * hh + 4);
                            za[0] = fmaf(al[j], w0.x, za[0]); za[1] = fmaf(al[j], w0.y, za[1]); za[2] = fmaf(al[j], w0.z, za[2]); za[3] = fmaf(al[j], w0.w, za[3]);
                            za[4] = fmaf(al[j], w1.x, za[4]); za[5] = fmaf(al[j], w1.y, za[5]); za[6] = fmaf(al[j], w1.z, za[6]); za[7] = fmaf(al[j], w1.w, za[7]); }
                        float la[8];
#pragma unroll
                        for (int e = 0; e < 8; ++e) la[e] = (fminf(za[e], 0.f) - __logf(1.f + __expf(-fabsf(za[e])))) * 0.0625f;
                        *(LAS f32x4*)(LA + (32 * ib + r) * 36 + 16 * ks + 8 * hh) = (f32x4){la[0], la[1], la[2], la[3]}; *(LAS f32x4*)(LA + (32 * ib + r) * 36 + 16 * ks + 8 * hh + 4) = (f32x4){la[4], la[5], la[6], la[7]}; } }
                lds_wait();
                u32x4 qraw[2][2], kraw[2][2];
#pragma unroll
                for (int ib = 0; ib < 2; ++ib) { const bf16* zr = Z + (size_t)(row0 + 32 * ib + r) * ZW;
#pragma unroll
                    for (int ks = 0; ks < 2; ++ks) { qraw[ib][ks] = *(const u32x4*)(zr + ZQ + h * 32 + 16 * ks + 8 * hh); kraw[ib][ks] = *(const u32x4*)(zr + ZK + h * 32 + 16 * ks + 8 * hh); } }
                { float bend; float v[32], s = 0.f;
#pragma unroll
                  for (int qq = 0; qq < 32; ++qq) { const int q = 32 * hh + qq, i = dir ? 63 - q : q; v[qq] = LA[i * 36 + r]; s += v[qq]; }
                  const auto sw = __builtin_amdgcn_permlane32_swap(__float_as_uint(s), __float_as_uint(s), false, false);
                  const float h0 = __uint_as_float(sw[0]), h1 = __uint_as_float(sw[1]); bend = h0 + h1;
                  float run = hh ? h0 : 0.f;
#pragma unroll
                  for (int qq = 0; qq < 32; ++qq) { const int q = 32 * hh + qq, i = dir ? 63 - q : q; run += v[qq]; LA[i * 36 + r] = run; }
                  if (hh == 0) DD[w * 32 + r] = __expf(bend); }
                lds_wait();
                bf16x8 vt[2][4];
#pragma unroll
                for (int db = 0; db < 2; ++db)
#pragma unroll
                    for (int s4 = 0; s4 < 4; ++s4) vt[db][s4] = *(const bf16x8*)(GVT + ((size_t)(b * 4 + h) * 64 + 32 * db + r) * 2304 + kk0 + 16 * s4 + 8 * hh);
                bf16x8 ki[2][2];
#pragma unroll
                for (int ib = 0; ib < 2; ++ib) {
#pragma unroll
                    for (int ks = 0; ks < 2; ++ks) { const int dk0 = 16 * ks + 8 * hh; float q8[8], k8[8], b8[8]; unpack8(qraw[ib][ks], q8); unpack8(kraw[ib][ks], k8);
                        { const f32x4 x0 = *(const LAS f32x4*)(LA + (32 * ib + r) * 36 + dk0), x1 = *(const LAS f32x4*)(LA + (32 * ib + r) * 36 + dk0 + 4); b8[0] = x0.x; b8[1] = x0.y; b8[2] = x0.z; b8[3] = x0.w; b8[4] = x1.x; b8[5] = x1.y; b8[6] = x1.z; b8[7] = x1.w; }
                        float qo[8], ko[8];
#pragma unroll
                        for (int e = 0; e < 8; ++e) { const float eb = __expf(b8[e]), ieb = 1.f / eb; qo[e] = q8[e] * 0.17677669529663687f * eb; ko[e] = k8[e] * ieb;
                            *(LAS bf16*)(KTT + ((dk0 + e) * 72 + (ib ? pos1 : pos0)) * 2) = f2bf(ko[e] * DD[w * 32 + dk0 + e]); }
                        u32x4 wq, wk; wq.x = pk2(qo[0], qo[1]); wq.y = pk2(qo[2], qo[3]); wq.z = pk2(qo[4], qo[5]); wq.w = pk2(qo[6], qo[7]); wk.x = pk2(ko[0], ko[1]); wk.y = pk2(ko[2], ko[3]); wk.z = pk2(ko[4], ko[5]); wk.w = pk2(ko[6], ko[7]);
                        qd[ib][ks] = __builtin_bit_cast(bf16x8, wq); ki[ib][ks] = __builtin_bit_cast(bf16x8, wk); } }
                f32x16 zero16;
#pragma unroll
                for (int i = 0; i < 16; ++i) zero16[i] = 0.f;
                f32x16 a00 = __builtin_amdgcn_mfma_f32_32x32x16_bf16(ki[0][0], qd[0][0], zero16, 0, 0, 0); a00 = __builtin_amdgcn_mfma_f32_32x32x16_bf16(ki[0][1], qd[0][1], a00, 0, 0, 0);
                f32x16 a11 = __builtin_amdgcn_mfma_f32_32x32x16_bf16(ki[1][0], qd[1][0], zero16, 0, 0, 0); a11 = __builtin_amdgcn_mfma_f32_32x32x16_bf16(ki[1][1], qd[1][1], a11, 0, 0, 0);
                f32x16 aof;
                if (dir == 0) { aof = __builtin_amdgcn_mfma_f32_32x32x16_bf16(ki[0][0], qd[1][0], zero16, 0, 0, 0); aof = __builtin_amdgcn_mfma_f32_32x32x16_bf16(ki[0][1], qd[1][1], aof, 0, 0, 0); }
                else { aof = __builtin_amdgcn_mfma_f32_32x32x16_bf16(ki[1][0], qd[0][0], zero16, 0, 0, 0); aof = __builtin_amdgcn_mfma_f32_32x32x16_bf16(ki[1][1], qd[0][1], aof, 0, 0, 0); }
#pragma unroll
                for (int i = 0; i < 16; ++i) { const int j = (i & 3) + 8 * (i >> 2) + 4 * hh; const bool keep = dir ? (j >= r) : (j <= r); a00[i] = keep ? a00[i] : 0.f; a11[i] = keep ? a11[i] : 0.f; }
#define GLA_P(X, s) ({ u32x4 w_; w_.x = pk2((X)[8 * (s)], (X)[8 * (s) + 1]); w_.y = pk2((X)[8 * (s) + 2], (X)[8 * (s) + 3]); w_.z = pk2((X)[8 * (s) + 4], (X)[8 * (s) + 5]); w_.w = pk2((X)[8 * (s) + 6], (X)[8 * (s) + 7]); __builtin_bit_cast(bf16x8, w_); })
                const bf16x8 p00a = GLA_P(a00, 0), p00b = GLA_P(a00, 1), p11a = GLA_P(a11, 0), p11b = GLA_P(a11, 1), pofa = GLA_P(aof, 0), pofb = GLA_P(aof, 1);
#pragma unroll
                for (int db = 0; db < 2; ++db) {
                    f32x16 o0 = __builtin_amdgcn_mfma_f32_32x32x16_bf16(vt[db][0], p00a, zero16, 0, 0, 0); o0 = __builtin_amdgcn_mfma_f32_32x32x16_bf16(vt[db][1], p00b, o0, 0, 0, 0);
                    f32x16 o1 = __builtin_amdgcn_mfma_f32_32x32x16_bf16(vt[db][2], p11a, zero16, 0, 0, 0); o1 = __builtin_amdgcn_mfma_f32_32x32x16_bf16(vt[db][3], p11b, o1, 0, 0, 0);
                    if (dir == 0) { o1 = __builtin_amdgcn_mfma_f32_32x32x16_bf16(vt[db][0], pofa, o1, 0, 0, 0); o1 = __builtin_amdgcn_mfma_f32_32x32x16_bf16(vt[db][1], pofb, o1, 0, 0, 0); }
                    else { o0 = __builtin_amdgcn_mfma_f32_32x32x16_bf16(vt[db][2], pofa, o0, 0, 0, 0); o0 = __builtin_amdgcn_mfma_f32_32x32x16_bf16(vt[db][3], pofb, o0, 0, 0, 0); }
                    oacc[db][0] = o0; oacc[db][1] = o1; }
#undef GLA_P
                lds_wait();
                bf16x8 kf[4];
#pragma unroll
                for (int s4 = 0; s4 < 4; ++s4) kf[s4] = *(const LAS bf16x8*)(KTT + (r * 72 + 16 * s4 + 8 * hh) * 2);
#pragma unroll
                for (int db = 0; db < 2; ++db) { f32x16 uu = __builtin_amdgcn_mfma_f32_32x32x16_bf16(vt[db][0], kf[0], zero16, 0, 0, 0);
#pragma unroll
                    for (int s4 = 1; s4 < 4; ++s4) uu = __builtin_amdgcn_mfma_f32_32x32x16_bf16(vt[db][s4], kf[s4], uu, 0, 0, 0);
#pragma unroll
                    for (int i = 0; i < 16; ++i) LA[(32 * db + (i & 3) + 8 * (i >> 2) + 4 * hh) * 32 + r] = uu[i]; }
            }
            __syncthreads();
            const int dv2 = tid >> 3, dk4 = (tid & 7) * 4;
            f32x4 ur[8], dr[8];
#pragma unroll
            for (int cc = 0; cc < 8; ++cc) { ur[cc] = *(const LAS f32x4*)((LAS float*)(c.lds + 8192 + cc * 13824) + dv2 * 32 + dk4); dr[cc] = *(const LAS f32x4*)(DD + cc * 32 + dk4); }
            __syncthreads();
#pragma unroll
            for (int cc = 0; cc < 8; ++cc) if (gi * 8 + cc < 36) { u32x2 sp; sp.x = pk2(Sst[0], Sst[1]); sp.y = pk2(Sst[2], Sst[3]); *(LAS u32x2*)(c.lds + 8192 + cc * 13824 + (dv2 * 40 + dk4) * 2) = sp;
                Sst[0] = fmaf(dr[cc].x, Sst[0], ur[cc].x); Sst[1] = fmaf(dr[cc].y, Sst[1], ur[cc].y); Sst[2] = fmaf(dr[cc].z, Sst[2], ur[cc].z); Sst[3] = fmaf(dr[cc].w, Sst[3], ur[cc].w); }
            __syncthreads();
            if (active) {
#pragma unroll
                for (int db = 0; db < 2; ++db) { const bf16x8 s0 = *(const LAS bf16x8*)(RW + ((32 * db + r) * 40 + 8 * hh) * 2), s1 = *(const LAS bf16x8*)(RW + ((32 * db + r) * 40 + 16 + 8 * hh) * 2);
#pragma unroll
                    for (int ib = 0; ib < 2; ++ib) { oacc[db][ib] = __builtin_amdgcn_mfma_f32_32x32x16_bf16(s0, qd[ib][0], oacc[db][ib], 0, 0, 0); oacc[db][ib] = __builtin_amdgcn_mfma_f32_32x32x16_bf16(s1, qd[ib][1], oacc[db][ib], 0, 0, 0); } }
#pragma unroll
                for (int ib = 0; ib < 2; ++ib) { bf16* orow = OG + ((size_t)dir * NTOK + row0 + 32 * ib + r) * 256 + h * 64 + 4 * hh;
#pragma unroll
                    for (int db = 0; db < 2; ++db)
#pragma unroll
                        for (int g4 = 0; g4 < 4; ++g4) { u32x2 wv; wv.x = pk2(oacc[db][ib][4 * g4], oacc[db][ib][4 * g4 + 1]); wv.y = pk2(oacc[db][ib][4 * g4 + 2], oacc[db][ib][4 * g4 + 3]); *(u32x2*)(orow + 32 * db + 8 * g4) = wv; } }
                lds_wait();
            }
        }
    }
    __syncthreads();
}
__device__ __forceinline__ void phase_gla_final(const Ctx& c, KParams p, int l, int nrows) {
    const bf16* Z = (const bf16*)(c.ws + WS_Z); const bf16* OG = (const bf16*)(c.ws + WS_T1); bf16* MIX = (bf16*)(c.ws + WS_MIX);
    const int gw = c.blk * NWAVES + c.wave, NGW = c.G * NWAVES; const f32x4 g = *(const f32x4*)(p->in[I_GLAG] + l * 256 + 4 * c.lane);
    for (int r0 = gw; r0 < nrows; r0 += 4 * NGW) {
        u32x2 of[4], ob[4], rg[4];
#pragma unroll
        for (int k = 0; k < 4; ++k) { const int r = r0 + k * NGW; of[k] = ob[k] = rg[k] = (u32x2){0u, 0u};
            if (r < nrows) { of[k] = *(const u32x2*)(OG + (size_t)r * 256 + 4 * c.lane); ob[k] = *(const u32x2*)(OG + ((size_t)NTOK + r) * 256 + 4 * c.lane); rg[k] = *(const u32x2*)(Z + (size_t)r * ZW + ZR + 4 * c.lane); } }
#pragma unroll
        for (int k = 0; k < 4; ++k) { const int r = r0 + k * NGW;
            f32x4 o = (f32x4){__uint_as_float(of[k].x << 16) + __uint_as_float(ob[k].x << 16), __uint_as_float(of[k].x & 0xffff0000u) + __uint_as_float(ob[k].x & 0xffff0000u),
                              __uint_as_float(of[k].y << 16) + __uint_as_float(ob[k].y << 16), __uint_as_float(of[k].y & 0xffff0000u) + __uint_as_float(ob[k].y & 0xffff0000u)};
            float ss = (o.x * o.x + o.y * o.y) + (o.z * o.z + o.w * o.w);
            ss += shx<1>(ss); ss += shx<2>(ss); ss += shx<4>(ss); ss += shx<8>(ss);
            const float rstd = rsqrtf(ss * (1.f / 64.f) + EPS);
            const float g0 = __uint_as_float(rg[k].x << 16), g1 = __uint_as_float(rg[k].x & 0xffff0000u), g2 = __uint_as_float(rg[k].y << 16), g3 = __uint_as_float(rg[k].y & 0xffff0000u);
            u32x2 w; w.x = pk2(o.x * rstd * g.x * siluf_(g0), o.y * rstd * g.y * siluf_(g1)); w.y = pk2(o.z * rstd * g.z * siluf_(g2), o.w * rstd * g.w * siluf_(g3));
            if (r < nrows) *(u32x2*)(MIX + (size_t)r * DM + 4 * c.lane) = w; }
    }
}

__device__ __forceinline__ void phase_conv1(const Ctx& c, KParams p, int l, bool with_ctx) {
    const bf16* Z = (const bf16*)(c.ws + WS_Z); bf16* CV = (bf16*)(c.ws + WS_CV);
    constexpr int TT = 64, HR = TT + 30;
    LAS float* glu = (LAS float*)c.lds;
    LAS float* dws = glu + HR * 256;
    for (int i = c.tid; i < 31 * 256; i += NTHR) dws[i] = p->in[I_CDW][(size_t)l * 31 * 256 + i];
    const int ntiles = with_ctx ? 1024 + 128 : 1024;
    const f32x4 dwb = *(const f32x4*)(p->in[I_CDB] + l * 256 + 4 * c.lane), lg = *(const f32x4*)(p->in[I_CLG] + l * 256 + 4 * c.lane), lb = *(const f32x4*)(p->in[I_CLB] + l * 256 + 4 * c.lane);
    for (int tile = c.blk; tile < ntiles; tile += c.G) {
        int rowbase, t0, slen;
        if (tile < 1024) { const int b = tile >> 5; rowbase = b * SEQ; t0 = (tile & 31) * TT; slen = SEQ; } else { const int q = tile - 1024, b = q >> 2; rowbase = NLAT + b * CTXL; t0 = (q & 3) * TT; slen = CTXL; }
        __syncthreads();
        u32x2 ra[12], rg[12];
#pragma unroll
        for (int k = 0; k < 12; ++k) { const int idx = c.tid + k * NTHR, j = idx >> 6, c4 = (idx & 63) * 4, t = t0 - 15 + j; ra[k] = (u32x2){0u, 0u}; rg[k] = (u32x2){0u, 0u};
            if (idx < HR * 64 && t >= 0 && t < slen) { const bf16* zr = Z + (size_t)(rowbase + t) * ZW; ra[k] = *(const u32x2*)(zr + ZCA + c4); rg[k] = *(const u32x2*)(zr + ZCG + c4); } }
#pragma unroll
        for (int k = 0; k < 12; ++k) { const int idx = c.tid + k * NTHR, j = idx >> 6, c4 = (idx & 63) * 4; f32x4 v;
            v.x = __uint_as_float(ra[k].x << 16) * sigmoidf_(__uint_as_float(rg[k].x << 16)); v.y = __uint_as_float(ra[k].x & 0xffff0000u) * sigmoidf_(__uint_as_float(rg[k].x & 0xffff0000u));
            v.z = __uint_as_float(ra[k].y << 16) * sigmoidf_(__uint_as_float(rg[k].y << 16)); v.w = __uint_as_float(ra[k].y & 0xffff0000u) * sigmoidf_(__uint_as_float(rg[k].y & 0xffff0000u));
            if (idx < HR * 64) *(LAS f32x4*)(glu + j * 256 + c4) = v; }
        __syncthreads();
        for (int q = 0; q < 8; ++q) { const int i = c.wave * 8 + q; f32x4 a = dwb;
#pragma unroll
            for (int j = 0; j < 31; ++j) a += *(const LAS f32x4*)(glu + (i + j) * 256 + 4 * c.lane) * *(const LAS f32x4*)(dws + j * 256 + 4 * c.lane);
            const float mu = wave_sum((a.x + a.y) + (a.z + a.w)) * (1.f / 256.f); const f32x4 dlt = a - mu;
            const float var = wave_sum((dlt.x * dlt.x + dlt.y * dlt.y) + (dlt.z * dlt.z + dlt.w * dlt.w)) * (1.f / 256.f); const float rstd = rsqrtf(var + EPS);
            const f32x4 y = dlt * rstd * lg + lb;
            u32x2 w; w.x = pk2(siluf_(y.x), siluf_(y.y)); w.y = pk2(siluf_(y.z), siluf_(y.w));
            *(u32x2*)(CV + (size_t)(rowbase + t0 + i) * 256 + 4 * c.lane) = w; }
    }
    __syncthreads();
}

__device__ __forceinline__ void phase_s5_carry(const Ctx& c, int l) {
    const bf16* XE = (const bf16*)(c.ws + WS_Y5); bf16* UP = (bf16*)(c.ws + WS_UP); const float* S5P = (const float*)(c.ws + WS_S5P);
    for (int i = c.blk * NTHR + c.tid; i < NB * 2 * 16 * 64; i += c.G * NTHR) {
        const int pp = i & 63, g = (i >> 6) & 15, dir = (i >> 10) & 1, b = i >> 11;
        const float* PW = S5P + ((size_t)((l * 2 + dir) * 16 + g) * 64 + pp) * 34 + 32; const float ar = PW[0], ai = PW[1];
        const size_t rbase = (size_t)g * 4608 + (size_t)b * 144; float xr = 0.f, xi = 0.f;
        for (int s0 = 0; s0 < 144; s0 += 8) {
            float er[8], ei[8];
#pragma unroll
            for (int q = 0; q < 8; ++q) { const int s = s0 + q; const int ci = dir == 0 ? s : (s < 16 ? 15 - s : 159 - s); const bf16* xe = XE + (rbase + ci) * 256 + dir * 128 + pp; er[q] = bf2f(xe[0]); ei[q] = bf2f(xe[64]); }
#pragma unroll
            for (int q = 0; q < 8; ++q) { const int s = s0 + q; const int ci = dir == 0 ? s : (s < 16 ? 15 - s : 159 - s); bf16* up = UP + (rbase + ci) * 512 + 256 + dir * 128 + pp; up[0] = f2bf(xr); up[64] = f2bf(xi);
                const float nr = ar * xr - ai * xi + er[q], ni = ar * xi + ai * xr + ei[q]; xr = nr; xi = ni; }
        }
    }
}

__device__ __forceinline__ void phase_mla_prep(const Ctx& c, KParams p) {
    const bf16* Z = (const bf16*)(c.ws + WS_Z); float* RS = (float*)(c.ws + WS_RS); bf16* Kb = (bf16*)(c.ws + WS_H) + (size_t)NTOK * 384; const float* ROPE = (const float*)(c.ws + WS_TAB + TAB_ROPE);
    const int gw = c.blk * NWAVES + c.wave, NGW = c.G * NWAVES, lane = c.lane, d = lane & 31;
    for (int r0 = gw; r0 < NTOK; r0 += 4 * NGW) {
        u32x2 q4[4]; unsigned k2[4]; bf16 xr[4]; f32x2 cs[4];
#pragma unroll
        for (int k = 0; k < 4; ++k) { const int r = r0 + k * NGW; q4[k] = (u32x2){0u, 0u}; k2[k] = 0u; xr[k] = 0; cs[k] = (f32x2){1.f, 0.f};
            if (r < NTOK) { const bf16* zr = Z + (size_t)r * ZW; q4[k] = *(const u32x2*)(zr + ZCQ + 4 * lane); k2[k] = *(const unsigned*)(zr + ZCKV + 2 * lane); xr[k] = zr[ZKR + d];
                if (r < NLAT) cs[k] = *(const f32x2*)(ROPE + (((r & 2047) * 2 + (d >> 4)) * 8 + (d & 7)) * 2); } }
#pragma unroll
        for (int k = 0; k < 4; ++k) { const int r = r0 + k * NGW;
            const float a0 = __uint_as_float(q4[k].x << 16), a1 = __uint_as_float(q4[k].x & 0xffff0000u), a2 = __uint_as_float(q4[k].y << 16), a3 = __uint_as_float(q4[k].y & 0xffff0000u);
            const float b0 = __uint_as_float(k2[k] << 16), b1 = __uint_as_float(k2[k] & 0xffff0000u);
            const float sq = wave_sum((a0 * a0 + a1 * a1) + (a2 * a2 + a3 * a3)), sk = wave_sum(b0 * b0 + b1 * b1);
            const float x = bf2f(xr[k]); const float px = shx<8>(x);
            const float o = (d & 8) ? fmaf(x, cs[k].x, px * cs[k].y) : fmaf(x, cs[k].x, -px * cs[k].y);
            if (r < NTOK) { if (lane == 0) { RS[(size_t)r * 2] = rsqrtf(sq * (1.f / 256.f) + EPS); RS[(size_t)r * 2 + 1] = rsqrtf(sk * (1.f / 128.f) + EPS); }
                const bf16 ob = f2bf(o); bf16* kr = Kb + (size_t)r * 384 + 64 + d; if (lane < 32) { kr[0] = ob; kr[96] = ob; kr[192] = ob; kr[288] = ob; } } }
    }
}
__device__ __forceinline__ void phase_attn(const Ctx& c, bool with_ctx) {
    const bf16* Qb = (const bf16*)(c.ws + WS_H); const bf16* Kb = Qb + (size_t)NTOK * 384; const bf16* VT = Kb + (size_t)NTOK * 384; bf16* MIX = (bf16*)(c.ws + WS_MIX);
    constexpr int KROW = 208, VROW = 144, KBUF = 64 * KROW, VBUF = 64 * VROW;
    LAS unsigned char* Kt = c.lds; LAS unsigned char* Vt = c.lds + 2 * KBUF;
    const int lane = c.lane, ln = lane & 31, hh = lane >> 5, tid = c.tid;
    const int nunits = with_ctx ? 1152 : 1024;
    for (int L = c.blk; L < nunits; L += c.G) {
        int u = L;
        if (c.G == 256 && L < 1024) { const int r = L >> 8, x = L & 7, j = (L & 255) >> 3; u = ((r * 32 + x * 4 + (j >> 3)) << 3) | (j & 7); }
        int b, h, qrow0, kt0, nkt;
        if (u < 1024) { b = u >> 5; h = (u >> 3) & 3; qrow0 = b * SEQ + (u & 7) * 256; kt0 = 0; nkt = 36; } else { const int q = u - 1024; b = q >> 2; h = q & 3; qrow0 = NLAT + b * CTXL; kt0 = 32; nkt = 4; }
        const bf16* vtb = VT + (size_t)((b * 4 + h) * 64) * 2304;
        bf16x8 qf[6];
        { const bf16* qr = Qb + (size_t)(qrow0 + 32 * c.wave + ln) * 384 + h * 96 + 8 * hh;
#pragma unroll
          for (int ks = 0; ks < 6; ++ks) qf[ks] = *(const bf16x8*)(qr + 16 * ks); }
        if (u < 1024) {
            const float* ROPE = (const float*)(c.ws + WS_TAB + TAB_ROPE) + (size_t)((qrow0 + 32 * c.wave + ln) & 2047) * 32;
#pragma unroll
            for (int ax = 0; ax < 2; ++ax) { const u32x4 own = __builtin_bit_cast(u32x4, qf[4 + ax]); u32x4 oth, res;
#pragma unroll
                for (int i = 0; i < 4; ++i) { const auto sw = __builtin_amdgcn_permlane32_swap(own[i], own[i], false, false); oth[i] = hh ? sw[0] : sw[1]; }
#pragma unroll
                for (int i = 0; i < 4; ++i) { const f32x4 cs = *(const f32x4*)(ROPE + ax * 16 + 4 * i);
                    const float v0 = __uint_as_float(own[i] << 16), v1 = __uint_as_float(own[i] & 0xffff0000u), p0 = __uint_as_float(oth[i] << 16), p1 = __uint_as_float(oth[i] & 0xffff0000u);
                    const float sg = hh ? 1.f : -1.f; res[i] = pk2(fmaf(v0, cs.x, sg * p0 * cs.y), fmaf(v1, cs.z, sg * p1 * cs.w)); }
                qf[4 + ax] = __builtin_bit_cast(bf16x8, res); } }
        f32x16 oacc[2];
#pragma unroll
        for (int i = 0; i < 16; ++i) { oacc[0][i] = 0.f; oacc[1][i] = 0.f; }
        float mrun = 0.f, lsum = 0.f;
        const int k0key = tid / 12, k0pt = tid % 12, k1key = (512 + tid) / 12, k1pt = (512 + tid) % 12; const bool k1on = tid < 256;
        u32x4 sk0, sk1 = (u32x4){0u, 0u, 0u, 0u}, sv;
        auto key_row = [&](int kt, int j) -> int { const int kk = kt * 64 + j; return kk < 2048 ? b * SEQ + kk : NLAT + b * CTXL + (kk - 2048); };
#define ATT_LOAD(kt) do { sk0 = *(const u32x4*)(Kb + (size_t)key_row((kt), k0key) * 384 + h * 96 + k0pt * 8); if (k1on) sk1 = *(const u32x4*)(Kb + (size_t)key_row((kt), k1key) * 384 + h * 96 + k1pt * 8); \
        sv = *(const u32x4*)(vtb + (size_t)(tid >> 3) * 2304 + (kt) * 64 + (tid & 7) * 8); } while (0)
#define ATT_STORE(buf) do { *(LAS u32x4*)(Kt + (buf) * KBUF + k0key * KROW + k0pt * 16) = sk0; if (k1on) *(LAS u32x4*)(Kt + (buf) * KBUF + k1key * KROW + k1pt * 16) = sk1; \
        *(LAS u32x4*)(Vt + (buf) * VBUF + (tid >> 3) * VROW + (tid & 7) * 16) = sv; } while (0)
        __syncthreads();
        ATT_LOAD(kt0); ATT_STORE(0);
        __syncthreads();
        for (int it = 0; it < nkt; ++it) {
            const int cur = it & 1;
            if (it + 1 < nkt) ATT_LOAD(kt0 + it + 1);
            f32x16 sacc[2];
            const float nm = -mrun;
#pragma unroll
            for (int kb = 0; kb < 2; ++kb) {
#pragma unroll
                for (int i = 0; i < 16; ++i) sacc[kb][i] = nm;
#pragma unroll
                for (int ks = 0; ks < 6; ++ks) { const bf16x8 a = *(const LAS bf16x8*)(Kt + cur * KBUF + (32 * kb + ln) * KROW + ks * 32 + hh * 16);
                    sacc[kb] = __builtin_amdgcn_mfma_f32_32x32x16_bf16(a, qf[ks], sacc[kb], 0, 0, 0); } }
            float mx = fmaxf(fmaxf(sacc[0][0], sacc[0][1]), sacc[0][2]);
#pragma unroll
            for (int i = 3; i < 15; i += 2) mx = fmaxf(fmaxf(mx, sacc[0][i]), sacc[0][i + 1]);
            mx = fmaxf(mx, sacc[0][15]);
#pragma unroll
            for (int i = 0; i < 16; i += 2) mx = fmaxf(fmaxf(mx, sacc[1][i]), sacc[1][i + 1]);
            { const auto r = __builtin_amdgcn_permlane32_swap(__float_as_uint(mx), __float_as_uint(mx), false, false); mx = fmaxf(__uint_as_float(r[0]), __uint_as_float(r[1])); }
            if (it == 0 || __builtin_amdgcn_ballot_w64(mx > 8.0f) != 0ull) {
                const float up = it == 0 ? mx : fmaxf(mx, 0.f), alpha = __builtin_amdgcn_exp2f(-up); mrun += up; lsum *= alpha;
#pragma unroll
                for (int i = 0; i < 16; ++i) { oacc[0][i] *= alpha; oacc[1][i] *= alpha; sacc[0][i] -= up; sacc[1][i] -= up; }
            }
            float ps = 0.f;
#pragma unroll
            for (int kb = 0; kb < 2; ++kb)
#pragma unroll
                for (int i = 0; i < 16; ++i) { const float pv = __builtin_amdgcn_exp2f(sacc[kb][i]); sacc[kb][i] = pv; ps += pv; }
            lsum += ps;
            bf16x8 pb[4];
#pragma unroll
            for (int s4 = 0; s4 < 4; ++s4) { const int kb = s4 >> 1, o8 = 8 * (s4 & 1); u32x4 w;
                w.x = pk2(sacc[kb][o8 + 0], sacc[kb][o8 + 1]); w.y = pk2(sacc[kb][o8 + 2], sacc[kb][o8 + 3]); w.z = pk2(sacc[kb][o8 + 4], sacc[kb][o8 + 5]); w.w = pk2(sacc[kb][o8 + 6], sacc[kb][o8 + 7]);
                pb[s4] = __builtin_bit_cast(bf16x8, w); }
#pragma unroll
            for (int db = 0; db < 2; ++db)
#pragma unroll
                for (int s4 = 0; s4 < 4; ++s4) { const bf16x8 a = *(const LAS bf16x8*)(Vt + cur * VBUF + (32 * db + ln) * VROW + s4 * 32 + hh * 16);
                    oacc[db] = __builtin_amdgcn_mfma_f32_32x32x16_bf16(a, pb[s4], oacc[db], 0, 0, 0); }
            if (it + 1 < nkt) ATT_STORE(cur ^ 1);
            __syncthreads();
        }
#undef ATT_LOAD
#undef ATT_STORE
        { const auto r = __builtin_amdgcn_permlane32_swap(__float_as_uint(lsum), __float_as_uint(lsum), false, false); lsum = __uint_as_float(r[0]) + __uint_as_float(r[1]); }
        const float inv = 1.f / lsum;
        bf16* dst = MIX + (size_t)(qrow0 + 32 * c.wave + ln) * DM + 768 + h * 64 + 4 * hh;
#pragma unroll
        for (int db = 0; db < 2; ++db)
#pragma unroll
            for (int g4 = 0; g4 < 4; ++g4) { u32x2 w; w.x = pk2(oacc[db][4 * g4] * inv, oacc[db][4 * g4 + 1] * inv); w.y = pk2(oacc[db][4 * g4 + 2] * inv, oacc[db][4 * g4 + 3] * inv);
                *(u32x2*)(dst + 32 * db + 8 * g4) = w; }
    }
    __syncthreads();
}

__device__ __forceinline__ void phase_norm2_route(const Ctx& c, KParams p, int l, int ntok) {
    const float* MOD = (const float*)(c.ws + WS_MOD) + (size_t)l * 33 * 6144;
    const float* xl = l == 0 ? p->in[I_X] : p->out; const float* xc = l == 0 ? p->in[I_CTX] : (const float*)(c.ws + WS_XC);
    bf16* H = (bf16*)(c.ws + WS_H);
    int* TKEP = (int*)(c.ws + WS_RT + RT_TKEP); float* TKW = (float*)(c.ws + WS_RT + RT_TKW); int* TB = (int*)(c.ws + WS_TB);
    int* CNT = (int*)(c.ws + WS_CTL) + CW_CNT + l * NCH * NE;
    constexpr int HROW = 1032;
    LAS bf16* hhi = (LAS bf16*)c.lds;
    LAS bf16* hlo = hhi + 32 * HROW;
    LAS float* lgs = (LAS float*)(c.lds + 132096);
    LAS int* hist = (LAS int*)(c.lds + 140288);
    const bf16* Whi = (const bf16*)(c.ws + WS_TAB + TAB_RWT) + (size_t)(l * 2) * 65536; const bf16* Wlo = Whi + 65536;
    const float rbias = p->in[I_RB][l * 64 + c.lane];
    const int ntiles = ntok / 32, rpc = ntok / NCH, lane = c.lane, mb = c.wave >> 2, nb = c.wave & 3;
    for (int tile = c.blk; tile < ntiles; tile += c.G) {
        __syncthreads();
        if (c.tid < 64) hist[c.tid] = 0;
        for (int q = 0; q < 4; ++q) { const int r = tile * 32 + c.wave * 4 + q; const float* xr = r < NLAT ? xl + (size_t)r * DM : xc + (size_t)(r - NLAT) * DM; const float* m = MOD + (size_t)mod_row(r) * 6144;
            float* xo = r < NLAT ? p->out + (size_t)r * DM : (float*)(c.ws + WS_XC) + (size_t)(r - NLAT) * DM;
            f32x4 v[4]; norm_row_add(xr, (const bf16*)(c.ws + WS_Z) + (size_t)r * DM, xo, p->in[I_N2G] + l * DM, m + 3072, m + 4096, c.ws + WS_H8 + (size_t)r * DM, lane, v);
#pragma unroll
            for (int j = 0; j < 4; ++j) { u32x2 hi; hi.x = pk2(v[j].x, v[j].y); hi.y = pk2(v[j].z, v[j].w);
                const float r0 = v[j].x - __uint_as_float(hi.x << 16), r1 = v[j].y - __uint_as_float(hi.x & 0xffff0000u), r2 = v[j].z - __uint_as_float(hi.y << 16), r3 = v[j].w - __uint_as_float(hi.y & 0xffff0000u);
                u32x2 lo; lo.x = pk2(r0, r1); lo.y = pk2(r2, r3);
                *(LAS u32x2*)(hhi + (c.wave * 4 + q) * HROW + 4 * lane + 256 * j) = hi; *(LAS u32x2*)(hlo + (c.wave * 4 + q) * HROW + 4 * lane + 256 * j) = lo; } }
        __syncthreads();
        { f32x4 acc = (f32x4){0.f, 0.f, 0.f, 0.f};
          const LAS bf16* ah = hhi + (mb * 16 + (lane & 15)) * HROW + 8 * (lane >> 4); const LAS bf16* al = hlo + (mb * 16 + (lane & 15)) * HROW + 8 * (lane >> 4);
          const bf16* bh = Whi + (size_t)(nb * 16 + (lane & 15)) * 1024 + 8 * (lane >> 4); const bf16* bl = Wlo + (size_t)(nb * 16 + (lane & 15)) * 1024 + 8 * (lane >> 4);
#pragma unroll 8
          for (int ks = 0; ks < 32; ++ks) { const bf16x8 a_h = *(const LAS bf16x8*)(ah + 32 * ks), a_l = *(const LAS bf16x8*)(al + 32 * ks), b_h = *(const bf16x8*)(bh + 32 * ks), b_l = *(const bf16x8*)(bl + 32 * ks);
              acc = __builtin_amdgcn_mfma_f32_16x16x32_bf16(a_h, b_h, acc, 0, 0, 0); acc = __builtin_amdgcn_mfma_f32_16x16x32_bf16(a_h, b_l, acc, 0, 0, 0); acc = __builtin_amdgcn_mfma_f32_16x16x32_bf16(a_l, b_h, acc, 0, 0, 0); }
#pragma unroll
          for (int i = 0; i < 4; ++i) lgs[(mb * 16 + 4 * (lane >> 4) + i) * 64 + nb * 16 + (lane & 15)] = acc[i]; }
        __syncthreads();
#pragma unroll
        for (int q = 0; q < 4; ++q) {
            const int r = tile * 32 + c.wave * 4 + q;
            const float s = sigmoidf_(lgs[(c.wave * 4 + q) * 64 + lane]), bs = s + rbias;
            float m1 = bs; m1 = fmaxf(m1, shx<1>(m1)); m1 = fmaxf(m1, shx<2>(m1)); m1 = fmaxf(m1, shx<4>(m1));
            const unsigned long long eq = __ballot(bs == m1); const unsigned gm = (unsigned)(eq >> (lane & 56)) & 0xffu; const int first = __ffs(gm) - 1;
            float m2 = ((lane & 7) == first) ? -1e30f : bs; m2 = fmaxf(m2, shx<1>(m2)); m2 = fmaxf(m2, shx<2>(m2)); m2 = fmaxf(m2, shx<4>(m2));
            const float gs = m1 + m2; const int g = lane >> 3; int rank = 0;
#pragma unroll
            for (int j = 0; j < 8; ++j) { const float o = rdl(gs, 8 * j); rank += (o > gs || (o == gs && j < g)) ? 1 : 0; }
            float cand = rank < 4 ? bs : -1e30f; int my_e = 0; float my_w = 0.f, wsum = 0.f;
#pragma unroll
            for (int k = 0; k < 8; ++k) { const float mm = wave_max(cand); const unsigned long long e2 = __ballot(cand == mm); const int idx = __ffsll((long long)e2) - 1; const float wk = rdl(s, idx);
                if (lane == idx) cand = -1e30f; if (lane == k) { my_e = idx; my_w = wk; } wsum += wk; }
            if (lane < 8) { const int lp = atomicAdd((int*)&hist[my_e], 1); TKEP[(size_t)r * 8 + lane] = my_e | (lp << 8); TKW[(size_t)r * 8 + lane] = my_w / wsum * 2.5f; }
        }
        __syncthreads();
        if (c.tid < 64) { const int n = hist[c.tid]; int base = 0; if (n > 0) base = atomicAdd(&CNT[((tile * 32) / rpc) * NE + c.tid], n); TB[tile * 64 + c.tid] = base; }
    }
    __syncthreads();
}
__device__ __forceinline__ void phase_route_fill(const Ctx& c, int l, int ntok) {
    const int* TKEP = (const int*)(c.ws + WS_RT + RT_TKEP); int* SLOT = (int*)(c.ws + WS_RT + RT_SLOT); const int* TB = (const int*)(c.ws + WS_TB);
    const int* CNT = (const int*)(c.ws + WS_CTL) + CW_CNT + l * NCH * NE; int* ROWL = (int*)(c.ws + WS_ROWL);
    LAS int* est = (LAS int*)c.lds;
    const int rpc = ntok / NCH;
    __syncthreads();
    if (c.tid < NCH) { int s = 0; for (int e = 0; e < NE; ++e) { est[c.tid * 65 + e] = s; s += (CNT[c.tid * NE + e] + 255) & ~255; } est[c.tid * 65 + 64] = s; }
    __syncthreads();
    const size_t na = (size_t)ntok * 8;
    for (size_t a = (size_t)c.blk * NTHR + c.tid; a < na; a += (size_t)c.G * NTHR) { const int t = (int)(a >> 3), ch = t / rpc; const int ep = TKEP[a], e = ep & 255, lp = ep >> 8;
        const int slot = est[ch * 65 + e] + TB[(t >> 5) * 64 + e] + lp; SLOT[a] = slot; ROWL[(size_t)ch * RPCMAX + slot] = t; }
    for (int i = c.blk * NTHR + c.tid; i < NCH * NE * 256; i += c.G * NTHR) { const int ch = i >> 14, e = (i >> 8) & 63, j = i & 255; const int n = CNT[ch * NE + e]; const int pad = ((n + 255) & ~255) - n;
        if (j < pad) ROWL[(size_t)ch * RPCMAX + est[ch * 65 + e] + n + j] = ch * rpc; }
    __syncthreads();
}

__device__ __forceinline__ void moe_tile_table(const Ctx& c, int l, int ch, LAS int* tst) {
    const int* CNT = (const int*)(c.ws + WS_CTL) + CW_CNT + l * NCH * NE + ch * NE;
    LAS unsigned char* texp = (LAS unsigned char*)(tst + 80);
    __syncthreads();
    if (c.tid == 0) { int s = 0; for (int e = 0; e < NE; ++e) { tst[e] = s; s += (CNT[e] + 255) >> 8; } tst[64] = s; }
    __syncthreads();
    if (c.tid < NE) { for (int t = tst[c.tid]; t < tst[c.tid + 1]; ++t) texp[t] = (unsigned char)c.tid; }
    __syncthreads();
}
__device__ __forceinline__ void phase_combine(const Ctx& c, KParams p, int l, int ch, int rpc) {
    const float* MOD = (const float*)(c.ws + WS_MOD) + (size_t)l * 33 * 6144 + 5120; const float* MODn = (const float*)(c.ws + WS_MOD) + (size_t)33 * 6144;
    const int* SLOT = (const int*)(c.ws + WS_RT + RT_SLOT); const float* TKW = (const float*)(c.ws + WS_RT + RT_TKW);
    const unsigned char* OB = (const unsigned char*)(c.ws + WS_OB); const bf16* OBS = (const bf16*)(c.ws + WS_OBS);
    float* xl = p->out; float* xc = (float*)(c.ws + WS_XC); bf16* H = (bf16*)(c.ws + WS_H);
    const int gw = c.blk * NWAVES + c.wave, NGW = c.G * NWAVES, lane = c.lane;
    const int col0 = (lane >> 4) * 256 + ((lane >> 2) & 3) * 32 + (lane & 3) * 8;
    f32x4 gn[4];
#pragma unroll
    for (int q = 0; q < 4; ++q) gn[q] = *(const f32x4*)((l == 0 ? p->in[I_N1G] + DM : p->in[I_FG]) + col0 + 128 * (q >> 1) + 4 * (q & 1));
    int sl_n = 0; float w_n = 0.f;
    if (gw < rpc && lane < 8) { sl_n = SLOT[(size_t)(ch * rpc + gw) * 8 + lane]; w_n = TKW[(size_t)(ch * rpc + gw) * 8 + lane] * 0.0625f; }
    for (int i = gw; i < rpc; i += NGW) {
        const int t = ch * rpc + i; float* xr = t < NLAT ? xl + (size_t)t * DM : xc + (size_t)(t - NLAT) * DM; const int mr = mod_row(t); const float* g2 = MOD + (size_t)mr * 6144;
        const int sl = sl_n; const float w = w_n;
        u32x4 ob[8], os0, os1; f32x4 xv[4];
#pragma unroll
        for (int e = 0; e < 8; ++e) ob[e] = *(const u32x4*)(OB + (size_t)rdli(sl, e) * 1024 + lane * 16);
        os0 = *(const u32x4*)(OBS + (size_t)i * DM + col0); os1 = *(const u32x4*)(OBS + (size_t)i * DM + col0 + 128);
#pragma unroll
        for (int q = 0; q < 4; ++q) xv[q] = *(const f32x4*)(xr + col0 + 128 * (q >> 1) + 4 * (q & 1));
        if (i + NGW < rpc && lane < 8) { sl_n = SLOT[(size_t)(t + NGW) * 8 + lane]; w_n = TKW[(size_t)(t + NGW) * 8 + lane] * 0.0625f; }
        float a[16]; { float t8[8]; unpack8(os0, t8);
#pragma unroll
            for (int q = 0; q < 8; ++q) a[q] = t8[q];
            unpack8(os1, t8);
#pragma unroll
            for (int q = 0; q < 8; ++q) a[8 + q] = t8[q]; }
#pragma unroll
        for (int e = 0; e < 8; ++e) { const float wk = rdl(w, e);
#pragma unroll
            for (int q = 0; q < 4; ++q) { const f32x2 lo = __builtin_amdgcn_cvt_pk_f32_fp8((int)ob[e][q], false), hi = __builtin_amdgcn_cvt_pk_f32_fp8((int)ob[e][q], true);
                a[4 * q] = fmaf(wk, lo.x, a[4 * q]); a[4 * q + 1] = fmaf(wk, lo.y, a[4 * q + 1]); a[4 * q + 2] = fmaf(wk, hi.x, a[4 * q + 2]); a[4 * q + 3] = fmaf(wk, hi.y, a[4 * q + 3]); } }
        f32x4 xn[4]; float ss = 0.f;
#pragma unroll
        for (int q = 0; q < 4; ++q) { const int cc = col0 + 128 * (q >> 1) + 4 * (q & 1); const f32x4 gv = *(const f32x4*)(g2 + cc);
            xn[q] = xv[q] + gv * (f32x4){a[4 * q], a[4 * q + 1], a[4 * q + 2], a[4 * q + 3]}; ss += (xn[q].x * xn[q].x + xn[q].y * xn[q].y) + (xn[q].z * xn[q].z + xn[q].w * xn[q].w); }
        const float rstd = rsqrtf(wave_sum(ss) * (1.f / 1024.f) + EPS);
        if (l == 0) { const float* mn = MODn + (size_t)mr * 6144; bf16* hr = H + (size_t)t * DM;
#pragma unroll
            for (int q = 0; q < 4; ++q) { const int cc = col0 + 128 * (q >> 1) + 4 * (q & 1); *(f32x4*)(xr + cc) = xn[q];
                const f32x4 s0 = *(const f32x4*)(mn + cc), s1 = *(const f32x4*)(mn + 1024 + cc); const f32x4 hv = xn[q] * rstd * gn[q] * (s1 + 1.0f) + s0;
                u32x2 o; o.x = pk2(hv.x, hv.y); o.y = pk2(hv.z, hv.w); *(u32x2*)(hr + cc) = o; } }
        else {
#pragma unroll
            for (int q = 0; q < 4; ++q) { const int cc = col0 + 128 * (q >> 1) + 4 * (q & 1); *(f32x4*)(xr + cc) = xn[q] * rstd * gn[q]; } }
    }
}
constexpr int LDS_BYTES = 147456;
constexpr int LDS_TAB = 131072, LDS_XB = LDS_BYTES - 16;
enum { J_INPROJ = 0, J_S5G1, J_PW, J_Q, J_KV, J_S5G2, J_GLU, J_OUT, J_GU, J_GUS, J_DN, J_DNS };
enum { SK_DENSE = 0, SK_S5, SK_MOE };
enum { EK_INPROJ = 0, EK_S5X, EK_S5Y, EK_BIAS, EK_GLU, EK_Q, EK_KV, EK_RESID, EK_SWIGLU, EK_OB8, EK_BF16 };
struct JSched {
    int sk, G, c; pg8::DenseOrder d; const char* W; size_t wexp, wtile; const LAS unsigned char* texp; int ntile, npn;
    __device__ __forceinline__ bool next(int i, pg8::Unit& u) const {
        if (sk == SK_DENSE) return d.next(i, u);
        const int L = i * G + c;
        if (sk == SK_S5) { if (L >= 288) return false; u.pm = L; u.pn = 0; u.e = L / 18; u.B = W + (size_t)u.e * wexp; return true; }
        if (L >= ntile * npn) return false;
        const int T = npn == 2 ? (L >> 1) : (L >> 2), pn = L & (npn - 1); const int e = __builtin_amdgcn_readfirstlane((int)texp[T]);
        u.pm = T; u.pn = pn; u.e = e; u.B = W + (size_t)e * wexp + (size_t)pn * wtile; return true;
    }
};
struct JRows { const int* list; unsigned ldab;
    __device__ __forceinline__ unsigned off(const pg8::Unit& u, int r) const { const int row = u.pm * 256 + r; return (unsigned)(list ? list[row] : row) * ldab; } };
struct JEpi {
    int ek; void* p0; void* p1; void* p2; const void* q0; const void* q1; const void* q2; int i0;
    __device__ __forceinline__ void operator()(EPI_ARGS) const {
        switch (ek) {
        case EK_INPROJ: EpiInProj{(bf16*)p0, (bf16*)p1, (bf16*)p2}(acc, u, wr, wc, fr, fq); break;
        case EK_S5X:    EpiS5X{(bf16*)p0}(acc, u, wr, wc, fr, fq); break;
        case EK_S5Y:    EpiS5Y{(bf16*)p0}(acc, u, wr, wc, fr, fq); break;
        case EK_BIAS:   EpiBiasBf16{(bf16*)p0, i0, (const float*)q0}(acc, u, wr, wc, fr, fq); break;
        case EK_GLU:    EpiGluSig{(bf16*)p0, i0, (const float*)q0}(acc, u, wr, wc, fr, fq); break;
        case EK_Q:      EpiQ{(bf16*)p0, (const float*)q0}(acc, u, wr, wc, fr, fq); break;
        case EK_KV:     EpiKV{(bf16*)p0, (bf16*)p1, (const float*)q0}(acc, u, wr, wc, fr, fq); break;
        case EK_RESID:  EpiDelta{(bf16*)p0, (const float*)q0}(acc, u, wr, wc, fr, fq); break;
        default:        EpiBf16{(bf16*)p0, i0}(acc, u, wr, wc, fr, fq); break;
        }
    }
};
struct JEpi8 {
    int ek; void* p0; int i0;
    __device__ __forceinline__ void operator()(EPI_ARGS) const {
        if (ek == EK_SWIGLU) EpiSwiglu{(unsigned char*)p0, i0, 1.0f / 256.0f}(acc, u, wr, wc, fr, fq);
        else if (ek == EK_OB8) EpiOB8{(unsigned char*)p0, 16.0f / 1024.0f}(acc, u, wr, wc, fr, fq);
        else EpiBf16S{(bf16*)p0, i0, 1.0f / 1024.0f}(acc, u, wr, wc, fr, fq);
    }
};
__device__ __forceinline__ void gemm_job(KParams p, LAS unsigned char* lds, int job, int l, int ch) {
    unsigned char* ws = p->ws;
    const int G = gridDim.x, blk = blockIdx.x;
    const bool last = (l == 1); const int nrows = last ? NLAT : NTOK, rpc = nrows / NCH;
    unsigned char* sm = ws + WS_WSM + (size_t)l * WSM_L;
    const LAS int* tst = (const LAS int*)(lds + LDS_TAB);
    auto rot8 = [&](int units) { return ((units % G) + 7) & ~7; };
    auto rotc = [&](int rot) { return (blk + G - rot % G) % G; };
    const char* A = nullptr; int K = 256; bool fp8 = false; JSched S; JRows R; JEpi E;
    S.sk = SK_DENSE; S.G = G; S.c = blk; S.W = nullptr; S.wexp = 0; S.wtile = 0; S.texp = (const LAS unsigned char*)(tst + 80); S.ntile = 0; S.npn = 2; S.d.init(1, 1, G, blk, nullptr, 256);
    R.list = nullptr; R.ldab = 512u; E.ek = EK_BF16; E.p0 = E.p1 = E.p2 = nullptr; E.q0 = E.q1 = E.q2 = nullptr; E.i0 = 0;
    switch (job) {
    case J_INPROJ: A = (const char*)(ws + WS_H); K = 1024; R.ldab = 2048u; S.d.init(NTOK / 256, ZW / 256, G, blk, (const bf16*)(ws + WS_WIN) + (size_t)l * 2048 * 1024, 1024);
        E.ek = EK_INPROJ; E.p0 = ws + WS_Z; E.p1 = ws + WS_UP; E.p2 = ws + WS_GVT; break;
    case J_S5G1: A = (const char*)(ws + WS_UP); K = 256; R.ldab = 1024u; S.sk = SK_S5; S.W = (const char*)(ws + WS_S5W) + (size_t)l * 16 * 256 * 256 * 2; S.wexp = (size_t)256 * 256 * 2; E.ek = EK_S5X; E.p0 = ws + WS_Y5; break;
    case J_PW: A = (const char*)(ws + WS_CV); K = 256; R.ldab = 512u; S.d.init(nrows / 256, 1, G, blk, (const bf16*)(sm + WSM_PW), 256); E.ek = EK_BIAS; E.p0 = (bf16*)(ws + WS_MIX) + 256; E.i0 = DM; E.q0 = p->in[I_CPB] + l * 256; break;
    case J_Q: A = (const char*)(ws + WS_Z) + ZCQ * 2; K = 256; R.ldab = (unsigned)ZW * 2u; S.d.init(NTOK / 256, 2, G, rotc(rot8(nrows / 256)), (const bf16*)(sm + WSM_UQ), 256);
        E.ek = EK_Q; E.p0 = ws + WS_H; E.q0 = ws + WS_RS; break;
    case J_KV: A = (const char*)(ws + WS_Z) + ZCKV * 2; K = 256; R.ldab = (unsigned)ZW * 2u; S.d.init(NTOK / 256, 2, G, rotc(rot8(nrows / 256) + rot8(NTOK / 256 * 2)), (const bf16*)(sm + WSM_UK), 256);
        E.ek = EK_KV; E.p0 = (bf16*)(ws + WS_H) + (size_t)NTOK * 384; E.p1 = (bf16*)(ws + WS_H) + (size_t)NTOK * 768; E.q0 = ws + WS_RS; break;
    case J_S5G2: A = (const char*)(ws + WS_UP); K = 512; R.ldab = 1024u; S.sk = SK_S5; S.W = (const char*)(ws + WS_S5W) + (size_t)32 * 256 * 256 * 2 + (size_t)l * 16 * 256 * 512 * 2; S.wexp = (size_t)256 * 512 * 2; E.ek = EK_S5Y; E.p0 = ws + WS_Y5; break;
    case J_GLU: A = (const char*)(ws + WS_Y5); K = 256; R.ldab = 512u; S.d.init(nrows / 256, 2, G, blk, (const bf16*)(sm + WSM_GLU), 256); E.ek = EK_GLU; E.p0 = (bf16*)(ws + WS_MIX) + 512; E.i0 = DM; E.q0 = p->in[I_S5GB] + l * 512; break;
    case J_OUT: A = (const char*)(ws + WS_MIX); K = 1024; R.ldab = 2048u; S.d.init(nrows / 256, 4, G, blk, (const bf16*)(ws + WS_WOUT) + (size_t)l * 1024 * 1024, 1024);
        E.ek = EK_RESID; E.p0 = ws + WS_Z; E.q0 = (const float*)(ws + WS_MOD) + (size_t)l * 33 * 6144 + 2048; break;
    case J_GU: A = (const char*)(ws + WS_H8); K = 512; fp8 = true; R.list = (const int*)(ws + WS_ROWL) + (size_t)ch * RPCMAX; R.ldab = 1024u; S.sk = SK_MOE; S.ntile = __builtin_amdgcn_readfirstlane(tst[64]); S.npn = 2; S.W = (const char*)(ws + WS_WMOE) + (size_t)l * 48 * MiB; S.wexp = (size_t)512 * 1024; S.wtile = (size_t)256 * 1024;
        E.ek = EK_SWIGLU; E.p0 = ws + WS_HB; E.i0 = 256; break;
    case J_GUS: A = (const char*)(ws + WS_H8) + (size_t)ch * rpc * 1024; K = 512; fp8 = true; R.ldab = 1024u; S.d.init(rpc / 256, 2, G, rotc(rot8(__builtin_amdgcn_readfirstlane(tst[64]) * 2)), (const bf16*)((const unsigned char*)(ws + WS_WSH) + (size_t)l * (512 * 1024 + 1024 * 256) * 2), 512); E.ek = EK_SWIGLU; E.p0 = ws + WS_HBS; E.i0 = 256; break;
    case J_DN: A = (const char*)(ws + WS_HB); K = 128; fp8 = true; R.ldab = 256u; S.sk = SK_MOE; S.ntile = __builtin_amdgcn_readfirstlane(tst[64]); S.npn = 4; S.W = (const char*)(ws + WS_WMOE) + (size_t)l * 48 * MiB + (size_t)NE * 512 * 1024; S.wexp = (size_t)1024 * 256; S.wtile = (size_t)256 * 256;
        E.ek = EK_OB8; E.p0 = ws + WS_OB; break;
    default: A = (const char*)(ws + WS_HBS); K = 128; fp8 = true; R.ldab = 256u; S.d.init(rpc / 256, 4, G, rotc(rot8(__builtin_amdgcn_readfirstlane(tst[64]) * 4)), (const bf16*)((const unsigned char*)(ws + WS_WSH) + (size_t)l * (512 * 1024 + 1024 * 256) * 2 + 512 * 1024), 128); E.ek = EK_BF16; E.p0 = ws + WS_OBS; E.i0 = DM; break;
    }
    __builtin_amdgcn_s_waitcnt(0x0F70);
    if (fp8) pg8::gemm_phase<true>(lds, A, K, S, R, JEpi8{E.ek, E.p0, E.i0});
    else pg8::gemm_phase<false>(lds, A, K, S, R, E);
}


__global__ void __launch_bounds__(NTHR, 2) fwd_kernel(Params pk) {
    extern __shared__ __attribute__((aligned(16))) unsigned char lds_raw[];
    LAS unsigned char* const lds0 = (LAS unsigned char*)lds_raw;
    if (threadIdx.x < 4) ((LAS unsigned*)(lds0 + LDS_XB))[threadIdx.x] = 0u;
    __syncthreads();
    (void)xcd_barrier_post((unsigned*)(pk.ws + WS_CTL) + CW_BAR, (volatile LAS unsigned*)(lds0 + LDS_XB));
    constexpr int NSTEP = 15 + 6 * NCH;
#ifndef PROBE_DUP
#define PROBE_DUP (-9)
#endif
#pragma unroll 1
    for (int it_ = -2; it_ < 2 * NSTEP + (PROBE_DUP >= 0 ? 2 : 0); ++it_) {
        int gs = it_; if (PROBE_DUP >= 0) { if (it_ > PROBE_DUP) gs -= 1; if (it_ > NSTEP + PROBE_DUP + 1) gs -= 1; }
        KParams p = fresh_params(); Ctx c; { int t_ = threadIdx.x; asm volatile("" : "+v"(t_)); c.lds = lds0; c.tid = t_; c.lane = t_ & 63; c.wave = __builtin_amdgcn_readfirstlane(t_ >> 6); c.blk = blockIdx.x; c.G = gridDim.x; c.ws = p->ws; }
        LAS int* tst = (LAS int*)(c.lds + LDS_TAB);
        int l = 0, s = gs, ch = 0, job = -1; bool seam = true;
        if (gs >= 0) { l = gs >= NSTEP ? 1 : 0; s = gs - l * NSTEP; if (s >= 15) { ch = (s - 15) / 6; s = 15 + (s - 15) % 6; } }
        const bool last = (l == 1); const int nrows = last ? NLAT : NTOK, rpc = nrows / NCH;
        switch (s) {
        case -2: prologue(c, p); break;
        case -1: prologue2(c, p); phase_norm1(c, p, 0); break;
        case 0: seam = false; break;
        case 1: job = J_INPROJ; break;
        case 2: phase_gla(c, p, l); phase_conv1(c, p, l, !last); phase_mla_prep(c, p); seam = false; break;
        case 3: job = J_S5G1; break;
        case 4: phase_gla_final(c, p, l, nrows); seam = false; break;
        case 5: job = J_PW; seam = false; break;
        case 6: job = J_Q; seam = false; break;
        case 7: job = J_KV; seam = false; break;
        case 8: phase_s5_carry(c, l); break;
        case 9: phase_attn(c, !last); seam = false; break;
        case 10: job = J_S5G2; break;
        case 11: job = J_GLU; break;
        case 12: job = J_OUT; break;
        case 13: phase_norm2_route(c, p, l, nrows); break;
        case 14: phase_route_fill(c, l, nrows); break;
        case 15: moe_tile_table(c, l, ch, tst); job = J_GU; seam = false; break;
        case 16: job = J_GUS; break;
        case 17: job = J_DN; seam = false; break;
        case 18: job = J_DNS; break;
        case 19: phase_combine(c, p, l, ch, rpc); break;
        default: seam = false; break;
        }
        if (job >= 0) gemm_job(p, c.lds, job, l, ch);
        if (seam && gs + 1 < 2 * NSTEP) { XcdBarrier b_; b_.bar = (unsigned*)(p->ws + WS_CTL) + CW_BAR; b_.x = xb_xcc_id(); b_.st = (volatile LAS unsigned*)(lds0 + LDS_XB); xcd_barrier(b_); }
    }
}

extern "C" void kernel_launch(void* const* d_in, const int* in_sizes, int n_in, void* d_out, int out_size, void* d_ws, size_t ws_size, hipStream_t stream) {
    static int grid = 0;
    if (grid == 0) {
        if (n_in != 42 || out_size != NLAT * DM || ws_size < WS_END) { fprintf(stderr, "kernel_launch: unexpected shapes (n_in %d out %d ws %zu)\n", n_in, out_size, ws_size); grid = -1; return; }
        int dev = 0, cus = 0;
        if (hipGetDevice(&dev) != hipSuccess || hipDeviceGetAttribute(&cus, hipDeviceAttributeMultiprocessorCount, dev) != hipSuccess) { grid = -1; return; }
        if (hipFuncSetAttribute((const void*)fwd_kernel, hipFuncAttributeMaxDynamicSharedMemorySize, LDS_BYTES) != hipSuccess) { fprintf(stderr, "kernel_launch: hipFuncSetAttribute failed\n"); grid = -1; return; }
        int per_cu = 0;
        if (hipOccupancyMaxActiveBlocksPerMultiprocessor(&per_cu, (const void*)fwd_kernel, NTHR, LDS_BYTES) != hipSuccess || per_cu < 1) fprintf(stderr, "kernel_launch: occupancy query reports %d\n", per_cu);
        (void)hipGetLastError();
        grid = cus;
    }
    if (grid < 0) return;
    (void)hipMemsetAsync((char*)d_ws + WS_CTL, 0, CTL_BYTES, stream);
    Params p{};
    for (int i = 0; i < 42; ++i) p.in[i] = (const float*)d_in[i];
    p.out = (float*)d_out; p.ws = (unsigned char*)d_ws; p.ph_lo = 0; p.ph_hi = 1 << 20;
    hipLaunchKernelGGL(fwd_kernel, dim3(grid), dim3(NTHR), LDS_BYTES, stream, p);
}
```

```cpp
#include <hip/hip_runtime.h>
#include <cstdio>
#include <cstdint>

#define LAS __attribute__((address_space(3)))
typedef unsigned short bf16;
typedef short bf16x8 __attribute__((ext_vector_type(8)));
typedef float f32x4 __attribute__((ext_vector_type(4)));
typedef float f32x2 __attribute__((ext_vector_type(2)));
typedef float f32x16 __attribute__((ext_vector_type(16)));
typedef unsigned u32x4 __attribute__((ext_vector_type(4)));
typedef unsigned u32x2 __attribute__((ext_vector_type(2)));
typedef int i32x4 __attribute__((ext_vector_type(4)));
typedef int i32x8 __attribute__((ext_vector_type(8)));

constexpr int NB = 32, SEQ = 2048, CTXL = 256, DM = 1024;
constexpr int NLAT = NB * SEQ, NCTX = NB * CTXL, NTOK = NLAT + NCTX;
constexpr int ZW = 2048;
constexpr int ZQ = 0, ZK = 128, ZV = 256, ZR = 512, ZCA = 768, ZCG = 1024, ZS5 = 1280, ZCQ = 1536, ZCKV = 1792, ZKR = 1920, ZAF = 1952, ZAB = 1968;
constexpr int NE = 64, TOPK = 8;
constexpr int NCH = 2;
constexpr int RPCMAX = (NTOK / NCH) * 8 + 64 * 256;
constexpr float EPS = 1e-6f;
constexpr int NWAVES = 8, NTHR = 512;

constexpr size_t MiB = (size_t)1 << 20;
constexpr size_t WS_CTL = 0, CTL_BYTES = 1 * MiB;
constexpr size_t WS_MOD = 1 * MiB;
constexpr size_t WS_TAB = 3 * MiB;
constexpr size_t WS_WSM = 5 * MiB;
constexpr size_t WS_WIN = 8 * MiB;
constexpr size_t WS_WOUT = 16 * MiB;
constexpr size_t WS_WSH = 20 * MiB;
constexpr size_t WS_TB = 23 * MiB;
constexpr size_t WS_RT = 24 * MiB;
constexpr size_t WS_ROWL = 32 * MiB;
constexpr size_t WS_RS = 35 * MiB;
constexpr size_t WS_WMOE = 36 * MiB;
constexpr size_t WS_XC = 132 * MiB;
constexpr size_t WS_H = 164 * MiB;
constexpr size_t WS_H8 = WS_H + 72 * MiB;
constexpr size_t WS_Z = 308 * MiB;
constexpr size_t WS_MIX = 596 * MiB;
constexpr size_t WS_T1 = 740 * MiB;
constexpr size_t WS_UP = 812 * MiB;
constexpr size_t WS_CV = 884 * MiB;
constexpr size_t WS_Y5 = 920 * MiB;
constexpr size_t WS_S5W = 956 * MiB;
constexpr size_t WS_S5P = 968 * MiB;
constexpr size_t WS_GVT = 969 * MiB;
constexpr size_t WS_END = 1005 * MiB;
constexpr size_t WS_HB = WS_Z;
constexpr size_t WS_HBS = WS_Z + 152 * MiB;
constexpr size_t WS_OBS = WS_Z + 170 * MiB;
constexpr size_t WS_OB = WS_MIX;
static_assert((size_t)RPCMAX * 512 <= 152 * MiB && WS_OBS + (size_t)(NTOK / NCH) * 2048 <= WS_MIX && WS_OB + (size_t)RPCMAX * 1024 <= WS_S5W, "MoE overlays");
constexpr int CW_BAR = 0;
constexpr int CW_CNT = 4096;
constexpr size_t WSM_L = 1 * MiB;
constexpr size_t WSM_PW = 0, WSM_GLU = 128 * 1024, WSM_UQ = 384 * 1024, WSM_UK = 640 * 1024, WSM_UV = 768 * 1024;
constexpr size_t TAB_ROPE = 0;
constexpr size_t TAB_S5 = 256 * 1024;
constexpr size_t TAB_RWT = 1536 * 1024;
constexpr size_t RT_TKEP = 0, RT_TKW = 2400000, RT_SLOT = 4800000;

__device__ __forceinline__ float bf2f(bf16 v) { return __uint_as_float(((unsigned)v) << 16); }
typedef __bf16 bf16x2_t __attribute__((ext_vector_type(2)));
__device__ __forceinline__ unsigned pk2(float lo, float hi) { const f32x2 v = {lo, hi}; return __builtin_bit_cast(unsigned, __builtin_convertvector(v, bf16x2_t)); }
__device__ __forceinline__ bf16 f2bf(float f) { return __builtin_bit_cast(unsigned short, (__bf16)f); }
template <int O> __device__ __forceinline__ float shx(float v) {
    return __int_as_float(__builtin_amdgcn_ds_swizzle(__float_as_int(v), (O << 10) | 0x1f)); }
__device__ __forceinline__ float rdl(float v, int l) { return __int_as_float(__builtin_amdgcn_readlane(__float_as_int(v), l)); }
__device__ __forceinline__ int rdli(int v, int l) { return __builtin_amdgcn_readlane(v, l); }
__device__ __forceinline__ float wave_sum(float v) {
    v += shx<1>(v); v += shx<2>(v); v += shx<4>(v); v += shx<8>(v); v += shx<16>(v);
    const auto r = __builtin_amdgcn_permlane32_swap(__float_as_uint(v), __float_as_uint(v), false, false);
    return __uint_as_float(r[0]) + __uint_as_float(r[1]);
}
__device__ __forceinline__ float wave_max(float v) {
    v = fmaxf(v, shx<1>(v)); v = fmaxf(v, shx<2>(v)); v = fmaxf(v, shx<4>(v)); v = fmaxf(v, shx<8>(v)); v = fmaxf(v, shx<16>(v));
    const auto r = __builtin_amdgcn_permlane32_swap(__float_as_uint(v), __float_as_uint(v), false, false);
    return fmaxf(__uint_as_float(r[0]), __uint_as_float(r[1]));
}
__device__ __forceinline__ float sigmoidf_(float x) { return 1.0f / (1.0f + __expf(-x)); }
__device__ __forceinline__ float siluf_(float x) { return x / (1.0f + __expf(-x)); }
__device__ __forceinline__ void unpack8(const u32x4 w, float (&v)[8]) {
    v[0] = __uint_as_float(w.x << 16); v[1] = __uint_as_float(w.x & 0xffff0000u);
    v[2] = __uint_as_float(w.y << 16); v[3] = __uint_as_float(w.y & 0xffff0000u);
    v[4] = __uint_as_float(w.z << 16); v[5] = __uint_as_float(w.z & 0xffff0000u);
    v[6] = __uint_as_float(w.w << 16); v[7] = __uint_as_float(w.w & 0xffff0000u);
}
__device__ __forceinline__ void lds_wait() { asm volatile("s_waitcnt lgkmcnt(0)" ::: "memory"); }

#define XB_TMO      128
#define XB_XCNT(j)  (256  + 64 * (j))
#define XB_XSUB(j)  (1280 + 64 * (j))
#define XB_XGEN(j)  (2304 + 64 * (j))
#define XB_TOP      3328
#define XB_TOPGEN   3392
#define XCD_BAR_WORDS 3456
#define XB_SPIN_CAP (1u << 22)
__device__ __forceinline__ unsigned xb_ld(unsigned* p)              { return __hip_atomic_load(p, __ATOMIC_RELAXED, __HIP_MEMORY_SCOPE_AGENT); }
__device__ __forceinline__ unsigned xb_add(unsigned* p, unsigned v) { return __hip_atomic_fetch_add(p, v, __ATOMIC_RELAXED, __HIP_MEMORY_SCOPE_AGENT); }
__device__ __forceinline__ unsigned xb_xcc_id() { return (unsigned)__builtin_amdgcn_s_getreg((3 << 11) | 20) & 0xFu; }
#define XB_SPIN(cond, bar) do { unsigned _sp = 0; while (cond) { __builtin_amdgcn_s_sleep(1); \
    if ((++_sp & 255u) == 0u) { if (xb_ld(&(bar)[XB_TMO])) break; if (_sp > XB_SPIN_CAP) { atomicAdd(&(bar)[XB_TMO], 1u); break; } } } } while (0)
struct XcdBarrier { unsigned* bar; unsigned x; volatile LAS unsigned* st; };
__device__ __forceinline__ XcdBarrier xcd_barrier_post(unsigned* bar, volatile LAS unsigned* st) {
    XcdBarrier b; b.bar = bar; b.x = xb_xcc_id(); b.st = st;
    if (threadIdx.x == 0) (void)xb_add(&bar[XB_XCNT(b.x)], 1u);
    return b;
}
__device__ __forceinline__ void xcd_barrier_complete(unsigned* bar, unsigned x, unsigned& nloc, unsigned& nx) {
    const unsigned G = gridDim.x * gridDim.y * gridDim.z;
    unsigned sum, cnt, mine, sp = 0u;
    for (;;) {
        sum = 0u; cnt = 0u; mine = 0u;
#pragma unroll
        for (unsigned j = 0; j < 16; ++j) { const unsigned c = xb_ld(&bar[XB_XCNT(j)]); sum += c; cnt += (c > 0u) ? 1u : 0u; mine = (j == x) ? c : mine; }
        if (sum == G) break;
        __builtin_amdgcn_s_sleep(1);
        if ((++sp & 255u) == 0u) { if (xb_ld(&bar[XB_TMO])) break; if (sp > XB_SPIN_CAP) { atomicAdd(&bar[XB_TMO], 1u); break; } }
    }
    nloc = mine > 0u ? mine : 1u; nx = cnt > 0u ? cnt : 1u;
}
__device__ __forceinline__ void xcd_barrier(const XcdBarrier& b) {
    asm volatile("s_waitcnt vmcnt(0)" ::: "memory");
    __syncthreads();
    if (threadIdx.x == 0) {
        unsigned* bar = b.bar;
        __builtin_amdgcn_s_waitcnt(0);
        unsigned nloc = b.st[0], nx = b.st[1];
        if (nloc == 0u) { xcd_barrier_complete(bar, b.x, nloc, nx); b.st[0] = nloc; b.st[1] = nx; }
        const unsigned old = xb_add(&bar[XB_XSUB(b.x)], 1u);
        const unsigned gen = old / nloc;
        if (old + 1u == (gen + 1u) * nloc) {
            __builtin_amdgcn_fence(__ATOMIC_RELEASE, "agent");
            asm volatile("s_waitcnt vmcnt(0)" ::: "memory");
            const unsigned og = xb_add(&bar[XB_TOP], 1u);
            const unsigned tg = og / nx;
            if (og + 1u == (tg + 1u) * nx) xb_add(&bar[XB_TOPGEN], 1u);
            else XB_SPIN(xb_ld(&bar[XB_TOPGEN]) == tg, bar);
            __builtin_amdgcn_fence(__ATOMIC_ACQUIRE, "agent");
            xb_add(&bar[XB_XGEN(b.x)], 1u);
            asm volatile("s_waitcnt vmcnt(0)" ::: "memory");
        } else {
            XB_SPIN(xb_ld(&bar[XB_XGEN(b.x)]) == gen, bar);
            __builtin_amdgcn_fence(__ATOMIC_ACQUIRE, "agent");
            asm volatile("s_waitcnt vmcnt(0)" ::: "memory");
        }
    }
    __syncthreads();
}

namespace pg8 {
constexpr int BM = 256, BK = 64, HALF = 128, HTB = HALF * BK * 2, STAGE_BYTES = 8 * HTB, NXCD = 8, WGM = 8;
__device__ __forceinline__ int lds_byte(int r, int c) { const int st = (r >> 4) * 2 + (c >> 5), rr = r & 15, cc = c & 31, ob = rr * 64 + cc * 2; return st * 1024 + (ob ^ (((ob >> 9) & 1) << 5)); }
__device__ __forceinline__ void stage_rc(int b, int& R, int& C) { const int st = b / 1024, sb = b % 1024, swz = sb ^ (((sb >> 9) & 1) << 5); R = (st >> 1) * 16 + swz / 64; C = (st & 1) * 32 + (swz % 64) / 2; }
__device__ __forceinline__ int perm32(int rho) { const int n = rho >> 4, i = rho & 15; return 8 * (i >> 2) + 4 * n + (i & 3); }

struct Unit { int pm, pn, e; const char* B; };

struct DenseOrder {
    int nM, nN, nwg, G, c; const char* Bt; size_t btile;
    __device__ __forceinline__ void init(int nM_, int nN_, int G_, int c_, const bf16* Bt_, int K) { nM = nM_; nN = nN_; nwg = nM * nN; G = G_; c = c_; Bt = (const char*)Bt_; btile = (size_t)256 * K * 2; }
    __device__ __forceinline__ bool next(int i, Unit& u) const {
        const long L = (long)i * G + c; if (L >= nwg) return false;
        int wgid = (int)L; { const int q = nwg / NXCD, r = nwg % NXCD, xcd = wgid % NXCD, off = wgid / NXCD; wgid = (xcd < r ? xcd * (q + 1) : r * (q + 1) + (xcd - r) * q) + off; }
        const int nig = WGM * nN, gid = wgid / nig, fm = gid * WGM, gsz = (nM - fm) < WGM ? (nM - fm) : WGM;
        u.pm = fm + ((wgid % nig) % gsz); u.pn = (wgid % nig) / gsz; u.e = 0; u.B = Bt + (size_t)u.pn * btile; return true;
    }
};
struct RowsDense { unsigned ldab; __device__ __forceinline__ unsigned off(const Unit& u, int r) const { return (unsigned)(u.pm * 256 + r) * ldab; } };
struct RowsGather { const int* list; unsigned ldab; __device__ __forceinline__ unsigned off(const Unit& u, int r) const { return (unsigned)list[u.pm * 256 + r] * ldab; } };

template <bool FP8, class Epi, class Sched, class Rows>
__device__ __forceinline__ void gemm_phase(LAS unsigned char* lds, const char* Abase, const int K, const Sched& S, const Rows& RW, const Epi& E) {
    int tid_ = threadIdx.x; asm volatile("" : "+v"(tid_));
    const int tid = tid_, wid = __builtin_amdgcn_readfirstlane(tid >> 6), lane = tid & 63, wr = wid >> 2, wc = wid & 3, fr = lane & 15, fq = lane >> 4;
    const int nt = K / BK;
    int sR[2]; unsigned sC[2], voffB[2];
#pragma unroll
    for (int i = 0; i < 2; ++i) { int R, C; stage_rc(tid * 16 + i * 8192, R, C); sR[i] = R; sC[i] = (unsigned)C * 2u; const int Rb = (R & ~31) + perm32(R & 31); voffB[i] = (unsigned)(Rb * K + C) * 2u; }
    const size_t kstep = (size_t)(BK * 2);
    const size_t hstepB = (size_t)HALF * K * 2;
    const unsigned ldsw = (unsigned)wid * 1024u;
    const int aoff = lds_byte(wr * 64 + fr, fq * 8), boff = lds_byte(wc * 32 + fr, fq * 8);
#define PG8_SA(b, h) (((b) * 2 + (h)) * HTB)
#define PG8_SB(b, h) ((4 + (b) * 2 + (h)) * HTB)
#define PG8_STAGE(bufoff, gbase, voff) do { const char* _gb = (const char*)(gbase); asm volatile("" : "+s"(_gb)); _Pragma("unroll") for (int _i = 0; _i < 2; ++_i) { unsigned _o = (voff)[_i]; asm volatile("" : "+v"(_o)); \
        __builtin_amdgcn_global_load_lds((const unsigned*)(_gb + _o), (LAS unsigned*)(lds + (bufoff) + ldsw + _i * 8192), 16, 0, 0); } } while (0)
#define PG8_LDA(dst, b, h) do { _Pragma("unroll") for (int m = 0; m < 4; ++m) dst[m] = PG8_CAT(*(const LAS i32x4*)(lds + PG8_SA(b, h) + aoff + m * 2048), *(const LAS i32x4*)(lds + PG8_SA(b, h) + aoff + m * 2048 + 1024)); } while (0)
#define PG8_LDB(dst, b, h) do { _Pragma("unroll") for (int n = 0; n < 2; ++n) dst[n] = PG8_CAT(*(const LAS i32x4*)(lds + PG8_SB(b, h) + boff + n * 2048), *(const LAS i32x4*)(lds + PG8_SB(b, h) + boff + n * 2048 + 1024)); } while (0)
#define PG8_CAT(x0, x1) __builtin_shufflevector((x0), (x1), 0, 1, 2, 3, 4, 5, 6, 7)
#define PG8_LO(x) __builtin_bit_cast(bf16x8, __builtin_shufflevector((x), (x), 0, 1, 2, 3))
#define PG8_HI(x) __builtin_bit_cast(bf16x8, __builtin_shufflevector((x), (x), 4, 5, 6, 7))
#define PG8_MMA(ai, bj, At, Bt) do { __builtin_amdgcn_s_setprio(1); \
        if (FP8) { _Pragma("unroll") for (int m = 0; m < 4; ++m) _Pragma("unroll") for (int n = 0; n < 2; ++n) \
            acc[ai][bj][m][n] = __builtin_amdgcn_mfma_scale_f32_16x16x128_f8f6f4(Bt[n], At[m], acc[ai][bj][m][n], 0, 0, 0, 0x7f7f7f7f, 0, 0x7f7f7f7f); } \
        else { _Pragma("unroll") for (int m = 0; m < 4; ++m) _Pragma("unroll") for (int n = 0; n < 2; ++n) { \
            acc[ai][bj][m][n] = __builtin_amdgcn_mfma_f32_16x16x32_bf16(PG8_LO(Bt[n]), PG8_LO(At[m]), acc[ai][bj][m][n], 0, 0, 0); \
            acc[ai][bj][m][n] = __builtin_amdgcn_mfma_f32_16x16x32_bf16(PG8_HI(Bt[n]), PG8_HI(At[m]), acc[ai][bj][m][n], 0, 0, 0); } } \
        __builtin_amdgcn_s_setprio(0); } while (0)
#define PG8_WAIT_V(n) asm volatile("s_waitcnt vmcnt(" #n ")" ::: "memory")
#define PG8_WAIT_L(n) asm volatile("s_waitcnt lgkmcnt(" #n ")" ::: "memory")
#define PG8_BAR __builtin_amdgcn_s_barrier()
#define PG8_SCHED __builtin_amdgcn_sched_barrier(0)
    Unit cur, nxt; int ui = 0;
    if (!S.next(0, cur)) return;
    f32x4 acc[2][2][4][2];
#pragma unroll
    for (int a = 0; a < 2; ++a)
#pragma unroll
        for (int b = 0; b < 2; ++b)
#pragma unroll
            for (int m = 0; m < 4; ++m)
#pragma unroll
                for (int n = 0; n < 2; ++n) acc[a][b][m][n] = (f32x4){0.f, 0.f, 0.f, 0.f};
    i32x8 At[4], B0[2], B1[2];
    unsigned oA0[2], oA1[2];
#pragma unroll
    for (int i = 0; i < 2; ++i) { oA0[i] = RW.off(cur, sR[i]) + sC[i]; oA1[i] = RW.off(cur, HALF + sR[i]) + sC[i]; }
    const char* cB = cur.B;
    PG8_STAGE(PG8_SB(0, 0), cB, voffB); PG8_STAGE(PG8_SB(0, 1), cB + hstepB, voffB); PG8_STAGE(PG8_SA(0, 0), Abase, oA0); PG8_STAGE(PG8_SA(0, 1), Abase, oA1);
    if (wr == 1) PG8_BAR;
    PG8_WAIT_V(2); PG8_BAR;
    PG8_STAGE(PG8_SB(1, 0), cB + kstep, voffB); PG8_STAGE(PG8_SA(1, 0), Abase + kstep, oA0); PG8_STAGE(PG8_SB(1, 1), cB + hstepB + kstep, voffB);
    PG8_WAIT_V(6); PG8_BAR;
    for (;;) {
        const bool has_next = S.next(ui + 1, nxt);
        unsigned gi0 = 0u, gi1 = 0u, gi2 = 0u, gi3 = 0u;
        if (has_next && RW.list) {
            int t2 = threadIdx.x; asm volatile("" : "+v"(t2)); int R0, C0, R1, C1; stage_rc(t2 * 16, R0, C0); stage_rc(t2 * 16 + 8192, R1, C1);
            const int* lb = RW.list + (size_t)nxt.pm * 256; const unsigned o0 = (unsigned)R0 * 4u, o1 = (unsigned)R1 * 4u, o2 = (unsigned)(HALF + R0) * 4u, o3 = (unsigned)(HALF + R1) * 4u;
            asm volatile("global_load_dword %0, %4, %8\n\tglobal_load_dword %1, %5, %8\n\tglobal_load_dword %2, %6, %8\n\tglobal_load_dword %3, %7, %8"
                         : "=&v"(gi0), "=&v"(gi1), "=&v"(gi2), "=&v"(gi3) : "v"(o0), "v"(o1), "v"(o2), "v"(o3), "s"(lb));
        }
#pragma unroll 1
        for (int t = 0; t < nt; t += 2) {
            const bool last = (t == nt - 2);
            const char* a1 = Abase + (size_t)(t + 1) * kstep;
            PG8_LDB(B0, 0, 0); PG8_LDB(B1, 0, 1); PG8_SCHED; PG8_LDA(At, 0, 0); PG8_STAGE(PG8_SA(1, 1), a1, oA1);
            PG8_WAIT_V(8); PG8_WAIT_L(0); PG8_BAR; PG8_MMA(0, 0, At, B0); PG8_MMA(0, 1, At, B1); PG8_BAR; PG8_SCHED;
            const char* a2; const char* b2;
            if (last) {
                if (has_next) {
                    int t2 = threadIdx.x; asm volatile("" : "+v"(t2));
#pragma unroll
                    for (int i = 0; i < 2; ++i) { int R, C; stage_rc(t2 * 16 + i * 8192, R, C);
                        if (RW.list) { asm volatile("" : "+v"(gi0), "+v"(gi1), "+v"(gi2), "+v"(gi3)); oA0[i] = (i ? gi1 : gi0) * RW.ldab + (unsigned)C * 2u; oA1[i] = (i ? gi3 : gi2) * RW.ldab + (unsigned)C * 2u; }
                        else { oA0[i] = (unsigned)(nxt.pm * 256 + R) * RW.ldab + (unsigned)C * 2u; oA1[i] = (unsigned)(nxt.pm * 256 + HALF + R) * RW.ldab + (unsigned)C * 2u; } }
                    cB = nxt.B;
                }
                a2 = Abase; b2 = cB;
            } else { a2 = Abase + (size_t)(t + 2) * kstep; b2 = cB + (size_t)(t + 2) * kstep; }
            const char* a3 = a2 + kstep; const char* b3 = b2 + kstep;
            PG8_LDA(At, 0, 1); PG8_STAGE(PG8_SB(0, 0), b2, voffB); PG8_STAGE(PG8_SB(0, 1), b2 + hstepB, voffB); PG8_STAGE(PG8_SA(0, 0), a2, oA0);
            PG8_WAIT_V(8); PG8_WAIT_L(0); PG8_BAR; PG8_MMA(1, 0, At, B0); PG8_MMA(1, 1, At, B1); PG8_BAR; PG8_SCHED;
            PG8_LDB(B0, 1, 0); PG8_LDB(B1, 1, 1); PG8_SCHED; PG8_LDA(At, 1, 0); PG8_STAGE(PG8_SA(0, 1), a2, oA1);
            PG8_WAIT_V(8); PG8_WAIT_L(0); PG8_BAR; PG8_MMA(0, 0, At, B0); PG8_MMA(0, 1, At, B1); PG8_BAR; PG8_SCHED;
            PG8_LDA(At, 1, 1); PG8_STAGE(PG8_SB(1, 0), b3, voffB); PG8_STAGE(PG8_SB(1, 1), b3 + hstepB, voffB); PG8_STAGE(PG8_SA(1, 0), a3, oA0);
            PG8_WAIT_V(8); PG8_WAIT_L(0); PG8_BAR; PG8_MMA(1, 0, At, B0); PG8_MMA(1, 1, At, B1); PG8_BAR; PG8_SCHED;
        }
        if (wr == 0) PG8_BAR;
        { Unit eu = cur; asm volatile("" : "+s"(eu.pm), "+s"(eu.pn)); int t3 = threadIdx.x; asm volatile("" : "+v"(t3)); E(acc, eu, wr, wc, t3 & 15, (t3 & 63) >> 4); }
        if (!has_next) break;
#pragma unroll
        for (int a = 0; a < 2; ++a)
#pragma unroll
            for (int b = 0; b < 2; ++b)
#pragma unroll
                for (int m = 0; m < 4; ++m)
#pragma unroll
                    for (int n = 0; n < 2; ++n) acc[a][b][m][n] = (f32x4){0.f, 0.f, 0.f, 0.f};
        cur = nxt; ++ui;
        if (wr == 1) PG8_BAR;
    }
    PG8_WAIT_V(0);
    PG8_BAR;
#undef PG8_SA
#undef PG8_SB
#undef PG8_STAGE
#undef PG8_LDA
#undef PG8_LDB
#undef PG8_MMA
#undef PG8_CAT
#undef PG8_LO
#undef PG8_HI
#undef PG8_WAIT_V
#undef PG8_WAIT_L
#undef PG8_BAR
#undef PG8_SCHED
}
}

struct Params { const float* in[42]; float* out; unsigned char* ws; int ph_lo, ph_hi; };
enum { I_X = 0, I_C, I_CTX, I_CCTX, I_ADAW, I_ADAB, I_N1G, I_N2G, I_WIN, I_WOUT, I_GLAW, I_GLAB, I_GLAG, I_CDW, I_CDB, I_CLG, I_CLB, I_CPW, I_CPB,
       I_S5LR, I_S5LI, I_S5DT, I_S5BR, I_S5BI, I_S5CR, I_S5CI, I_S5D, I_S5GW, I_S5GB, I_QNG, I_KVNG, I_WUQ, I_WUKV, I_RW, I_RB, I_MG, I_MU, I_MD, I_SG, I_SU, I_SD, I_FG };

typedef const __attribute__((address_space(4))) Params* KParams;
__device__ __forceinline__ KParams fresh_params() { KParams kp = (KParams)__builtin_amdgcn_kernarg_segment_ptr(); asm volatile("" : "+s"(kp)); return kp; }
struct Ctx {
    LAS unsigned char* lds;
    int tid, lane, wave, blk, G;
    unsigned char* ws;
};

__device__ __forceinline__ int mod_row(int r) { return r < NLAT ? (r >> 11) : 32; }

__device__ __forceinline__ unsigned pk4_fp8(float a, float b, float c2, float d) {
    int pk = __builtin_amdgcn_cvt_pk_fp8_f32(__builtin_amdgcn_fmed3f(a, -440.f, 440.f), __builtin_amdgcn_fmed3f(b, -440.f, 440.f), 0, false);
    pk = __builtin_amdgcn_cvt_pk_fp8_f32(__builtin_amdgcn_fmed3f(c2, -440.f, 440.f), __builtin_amdgcn_fmed3f(d, -440.f, 440.f), pk, true); return (unsigned)pk; }
template <bool F8 = false>
__device__ __forceinline__ void tr_item(const float* W, int ldw, int k0, int n0, bf16* dst, int ldk, const float* kscale, float sc, LAS float* scr, int lane) {
    float tv[32];
#pragma unroll
    for (int i = 0; i < 32; ++i) tv[i] = W[(size_t)(k0 + 2 * i + (lane >> 5)) * ldw + n0 + (lane & 31)];
#pragma unroll
    for (int i = 0; i < 32; ++i) { const int kk = 2 * i + (lane >> 5); float v = tv[i] * sc; if (kscale) v *= kscale[k0 + kk]; scr[kk * 33 + (lane & 31)] = v; }
    lds_wait();
    const int c = lane & 7;
#pragma unroll
    for (int j = 0; j < 4; ++j) { const int n = (lane >> 3) + 8 * j; const LAS float* s = scr + (8 * c) * 33 + n;
        if (F8) { u32x2 o; o.x = pk4_fp8(s[0 * 33], s[1 * 33], s[2 * 33], s[3 * 33]); o.y = pk4_fp8(s[4 * 33], s[5 * 33], s[6 * 33], s[7 * 33]); *(u32x2*)((unsigned char*)dst + (size_t)n * ldk + k0 + 8 * c) = o; }
        else { u32x4 o; o.x = pk2(s[0 * 33], s[1 * 33]); o.y = pk2(s[2 * 33], s[3 * 33]); o.z = pk2(s[4 * 33], s[5 * 33]); o.w = pk2(s[6 * 33], s[7 * 33]);
            *(u32x4*)(dst + (size_t)n * ldk + k0 + 8 * c) = o; } }
    lds_wait();
}
template <int KIND> __device__ __forceinline__ int tr_dst(int n0) {
    if (KIND == 0) return n0;
    if (KIND == 1) return n0 < 768 ? n0 : (n0 == 768 ? 1952 : n0 - 32);
    if (KIND == 2) { const int half = n0 >> 8, c = n0 & 255; return (c >> 7) * 256 + half * 128 + (c & 127); }
    if (KIND == 3) { const int head = n0 / 96, d0 = n0 % 96; return d0 < 64 ? head * 64 + d0 : 256 + head * 32; }
    if (KIND == 4) { const int head = n0 >> 7, d0 = n0 & 127; return d0 < 64 ? head * 64 + d0 : 256 + head * 64 + (d0 - 64); }
    if (KIND == 5) return (n0 >> 7) * 256 + (n0 & 127);
    if (KIND == 6) return (n0 >> 7) * 256 + 128 + (n0 & 127);
    return n0;
}
template <int KIND, bool F8 = false> __device__ __forceinline__ void tr_matrix(const Ctx& c, const float* W, int ldw, int K, int Nsrc, bf16* WT, int ldk, const float* kscale, float sc) {
    LAS float* scr = (LAS float*)(c.lds + c.wave * 8704);
    const int gw = c.blk * NWAVES + c.wave, NGW = c.G * NWAVES, ng = Nsrc / 32, items = (K / 64) * ng;
    for (int it = gw; it < items; it += NGW) { const int kb = it / ng, g = it % ng; tr_item<F8>(W, ldw, kb * 64, 32 * g, F8 ? (bf16*)((unsigned char*)WT + (size_t)tr_dst<KIND>(32 * g) * ldk) : WT + (size_t)tr_dst<KIND>(32 * g) * ldk, ldk, kscale, sc, scr, c.lane); }
}
__device__ __forceinline__ void zero_fill16(const Ctx& c, void* p, size_t bytes) {
    u32x4* q = (u32x4*)p; const size_t n = bytes / 16;
    for (size_t i = (size_t)c.blk * NTHR + c.tid; i < n; i += (size_t)c.G * NTHR) q[i] = (u32x4){0u, 0u, 0u, 0u};
}
__device__ __forceinline__ void sincos_r(float x, float& s, float& co) {
    const float n = rintf(x * 0.15915494309189535f);
    float r = fmaf(n, -6.28125f, x); r = fmaf(n, -1.9353071795864769e-3f, r);
    s = __sinf(r); co = __cosf(r);
}

__device__ __forceinline__ void prologue_moe_weights(const Ctx& c, KParams p, int l) {
    unsigned char* WGU8 = c.ws + WS_WMOE + (size_t)l * 48 * MiB;
    unsigned char* WD8 = WGU8 + (size_t)NE * 512 * 1024;
    LAS float* scr = (LAS float*)(c.lds + c.wave * 8704);
    const int gw = c.blk * NWAVES + c.wave, NGW = c.G * NWAVES;
    for (int it = gw; it < NE * 384; it += NGW) {
        const int e = it / 384, r = it % 384;
        if (r < 256) { const int up = r >> 7, q = r & 127, kb = q >> 3, g = q & 7;
            const float* W = p->in[up ? I_MU : I_MG] + ((size_t)l * NE + e) * 1024 * 256;
            const int nd = up ? tr_dst<6>(32 * g) : tr_dst<5>(32 * g);
            tr_item<true>(W, 256, kb * 64, 32 * g, (bf16*)(WGU8 + (size_t)e * 512 * 1024 + (size_t)nd * 1024), 1024, nullptr, 64.f, scr, c.lane);
        } else { const int q = r - 256, kb = q >> 5, g = q & 31;
            const float* W = p->in[I_MD] + ((size_t)l * NE + e) * 256 * 1024;
            tr_item<true>(W, 1024, kb * 64, 32 * g, (bf16*)(WD8 + (size_t)e * 1024 * 256 + (size_t)(32 * g) * 256), 256, nullptr, 64.f, scr, c.lane);
        }
    }
}

__device__ __forceinline__ void prologue(const Ctx& c, KParams p) {
    float* MOD = (float*)(c.ws + WS_MOD);
    {
        const int u = c.G - 1 - c.blk;
        if (u < 96) {
            LAS float* sc = (LAS float*)(c.lds + 72 * 1024);
            LAS float* part = (LAS float*)c.lds;
            const int l = u / 48, kq = c.tid >> 7, cj = c.tid & 127, col = (u % 48) * 128 + cj;
            const float* W = p->in[I_ADAW] + (size_t)l * 1024 * 6144;
            float acc[33];
#pragma unroll
            for (int b = 0; b < 33; ++b) acc[b] = 0.f;
            for (int j = 0; j < 4; ++j) {
                __syncthreads();
                for (int i = c.tid; i < 4 * 33 * 64; i += NTHR) { const int q = i / (33 * 64), r = i % (33 * 64), b = r >> 6, kk = r & 63, k = 256 * q + 64 * j + kk; const float v = b < 32 ? p->in[I_C][b * 1024 + k] : p->in[I_CCTX][k]; sc[i] = siluf_(v); }
                __syncthreads();
                const float* wp = W + (size_t)(256 * kq + 64 * j) * 6144 + col; const LAS float* sq = sc + kq * 33 * 64;
#pragma unroll 8
                for (int kk = 0; kk < 64; ++kk) { const float w = wp[(size_t)kk * 6144];
#pragma unroll
                    for (int b = 0; b < 33; ++b) acc[b] = fmaf(sq[b * 64 + kk], w, acc[b]); }
            }
#pragma unroll
            for (int b = 0; b < 33; ++b) part[(kq * 33 + b) * 128 + cj] = acc[b];
            __syncthreads();
            for (int i = c.tid; i < 33 * 128; i += NTHR) { const int b = i >> 7, cc = i & 127, gc = (u % 48) * 128 + cc;
                MOD[((size_t)l * 33 + b) * 6144 + gc] = (part[(0 * 33 + b) * 128 + cc] + part[(1 * 33 + b) * 128 + cc]) + (part[(2 * 33 + b) * 128 + cc] + part[(3 * 33 + b) * 128 + cc]) + p->in[I_ADAB][l * 6144 + gc]; }
            __syncthreads();
        }
    }
    {
        float* ROPE = (float*)(c.ws + WS_TAB + TAB_ROPE);
        for (int i = c.blk * NTHR + c.tid; i < 2048 * 16; i += c.G * NTHR) { const int t = i >> 4, ax = (i >> 3) & 1, f = i & 7;
            const float pos = (float)(ax == 0 ? (t >> 6) : (t & 63)); const float inv = __expf(-(float)f * (9.210340371976184f / 8.0f));
            float s, co; sincos_r(pos * inv, s, co); ROPE[i * 2] = co; ROPE[i * 2 + 1] = s; }
        bf16* RWT = (bf16*)(c.ws + WS_TAB + TAB_RWT);
        for (int i = c.blk * NTHR + c.tid; i < 2 * 64 * 1024; i += c.G * NTHR) { const int l = i >> 16, n = (i >> 10) & 63, k = i & 1023; const float wv = p->in[I_RW][((size_t)l * 1024 + k) * 64 + n];
            const bf16 hi = f2bf(wv); RWT[(size_t)(l * 2) * 65536 + n * 1024 + k] = hi; RWT[(size_t)(l * 2 + 1) * 65536 + n * 1024 + k] = f2bf(wv - bf2f(hi)); }
        float* S5T = (float*)(c.ws + WS_TAB + TAB_S5);
        for (int i = c.blk * NTHR + c.tid; i < 2 * 2 * 16 * 64; i += c.G * NTHR) {
            const int pp = i & 63, g = (i >> 6) & 15, ld = i >> 10;
            const float lr = p->in[I_S5LR][i], li = p->in[I_S5LI][i], dt = __expf(p->in[I_S5DT][ld * 16 + g]);
            const float mag = __expf(lr * dt); float s, co; sincos_r(li * dt, s, co);
            const float are = mag * co, aim = mag * s, den = lr * lr + li * li;
            const float fre = ((are - 1.f) * lr + aim * li) / den, fim = (aim * lr - (are - 1.f) * li) / den;
            float* T = S5T + (size_t)i * 66; T[0] = are; T[1] = aim;
            { float* PW = (float*)(c.ws + WS_S5P) + (size_t)i * 34; float pr = 1.f, pi = 0.f;
              for (int e = 0; e <= 16; ++e) { PW[2 * e] = pr; PW[2 * e + 1] = pi; const float nr = pr * are - pi * aim, ni = pr * aim + pi * are; pr = nr; pi = ni; } }
            for (int ch = 0; ch < 16; ++ch) { const float br = p->in[I_S5BR][(size_t)i * 16 + ch], bi = p->in[I_S5BI][(size_t)i * 16 + ch];
                T[2 + ch] = fre * br - fim * bi; T[18 + ch] = fre * bi + fim * br;
                T[34 + ch] = p->in[I_S5CR][((size_t)(ld * 16 + g) * 16 + ch) * 64 + pp]; T[50 + ch] = p->in[I_S5CI][((size_t)(ld * 16 + g) * 16 + ch) * 64 + pp]; }
        }
    }
    for (int l = 0; l < 2; ++l) {
        bf16* WIN = (bf16*)(c.ws + WS_WIN) + (size_t)l * 2048 * 1024;
        tr_matrix<1>(c, p->in[I_WIN] + (size_t)l * 1024 * 1984, 1984, 1024, 1984, WIN, 1024, nullptr, 1.f);
        zero_fill16(c, WIN + (size_t)1984 * 1024, (size_t)64 * 1024 * 2);
        tr_matrix<0, true>(c, p->in[I_WOUT] + (size_t)l * 1024 * 1024, 1024, 1024, 1024, (bf16*)(c.ws + WS_WOUT) + (size_t)l * 1024 * 1024, 1024, nullptr, 64.f);
        unsigned char* sm = c.ws + WS_WSM + (size_t)l * WSM_L;
        tr_matrix<0>(c, p->in[I_CPW] + (size_t)l * 256 * 256, 256, 256, 256, (bf16*)(sm + WSM_PW), 256, nullptr, 1.f);
        tr_matrix<2>(c, p->in[I_S5GW] + (size_t)l * 256 * 512, 512, 256, 512, (bf16*)(sm + WSM_GLU), 256, nullptr, 1.f);
        tr_matrix<3>(c, p->in[I_WUQ] + (size_t)l * 256 * 384, 384, 256, 384, (bf16*)(sm + WSM_UQ), 256, p->in[I_QNG] + l * 256, 0.14724445f  );
        zero_fill16(c, (bf16*)(sm + WSM_UQ) + (size_t)384 * 256, (size_t)128 * 256 * 2);
        zero_fill16(c, sm + WSM_UK, (size_t)512 * 256 * 2);
    }
    for (int l = 0; l < 2; ++l) {
        bf16* WSGU = (bf16*)(c.ws + WS_WSH) + (size_t)l * (512 * 1024 + 1024 * 256); bf16* WSD = WSGU + 512 * 1024;
        tr_matrix<5, true>(c, p->in[I_SG] + (size_t)l * 1024 * 256, 256, 1024, 256, WSGU, 1024, nullptr, 64.f);
        tr_matrix<6, true>(c, p->in[I_SU] + (size_t)l * 1024 * 256, 256, 1024, 256, WSGU, 1024, nullptr, 64.f);
        tr_matrix<0, true>(c, p->in[I_SD] + (size_t)l * 256 * 1024, 1024, 256, 1024, (bf16*)((unsigned char*)WSGU + 512 * 1024), 256, nullptr, 64.f);
    }
    prologue_moe_weights(c, p, 0);
    prologue_moe_weights(c, p, 1);
}
__device__ __forceinline__ void prologue_s5_weights(const Ctx& c, KParams p) {
    const float* S5T = (const float*)(c.ws + WS_TAB + TAB_S5); const float* S5P = (const float*)(c.ws + WS_S5P);
    LAS float* pw = (LAS float*)c.lds;
    LAS float* bb = pw + 2 * 17 * 64 * 2;
    LAS float* cc = bb + 2 * 64 * 16 * 2;
    LAS float* kt = cc + 2 * 16 * 64 * 2;
    for (int u = c.blk; u < 32; u += c.G) {
        const int l = u >> 4, g = u & 15;
        __syncthreads();
        for (int i = c.tid; i < 2 * 64; i += NTHR) { const int dir = i >> 6, pp = i & 63; const size_t row = (size_t)((l * 2 + dir) * 16 + g) * 64 + pp; const float* T = S5T + row * 66; const float* PW = S5P + row * 34;
            for (int e = 0; e <= 16; ++e) { pw[((dir * 17 + e) * 64 + pp) * 2] = PW[2 * e]; pw[((dir * 17 + e) * 64 + pp) * 2 + 1] = PW[2 * e + 1]; }
            for (int ch = 0; ch < 16; ++ch) { bb[((dir * 64 + pp) * 16 + ch) * 2] = T[2 + ch]; bb[((dir * 64 + pp) * 16 + ch) * 2 + 1] = T[18 + ch]; cc[((dir * 16 + ch) * 64 + pp) * 2] = T[34 + ch]; cc[((dir * 16 + ch) * 64 + pp) * 2 + 1] = T[50 + ch]; } }
        __syncthreads();
        for (int i = c.tid; i < 2 * 16 * 256; i += NTHR) { const int dir = i >> 12, tau = (i >> 8) & 15, c1 = (i >> 4) & 15, c0 = i & 15; float s = 0.f;
            for (int pp = 0; pp < 64; ++pp) { const float cr = cc[((dir * 16 + c1) * 64 + pp) * 2], ci = cc[((dir * 16 + c1) * 64 + pp) * 2 + 1], pr = pw[((dir * 17 + tau) * 64 + pp) * 2], pi = pw[((dir * 17 + tau) * 64 + pp) * 2 + 1];
                const float wr_ = cr * pr - ci * pi, wi_ = cr * pi + ci * pr; s += wr_ * bb[((dir * 64 + pp) * 16 + c0) * 2] - wi_ * bb[((dir * 64 + pp) * 16 + c0) * 2 + 1]; }
            kt[i] = s; }
        __syncthreads();
        bf16* B1 = (bf16*)(c.ws + WS_S5W) + (size_t)(l * 16 + g) * 256 * 256;
        bf16* B2 = (bf16*)(c.ws + WS_S5W) + (size_t)32 * 256 * 256 + (size_t)(l * 16 + g) * 256 * 512;
        const float* dsk = p->in[I_S5D] + l * 256 + g * 16;
        for (int i = c.tid; i < 256 * 256; i += NTHR) { const int n = i >> 8, k = i & 255, dir = n >> 7, ri = (n >> 6) & 1, pp = n & 63, s = k >> 4, ch = k & 15, e = dir ? s : 15 - s;
            const float pr = pw[((dir * 17 + e) * 64 + pp) * 2], pi = pw[((dir * 17 + e) * 64 + pp) * 2 + 1], br = bb[((dir * 64 + pp) * 16 + ch) * 2], bi = bb[((dir * 64 + pp) * 16 + ch) * 2 + 1];
            B1[i] = f2bf(ri ? pr * bi + pi * br : pr * br - pi * bi); }
        for (int i = c.tid; i < 256 * 512; i += NTHR) { const int n = i >> 9, k = i & 511, t = n >> 4, c1 = n & 15; float v;
            if (k < 256) { const int s = k >> 4, c0 = k & 15; v = 0.f; if (s <= t) v += kt[((0 * 16 + (t - s)) * 16 + c1) * 16 + c0]; if (s >= t) v += kt[((1 * 16 + (s - t)) * 16 + c1) * 16 + c0]; if (s == t && c0 == c1) v += dsk[c0]; }
            else { const int q = k - 256, dir = q >> 7, ri = (q >> 6) & 1, pp = q & 63, e = dir ? 16 - t : t + 1;
                const float cr = cc[((dir * 16 + c1) * 64 + pp) * 2], ci = cc[((dir * 16 + c1) * 64 + pp) * 2 + 1], pr = pw[((dir * 17 + e) * 64 + pp) * 2], pi = pw[((dir * 17 + e) * 64 + pp) * 2 + 1];
                v = ri ? -(cr * pi + ci * pr) : (cr * pr - ci * pi); }
            B2[i] = f2bf(v); }
    }
    __syncthreads();
}
__device__ __forceinline__ void prologue2(const Ctx& c, KParams p) {
    prologue_s5_weights(c, p);
    for (int l = 0; l < 2; ++l) { unsigned char* sm = c.ws + WS_WSM + (size_t)l * WSM_L;
        tr_matrix<4>(c, p->in[I_WUKV] + (size_t)l * 128 * 512, 512, 128, 512, (bf16*)(sm + WSM_UK), 256, p->in[I_KVNG] + l * 128, 1.f); }
}

__device__ __forceinline__ void norm_row(const float* xrow, const float* gain, const float* sh, const float* sc, bf16* orow, int lane, f32x4 (&v)[4]) {
    float ss = 0.f;
#pragma unroll
    for (int j = 0; j < 4; ++j) { v[j] = *(const f32x4*)(xrow + 4 * lane + 256 * j); ss += (v[j].x * v[j].x + v[j].y * v[j].y) + (v[j].z * v[j].z + v[j].w * v[j].w); }
    const float rstd = rsqrtf(wave_sum(ss) * (1.f / 1024.f) + EPS);
#pragma unroll
    for (int j = 0; j < 4; ++j) { const int cc = 4 * lane + 256 * j; const f32x4 g = *(const f32x4*)(gain + cc), s1 = *(const f32x4*)(sc + cc), s0 = *(const f32x4*)(sh + cc);
        v[j] = v[j] * rstd * g * (s1 + 1.0f) + s0;
        u32x2 o; o.x = pk2(v[j].x, v[j].y); o.y = pk2(v[j].z, v[j].w); *(u32x2*)(orow + cc) = o; }
}
__device__ __forceinline__ void norm_row_add(const float* xrow, const bf16* drow, float* xout, const float* gain, const float* sh, const float* sc, unsigned char* orow8, int lane, f32x4 (&v)[4]) {
    float ss = 0.f; u32x2 dl[4];
#pragma unroll
    for (int j = 0; j < 4; ++j) { v[j] = *(const f32x4*)(xrow + 4 * lane + 256 * j); dl[j] = *(const u32x2*)(drow + 4 * lane + 256 * j); }
#pragma unroll
    for (int j = 0; j < 4; ++j) { v[j] += (f32x4){__uint_as_float(dl[j].x << 16), __uint_as_float(dl[j].x & 0xffff0000u), __uint_as_float(dl[j].y << 16), __uint_as_float(dl[j].y & 0xffff0000u)};
        *(f32x4*)(xout + 4 * lane + 256 * j) = v[j]; ss += (v[j].x * v[j].x + v[j].y * v[j].y) + (v[j].z * v[j].z + v[j].w * v[j].w); }
    const float rstd = rsqrtf(wave_sum(ss) * (1.f / 1024.f) + EPS);
#pragma unroll
    for (int j = 0; j < 4; ++j) { const int cc = 4 * lane + 256 * j; const f32x4 g = *(const f32x4*)(gain + cc), s1 = *(const f32x4*)(sc + cc), s0 = *(const f32x4*)(sh + cc);
        v[j] = v[j] * rstd * g * (s1 + 1.0f) + s0;
        *(unsigned*)(orow8 + cc) = pk4_fp8(v[j].x * 4.f, v[j].y * 4.f, v[j].z * 4.f, v[j].w * 4.f); }
}
__device__ __forceinline__ void phase_norm1(const Ctx& c, KParams p, int l) {
    const float* MOD = (const float*)(c.ws + WS_MOD) + (size_t)l * 33 * 6144;
    const float* xl = l == 0 ? p->in[I_X] : p->out; const float* xc = l == 0 ? p->in[I_CTX] : (const float*)(c.ws + WS_XC);
    bf16* H = (bf16*)(c.ws + WS_H); const float* gain = p->in[I_N1G] + l * DM;
    const int gw = c.blk * NWAVES + c.wave, NGW = c.G * NWAVES, lane = c.lane;
    for (int r0 = gw; r0 < NTOK; r0 += 2 * NGW) {
        f32x4 v[2][4]; float ss[2];
#pragma unroll
        for (int k = 0; k < 2; ++k) { const int r = r0 + k * NGW < NTOK ? r0 + k * NGW : r0; const float* xr = r < NLAT ? xl + (size_t)r * DM : xc + (size_t)(r - NLAT) * DM;
#pragma unroll
            for (int j = 0; j < 4; ++j) v[k][j] = *(const f32x4*)(xr + 4 * lane + 256 * j); }
#pragma unroll
        for (int k = 0; k < 2; ++k) { ss[k] = 0.f;
#pragma unroll
            for (int j = 0; j < 4; ++j) ss[k] += (v[k][j].x * v[k][j].x + v[k][j].y * v[k][j].y) + (v[k][j].z * v[k][j].z + v[k][j].w * v[k][j].w); }
#pragma unroll
        for (int k = 0; k < 2; ++k) { const int r = r0 + k * NGW; if (r < NTOK) { const float rstd = rsqrtf(wave_sum(ss[k]) * (1.f / 1024.f) + EPS); const float* m = MOD + (size_t)mod_row(r) * 6144; bf16* orow = H + (size_t)r * DM;
#pragma unroll
            for (int j = 0; j < 4; ++j) { const int cc = 4 * lane + 256 * j; const f32x4 g = *(const f32x4*)(gain + cc), s1 = *(const f32x4*)(m + 1024 + cc), s0 = *(const f32x4*)(m + cc);
                const f32x4 y = v[k][j] * rstd * g * (s1 + 1.0f) + s0; u32x2 o; o.x = pk2(y.x, y.y); o.y = pk2(y.z, y.w); *(u32x2*)(orow + cc) = o; } } }
    }
}

#define EPI_ARGS const f32x4 (&acc)[2][2][4][2], const pg8::Unit& u, int wr, int wc, int fr, int fq
#define EPI_ROWS for (int ai = 0; ai < 2; ++ai) _Pragma("unroll") for (int m = 0; m < 4; ++m)
struct EpiBf16 {
    bf16* O; int ldo;
    __device__ __forceinline__ void operator()(EPI_ARGS) const {
        const int r0 = u.pm * 256 + wr * 64 + fr, c0 = u.pn * 256 + wc * 32 + 8 * fq;
#pragma unroll
        EPI_ROWS { bf16* rp = O + (size_t)(r0 + ai * 128 + m * 16) * ldo + c0;
#pragma unroll
            for (int bj = 0; bj < 2; ++bj) { const f32x4 a = acc[ai][bj][m][0], b = acc[ai][bj][m][1]; u32x4 w; w.x = pk2(a.x, a.y); w.y = pk2(a.z, a.w); w.z = pk2(b.x, b.y); w.w = pk2(b.z, b.w); *(u32x4*)(rp + bj * 128) = w; } asm volatile("" ::: "memory"); }
    }
};
struct EpiInProj {
    bf16* O; bf16* UP; bf16* GVT;
    __device__ __forceinline__ void operator()(EPI_ARGS) const {
        const int r0 = u.pm * 256 + wr * 64 + fr, c0 = u.pn * 256 + wc * 32 + 8 * fq;
#pragma unroll
        EPI_ROWS { const int row = r0 + ai * 128 + m * 16; bf16* rp = O + (size_t)row * ZW + c0;
            const int crow = row < NLAT ? (row >> 11) * 144 + 16 + ((row & 2047) >> 4) : ((row - NLAT) >> 8) * 144 + (((row - NLAT) & 255) >> 4);
#pragma unroll
            for (int bj = 0; bj < 2; ++bj) { const f32x4 a = acc[ai][bj][m][0], b = acc[ai][bj][m][1]; u32x4 w; w.x = pk2(a.x, a.y); w.y = pk2(a.z, a.w); w.z = pk2(b.x, b.y); w.w = pk2(b.z, b.w);
                if (u.pn != 1 && u.pn != 5) *(u32x4*)(rp + bj * 128) = w;
                if (u.pn == 5) { const int g = 8 * bj + 2 * wc + (fq >> 1); *(u32x4*)(UP + ((size_t)g * 4608 + crow) * 512 + fr * 16 + 8 * (fq & 1)) = w; }
                if (u.pn == 1) { const int col = 128 * bj + 32 * wc + 8 * fq, bb = row < NLAT ? (row >> 11) : ((row - NLAT) >> 8), kk = row < NLAT ? 256 + (row & 2047) : ((row - NLAT) & 255);
                    bf16* dst = GVT + ((size_t)(bb * 4 + (col >> 6)) * 64 + (col & 63)) * 2304 + (kk & ~15) + 8 * ((fr >> 2) & 1) + 4 * (fr >> 3) + (fr & 3);
#pragma unroll
                    for (int n = 0; n < 2; ++n)
#pragma unroll
                        for (int i = 0; i < 4; ++i) dst[(size_t)(4 * n + i) * 2304] = f2bf(acc[ai][bj][m][n][i]); } }
            asm volatile("" ::: "memory"); }
    }
};
struct EpiS5X {
    bf16* XE;
    __device__ __forceinline__ void operator()(EPI_ARGS) const {
        const int r0 = u.pm * 256 + wr * 64 + fr, c0 = wc * 32 + 8 * fq;
#pragma unroll
        EPI_ROWS { bf16* rp = XE + (size_t)(r0 + ai * 128 + m * 16) * 256 + c0;
#pragma unroll
            for (int bj = 0; bj < 2; ++bj) { const f32x4 a = acc[ai][bj][m][0], b = acc[ai][bj][m][1]; u32x4 w; w.x = pk2(a.x, a.y); w.y = pk2(a.z, a.w); w.z = pk2(b.x, b.y); w.w = pk2(b.z, b.w); *(u32x4*)(rp + bj * 128) = w; }
            asm volatile("" ::: "memory"); }
    }
};
struct EpiS5Y {
    bf16* Y;
    __device__ __forceinline__ void operator()(EPI_ARGS) const {
        const int r0 = u.pm * 256 + wr * 64 + fr;
#pragma unroll
        EPI_ROWS { const int grow = r0 + ai * 128 + m * 16; const int g = grow / 4608, rem = grow - g * 4608, b = rem / 144, ci = rem - b * 144;
            const int tok0 = ci < 16 ? NLAT + b * CTXL + ci * 16 : b * SEQ + (ci - 16) * 16;
#pragma unroll
            for (int bj = 0; bj < 2; ++bj) { const int t = 8 * bj + 2 * wc + (fq >> 1); const f32x4 a = acc[ai][bj][m][0], bq = acc[ai][bj][m][1]; u32x4 w; w.x = pk2(a.x, a.y); w.y = pk2(a.z, a.w); w.z = pk2(bq.x, bq.y); w.w = pk2(bq.z, bq.w);
                *(u32x4*)(Y + (size_t)(tok0 + t) * 256 + g * 16 + 8 * (fq & 1)) = w; }
            asm volatile("" ::: "memory"); }
    }
};
struct EpiOB8 {
    unsigned char* OB; float sc;
    __device__ __forceinline__ void operator()(EPI_ARGS) const {
        const int r0 = u.pm * 256 + wr * 64 + fr;
#pragma unroll
        EPI_ROWS { unsigned char* rp = OB + (size_t)(r0 + ai * 128 + m * 16) * 1024 + u.pn * 256 + (wc * 4 + fq) * 16; u32x4 w;
#pragma unroll
            for (int bj = 0; bj < 2; ++bj)
#pragma unroll
                for (int n = 0; n < 2; ++n) { const f32x4 a = acc[ai][bj][m][n] * sc; int pk = 0;
                    pk = __builtin_amdgcn_cvt_pk_fp8_f32(__builtin_amdgcn_fmed3f(a.x, -440.f, 440.f), __builtin_amdgcn_fmed3f(a.y, -440.f, 440.f), pk, false);
                    pk = __builtin_amdgcn_cvt_pk_fp8_f32(__builtin_amdgcn_fmed3f(a.z, -440.f, 440.f), __builtin_amdgcn_fmed3f(a.w, -440.f, 440.f), pk, true); w[2 * bj + n] = (unsigned)pk; }
            *(u32x4*)rp = w; asm volatile("" ::: "memory"); }
    }
};
struct EpiBf16S {
    bf16* O; int ldo; float sc;
    __device__ __forceinline__ void operator()(EPI_ARGS) const {
        const int r0 = u.pm * 256 + wr * 64 + fr, c0 = u.pn * 256 + wc * 32 + 8 * fq;
#pragma unroll
        EPI_ROWS { bf16* rp = O + (size_t)(r0 + ai * 128 + m * 16) * ldo + c0;
#pragma unroll
            for (int bj = 0; bj < 2; ++bj) { const f32x4 a = acc[ai][bj][m][0] * sc, b = acc[ai][bj][m][1] * sc; u32x4 w; w.x = pk2(a.x, a.y); w.y = pk2(a.z, a.w); w.z = pk2(b.x, b.y); w.w = pk2(b.z, b.w); *(u32x4*)(rp + bj * 128) = w; }
            asm volatile("" ::: "memory"); }
    }
};
struct EpiBiasBf16 {
    unsigned char* O; int ldo; const float* bias;
    __device__ __forceinline__ void operator()(EPI_ARGS) const {
        const int r0 = u.pm * 256 + wr * 64 + fr, c0 = u.pn * 256 + wc * 32 + 8 * fq;
        f32x4 bv[2][2];
#pragma unroll
        for (int bj = 0; bj < 2; ++bj) { bv[bj][0] = *(const f32x4*)(bias + c0 + bj * 128); bv[bj][1] = *(const f32x4*)(bias + c0 + bj * 128 + 4); }
        __builtin_amdgcn_s_waitcnt(0x0F70);
#pragma unroll
        EPI_ROWS { unsigned char* rp = O + (size_t)(r0 + ai * 128 + m * 16) * ldo + c0;
#pragma unroll
            for (int bj = 0; bj < 2; ++bj) { const f32x4 a = (acc[ai][bj][m][0] + bv[bj][0]) * 16.f, b = (acc[ai][bj][m][1] + bv[bj][1]) * 16.f; u32x2 w; w.x = pk4_fp8(a.x, a.y, a.z, a.w); w.y = pk4_fp8(b.x, b.y, b.z, b.w); *(u32x2*)(rp + bj * 128) = w; } asm volatile("" ::: "memory"); }
    }
};
struct EpiGluSig {
    unsigned char* O; int ldo; const float* bias;
    __device__ __forceinline__ void operator()(EPI_ARGS) const {
        const int r0 = u.pm * 256 + wr * 64 + fr, c0 = u.pn * 128 + wc * 32 + 8 * fq;
        f32x4 b1[2], b2[2];
#pragma unroll
        for (int n = 0; n < 2; ++n) { b1[n] = *(const f32x4*)(bias + c0 + 4 * n); b2[n] = *(const f32x4*)(bias + 256 + c0 + 4 * n); }
        __builtin_amdgcn_s_waitcnt(0x0F70);
#pragma unroll
        EPI_ROWS { unsigned char* rp = O + (size_t)(r0 + ai * 128 + m * 16) * ldo + c0; float o[8];
#pragma unroll
            for (int n = 0; n < 2; ++n)
#pragma unroll
                for (int i = 0; i < 4; ++i) o[4 * n + i] = (acc[ai][0][m][n][i] + b1[n][i]) * (16.f * sigmoidf_(acc[ai][1][m][n][i] + b2[n][i]));
            u32x2 w; w.x = pk4_fp8(o[0], o[1], o[2], o[3]); w.y = pk4_fp8(o[4], o[5], o[6], o[7]); *(u32x2*)rp = w; asm volatile("" ::: "memory"); }
    }
};
struct EpiSwiglu {
    unsigned char* O; int ldo; float sc;
    __device__ __forceinline__ void operator()(EPI_ARGS) const {
        const int r0 = u.pm * 256 + wr * 64 + fr, c0 = u.pn * 128 + wc * 32 + 8 * fq;
#pragma unroll
        EPI_ROWS { unsigned char* rp = O + (size_t)(r0 + ai * 128 + m * 16) * ldo + c0; float o[8];
#pragma unroll
            for (int n = 0; n < 2; ++n)
#pragma unroll
                for (int i = 0; i < 4; ++i) o[4 * n + i] = siluf_(acc[ai][0][m][n][i] * sc) * (acc[ai][1][m][n][i] * (sc * 16.0f));
            u32x2 w; w.x = pk4_fp8(o[0], o[1], o[2], o[3]); w.y = pk4_fp8(o[4], o[5], o[6], o[7]); *(u32x2*)rp = w; asm volatile("" ::: "memory"); }
    }
};
struct EpiQ {
    bf16* Q; const float* RS;
    __device__ __forceinline__ void operator()(EPI_ARGS) const {
        const int r0 = u.pm * 256 + wr * 64 + fr; float rq[8];
#pragma unroll
        for (int g = 0; g < 8; ++g) rq[g] = RS[(size_t)(r0 + (g >> 2) * 128 + (g & 3) * 16) * 2];
        __builtin_amdgcn_s_waitcnt(0x0F70);
#pragma unroll
        EPI_ROWS { const int row = r0 + ai * 128 + m * 16; const float rs = rq[ai * 4 + m]; bf16* rp = Q + (size_t)row * 384;
            if (u.pn == 0) {
#pragma unroll
                for (int bj = 0; bj < 2; ++bj) { const int head = 2 * bj + (wc >> 1), d = 32 * (wc & 1) + 8 * fq; const f32x4 a = acc[ai][bj][m][0] * rs, b = acc[ai][bj][m][1] * rs;
                    u32x4 w; w.x = pk2(a.x, a.y); w.y = pk2(a.z, a.w); w.z = pk2(b.x, b.y); w.w = pk2(b.z, b.w); *(u32x4*)(rp + head * 96 + d) = w; }
            } else { const f32x4 a = acc[ai][0][m][0] * rs, b = acc[ai][0][m][1] * rs;
                u32x4 w; w.x = pk2(a.x, a.y); w.y = pk2(a.z, a.w); w.z = pk2(b.x, b.y); w.w = pk2(b.z, b.w); *(u32x4*)(rp + wc * 96 + 64 + 8 * fq) = w; }
            asm volatile("" ::: "memory"); }
    }
};
struct EpiKV {
    bf16* Kb; bf16* VT; const float* RS;
    __device__ __forceinline__ void operator()(EPI_ARGS) const {
        const int r0 = u.pm * 256 + wr * 64 + fr;
        const int p16 = 8 * ((fr >> 2) & 1) + 4 * (fr >> 3) + (fr & 3); float rkv[8];
#pragma unroll
        for (int g = 0; g < 8; ++g) rkv[g] = RS[(size_t)(r0 + (g >> 2) * 128 + (g & 3) * 16) * 2 + 1];
        __builtin_amdgcn_s_waitcnt(0x0F70);
#pragma unroll
        EPI_ROWS { const int row = r0 + ai * 128 + m * 16; const float rk = rkv[ai * 4 + m];
            if (u.pn == 0) {
#pragma unroll
                for (int bj = 0; bj < 2; ++bj) { const int head = 2 * bj + (wc >> 1), d = 32 * (wc & 1) + 8 * fq; const f32x4 a = acc[ai][bj][m][0] * rk, b = acc[ai][bj][m][1] * rk;
                    u32x4 w; w.x = pk2(a.x, a.y); w.y = pk2(a.z, a.w); w.z = pk2(b.x, b.y); w.w = pk2(b.z, b.w);
                    *(u32x4*)(Kb + (size_t)row * 384 + head * 96 + d) = w; }
            } else {
                const int bb = row < NLAT ? (row >> 11) : ((row - NLAT) >> 8); const int kk = row < NLAT ? (row & 2047) : 2048 + ((row - NLAT) & 255);
                const int pos = (kk & ~15) + p16;
#pragma unroll
                for (int bj = 0; bj < 2; ++bj) { const int head = 2 * bj + (wc >> 1), d = 32 * (wc & 1) + 8 * fq; bf16* dst = VT + ((size_t)((bb * 4 + head) * 64 + d)) * 2304 + pos;
#pragma unroll
                    for (int n = 0; n < 2; ++n)
#pragma unroll
                        for (int i = 0; i < 4; ++i) dst[(size_t)(4 * n + i) * 2304] = f2bf(acc[ai][bj][m][n][i] * rk); }
            }
            asm volatile("" ::: "memory"); }
    }
};
struct EpiDelta {
    bf16* D; const float* MODg; float sc;
    __device__ __forceinline__ void operator()(EPI_ARGS) const {
        const int rt = u.pm * 256; const float* g = MODg + (size_t)(rt < NLAT ? (rt >> 11) : 32) * 6144;
        const int r0 = rt + wr * 64 + fr, c0 = u.pn * 256 + wc * 32 + 8 * fq;
        f32x4 gv[2][2];
#pragma unroll
        for (int bj = 0; bj < 2; ++bj) { gv[bj][0] = *(const f32x4*)(g + c0 + bj * 128) * sc; gv[bj][1] = *(const f32x4*)(g + c0 + bj * 128 + 4) * sc; }
        __builtin_amdgcn_s_waitcnt(0x0F70);
#pragma unroll
        EPI_ROWS { bf16* rp = D + (size_t)(r0 + ai * 128 + m * 16) * DM + c0;
#pragma unroll
            for (int bj = 0; bj < 2; ++bj) { const f32x4 a = gv[bj][0] * acc[ai][bj][m][0], b = gv[bj][1] * acc[ai][bj][m][1]; u32x4 w; w.x = pk2(a.x, a.y); w.y = pk2(a.z, a.w); w.z = pk2(b.x, b.y); w.w = pk2(b.z, b.w); *(u32x4*)(rp + bj * 128) = w; }
            asm volatile("" ::: "memory"); }
    }
};

__device__ __forceinline__ int seq_row(int b, int dir, int pos) {
    if (pos < CTXL) return NLAT + b * CTXL + (dir ? CTXL - 1 - pos : pos);
    const int t = pos - CTXL; return b * SEQ + (dir ? SEQ - 1 - t : t);
}
__device__ __forceinline__ void phase_gla(const Ctx& c, KParams p, int l) {
    const bf16* Z = (const bf16*)(c.ws + WS_Z); const bf16* GVT = (const bf16*)(c.ws + WS_GVT); bf16* OG = (bf16*)(c.ws + WS_T1);
    const int w = c.wave, tid = c.tid;
    LAS float* wtab = (LAS float*)c.lds;
    LAS float* DD = (LAS float*)(c.lds + 4096);
    LAS unsigned char* RW = c.lds + 8192 + w * 13824;
    LAS float* LA = (LAS float*)RW;
    LAS unsigned char* KTT = RW + 9216;
    for (int u = c.blk; u < 256; u += c.G) {
        const int b = u >> 3, h = (u >> 1) & 3, dir = u & 1;
        __syncthreads();
        { const float* wa = p->in[I_GLAW] + ((size_t)(l * 2 + dir) * 16) * 128 + h * 32; wtab[tid] = wa[(tid >> 5) * 128 + (tid & 31)]; if (tid < 32) wtab[512 + tid] = p->in[I_GLAB][(l * 2 + dir) * 128 + h * 32 + tid]; }
        float Sst[4] = {0.f, 0.f, 0.f, 0.f};
        __syncthreads();
        for (int gi = 0; gi < 5; ++gi) {
            const int pc = gi * 8 + w; const bool active = pc < 36;
            int lane_ = c.lane; asm volatile("" : "+v"(lane_));
            const int r = lane_ & 31, hh = lane_ >> 5;
            const int p16 = 8 * ((r >> 2) & 1) + 4 * ((r & 15) >> 3) + (r & 3);
            const int pos0 = (r & 16) + p16, pos1 = 32 + pos0;
            bf16x8 qd[2][2]; f32x16 oacc[2][2]; int row0 = 0;
            if (active) {
                int kk0;
                if (dir == 0) { if (pc < 4) { row0 = NLAT + b * CTXL + pc * 64; kk0 = pc * 64; } else { row0 = b * SEQ + (pc - 4) * 64; kk0 = 256 + (pc - 4) * 64; } }
                else { if (pc < 4) { row0 = NLAT + b * CTXL + (3 - pc) * 64; kk0 = (3 - pc) * 64; } else { row0 = b * SEQ + (35 - pc) * 64; kk0 = 256 + (35 - pc) * 64; } }
#pragma unroll
                for (int ib = 0; ib < 2; ++ib) { const bf16* zr = Z + (size_t)(row0 + 32 * ib + r) * ZW; float al[16]; { const u32x4 a0 = *(const u32x4*)(zr + ZAF + dir * 16), a1 = *(const u32x4*)(zr + ZAF + dir * 16 + 8); float t8[8]; unpack8(a0, t8);
#pragma unroll
                        for (int j = 0; j < 8; ++j) al[j] = t8[j];
                        unpack8(a1, t8);
#pragma unroll
                        for (int j = 0; j < 8; ++j) al[8 + j] = t8[j]; }
#pragma unroll
                    for (int ks = 0; ks < 2; ++ks) { float za[8]; { const f32x4 b0 = *(const LAS f32x4*)(wtab + 512 + 16 * ks + 8 * hh), b1 = *(const LAS f32x4*)(wtab + 512 + 16 * ks + 8 * hh + 4);
                            za[0] = b0.x; za[1] = b0.y; za[2] = b0.z; za[3] = b0.w; za[4] = b1.x; za[5] = b1.y; za[6] = b1.z; za[7] = b1.w; }
#pragma unroll
                        for (int j = 0; j < 16; ++j) { const f32x4 w0 = *(const LAS f32x4*)(wtab + j * 32 + 16 * ks + 8 * hh), w1 = *(const LAS f32x4*)(wtab + j * 32 + 16 * ks + 8 * hh + 4);
                            za[0] = fmaf(al[j], w0.x, za[0]); za[1] = fmaf(al[j], w0.y, za[1]); za[2] = fmaf(al[j], w0.z, za[2]); za[3] = fmaf(al[j], w0.w, za[3]);
                            za[4] = fmaf(al[j], w1.x, za[4]); za[5] = fmaf(al[j], w1.y, za[5]); za[6] = fmaf(al[j], w1.z, za[6]); za[7] = fmaf(al[j], w1.w, za[7]); }
                        float la[8];
#pragma unroll
                        for (int e = 0; e < 8; ++e) la[e] = (fminf(za[e], 0.f) - __logf(1.f + __expf(-fabsf(za[e])))) * 0.0625f;
                        *(LAS f32x4*)(LA + (32 * ib + r) * 36 + 16 * ks + 8 * hh) = (f32x4){la[0], la[1], la[2], la[3]}; *(LAS f32x4*)(LA + (32 * ib + r) * 36 + 16 * ks + 8 * hh + 4) = (f32x4){la[4], la[5], la[6], la[7]}; } }
                lds_wait();
                u32x4 qraw[2][2], kraw[2][2];
#pragma unroll
                for (int ib = 0; ib < 2; ++ib) { const bf16* zr = Z + (size_t)(row0 + 32 * ib + r) * ZW;
#pragma unroll
                    for (int ks = 0; ks < 2; ++ks) { qraw[ib][ks] = *(const u32x4*)(zr + ZQ + h * 32 + 16 * ks + 8 * hh); kraw[ib][ks] = *(const u32x4*)(zr + ZK + h * 32 + 16 * ks + 8 * hh); } }
                { float bend; float v[32], s = 0.f;
#pragma unroll
                  for (int qq = 0; qq < 32; ++qq) { const int q = 32 * hh + qq, i = dir ? 63 - q : q; v[qq] = LA[i * 36 + r]; s += v[qq]; }
                  const auto sw = __builtin_amdgcn_permlane32_swap(__float_as_uint(s), __float_as_uint(s), false, false);
                  const float h0 = __uint_as_float(sw[0]), h1 = __uint_as_float(sw[1]); bend = h0 + h1;
                  float run = hh ? h0 : 0.f;
#pragma unroll
                  for (int qq = 0; qq < 32; ++qq) { const int q = 32 * hh + qq, i = dir ? 63 - q : q; run += v[qq]; LA[i * 36 + r] = run; }
                  if (hh == 0) DD[w * 32 + r] = __expf(bend); }
                lds_wait();
                bf16x8 vt[2][4];
#pragma unroll
                for (int db = 0; db < 2; ++db)
#pragma unroll
                    for (int s4 = 0; s4 < 4; ++s4) vt[db][s4] = *(const bf16x8*)(GVT + ((size_t)(b * 4 + h) * 64 + 32 * db + r) * 2304 + kk0 + 16 * s4 + 8 * hh);
                bf16x8 ki[2][2];
#pragma unroll
                for (int ib = 0; ib < 2; ++ib) {
#pragma unroll
                    for (int ks = 0; ks < 2; ++ks) { const int dk0 = 16 * ks + 8 * hh; float q8[8], k8[8], b8[8]; unpack8(qraw[ib][ks], q8); unpack8(kraw[ib][ks], k8);
                        { const f32x4 x0 = *(const LAS f32x4*)(LA + (32 * ib + r) * 36 + dk0), x1 = *(const LAS f32x4*)(LA + (32 * ib + r) * 36 + dk0 + 4); b8[0] = x0.x; b8[1] = x0.y; b8[2] = x0.z; b8[3] = x0.w; b8[4] = x1.x; b8[5] = x1.y; b8[6] = x1.z; b8[7] = x1.w; }
                        float qo[8], ko[8];
#pragma unroll
                        for (int e = 0; e < 8; ++e) { const float eb = __expf(b8[e]), ieb = 1.f / eb; qo[e] = q8[e] * 0.17677669529663687f * eb; ko[e] = k8[e] * ieb;
                            *(LAS bf16*)(KTT + ((dk0 + e) * 72 + (ib ? pos1 : pos0)) * 2) = f2bf(ko[e] * DD[w * 32 + dk0 + e]); }
                        u32x4 wq, wk; wq.x = pk2(qo[0], qo[1]); wq.y = pk2(qo[2], qo[3]); wq.z = pk2(qo[4], qo[5]); wq.w = pk2(qo[6], qo[7]); wk.x = pk2(ko[0], ko[1]); wk.y = pk2(ko[2], ko[3]); wk.z = pk2(ko[4], ko[5]); wk.w = pk2(ko[6], ko[7]);
                        qd[ib][ks] = __builtin_bit_cast(bf16x8, wq); ki[ib][ks] = __builtin_bit_cast(bf16x8, wk); } }
                f32x16 zero16;
#pragma unroll
                for (int i = 0; i < 16; ++i) zero16[i] = 0.f;
                f32x16 a00 = __builtin_amdgcn_mfma_f32_32x32x16_bf16(ki[0][0], qd[0][0], zero16, 0, 0, 0); a00 = __builtin_amdgcn_mfma_f32_32x32x16_bf16(ki[0][1], qd[0][1], a00, 0, 0, 0);
                f32x16 a11 = __builtin_amdgcn_mfma_f32_32x32x16_bf16(ki[1][0], qd[1][0], zero16, 0, 0, 0); a11 = __builtin_amdgcn_mfma_f32_32x32x16_bf16(ki[1][1], qd[1][1], a11, 0, 0, 0);
                f32x16 aof;
                if (dir == 0) { aof = __builtin_amdgcn_mfma_f32_32x32x16_bf16(ki[0][0], qd[1][0], zero16, 0, 0, 0); aof = __builtin_amdgcn_mfma_f32_32x32x16_bf16(ki[0][1], qd[1][1], aof, 0, 0, 0); }
                else { aof = __builtin_amdgcn_mfma_f32_32x32x16_bf16(ki[1][0], qd[0][0], zero16, 0, 0, 0); aof = __builtin_amdgcn_mfma_f32_32x32x16_bf16(ki[1][1], qd[0][1], aof, 0, 0, 0); }
#pragma unroll
                for (int i = 0; i < 16; ++i) { const int j = (i & 3) + 8 * (i >> 2) + 4 * hh; const bool keep = dir ? (j >= r) : (j <= r); a00[i] = keep ? a00[i] : 0.f; a11[i] = keep ? a11[i] : 0.f; }
#define GLA_P(X, s) ({ u32x4 w_; w_.x = pk2((X)[8 * (s)], (X)[8 * (s) + 1]); w_.y = pk2((X)[8 * (s) + 2], (X)[8 * (s) + 3]); w_.z = pk2((X)[8 * (s) + 4], (X)[8 * (s) + 5]); w_.w = pk2((X)[8 * (s) + 6], (X)[8 * (s) + 7]); __builtin_bit_cast(bf16x8, w_); })
                const bf16x8 p00a = GLA_P(a00, 0), p00b = GLA_P(a00, 1), p11a = GLA_P(a11, 0), p11b = GLA_P(a11, 1), pofa = GLA_P(aof, 0), pofb = GLA_P(aof, 1);
#pragma unroll
                for (int db = 0; db < 2; ++db) {
                    f32x16 o0 = __builtin_amdgcn_mfma_f32_32x32x16_bf16(vt[db][0], p00a, zero16, 0, 0, 0); o0 = __builtin_amdgcn_mfma_f32_32x32x16_bf16(vt[db][1], p00b, o0, 0, 0, 0);
                    f32x16 o1 = __builtin_amdgcn_mfma_f32_32x32x16_bf16(vt[db][2], p11a, zero16, 0, 0, 0); o1 = __builtin_amdgcn_mfma_f32_32x32x16_bf16(vt[db][3], p11b, o1, 0, 0, 0);
                    if (dir == 0) { o1 = __builtin_amdgcn_mfma_f32_32x32x16_bf16(vt[db][0], pofa, o1, 0, 0, 0); o1 = __builtin_amdgcn_mfma_f32_32x32x16_bf16(vt[db][1], pofb, o1, 0, 0, 0); }
                    else { o0 = __builtin_amdgcn_mfma_f32_32x32x16_bf16(vt[db][2], pofa, o0, 0, 0, 0); o0 = __builtin_amdgcn_mfma_f32_32x32x16_bf16(vt[db][3], pofb, o0, 0, 0, 0); }
                    oacc[db][0] = o0; oacc[db][1] = o1; }
#undef GLA_P
                lds_wait();
                bf16x8 kf[4];
#pragma unroll
                for (int s4 = 0; s4 < 4; ++s4) kf[s4] = *(const LAS bf16x8*)(KTT + (r * 72 + 16 * s4 + 8 * hh) * 2);
#pragma unroll
                for (int db = 0; db < 2; ++db) { f32x16 uu = __builtin_amdgcn_mfma_f32_32x32x16_bf16(vt[db][0], kf[0], zero16, 0, 0, 0);
#pragma unroll
                    for (int s4 = 1; s4 < 4; ++s4) uu = __builtin_amdgcn_mfma_f32_32x32x16_bf16(vt[db][s4], kf[s4], uu, 0, 0, 0);
#pragma unroll
                    for (int i = 0; i < 16; ++i) LA[(32 * db + (i & 3) + 8 * (i >> 2) + 4 * hh) * 32 + r] = uu[i]; }
            }
            __syncthreads();
            const int dv2 = tid >> 3, dk4 = (tid & 7) * 4;
            f32x4 ur[8], dr[8];
#pragma unroll
            for (int cc = 0; cc < 8; ++cc) { ur[cc] = *(const LAS f32x4*)((LAS float*)(c.lds + 8192 + cc * 13824) + dv2 * 32 + dk4); dr[cc] = *(const LAS f32x4*)(DD + cc * 32 + dk4); }
            __syncthreads();
#pragma unroll
            for (int cc = 0; cc < 8; ++cc) if (gi * 8 + cc < 36) { u32x2 sp; sp.x = pk2(Sst[0], Sst[1]); sp.y = pk2(Sst[2], Sst[3]); *(LAS u32x2*)(c.lds + 8192 + cc * 13824 + (dv2 * 40 + dk4) * 2) = sp;
                Sst[0] = fmaf(dr[cc].x, Sst[0], ur[cc].x); Sst[1] = fmaf(dr[cc].y, Sst[1], ur[cc].y); Sst[2] = fmaf(dr[cc].z, Sst[2], ur[cc].z); Sst[3] = fmaf(dr[cc].w, Sst[3], ur[cc].w); }
            __syncthreads();
            if (active) {
#pragma unroll
                for (int db = 0; db < 2; ++db) { const bf16x8 s0 = *(const LAS bf16x8*)(RW + ((32 * db + r) * 40 + 8 * hh) * 2), s1 = *(const LAS bf16x8*)(RW + ((32 * db + r) * 40 + 16 + 8 * hh) * 2);
#pragma unroll
                    for (int ib = 0; ib < 2; ++ib) { oacc[db][ib] = __builtin_amdgcn_mfma_f32_32x32x16_bf16(s0, qd[ib][0], oacc[db][ib], 0, 0, 0); oacc[db][ib] = __builtin_amdgcn_mfma_f32_32x32x16_bf16(s1, qd[ib][1], oacc[db][ib], 0, 0, 0); } }
#pragma unroll
                for (int ib = 0; ib < 2; ++ib) { bf16* orow = OG + ((size_t)dir * NTOK + row0 + 32 * ib + r) * 256 + h * 64 + 4 * hh;
#pragma unroll
                    for (int db = 0; db < 2; ++db)
#pragma unroll
                        for (int g4 = 0; g4 < 4; ++g4) { u32x2 wv; wv.x = pk2(oacc[db][ib][4 * g4], oacc[db][ib][4 * g4 + 1]); wv.y = pk2(oacc[db][ib][4 * g4 + 2], oacc[db][ib][4 * g4 + 3]); *(u32x2*)(orow + 32 * db + 8 * g4) = wv; } }
                lds_wait();
            }
        }
    }
    __syncthreads();
}
__device__ __forceinline__ void phase_gla_final(const Ctx& c, KParams p, int l, int nrows) {
    const bf16* Z = (const bf16*)(c.ws + WS_Z); const bf16* OG = (const bf16*)(c.ws + WS_T1); unsigned char* MIX = c.ws + WS_MIX;
    const int gw = c.blk * NWAVES + c.wave, NGW = c.G * NWAVES; const f32x4 g = *(const f32x4*)(p->in[I_GLAG] + l * 256 + 4 * c.lane);
    for (int r0 = gw; r0 < nrows; r0 += 4 * NGW) {
        u32x2 of[4], ob[4], rg[4];
#pragma unroll
        for (int k = 0; k < 4; ++k) { const int r = r0 + k * NGW; of[k] = ob[k] = rg[k] = (u32x2){0u, 0u};
            if (r < nrows) { of[k] = *(const u32x2*)(OG + (size_t)r * 256 + 4 * c.lane); ob[k] = *(const u32x2*)(OG + ((size_t)NTOK + r) * 256 + 4 * c.lane); rg[k] = *(const u32x2*)(Z + (size_t)r * ZW + ZR + 4 * c.lane); } }
#pragma unroll
        for (int k = 0; k < 4; ++k) { const int r = r0 + k * NGW;
            f32x4 o = (f32x4){__uint_as_float(of[k].x << 16) + __uint_as_float(ob[k].x << 16), __uint_as_float(of[k].x & 0xffff0000u) + __uint_as_float(ob[k].x & 0xffff0000u),
                              __uint_as_float(of[k].y << 16) + __uint_as_float(ob[k].y << 16), __uint_as_float(of[k].y & 0xffff0000u) + __uint_as_float(ob[k].y & 0xffff0000u)};
            float ss = (o.x * o.x + o.y * o.y) + (o.z * o.z + o.w * o.w);
            ss += shx<1>(ss); ss += shx<2>(ss); ss += shx<4>(ss); ss += shx<8>(ss);
            const float rstd = rsqrtf(ss * (1.f / 64.f) + EPS);
            const float g0 = __uint_as_float(rg[k].x << 16), g1 = __uint_as_float(rg[k].x & 0xffff0000u), g2 = __uint_as_float(rg[k].y << 16), g3 = __uint_as_float(rg[k].y & 0xffff0000u);
            const float r16 = rstd * 16.f; const unsigned w = pk4_fp8(o.x * r16 * g.x * siluf_(g0), o.y * r16 * g.y * siluf_(g1), o.z * r16 * g.z * siluf_(g2), o.w * r16 * g.w * siluf_(g3));
            if (r < nrows) *(unsigned*)(MIX + (size_t)r * DM + 4 * c.lane) = w; }
    }
}

__device__ __forceinline__ void phase_conv1(const Ctx& c, KParams p, int l, bool with_ctx) {
    const bf16* Z = (const bf16*)(c.ws + WS_Z); bf16* CV = (bf16*)(c.ws + WS_CV);
    constexpr int TT = 64, HR = TT + 30;
    LAS float* glu = (LAS float*)c.lds;
    LAS float* dws = glu + HR * 256;
    for (int i = c.tid; i < 31 * 256; i += NTHR) dws[i] = p->in[I_CDW][(size_t)l * 31 * 256 + i];
    const int ntiles = with_ctx ? 1024 + 128 : 1024;
    const f32x4 dwb = *(const f32x4*)(p->in[I_CDB] + l * 256 + 4 * c.lane), lg = *(const f32x4*)(p->in[I_CLG] + l * 256 + 4 * c.lane), lb = *(const f32x4*)(p->in[I_CLB] + l * 256 + 4 * c.lane);
    for (int tile = c.blk; tile < ntiles; tile += c.G) {
        int rowbase, t0, slen;
        if (tile < 1024) { const int b = tile >> 5; rowbase = b * SEQ; t0 = (tile & 31) * TT; slen = SEQ; } else { const int q = tile - 1024, b = q >> 2; rowbase = NLAT + b * CTXL; t0 = (q & 3) * TT; slen = CTXL; }
        __syncthreads();
        u32x2 ra[12], rg[12];
#pragma unroll
        for (int k = 0; k < 12; ++k) { const int idx = c.tid + k * NTHR, j = idx >> 6, c4 = (idx & 63) * 4, t = t0 - 15 + j; ra[k] = (u32x2){0u, 0u}; rg[k] = (u32x2){0u, 0u};
            if (idx < HR * 64 && t >= 0 && t < slen) { const bf16* zr = Z + (size_t)(rowbase + t) * ZW; ra[k] = *(const u32x2*)(zr + ZCA + c4); rg[k] = *(const u32x2*)(zr + ZCG + c4); } }
#pragma unroll
        for (int k = 0; k < 12; ++k) { const int idx = c.tid + k * NTHR, j = idx >> 6, c4 = (idx & 63) * 4; f32x4 v;
            v.x = __uint_as_float(ra[k].x << 16) * sigmoidf_(__uint_as_float(rg[k].x << 16)); v.y = __uint_as_float(ra[k].x & 0xffff0000u) * sigmoidf_(__uint_as_float(rg[k].x & 0xffff0000u));
            v.z = __uint_as_float(ra[k].y << 16) * sigmoidf_(__uint_as_float(rg[k].y << 16)); v.w = __uint_as_float(ra[k].y & 0xffff0000u) * sigmoidf_(__uint_as_float(rg[k].y & 0xffff0000u));
            if (idx < HR * 64) *(LAS f32x4*)(glu + j * 256 + c4) = v; }
        __syncthreads();
        for (int q = 0; q < 8; ++q) { const int i = c.wave * 8 + q; f32x4 a = dwb;
#pragma unroll
            for (int j = 0; j < 31; ++j) a += *(const LAS f32x4*)(glu + (i + j) * 256 + 4 * c.lane) * *(const LAS f32x4*)(dws + j * 256 + 4 * c.lane);
            const float mu = wave_sum((a.x + a.y) + (a.z + a.w)) * (1.f / 256.f); const f32x4 dlt = a - mu;
            const float var = wave_sum((dlt.x * dlt.x + dlt.y * dlt.y) + (dlt.z * dlt.z + dlt.w * dlt.w)) * (1.f / 256.f); const float rstd = rsqrtf(var + EPS);
            const f32x4 y = dlt * rstd * lg + lb;
            u32x2 w; w.x = pk2(siluf_(y.x), siluf_(y.y)); w.y = pk2(siluf_(y.z), siluf_(y.w));
            *(u32x2*)(CV + (size_t)(rowbase + t0 + i) * 256 + 4 * c.lane) = w; }
    }
    __syncthreads();
}

__device__ __forceinline__ void phase_s5_carry(const Ctx& c, int l) {
    const bf16* XE = (const bf16*)(c.ws + WS_Y5); bf16* UP = (bf16*)(c.ws + WS_UP); const float* S5P = (const float*)(c.ws + WS_S5P);
    for (int i = c.blk * NTHR + c.tid; i < NB * 2 * 16 * 64; i += c.G * NTHR) {
        const int pp = i & 63, g = (i >> 6) & 15, dir = (i >> 10) & 1, b = i >> 11;
        const float* PW = S5P + ((size_t)((l * 2 + dir) * 16 + g) * 64 + pp) * 34 + 32; const float ar = PW[0], ai = PW[1];
        const size_t rbase = (size_t)g * 4608 + (size_t)b * 144; float xr = 0.f, xi = 0.f;
        for (int s0 = 0; s0 < 144; s0 += 8) {
            float er[8], ei[8];
#pragma unroll
            for (int q = 0; q < 8; ++q) { const int s = s0 + q; const int ci = dir == 0 ? s : (s < 16 ? 15 - s : 159 - s); const bf16* xe = XE + (rbase + ci) * 256 + dir * 128 + pp; er[q] = bf2f(xe[0]); ei[q] = bf2f(xe[64]); }
#pragma unroll
            for (int q = 0; q < 8; ++q) { const int s = s0 + q; const int ci = dir == 0 ? s : (s < 16 ? 15 - s : 159 - s); bf16* up = UP + (rbase + ci) * 512 + 256 + dir * 128 + pp; up[0] = f2bf(xr); up[64] = f2bf(xi);
                const float nr = ar * xr - ai * xi + er[q], ni = ar * xi + ai * xr + ei[q]; xr = nr; xi = ni; }
        }
    }
}

__device__ __forceinline__ void phase_mla_prep(const Ctx& c, KParams p) {
    const bf16* Z = (const bf16*)(c.ws + WS_Z); float* RS = (float*)(c.ws + WS_RS); bf16* Kb = (bf16*)(c.ws + WS_H) + (size_t)NTOK * 384; const float* ROPE = (const float*)(c.ws + WS_TAB + TAB_ROPE);
    const int gw = c.blk * NWAVES + c.wave, NGW = c.G * NWAVES, lane = c.lane, d = lane & 31;
    for (int r0 = gw; r0 < NTOK; r0 += 4 * NGW) {
        u32x2 q4[4]; unsigned k2[4]; bf16 xr[4]; f32x2 cs[4];
#pragma unroll
        for (int k = 0; k < 4; ++k) { const int r = r0 + k * NGW; q4[k] = (u32x2){0u, 0u}; k2[k] = 0u; xr[k] = 0; cs[k] = (f32x2){1.f, 0.f};
            if (r < NTOK) { const bf16* zr = Z + (size_t)r * ZW; q4[k] = *(const u32x2*)(zr + ZCQ + 4 * lane); k2[k] = *(const unsigned*)(zr + ZCKV + 2 * lane); xr[k] = zr[ZKR + d];
                if (r < NLAT) cs[k] = *(const f32x2*)(ROPE + (((r & 2047) * 2 + (d >> 4)) * 8 + (d & 7)) * 2); } }
#pragma unroll
        for (int k = 0; k < 4; ++k) { const int r = r0 + k * NGW;
            const float a0 = __uint_as_float(q4[k].x << 16), a1 = __uint_as_float(q4[k].x & 0xffff0000u), a2 = __uint_as_float(q4[k].y << 16), a3 = __uint_as_float(q4[k].y & 0xffff0000u);
            const float b0 = __uint_as_float(k2[k] << 16), b1 = __uint_as_float(k2[k] & 0xffff0000u);
            const float sq = wave_sum((a0 * a0 + a1 * a1) + (a2 * a2 + a3 * a3)), sk = wave_sum(b0 * b0 + b1 * b1);
            const float x = bf2f(xr[k]); const float px = shx<8>(x);
            const float o = (d & 8) ? fmaf(x, cs[k].x, px * cs[k].y) : fmaf(x, cs[k].x, -px * cs[k].y);
            if (r < NTOK) { if (lane == 0) { RS[(size_t)r * 2] = rsqrtf(sq * (1.f / 256.f) + EPS); RS[(size_t)r * 2 + 1] = rsqrtf(sk * (1.f / 128.f) + EPS); }
                const bf16 ob = f2bf(o); bf16* kr = Kb + (size_t)r * 384 + 64 + d; if (lane < 32) { kr[0] = ob; kr[96] = ob; kr[192] = ob; kr[288] = ob; } } }
    }
}
__device__ __forceinline__ void phase_attn(const Ctx& c, bool with_ctx) {
    const bf16* Qb = (const bf16*)(c.ws + WS_H); const bf16* Kb = Qb + (size_t)NTOK * 384; const bf16* VT = Kb + (size_t)NTOK * 384; unsigned char* MIX = c.ws + WS_MIX;
    constexpr int KROW = 208, VROW = 144, KBUF = 64 * KROW, VBUF = 64 * VROW;
    LAS unsigned char* Kt = c.lds; LAS unsigned char* Vt = c.lds + 2 * KBUF;
    const int lane = c.lane, ln = lane & 31, hh = lane >> 5, tid = c.tid;
    const int nunits = with_ctx ? 1152 : 1024;
    for (int L = c.blk; L < nunits; L += c.G) {
        int u = L;
        if (c.G == 256 && L < 1024) { const int r = L >> 8, x = L & 7, j = (L & 255) >> 3; u = ((r * 32 + x * 4 + (j >> 3)) << 3) | (j & 7); }
        int b, h, qrow0, kt0, nkt;
        if (u < 1024) { b = u >> 5; h = (u >> 3) & 3; qrow0 = b * SEQ + (u & 7) * 256; kt0 = 0; nkt = 36; } else { const int q = u - 1024; b = q >> 2; h = q & 3; qrow0 = NLAT + b * CTXL; kt0 = 32; nkt = 4; }
        const bf16* vtb = VT + (size_t)((b * 4 + h) * 64) * 2304;
        bf16x8 qf[6];
        { const bf16* qr = Qb + (size_t)(qrow0 + 32 * c.wave + ln) * 384 + h * 96 + 8 * hh;
#pragma unroll
          for (int ks = 0; ks < 6; ++ks) qf[ks] = *(const bf16x8*)(qr + 16 * ks); }
        if (u < 1024) {
            const float* ROPE = (const float*)(c.ws + WS_TAB + TAB_ROPE) + (size_t)((qrow0 + 32 * c.wave + ln) & 2047) * 32;
#pragma unroll
            for (int ax = 0; ax < 2; ++ax) { const u32x4 own = __builtin_bit_cast(u32x4, qf[4 + ax]); u32x4 oth, res;
#pragma unroll
                for (int i = 0; i < 4; ++i) { const auto sw = __builtin_amdgcn_permlane32_swap(own[i], own[i], false, false); oth[i] = hh ? sw[0] : sw[1]; }
#pragma unroll
                for (int i = 0; i < 4; ++i) { const f32x4 cs = *(const f32x4*)(ROPE + ax * 16 + 4 * i);
                    const float v0 = __uint_as_float(own[i] << 16), v1 = __uint_as_float(own[i] & 0xffff0000u), p0 = __uint_as_float(oth[i] << 16), p1 = __uint_as_float(oth[i] & 0xffff0000u);
                    const float sg = hh ? 1.f : -1.f; res[i] = pk2(fmaf(v0, cs.x, sg * p0 * cs.y), fmaf(v1, cs.z, sg * p1 * cs.w)); }
                qf[4 + ax] = __builtin_bit_cast(bf16x8, res); } }
        f32x16 oacc[2];
#pragma unroll
        for (int i = 0; i < 16; ++i) { oacc[0][i] = 0.f; oacc[1][i] = 0.f; }
        float mrun = 0.f, lsum = 0.f;
        const int k0key = tid / 12, k0pt = tid % 12, k1key = (512 + tid) / 12, k1pt = (512 + tid) % 12; const bool k1on = tid < 256;
        u32x4 sk0, sk1 = (u32x4){0u, 0u, 0u, 0u}, sv;
        auto key_row = [&](int kt, int j) -> int { const int kk = kt * 64 + j; return kk < 2048 ? b * SEQ + kk : NLAT + b * CTXL + (kk - 2048); };
#define ATT_LOAD(kt) do { sk0 = *(const u32x4*)(Kb + (size_t)key_row((kt), k0key) * 384 + h * 96 + k0pt * 8); if (k1on) sk1 = *(const u32x4*)(Kb + (size_t)key_row((kt), k1key) * 384 + h * 96 + k1pt * 8); \
        sv = *(const u32x4*)(vtb + (size_t)(tid >> 3) * 2304 + (kt) * 64 + (tid & 7) * 8); } while (0)
#define ATT_STORE(buf) do { *(LAS u32x4*)(Kt + (buf) * KBUF + k0key * KROW + k0pt * 16) = sk0; if (k1on) *(LAS u32x4*)(Kt + (buf) * KBUF + k1key * KROW + k1pt * 16) = sk1; \
        *(LAS u32x4*)(Vt + (buf) * VBUF + (tid >> 3) * VROW + (tid & 7) * 16) = sv; } while (0)
        __syncthreads();
        ATT_LOAD(kt0); ATT_STORE(0);
        __syncthreads();
        for (int it = 0; it < nkt; ++it) {
            const int cur = it & 1;
            if (it + 1 < nkt) ATT_LOAD(kt0 + it + 1);
            f32x16 sacc[2];
            const float nm = -mrun;
#pragma unroll
            for (int kb = 0; kb < 2; ++kb) {
#pragma unroll
                for (int i = 0; i < 16; ++i) sacc[kb][i] = nm;
#pragma unroll
                for (int ks = 0; ks < 6; ++ks) { const bf16x8 a = *(const LAS bf16x8*)(Kt + cur * KBUF + (32 * kb + ln) * KROW + ks * 32 + hh * 16);
                    sacc[kb] = __builtin_amdgcn_mfma_f32_32x32x16_bf16(a, qf[ks], sacc[kb], 0, 0, 0); } }
            float mx = fmaxf(fmaxf(sacc[0][0], sacc[0][1]), sacc[0][2]);
#pragma unroll
            for (int i = 3; i < 15; i += 2) mx = fmaxf(fmaxf(mx, sacc[0][i]), sacc[0][i + 1]);
            mx = fmaxf(mx, sacc[0][15]);
#pragma unroll
            for (int i = 0; i < 16; i += 2) mx = fmaxf(fmaxf(mx, sacc[1][i]), sacc[1][i + 1]);
            { const auto r = __builtin_amdgcn_permlane32_swap(__float_as_uint(mx), __float_as_uint(mx), false, false); mx = fmaxf(__uint_as_float(r[0]), __uint_as_float(r[1])); }
            if (it == 0 || __builtin_amdgcn_ballot_w64(mx > 8.0f) != 0ull) {
                const float up = it == 0 ? mx : fmaxf(mx, 0.f), alpha = __builtin_amdgcn_exp2f(-up); mrun += up; lsum *= alpha;
#pragma unroll
                for (int i = 0; i < 16; ++i) { oacc[0][i] *= alpha; oacc[1][i] *= alpha; sacc[0][i] -= up; sacc[1][i] -= up; }
            }
            float ps = 0.f;
#pragma unroll
            for (int kb = 0; kb < 2; ++kb)
#pragma unroll
                for (int i = 0; i < 16; ++i) { const float pv = __builtin_amdgcn_exp2f(sacc[kb][i]); sacc[kb][i] = pv; ps += pv; }
            lsum += ps;
            bf16x8 pb[4];
#pragma unroll
            for (int s4 = 0; s4 < 4; ++s4) { const int kb = s4 >> 1, o8 = 8 * (s4 & 1); u32x4 w;
                w.x = pk2(sacc[kb][o8 + 0], sacc[kb][o8 + 1]); w.y = pk2(sacc[kb][o8 + 2], sacc[kb][o8 + 3]); w.z = pk2(sacc[kb][o8 + 4], sacc[kb][o8 + 5]); w.w = pk2(sacc[kb][o8 + 6], sacc[kb][o8 + 7]);
                pb[s4] = __builtin_bit_cast(bf16x8, w); }
#pragma unroll
            for (int db = 0; db < 2; ++db)
#pragma unroll
                for (int s4 = 0; s4 < 4; ++s4) { const bf16x8 a = *(const LAS bf16x8*)(Vt + cur * VBUF + (32 * db + ln) * VROW + s4 * 32 + hh * 16);
                    oacc[db] = __builtin_amdgcn_mfma_f32_32x32x16_bf16(a, pb[s4], oacc[db], 0, 0, 0); }
            if (it + 1 < nkt) ATT_STORE(cur ^ 1);
            __syncthreads();
        }
#undef ATT_LOAD
#undef ATT_STORE
        { const auto r = __builtin_amdgcn_permlane32_swap(__float_as_uint(lsum), __float_as_uint(lsum), false, false); lsum = __uint_as_float(r[0]) + __uint_as_float(r[1]); }
        const float inv = 16.f / lsum;
        unsigned char* dst = MIX + (size_t)(qrow0 + 32 * c.wave + ln) * DM + 768 + h * 64 + 4 * hh;
#pragma unroll
        for (int db = 0; db < 2; ++db)
#pragma unroll
            for (int g4 = 0; g4 < 4; ++g4) *(unsigned*)(dst + 32 * db + 8 * g4) = pk4_fp8(oacc[db][4 * g4] * inv, oacc[db][4 * g4 + 1] * inv, oacc[db][4 * g4 + 2] * inv, oacc[db][4 * g4 + 3] * inv);
    }
    __syncthreads();
}

__device__ __forceinline__ void phase_norm2_route(const Ctx& c, KParams p, int l, int ntok) {
    const float* MOD = (const float*)(c.ws + WS_MOD) + (size_t)l * 33 * 6144;
    const float* xl = l == 0 ? p->in[I_X] : p->out; const float* xc = l == 0 ? p->in[I_CTX] : (const float*)(c.ws + WS_XC);
    bf16* H = (bf16*)(c.ws + WS_H);
    int* TKEP = (int*)(c.ws + WS_RT + RT_TKEP); float* TKW = (float*)(c.ws + WS_RT + RT_TKW); int* TB = (int*)(c.ws + WS_TB);
    int* CNT = (int*)(c.ws + WS_CTL) + CW_CNT + l * NCH * NE;
    constexpr int HROW = 1032;
    LAS bf16* hhi = (LAS bf16*)c.lds;
    LAS bf16* hlo = hhi + 32 * HROW;
    LAS float* lgs = (LAS float*)(c.lds + 132096);
    LAS int* hist = (LAS int*)(c.lds + 140288);
    const bf16* Whi = (const bf16*)(c.ws + WS_TAB + TAB_RWT) + (size_t)(l * 2) * 65536; const bf16* Wlo = Whi + 65536;
    const float rbias = p->in[I_RB][l * 64 + c.lane];
    const int ntiles = ntok / 32, rpc = ntok / NCH, lane = c.lane, mb = c.wave >> 2, nb = c.wave & 3;
    for (int tile = c.blk; tile < ntiles; tile += c.G) {
        __syncthreads();
        if (c.tid < 64) hist[c.tid] = 0;
        for (int q = 0; q < 4; ++q) { const int r = tile * 32 + c.wave * 4 + q; const float* xr = r < NLAT ? xl + (size_t)r * DM : xc + (size_t)(r - NLAT) * DM; const float* m = MOD + (size_t)mod_row(r) * 6144;
            float* xo = r < NLAT ? p->out + (size_t)r * DM : (float*)(c.ws + WS_XC) + (size_t)(r - NLAT) * DM;
            f32x4 v[4]; norm_row_add(xr, (const bf16*)(c.ws + WS_Z) + (size_t)r * DM, xo, p->in[I_N2G] + l * DM, m + 3072, m + 4096, c.ws + WS_H8 + (size_t)r * DM, lane, v);
#pragma unroll
            for (int j = 0; j < 4; ++j) { u32x2 hi; hi.x = pk2(v[j].x, v[j].y); hi.y = pk2(v[j].z, v[j].w);
                const float r0 = v[j].x - __uint_as_float(hi.x << 16), r1 = v[j].y - __uint_as_float(hi.x & 0xffff0000u), r2 = v[j].z - __uint_as_float(hi.y << 16), r3 = v[j].w - __uint_as_float(hi.y & 0xffff0000u);
                u32x2 lo; lo.x = pk2(r0, r1); lo.y = pk2(r2, r3);
                *(LAS u32x2*)(hhi + (c.wave * 4 + q) * HROW + 4 * lane + 256 * j) = hi; *(LAS u32x2*)(hlo + (c.wave * 4 + q) * HROW + 4 * lane + 256 * j) = lo; } }
        __syncthreads();
        { f32x4 acc = (f32x4){0.f, 0.f, 0.f, 0.f};
          const LAS bf16* ah = hhi + (mb * 16 + (lane & 15)) * HROW + 8 * (lane >> 4); const LAS bf16* al = hlo + (mb * 16 + (lane & 15)) * HROW + 8 * (lane >> 4);
          const bf16* bh = Whi + (size_t)(nb * 16 + (lane & 15)) * 1024 + 8 * (lane >> 4); const bf16* bl = Wlo + (size_t)(nb * 16 + (lane & 15)) * 1024 + 8 * (lane >> 4);
#pragma unroll 8
          for (int ks = 0; ks < 32; ++ks) { const bf16x8 a_h = *(const LAS bf16x8*)(ah + 32 * ks), a_l = *(const LAS bf16x8*)(al + 32 * ks), b_h = *(const bf16x8*)(bh + 32 * ks), b_l = *(const bf16x8*)(bl + 32 * ks);
              acc = __builtin_amdgcn_mfma_f32_16x16x32_bf16(a_h, b_h, acc, 0, 0, 0); acc = __builtin_amdgcn_mfma_f32_16x16x32_bf16(a_h, b_l, acc, 0, 0, 0); acc = __builtin_amdgcn_mfma_f32_16x16x32_bf16(a_l, b_h, acc, 0, 0, 0); }
#pragma unroll
          for (int i = 0; i < 4; ++i) lgs[(mb * 16 + 4 * (lane >> 4) + i) * 64 + nb * 16 + (lane & 15)] = acc[i]; }
        __syncthreads();
#pragma unroll
        for (int q = 0; q < 4; ++q) {
            const int r = tile * 32 + c.wave * 4 + q;
            const float s = sigmoidf_(lgs[(c.wave * 4 + q) * 64 + lane]), bs = s + rbias;
            float m1 = bs; m1 = fmaxf(m1, shx<1>(m1)); m1 = fmaxf(m1, shx<2>(m1)); m1 = fmaxf(m1, shx<4>(m1));
            const unsigned long long eq = __ballot(bs == m1); const unsigned gm = (unsigned)(eq >> (lane & 56)) & 0xffu; const int first = __ffs(gm) - 1;
            float m2 = ((lane & 7) == first) ? -1e30f : bs; m2 = fmaxf(m2, shx<1>(m2)); m2 = fmaxf(m2, shx<2>(m2)); m2 = fmaxf(m2, shx<4>(m2));
            const float gs = m1 + m2; const int g = lane >> 3; int rank = 0;
#pragma unroll
            for (int j = 0; j < 8; ++j) { const float o = rdl(gs, 8 * j); rank += (o > gs || (o == gs && j < g)) ? 1 : 0; }
            float cand = rank < 4 ? bs : -1e30f; int my_e = 0; float my_w = 0.f, wsum = 0.f;
#pragma unroll
            for (int k = 0; k < 8; ++k) { const float mm = wave_max(cand); const unsigned long long e2 = __ballot(cand == mm); const int idx = __ffsll((long long)e2) - 1; const float wk = rdl(s, idx);
                if (lane == idx) cand = -1e30f; if (lane == k) { my_e = idx; my_w = wk; } wsum += wk; }
            if (lane < 8) { const int lp = atomicAdd((int*)&hist[my_e], 1); TKEP[(size_t)r * 8 + lane] = my_e | (lp << 8); TKW[(size_t)r * 8 + lane] = my_w / wsum * 2.5f; }
        }
        __syncthreads();
        if (c.tid < 64) { const int n = hist[c.tid]; int base = 0; if (n > 0) base = atomicAdd(&CNT[((tile * 32) / rpc) * NE + c.tid], n); TB[tile * 64 + c.tid] = base; }
    }
    __syncthreads();
}
__device__ __forceinline__ void phase_route_fill(const Ctx& c, int l, int ntok) {
    const int* TKEP = (const int*)(c.ws + WS_RT + RT_TKEP); int* SLOT = (int*)(c.ws + WS_RT + RT_SLOT); const int* TB = (const int*)(c.ws + WS_TB);
    const int* CNT = (const int*)(c.ws + WS_CTL) + CW_CNT + l * NCH * NE; int* ROWL = (int*)(c.ws + WS_ROWL);
    LAS int* est = (LAS int*)c.lds;
    const int rpc = ntok / NCH;
    __syncthreads();
    if (c.tid < NCH) { int s = 0; for (int e = 0; e < NE; ++e) { est[c.tid * 65 + e] = s; s += (CNT[c.tid * NE + e] + 255) & ~255; } est[c.tid * 65 + 64] = s; }
    __syncthreads();
    const size_t na = (size_t)ntok * 8;
    for (size_t a = (size_t)c.blk * NTHR + c.tid; a < na; a += (size_t)c.G * NTHR) { const int t = (int)(a >> 3), ch = t / rpc; const int ep = TKEP[a], e = ep & 255, lp = ep >> 8;
        const int slot = est[ch * 65 + e] + TB[(t >> 5) * 64 + e] + lp; SLOT[a] = slot; ROWL[(size_t)ch * RPCMAX + slot] = t; }
    for (int i = c.blk * NTHR + c.tid; i < NCH * NE * 256; i += c.G * NTHR) { const int ch = i >> 14, e = (i >> 8) & 63, j = i & 255; const int n = CNT[ch * NE + e]; const int pad = ((n + 255) & ~255) - n;
        if (j < pad) ROWL[(size_t)ch * RPCMAX + est[ch * 65 + e] + n + j] = ch * rpc; }
    __syncthreads();
}

__device__ __forceinline__ void moe_tile_table(const Ctx& c, int l, int ch, LAS int* tst) {
    const int* CNT = (const int*)(c.ws + WS_CTL) + CW_CNT + l * NCH * NE + ch * NE;
    LAS unsigned char* texp = (LAS unsigned char*)(tst + 80);
    __syncthreads();
    if (c.tid == 0) { int s = 0; for (int e = 0; e < NE; ++e) { tst[e] = s; s += (CNT[e] + 255) >> 8; } tst[64] = s; }
    __syncthreads();
    if (c.tid < NE) { for (int t = tst[c.tid]; t < tst[c.tid + 1]; ++t) texp[t] = (unsigned char)c.tid; }
    __syncthreads();
}
__device__ __forceinline__ void phase_combine(const Ctx& c, KParams p, int l, int ch, int rpc) {
    const float* MOD = (const float*)(c.ws + WS_MOD) + (size_t)l * 33 * 6144 + 5120; const float* MODn = (const float*)(c.ws + WS_MOD) + (size_t)33 * 6144;
    const int* SLOT = (const int*)(c.ws + WS_RT + RT_SLOT); const float* TKW = (const float*)(c.ws + WS_RT + RT_TKW);
    const unsigned char* OB = (const unsigned char*)(c.ws + WS_OB); const bf16* OBS = (const bf16*)(c.ws + WS_OBS);
    float* xl = p->out; float* xc = (float*)(c.ws + WS_XC); bf16* H = (bf16*)(c.ws + WS_H);
    const int gw = c.blk * NWAVES + c.wave, NGW = c.G * NWAVES, lane = c.lane;
    const int col0 = (lane >> 4) * 256 + ((lane >> 2) & 3) * 32 + (lane & 3) * 8;
    f32x4 gn[4];
#pragma unroll
    for (int q = 0; q < 4; ++q) gn[q] = *(const f32x4*)((l == 0 ? p->in[I_N1G] + DM : p->in[I_FG]) + col0 + 128 * (q >> 1) + 4 * (q & 1));
    int sl_n = 0; float w_n = 0.f;
    if (gw < rpc && lane < 8) { sl_n = SLOT[(size_t)(ch * rpc + gw) * 8 + lane]; w_n = TKW[(size_t)(ch * rpc + gw) * 8 + lane] * 0.0625f; }
    for (int i = gw; i < rpc; i += NGW) {
        const int t = ch * rpc + i; float* xr = t < NLAT ? xl + (size_t)t * DM : xc + (size_t)(t - NLAT) * DM; const int mr = mod_row(t); const float* g2 = MOD + (size_t)mr * 6144;
        const int sl = sl_n; const float w = w_n;
        u32x4 ob[8], os0, os1; f32x4 xv[4];
#pragma unroll
        for (int e = 0; e < 8; ++e) ob[e] = *(const u32x4*)(OB + (size_t)rdli(sl, e) * 1024 + lane * 16);
        os0 = *(const u32x4*)(OBS + (size_t)i * DM + col0); os1 = *(const u32x4*)(OBS + (size_t)i * DM + col0 + 128);
#pragma unroll
        for (int q = 0; q < 4; ++q) xv[q] = *(const f32x4*)(xr + col0 + 128 * (q >> 1) + 4 * (q & 1));
        if (i + NGW < rpc && lane < 8) { sl_n = SLOT[(size_t)(t + NGW) * 8 + lane]; w_n = TKW[(size_t)(t + NGW) * 8 + lane] * 0.0625f; }
        float a[16]; { float t8[8]; unpack8(os0, t8);
#pragma unroll
            for (int q = 0; q < 8; ++q) a[q] = t8[q];
            unpack8(os1, t8);
#pragma unroll
            for (int q = 0; q < 8; ++q) a[8 + q] = t8[q]; }
#pragma unroll
        for (int e = 0; e < 8; ++e) { const float wk = rdl(w, e);
#pragma unroll
            for (int q = 0; q < 4; ++q) { const f32x2 lo = __builtin_amdgcn_cvt_pk_f32_fp8((int)ob[e][q], false), hi = __builtin_amdgcn_cvt_pk_f32_fp8((int)ob[e][q], true);
                a[4 * q] = fmaf(wk, lo.x, a[4 * q]); a[4 * q + 1] = fmaf(wk, lo.y, a[4 * q + 1]); a[4 * q + 2] = fmaf(wk, hi.x, a[4 * q + 2]); a[4 * q + 3] = fmaf(wk, hi.y, a[4 * q + 3]); } }
        f32x4 xn[4]; float ss = 0.f;
#pragma unroll
        for (int q = 0; q < 4; ++q) { const int cc = col0 + 128 * (q >> 1) + 4 * (q & 1); const f32x4 gv = *(const f32x4*)(g2 + cc);
            xn[q] = xv[q] + gv * (f32x4){a[4 * q], a[4 * q + 1], a[4 * q + 2], a[4 * q + 3]}; ss += (xn[q].x * xn[q].x + xn[q].y * xn[q].y) + (xn[q].z * xn[q].z + xn[q].w * xn[q].w); }
        const float rstd = rsqrtf(wave_sum(ss) * (1.f / 1024.f) + EPS);
        if (l == 0) { const float* mn = MODn + (size_t)mr * 6144; bf16* hr = H + (size_t)t * DM;
#pragma unroll
            for (int q = 0; q < 4; ++q) { const int cc = col0 + 128 * (q >> 1) + 4 * (q & 1); *(f32x4*)(xr + cc) = xn[q];
                const f32x4 s0 = *(const f32x4*)(mn + cc), s1 = *(const f32x4*)(mn + 1024 + cc); const f32x4 hv = xn[q] * rstd * gn[q] * (s1 + 1.0f) + s0;
                u32x2 o; o.x = pk2(hv.x, hv.y); o.y = pk2(hv.z, hv.w); *(u32x2*)(hr + cc) = o; } }
        else {
#pragma unroll
            for (int q = 0; q < 4; ++q) { const int cc = col0 + 128 * (q >> 1) + 4 * (q & 1); *(f32x4*)(xr + cc) = xn[q] * rstd * gn[q]; } }
    }
}
constexpr int LDS_BYTES = 147456;
constexpr int LDS_TAB = 131072, LDS_XB = LDS_BYTES - 16;
enum { J_INPROJ = 0, J_S5G1, J_PW, J_Q, J_KV, J_S5G2, J_GLU, J_OUT, J_GU, J_GUS, J_DN, J_DNS };
enum { SK_DENSE = 0, SK_S5, SK_MOE };
enum { EK_INPROJ = 0, EK_S5X, EK_S5Y, EK_BIAS, EK_GLU, EK_Q, EK_KV, EK_RESID, EK_SWIGLU, EK_OB8, EK_BF16 };
struct JSched {
    int sk, G, c; pg8::DenseOrder d; const char* W; size_t wexp, wtile; const LAS unsigned char* texp; int ntile, npn;
    __device__ __forceinline__ bool next(int i, pg8::Unit& u) const {
        if (sk == SK_DENSE) return d.next(i, u);
        const int L = i * G + c;
        if (sk == SK_S5) { if (L >= 288) return false; u.pm = L; u.pn = 0; u.e = L / 18; u.B = W + (size_t)u.e * wexp; return true; }
        if (L >= ntile * npn) return false;
        const int T = npn == 2 ? (L >> 1) : (L >> 2), pn = L & (npn - 1); const int e = __builtin_amdgcn_readfirstlane((int)texp[T]);
        u.pm = T; u.pn = pn; u.e = e; u.B = W + (size_t)e * wexp + (size_t)pn * wtile; return true;
    }
};
struct JRows { const int* list; unsigned ldab;
    __device__ __forceinline__ unsigned off(const pg8::Unit& u, int r) const { const int row = u.pm * 256 + r; return (unsigned)(list ? list[row] : row) * ldab; } };
struct JEpi {
    int ek; void* p0; void* p1; void* p2; const void* q0; const void* q1; const void* q2; int i0;
    __device__ __forceinline__ void operator()(EPI_ARGS) const {
        switch (ek) {
        case EK_INPROJ: EpiInProj{(bf16*)p0, (bf16*)p1, (bf16*)p2}(acc, u, wr, wc, fr, fq); break;
        case EK_S5X:    EpiS5X{(bf16*)p0}(acc, u, wr, wc, fr, fq); break;
        case EK_S5Y:    EpiS5Y{(bf16*)p0}(acc, u, wr, wc, fr, fq); break;
        case EK_BIAS:   EpiBiasBf16{(unsigned char*)p0, i0, (const float*)q0}(acc, u, wr, wc, fr, fq); break;
        case EK_GLU:    EpiGluSig{(unsigned char*)p0, i0, (const float*)q0}(acc, u, wr, wc, fr, fq); break;
        case EK_Q:      EpiQ{(bf16*)p0, (const float*)q0}(acc, u, wr, wc, fr, fq); break;
        case EK_KV:     EpiKV{(bf16*)p0, (bf16*)p1, (const float*)q0}(acc, u, wr, wc, fr, fq); break;
        default:        EpiBf16{(bf16*)p0, i0}(acc, u, wr, wc, fr, fq); break;
        }
    }
};
struct JEpi8 {
    int ek; void* p0; int i0; const void* q0;
    __device__ __forceinline__ void operator()(EPI_ARGS) const {
        if (ek == EK_SWIGLU) EpiSwiglu{(unsigned char*)p0, i0, 1.0f / 256.0f}(acc, u, wr, wc, fr, fq);
        else if (ek == EK_OB8) EpiOB8{(unsigned char*)p0, 16.0f / 1024.0f}(acc, u, wr, wc, fr, fq);
        else if (ek == EK_RESID) EpiDelta{(bf16*)p0, (const float*)q0, 1.0f / 1024.0f}(acc, u, wr, wc, fr, fq);
        else EpiBf16S{(bf16*)p0, i0, 1.0f / 1024.0f}(acc, u, wr, wc, fr, fq);
    }
};
__device__ __forceinline__ void gemm_job(KParams p, LAS unsigned char* lds, int job, int l, int ch) {
    unsigned char* ws = p->ws;
    const int G = gridDim.x, blk = blockIdx.x;
    const bool last = (l == 1); const int nrows = last ? NLAT : NTOK, rpc = nrows / NCH;
    unsigned char* sm = ws + WS_WSM + (size_t)l * WSM_L;
    const LAS int* tst = (const LAS int*)(lds + LDS_TAB);
    auto rot8 = [&](int units) { return ((units % G) + 7) & ~7; };
    auto rotc = [&](int rot) { return (blk + G - rot % G) % G; };
    const char* A = nullptr; int K = 256; bool fp8 = false; JSched S; JRows R; JEpi E;
    S.sk = SK_DENSE; S.G = G; S.c = blk; S.W = nullptr; S.wexp = 0; S.wtile = 0; S.texp = (const LAS unsigned char*)(tst + 80); S.ntile = 0; S.npn = 2; S.d.init(1, 1, G, blk, nullptr, 256);
    R.list = nullptr; R.ldab = 512u; E.ek = EK_BF16; E.p0 = E.p1 = E.p2 = nullptr; E.q0 = E.q1 = E.q2 = nullptr; E.i0 = 0;
    switch (job) {
    case J_INPROJ: A = (const char*)(ws + WS_H); K = 1024; R.ldab = 2048u; S.d.init(NTOK / 256, ZW / 256, G, blk, (const bf16*)(ws + WS_WIN) + (size_t)l * 2048 * 1024, 1024);
        E.ek = EK_INPROJ; E.p0 = ws + WS_Z; E.p1 = ws + WS_UP; E.p2 = ws + WS_GVT; break;
    case J_S5G1: A = (const char*)(ws + WS_UP); K = 256; R.ldab = 1024u; S.sk = SK_S5; S.W = (const char*)(ws + WS_S5W) + (size_t)l * 16 * 256 * 256 * 2; S.wexp = (size_t)256 * 256 * 2; E.ek = EK_S5X; E.p0 = ws + WS_Y5; break;
    case J_PW: A = (const char*)(ws + WS_CV); K = 256; R.ldab = 512u; S.d.init(nrows / 256, 1, G, blk, (const bf16*)(sm + WSM_PW), 256); E.ek = EK_BIAS; E.p0 = ws + WS_MIX + 256; E.i0 = DM; E.q0 = p->in[I_CPB] + l * 256; break;
    case J_Q: A = (const char*)(ws + WS_Z) + ZCQ * 2; K = 256; R.ldab = (unsigned)ZW * 2u; S.d.init(NTOK / 256, 2, G, rotc(rot8(nrows / 256)), (const bf16*)(sm + WSM_UQ), 256);
        E.ek = EK_Q; E.p0 = ws + WS_H; E.q0 = ws + WS_RS; break;
    case J_KV: A = (const char*)(ws + WS_Z) + ZCKV * 2; K = 256; R.ldab = (unsigned)ZW * 2u; S.d.init(NTOK / 256, 2, G, rotc(rot8(nrows / 256) + rot8(NTOK / 256 * 2)), (const bf16*)(sm + WSM_UK), 256);
        E.ek = EK_KV; E.p0 = (bf16*)(ws + WS_H) + (size_t)NTOK * 384; E.p1 = (bf16*)(ws + WS_H) + (size_t)NTOK * 768; E.q0 = ws + WS_RS; break;
    case J_S5G2: A = (const char*)(ws + WS_UP); K = 512; R.ldab = 1024u; S.sk = SK_S5; S.W = (const char*)(ws + WS_S5W) + (size_t)32 * 256 * 256 * 2 + (size_t)l * 16 * 256 * 512 * 2; S.wexp = (size_t)256 * 512 * 2; E.ek = EK_S5Y; E.p0 = ws + WS_Y5; break;
    case J_GLU: A = (const char*)(ws + WS_Y5); K = 256; R.ldab = 512u; S.d.init(nrows / 256, 2, G, blk, (const bf16*)(sm + WSM_GLU), 256); E.ek = EK_GLU; E.p0 = ws + WS_MIX + 512; E.i0 = DM; E.q0 = p->in[I_S5GB] + l * 512; break;
    case J_OUT: A = (const char*)(ws + WS_MIX); K = 512; fp8 = true; R.ldab = 1024u; S.d.init(nrows / 256, 4, G, blk, (const bf16*)(ws + WS_WOUT) + (size_t)l * 1024 * 1024, 512);
        E.ek = EK_RESID; E.p0 = ws + WS_Z; E.q0 = (const float*)(ws + WS_MOD) + (size_t)l * 33 * 6144 + 2048; break;
    case J_GU: A = (const char*)(ws + WS_H8); K = 512; fp8 = true; R.list = (const int*)(ws + WS_ROWL) + (size_t)ch * RPCMAX; R.ldab = 1024u; S.sk = SK_MOE; S.ntile = __builtin_amdgcn_readfirstlane(tst[64]); S.npn = 2; S.W = (const char*)(ws + WS_WMOE) + (size_t)l * 48 * MiB; S.wexp = (size_t)512 * 1024; S.wtile = (size_t)256 * 1024;
        E.ek = EK_SWIGLU; E.p0 = ws + WS_HB; E.i0 = 256; break;
    case J_GUS: A = (const char*)(ws + WS_H8) + (size_t)ch * rpc * 1024; K = 512; fp8 = true; R.ldab = 1024u; S.d.init(rpc / 256, 2, G, rotc(rot8(__builtin_amdgcn_readfirstlane(tst[64]) * 2)), (const bf16*)((const unsigned char*)(ws + WS_WSH) + (size_t)l * (512 * 1024 + 1024 * 256) * 2), 512); E.ek = EK_SWIGLU; E.p0 = ws + WS_HBS; E.i0 = 256; break;
    case J_DN: A = (const char*)(ws + WS_HB); K = 128; fp8 = true; R.ldab = 256u; S.sk = SK_MOE; S.ntile = __builtin_amdgcn_readfirstlane(tst[64]); S.npn = 4; S.W = (const char*)(ws + WS_WMOE) + (size_t)l * 48 * MiB + (size_t)NE * 512 * 1024; S.wexp = (size_t)1024 * 256; S.wtile = (size_t)256 * 256;
        E.ek = EK_OB8; E.p0 = ws + WS_OB; break;
    default: A = (const char*)(ws + WS_HBS); K = 128; fp8 = true; R.ldab = 256u; S.d.init(rpc / 256, 4, G, rotc(rot8(__builtin_amdgcn_readfirstlane(tst[64]) * 4)), (const bf16*)((const unsigned char*)(ws + WS_WSH) + (size_t)l * (512 * 1024 + 1024 * 256) * 2 + 512 * 1024), 128); E.ek = EK_BF16; E.p0 = ws + WS_OBS; E.i0 = DM; break;
    }
    __builtin_amdgcn_s_waitcnt(0x0F70);
    if (fp8) pg8::gemm_phase<true>(lds, A, K, S, R, JEpi8{E.ek, E.p0, E.i0, E.q0});
    else pg8::gemm_phase<false>(lds, A, K, S, R, E);
}


__global__ void __launch_bounds__(NTHR, 2) fwd_kernel(Params pk) {
    extern __shared__ __attribute__((aligned(16))) unsigned char lds_raw[];
    LAS unsigned char* const lds0 = (LAS unsigned char*)lds_raw;
    if (threadIdx.x < 4) ((LAS unsigned*)(lds0 + LDS_XB))[threadIdx.x] = 0u;
    __syncthreads();
    (void)xcd_barrier_post((unsigned*)(pk.ws + WS_CTL) + CW_BAR, (volatile LAS unsigned*)(lds0 + LDS_XB));
    constexpr int NSTEP = 15 + 6 * NCH;
#ifndef PROBE_DUP
#define PROBE_DUP (-9)
#endif
#pragma unroll 1
    for (int it_ = -2; it_ < 2 * NSTEP + (PROBE_DUP >= 0 ? 2 : 0); ++it_) {
        int gs = it_; if (PROBE_DUP >= 0) { if (it_ > PROBE_DUP) gs -= 1; if (it_ > NSTEP + PROBE_DUP + 1) gs -= 1; }
        KParams p = fresh_params(); Ctx c; { int t_ = threadIdx.x; asm volatile("" : "+v"(t_)); c.lds = lds0; c.tid = t_; c.lane = t_ & 63; c.wave = __builtin_amdgcn_readfirstlane(t_ >> 6); c.blk = blockIdx.x; c.G = gridDim.x; c.ws = p->ws; }
        LAS int* tst = (LAS int*)(c.lds + LDS_TAB);
        int l = 0, s = gs, ch = 0, job = -1; bool seam = true;
        if (gs >= 0) { l = gs >= NSTEP ? 1 : 0; s = gs - l * NSTEP; if (s >= 15) { ch = (s - 15) / 6; s = 15 + (s - 15) % 6; } }
        const bool last = (l == 1); const int nrows = last ? NLAT : NTOK, rpc = nrows / NCH;
        switch (s) {
        case -2: prologue(c, p); break;
        case -1: prologue2(c, p); phase_norm1(c, p, 0); break;
        case 0: seam = false; break;
        case 1: job = J_INPROJ; break;
        case 2: phase_gla(c, p, l); phase_conv1(c, p, l, !last); phase_mla_prep(c, p); seam = false; break;
        case 3: job = J_S5G1; break;
        case 4: phase_gla_final(c, p, l, nrows); seam = false; break;
        case 5: job = J_PW; seam = false; break;
        case 6: job = J_Q; seam = false; break;
        case 7: job = J_KV; seam = false; break;
        case 8: phase_s5_carry(c, l); break;
        case 9: phase_attn(c, !last); seam = false; break;
        case 10: job = J_S5G2; break;
        case 11: job = J_GLU; break;
        case 12: job = J_OUT; break;
        case 13: phase_norm2_route(c, p, l, nrows); break;
        case 14: phase_route_fill(c, l, nrows); break;
        case 15: moe_tile_table(c, l, ch, tst); job = J_GU; seam = false; break;
        case 16: job = J_GUS; break;
        case 17: job = J_DN; seam = false; break;
        case 18: job = J_DNS; break;
        case 19: phase_combine(c, p, l, ch, rpc); break;
        default: seam = false; break;
        }
        if (job >= 0) gemm_job(p, c.lds, job, l, ch);
        if (seam && gs + 1 < 2 * NSTEP) { XcdBarrier b_; b_.bar = (unsigned*)(p->ws + WS_CTL) + CW_BAR; b_.x = xb_xcc_id(); b_.st = (volatile LAS unsigned*)(lds0 + LDS_XB); xcd_barrier(b_); }
    }
}

extern "C" void kernel_launch(void* const* d_in, const int* in_sizes, int n_in, void* d_out, int out_size, void* d_ws, size_t ws_size, hipStream_t stream) {
    static int grid = 0;
    if (grid == 0) {
        if (n_in != 42 || out_size != NLAT * DM || ws_size < WS_END) { fprintf(stderr, "kernel_launch: unexpected shapes (n_in %d out %d ws %zu)\n", n_in, out_size, ws_size); grid = -1; return; }
        int dev = 0, cus = 0;
        if (hipGetDevice(&dev) != hipSuccess || hipDeviceGetAttribute(&cus, hipDeviceAttributeMultiprocessorCount, dev) != hipSuccess) { grid = -1; return; }
        if (hipFuncSetAttribute((const void*)fwd_kernel, hipFuncAttributeMaxDynamicSharedMemorySize, LDS_BYTES) != hipSuccess) { fprintf(stderr, "kernel_launch: hipFuncSetAttribute failed\n"); grid = -1; return; }
        int per_cu = 0;
        if (hipOccupancyMaxActiveBlocksPerMultiprocessor(&per_cu, (const void*)fwd_kernel, NTHR, LDS_BYTES) != hipSuccess || per_cu < 1) fprintf(stderr, "kernel_launch: occupancy query reports %d\n", per_cu);
        (void)hipGetLastError();
        grid = cus;
    }
    if (grid < 0) return;
    (void)hipMemsetAsync((char*)d_ws + WS_CTL, 0, CTL_BYTES, stream);
    Params p{};
    for (int i = 0; i < 42; ++i) p.in[i] = (const float*)d_in[i];
    p.out = (float*)d_out; p.ws = (unsigned char*)d_ws; p.ph_lo = 0; p.ph_hi = 1 << 20;
    hipLaunchKernelGGL(fwd_kernel, dim3(grid), dim3(NTHR), LDS_BYTES, stream, p);
}
```

```cpp
#include <hip/hip_runtime.h>
#include <cstdio>
#include <cstdint>

#define LAS __attribute__((address_space(3)))
typedef unsigned short bf16;
typedef short bf16x8 __attribute__((ext_vector_type(8)));
typedef float f32x4 __attribute__((ext_vector_type(4)));
typedef float f32x2 __attribute__((ext_vector_type(2)));
typedef float f32x16 __attribute__((ext_vector_type(16)));
typedef unsigned u32x4 __attribute__((ext_vector_type(4)));
typedef unsigned u32x2 __attribute__((ext_vector_type(2)));
typedef int i32x4 __attribute__((ext_vector_type(4)));
typedef int i32x8 __attribute__((ext_vector_type(8)));

constexpr int NB = 32, SEQ = 2048, CTXL = 256, DM = 1024;
constexpr int NLAT = NB * SEQ, NCTX = NB * CTXL, NTOK = NLAT + NCTX;
constexpr int ZW = 2048;
constexpr int ZQ = 0, ZK = 128, ZV = 256, ZR = 512, ZCA = 768, ZCG = 1024, ZS5 = 1280, ZCQ = 1536, ZCKV = 1792, ZKR = 1920, ZAF = 1952, ZAB = 1968;
constexpr int NE = 64, TOPK = 8;
constexpr int NCH = 2;
constexpr int RPCMAX = (NTOK / NCH) * 8 + 64 * 256;
constexpr float EPS = 1e-6f;
constexpr int NWAVES = 8, NTHR = 512;

constexpr size_t MiB = (size_t)1 << 20;
constexpr size_t WS_CTL = 0, CTL_BYTES = 1 * MiB;
constexpr size_t WS_MOD = 1 * MiB;
constexpr size_t WS_TAB = 3 * MiB;
constexpr size_t WS_WSM = 5 * MiB;
constexpr size_t WS_WIN = 8 * MiB;
constexpr size_t WS_WOUT = 16 * MiB;
constexpr size_t WS_WSH = 20 * MiB;
constexpr size_t WS_TB = 23 * MiB;
constexpr size_t WS_RT = 24 * MiB;
constexpr size_t WS_ROWL = 32 * MiB;
constexpr size_t WS_RS = 35 * MiB;
constexpr size_t WS_WMOE = 36 * MiB;
constexpr size_t WS_XC = 132 * MiB;
constexpr size_t WS_H = 164 * MiB;
constexpr size_t WS_H8 = WS_H + 72 * MiB;
constexpr size_t WS_Z = 308 * MiB;
constexpr size_t WS_MIX = 596 * MiB;
constexpr size_t WS_T1 = 740 * MiB;
constexpr size_t WS_UP = 812 * MiB;
constexpr size_t WS_CV = 884 * MiB;
constexpr size_t WS_Y5 = 920 * MiB;
constexpr size_t WS_S5W = 956 * MiB;
constexpr size_t WS_S5P = 968 * MiB;
constexpr size_t WS_GVT = 969 * MiB;
constexpr size_t WS_END = 1005 * MiB;
constexpr size_t WS_HB = WS_Z;
constexpr size_t WS_HBS = WS_Z + 152 * MiB;
constexpr size_t WS_OBS = WS_Z + 170 * MiB;
constexpr size_t WS_OB = WS_MIX;
static_assert((size_t)RPCMAX * 512 <= 152 * MiB && WS_OBS + (size_t)(NTOK / NCH) * 2048 <= WS_MIX && WS_OB + (size_t)RPCMAX * 1024 <= WS_S5W, "MoE overlays");
constexpr int CW_BAR = 0;
constexpr int CW_CNT = 4096;
constexpr size_t WSM_L = 1 * MiB;
constexpr size_t WSM_PW = 0, WSM_GLU = 128 * 1024, WSM_UQ = 384 * 1024, WSM_UK = 640 * 1024, WSM_UV = 768 * 1024;
constexpr size_t TAB_ROPE = 0;
constexpr size_t TAB_S5 = 256 * 1024;
constexpr size_t TAB_RWT = 1536 * 1024;
constexpr size_t RT_TKEP = 0, RT_TKW = 2400000, RT_SLOT = 4800000;

__device__ __forceinline__ float bf2f(bf16 v) { return __uint_as_float(((unsigned)v) << 16); }
typedef __bf16 bf16x2_t __attribute__((ext_vector_type(2)));
__device__ __forceinline__ unsigned pk2(float lo, float hi) { const f32x2 v = {lo, hi}; return __builtin_bit_cast(unsigned, __builtin_convertvector(v, bf16x2_t)); }
__device__ __forceinline__ bf16 f2bf(float f) { return __builtin_bit_cast(unsigned short, (__bf16)f); }
template <int O> __device__ __forceinline__ float shx(float v) {
    return __int_as_float(__builtin_amdgcn_ds_swizzle(__float_as_int(v), (O << 10) | 0x1f)); }
__device__ __forceinline__ float rdl(float v, int l) { return __int_as_float(__builtin_amdgcn_readlane(__float_as_int(v), l)); }
__device__ __forceinline__ int rdli(int v, int l) { return __builtin_amdgcn_readlane(v, l); }
__device__ __forceinline__ float wave_sum(float v) {
    v += shx<1>(v); v += shx<2>(v); v += shx<4>(v); v += shx<8>(v); v += shx<16>(v);
    const auto r = __builtin_amdgcn_permlane32_swap(__float_as_uint(v), __float_as_uint(v), false, false);
    return __uint_as_float(r[0]) + __uint_as_float(r[1]);
}
__device__ __forceinline__ float wave_max(float v) {
    v = fmaxf(v, shx<1>(v)); v = fmaxf(v, shx<2>(v)); v = fmaxf(v, shx<4>(v)); v = fmaxf(v, shx<8>(v)); v = fmaxf(v, shx<16>(v));
    const auto r = __builtin_amdgcn_permlane32_swap(__float_as_uint(v), __float_as_uint(v), false, false);
    return fmaxf(__uint_as_float(r[0]), __uint_as_float(r[1]));
}
__device__ __forceinline__ float sigmoidf_(float x) { return 1.0f / (1.0f + __expf(-x)); }
__device__ __forceinline__ float siluf_(float x) { return x / (1.0f + __expf(-x)); }
__device__ __forceinline__ void unpack8(const u32x4 w, float (&v)[8]) {
    v[0] = __uint_as_float(w.x << 16); v[1] = __uint_as_float(w.x & 0xffff0000u);
    v[2] = __uint_as_float(w.y << 16); v[3] = __uint_as_float(w.y & 0xffff0000u);
    v[4] = __uint_as_float(w.z << 16); v[5] = __uint_as_float(w.z & 0xffff0000u);
    v[6] = __uint_as_float(w.w << 16); v[7] = __uint_as_float(w.w & 0xffff0000u);
}
__device__ __forceinline__ void lds_wait() { asm volatile("s_waitcnt lgkmcnt(0)" ::: "memory"); }

#define XB_TMO      128
#define XB_XCNT(j)  (256  + 64 * (j))
#define XB_XSUB(j)  (1280 + 64 * (j))
#define XB_XGEN(j)  (2304 + 64 * (j))
#define XB_TOP      3328
#define XB_TOPGEN   3392
#define XCD_BAR_WORDS 3456
#define XB_SPIN_CAP (1u << 22)
__device__ __forceinline__ unsigned xb_ld(unsigned* p)              { return __hip_atomic_load(p, __ATOMIC_RELAXED, __HIP_MEMORY_SCOPE_AGENT); }
__device__ __forceinline__ unsigned xb_add(unsigned* p, unsigned v) { return __hip_atomic_fetch_add(p, v, __ATOMIC_RELAXED, __HIP_MEMORY_SCOPE_AGENT); }
__device__ __forceinline__ unsigned xb_xcc_id() { return (unsigned)__builtin_amdgcn_s_getreg((3 << 11) | 20) & 0xFu; }
#define XB_SPIN(cond, bar) do { unsigned _sp = 0; while (cond) { __builtin_amdgcn_s_sleep(1); \
    if ((++_sp & 255u) == 0u) { if (xb_ld(&(bar)[XB_TMO])) break; if (_sp > XB_SPIN_CAP) { atomicAdd(&(bar)[XB_TMO], 1u); break; } } } } while (0)
struct XcdBarrier { unsigned* bar; unsigned x; volatile LAS unsigned* st; };
__device__ __forceinline__ XcdBarrier xcd_barrier_post(unsigned* bar, volatile LAS unsigned* st) {
    XcdBarrier b; b.bar = bar; b.x = xb_xcc_id(); b.st = st;
    if (threadIdx.x == 0) (void)xb_add(&bar[XB_XCNT(b.x)], 1u);
    return b;
}
__device__ __forceinline__ void xcd_barrier_complete(unsigned* bar, unsigned x, unsigned& nloc, unsigned& nx) {
    const unsigned G = gridDim.x * gridDim.y * gridDim.z;
    unsigned sum, cnt, mine, sp = 0u;
    for (;;) {
        sum = 0u; cnt = 0u; mine = 0u;
#pragma unroll
        for (unsigned j = 0; j < 16; ++j) { const unsigned c = xb_ld(&bar[XB_XCNT(j)]); sum += c; cnt += (c > 0u) ? 1u : 0u; mine = (j == x) ? c : mine; }
        if (sum == G) break;
        __builtin_amdgcn_s_sleep(1);
        if ((++sp & 255u) == 0u) { if (xb_ld(&bar[XB_TMO])) break; if (sp > XB_SPIN_CAP) { atomicAdd(&bar[XB_TMO], 1u); break; } }
    }
    nloc = mine > 0u ? mine : 1u; nx = cnt > 0u ? cnt : 1u;
}
__device__ __forceinline__ void xcd_barrier(const XcdBarrier& b) {
    asm volatile("s_waitcnt vmcnt(0)" ::: "memory");
    __syncthreads();
    if (threadIdx.x == 0) {
        unsigned* bar = b.bar;
        __builtin_amdgcn_s_waitcnt(0);
        unsigned nloc = b.st[0], nx = b.st[1];
        if (nloc == 0u) { xcd_barrier_complete(bar, b.x, nloc, nx); b.st[0] = nloc; b.st[1] = nx; }
        const unsigned old = xb_add(&bar[XB_XSUB(b.x)], 1u);
        const unsigned gen = old / nloc;
        if (old + 1u == (gen + 1u) * nloc) {
            __builtin_amdgcn_fence(__ATOMIC_RELEASE, "agent");
            asm volatile("s_waitcnt vmcnt(0)" ::: "memory");
            const unsigned og = xb_add(&bar[XB_TOP], 1u);
            const unsigned tg = og / nx;
            if (og + 1u == (tg + 1u) * nx) xb_add(&bar[XB_TOPGEN], 1u);
            else XB_SPIN(xb_ld(&bar[XB_TOPGEN]) == tg, bar);
            __builtin_amdgcn_fence(__ATOMIC_ACQUIRE, "agent");
            xb_add(&bar[XB_XGEN(b.x)], 1u);
            asm volatile("s_waitcnt vmcnt(0)" ::: "memory");
        } else {
            XB_SPIN(xb_ld(&bar[XB_XGEN(b.x)]) == gen, bar);
            __builtin_amdgcn_fence(__ATOMIC_ACQUIRE, "agent");
            asm volatile("s_waitcnt vmcnt(0)" ::: "memory");
        }
    }
    __syncthreads();
}

namespace pg8 {
constexpr int BM = 256, BK = 64, HALF = 128, HTB = HALF * BK * 2, STAGE_BYTES = 8 * HTB, NXCD = 8, WGM = 8;
__device__ __forceinline__ int lds_byte(int r, int c) { const int st = (r >> 4) * 2 + (c >> 5), rr = r & 15, cc = c & 31, ob = rr * 64 + cc * 2; return st * 1024 + (ob ^ (((ob >> 9) & 1) << 5)); }
__device__ __forceinline__ void stage_rc(int b, int& R, int& C) { const int st = b / 1024, sb = b % 1024, swz = sb ^ (((sb >> 9) & 1) << 5); R = (st >> 1) * 16 + swz / 64; C = (st & 1) * 32 + (swz % 64) / 2; }
__device__ __forceinline__ int perm32(int rho) { const int n = rho >> 4, i = rho & 15; return 8 * (i >> 2) + 4 * n + (i & 3); }

struct Unit { int pm, pn, e; const char* B; };

struct DenseOrder {
    int nM, nN, nwg, G, c; const char* Bt; size_t btile;
    __device__ __forceinline__ void init(int nM_, int nN_, int G_, int c_, const bf16* Bt_, int K) { nM = nM_; nN = nN_; nwg = nM * nN; G = G_; c = c_; Bt = (const char*)Bt_; btile = (size_t)256 * K * 2; }
    __device__ __forceinline__ bool next(int i, Unit& u) const {
        const long L = (long)i * G + c; if (L >= nwg) return false;
        int wgid = (int)L; { const int q = nwg / NXCD, r = nwg % NXCD, xcd = wgid % NXCD, off = wgid / NXCD; wgid = (xcd < r ? xcd * (q + 1) : r * (q + 1) + (xcd - r) * q) + off; }
        const int nig = WGM * nN, gid = wgid / nig, fm = gid * WGM, gsz = (nM - fm) < WGM ? (nM - fm) : WGM;
        u.pm = fm + ((wgid % nig) % gsz); u.pn = (wgid % nig) / gsz; u.e = 0; u.B = Bt + (size_t)u.pn * btile; return true;
    }
};
struct RowsDense { unsigned ldab; __device__ __forceinline__ unsigned off(const Unit& u, int r) const { return (unsigned)(u.pm * 256 + r) * ldab; } };
struct RowsGather { const int* list; unsigned ldab; __device__ __forceinline__ unsigned off(const Unit& u, int r) const { return (unsigned)list[u.pm * 256 + r] * ldab; } };

template <bool FP8, class Epi, class Sched, class Rows>
__device__ __forceinline__ void gemm_phase(LAS unsigned char* lds, const char* Abase, const int K, const Sched& S, const Rows& RW, const Epi& E) {
    int tid_ = threadIdx.x; asm volatile("" : "+v"(tid_));
    const int tid = tid_, wid = __builtin_amdgcn_readfirstlane(tid >> 6), lane = tid & 63, wr = wid >> 2, wc = wid & 3, fr = lane & 15, fq = lane >> 4;
    const int nt = K / BK;
    int sR[2]; unsigned sC[2], voffB[2];
#pragma unroll
    for (int i = 0; i < 2; ++i) { int R, C; stage_rc(tid * 16 + i * 8192, R, C); sR[i] = R; sC[i] = (unsigned)C * 2u; const int Rb = (R & ~31) + perm32(R & 31); voffB[i] = (unsigned)(Rb * K + C) * 2u; }
    const size_t kstep = (size_t)(BK * 2);
    const size_t hstepB = (size_t)HALF * K * 2;
    const unsigned ldsw = (unsigned)wid * 1024u;
    const int aoff = lds_byte(wr * 64 + fr, fq * 8), boff = lds_byte(wc * 32 + fr, fq * 8);
#define PG8_SA(b, h) (((b) * 2 + (h)) * HTB)
#define PG8_SB(b, h) ((4 + (b) * 2 + (h)) * HTB)
#define PG8_STAGE(bufoff, gbase, voff) do { const char* _gb = (const char*)(gbase); asm volatile("" : "+s"(_gb)); _Pragma("unroll") for (int _i = 0; _i < 2; ++_i) { unsigned _o = (voff)[_i]; asm volatile("" : "+v"(_o)); \
        __builtin_amdgcn_global_load_lds((const unsigned*)(_gb + _o), (LAS unsigned*)(lds + (bufoff) + ldsw + _i * 8192), 16, 0, 0); } } while (0)
#define PG8_LDA(dst, b, h) do { _Pragma("unroll") for (int m = 0; m < 4; ++m) dst[m] = PG8_CAT(*(const LAS i32x4*)(lds + PG8_SA(b, h) + aoff + m * 2048), *(const LAS i32x4*)(lds + PG8_SA(b, h) + aoff + m * 2048 + 1024)); } while (0)
#define PG8_LDB(dst, b, h) do { _Pragma("unroll") for (int n = 0; n < 2; ++n) dst[n] = PG8_CAT(*(const LAS i32x4*)(lds + PG8_SB(b, h) + boff + n * 2048), *(const LAS i32x4*)(lds + PG8_SB(b, h) + boff + n * 2048 + 1024)); } while (0)
#define PG8_CAT(x0, x1) __builtin_shufflevector((x0), (x1), 0, 1, 2, 3, 4, 5, 6, 7)
#define PG8_LO(x) __builtin_bit_cast(bf16x8, __builtin_shufflevector((x), (x), 0, 1, 2, 3))
#define PG8_HI(x) __builtin_bit_cast(bf16x8, __builtin_shufflevector((x), (x), 4, 5, 6, 7))
#define PG8_MMA(ai, bj, At, Bt) do { __builtin_amdgcn_s_setprio(1); \
        if (FP8) { _Pragma("unroll") for (int m = 0; m < 4; ++m) _Pragma("unroll") for (int n = 0; n < 2; ++n) \
            acc[ai][bj][m][n] = __builtin_amdgcn_mfma_scale_f32_16x16x128_f8f6f4(Bt[n], At[m], acc[ai][bj][m][n], 0, 0, 0, 0x7f7f7f7f, 0, 0x7f7f7f7f); } \
        else { _Pragma("unroll") for (int m = 0; m < 4; ++m) _Pragma("unroll") for (int n = 0; n < 2; ++n) { \
            acc[ai][bj][m][n] = __builtin_amdgcn_mfma_f32_16x16x32_bf16(PG8_LO(Bt[n]), PG8_LO(At[m]), acc[ai][bj][m][n], 0, 0, 0); \
            acc[ai][bj][m][n] = __builtin_amdgcn_mfma_f32_16x16x32_bf16(PG8_HI(Bt[n]), PG8_HI(At[m]), acc[ai][bj][m][n], 0, 0, 0); } } \
        __builtin_amdgcn_s_setprio(0); } while (0)
#define PG8_WAIT_V(n) asm volatile("s_waitcnt vmcnt(" #n ")" ::: "memory")
#define PG8_WAIT_L(n) asm volatile("s_waitcnt lgkmcnt(" #n ")" ::: "memory")
#define PG8_BAR __builtin_amdgcn_s_barrier()
#define PG8_SCHED __builtin_amdgcn_sched_barrier(0)
    Unit cur, nxt; int ui = 0;
    if (!S.next(0, cur)) return;
    f32x4 acc[2][2][4][2];
#pragma unroll
    for (int a = 0; a < 2; ++a)
#pragma unroll
        for (int b = 0; b < 2; ++b)
#pragma unroll
            for (int m = 0; m < 4; ++m)
#pragma unroll
                for (int n = 0; n < 2; ++n) acc[a][b][m][n] = (f32x4){0.f, 0.f, 0.f, 0.f};
    i32x8 At[4], B0[2], B1[2];
    unsigned oA0[2], oA1[2];
#pragma unroll
    for (int i = 0; i < 2; ++i) { oA0[i] = RW.off(cur, sR[i]) + sC[i]; oA1[i] = RW.off(cur, HALF + sR[i]) + sC[i]; }
    const char* cB = cur.B;
    PG8_STAGE(PG8_SB(0, 0), cB, voffB); PG8_STAGE(PG8_SB(0, 1), cB + hstepB, voffB); PG8_STAGE(PG8_SA(0, 0), Abase, oA0); PG8_STAGE(PG8_SA(0, 1), Abase, oA1);
    if (wr == 1) PG8_BAR;
    PG8_WAIT_V(2); PG8_BAR;
    PG8_STAGE(PG8_SB(1, 0), cB + kstep, voffB); PG8_STAGE(PG8_SA(1, 0), Abase + kstep, oA0); PG8_STAGE(PG8_SB(1, 1), cB + hstepB + kstep, voffB);
    PG8_WAIT_V(6); PG8_BAR;
    for (;;) {
        const bool has_next = S.next(ui + 1, nxt);
        unsigned gi0 = 0u, gi1 = 0u, gi2 = 0u, gi3 = 0u;
        if (has_next && RW.list) {
            int t2 = threadIdx.x; asm volatile("" : "+v"(t2)); int R0, C0, R1, C1; stage_rc(t2 * 16, R0, C0); stage_rc(t2 * 16 + 8192, R1, C1);
            const int* lb = RW.list + (size_t)nxt.pm * 256; const unsigned o0 = (unsigned)R0 * 4u, o1 = (unsigned)R1 * 4u, o2 = (unsigned)(HALF + R0) * 4u, o3 = (unsigned)(HALF + R1) * 4u;
            asm volatile("global_load_dword %0, %4, %8\n\tglobal_load_dword %1, %5, %8\n\tglobal_load_dword %2, %6, %8\n\tglobal_load_dword %3, %7, %8"
                         : "=&v"(gi0), "=&v"(gi1), "=&v"(gi2), "=&v"(gi3) : "v"(o0), "v"(o1), "v"(o2), "v"(o3), "s"(lb));
        }
#pragma unroll 1
        for (int t = 0; t < nt; t += 2) {
            const bool last = (t == nt - 2);
            const char* a1 = Abase + (size_t)(t + 1) * kstep;
            PG8_LDB(B0, 0, 0); PG8_LDB(B1, 0, 1); PG8_SCHED; PG8_LDA(At, 0, 0); PG8_STAGE(PG8_SA(1, 1), a1, oA1);
            PG8_WAIT_V(8); PG8_WAIT_L(0); PG8_BAR; PG8_MMA(0, 0, At, B0); PG8_MMA(0, 1, At, B1); PG8_BAR; PG8_SCHED;
            const char* a2; const char* b2;
            if (last) {
                if (has_next) {
                    int t2 = threadIdx.x; asm volatile("" : "+v"(t2));
#pragma unroll
                    for (int i = 0; i < 2; ++i) { int R, C; stage_rc(t2 * 16 + i * 8192, R, C);
                        if (RW.list) { asm volatile("" : "+v"(gi0), "+v"(gi1), "+v"(gi2), "+v"(gi3)); oA0[i] = (i ? gi1 : gi0) * RW.ldab + (unsigned)C * 2u; oA1[i] = (i ? gi3 : gi2) * RW.ldab + (unsigned)C * 2u; }
                        else { oA0[i] = (unsigned)(nxt.pm * 256 + R) * RW.ldab + (unsigned)C * 2u; oA1[i] = (unsigned)(nxt.pm * 256 + HALF + R) * RW.ldab + (unsigned)C * 2u; } }
                    cB = nxt.B;
                }
                a2 = Abase; b2 = cB;
            } else { a2 = Abase + (size_t)(t + 2) * kstep; b2 = cB + (size_t)(t + 2) * kstep; }
            const char* a3 = a2 + kstep; const char* b3 = b2 + kstep;
            PG8_LDA(At, 0, 1); PG8_STAGE(PG8_SB(0, 0), b2, voffB); PG8_STAGE(PG8_SB(0, 1), b2 + hstepB, voffB); PG8_STAGE(PG8_SA(0, 0), a2, oA0);
            PG8_WAIT_V(8); PG8_WAIT_L(0); PG8_BAR; PG8_MMA(1, 0, At, B0); PG8_MMA(1, 1, At, B1); PG8_BAR; PG8_SCHED;
            PG8_LDB(B0, 1, 0); PG8_LDB(B1, 1, 1); PG8_SCHED; PG8_LDA(At, 1, 0); PG8_STAGE(PG8_SA(0, 1), a2, oA1);
            PG8_WAIT_V(8); PG8_WAIT_L(0); PG8_BAR; PG8_MMA(0, 0, At, B0); PG8_MMA(0, 1, At, B1); PG8_BAR; PG8_SCHED;
            PG8_LDA(At, 1, 1); PG8_STAGE(PG8_SB(1, 0), b3, voffB); PG8_STAGE(PG8_SB(1, 1), b3 + hstepB, voffB); PG8_STAGE(PG8_SA(1, 0), a3, oA0);
            PG8_WAIT_V(8); PG8_WAIT_L(0); PG8_BAR; PG8_MMA(1, 0, At, B0); PG8_MMA(1, 1, At, B1); PG8_BAR; PG8_SCHED;
        }
        if (wr == 0) PG8_BAR;
        { Unit eu = cur; asm volatile("" : "+s"(eu.pm), "+s"(eu.pn)); int t3 = threadIdx.x; asm volatile("" : "+v"(t3)); E(acc, eu, wr, wc, t3 & 15, (t3 & 63) >> 4); }
        if (!has_next) break;
#pragma unroll
        for (int a = 0; a < 2; ++a)
#pragma unroll
            for (int b = 0; b < 2; ++b)
#pragma unroll
                for (int m = 0; m < 4; ++m)
#pragma unroll
                    for (int n = 0; n < 2; ++n) acc[a][b][m][n] = (f32x4){0.f, 0.f, 0.f, 0.f};
        cur = nxt; ++ui;
        if (wr == 1) PG8_BAR;
    }
    PG8_WAIT_V(0);
    PG8_BAR;
#undef PG8_SA
#undef PG8_SB
#undef PG8_STAGE
#undef PG8_LDA
#undef PG8_LDB
#undef PG8_MMA
#undef PG8_CAT
#undef PG8_LO
#undef PG8_HI
#undef PG8_WAIT_V
#undef PG8_WAIT_L
#undef PG8_BAR
#undef PG8_SCHED
}
}

struct Params { const float* in[42]; float* out; unsigned char* ws; int ph_lo, ph_hi; };
enum { I_X = 0, I_C, I_CTX, I_CCTX, I_ADAW, I_ADAB, I_N1G, I_N2G, I_WIN, I_WOUT, I_GLAW, I_GLAB, I_GLAG, I_CDW, I_CDB, I_CLG, I_CLB, I_CPW, I_CPB,
       I_S5LR, I_S5LI, I_S5DT, I_S5BR, I_S5BI, I_S5CR, I_S5CI, I_S5D, I_S5GW, I_S5GB, I_QNG, I_KVNG, I_WUQ, I_WUKV, I_RW, I_RB, I_MG, I_MU, I_MD, I_SG, I_SU, I_SD, I_FG };

typedef const __attribute__((address_space(4))) Params* KParams;
__device__ __forceinline__ KParams fresh_params() { KParams kp = (KParams)__builtin_amdgcn_kernarg_segment_ptr(); asm volatile("" : "+s"(kp)); return kp; }
struct Ctx {
    LAS unsigned char* lds;
    int tid, lane, wave, blk, G;
    unsigned char* ws;
};

__device__ __forceinline__ int mod_row(int r) { return r < NLAT ? (r >> 11) : 32; }

__device__ __forceinline__ unsigned pk4_fp8(float a, float b, float c2, float d) {
    int pk = __builtin_amdgcn_cvt_pk_fp8_f32(__builtin_amdgcn_fmed3f(a, -440.f, 440.f), __builtin_amdgcn_fmed3f(b, -440.f, 440.f), 0, false);
    pk = __builtin_amdgcn_cvt_pk_fp8_f32(__builtin_amdgcn_fmed3f(c2, -440.f, 440.f), __builtin_amdgcn_fmed3f(d, -440.f, 440.f), pk, true); return (unsigned)pk; }
template <bool F8 = false>
__device__ __forceinline__ void tr_item(const float* W, int ldw, int k0, int n0, bf16* dst, int ldk, const float* kscale, float sc, LAS float* scr, int lane) {
    float tv[32];
#pragma unroll
    for (int i = 0; i < 32; ++i) tv[i] = W[(size_t)(k0 + 2 * i + (lane >> 5)) * ldw + n0 + (lane & 31)];
#pragma unroll
    for (int i = 0; i < 32; ++i) { const int kk = 2 * i + (lane >> 5); float v = tv[i] * sc; if (kscale) v *= kscale[k0 + kk]; scr[kk * 33 + (lane & 31)] = v; }
    lds_wait();
    const int c = lane & 7;
#pragma unroll
    for (int j = 0; j < 4; ++j) { const int n = (lane >> 3) + 8 * j; const LAS float* s = scr + (8 * c) * 33 + n;
        if (F8) { u32x2 o; o.x = pk4_fp8(s[0 * 33], s[1 * 33], s[2 * 33], s[3 * 33]); o.y = pk4_fp8(s[4 * 33], s[5 * 33], s[6 * 33], s[7 * 33]); *(u32x2*)((unsigned char*)dst + (size_t)n * ldk + k0 + 8 * c) = o; }
        else { u32x4 o; o.x = pk2(s[0 * 33], s[1 * 33]); o.y = pk2(s[2 * 33], s[3 * 33]); o.z = pk2(s[4 * 33], s[5 * 33]); o.w = pk2(s[6 * 33], s[7 * 33]);
            *(u32x4*)(dst + (size_t)n * ldk + k0 + 8 * c) = o; } }
    lds_wait();
}
template <int KIND> __device__ __forceinline__ int tr_dst(int n0) {
    if (KIND == 0) return n0;
    if (KIND == 1) return n0 < 768 ? n0 : (n0 == 768 ? 1952 : n0 - 32);
    if (KIND == 2) { const int half = n0 >> 8, c = n0 & 255; return (c >> 7) * 256 + half * 128 + (c & 127); }
    if (KIND == 3) { const int head = n0 / 96, d0 = n0 % 96; return d0 < 64 ? head * 64 + d0 : 256 + head * 32; }
    if (KIND == 4) { const int head = n0 >> 7, d0 = n0 & 127; return d0 < 64 ? head * 64 + d0 : 256 + head * 64 + (d0 - 64); }
    if (KIND == 5) return (n0 >> 7) * 256 + (n0 & 127);
    if (KIND == 6) return (n0 >> 7) * 256 + 128 + (n0 & 127);
    return n0;
}
template <int KIND, bool F8 = false> __device__ __forceinline__ void tr_matrix(const Ctx& c, const float* W, int ldw, int K, int Nsrc, bf16* WT, int ldk, const float* kscale, float sc) {
    LAS float* scr = (LAS float*)(c.lds + c.wave * 8704);
    const int gw = c.blk * NWAVES + c.wave, NGW = c.G * NWAVES, ng = Nsrc / 32, items = (K / 64) * ng;
    for (int it = gw; it < items; it += NGW) { const int kb = it / ng, g = it % ng; tr_item<F8>(W, ldw, kb * 64, 32 * g, F8 ? (bf16*)((unsigned char*)WT + (size_t)tr_dst<KIND>(32 * g) * ldk) : WT + (size_t)tr_dst<KIND>(32 * g) * ldk, ldk, kscale, sc, scr, c.lane); }
}
__device__ __forceinline__ void zero_fill16(const Ctx& c, void* p, size_t bytes) {
    u32x4* q = (u32x4*)p; const size_t n = bytes / 16;
    for (size_t i = (size_t)c.blk * NTHR + c.tid; i < n; i += (size_t)c.G * NTHR) q[i] = (u32x4){0u, 0u, 0u, 0u};
}
__device__ __forceinline__ void sincos_r(float x, float& s, float& co) {
    const float n = rintf(x * 0.15915494309189535f);
    float r = fmaf(n, -6.28125f, x); r = fmaf(n, -1.9353071795864769e-3f, r);
    s = __sinf(r); co = __cosf(r);
}

__device__ __forceinline__ void prologue_moe_weights(const Ctx& c, KParams p, int l) {
    unsigned char* WGU8 = c.ws + WS_WMOE + (size_t)l * 48 * MiB;
    unsigned char* WD8 = WGU8 + (size_t)NE * 512 * 1024;
    LAS float* scr = (LAS float*)(c.lds + c.wave * 8704);
    const int gw = c.blk * NWAVES + c.wave, NGW = c.G * NWAVES;
    for (int it = gw; it < NE * 384; it += NGW) {
        const int e = it / 384, r = it % 384;
        if (r < 256) { const int up = r >> 7, q = r & 127, kb = q >> 3, g = q & 7;
            const float* W = p->in[up ? I_MU : I_MG] + ((size_t)l * NE + e) * 1024 * 256;
            const int nd = up ? tr_dst<6>(32 * g) : tr_dst<5>(32 * g);
            tr_item<true>(W, 256, kb * 64, 32 * g, (bf16*)(WGU8 + (size_t)e * 512 * 1024 + (size_t)nd * 1024), 1024, nullptr, 64.f, scr, c.lane);
        } else { const int q = r - 256, kb = q >> 5, g = q & 31;
            const float* W = p->in[I_MD] + ((size_t)l * NE + e) * 256 * 1024;
            tr_item<true>(W, 1024, kb * 64, 32 * g, (bf16*)(WD8 + (size_t)e * 1024 * 256 + (size_t)(32 * g) * 256), 256, nullptr, 64.f, scr, c.lane);
        }
    }
}

__device__ __forceinline__ void prologue(const Ctx& c, KParams p) {
    float* MOD = (float*)(c.ws + WS_MOD);
    {
        const int u = c.G - 1 - c.blk;
        if (u < 96) {
            LAS float* sc = (LAS float*)(c.lds + 72 * 1024);
            LAS float* part = (LAS float*)c.lds;
            const int l = u / 48, kq = c.tid >> 7, cj = c.tid & 127, col = (u % 48) * 128 + cj;
            const float* W = p->in[I_ADAW] + (size_t)l * 1024 * 6144;
            float acc[33];
#pragma unroll
            for (int b = 0; b < 33; ++b) acc[b] = 0.f;
            for (int j = 0; j < 4; ++j) {
                __syncthreads();
                for (int i = c.tid; i < 4 * 33 * 64; i += NTHR) { const int q = i / (33 * 64), r = i % (33 * 64), b = r >> 6, kk = r & 63, k = 256 * q + 64 * j + kk; const float v = b < 32 ? p->in[I_C][b * 1024 + k] : p->in[I_CCTX][k]; sc[i] = siluf_(v); }
                __syncthreads();
                const float* wp = W + (size_t)(256 * kq + 64 * j) * 6144 + col; const LAS float* sq = sc + kq * 33 * 64;
#pragma unroll 8
                for (int kk = 0; kk < 64; ++kk) { const float w = wp[(size_t)kk * 6144];
#pragma unroll
                    for (int b = 0; b < 33; ++b) acc[b] = fmaf(sq[b * 64 + kk], w, acc[b]); }
            }
#pragma unroll
            for (int b = 0; b < 33; ++b) part[(kq * 33 + b) * 128 + cj] = acc[b];
            __syncthreads();
            for (int i = c.tid; i < 33 * 128; i += NTHR) { const int b = i >> 7, cc = i & 127, gc = (u % 48) * 128 + cc;
                MOD[((size_t)l * 33 + b) * 6144 + gc] = (part[(0 * 33 + b) * 128 + cc] + part[(1 * 33 + b) * 128 + cc]) + (part[(2 * 33 + b) * 128 + cc] + part[(3 * 33 + b) * 128 + cc]) + p->in[I_ADAB][l * 6144 + gc]; }
            __syncthreads();
        }
    }
    {
        float* ROPE = (float*)(c.ws + WS_TAB + TAB_ROPE);
        for (int i = c.blk * NTHR + c.tid; i < 2048 * 16; i += c.G * NTHR) { const int t = i >> 4, ax = (i >> 3) & 1, f = i & 7;
            const float pos = (float)(ax == 0 ? (t >> 6) : (t & 63)); const float inv = __expf(-(float)f * (9.210340371976184f / 8.0f));
            float s, co; sincos_r(pos * inv, s, co); ROPE[i * 2] = co; ROPE[i * 2 + 1] = s; }
        bf16* RWT = (bf16*)(c.ws + WS_TAB + TAB_RWT);
        for (int i = c.blk * NTHR + c.tid; i < 2 * 64 * 1024; i += c.G * NTHR) { const int l = i >> 16, n = (i >> 10) & 63, k = i & 1023; const float wv = p->in[I_RW][((size_t)l * 1024 + k) * 64 + n];
            const bf16 hi = f2bf(wv); RWT[(size_t)(l * 2) * 65536 + n * 1024 + k] = hi; RWT[(size_t)(l * 2 + 1) * 65536 + n * 1024 + k] = f2bf(wv - bf2f(hi)); }
        float* S5T = (float*)(c.ws + WS_TAB + TAB_S5);
        for (int i = c.blk * NTHR + c.tid; i < 2 * 2 * 16 * 64; i += c.G * NTHR) {
            const int pp = i & 63, g = (i >> 6) & 15, ld = i >> 10;
            const float lr = p->in[I_S5LR][i], li = p->in[I_S5LI][i], dt = __expf(p->in[I_S5DT][ld * 16 + g]);
            const float mag = __expf(lr * dt); float s, co; sincos_r(li * dt, s, co);
            const float are = mag * co, aim = mag * s, den = lr * lr + li * li;
            const float fre = ((are - 1.f) * lr + aim * li) / den, fim = (aim * lr - (are - 1.f) * li) / den;
            float* T = S5T + (size_t)i * 66; T[0] = are; T[1] = aim;
            { float* PW = (float*)(c.ws + WS_S5P) + (size_t)i * 34; float pr = 1.f, pi = 0.f;
              for (int e = 0; e <= 16; ++e) { PW[2 * e] = pr; PW[2 * e + 1] = pi; const float nr = pr * are - pi * aim, ni = pr * aim + pi * are; pr = nr; pi = ni; } }
            for (int ch = 0; ch < 16; ++ch) { const float br = p->in[I_S5BR][(size_t)i * 16 + ch], bi = p->in[I_S5BI][(size_t)i * 16 + ch];
                T[2 + ch] = fre * br - fim * bi; T[18 + ch] = fre * bi + fim * br;
                T[34 + ch] = p->in[I_S5CR][((size_t)(ld * 16 + g) * 16 + ch) * 64 + pp]; T[50 + ch] = p->in[I_S5CI][((size_t)(ld * 16 + g) * 16 + ch) * 64 + pp]; }
        }
    }
    for (int l = 0; l < 2; ++l) {
        bf16* WIN = (bf16*)(c.ws + WS_WIN) + (size_t)l * 2048 * 1024;
        tr_matrix<1, true>(c, p->in[I_WIN] + (size_t)l * 1024 * 1984, 1984, 1024, 1984, WIN, 1024, nullptr, 64.f);
        zero_fill16(c, (unsigned char*)WIN + (size_t)1984 * 1024, (size_t)64 * 1024);
        tr_matrix<0, true>(c, p->in[I_WOUT] + (size_t)l * 1024 * 1024, 1024, 1024, 1024, (bf16*)(c.ws + WS_WOUT) + (size_t)l * 1024 * 1024, 1024, nullptr, 64.f);
        unsigned char* sm = c.ws + WS_WSM + (size_t)l * WSM_L;
        tr_matrix<0>(c, p->in[I_CPW] + (size_t)l * 256 * 256, 256, 256, 256, (bf16*)(sm + WSM_PW), 256, nullptr, 1.f);
        tr_matrix<2>(c, p->in[I_S5GW] + (size_t)l * 256 * 512, 512, 256, 512, (bf16*)(sm + WSM_GLU), 256, nullptr, 1.f);
        tr_matrix<3>(c, p->in[I_WUQ] + (size_t)l * 256 * 384, 384, 256, 384, (bf16*)(sm + WSM_UQ), 256, p->in[I_QNG] + l * 256, 0.14724445f  );
        zero_fill16(c, (bf16*)(sm + WSM_UQ) + (size_t)384 * 256, (size_t)128 * 256 * 2);
        zero_fill16(c, sm + WSM_UK, (size_t)512 * 256 * 2);
    }
    for (int l = 0; l < 2; ++l) {
        bf16* WSGU = (bf16*)(c.ws + WS_WSH) + (size_t)l * (512 * 1024 + 1024 * 256); bf16* WSD = WSGU + 512 * 1024;
        tr_matrix<5, true>(c, p->in[I_SG] + (size_t)l * 1024 * 256, 256, 1024, 256, WSGU, 1024, nullptr, 64.f);
        tr_matrix<6, true>(c, p->in[I_SU] + (size_t)l * 1024 * 256, 256, 1024, 256, WSGU, 1024, nullptr, 64.f);
        tr_matrix<0, true>(c, p->in[I_SD] + (size_t)l * 256 * 1024, 1024, 256, 1024, (bf16*)((unsigned char*)WSGU + 512 * 1024), 256, nullptr, 64.f);
    }
    prologue_moe_weights(c, p, 0);
    prologue_moe_weights(c, p, 1);
}
__device__ __forceinline__ void prologue_s5_weights(const Ctx& c, KParams p) {
    const float* S5T = (const float*)(c.ws + WS_TAB + TAB_S5); const float* S5P = (const float*)(c.ws + WS_S5P);
    LAS float* pw = (LAS float*)c.lds;
    LAS float* bb = pw + 2 * 17 * 64 * 2;
    LAS float* cc = bb + 2 * 64 * 16 * 2;
    LAS float* kt = cc + 2 * 16 * 64 * 2;
    for (int u = c.blk; u < 32; u += c.G) {
        const int l = u >> 4, g = u & 15;
        __syncthreads();
        for (int i = c.tid; i < 2 * 64; i += NTHR) { const int dir = i >> 6, pp = i & 63; const size_t row = (size_t)((l * 2 + dir) * 16 + g) * 64 + pp; const float* T = S5T + row * 66; const float* PW = S5P + row * 34;
            for (int e = 0; e <= 16; ++e) { pw[((dir * 17 + e) * 64 + pp) * 2] = PW[2 * e]; pw[((dir * 17 + e) * 64 + pp) * 2 + 1] = PW[2 * e + 1]; }
            for (int ch = 0; ch < 16; ++ch) { bb[((dir * 64 + pp) * 16 + ch) * 2] = T[2 + ch]; bb[((dir * 64 + pp) * 16 + ch) * 2 + 1] = T[18 + ch]; cc[((dir * 16 + ch) * 64 + pp) * 2] = T[34 + ch]; cc[((dir * 16 + ch) * 64 + pp) * 2 + 1] = T[50 + ch]; } }
        __syncthreads();
        for (int i = c.tid; i < 2 * 16 * 256; i += NTHR) { const int dir = i >> 12, tau = (i >> 8) & 15, c1 = (i >> 4) & 15, c0 = i & 15; float s = 0.f;
            for (int pp = 0; pp < 64; ++pp) { const float cr = cc[((dir * 16 + c1) * 64 + pp) * 2], ci = cc[((dir * 16 + c1) * 64 + pp) * 2 + 1], pr = pw[((dir * 17 + tau) * 64 + pp) * 2], pi = pw[((dir * 17 + tau) * 64 + pp) * 2 + 1];
                const float wr_ = cr * pr - ci * pi, wi_ = cr * pi + ci * pr; s += wr_ * bb[((dir * 64 + pp) * 16 + c0) * 2] - wi_ * bb[((dir * 64 + pp) * 16 + c0) * 2 + 1]; }
            kt[i] = s; }
        __syncthreads();
        bf16* B1 = (bf16*)(c.ws + WS_S5W) + (size_t)(l * 16 + g) * 256 * 256;
        bf16* B2 = (bf16*)(c.ws + WS_S5W) + (size_t)32 * 256 * 256 + (size_t)(l * 16 + g) * 256 * 512;
        const float* dsk = p->in[I_S5D] + l * 256 + g * 16;
        for (int i = c.tid; i < 256 * 256; i += NTHR) { const int n = i >> 8, k = i & 255, dir = n >> 7, ri = (n >> 6) & 1, pp = n & 63, s = k >> 4, ch = k & 15, e = dir ? s : 15 - s;
            const float pr = pw[((dir * 17 + e) * 64 + pp) * 2], pi = pw[((dir * 17 + e) * 64 + pp) * 2 + 1], br = bb[((dir * 64 + pp) * 16 + ch) * 2], bi = bb[((dir * 64 + pp) * 16 + ch) * 2 + 1];
            B1[i] = f2bf(ri ? pr * bi + pi * br : pr * br - pi * bi); }
        for (int i = c.tid; i < 256 * 512; i += NTHR) { const int n = i >> 9, k = i & 511, t = n >> 4, c1 = n & 15; float v;
            if (k < 256) { const int s = k >> 4, c0 = k & 15; v = 0.f; if (s <= t) v += kt[((0 * 16 + (t - s)) * 16 + c1) * 16 + c0]; if (s >= t) v += kt[((1 * 16 + (s - t)) * 16 + c1) * 16 + c0]; if (s == t && c0 == c1) v += dsk[c0]; }
            else { const int q = k - 256, dir = q >> 7, ri = (q >> 6) & 1, pp = q & 63, e = dir ? 16 - t : t + 1;
                const float cr = cc[((dir * 16 + c1) * 64 + pp) * 2], ci = cc[((dir * 16 + c1) * 64 + pp) * 2 + 1], pr = pw[((dir * 17 + e) * 64 + pp) * 2], pi = pw[((dir * 17 + e) * 64 + pp) * 2 + 1];
                v = ri ? -(cr * pi + ci * pr) : (cr * pr - ci * pi); }
            B2[i] = f2bf(v); }
    }
    __syncthreads();
}
__device__ __forceinline__ void prologue2(const Ctx& c, KParams p) {
    prologue_s5_weights(c, p);
    for (int l = 0; l < 2; ++l) { unsigned char* sm = c.ws + WS_WSM + (size_t)l * WSM_L;
        tr_matrix<4>(c, p->in[I_WUKV] + (size_t)l * 128 * 512, 512, 128, 512, (bf16*)(sm + WSM_UK), 256, p->in[I_KVNG] + l * 128, 1.f); }
}

__device__ __forceinline__ void norm_row(const float* xrow, const float* gain, const float* sh, const float* sc, bf16* orow, int lane, f32x4 (&v)[4]) {
    float ss = 0.f;
#pragma unroll
    for (int j = 0; j < 4; ++j) { v[j] = *(const f32x4*)(xrow + 4 * lane + 256 * j); ss += (v[j].x * v[j].x + v[j].y * v[j].y) + (v[j].z * v[j].z + v[j].w * v[j].w); }
    const float rstd = rsqrtf(wave_sum(ss) * (1.f / 1024.f) + EPS);
#pragma unroll
    for (int j = 0; j < 4; ++j) { const int cc = 4 * lane + 256 * j; const f32x4 g = *(const f32x4*)(gain + cc), s1 = *(const f32x4*)(sc + cc), s0 = *(const f32x4*)(sh + cc);
        v[j] = v[j] * rstd * g * (s1 + 1.0f) + s0;
        u32x2 o; o.x = pk2(v[j].x, v[j].y); o.y = pk2(v[j].z, v[j].w); *(u32x2*)(orow + cc) = o; }
}
__device__ __forceinline__ void norm_row_add(const float* xrow, const bf16* drow, float* xout, const float* gain, const float* sh, const float* sc, unsigned char* orow8, int lane, f32x4 (&v)[4]) {
    float ss = 0.f; u32x2 dl[4];
#pragma unroll
    for (int j = 0; j < 4; ++j) { v[j] = *(const f32x4*)(xrow + 4 * lane + 256 * j); dl[j] = *(const u32x2*)(drow + 4 * lane + 256 * j); }
#pragma unroll
    for (int j = 0; j < 4; ++j) { v[j] += (f32x4){__uint_as_float(dl[j].x << 16), __uint_as_float(dl[j].x & 0xffff0000u), __uint_as_float(dl[j].y << 16), __uint_as_float(dl[j].y & 0xffff0000u)};
        *(f32x4*)(xout + 4 * lane + 256 * j) = v[j]; ss += (v[j].x * v[j].x + v[j].y * v[j].y) + (v[j].z * v[j].z + v[j].w * v[j].w); }
    const float rstd = rsqrtf(wave_sum(ss) * (1.f / 1024.f) + EPS);
#pragma unroll
    for (int j = 0; j < 4; ++j) { const int cc = 4 * lane + 256 * j; const f32x4 g = *(const f32x4*)(gain + cc), s1 = *(const f32x4*)(sc + cc), s0 = *(const f32x4*)(sh + cc);
        v[j] = v[j] * rstd * g * (s1 + 1.0f) + s0;
        *(unsigned*)(orow8 + cc) = pk4_fp8(v[j].x * 4.f, v[j].y * 4.f, v[j].z * 4.f, v[j].w * 4.f); }
}
__device__ __forceinline__ void phase_norm1(const Ctx& c, KParams p, int l) {
    const float* MOD = (const float*)(c.ws + WS_MOD) + (size_t)l * 33 * 6144;
    const float* xl = l == 0 ? p->in[I_X] : p->out; const float* xc = l == 0 ? p->in[I_CTX] : (const float*)(c.ws + WS_XC);
    unsigned char* H = c.ws + WS_H; const float* gain = p->in[I_N1G] + l * DM;
    const int gw = c.blk * NWAVES + c.wave, NGW = c.G * NWAVES, lane = c.lane;
    for (int r0 = gw; r0 < NTOK; r0 += 2 * NGW) {
        f32x4 v[2][4]; float ss[2];
#pragma unroll
        for (int k = 0; k < 2; ++k) { const int r = r0 + k * NGW < NTOK ? r0 + k * NGW : r0; const float* xr = r < NLAT ? xl + (size_t)r * DM : xc + (size_t)(r - NLAT) * DM;
#pragma unroll
            for (int j = 0; j < 4; ++j) v[k][j] = *(const f32x4*)(xr + 4 * lane + 256 * j); }
#pragma unroll
        for (int k = 0; k < 2; ++k) { ss[k] = 0.f;
#pragma unroll
            for (int j = 0; j < 4; ++j) ss[k] += (v[k][j].x * v[k][j].x + v[k][j].y * v[k][j].y) + (v[k][j].z * v[k][j].z + v[k][j].w * v[k][j].w); }
#pragma unroll
        for (int k = 0; k < 2; ++k) { const int r = r0 + k * NGW; if (r < NTOK) { const float rstd = rsqrtf(wave_sum(ss[k]) * (1.f / 1024.f) + EPS); const float* m = MOD + (size_t)mod_row(r) * 6144; unsigned char* orow = H + (size_t)r * DM;
#pragma unroll
            for (int j = 0; j < 4; ++j) { const int cc = 4 * lane + 256 * j; const f32x4 g = *(const f32x4*)(gain + cc), s1 = *(const f32x4*)(m + 1024 + cc), s0 = *(const f32x4*)(m + cc);
                const f32x4 y = (v[k][j] * rstd * g * (s1 + 1.0f) + s0) * 4.f; *(unsigned*)(orow + cc) = pk4_fp8(y.x, y.y, y.z, y.w); } } }
    }
}

#define EPI_ARGS const f32x4 (&acc)[2][2][4][2], const pg8::Unit& u, int wr, int wc, int fr, int fq
#define EPI_ROWS for (int ai = 0; ai < 2; ++ai) _Pragma("unroll") for (int m = 0; m < 4; ++m)
struct EpiBf16 {
    bf16* O; int ldo;
    __device__ __forceinline__ void operator()(EPI_ARGS) const {
        const int r0 = u.pm * 256 + wr * 64 + fr, c0 = u.pn * 256 + wc * 32 + 8 * fq;
#pragma unroll
        EPI_ROWS { bf16* rp = O + (size_t)(r0 + ai * 128 + m * 16) * ldo + c0;
#pragma unroll
            for (int bj = 0; bj < 2; ++bj) { const f32x4 a = acc[ai][bj][m][0], b = acc[ai][bj][m][1]; u32x4 w; w.x = pk2(a.x, a.y); w.y = pk2(a.z, a.w); w.z = pk2(b.x, b.y); w.w = pk2(b.z, b.w); *(u32x4*)(rp + bj * 128) = w; } asm volatile("" ::: "memory"); }
    }
};
struct EpiInProj {
    bf16* O; bf16* UP; bf16* GVT; float sc;
    __device__ __forceinline__ void operator()(EPI_ARGS) const {
        const int r0 = u.pm * 256 + wr * 64 + fr, c0 = u.pn * 256 + wc * 32 + 8 * fq;
#pragma unroll
        EPI_ROWS { const int row = r0 + ai * 128 + m * 16; bf16* rp = O + (size_t)row * ZW + c0;
            const int crow = row < NLAT ? (row >> 11) * 144 + 16 + ((row & 2047) >> 4) : ((row - NLAT) >> 8) * 144 + (((row - NLAT) & 255) >> 4);
#pragma unroll
            for (int bj = 0; bj < 2; ++bj) { const f32x4 a = acc[ai][bj][m][0] * sc, b = acc[ai][bj][m][1] * sc; u32x4 w; w.x = pk2(a.x, a.y); w.y = pk2(a.z, a.w); w.z = pk2(b.x, b.y); w.w = pk2(b.z, b.w);
                if (u.pn != 1 && u.pn != 5) *(u32x4*)(rp + bj * 128) = w;
                if (u.pn == 5) { const int g = 8 * bj + 2 * wc + (fq >> 1); *(u32x4*)(UP + ((size_t)g * 4608 + crow) * 512 + fr * 16 + 8 * (fq & 1)) = w; }
                if (u.pn == 1) { const int col = 128 * bj + 32 * wc + 8 * fq, bb = row < NLAT ? (row >> 11) : ((row - NLAT) >> 8), kk = row < NLAT ? 256 + (row & 2047) : ((row - NLAT) & 255);
                    bf16* dst = GVT + ((size_t)(bb * 4 + (col >> 6)) * 64 + (col & 63)) * 2304 + (kk & ~15) + 8 * ((fr >> 2) & 1) + 4 * (fr >> 3) + (fr & 3);
#pragma unroll
                    for (int n = 0; n < 2; ++n)
#pragma unroll
                        for (int i = 0; i < 4; ++i) dst[(size_t)(4 * n + i) * 2304] = f2bf(acc[ai][bj][m][n][i] * sc); } }
            asm volatile("" ::: "memory"); }
    }
};
struct EpiS5X {
    bf16* XE;
    __device__ __forceinline__ void operator()(EPI_ARGS) const {
        const int r0 = u.pm * 256 + wr * 64 + fr, c0 = wc * 32 + 8 * fq;
#pragma unroll
        EPI_ROWS { bf16* rp = XE + (size_t)(r0 + ai * 128 + m * 16) * 256 + c0;
#pragma unroll
            for (int bj = 0; bj < 2; ++bj) { const f32x4 a = acc[ai][bj][m][0], b = acc[ai][bj][m][1]; u32x4 w; w.x = pk2(a.x, a.y); w.y = pk2(a.z, a.w); w.z = pk2(b.x, b.y); w.w = pk2(b.z, b.w); *(u32x4*)(rp + bj * 128) = w; }
            asm volatile("" ::: "memory"); }
    }
};
struct EpiS5Y {
    bf16* Y;
    __device__ __forceinline__ void operator()(EPI_ARGS) const {
        const int r0 = u.pm * 256 + wr * 64 + fr;
#pragma unroll
        EPI_ROWS { const int grow = r0 + ai * 128 + m * 16; const int g = grow / 4608, rem = grow - g * 4608, b = rem / 144, ci = rem - b * 144;
            const int tok0 = ci < 16 ? NLAT + b * CTXL + ci * 16 : b * SEQ + (ci - 16) * 16;
#pragma unroll
            for (int bj = 0; bj < 2; ++bj) { const int t = 8 * bj + 2 * wc + (fq >> 1); const f32x4 a = acc[ai][bj][m][0], bq = acc[ai][bj][m][1]; u32x4 w; w.x = pk2(a.x, a.y); w.y = pk2(a.z, a.w); w.z = pk2(bq.x, bq.y); w.w = pk2(bq.z, bq.w);
                *(u32x4*)(Y + (size_t)(tok0 + t) * 256 + g * 16 + 8 * (fq & 1)) = w; }
            asm volatile("" ::: "memory"); }
    }
};
struct EpiOB8 {
    unsigned char* OB; float sc;
    __device__ __forceinline__ void operator()(EPI_ARGS) const {
        const int r0 = u.pm * 256 + wr * 64 + fr;
#pragma unroll
        EPI_ROWS { unsigned char* rp = OB + (size_t)(r0 + ai * 128 + m * 16) * 1024 + u.pn * 256 + (wc * 4 + fq) * 16; u32x4 w;
#pragma unroll
            for (int bj = 0; bj < 2; ++bj)
#pragma unroll
                for (int n = 0; n < 2; ++n) { const f32x4 a = acc[ai][bj][m][n] * sc; int pk = 0;
                    pk = __builtin_amdgcn_cvt_pk_fp8_f32(__builtin_amdgcn_fmed3f(a.x, -440.f, 440.f), __builtin_amdgcn_fmed3f(a.y, -440.f, 440.f), pk, false);
                    pk = __builtin_amdgcn_cvt_pk_fp8_f32(__builtin_amdgcn_fmed3f(a.z, -440.f, 440.f), __builtin_amdgcn_fmed3f(a.w, -440.f, 440.f), pk, true); w[2 * bj + n] = (unsigned)pk; }
            *(u32x4*)rp = w; asm volatile("" ::: "memory"); }
    }
};
struct EpiBf16S {
    bf16* O; int ldo; float sc;
    __device__ __forceinline__ void operator()(EPI_ARGS) const {
        const int r0 = u.pm * 256 + wr * 64 + fr, c0 = u.pn * 256 + wc * 32 + 8 * fq;
#pragma unroll
        EPI_ROWS { bf16* rp = O + (size_t)(r0 + ai * 128 + m * 16) * ldo + c0;
#pragma unroll
            for (int bj = 0; bj < 2; ++bj) { const f32x4 a = acc[ai][bj][m][0] * sc, b = acc[ai][bj][m][1] * sc; u32x4 w; w.x = pk2(a.x, a.y); w.y = pk2(a.z, a.w); w.z = pk2(b.x, b.y); w.w = pk2(b.z, b.w); *(u32x4*)(rp + bj * 128) = w; }
            asm volatile("" ::: "memory"); }
    }
};
struct EpiBiasBf16 {
    unsigned char* O; int ldo; const float* bias;
    __device__ __forceinline__ void operator()(EPI_ARGS) const {
        const int r0 = u.pm * 256 + wr * 64 + fr, c0 = u.pn * 256 + wc * 32 + 8 * fq;
        f32x4 bv[2][2];
#pragma unroll
        for (int bj = 0; bj < 2; ++bj) { bv[bj][0] = *(const f32x4*)(bias + c0 + bj * 128); bv[bj][1] = *(const f32x4*)(bias + c0 + bj * 128 + 4); }
        __builtin_amdgcn_s_waitcnt(0x0F70);
#pragma unroll
        EPI_ROWS { unsigned char* rp = O + (size_t)(r0 + ai * 128 + m * 16) * ldo + c0;
#pragma unroll
            for (int bj = 0; bj < 2; ++bj) { const f32x4 a = (acc[ai][bj][m][0] + bv[bj][0]) * 16.f, b = (acc[ai][bj][m][1] + bv[bj][1]) * 16.f; u32x2 w; w.x = pk4_fp8(a.x, a.y, a.z, a.w); w.y = pk4_fp8(b.x, b.y, b.z, b.w); *(u32x2*)(rp + bj * 128) = w; } asm volatile("" ::: "memory"); }
    }
};
struct EpiGluSig {
    unsigned char* O; int ldo; const float* bias;
    __device__ __forceinline__ void operator()(EPI_ARGS) const {
        const int r0 = u.pm * 256 + wr * 64 + fr, c0 = u.pn * 128 + wc * 32 + 8 * fq;
        f32x4 b1[2], b2[2];
#pragma unroll
        for (int n = 0; n < 2; ++n) { b1[n] = *(const f32x4*)(bias + c0 + 4 * n); b2[n] = *(const f32x4*)(bias + 256 + c0 + 4 * n); }
        __builtin_amdgcn_s_waitcnt(0x0F70);
#pragma unroll
        EPI_ROWS { unsigned char* rp = O + (size_t)(r0 + ai * 128 + m * 16) * ldo + c0; float o[8];
#pragma unroll
            for (int n = 0; n < 2; ++n)
#pragma unroll
                for (int i = 0; i < 4; ++i) o[4 * n + i] = (acc[ai][0][m][n][i] + b1[n][i]) * (16.f * sigmoidf_(acc[ai][1][m][n][i] + b2[n][i]));
            u32x2 w; w.x = pk4_fp8(o[0], o[1], o[2], o[3]); w.y = pk4_fp8(o[4], o[5], o[6], o[7]); *(u32x2*)rp = w; asm volatile("" ::: "memory"); }
    }
};
struct EpiSwiglu {
    unsigned char* O; int ldo; float sc;
    __device__ __forceinline__ void operator()(EPI_ARGS) const {
        const int r0 = u.pm * 256 + wr * 64 + fr, c0 = u.pn * 128 + wc * 32 + 8 * fq;
#pragma unroll
        EPI_ROWS { unsigned char* rp = O + (size_t)(r0 + ai * 128 + m * 16) * ldo + c0; float o[8];
#pragma unroll
            for (int n = 0; n < 2; ++n)
#pragma unroll
                for (int i = 0; i < 4; ++i) o[4 * n + i] = siluf_(acc[ai][0][m][n][i] * sc) * (acc[ai][1][m][n][i] * (sc * 16.0f));
            u32x2 w; w.x = pk4_fp8(o[0], o[1], o[2], o[3]); w.y = pk4_fp8(o[4], o[5], o[6], o[7]); *(u32x2*)rp = w; asm volatile("" ::: "memory"); }
    }
};
struct EpiQ {
    bf16* Q; const float* RS;
    __device__ __forceinline__ void operator()(EPI_ARGS) const {
        const int r0 = u.pm * 256 + wr * 64 + fr; float rq[8];
#pragma unroll
        for (int g = 0; g < 8; ++g) rq[g] = RS[(size_t)(r0 + (g >> 2) * 128 + (g & 3) * 16) * 2];
        __builtin_amdgcn_s_waitcnt(0x0F70);
#pragma unroll
        EPI_ROWS { const int row = r0 + ai * 128 + m * 16; const float rs = rq[ai * 4 + m]; bf16* rp = Q + (size_t)row * 384;
            if (u.pn == 0) {
#pragma unroll
                for (int bj = 0; bj < 2; ++bj) { const int head = 2 * bj + (wc >> 1), d = 32 * (wc & 1) + 8 * fq; const f32x4 a = acc[ai][bj][m][0] * rs, b = acc[ai][bj][m][1] * rs;
                    u32x4 w; w.x = pk2(a.x, a.y); w.y = pk2(a.z, a.w); w.z = pk2(b.x, b.y); w.w = pk2(b.z, b.w); *(u32x4*)(rp + head * 96 + d) = w; }
            } else { const f32x4 a = acc[ai][0][m][0] * rs, b = acc[ai][0][m][1] * rs;
                u32x4 w; w.x = pk2(a.x, a.y); w.y = pk2(a.z, a.w); w.z = pk2(b.x, b.y); w.w = pk2(b.z, b.w); *(u32x4*)(rp + wc * 96 + 64 + 8 * fq) = w; }
            asm volatile("" ::: "memory"); }
    }
};
struct EpiKV {
    bf16* Kb; bf16* VT; const float* RS;
    __device__ __forceinline__ void operator()(EPI_ARGS) const {
        const int r0 = u.pm * 256 + wr * 64 + fr;
        const int p16 = 8 * ((fr >> 2) & 1) + 4 * (fr >> 3) + (fr & 3); float rkv[8];
#pragma unroll
        for (int g = 0; g < 8; ++g) rkv[g] = RS[(size_t)(r0 + (g >> 2) * 128 + (g & 3) * 16) * 2 + 1];
        __builtin_amdgcn_s_waitcnt(0x0F70);
#pragma unroll
        EPI_ROWS { const int row = r0 + ai * 128 + m * 16; const float rk = rkv[ai * 4 + m];
            if (u.pn == 0) {
#pragma unroll
                for (int bj = 0; bj < 2; ++bj) { const int head = 2 * bj + (wc >> 1), d = 32 * (wc & 1) + 8 * fq; const f32x4 a = acc[ai][bj][m][0] * rk, b = acc[ai][bj][m][1] * rk;
                    u32x4 w; w.x = pk2(a.x, a.y); w.y = pk2(a.z, a.w); w.z = pk2(b.x, b.y); w.w = pk2(b.z, b.w);
                    *(u32x4*)(Kb + (size_t)row * 384 + head * 96 + d) = w; }
            } else {
                const int bb = row < NLAT ? (row >> 11) : ((row - NLAT) >> 8); const int kk = row < NLAT ? (row & 2047) : 2048 + ((row - NLAT) & 255);
                const int pos = (kk & ~15) + p16;
#pragma unroll
                for (int bj = 0; bj < 2; ++bj) { const int head = 2 * bj + (wc >> 1), d = 32 * (wc & 1) + 8 * fq; bf16* dst = VT + ((size_t)((bb * 4 + head) * 64 + d)) * 2304 + pos;
#pragma unroll
                    for (int n = 0; n < 2; ++n)
#pragma unroll
                        for (int i = 0; i < 4; ++i) dst[(size_t)(4 * n + i) * 2304] = f2bf(acc[ai][bj][m][n][i] * rk); }
            }
            asm volatile("" ::: "memory"); }
    }
};
struct EpiDelta {
    bf16* D; const float* MODg; float sc;
    __device__ __forceinline__ void operator()(EPI_ARGS) const {
        const int rt = u.pm * 256; const float* g = MODg + (size_t)(rt < NLAT ? (rt >> 11) : 32) * 6144;
        const int r0 = rt + wr * 64 + fr, c0 = u.pn * 256 + wc * 32 + 8 * fq;
        f32x4 gv[2][2];
#pragma unroll
        for (int bj = 0; bj < 2; ++bj) { gv[bj][0] = *(const f32x4*)(g + c0 + bj * 128) * sc; gv[bj][1] = *(const f32x4*)(g + c0 + bj * 128 + 4) * sc; }
        __builtin_amdgcn_s_waitcnt(0x0F70);
#pragma unroll
        EPI_ROWS { bf16* rp = D + (size_t)(r0 + ai * 128 + m * 16) * DM + c0;
#pragma unroll
            for (int bj = 0; bj < 2; ++bj) { const f32x4 a = gv[bj][0] * acc[ai][bj][m][0], b = gv[bj][1] * acc[ai][bj][m][1]; u32x4 w; w.x = pk2(a.x, a.y); w.y = pk2(a.z, a.w); w.z = pk2(b.x, b.y); w.w = pk2(b.z, b.w); *(u32x4*)(rp + bj * 128) = w; }
            asm volatile("" ::: "memory"); }
    }
};

__device__ __forceinline__ int seq_row(int b, int dir, int pos) {
    if (pos < CTXL) return NLAT + b * CTXL + (dir ? CTXL - 1 - pos : pos);
    const int t = pos - CTXL; return b * SEQ + (dir ? SEQ - 1 - t : t);
}
__device__ __forceinline__ void phase_gla(const Ctx& c, KParams p, int l) {
    const bf16* Z = (const bf16*)(c.ws + WS_Z); const bf16* GVT = (const bf16*)(c.ws + WS_GVT); bf16* OG = (bf16*)(c.ws + WS_T1);
    const int w = c.wave, tid = c.tid;
    LAS float* wtab = (LAS float*)c.lds;
    LAS float* DD = (LAS float*)(c.lds + 4096);
    LAS unsigned char* RW = c.lds + 8192 + w * 13824;
    LAS float* LA = (LAS float*)RW;
    LAS unsigned char* KTT = RW + 9216;
    for (int u = c.blk; u < 256; u += c.G) {
        const int b = u >> 3, h = (u >> 1) & 3, dir = u & 1;
        __syncthreads();
        { const float* wa = p->in[I_GLAW] + ((size_t)(l * 2 + dir) * 16) * 128 + h * 32; wtab[tid] = wa[(tid >> 5) * 128 + (tid & 31)]; if (tid < 32) wtab[512 + tid] = p->in[I_GLAB][(l * 2 + dir) * 128 + h * 32 + tid]; }
        float Sst[4] = {0.f, 0.f, 0.f, 0.f};
        __syncthreads();
        for (int gi = 0; gi < 5; ++gi) {
            const int pc = gi * 8 + w; const bool active = pc < 36;
            int lane_ = c.lane; asm volatile("" : "+v"(lane_));
            const int r = lane_ & 31, hh = lane_ >> 5;
            const int p16 = 8 * ((r >> 2) & 1) + 4 * ((r & 15) >> 3) + (r & 3);
            const int pos0 = (r & 16) + p16, pos1 = 32 + pos0;
            bf16x8 qd[2][2]; f32x16 oacc[2][2]; int row0 = 0;
            if (active) {
                int kk0;
                if (dir == 0) { if (pc < 4) { row0 = NLAT + b * CTXL + pc * 64; kk0 = pc * 64; } else { row0 = b * SEQ + (pc - 4) * 64; kk0 = 256 + (pc - 4) * 64; } }
                else { if (pc < 4) { row0 = NLAT + b * CTXL + (3 - pc) * 64; kk0 = (3 - pc) * 64; } else { row0 = b * SEQ + (35 - pc) * 64; kk0 = 256 + (35 - pc) * 64; } }
#pragma unroll
                for (int ib = 0; ib < 2; ++ib) { const bf16* zr = Z + (size_t)(row0 + 32 * ib + r) * ZW; float al[16]; { const u32x4 a0 = *(const u32x4*)(zr + ZAF + dir * 16), a1 = *(const u32x4*)(zr + ZAF + dir * 16 + 8); float t8[8]; unpack8(a0, t8);
#pragma unroll
                        for (int j = 0; j < 8; ++j) al[j] = t8[j];
                        unpack8(a1, t8);
#pragma unroll
                        for (int j = 0; j < 8; ++j) al[8 + j] = t8[j]; }
#pragma unroll
                    for (int ks = 0; ks < 2; ++ks) { float za[8]; { const f32x4 b0 = *(const LAS f32x4*)(wtab + 512 + 16 * ks + 8 * hh), b1 = *(const LAS f32x4*)(wtab + 512 + 16 * ks + 8 * hh + 4);
                            za[0] = b0.x; za[1] = b0.y; za[2] = b0.z; za[3] = b0.w; za[4] = b1.x; za[5] = b1.y; za[6] = b1.z; za[7] = b1.w; }
#pragma unroll
                        for (int j = 0; j < 16; ++j) { const f32x4 w0 = *(const LAS f32x4*)(wtab + j * 32 + 16 * ks + 8 * hh), w1 = *(const LAS f32x4*)(wtab + j * 32 + 16 * ks + 8 * hh + 4);
                            za[0] = fmaf(al[j], w0.x, za[0]); za[1] = fmaf(al[j], w0.y, za[1]); za[2] = fmaf(al[j], w0.z, za[2]); za[3] = fmaf(al[j], w0.w, za[3]);
                            za[4] = fmaf(al[j], w1.x, za[4]); za[5] = fmaf(al[j], w1.y, za[5]); za[6] = fmaf(al[j], w1.z, za[6]); za[7] = fmaf(al[j], w1.w, za[7]); }
                        float la[8];
#pragma unroll
                        for (int e = 0; e < 8; ++e) la[e] = (fminf(za[e], 0.f) - __logf(1.f + __expf(-fabsf(za[e])))) * 0.0625f;
                        *(LAS f32x4*)(LA + (32 * ib + r) * 36 + 16 * ks + 8 * hh) = (f32x4){la[0], la[1], la[2], la[3]}; *(LAS f32x4*)(LA + (32 * ib + r) * 36 + 16 * ks + 8 * hh + 4) = (f32x4){la[4], la[5], la[6], la[7]}; } }
                lds_wait();
                u32x4 qraw[2][2], kraw[2][2];
#pragma unroll
                for (int ib = 0; ib < 2; ++ib) { const bf16* zr = Z + (size_t)(row0 + 32 * ib + r) * ZW;
#pragma unroll
                    for (int ks = 0; ks < 2; ++ks) { qraw[ib][ks] = *(const u32x4*)(zr + ZQ + h * 32 + 16 * ks + 8 * hh); kraw[ib][ks] = *(const u32x4*)(zr + ZK + h * 32 + 16 * ks + 8 * hh); } }
                { float bend; float v[32], s = 0.f;
#pragma unroll
                  for (int qq = 0; qq < 32; ++qq) { const int q = 32 * hh + qq, i = dir ? 63 - q : q; v[qq] = LA[i * 36 + r]; s += v[qq]; }
                  const auto sw = __builtin_amdgcn_permlane32_swap(__float_as_uint(s), __float_as_uint(s), false, false);
                  const float h0 = __uint_as_float(sw[0]), h1 = __uint_as_float(sw[1]); bend = h0 + h1;
                  float run = hh ? h0 : 0.f;
#pragma unroll
                  for (int qq = 0; qq < 32; ++qq) { const int q = 32 * hh + qq, i = dir ? 63 - q : q; run += v[qq]; LA[i * 36 + r] = run; }
                  if (hh == 0) DD[w * 32 + r] = __expf(bend); }
                lds_wait();
                bf16x8 vt[2][4];
#pragma unroll
                for (int db = 0; db < 2; ++db)
#pragma unroll
                    for (int s4 = 0; s4 < 4; ++s4) vt[db][s4] = *(const bf16x8*)(GVT + ((size_t)(b * 4 + h) * 64 + 32 * db + r) * 2304 + kk0 + 16 * s4 + 8 * hh);
                bf16x8 ki[2][2];
#pragma unroll
                for (int ib = 0; ib < 2; ++ib) {
#pragma unroll
                    for (int ks = 0; ks < 2; ++ks) { const int dk0 = 16 * ks + 8 * hh; float q8[8], k8[8], b8[8]; unpack8(qraw[ib][ks], q8); unpack8(kraw[ib][ks], k8);
                        { const f32x4 x0 = *(const LAS f32x4*)(LA + (32 * ib + r) * 36 + dk0), x1 = *(const LAS f32x4*)(LA + (32 * ib + r) * 36 + dk0 + 4); b8[0] = x0.x; b8[1] = x0.y; b8[2] = x0.z; b8[3] = x0.w; b8[4] = x1.x; b8[5] = x1.y; b8[6] = x1.z; b8[7] = x1.w; }
                        float qo[8], ko[8];
#pragma unroll
                        for (int e = 0; e < 8; ++e) { const float eb = __expf(b8[e]), ieb = 1.f / eb; qo[e] = q8[e] * 0.17677669529663687f * eb; ko[e] = k8[e] * ieb;
                            *(LAS bf16*)(KTT + ((dk0 + e) * 72 + (ib ? pos1 : pos0)) * 2) = f2bf(ko[e] * DD[w * 32 + dk0 + e]); }
                        u32x4 wq, wk; wq.x = pk2(qo[0], qo[1]); wq.y = pk2(qo[2], qo[3]); wq.z = pk2(qo[4], qo[5]); wq.w = pk2(qo[6], qo[7]); wk.x = pk2(ko[0], ko[1]); wk.y = pk2(ko[2], ko[3]); wk.z = pk2(ko[4], ko[5]); wk.w = pk2(ko[6], ko[7]);
                        qd[ib][ks] = __builtin_bit_cast(bf16x8, wq); ki[ib][ks] = __builtin_bit_cast(bf16x8, wk); } }
                f32x16 zero16;
#pragma unroll
                for (int i = 0; i < 16; ++i) zero16[i] = 0.f;
                f32x16 a00 = __builtin_amdgcn_mfma_f32_32x32x16_bf16(ki[0][0], qd[0][0], zero16, 0, 0, 0); a00 = __builtin_amdgcn_mfma_f32_32x32x16_bf16(ki[0][1], qd[0][1], a00, 0, 0, 0);
                f32x16 a11 = __builtin_amdgcn_mfma_f32_32x32x16_bf16(ki[1][0], qd[1][0], zero16, 0, 0, 0); a11 = __builtin_amdgcn_mfma_f32_32x32x16_bf16(ki[1][1], qd[1][1], a11, 0, 0, 0);
                f32x16 aof;
                if (dir == 0) { aof = __builtin_amdgcn_mfma_f32_32x32x16_bf16(ki[0][0], qd[1][0], zero16, 0, 0, 0); aof = __builtin_amdgcn_mfma_f32_32x32x16_bf16(ki[0][1], qd[1][1], aof, 0, 0, 0); }
                else { aof = __builtin_amdgcn_mfma_f32_32x32x16_bf16(ki[1][0], qd[0][0], zero16, 0, 0, 0); aof = __builtin_amdgcn_mfma_f32_32x32x16_bf16(ki[1][1], qd[0][1], aof, 0, 0, 0); }
#pragma unroll
                for (int i = 0; i < 16; ++i) { const int j = (i & 3) + 8 * (i >> 2) + 4 * hh; const bool keep = dir ? (j >= r) : (j <= r); a00[i] = keep ? a00[i] : 0.f; a11[i] = keep ? a11[i] : 0.f; }
#define GLA_P(X, s) ({ u32x4 w_; w_.x = pk2((X)[8 * (s)], (X)[8 * (s) + 1]); w_.y = pk2((X)[8 * (s) + 2], (X)[8 * (s) + 3]); w_.z = pk2((X)[8 * (s) + 4], (X)[8 * (s) + 5]); w_.w = pk2((X)[8 * (s) + 6], (X)[8 * (s) + 7]); __builtin_bit_cast(bf16x8, w_); })
                const bf16x8 p00a = GLA_P(a00, 0), p00b = GLA_P(a00, 1), p11a = GLA_P(a11, 0), p11b = GLA_P(a11, 1), pofa = GLA_P(aof, 0), pofb = GLA_P(aof, 1);
#pragma unroll
                for (int db = 0; db < 2; ++db) {
                    f32x16 o0 = __builtin_amdgcn_mfma_f32_32x32x16_bf16(vt[db][0], p00a, zero16, 0, 0, 0); o0 = __builtin_amdgcn_mfma_f32_32x32x16_bf16(vt[db][1], p00b, o0, 0, 0, 0);
                    f32x16 o1 = __builtin_amdgcn_mfma_f32_32x32x16_bf16(vt[db][2], p11a, zero16, 0, 0, 0); o1 = __builtin_amdgcn_mfma_f32_32x32x16_bf16(vt[db][3], p11b, o1, 0, 0, 0);
                    if (dir == 0) { o1 = __builtin_amdgcn_mfma_f32_32x32x16_bf16(vt[db][0], pofa, o1, 0, 0, 0); o1 = __builtin_amdgcn_mfma_f32_32x32x16_bf16(vt[db][1], pofb, o1, 0, 0, 0); }
                    else { o0 = __builtin_amdgcn_mfma_f32_32x32x16_bf16(vt[db][2], pofa, o0, 0, 0, 0); o0 = __builtin_amdgcn_mfma_f32_32x32x16_bf16(vt[db][3], pofb, o0, 0, 0, 0); }
                    oacc[db][0] = o0; oacc[db][1] = o1; }
#undef GLA_P
                lds_wait();
                bf16x8 kf[4];
#pragma unroll
                for (int s4 = 0; s4 < 4; ++s4) kf[s4] = *(const LAS bf16x8*)(KTT + (r * 72 + 16 * s4 + 8 * hh) * 2);
#pragma unroll
                for (int db = 0; db < 2; ++db) { f32x16 uu = __builtin_amdgcn_mfma_f32_32x32x16_bf16(vt[db][0], kf[0], zero16, 0, 0, 0);
#pragma unroll
                    for (int s4 = 1; s4 < 4; ++s4) uu = __builtin_amdgcn_mfma_f32_32x32x16_bf16(vt[db][s4], kf[s4], uu, 0, 0, 0);
#pragma unroll
                    for (int i = 0; i < 16; ++i) LA[(32 * db + (i & 3) + 8 * (i >> 2) + 4 * hh) * 32 + r] = uu[i]; }
            }
            __syncthreads();
            const int dv2 = tid >> 3, dk4 = (tid & 7) * 4;
            f32x4 ur[8], dr[8];
#pragma unroll
            for (int cc = 0; cc < 8; ++cc) { ur[cc] = *(const LAS f32x4*)((LAS float*)(c.lds + 8192 + cc * 13824) + dv2 * 32 + dk4); dr[cc] = *(const LAS f32x4*)(DD + cc * 32 + dk4); }
            __syncthreads();
#pragma unroll
            for (int cc = 0; cc < 8; ++cc) if (gi * 8 + cc < 36) { u32x2 sp; sp.x = pk2(Sst[0], Sst[1]); sp.y = pk2(Sst[2], Sst[3]); *(LAS u32x2*)(c.lds + 8192 + cc * 13824 + (dv2 * 40 + dk4) * 2) = sp;
                Sst[0] = fmaf(dr[cc].x, Sst[0], ur[cc].x); Sst[1] = fmaf(dr[cc].y, Sst[1], ur[cc].y); Sst[2] = fmaf(dr[cc].z, Sst[2], ur[cc].z); Sst[3] = fmaf(dr[cc].w, Sst[3], ur[cc].w); }
            __syncthreads();
            if (active) {
#pragma unroll
                for (int db = 0; db < 2; ++db) { const bf16x8 s0 = *(const LAS bf16x8*)(RW + ((32 * db + r) * 40 + 8 * hh) * 2), s1 = *(const LAS bf16x8*)(RW + ((32 * db + r) * 40 + 16 + 8 * hh) * 2);
#pragma unroll
                    for (int ib = 0; ib < 2; ++ib) { oacc[db][ib] = __builtin_amdgcn_mfma_f32_32x32x16_bf16(s0, qd[ib][0], oacc[db][ib], 0, 0, 0); oacc[db][ib] = __builtin_amdgcn_mfma_f32_32x32x16_bf16(s1, qd[ib][1], oacc[db][ib], 0, 0, 0); } }
#pragma unroll
                for (int ib = 0; ib < 2; ++ib) { bf16* orow = OG + ((size_t)dir * NTOK + row0 + 32 * ib + r) * 256 + h * 64 + 4 * hh;
#pragma unroll
                    for (int db = 0; db < 2; ++db)
#pragma unroll
                        for (int g4 = 0; g4 < 4; ++g4) { u32x2 wv; wv.x = pk2(oacc[db][ib][4 * g4], oacc[db][ib][4 * g4 + 1]); wv.y = pk2(oacc[db][ib][4 * g4 + 2], oacc[db][ib][4 * g4 + 3]); *(u32x2*)(orow + 32 * db + 8 * g4) = wv; } }
                lds_wait();
            }
        }
    }
    __syncthreads();
}
__device__ __forceinline__ void phase_gla_final(const Ctx& c, KParams p, int l, int nrows) {
    const bf16* Z = (const bf16*)(c.ws + WS_Z); const bf16* OG = (const bf16*)(c.ws + WS_T1); unsigned char* MIX = c.ws + WS_MIX;
    const int gw = c.blk * NWAVES + c.wave, NGW = c.G * NWAVES; const f32x4 g = *(const f32x4*)(p->in[I_GLAG] + l * 256 + 4 * c.lane);
    for (int r0 = gw; r0 < nrows; r0 += 4 * NGW) {
        u32x2 of[4], ob[4], rg[4];
#pragma unroll
        for (int k = 0; k < 4; ++k) { const int r = r0 + k * NGW; of[k] = ob[k] = rg[k] = (u32x2){0u, 0u};
            if (r < nrows) { of[k] = *(const u32x2*)(OG + (size_t)r * 256 + 4 * c.lane); ob[k] = *(const u32x2*)(OG + ((size_t)NTOK + r) * 256 + 4 * c.lane); rg[k] = *(const u32x2*)(Z + (size_t)r * ZW + ZR + 4 * c.lane); } }
#pragma unroll
        for (int k = 0; k < 4; ++k) { const int r = r0 + k * NGW;
            f32x4 o = (f32x4){__uint_as_float(of[k].x << 16) + __uint_as_float(ob[k].x << 16), __uint_as_float(of[k].x & 0xffff0000u) + __uint_as_float(ob[k].x & 0xffff0000u),
                              __uint_as_float(of[k].y << 16) + __uint_as_float(ob[k].y << 16), __uint_as_float(of[k].y & 0xffff0000u) + __uint_as_float(ob[k].y & 0xffff0000u)};
            float ss = (o.x * o.x + o.y * o.y) + (o.z * o.z + o.w * o.w);
            ss += shx<1>(ss); ss += shx<2>(ss); ss += shx<4>(ss); ss += shx<8>(ss);
            const float rstd = rsqrtf(ss * (1.f / 64.f) + EPS);
            const float g0 = __uint_as_float(rg[k].x << 16), g1 = __uint_as_float(rg[k].x & 0xffff0000u), g2 = __uint_as_float(rg[k].y << 16), g3 = __uint_as_float(rg[k].y & 0xffff0000u);
            const float r16 = rstd * 16.f; const unsigned w = pk4_fp8(o.x * r16 * g.x * siluf_(g0), o.y * r16 * g.y * siluf_(g1), o.z * r16 * g.z * siluf_(g2), o.w * r16 * g.w * siluf_(g3));
            if (r < nrows) *(unsigned*)(MIX + (size_t)r * DM + 4 * c.lane) = w; }
    }
}

__device__ __forceinline__ void phase_conv1(const Ctx& c, KParams p, int l, bool with_ctx) {
    const bf16* Z = (const bf16*)(c.ws + WS_Z); bf16* CV = (bf16*)(c.ws + WS_CV);
    constexpr int TT = 64, HR = TT + 30;
    LAS float* glu = (LAS float*)c.lds;
    LAS float* dws = glu + HR * 256;
    for (int i = c.tid; i < 31 * 256; i += NTHR) dws[i] = p->in[I_CDW][(size_t)l * 31 * 256 + i];
    const int ntiles = with_ctx ? 1024 + 128 : 1024;
    const f32x4 dwb = *(const f32x4*)(p->in[I_CDB] + l * 256 + 4 * c.lane), lg = *(const f32x4*)(p->in[I_CLG] + l * 256 + 4 * c.lane), lb = *(const f32x4*)(p->in[I_CLB] + l * 256 + 4 * c.lane);
    for (int tile = c.blk; tile < ntiles; tile += c.G) {
        int rowbase, t0, slen;
        if (tile < 1024) { const int b = tile >> 5; rowbase = b * SEQ; t0 = (tile & 31) * TT; slen = SEQ; } else { const int q = tile - 1024, b = q >> 2; rowbase = NLAT + b * CTXL; t0 = (q & 3) * TT; slen = CTXL; }
        __syncthreads();
        u32x2 ra[12], rg[12];
#pragma unroll
        for (int k = 0; k < 12; ++k) { const int idx = c.tid + k * NTHR, j = idx >> 6, c4 = (idx & 63) * 4, t = t0 - 15 + j; ra[k] = (u32x2){0u, 0u}; rg[k] = (u32x2){0u, 0u};
            if (idx < HR * 64 && t >= 0 && t < slen) { const bf16* zr = Z + (size_t)(rowbase + t) * ZW; ra[k] = *(const u32x2*)(zr + ZCA + c4); rg[k] = *(const u32x2*)(zr + ZCG + c4); } }
#pragma unroll
        for (int k = 0; k < 12; ++k) { const int idx = c.tid + k * NTHR, j = idx >> 6, c4 = (idx & 63) * 4; f32x4 v;
            v.x = __uint_as_float(ra[k].x << 16) * sigmoidf_(__uint_as_float(rg[k].x << 16)); v.y = __uint_as_float(ra[k].x & 0xffff0000u) * sigmoidf_(__uint_as_float(rg[k].x & 0xffff0000u));
            v.z = __uint_as_float(ra[k].y << 16) * sigmoidf_(__uint_as_float(rg[k].y << 16)); v.w = __uint_as_float(ra[k].y & 0xffff0000u) * sigmoidf_(__uint_as_float(rg[k].y & 0xffff0000u));
            if (idx < HR * 64) *(LAS f32x4*)(glu + j * 256 + c4) = v; }
        __syncthreads();
        for (int q = 0; q < 8; ++q) { const int i = c.wave * 8 + q; f32x4 a = dwb;
#pragma unroll
            for (int j = 0; j < 31; ++j) a += *(const LAS f32x4*)(glu + (i + j) * 256 + 4 * c.lane) * *(const LAS f32x4*)(dws + j * 256 + 4 * c.lane);
            const float mu = wave_sum((a.x + a.y) + (a.z + a.w)) * (1.f / 256.f); const f32x4 dlt = a - mu;
            const float var = wave_sum((dlt.x * dlt.x + dlt.y * dlt.y) + (dlt.z * dlt.z + dlt.w * dlt.w)) * (1.f / 256.f); const float rstd = rsqrtf(var + EPS);
            const f32x4 y = dlt * rstd * lg + lb;
            u32x2 w; w.x = pk2(siluf_(y.x), siluf_(y.y)); w.y = pk2(siluf_(y.z), siluf_(y.w));
            *(u32x2*)(CV + (size_t)(rowbase + t0 + i) * 256 + 4 * c.lane) = w; }
    }
    __syncthreads();
}

__device__ __forceinline__ void phase_s5_carry(const Ctx& c, int l) {
    const bf16* XE = (const bf16*)(c.ws + WS_Y5); bf16* UP = (bf16*)(c.ws + WS_UP); const float* S5P = (const float*)(c.ws + WS_S5P);
    for (int i = c.blk * NTHR + c.tid; i < NB * 2 * 16 * 64; i += c.G * NTHR) {
        const int pp = i & 63, g = (i >> 6) & 15, dir = (i >> 10) & 1, b = i >> 11;
        const float* PW = S5P + ((size_t)((l * 2 + dir) * 16 + g) * 64 + pp) * 34 + 32; const float ar = PW[0], ai = PW[1];
        const size_t rbase = (size_t)g * 4608 + (size_t)b * 144; float xr = 0.f, xi = 0.f;
        for (int s0 = 0; s0 < 144; s0 += 8) {
            float er[8], ei[8];
#pragma unroll
            for (int q = 0; q < 8; ++q) { const int s = s0 + q; const int ci = dir == 0 ? s : (s < 16 ? 15 - s : 159 - s); const bf16* xe = XE + (rbase + ci) * 256 + dir * 128 + pp; er[q] = bf2f(xe[0]); ei[q] = bf2f(xe[64]); }
#pragma unroll
            for (int q = 0; q < 8; ++q) { const int s = s0 + q; const int ci = dir == 0 ? s : (s < 16 ? 15 - s : 159 - s); bf16* up = UP + (rbase + ci) * 512 + 256 + dir * 128 + pp; up[0] = f2bf(xr); up[64] = f2bf(xi);
                const float nr = ar * xr - ai * xi + er[q], ni = ar * xi + ai * xr + ei[q]; xr = nr; xi = ni; }
        }
    }
}

__device__ __forceinline__ void phase_mla_prep(const Ctx& c, KParams p) {
    const bf16* Z = (const bf16*)(c.ws + WS_Z); float* RS = (float*)(c.ws + WS_RS); bf16* Kb = (bf16*)(c.ws + WS_H) + (size_t)NTOK * 384; const float* ROPE = (const float*)(c.ws + WS_TAB + TAB_ROPE);
    const int gw = c.blk * NWAVES + c.wave, NGW = c.G * NWAVES, lane = c.lane, d = lane & 31;
    for (int r0 = gw; r0 < NTOK; r0 += 4 * NGW) {
        u32x2 q4[4]; unsigned k2[4]; bf16 xr[4]; f32x2 cs[4];
#pragma unroll
        for (int k = 0; k < 4; ++k) { const int r = r0 + k * NGW; q4[k] = (u32x2){0u, 0u}; k2[k] = 0u; xr[k] = 0; cs[k] = (f32x2){1.f, 0.f};
            if (r < NTOK) { const bf16* zr = Z + (size_t)r * ZW; q4[k] = *(const u32x2*)(zr + ZCQ + 4 * lane); k2[k] = *(const unsigned*)(zr + ZCKV + 2 * lane); xr[k] = zr[ZKR + d];
                if (r < NLAT) cs[k] = *(const f32x2*)(ROPE + (((r & 2047) * 2 + (d >> 4)) * 8 + (d & 7)) * 2); } }
#pragma unroll
        for (int k = 0; k < 4; ++k) { const int r = r0 + k * NGW;
            const float a0 = __uint_as_float(q4[k].x << 16), a1 = __uint_as_float(q4[k].x & 0xffff0000u), a2 = __uint_as_float(q4[k].y << 16), a3 = __uint_as_float(q4[k].y & 0xffff0000u);
            const float b0 = __uint_as_float(k2[k] << 16), b1 = __uint_as_float(k2[k] & 0xffff0000u);
            const float sq = wave_sum((a0 * a0 + a1 * a1) + (a2 * a2 + a3 * a3)), sk = wave_sum(b0 * b0 + b1 * b1);
            const float x = bf2f(xr[k]); const float px = shx<8>(x);
            const float o = (d & 8) ? fmaf(x, cs[k].x, px * cs[k].y) : fmaf(x, cs[k].x, -px * cs[k].y);
            if (r < NTOK) { if (lane == 0) { RS[(size_t)r * 2] = rsqrtf(sq * (1.f / 256.f) + EPS); RS[(size_t)r * 2 + 1] = rsqrtf(sk * (1.f / 128.f) + EPS); }
                const bf16 ob = f2bf(o); bf16* kr = Kb + (size_t)r * 384 + 64 + d; if (lane < 32) { kr[0] = ob; kr[96] = ob; kr[192] = ob; kr[288] = ob; } } }
    }
}
__device__ __forceinline__ void phase_attn(const Ctx& c, bool with_ctx) {
    const bf16* Qb = (const bf16*)(c.ws + WS_H); const bf16* Kb = Qb + (size_t)NTOK * 384; const bf16* VT = Kb + (size_t)NTOK * 384; unsigned char* MIX = c.ws + WS_MIX;
    constexpr int KROW = 208, VROW = 144, KBUF = 64 * KROW, VBUF = 64 * VROW;
    LAS unsigned char* Kt = c.lds; LAS unsigned char* Vt = c.lds + 2 * KBUF;
    const int lane = c.lane, ln = lane & 31, hh = lane >> 5, tid = c.tid;
    const int nunits = with_ctx ? 1152 : 1024;
    for (int L = c.blk; L < nunits; L += c.G) {
        int u = L;
        if (c.G == 256 && L < 1024) { const int r = L >> 8, x = L & 7, j = (L & 255) >> 3; u = ((r * 32 + x * 4 + (j >> 3)) << 3) | (j & 7); }
        int b, h, qrow0, kt0, nkt;
        if (u < 1024) { b = u >> 5; h = (u >> 3) & 3; qrow0 = b * SEQ + (u & 7) * 256; kt0 = 0; nkt = 36; } else { const int q = u - 1024; b = q >> 2; h = q & 3; qrow0 = NLAT + b * CTXL; kt0 = 32; nkt = 4; }
        const bf16* vtb = VT + (size_t)((b * 4 + h) * 64) * 2304;
        bf16x8 qf[6];
        { const bf16* qr = Qb + (size_t)(qrow0 + 32 * c.wave + ln) * 384 + h * 96 + 8 * hh;
#pragma unroll
          for (int ks = 0; ks < 6; ++ks) qf[ks] = *(const bf16x8*)(qr + 16 * ks); }
        if (u < 1024) {
            const float* ROPE = (const float*)(c.ws + WS_TAB + TAB_ROPE) + (size_t)((qrow0 + 32 * c.wave + ln) & 2047) * 32;
#pragma unroll
            for (int ax = 0; ax < 2; ++ax) { const u32x4 own = __builtin_bit_cast(u32x4, qf[4 + ax]); u32x4 oth, res;
#pragma unroll
                for (int i = 0; i < 4; ++i) { const auto sw = __builtin_amdgcn_permlane32_swap(own[i], own[i], false, false); oth[i] = hh ? sw[0] : sw[1]; }
#pragma unroll
                for (int i = 0; i < 4; ++i) { const f32x4 cs = *(const f32x4*)(ROPE + ax * 16 + 4 * i);
                    const float v0 = __uint_as_float(own[i] << 16), v1 = __uint_as_float(own[i] & 0xffff0000u), p0 = __uint_as_float(oth[i] << 16), p1 = __uint_as_float(oth[i] & 0xffff0000u);
                    const float sg = hh ? 1.f : -1.f; res[i] = pk2(fmaf(v0, cs.x, sg * p0 * cs.y), fmaf(v1, cs.z, sg * p1 * cs.w)); }
                qf[4 + ax] = __builtin_bit_cast(bf16x8, res); } }
        f32x16 oacc[2];
#pragma unroll
        for (int i = 0; i < 16; ++i) { oacc[0][i] = 0.f; oacc[1][i] = 0.f; }
        float mrun = 0.f, lsum = 0.f;
        const int k0key = tid / 12, k0pt = tid % 12, k1key = (512 + tid) / 12, k1pt = (512 + tid) % 12; const bool k1on = tid < 256;
        u32x4 sk0, sk1 = (u32x4){0u, 0u, 0u, 0u}, sv;
        auto key_row = [&](int kt, int j) -> int { const int kk = kt * 64 + j; return kk < 2048 ? b * SEQ + kk : NLAT + b * CTXL + (kk - 2048); };
#define ATT_LOAD(kt) do { sk0 = *(const u32x4*)(Kb + (size_t)key_row((kt), k0key) * 384 + h * 96 + k0pt * 8); if (k1on) sk1 = *(const u32x4*)(Kb + (size_t)key_row((kt), k1key) * 384 + h * 96 + k1pt * 8); \
        sv = *(const u32x4*)(vtb + (size_t)(tid >> 3) * 2304 + (kt) * 64 + (tid & 7) * 8); } while (0)
#define ATT_STORE(buf) do { *(LAS u32x4*)(Kt + (buf) * KBUF + k0key * KROW + k0pt * 16) = sk0; if (k1on) *(LAS u32x4*)(Kt + (buf) * KBUF + k1key * KROW + k1pt * 16) = sk1; \
        *(LAS u32x4*)(Vt + (buf) * VBUF + (tid >> 3) * VROW + (tid & 7) * 16) = sv; } while (0)
        __syncthreads();
        ATT_LOAD(kt0); ATT_STORE(0);
        __syncthreads();
        for (int it = 0; it < nkt; ++it) {
            const int cur = it & 1;
            if (it + 1 < nkt) ATT_LOAD(kt0 + it + 1);
            f32x16 sacc[2];
            const float nm = -mrun;
#pragma unroll
            for (int kb = 0; kb < 2; ++kb) {
#pragma unroll
                for (int i = 0; i < 16; ++i) sacc[kb][i] = nm;
#pragma unroll
                for (int ks = 0; ks < 6; ++ks) { const bf16x8 a = *(const LAS bf16x8*)(Kt + cur * KBUF + (32 * kb + ln) * KROW + ks * 32 + hh * 16);
                    sacc[kb] = __builtin_amdgcn_mfma_f32_32x32x16_bf16(a, qf[ks], sacc[kb], 0, 0, 0); } }
            float mx = fmaxf(fmaxf(sacc[0][0], sacc[0][1]), sacc[0][2]);
#pragma unroll
            for (int i = 3; i < 15; i += 2) mx = fmaxf(fmaxf(mx, sacc[0][i]), sacc[0][i + 1]);
            mx = fmaxf(mx, sacc[0][15]);
#pragma unroll
            for (int i = 0; i < 16; i += 2) mx = fmaxf(fmaxf(mx, sacc[1][i]), sacc[1][i + 1]);
            { const auto r = __builtin_amdgcn_permlane32_swap(__float_as_uint(mx), __float_as_uint(mx), false, false); mx = fmaxf(__uint_as_float(r[0]), __uint_as_float(r[1])); }
            if (it == 0 || __builtin_amdgcn_ballot_w64(mx > 8.0f) != 0ull) {
                const float up = it == 0 ? mx : fmaxf(mx, 0.f), alpha = __builtin_amdgcn_exp2f(-up); mrun += up; lsum *= alpha;
#pragma unroll
                for (int i = 0; i < 16; ++i) { oacc[0][i] *= alpha; oacc[1][i] *= alpha; sacc[0][i] -= up; sacc[1][i] -= up; }
            }
            float ps = 0.f;
#pragma unroll
            for (int kb = 0; kb < 2; ++kb)
#pragma unroll
                for (int i = 0; i < 16; ++i) { const float pv = __builtin_amdgcn_exp2f(sacc[kb][i]); sacc[kb][i] = pv; ps += pv; }
            lsum += ps;
            bf16x8 pb[4];
#pragma unroll
            for (int s4 = 0; s4 < 4; ++s4) { const int kb = s4 >> 1, o8 = 8 * (s4 & 1); u32x4 w;
                w.x = pk2(sacc[kb][o8 + 0], sacc[kb][o8 + 1]); w.y = pk2(sacc[kb][o8 + 2], sacc[kb][o8 + 3]); w.z = pk2(sacc[kb][o8 + 4], sacc[kb][o8 + 5]); w.w = pk2(sacc[kb][o8 + 6], sacc[kb][o8 + 7]);
                pb[s4] = __builtin_bit_cast(bf16x8, w); }
#pragma unroll
            for (int db = 0; db < 2; ++db)
#pragma unroll
                for (int s4 = 0; s4 < 4; ++s4) { const bf16x8 a = *(const LAS bf16x8*)(Vt + cur * VBUF + (32 * db + ln) * VROW + s4 * 32 + hh * 16);
                    oacc[db] = __builtin_amdgcn_mfma_f32_32x32x16_bf16(a, pb[s4], oacc[db], 0, 0, 0); }
            if (it + 1 < nkt) ATT_STORE(cur ^ 1);
            __syncthreads();
        }
#undef ATT_LOAD
#undef ATT_STORE
        { const auto r = __builtin_amdgcn_permlane32_swap(__float_as_uint(lsum), __float_as_uint(lsum), false, false); lsum = __uint_as_float(r[0]) + __uint_as_float(r[1]); }
        const float inv = 16.f / lsum;
        unsigned char* dst = MIX + (size_t)(qrow0 + 32 * c.wave + ln) * DM + 768 + h * 64 + 4 * hh;
#pragma unroll
        for (int db = 0; db < 2; ++db)
#pragma unroll
            for (int g4 = 0; g4 < 4; ++g4) *(unsigned*)(dst + 32 * db + 8 * g4) = pk4_fp8(oacc[db][4 * g4] * inv, oacc[db][4 * g4 + 1] * inv, oacc[db][4 * g4 + 2] * inv, oacc[db][4 * g4 + 3] * inv);
    }
    __syncthreads();
}

__device__ __forceinline__ void phase_norm2_route(const Ctx& c, KParams p, int l, int ntok) {
    const float* MOD = (const float*)(c.ws + WS_MOD) + (size_t)l * 33 * 6144;
    const float* xl = l == 0 ? p->in[I_X] : p->out; const float* xc = l == 0 ? p->in[I_CTX] : (const float*)(c.ws + WS_XC);
    bf16* H = (bf16*)(c.ws + WS_H);
    int* TKEP = (int*)(c.ws + WS_RT + RT_TKEP); float* TKW = (float*)(c.ws + WS_RT + RT_TKW); int* TB = (int*)(c.ws + WS_TB);
    int* CNT = (int*)(c.ws + WS_CTL) + CW_CNT + l * NCH * NE;
    constexpr int HROW = 1032;
    LAS bf16* hhi = (LAS bf16*)c.lds;
    LAS bf16* hlo = hhi + 32 * HROW;
    LAS float* lgs = (LAS float*)(c.lds + 132096);
    LAS int* hist = (LAS int*)(c.lds + 140288);
    const bf16* Whi = (const bf16*)(c.ws + WS_TAB + TAB_RWT) + (size_t)(l * 2) * 65536; const bf16* Wlo = Whi + 65536;
    const float rbias = p->in[I_RB][l * 64 + c.lane];
    const int ntiles = ntok / 32, rpc = ntok / NCH, lane = c.lane, mb = c.wave >> 2, nb = c.wave & 3;
    for (int tile = c.blk; tile < ntiles; tile += c.G) {
        __syncthreads();
        if (c.tid < 64) hist[c.tid] = 0;
        for (int q = 0; q < 4; ++q) { const int r = tile * 32 + c.wave * 4 + q; const float* xr = r < NLAT ? xl + (size_t)r * DM : xc + (size_t)(r - NLAT) * DM; const float* m = MOD + (size_t)mod_row(r) * 6144;
            float* xo = r < NLAT ? p->out + (size_t)r * DM : (float*)(c.ws + WS_XC) + (size_t)(r - NLAT) * DM;
            f32x4 v[4]; norm_row_add(xr, (const bf16*)(c.ws + WS_Z) + (size_t)r * DM, xo, p->in[I_N2G] + l * DM, m + 3072, m + 4096, c.ws + WS_H8 + (size_t)r * DM, lane, v);
#pragma unroll
            for (int j = 0; j < 4; ++j) { u32x2 hi; hi.x = pk2(v[j].x, v[j].y); hi.y = pk2(v[j].z, v[j].w);
                const float r0 = v[j].x - __uint_as_float(hi.x << 16), r1 = v[j].y - __uint_as_float(hi.x & 0xffff0000u), r2 = v[j].z - __uint_as_float(hi.y << 16), r3 = v[j].w - __uint_as_float(hi.y & 0xffff0000u);
                u32x2 lo; lo.x = pk2(r0, r1); lo.y = pk2(r2, r3);
                *(LAS u32x2*)(hhi + (c.wave * 4 + q) * HROW + 4 * lane + 256 * j) = hi; *(LAS u32x2*)(hlo + (c.wave * 4 + q) * HROW + 4 * lane + 256 * j) = lo; } }
        __syncthreads();
        { f32x4 acc = (f32x4){0.f, 0.f, 0.f, 0.f};
          const LAS bf16* ah = hhi + (mb * 16 + (lane & 15)) * HROW + 8 * (lane >> 4); const LAS bf16* al = hlo + (mb * 16 + (lane & 15)) * HROW + 8 * (lane >> 4);
          const bf16* bh = Whi + (size_t)(nb * 16 + (lane & 15)) * 1024 + 8 * (lane >> 4); const bf16* bl = Wlo + (size_t)(nb * 16 + (lane & 15)) * 1024 + 8 * (lane >> 4);
#pragma unroll 8
          for (int ks = 0; ks < 32; ++ks) { const bf16x8 a_h = *(const LAS bf16x8*)(ah + 32 * ks), a_l = *(const LAS bf16x8*)(al + 32 * ks), b_h = *(const bf16x8*)(bh + 32 * ks), b_l = *(const bf16x8*)(bl + 32 * ks);
              acc = __builtin_amdgcn_mfma_f32_16x16x32_bf16(a_h, b_h, acc, 0, 0, 0); acc = __builtin_amdgcn_mfma_f32_16x16x32_bf16(a_h, b_l, acc, 0, 0, 0); acc = __builtin_amdgcn_mfma_f32_16x16x32_bf16(a_l, b_h, acc, 0, 0, 0); }
#pragma unroll
          for (int i = 0; i < 4; ++i) lgs[(mb * 16 + 4 * (lane >> 4) + i) * 64 + nb * 16 + (lane & 15)] = acc[i]; }
        __syncthreads();
#pragma unroll
        for (int q = 0; q < 4; ++q) {
            const int r = tile * 32 + c.wave * 4 + q;
            const float s = sigmoidf_(lgs[(c.wave * 4 + q) * 64 + lane]), bs = s + rbias;
            float m1 = bs; m1 = fmaxf(m1, shx<1>(m1)); m1 = fmaxf(m1, shx<2>(m1)); m1 = fmaxf(m1, shx<4>(m1));
            const unsigned long long eq = __ballot(bs == m1); const unsigned gm = (unsigned)(eq >> (lane & 56)) & 0xffu; const int first = __ffs(gm) - 1;
            float m2 = ((lane & 7) == first) ? -1e30f : bs; m2 = fmaxf(m2, shx<1>(m2)); m2 = fmaxf(m2, shx<2>(m2)); m2 = fmaxf(m2, shx<4>(m2));
            const float gs = m1 + m2; const int g = lane >> 3; int rank = 0;
#pragma unroll
            for (int j = 0; j < 8; ++j) { const float o = rdl(gs, 8 * j); rank += (o > gs || (o == gs && j < g)) ? 1 : 0; }
            float cand = rank < 4 ? bs : -1e30f; int my_e = 0; float my_w = 0.f, wsum = 0.f;
#pragma unroll
            for (int k = 0; k < 8; ++k) { const float mm = wave_max(cand); const unsigned long long e2 = __ballot(cand == mm); const int idx = __ffsll((long long)e2) - 1; const float wk = rdl(s, idx);
                if (lane == idx) cand = -1e30f; if (lane == k) { my_e = idx; my_w = wk; } wsum += wk; }
            if (lane < 8) { const int lp = atomicAdd((int*)&hist[my_e], 1); TKEP[(size_t)r * 8 + lane] = my_e | (lp << 8); TKW[(size_t)r * 8 + lane] = my_w / wsum * 2.5f; }
        }
        __syncthreads();
        if (c.tid < 64) { const int n = hist[c.tid]; int base = 0; if (n > 0) base = atomicAdd(&CNT[((tile * 32) / rpc) * NE + c.tid], n); TB[tile * 64 + c.tid] = base; }
    }
    __syncthreads();
}
__device__ __forceinline__ void phase_route_fill(const Ctx& c, int l, int ntok) {
    const int* TKEP = (const int*)(c.ws + WS_RT + RT_TKEP); int* SLOT = (int*)(c.ws + WS_RT + RT_SLOT); const int* TB = (const int*)(c.ws + WS_TB);
    const int* CNT = (const int*)(c.ws + WS_CTL) + CW_CNT + l * NCH * NE; int* ROWL = (int*)(c.ws + WS_ROWL);
    LAS int* est = (LAS int*)c.lds;
    const int rpc = ntok / NCH;
    __syncthreads();
    if (c.tid < NCH) { int s = 0; for (int e = 0; e < NE; ++e) { est[c.tid * 65 + e] = s; s += (CNT[c.tid * NE + e] + 255) & ~255; } est[c.tid * 65 + 64] = s; }
    __syncthreads();
    const size_t na = (size_t)ntok * 8;
    for (size_t a = (size_t)c.blk * NTHR + c.tid; a < na; a += (size_t)c.G * NTHR) { const int t = (int)(a >> 3), ch = t / rpc; const int ep = TKEP[a], e = ep & 255, lp = ep >> 8;
        const int slot = est[ch * 65 + e] + TB[(t >> 5) * 64 + e] + lp; SLOT[a] = slot; ROWL[(size_t)ch * RPCMAX + slot] = t; }
    for (int i = c.blk * NTHR + c.tid; i < NCH * NE * 256; i += c.G * NTHR) { const int ch = i >> 14, e = (i >> 8) & 63, j = i & 255; const int n = CNT[ch * NE + e]; const int pad = ((n + 255) & ~255) - n;
        if (j < pad) ROWL[(size_t)ch * RPCMAX + est[ch * 65 + e] + n + j] = ch * rpc; }
    __syncthreads();
}

__device__ __forceinline__ void moe_tile_table(const Ctx& c, int l, int ch, LAS int* tst) {
    const int* CNT = (const int*)(c.ws + WS_CTL) + CW_CNT + l * NCH * NE + ch * NE;
    LAS unsigned char* texp = (LAS unsigned char*)(tst + 80);
    __syncthreads();
    if (c.tid == 0) { int s = 0; for (int e = 0; e < NE; ++e) { tst[e] = s; s += (CNT[e] + 255) >> 8; } tst[64] = s; }
    __syncthreads();
    if (c.tid < NE) { for (int t = tst[c.tid]; t < tst[c.tid + 1]; ++t) texp[t] = (unsigned char)c.tid; }
    __syncthreads();
}
__device__ __forceinline__ void phase_combine(const Ctx& c, KParams p, int l, int ch, int rpc) {
    const float* MOD = (const float*)(c.ws + WS_MOD) + (size_t)l * 33 * 6144 + 5120; const float* MODn = (const float*)(c.ws + WS_MOD) + (size_t)33 * 6144;
    const int* SLOT = (const int*)(c.ws + WS_RT + RT_SLOT); const float* TKW = (const float*)(c.ws + WS_RT + RT_TKW);
    const unsigned char* OB = (const unsigned char*)(c.ws + WS_OB); const bf16* OBS = (const bf16*)(c.ws + WS_OBS);
    float* xl = p->out; float* xc = (float*)(c.ws + WS_XC); unsigned char* H = c.ws + WS_H;
    const int gw = c.blk * NWAVES + c.wave, NGW = c.G * NWAVES, lane = c.lane;
    const int col0 = (lane >> 4) * 256 + ((lane >> 2) & 3) * 32 + (lane & 3) * 8;
    f32x4 gn[4];
#pragma unroll
    for (int q = 0; q < 4; ++q) gn[q] = *(const f32x4*)((l == 0 ? p->in[I_N1G] + DM : p->in[I_FG]) + col0 + 128 * (q >> 1) + 4 * (q & 1));
    int sl_n = 0; float w_n = 0.f;
    if (gw < rpc && lane < 8) { sl_n = SLOT[(size_t)(ch * rpc + gw) * 8 + lane]; w_n = TKW[(size_t)(ch * rpc + gw) * 8 + lane] * 0.0625f; }
    for (int i = gw; i < rpc; i += NGW) {
        const int t = ch * rpc + i; float* xr = t < NLAT ? xl + (size_t)t * DM : xc + (size_t)(t - NLAT) * DM; const int mr = mod_row(t); const float* g2 = MOD + (size_t)mr * 6144;
        const int sl = sl_n; const float w = w_n;
        u32x4 ob[8], os0, os1; f32x4 xv[4];
#pragma unroll
        for (int e = 0; e < 8; ++e) ob[e] = *(const u32x4*)(OB + (size_t)rdli(sl, e) * 1024 + lane * 16);
        os0 = *(const u32x4*)(OBS + (size_t)i * DM + col0); os1 = *(const u32x4*)(OBS + (size_t)i * DM + col0 + 128);
#pragma unroll
        for (int q = 0; q < 4; ++q) xv[q] = *(const f32x4*)(xr + col0 + 128 * (q >> 1) + 4 * (q & 1));
        if (i + NGW < rpc && lane < 8) { sl_n = SLOT[(size_t)(t + NGW) * 8 + lane]; w_n = TKW[(size_t)(t + NGW) * 8 + lane] * 0.0625f; }
        float a[16]; { float t8[8]; unpack8(os0, t8);
#pragma unroll
            for (int q = 0; q < 8; ++q) a[q] = t8[q];
            unpack8(os1, t8);
#pragma unroll
            for (int q = 0; q < 8; ++q) a[8 + q] = t8[q]; }
#pragma unroll
        for (int e = 0; e < 8; ++e) { const float wk = rdl(w, e);
#pragma unroll
            for (int q = 0; q < 4; ++q) { const f32x2 lo = __builtin_amdgcn_cvt_pk_f32_fp8((int)ob[e][q], false), hi = __builtin_amdgcn_cvt_pk_f32_fp8((int)ob[e][q], true);
                a[4 * q] = fmaf(wk, lo.x, a[4 * q]); a[4 * q + 1] = fmaf(wk, lo.y, a[4 * q + 1]); a[4 * q + 2] = fmaf(wk, hi.x, a[4 * q + 2]); a[4 * q + 3] = fmaf(wk, hi.y, a[4 * q + 3]); } }
        f32x4 xn[4]; float ss = 0.f;
#pragma unroll
        for (int q = 0; q < 4; ++q) { const int cc = col0 + 128 * (q >> 1) + 4 * (q & 1); const f32x4 gv = *(const f32x4*)(g2 + cc);
            xn[q] = xv[q] + gv * (f32x4){a[4 * q], a[4 * q + 1], a[4 * q + 2], a[4 * q + 3]}; ss += (xn[q].x * xn[q].x + xn[q].y * xn[q].y) + (xn[q].z * xn[q].z + xn[q].w * xn[q].w); }
        const float rstd = rsqrtf(wave_sum(ss) * (1.f / 1024.f) + EPS);
        if (l == 0) { const float* mn = MODn + (size_t)mr * 6144; unsigned char* hr = H + (size_t)t * DM;
#pragma unroll
            for (int q = 0; q < 4; ++q) { const int cc = col0 + 128 * (q >> 1) + 4 * (q & 1); *(f32x4*)(xr + cc) = xn[q];
                const f32x4 s0 = *(const f32x4*)(mn + cc), s1 = *(const f32x4*)(mn + 1024 + cc); const f32x4 hv = (xn[q] * rstd * gn[q] * (s1 + 1.0f) + s0) * 4.f;
                *(unsigned*)(hr + cc) = pk4_fp8(hv.x, hv.y, hv.z, hv.w); } }
        else {
#pragma unroll
            for (int q = 0; q < 4; ++q) { const int cc = col0 + 128 * (q >> 1) + 4 * (q & 1); *(f32x4*)(xr + cc) = xn[q] * rstd * gn[q]; } }
    }
}
constexpr int LDS_BYTES = 147456;
constexpr int LDS_TAB = 131072, LDS_XB = LDS_BYTES - 16;
enum { J_INPROJ = 0, J_S5G1, J_PW, J_Q, J_KV, J_S5G2, J_GLU, J_OUT, J_GU, J_GUS, J_DN, J_DNS };
enum { SK_DENSE = 0, SK_S5, SK_MOE };
enum { EK_INPROJ = 0, EK_S5X, EK_S5Y, EK_BIAS, EK_GLU, EK_Q, EK_KV, EK_RESID, EK_SWIGLU, EK_OB8, EK_BF16 };
struct JSched {
    int sk, G, c; pg8::DenseOrder d; const char* W; size_t wexp, wtile; const LAS unsigned char* texp; int ntile, npn;
    __device__ __forceinline__ bool next(int i, pg8::Unit& u) const {
        if (sk == SK_DENSE) return d.next(i, u);
        const int L = i * G + c;
        if (sk == SK_S5) { if (L >= 288) return false; u.pm = L; u.pn = 0; u.e = L / 18; u.B = W + (size_t)u.e * wexp; return true; }
        if (L >= ntile * npn) return false;
        const int T = npn == 2 ? (L >> 1) : (L >> 2), pn = L & (npn - 1); const int e = __builtin_amdgcn_readfirstlane((int)texp[T]);
        u.pm = T; u.pn = pn; u.e = e; u.B = W + (size_t)e * wexp + (size_t)pn * wtile; return true;
    }
};
struct JRows { const int* list; unsigned ldab;
    __device__ __forceinline__ unsigned off(const pg8::Unit& u, int r) const { const int row = u.pm * 256 + r; return (unsigned)(list ? list[row] : row) * ldab; } };
struct JEpi {
    int ek; void* p0; void* p1; void* p2; const void* q0; const void* q1; const void* q2; int i0;
    __device__ __forceinline__ void operator()(EPI_ARGS) const {
        switch (ek) {
        case EK_S5X:    EpiS5X{(bf16*)p0}(acc, u, wr, wc, fr, fq); break;
        case EK_S5Y:    EpiS5Y{(bf16*)p0}(acc, u, wr, wc, fr, fq); break;
        case EK_BIAS:   EpiBiasBf16{(unsigned char*)p0, i0, (const float*)q0}(acc, u, wr, wc, fr, fq); break;
        case EK_GLU:    EpiGluSig{(unsigned char*)p0, i0, (const float*)q0}(acc, u, wr, wc, fr, fq); break;
        case EK_Q:      EpiQ{(bf16*)p0, (const float*)q0}(acc, u, wr, wc, fr, fq); break;
        case EK_KV:     EpiKV{(bf16*)p0, (bf16*)p1, (const float*)q0}(acc, u, wr, wc, fr, fq); break;
        default:        EpiBf16{(bf16*)p0, i0}(acc, u, wr, wc, fr, fq); break;
        }
    }
};
struct JEpi8 {
    int ek; void* p0; int i0; const void* q0; void* p1; void* p2;
    __device__ __forceinline__ void operator()(EPI_ARGS) const {
        if (ek == EK_SWIGLU) EpiSwiglu{(unsigned char*)p0, i0, 1.0f / 256.0f}(acc, u, wr, wc, fr, fq);
        else if (ek == EK_OB8) EpiOB8{(unsigned char*)p0, 16.0f / 1024.0f}(acc, u, wr, wc, fr, fq);
        else if (ek == EK_INPROJ) EpiInProj{(bf16*)p0, (bf16*)p1, (bf16*)p2, 1.0f / 256.0f}(acc, u, wr, wc, fr, fq);
        else if (ek == EK_RESID) EpiDelta{(bf16*)p0, (const float*)q0, 1.0f / 1024.0f}(acc, u, wr, wc, fr, fq);
        else EpiBf16S{(bf16*)p0, i0, 1.0f / 1024.0f}(acc, u, wr, wc, fr, fq);
    }
};
__device__ __forceinline__ void gemm_job(KParams p, LAS unsigned char* lds, int job, int l, int ch) {
    unsigned char* ws = p->ws;
    const int G = gridDim.x, blk = blockIdx.x;
    const bool last = (l == 1); const int nrows = last ? NLAT : NTOK, rpc = nrows / NCH;
    unsigned char* sm = ws + WS_WSM + (size_t)l * WSM_L;
    const LAS int* tst = (const LAS int*)(lds + LDS_TAB);
    auto rot8 = [&](int units) { return ((units % G) + 7) & ~7; };
    auto rotc = [&](int rot) { return (blk + G - rot % G) % G; };
    const char* A = nullptr; int K = 256; bool fp8 = false; JSched S; JRows R; JEpi E;
    S.sk = SK_DENSE; S.G = G; S.c = blk; S.W = nullptr; S.wexp = 0; S.wtile = 0; S.texp = (const LAS unsigned char*)(tst + 80); S.ntile = 0; S.npn = 2; S.d.init(1, 1, G, blk, nullptr, 256);
    R.list = nullptr; R.ldab = 512u; E.ek = EK_BF16; E.p0 = E.p1 = E.p2 = nullptr; E.q0 = E.q1 = E.q2 = nullptr; E.i0 = 0;
    switch (job) {
    case J_INPROJ: A = (const char*)(ws + WS_H); K = 512; fp8 = true; R.ldab = 1024u; S.d.init(NTOK / 256, ZW / 256, G, blk, (const bf16*)(ws + WS_WIN) + (size_t)l * 2048 * 1024, 512);
        E.ek = EK_INPROJ; E.p0 = ws + WS_Z; E.p1 = ws + WS_UP; E.p2 = ws + WS_GVT; break;
    case J_S5G1: A = (const char*)(ws + WS_UP); K = 256; R.ldab = 1024u; S.sk = SK_S5; S.W = (const char*)(ws + WS_S5W) + (size_t)l * 16 * 256 * 256 * 2; S.wexp = (size_t)256 * 256 * 2; E.ek = EK_S5X; E.p0 = ws + WS_Y5; break;
    case J_PW: A = (const char*)(ws + WS_CV); K = 256; R.ldab = 512u; S.d.init(nrows / 256, 1, G, blk, (const bf16*)(sm + WSM_PW), 256); E.ek = EK_BIAS; E.p0 = ws + WS_MIX + 256; E.i0 = DM; E.q0 = p->in[I_CPB] + l * 256; break;
    case J_Q: A = (const char*)(ws + WS_Z) + ZCQ * 2; K = 256; R.ldab = (unsigned)ZW * 2u; S.d.init(NTOK / 256, 2, G, rotc(rot8(nrows / 256)), (const bf16*)(sm + WSM_UQ), 256);
        E.ek = EK_Q; E.p0 = ws + WS_H; E.q0 = ws + WS_RS; break;
    case J_KV: A = (const char*)(ws + WS_Z) + ZCKV * 2; K = 256; R.ldab = (unsigned)ZW * 2u; S.d.init(NTOK / 256, 2, G, rotc(rot8(nrows / 256) + rot8(NTOK / 256 * 2)), (const bf16*)(sm + WSM_UK), 256);
        E.ek = EK_KV; E.p0 = (bf16*)(ws + WS_H) + (size_t)NTOK * 384; E.p1 = (bf16*)(ws + WS_H) + (size_t)NTOK * 768; E.q0 = ws + WS_RS; break;
    case J_S5G2: A = (const char*)(ws + WS_UP); K = 512; R.ldab = 1024u; S.sk = SK_S5; S.W = (const char*)(ws + WS_S5W) + (size_t)32 * 256 * 256 * 2 + (size_t)l * 16 * 256 * 512 * 2; S.wexp = (size_t)256 * 512 * 2; E.ek = EK_S5Y; E.p0 = ws + WS_Y5; break;
    case J_GLU: A = (const char*)(ws + WS_Y5); K = 256; R.ldab = 512u; S.d.init(nrows / 256, 2, G, blk, (const bf16*)(sm + WSM_GLU), 256); E.ek = EK_GLU; E.p0 = ws + WS_MIX + 512; E.i0 = DM; E.q0 = p->in[I_S5GB] + l * 512; break;
    case J_OUT: A = (const char*)(ws + WS_MIX); K = 512; fp8 = true; R.ldab = 1024u; S.d.init(nrows / 256, 4, G, blk, (const bf16*)(ws + WS_WOUT) + (size_t)l * 1024 * 1024, 512);
        E.ek = EK_RESID; E.p0 = ws + WS_Z; E.q0 = (const float*)(ws + WS_MOD) + (size_t)l * 33 * 6144 + 2048; break;
    case J_GU: A = (const char*)(ws + WS_H8); K = 512; fp8 = true; R.list = (const int*)(ws + WS_ROWL) + (size_t)ch * RPCMAX; R.ldab = 1024u; S.sk = SK_MOE; S.ntile = __builtin_amdgcn_readfirstlane(tst[64]); S.npn = 2; S.W = (const char*)(ws + WS_WMOE) + (size_t)l * 48 * MiB; S.wexp = (size_t)512 * 1024; S.wtile = (size_t)256 * 1024;
        E.ek = EK_SWIGLU; E.p0 = ws + WS_HB; E.i0 = 256; break;
    case J_GUS: A = (const char*)(ws + WS_H8) + (size_t)ch * rpc * 1024; K = 512; fp8 = true; R.ldab = 1024u; S.d.init(rpc / 256, 2, G, rotc(rot8(__builtin_amdgcn_readfirstlane(tst[64]) * 2)), (const bf16*)((const unsigned char*)(ws + WS_WSH) + (size_t)l * (512 * 1024 + 1024 * 256) * 2), 512); E.ek = EK_SWIGLU; E.p0 = ws + WS_HBS; E.i0 = 256; break;
    case J_DN: A = (const char*)(ws + WS_HB); K = 128; fp8 = true; R.ldab = 256u; S.sk = SK_MOE; S.ntile = __builtin_amdgcn_readfirstlane(tst[64]); S.npn = 4; S.W = (const char*)(ws + WS_WMOE) + (size_t)l * 48 * MiB + (size_t)NE * 512 * 1024; S.wexp = (size_t)1024 * 256; S.wtile = (size_t)256 * 256;
        E.ek = EK_OB8; E.p0 = ws + WS_OB; break;
    default: A = (const char*)(ws + WS_HBS); K = 128; fp8 = true; R.ldab = 256u; S.d.init(rpc / 256, 4, G, rotc(rot8(__builtin_amdgcn_readfirstlane(tst[64]) * 4)), (const bf16*)((const unsigned char*)(ws + WS_WSH) + (size_t)l * (512 * 1024 + 1024 * 256) * 2 + 512 * 1024), 128); E.ek = EK_BF16; E.p0 = ws + WS_OBS; E.i0 = DM; break;
    }
    __builtin_amdgcn_s_waitcnt(0x0F70);
    if (fp8) pg8::gemm_phase<true>(lds, A, K, S, R, JEpi8{E.ek, E.p0, E.i0, E.q0, E.p1, E.p2});
    else pg8::gemm_phase<false>(lds, A, K, S, R, E);
}


__global__ void __launch_bounds__(NTHR, 2) fwd_kernel(Params pk) {
    extern __shared__ __attribute__((aligned(16))) unsigned char lds_raw[];
    LAS unsigned char* const lds0 = (LAS unsigned char*)lds_raw;
    if (threadIdx.x < 4) ((LAS unsigned*)(lds0 + LDS_XB))[threadIdx.x] = 0u;
    __syncthreads();
    (void)xcd_barrier_post((unsigned*)(pk.ws + WS_CTL) + CW_BAR, (volatile LAS unsigned*)(lds0 + LDS_XB));
    constexpr int NSTEP = 15 + 6 * NCH;
#ifndef PROBE_DUP
#define PROBE_DUP (-9)
#endif
#pragma unroll 1
    for (int it_ = -2; it_ < 2 * NSTEP + (PROBE_DUP >= 0 ? 2 : 0); ++it_) {
        int gs = it_; if (PROBE_DUP >= 0) { if (it_ > PROBE_DUP) gs -= 1; if (it_ > NSTEP + PROBE_DUP + 1) gs -= 1; }
        KParams p = fresh_params(); Ctx c; { int t_ = threadIdx.x; asm volatile("" : "+v"(t_)); c.lds = lds0; c.tid = t_; c.lane = t_ & 63; c.wave = __builtin_amdgcn_readfirstlane(t_ >> 6); c.blk = blockIdx.x; c.G = gridDim.x; c.ws = p->ws; }
        LAS int* tst = (LAS int*)(c.lds + LDS_TAB);
        int l = 0, s = gs, ch = 0, job = -1; bool seam = true;
        if (gs >= 0) { l = gs >= NSTEP ? 1 : 0; s = gs - l * NSTEP; if (s >= 15) { ch = (s - 15) / 6; s = 15 + (s - 15) % 6; } }
        const bool last = (l == 1); const int nrows = last ? NLAT : NTOK, rpc = nrows / NCH;
        switch (s) {
        case -2: prologue(c, p); break;
        case -1: prologue2(c, p); phase_norm1(c, p, 0); break;
        case 0: seam = false; break;
        case 1: job = J_INPROJ; break;
        case 2: phase_gla(c, p, l); phase_conv1(c, p, l, !last); phase_mla_prep(c, p); seam = false; break;
        case 3: job = J_S5G1; break;
        case 4: phase_gla_final(c, p, l, nrows); seam = false; break;
        case 5: job = J_PW; seam = false; break;
        case 6: job = J_Q; seam = false; break;
        case 7: job = J_KV; seam = false; break;
        case 8: phase_s5_carry(c, l); break;
        case 9: phase_attn(c, !last); seam = false; break;
        case 10: job = J_S5G2; break;
        case 11: job = J_GLU; break;
        case 12: job = J_OUT; break;
        case 13: phase_norm2_route(c, p, l, nrows); break;
        case 14: phase_route_fill(c, l, nrows); break;
        case 15: moe_tile_table(c, l, ch, tst); job = J_GU; seam = false; break;
        case 16: job = J_GUS; break;
        case 17: job = J_DN; seam = false; break;
        case 18: job = J_DNS; break;
        case 19: phase_combine(c, p, l, ch, rpc); break;
        default: seam = false; break;
        }
        if (job >= 0) gemm_job(p, c.lds, job, l, ch);
        if (seam && gs + 1 < 2 * NSTEP) { XcdBarrier b_; b_.bar = (unsigned*)(p->ws + WS_CTL) + CW_BAR; b_.x = xb_xcc_id(); b_.st = (volatile LAS unsigned*)(lds0 + LDS_XB); xcd_barrier(b_); }
    }
}

extern "C" void kernel_launch(void* const* d_in, const int* in_sizes, int n_in, void* d_out, int out_size, void* d_ws, size_t ws_size, hipStream_t stream) {
    static int grid = 0;
    if (grid == 0) {
        if (n_in != 42 || out_size != NLAT * DM || ws_size < WS_END) { fprintf(stderr, "kernel_launch: unexpected shapes (n_in %d out %d ws %zu)\n", n_in, out_size, ws_size); grid = -1; return; }
        int dev = 0, cus = 0;
        if (hipGetDevice(&dev) != hipSuccess || hipDeviceGetAttribute(&cus, hipDeviceAttributeMultiprocessorCount, dev) != hipSuccess) { grid = -1; return; }
        if (hipFuncSetAttribute((const void*)fwd_kernel, hipFuncAttributeMaxDynamicSharedMemorySize, LDS_BYTES) != hipSuccess) { fprintf(stderr, "kernel_launch: hipFuncSetAttribute failed\n"); grid = -1; return; }
        int per_cu = 0;
        if (hipOccupancyMaxActiveBlocksPerMultiprocessor(&per_cu, (const void*)fwd_kernel, NTHR, LDS_BYTES) != hipSuccess || per_cu < 1) fprintf(stderr, "kernel_launch: occupancy query reports %d\n", per_cu);
        (void)hipGetLastError();
        grid = cus;
    }
    if (grid < 0) return;
    (void)hipMemsetAsync((char*)d_ws + WS_CTL, 0, CTL_BYTES, stream);
    Params p{};
    for (int i = 0; i < 42; ++i) p.in[i] = (const float*)d_in[i];
    p.out = (float*)d_out; p.ws = (unsigned char*)d_ws; p.ph_lo = 0; p.ph_hi = 1 << 20;
    hipLaunchKernelGGL(fwd_kernel, dim3(grid), dim3(NTHR), LDS_BYTES, stream, p);
}
```

```cpp
#include <hip/hip_runtime.h>
#include <cstdio>
#include <cstdint>

#define LAS __attribute__((address_space(3)))
typedef unsigned short bf16;
typedef short bf16x8 __attribute__((ext_vector_type(8)));
typedef float f32x4 __attribute__((ext_vector_type(4)));
typedef float f32x2 __attribute__((ext_vector_type(2)));
typedef float f32x16 __attribute__((ext_vector_type(16)));
typedef unsigned u32x4 __attribute__((ext_vector_type(4)));
typedef unsigned u32x2 __attribute__((ext_vector_type(2)));
typedef int i32x4 __attribute__((ext_vector_type(4)));
typedef int i32x8 __attribute__((ext_vector_type(8)));

constexpr int NB = 32, SEQ = 2048, CTXL = 256, DM = 1024;
constexpr int NLAT = NB * SEQ, NCTX = NB * CTXL, NTOK = NLAT + NCTX;
constexpr int ZW = 2048;
constexpr int ZQ = 0, ZK = 128, ZV = 256, ZR = 512, ZCA = 768, ZCG = 1024, ZS5 = 1280, ZCQ = 1536, ZCKV = 1792, ZKR = 1920, ZAF = 1952, ZAB = 1968;
constexpr int NE = 64, TOPK = 8;
constexpr int NCH = 2;
constexpr int RPCMAX = (NTOK / NCH) * 8 + 64 * 256;
constexpr float EPS = 1e-6f;
constexpr int NWAVES = 8, NTHR = 512;

constexpr size_t MiB = (size_t)1 << 20;
constexpr size_t WS_CTL = 0, CTL_BYTES = 1 * MiB;
constexpr size_t WS_MOD = 1 * MiB;
constexpr size_t WS_TAB = 3 * MiB;
constexpr size_t WS_WSM = 5 * MiB;
constexpr size_t WS_WIN = 8 * MiB;
constexpr size_t WS_WOUT = 16 * MiB;
constexpr size_t WS_WSH = 20 * MiB;
constexpr size_t WS_TB = 23 * MiB;
constexpr size_t WS_RT = 24 * MiB;
constexpr size_t WS_ROWL = 32 * MiB;
constexpr size_t WS_RS = 35 * MiB;
constexpr size_t WS_WMOE = 36 * MiB;
constexpr size_t WS_XC = 132 * MiB;
constexpr size_t WS_H = 164 * MiB;
constexpr size_t WS_H8 = WS_H + 72 * MiB;
constexpr size_t WS_Z = 308 * MiB;
constexpr size_t WS_MIX = 596 * MiB;
constexpr size_t WS_T1 = 740 * MiB;
constexpr size_t WS_UP = 812 * MiB;
constexpr size_t WS_CV = 884 * MiB;
constexpr size_t WS_Y5 = 920 * MiB;
constexpr size_t WS_S5W = 956 * MiB;
constexpr size_t WS_S5P = 968 * MiB;
constexpr size_t WS_GVT = 969 * MiB;
constexpr size_t WS_END = 1005 * MiB;
constexpr size_t WS_HB = WS_Z;
constexpr size_t WS_HBS = WS_Z + 152 * MiB;
constexpr size_t WS_OBS = WS_Z + 170 * MiB;
constexpr size_t WS_OB = WS_MIX;
static_assert((size_t)RPCMAX * 512 <= 152 * MiB && WS_OBS + (size_t)(NTOK / NCH) * 2048 <= WS_MIX && WS_OB + (size_t)RPCMAX * 1024 <= WS_S5W, "MoE overlays");
constexpr int CW_BAR = 0;
constexpr int CW_CNT = 4096;
constexpr size_t WSM_L = 1 * MiB;
constexpr size_t WSM_PW = 0, WSM_GLU = 128 * 1024, WSM_UQ = 384 * 1024, WSM_UK = 640 * 1024, WSM_UV = 768 * 1024;
constexpr size_t TAB_ROPE = 0;
constexpr size_t TAB_S5 = 256 * 1024;
constexpr size_t TAB_RWT = 1536 * 1024;
constexpr size_t RT_TKEP = 0, RT_TKW = 2400000, RT_SLOT = 4800000;

__device__ __forceinline__ float bf2f(bf16 v) { return __uint_as_float(((unsigned)v) << 16); }
typedef __bf16 bf16x2_t __attribute__((ext_vector_type(2)));
__device__ __forceinline__ unsigned pk2(float lo, float hi) { const f32x2 v = {lo, hi}; return __builtin_bit_cast(unsigned, __builtin_convertvector(v, bf16x2_t)); }
__device__ __forceinline__ bf16 f2bf(float f) { return __builtin_bit_cast(unsigned short, (__bf16)f); }
template <int O> __device__ __forceinline__ float shx(float v) {
    return __int_as_float(__builtin_amdgcn_ds_swizzle(__float_as_int(v), (O << 10) | 0x1f)); }
__device__ __forceinline__ float rdl(float v, int l) { return __int_as_float(__builtin_amdgcn_readlane(__float_as_int(v), l)); }
__device__ __forceinline__ int rdli(int v, int l) { return __builtin_amdgcn_readlane(v, l); }
__device__ __forceinline__ float wave_sum(float v) {
    v += shx<1>(v); v += shx<2>(v); v += shx<4>(v); v += shx<8>(v); v += shx<16>(v);
    const auto r = __builtin_amdgcn_permlane32_swap(__float_as_uint(v), __float_as_uint(v), false, false);
    return __uint_as_float(r[0]) + __uint_as_float(r[1]);
}
__device__ __forceinline__ float wave_max(float v) {
    v = fmaxf(v, shx<1>(v)); v = fmaxf(v, shx<2>(v)); v = fmaxf(v, shx<4>(v)); v = fmaxf(v, shx<8>(v)); v = fmaxf(v, shx<16>(v));
    const auto r = __builtin_amdgcn_permlane32_swap(__float_as_uint(v), __float_as_uint(v), false, false);
    return fmaxf(__uint_as_float(r[0]), __uint_as_float(r[1]));
}
__device__ __forceinline__ float sigmoidf_(float x) { return 1.0f / (1.0f + __expf(-x)); }
__device__ __forceinline__ float siluf_(float x) { return x / (1.0f + __expf(-x)); }
__device__ __forceinline__ void unpack8(const u32x4 w, float (&v)[8]) {
    v[0] = __uint_as_float(w.x << 16); v[1] = __uint_as_float(w.x & 0xffff0000u);
    v[2] = __uint_as_float(w.y << 16); v[3] = __uint_as_float(w.y & 0xffff0000u);
    v[4] = __uint_as_float(w.z << 16); v[5] = __uint_as_float(w.z & 0xffff0000u);
    v[6] = __uint_as_float(w.w << 16); v[7] = __uint_as_float(w.w & 0xffff0000u);
}
__device__ __forceinline__ void lds_wait() { asm volatile("s_waitcnt lgkmcnt(0)" ::: "memory"); }

#define XB_TMO      128
#define XB_XCNT(j)  (256  + 64 * (j))
#define XB_XSUB(j)  (1280 + 64 * (j))
#define XB_XGEN(j)  (2304 + 64 * (j))
#define XB_TOP      3328
#define XB_TOPGEN   3392
#define XCD_BAR_WORDS 3456
#define XB_SPIN_CAP (1u << 22)
__device__ __forceinline__ unsigned xb_ld(unsigned* p)              { return __hip_atomic_load(p, __ATOMIC_RELAXED, __HIP_MEMORY_SCOPE_AGENT); }
__device__ __forceinline__ unsigned xb_add(unsigned* p, unsigned v) { return __hip_atomic_fetch_add(p, v, __ATOMIC_RELAXED, __HIP_MEMORY_SCOPE_AGENT); }
__device__ __forceinline__ unsigned xb_xcc_id() { return (unsigned)__builtin_amdgcn_s_getreg((3 << 11) | 20) & 0xFu; }
#define XB_SPIN(cond, bar) do { unsigned _sp = 0; while (cond) { __builtin_amdgcn_s_sleep(1); \
    if ((++_sp & 255u) == 0u) { if (xb_ld(&(bar)[XB_TMO])) break; if (_sp > XB_SPIN_CAP) { atomicAdd(&(bar)[XB_TMO], 1u); break; } } } } while (0)
struct XcdBarrier { unsigned* bar; unsigned x; volatile LAS unsigned* st; };
__device__ __forceinline__ XcdBarrier xcd_barrier_post(unsigned* bar, volatile LAS unsigned* st) {
    XcdBarrier b; b.bar = bar; b.x = xb_xcc_id(); b.st = st;
    if (threadIdx.x == 0) (void)xb_add(&bar[XB_XCNT(b.x)], 1u);
    return b;
}
__device__ __forceinline__ void xcd_barrier_complete(unsigned* bar, unsigned x, unsigned& nloc, unsigned& nx) {
    const unsigned G = gridDim.x * gridDim.y * gridDim.z;
    unsigned sum, cnt, mine, sp = 0u;
    for (;;) {
        sum = 0u; cnt = 0u; mine = 0u;
#pragma unroll
        for (unsigned j = 0; j < 16; ++j) { const unsigned c = xb_ld(&bar[XB_XCNT(j)]); sum += c; cnt += (c > 0u) ? 1u : 0u; mine = (j == x) ? c : mine; }
        if (sum == G) break;
        __builtin_amdgcn_s_sleep(1);
        if ((++sp & 255u) == 0u) { if (xb_ld(&bar[XB_TMO])) break; if (sp > XB_SPIN_CAP) { atomicAdd(&bar[XB_TMO], 1u); break; } }
    }
    nloc = mine > 0u ? mine : 1u; nx = cnt > 0u ? cnt : 1u;
}
__device__ __forceinline__ void xcd_barrier(const XcdBarrier& b) {
    asm volatile("s_waitcnt vmcnt(0)" ::: "memory");
    __syncthreads();
    if (threadIdx.x == 0) {
        unsigned* bar = b.bar;
        __builtin_amdgcn_s_waitcnt(0);
        unsigned nloc = b.st[0], nx = b.st[1];
        if (nloc == 0u) { xcd_barrier_complete(bar, b.x, nloc, nx); b.st[0] = nloc; b.st[1] = nx; }
        const unsigned old = xb_add(&bar[XB_XSUB(b.x)], 1u);
        const unsigned gen = old / nloc;
        if (old + 1u == (gen + 1u) * nloc) {
            __builtin_amdgcn_fence(__ATOMIC_RELEASE, "agent");
            asm volatile("s_waitcnt vmcnt(0)" ::: "memory");
            const unsigned og = xb_add(&bar[XB_TOP], 1u);
            const unsigned tg = og / nx;
            if (og + 1u == (tg + 1u) * nx) xb_add(&bar[XB_TOPGEN], 1u);
            else XB_SPIN(xb_ld(&bar[XB_TOPGEN]) == tg, bar);
            __builtin_amdgcn_fence(__ATOMIC_ACQUIRE, "agent");
            xb_add(&bar[XB_XGEN(b.x)], 1u);
            asm volatile("s_waitcnt vmcnt(0)" ::: "memory");
        } else {
            XB_SPIN(xb_ld(&bar[XB_XGEN(b.x)]) == gen, bar);
            __builtin_amdgcn_fence(__ATOMIC_ACQUIRE, "agent");
            asm volatile("s_waitcnt vmcnt(0)" ::: "memory");
        }
    }
    __syncthreads();
}

namespace pg8 {
constexpr int BM = 256, BK = 64, HALF = 128, HTB = HALF * BK * 2, STAGE_BYTES = 8 * HTB, NXCD = 8, WGM = 8;
__device__ __forceinline__ int lds_byte(int r, int c) { const int st = (r >> 4) * 2 + (c >> 5), rr = r & 15, cc = c & 31, ob = rr * 64 + cc * 2; return st * 1024 + (ob ^ (((ob >> 9) & 1) << 5)); }
__device__ __forceinline__ void stage_rc(int b, int& R, int& C) { const int st = b / 1024, sb = b % 1024, swz = sb ^ (((sb >> 9) & 1) << 5); R = (st >> 1) * 16 + swz / 64; C = (st & 1) * 32 + (swz % 64) / 2; }
__device__ __forceinline__ int perm32(int rho) { const int n = rho >> 4, i = rho & 15; return 8 * (i >> 2) + 4 * n + (i & 3); }

struct Unit { int pm, pn, e; const char* B; };

struct DenseOrder {
    int nM, nN, nwg, G, c; const char* Bt; size_t btile;
    __device__ __forceinline__ void init(int nM_, int nN_, int G_, int c_, const bf16* Bt_, int K) { nM = nM_; nN = nN_; nwg = nM * nN; G = G_; c = c_; Bt = (const char*)Bt_; btile = (size_t)256 * K * 2; }
    __device__ __forceinline__ bool next(int i, Unit& u) const {
        const long L = (long)i * G + c; if (L >= nwg) return false;
        int wgid = (int)L; { const int q = nwg / NXCD, r = nwg % NXCD, xcd = wgid % NXCD, off = wgid / NXCD; wgid = (xcd < r ? xcd * (q + 1) : r * (q + 1) + (xcd - r) * q) + off; }
        const int nig = WGM * nN, gid = wgid / nig, fm = gid * WGM, gsz = (nM - fm) < WGM ? (nM - fm) : WGM;
        u.pm = fm + ((wgid % nig) % gsz); u.pn = (wgid % nig) / gsz; u.e = 0; u.B = Bt + (size_t)u.pn * btile; return true;
    }
};
struct RowsDense { unsigned ldab; __device__ __forceinline__ unsigned off(const Unit& u, int r) const { return (unsigned)(u.pm * 256 + r) * ldab; } };
struct RowsGather { const int* list; unsigned ldab; __device__ __forceinline__ unsigned off(const Unit& u, int r) const { return (unsigned)list[u.pm * 256 + r] * ldab; } };

template <bool FP8, class Epi, class Sched, class Rows>
__device__ __forceinline__ void gemm_phase(LAS unsigned char* lds, const char* Abase, const int K, const Sched& S, const Rows& RW, const Epi& E) {
    int tid_ = threadIdx.x; asm volatile("" : "+v"(tid_));
    const int tid = tid_, wid = __builtin_amdgcn_readfirstlane(tid >> 6), lane = tid & 63, wr = wid >> 2, wc = wid & 3, fr = lane & 15, fq = lane >> 4;
    const int nt = K / BK;
    int sR[2]; unsigned sC[2], voffB[2];
#pragma unroll
    for (int i = 0; i < 2; ++i) { int R, C; stage_rc(tid * 16 + i * 8192, R, C); sR[i] = R; sC[i] = (unsigned)C * 2u; const int Rb = (R & ~31) + perm32(R & 31); voffB[i] = (unsigned)(Rb * K + C) * 2u; }
    const size_t kstep = (size_t)(BK * 2);
    const size_t hstepB = (size_t)HALF * K * 2;
    const unsigned ldsw = (unsigned)wid * 1024u;
    const int aoff = lds_byte(wr * 64 + fr, fq * 8), boff = lds_byte(wc * 32 + fr, fq * 8);
#define PG8_SA(b, h) (((b) * 2 + (h)) * HTB)
#define PG8_SB(b, h) ((4 + (b) * 2 + (h)) * HTB)
#define PG8_STAGE(bufoff, gbase, voff) do { const char* _gb = (const char*)(gbase); asm volatile("" : "+s"(_gb)); _Pragma("unroll") for (int _i = 0; _i < 2; ++_i) { unsigned _o = (voff)[_i]; asm volatile("" : "+v"(_o)); \
        __builtin_amdgcn_global_load_lds((const unsigned*)(_gb + _o), (LAS unsigned*)(lds + (bufoff) + ldsw + _i * 8192), 16, 0, 0); } } while (0)
#define PG8_LDA(dst, b, h) do { _Pragma("unroll") for (int m = 0; m < 4; ++m) dst[m] = PG8_CAT(*(const LAS i32x4*)(lds + PG8_SA(b, h) + aoff + m * 2048), *(const LAS i32x4*)(lds + PG8_SA(b, h) + aoff + m * 2048 + 1024)); } while (0)
#define PG8_LDB(dst, b, h) do { _Pragma("unroll") for (int n = 0; n < 2; ++n) dst[n] = PG8_CAT(*(const LAS i32x4*)(lds + PG8_SB(b, h) + boff + n * 2048), *(const LAS i32x4*)(lds + PG8_SB(b, h) + boff + n * 2048 + 1024)); } while (0)
#define PG8_CAT(x0, x1) __builtin_shufflevector((x0), (x1), 0, 1, 2, 3, 4, 5, 6, 7)
#define PG8_LO(x) __builtin_bit_cast(bf16x8, __builtin_shufflevector((x), (x), 0, 1, 2, 3))
#define PG8_HI(x) __builtin_bit_cast(bf16x8, __builtin_shufflevector((x), (x), 4, 5, 6, 7))
#define PG8_MMA(ai, bj, At, Bt) do { __builtin_amdgcn_s_setprio(1); \
        if (FP8) { _Pragma("unroll") for (int m = 0; m < 4; ++m) _Pragma("unroll") for (int n = 0; n < 2; ++n) \
            acc[ai][bj][m][n] = __builtin_amdgcn_mfma_scale_f32_16x16x128_f8f6f4(Bt[n], At[m], acc[ai][bj][m][n], 0, 0, 0, 0x7f7f7f7f, 0, 0x7f7f7f7f); } \
        else { _Pragma("unroll") for (int m = 0; m < 4; ++m) _Pragma("unroll") for (int n = 0; n < 2; ++n) { \
            acc[ai][bj][m][n] = __builtin_amdgcn_mfma_f32_16x16x32_bf16(PG8_LO(Bt[n]), PG8_LO(At[m]), acc[ai][bj][m][n], 0, 0, 0); \
            acc[ai][bj][m][n] = __builtin_amdgcn_mfma_f32_16x16x32_bf16(PG8_HI(Bt[n]), PG8_HI(At[m]), acc[ai][bj][m][n], 0, 0, 0); } } \
        __builtin_amdgcn_s_setprio(0); } while (0)
#define PG8_WAIT_V(n) asm volatile("s_waitcnt vmcnt(" #n ")" ::: "memory")
#define PG8_WAIT_L(n) asm volatile("s_waitcnt lgkmcnt(" #n ")" ::: "memory")
#define PG8_BAR __builtin_amdgcn_s_barrier()
#define PG8_SCHED __builtin_amdgcn_sched_barrier(0)
    Unit cur, nxt; int ui = 0;
    if (!S.next(0, cur)) return;
    f32x4 acc[2][2][4][2];
#pragma unroll
    for (int a = 0; a < 2; ++a)
#pragma unroll
        for (int b = 0; b < 2; ++b)
#pragma unroll
            for (int m = 0; m < 4; ++m)
#pragma unroll
                for (int n = 0; n < 2; ++n) acc[a][b][m][n] = (f32x4){0.f, 0.f, 0.f, 0.f};
    i32x8 At[4], B0[2], B1[2];
    unsigned oA0[2], oA1[2];
#pragma unroll
    for (int i = 0; i < 2; ++i) { oA0[i] = RW.off(cur, sR[i]) + sC[i]; oA1[i] = RW.off(cur, HALF + sR[i]) + sC[i]; }
    const char* cB = cur.B;
    PG8_STAGE(PG8_SB(0, 0), cB, voffB); PG8_STAGE(PG8_SB(0, 1), cB + hstepB, voffB); PG8_STAGE(PG8_SA(0, 0), Abase, oA0); PG8_STAGE(PG8_SA(0, 1), Abase, oA1);
    if (wr == 1) PG8_BAR;
    PG8_WAIT_V(2); PG8_BAR;
    PG8_STAGE(PG8_SB(1, 0), cB + kstep, voffB); PG8_STAGE(PG8_SA(1, 0), Abase + kstep, oA0); PG8_STAGE(PG8_SB(1, 1), cB + hstepB + kstep, voffB);
    PG8_WAIT_V(6); PG8_BAR;
    for (;;) {
        const bool has_next = S.next(ui + 1, nxt);
        unsigned gi0 = 0u, gi1 = 0u, gi2 = 0u, gi3 = 0u;
        if (has_next && RW.list) {
            int t2 = threadIdx.x; asm volatile("" : "+v"(t2)); int R0, C0, R1, C1; stage_rc(t2 * 16, R0, C0); stage_rc(t2 * 16 + 8192, R1, C1);
            const int* lb = RW.list + (size_t)nxt.pm * 256; const unsigned o0 = (unsigned)R0 * 4u, o1 = (unsigned)R1 * 4u, o2 = (unsigned)(HALF + R0) * 4u, o3 = (unsigned)(HALF + R1) * 4u;
            asm volatile("global_load_dword %0, %4, %8\n\tglobal_load_dword %1, %5, %8\n\tglobal_load_dword %2, %6, %8\n\tglobal_load_dword %3, %7, %8"
                         : "=&v"(gi0), "=&v"(gi1), "=&v"(gi2), "=&v"(gi3) : "v"(o0), "v"(o1), "v"(o2), "v"(o3), "s"(lb));
        }
#pragma unroll 1
        for (int t = 0; t < nt; t += 2) {
            const bool last = (t == nt - 2);
            const char* a1 = Abase + (size_t)(t + 1) * kstep;
            PG8_LDB(B0, 0, 0); PG8_LDB(B1, 0, 1); PG8_SCHED; PG8_LDA(At, 0, 0); PG8_STAGE(PG8_SA(1, 1), a1, oA1);
            PG8_WAIT_V(8); PG8_WAIT_L(0); PG8_BAR; PG8_MMA(0, 0, At, B0); PG8_MMA(0, 1, At, B1); PG8_BAR; PG8_SCHED;
            const char* a2; const char* b2;
            if (last) {
                if (has_next) {
                    int t2 = threadIdx.x; asm volatile("" : "+v"(t2));
#pragma unroll
                    for (int i = 0; i < 2; ++i) { int R, C; stage_rc(t2 * 16 + i * 8192, R, C);
                        if (RW.list) { asm volatile("" : "+v"(gi0), "+v"(gi1), "+v"(gi2), "+v"(gi3)); oA0[i] = (i ? gi1 : gi0) * RW.ldab + (unsigned)C * 2u; oA1[i] = (i ? gi3 : gi2) * RW.ldab + (unsigned)C * 2u; }
                        else { oA0[i] = (unsigned)(nxt.pm * 256 + R) * RW.ldab + (unsigned)C * 2u; oA1[i] = (unsigned)(nxt.pm * 256 + HALF + R) * RW.ldab + (unsigned)C * 2u; } }
                    cB = nxt.B;
                }
                a2 = Abase; b2 = cB;
            } else { a2 = Abase + (size_t)(t + 2) * kstep; b2 = cB + (size_t)(t + 2) * kstep; }
            const char* a3 = a2 + kstep; const char* b3 = b2 + kstep;
            PG8_LDA(At, 0, 1); PG8_STAGE(PG8_SB(0, 0), b2, voffB); PG8_STAGE(PG8_SB(0, 1), b2 + hstepB, voffB); PG8_STAGE(PG8_SA(0, 0), a2, oA0);
            PG8_WAIT_V(8); PG8_WAIT_L(0); PG8_BAR; PG8_MMA(1, 0, At, B0); PG8_MMA(1, 1, At, B1); PG8_BAR; PG8_SCHED;
            PG8_LDB(B0, 1, 0); PG8_LDB(B1, 1, 1); PG8_SCHED; PG8_LDA(At, 1, 0); PG8_STAGE(PG8_SA(0, 1), a2, oA1);
            PG8_WAIT_V(8); PG8_WAIT_L(0); PG8_BAR; PG8_MMA(0, 0, At, B0); PG8_MMA(0, 1, At, B1); PG8_BAR; PG8_SCHED;
            PG8_LDA(At, 1, 1); PG8_STAGE(PG8_SB(1, 0), b3, voffB); PG8_STAGE(PG8_SB(1, 1), b3 + hstepB, voffB); PG8_STAGE(PG8_SA(1, 0), a3, oA0);
            PG8_WAIT_V(8); PG8_WAIT_L(0); PG8_BAR; PG8_MMA(1, 0, At, B0); PG8_MMA(1, 1, At, B1); PG8_BAR; PG8_SCHED;
        }
        if (wr == 0) PG8_BAR;
        { Unit eu = cur; asm volatile("" : "+s"(eu.pm), "+s"(eu.pn)); int t3 = threadIdx.x; asm volatile("" : "+v"(t3)); E(acc, eu, wr, wc, t3 & 15, (t3 & 63) >> 4); }
        if (!has_next) break;
#pragma unroll
        for (int a = 0; a < 2; ++a)
#pragma unroll
            for (int b = 0; b < 2; ++b)
#pragma unroll
                for (int m = 0; m < 4; ++m)
#pragma unroll
                    for (int n = 0; n < 2; ++n) acc[a][b][m][n] = (f32x4){0.f, 0.f, 0.f, 0.f};
        cur = nxt; ++ui;
        if (wr == 1) PG8_BAR;
    }
    PG8_WAIT_V(0);
    PG8_BAR;
#undef PG8_SA
#undef PG8_SB
#undef PG8_STAGE
#undef PG8_LDA
#undef PG8_LDB
#undef PG8_MMA
#undef PG8_CAT
#undef PG8_LO
#undef PG8_HI
#undef PG8_WAIT_V
#undef PG8_WAIT_L
#undef PG8_BAR
#undef PG8_SCHED
}
}

struct Params { const float* in[42]; float* out; unsigned char* ws; int ph_lo, ph_hi; };
enum { I_X = 0, I_C, I_CTX, I_CCTX, I_ADAW, I_ADAB, I_N1G, I_N2G, I_WIN, I_WOUT, I_GLAW, I_GLAB, I_GLAG, I_CDW, I_CDB, I_CLG, I_CLB, I_CPW, I_CPB,
       I_S5LR, I_S5LI, I_S5DT, I_S5BR, I_S5BI, I_S5CR, I_S5CI, I_S5D, I_S5GW, I_S5GB, I_QNG, I_KVNG, I_WUQ, I_WUKV, I_RW, I_RB, I_MG, I_MU, I_MD, I_SG, I_SU, I_SD, I_FG };

typedef const __attribute__((address_space(4))) Params* KParams;
__device__ __forceinline__ KParams fresh_params() { KParams kp = (KParams)__builtin_amdgcn_kernarg_segment_ptr(); asm volatile("" : "+s"(kp)); return kp; }
struct Ctx {
    LAS unsigned char* lds;
    int tid, lane, wave, blk, G;
    unsigned char* ws;
};

__device__ __forceinline__ int mod_row(int r) { return r < NLAT ? (r >> 11) : 32; }

__device__ __forceinline__ unsigned pk4_fp8(float a, float b, float c2, float d) {
    int pk = __builtin_amdgcn_cvt_pk_fp8_f32(__builtin_amdgcn_fmed3f(a, -440.f, 440.f), __builtin_amdgcn_fmed3f(b, -440.f, 440.f), 0, false);
    pk = __builtin_amdgcn_cvt_pk_fp8_f32(__builtin_amdgcn_fmed3f(c2, -440.f, 440.f), __builtin_amdgcn_fmed3f(d, -440.f, 440.f), pk, true); return (unsigned)pk; }
template <bool F8 = false>
__device__ __forceinline__ void tr_item(const float* W, int ldw, int k0, int n0, bf16* dst, int ldk, const float* kscale, float sc, LAS float* scr, int lane) {
    float tv[32];
#pragma unroll
    for (int i = 0; i < 32; ++i) tv[i] = W[(size_t)(k0 + 2 * i + (lane >> 5)) * ldw + n0 + (lane & 31)];
#pragma unroll
    for (int i = 0; i < 32; ++i) { const int kk = 2 * i + (lane >> 5); float v = tv[i] * sc; if (kscale) v *= kscale[k0 + kk]; scr[kk * 33 + (lane & 31)] = v; }
    lds_wait();
    const int c = lane & 7;
#pragma unroll
    for (int j = 0; j < 4; ++j) { const int n = (lane >> 3) + 8 * j; const LAS float* s = scr + (8 * c) * 33 + n;
        if (F8) { u32x2 o; o.x = pk4_fp8(s[0 * 33], s[1 * 33], s[2 * 33], s[3 * 33]); o.y = pk4_fp8(s[4 * 33], s[5 * 33], s[6 * 33], s[7 * 33]); *(u32x2*)((unsigned char*)dst + (size_t)n * ldk + k0 + 8 * c) = o; }
        else { u32x4 o; o.x = pk2(s[0 * 33], s[1 * 33]); o.y = pk2(s[2 * 33], s[3 * 33]); o.z = pk2(s[4 * 33], s[5 * 33]); o.w = pk2(s[6 * 33], s[7 * 33]);
            *(u32x4*)(dst + (size_t)n * ldk + k0 + 8 * c) = o; } }
    lds_wait();
}
template <int KIND> __device__ __forceinline__ int tr_dst(int n0) {
    if (KIND == 0) return n0;
    if (KIND == 1) return n0 < 768 ? n0 : (n0 == 768 ? 1952 : n0 - 32);
    if (KIND == 2) { const int half = n0 >> 8, c = n0 & 255; return (c >> 7) * 256 + half * 128 + (c & 127); }
    if (KIND == 3) { const int head = n0 / 96, d0 = n0 % 96; return d0 < 64 ? head * 64 + d0 : 256 + head * 32; }
    if (KIND == 4) { const int head = n0 >> 7, d0 = n0 & 127; return d0 < 64 ? head * 64 + d0 : 256 + head * 64 + (d0 - 64); }
    if (KIND == 5) return (n0 >> 7) * 256 + (n0 & 127);
    if (KIND == 6) return (n0 >> 7) * 256 + 128 + (n0 & 127);
    return n0;
}
template <int KIND, bool F8 = false> __device__ __forceinline__ void tr_matrix(const Ctx& c, const float* W, int ldw, int K, int Nsrc, bf16* WT, int ldk, const float* kscale, float sc) {
    LAS float* scr = (LAS float*)(c.lds + c.wave * 8704);
    const int gw = c.blk * NWAVES + c.wave, NGW = c.G * NWAVES, ng = Nsrc / 32, items = (K / 64) * ng;
    for (int it = gw; it < items; it += NGW) { const int kb = it / ng, g = it % ng; tr_item<F8>(W, ldw, kb * 64, 32 * g, F8 ? (bf16*)((unsigned char*)WT + (size_t)tr_dst<KIND>(32 * g) * ldk) : WT + (size_t)tr_dst<KIND>(32 * g) * ldk, ldk, kscale, sc, scr, c.lane); }
}
__device__ __forceinline__ void zero_fill16(const Ctx& c, void* p, size_t bytes) {
    u32x4* q = (u32x4*)p; const size_t n = bytes / 16;
    for (size_t i = (size_t)c.blk * NTHR + c.tid; i < n; i += (size_t)c.G * NTHR) q[i] = (u32x4){0u, 0u, 0u, 0u};
}
__device__ __forceinline__ void sincos_r(float x, float& s, float& co) {
    const float n = rintf(x * 0.15915494309189535f);
    float r = fmaf(n, -6.28125f, x); r = fmaf(n, -1.9353071795864769e-3f, r);
    s = __sinf(r); co = __cosf(r);
}

__device__ __forceinline__ void prologue_moe_weights(const Ctx& c, KParams p, int l) {
    unsigned char* WGU8 = c.ws + WS_WMOE + (size_t)l * 48 * MiB;
    unsigned char* WD8 = WGU8 + (size_t)NE * 512 * 1024;
    LAS float* scr = (LAS float*)(c.lds + c.wave * 8704);
    const int gw = c.blk * NWAVES + c.wave, NGW = c.G * NWAVES;
    for (int it = gw; it < NE * 384; it += NGW) {
        const int e = it / 384, r = it % 384;
        if (r < 256) { const int up = r >> 7, q = r & 127, kb = q >> 3, g = q & 7;
            const float* W = p->in[up ? I_MU : I_MG] + ((size_t)l * NE + e) * 1024 * 256;
            const int nd = up ? tr_dst<6>(32 * g) : tr_dst<5>(32 * g);
            tr_item<true>(W, 256, kb * 64, 32 * g, (bf16*)(WGU8 + (size_t)e * 512 * 1024 + (size_t)nd * 1024), 1024, nullptr, 64.f, scr, c.lane);
        } else { const int q = r - 256, kb = q >> 5, g = q & 31;
            const float* W = p->in[I_MD] + ((size_t)l * NE + e) * 256 * 1024;
            tr_item<true>(W, 1024, kb * 64, 32 * g, (bf16*)(WD8 + (size_t)e * 1024 * 256 + (size_t)(32 * g) * 256), 256, nullptr, 64.f, scr, c.lane);
        }
    }
}

__device__ __forceinline__ void prologue(const Ctx& c, KParams p) {
    float* MOD = (float*)(c.ws + WS_MOD);
    {
        const int u = c.G - 1 - c.blk;
        if (u < 96) {
            LAS float* sc = (LAS float*)(c.lds + 72 * 1024);
            LAS float* part = (LAS float*)c.lds;
            const int l = u / 48, kq = c.tid >> 7, cj = c.tid & 127, col = (u % 48) * 128 + cj;
            const float* W = p->in[I_ADAW] + (size_t)l * 1024 * 6144;
            float acc[33];
#pragma unroll
            for (int b = 0; b < 33; ++b) acc[b] = 0.f;
            for (int j = 0; j < 4; ++j) {
                __syncthreads();
                for (int i = c.tid; i < 4 * 33 * 64; i += NTHR) { const int q = i / (33 * 64), r = i % (33 * 64), b = r >> 6, kk = r & 63, k = 256 * q + 64 * j + kk; const float v = b < 32 ? p->in[I_C][b * 1024 + k] : p->in[I_CCTX][k]; sc[i] = siluf_(v); }
                __syncthreads();
                const float* wp = W + (size_t)(256 * kq + 64 * j) * 6144 + col; const LAS float* sq = sc + kq * 33 * 64;
#pragma unroll 8
                for (int kk = 0; kk < 64; ++kk) { const float w = wp[(size_t)kk * 6144];
#pragma unroll
                    for (int b = 0; b < 33; ++b) acc[b] = fmaf(sq[b * 64 + kk], w, acc[b]); }
            }
#pragma unroll
            for (int b = 0; b < 33; ++b) part[(kq * 33 + b) * 128 + cj] = acc[b];
            __syncthreads();
            for (int i = c.tid; i < 33 * 128; i += NTHR) { const int b = i >> 7, cc = i & 127, gc = (u % 48) * 128 + cc;
                MOD[((size_t)l * 33 + b) * 6144 + gc] = (part[(0 * 33 + b) * 128 + cc] + part[(1 * 33 + b) * 128 + cc]) + (part[(2 * 33 + b) * 128 + cc] + part[(3 * 33 + b) * 128 + cc]) + p->in[I_ADAB][l * 6144 + gc]; }
            __syncthreads();
        }
    }
    {
        float* ROPE = (float*)(c.ws + WS_TAB + TAB_ROPE);
        for (int i = c.blk * NTHR + c.tid; i < 2048 * 16; i += c.G * NTHR) { const int t = i >> 4, ax = (i >> 3) & 1, f = i & 7;
            const float pos = (float)(ax == 0 ? (t >> 6) : (t & 63)); const float inv = __expf(-(float)f * (9.210340371976184f / 8.0f));
            float s, co; sincos_r(pos * inv, s, co); ROPE[i * 2] = co; ROPE[i * 2 + 1] = s; }
        bf16* RWT = (bf16*)(c.ws + WS_TAB + TAB_RWT);
        for (int i = c.blk * NTHR + c.tid; i < 2 * 64 * 1024; i += c.G * NTHR) { const int l = i >> 16, n = (i >> 10) & 63, k = i & 1023; const float wv = p->in[I_RW][((size_t)l * 1024 + k) * 64 + n];
            const bf16 hi = f2bf(wv); RWT[(size_t)(l * 2) * 65536 + n * 1024 + k] = hi; RWT[(size_t)(l * 2 + 1) * 65536 + n * 1024 + k] = f2bf(wv - bf2f(hi)); }
        float* S5T = (float*)(c.ws + WS_TAB + TAB_S5);
        for (int i = c.blk * NTHR + c.tid; i < 2 * 2 * 16 * 64; i += c.G * NTHR) {
            const int pp = i & 63, g = (i >> 6) & 15, ld = i >> 10;
            const float lr = p->in[I_S5LR][i], li = p->in[I_S5LI][i], dt = __expf(p->in[I_S5DT][ld * 16 + g]);
            const float mag = __expf(lr * dt); float s, co; sincos_r(li * dt, s, co);
            const float are = mag * co, aim = mag * s, den = lr * lr + li * li;
            const float fre = ((are - 1.f) * lr + aim * li) / den, fim = (aim * lr - (are - 1.f) * li) / den;
            float* T = S5T + (size_t)i * 66; T[0] = are; T[1] = aim;
            { float* PW = (float*)(c.ws + WS_S5P) + (size_t)i * 34; float pr = 1.f, pi = 0.f;
              for (int e = 0; e <= 16; ++e) { PW[2 * e] = pr; PW[2 * e + 1] = pi; const float nr = pr * are - pi * aim, ni = pr * aim + pi * are; pr = nr; pi = ni; } }
            for (int ch = 0; ch < 16; ++ch) { const float br = p->in[I_S5BR][(size_t)i * 16 + ch], bi = p->in[I_S5BI][(size_t)i * 16 + ch];
                T[2 + ch] = fre * br - fim * bi; T[18 + ch] = fre * bi + fim * br;
                T[34 + ch] = p->in[I_S5CR][((size_t)(ld * 16 + g) * 16 + ch) * 64 + pp]; T[50 + ch] = p->in[I_S5CI][((size_t)(ld * 16 + g) * 16 + ch) * 64 + pp]; }
        }
    }
    for (int l = 0; l < 2; ++l) {
        bf16* WIN = (bf16*)(c.ws + WS_WIN) + (size_t)l * 2048 * 1024;
        tr_matrix<1, true>(c, p->in[I_WIN] + (size_t)l * 1024 * 1984, 1984, 1024, 1984, WIN, 1024, nullptr, 64.f);
        zero_fill16(c, (unsigned char*)WIN + (size_t)1984 * 1024, (size_t)64 * 1024);
        tr_matrix<0, true>(c, p->in[I_WOUT] + (size_t)l * 1024 * 1024, 1024, 1024, 1024, (bf16*)(c.ws + WS_WOUT) + (size_t)l * 1024 * 1024, 1024, nullptr, 64.f);
        unsigned char* sm = c.ws + WS_WSM + (size_t)l * WSM_L;
        tr_matrix<0>(c, p->in[I_CPW] + (size_t)l * 256 * 256, 256, 256, 256, (bf16*)(sm + WSM_PW), 256, nullptr, 1.f);
        tr_matrix<2>(c, p->in[I_S5GW] + (size_t)l * 256 * 512, 512, 256, 512, (bf16*)(sm + WSM_GLU), 256, nullptr, 1.f);
        tr_matrix<3>(c, p->in[I_WUQ] + (size_t)l * 256 * 384, 384, 256, 384, (bf16*)(sm + WSM_UQ), 256, p->in[I_QNG] + l * 256, 0.14724445f  );
        zero_fill16(c, (bf16*)(sm + WSM_UQ) + (size_t)384 * 256, (size_t)128 * 256 * 2);
        zero_fill16(c, sm + WSM_UK, (size_t)512 * 256 * 2);
    }
    for (int l = 0; l < 2; ++l) {
        bf16* WSGU = (bf16*)(c.ws + WS_WSH) + (size_t)l * (512 * 1024 + 1024 * 256); bf16* WSD = WSGU + 512 * 1024;
        tr_matrix<5, true>(c, p->in[I_SG] + (size_t)l * 1024 * 256, 256, 1024, 256, WSGU, 1024, nullptr, 64.f);
        tr_matrix<6, true>(c, p->in[I_SU] + (size_t)l * 1024 * 256, 256, 1024, 256, WSGU, 1024, nullptr, 64.f);
        tr_matrix<0, true>(c, p->in[I_SD] + (size_t)l * 256 * 1024, 1024, 256, 1024, (bf16*)((unsigned char*)WSGU + 512 * 1024), 256, nullptr, 64.f);
    }
    prologue_moe_weights(c, p, 0);
    prologue_moe_weights(c, p, 1);
}
__device__ __forceinline__ void prologue_s5_weights(const Ctx& c, KParams p) {
    const float* S5T = (const float*)(c.ws + WS_TAB + TAB_S5); const float* S5P = (const float*)(c.ws + WS_S5P);
    LAS float* pw = (LAS float*)c.lds;
    LAS float* bb = pw + 2 * 17 * 64 * 2;
    LAS float* cc = bb + 2 * 64 * 16 * 2;
    LAS float* kt = cc + 2 * 16 * 64 * 2;
    for (int u = c.blk; u < 32; u += c.G) {
        const int l = u >> 4, g = u & 15;
        __syncthreads();
        for (int i = c.tid; i < 2 * 64; i += NTHR) { const int dir = i >> 6, pp = i & 63; const size_t row = (size_t)((l * 2 + dir) * 16 + g) * 64 + pp; const float* T = S5T + row * 66; const float* PW = S5P + row * 34;
            for (int e = 0; e <= 16; ++e) { pw[((dir * 17 + e) * 64 + pp) * 2] = PW[2 * e]; pw[((dir * 17 + e) * 64 + pp) * 2 + 1] = PW[2 * e + 1]; }
            for (int ch = 0; ch < 16; ++ch) { bb[((dir * 64 + pp) * 16 + ch) * 2] = T[2 + ch]; bb[((dir * 64 + pp) * 16 + ch) * 2 + 1] = T[18 + ch]; cc[((dir * 16 + ch) * 64 + pp) * 2] = T[34 + ch]; cc[((dir * 16 + ch) * 64 + pp) * 2 + 1] = T[50 + ch]; } }
        __syncthreads();
        for (int i = c.tid; i < 2 * 16 * 256; i += NTHR) { const int dir = i >> 12, tau = (i >> 8) & 15, c1 = (i >> 4) & 15, c0 = i & 15; float s = 0.f;
            for (int pp = 0; pp < 64; ++pp) { const float cr = cc[((dir * 16 + c1) * 64 + pp) * 2], ci = cc[((dir * 16 + c1) * 64 + pp) * 2 + 1], pr = pw[((dir * 17 + tau) * 64 + pp) * 2], pi = pw[((dir * 17 + tau) * 64 + pp) * 2 + 1];
                const float wr_ = cr * pr - ci * pi, wi_ = cr * pi + ci * pr; s += wr_ * bb[((dir * 64 + pp) * 16 + c0) * 2] - wi_ * bb[((dir * 64 + pp) * 16 + c0) * 2 + 1]; }
            kt[i] = s; }
        __syncthreads();
        bf16* B1 = (bf16*)(c.ws + WS_S5W) + (size_t)(l * 16 + g) * 256 * 256;
        bf16* B2 = (bf16*)(c.ws + WS_S5W) + (size_t)32 * 256 * 256 + (size_t)(l * 16 + g) * 256 * 512;
        const float* dsk = p->in[I_S5D] + l * 256 + g * 16;
        for (int i = c.tid; i < 256 * 256; i += NTHR) { const int n = i >> 8, k = i & 255, dir = n >> 7, ri = (n >> 6) & 1, pp = n & 63, s = k >> 4, ch = k & 15, e = dir ? s : 15 - s;
            const float pr = pw[((dir * 17 + e) * 64 + pp) * 2], pi = pw[((dir * 17 + e) * 64 + pp) * 2 + 1], br = bb[((dir * 64 + pp) * 16 + ch) * 2], bi = bb[((dir * 64 + pp) * 16 + ch) * 2 + 1];
            B1[i] = f2bf(ri ? pr * bi + pi * br : pr * br - pi * bi); }
        for (int i = c.tid; i < 256 * 512; i += NTHR) { const int n = i >> 9, k = i & 511, t = n >> 4, c1 = n & 15; float v;
            if (k < 256) { const int s = k >> 4, c0 = k & 15; v = 0.f; if (s <= t) v += kt[((0 * 16 + (t - s)) * 16 + c1) * 16 + c0]; if (s >= t) v += kt[((1 * 16 + (s - t)) * 16 + c1) * 16 + c0]; if (s == t && c0 == c1) v += dsk[c0]; }
            else { const int q = k - 256, dir = q >> 7, ri = (q >> 6) & 1, pp = q & 63, e = dir ? 16 - t : t + 1;
                const float cr = cc[((dir * 16 + c1) * 64 + pp) * 2], ci = cc[((dir * 16 + c1) * 64 + pp) * 2 + 1], pr = pw[((dir * 17 + e) * 64 + pp) * 2], pi = pw[((dir * 17 + e) * 64 + pp) * 2 + 1];
                v = ri ? -(cr * pi + ci * pr) : (cr * pr - ci * pi); }
            B2[i] = f2bf(v); }
    }
    __syncthreads();
}
__device__ __forceinline__ void prologue2(const Ctx& c, KParams p) {
    prologue_s5_weights(c, p);
    for (int l = 0; l < 2; ++l) { unsigned char* sm = c.ws + WS_WSM + (size_t)l * WSM_L;
        tr_matrix<4>(c, p->in[I_WUKV] + (size_t)l * 128 * 512, 512, 128, 512, (bf16*)(sm + WSM_UK), 256, p->in[I_KVNG] + l * 128, 1.f); }
}

__device__ __forceinline__ void norm_row(const float* xrow, const float* gain, const float* sh, const float* sc, bf16* orow, int lane, f32x4 (&v)[4]) {
    float ss = 0.f;
#pragma unroll
    for (int j = 0; j < 4; ++j) { v[j] = *(const f32x4*)(xrow + 4 * lane + 256 * j); ss += (v[j].x * v[j].x + v[j].y * v[j].y) + (v[j].z * v[j].z + v[j].w * v[j].w); }
    const float rstd = rsqrtf(wave_sum(ss) * (1.f / 1024.f) + EPS);
#pragma unroll
    for (int j = 0; j < 4; ++j) { const int cc = 4 * lane + 256 * j; const f32x4 g = *(const f32x4*)(gain + cc), s1 = *(const f32x4*)(sc + cc), s0 = *(const f32x4*)(sh + cc);
        v[j] = v[j] * rstd * g * (s1 + 1.0f) + s0;
        u32x2 o; o.x = pk2(v[j].x, v[j].y); o.y = pk2(v[j].z, v[j].w); *(u32x2*)(orow + cc) = o; }
}
__device__ __forceinline__ void norm_row_add(const float* xrow, const bf16* drow, float* xout, const float* gain, const float* sh, const float* sc, unsigned char* orow8, int lane, f32x4 (&v)[4]) {
    float ss = 0.f; u32x2 dl[4];
#pragma unroll
    for (int j = 0; j < 4; ++j) { v[j] = *(const f32x4*)(xrow + 4 * lane + 256 * j); dl[j] = *(const u32x2*)(drow + 4 * lane + 256 * j); }
#pragma unroll
    for (int j = 0; j < 4; ++j) { v[j] += (f32x4){__uint_as_float(dl[j].x << 16), __uint_as_float(dl[j].x & 0xffff0000u), __uint_as_float(dl[j].y << 16), __uint_as_float(dl[j].y & 0xffff0000u)};
        *(f32x4*)(xout + 4 * lane + 256 * j) = v[j]; ss += (v[j].x * v[j].x + v[j].y * v[j].y) + (v[j].z * v[j].z + v[j].w * v[j].w); }
    const float rstd = rsqrtf(wave_sum(ss) * (1.f / 1024.f) + EPS);
#pragma unroll
    for (int j = 0; j < 4; ++j) { const int cc = 4 * lane + 256 * j; const f32x4 g = *(const f32x4*)(gain + cc), s1 = *(const f32x4*)(sc + cc), s0 = *(const f32x4*)(sh + cc);
        v[j] = v[j] * rstd * g * (s1 + 1.0f) + s0;
        *(unsigned*)(orow8 + cc) = pk4_fp8(v[j].x * 4.f, v[j].y * 4.f, v[j].z * 4.f, v[j].w * 4.f); }
}
__device__ __forceinline__ void phase_norm1(const Ctx& c, KParams p, int l) {
    const float* MOD = (const float*)(c.ws + WS_MOD) + (size_t)l * 33 * 6144;
    const float* xl = l == 0 ? p->in[I_X] : p->out; const float* xc = l == 0 ? p->in[I_CTX] : (const float*)(c.ws + WS_XC);
    unsigned char* H = c.ws + WS_H; const float* gain = p->in[I_N1G] + l * DM;
    const int gw = c.blk * NWAVES + c.wave, NGW = c.G * NWAVES, lane = c.lane;
    for (int r0 = gw; r0 < NTOK; r0 += 2 * NGW) {
        f32x4 v[2][4]; float ss[2];
#pragma unroll
        for (int k = 0; k < 2; ++k) { const int r = r0 + k * NGW < NTOK ? r0 + k * NGW : r0; const float* xr = r < NLAT ? xl + (size_t)r * DM : xc + (size_t)(r - NLAT) * DM;
#pragma unroll
            for (int j = 0; j < 4; ++j) v[k][j] = *(const f32x4*)(xr + 4 * lane + 256 * j); }
#pragma unroll
        for (int k = 0; k < 2; ++k) { ss[k] = 0.f;
#pragma unroll
            for (int j = 0; j < 4; ++j) ss[k] += (v[k][j].x * v[k][j].x + v[k][j].y * v[k][j].y) + (v[k][j].z * v[k][j].z + v[k][j].w * v[k][j].w); }
#pragma unroll
        for (int k = 0; k < 2; ++k) { const int r = r0 + k * NGW; if (r < NTOK) { const float rstd = rsqrtf(wave_sum(ss[k]) * (1.f / 1024.f) + EPS); const float* m = MOD + (size_t)mod_row(r) * 6144; unsigned char* orow = H + (size_t)r * DM;
#pragma unroll
            for (int j = 0; j < 4; ++j) { const int cc = 4 * lane + 256 * j; const f32x4 g = *(const f32x4*)(gain + cc), s1 = *(const f32x4*)(m + 1024 + cc), s0 = *(const f32x4*)(m + cc);
                const f32x4 y = (v[k][j] * rstd * g * (s1 + 1.0f) + s0) * 4.f; *(unsigned*)(orow + cc) = pk4_fp8(y.x, y.y, y.z, y.w); } } }
    }
}

#define EPI_ARGS const f32x4 (&acc)[2][2][4][2], const pg8::Unit& u, int wr, int wc, int fr, int fq
#define EPI_ROWS for (int ai = 0; ai < 2; ++ai) _Pragma("unroll") for (int m = 0; m < 4; ++m)
struct EpiBf16 {
    bf16* O; int ldo;
    __device__ __forceinline__ void operator()(EPI_ARGS) const {
        const int r0 = u.pm * 256 + wr * 64 + fr, c0 = u.pn * 256 + wc * 32 + 8 * fq;
#pragma unroll
        EPI_ROWS { bf16* rp = O + (size_t)(r0 + ai * 128 + m * 16) * ldo + c0;
#pragma unroll
            for (int bj = 0; bj < 2; ++bj) { const f32x4 a = acc[ai][bj][m][0], b = acc[ai][bj][m][1]; u32x4 w; w.x = pk2(a.x, a.y); w.y = pk2(a.z, a.w); w.z = pk2(b.x, b.y); w.w = pk2(b.z, b.w); *(u32x4*)(rp + bj * 128) = w; } asm volatile("" ::: "memory"); }
    }
};
struct EpiInProj {
    bf16* O; bf16* UP; bf16* GVT; float sc;
    __device__ __forceinline__ void operator()(EPI_ARGS) const {
        const int r0 = u.pm * 256 + wr * 64 + fr, c0 = u.pn * 256 + wc * 32 + 8 * fq;
#pragma unroll
        EPI_ROWS { const int row = r0 + ai * 128 + m * 16; bf16* rp = O + (size_t)row * ZW + c0;
            const int crow = row < NLAT ? (row >> 11) * 144 + 16 + ((row & 2047) >> 4) : ((row - NLAT) >> 8) * 144 + (((row - NLAT) & 255) >> 4);
#pragma unroll
            for (int bj = 0; bj < 2; ++bj) { const f32x4 a = acc[ai][bj][m][0] * sc, b = acc[ai][bj][m][1] * sc; u32x4 w; w.x = pk2(a.x, a.y); w.y = pk2(a.z, a.w); w.z = pk2(b.x, b.y); w.w = pk2(b.z, b.w);
                if (u.pn != 1 && u.pn != 5) *(u32x4*)(rp + bj * 128) = w;
                if (u.pn == 5) { const int g = 8 * bj + 2 * wc + (fq >> 1); *(u32x4*)(UP + ((size_t)g * 4608 + crow) * 512 + fr * 16 + 8 * (fq & 1)) = w; }
                if (u.pn == 1) { const int col = 128 * bj + 32 * wc + 8 * fq, bb = row < NLAT ? (row >> 11) : ((row - NLAT) >> 8), kk = row < NLAT ? 256 + (row & 2047) : ((row - NLAT) & 255);
                    bf16* dst = GVT + ((size_t)(bb * 4 + (col >> 6)) * 64 + (col & 63)) * 2304 + (kk & ~15) + 8 * ((fr >> 2) & 1) + 4 * (fr >> 3) + (fr & 3);
#pragma unroll
                    for (int n = 0; n < 2; ++n)
#pragma unroll
                        for (int i = 0; i < 4; ++i) dst[(size_t)(4 * n + i) * 2304] = f2bf(acc[ai][bj][m][n][i] * sc); } }
            asm volatile("" ::: "memory"); }
    }
};
struct EpiS5X {
    bf16* XE;
    __device__ __forceinline__ void operator()(EPI_ARGS) const {
        const int r0 = u.pm * 256 + wr * 64 + fr, c0 = wc * 32 + 8 * fq;
#pragma unroll
        EPI_ROWS { bf16* rp = XE + (size_t)(r0 + ai * 128 + m * 16) * 256 + c0;
#pragma unroll
            for (int bj = 0; bj < 2; ++bj) { const f32x4 a = acc[ai][bj][m][0], b = acc[ai][bj][m][1]; u32x4 w; w.x = pk2(a.x, a.y); w.y = pk2(a.z, a.w); w.z = pk2(b.x, b.y); w.w = pk2(b.z, b.w); *(u32x4*)(rp + bj * 128) = w; }
            asm volatile("" ::: "memory"); }
    }
};
struct EpiS5Y {
    bf16* Y;
    __device__ __forceinline__ void operator()(EPI_ARGS) const {
        const int r0 = u.pm * 256 + wr * 64 + fr;
#pragma unroll
        EPI_ROWS { const int grow = r0 + ai * 128 + m * 16; const int g = grow / 4608, rem = grow - g * 4608, b = rem / 144, ci = rem - b * 144;
            const int tok0 = ci < 16 ? NLAT + b * CTXL + ci * 16 : b * SEQ + (ci - 16) * 16;
#pragma unroll
            for (int bj = 0; bj < 2; ++bj) { const int t = 8 * bj + 2 * wc + (fq >> 1); const f32x4 a = acc[ai][bj][m][0], bq = acc[ai][bj][m][1]; u32x4 w; w.x = pk2(a.x, a.y); w.y = pk2(a.z, a.w); w.z = pk2(bq.x, bq.y); w.w = pk2(bq.z, bq.w);
                *(u32x4*)(Y + (size_t)(tok0 + t) * 256 + g * 16 + 8 * (fq & 1)) = w; }
            asm volatile("" ::: "memory"); }
    }
};
struct EpiOB8 {
    unsigned char* OB; float sc;
    __device__ __forceinline__ void operator()(EPI_ARGS) const {
        const int r0 = u.pm * 256 + wr * 64 + fr;
#pragma unroll
        EPI_ROWS { unsigned char* rp = OB + (size_t)(r0 + ai * 128 + m * 16) * 1024 + u.pn * 256 + (wc * 4 + fq) * 16; u32x4 w;
#pragma unroll
            for (int bj = 0; bj < 2; ++bj)
#pragma unroll
                for (int n = 0; n < 2; ++n) { const f32x4 a = acc[ai][bj][m][n] * sc; int pk = 0;
                    pk = __builtin_amdgcn_cvt_pk_fp8_f32(__builtin_amdgcn_fmed3f(a.x, -440.f, 440.f), __builtin_amdgcn_fmed3f(a.y, -440.f, 440.f), pk, false);
                    pk = __builtin_amdgcn_cvt_pk_fp8_f32(__builtin_amdgcn_fmed3f(a.z, -440.f, 440.f), __builtin_amdgcn_fmed3f(a.w, -440.f, 440.f), pk, true); w[2 * bj + n] = (unsigned)pk; }
            *(u32x4*)rp = w; asm volatile("" ::: "memory"); }
    }
};
struct EpiBf16S {
    bf16* O; int ldo; float sc;
    __device__ __forceinline__ void operator()(EPI_ARGS) const {
        const int r0 = u.pm * 256 + wr * 64 + fr, c0 = u.pn * 256 + wc * 32 + 8 * fq;
#pragma unroll
        EPI_ROWS { bf16* rp = O + (size_t)(r0 + ai * 128 + m * 16) * ldo + c0;
#pragma unroll
            for (int bj = 0; bj < 2; ++bj) { const f32x4 a = acc[ai][bj][m][0] * sc, b = acc[ai][bj][m][1] * sc; u32x4 w; w.x = pk2(a.x, a.y); w.y = pk2(a.z, a.w); w.z = pk2(b.x, b.y); w.w = pk2(b.z, b.w); *(u32x4*)(rp + bj * 128) = w; }
            asm volatile("" ::: "memory"); }
    }
};
struct EpiBiasBf16 {
    unsigned char* O; int ldo; const float* bias;
    __device__ __forceinline__ void operator()(EPI_ARGS) const {
        const int r0 = u.pm * 256 + wr * 64 + fr, c0 = u.pn * 256 + wc * 32 + 8 * fq;
        f32x4 bv[2][2];
#pragma unroll
        for (int bj = 0; bj < 2; ++bj) { bv[bj][0] = *(const f32x4*)(bias + c0 + bj * 128); bv[bj][1] = *(const f32x4*)(bias + c0 + bj * 128 + 4); }
        __builtin_amdgcn_s_waitcnt(0x0F70);
#pragma unroll
        EPI_ROWS { unsigned char* rp = O + (size_t)(r0 + ai * 128 + m * 16) * ldo + c0;
#pragma unroll
            for (int bj = 0; bj < 2; ++bj) { const f32x4 a = (acc[ai][bj][m][0] + bv[bj][0]) * 16.f, b = (acc[ai][bj][m][1] + bv[bj][1]) * 16.f; u32x2 w; w.x = pk4_fp8(a.x, a.y, a.z, a.w); w.y = pk4_fp8(b.x, b.y, b.z, b.w); *(u32x2*)(rp + bj * 128) = w; } asm volatile("" ::: "memory"); }
    }
};
struct EpiGluSig {
    unsigned char* O; int ldo; const float* bias;
    __device__ __forceinline__ void operator()(EPI_ARGS) const {
        const int r0 = u.pm * 256 + wr * 64 + fr, c0 = u.pn * 128 + wc * 32 + 8 * fq;
        f32x4 b1[2], b2[2];
#pragma unroll
        for (int n = 0; n < 2; ++n) { b1[n] = *(const f32x4*)(bias + c0 + 4 * n); b2[n] = *(const f32x4*)(bias + 256 + c0 + 4 * n); }
        __builtin_amdgcn_s_waitcnt(0x0F70);
#pragma unroll
        EPI_ROWS { unsigned char* rp = O + (size_t)(r0 + ai * 128 + m * 16) * ldo + c0; float o[8];
#pragma unroll
            for (int n = 0; n < 2; ++n)
#pragma unroll
                for (int i = 0; i < 4; ++i) o[4 * n + i] = (acc[ai][0][m][n][i] + b1[n][i]) * (16.f * sigmoidf_(acc[ai][1][m][n][i] + b2[n][i]));
            u32x2 w; w.x = pk4_fp8(o[0], o[1], o[2], o[3]); w.y = pk4_fp8(o[4], o[5], o[6], o[7]); *(u32x2*)rp = w; asm volatile("" ::: "memory"); }
    }
};
struct EpiSwiglu {
    unsigned char* O; int ldo; float sc;
    __device__ __forceinline__ void operator()(EPI_ARGS) const {
        const int r0 = u.pm * 256 + wr * 64 + fr, c0 = u.pn * 128 + wc * 32 + 8 * fq;
#pragma unroll
        EPI_ROWS { unsigned char* rp = O + (size_t)(r0 + ai * 128 + m * 16) * ldo + c0; float o[8];
#pragma unroll
            for (int n = 0; n < 2; ++n)
#pragma unroll
                for (int i = 0; i < 4; ++i) o[4 * n + i] = siluf_(acc[ai][0][m][n][i] * sc) * (acc[ai][1][m][n][i] * (sc * 16.0f));
            u32x2 w; w.x = pk4_fp8(o[0], o[1], o[2], o[3]); w.y = pk4_fp8(o[4], o[5], o[6], o[7]); *(u32x2*)rp = w; asm volatile("" ::: "memory"); }
    }
};
struct EpiQ {
    bf16* Q; const float* RS;
    __device__ __forceinline__ void operator()(EPI_ARGS) const {
        const int r0 = u.pm * 256 + wr * 64 + fr; float rq[8];
#pragma unroll
        for (int g = 0; g < 8; ++g) rq[g] = RS[(size_t)(r0 + (g >> 2) * 128 + (g & 3) * 16) * 2];
        __builtin_amdgcn_s_waitcnt(0x0F70);
#pragma unroll
        EPI_ROWS { const int row = r0 + ai * 128 + m * 16; const float rs = rq[ai * 4 + m]; bf16* rp = Q + (size_t)row * 384;
            if (u.pn == 0) {
#pragma unroll
                for (int bj = 0; bj < 2; ++bj) { const int head = 2 * bj + (wc >> 1), d = 32 * (wc & 1) + 8 * fq; const f32x4 a = acc[ai][bj][m][0] * rs, b = acc[ai][bj][m][1] * rs;
                    u32x4 w; w.x = pk2(a.x, a.y); w.y = pk2(a.z, a.w); w.z = pk2(b.x, b.y); w.w = pk2(b.z, b.w); *(u32x4*)(rp + head * 96 + d) = w; }
            } else { const f32x4 a = acc[ai][0][m][0] * rs, b = acc[ai][0][m][1] * rs;
                u32x4 w; w.x = pk2(a.x, a.y); w.y = pk2(a.z, a.w); w.z = pk2(b.x, b.y); w.w = pk2(b.z, b.w); *(u32x4*)(rp + wc * 96 + 64 + 8 * fq) = w; }
            asm volatile("" ::: "memory"); }
    }
};
struct EpiKV {
    bf16* Kb; bf16* VT; const float* RS;
    __device__ __forceinline__ void operator()(EPI_ARGS) const {
        const int r0 = u.pm * 256 + wr * 64 + fr;
        const int p16 = 8 * ((fr >> 2) & 1) + 4 * (fr >> 3) + (fr & 3); float rkv[8];
#pragma unroll
        for (int g = 0; g < 8; ++g) rkv[g] = RS[(size_t)(r0 + (g >> 2) * 128 + (g & 3) * 16) * 2 + 1];
        __builtin_amdgcn_s_waitcnt(0x0F70);
#pragma unroll
        EPI_ROWS { const int row = r0 + ai * 128 + m * 16; const float rk = rkv[ai * 4 + m];
            if (u.pn == 0) {
#pragma unroll
                for (int bj = 0; bj < 2; ++bj) { const int head = 2 * bj + (wc >> 1), d = 32 * (wc & 1) + 8 * fq; const f32x4 a = acc[ai][bj][m][0] * rk, b = acc[ai][bj][m][1] * rk;
                    u32x4 w; w.x = pk2(a.x, a.y); w.y = pk2(a.z, a.w); w.z = pk2(b.x, b.y); w.w = pk2(b.z, b.w);
                    *(u32x4*)(Kb + (size_t)row * 384 + head * 96 + d) = w; }
            } else {
                const int bb = row < NLAT ? (row >> 11) : ((row - NLAT) >> 8); const int kk = row < NLAT ? (row & 2047) : 2048 + ((row - NLAT) & 255);
                const int pos = (kk & ~15) + p16;
#pragma unroll
                for (int bj = 0; bj < 2; ++bj) { const int head = 2 * bj + (wc >> 1), d = 32 * (wc & 1) + 8 * fq; bf16* dst = VT + ((size_t)((bb * 4 + head) * 64 + d)) * 2304 + pos;
#pragma unroll
                    for (int n = 0; n < 2; ++n)
#pragma unroll
                        for (int i = 0; i < 4; ++i) dst[(size_t)(4 * n + i) * 2304] = f2bf(acc[ai][bj][m][n][i] * rk); }
            }
            asm volatile("" ::: "memory"); }
    }
};
struct EpiDelta {
    bf16* D; const float* MODg; float sc;
    __device__ __forceinline__ void operator()(EPI_ARGS) const {
        const int rt = u.pm * 256; const float* g = MODg + (size_t)(rt < NLAT ? (rt >> 11) : 32) * 6144;
        const int r0 = rt + wr * 64 + fr, c0 = u.pn * 256 + wc * 32 + 8 * fq;
        f32x4 gv[2][2];
#pragma unroll
        for (int bj = 0; bj < 2; ++bj) { gv[bj][0] = *(const f32x4*)(g + c0 + bj * 128) * sc; gv[bj][1] = *(const f32x4*)(g + c0 + bj * 128 + 4) * sc; }
        __builtin_amdgcn_s_waitcnt(0x0F70);
#pragma unroll
        EPI_ROWS { bf16* rp = D + (size_t)(r0 + ai * 128 + m * 16) * DM + c0;
#pragma unroll
            for (int bj = 0; bj < 2; ++bj) { const f32x4 a = gv[bj][0] * acc[ai][bj][m][0], b = gv[bj][1] * acc[ai][bj][m][1]; u32x4 w; w.x = pk2(a.x, a.y); w.y = pk2(a.z, a.w); w.z = pk2(b.x, b.y); w.w = pk2(b.z, b.w); *(u32x4*)(rp + bj * 128) = w; }
            asm volatile("" ::: "memory"); }
    }
};

__device__ __forceinline__ int seq_row(int b, int dir, int pos) {
    if (pos < CTXL) return NLAT + b * CTXL + (dir ? CTXL - 1 - pos : pos);
    const int t = pos - CTXL; return b * SEQ + (dir ? SEQ - 1 - t : t);
}
__device__ __forceinline__ void phase_gla(const Ctx& c, KParams p, int l) {
    const bf16* Z = (const bf16*)(c.ws + WS_Z); const bf16* GVT = (const bf16*)(c.ws + WS_GVT); bf16* OG = (bf16*)(c.ws + WS_T1);
    const int w = c.wave, tid = c.tid;
    LAS float* wtab = (LAS float*)c.lds;
    LAS float* DD = (LAS float*)(c.lds + 4096);
    LAS unsigned char* RW = c.lds + 8192 + w * 13824;
    LAS float* LA = (LAS float*)RW;
    LAS unsigned char* KTT = RW + 9216;
    for (int u = c.blk; u < 256; u += c.G) {
        const int b = u >> 3, h = (u >> 1) & 3, dir = u & 1;
        __syncthreads();
        { const float* wa = p->in[I_GLAW] + ((size_t)(l * 2 + dir) * 16) * 128 + h * 32; wtab[tid] = wa[(tid >> 5) * 128 + (tid & 31)]; if (tid < 32) wtab[512 + tid] = p->in[I_GLAB][(l * 2 + dir) * 128 + h * 32 + tid]; }
        float Sst[4] = {0.f, 0.f, 0.f, 0.f};
        __syncthreads();
        for (int gi = 0; gi < 5; ++gi) {
            const int pc = gi * 8 + w; const bool active = pc < 36;
            int lane_ = c.lane; asm volatile("" : "+v"(lane_));
            const int r = lane_ & 31, hh = lane_ >> 5;
            const int p16 = 8 * ((r >> 2) & 1) + 4 * ((r & 15) >> 3) + (r & 3);
            const int pos0 = (r & 16) + p16, pos1 = 32 + pos0;
            bf16x8 qd[2][2]; f32x16 oacc[2][2]; int row0 = 0;
            if (active) {
                int kk0;
                if (dir == 0) { if (pc < 4) { row0 = NLAT + b * CTXL + pc * 64; kk0 = pc * 64; } else { row0 = b * SEQ + (pc - 4) * 64; kk0 = 256 + (pc - 4) * 64; } }
                else { if (pc < 4) { row0 = NLAT + b * CTXL + (3 - pc) * 64; kk0 = (3 - pc) * 64; } else { row0 = b * SEQ + (35 - pc) * 64; kk0 = 256 + (35 - pc) * 64; } }
#pragma unroll
                for (int ib = 0; ib < 2; ++ib) { const bf16* zr = Z + (size_t)(row0 + 32 * ib + r) * ZW; float al[16]; { const u32x4 a0 = *(const u32x4*)(zr + ZAF + dir * 16), a1 = *(const u32x4*)(zr + ZAF + dir * 16 + 8); float t8[8]; unpack8(a0, t8);
#pragma unroll
                        for (int j = 0; j < 8; ++j) al[j] = t8[j];
                        unpack8(a1, t8);
#pragma unroll
                        for (int j = 0; j < 8; ++j) al[8 + j] = t8[j]; }
#pragma unroll
                    for (int ks = 0; ks < 2; ++ks) { float za[8]; { const f32x4 b0 = *(const LAS f32x4*)(wtab + 512 + 16 * ks + 8 * hh), b1 = *(const LAS f32x4*)(wtab + 512 + 16 * ks + 8 * hh + 4);
                            za[0] = b0.x; za[1] = b0.y; za[2] = b0.z; za[3] = b0.w; za[4] = b1.x; za[5] = b1.y; za[6] = b1.z; za[7] = b1.w; }
#pragma unroll
                        for (int j = 0; j < 16; ++j) { const f32x4 w0 = *(const LAS f32x4*)(wtab + j * 32 + 16 * ks + 8 * hh), w1 = *(const LAS f32x4*)(wtab + j * 32 + 16 * ks + 8 * hh + 4);
                            za[0] = fmaf(al[j], w0.x, za[0]); za[1] = fmaf(al[j], w0.y, za[1]); za[2] = fmaf(al[j], w0.z, za[2]); za[3] = fmaf(al[j], w0.w, za[3]);
                            za[4] = fmaf(al[j], w1.x, za[4]); za[5] = fmaf(al[j], w1.y, za[5]); za[6] = fmaf(al[j], w1.z, za[6]); za[7] = fmaf(al[j], w1.w, za[7]); }
                        float la[8];
#pragma unroll
                        for (int e = 0; e < 8; ++e) la[e] = (fminf(za[e], 0.f) - __logf(1.f + __expf(-fabsf(za[e])))) * 0.0625f;
                        *(LAS f32x4*)(LA + (32 * ib + r) * 36 + 16 * ks + 8 * hh) = (f32x4){la[0], la[1], la[2], la[3]}; *(LAS f32x4*)(LA + (32 * ib + r) * 36 + 16 * ks + 8 * hh + 4) = (f32x4){la[4], la[5], la[6], la[7]}; } }
                lds_wait();
                u32x4 qraw[2][2], kraw[2][2];
#pragma unroll
                for (int ib = 0; ib < 2; ++ib) { const bf16* zr = Z + (size_t)(row0 + 32 * ib + r) * ZW;
#pragma unroll
                    for (int ks = 0; ks < 2; ++ks) { qraw[ib][ks] = *(const u32x4*)(zr + ZQ + h * 32 + 16 * ks + 8 * hh); kraw[ib][ks] = *(const u32x4*)(zr + ZK + h * 32 + 16 * ks + 8 * hh); } }
                { float bend; float v[32], s = 0.f;
#pragma unroll
                  for (int qq = 0; qq < 32; ++qq) { const int q = 32 * hh + qq, i = dir ? 63 - q : q; v[qq] = LA[i * 36 + r]; s += v[qq]; }
                  const auto sw = __builtin_amdgcn_permlane32_swap(__float_as_uint(s), __float_as_uint(s), false, false);
                  const float h0 = __uint_as_float(sw[0]), h1 = __uint_as_float(sw[1]); bend = h0 + h1;
                  float run = hh ? h0 : 0.f;
#pragma unroll
                  for (int qq = 0; qq < 32; ++qq) { const int q = 32 * hh + qq, i = dir ? 63 - q : q; run += v[qq]; LA[i * 36 + r] = run; }
                  if (hh == 0) DD[w * 32 + r] = __expf(bend); }
                lds_wait();
                bf16x8 vt[2][4];
#pragma unroll
                for (int db = 0; db < 2; ++db)
#pragma unroll
                    for (int s4 = 0; s4 < 4; ++s4) vt[db][s4] = *(const bf16x8*)(GVT + ((size_t)(b * 4 + h) * 64 + 32 * db + r) * 2304 + kk0 + 16 * s4 + 8 * hh);
                bf16x8 ki[2][2];
#pragma unroll
                for (int ib = 0; ib < 2; ++ib) {
#pragma unroll
                    for (int ks = 0; ks < 2; ++ks) { const int dk0 = 16 * ks + 8 * hh; float q8[8], k8[8], b8[8]; unpack8(qraw[ib][ks], q8); unpack8(kraw[ib][ks], k8);
                        { const f32x4 x0 = *(const LAS f32x4*)(LA + (32 * ib + r) * 36 + dk0), x1 = *(const LAS f32x4*)(LA + (32 * ib + r) * 36 + dk0 + 4); b8[0] = x0.x; b8[1] = x0.y; b8[2] = x0.z; b8[3] = x0.w; b8[4] = x1.x; b8[5] = x1.y; b8[6] = x1.z; b8[7] = x1.w; }
                        float qo[8], ko[8];
#pragma unroll
                        for (int e = 0; e < 8; ++e) { const float eb = __expf(b8[e]), ieb = 1.f / eb; qo[e] = q8[e] * 0.17677669529663687f * eb; ko[e] = k8[e] * ieb;
                            *(LAS bf16*)(KTT + ((dk0 + e) * 72 + (ib ? pos1 : pos0)) * 2) = f2bf(ko[e] * DD[w * 32 + dk0 + e]); }
                        u32x4 wq, wk; wq.x = pk2(qo[0], qo[1]); wq.y = pk2(qo[2], qo[3]); wq.z = pk2(qo[4], qo[5]); wq.w = pk2(qo[6], qo[7]); wk.x = pk2(ko[0], ko[1]); wk.y = pk2(ko[2], ko[3]); wk.z = pk2(ko[4], ko[5]); wk.w = pk2(ko[6], ko[7]);
                        qd[ib][ks] = __builtin_bit_cast(bf16x8, wq); ki[ib][ks] = __builtin_bit_cast(bf16x8, wk); } }
                f32x16 zero16;
#pragma unroll
                for (int i = 0; i < 16; ++i) zero16[i] = 0.f;
                f32x16 a00 = __builtin_amdgcn_mfma_f32_32x32x16_bf16(ki[0][0], qd[0][0], zero16, 0, 0, 0); a00 = __builtin_amdgcn_mfma_f32_32x32x16_bf16(ki[0][1], qd[0][1], a00, 0, 0, 0);
                f32x16 a11 = __builtin_amdgcn_mfma_f32_32x32x16_bf16(ki[1][0], qd[1][0], zero16, 0, 0, 0); a11 = __builtin_amdgcn_mfma_f32_32x32x16_bf16(ki[1][1], qd[1][1], a11, 0, 0, 0);
                f32x16 aof;
                if (dir == 0) { aof = __builtin_amdgcn_mfma_f32_32x32x16_bf16(ki[0][0], qd[1][0], zero16, 0, 0, 0); aof = __builtin_amdgcn_mfma_f32_32x32x16_bf16(ki[0][1], qd[1][1], aof, 0, 0, 0); }
                else { aof = __builtin_amdgcn_mfma_f32_32x32x16_bf16(ki[1][0], qd[0][0], zero16, 0, 0, 0); aof = __builtin_amdgcn_mfma_f32_32x32x16_bf16(ki[1][1], qd[0][1], aof, 0, 0, 0); }
#pragma unroll
                for (int i = 0; i < 16; ++i) { const int j = (i & 3) + 8 * (i >> 2) + 4 * hh; const bool keep = dir ? (j >= r) : (j <= r); a00[i] = keep ? a00[i] : 0.f; a11[i] = keep ? a11[i] : 0.f; }
#define GLA_P(X, s) ({ u32x4 w_; w_.x = pk2((X)[8 * (s)], (X)[8 * (s) + 1]); w_.y = pk2((X)[8 * (s) + 2], (X)[8 * (s) + 3]); w_.z = pk2((X)[8 * (s) + 4], (X)[8 * (s) + 5]); w_.w = pk2((X)[8 * (s) + 6], (X)[8 * (s) + 7]); __builtin_bit_cast(bf16x8, w_); })
                const bf16x8 p00a = GLA_P(a00, 0), p00b = GLA_P(a00, 1), p11a = GLA_P(a11, 0), p11b = GLA_P(a11, 1), pofa = GLA_P(aof, 0), pofb = GLA_P(aof, 1);
#pragma unroll
                for (int db = 0; db < 2; ++db) {
                    f32x16 o0 = __builtin_amdgcn_mfma_f32_32x32x16_bf16(vt[db][0], p00a, zero16, 0, 0, 0); o0 = __builtin_amdgcn_mfma_f32_32x32x16_bf16(vt[db][1], p00b, o0, 0, 0, 0);
                    f32x16 o1 = __builtin_amdgcn_mfma_f32_32x32x16_bf16(vt[db][2], p11a, zero16, 0, 0, 0); o1 = __builtin_amdgcn_mfma_f32_32x32x16_bf16(vt[db][3], p11b, o1, 0, 0, 0);
                    if (dir == 0) { o1 = __builtin_amdgcn_mfma_f32_32x32x16_bf16(vt[db][0], pofa, o1, 0, 0, 0); o1 = __builtin_amdgcn_mfma_f32_32x32x16_bf16(vt[db][1], pofb, o1, 0, 0, 0); }
                    else { o0 = __builtin_amdgcn_mfma_f32_32x32x16_bf16(vt[db][2], pofa, o0, 0, 0, 0); o0 = __builtin_amdgcn_mfma_f32_32x32x16_bf16(vt[db][3], pofb, o0, 0, 0, 0); }
                    oacc[db][0] = o0; oacc[db][1] = o1; }
#undef GLA_P
                lds_wait();
                bf16x8 kf[4];
#pragma unroll
                for (int s4 = 0; s4 < 4; ++s4) kf[s4] = *(const LAS bf16x8*)(KTT + (r * 72 + 16 * s4 + 8 * hh) * 2);
#pragma unroll
                for (int db = 0; db < 2; ++db) { f32x16 uu = __builtin_amdgcn_mfma_f32_32x32x16_bf16(vt[db][0], kf[0], zero16, 0, 0, 0);
#pragma unroll
                    for (int s4 = 1; s4 < 4; ++s4) uu = __builtin_amdgcn_mfma_f32_32x32x16_bf16(vt[db][s4], kf[s4], uu, 0, 0, 0);
#pragma unroll
                    for (int i = 0; i < 16; ++i) LA[(32 * db + (i & 3) + 8 * (i >> 2) + 4 * hh) * 32 + r] = uu[i]; }
            }
            __syncthreads();
            const int dv2 = tid >> 3, dk4 = (tid & 7) * 4;
            f32x4 ur[8], dr[8];
#pragma unroll
            for (int cc = 0; cc < 8; ++cc) { ur[cc] = *(const LAS f32x4*)((LAS float*)(c.lds + 8192 + cc * 13824) + dv2 * 32 + dk4); dr[cc] = *(const LAS f32x4*)(DD + cc * 32 + dk4); }
            __syncthreads();
#pragma unroll
            for (int cc = 0; cc < 8; ++cc) if (gi * 8 + cc < 36) { u32x2 sp; sp.x = pk2(Sst[0], Sst[1]); sp.y = pk2(Sst[2], Sst[3]); *(LAS u32x2*)(c.lds + 8192 + cc * 13824 + (dv2 * 40 + dk4) * 2) = sp;
                Sst[0] = fmaf(dr[cc].x, Sst[0], ur[cc].x); Sst[1] = fmaf(dr[cc].y, Sst[1], ur[cc].y); Sst[2] = fmaf(dr[cc].z, Sst[2], ur[cc].z); Sst[3] = fmaf(dr[cc].w, Sst[3], ur[cc].w); }
            __syncthreads();
            if (active) {
#pragma unroll
                for (int db = 0; db < 2; ++db) { const bf16x8 s0 = *(const LAS bf16x8*)(RW + ((32 * db + r) * 40 + 8 * hh) * 2), s1 = *(const LAS bf16x8*)(RW + ((32 * db + r) * 40 + 16 + 8 * hh) * 2);
#pragma unroll
                    for (int ib = 0; ib < 2; ++ib) { oacc[db][ib] = __builtin_amdgcn_mfma_f32_32x32x16_bf16(s0, qd[ib][0], oacc[db][ib], 0, 0, 0); oacc[db][ib] = __builtin_amdgcn_mfma_f32_32x32x16_bf16(s1, qd[ib][1], oacc[db][ib], 0, 0, 0); } }
#pragma unroll
                for (int ib = 0; ib < 2; ++ib) { bf16* orow = OG + ((size_t)dir * NTOK + row0 + 32 * ib + r) * 256 + h * 64 + 4 * hh;
#pragma unroll
                    for (int db = 0; db < 2; ++db)
#pragma unroll
                        for (int g4 = 0; g4 < 4; ++g4) { u32x2 wv; wv.x = pk2(oacc[db][ib][4 * g4], oacc[db][ib][4 * g4 + 1]); wv.y = pk2(oacc[db][ib][4 * g4 + 2], oacc[db][ib][4 * g4 + 3]); *(u32x2*)(orow + 32 * db + 8 * g4) = wv; } }
                lds_wait();
            }
        }
    }
    __syncthreads();
}
__device__ __forceinline__ void phase_gla_final(const Ctx& c, KParams p, int l, int nrows) {
    const bf16* Z = (const bf16*)(c.ws + WS_Z); const bf16* OG = (const bf16*)(c.ws + WS_T1); unsigned char* MIX = c.ws + WS_MIX;
    const int gw = c.blk * NWAVES + c.wave, NGW = c.G * NWAVES; const f32x4 g = *(const f32x4*)(p->in[I_GLAG] + l * 256 + 4 * c.lane);
    for (int r0 = gw; r0 < nrows; r0 += 4 * NGW) {
        u32x2 of[4], ob[4], rg[4];
#pragma unroll
        for (int k = 0; k < 4; ++k) { const int r = r0 + k * NGW; of[k] = ob[k] = rg[k] = (u32x2){0u, 0u};
            if (r < nrows) { of[k] = *(const u32x2*)(OG + (size_t)r * 256 + 4 * c.lane); ob[k] = *(const u32x2*)(OG + ((size_t)NTOK + r) * 256 + 4 * c.lane); rg[k] = *(const u32x2*)(Z + (size_t)r * ZW + ZR + 4 * c.lane); } }
#pragma unroll
        for (int k = 0; k < 4; ++k) { const int r = r0 + k * NGW;
            f32x4 o = (f32x4){__uint_as_float(of[k].x << 16) + __uint_as_float(ob[k].x << 16), __uint_as_float(of[k].x & 0xffff0000u) + __uint_as_float(ob[k].x & 0xffff0000u),
                              __uint_as_float(of[k].y << 16) + __uint_as_float(ob[k].y << 16), __uint_as_float(of[k].y & 0xffff0000u) + __uint_as_float(ob[k].y & 0xffff0000u)};
            float ss = (o.x * o.x + o.y * o.y) + (o.z * o.z + o.w * o.w);
            ss += shx<1>(ss); ss += shx<2>(ss); ss += shx<4>(ss); ss += shx<8>(ss);
            const float rstd = rsqrtf(ss * (1.f / 64.f) + EPS);
            const float g0 = __uint_as_float(rg[k].x << 16), g1 = __uint_as_float(rg[k].x & 0xffff0000u), g2 = __uint_as_float(rg[k].y << 16), g3 = __uint_as_float(rg[k].y & 0xffff0000u);
            const float r16 = rstd * 16.f; const unsigned w = pk4_fp8(o.x * r16 * g.x * siluf_(g0), o.y * r16 * g.y * siluf_(g1), o.z * r16 * g.z * siluf_(g2), o.w * r16 * g.w * siluf_(g3));
            if (r < nrows) *(unsigned*)(MIX + (size_t)r * DM + 4 * c.lane) = w; }
    }
}

__device__ __forceinline__ void phase_conv1(const Ctx& c, KParams p, int l, bool with_ctx) {
    const bf16* Z = (const bf16*)(c.ws + WS_Z); bf16* CV = (bf16*)(c.ws + WS_CV);
    constexpr int TT = 64, HR = TT + 30;
    LAS float* glu = (LAS float*)c.lds;
    f32x4 wj[31];
#pragma unroll
    for (int j = 0; j < 31; ++j) wj[j] = *(const f32x4*)(p->in[I_CDW] + ((size_t)l * 31 + j) * 256 + 4 * c.lane);
    const int ntiles = with_ctx ? 1024 + 128 : 1024;
    const f32x4 dwb = *(const f32x4*)(p->in[I_CDB] + l * 256 + 4 * c.lane), lg = *(const f32x4*)(p->in[I_CLG] + l * 256 + 4 * c.lane), lb = *(const f32x4*)(p->in[I_CLB] + l * 256 + 4 * c.lane);
    for (int tile = c.blk; tile < ntiles; tile += c.G) {
        int rowbase, t0, slen;
        if (tile < 1024) { const int b = tile >> 5; rowbase = b * SEQ; t0 = (tile & 31) * TT; slen = SEQ; } else { const int q = tile - 1024, b = q >> 2; rowbase = NLAT + b * CTXL; t0 = (q & 3) * TT; slen = CTXL; }
        __syncthreads();
        u32x2 ra[12], rg[12];
#pragma unroll
        for (int k = 0; k < 12; ++k) { const int idx = c.tid + k * NTHR, j = idx >> 6, c4 = (idx & 63) * 4, t = t0 - 15 + j; ra[k] = (u32x2){0u, 0u}; rg[k] = (u32x2){0u, 0u};
            if (idx < HR * 64 && t >= 0 && t < slen) { const bf16* zr = Z + (size_t)(rowbase + t) * ZW; ra[k] = *(const u32x2*)(zr + ZCA + c4); rg[k] = *(const u32x2*)(zr + ZCG + c4); } }
#pragma unroll
        for (int k = 0; k < 12; ++k) { const int idx = c.tid + k * NTHR, j = idx >> 6, c4 = (idx & 63) * 4; f32x4 v;
            v.x = __uint_as_float(ra[k].x << 16) * sigmoidf_(__uint_as_float(rg[k].x << 16)); v.y = __uint_as_float(ra[k].x & 0xffff0000u) * sigmoidf_(__uint_as_float(rg[k].x & 0xffff0000u));
            v.z = __uint_as_float(ra[k].y << 16) * sigmoidf_(__uint_as_float(rg[k].y << 16)); v.w = __uint_as_float(ra[k].y & 0xffff0000u) * sigmoidf_(__uint_as_float(rg[k].y & 0xffff0000u));
            if (idx < HR * 64) *(LAS f32x4*)(glu + j * 256 + c4) = v; }
        __syncthreads();
        f32x4 acc8[8];
#pragma unroll
        for (int q = 0; q < 8; ++q) acc8[q] = dwb;
#pragma unroll
        for (int r = 0; r < 38; ++r) { const f32x4 x = *(const LAS f32x4*)(glu + (c.wave * 8 + r) * 256 + 4 * c.lane);
#pragma unroll
            for (int q = 0; q < 8; ++q) if (r - q >= 0 && r - q < 31) acc8[q] += x * wj[r - q]; }
#pragma unroll
        for (int q = 0; q < 8; ++q) { const int i = c.wave * 8 + q; const f32x4 a = acc8[q];
            const float mu = wave_sum((a.x + a.y) + (a.z + a.w)) * (1.f / 256.f); const f32x4 dlt = a - mu;
            const float var = wave_sum((dlt.x * dlt.x + dlt.y * dlt.y) + (dlt.z * dlt.z + dlt.w * dlt.w)) * (1.f / 256.f); const float rstd = rsqrtf(var + EPS);
            const f32x4 y = dlt * rstd * lg + lb;
            u32x2 w; w.x = pk2(siluf_(y.x), siluf_(y.y)); w.y = pk2(siluf_(y.z), siluf_(y.w));
            *(u32x2*)(CV + (size_t)(rowbase + t0 + i) * 256 + 4 * c.lane) = w; }
    }
    __syncthreads();
}

__device__ __forceinline__ void phase_s5_carry(const Ctx& c, int l) {
    const bf16* XE = (const bf16*)(c.ws + WS_Y5); bf16* UP = (bf16*)(c.ws + WS_UP); const float* S5P = (const float*)(c.ws + WS_S5P);
    for (int i = c.blk * NTHR + c.tid; i < NB * 2 * 16 * 64; i += c.G * NTHR) {
        const int pp = i & 63, g = (i >> 6) & 15, dir = (i >> 10) & 1, b = i >> 11;
        const float* PW = S5P + ((size_t)((l * 2 + dir) * 16 + g) * 64 + pp) * 34 + 32; const float ar = PW[0], ai = PW[1];
        const size_t rbase = (size_t)g * 4608 + (size_t)b * 144; float xr = 0.f, xi = 0.f;
        for (int s0 = 0; s0 < 144; s0 += 8) {
            float er[8], ei[8];
#pragma unroll
            for (int q = 0; q < 8; ++q) { const int s = s0 + q; const int ci = dir == 0 ? s : (s < 16 ? 15 - s : 159 - s); const bf16* xe = XE + (rbase + ci) * 256 + dir * 128 + pp; er[q] = bf2f(xe[0]); ei[q] = bf2f(xe[64]); }
#pragma unroll
            for (int q = 0; q < 8; ++q) { const int s = s0 + q; const int ci = dir == 0 ? s : (s < 16 ? 15 - s : 159 - s); bf16* up = UP + (rbase + ci) * 512 + 256 + dir * 128 + pp; up[0] = f2bf(xr); up[64] = f2bf(xi);
                const float nr = ar * xr - ai * xi + er[q], ni = ar * xi + ai * xr + ei[q]; xr = nr; xi = ni; }
        }
    }
}

__device__ __forceinline__ void phase_mla_prep(const Ctx& c, KParams p) {
    const bf16* Z = (const bf16*)(c.ws + WS_Z); float* RS = (float*)(c.ws + WS_RS); bf16* Kb = (bf16*)(c.ws + WS_H) + (size_t)NTOK * 384; const float* ROPE = (const float*)(c.ws + WS_TAB + TAB_ROPE);
    const int gw = c.blk * NWAVES + c.wave, NGW = c.G * NWAVES, lane = c.lane, d = lane & 31;
    for (int r0 = gw; r0 < NTOK; r0 += 4 * NGW) {
        u32x2 q4[4]; unsigned k2[4]; bf16 xr[4]; f32x2 cs[4];
#pragma unroll
        for (int k = 0; k < 4; ++k) { const int r = r0 + k * NGW; q4[k] = (u32x2){0u, 0u}; k2[k] = 0u; xr[k] = 0; cs[k] = (f32x2){1.f, 0.f};
            if (r < NTOK) { const bf16* zr = Z + (size_t)r * ZW; q4[k] = *(const u32x2*)(zr + ZCQ + 4 * lane); k2[k] = *(const unsigned*)(zr + ZCKV + 2 * lane); xr[k] = zr[ZKR + d];
                if (r < NLAT) cs[k] = *(const f32x2*)(ROPE + (((r & 2047) * 2 + (d >> 4)) * 8 + (d & 7)) * 2); } }
#pragma unroll
        for (int k = 0; k < 4; ++k) { const int r = r0 + k * NGW;
            const float a0 = __uint_as_float(q4[k].x << 16), a1 = __uint_as_float(q4[k].x & 0xffff0000u), a2 = __uint_as_float(q4[k].y << 16), a3 = __uint_as_float(q4[k].y & 0xffff0000u);
            const float b0 = __uint_as_float(k2[k] << 16), b1 = __uint_as_float(k2[k] & 0xffff0000u);
            const float sq = wave_sum((a0 * a0 + a1 * a1) + (a2 * a2 + a3 * a3)), sk = wave_sum(b0 * b0 + b1 * b1);
            const float x = bf2f(xr[k]); const float px = shx<8>(x);
            const float o = (d & 8) ? fmaf(x, cs[k].x, px * cs[k].y) : fmaf(x, cs[k].x, -px * cs[k].y);
            if (r < NTOK) { if (lane == 0) { RS[(size_t)r * 2] = rsqrtf(sq * (1.f / 256.f) + EPS); RS[(size_t)r * 2 + 1] = rsqrtf(sk * (1.f / 128.f) + EPS); }
                const bf16 ob = f2bf(o); bf16* kr = Kb + (size_t)r * 384 + 64 + d; if (lane < 32) { kr[0] = ob; kr[96] = ob; kr[192] = ob; kr[288] = ob; } } }
    }
}
__device__ __forceinline__ void phase_attn(const Ctx& c, bool with_ctx) {
    const bf16* Qb = (const bf16*)(c.ws + WS_H); const bf16* Kb = Qb + (size_t)NTOK * 384; const bf16* VT = Kb + (size_t)NTOK * 384; unsigned char* MIX = c.ws + WS_MIX;
    constexpr int KROW = 208, VROW = 144, KBUF = 64 * KROW, VBUF = 64 * VROW;
    LAS unsigned char* Kt = c.lds; LAS unsigned char* Vt = c.lds + 2 * KBUF;
    const int lane = c.lane, ln = lane & 31, hh = lane >> 5, tid = c.tid;
    const int nunits = with_ctx ? 1152 : 1024;
    for (int L = c.blk; L < nunits; L += c.G) {
        int u = L;
        if (c.G == 256 && L < 1024) { const int r = L >> 8, x = L & 7, j = (L & 255) >> 3; u = ((r * 32 + x * 4 + (j >> 3)) << 3) | (j & 7); }
        int b, h, qrow0, kt0, nkt;
        if (u < 1024) { b = u >> 5; h = (u >> 3) & 3; qrow0 = b * SEQ + (u & 7) * 256; kt0 = 0; nkt = 36; } else { const int q = u - 1024; b = q >> 2; h = q & 3; qrow0 = NLAT + b * CTXL; kt0 = 32; nkt = 4; }
        const bf16* vtb = VT + (size_t)((b * 4 + h) * 64) * 2304;
        bf16x8 qf[6];
        { const bf16* qr = Qb + (size_t)(qrow0 + 32 * c.wave + ln) * 384 + h * 96 + 8 * hh;
#pragma unroll
          for (int ks = 0; ks < 6; ++ks) qf[ks] = *(const bf16x8*)(qr + 16 * ks); }
        if (u < 1024) {
            const float* ROPE = (const float*)(c.ws + WS_TAB + TAB_ROPE) + (size_t)((qrow0 + 32 * c.wave + ln) & 2047) * 32;
#pragma unroll
            for (int ax = 0; ax < 2; ++ax) { const u32x4 own = __builtin_bit_cast(u32x4, qf[4 + ax]); u32x4 oth, res;
#pragma unroll
                for (int i = 0; i < 4; ++i) { const auto sw = __builtin_amdgcn_permlane32_swap(own[i], own[i], false, false); oth[i] = hh ? sw[0] : sw[1]; }
#pragma unroll
                for (int i = 0; i < 4; ++i) { const f32x4 cs = *(const f32x4*)(ROPE + ax * 16 + 4 * i);
                    const float v0 = __uint_as_float(own[i] << 16), v1 = __uint_as_float(own[i] & 0xffff0000u), p0 = __uint_as_float(oth[i] << 16), p1 = __uint_as_float(oth[i] & 0xffff0000u);
                    const float sg = hh ? 1.f : -1.f; res[i] = pk2(fmaf(v0, cs.x, sg * p0 * cs.y), fmaf(v1, cs.z, sg * p1 * cs.w)); }
                qf[4 + ax] = __builtin_bit_cast(bf16x8, res); } }
        f32x16 oacc[2];
#pragma unroll
        for (int i = 0; i < 16; ++i) { oacc[0][i] = 0.f; oacc[1][i] = 0.f; }
        float mrun = 0.f, lsum = 0.f;
        const int k0key = tid / 12, k0pt = tid % 12, k1key = (512 + tid) / 12, k1pt = (512 + tid) % 12; const bool k1on = tid < 256;
        u32x4 sk0, sk1 = (u32x4){0u, 0u, 0u, 0u}, sv;
        auto key_row = [&](int kt, int j) -> int { const int kk = kt * 64 + j; return kk < 2048 ? b * SEQ + kk : NLAT + b * CTXL + (kk - 2048); };
#define ATT_LOAD(kt) do { sk0 = *(const u32x4*)(Kb + (size_t)key_row((kt), k0key) * 384 + h * 96 + k0pt * 8); if (k1on) sk1 = *(const u32x4*)(Kb + (size_t)key_row((kt), k1key) * 384 + h * 96 + k1pt * 8); \
        sv = *(const u32x4*)(vtb + (size_t)(tid >> 3) * 2304 + (kt) * 64 + (tid & 7) * 8); } while (0)
#define ATT_STORE(buf) do { *(LAS u32x4*)(Kt + (buf) * KBUF + k0key * KROW + k0pt * 16) = sk0; if (k1on) *(LAS u32x4*)(Kt + (buf) * KBUF + k1key * KROW + k1pt * 16) = sk1; \
        *(LAS u32x4*)(Vt + (buf) * VBUF + (tid >> 3) * VROW + (tid & 7) * 16) = sv; } while (0)
        __syncthreads();
        ATT_LOAD(kt0); ATT_STORE(0);
        __syncthreads();
        for (int it = 0; it < nkt; ++it) {
            const int cur = it & 1;
            if (it + 1 < nkt) ATT_LOAD(kt0 + it + 1);
            f32x16 sacc[2];
            const float nm = -mrun;
#pragma unroll
            for (int kb = 0; kb < 2; ++kb) {
#pragma unroll
                for (int i = 0; i < 16; ++i) sacc[kb][i] = nm;
#pragma unroll
                for (int ks = 0; ks < 6; ++ks) { const bf16x8 a = *(const LAS bf16x8*)(Kt + cur * KBUF + (32 * kb + ln) * KROW + ks * 32 + hh * 16);
                    sacc[kb] = __builtin_amdgcn_mfma_f32_32x32x16_bf16(a, qf[ks], sacc[kb], 0, 0, 0); } }
            float mx = fmaxf(fmaxf(sacc[0][0], sacc[0][1]), sacc[0][2]);
#pragma unroll
            for (int i = 3; i < 15; i += 2) mx = fmaxf(fmaxf(mx, sacc[0][i]), sacc[0][i + 1]);
            mx = fmaxf(mx, sacc[0][15]);
#pragma unroll
            for (int i = 0; i < 16; i += 2) mx = fmaxf(fmaxf(mx, sacc[1][i]), sacc[1][i + 1]);
            { const auto r = __builtin_amdgcn_permlane32_swap(__float_as_uint(mx), __float_as_uint(mx), false, false); mx = fmaxf(__uint_as_float(r[0]), __uint_as_float(r[1])); }
            if (it == 0 || __builtin_amdgcn_ballot_w64(mx > 8.0f) != 0ull) {
                const float up = it == 0 ? mx : fmaxf(mx, 0.f), alpha = __builtin_amdgcn_exp2f(-up); mrun += up; lsum *= alpha;
#pragma unroll
                for (int i = 0; i < 16; ++i) { oacc[0][i] *= alpha; oacc[1][i] *= alpha; sacc[0][i] -= up; sacc[1][i] -= up; }
            }
            float ps = 0.f;
#pragma unroll
            for (int kb = 0; kb < 2; ++kb)
#pragma unroll
                for (int i = 0; i < 16; ++i) { const float pv = __builtin_amdgcn_exp2f(sacc[kb][i]); sacc[kb][i] = pv; ps += pv; }
            lsum += ps;
            bf16x8 pb[4];
#pragma unroll
            for (int s4 = 0; s4 < 4; ++s4) { const int kb = s4 >> 1, o8 = 8 * (s4 & 1); u32x4 w;
                w.x = pk2(sacc[kb][o8 + 0], sacc[kb][o8 + 1]); w.y = pk2(sacc[kb][o8 + 2], sacc[kb][o8 + 3]); w.z = pk2(sacc[kb][o8 + 4], sacc[kb][o8 + 5]); w.w = pk2(sacc[kb][o8 + 6], sacc[kb][o8 + 7]);
                pb[s4] = __builtin_bit_cast(bf16x8, w); }
#pragma unroll
            for (int db = 0; db < 2; ++db)
#pragma unroll
                for (int s4 = 0; s4 < 4; ++s4) { const bf16x8 a = *(const LAS bf16x8*)(Vt + cur * VBUF + (32 * db + ln) * VROW + s4 * 32 + hh * 16);
                    oacc[db] = __builtin_amdgcn_mfma_f32_32x32x16_bf16(a, pb[s4], oacc[db], 0, 0, 0); }
            if (it + 1 < nkt) ATT_STORE(cur ^ 1);
            __syncthreads();
        }
#undef ATT_LOAD
#undef ATT_STORE
        { const auto r = __builtin_amdgcn_permlane32_swap(__float_as_uint(lsum), __float_as_uint(lsum), false, false); lsum = __uint_as_float(r[0]) + __uint_as_float(r[1]); }
        const float inv = 16.f / lsum;
        unsigned char* dst = MIX + (size_t)(qrow0 + 32 * c.wave + ln) * DM + 768 + h * 64 + 4 * hh;
#pragma unroll
        for (int db = 0; db < 2; ++db)
#pragma unroll
            for (int g4 = 0; g4 < 4; ++g4) *(unsigned*)(dst + 32 * db + 8 * g4) = pk4_fp8(oacc[db][4 * g4] * inv, oacc[db][4 * g4 + 1] * inv, oacc[db][4 * g4 + 2] * inv, oacc[db][4 * g4 + 3] * inv);
    }
    __syncthreads();
}

__device__ __forceinline__ void phase_norm2_route(const Ctx& c, KParams p, int l, int ntok) {
    const float* MOD = (const float*)(c.ws + WS_MOD) + (size_t)l * 33 * 6144;
    const float* xl = l == 0 ? p->in[I_X] : p->out; const float* xc = l == 0 ? p->in[I_CTX] : (const float*)(c.ws + WS_XC);
    bf16* H = (bf16*)(c.ws + WS_H);
    int* TKEP = (int*)(c.ws + WS_RT + RT_TKEP); float* TKW = (float*)(c.ws + WS_RT + RT_TKW); int* TB = (int*)(c.ws + WS_TB);
    int* CNT = (int*)(c.ws + WS_CTL) + CW_CNT + l * NCH * NE;
    constexpr int HROW = 1032;
    LAS bf16* hhi = (LAS bf16*)c.lds;
    LAS bf16* hlo = hhi + 32 * HROW;
    LAS float* lgs = (LAS float*)(c.lds + 132096);
    LAS int* hist = (LAS int*)(c.lds + 140288);
    const bf16* Whi = (const bf16*)(c.ws + WS_TAB + TAB_RWT) + (size_t)(l * 2) * 65536; const bf16* Wlo = Whi + 65536;
    const float rbias = p->in[I_RB][l * 64 + c.lane];
    const int ntiles = ntok / 32, rpc = ntok / NCH, lane = c.lane, mb = c.wave >> 2, nb = c.wave & 3;
    for (int tile = c.blk; tile < ntiles; tile += c.G) {
        __syncthreads();
        if (c.tid < 64) hist[c.tid] = 0;
        for (int q = 0; q < 4; ++q) { const int r = tile * 32 + c.wave * 4 + q; const float* xr = r < NLAT ? xl + (size_t)r * DM : xc + (size_t)(r - NLAT) * DM; const float* m = MOD + (size_t)mod_row(r) * 6144;
            float* xo = r < NLAT ? p->out + (size_t)r * DM : (float*)(c.ws + WS_XC) + (size_t)(r - NLAT) * DM;
            f32x4 v[4]; norm_row_add(xr, (const bf16*)(c.ws + WS_Z) + (size_t)r * DM, xo, p->in[I_N2G] + l * DM, m + 3072, m + 4096, c.ws + WS_H8 + (size_t)r * DM, lane, v);
#pragma unroll
            for (int j = 0; j < 4; ++j) { u32x2 hi; hi.x = pk2(v[j].x, v[j].y); hi.y = pk2(v[j].z, v[j].w);
                const float r0 = v[j].x - __uint_as_float(hi.x << 16), r1 = v[j].y - __uint_as_float(hi.x & 0xffff0000u), r2 = v[j].z - __uint_as_float(hi.y << 16), r3 = v[j].w - __uint_as_float(hi.y & 0xffff0000u);
                u32x2 lo; lo.x = pk2(r0, r1); lo.y = pk2(r2, r3);
                *(LAS u32x2*)(hhi + (c.wave * 4 + q) * HROW + 4 * lane + 256 * j) = hi; *(LAS u32x2*)(hlo + (c.wave * 4 + q) * HROW + 4 * lane + 256 * j) = lo; } }
        __syncthreads();
        { f32x4 acc = (f32x4){0.f, 0.f, 0.f, 0.f};
          const LAS bf16* ah = hhi + (mb * 16 + (lane & 15)) * HROW + 8 * (lane >> 4); const LAS bf16* al = hlo + (mb * 16 + (lane & 15)) * HROW + 8 * (lane >> 4);
          const bf16* bh = Whi + (size_t)(nb * 16 + (lane & 15)) * 1024 + 8 * (lane >> 4); const bf16* bl = Wlo + (size_t)(nb * 16 + (lane & 15)) * 1024 + 8 * (lane >> 4);
#pragma unroll 8
          for (int ks = 0; ks < 32; ++ks) { const bf16x8 a_h = *(const LAS bf16x8*)(ah + 32 * ks), a_l = *(const LAS bf16x8*)(al + 32 * ks), b_h = *(const bf16x8*)(bh + 32 * ks), b_l = *(const bf16x8*)(bl + 32 * ks);
              acc = __builtin_amdgcn_mfma_f32_16x16x32_bf16(a_h, b_h, acc, 0, 0, 0); acc = __builtin_amdgcn_mfma_f32_16x16x32_bf16(a_h, b_l, acc, 0, 0, 0); acc = __builtin_amdgcn_mfma_f32_16x16x32_bf16(a_l, b_h, acc, 0, 0, 0); }
#pragma unroll
          for (int i = 0; i < 4; ++i) lgs[(mb * 16 + 4 * (lane >> 4) + i) * 64 + nb * 16 + (lane & 15)] = acc[i]; }
        __syncthreads();
#pragma unroll
        for (int q = 0; q < 4; ++q) {
            const int r = tile * 32 + c.wave * 4 + q;
            const float s = sigmoidf_(lgs[(c.wave * 4 + q) * 64 + lane]), bs = s + rbias;
            float m1 = bs; m1 = fmaxf(m1, shx<1>(m1)); m1 = fmaxf(m1, shx<2>(m1)); m1 = fmaxf(m1, shx<4>(m1));
            const unsigned long long eq = __ballot(bs == m1); const unsigned gm = (unsigned)(eq >> (lane & 56)) & 0xffu; const int first = __ffs(gm) - 1;
            float m2 = ((lane & 7) == first) ? -1e30f : bs; m2 = fmaxf(m2, shx<1>(m2)); m2 = fmaxf(m2, shx<2>(m2)); m2 = fmaxf(m2, shx<4>(m2));
            const float gs = m1 + m2; const int g = lane >> 3; int rank = 0;
#pragma unroll
            for (int j = 0; j < 8; ++j) { const float o = rdl(gs, 8 * j); rank += (o > gs || (o == gs && j < g)) ? 1 : 0; }
            float cand = rank < 4 ? bs : -1e30f; int my_e = 0; float my_w = 0.f, wsum = 0.f;
#pragma unroll
            for (int k = 0; k < 8; ++k) { const float mm = wave_max(cand); const unsigned long long e2 = __ballot(cand == mm); const int idx = __ffsll((long long)e2) - 1; const float wk = rdl(s, idx);
                if (lane == idx) cand = -1e30f; if (lane == k) { my_e = idx; my_w = wk; } wsum += wk; }
            if (lane < 8) { const int lp = atomicAdd((int*)&hist[my_e], 1); TKEP[(size_t)r * 8 + lane] = my_e | (lp << 8); TKW[(size_t)r * 8 + lane] = my_w / wsum * 2.5f; }
        }
        __syncthreads();
        if (c.tid < 64) { const int n = hist[c.tid]; int base = 0; if (n > 0) base = atomicAdd(&CNT[((tile * 32) / rpc) * NE + c.tid], n); TB[tile * 64 + c.tid] = base; }
    }
    __syncthreads();
}
__device__ __forceinline__ void phase_route_fill(const Ctx& c, int l, int ntok) {
    const int* TKEP = (const int*)(c.ws + WS_RT + RT_TKEP); int* SLOT = (int*)(c.ws + WS_RT + RT_SLOT); const int* TB = (const int*)(c.ws + WS_TB);
    const int* CNT = (const int*)(c.ws + WS_CTL) + CW_CNT + l * NCH * NE; int* ROWL = (int*)(c.ws + WS_ROWL);
    LAS int* est = (LAS int*)c.lds;
    const int rpc = ntok / NCH;
    __syncthreads();
    if (c.tid < NCH) { int s = 0; for (int e = 0; e < NE; ++e) { est[c.tid * 65 + e] = s; s += (CNT[c.tid * NE + e] + 255) & ~255; } est[c.tid * 65 + 64] = s; }
    __syncthreads();
    const size_t na = (size_t)ntok * 8;
    for (size_t a = (size_t)c.blk * NTHR + c.tid; a < na; a += (size_t)c.G * NTHR) { const int t = (int)(a >> 3), ch = t / rpc; const int ep = TKEP[a], e = ep & 255, lp = ep >> 8;
        const int slot = est[ch * 65 + e] + TB[(t >> 5) * 64 + e] + lp; SLOT[a] = slot; ROWL[(size_t)ch * RPCMAX + slot] = t; }
    for (int i = c.blk * NTHR + c.tid; i < NCH * NE * 256; i += c.G * NTHR) { const int ch = i >> 14, e = (i >> 8) & 63, j = i & 255; const int n = CNT[ch * NE + e]; const int pad = ((n + 255) & ~255) - n;
        if (j < pad) ROWL[(size_t)ch * RPCMAX + est[ch * 65 + e] + n + j] = ch * rpc; }
    __syncthreads();
}

__device__ __forceinline__ void moe_tile_table(const Ctx& c, int l, int ch, LAS int* tst) {
    const int* CNT = (const int*)(c.ws + WS_CTL) + CW_CNT + l * NCH * NE + ch * NE;
    LAS unsigned char* texp = (LAS unsigned char*)(tst + 80);
    __syncthreads();
    if (c.tid == 0) { int s = 0; for (int e = 0; e < NE; ++e) { tst[e] = s; s += (CNT[e] + 255) >> 8; } tst[64] = s; }
    __syncthreads();
    if (c.tid < NE) { for (int t = tst[c.tid]; t < tst[c.tid + 1]; ++t) texp[t] = (unsigned char)c.tid; }
    __syncthreads();
}
__device__ __forceinline__ void phase_combine(const Ctx& c, KParams p, int l, int ch, int rpc) {
    const float* MOD = (const float*)(c.ws + WS_MOD) + (size_t)l * 33 * 6144 + 5120; const float* MODn = (const float*)(c.ws + WS_MOD) + (size_t)33 * 6144;
    const int* SLOT = (const int*)(c.ws + WS_RT + RT_SLOT); const float* TKW = (const float*)(c.ws + WS_RT + RT_TKW);
    const unsigned char* OB = (const unsigned char*)(c.ws + WS_OB); const bf16* OBS = (const bf16*)(c.ws + WS_OBS);
    float* xl = p->out; float* xc = (float*)(c.ws + WS_XC); unsigned char* H = c.ws + WS_H;
    const int gw = c.blk * NWAVES + c.wave, NGW = c.G * NWAVES, lane = c.lane;
    const int col0 = (lane >> 4) * 256 + ((lane >> 2) & 3) * 32 + (lane & 3) * 8;
    f32x4 gn[4];
#pragma unroll
    for (int q = 0; q < 4; ++q) gn[q] = *(const f32x4*)((l == 0 ? p->in[I_N1G] + DM : p->in[I_FG]) + col0 + 128 * (q >> 1) + 4 * (q & 1));
    int sl_n = 0; float w_n = 0.f;
    if (gw < rpc && lane < 8) { sl_n = SLOT[(size_t)(ch * rpc + gw) * 8 + lane]; w_n = TKW[(size_t)(ch * rpc + gw) * 8 + lane] * 0.0625f; }
    for (int i = gw; i < rpc; i += NGW) {
        const int t = ch * rpc + i; float* xr = t < NLAT ? xl + (size_t)t * DM : xc + (size_t)(t - NLAT) * DM; const int mr = mod_row(t); const float* g2 = MOD + (size_t)mr * 6144;
        const int sl = sl_n; const float w = w_n;
        u32x4 ob[8], os0, os1; f32x4 xv[4];
#pragma unroll
        for (int e = 0; e < 8; ++e) ob[e] = *(const u32x4*)(OB + (size_t)rdli(sl, e) * 1024 + lane * 16);
        os0 = *(const u32x4*)(OBS + (size_t)i * DM + col0); os1 = *(const u32x4*)(OBS + (size_t)i * DM + col0 + 128);
#pragma unroll
        for (int q = 0; q < 4; ++q) xv[q] = *(const f32x4*)(xr + col0 + 128 * (q >> 1) + 4 * (q & 1));
        if (i + NGW < rpc && lane < 8) { sl_n = SLOT[(size_t)(t + NGW) * 8 + lane]; w_n = TKW[(size_t)(t + NGW) * 8 + lane] * 0.0625f; }
        float a[16]; { float t8[8]; unpack8(os0, t8);
#pragma unroll
            for (int q = 0; q < 8; ++q) a[q] = t8[q];
            unpack8(os1, t8);
#pragma unroll
            for (int q = 0; q < 8; ++q) a[8 + q] = t8[q]; }
#pragma unroll
        for (int e = 0; e < 8; ++e) { const float wk = rdl(w, e);
#pragma unroll
            for (int q = 0; q < 4; ++q) { const f32x2 lo = __builtin_amdgcn_cvt_pk_f32_fp8((int)ob[e][q], false), hi = __builtin_amdgcn_cvt_pk_f32_fp8((int)ob[e][q], true);
                a[4 * q] = fmaf(wk, lo.x, a[4 * q]); a[4 * q + 1] = fmaf(wk, lo.y, a[4 * q + 1]); a[4 * q + 2] = fmaf(wk, hi.x, a[4 * q + 2]); a[4 * q + 3] = fmaf(wk, hi.y, a[4 * q + 3]); } }
        f32x4 xn[4]; float ss = 0.f;
#pragma unroll
        for (int q = 0; q < 4; ++q) { const int cc = col0 + 128 * (q >> 1) + 4 * (q & 1); const f32x4 gv = *(const f32x4*)(g2 + cc);
            xn[q] = xv[q] + gv * (f32x4){a[4 * q], a[4 * q + 1], a[4 * q + 2], a[4 * q + 3]}; ss += (xn[q].x * xn[q].x + xn[q].y * xn[q].y) + (xn[q].z * xn[q].z + xn[q].w * xn[q].w); }
        const float rstd = rsqrtf(wave_sum(ss) * (1.f / 1024.f) + EPS);
        if (l == 0) { const float* mn = MODn + (size_t)mr * 6144; unsigned char* hr = H + (size_t)t * DM;
#pragma unroll
            for (int q = 0; q < 4; ++q) { const int cc = col0 + 128 * (q >> 1) + 4 * (q & 1); *(f32x4*)(xr + cc) = xn[q];
                const f32x4 s0 = *(const f32x4*)(mn + cc), s1 = *(const f32x4*)(mn + 1024 + cc); const f32x4 hv = (xn[q] * rstd * gn[q] * (s1 + 1.0f) + s0) * 4.f;
                *(unsigned*)(hr + cc) = pk4_fp8(hv.x, hv.y, hv.z, hv.w); } }
        else {
#pragma unroll
            for (int q = 0; q < 4; ++q) { const int cc = col0 + 128 * (q >> 1) + 4 * (q & 1); *(f32x4*)(xr + cc) = xn[q] * rstd * gn[q]; } }
    }
}
constexpr int LDS_BYTES = 147456;
constexpr int LDS_TAB = 131072, LDS_XB = LDS_BYTES - 16;
enum { J_INPROJ = 0, J_S5G1, J_PW, J_Q, J_KV, J_S5G2, J_GLU, J_OUT, J_GU, J_GUS, J_DN, J_DNS };
enum { SK_DENSE = 0, SK_S5, SK_MOE };
enum { EK_INPROJ = 0, EK_S5X, EK_S5Y, EK_BIAS, EK_GLU, EK_Q, EK_KV, EK_RESID, EK_SWIGLU, EK_OB8, EK_BF16 };
struct JSched {
    int sk, G, c; pg8::DenseOrder d; const char* W; size_t wexp, wtile; const LAS unsigned char* texp; int ntile, npn;
    __device__ __forceinline__ bool next(int i, pg8::Unit& u) const {
        if (sk == SK_DENSE) return d.next(i, u);
        const int L = i * G + c;
        if (sk == SK_S5) { if (L >= 288) return false; u.pm = L; u.pn = 0; u.e = L / 18; u.B = W + (size_t)u.e * wexp; return true; }
        if (L >= ntile * npn) return false;
        const int T = npn == 2 ? (L >> 1) : (L >> 2), pn = L & (npn - 1); const int e = __builtin_amdgcn_readfirstlane((int)texp[T]);
        u.pm = T; u.pn = pn; u.e = e; u.B = W + (size_t)e * wexp + (size_t)pn * wtile; return true;
    }
};
struct JRows { const int* list; unsigned ldab;
    __device__ __forceinline__ unsigned off(const pg8::Unit& u, int r) const { const int row = u.pm * 256 + r; return (unsigned)(list ? list[row] : row) * ldab; } };
struct JEpi {
    int ek; void* p0; void* p1; void* p2; const void* q0; const void* q1; const void* q2; int i0;
    __device__ __forceinline__ void operator()(EPI_ARGS) const {
        switch (ek) {
        case EK_S5X:    EpiS5X{(bf16*)p0}(acc, u, wr, wc, fr, fq); break;
        case EK_S5Y:    EpiS5Y{(bf16*)p0}(acc, u, wr, wc, fr, fq); break;
        case EK_BIAS:   EpiBiasBf16{(unsigned char*)p0, i0, (const float*)q0}(acc, u, wr, wc, fr, fq); break;
        case EK_GLU:    EpiGluSig{(unsigned char*)p0, i0, (const float*)q0}(acc, u, wr, wc, fr, fq); break;
        case EK_Q:      EpiQ{(bf16*)p0, (const float*)q0}(acc, u, wr, wc, fr, fq); break;
        case EK_KV:     EpiKV{(bf16*)p0, (bf16*)p1, (const float*)q0}(acc, u, wr, wc, fr, fq); break;
        default:        EpiBf16{(bf16*)p0, i0}(acc, u, wr, wc, fr, fq); break;
        }
    }
};
struct JEpi8 {
    int ek; void* p0; int i0; const void* q0; void* p1; void* p2;
    __device__ __forceinline__ void operator()(EPI_ARGS) const {
        if (ek == EK_SWIGLU) EpiSwiglu{(unsigned char*)p0, i0, 1.0f / 256.0f}(acc, u, wr, wc, fr, fq);
        else if (ek == EK_OB8) EpiOB8{(unsigned char*)p0, 16.0f / 1024.0f}(acc, u, wr, wc, fr, fq);
        else if (ek == EK_INPROJ) EpiInProj{(bf16*)p0, (bf16*)p1, (bf16*)p2, 1.0f / 256.0f}(acc, u, wr, wc, fr, fq);
        else if (ek == EK_RESID) EpiDelta{(bf16*)p0, (const float*)q0, 1.0f / 1024.0f}(acc, u, wr, wc, fr, fq);
        else EpiBf16S{(bf16*)p0, i0, 1.0f / 1024.0f}(acc, u, wr, wc, fr, fq);
    }
};
__device__ __forceinline__ void gemm_job(KParams p, LAS unsigned char* lds, int job, int l, int ch) {
    unsigned char* ws = p->ws;
    const int G = gridDim.x, blk = blockIdx.x;
    const bool last = (l == 1); const int nrows = last ? NLAT : NTOK, rpc = nrows / NCH;
    unsigned char* sm = ws + WS_WSM + (size_t)l * WSM_L;
    const LAS int* tst = (const LAS int*)(lds + LDS_TAB);
    auto rot8 = [&](int units) { return ((units % G) + 7) & ~7; };
    auto rotc = [&](int rot) { return (blk + G - rot % G) % G; };
    const char* A = nullptr; int K = 256; bool fp8 = false; JSched S; JRows R; JEpi E;
    S.sk = SK_DENSE; S.G = G; S.c = blk; S.W = nullptr; S.wexp = 0; S.wtile = 0; S.texp = (const LAS unsigned char*)(tst + 80); S.ntile = 0; S.npn = 2; S.d.init(1, 1, G, blk, nullptr, 256);
    R.list = nullptr; R.ldab = 512u; E.ek = EK_BF16; E.p0 = E.p1 = E.p2 = nullptr; E.q0 = E.q1 = E.q2 = nullptr; E.i0 = 0;
    switch (job) {
    case J_INPROJ: A = (const char*)(ws + WS_H); K = 512; fp8 = true; R.ldab = 1024u; S.d.init(NTOK / 256, ZW / 256, G, blk, (const bf16*)(ws + WS_WIN) + (size_t)l * 2048 * 1024, 512);
        E.ek = EK_INPROJ; E.p0 = ws + WS_Z; E.p1 = ws + WS_UP; E.p2 = ws + WS_GVT; break;
    case J_S5G1: A = (const char*)(ws + WS_UP); K = 256; R.ldab = 1024u; S.sk = SK_S5; S.W = (const char*)(ws + WS_S5W) + (size_t)l * 16 * 256 * 256 * 2; S.wexp = (size_t)256 * 256 * 2; E.ek = EK_S5X; E.p0 = ws + WS_Y5; break;
    case J_PW: A = (const char*)(ws + WS_CV); K = 256; R.ldab = 512u; S.d.init(nrows / 256, 1, G, blk, (const bf16*)(sm + WSM_PW), 256); E.ek = EK_BIAS; E.p0 = ws + WS_MIX + 256; E.i0 = DM; E.q0 = p->in[I_CPB] + l * 256; break;
    case J_Q: A = (const char*)(ws + WS_Z) + ZCQ * 2; K = 256; R.ldab = (unsigned)ZW * 2u; S.d.init(NTOK / 256, 2, G, rotc(rot8(nrows / 256)), (const bf16*)(sm + WSM_UQ), 256);
        E.ek = EK_Q; E.p0 = ws + WS_H; E.q0 = ws + WS_RS; break;
    case J_KV: A = (const char*)(ws + WS_Z) + ZCKV * 2; K = 256; R.ldab = (unsigned)ZW * 2u; S.d.init(NTOK / 256, 2, G, rotc(rot8(nrows / 256) + rot8(NTOK / 256 * 2)), (const bf16*)(sm + WSM_UK), 256);
        E.ek = EK_KV; E.p0 = (bf16*)(ws + WS_H) + (size_t)NTOK * 384; E.p1 = (bf16*)(ws + WS_H) + (size_t)NTOK * 768; E.q0 = ws + WS_RS; break;
    case J_S5G2: A = (const char*)(ws + WS_UP); K = 512; R.ldab = 1024u; S.sk = SK_S5; S.W = (const char*)(ws + WS_S5W) + (size_t)32 * 256 * 256 * 2 + (size_t)l * 16 * 256 * 512 * 2; S.wexp = (size_t)256 * 512 * 2; E.ek = EK_S5Y; E.p0 = ws + WS_Y5; break;
    case J_GLU: A = (const char*)(ws + WS_Y5); K = 256; R.ldab = 512u; S.d.init(nrows / 256, 2, G, blk, (const bf16*)(sm + WSM_GLU), 256); E.ek = EK_GLU; E.p0 = ws + WS_MIX + 512; E.i0 = DM; E.q0 = p->in[I_S5GB] + l * 512; break;
    case J_OUT: A = (const char*)(ws + WS_MIX); K = 512; fp8 = true; R.ldab = 1024u; S.d.init(nrows / 256, 4, G, blk, (const bf16*)(ws + WS_WOUT) + (size_t)l * 1024 * 1024, 512);
        E.ek = EK_RESID; E.p0 = ws + WS_Z; E.q0 = (const float*)(ws + WS_MOD) + (size_t)l * 33 * 6144 + 2048; break;
    case J_GU: A = (const char*)(ws + WS_H8); K = 512; fp8 = true; R.list = (const int*)(ws + WS_ROWL) + (size_t)ch * RPCMAX; R.ldab = 1024u; S.sk = SK_MOE; S.ntile = __builtin_amdgcn_readfirstlane(tst[64]); S.npn = 2; S.W = (const char*)(ws + WS_WMOE) + (size_t)l * 48 * MiB; S.wexp = (size_t)512 * 1024; S.wtile = (size_t)256 * 1024;
        E.ek = EK_SWIGLU; E.p0 = ws + WS_HB; E.i0 = 256; break;
    case J_GUS: A = (const char*)(ws + WS_H8) + (size_t)ch * rpc * 1024; K = 512; fp8 = true; R.ldab = 1024u; S.d.init(rpc / 256, 2, G, rotc(rot8(__builtin_amdgcn_readfirstlane(tst[64]) * 2)), (const bf16*)((const unsigned char*)(ws + WS_WSH) + (size_t)l * (512 * 1024 + 1024 * 256) * 2), 512); E.ek = EK_SWIGLU; E.p0 = ws + WS_HBS; E.i0 = 256; break;
    case J_DN: A = (const char*)(ws + WS_HB); K = 128; fp8 = true; R.ldab = 256u; S.sk = SK_MOE; S.ntile = __builtin_amdgcn_readfirstlane(tst[64]); S.npn = 4; S.W = (const char*)(ws + WS_WMOE) + (size_t)l * 48 * MiB + (size_t)NE * 512 * 1024; S.wexp = (size_t)1024 * 256; S.wtile = (size_t)256 * 256;
        E.ek = EK_OB8; E.p0 = ws + WS_OB; break;
    default: A = (const char*)(ws + WS_HBS); K = 128; fp8 = true; R.ldab = 256u; S.d.init(rpc / 256, 4, G, rotc(rot8(__builtin_amdgcn_readfirstlane(tst[64]) * 4)), (const bf16*)((const unsigned char*)(ws + WS_WSH) + (size_t)l * (512 * 1024 + 1024 * 256) * 2 + 512 * 1024), 128); E.ek = EK_BF16; E.p0 = ws + WS_OBS; E.i0 = DM; break;
    }
    __builtin_amdgcn_s_waitcnt(0x0F70);
    if (fp8) pg8::gemm_phase<true>(lds, A, K, S, R, JEpi8{E.ek, E.p0, E.i0, E.q0, E.p1, E.p2});
    else pg8::gemm_phase<false>(lds, A, K, S, R, E);
}


__global__ void __launch_bounds__(NTHR, 2) fwd_kernel(Params pk) {
    extern __shared__ __attribute__((aligned(16))) unsigned char lds_raw[];
    LAS unsigned char* const lds0 = (LAS unsigned char*)lds_raw;
    if (threadIdx.x < 4) ((LAS unsigned*)(lds0 + LDS_XB))[threadIdx.x] = 0u;
    __syncthreads();
    (void)xcd_barrier_post((unsigned*)(pk.ws + WS_CTL) + CW_BAR, (volatile LAS unsigned*)(lds0 + LDS_XB));
    constexpr int NSTEP = 15 + 6 * NCH;
#ifndef PROBE_DUP
#define PROBE_DUP (-9)
#endif
#pragma unroll 1
    for (int it_ = -2; it_ < 2 * NSTEP + (PROBE_DUP >= 0 ? 2 : 0); ++it_) {
        int gs = it_; if (PROBE_DUP >= 0) { if (it_ > PROBE_DUP) gs -= 1; if (it_ > NSTEP + PROBE_DUP + 1) gs -= 1; }
        KParams p = fresh_params(); Ctx c; { int t_ = threadIdx.x; asm volatile("" : "+v"(t_)); c.lds = lds0; c.tid = t_; c.lane = t_ & 63; c.wave = __builtin_amdgcn_readfirstlane(t_ >> 6); c.blk = blockIdx.x; c.G = gridDim.x; c.ws = p->ws; }
        LAS int* tst = (LAS int*)(c.lds + LDS_TAB);
        int l = 0, s = gs, ch = 0, job = -1; bool seam = true;
        if (gs >= 0) { l = gs >= NSTEP ? 1 : 0; s = gs - l * NSTEP; if (s >= 15) { ch = (s - 15) / 6; s = 15 + (s - 15) % 6; } }
        const bool last = (l == 1); const int nrows = last ? NLAT : NTOK, rpc = nrows / NCH;
        switch (s) {
        case -2: prologue(c, p); break;
        case -1: prologue2(c, p); phase_norm1(c, p, 0); break;
        case 0: seam = false; break;
        case 1: job = J_INPROJ; break;
        case 2: phase_gla(c, p, l); phase_conv1(c, p, l, !last); phase_mla_prep(c, p); seam = false; break;
        case 3: job = J_S5G1; break;
        case 4: phase_gla_final(c, p, l, nrows); seam = false; break;
        case 5: job = J_PW; seam = false; break;
        case 6: job = J_Q; seam = false; break;
        case 7: job = J_KV; seam = false; break;
        case 8: phase_s5_carry(c, l); break;
        case 9: phase_attn(c, !last); seam = false; break;
        case 10: job = J_S5G2; break;
        case 11: job = J_GLU; break;
        case 12: job = J_OUT; break;
        case 13: phase_norm2_route(c, p, l, nrows); break;
        case 14: phase_route_fill(c, l, nrows); break;
        case 15: moe_tile_table(c, l, ch, tst); job = J_GU; seam = false; break;
        case 16: job = J_GUS; break;
        case 17: job = J_DN; seam = false; break;
        case 18: job = J_DNS; break;
        case 19: phase_combine(c, p, l, ch, rpc); break;
        default: seam = false; break;
        }
        if (job >= 0) gemm_job(p, c.lds, job, l, ch);
        if (seam && gs + 1 < 2 * NSTEP) { XcdBarrier b_; b_.bar = (unsigned*)(p->ws + WS_CTL) + CW_BAR; b_.x = xb_xcc_id(); b_.st = (volatile LAS unsigned*)(lds0 + LDS_XB); xcd_barrier(b_); }
    }
}

extern "C" void kernel_launch(void* const* d_in, const int* in_sizes, int n_in, void* d_out, int out_size, void* d_ws, size_t ws_size, hipStream_t stream) {
    static int grid = 0;
    if (grid == 0) {
        if (n_in != 42 || out_size != NLAT * DM || ws_size < WS_END) { fprintf(stderr, "kernel_launch: unexpected shapes (n_in %d out %d ws %zu)\n", n_in, out_size, ws_size); grid = -1; return; }
        int dev = 0, cus = 0;
        if (hipGetDevice(&dev) != hipSuccess || hipDeviceGetAttribute(&cus, hipDeviceAttributeMultiprocessorCount, dev) != hipSuccess) { grid = -1; return; }
        if (hipFuncSetAttribute((const void*)fwd_kernel, hipFuncAttributeMaxDynamicSharedMemorySize, LDS_BYTES) != hipSuccess) { fprintf(stderr, "kernel_launch: hipFuncSetAttribute failed\n"); grid = -1; return; }
        int per_cu = 0;
        if (hipOccupancyMaxActiveBlocksPerMultiprocessor(&per_cu, (const void*)fwd_kernel, NTHR, LDS_BYTES) != hipSuccess || per_cu < 1) fprintf(stderr, "kernel_launch: occupancy query reports %d\n", per_cu);
        (void)hipGetLastError();
        grid = cus;
    }
    if (grid < 0) return;
    (void)hipMemsetAsync((char*)d_ws + WS_CTL, 0, CTL_BYTES, stream);
    Params p{};
    for (int i = 0; i < 42; ++i) p.in[i] = (const float*)d_in[i];
    p.out = (float*)d_out; p.ws = (unsigned char*)d_ws; p.ph_lo = 0; p.ph_hi = 1 << 20;
    hipLaunchKernelGGL(fwd_kernel, dim3(grid), dim3(NTHR), LDS_BYTES, stream, p);
}
```

```cpp
#include <hip/hip_runtime.h>
#include <cstdio>
#include <cstdint>

#define LAS __attribute__((address_space(3)))
typedef unsigned short bf16;
typedef short bf16x8 __attribute__((ext_vector_type(8)));
typedef float f32x4 __attribute__((ext_vector_type(4)));
typedef float f32x2 __attribute__((ext_vector_type(2)));
typedef float f32x16 __attribute__((ext_vector_type(16)));
typedef unsigned u32x4 __attribute__((ext_vector_type(4)));
typedef unsigned u32x2 __attribute__((ext_vector_type(2)));
typedef int i32x4 __attribute__((ext_vector_type(4)));
typedef int i32x8 __attribute__((ext_vector_type(8)));

constexpr int NB = 32, SEQ = 2048, CTXL = 256, DM = 1024;
constexpr int NLAT = NB * SEQ, NCTX = NB * CTXL, NTOK = NLAT + NCTX;
constexpr int ZW = 2048;
constexpr int ZQ = 0, ZK = 128, ZV = 256, ZR = 512, ZCA = 768, ZCG = 1024, ZS5 = 1280, ZCQ = 1536, ZCKV = 1792, ZKR = 1920, ZAF = 1952, ZAB = 1968;
constexpr int NE = 64, TOPK = 8;
constexpr int NCH = 2;
constexpr int RPCMAX = (NTOK / NCH) * 8 + 64 * 256;
constexpr float EPS = 1e-6f;
constexpr int NWAVES = 8, NTHR = 512;

constexpr size_t MiB = (size_t)1 << 20;
constexpr size_t WS_CTL = 0, CTL_BYTES = 1 * MiB;
constexpr size_t WS_MOD = 1 * MiB;
constexpr size_t WS_TAB = 3 * MiB;
constexpr size_t WS_WSM = 5 * MiB;
constexpr size_t WS_WIN = 8 * MiB;
constexpr size_t WS_WOUT = 16 * MiB;
constexpr size_t WS_WSH = 20 * MiB;
constexpr size_t WS_TB = 23 * MiB;
constexpr size_t WS_RT = 24 * MiB;
constexpr size_t WS_ROWL = 32 * MiB;
constexpr size_t WS_RS = 35 * MiB;
constexpr size_t WS_WMOE = 36 * MiB;
constexpr size_t WS_XC = 132 * MiB;
constexpr size_t WS_H = 164 * MiB;
constexpr size_t WS_H8 = WS_H + 72 * MiB;
constexpr size_t WS_Z = 308 * MiB;
constexpr size_t WS_MIX = 596 * MiB;
constexpr size_t WS_T1 = 740 * MiB;
constexpr size_t WS_UP = 812 * MiB;
constexpr size_t WS_CV = 884 * MiB;
constexpr size_t WS_Y5 = 920 * MiB;
constexpr size_t WS_S5W = 956 * MiB;
constexpr size_t WS_S5P = 968 * MiB;
constexpr size_t WS_GVT = 969 * MiB;
constexpr size_t WS_END = 1005 * MiB;
constexpr size_t WS_HB = WS_Z;
constexpr size_t WS_HBS = WS_Z + 152 * MiB;
constexpr size_t WS_OBS = WS_Z + 170 * MiB;
constexpr size_t WS_OB = WS_MIX;
static_assert((size_t)RPCMAX * 512 <= 152 * MiB && WS_OBS + (size_t)(NTOK / NCH) * 2048 <= WS_MIX && WS_OB + (size_t)RPCMAX * 1024 <= WS_S5W, "MoE overlays");
constexpr int CW_BAR = 0;
constexpr int CW_CNT = 4096;
constexpr size_t WSM_L = 1 * MiB;
constexpr size_t WSM_PW = 0, WSM_GLU = 128 * 1024, WSM_UQ = 384 * 1024, WSM_UK = 640 * 1024, WSM_UV = 768 * 1024;
constexpr size_t TAB_ROPE = 0;
constexpr size_t TAB_S5 = 256 * 1024;
constexpr size_t TAB_RWT = 1536 * 1024;
constexpr size_t RT_TKEP = 0, RT_TKW = 2400000, RT_SLOT = 4800000;

__device__ __forceinline__ float bf2f(bf16 v) { return __uint_as_float(((unsigned)v) << 16); }
typedef __bf16 bf16x2_t __attribute__((ext_vector_type(2)));
__device__ __forceinline__ unsigned pk2(float lo, float hi) { const f32x2 v = {lo, hi}; return __builtin_bit_cast(unsigned, __builtin_convertvector(v, bf16x2_t)); }
__device__ __forceinline__ bf16 f2bf(float f) { return __builtin_bit_cast(unsigned short, (__bf16)f); }
template <int O> __device__ __forceinline__ float shx(float v) {
    return __int_as_float(__builtin_amdgcn_ds_swizzle(__float_as_int(v), (O << 10) | 0x1f)); }
__device__ __forceinline__ float rdl(float v, int l) { return __int_as_float(__builtin_amdgcn_readlane(__float_as_int(v), l)); }
__device__ __forceinline__ int rdli(int v, int l) { return __builtin_amdgcn_readlane(v, l); }
__device__ __forceinline__ float wave_sum(float v) {
    v += shx<1>(v); v += shx<2>(v); v += shx<4>(v); v += shx<8>(v); v += shx<16>(v);
    const auto r = __builtin_amdgcn_permlane32_swap(__float_as_uint(v), __float_as_uint(v), false, false);
    return __uint_as_float(r[0]) + __uint_as_float(r[1]);
}
__device__ __forceinline__ float wave_max(float v) {
    v = fmaxf(v, shx<1>(v)); v = fmaxf(v, shx<2>(v)); v = fmaxf(v, shx<4>(v)); v = fmaxf(v, shx<8>(v)); v = fmaxf(v, shx<16>(v));
    const auto r = __builtin_amdgcn_permlane32_swap(__float_as_uint(v), __float_as_uint(v), false, false);
    return fmaxf(__uint_as_float(r[0]), __uint_as_float(r[1]));
}
__device__ __forceinline__ float sigmoidf_(float x) { return 1.0f / (1.0f + __expf(-x)); }
__device__ __forceinline__ float siluf_(float x) { return x / (1.0f + __expf(-x)); }
__device__ __forceinline__ void unpack8(const u32x4 w, float (&v)[8]) {
    v[0] = __uint_as_float(w.x << 16); v[1] = __uint_as_float(w.x & 0xffff0000u);
    v[2] = __uint_as_float(w.y << 16); v[3] = __uint_as_float(w.y & 0xffff0000u);
    v[4] = __uint_as_float(w.z << 16); v[5] = __uint_as_float(w.z & 0xffff0000u);
    v[6] = __uint_as_float(w.w << 16); v[7] = __uint_as_float(w.w & 0xffff0000u);
}
__device__ __forceinline__ void lds_wait() { asm volatile("s_waitcnt lgkmcnt(0)" ::: "memory"); }

#define XB_TMO      128
#define XB_XCNT(j)  (256  + 64 * (j))
#define XB_XSUB(j)  (1280 + 64 * (j))
#define XB_XGEN(j)  (2304 + 64 * (j))
#define XB_TOP      3328
#define XB_TOPGEN   3392
#define XCD_BAR_WORDS 3456
#define XB_SPIN_CAP (1u << 22)
__device__ __forceinline__ unsigned xb_ld(unsigned* p)              { return __hip_atomic_load(p, __ATOMIC_RELAXED, __HIP_MEMORY_SCOPE_AGENT); }
__device__ __forceinline__ unsigned xb_add(unsigned* p, unsigned v) { return __hip_atomic_fetch_add(p, v, __ATOMIC_RELAXED, __HIP_MEMORY_SCOPE_AGENT); }
__device__ __forceinline__ unsigned xb_xcc_id() { return (unsigned)__builtin_amdgcn_s_getreg((3 << 11) | 20) & 0xFu; }
#define XB_SPIN(cond, bar) do { unsigned _sp = 0; while (cond) { __builtin_amdgcn_s_sleep(1); \
    if ((++_sp & 255u) == 0u) { if (xb_ld(&(bar)[XB_TMO])) break; if (_sp > XB_SPIN_CAP) { atomicAdd(&(bar)[XB_TMO], 1u); break; } } } } while (0)
struct XcdBarrier { unsigned* bar; unsigned x; volatile LAS unsigned* st; };
__device__ __forceinline__ XcdBarrier xcd_barrier_post(unsigned* bar, volatile LAS unsigned* st) {
    XcdBarrier b; b.bar = bar; b.x = xb_xcc_id(); b.st = st;
    if (threadIdx.x == 0) (void)xb_add(&bar[XB_XCNT(b.x)], 1u);
    return b;
}
__device__ __forceinline__ void xcd_barrier_complete(unsigned* bar, unsigned x, unsigned& nloc, unsigned& nx) {
    const unsigned G = gridDim.x * gridDim.y * gridDim.z;
    unsigned sum, cnt, mine, sp = 0u;
    for (;;) {
        sum = 0u; cnt = 0u; mine = 0u;
#pragma unroll
        for (unsigned j = 0; j < 16; ++j) { const unsigned c = xb_ld(&bar[XB_XCNT(j)]); sum += c; cnt += (c > 0u) ? 1u : 0u; mine = (j == x) ? c : mine; }
        if (sum == G) break;
        __builtin_amdgcn_s_sleep(1);
        if ((++sp & 255u) == 0u) { if (xb_ld(&bar[XB_TMO])) break; if (sp > XB_SPIN_CAP) { atomicAdd(&bar[XB_TMO], 1u); break; } }
    }
    nloc = mine > 0u ? mine : 1u; nx = cnt > 0u ? cnt : 1u;
}
__device__ __forceinline__ void xcd_barrier(const XcdBarrier& b) {
    asm volatile("s_waitcnt vmcnt(0)" ::: "memory");
    __syncthreads();
    if (threadIdx.x == 0) {
        unsigned* bar = b.bar;
        __builtin_amdgcn_s_waitcnt(0);
        unsigned nloc = b.st[0], nx = b.st[1];
        if (nloc == 0u) { xcd_barrier_complete(bar, b.x, nloc, nx); b.st[0] = nloc; b.st[1] = nx; }
        const unsigned old = xb_add(&bar[XB_XSUB(b.x)], 1u);
        const unsigned gen = old / nloc;
        if (old + 1u == (gen + 1u) * nloc) {
            __builtin_amdgcn_fence(__ATOMIC_RELEASE, "agent");
            asm volatile("s_waitcnt vmcnt(0)" ::: "memory");
            const unsigned og = xb_add(&bar[XB_TOP], 1u);
            const unsigned tg = og / nx;
            if (og + 1u == (tg + 1u) * nx) xb_add(&bar[XB_TOPGEN], 1u);
            else XB_SPIN(xb_ld(&bar[XB_TOPGEN]) == tg, bar);
            __builtin_amdgcn_fence(__ATOMIC_ACQUIRE, "agent");
            xb_add(&bar[XB_XGEN(b.x)], 1u);
            asm volatile("s_waitcnt vmcnt(0)" ::: "memory");
        } else {
            XB_SPIN(xb_ld(&bar[XB_XGEN(b.x)]) == gen, bar);
            __builtin_amdgcn_fence(__ATOMIC_ACQUIRE, "agent");
            asm volatile("s_waitcnt vmcnt(0)" ::: "memory");
        }
    }
    __syncthreads();
}

namespace pg8 {
constexpr int BM = 256, BK = 64, HALF = 128, HTB = HALF * BK * 2, STAGE_BYTES = 8 * HTB, NXCD = 8, WGM = 8;
__device__ __forceinline__ int lds_byte(int r, int c) { const int st = (r >> 4) * 2 + (c >> 5), rr = r & 15, cc = c & 31, ob = rr * 64 + cc * 2; return st * 1024 + (ob ^ (((ob >> 9) & 1) << 5)); }
__device__ __forceinline__ void stage_rc(int b, int& R, int& C) { const int st = b / 1024, sb = b % 1024, swz = sb ^ (((sb >> 9) & 1) << 5); R = (st >> 1) * 16 + swz / 64; C = (st & 1) * 32 + (swz % 64) / 2; }
__device__ __forceinline__ int perm32(int rho) { const int n = rho >> 4, i = rho & 15; return 8 * (i >> 2) + 4 * n + (i & 3); }

struct Unit { int pm, pn, e; const char* B; };

struct DenseOrder {
    int nM, nN, nwg, G, c; const char* Bt; size_t btile;
    __device__ __forceinline__ void init(int nM_, int nN_, int G_, int c_, const bf16* Bt_, int K) { nM = nM_; nN = nN_; nwg = nM * nN; G = G_; c = c_; Bt = (const char*)Bt_; btile = (size_t)256 * K * 2; }
    __device__ __forceinline__ bool next(int i, Unit& u) const {
        const long L = (long)i * G + c; if (L >= nwg) return false;
        int wgid = (int)L; { const int q = nwg / NXCD, r = nwg % NXCD, xcd = wgid % NXCD, off = wgid / NXCD; wgid = (xcd < r ? xcd * (q + 1) : r * (q + 1) + (xcd - r) * q) + off; }
        const int nig = WGM * nN, gid = wgid / nig, fm = gid * WGM, gsz = (nM - fm) < WGM ? (nM - fm) : WGM;
        u.pm = fm + ((wgid % nig) % gsz); u.pn = (wgid % nig) / gsz; u.e = 0; u.B = Bt + (size_t)u.pn * btile; return true;
    }
};
struct RowsDense { unsigned ldab; __device__ __forceinline__ unsigned off(const Unit& u, int r) const { return (unsigned)(u.pm * 256 + r) * ldab; } };
struct RowsGather { const int* list; unsigned ldab; __device__ __forceinline__ unsigned off(const Unit& u, int r) const { return (unsigned)list[u.pm * 256 + r] * ldab; } };

template <bool FP8, class Epi, class Sched, class Rows>
__device__ __forceinline__ void gemm_phase(LAS unsigned char* lds, const char* Abase, const int K, const Sched& S, const Rows& RW, const Epi& E) {
    int tid_ = threadIdx.x; asm volatile("" : "+v"(tid_));
    const int tid = tid_, wid = __builtin_amdgcn_readfirstlane(tid >> 6), lane = tid & 63, wr = wid >> 2, wc = wid & 3, fr = lane & 15, fq = lane >> 4;
    const int nt = K / BK;
    int sR[2]; unsigned sC[2], voffB[2];
#pragma unroll
    for (int i = 0; i < 2; ++i) { int R, C; stage_rc(tid * 16 + i * 8192, R, C); sR[i] = R; sC[i] = (unsigned)C * 2u; const int Rb = (R & ~31) + perm32(R & 31); voffB[i] = (unsigned)(Rb * K + C) * 2u; }
    const size_t kstep = (size_t)(BK * 2);
    const size_t hstepB = (size_t)HALF * K * 2;
    const unsigned ldsw = (unsigned)wid * 1024u;
    const int aoff = lds_byte(wr * 64 + fr, fq * 8), boff = lds_byte(wc * 32 + fr, fq * 8);
#define PG8_SA(b, h) (((b) * 2 + (h)) * HTB)
#define PG8_SB(b, h) ((4 + (b) * 2 + (h)) * HTB)
#define PG8_STAGE(bufoff, gbase, voff) do { const char* _gb = (const char*)(gbase); asm volatile("" : "+s"(_gb)); _Pragma("unroll") for (int _i = 0; _i < 2; ++_i) { unsigned _o = (voff)[_i]; asm volatile("" : "+v"(_o)); \
        __builtin_amdgcn_global_load_lds((const unsigned*)(_gb + _o), (LAS unsigned*)(lds + (bufoff) + ldsw + _i * 8192), 16, 0, 0); } } while (0)
#define PG8_LDA(dst, b, h) do { _Pragma("unroll") for (int m = 0; m < 4; ++m) dst[m] = PG8_CAT(*(const LAS i32x4*)(lds + PG8_SA(b, h) + aoff + m * 2048), *(const LAS i32x4*)(lds + PG8_SA(b, h) + aoff + m * 2048 + 1024)); } while (0)
#define PG8_LDB(dst, b, h) do { _Pragma("unroll") for (int n = 0; n < 2; ++n) dst[n] = PG8_CAT(*(const LAS i32x4*)(lds + PG8_SB(b, h) + boff + n * 2048), *(const LAS i32x4*)(lds + PG8_SB(b, h) + boff + n * 2048 + 1024)); } while (0)
#define PG8_CAT(x0, x1) __builtin_shufflevector((x0), (x1), 0, 1, 2, 3, 4, 5, 6, 7)
#define PG8_LO(x) __builtin_bit_cast(bf16x8, __builtin_shufflevector((x), (x), 0, 1, 2, 3))
#define PG8_HI(x) __builtin_bit_cast(bf16x8, __builtin_shufflevector((x), (x), 4, 5, 6, 7))
#define PG8_MMA(ai, bj, At, Bt) do { __builtin_amdgcn_s_setprio(1); \
        if (FP8) { _Pragma("unroll") for (int m = 0; m < 4; ++m) _Pragma("unroll") for (int n = 0; n < 2; ++n) \
            acc[ai][bj][m][n] = __builtin_amdgcn_mfma_scale_f32_16x16x128_f8f6f4(Bt[n], At[m], acc[ai][bj][m][n], 0, 0, 0, 0x7f7f7f7f, 0, 0x7f7f7f7f); } \
        else { _Pragma("unroll") for (int m = 0; m < 4; ++m) _Pragma("unroll") for (int n = 0; n < 2; ++n) { \
            acc[ai][bj][m][n] = __builtin_amdgcn_mfma_f32_16x16x32_bf16(PG8_LO(Bt[n]), PG8_LO(At[m]), acc[ai][bj][m][n], 0, 0, 0); \
            acc[ai][bj][m][n] = __builtin_amdgcn_mfma_f32_16x16x32_bf16(PG8_HI(Bt[n]), PG8_HI(At[m]), acc[ai][bj][m][n], 0, 0, 0); } } \
        __builtin_amdgcn_s_setprio(0); } while (0)
#define PG8_WAIT_V(n) asm volatile("s_waitcnt vmcnt(" #n ")" ::: "memory")
#define PG8_WAIT_L(n) asm volatile("s_waitcnt lgkmcnt(" #n ")" ::: "memory")
#define PG8_BAR __builtin_amdgcn_s_barrier()
#define PG8_SCHED __builtin_amdgcn_sched_barrier(0)
    Unit cur, nxt; int ui = 0;
    if (!S.next(0, cur)) return;
    f32x4 acc[2][2][4][2];
#pragma unroll
    for (int a = 0; a < 2; ++a)
#pragma unroll
        for (int b = 0; b < 2; ++b)
#pragma unroll
            for (int m = 0; m < 4; ++m)
#pragma unroll
                for (int n = 0; n < 2; ++n) acc[a][b][m][n] = (f32x4){0.f, 0.f, 0.f, 0.f};
    i32x8 At[4], B0[2], B1[2];
    unsigned oA0[2], oA1[2];
#pragma unroll
    for (int i = 0; i < 2; ++i) { oA0[i] = RW.off(cur, sR[i]) + sC[i]; oA1[i] = RW.off(cur, HALF + sR[i]) + sC[i]; }
    const char* cB = cur.B;
    PG8_STAGE(PG8_SB(0, 0), cB, voffB); PG8_STAGE(PG8_SB(0, 1), cB + hstepB, voffB); PG8_STAGE(PG8_SA(0, 0), Abase, oA0); PG8_STAGE(PG8_SA(0, 1), Abase, oA1);
    if (wr == 1) PG8_BAR;
    PG8_WAIT_V(2); PG8_BAR;
    PG8_STAGE(PG8_SB(1, 0), cB + kstep, voffB); PG8_STAGE(PG8_SA(1, 0), Abase + kstep, oA0); PG8_STAGE(PG8_SB(1, 1), cB + hstepB + kstep, voffB);
    PG8_WAIT_V(6); PG8_BAR;
    for (;;) {
        const bool has_next = S.next(ui + 1, nxt);
        unsigned gi0 = 0u, gi1 = 0u, gi2 = 0u, gi3 = 0u;
        if (has_next && RW.list) {
            int t2 = threadIdx.x; asm volatile("" : "+v"(t2)); int R0, C0, R1, C1; stage_rc(t2 * 16, R0, C0); stage_rc(t2 * 16 + 8192, R1, C1);
            const int* lb = RW.list + (size_t)nxt.pm * 256; const unsigned o0 = (unsigned)R0 * 4u, o1 = (unsigned)R1 * 4u, o2 = (unsigned)(HALF + R0) * 4u, o3 = (unsigned)(HALF + R1) * 4u;
            asm volatile("global_load_dword %0, %4, %8\n\tglobal_load_dword %1, %5, %8\n\tglobal_load_dword %2, %6, %8\n\tglobal_load_dword %3, %7, %8"
                         : "=&v"(gi0), "=&v"(gi1), "=&v"(gi2), "=&v"(gi3) : "v"(o0), "v"(o1), "v"(o2), "v"(o3), "s"(lb));
        }
#pragma unroll 1
        for (int t = 0; t < nt; t += 2) {
            const bool last = (t == nt - 2);
            const char* a1 = Abase + (size_t)(t + 1) * kstep;
            PG8_LDB(B0, 0, 0); PG8_LDB(B1, 0, 1); PG8_SCHED; PG8_LDA(At, 0, 0); PG8_STAGE(PG8_SA(1, 1), a1, oA1);
            PG8_WAIT_V(8); PG8_WAIT_L(0); PG8_BAR; PG8_MMA(0, 0, At, B0); PG8_MMA(0, 1, At, B1); PG8_BAR; PG8_SCHED;
            const char* a2; const char* b2;
            if (last) {
                if (has_next) {
                    int t2 = threadIdx.x; asm volatile("" : "+v"(t2));
#pragma unroll
                    for (int i = 0; i < 2; ++i) { int R, C; stage_rc(t2 * 16 + i * 8192, R, C);
                        if (RW.list) { asm volatile("" : "+v"(gi0), "+v"(gi1), "+v"(gi2), "+v"(gi3)); oA0[i] = (i ? gi1 : gi0) * RW.ldab + (unsigned)C * 2u; oA1[i] = (i ? gi3 : gi2) * RW.ldab + (unsigned)C * 2u; }
                        else { oA0[i] = (unsigned)(nxt.pm * 256 + R) * RW.ldab + (unsigned)C * 2u; oA1[i] = (unsigned)(nxt.pm * 256 + HALF + R) * RW.ldab + (unsigned)C * 2u; } }
                    cB = nxt.B;
                }
                a2 = Abase; b2 = cB;
            } else { a2 = Abase + (size_t)(t + 2) * kstep; b2 = cB + (size_t)(t + 2) * kstep; }
            const char* a3 = a2 + kstep; const char* b3 = b2 + kstep;
            PG8_LDA(At, 0, 1); PG8_STAGE(PG8_SB(0, 0), b2, voffB); PG8_STAGE(PG8_SB(0, 1), b2 + hstepB, voffB); PG8_STAGE(PG8_SA(0, 0), a2, oA0);
            PG8_WAIT_V(8); PG8_WAIT_L(0); PG8_BAR; PG8_MMA(1, 0, At, B0); PG8_MMA(1, 1, At, B1); PG8_BAR; PG8_SCHED;
            PG8_LDB(B0, 1, 0); PG8_LDB(B1, 1, 1); PG8_SCHED; PG8_LDA(At, 1, 0); PG8_STAGE(PG8_SA(0, 1), a2, oA1);
            PG8_WAIT_V(8); PG8_WAIT_L(0); PG8_BAR; PG8_MMA(0, 0, At, B0); PG8_MMA(0, 1, At, B1); PG8_BAR; PG8_SCHED;
            PG8_LDA(At, 1, 1); PG8_STAGE(PG8_SB(1, 0), b3, voffB); PG8_STAGE(PG8_SB(1, 1), b3 + hstepB, voffB); PG8_STAGE(PG8_SA(1, 0), a3, oA0);
            PG8_WAIT_V(8); PG8_WAIT_L(0); PG8_BAR; PG8_MMA(1, 0, At, B0); PG8_MMA(1, 1, At, B1); PG8_BAR; PG8_SCHED;
        }
        if (wr == 0) PG8_BAR;
        { Unit eu = cur; asm volatile("" : "+s"(eu.pm), "+s"(eu.pn)); int t3 = threadIdx.x; asm volatile("" : "+v"(t3)); E(acc, eu, wr, wc, t3 & 15, (t3 & 63) >> 4); }
        if (!has_next) break;
#pragma unroll
        for (int a = 0; a < 2; ++a)
#pragma unroll
            for (int b = 0; b < 2; ++b)
#pragma unroll
                for (int m = 0; m < 4; ++m)
#pragma unroll
                    for (int n = 0; n < 2; ++n) acc[a][b][m][n] = (f32x4){0.f, 0.f, 0.f, 0.f};
        cur = nxt; ++ui;
        if (wr == 1) PG8_BAR;
    }
    PG8_WAIT_V(0);
    PG8_BAR;
#undef PG8_SA
#undef PG8_SB
#undef PG8_STAGE
#undef PG8_LDA
#undef PG8_LDB
#undef PG8_MMA
#undef PG8_CAT
#undef PG8_LO
#undef PG8_HI
#undef PG8_WAIT_V
#undef PG8_WAIT_L
#undef PG8_BAR
#undef PG8_SCHED
}
}

struct Params { const float* in[42]; float* out; unsigned char* ws; int ph_lo, ph_hi; };
enum { I_X = 0, I_C, I_CTX, I_CCTX, I_ADAW, I_ADAB, I_N1G, I_N2G, I_WIN, I_WOUT, I_GLAW, I_GLAB, I_GLAG, I_CDW, I_CDB, I_CLG, I_CLB, I_CPW, I_CPB,
       I_S5LR, I_S5LI, I_S5DT, I_S5BR, I_S5BI, I_S5CR, I_S5CI, I_S5D, I_S5GW, I_S5GB, I_QNG, I_KVNG, I_WUQ, I_WUKV, I_RW, I_RB, I_MG, I_MU, I_MD, I_SG, I_SU, I_SD, I_FG };

typedef const __attribute__((address_space(4))) Params* KParams;
__device__ __forceinline__ KParams fresh_params() { KParams kp = (KParams)__builtin_amdgcn_kernarg_segment_ptr(); asm volatile("" : "+s"(kp)); return kp; }
struct Ctx {
    LAS unsigned char* lds;
    int tid, lane, wave, blk, G;
    unsigned char* ws;
};

__device__ __forceinline__ int mod_row(int r) { return r < NLAT ? (r >> 11) : 32; }

__device__ __forceinline__ unsigned pk4_fp8(float a, float b, float c2, float d) {
    int pk = __builtin_amdgcn_cvt_pk_fp8_f32(__builtin_amdgcn_fmed3f(a, -440.f, 440.f), __builtin_amdgcn_fmed3f(b, -440.f, 440.f), 0, false);
    pk = __builtin_amdgcn_cvt_pk_fp8_f32(__builtin_amdgcn_fmed3f(c2, -440.f, 440.f), __builtin_amdgcn_fmed3f(d, -440.f, 440.f), pk, true); return (unsigned)pk; }
template <bool F8 = false>
__device__ __forceinline__ void tr_item(const float* W, int ldw, int k0, int n0, bf16* dst, int ldk, const float* kscale, float sc, LAS float* scr, int lane) {
    float tv[32];
#pragma unroll
    for (int i = 0; i < 32; ++i) tv[i] = W[(size_t)(k0 + 2 * i + (lane >> 5)) * ldw + n0 + (lane & 31)];
#pragma unroll
    for (int i = 0; i < 32; ++i) { const int kk = 2 * i + (lane >> 5); float v = tv[i] * sc; if (kscale) v *= kscale[k0 + kk]; scr[kk * 33 + (lane & 31)] = v; }
    lds_wait();
    const int c = lane & 7;
#pragma unroll
    for (int j = 0; j < 4; ++j) { const int n = (lane >> 3) + 8 * j; const LAS float* s = scr + (8 * c) * 33 + n;
        if (F8) { u32x2 o; o.x = pk4_fp8(s[0 * 33], s[1 * 33], s[2 * 33], s[3 * 33]); o.y = pk4_fp8(s[4 * 33], s[5 * 33], s[6 * 33], s[7 * 33]); *(u32x2*)((unsigned char*)dst + (size_t)n * ldk + k0 + 8 * c) = o; }
        else { u32x4 o; o.x = pk2(s[0 * 33], s[1 * 33]); o.y = pk2(s[2 * 33], s[3 * 33]); o.z = pk2(s[4 * 33], s[5 * 33]); o.w = pk2(s[6 * 33], s[7 * 33]);
            *(u32x4*)(dst + (size_t)n * ldk + k0 + 8 * c) = o; } }
    lds_wait();
}
template <int KIND> __device__ __forceinline__ int tr_dst(int n0) {
    if (KIND == 0) return n0;
    if (KIND == 1) return n0 < 768 ? n0 : (n0 == 768 ? 1952 : n0 - 32);
    if (KIND == 2) { const int half = n0 >> 8, c = n0 & 255; return (c >> 7) * 256 + half * 128 + (c & 127); }
    if (KIND == 3) { const int head = n0 / 96, d0 = n0 % 96; return d0 < 64 ? head * 64 + d0 : 256 + head * 32; }
    if (KIND == 4) { const int head = n0 >> 7, d0 = n0 & 127; return d0 < 64 ? head * 64 + d0 : 256 + head * 64 + (d0 - 64); }
    if (KIND == 5) return (n0 >> 7) * 256 + (n0 & 127);
    if (KIND == 6) return (n0 >> 7) * 256 + 128 + (n0 & 127);
    return n0;
}
template <int KIND, bool F8 = false> __device__ __forceinline__ void tr_matrix(const Ctx& c, const float* W, int ldw, int K, int Nsrc, bf16* WT, int ldk, const float* kscale, float sc) {
    LAS float* scr = (LAS float*)(c.lds + c.wave * 8704);
    const int gw = c.blk * NWAVES + c.wave, NGW = c.G * NWAVES, ng = Nsrc / 32, items = (K / 64) * ng;
    for (int it = gw; it < items; it += NGW) { const int kb = it / ng, g = it % ng; tr_item<F8>(W, ldw, kb * 64, 32 * g, F8 ? (bf16*)((unsigned char*)WT + (size_t)tr_dst<KIND>(32 * g) * ldk) : WT + (size_t)tr_dst<KIND>(32 * g) * ldk, ldk, kscale, sc, scr, c.lane); }
}
__device__ __forceinline__ void zero_fill16(const Ctx& c, void* p, size_t bytes) {
    u32x4* q = (u32x4*)p; const size_t n = bytes / 16;
    for (size_t i = (size_t)c.blk * NTHR + c.tid; i < n; i += (size_t)c.G * NTHR) q[i] = (u32x4){0u, 0u, 0u, 0u};
}
__device__ __forceinline__ void sincos_r(float x, float& s, float& co) {
    const float n = rintf(x * 0.15915494309189535f);
    float r = fmaf(n, -6.28125f, x); r = fmaf(n, -1.9353071795864769e-3f, r);
    s = __sinf(r); co = __cosf(r);
}

__device__ __forceinline__ void prologue_moe_weights(const Ctx& c, KParams p, int l) {
    unsigned char* WGU8 = c.ws + WS_WMOE + (size_t)l * 48 * MiB;
    unsigned char* WD8 = WGU8 + (size_t)NE * 512 * 1024;
    LAS float* scr = (LAS float*)(c.lds + c.wave * 8704);
    const int gw = c.blk * NWAVES + c.wave, NGW = c.G * NWAVES;
    for (int it = gw; it < NE * 384; it += NGW) {
        const int e = it / 384, r = it % 384;
        if (r < 256) { const int up = r >> 7, q = r & 127, kb = q >> 3, g = q & 7;
            const float* W = p->in[up ? I_MU : I_MG] + ((size_t)l * NE + e) * 1024 * 256;
            const int nd = up ? tr_dst<6>(32 * g) : tr_dst<5>(32 * g);
            tr_item<true>(W, 256, kb * 64, 32 * g, (bf16*)(WGU8 + (size_t)e * 512 * 1024 + (size_t)nd * 1024), 1024, nullptr, 64.f, scr, c.lane);
        } else { const int q = r - 256, kb = q >> 5, g = q & 31;
            const float* W = p->in[I_MD] + ((size_t)l * NE + e) * 256 * 1024;
            tr_item<true>(W, 1024, kb * 64, 32 * g, (bf16*)(WD8 + (size_t)e * 1024 * 256 + (size_t)(32 * g) * 256), 256, nullptr, 64.f, scr, c.lane);
        }
    }
}

__device__ __forceinline__ void prologue(const Ctx& c, KParams p) {
    float* MOD = (float*)(c.ws + WS_MOD);
    {
        const int u = c.G - 1 - c.blk;
        if (u < 96) {
            LAS float* sc = (LAS float*)(c.lds + 72 * 1024);
            LAS float* part = (LAS float*)c.lds;
            const int l = u / 48, kq = c.tid >> 7, cj = c.tid & 127, col = (u % 48) * 128 + cj;
            const float* W = p->in[I_ADAW] + (size_t)l * 1024 * 6144;
            float acc[33];
#pragma unroll
            for (int b = 0; b < 33; ++b) acc[b] = 0.f;
            for (int j = 0; j < 4; ++j) {
                __syncthreads();
                for (int i = c.tid; i < 4 * 33 * 64; i += NTHR) { const int q = i / (33 * 64), r = i % (33 * 64), b = r >> 6, kk = r & 63, k = 256 * q + 64 * j + kk; const float v = b < 32 ? p->in[I_C][b * 1024 + k] : p->in[I_CCTX][k]; sc[i] = siluf_(v); }
                __syncthreads();
                const float* wp = W + (size_t)(256 * kq + 64 * j) * 6144 + col; const LAS float* sq = sc + kq * 33 * 64;
#pragma unroll 8
                for (int kk = 0; kk < 64; ++kk) { const float w = wp[(size_t)kk * 6144];
#pragma unroll
                    for (int b = 0; b < 33; ++b) acc[b] = fmaf(sq[b * 64 + kk], w, acc[b]); }
            }
#pragma unroll
            for (int b = 0; b < 33; ++b) part[(kq * 33 + b) * 128 + cj] = acc[b];
            __syncthreads();
            for (int i = c.tid; i < 33 * 128; i += NTHR) { const int b = i >> 7, cc = i & 127, gc = (u % 48) * 128 + cc;
                MOD[((size_t)l * 33 + b) * 6144 + gc] = (part[(0 * 33 + b) * 128 + cc] + part[(1 * 33 + b) * 128 + cc]) + (part[(2 * 33 + b) * 128 + cc] + part[(3 * 33 + b) * 128 + cc]) + p->in[I_ADAB][l * 6144 + gc]; }
            __syncthreads();
        }
    }
    {
        float* ROPE = (float*)(c.ws + WS_TAB + TAB_ROPE);
        for (int i = c.blk * NTHR + c.tid; i < 2048 * 16; i += c.G * NTHR) { const int t = i >> 4, ax = (i >> 3) & 1, f = i & 7;
            const float pos = (float)(ax == 0 ? (t >> 6) : (t & 63)); const float inv = __expf(-(float)f * (9.210340371976184f / 8.0f));
            float s, co; sincos_r(pos * inv, s, co); ROPE[i * 2] = co; ROPE[i * 2 + 1] = s; }
        bf16* RWT = (bf16*)(c.ws + WS_TAB + TAB_RWT);
        for (int i = c.blk * NTHR + c.tid; i < 2 * 64 * 1024; i += c.G * NTHR) { const int l = i >> 16, n = (i >> 10) & 63, k = i & 1023; const float wv = p->in[I_RW][((size_t)l * 1024 + k) * 64 + n];
            const bf16 hi = f2bf(wv); RWT[(size_t)(l * 2) * 65536 + n * 1024 + k] = hi; RWT[(size_t)(l * 2 + 1) * 65536 + n * 1024 + k] = f2bf(wv - bf2f(hi)); }
        float* S5T = (float*)(c.ws + WS_TAB + TAB_S5);
        for (int i = c.blk * NTHR + c.tid; i < 2 * 2 * 16 * 64; i += c.G * NTHR) {
            const int pp = i & 63, g = (i >> 6) & 15, ld = i >> 10;
            const float lr = p->in[I_S5LR][i], li = p->in[I_S5LI][i], dt = __expf(p->in[I_S5DT][ld * 16 + g]);
            const float mag = __expf(lr * dt); float s, co; sincos_r(li * dt, s, co);
            const float are = mag * co, aim = mag * s, den = lr * lr + li * li;
            const float fre = ((are - 1.f) * lr + aim * li) / den, fim = (aim * lr - (are - 1.f) * li) / den;
            float* T = S5T + (size_t)i * 66; T[0] = are; T[1] = aim;
            { float* PW = (float*)(c.ws + WS_S5P) + (size_t)i * 34; float pr = 1.f, pi = 0.f;
              for (int e = 0; e <= 16; ++e) { PW[2 * e] = pr; PW[2 * e + 1] = pi; const float nr = pr * are - pi * aim, ni = pr * aim + pi * are; pr = nr; pi = ni; } }
            for (int ch = 0; ch < 16; ++ch) { const float br = p->in[I_S5BR][(size_t)i * 16 + ch], bi = p->in[I_S5BI][(size_t)i * 16 + ch];
                T[2 + ch] = fre * br - fim * bi; T[18 + ch] = fre * bi + fim * br;
                T[34 + ch] = p->in[I_S5CR][((size_t)(ld * 16 + g) * 16 + ch) * 64 + pp]; T[50 + ch] = p->in[I_S5CI][((size_t)(ld * 16 + g) * 16 + ch) * 64 + pp]; }
        }
    }
    for (int l = 0; l < 2; ++l) {
        bf16* WIN = (bf16*)(c.ws + WS_WIN) + (size_t)l * 2048 * 1024;
        tr_matrix<1, true>(c, p->in[I_WIN] + (size_t)l * 1024 * 1984, 1984, 1024, 1984, WIN, 1024, nullptr, 64.f);
        zero_fill16(c, (unsigned char*)WIN + (size_t)1984 * 1024, (size_t)64 * 1024);
        tr_matrix<0, true>(c, p->in[I_WOUT] + (size_t)l * 1024 * 1024, 1024, 1024, 1024, (bf16*)(c.ws + WS_WOUT) + (size_t)l * 1024 * 1024, 1024, nullptr, 64.f);
        unsigned char* sm = c.ws + WS_WSM + (size_t)l * WSM_L;
        tr_matrix<0>(c, p->in[I_CPW] + (size_t)l * 256 * 256, 256, 256, 256, (bf16*)(sm + WSM_PW), 256, nullptr, 1.f);
        tr_matrix<2>(c, p->in[I_S5GW] + (size_t)l * 256 * 512, 512, 256, 512, (bf16*)(sm + WSM_GLU), 256, nullptr, 1.f);
        tr_matrix<3>(c, p->in[I_WUQ] + (size_t)l * 256 * 384, 384, 256, 384, (bf16*)(sm + WSM_UQ), 256, p->in[I_QNG] + l * 256, 0.14724445f  );
        zero_fill16(c, (bf16*)(sm + WSM_UQ) + (size_t)384 * 256, (size_t)128 * 256 * 2);
        zero_fill16(c, sm + WSM_UK, (size_t)512 * 256 * 2);
    }
    for (int l = 0; l < 2; ++l) {
        bf16* WSGU = (bf16*)(c.ws + WS_WSH) + (size_t)l * (512 * 1024 + 1024 * 256); bf16* WSD = WSGU + 512 * 1024;
        tr_matrix<5, true>(c, p->in[I_SG] + (size_t)l * 1024 * 256, 256, 1024, 256, WSGU, 1024, nullptr, 64.f);
        tr_matrix<6, true>(c, p->in[I_SU] + (size_t)l * 1024 * 256, 256, 1024, 256, WSGU, 1024, nullptr, 64.f);
        tr_matrix<0, true>(c, p->in[I_SD] + (size_t)l * 256 * 1024, 1024, 256, 1024, (bf16*)((unsigned char*)WSGU + 512 * 1024), 256, nullptr, 64.f);
    }
    prologue_moe_weights(c, p, 0);
    prologue_moe_weights(c, p, 1);
}
__device__ __forceinline__ void prologue_s5_weights(const Ctx& c, KParams p) {
    const float* S5T = (const float*)(c.ws + WS_TAB + TAB_S5); const float* S5P = (const float*)(c.ws + WS_S5P);
    LAS float* pw = (LAS float*)c.lds;
    LAS float* bb = pw + 2 * 17 * 64 * 2;
    LAS float* cc = bb + 2 * 64 * 16 * 2;
    LAS float* kt = cc + 2 * 16 * 64 * 2;
    for (int u = c.blk; u < 32; u += c.G) {
        const int l = u >> 4, g = u & 15;
        __syncthreads();
        for (int i = c.tid; i < 2 * 64; i += NTHR) { const int dir = i >> 6, pp = i & 63; const size_t row = (size_t)((l * 2 + dir) * 16 + g) * 64 + pp; const float* T = S5T + row * 66; const float* PW = S5P + row * 34;
            for (int e = 0; e <= 16; ++e) { pw[((dir * 17 + e) * 64 + pp) * 2] = PW[2 * e]; pw[((dir * 17 + e) * 64 + pp) * 2 + 1] = PW[2 * e + 1]; }
            for (int ch = 0; ch < 16; ++ch) { bb[((dir * 64 + pp) * 16 + ch) * 2] = T[2 + ch]; bb[((dir * 64 + pp) * 16 + ch) * 2 + 1] = T[18 + ch]; cc[((dir * 16 + ch) * 64 + pp) * 2] = T[34 + ch]; cc[((dir * 16 + ch) * 64 + pp) * 2 + 1] = T[50 + ch]; } }
        __syncthreads();
        for (int i = c.tid; i < 2 * 16 * 256; i += NTHR) { const int dir = i >> 12, tau = (i >> 8) & 15, c1 = (i >> 4) & 15, c0 = i & 15; float s = 0.f;
            for (int pp = 0; pp < 64; ++pp) { const float cr = cc[((dir * 16 + c1) * 64 + pp) * 2], ci = cc[((dir * 16 + c1) * 64 + pp) * 2 + 1], pr = pw[((dir * 17 + tau) * 64 + pp) * 2], pi = pw[((dir * 17 + tau) * 64 + pp) * 2 + 1];
                const float wr_ = cr * pr - ci * pi, wi_ = cr * pi + ci * pr; s += wr_ * bb[((dir * 64 + pp) * 16 + c0) * 2] - wi_ * bb[((dir * 64 + pp) * 16 + c0) * 2 + 1]; }
            kt[i] = s; }
        __syncthreads();
        bf16* B1 = (bf16*)(c.ws + WS_S5W) + (size_t)(l * 16 + g) * 256 * 256;
        bf16* B2 = (bf16*)(c.ws + WS_S5W) + (size_t)32 * 256 * 256 + (size_t)(l * 16 + g) * 256 * 512;
        const float* dsk = p->in[I_S5D] + l * 256 + g * 16;
        for (int i = c.tid; i < 256 * 256; i += NTHR) { const int n = i >> 8, k = i & 255, dir = n >> 7, ri = (n >> 6) & 1, pp = n & 63, s = k >> 4, ch = k & 15, e = dir ? s : 15 - s;
            const float pr = pw[((dir * 17 + e) * 64 + pp) * 2], pi = pw[((dir * 17 + e) * 64 + pp) * 2 + 1], br = bb[((dir * 64 + pp) * 16 + ch) * 2], bi = bb[((dir * 64 + pp) * 16 + ch) * 2 + 1];
            B1[i] = f2bf(ri ? pr * bi + pi * br : pr * br - pi * bi); }
        for (int i = c.tid; i < 256 * 512; i += NTHR) { const int n = i >> 9, k = i & 511, t = n >> 4, c1 = n & 15; float v;
            if (k < 256) { const int s = k >> 4, c0 = k & 15; v = 0.f; if (s <= t) v += kt[((0 * 16 + (t - s)) * 16 + c1) * 16 + c0]; if (s >= t) v += kt[((1 * 16 + (s - t)) * 16 + c1) * 16 + c0]; if (s == t && c0 == c1) v += dsk[c0]; }
            else { const int q = k - 256, dir = q >> 7, ri = (q >> 6) & 1, pp = q & 63, e = dir ? 16 - t : t + 1;
                const float cr = cc[((dir * 16 + c1) * 64 + pp) * 2], ci = cc[((dir * 16 + c1) * 64 + pp) * 2 + 1], pr = pw[((dir * 17 + e) * 64 + pp) * 2], pi = pw[((dir * 17 + e) * 64 + pp) * 2 + 1];
                v = ri ? -(cr * pi + ci * pr) : (cr * pr - ci * pi); }
            B2[i] = f2bf(v); }
    }
    __syncthreads();
}
__device__ __forceinline__ void prologue2(const Ctx& c, KParams p) {
    prologue_s5_weights(c, p);
    for (int l = 0; l < 2; ++l) { unsigned char* sm = c.ws + WS_WSM + (size_t)l * WSM_L;
        tr_matrix<4>(c, p->in[I_WUKV] + (size_t)l * 128 * 512, 512, 128, 512, (bf16*)(sm + WSM_UK), 256, p->in[I_KVNG] + l * 128, 1.f); }
}

__device__ __forceinline__ void norm_row(const float* xrow, const float* gain, const float* sh, const float* sc, bf16* orow, int lane, f32x4 (&v)[4]) {
    float ss = 0.f;
#pragma unroll
    for (int j = 0; j < 4; ++j) { v[j] = *(const f32x4*)(xrow + 4 * lane + 256 * j); ss += (v[j].x * v[j].x + v[j].y * v[j].y) + (v[j].z * v[j].z + v[j].w * v[j].w); }
    const float rstd = rsqrtf(wave_sum(ss) * (1.f / 1024.f) + EPS);
#pragma unroll
    for (int j = 0; j < 4; ++j) { const int cc = 4 * lane + 256 * j; const f32x4 g = *(const f32x4*)(gain + cc), s1 = *(const f32x4*)(sc + cc), s0 = *(const f32x4*)(sh + cc);
        v[j] = v[j] * rstd * g * (s1 + 1.0f) + s0;
        u32x2 o; o.x = pk2(v[j].x, v[j].y); o.y = pk2(v[j].z, v[j].w); *(u32x2*)(orow + cc) = o; }
}
__device__ __forceinline__ void norm_row_add(const float* xrow, const bf16* drow, float* xout, const float* gain, const float* sh, const float* sc, unsigned char* orow8, int lane, f32x4 (&v)[4]) {
    float ss = 0.f; u32x2 dl[4];
#pragma unroll
    for (int j = 0; j < 4; ++j) { v[j] = *(const f32x4*)(xrow + 4 * lane + 256 * j); dl[j] = *(const u32x2*)(drow + 4 * lane + 256 * j); }
#pragma unroll
    for (int j = 0; j < 4; ++j) { v[j] += (f32x4){__uint_as_float(dl[j].x << 16), __uint_as_float(dl[j].x & 0xffff0000u), __uint_as_float(dl[j].y << 16), __uint_as_float(dl[j].y & 0xffff0000u)};
        *(f32x4*)(xout + 4 * lane + 256 * j) = v[j]; ss += (v[j].x * v[j].x + v[j].y * v[j].y) + (v[j].z * v[j].z + v[j].w * v[j].w); }
    const float rstd = rsqrtf(wave_sum(ss) * (1.f / 1024.f) + EPS);
#pragma unroll
    for (int j = 0; j < 4; ++j) { const int cc = 4 * lane + 256 * j; const f32x4 g = *(const f32x4*)(gain + cc), s1 = *(const f32x4*)(sc + cc), s0 = *(const f32x4*)(sh + cc);
        v[j] = v[j] * rstd * g * (s1 + 1.0f) + s0;
        *(unsigned*)(orow8 + cc) = pk4_fp8(v[j].x * 4.f, v[j].y * 4.f, v[j].z * 4.f, v[j].w * 4.f); }
}
__device__ __forceinline__ void phase_norm1(const Ctx& c, KParams p, int l) {
    const float* MOD = (const float*)(c.ws + WS_MOD) + (size_t)l * 33 * 6144;
    const float* xl = l == 0 ? p->in[I_X] : p->out; const float* xc = l == 0 ? p->in[I_CTX] : (const float*)(c.ws + WS_XC);
    unsigned char* H = c.ws + WS_H; const float* gain = p->in[I_N1G] + l * DM;
    const int gw = c.blk * NWAVES + c.wave, NGW = c.G * NWAVES, lane = c.lane;
    for (int r0 = gw; r0 < NTOK; r0 += 2 * NGW) {
        f32x4 v[2][4]; float ss[2];
#pragma unroll
        for (int k = 0; k < 2; ++k) { const int r = r0 + k * NGW < NTOK ? r0 + k * NGW : r0; const float* xr = r < NLAT ? xl + (size_t)r * DM : xc + (size_t)(r - NLAT) * DM;
#pragma unroll
            for (int j = 0; j < 4; ++j) v[k][j] = *(const f32x4*)(xr + 4 * lane + 256 * j); }
#pragma unroll
        for (int k = 0; k < 2; ++k) { ss[k] = 0.f;
#pragma unroll
            for (int j = 0; j < 4; ++j) ss[k] += (v[k][j].x * v[k][j].x + v[k][j].y * v[k][j].y) + (v[k][j].z * v[k][j].z + v[k][j].w * v[k][j].w); }
#pragma unroll
        for (int k = 0; k < 2; ++k) { const int r = r0 + k * NGW; if (r < NTOK) { const float rstd = rsqrtf(wave_sum(ss[k]) * (1.f / 1024.f) + EPS); const float* m = MOD + (size_t)mod_row(r) * 6144; unsigned char* orow = H + (size_t)r * DM;
#pragma unroll
            for (int j = 0; j < 4; ++j) { const int cc = 4 * lane + 256 * j; const f32x4 g = *(const f32x4*)(gain + cc), s1 = *(const f32x4*)(m + 1024 + cc), s0 = *(const f32x4*)(m + cc);
                const f32x4 y = (v[k][j] * rstd * g * (s1 + 1.0f) + s0) * 4.f; *(unsigned*)(orow + cc) = pk4_fp8(y.x, y.y, y.z, y.w); } } }
    }
}

#define EPI_ARGS const f32x4 (&acc)[2][2][4][2], const pg8::Unit& u, int wr, int wc, int fr, int fq
#define EPI_ROWS for (int ai = 0; ai < 2; ++ai) _Pragma("unroll") for (int m = 0; m < 4; ++m)
struct EpiBf16 {
    bf16* O; int ldo;
    __device__ __forceinline__ void operator()(EPI_ARGS) const {
        const int r0 = u.pm * 256 + wr * 64 + fr, c0 = u.pn * 256 + wc * 32 + 8 * fq;
#pragma unroll
        EPI_ROWS { bf16* rp = O + (size_t)(r0 + ai * 128 + m * 16) * ldo + c0;
#pragma unroll
            for (int bj = 0; bj < 2; ++bj) { const f32x4 a = acc[ai][bj][m][0], b = acc[ai][bj][m][1]; u32x4 w; w.x = pk2(a.x, a.y); w.y = pk2(a.z, a.w); w.z = pk2(b.x, b.y); w.w = pk2(b.z, b.w); *(u32x4*)(rp + bj * 128) = w; } asm volatile("" ::: "memory"); }
    }
};
struct EpiInProj {
    bf16* O; bf16* UP; bf16* GVT; float sc;
    __device__ __forceinline__ void operator()(EPI_ARGS) const {
        const int r0 = u.pm * 256 + wr * 64 + fr, c0 = u.pn * 256 + wc * 32 + 8 * fq;
#pragma unroll
        EPI_ROWS { const int row = r0 + ai * 128 + m * 16; bf16* rp = O + (size_t)row * ZW + c0;
            const int crow = row < NLAT ? (row >> 11) * 144 + 16 + ((row & 2047) >> 4) : ((row - NLAT) >> 8) * 144 + (((row - NLAT) & 255) >> 4);
#pragma unroll
            for (int bj = 0; bj < 2; ++bj) { const f32x4 a = acc[ai][bj][m][0] * sc, b = acc[ai][bj][m][1] * sc; u32x4 w; w.x = pk2(a.x, a.y); w.y = pk2(a.z, a.w); w.z = pk2(b.x, b.y); w.w = pk2(b.z, b.w);
                if (u.pn != 1 && u.pn != 5) *(u32x4*)(rp + bj * 128) = w;
                if (u.pn == 5) { const int g = 8 * bj + 2 * wc + (fq >> 1); *(u32x4*)(UP + ((size_t)g * 4608 + crow) * 512 + fr * 16 + 8 * (fq & 1)) = w; }
                if (u.pn == 1) { const int col = 128 * bj + 32 * wc + 8 * fq, bb = row < NLAT ? (row >> 11) : ((row - NLAT) >> 8), kk = row < NLAT ? 256 + (row & 2047) : ((row - NLAT) & 255);
                    bf16* dst = GVT + ((size_t)(bb * 4 + (col >> 6)) * 64 + (col & 63)) * 2304 + (kk & ~15) + 8 * ((fr >> 2) & 1) + 4 * (fr >> 3) + (fr & 3);
#pragma unroll
                    for (int n = 0; n < 2; ++n)
#pragma unroll
                        for (int i = 0; i < 4; ++i) dst[(size_t)(4 * n + i) * 2304] = f2bf(acc[ai][bj][m][n][i] * sc); } }
            asm volatile("" ::: "memory"); }
    }
};
struct EpiS5X {
    bf16* XE;
    __device__ __forceinline__ void operator()(EPI_ARGS) const {
        const int r0 = u.pm * 256 + wr * 64 + fr, c0 = wc * 32 + 8 * fq;
#pragma unroll
        EPI_ROWS { bf16* rp = XE + (size_t)(r0 + ai * 128 + m * 16) * 256 + c0;
#pragma unroll
            for (int bj = 0; bj < 2; ++bj) { const f32x4 a = acc[ai][bj][m][0], b = acc[ai][bj][m][1]; u32x4 w; w.x = pk2(a.x, a.y); w.y = pk2(a.z, a.w); w.z = pk2(b.x, b.y); w.w = pk2(b.z, b.w); *(u32x4*)(rp + bj * 128) = w; }
            asm volatile("" ::: "memory"); }
    }
};
struct EpiS5Y {
    bf16* Y;
    __device__ __forceinline__ void operator()(EPI_ARGS) const {
        const int r0 = u.pm * 256 + wr * 64 + fr;
#pragma unroll
        EPI_ROWS { const int grow = r0 + ai * 128 + m * 16; const int g = grow / 4608, rem = grow - g * 4608, b = rem / 144, ci = rem - b * 144;
            const int tok0 = ci < 16 ? NLAT + b * CTXL + ci * 16 : b * SEQ + (ci - 16) * 16;
#pragma unroll
            for (int bj = 0; bj < 2; ++bj) { const int t = 8 * bj + 2 * wc + (fq >> 1); const f32x4 a = acc[ai][bj][m][0], bq = acc[ai][bj][m][1]; u32x4 w; w.x = pk2(a.x, a.y); w.y = pk2(a.z, a.w); w.z = pk2(bq.x, bq.y); w.w = pk2(bq.z, bq.w);
                *(u32x4*)(Y + (size_t)(tok0 + t) * 256 + g * 16 + 8 * (fq & 1)) = w; }
            asm volatile("" ::: "memory"); }
    }
};
struct EpiOB8 {
    unsigned char* OB; float sc;
    __device__ __forceinline__ void operator()(EPI_ARGS) const {
        const int r0 = u.pm * 256 + wr * 64 + fr;
#pragma unroll
        EPI_ROWS { unsigned char* rp = OB + (size_t)(r0 + ai * 128 + m * 16) * 1024 + u.pn * 256 + (wc * 4 + fq) * 16; u32x4 w;
#pragma unroll
            for (int bj = 0; bj < 2; ++bj)
#pragma unroll
                for (int n = 0; n < 2; ++n) { const f32x4 a = acc[ai][bj][m][n] * sc; int pk = 0;
                    pk = __builtin_amdgcn_cvt_pk_fp8_f32(__builtin_amdgcn_fmed3f(a.x, -440.f, 440.f), __builtin_amdgcn_fmed3f(a.y, -440.f, 440.f), pk, false);
                    pk = __builtin_amdgcn_cvt_pk_fp8_f32(__builtin_amdgcn_fmed3f(a.z, -440.f, 440.f), __builtin_amdgcn_fmed3f(a.w, -440.f, 440.f), pk, true); w[2 * bj + n] = (unsigned)pk; }
            *(u32x4*)rp = w; asm volatile("" ::: "memory"); }
    }
};
struct EpiBf16S {
    bf16* O; int ldo; float sc;
    __device__ __forceinline__ void operator()(EPI_ARGS) const {
        const int r0 = u.pm * 256 + wr * 64 + fr, c0 = u.pn * 256 + wc * 32 + 8 * fq;
#pragma unroll
        EPI_ROWS { bf16* rp = O + (size_t)(r0 + ai * 128 + m * 16) * ldo + c0;
#pragma unroll
            for (int bj = 0; bj < 2; ++bj) { const f32x4 a = acc[ai][bj][m][0] * sc, b = acc[ai][bj][m][1] * sc; u32x4 w; w.x = pk2(a.x, a.y); w.y = pk2(a.z, a.w); w.z = pk2(b.x, b.y); w.w = pk2(b.z, b.w); *(u32x4*)(rp + bj * 128) = w; }
            asm volatile("" ::: "memory"); }
    }
};
struct EpiBiasBf16 {
    unsigned char* O; int ldo; const float* bias;
    __device__ __forceinline__ void operator()(EPI_ARGS) const {
        const int r0 = u.pm * 256 + wr * 64 + fr, c0 = u.pn * 256 + wc * 32 + 8 * fq;
        f32x4 bv[2][2];
#pragma unroll
        for (int bj = 0; bj < 2; ++bj) { bv[bj][0] = *(const f32x4*)(bias + c0 + bj * 128); bv[bj][1] = *(const f32x4*)(bias + c0 + bj * 128 + 4); }
        __builtin_amdgcn_s_waitcnt(0x0F70);
#pragma unroll
        EPI_ROWS { unsigned char* rp = O + (size_t)(r0 + ai * 128 + m * 16) * ldo + c0;
#pragma unroll
            for (int bj = 0; bj < 2; ++bj) { const f32x4 a = (acc[ai][bj][m][0] + bv[bj][0]) * 16.f, b = (acc[ai][bj][m][1] + bv[bj][1]) * 16.f; u32x2 w; w.x = pk4_fp8(a.x, a.y, a.z, a.w); w.y = pk4_fp8(b.x, b.y, b.z, b.w); *(u32x2*)(rp + bj * 128) = w; } asm volatile("" ::: "memory"); }
    }
};
struct EpiGluSig {
    unsigned char* O; int ldo; const float* bias;
    __device__ __forceinline__ void operator()(EPI_ARGS) const {
        const int r0 = u.pm * 256 + wr * 64 + fr, c0 = u.pn * 128 + wc * 32 + 8 * fq;
        f32x4 b1[2], b2[2];
#pragma unroll
        for (int n = 0; n < 2; ++n) { b1[n] = *(const f32x4*)(bias + c0 + 4 * n); b2[n] = *(const f32x4*)(bias + 256 + c0 + 4 * n); }
        __builtin_amdgcn_s_waitcnt(0x0F70);
#pragma unroll
        EPI_ROWS { unsigned char* rp = O + (size_t)(r0 + ai * 128 + m * 16) * ldo + c0; float o[8];
#pragma unroll
            for (int n = 0; n < 2; ++n)
#pragma unroll
                for (int i = 0; i < 4; ++i) o[4 * n + i] = (acc[ai][0][m][n][i] + b1[n][i]) * (16.f * sigmoidf_(acc[ai][1][m][n][i] + b2[n][i]));
            u32x2 w; w.x = pk4_fp8(o[0], o[1], o[2], o[3]); w.y = pk4_fp8(o[4], o[5], o[6], o[7]); *(u32x2*)rp = w; asm volatile("" ::: "memory"); }
    }
};
struct EpiSwiglu {
    unsigned char* O; int ldo; float sc;
    __device__ __forceinline__ void operator()(EPI_ARGS) const {
        const int r0 = u.pm * 256 + wr * 64 + fr, c0 = u.pn * 128 + wc * 32 + 8 * fq;
#pragma unroll
        EPI_ROWS { unsigned char* rp = O + (size_t)(r0 + ai * 128 + m * 16) * ldo + c0; float o[8];
#pragma unroll
            for (int n = 0; n < 2; ++n)
#pragma unroll
                for (int i = 0; i < 4; ++i) o[4 * n + i] = siluf_(acc[ai][0][m][n][i] * sc) * (acc[ai][1][m][n][i] * (sc * 16.0f));
            u32x2 w; w.x = pk4_fp8(o[0], o[1], o[2], o[3]); w.y = pk4_fp8(o[4], o[5], o[6], o[7]); *(u32x2*)rp = w; asm volatile("" ::: "memory"); }
    }
};
struct EpiQ {
    bf16* Q; const float* RS;
    __device__ __forceinline__ void operator()(EPI_ARGS) const {
        const int r0 = u.pm * 256 + wr * 64 + fr; float rq[8];
#pragma unroll
        for (int g = 0; g < 8; ++g) rq[g] = RS[(size_t)(r0 + (g >> 2) * 128 + (g & 3) * 16) * 2];
        __builtin_amdgcn_s_waitcnt(0x0F70);
#pragma unroll
        EPI_ROWS { const int row = r0 + ai * 128 + m * 16; const float rs = rq[ai * 4 + m]; bf16* rp = Q + (size_t)row * 384;
            if (u.pn == 0) {
#pragma unroll
                for (int bj = 0; bj < 2; ++bj) { const int head = 2 * bj + (wc >> 1), d = 32 * (wc & 1) + 8 * fq; const f32x4 a = acc[ai][bj][m][0] * rs, b = acc[ai][bj][m][1] * rs;
                    u32x4 w; w.x = pk2(a.x, a.y); w.y = pk2(a.z, a.w); w.z = pk2(b.x, b.y); w.w = pk2(b.z, b.w); *(u32x4*)(rp + head * 96 + d) = w; }
            } else { const f32x4 a = acc[ai][0][m][0] * rs, b = acc[ai][0][m][1] * rs;
                u32x4 w; w.x = pk2(a.x, a.y); w.y = pk2(a.z, a.w); w.z = pk2(b.x, b.y); w.w = pk2(b.z, b.w); *(u32x4*)(rp + wc * 96 + 64 + 8 * fq) = w; }
            asm volatile("" ::: "memory"); }
    }
};
struct EpiKV {
    bf16* Kb; bf16* VT; const float* RS;
    __device__ __forceinline__ void operator()(EPI_ARGS) const {
        const int r0 = u.pm * 256 + wr * 64 + fr;
        const int p16 = 8 * ((fr >> 2) & 1) + 4 * (fr >> 3) + (fr & 3); float rkv[8];
#pragma unroll
        for (int g = 0; g < 8; ++g) rkv[g] = RS[(size_t)(r0 + (g >> 2) * 128 + (g & 3) * 16) * 2 + 1];
        __builtin_amdgcn_s_waitcnt(0x0F70);
#pragma unroll
        EPI_ROWS { const int row = r0 + ai * 128 + m * 16; const float rk = rkv[ai * 4 + m];
            if (u.pn == 0) {
#pragma unroll
                for (int bj = 0; bj < 2; ++bj) { const int head = 2 * bj + (wc >> 1), d = 32 * (wc & 1) + 8 * fq; const f32x4 a = acc[ai][bj][m][0] * rk, b = acc[ai][bj][m][1] * rk;
                    u32x4 w; w.x = pk2(a.x, a.y); w.y = pk2(a.z, a.w); w.z = pk2(b.x, b.y); w.w = pk2(b.z, b.w);
                    *(u32x4*)(Kb + (size_t)row * 384 + head * 96 + d) = w; }
            } else {
                const int bb = row < NLAT ? (row >> 11) : ((row - NLAT) >> 8); const int kk = row < NLAT ? (row & 2047) : 2048 + ((row - NLAT) & 255);
                const int pos = (kk & ~15) + p16;
#pragma unroll
                for (int bj = 0; bj < 2; ++bj) { const int head = 2 * bj + (wc >> 1), d = 32 * (wc & 1) + 8 * fq; bf16* dst = VT + ((size_t)((bb * 4 + head) * 64 + d)) * 2304 + pos;
#pragma unroll
                    for (int n = 0; n < 2; ++n)
#pragma unroll
                        for (int i = 0; i < 4; ++i) dst[(size_t)(4 * n + i) * 2304] = f2bf(acc[ai][bj][m][n][i] * rk); }
            }
            asm volatile("" ::: "memory"); }
    }
};
struct EpiDelta {
    bf16* D; const float* MODg; float sc;
    __device__ __forceinline__ void operator()(EPI_ARGS) const {
        const int rt = u.pm * 256; const float* g = MODg + (size_t)(rt < NLAT ? (rt >> 11) : 32) * 6144;
        const int r0 = rt + wr * 64 + fr, c0 = u.pn * 256 + wc * 32 + 8 * fq;
        f32x4 gv[2][2];
#pragma unroll
        for (int bj = 0; bj < 2; ++bj) { gv[bj][0] = *(const f32x4*)(g + c0 + bj * 128) * sc; gv[bj][1] = *(const f32x4*)(g + c0 + bj * 128 + 4) * sc; }
        __builtin_amdgcn_s_waitcnt(0x0F70);
#pragma unroll
        EPI_ROWS { bf16* rp = D + (size_t)(r0 + ai * 128 + m * 16) * DM + c0;
#pragma unroll
            for (int bj = 0; bj < 2; ++bj) { const f32x4 a = gv[bj][0] * acc[ai][bj][m][0], b = gv[bj][1] * acc[ai][bj][m][1]; u32x4 w; w.x = pk2(a.x, a.y); w.y = pk2(a.z, a.w); w.z = pk2(b.x, b.y); w.w = pk2(b.z, b.w); *(u32x4*)(rp + bj * 128) = w; }
            asm volatile("" ::: "memory"); }
    }
};

__device__ __forceinline__ int seq_row(int b, int dir, int pos) {
    if (pos < CTXL) return NLAT + b * CTXL + (dir ? CTXL - 1 - pos : pos);
    const int t = pos - CTXL; return b * SEQ + (dir ? SEQ - 1 - t : t);
}
__device__ __forceinline__ void phase_gla(const Ctx& c, KParams p, int l) {
    const bf16* Z = (const bf16*)(c.ws + WS_Z); const bf16* GVT = (const bf16*)(c.ws + WS_GVT); bf16* OG = (bf16*)(c.ws + WS_T1);
    const int w = c.wave, tid = c.tid;
    LAS float* wtab = (LAS float*)c.lds;
    LAS float* DD = (LAS float*)(c.lds + 4096);
    LAS unsigned char* RW = c.lds + 8192 + w * 13824;
    LAS float* LA = (LAS float*)RW;
    LAS unsigned char* KTT = RW + 9216;
    for (int u = c.blk; u < 256; u += c.G) {
        const int b = u >> 3, h = (u >> 1) & 3, dir = u & 1;
        __syncthreads();
        { const float* wa = p->in[I_GLAW] + ((size_t)(l * 2 + dir) * 16) * 128 + h * 32; wtab[tid] = wa[(tid >> 5) * 128 + (tid & 31)]; if (tid < 32) wtab[512 + tid] = p->in[I_GLAB][(l * 2 + dir) * 128 + h * 32 + tid]; }
        float Sst[4] = {0.f, 0.f, 0.f, 0.f};
        __syncthreads();
        for (int gi = 0; gi < 5; ++gi) {
            const int pc = gi * 8 + w; const bool active = pc < 36;
            int lane_ = c.lane; asm volatile("" : "+v"(lane_));
            const int r = lane_ & 31, hh = lane_ >> 5;
            const int p16 = 8 * ((r >> 2) & 1) + 4 * ((r & 15) >> 3) + (r & 3);
            const int pos0 = (r & 16) + p16, pos1 = 32 + pos0;
            bf16x8 qd[2][2]; f32x16 oacc[2][2]; int row0 = 0;
            if (active) {
                int kk0;
                if (dir == 0) { if (pc < 4) { row0 = NLAT + b * CTXL + pc * 64; kk0 = pc * 64; } else { row0 = b * SEQ + (pc - 4) * 64; kk0 = 256 + (pc - 4) * 64; } }
                else { if (pc < 4) { row0 = NLAT + b * CTXL + (3 - pc) * 64; kk0 = (3 - pc) * 64; } else { row0 = b * SEQ + (35 - pc) * 64; kk0 = 256 + (35 - pc) * 64; } }
#pragma unroll
                for (int ib = 0; ib < 2; ++ib) { const bf16* zr = Z + (size_t)(row0 + 32 * ib + r) * ZW; float al[16]; { const u32x4 a0 = *(const u32x4*)(zr + ZAF + dir * 16), a1 = *(const u32x4*)(zr + ZAF + dir * 16 + 8); float t8[8]; unpack8(a0, t8);
#pragma unroll
                        for (int j = 0; j < 8; ++j) al[j] = t8[j];
                        unpack8(a1, t8);
#pragma unroll
                        for (int j = 0; j < 8; ++j) al[8 + j] = t8[j]; }
#pragma unroll
                    for (int ks = 0; ks < 2; ++ks) { float za[8]; { const f32x4 b0 = *(const LAS f32x4*)(wtab + 512 + 16 * ks + 8 * hh), b1 = *(const LAS f32x4*)(wtab + 512 + 16 * ks + 8 * hh + 4);
                            za[0] = b0.x; za[1] = b0.y; za[2] = b0.z; za[3] = b0.w; za[4] = b1.x; za[5] = b1.y; za[6] = b1.z; za[7] = b1.w; }
#pragma unroll
                        for (int j = 0; j < 16; ++j) { const f32x4 w0 = *(const LAS f32x4*)(wtab + j * 32 + 16 * ks + 8 * hh), w1 = *(const LAS f32x4*)(wtab + j * 32 + 16 * ks + 8 * hh + 4);
                            za[0] = fmaf(al[j], w0.x, za[0]); za[1] = fmaf(al[j], w0.y, za[1]); za[2] = fmaf(al[j], w0.z, za[2]); za[3] = fmaf(al[j], w0.w, za[3]);
                            za[4] = fmaf(al[j], w1.x, za[4]); za[5] = fmaf(al[j], w1.y, za[5]); za[6] = fmaf(al[j], w1.z, za[6]); za[7] = fmaf(al[j], w1.w, za[7]); }
                        float la[8];
#pragma unroll
                        for (int e = 0; e < 8; ++e) la[e] = (fminf(za[e], 0.f) - __logf(1.f + __expf(-fabsf(za[e])))) * 0.0625f;
                        *(LAS f32x4*)(LA + (32 * ib + r) * 36 + 16 * ks + 8 * hh) = (f32x4){la[0], la[1], la[2], la[3]}; *(LAS f32x4*)(LA + (32 * ib + r) * 36 + 16 * ks + 8 * hh + 4) = (f32x4){la[4], la[5], la[6], la[7]}; } }
                lds_wait();
                u32x4 qraw[2][2], kraw[2][2];
#pragma unroll
                for (int ib = 0; ib < 2; ++ib) { const bf16* zr = Z + (size_t)(row0 + 32 * ib + r) * ZW;
#pragma unroll
                    for (int ks = 0; ks < 2; ++ks) { qraw[ib][ks] = *(const u32x4*)(zr + ZQ + h * 32 + 16 * ks + 8 * hh); kraw[ib][ks] = *(const u32x4*)(zr + ZK + h * 32 + 16 * ks + 8 * hh); } }
                { float bend; float v[32], s = 0.f;
#pragma unroll
                  for (int qq = 0; qq < 32; ++qq) { const int q = 32 * hh + qq, i = dir ? 63 - q : q; v[qq] = LA[i * 36 + r]; s += v[qq]; }
                  const auto sw = __builtin_amdgcn_permlane32_swap(__float_as_uint(s), __float_as_uint(s), false, false);
                  const float h0 = __uint_as_float(sw[0]), h1 = __uint_as_float(sw[1]); bend = h0 + h1;
                  float run = hh ? h0 : 0.f;
#pragma unroll
                  for (int qq = 0; qq < 32; ++qq) { const int q = 32 * hh + qq, i = dir ? 63 - q : q; run += v[qq]; LA[i * 36 + r] = run; }
                  if (hh == 0) DD[w * 32 + r] = __expf(bend); }
                lds_wait();
                bf16x8 vt[2][4];
#pragma unroll
                for (int db = 0; db < 2; ++db)
#pragma unroll
                    for (int s4 = 0; s4 < 4; ++s4) vt[db][s4] = *(const bf16x8*)(GVT + ((size_t)(b * 4 + h) * 64 + 32 * db + r) * 2304 + kk0 + 16 * s4 + 8 * hh);
                bf16x8 ki[2][2];
#pragma unroll
                for (int ib = 0; ib < 2; ++ib) {
#pragma unroll
                    for (int ks = 0; ks < 2; ++ks) { const int dk0 = 16 * ks + 8 * hh; float q8[8], k8[8], b8[8]; unpack8(qraw[ib][ks], q8); unpack8(kraw[ib][ks], k8);
                        { const f32x4 x0 = *(const LAS f32x4*)(LA + (32 * ib + r) * 36 + dk0), x1 = *(const LAS f32x4*)(LA + (32 * ib + r) * 36 + dk0 + 4); b8[0] = x0.x; b8[1] = x0.y; b8[2] = x0.z; b8[3] = x0.w; b8[4] = x1.x; b8[5] = x1.y; b8[6] = x1.z; b8[7] = x1.w; }
                        float qo[8], ko[8];
#pragma unroll
                        for (int e = 0; e < 8; ++e) { const float eb = __expf(b8[e]), ieb = 1.f / eb; qo[e] = q8[e] * 0.17677669529663687f * eb; ko[e] = k8[e] * ieb;
                            *(LAS bf16*)(KTT + ((dk0 + e) * 72 + (ib ? pos1 : pos0)) * 2) = f2bf(ko[e] * DD[w * 32 + dk0 + e]); }
                        u32x4 wq, wk; wq.x = pk2(qo[0], qo[1]); wq.y = pk2(qo[2], qo[3]); wq.z = pk2(qo[4], qo[5]); wq.w = pk2(qo[6], qo[7]); wk.x = pk2(ko[0], ko[1]); wk.y = pk2(ko[2], ko[3]); wk.z = pk2(ko[4], ko[5]); wk.w = pk2(ko[6], ko[7]);
                        qd[ib][ks] = __builtin_bit_cast(bf16x8, wq); ki[ib][ks] = __builtin_bit_cast(bf16x8, wk); } }
                f32x16 zero16;
#pragma unroll
                for (int i = 0; i < 16; ++i) zero16[i] = 0.f;
                f32x16 a00 = __builtin_amdgcn_mfma_f32_32x32x16_bf16(ki[0][0], qd[0][0], zero16, 0, 0, 0); a00 = __builtin_amdgcn_mfma_f32_32x32x16_bf16(ki[0][1], qd[0][1], a00, 0, 0, 0);
                f32x16 a11 = __builtin_amdgcn_mfma_f32_32x32x16_bf16(ki[1][0], qd[1][0], zero16, 0, 0, 0); a11 = __builtin_amdgcn_mfma_f32_32x32x16_bf16(ki[1][1], qd[1][1], a11, 0, 0, 0);
                f32x16 aof;
                if (dir == 0) { aof = __builtin_amdgcn_mfma_f32_32x32x16_bf16(ki[0][0], qd[1][0], zero16, 0, 0, 0); aof = __builtin_amdgcn_mfma_f32_32x32x16_bf16(ki[0][1], qd[1][1], aof, 0, 0, 0); }
                else { aof = __builtin_amdgcn_mfma_f32_32x32x16_bf16(ki[1][0], qd[0][0], zero16, 0, 0, 0); aof = __builtin_amdgcn_mfma_f32_32x32x16_bf16(ki[1][1], qd[0][1], aof, 0, 0, 0); }
#pragma unroll
                for (int i = 0; i < 16; ++i) { const int j = (i & 3) + 8 * (i >> 2) + 4 * hh; const bool keep = dir ? (j >= r) : (j <= r); a00[i] = keep ? a00[i] : 0.f; a11[i] = keep ? a11[i] : 0.f; }
#define GLA_P(X, s) ({ u32x4 w_; w_.x = pk2((X)[8 * (s)], (X)[8 * (s) + 1]); w_.y = pk2((X)[8 * (s) + 2], (X)[8 * (s) + 3]); w_.z = pk2((X)[8 * (s) + 4], (X)[8 * (s) + 5]); w_.w = pk2((X)[8 * (s) + 6], (X)[8 * (s) + 7]); __builtin_bit_cast(bf16x8, w_); })
                const bf16x8 p00a = GLA_P(a00, 0), p00b = GLA_P(a00, 1), p11a = GLA_P(a11, 0), p11b = GLA_P(a11, 1), pofa = GLA_P(aof, 0), pofb = GLA_P(aof, 1);
#pragma unroll
                for (int db = 0; db < 2; ++db) {
                    f32x16 o0 = __builtin_amdgcn_mfma_f32_32x32x16_bf16(vt[db][0], p00a, zero16, 0, 0, 0); o0 = __builtin_amdgcn_mfma_f32_32x32x16_bf16(vt[db][1], p00b, o0, 0, 0, 0);
                    f32x16 o1 = __builtin_amdgcn_mfma_f32_32x32x16_bf16(vt[db][2], p11a, zero16, 0, 0, 0); o1 = __builtin_amdgcn_mfma_f32_32x32x16_bf16(vt[db][3], p11b, o1, 0, 0, 0);
                    if (dir == 0) { o1 = __builtin_amdgcn_mfma_f32_32x32x16_bf16(vt[db][0], pofa, o1, 0, 0, 0); o1 = __builtin_amdgcn_mfma_f32_32x32x16_bf16(vt[db][1], pofb, o1, 0, 0, 0); }
                    else { o0 = __builtin_amdgcn_mfma_f32_32x32x16_bf16(vt[db][2], pofa, o0, 0, 0, 0); o0 = __builtin_amdgcn_mfma_f32_32x32x16_bf16(vt[db][3], pofb, o0, 0, 0, 0); }
                    oacc[db][0] = o0; oacc[db][1] = o1; }
#undef GLA_P
                lds_wait();
                bf16x8 kf[4];
#pragma unroll
                for (int s4 = 0; s4 < 4; ++s4) kf[s4] = *(const LAS bf16x8*)(KTT + (r * 72 + 16 * s4 + 8 * hh) * 2);
#pragma unroll
                for (int db = 0; db < 2; ++db) { f32x16 uu = __builtin_amdgcn_mfma_f32_32x32x16_bf16(vt[db][0], kf[0], zero16, 0, 0, 0);
#pragma unroll
                    for (int s4 = 1; s4 < 4; ++s4) uu = __builtin_amdgcn_mfma_f32_32x32x16_bf16(vt[db][s4], kf[s4], uu, 0, 0, 0);
#pragma unroll
                    for (int i = 0; i < 16; ++i) LA[(32 * db + (i & 3) + 8 * (i >> 2) + 4 * hh) * 32 + r] = uu[i]; }
            }
            __syncthreads();
            const int dv2 = tid >> 3, dk4 = (tid & 7) * 4;
            f32x4 ur[8], dr[8];
#pragma unroll
            for (int cc = 0; cc < 8; ++cc) { ur[cc] = *(const LAS f32x4*)((LAS float*)(c.lds + 8192 + cc * 13824) + dv2 * 32 + dk4); dr[cc] = *(const LAS f32x4*)(DD + cc * 32 + dk4); }
            __syncthreads();
#pragma unroll
            for (int cc = 0; cc < 8; ++cc) if (gi * 8 + cc < 36) { u32x2 sp; sp.x = pk2(Sst[0], Sst[1]); sp.y = pk2(Sst[2], Sst[3]); *(LAS u32x2*)(c.lds + 8192 + cc * 13824 + (dv2 * 40 + dk4) * 2) = sp;
                Sst[0] = fmaf(dr[cc].x, Sst[0], ur[cc].x); Sst[1] = fmaf(dr[cc].y, Sst[1], ur[cc].y); Sst[2] = fmaf(dr[cc].z, Sst[2], ur[cc].z); Sst[3] = fmaf(dr[cc].w, Sst[3], ur[cc].w); }
            __syncthreads();
            if (active) {
#pragma unroll
                for (int db = 0; db < 2; ++db) { const bf16x8 s0 = *(const LAS bf16x8*)(RW + ((32 * db + r) * 40 + 8 * hh) * 2), s1 = *(const LAS bf16x8*)(RW + ((32 * db + r) * 40 + 16 + 8 * hh) * 2);
#pragma unroll
                    for (int ib = 0; ib < 2; ++ib) { oacc[db][ib] = __builtin_amdgcn_mfma_f32_32x32x16_bf16(s0, qd[ib][0], oacc[db][ib], 0, 0, 0); oacc[db][ib] = __builtin_amdgcn_mfma_f32_32x32x16_bf16(s1, qd[ib][1], oacc[db][ib], 0, 0, 0); } }
#pragma unroll
                for (int ib = 0; ib < 2; ++ib) { bf16* orow = OG + ((size_t)dir * NTOK + row0 + 32 * ib + r) * 256 + h * 64 + 4 * hh;
#pragma unroll
                    for (int db = 0; db < 2; ++db)
#pragma unroll
                        for (int g4 = 0; g4 < 4; ++g4) { u32x2 wv; wv.x = pk2(oacc[db][ib][4 * g4], oacc[db][ib][4 * g4 + 1]); wv.y = pk2(oacc[db][ib][4 * g4 + 2], oacc[db][ib][4 * g4 + 3]); *(u32x2*)(orow + 32 * db + 8 * g4) = wv; } }
                lds_wait();
            }
        }
    }
    __syncthreads();
}
__device__ __forceinline__ void phase_gla_final(const Ctx& c, KParams p, int l, int nrows) {
    const bf16* Z = (const bf16*)(c.ws + WS_Z); const bf16* OG = (const bf16*)(c.ws + WS_T1); unsigned char* MIX = c.ws + WS_MIX;
    const int gw = c.blk * NWAVES + c.wave, NGW = c.G * NWAVES; const f32x4 g = *(const f32x4*)(p->in[I_GLAG] + l * 256 + 4 * c.lane);
    for (int r0 = gw; r0 < nrows; r0 += 4 * NGW) {
        u32x2 of[4], ob[4], rg[4];
#pragma unroll
        for (int k = 0; k < 4; ++k) { const int r = r0 + k * NGW; of[k] = ob[k] = rg[k] = (u32x2){0u, 0u};
            if (r < nrows) { of[k] = *(const u32x2*)(OG + (size_t)r * 256 + 4 * c.lane); ob[k] = *(const u32x2*)(OG + ((size_t)NTOK + r) * 256 + 4 * c.lane); rg[k] = *(const u32x2*)(Z + (size_t)r * ZW + ZR + 4 * c.lane); } }
#pragma unroll
        for (int k = 0; k < 4; ++k) { const int r = r0 + k * NGW;
            f32x4 o = (f32x4){__uint_as_float(of[k].x << 16) + __uint_as_float(ob[k].x << 16), __uint_as_float(of[k].x & 0xffff0000u) + __uint_as_float(ob[k].x & 0xffff0000u),
                              __uint_as_float(of[k].y << 16) + __uint_as_float(ob[k].y << 16), __uint_as_float(of[k].y & 0xffff0000u) + __uint_as_float(ob[k].y & 0xffff0000u)};
            float ss = (o.x * o.x + o.y * o.y) + (o.z * o.z + o.w * o.w);
            ss += shx<1>(ss); ss += shx<2>(ss); ss += shx<4>(ss); ss += shx<8>(ss);
            const float rstd = rsqrtf(ss * (1.f / 64.f) + EPS);
            const float g0 = __uint_as_float(rg[k].x << 16), g1 = __uint_as_float(rg[k].x & 0xffff0000u), g2 = __uint_as_float(rg[k].y << 16), g3 = __uint_as_float(rg[k].y & 0xffff0000u);
            const float r16 = rstd * 16.f; const unsigned w = pk4_fp8(o.x * r16 * g.x * siluf_(g0), o.y * r16 * g.y * siluf_(g1), o.z * r16 * g.z * siluf_(g2), o.w * r16 * g.w * siluf_(g3));
            if (r < nrows) *(unsigned*)(MIX + (size_t)r * DM + 4 * c.lane) = w; }
    }
}

__device__ __forceinline__ void phase_conv1(const Ctx& c, KParams p, int l, bool with_ctx) {
    const bf16* Z = (const bf16*)(c.ws + WS_Z); bf16* CV = (bf16*)(c.ws + WS_CV);
    constexpr int TT = 64, HR = TT + 30;
    LAS float* glu = (LAS float*)c.lds;
    f32x4 wj[31];
#pragma unroll
    for (int j = 0; j < 31; ++j) wj[j] = *(const f32x4*)(p->in[I_CDW] + ((size_t)l * 31 + j) * 256 + 4 * c.lane);
    const int ntiles = with_ctx ? 1024 + 128 : 1024;
    const f32x4 dwb = *(const f32x4*)(p->in[I_CDB] + l * 256 + 4 * c.lane), lg = *(const f32x4*)(p->in[I_CLG] + l * 256 + 4 * c.lane), lb = *(const f32x4*)(p->in[I_CLB] + l * 256 + 4 * c.lane);
    for (int tile = c.blk; tile < ntiles; tile += c.G) {
        int rowbase, t0, slen;
        if (tile < 1024) { const int b = tile >> 5; rowbase = b * SEQ; t0 = (tile & 31) * TT; slen = SEQ; } else { const int q = tile - 1024, b = q >> 2; rowbase = NLAT + b * CTXL; t0 = (q & 3) * TT; slen = CTXL; }
        __syncthreads();
        u32x2 ra[12], rg[12];
#pragma unroll
        for (int k = 0; k < 12; ++k) { const int idx = c.tid + k * NTHR, j = idx >> 6, c4 = (idx & 63) * 4, t = t0 - 15 + j; ra[k] = (u32x2){0u, 0u}; rg[k] = (u32x2){0u, 0u};
            if (idx < HR * 64 && t >= 0 && t < slen) { const bf16* zr = Z + (size_t)(rowbase + t) * ZW; ra[k] = *(const u32x2*)(zr + ZCA + c4); rg[k] = *(const u32x2*)(zr + ZCG + c4); } }
#pragma unroll
        for (int k = 0; k < 12; ++k) { const int idx = c.tid + k * NTHR, j = idx >> 6, c4 = (idx & 63) * 4; f32x4 v;
            v.x = __uint_as_float(ra[k].x << 16) * sigmoidf_(__uint_as_float(rg[k].x << 16)); v.y = __uint_as_float(ra[k].x & 0xffff0000u) * sigmoidf_(__uint_as_float(rg[k].x & 0xffff0000u));
            v.z = __uint_as_float(ra[k].y << 16) * sigmoidf_(__uint_as_float(rg[k].y << 16)); v.w = __uint_as_float(ra[k].y & 0xffff0000u) * sigmoidf_(__uint_as_float(rg[k].y & 0xffff0000u));
            if (idx < HR * 64) *(LAS f32x4*)(glu + j * 256 + c4) = v; }
        __syncthreads();
        f32x4 acc8[8];
#pragma unroll
        for (int q = 0; q < 8; ++q) acc8[q] = dwb;
#pragma unroll
        for (int r = 0; r < 38; ++r) { const f32x4 x = *(const LAS f32x4*)(glu + (c.wave * 8 + r) * 256 + 4 * c.lane);
#pragma unroll
            for (int q = 0; q < 8; ++q) if (r - q >= 0 && r - q < 31) acc8[q] += x * wj[r - q]; }
#pragma unroll
        for (int q = 0; q < 8; ++q) { const int i = c.wave * 8 + q; const f32x4 a = acc8[q];
            const float mu = wave_sum((a.x + a.y) + (a.z + a.w)) * (1.f / 256.f); const f32x4 dlt = a - mu;
            const float var = wave_sum((dlt.x * dlt.x + dlt.y * dlt.y) + (dlt.z * dlt.z + dlt.w * dlt.w)) * (1.f / 256.f); const float rstd = rsqrtf(var + EPS);
            const f32x4 y = dlt * rstd * lg + lb;
            u32x2 w; w.x = pk2(siluf_(y.x), siluf_(y.y)); w.y = pk2(siluf_(y.z), siluf_(y.w));
            *(u32x2*)(CV + (size_t)(rowbase + t0 + i) * 256 + 4 * c.lane) = w; }
    }
    __syncthreads();
}

__device__ __forceinline__ void phase_s5_carry(const Ctx& c, int l) {
    const bf16* XE = (const bf16*)(c.ws + WS_Y5); bf16* UP = (bf16*)(c.ws + WS_UP); const float* S5P = (const float*)(c.ws + WS_S5P);
    for (int i = c.blk * NTHR + c.tid; i < NB * 2 * 16 * 64; i += c.G * NTHR) {
        const int pp = i & 63, g = (i >> 6) & 15, dir = (i >> 10) & 1, b = i >> 11;
        const float* PW = S5P + ((size_t)((l * 2 + dir) * 16 + g) * 64 + pp) * 34 + 32; const float ar = PW[0], ai = PW[1];
        const size_t rbase = (size_t)g * 4608 + (size_t)b * 144; float xr = 0.f, xi = 0.f;
        float er[16], ei[16], fr_[16], fi_[16];
        auto chunk_of = [&](int s) { return dir == 0 ? s : (s < 16 ? 15 - s : 159 - s); };
#pragma unroll
        for (int q = 0; q < 16; ++q) { const bf16* xe = XE + (rbase + chunk_of(q)) * 256 + dir * 128 + pp; er[q] = bf2f(xe[0]); ei[q] = bf2f(xe[64]); }
#pragma unroll 1
        for (int s0 = 0; s0 < 144; s0 += 16) {
            if (s0 + 16 < 144) {
#pragma unroll
                for (int q = 0; q < 16; ++q) { const bf16* xe = XE + (rbase + chunk_of(s0 + 16 + q)) * 256 + dir * 128 + pp; fr_[q] = bf2f(xe[0]); fi_[q] = bf2f(xe[64]); } }
#pragma unroll
            for (int q = 0; q < 16; ++q) { bf16* up = UP + (rbase + chunk_of(s0 + q)) * 512 + 256 + dir * 128 + pp; up[0] = f2bf(xr); up[64] = f2bf(xi);
                const float nr = ar * xr - ai * xi + er[q], ni = ar * xi + ai * xr + ei[q]; xr = nr; xi = ni; }
            if (s0 + 16 < 144) {
#pragma unroll
                for (int q = 0; q < 16; ++q) { er[q] = fr_[q]; ei[q] = fi_[q]; } }
        }
    }
}

__device__ __forceinline__ void phase_mla_prep(const Ctx& c, KParams p) {
    const bf16* Z = (const bf16*)(c.ws + WS_Z); float* RS = (float*)(c.ws + WS_RS); bf16* Kb = (bf16*)(c.ws + WS_H) + (size_t)NTOK * 384; const float* ROPE = (const float*)(c.ws + WS_TAB + TAB_ROPE);
    const int gw = c.blk * NWAVES + c.wave, NGW = c.G * NWAVES, lane = c.lane, d = lane & 31;
    for (int r0 = gw; r0 < NTOK; r0 += 4 * NGW) {
        u32x2 q4[4]; unsigned k2[4]; bf16 xr[4]; f32x2 cs[4];
#pragma unroll
        for (int k = 0; k < 4; ++k) { const int r = r0 + k * NGW; q4[k] = (u32x2){0u, 0u}; k2[k] = 0u; xr[k] = 0; cs[k] = (f32x2){1.f, 0.f};
            if (r < NTOK) { const bf16* zr = Z + (size_t)r * ZW; q4[k] = *(const u32x2*)(zr + ZCQ + 4 * lane); k2[k] = *(const unsigned*)(zr + ZCKV + 2 * lane); xr[k] = zr[ZKR + d];
                if (r < NLAT) cs[k] = *(const f32x2*)(ROPE + (((r & 2047) * 2 + (d >> 4)) * 8 + (d & 7)) * 2); } }
#pragma unroll
        for (int k = 0; k < 4; ++k) { const int r = r0 + k * NGW;
            const float a0 = __uint_as_float(q4[k].x << 16), a1 = __uint_as_float(q4[k].x & 0xffff0000u), a2 = __uint_as_float(q4[k].y << 16), a3 = __uint_as_float(q4[k].y & 0xffff0000u);
            const float b0 = __uint_as_float(k2[k] << 16), b1 = __uint_as_float(k2[k] & 0xffff0000u);
            const float sq = wave_sum((a0 * a0 + a1 * a1) + (a2 * a2 + a3 * a3)), sk = wave_sum(b0 * b0 + b1 * b1);
            const float x = bf2f(xr[k]); const float px = shx<8>(x);
            const float o = (d & 8) ? fmaf(x, cs[k].x, px * cs[k].y) : fmaf(x, cs[k].x, -px * cs[k].y);
            if (r < NTOK) { if (lane == 0) { RS[(size_t)r * 2] = rsqrtf(sq * (1.f / 256.f) + EPS); RS[(size_t)r * 2 + 1] = rsqrtf(sk * (1.f / 128.f) + EPS); }
                const bf16 ob = f2bf(o); bf16* kr = Kb + (size_t)r * 384 + 64 + d; if (lane < 32) { kr[0] = ob; kr[96] = ob; kr[192] = ob; kr[288] = ob; } } }
    }
}
__device__ __forceinline__ void phase_attn(const Ctx& c, bool with_ctx) {
    const bf16* Qb = (const bf16*)(c.ws + WS_H); const bf16* Kb = Qb + (size_t)NTOK * 384; const bf16* VT = Kb + (size_t)NTOK * 384; unsigned char* MIX = c.ws + WS_MIX;
    constexpr int KROW = 208, VROW = 144, KBUF = 64 * KROW, VBUF = 64 * VROW;
    LAS unsigned char* Kt = c.lds; LAS unsigned char* Vt = c.lds + 2 * KBUF;
    const int lane = c.lane, ln = lane & 31, hh = lane >> 5, tid = c.tid;
    const int nunits = with_ctx ? 1152 : 1024;
    for (int L = c.blk; L < nunits; L += c.G) {
        int u = L;
        if (c.G == 256 && L < 1024) { const int r = L >> 8, x = L & 7, j = (L & 255) >> 3; u = ((r * 32 + x * 4 + (j >> 3)) << 3) | (j & 7); }
        int b, h, qrow0, kt0, nkt;
        if (u < 1024) { b = u >> 5; h = (u >> 3) & 3; qrow0 = b * SEQ + (u & 7) * 256; kt0 = 0; nkt = 36; } else { const int q = u - 1024; b = q >> 2; h = q & 3; qrow0 = NLAT + b * CTXL; kt0 = 32; nkt = 4; }
        const bf16* vtb = VT + (size_t)((b * 4 + h) * 64) * 2304;
        bf16x8 qf[6];
        { const bf16* qr = Qb + (size_t)(qrow0 + 32 * c.wave + ln) * 384 + h * 96 + 8 * hh;
#pragma unroll
          for (int ks = 0; ks < 6; ++ks) qf[ks] = *(const bf16x8*)(qr + 16 * ks); }
        if (u < 1024) {
            const float* ROPE = (const float*)(c.ws + WS_TAB + TAB_ROPE) + (size_t)((qrow0 + 32 * c.wave + ln) & 2047) * 32;
#pragma unroll
            for (int ax = 0; ax < 2; ++ax) { const u32x4 own = __builtin_bit_cast(u32x4, qf[4 + ax]); u32x4 oth, res;
#pragma unroll
                for (int i = 0; i < 4; ++i) { const auto sw = __builtin_amdgcn_permlane32_swap(own[i], own[i], false, false); oth[i] = hh ? sw[0] : sw[1]; }
#pragma unroll
                for (int i = 0; i < 4; ++i) { const f32x4 cs = *(const f32x4*)(ROPE + ax * 16 + 4 * i);
                    const float v0 = __uint_as_float(own[i] << 16), v1 = __uint_as_float(own[i] & 0xffff0000u), p0 = __uint_as_float(oth[i] << 16), p1 = __uint_as_float(oth[i] & 0xffff0000u);
                    const float sg = hh ? 1.f : -1.f; res[i] = pk2(fmaf(v0, cs.x, sg * p0 * cs.y), fmaf(v1, cs.z, sg * p1 * cs.w)); }
                qf[4 + ax] = __builtin_bit_cast(bf16x8, res); } }
        f32x16 oacc[2];
#pragma unroll
        for (int i = 0; i < 16; ++i) { oacc[0][i] = 0.f; oacc[1][i] = 0.f; }
        float mrun = 0.f, lsum = 0.f;
        const int k0key = tid / 12, k0pt = tid % 12, k1key = (512 + tid) / 12, k1pt = (512 + tid) % 12; const bool k1on = tid < 256;
        u32x4 sk0, sk1 = (u32x4){0u, 0u, 0u, 0u}, sv;
        auto key_row = [&](int kt, int j) -> int { const int kk = kt * 64 + j; return kk < 2048 ? b * SEQ + kk : NLAT + b * CTXL + (kk - 2048); };
#define ATT_LOAD(kt) do { sk0 = *(const u32x4*)(Kb + (size_t)key_row((kt), k0key) * 384 + h * 96 + k0pt * 8); if (k1on) sk1 = *(const u32x4*)(Kb + (size_t)key_row((kt), k1key) * 384 + h * 96 + k1pt * 8); \
        sv = *(const u32x4*)(vtb + (size_t)(tid >> 3) * 2304 + (kt) * 64 + (tid & 7) * 8); } while (0)
#define ATT_STORE(buf) do { *(LAS u32x4*)(Kt + (buf) * KBUF + k0key * KROW + k0pt * 16) = sk0; if (k1on) *(LAS u32x4*)(Kt + (buf) * KBUF + k1key * KROW + k1pt * 16) = sk1; \
        *(LAS u32x4*)(Vt + (buf) * VBUF + (tid >> 3) * VROW + (tid & 7) * 16) = sv; } while (0)
        __syncthreads();
        ATT_LOAD(kt0); ATT_STORE(0);
        __syncthreads();
        for (int it = 0; it < nkt; ++it) {
            const int cur = it & 1;
            if (it + 1 < nkt) ATT_LOAD(kt0 + it + 1);
            f32x16 sacc[2];
            const float nm = -mrun;
#pragma unroll
            for (int kb = 0; kb < 2; ++kb) {
#pragma unroll
                for (int i = 0; i < 16; ++i) sacc[kb][i] = nm;
#pragma unroll
                for (int ks = 0; ks < 6; ++ks) { const bf16x8 a = *(const LAS bf16x8*)(Kt + cur * KBUF + (32 * kb + ln) * KROW + ks * 32 + hh * 16);
                    sacc[kb] = __builtin_amdgcn_mfma_f32_32x32x16_bf16(a, qf[ks], sacc[kb], 0, 0, 0); } }
            float mx = fmaxf(fmaxf(sacc[0][0], sacc[0][1]), sacc[0][2]);
#pragma unroll
            for (int i = 3; i < 15; i += 2) mx = fmaxf(fmaxf(mx, sacc[0][i]), sacc[0][i + 1]);
            mx = fmaxf(mx, sacc[0][15]);
#pragma unroll
            for (int i = 0; i < 16; i += 2) mx = fmaxf(fmaxf(mx, sacc[1][i]), sacc[1][i + 1]);
            { const auto r = __builtin_amdgcn_permlane32_swap(__float_as_uint(mx), __float_as_uint(mx), false, false); mx = fmaxf(__uint_as_float(r[0]), __uint_as_float(r[1])); }
            if (it == 0 || __builtin_amdgcn_ballot_w64(mx > 8.0f) != 0ull) {
                const float up = it == 0 ? mx : fmaxf(mx, 0.f), alpha = __builtin_amdgcn_exp2f(-up); mrun += up; lsum *= alpha;
#pragma unroll
                for (int i = 0; i < 16; ++i) { oacc[0][i] *= alpha; oacc[1][i] *= alpha; sacc[0][i] -= up; sacc[1][i] -= up; }
            }
            float ps = 0.f;
#pragma unroll
            for (int kb = 0; kb < 2; ++kb)
#pragma unroll
                for (int i = 0; i < 16; ++i) { const float pv = __builtin_amdgcn_exp2f(sacc[kb][i]); sacc[kb][i] = pv; ps += pv; }
            lsum += ps;
            bf16x8 pb[4];
#pragma unroll
            for (int s4 = 0; s4 < 4; ++s4) { const int kb = s4 >> 1, o8 = 8 * (s4 & 1); u32x4 w;
                w.x = pk2(sacc[kb][o8 + 0], sacc[kb][o8 + 1]); w.y = pk2(sacc[kb][o8 + 2], sacc[kb][o8 + 3]); w.z = pk2(sacc[kb][o8 + 4], sacc[kb][o8 + 5]); w.w = pk2(sacc[kb][o8 + 6], sacc[kb][o8 + 7]);
                pb[s4] = __builtin_bit_cast(bf16x8, w); }
#pragma unroll
            for (int db = 0; db < 2; ++db)
#pragma unroll
                for (int s4 = 0; s4 < 4; ++s4) { const bf16x8 a = *(const LAS bf16x8*)(Vt + cur * VBUF + (32 * db + ln) * VROW + s4 * 32 + hh * 16);
                    oacc[db] = __builtin_amdgcn_mfma_f32_32x32x16_bf16(a, pb[s4], oacc[db], 0, 0, 0); }
            if (it + 1 < nkt) ATT_STORE(cur ^ 1);
            __syncthreads();
        }
#undef ATT_LOAD
#undef ATT_STORE
        { const auto r = __builtin_amdgcn_permlane32_swap(__float_as_uint(lsum), __float_as_uint(lsum), false, false); lsum = __uint_as_float(r[0]) + __uint_as_float(r[1]); }
        const float inv = 16.f / lsum;
        unsigned char* dst = MIX + (size_t)(qrow0 + 32 * c.wave + ln) * DM + 768 + h * 64 + 4 * hh;
#pragma unroll
        for (int db = 0; db < 2; ++db)
#pragma unroll
            for (int g4 = 0; g4 < 4; ++g4) *(unsigned*)(dst + 32 * db + 8 * g4) = pk4_fp8(oacc[db][4 * g4] * inv, oacc[db][4 * g4 + 1] * inv, oacc[db][4 * g4 + 2] * inv, oacc[db][4 * g4 + 3] * inv);
    }
    __syncthreads();
}

__device__ __forceinline__ void phase_norm2_route(const Ctx& c, KParams p, int l, int ntok) {
    const float* MOD = (const float*)(c.ws + WS_MOD) + (size_t)l * 33 * 6144;
    const float* xl = l == 0 ? p->in[I_X] : p->out; const float* xc = l == 0 ? p->in[I_CTX] : (const float*)(c.ws + WS_XC);
    bf16* H = (bf16*)(c.ws + WS_H);
    int* TKEP = (int*)(c.ws + WS_RT + RT_TKEP); float* TKW = (float*)(c.ws + WS_RT + RT_TKW); int* TB = (int*)(c.ws + WS_TB);
    int* CNT = (int*)(c.ws + WS_CTL) + CW_CNT + l * NCH * NE;
    constexpr int HROW = 1032;
    LAS bf16* hhi = (LAS bf16*)c.lds;
    LAS bf16* hlo = hhi + 32 * HROW;
    LAS float* lgs = (LAS float*)(c.lds + 132096);
    LAS int* hist = (LAS int*)(c.lds + 140288);
    const bf16* Whi = (const bf16*)(c.ws + WS_TAB + TAB_RWT) + (size_t)(l * 2) * 65536; const bf16* Wlo = Whi + 65536;
    const float rbias = p->in[I_RB][l * 64 + c.lane];
    const int ntiles = ntok / 32, rpc = ntok / NCH, lane = c.lane, mb = c.wave >> 2, nb = c.wave & 3;
    for (int tile = c.blk; tile < ntiles; tile += c.G) {
        __syncthreads();
        if (c.tid < 64) hist[c.tid] = 0;
        for (int q = 0; q < 4; ++q) { const int r = tile * 32 + c.wave * 4 + q; const float* xr = r < NLAT ? xl + (size_t)r * DM : xc + (size_t)(r - NLAT) * DM; const float* m = MOD + (size_t)mod_row(r) * 6144;
            float* xo = r < NLAT ? p->out + (size_t)r * DM : (float*)(c.ws + WS_XC) + (size_t)(r - NLAT) * DM;
            f32x4 v[4]; norm_row_add(xr, (const bf16*)(c.ws + WS_Z) + (size_t)r * DM, xo, p->in[I_N2G] + l * DM, m + 3072, m + 4096, c.ws + WS_H8 + (size_t)r * DM, lane, v);
#pragma unroll
            for (int j = 0; j < 4; ++j) { u32x2 hi; hi.x = pk2(v[j].x, v[j].y); hi.y = pk2(v[j].z, v[j].w);
                const float r0 = v[j].x - __uint_as_float(hi.x << 16), r1 = v[j].y - __uint_as_float(hi.x & 0xffff0000u), r2 = v[j].z - __uint_as_float(hi.y << 16), r3 = v[j].w - __uint_as_float(hi.y & 0xffff0000u);
                u32x2 lo; lo.x = pk2(r0, r1); lo.y = pk2(r2, r3);
                *(LAS u32x2*)(hhi + (c.wave * 4 + q) * HROW + 4 * lane + 256 * j) = hi; *(LAS u32x2*)(hlo + (c.wave * 4 + q) * HROW + 4 * lane + 256 * j) = lo; } }
        __syncthreads();
        { f32x4 acc = (f32x4){0.f, 0.f, 0.f, 0.f};
          const LAS bf16* ah = hhi + (mb * 16 + (lane & 15)) * HROW + 8 * (lane >> 4); const LAS bf16* al = hlo + (mb * 16 + (lane & 15)) * HROW + 8 * (lane >> 4);
          const bf16* bh = Whi + (size_t)(nb * 16 + (lane & 15)) * 1024 + 8 * (lane >> 4); const bf16* bl = Wlo + (size_t)(nb * 16 + (lane & 15)) * 1024 + 8 * (lane >> 4);
#pragma unroll 8
          for (int ks = 0; ks < 32; ++ks) { const bf16x8 a_h = *(const LAS bf16x8*)(ah + 32 * ks), a_l = *(const LAS bf16x8*)(al + 32 * ks), b_h = *(const bf16x8*)(bh + 32 * ks), b_l = *(const bf16x8*)(bl + 32 * ks);
              acc = __builtin_amdgcn_mfma_f32_16x16x32_bf16(a_h, b_h, acc, 0, 0, 0); acc = __builtin_amdgcn_mfma_f32_16x16x32_bf16(a_h, b_l, acc, 0, 0, 0); acc = __builtin_amdgcn_mfma_f32_16x16x32_bf16(a_l, b_h, acc, 0, 0, 0); }
#pragma unroll
          for (int i = 0; i < 4; ++i) lgs[(mb * 16 + 4 * (lane >> 4) + i) * 64 + nb * 16 + (lane & 15)] = acc[i]; }
        __syncthreads();
#pragma unroll
        for (int q = 0; q < 4; ++q) {
            const int r = tile * 32 + c.wave * 4 + q;
            const float s = sigmoidf_(lgs[(c.wave * 4 + q) * 64 + lane]), bs = s + rbias;
            float m1 = bs; m1 = fmaxf(m1, shx<1>(m1)); m1 = fmaxf(m1, shx<2>(m1)); m1 = fmaxf(m1, shx<4>(m1));
            const unsigned long long eq = __ballot(bs == m1); const unsigned gm = (unsigned)(eq >> (lane & 56)) & 0xffu; const int first = __ffs(gm) - 1;
            float m2 = ((lane & 7) == first) ? -1e30f : bs; m2 = fmaxf(m2, shx<1>(m2)); m2 = fmaxf(m2, shx<2>(m2)); m2 = fmaxf(m2, shx<4>(m2));
            const float gs = m1 + m2; const int g = lane >> 3; int rank = 0;
#pragma unroll
            for (int j = 0; j < 8; ++j) { const float o = rdl(gs, 8 * j); rank += (o > gs || (o == gs && j < g)) ? 1 : 0; }
            float cand = rank < 4 ? bs : -1e30f; int my_e = 0; float my_w = 0.f, wsum = 0.f;
#pragma unroll
            for (int k = 0; k < 8; ++k) { const float mm = wave_max(cand); const unsigned long long e2 = __ballot(cand == mm); const int idx = __ffsll((long long)e2) - 1; const float wk = rdl(s, idx);
                if (lane == idx) cand = -1e30f; if (lane == k) { my_e = idx; my_w = wk; } wsum += wk; }
            if (lane < 8) { const int lp = atomicAdd((int*)&hist[my_e], 1); TKEP[(size_t)r * 8 + lane] = my_e | (lp << 8); TKW[(size_t)r * 8 + lane] = my_w / wsum * 2.5f; }
        }
        __syncthreads();
        if (c.tid < 64) { const int n = hist[c.tid]; int base = 0; if (n > 0) base = atomicAdd(&CNT[((tile * 32) / rpc) * NE + c.tid], n); TB[tile * 64 + c.tid] = base; }
    }
    __syncthreads();
}
__device__ __forceinline__ void phase_route_fill(const Ctx& c, int l, int ntok) {
    const int* TKEP = (const int*)(c.ws + WS_RT + RT_TKEP); int* SLOT = (int*)(c.ws + WS_RT + RT_SLOT); const int* TB = (const int*)(c.ws + WS_TB);
    const int* CNT = (const int*)(c.ws + WS_CTL) + CW_CNT + l * NCH * NE; int* ROWL = (int*)(c.ws + WS_ROWL);
    LAS int* est = (LAS int*)c.lds;
    const int rpc = ntok / NCH;
    __syncthreads();
    if (c.tid < NCH) { int s = 0; for (int e = 0; e < NE; ++e) { est[c.tid * 65 + e] = s; s += (CNT[c.tid * NE + e] + 255) & ~255; } est[c.tid * 65 + 64] = s; }
    __syncthreads();
    const size_t na = (size_t)ntok * 8;
    for (size_t a = (size_t)c.blk * NTHR + c.tid; a < na; a += (size_t)c.G * NTHR) { const int t = (int)(a >> 3), ch = t / rpc; const int ep = TKEP[a], e = ep & 255, lp = ep >> 8;
        const int slot = est[ch * 65 + e] + TB[(t >> 5) * 64 + e] + lp; SLOT[a] = slot; ROWL[(size_t)ch * RPCMAX + slot] = t; }
    for (int i = c.blk * NTHR + c.tid; i < NCH * NE * 256; i += c.G * NTHR) { const int ch = i >> 14, e = (i >> 8) & 63, j = i & 255; const int n = CNT[ch * NE + e]; const int pad = ((n + 255) & ~255) - n;
        if (j < pad) ROWL[(size_t)ch * RPCMAX + est[ch * 65 + e] + n + j] = ch * rpc; }
    __syncthreads();
}

__device__ __forceinline__ void moe_tile_table(const Ctx& c, int l, int ch, LAS int* tst) {
    const int* CNT = (const int*)(c.ws + WS_CTL) + CW_CNT + l * NCH * NE + ch * NE;
    LAS unsigned char* texp = (LAS unsigned char*)(tst + 80);
    __syncthreads();
    if (c.tid == 0) { int s = 0; for (int e = 0; e < NE; ++e) { tst[e] = s; s += (CNT[e] + 255) >> 8; } tst[64] = s; }
    __syncthreads();
    if (c.tid < NE) { for (int t = tst[c.tid]; t < tst[c.tid + 1]; ++t) texp[t] = (unsigned char)c.tid; }
    __syncthreads();
}
__device__ __forceinline__ void phase_combine(const Ctx& c, KParams p, int l, int ch, int rpc) {
    const float* MOD = (const float*)(c.ws + WS_MOD) + (size_t)l * 33 * 6144 + 5120; const float* MODn = (const float*)(c.ws + WS_MOD) + (size_t)33 * 6144;
    const int* SLOT = (const int*)(c.ws + WS_RT + RT_SLOT); const float* TKW = (const float*)(c.ws + WS_RT + RT_TKW);
    const unsigned char* OB = (const unsigned char*)(c.ws + WS_OB); const bf16* OBS = (const bf16*)(c.ws + WS_OBS);
    float* xl = p->out; float* xc = (float*)(c.ws + WS_XC); unsigned char* H = c.ws + WS_H;
    const int gw = c.blk * NWAVES + c.wave, NGW = c.G * NWAVES, lane = c.lane;
    const int col0 = (lane >> 4) * 256 + ((lane >> 2) & 3) * 32 + (lane & 3) * 8;
    f32x4 gn[4];
#pragma unroll
    for (int q = 0; q < 4; ++q) gn[q] = *(const f32x4*)((l == 0 ? p->in[I_N1G] + DM : p->in[I_FG]) + col0 + 128 * (q >> 1) + 4 * (q & 1));
    int sl_n = 0; float w_n = 0.f;
    if (gw < rpc && lane < 8) { sl_n = SLOT[(size_t)(ch * rpc + gw) * 8 + lane]; w_n = TKW[(size_t)(ch * rpc + gw) * 8 + lane] * 0.0625f; }
    for (int i = gw; i < rpc; i += NGW) {
        const int t = ch * rpc + i; float* xr = t < NLAT ? xl + (size_t)t * DM : xc + (size_t)(t - NLAT) * DM; const int mr = mod_row(t); const float* g2 = MOD + (size_t)mr * 6144;
        const int sl = sl_n; const float w = w_n;
        u32x4 ob[8], os0, os1; f32x4 xv[4];
#pragma unroll
        for (int e = 0; e < 8; ++e) ob[e] = *(const u32x4*)(OB + (size_t)rdli(sl, e) * 1024 + lane * 16);
        os0 = *(const u32x4*)(OBS + (size_t)i * DM + col0); os1 = *(const u32x4*)(OBS + (size_t)i * DM + col0 + 128);
#pragma unroll
        for (int q = 0; q < 4; ++q) xv[q] = *(const f32x4*)(xr + col0 + 128 * (q >> 1) + 4 * (q & 1));
        if (i + NGW < rpc && lane < 8) { sl_n = SLOT[(size_t)(t + NGW) * 8 + lane]; w_n = TKW[(size_t)(t + NGW) * 8 + lane] * 0.0625f; }
        float a[16]; { float t8[8]; unpack8(os0, t8);
#pragma unroll
            for (int q = 0; q < 8; ++q) a[q] = t8[q];
            unpack8(os1, t8);
#pragma unroll
            for (int q = 0; q < 8; ++q) a[8 + q] = t8[q]; }
#pragma unroll
        for (int e = 0; e < 8; ++e) { const float wk = rdl(w, e);
#pragma unroll
            for (int q = 0; q < 4; ++q) { const f32x2 lo = __builtin_amdgcn_cvt_pk_f32_fp8((int)ob[e][q], false), hi = __builtin_amdgcn_cvt_pk_f32_fp8((int)ob[e][q], true);
                a[4 * q] = fmaf(wk, lo.x, a[4 * q]); a[4 * q + 1] = fmaf(wk, lo.y, a[4 * q + 1]); a[4 * q + 2] = fmaf(wk, hi.x, a[4 * q + 2]); a[4 * q + 3] = fmaf(wk, hi.y, a[4 * q + 3]); } }
        f32x4 xn[4]; float ss = 0.f;
#pragma unroll
        for (int q = 0; q < 4; ++q) { const int cc = col0 + 128 * (q >> 1) + 4 * (q & 1); const f32x4 gv = *(const f32x4*)(g2 + cc);
            xn[q] = xv[q] + gv * (f32x4){a[4 * q], a[4 * q + 1], a[4 * q + 2], a[4 * q + 3]}; ss += (xn[q].x * xn[q].x + xn[q].y * xn[q].y) + (xn[q].z * xn[q].z + xn[q].w * xn[q].w); }
        const float rstd = rsqrtf(wave_sum(ss) * (1.f / 1024.f) + EPS);
        if (l == 0) { const float* mn = MODn + (size_t)mr * 6144; unsigned char* hr = H + (size_t)t * DM;
#pragma unroll
            for (int q = 0; q < 4; ++q) { const int cc = col0 + 128 * (q >> 1) + 4 * (q & 1); *(f32x4*)(xr + cc) = xn[q];
                const f32x4 s0 = *(const f32x4*)(mn + cc), s1 = *(const f32x4*)(mn + 1024 + cc); const f32x4 hv = (xn[q] * rstd * gn[q] * (s1 + 1.0f) + s0) * 4.f;
                *(unsigned*)(hr + cc) = pk4_fp8(hv.x, hv.y, hv.z, hv.w); } }
        else {
#pragma unroll
            for (int q = 0; q < 4; ++q) { const int cc = col0 + 128 * (q >> 1) + 4 * (q & 1); *(f32x4*)(xr + cc) = xn[q] * rstd * gn[q]; } }
    }
}
constexpr int LDS_BYTES = 147456;
constexpr int LDS_TAB = 131072, LDS_XB = LDS_BYTES - 16;
enum { J_INPROJ = 0, J_S5G1, J_PW, J_Q, J_KV, J_S5G2, J_GLU, J_OUT, J_GU, J_GUS, J_DN, J_DNS };
enum { SK_DENSE = 0, SK_S5, SK_MOE };
enum { EK_INPROJ = 0, EK_S5X, EK_S5Y, EK_BIAS, EK_GLU, EK_Q, EK_KV, EK_RESID, EK_SWIGLU, EK_OB8, EK_BF16 };
struct JSched {
    int sk, G, c; pg8::DenseOrder d; const char* W; size_t wexp, wtile; const LAS unsigned char* texp; int ntile, npn;
    __device__ __forceinline__ bool next(int i, pg8::Unit& u) const {
        if (sk == SK_DENSE) return d.next(i, u);
        const int L = i * G + c;
        if (sk == SK_S5) { if (L >= 288) return false; u.pm = L; u.pn = 0; u.e = L / 18; u.B = W + (size_t)u.e * wexp; return true; }
        if (L >= ntile * npn) return false;
        const int T = npn == 2 ? (L >> 1) : (L >> 2), pn = L & (npn - 1); const int e = __builtin_amdgcn_readfirstlane((int)texp[T]);
        u.pm = T; u.pn = pn; u.e = e; u.B = W + (size_t)e * wexp + (size_t)pn * wtile; return true;
    }
};
struct JRows { const int* list; unsigned ldab;
    __device__ __forceinline__ unsigned off(const pg8::Unit& u, int r) const { const int row = u.pm * 256 + r; return (unsigned)(list ? list[row] : row) * ldab; } };
struct JEpi {
    int ek; void* p0; void* p1; void* p2; const void* q0; const void* q1; const void* q2; int i0;
    __device__ __forceinline__ void operator()(EPI_ARGS) const {
        switch (ek) {
        case EK_S5X:    EpiS5X{(bf16*)p0}(acc, u, wr, wc, fr, fq); break;
        case EK_S5Y:    EpiS5Y{(bf16*)p0}(acc, u, wr, wc, fr, fq); break;
        case EK_BIAS:   EpiBiasBf16{(unsigned char*)p0, i0, (const float*)q0}(acc, u, wr, wc, fr, fq); break;
        case EK_GLU:    EpiGluSig{(unsigned char*)p0, i0, (const float*)q0}(acc, u, wr, wc, fr, fq); break;
        case EK_Q:      EpiQ{(bf16*)p0, (const float*)q0}(acc, u, wr, wc, fr, fq); break;
        case EK_KV:     EpiKV{(bf16*)p0, (bf16*)p1, (const float*)q0}(acc, u, wr, wc, fr, fq); break;
        default:        EpiBf16{(bf16*)p0, i0}(acc, u, wr, wc, fr, fq); break;
        }
    }
};
struct JEpi8 {
    int ek; void* p0; int i0; const void* q0; void* p1; void* p2;
    __device__ __forceinline__ void operator()(EPI_ARGS) const {
        if (ek == EK_SWIGLU) EpiSwiglu{(unsigned char*)p0, i0, 1.0f / 256.0f}(acc, u, wr, wc, fr, fq);
        else if (ek == EK_OB8) EpiOB8{(unsigned char*)p0, 16.0f / 1024.0f}(acc, u, wr, wc, fr, fq);
        else if (ek == EK_INPROJ) EpiInProj{(bf16*)p0, (bf16*)p1, (bf16*)p2, 1.0f / 256.0f}(acc, u, wr, wc, fr, fq);
        else if (ek == EK_RESID) EpiDelta{(bf16*)p0, (const float*)q0, 1.0f / 1024.0f}(acc, u, wr, wc, fr, fq);
        else EpiBf16S{(bf16*)p0, i0, 1.0f / 1024.0f}(acc, u, wr, wc, fr, fq);
    }
};
__device__ __forceinline__ void gemm_job(KParams p, LAS unsigned char* lds, int job, int l, int ch) {
    unsigned char* ws = p->ws;
    const int G = gridDim.x, blk = blockIdx.x;
    const bool last = (l == 1); const int nrows = last ? NLAT : NTOK, rpc = nrows / NCH;
    unsigned char* sm = ws + WS_WSM + (size_t)l * WSM_L;
    const LAS int* tst = (const LAS int*)(lds + LDS_TAB);
    auto rot8 = [&](int units) { return ((units % G) + 7) & ~7; };
    auto rotc = [&](int rot) { return (blk + G - rot % G) % G; };
    const char* A = nullptr; int K = 256; bool fp8 = false; JSched S; JRows R; JEpi E;
    S.sk = SK_DENSE; S.G = G; S.c = blk; S.W = nullptr; S.wexp = 0; S.wtile = 0; S.texp = (const LAS unsigned char*)(tst + 80); S.ntile = 0; S.npn = 2; S.d.init(1, 1, G, blk, nullptr, 256);
    R.list = nullptr; R.ldab = 512u; E.ek = EK_BF16; E.p0 = E.p1 = E.p2 = nullptr; E.q0 = E.q1 = E.q2 = nullptr; E.i0 = 0;
    switch (job) {
    case J_INPROJ: A = (const char*)(ws + WS_H); K = 512; fp8 = true; R.ldab = 1024u; S.d.init(NTOK / 256, ZW / 256, G, blk, (const bf16*)(ws + WS_WIN) + (size_t)l * 2048 * 1024, 512);
        E.ek = EK_INPROJ; E.p0 = ws + WS_Z; E.p1 = ws + WS_UP; E.p2 = ws + WS_GVT; break;
    case J_S5G1: A = (const char*)(ws + WS_UP); K = 256; R.ldab = 1024u; S.sk = SK_S5; S.W = (const char*)(ws + WS_S5W) + (size_t)l * 16 * 256 * 256 * 2; S.wexp = (size_t)256 * 256 * 2; E.ek = EK_S5X; E.p0 = ws + WS_Y5; break;
    case J_PW: A = (const char*)(ws + WS_CV); K = 256; R.ldab = 512u; S.d.init(nrows / 256, 1, G, blk, (const bf16*)(sm + WSM_PW), 256); E.ek = EK_BIAS; E.p0 = ws + WS_MIX + 256; E.i0 = DM; E.q0 = p->in[I_CPB] + l * 256; break;
    case J_Q: A = (const char*)(ws + WS_Z) + ZCQ * 2; K = 256; R.ldab = (unsigned)ZW * 2u; S.d.init(NTOK / 256, 2, G, rotc(rot8(nrows / 256)), (const bf16*)(sm + WSM_UQ), 256);
        E.ek = EK_Q; E.p0 = ws + WS_H; E.q0 = ws + WS_RS; break;
    case J_KV: A = (const char*)(ws + WS_Z) + ZCKV * 2; K = 256; R.ldab = (unsigned)ZW * 2u; S.d.init(NTOK / 256, 2, G, rotc(rot8(nrows / 256) + rot8(NTOK / 256 * 2)), (const bf16*)(sm + WSM_UK), 256);
        E.ek = EK_KV; E.p0 = (bf16*)(ws + WS_H) + (size_t)NTOK * 384; E.p1 = (bf16*)(ws + WS_H) + (size_t)NTOK * 768; E.q0 = ws + WS_RS; break;
    case J_S5G2: A = (const char*)(ws + WS_UP); K = 512; R.ldab = 1024u; S.sk = SK_S5; S.W = (const char*)(ws + WS_S5W) + (size_t)32 * 256 * 256 * 2 + (size_t)l * 16 * 256 * 512 * 2; S.wexp = (size_t)256 * 512 * 2; E.ek = EK_S5Y; E.p0 = ws + WS_Y5; break;
    case J_GLU: A = (const char*)(ws + WS_Y5); K = 256; R.ldab = 512u; S.d.init(nrows / 256, 2, G, blk, (const bf16*)(sm + WSM_GLU), 256); E.ek = EK_GLU; E.p0 = ws + WS_MIX + 512; E.i0 = DM; E.q0 = p->in[I_S5GB] + l * 512; break;
    case J_OUT: A = (const char*)(ws + WS_MIX); K = 512; fp8 = true; R.ldab = 1024u; S.d.init(nrows / 256, 4, G, blk, (const bf16*)(ws + WS_WOUT) + (size_t)l * 1024 * 1024, 512);
        E.ek = EK_RESID; E.p0 = ws + WS_Z; E.q0 = (const float*)(ws + WS_MOD) + (size_t)l * 33 * 6144 + 2048; break;
    case J_GU: A = (const char*)(ws + WS_H8); K = 512; fp8 = true; R.list = (const int*)(ws + WS_ROWL) + (size_t)ch * RPCMAX; R.ldab = 1024u; S.sk = SK_MOE; S.ntile = __builtin_amdgcn_readfirstlane(tst[64]); S.npn = 2; S.W = (const char*)(ws + WS_WMOE) + (size_t)l * 48 * MiB; S.wexp = (size_t)512 * 1024; S.wtile = (size_t)256 * 1024;
        E.ek = EK_SWIGLU; E.p0 = ws + WS_HB; E.i0 = 256; break;
    case J_GUS: A = (const char*)(ws + WS_H8) + (size_t)ch * rpc * 1024; K = 512; fp8 = true; R.ldab = 1024u; S.d.init(rpc / 256, 2, G, rotc(rot8(__builtin_amdgcn_readfirstlane(tst[64]) * 2)), (const bf16*)((const unsigned char*)(ws + WS_WSH) + (size_t)l * (512 * 1024 + 1024 * 256) * 2), 512); E.ek = EK_SWIGLU; E.p0 = ws + WS_HBS; E.i0 = 256; break;
    case J_DN: A = (const char*)(ws + WS_HB); K = 128; fp8 = true; R.ldab = 256u; S.sk = SK_MOE; S.ntile = __builtin_amdgcn_readfirstlane(tst[64]); S.npn = 4; S.W = (const char*)(ws + WS_WMOE) + (size_t)l * 48 * MiB + (size_t)NE * 512 * 1024; S.wexp = (size_t)1024 * 256; S.wtile = (size_t)256 * 256;
        E.ek = EK_OB8; E.p0 = ws + WS_OB; break;
    default: A = (const char*)(ws + WS_HBS); K = 128; fp8 = true; R.ldab = 256u; S.d.init(rpc / 256, 4, G, rotc(rot8(__builtin_amdgcn_readfirstlane(tst[64]) * 4)), (const bf16*)((const unsigned char*)(ws + WS_WSH) + (size_t)l * (512 * 1024 + 1024 * 256) * 2 + 512 * 1024), 128); E.ek = EK_BF16; E.p0 = ws + WS_OBS; E.i0 = DM; break;
    }
    __builtin_amdgcn_s_waitcnt(0x0F70);
    if (fp8) pg8::gemm_phase<true>(lds, A, K, S, R, JEpi8{E.ek, E.p0, E.i0, E.q0, E.p1, E.p2});
    else pg8::gemm_phase<false>(lds, A, K, S, R, E);
}


__global__ void __launch_bounds__(NTHR, 2) fwd_kernel(Params pk) {
    extern __shared__ __attribute__((aligned(16))) unsigned char lds_raw[];
    LAS unsigned char* const lds0 = (LAS unsigned char*)lds_raw;
    if (threadIdx.x < 4) ((LAS unsigned*)(lds0 + LDS_XB))[threadIdx.x] = 0u;
    __syncthreads();
    (void)xcd_barrier_post((unsigned*)(pk.ws + WS_CTL) + CW_BAR, (volatile LAS unsigned*)(lds0 + LDS_XB));
    constexpr int NSTEP = 15 + 6 * NCH;
#ifndef PROBE_DUP
#define PROBE_DUP (-9)
#endif
#pragma unroll 1
    for (int it_ = -2; it_ < 2 * NSTEP + (PROBE_DUP >= 0 ? 2 : 0); ++it_) {
        int gs = it_; if (PROBE_DUP >= 0) { if (it_ > PROBE_DUP) gs -= 1; if (it_ > NSTEP + PROBE_DUP + 1) gs -= 1; }
        KParams p = fresh_params(); Ctx c; { int t_ = threadIdx.x; asm volatile("" : "+v"(t_)); c.lds = lds0; c.tid = t_; c.lane = t_ & 63; c.wave = __builtin_amdgcn_readfirstlane(t_ >> 6); c.blk = blockIdx.x; c.G = gridDim.x; c.ws = p->ws; }
        LAS int* tst = (LAS int*)(c.lds + LDS_TAB);
        int l = 0, s = gs, ch = 0, job = -1; bool seam = true;
        if (gs >= 0) { l = gs >= NSTEP ? 1 : 0; s = gs - l * NSTEP; if (s >= 15) { ch = (s - 15) / 6; s = 15 + (s - 15) % 6; } }
        const bool last = (l == 1); const int nrows = last ? NLAT : NTOK, rpc = nrows / NCH;
        switch (s) {
        case -2: prologue(c, p); break;
        case -1: prologue2(c, p); phase_norm1(c, p, 0); break;
        case 0: seam = false; break;
        case 1: job = J_INPROJ; break;
        case 2: phase_gla(c, p, l); phase_conv1(c, p, l, !last); phase_mla_prep(c, p); seam = false; break;
        case 3: job = J_S5G1; break;
        case 4: phase_gla_final(c, p, l, nrows); seam = false; break;
        case 5: job = J_PW; seam = false; break;
        case 6: job = J_Q; seam = false; break;
        case 7: job = J_KV; seam = false; break;
        case 8: phase_s5_carry(c, l); break;
        case 9: phase_attn(c, !last); seam = false; break;
        case 10: job = J_S5G2; break;
        case 11: job = J_GLU; break;
        case 12: job = J_OUT; break;
        case 13: phase_norm2_route(c, p, l, nrows); break;
        case 14: phase_route_fill(c, l, nrows); break;
        case 15: moe_tile_table(c, l, ch, tst); job = J_GU; seam = false; break;
        case 16: job = J_GUS; break;
        case 17: job = J_DN; seam = false; break;
        case 18: job = J_DNS; break;
        case 19: phase_combine(c, p, l, ch, rpc); break;
        default: seam = false; break;
        }
        if (job >= 0) gemm_job(p, c.lds, job, l, ch);
        if (seam && gs + 1 < 2 * NSTEP) { XcdBarrier b_; b_.bar = (unsigned*)(p->ws + WS_CTL) + CW_BAR; b_.x = xb_xcc_id(); b_.st = (volatile LAS unsigned*)(lds0 + LDS_XB); xcd_barrier(b_); }
    }
}

extern "C" void kernel_launch(void* const* d_in, const int* in_sizes, int n_in, void* d_out, int out_size, void* d_ws, size_t ws_size, hipStream_t stream) {
    static int grid = 0;
    if (grid == 0) {
        if (n_in != 42 || out_size != NLAT * DM || ws_size < WS_END) { fprintf(stderr, "kernel_launch: unexpected shapes (n_in %d out %d ws %zu)\n", n_in, out_size, ws_size); grid = -1; return; }
        int dev = 0, cus = 0;
        if (hipGetDevice(&dev) != hipSuccess || hipDeviceGetAttribute(&cus, hipDeviceAttributeMultiprocessorCount, dev) != hipSuccess) { grid = -1; return; }
        if (hipFuncSetAttribute((const void*)fwd_kernel, hipFuncAttributeMaxDynamicSharedMemorySize, LDS_BYTES) != hipSuccess) { fprintf(stderr, "kernel_launch: hipFuncSetAttribute failed\n"); grid = -1; return; }
        int per_cu = 0;
        if (hipOccupancyMaxActiveBlocksPerMultiprocessor(&per_cu, (const void*)fwd_kernel, NTHR, LDS_BYTES) != hipSuccess || per_cu < 1) fprintf(stderr, "kernel_launch: occupancy query reports %d\n", per_cu);
        (void)hipGetLastError();
        grid = cus;
    }
    if (grid < 0) return;
    (void)hipMemsetAsync((char*)d_ws + WS_CTL, 0, CTL_BYTES, stream);
    Params p{};
    for (int i = 0; i < 42; ++i) p.in[i] = (const float*)d_in[i];
    p.out = (float*)d_out; p.ws = (unsigned char*)d_ws; p.ph_lo = 0; p.ph_hi = 1 << 20;
    hipLaunchKernelGGL(fwd_kernel, dim3(grid), dim3(NTHR), LDS_BYTES, stream, p);
}
```

```cpp
#include <hip/hip_runtime.h>
#include <cstdio>
#include <cstdint>

#define LAS __attribute__((address_space(3)))
typedef unsigned short bf16;
typedef short bf16x8 __attribute__((ext_vector_type(8)));
typedef float f32x4 __attribute__((ext_vector_type(4)));
typedef float f32x2 __attribute__((ext_vector_type(2)));
typedef float f32x16 __attribute__((ext_vector_type(16)));
typedef unsigned u32x4 __attribute__((ext_vector_type(4)));
typedef unsigned u32x2 __attribute__((ext_vector_type(2)));
typedef int i32x4 __attribute__((ext_vector_type(4)));
typedef int i32x8 __attribute__((ext_vector_type(8)));

constexpr int NB = 32, SEQ = 2048, CTXL = 256, DM = 1024;
constexpr int NLAT = NB * SEQ, NCTX = NB * CTXL, NTOK = NLAT + NCTX;
constexpr int ZW = 2048;
constexpr int ZQ = 0, ZK = 128, ZV = 256, ZR = 512, ZCA = 768, ZCG = 1024, ZS5 = 1280, ZCQ = 1536, ZCKV = 1792, ZKR = 1920, ZAF = 1952, ZAB = 1968;
constexpr int NE = 64, TOPK = 8;
constexpr int NCH = 2;
constexpr int RPCMAX = (NTOK / NCH) * 8 + 64 * 256;
constexpr float EPS = 1e-6f;
constexpr int NWAVES = 8, NTHR = 512;

constexpr size_t MiB = (size_t)1 << 20;
constexpr size_t WS_CTL = 0, CTL_BYTES = 1 * MiB;
constexpr size_t WS_MOD = 1 * MiB;
constexpr size_t WS_TAB = 3 * MiB;
constexpr size_t WS_WSM = 5 * MiB;
constexpr size_t WS_WIN = 8 * MiB;
constexpr size_t WS_WOUT = 16 * MiB;
constexpr size_t WS_WSH = 20 * MiB;
constexpr size_t WS_TB = 23 * MiB;
constexpr size_t WS_RT = 24 * MiB;
constexpr size_t WS_ROWL = 32 * MiB;
constexpr size_t WS_RS = 35 * MiB;
constexpr size_t WS_WMOE = 36 * MiB;
constexpr size_t WS_XC = 132 * MiB;
constexpr size_t WS_H = 164 * MiB;
constexpr size_t WS_H8 = WS_H + 72 * MiB;
constexpr size_t WS_Z = 308 * MiB;
constexpr size_t WS_MIX = 596 * MiB;
constexpr size_t WS_T1 = 740 * MiB;
constexpr size_t WS_UP = 812 * MiB;
constexpr size_t WS_CV = 884 * MiB;
constexpr size_t WS_Y5 = 920 * MiB;
constexpr size_t WS_S5W = 956 * MiB;
constexpr size_t WS_S5P = 968 * MiB;
constexpr size_t WS_GVT = 969 * MiB;
constexpr size_t WS_END = 1005 * MiB;
constexpr size_t WS_HB = WS_Z;
constexpr size_t WS_HBS = WS_Z + 152 * MiB;
constexpr size_t WS_OBS = WS_Z + 170 * MiB;
constexpr size_t WS_OB = WS_MIX;
static_assert((size_t)RPCMAX * 512 <= 152 * MiB && WS_OBS + (size_t)(NTOK / NCH) * 2048 <= WS_MIX && WS_OB + (size_t)RPCMAX * 1024 <= WS_S5W, "MoE overlays");
constexpr int CW_BAR = 0;
constexpr int CW_CNT = 4096;
constexpr size_t WSM_L = 1 * MiB;
constexpr size_t WSM_PW = 0, WSM_GLU = 128 * 1024, WSM_UQ = 384 * 1024, WSM_UK = 640 * 1024, WSM_UV = 768 * 1024;
constexpr size_t TAB_ROPE = 0;
constexpr size_t TAB_S5 = 256 * 1024;
constexpr size_t TAB_RWT = 1536 * 1024;
constexpr size_t RT_TKEP = 0, RT_TKW = 2400000, RT_SLOT = 4800000;

__device__ __forceinline__ float bf2f(bf16 v) { return __uint_as_float(((unsigned)v) << 16); }
typedef __bf16 bf16x2_t __attribute__((ext_vector_type(2)));
__device__ __forceinline__ unsigned pk2(float lo, float hi) { const f32x2 v = {lo, hi}; return __builtin_bit_cast(unsigned, __builtin_convertvector(v, bf16x2_t)); }
__device__ __forceinline__ bf16 f2bf(float f) { return __builtin_bit_cast(unsigned short, (__bf16)f); }
template <int O> __device__ __forceinline__ float shx(float v) {
    return __int_as_float(__builtin_amdgcn_ds_swizzle(__float_as_int(v), (O << 10) | 0x1f)); }
__device__ __forceinline__ float rdl(float v, int l) { return __int_as_float(__builtin_amdgcn_readlane(__float_as_int(v), l)); }
__device__ __forceinline__ int rdli(int v, int l) { return __builtin_amdgcn_readlane(v, l); }
__device__ __forceinline__ float wave_sum(float v) {
    v += shx<1>(v); v += shx<2>(v); v += shx<4>(v); v += shx<8>(v); v += shx<16>(v);
    const auto r = __builtin_amdgcn_permlane32_swap(__float_as_uint(v), __float_as_uint(v), false, false);
    return __uint_as_float(r[0]) + __uint_as_float(r[1]);
}
__device__ __forceinline__ float wave_max(float v) {
    v = fmaxf(v, shx<1>(v)); v = fmaxf(v, shx<2>(v)); v = fmaxf(v, shx<4>(v)); v = fmaxf(v, shx<8>(v)); v = fmaxf(v, shx<16>(v));
    const auto r = __builtin_amdgcn_permlane32_swap(__float_as_uint(v), __float_as_uint(v), false, false);
    return fmaxf(__uint_as_float(r[0]), __uint_as_float(r[1]));
}
__device__ __forceinline__ float sigmoidf_(float x) { return 1.0f / (1.0f + __expf(-x)); }
__device__ __forceinline__ float siluf_(float x) { return x / (1.0f + __expf(-x)); }
__device__ __forceinline__ void unpack8(const u32x4 w, float (&v)[8]) {
    v[0] = __uint_as_float(w.x << 16); v[1] = __uint_as_float(w.x & 0xffff0000u);
    v[2] = __uint_as_float(w.y << 16); v[3] = __uint_as_float(w.y & 0xffff0000u);
    v[4] = __uint_as_float(w.z << 16); v[5] = __uint_as_float(w.z & 0xffff0000u);
    v[6] = __uint_as_float(w.w << 16); v[7] = __uint_as_float(w.w & 0xffff0000u);
}
__device__ __forceinline__ void lds_wait() { asm volatile("s_waitcnt lgkmcnt(0)" ::: "memory"); }

#define XB_TMO      128
#define XB_XCNT(j)  (256  + 64 * (j))
#define XB_XSUB(j)  (1280 + 64 * (j))
#define XB_XGEN(j)  (2304 + 64 * (j))
#define XB_TOP      3328
#define XB_TOPGEN   3392
#define XCD_BAR_WORDS 3456
#define XB_SPIN_CAP (1u << 22)
__device__ __forceinline__ unsigned xb_ld(unsigned* p)              { return __hip_atomic_load(p, __ATOMIC_RELAXED, __HIP_MEMORY_SCOPE_AGENT); }
__device__ __forceinline__ unsigned xb_add(unsigned* p, unsigned v) { return __hip_atomic_fetch_add(p, v, __ATOMIC_RELAXED, __HIP_MEMORY_SCOPE_AGENT); }
__device__ __forceinline__ unsigned xb_xcc_id() { return (unsigned)__builtin_amdgcn_s_getreg((3 << 11) | 20) & 0xFu; }
#define XB_SPIN(cond, bar) do { unsigned _sp = 0; while (cond) { __builtin_amdgcn_s_sleep(1); \
    if ((++_sp & 255u) == 0u) { if (xb_ld(&(bar)[XB_TMO])) break; if (_sp > XB_SPIN_CAP) { atomicAdd(&(bar)[XB_TMO], 1u); break; } } } } while (0)
struct XcdBarrier { unsigned* bar; unsigned x; volatile LAS unsigned* st; };
__device__ __forceinline__ XcdBarrier xcd_barrier_post(unsigned* bar, volatile LAS unsigned* st) {
    XcdBarrier b; b.bar = bar; b.x = xb_xcc_id(); b.st = st;
    if (threadIdx.x == 0) (void)xb_add(&bar[XB_XCNT(b.x)], 1u);
    return b;
}
__device__ __forceinline__ void xcd_barrier_complete(unsigned* bar, unsigned x, unsigned& nloc, unsigned& nx) {
    const unsigned G = gridDim.x * gridDim.y * gridDim.z;
    unsigned sum, cnt, mine, sp = 0u;
    for (;;) {
        sum = 0u; cnt = 0u; mine = 0u;
#pragma unroll
        for (unsigned j = 0; j < 16; ++j) { const unsigned c = xb_ld(&bar[XB_XCNT(j)]); sum += c; cnt += (c > 0u) ? 1u : 0u; mine = (j == x) ? c : mine; }
        if (sum == G) break;
        __builtin_amdgcn_s_sleep(1);
        if ((++sp & 255u) == 0u) { if (xb_ld(&bar[XB_TMO])) break; if (sp > XB_SPIN_CAP) { atomicAdd(&bar[XB_TMO], 1u); break; } }
    }
    nloc = mine > 0u ? mine : 1u; nx = cnt > 0u ? cnt : 1u;
}
__device__ __forceinline__ void xcd_barrier(const XcdBarrier& b) {
    asm volatile("s_waitcnt vmcnt(0)" ::: "memory");
    __syncthreads();
    if (threadIdx.x == 0) {
        unsigned* bar = b.bar;
        __builtin_amdgcn_s_waitcnt(0);
        unsigned nloc = b.st[0], nx = b.st[1];
        if (nloc == 0u) { xcd_barrier_complete(bar, b.x, nloc, nx); b.st[0] = nloc; b.st[1] = nx; }
        const unsigned old = xb_add(&bar[XB_XSUB(b.x)], 1u);
        const unsigned gen = old / nloc;
        if (old + 1u == (gen + 1u) * nloc) {
            __builtin_amdgcn_fence(__ATOMIC_RELEASE, "agent");
            asm volatile("s_waitcnt vmcnt(0)" ::: "memory");
            const unsigned og = xb_add(&bar[XB_TOP], 1u);
            const unsigned tg = og / nx;
            if (og + 1u == (tg + 1u) * nx) xb_add(&bar[XB_TOPGEN], 1u);
            else XB_SPIN(xb_ld(&bar[XB_TOPGEN]) == tg, bar);
            __builtin_amdgcn_fence(__ATOMIC_ACQUIRE, "agent");
            xb_add(&bar[XB_XGEN(b.x)], 1u);
            asm volatile("s_waitcnt vmcnt(0)" ::: "memory");
        } else {
            XB_SPIN(xb_ld(&bar[XB_XGEN(b.x)]) == gen, bar);
            __builtin_amdgcn_fence(__ATOMIC_ACQUIRE, "agent");
            asm volatile("s_waitcnt vmcnt(0)" ::: "memory");
        }
    }
    __syncthreads();
}

namespace pg8 {
constexpr int BM = 256, BK = 64, HALF = 128, HTB = HALF * BK * 2, STAGE_BYTES = 8 * HTB, NXCD = 8, WGM = 8;
__device__ __forceinline__ int lds_byte(int r, int c) { const int st = (r >> 4) * 2 + (c >> 5), rr = r & 15, cc = c & 31, ob = rr * 64 + cc * 2; return st * 1024 + (ob ^ (((ob >> 9) & 1) << 5)); }
__device__ __forceinline__ void stage_rc(int b, int& R, int& C) { const int st = b / 1024, sb = b % 1024, swz = sb ^ (((sb >> 9) & 1) << 5); R = (st >> 1) * 16 + swz / 64; C = (st & 1) * 32 + (swz % 64) / 2; }
__device__ __forceinline__ int perm32(int rho) { const int n = rho >> 4, i = rho & 15; return 8 * (i >> 2) + 4 * n + (i & 3); }

struct Unit { int pm, pn, e; const char* B; };

struct DenseOrder {
    int nM, nN, nwg, G, c; const char* Bt; size_t btile;
    __device__ __forceinline__ void init(int nM_, int nN_, int G_, int c_, const bf16* Bt_, int K) { nM = nM_; nN = nN_; nwg = nM * nN; G = G_; c = c_; Bt = (const char*)Bt_; btile = (size_t)256 * K * 2; }
    __device__ __forceinline__ bool next(int i, Unit& u) const {
        const long L = (long)i * G + c; if (L >= nwg) return false;
        int wgid = (int)L; { const int q = nwg / NXCD, r = nwg % NXCD, xcd = wgid % NXCD, off = wgid / NXCD; wgid = (xcd < r ? xcd * (q + 1) : r * (q + 1) + (xcd - r) * q) + off; }
        const int nig = WGM * nN, gid = wgid / nig, fm = gid * WGM, gsz = (nM - fm) < WGM ? (nM - fm) : WGM;
        u.pm = fm + ((wgid % nig) % gsz); u.pn = (wgid % nig) / gsz; u.e = 0; u.B = Bt + (size_t)u.pn * btile; return true;
    }
};
struct RowsDense { unsigned ldab; __device__ __forceinline__ unsigned off(const Unit& u, int r) const { return (unsigned)(u.pm * 256 + r) * ldab; } };
struct RowsGather { const int* list; unsigned ldab; __device__ __forceinline__ unsigned off(const Unit& u, int r) const { return (unsigned)list[u.pm * 256 + r] * ldab; } };

template <bool FP8, class Epi, class Sched, class Rows>
__device__ __forceinline__ void gemm_phase(LAS unsigned char* lds, const char* Abase, const int K, const Sched& S, const Rows& RW, const Epi& E) {
    int tid_ = threadIdx.x; asm volatile("" : "+v"(tid_));
    const int tid = tid_, wid = __builtin_amdgcn_readfirstlane(tid >> 6), lane = tid & 63, wr = wid >> 2, wc = wid & 3, fr = lane & 15, fq = lane >> 4;
    const int nt = K / BK;
    int sR[2]; unsigned sC[2], voffB[2];
#pragma unroll
    for (int i = 0; i < 2; ++i) { int R, C; stage_rc(tid * 16 + i * 8192, R, C); sR[i] = R; sC[i] = (unsigned)C * 2u; const int Rb = (R & ~31) + perm32(R & 31); voffB[i] = (unsigned)(Rb * K + C) * 2u; }
    const size_t kstep = (size_t)(BK * 2);
    const size_t hstepB = (size_t)HALF * K * 2;
    const unsigned ldsw = (unsigned)wid * 1024u;
    const int aoff = lds_byte(wr * 64 + fr, fq * 8), boff = lds_byte(wc * 32 + fr, fq * 8);
#define PG8_SA(b, h) (((b) * 2 + (h)) * HTB)
#define PG8_SB(b, h) ((4 + (b) * 2 + (h)) * HTB)
#define PG8_STAGE(bufoff, gbase, voff) do { const char* _gb = (const char*)(gbase); asm volatile("" : "+s"(_gb)); _Pragma("unroll") for (int _i = 0; _i < 2; ++_i) { unsigned _o = (voff)[_i]; asm volatile("" : "+v"(_o)); \
        __builtin_amdgcn_global_load_lds((const unsigned*)(_gb + _o), (LAS unsigned*)(lds + (bufoff) + ldsw + _i * 8192), 16, 0, 0); } } while (0)
#define PG8_LDA(dst, b, h) do { _Pragma("unroll") for (int m = 0; m < 4; ++m) dst[m] = PG8_CAT(*(const LAS i32x4*)(lds + PG8_SA(b, h) + aoff + m * 2048), *(const LAS i32x4*)(lds + PG8_SA(b, h) + aoff + m * 2048 + 1024)); } while (0)
#define PG8_LDB(dst, b, h) do { _Pragma("unroll") for (int n = 0; n < 2; ++n) dst[n] = PG8_CAT(*(const LAS i32x4*)(lds + PG8_SB(b, h) + boff + n * 2048), *(const LAS i32x4*)(lds + PG8_SB(b, h) + boff + n * 2048 + 1024)); } while (0)
#define PG8_CAT(x0, x1) __builtin_shufflevector((x0), (x1), 0, 1, 2, 3, 4, 5, 6, 7)
#define PG8_LO(x) __builtin_bit_cast(bf16x8, __builtin_shufflevector((x), (x), 0, 1, 2, 3))
#define PG8_HI(x) __builtin_bit_cast(bf16x8, __builtin_shufflevector((x), (x), 4, 5, 6, 7))
#define PG8_MMA(ai, bj, At, Bt) do { __builtin_amdgcn_s_setprio(1); \
        if (FP8) { _Pragma("unroll") for (int m = 0; m < 4; ++m) _Pragma("unroll") for (int n = 0; n < 2; ++n) \
            acc[ai][bj][m][n] = __builtin_amdgcn_mfma_scale_f32_16x16x128_f8f6f4(Bt[n], At[m], acc[ai][bj][m][n], 0, 0, 0, 0x7f7f7f7f, 0, 0x7f7f7f7f); } \
        else { _Pragma("unroll") for (int m = 0; m < 4; ++m) _Pragma("unroll") for (int n = 0; n < 2; ++n) { \
            acc[ai][bj][m][n] = __builtin_amdgcn_mfma_f32_16x16x32_bf16(PG8_LO(Bt[n]), PG8_LO(At[m]), acc[ai][bj][m][n], 0, 0, 0); \
            acc[ai][bj][m][n] = __builtin_amdgcn_mfma_f32_16x16x32_bf16(PG8_HI(Bt[n]), PG8_HI(At[m]), acc[ai][bj][m][n], 0, 0, 0); } } \
        __builtin_amdgcn_s_setprio(0); } while (0)
#define PG8_WAIT_V(n) asm volatile("s_waitcnt vmcnt(" #n ")" ::: "memory")
#define PG8_WAIT_L(n) asm volatile("s_waitcnt lgkmcnt(" #n ")" ::: "memory")
#define PG8_BAR __builtin_amdgcn_s_barrier()
#define PG8_SCHED __builtin_amdgcn_sched_barrier(0)
    Unit cur, nxt; int ui = 0;
    if (!S.next(0, cur)) return;
    f32x4 acc[2][2][4][2];
#pragma unroll
    for (int a = 0; a < 2; ++a)
#pragma unroll
        for (int b = 0; b < 2; ++b)
#pragma unroll
            for (int m = 0; m < 4; ++m)
#pragma unroll
                for (int n = 0; n < 2; ++n) acc[a][b][m][n] = (f32x4){0.f, 0.f, 0.f, 0.f};
    i32x8 At[4], B0[2], B1[2];
    unsigned oA0[2], oA1[2];
#pragma unroll
    for (int i = 0; i < 2; ++i) { oA0[i] = RW.off(cur, sR[i]) + sC[i]; oA1[i] = RW.off(cur, HALF + sR[i]) + sC[i]; }
    const char* cB = cur.B;
    PG8_STAGE(PG8_SB(0, 0), cB, voffB); PG8_STAGE(PG8_SB(0, 1), cB + hstepB, voffB); PG8_STAGE(PG8_SA(0, 0), Abase, oA0); PG8_STAGE(PG8_SA(0, 1), Abase, oA1);
    if (wr == 1) PG8_BAR;
    PG8_WAIT_V(2); PG8_BAR;
    PG8_STAGE(PG8_SB(1, 0), cB + kstep, voffB); PG8_STAGE(PG8_SA(1, 0), Abase + kstep, oA0); PG8_STAGE(PG8_SB(1, 1), cB + hstepB + kstep, voffB);
    PG8_WAIT_V(6); PG8_BAR;
    for (;;) {
        const bool has_next = S.next(ui + 1, nxt);
        unsigned gi0 = 0u, gi1 = 0u, gi2 = 0u, gi3 = 0u;
        if (has_next && RW.list) {
            int t2 = threadIdx.x; asm volatile("" : "+v"(t2)); int R0, C0, R1, C1; stage_rc(t2 * 16, R0, C0); stage_rc(t2 * 16 + 8192, R1, C1);
            const int* lb = RW.list + (size_t)nxt.pm * 256; const unsigned o0 = (unsigned)R0 * 4u, o1 = (unsigned)R1 * 4u, o2 = (unsigned)(HALF + R0) * 4u, o3 = (unsigned)(HALF + R1) * 4u;
            asm volatile("global_load_dword %0, %4, %8\n\tglobal_load_dword %1, %5, %8\n\tglobal_load_dword %2, %6, %8\n\tglobal_load_dword %3, %7, %8"
                         : "=&v"(gi0), "=&v"(gi1), "=&v"(gi2), "=&v"(gi3) : "v"(o0), "v"(o1), "v"(o2), "v"(o3), "s"(lb));
        }
#pragma unroll 1
        for (int t = 0; t < nt; t += 2) {
            const bool last = (t == nt - 2);
            const char* a1 = Abase + (size_t)(t + 1) * kstep;
            PG8_LDB(B0, 0, 0); PG8_LDB(B1, 0, 1); PG8_SCHED; PG8_LDA(At, 0, 0); PG8_STAGE(PG8_SA(1, 1), a1, oA1);
            PG8_WAIT_V(8); PG8_WAIT_L(0); PG8_BAR; PG8_MMA(0, 0, At, B0); PG8_MMA(0, 1, At, B1); PG8_BAR; PG8_SCHED;
            const char* a2; const char* b2;
            if (last) {
                if (has_next) {
                    int t2 = threadIdx.x; asm volatile("" : "+v"(t2));
#pragma unroll
                    for (int i = 0; i < 2; ++i) { int R, C; stage_rc(t2 * 16 + i * 8192, R, C);
                        if (RW.list) { asm volatile("" : "+v"(gi0), "+v"(gi1), "+v"(gi2), "+v"(gi3)); oA0[i] = (i ? gi1 : gi0) * RW.ldab + (unsigned)C * 2u; oA1[i] = (i ? gi3 : gi2) * RW.ldab + (unsigned)C * 2u; }
                        else { oA0[i] = (unsigned)(nxt.pm * 256 + R) * RW.ldab + (unsigned)C * 2u; oA1[i] = (unsigned)(nxt.pm * 256 + HALF + R) * RW.ldab + (unsigned)C * 2u; } }
                    cB = nxt.B;
                }
                a2 = Abase; b2 = cB;
            } else { a2 = Abase + (size_t)(t + 2) * kstep; b2 = cB + (size_t)(t + 2) * kstep; }
            const char* a3 = a2 + kstep; const char* b3 = b2 + kstep;
            PG8_LDA(At, 0, 1); PG8_STAGE(PG8_SB(0, 0), b2, voffB); PG8_STAGE(PG8_SB(0, 1), b2 + hstepB, voffB); PG8_STAGE(PG8_SA(0, 0), a2, oA0);
            PG8_WAIT_V(8); PG8_WAIT_L(0); PG8_BAR; PG8_MMA(1, 0, At, B0); PG8_MMA(1, 1, At, B1); PG8_BAR; PG8_SCHED;
            PG8_LDB(B0, 1, 0); PG8_LDB(B1, 1, 1); PG8_SCHED; PG8_LDA(At, 1, 0); PG8_STAGE(PG8_SA(0, 1), a2, oA1);
            PG8_WAIT_V(8); PG8_WAIT_L(0); PG8_BAR; PG8_MMA(0, 0, At, B0); PG8_MMA(0, 1, At, B1); PG8_BAR; PG8_SCHED;
            PG8_LDA(At, 1, 1); PG8_STAGE(PG8_SB(1, 0), b3, voffB); PG8_STAGE(PG8_SB(1, 1), b3 + hstepB, voffB); PG8_STAGE(PG8_SA(1, 0), a3, oA0);
            PG8_WAIT_V(8); PG8_WAIT_L(0); PG8_BAR; PG8_MMA(1, 0, At, B0); PG8_MMA(1, 1, At, B1); PG8_BAR; PG8_SCHED;
        }
        if (wr == 0) PG8_BAR;
        { Unit eu = cur; asm volatile("" : "+s"(eu.pm), "+s"(eu.pn)); int t3 = threadIdx.x; asm volatile("" : "+v"(t3)); E(acc, eu, wr, wc, t3 & 15, (t3 & 63) >> 4); }
        if (!has_next) break;
#pragma unroll
        for (int a = 0; a < 2; ++a)
#pragma unroll
            for (int b = 0; b < 2; ++b)
#pragma unroll
                for (int m = 0; m < 4; ++m)
#pragma unroll
                    for (int n = 0; n < 2; ++n) acc[a][b][m][n] = (f32x4){0.f, 0.f, 0.f, 0.f};
        cur = nxt; ++ui;
        if (wr == 1) PG8_BAR;
    }
    PG8_WAIT_V(0);
    PG8_BAR;
#undef PG8_SA
#undef PG8_SB
#undef PG8_STAGE
#undef PG8_LDA
#undef PG8_LDB
#undef PG8_MMA
#undef PG8_CAT
#undef PG8_LO
#undef PG8_HI
#undef PG8_WAIT_V
#undef PG8_WAIT_L
#undef PG8_BAR
#undef PG8_SCHED
}
}

struct Params { const float* in[42]; float* out; unsigned char* ws; int ph_lo, ph_hi; };
enum { I_X = 0, I_C, I_CTX, I_CCTX, I_ADAW, I_ADAB, I_N1G, I_N2G, I_WIN, I_WOUT, I_GLAW, I_GLAB, I_GLAG, I_CDW, I_CDB, I_CLG, I_CLB, I_CPW, I_CPB,
       I_S5LR, I_S5LI, I_S5DT, I_S5BR, I_S5BI, I_S5CR, I_S5CI, I_S5D, I_S5GW, I_S5GB, I_QNG, I_KVNG, I_WUQ, I_WUKV, I_RW, I_RB, I_MG, I_MU, I_MD, I_SG, I_SU, I_SD, I_FG };

typedef const __attribute__((address_space(4))) Params* KParams;
__device__ __forceinline__ KParams fresh_params() { KParams kp = (KParams)__builtin_amdgcn_kernarg_segment_ptr(); asm volatile("" : "+s"(kp)); return kp; }
struct Ctx {
    LAS unsigned char* lds;
    int tid, lane, wave, blk, G;
    unsigned char* ws;
};

__device__ __forceinline__ int mod_row(int r) { return r < NLAT ? (r >> 11) : 32; }

__device__ __forceinline__ unsigned pk4_fp8(float a, float b, float c2, float d) {
    int pk = __builtin_amdgcn_cvt_pk_fp8_f32(__builtin_amdgcn_fmed3f(a, -440.f, 440.f), __builtin_amdgcn_fmed3f(b, -440.f, 440.f), 0, false);
    pk = __builtin_amdgcn_cvt_pk_fp8_f32(__builtin_amdgcn_fmed3f(c2, -440.f, 440.f), __builtin_amdgcn_fmed3f(d, -440.f, 440.f), pk, true); return (unsigned)pk; }
template <bool F8 = false>
__device__ __forceinline__ void tr_item(const float* W, int ldw, int k0, int n0, bf16* dst, int ldk, const float* kscale, float sc, LAS float* scr, int lane) {
    float tv[32];
#pragma unroll
    for (int i = 0; i < 32; ++i) tv[i] = W[(size_t)(k0 + 2 * i + (lane >> 5)) * ldw + n0 + (lane & 31)];
#pragma unroll
    for (int i = 0; i < 32; ++i) { const int kk = 2 * i + (lane >> 5); float v = tv[i] * sc; if (kscale) v *= kscale[k0 + kk]; scr[kk * 33 + (lane & 31)] = v; }
    lds_wait();
    const int c = lane & 7;
#pragma unroll
    for (int j = 0; j < 4; ++j) { const int n = (lane >> 3) + 8 * j; const LAS float* s = scr + (8 * c) * 33 + n;
        if (F8) { u32x2 o; o.x = pk4_fp8(s[0 * 33], s[1 * 33], s[2 * 33], s[3 * 33]); o.y = pk4_fp8(s[4 * 33], s[5 * 33], s[6 * 33], s[7 * 33]); *(u32x2*)((unsigned char*)dst + (size_t)n * ldk + k0 + 8 * c) = o; }
        else { u32x4 o; o.x = pk2(s[0 * 33], s[1 * 33]); o.y = pk2(s[2 * 33], s[3 * 33]); o.z = pk2(s[4 * 33], s[5 * 33]); o.w = pk2(s[6 * 33], s[7 * 33]);
            *(u32x4*)(dst + (size_t)n * ldk + k0 + 8 * c) = o; } }
    lds_wait();
}
template <int KIND> __device__ __forceinline__ int tr_dst(int n0) {
    if (KIND == 0) return n0;
    if (KIND == 1) return n0 < 768 ? n0 : (n0 == 768 ? 1952 : n0 - 32);
    if (KIND == 2) { const int half = n0 >> 8, c = n0 & 255; return (c >> 7) * 256 + half * 128 + (c & 127); }
    if (KIND == 3) { const int head = n0 / 96, d0 = n0 % 96; return d0 < 64 ? head * 64 + d0 : 256 + head * 32; }
    if (KIND == 4) { const int head = n0 >> 7, d0 = n0 & 127; return d0 < 64 ? head * 64 + d0 : 256 + head * 64 + (d0 - 64); }
    if (KIND == 5) return (n0 >> 7) * 256 + (n0 & 127);
    if (KIND == 6) return (n0 >> 7) * 256 + 128 + (n0 & 127);
    return n0;
}
template <int KIND, bool F8 = false> __device__ __forceinline__ void tr_matrix(const Ctx& c, const float* W, int ldw, int K, int Nsrc, bf16* WT, int ldk, const float* kscale, float sc) {
    LAS float* scr = (LAS float*)(c.lds + c.wave * 8704);
    const int gw = c.blk * NWAVES + c.wave, NGW = c.G * NWAVES, ng = Nsrc / 32, items = (K / 64) * ng;
    for (int it = gw; it < items; it += NGW) { const int kb = it / ng, g = it % ng; tr_item<F8>(W, ldw, kb * 64, 32 * g, F8 ? (bf16*)((unsigned char*)WT + (size_t)tr_dst<KIND>(32 * g) * ldk) : WT + (size_t)tr_dst<KIND>(32 * g) * ldk, ldk, kscale, sc, scr, c.lane); }
}
__device__ __forceinline__ void zero_fill16(const Ctx& c, void* p, size_t bytes) {
    u32x4* q = (u32x4*)p; const size_t n = bytes / 16;
    for (size_t i = (size_t)c.blk * NTHR + c.tid; i < n; i += (size_t)c.G * NTHR) q[i] = (u32x4){0u, 0u, 0u, 0u};
}
__device__ __forceinline__ void sincos_r(float x, float& s, float& co) {
    const float n = rintf(x * 0.15915494309189535f);
    float r = fmaf(n, -6.28125f, x); r = fmaf(n, -1.9353071795864769e-3f, r);
    s = __sinf(r); co = __cosf(r);
}

__device__ __forceinline__ void prologue_moe_weights(const Ctx& c, KParams p, int l) {
    unsigned char* WGU8 = c.ws + WS_WMOE + (size_t)l * 48 * MiB;
    unsigned char* WD8 = WGU8 + (size_t)NE * 512 * 1024;
    LAS float* scr = (LAS float*)(c.lds + c.wave * 8704);
    const int gw = c.blk * NWAVES + c.wave, NGW = c.G * NWAVES;
    for (int it = gw; it < NE * 384; it += NGW) {
        const int e = it / 384, r = it % 384;
        if (r < 256) { const int up = r >> 7, q = r & 127, kb = q >> 3, g = q & 7;
            const float* W = p->in[up ? I_MU : I_MG] + ((size_t)l * NE + e) * 1024 * 256;
            const int nd = up ? tr_dst<6>(32 * g) : tr_dst<5>(32 * g);
            tr_item<true>(W, 256, kb * 64, 32 * g, (bf16*)(WGU8 + (size_t)e * 512 * 1024 + (size_t)nd * 1024), 1024, nullptr, 64.f, scr, c.lane);
        } else { const int q = r - 256, kb = q >> 5, g = q & 31;
            const float* W = p->in[I_MD] + ((size_t)l * NE + e) * 256 * 1024;
            tr_item<true>(W, 1024, kb * 64, 32 * g, (bf16*)(WD8 + (size_t)e * 1024 * 256 + (size_t)(32 * g) * 256), 256, nullptr, 64.f, scr, c.lane);
        }
    }
}

__device__ __forceinline__ void prologue(const Ctx& c, KParams p) {
    float* MOD = (float*)(c.ws + WS_MOD);
    {
        const int u = c.G - 1 - c.blk;
        if (u < 96) {
            LAS float* sc = (LAS float*)(c.lds + 72 * 1024);
            LAS float* part = (LAS float*)c.lds;
            const int l = u / 48, kq = c.tid >> 7, cj = c.tid & 127, col = (u % 48) * 128 + cj;
            const float* W = p->in[I_ADAW] + (size_t)l * 1024 * 6144;
            float acc[33];
#pragma unroll
            for (int b = 0; b < 33; ++b) acc[b] = 0.f;
            for (int j = 0; j < 4; ++j) {
                __syncthreads();
                for (int i = c.tid; i < 4 * 33 * 64; i += NTHR) { const int q = i / (33 * 64), r = i % (33 * 64), b = r >> 6, kk = r & 63, k = 256 * q + 64 * j + kk; const float v = b < 32 ? p->in[I_C][b * 1024 + k] : p->in[I_CCTX][k]; sc[i] = siluf_(v); }
                __syncthreads();
                const float* wp = W + (size_t)(256 * kq + 64 * j) * 6144 + col; const LAS float* sq = sc + kq * 33 * 64;
#pragma unroll 8
                for (int kk = 0; kk < 64; ++kk) { const float w = wp[(size_t)kk * 6144];
#pragma unroll
                    for (int b = 0; b < 33; ++b) acc[b] = fmaf(sq[b * 64 + kk], w, acc[b]); }
            }
#pragma unroll
            for (int b = 0; b < 33; ++b) part[(kq * 33 + b) * 128 + cj] = acc[b];
            __syncthreads();
            for (int i = c.tid; i < 33 * 128; i += NTHR) { const int b = i >> 7, cc = i & 127, gc = (u % 48) * 128 + cc;
                MOD[((size_t)l * 33 + b) * 6144 + gc] = (part[(0 * 33 + b) * 128 + cc] + part[(1 * 33 + b) * 128 + cc]) + (part[(2 * 33 + b) * 128 + cc] + part[(3 * 33 + b) * 128 + cc]) + p->in[I_ADAB][l * 6144 + gc]; }
            __syncthreads();
        }
    }
    {
        float* ROPE = (float*)(c.ws + WS_TAB + TAB_ROPE);
        for (int i = c.blk * NTHR + c.tid; i < 2048 * 16; i += c.G * NTHR) { const int t = i >> 4, ax = (i >> 3) & 1, f = i & 7;
            const float pos = (float)(ax == 0 ? (t >> 6) : (t & 63)); const float inv = __expf(-(float)f * (9.210340371976184f / 8.0f));
            float s, co; sincos_r(pos * inv, s, co); ROPE[i * 2] = co; ROPE[i * 2 + 1] = s; }
        bf16* RWT = (bf16*)(c.ws + WS_TAB + TAB_RWT);
        for (int i = c.blk * NTHR + c.tid; i < 2 * 64 * 1024; i += c.G * NTHR) { const int l = i >> 16, n = (i >> 10) & 63, k = i & 1023; const float wv = p->in[I_RW][((size_t)l * 1024 + k) * 64 + n];
            const bf16 hi = f2bf(wv); RWT[(size_t)(l * 2) * 65536 + n * 1024 + k] = hi; RWT[(size_t)(l * 2 + 1) * 65536 + n * 1024 + k] = f2bf(wv - bf2f(hi)); }
        float* S5T = (float*)(c.ws + WS_TAB + TAB_S5);
        for (int i = c.blk * NTHR + c.tid; i < 2 * 2 * 16 * 64; i += c.G * NTHR) {
            const int pp = i & 63, g = (i >> 6) & 15, ld = i >> 10;
            const float lr = p->in[I_S5LR][i], li = p->in[I_S5LI][i], dt = __expf(p->in[I_S5DT][ld * 16 + g]);
            const float mag = __expf(lr * dt); float s, co; sincos_r(li * dt, s, co);
            const float are = mag * co, aim = mag * s, den = lr * lr + li * li;
            const float fre = ((are - 1.f) * lr + aim * li) / den, fim = (aim * lr - (are - 1.f) * li) / den;
            float* T = S5T + (size_t)i * 66; T[0] = are; T[1] = aim;
            { float* PW = (float*)(c.ws + WS_S5P) + (size_t)i * 34; float pr = 1.f, pi = 0.f;
              for (int e = 0; e <= 16; ++e) { PW[2 * e] = pr; PW[2 * e + 1] = pi; const float nr = pr * are - pi * aim, ni = pr * aim + pi * are; pr = nr; pi = ni; } }
            for (int ch = 0; ch < 16; ++ch) { const float br = p->in[I_S5BR][(size_t)i * 16 + ch], bi = p->in[I_S5BI][(size_t)i * 16 + ch];
                T[2 + ch] = fre * br - fim * bi; T[18 + ch] = fre * bi + fim * br;
                T[34 + ch] = p->in[I_S5CR][((size_t)(ld * 16 + g) * 16 + ch) * 64 + pp]; T[50 + ch] = p->in[I_S5CI][((size_t)(ld * 16 + g) * 16 + ch) * 64 + pp]; }
        }
    }
    for (int l = 0; l < 2; ++l) {
        bf16* WIN = (bf16*)(c.ws + WS_WIN) + (size_t)l * 2048 * 1024;
        tr_matrix<1, true>(c, p->in[I_WIN] + (size_t)l * 1024 * 1984, 1984, 1024, 1984, WIN, 1024, nullptr, 64.f);
        zero_fill16(c, (unsigned char*)WIN + (size_t)1984 * 1024, (size_t)64 * 1024);
        tr_matrix<0, true>(c, p->in[I_WOUT] + (size_t)l * 1024 * 1024, 1024, 1024, 1024, (bf16*)(c.ws + WS_WOUT) + (size_t)l * 1024 * 1024, 1024, nullptr, 64.f);
        unsigned char* sm = c.ws + WS_WSM + (size_t)l * WSM_L;
        tr_matrix<0>(c, p->in[I_CPW] + (size_t)l * 256 * 256, 256, 256, 256, (bf16*)(sm + WSM_PW), 256, nullptr, 1.f);
        tr_matrix<2>(c, p->in[I_S5GW] + (size_t)l * 256 * 512, 512, 256, 512, (bf16*)(sm + WSM_GLU), 256, nullptr, 1.f);
        tr_matrix<3>(c, p->in[I_WUQ] + (size_t)l * 256 * 384, 384, 256, 384, (bf16*)(sm + WSM_UQ), 256, p->in[I_QNG] + l * 256, 0.14724445f  );
        zero_fill16(c, (bf16*)(sm + WSM_UQ) + (size_t)384 * 256, (size_t)128 * 256 * 2);
        zero_fill16(c, sm + WSM_UK, (size_t)512 * 256 * 2);
    }
    for (int l = 0; l < 2; ++l) {
        bf16* WSGU = (bf16*)(c.ws + WS_WSH) + (size_t)l * (512 * 1024 + 1024 * 256); bf16* WSD = WSGU + 512 * 1024;
        tr_matrix<5, true>(c, p->in[I_SG] + (size_t)l * 1024 * 256, 256, 1024, 256, WSGU, 1024, nullptr, 64.f);
        tr_matrix<6, true>(c, p->in[I_SU] + (size_t)l * 1024 * 256, 256, 1024, 256, WSGU, 1024, nullptr, 64.f);
        tr_matrix<0, true>(c, p->in[I_SD] + (size_t)l * 256 * 1024, 1024, 256, 1024, (bf16*)((unsigned char*)WSGU + 512 * 1024), 256, nullptr, 64.f);
    }
    prologue_moe_weights(c, p, 0);
    prologue_moe_weights(c, p, 1);
}
__device__ __forceinline__ void prologue_s5_weights(const Ctx& c, KParams p) {
    const float* S5T = (const float*)(c.ws + WS_TAB + TAB_S5); const float* S5P = (const float*)(c.ws + WS_S5P);
    LAS float* pw = (LAS float*)c.lds;
    LAS float* bb = pw + 2 * 17 * 64 * 2;
    LAS float* cc = bb + 2 * 64 * 16 * 2;
    LAS float* kt = cc + 2 * 16 * 64 * 2;
    for (int u = c.blk; u < 32; u += c.G) {
        const int l = u >> 4, g = u & 15;
        __syncthreads();
        for (int i = c.tid; i < 2 * 64; i += NTHR) { const int dir = i >> 6, pp = i & 63; const size_t row = (size_t)((l * 2 + dir) * 16 + g) * 64 + pp; const float* T = S5T + row * 66; const float* PW = S5P + row * 34;
            for (int e = 0; e <= 16; ++e) { pw[((dir * 17 + e) * 64 + pp) * 2] = PW[2 * e]; pw[((dir * 17 + e) * 64 + pp) * 2 + 1] = PW[2 * e + 1]; }
            for (int ch = 0; ch < 16; ++ch) { bb[((dir * 64 + pp) * 16 + ch) * 2] = T[2 + ch]; bb[((dir * 64 + pp) * 16 + ch) * 2 + 1] = T[18 + ch]; cc[((dir * 16 + ch) * 64 + pp) * 2] = T[34 + ch]; cc[((dir * 16 + ch) * 64 + pp) * 2 + 1] = T[50 + ch]; } }
        __syncthreads();
        for (int i = c.tid; i < 2 * 16 * 256; i += NTHR) { const int dir = i >> 12, tau = (i >> 8) & 15, c1 = (i >> 4) & 15, c0 = i & 15; float s = 0.f;
            for (int pp = 0; pp < 64; ++pp) { const float cr = cc[((dir * 16 + c1) * 64 + pp) * 2], ci = cc[((dir * 16 + c1) * 64 + pp) * 2 + 1], pr = pw[((dir * 17 + tau) * 64 + pp) * 2], pi = pw[((dir * 17 + tau) * 64 + pp) * 2 + 1];
                const float wr_ = cr * pr - ci * pi, wi_ = cr * pi + ci * pr; s += wr_ * bb[((dir * 64 + pp) * 16 + c0) * 2] - wi_ * bb[((dir * 64 + pp) * 16 + c0) * 2 + 1]; }
            kt[i] = s; }
        __syncthreads();
        bf16* B1 = (bf16*)(c.ws + WS_S5W) + (size_t)(l * 16 + g) * 256 * 256;
        bf16* B2 = (bf16*)(c.ws + WS_S5W) + (size_t)32 * 256 * 256 + (size_t)(l * 16 + g) * 256 * 512;
        const float* dsk = p->in[I_S5D] + l * 256 + g * 16;
        for (int i = c.tid; i < 256 * 256; i += NTHR) { const int n = i >> 8, k = i & 255, dir = n >> 7, ri = (n >> 6) & 1, pp = n & 63, s = k >> 4, ch = k & 15, e = dir ? s : 15 - s;
            const float pr = pw[((dir * 17 + e) * 64 + pp) * 2], pi = pw[((dir * 17 + e) * 64 + pp) * 2 + 1], br = bb[((dir * 64 + pp) * 16 + ch) * 2], bi = bb[((dir * 64 + pp) * 16 + ch) * 2 + 1];
            B1[i] = f2bf(ri ? pr * bi + pi * br : pr * br - pi * bi); }
        for (int i = c.tid; i < 256 * 512; i += NTHR) { const int n = i >> 9, k = i & 511, t = n >> 4, c1 = n & 15; float v;
            if (k < 256) { const int s = k >> 4, c0 = k & 15; v = 0.f; if (s <= t) v += kt[((0 * 16 + (t - s)) * 16 + c1) * 16 + c0]; if (s >= t) v += kt[((1 * 16 + (s - t)) * 16 + c1) * 16 + c0]; if (s == t && c0 == c1) v += dsk[c0]; }
            else { const int q = k - 256, dir = q >> 7, ri = (q >> 6) & 1, pp = q & 63, e = dir ? 16 - t : t + 1;
                const float cr = cc[((dir * 16 + c1) * 64 + pp) * 2], ci = cc[((dir * 16 + c1) * 64 + pp) * 2 + 1], pr = pw[((dir * 17 + e) * 64 + pp) * 2], pi = pw[((dir * 17 + e) * 64 + pp) * 2 + 1];
                v = ri ? -(cr * pi + ci * pr) : (cr * pr - ci * pi); }
            B2[i] = f2bf(v); }
    }
    __syncthreads();
}
__device__ __forceinline__ void prologue2(const Ctx& c, KParams p) {
    prologue_s5_weights(c, p);
    for (int l = 0; l < 2; ++l) { unsigned char* sm = c.ws + WS_WSM + (size_t)l * WSM_L;
        tr_matrix<4>(c, p->in[I_WUKV] + (size_t)l * 128 * 512, 512, 128, 512, (bf16*)(sm + WSM_UK), 256, p->in[I_KVNG] + l * 128, 1.f); }
}

__device__ __forceinline__ void norm_row(const float* xrow, const float* gain, const float* sh, const float* sc, bf16* orow, int lane, f32x4 (&v)[4]) {
    float ss = 0.f;
#pragma unroll
    for (int j = 0; j < 4; ++j) { v[j] = *(const f32x4*)(xrow + 4 * lane + 256 * j); ss += (v[j].x * v[j].x + v[j].y * v[j].y) + (v[j].z * v[j].z + v[j].w * v[j].w); }
    const float rstd = rsqrtf(wave_sum(ss) * (1.f / 1024.f) + EPS);
#pragma unroll
    for (int j = 0; j < 4; ++j) { const int cc = 4 * lane + 256 * j; const f32x4 g = *(const f32x4*)(gain + cc), s1 = *(const f32x4*)(sc + cc), s0 = *(const f32x4*)(sh + cc);
        v[j] = v[j] * rstd * g * (s1 + 1.0f) + s0;
        u32x2 o; o.x = pk2(v[j].x, v[j].y); o.y = pk2(v[j].z, v[j].w); *(u32x2*)(orow + cc) = o; }
}
__device__ __forceinline__ void norm_row_add(const float* xrow, const bf16* drow, float* xout, const float* gain, const float* sh, const float* sc, unsigned char* orow8, int lane, f32x4 (&v)[4]) {
    float ss = 0.f; u32x2 dl[4];
#pragma unroll
    for (int j = 0; j < 4; ++j) { v[j] = *(const f32x4*)(xrow + 4 * lane + 256 * j); dl[j] = *(const u32x2*)(drow + 4 * lane + 256 * j); }
#pragma unroll
    for (int j = 0; j < 4; ++j) { v[j] += (f32x4){__uint_as_float(dl[j].x << 16), __uint_as_float(dl[j].x & 0xffff0000u), __uint_as_float(dl[j].y << 16), __uint_as_float(dl[j].y & 0xffff0000u)};
        *(f32x4*)(xout + 4 * lane + 256 * j) = v[j]; ss += (v[j].x * v[j].x + v[j].y * v[j].y) + (v[j].z * v[j].z + v[j].w * v[j].w); }
    const float rstd = rsqrtf(wave_sum(ss) * (1.f / 1024.f) + EPS);
#pragma unroll
    for (int j = 0; j < 4; ++j) { const int cc = 4 * lane + 256 * j; const f32x4 g = *(const f32x4*)(gain + cc), s1 = *(const f32x4*)(sc + cc), s0 = *(const f32x4*)(sh + cc);
        v[j] = v[j] * rstd * g * (s1 + 1.0f) + s0;
        *(unsigned*)(orow8 + cc) = pk4_fp8(v[j].x * 4.f, v[j].y * 4.f, v[j].z * 4.f, v[j].w * 4.f); }
}
__device__ __forceinline__ void phase_norm1(const Ctx& c, KParams p, int l) {
    const float* MOD = (const float*)(c.ws + WS_MOD) + (size_t)l * 33 * 6144;
    const float* xl = l == 0 ? p->in[I_X] : p->out; const float* xc = l == 0 ? p->in[I_CTX] : (const float*)(c.ws + WS_XC);
    unsigned char* H = c.ws + WS_H; const float* gain = p->in[I_N1G] + l * DM;
    const int gw = c.blk * NWAVES + c.wave, NGW = c.G * NWAVES, lane = c.lane;
    for (int r0 = gw; r0 < NTOK; r0 += 2 * NGW) {
        f32x4 v[2][4]; float ss[2];
#pragma unroll
        for (int k = 0; k < 2; ++k) { const int r = r0 + k * NGW < NTOK ? r0 + k * NGW : r0; const float* xr = r < NLAT ? xl + (size_t)r * DM : xc + (size_t)(r - NLAT) * DM;
#pragma unroll
            for (int j = 0; j < 4; ++j) v[k][j] = *(const f32x4*)(xr + 4 * lane + 256 * j); }
#pragma unroll
        for (int k = 0; k < 2; ++k) { ss[k] = 0.f;
#pragma unroll
            for (int j = 0; j < 4; ++j) ss[k] += (v[k][j].x * v[k][j].x + v[k][j].y * v[k][j].y) + (v[k][j].z * v[k][j].z + v[k][j].w * v[k][j].w); }
#pragma unroll
        for (int k = 0; k < 2; ++k) { const int r = r0 + k * NGW; if (r < NTOK) { const float rstd = rsqrtf(wave_sum(ss[k]) * (1.f / 1024.f) + EPS); const float* m = MOD + (size_t)mod_row(r) * 6144; unsigned char* orow = H + (size_t)r * DM;
#pragma unroll
            for (int j = 0; j < 4; ++j) { const int cc = 4 * lane + 256 * j; const f32x4 g = *(const f32x4*)(gain + cc), s1 = *(const f32x4*)(m + 1024 + cc), s0 = *(const f32x4*)(m + cc);
                const f32x4 y = (v[k][j] * rstd * g * (s1 + 1.0f) + s0) * 4.f; *(unsigned*)(orow + cc) = pk4_fp8(y.x, y.y, y.z, y.w); } } }
    }
}

#define EPI_ARGS const f32x4 (&acc)[2][2][4][2], const pg8::Unit& u, int wr, int wc, int fr, int fq
#define EPI_ROWS for (int ai = 0; ai < 2; ++ai) _Pragma("unroll") for (int m = 0; m < 4; ++m)
struct EpiBf16 {
    bf16* O; int ldo;
    __device__ __forceinline__ void operator()(EPI_ARGS) const {
        const int r0 = u.pm * 256 + wr * 64 + fr, c0 = u.pn * 256 + wc * 32 + 8 * fq;
#pragma unroll
        EPI_ROWS { bf16* rp = O + (size_t)(r0 + ai * 128 + m * 16) * ldo + c0;
#pragma unroll
            for (int bj = 0; bj < 2; ++bj) { const f32x4 a = acc[ai][bj][m][0], b = acc[ai][bj][m][1]; u32x4 w; w.x = pk2(a.x, a.y); w.y = pk2(a.z, a.w); w.z = pk2(b.x, b.y); w.w = pk2(b.z, b.w); *(u32x4*)(rp + bj * 128) = w; } asm volatile("" ::: "memory"); }
    }
};
struct EpiInProj {
    bf16* O; bf16* UP; bf16* GVT; float sc;
    __device__ __forceinline__ void operator()(EPI_ARGS) const {
        const int r0 = u.pm * 256 + wr * 64 + fr, c0 = u.pn * 256 + wc * 32 + 8 * fq;
#pragma unroll
        EPI_ROWS { const int row = r0 + ai * 128 + m * 16; bf16* rp = O + (size_t)row * ZW + c0;
            const int crow = row < NLAT ? (row >> 11) * 144 + 16 + ((row & 2047) >> 4) : ((row - NLAT) >> 8) * 144 + (((row - NLAT) & 255) >> 4);
#pragma unroll
            for (int bj = 0; bj < 2; ++bj) { const f32x4 a = acc[ai][bj][m][0] * sc, b = acc[ai][bj][m][1] * sc; u32x4 w; w.x = pk2(a.x, a.y); w.y = pk2(a.z, a.w); w.z = pk2(b.x, b.y); w.w = pk2(b.z, b.w);
                if (u.pn != 1 && u.pn != 5) *(u32x4*)(rp + bj * 128) = w;
                if (u.pn == 5) { const int g = 8 * bj + 2 * wc + (fq >> 1); *(u32x4*)(UP + ((size_t)g * 4608 + crow) * 512 + fr * 16 + 8 * (fq & 1)) = w; }
                if (u.pn == 1) { const int col = 128 * bj + 32 * wc + 8 * fq, bb = row < NLAT ? (row >> 11) : ((row - NLAT) >> 8), kk = row < NLAT ? 256 + (row & 2047) : ((row - NLAT) & 255);
                    bf16* dst = GVT + ((size_t)(bb * 4 + (col >> 6)) * 64 + (col & 63)) * 2304 + (kk & ~15) + 8 * ((fr >> 2) & 1) + 4 * (fr >> 3) + (fr & 3);
#pragma unroll
                    for (int n = 0; n < 2; ++n)
#pragma unroll
                        for (int i = 0; i < 4; ++i) dst[(size_t)(4 * n + i) * 2304] = f2bf(acc[ai][bj][m][n][i] * sc); } }
            asm volatile("" ::: "memory"); }
    }
};
struct EpiS5X {
    bf16* XE;
    __device__ __forceinline__ void operator()(EPI_ARGS) const {
        const int r0 = u.pm * 256 + wr * 64 + fr, c0 = wc * 32 + 8 * fq;
#pragma unroll
        EPI_ROWS { bf16* rp = XE + (size_t)(r0 + ai * 128 + m * 16) * 256 + c0;
#pragma unroll
            for (int bj = 0; bj < 2; ++bj) { const f32x4 a = acc[ai][bj][m][0], b = acc[ai][bj][m][1]; u32x4 w; w.x = pk2(a.x, a.y); w.y = pk2(a.z, a.w); w.z = pk2(b.x, b.y); w.w = pk2(b.z, b.w); *(u32x4*)(rp + bj * 128) = w; }
            asm volatile("" ::: "memory"); }
    }
};
struct EpiS5Y {
    bf16* Y;
    __device__ __forceinline__ void operator()(EPI_ARGS) const {
        const int r0 = u.pm * 256 + wr * 64 + fr;
#pragma unroll
        EPI_ROWS { const int grow = r0 + ai * 128 + m * 16; const int g = grow / 4608, rem = grow - g * 4608, b = rem / 144, ci = rem - b * 144;
            const int tok0 = ci < 16 ? NLAT + b * CTXL + ci * 16 : b * SEQ + (ci - 16) * 16;
#pragma unroll
            for (int bj = 0; bj < 2; ++bj) { const int t = 8 * bj + 2 * wc + (fq >> 1); const f32x4 a = acc[ai][bj][m][0], bq = acc[ai][bj][m][1]; u32x4 w; w.x = pk2(a.x, a.y); w.y = pk2(a.z, a.w); w.z = pk2(bq.x, bq.y); w.w = pk2(bq.z, bq.w);
                *(u32x4*)(Y + (size_t)(tok0 + t) * 256 + g * 16 + 8 * (fq & 1)) = w; }
            asm volatile("" ::: "memory"); }
    }
};
struct EpiOB8 {
    unsigned char* OB; float sc;
    __device__ __forceinline__ void operator()(EPI_ARGS) const {
        const int r0 = u.pm * 256 + wr * 64 + fr;
#pragma unroll
        EPI_ROWS { unsigned char* rp = OB + (size_t)(r0 + ai * 128 + m * 16) * 1024 + u.pn * 256 + (wc * 4 + fq) * 16; u32x4 w;
#pragma unroll
            for (int bj = 0; bj < 2; ++bj)
#pragma unroll
                for (int n = 0; n < 2; ++n) { const f32x4 a = acc[ai][bj][m][n] * sc; int pk = 0;
                    pk = __builtin_amdgcn_cvt_pk_fp8_f32(__builtin_amdgcn_fmed3f(a.x, -440.f, 440.f), __builtin_amdgcn_fmed3f(a.y, -440.f, 440.f), pk, false);
                    pk = __builtin_amdgcn_cvt_pk_fp8_f32(__builtin_amdgcn_fmed3f(a.z, -440.f, 440.f), __builtin_amdgcn_fmed3f(a.w, -440.f, 440.f), pk, true); w[2 * bj + n] = (unsigned)pk; }
            *(u32x4*)rp = w; asm volatile("" ::: "memory"); }
    }
};
struct EpiBf16S {
    bf16* O; int ldo; float sc;
    __device__ __forceinline__ void operator()(EPI_ARGS) const {
        const int r0 = u.pm * 256 + wr * 64 + fr, c0 = u.pn * 256 + wc * 32 + 8 * fq;
#pragma unroll
        EPI_ROWS { bf16* rp = O + (size_t)(r0 + ai * 128 + m * 16) * ldo + c0;
#pragma unroll
            for (int bj = 0; bj < 2; ++bj) { const f32x4 a = acc[ai][bj][m][0] * sc, b = acc[ai][bj][m][1] * sc; u32x4 w; w.x = pk2(a.x, a.y); w.y = pk2(a.z, a.w); w.z = pk2(b.x, b.y); w.w = pk2(b.z, b.w); *(u32x4*)(rp + bj * 128) = w; }
            asm volatile("" ::: "memory"); }
    }
};
struct EpiBiasBf16 {
    unsigned char* O; int ldo; const float* bias;
    __device__ __forceinline__ void operator()(EPI_ARGS) const {
        const int r0 = u.pm * 256 + wr * 64 + fr, c0 = u.pn * 256 + wc * 32 + 8 * fq;
        f32x4 bv[2][2];
#pragma unroll
        for (int bj = 0; bj < 2; ++bj) { bv[bj][0] = *(const f32x4*)(bias + c0 + bj * 128); bv[bj][1] = *(const f32x4*)(bias + c0 + bj * 128 + 4); }
        __builtin_amdgcn_s_waitcnt(0x0F70);
#pragma unroll
        EPI_ROWS { unsigned char* rp = O + (size_t)(r0 + ai * 128 + m * 16) * ldo + c0;
#pragma unroll
            for (int bj = 0; bj < 2; ++bj) { const f32x4 a = (acc[ai][bj][m][0] + bv[bj][0]) * 16.f, b = (acc[ai][bj][m][1] + bv[bj][1]) * 16.f; u32x2 w; w.x = pk4_fp8(a.x, a.y, a.z, a.w); w.y = pk4_fp8(b.x, b.y, b.z, b.w); *(u32x2*)(rp + bj * 128) = w; } asm volatile("" ::: "memory"); }
    }
};
struct EpiGluSig {
    unsigned char* O; int ldo; const float* bias;
    __device__ __forceinline__ void operator()(EPI_ARGS) const {
        const int r0 = u.pm * 256 + wr * 64 + fr, c0 = u.pn * 128 + wc * 32 + 8 * fq;
        f32x4 b1[2], b2[2];
#pragma unroll
        for (int n = 0; n < 2; ++n) { b1[n] = *(const f32x4*)(bias + c0 + 4 * n); b2[n] = *(const f32x4*)(bias + 256 + c0 + 4 * n); }
        __builtin_amdgcn_s_waitcnt(0x0F70);
#pragma unroll
        EPI_ROWS { unsigned char* rp = O + (size_t)(r0 + ai * 128 + m * 16) * ldo + c0; float o[8];
#pragma unroll
            for (int n = 0; n < 2; ++n)
#pragma unroll
                for (int i = 0; i < 4; ++i) o[4 * n + i] = (acc[ai][0][m][n][i] + b1[n][i]) * (16.f * sigmoidf_(acc[ai][1][m][n][i] + b2[n][i]));
            u32x2 w; w.x = pk4_fp8(o[0], o[1], o[2], o[3]); w.y = pk4_fp8(o[4], o[5], o[6], o[7]); *(u32x2*)rp = w; asm volatile("" ::: "memory"); }
    }
};
struct EpiSwiglu {
    unsigned char* O; int ldo; float sc;
    __device__ __forceinline__ void operator()(EPI_ARGS) const {
        const int r0 = u.pm * 256 + wr * 64 + fr, c0 = u.pn * 128 + wc * 32 + 8 * fq;
#pragma unroll
        EPI_ROWS { unsigned char* rp = O + (size_t)(r0 + ai * 128 + m * 16) * ldo + c0; float o[8];
#pragma unroll
            for (int n = 0; n < 2; ++n)
#pragma unroll
                for (int i = 0; i < 4; ++i) o[4 * n + i] = siluf_(acc[ai][0][m][n][i] * sc) * (acc[ai][1][m][n][i] * (sc * 16.0f));
            u32x2 w; w.x = pk4_fp8(o[0], o[1], o[2], o[3]); w.y = pk4_fp8(o[4], o[5], o[6], o[7]); *(u32x2*)rp = w; asm volatile("" ::: "memory"); }
    }
};
struct EpiQ {
    bf16* Q; const float* RS;
    __device__ __forceinline__ void operator()(EPI_ARGS) const {
        const int r0 = u.pm * 256 + wr * 64 + fr; float rq[8];
#pragma unroll
        for (int g = 0; g < 8; ++g) rq[g] = RS[(size_t)(r0 + (g >> 2) * 128 + (g & 3) * 16) * 2];
        __builtin_amdgcn_s_waitcnt(0x0F70);
#pragma unroll
        EPI_ROWS { const int row = r0 + ai * 128 + m * 16; const float rs = rq[ai * 4 + m]; bf16* rp = Q + (size_t)row * 384;
            if (u.pn == 0) {
#pragma unroll
                for (int bj = 0; bj < 2; ++bj) { const int head = 2 * bj + (wc >> 1), d = 32 * (wc & 1) + 8 * fq; const f32x4 a = acc[ai][bj][m][0] * rs, b = acc[ai][bj][m][1] * rs;
                    u32x4 w; w.x = pk2(a.x, a.y); w.y = pk2(a.z, a.w); w.z = pk2(b.x, b.y); w.w = pk2(b.z, b.w); *(u32x4*)(rp + head * 96 + d) = w; }
            } else { const f32x4 a = acc[ai][0][m][0] * rs, b = acc[ai][0][m][1] * rs;
                u32x4 w; w.x = pk2(a.x, a.y); w.y = pk2(a.z, a.w); w.z = pk2(b.x, b.y); w.w = pk2(b.z, b.w); *(u32x4*)(rp + wc * 96 + 64 + 8 * fq) = w; }
            asm volatile("" ::: "memory"); }
    }
};
struct EpiKV {
    bf16* Kb; bf16* VT; const float* RS;
    __device__ __forceinline__ void operator()(EPI_ARGS) const {
        const int r0 = u.pm * 256 + wr * 64 + fr;
        const int p16 = 8 * ((fr >> 2) & 1) + 4 * (fr >> 3) + (fr & 3); float rkv[8];
#pragma unroll
        for (int g = 0; g < 8; ++g) rkv[g] = RS[(size_t)(r0 + (g >> 2) * 128 + (g & 3) * 16) * 2 + 1];
        __builtin_amdgcn_s_waitcnt(0x0F70);
#pragma unroll
        EPI_ROWS { const int row = r0 + ai * 128 + m * 16; const float rk = rkv[ai * 4 + m];
            if (u.pn == 0) {
#pragma unroll
                for (int bj = 0; bj < 2; ++bj) { const int head = 2 * bj + (wc >> 1), d = 32 * (wc & 1) + 8 * fq; const f32x4 a = acc[ai][bj][m][0] * rk, b = acc[ai][bj][m][1] * rk;
                    u32x4 w; w.x = pk2(a.x, a.y); w.y = pk2(a.z, a.w); w.z = pk2(b.x, b.y); w.w = pk2(b.z, b.w);
                    *(u32x4*)(Kb + (size_t)row * 384 + head * 96 + d) = w; }
            } else {
                const int bb = row < NLAT ? (row >> 11) : ((row - NLAT) >> 8); const int kk = row < NLAT ? (row & 2047) : 2048 + ((row - NLAT) & 255);
                const int pos = (kk & ~15) + p16;
#pragma unroll
                for (int bj = 0; bj < 2; ++bj) { const int head = 2 * bj + (wc >> 1), d = 32 * (wc & 1) + 8 * fq; bf16* dst = VT + ((size_t)((bb * 4 + head) * 64 + d)) * 2304 + pos;
#pragma unroll
                    for (int n = 0; n < 2; ++n)
#pragma unroll
                        for (int i = 0; i < 4; ++i) dst[(size_t)(4 * n + i) * 2304] = f2bf(acc[ai][bj][m][n][i] * rk); }
            }
            asm volatile("" ::: "memory"); }
    }
};
struct EpiDelta {
    bf16* D; const float* MODg; float sc;
    __device__ __forceinline__ void operator()(EPI_ARGS) const {
        const int rt = u.pm * 256; const float* g = MODg + (size_t)(rt < NLAT ? (rt >> 11) : 32) * 6144;
        const int r0 = rt + wr * 64 + fr, c0 = u.pn * 256 + wc * 32 + 8 * fq;
        f32x4 gv[2][2];
#pragma unroll
        for (int bj = 0; bj < 2; ++bj) { gv[bj][0] = *(const f32x4*)(g + c0 + bj * 128) * sc; gv[bj][1] = *(const f32x4*)(g + c0 + bj * 128 + 4) * sc; }
        __builtin_amdgcn_s_waitcnt(0x0F70);
#pragma unroll
        EPI_ROWS { bf16* rp = D + (size_t)(r0 + ai * 128 + m * 16) * DM + c0;
#pragma unroll
            for (int bj = 0; bj < 2; ++bj) { const f32x4 a = gv[bj][0] * acc[ai][bj][m][0], b = gv[bj][1] * acc[ai][bj][m][1]; u32x4 w; w.x = pk2(a.x, a.y); w.y = pk2(a.z, a.w); w.z = pk2(b.x, b.y); w.w = pk2(b.z, b.w); *(u32x4*)(rp + bj * 128) = w; }
            asm volatile("" ::: "memory"); }
    }
};

__device__ __forceinline__ int seq_row(int b, int dir, int pos) {
    if (pos < CTXL) return NLAT + b * CTXL + (dir ? CTXL - 1 - pos : pos);
    const int t = pos - CTXL; return b * SEQ + (dir ? SEQ - 1 - t : t);
}
__device__ __forceinline__ void phase_gla(const Ctx& c, KParams p, int l) {
    const bf16* Z = (const bf16*)(c.ws + WS_Z); const bf16* GVT = (const bf16*)(c.ws + WS_GVT); bf16* OG = (bf16*)(c.ws + WS_T1);
    const int w = c.wave, tid = c.tid;
    LAS float* wtab = (LAS float*)c.lds;
    LAS float* DD = (LAS float*)(c.lds + 4096);
    LAS unsigned char* RW = c.lds + 8192 + w * 13824;
    LAS float* LA = (LAS float*)RW;
    LAS unsigned char* KTT = RW + 9216;
    for (int u = c.blk; u < 256; u += c.G) {
        const int b = u >> 3, h = (u >> 1) & 3, dir = u & 1;
        __syncthreads();
        { const float* wa = p->in[I_GLAW] + ((size_t)(l * 2 + dir) * 16) * 128 + h * 32; wtab[tid] = wa[(tid >> 5) * 128 + (tid & 31)]; if (tid < 32) wtab[512 + tid] = p->in[I_GLAB][(l * 2 + dir) * 128 + h * 32 + tid]; }
        float Sst[4] = {0.f, 0.f, 0.f, 0.f};
        __syncthreads();
        for (int gi = 0; gi < 5; ++gi) {
            const int pc = gi * 8 + w; const bool active = pc < 36;
            int lane_ = c.lane; asm volatile("" : "+v"(lane_));
            const int r = lane_ & 31, hh = lane_ >> 5;
            const int p16 = 8 * ((r >> 2) & 1) + 4 * ((r & 15) >> 3) + (r & 3);
            const int pos0 = (r & 16) + p16, pos1 = 32 + pos0;
            bf16x8 qd[2][2]; f32x16 oacc[2][2]; int row0 = 0;
            if (active) {
                int kk0;
                if (dir == 0) { if (pc < 4) { row0 = NLAT + b * CTXL + pc * 64; kk0 = pc * 64; } else { row0 = b * SEQ + (pc - 4) * 64; kk0 = 256 + (pc - 4) * 64; } }
                else { if (pc < 4) { row0 = NLAT + b * CTXL + (3 - pc) * 64; kk0 = (3 - pc) * 64; } else { row0 = b * SEQ + (35 - pc) * 64; kk0 = 256 + (35 - pc) * 64; } }
#pragma unroll
                for (int ib = 0; ib < 2; ++ib) { const bf16* zr = Z + (size_t)(row0 + 32 * ib + r) * ZW; float al[16]; { const u32x4 a0 = *(const u32x4*)(zr + ZAF + dir * 16), a1 = *(const u32x4*)(zr + ZAF + dir * 16 + 8); float t8[8]; unpack8(a0, t8);
#pragma unroll
                        for (int j = 0; j < 8; ++j) al[j] = t8[j];
                        unpack8(a1, t8);
#pragma unroll
                        for (int j = 0; j < 8; ++j) al[8 + j] = t8[j]; }
#pragma unroll
                    for (int ks = 0; ks < 2; ++ks) { float za[8]; { const f32x4 b0 = *(const LAS f32x4*)(wtab + 512 + 16 * ks + 8 * hh), b1 = *(const LAS f32x4*)(wtab + 512 + 16 * ks + 8 * hh + 4);
                            za[0] = b0.x; za[1] = b0.y; za[2] = b0.z; za[3] = b0.w; za[4] = b1.x; za[5] = b1.y; za[6] = b1.z; za[7] = b1.w; }
#pragma unroll
                        for (int j = 0; j < 16; ++j) { const f32x4 w0 = *(const LAS f32x4*)(wtab + j * 32 + 16 * ks + 8 * hh), w1 = *(const LAS f32x4*)(wtab + j * 32 + 16 * ks + 8 * hh + 4);
                            za[0] = fmaf(al[j], w0.x, za[0]); za[1] = fmaf(al[j], w0.y, za[1]); za[2] = fmaf(al[j], w0.z, za[2]); za[3] = fmaf(al[j], w0.w, za[3]);
                            za[4] = fmaf(al[j], w1.x, za[4]); za[5] = fmaf(al[j], w1.y, za[5]); za[6] = fmaf(al[j], w1.z, za[6]); za[7] = fmaf(al[j], w1.w, za[7]); }
                        float la[8];
#pragma unroll
                        for (int e = 0; e < 8; ++e) la[e] = (fminf(za[e], 0.f) - __logf(1.f + __expf(-fabsf(za[e])))) * 0.0625f;
                        *(LAS f32x4*)(LA + (32 * ib + r) * 36 + 16 * ks + 8 * hh) = (f32x4){la[0], la[1], la[2], la[3]}; *(LAS f32x4*)(LA + (32 * ib + r) * 36 + 16 * ks + 8 * hh + 4) = (f32x4){la[4], la[5], la[6], la[7]}; } }
                lds_wait();
                u32x4 qraw[2][2], kraw[2][2];
#pragma unroll
                for (int ib = 0; ib < 2; ++ib) { const bf16* zr = Z + (size_t)(row0 + 32 * ib + r) * ZW;
#pragma unroll
                    for (int ks = 0; ks < 2; ++ks) { qraw[ib][ks] = *(const u32x4*)(zr + ZQ + h * 32 + 16 * ks + 8 * hh); kraw[ib][ks] = *(const u32x4*)(zr + ZK + h * 32 + 16 * ks + 8 * hh); } }
                { float bend; float v[32], s = 0.f;
#pragma unroll
                  for (int qq = 0; qq < 32; ++qq) { const int q = 32 * hh + qq, i = dir ? 63 - q : q; v[qq] = LA[i * 36 + r]; s += v[qq]; }
                  const auto sw = __builtin_amdgcn_permlane32_swap(__float_as_uint(s), __float_as_uint(s), false, false);
                  const float h0 = __uint_as_float(sw[0]), h1 = __uint_as_float(sw[1]); bend = h0 + h1;
                  float run = hh ? h0 : 0.f;
#pragma unroll
                  for (int qq = 0; qq < 32; ++qq) { const int q = 32 * hh + qq, i = dir ? 63 - q : q; run += v[qq]; LA[i * 36 + r] = run; }
                  if (hh == 0) DD[w * 32 + r] = __expf(bend); }
                lds_wait();
                bf16x8 vt[2][4];
#pragma unroll
                for (int db = 0; db < 2; ++db)
#pragma unroll
                    for (int s4 = 0; s4 < 4; ++s4) vt[db][s4] = *(const bf16x8*)(GVT + ((size_t)(b * 4 + h) * 64 + 32 * db + r) * 2304 + kk0 + 16 * s4 + 8 * hh);
                bf16x8 ki[2][2];
#pragma unroll
                for (int ib = 0; ib < 2; ++ib) {
#pragma unroll
                    for (int ks = 0; ks < 2; ++ks) { const int dk0 = 16 * ks + 8 * hh; float q8[8], k8[8], b8[8]; unpack8(qraw[ib][ks], q8); unpack8(kraw[ib][ks], k8);
                        { const f32x4 x0 = *(const LAS f32x4*)(LA + (32 * ib + r) * 36 + dk0), x1 = *(const LAS f32x4*)(LA + (32 * ib + r) * 36 + dk0 + 4); b8[0] = x0.x; b8[1] = x0.y; b8[2] = x0.z; b8[3] = x0.w; b8[4] = x1.x; b8[5] = x1.y; b8[6] = x1.z; b8[7] = x1.w; }
                        float qo[8], ko[8];
#pragma unroll
                        for (int e = 0; e < 8; ++e) { const float eb = __expf(b8[e]), ieb = 1.f / eb; qo[e] = q8[e] * 0.17677669529663687f * eb; ko[e] = k8[e] * ieb;
                            *(LAS bf16*)(KTT + ((dk0 + e) * 72 + (ib ? pos1 : pos0)) * 2) = f2bf(ko[e] * DD[w * 32 + dk0 + e]); }
                        u32x4 wq, wk; wq.x = pk2(qo[0], qo[1]); wq.y = pk2(qo[2], qo[3]); wq.z = pk2(qo[4], qo[5]); wq.w = pk2(qo[6], qo[7]); wk.x = pk2(ko[0], ko[1]); wk.y = pk2(ko[2], ko[3]); wk.z = pk2(ko[4], ko[5]); wk.w = pk2(ko[6], ko[7]);
                        qd[ib][ks] = __builtin_bit_cast(bf16x8, wq); ki[ib][ks] = __builtin_bit_cast(bf16x8, wk); } }
                f32x16 zero16;
#pragma unroll
                for (int i = 0; i < 16; ++i) zero16[i] = 0.f;
                f32x16 a00 = __builtin_amdgcn_mfma_f32_32x32x16_bf16(ki[0][0], qd[0][0], zero16, 0, 0, 0); a00 = __builtin_amdgcn_mfma_f32_32x32x16_bf16(ki[0][1], qd[0][1], a00, 0, 0, 0);
                f32x16 a11 = __builtin_amdgcn_mfma_f32_32x32x16_bf16(ki[1][0], qd[1][0], zero16, 0, 0, 0); a11 = __builtin_amdgcn_mfma_f32_32x32x16_bf16(ki[1][1], qd[1][1], a11, 0, 0, 0);
                f32x16 aof;
                if (dir == 0) { aof = __builtin_amdgcn_mfma_f32_32x32x16_bf16(ki[0][0], qd[1][0], zero16, 0, 0, 0); aof = __builtin_amdgcn_mfma_f32_32x32x16_bf16(ki[0][1], qd[1][1], aof, 0, 0, 0); }
                else { aof = __builtin_amdgcn_mfma_f32_32x32x16_bf16(ki[1][0], qd[0][0], zero16, 0, 0, 0); aof = __builtin_amdgcn_mfma_f32_32x32x16_bf16(ki[1][1], qd[0][1], aof, 0, 0, 0); }
#pragma unroll
                for (int i = 0; i < 16; ++i) { const int j = (i & 3) + 8 * (i >> 2) + 4 * hh; const bool keep = dir ? (j >= r) : (j <= r); a00[i] = keep ? a00[i] : 0.f; a11[i] = keep ? a11[i] : 0.f; }
#define GLA_P(X, s) ({ u32x4 w_; w_.x = pk2((X)[8 * (s)], (X)[8 * (s) + 1]); w_.y = pk2((X)[8 * (s) + 2], (X)[8 * (s) + 3]); w_.z = pk2((X)[8 * (s) + 4], (X)[8 * (s) + 5]); w_.w = pk2((X)[8 * (s) + 6], (X)[8 * (s) + 7]); __builtin_bit_cast(bf16x8, w_); })
                const bf16x8 p00a = GLA_P(a00, 0), p00b = GLA_P(a00, 1), p11a = GLA_P(a11, 0), p11b = GLA_P(a11, 1), pofa = GLA_P(aof, 0), pofb = GLA_P(aof, 1);
#pragma unroll
                for (int db = 0; db < 2; ++db) {
                    f32x16 o0 = __builtin_amdgcn_mfma_f32_32x32x16_bf16(vt[db][0], p00a, zero16, 0, 0, 0); o0 = __builtin_amdgcn_mfma_f32_32x32x16_bf16(vt[db][1], p00b, o0, 0, 0, 0);
                    f32x16 o1 = __builtin_amdgcn_mfma_f32_32x32x16_bf16(vt[db][2], p11a, zero16, 0, 0, 0); o1 = __builtin_amdgcn_mfma_f32_32x32x16_bf16(vt[db][3], p11b, o1, 0, 0, 0);
                    if (dir == 0) { o1 = __builtin_amdgcn_mfma_f32_32x32x16_bf16(vt[db][0], pofa, o1, 0, 0, 0); o1 = __builtin_amdgcn_mfma_f32_32x32x16_bf16(vt[db][1], pofb, o1, 0, 0, 0); }
                    else { o0 = __builtin_amdgcn_mfma_f32_32x32x16_bf16(vt[db][2], pofa, o0, 0, 0, 0); o0 = __builtin_amdgcn_mfma_f32_32x32x16_bf16(vt[db][3], pofb, o0, 0, 0, 0); }
                    oacc[db][0] = o0; oacc[db][1] = o1; }
#undef GLA_P
                lds_wait();
                bf16x8 kf[4];
#pragma unroll
                for (int s4 = 0; s4 < 4; ++s4) kf[s4] = *(const LAS bf16x8*)(KTT + (r * 72 + 16 * s4 + 8 * hh) * 2);
#pragma unroll
                for (int db = 0; db < 2; ++db) { f32x16 uu = __builtin_amdgcn_mfma_f32_32x32x16_bf16(vt[db][0], kf[0], zero16, 0, 0, 0);
#pragma unroll
                    for (int s4 = 1; s4 < 4; ++s4) uu = __builtin_amdgcn_mfma_f32_32x32x16_bf16(vt[db][s4], kf[s4], uu, 0, 0, 0);
#pragma unroll
                    for (int i = 0; i < 16; ++i) LA[(32 * db + (i & 3) + 8 * (i >> 2) + 4 * hh) * 32 + r] = uu[i]; }
            }
            __syncthreads();
            const int dv2 = tid >> 3, dk4 = (tid & 7) * 4;
            f32x4 ur[8], dr[8];
#pragma unroll
            for (int cc = 0; cc < 8; ++cc) { ur[cc] = *(const LAS f32x4*)((LAS float*)(c.lds + 8192 + cc * 13824) + dv2 * 32 + dk4); dr[cc] = *(const LAS f32x4*)(DD + cc * 32 + dk4); }
            __syncthreads();
#pragma unroll
            for (int cc = 0; cc < 8; ++cc) if (gi * 8 + cc < 36) { u32x2 sp; sp.x = pk2(Sst[0], Sst[1]); sp.y = pk2(Sst[2], Sst[3]); *(LAS u32x2*)(c.lds + 8192 + cc * 13824 + (dv2 * 40 + dk4) * 2) = sp;
                Sst[0] = fmaf(dr[cc].x, Sst[0], ur[cc].x); Sst[1] = fmaf(dr[cc].y, Sst[1], ur[cc].y); Sst[2] = fmaf(dr[cc].z, Sst[2], ur[cc].z); Sst[3] = fmaf(dr[cc].w, Sst[3], ur[cc].w); }
            __syncthreads();
            if (active) {
#pragma unroll
                for (int db = 0; db < 2; ++db) { const bf16x8 s0 = *(const LAS bf16x8*)(RW + ((32 * db + r) * 40 + 8 * hh) * 2), s1 = *(const LAS bf16x8*)(RW + ((32 * db + r) * 40 + 16 + 8 * hh) * 2);
#pragma unroll
                    for (int ib = 0; ib < 2; ++ib) { oacc[db][ib] = __builtin_amdgcn_mfma_f32_32x32x16_bf16(s0, qd[ib][0], oacc[db][ib], 0, 0, 0); oacc[db][ib] = __builtin_amdgcn_mfma_f32_32x32x16_bf16(s1, qd[ib][1], oacc[db][ib], 0, 0, 0); } }
#pragma unroll
                for (int ib = 0; ib < 2; ++ib) { bf16* orow = OG + ((size_t)dir * NTOK + row0 + 32 * ib + r) * 256 + h * 64 + 4 * hh;
#pragma unroll
                    for (int db = 0; db < 2; ++db)
#pragma unroll
                        for (int g4 = 0; g4 < 4; ++g4) { u32x2 wv; wv.x = pk2(oacc[db][ib][4 * g4], oacc[db][ib][4 * g4 + 1]); wv.y = pk2(oacc[db][ib][4 * g4 + 2], oacc[db][ib][4 * g4 + 3]); *(u32x2*)(orow + 32 * db + 8 * g4) = wv; } }
                lds_wait();
            }
        }
    }
    __syncthreads();
}
__device__ __forceinline__ void phase_gla_final(const Ctx& c, KParams p, int l, int nrows) {
    const bf16* Z = (const bf16*)(c.ws + WS_Z); const bf16* OG = (const bf16*)(c.ws + WS_T1); unsigned char* MIX = c.ws + WS_MIX;
    const int gw = c.blk * NWAVES + c.wave, NGW = c.G * NWAVES; const f32x4 g = *(const f32x4*)(p->in[I_GLAG] + l * 256 + 4 * c.lane);
    for (int r0 = gw; r0 < nrows; r0 += 4 * NGW) {
        u32x2 of[4], ob[4], rg[4];
#pragma unroll
        for (int k = 0; k < 4; ++k) { const int r = r0 + k * NGW; of[k] = ob[k] = rg[k] = (u32x2){0u, 0u};
            if (r < nrows) { of[k] = *(const u32x2*)(OG + (size_t)r * 256 + 4 * c.lane); ob[k] = *(const u32x2*)(OG + ((size_t)NTOK + r) * 256 + 4 * c.lane); rg[k] = *(const u32x2*)(Z + (size_t)r * ZW + ZR + 4 * c.lane); } }
#pragma unroll
        for (int k = 0; k < 4; ++k) { const int r = r0 + k * NGW;
            f32x4 o = (f32x4){__uint_as_float(of[k].x << 16) + __uint_as_float(ob[k].x << 16), __uint_as_float(of[k].x & 0xffff0000u) + __uint_as_float(ob[k].x & 0xffff0000u),
                              __uint_as_float(of[k].y << 16) + __uint_as_float(ob[k].y << 16), __uint_as_float(of[k].y & 0xffff0000u) + __uint_as_float(ob[k].y & 0xffff0000u)};
            float ss = (o.x * o.x + o.y * o.y) + (o.z * o.z + o.w * o.w);
            ss += shx<1>(ss); ss += shx<2>(ss); ss += shx<4>(ss); ss += shx<8>(ss);
            const float rstd = rsqrtf(ss * (1.f / 64.f) + EPS);
            const float g0 = __uint_as_float(rg[k].x << 16), g1 = __uint_as_float(rg[k].x & 0xffff0000u), g2 = __uint_as_float(rg[k].y << 16), g3 = __uint_as_float(rg[k].y & 0xffff0000u);
            const float r16 = rstd * 16.f; const unsigned w = pk4_fp8(o.x * r16 * g.x * siluf_(g0), o.y * r16 * g.y * siluf_(g1), o.z * r16 * g.z * siluf_(g2), o.w * r16 * g.w * siluf_(g3));
            if (r < nrows) *(unsigned*)(MIX + (size_t)r * DM + 4 * c.lane) = w; }
    }
}

__device__ __forceinline__ void phase_conv1(const Ctx& c, KParams p, int l, bool with_ctx) {
    const bf16* Z = (const bf16*)(c.ws + WS_Z); bf16* CV = (bf16*)(c.ws + WS_CV);
    constexpr int TT = 64, HR = TT + 30;
    LAS float* glu = (LAS float*)c.lds;
    f32x4 wj[31];
#pragma unroll
    for (int j = 0; j < 31; ++j) wj[j] = *(const f32x4*)(p->in[I_CDW] + ((size_t)l * 31 + j) * 256 + 4 * c.lane);
    const int ntiles = with_ctx ? 1024 + 128 : 1024;
    const f32x4 dwb = *(const f32x4*)(p->in[I_CDB] + l * 256 + 4 * c.lane), lg = *(const f32x4*)(p->in[I_CLG] + l * 256 + 4 * c.lane), lb = *(const f32x4*)(p->in[I_CLB] + l * 256 + 4 * c.lane);
    for (int tile = c.blk; tile < ntiles; tile += c.G) {
        int rowbase, t0, slen;
        if (tile < 1024) { const int b = tile >> 5; rowbase = b * SEQ; t0 = (tile & 31) * TT; slen = SEQ; } else { const int q = tile - 1024, b = q >> 2; rowbase = NLAT + b * CTXL; t0 = (q & 3) * TT; slen = CTXL; }
        __syncthreads();
        u32x2 ra[12], rg[12];
#pragma unroll
        for (int k = 0; k < 12; ++k) { const int idx = c.tid + k * NTHR, j = idx >> 6, c4 = (idx & 63) * 4, t = t0 - 15 + j; ra[k] = (u32x2){0u, 0u}; rg[k] = (u32x2){0u, 0u};
            if (idx < HR * 64 && t >= 0 && t < slen) { const bf16* zr = Z + (size_t)(rowbase + t) * ZW; ra[k] = *(const u32x2*)(zr + ZCA + c4); rg[k] = *(const u32x2*)(zr + ZCG + c4); } }
#pragma unroll
        for (int k = 0; k < 12; ++k) { const int idx = c.tid + k * NTHR, j = idx >> 6, c4 = (idx & 63) * 4; f32x4 v;
            v.x = __uint_as_float(ra[k].x << 16) * sigmoidf_(__uint_as_float(rg[k].x << 16)); v.y = __uint_as_float(ra[k].x & 0xffff0000u) * sigmoidf_(__uint_as_float(rg[k].x & 0xffff0000u));
            v.z = __uint_as_float(ra[k].y << 16) * sigmoidf_(__uint_as_float(rg[k].y << 16)); v.w = __uint_as_float(ra[k].y & 0xffff0000u) * sigmoidf_(__uint_as_float(rg[k].y & 0xffff0000u));
            if (idx < HR * 64) *(LAS f32x4*)(glu + j * 256 + c4) = v; }
        __syncthreads();
        f32x4 acc8[8];
#pragma unroll
        for (int q = 0; q < 8; ++q) acc8[q] = dwb;
#pragma unroll
        for (int r = 0; r < 38; ++r) { const f32x4 x = *(const LAS f32x4*)(glu + (c.wave * 8 + r) * 256 + 4 * c.lane);
#pragma unroll
            for (int q = 0; q < 8; ++q) if (r - q >= 0 && r - q < 31) acc8[q] += x * wj[r - q]; }
#pragma unroll
        for (int q = 0; q < 8; ++q) { const int i = c.wave * 8 + q; const f32x4 a = acc8[q];
            const float mu = wave_sum((a.x + a.y) + (a.z + a.w)) * (1.f / 256.f); const f32x4 dlt = a - mu;
            const float var = wave_sum((dlt.x * dlt.x + dlt.y * dlt.y) + (dlt.z * dlt.z + dlt.w * dlt.w)) * (1.f / 256.f); const float rstd = rsqrtf(var + EPS);
            const f32x4 y = dlt * rstd * lg + lb;
            u32x2 w; w.x = pk2(siluf_(y.x), siluf_(y.y)); w.y = pk2(siluf_(y.z), siluf_(y.w));
            *(u32x2*)(CV + (size_t)(rowbase + t0 + i) * 256 + 4 * c.lane) = w; }
    }
    __syncthreads();
}

__device__ __forceinline__ void phase_s5_carry(const Ctx& c, int l) {
    const bf16* XE = (const bf16*)(c.ws + WS_Y5); bf16* UP = (bf16*)(c.ws + WS_UP); const float* S5P = (const float*)(c.ws + WS_S5P);
    for (int i = c.blk * NTHR + c.tid; i < NB * 2 * 16 * 64; i += c.G * NTHR) {
        const int pp = i & 63, g = (i >> 6) & 15, dir = (i >> 10) & 1, b = i >> 11;
        const float* PW = S5P + ((size_t)((l * 2 + dir) * 16 + g) * 64 + pp) * 34 + 32; const float ar = PW[0], ai = PW[1];
        const size_t rbase = (size_t)g * 4608 + (size_t)b * 144; float xr = 0.f, xi = 0.f;
        float er[16], ei[16], fr_[16], fi_[16];
        auto chunk_of = [&](int s) { return dir == 0 ? s : (s < 16 ? 15 - s : 159 - s); };
#pragma unroll
        for (int q = 0; q < 16; ++q) { const bf16* xe = XE + (rbase + chunk_of(q)) * 256 + dir * 128 + pp; er[q] = bf2f(xe[0]); ei[q] = bf2f(xe[64]); }
#pragma unroll 1
        for (int s0 = 0; s0 < 144; s0 += 16) {
            if (s0 + 16 < 144) {
#pragma unroll
                for (int q = 0; q < 16; ++q) { const bf16* xe = XE + (rbase + chunk_of(s0 + 16 + q)) * 256 + dir * 128 + pp; fr_[q] = bf2f(xe[0]); fi_[q] = bf2f(xe[64]); } }
#pragma unroll
            for (int q = 0; q < 16; ++q) { bf16* up = UP + (rbase + chunk_of(s0 + q)) * 512 + 256 + dir * 128 + pp; up[0] = f2bf(xr); up[64] = f2bf(xi);
                const float nr = ar * xr - ai * xi + er[q], ni = ar * xi + ai * xr + ei[q]; xr = nr; xi = ni; }
            if (s0 + 16 < 144) {
#pragma unroll
                for (int q = 0; q < 16; ++q) { er[q] = fr_[q]; ei[q] = fi_[q]; } }
        }
    }
}

__device__ __forceinline__ void phase_mla_prep(const Ctx& c, KParams p) {
    const bf16* Z = (const bf16*)(c.ws + WS_Z); float* RS = (float*)(c.ws + WS_RS); bf16* Kb = (bf16*)(c.ws + WS_H) + (size_t)NTOK * 384; const float* ROPE = (const float*)(c.ws + WS_TAB + TAB_ROPE);
    const int gw = c.blk * NWAVES + c.wave, NGW = c.G * NWAVES, lane = c.lane, d = lane & 31;
    for (int r0 = gw; r0 < NTOK; r0 += 4 * NGW) {
        u32x2 q4[4]; unsigned k2[4]; bf16 xr[4]; f32x2 cs[4];
#pragma unroll
        for (int k = 0; k < 4; ++k) { const int r = r0 + k * NGW; q4[k] = (u32x2){0u, 0u}; k2[k] = 0u; xr[k] = 0; cs[k] = (f32x2){1.f, 0.f};
            if (r < NTOK) { const bf16* zr = Z + (size_t)r * ZW; q4[k] = *(const u32x2*)(zr + ZCQ + 4 * lane); k2[k] = *(const unsigned*)(zr + ZCKV + 2 * lane); xr[k] = zr[ZKR + d];
                if (r < NLAT) cs[k] = *(const f32x2*)(ROPE + (((r & 2047) * 2 + (d >> 4)) * 8 + (d & 7)) * 2); } }
#pragma unroll
        for (int k = 0; k < 4; ++k) { const int r = r0 + k * NGW;
            const float a0 = __uint_as_float(q4[k].x << 16), a1 = __uint_as_float(q4[k].x & 0xffff0000u), a2 = __uint_as_float(q4[k].y << 16), a3 = __uint_as_float(q4[k].y & 0xffff0000u);
            const float b0 = __uint_as_float(k2[k] << 16), b1 = __uint_as_float(k2[k] & 0xffff0000u);
            const float sq = wave_sum((a0 * a0 + a1 * a1) + (a2 * a2 + a3 * a3)), sk = wave_sum(b0 * b0 + b1 * b1);
            const float x = bf2f(xr[k]); const float px = shx<8>(x);
            const float o = (d & 8) ? fmaf(x, cs[k].x, px * cs[k].y) : fmaf(x, cs[k].x, -px * cs[k].y);
            if (r < NTOK) { if (lane == 0) { RS[(size_t)r * 2] = rsqrtf(sq * (1.f / 256.f) + EPS); RS[(size_t)r * 2 + 1] = rsqrtf(sk * (1.f / 128.f) + EPS); }
                const bf16 ob = f2bf(o); bf16* kr = Kb + (size_t)r * 384 + 64 + d; if (lane < 32) { kr[0] = ob; kr[96] = ob; kr[192] = ob; kr[288] = ob; } } }
    }
}
__device__ __forceinline__ void phase_attn(const Ctx& c, bool with_ctx) {
    const bf16* Qb = (const bf16*)(c.ws + WS_H); const bf16* Kb = Qb + (size_t)NTOK * 384; const bf16* VT = Kb + (size_t)NTOK * 384; unsigned char* MIX = c.ws + WS_MIX;
    constexpr int KROW = 208, VROW = 144, KBUF = 64 * KROW, VBUF = 64 * VROW;
    LAS unsigned char* Kt = c.lds; LAS unsigned char* Vt = c.lds + 2 * KBUF;
    const int lane = c.lane, ln = lane & 31, hh = lane >> 5, tid = c.tid;
    const int nunits = with_ctx ? 1152 : 1024;
    for (int L = c.blk; L < nunits; L += c.G) {
        int u = L;
        if (c.G == 256 && L < 1024) { const int r = L >> 8, x = L & 7, j = (L & 255) >> 3; u = ((r * 32 + x * 4 + (j >> 3)) << 3) | (j & 7); }
        int b, h, qrow0, kt0, nkt;
        if (u < 1024) { b = u >> 5; h = (u >> 3) & 3; qrow0 = b * SEQ + (u & 7) * 256; kt0 = 0; nkt = 36; } else { const int q = u - 1024; b = q >> 2; h = q & 3; qrow0 = NLAT + b * CTXL; kt0 = 32; nkt = 4; }
        const bf16* vtb = VT + (size_t)((b * 4 + h) * 64) * 2304;
        bf16x8 qf[6];
        { const bf16* qr = Qb + (size_t)(qrow0 + 32 * c.wave + ln) * 384 + h * 96 + 8 * hh;
#pragma unroll
          for (int ks = 0; ks < 6; ++ks) qf[ks] = *(const bf16x8*)(qr + 16 * ks); }
        if (u < 1024) {
            const float* ROPE = (const float*)(c.ws + WS_TAB + TAB_ROPE) + (size_t)((qrow0 + 32 * c.wave + ln) & 2047) * 32;
#pragma unroll
            for (int ax = 0; ax < 2; ++ax) { const u32x4 own = __builtin_bit_cast(u32x4, qf[4 + ax]); u32x4 oth, res;
#pragma unroll
                for (int i = 0; i < 4; ++i) { const auto sw = __builtin_amdgcn_permlane32_swap(own[i], own[i], false, false); oth[i] = hh ? sw[0] : sw[1]; }
#pragma unroll
                for (int i = 0; i < 4; ++i) { const f32x4 cs = *(const f32x4*)(ROPE + ax * 16 + 4 * i);
                    const float v0 = __uint_as_float(own[i] << 16), v1 = __uint_as_float(own[i] & 0xffff0000u), p0 = __uint_as_float(oth[i] << 16), p1 = __uint_as_float(oth[i] & 0xffff0000u);
                    const float sg = hh ? 1.f : -1.f; res[i] = pk2(fmaf(v0, cs.x, sg * p0 * cs.y), fmaf(v1, cs.z, sg * p1 * cs.w)); }
                qf[4 + ax] = __builtin_bit_cast(bf16x8, res); } }
        f32x16 oacc[2];
#pragma unroll
        for (int i = 0; i < 16; ++i) { oacc[0][i] = 0.f; oacc[1][i] = 0.f; }
        float mrun = 0.f, lsum = 0.f;
        const int k0key = tid / 12, k0pt = tid % 12, k1key = (512 + tid) / 12, k1pt = (512 + tid) % 12; const bool k1on = tid < 256;
        u32x4 sk0, sk1 = (u32x4){0u, 0u, 0u, 0u}, sv;
        auto key_row = [&](int kt, int j) -> int { const int kk = kt * 64 + j; return kk < 2048 ? b * SEQ + kk : NLAT + b * CTXL + (kk - 2048); };
#define ATT_LOAD(kt) do { sk0 = *(const u32x4*)(Kb + (size_t)key_row((kt), k0key) * 384 + h * 96 + k0pt * 8); if (k1on) sk1 = *(const u32x4*)(Kb + (size_t)key_row((kt), k1key) * 384 + h * 96 + k1pt * 8); \
        sv = *(const u32x4*)(vtb + (size_t)(tid >> 3) * 2304 + (kt) * 64 + (tid & 7) * 8); } while (0)
#define ATT_STORE(buf) do { *(LAS u32x4*)(Kt + (buf) * KBUF + k0key * KROW + k0pt * 16) = sk0; if (k1on) *(LAS u32x4*)(Kt + (buf) * KBUF + k1key * KROW + k1pt * 16) = sk1; \
        *(LAS u32x4*)(Vt + (buf) * VBUF + (tid >> 3) * VROW + (tid & 7) * 16) = sv; } while (0)
        __syncthreads();
        ATT_LOAD(kt0); ATT_STORE(0);
        __syncthreads();
        for (int it = 0; it < nkt; ++it) {
            const int cur = it & 1;
            if (it + 1 < nkt) ATT_LOAD(kt0 + it + 1);
            f32x16 sacc[2];
            const float nm = -mrun;
#pragma unroll
            for (int kb = 0; kb < 2; ++kb) {
#pragma unroll
                for (int i = 0; i < 16; ++i) sacc[kb][i] = nm;
#pragma unroll
                for (int ks = 0; ks < 6; ++ks) { const bf16x8 a = *(const LAS bf16x8*)(Kt + cur * KBUF + (32 * kb + ln) * KROW + ks * 32 + hh * 16);
                    sacc[kb] = __builtin_amdgcn_mfma_f32_32x32x16_bf16(a, qf[ks], sacc[kb], 0, 0, 0); } }
            float mx = fmaxf(fmaxf(sacc[0][0], sacc[0][1]), sacc[0][2]);
#pragma unroll
            for (int i = 3; i < 15; i += 2) mx = fmaxf(fmaxf(mx, sacc[0][i]), sacc[0][i + 1]);
            mx = fmaxf(mx, sacc[0][15]);
#pragma unroll
            for (int i = 0; i < 16; i += 2) mx = fmaxf(fmaxf(mx, sacc[1][i]), sacc[1][i + 1]);
            { const auto r = __builtin_amdgcn_permlane32_swap(__float_as_uint(mx), __float_as_uint(mx), false, false); mx = fmaxf(__uint_as_float(r[0]), __uint_as_float(r[1])); }
            if (it == 0 || __builtin_amdgcn_ballot_w64(mx > 8.0f) != 0ull) {
                const float up = it == 0 ? mx : fmaxf(mx, 0.f), alpha = __builtin_amdgcn_exp2f(-up); mrun += up; lsum *= alpha;
#pragma unroll
                for (int i = 0; i < 16; ++i) { oacc[0][i] *= alpha; oacc[1][i] *= alpha; sacc[0][i] -= up; sacc[1][i] -= up; }
            }
            float ps = 0.f;
#pragma unroll
            for (int kb = 0; kb < 2; ++kb)
#pragma unroll
                for (int i = 0; i < 16; ++i) { const float pv = __builtin_amdgcn_exp2f(sacc[kb][i]); sacc[kb][i] = pv; ps += pv; }
            lsum += ps;
            bf16x8 pb[4];
#pragma unroll
            for (int s4 = 0; s4 < 4; ++s4) { const int kb = s4 >> 1, o8 = 8 * (s4 & 1); u32x4 w;
                w.x = pk2(sacc[kb][o8 + 0], sacc[kb][o8 + 1]); w.y = pk2(sacc[kb][o8 + 2], sacc[kb][o8 + 3]); w.z = pk2(sacc[kb][o8 + 4], sacc[kb][o8 + 5]); w.w = pk2(sacc[kb][o8 + 6], sacc[kb][o8 + 7]);
                pb[s4] = __builtin_bit_cast(bf16x8, w); }
#pragma unroll
            for (int db = 0; db < 2; ++db)
#pragma unroll
                for (int s4 = 0; s4 < 4; ++s4) { const bf16x8 a = *(const LAS bf16x8*)(Vt + cur * VBUF + (32 * db + ln) * VROW + s4 * 32 + hh * 16);
                    oacc[db] = __builtin_amdgcn_mfma_f32_32x32x16_bf16(a, pb[s4], oacc[db], 0, 0, 0); }
            if (it + 1 < nkt) ATT_STORE(cur ^ 1);
            __syncthreads();
        }
#undef ATT_LOAD
#undef ATT_STORE
        { const auto r = __builtin_amdgcn_permlane32_swap(__float_as_uint(lsum), __float_as_uint(lsum), false, false); lsum = __uint_as_float(r[0]) + __uint_as_float(r[1]); }
        const float inv = 16.f / lsum;
        unsigned char* dst = MIX + (size_t)(qrow0 + 32 * c.wave + ln) * DM + 768 + h * 64 + 4 * hh;
#pragma unroll
        for (int db = 0; db < 2; ++db)
#pragma unroll
            for (int g4 = 0; g4 < 4; ++g4) *(unsigned*)(dst + 32 * db + 8 * g4) = pk4_fp8(oacc[db][4 * g4] * inv, oacc[db][4 * g4 + 1] * inv, oacc[db][4 * g4 + 2] * inv, oacc[db][4 * g4 + 3] * inv);
    }
    __syncthreads();
}

__device__ __forceinline__ void phase_norm2_route(const Ctx& c, KParams p, int l, int ntok) {
    const float* MOD = (const float*)(c.ws + WS_MOD) + (size_t)l * 33 * 6144;
    const float* xl = l == 0 ? p->in[I_X] : p->out; const float* xc = l == 0 ? p->in[I_CTX] : (const float*)(c.ws + WS_XC);
    bf16* H = (bf16*)(c.ws + WS_H);
    int* TKEP = (int*)(c.ws + WS_RT + RT_TKEP); float* TKW = (float*)(c.ws + WS_RT + RT_TKW); int* TB = (int*)(c.ws + WS_TB);
    int* CNT = (int*)(c.ws + WS_CTL) + CW_CNT + l * NCH * NE;
    constexpr int HROW = 1032;
    LAS bf16* hhi = (LAS bf16*)c.lds;
    LAS bf16* hlo = hhi + 32 * HROW;
    LAS float* lgs = (LAS float*)(c.lds + 132096);
    LAS int* hist = (LAS int*)(c.lds + 140288);
    const bf16* Whi = (const bf16*)(c.ws + WS_TAB + TAB_RWT) + (size_t)(l * 2) * 65536; const bf16* Wlo = Whi + 65536;
    const float rbias = p->in[I_RB][l * 64 + c.lane];
    const int ntiles = ntok / 32, rpc = ntok / NCH, lane = c.lane, mb = c.wave >> 2, nb = c.wave & 3;
    for (int tile = c.blk; tile < ntiles; tile += c.G) {
        __syncthreads();
        if (c.tid < 64) hist[c.tid] = 0;
        for (int q = 0; q < 4; ++q) { const int r = tile * 32 + c.wave * 4 + q; const float* xr = r < NLAT ? xl + (size_t)r * DM : xc + (size_t)(r - NLAT) * DM; const float* m = MOD + (size_t)mod_row(r) * 6144;
            float* xo = r < NLAT ? p->out + (size_t)r * DM : (float*)(c.ws + WS_XC) + (size_t)(r - NLAT) * DM;
            f32x4 v[4]; norm_row_add(xr, (const bf16*)(c.ws + WS_Z) + (size_t)r * DM, xo, p->in[I_N2G] + l * DM, m + 3072, m + 4096, c.ws + WS_H8 + (size_t)r * DM, lane, v);
#pragma unroll
            for (int j = 0; j < 4; ++j) { u32x2 hi; hi.x = pk2(v[j].x, v[j].y); hi.y = pk2(v[j].z, v[j].w);
                const float r0 = v[j].x - __uint_as_float(hi.x << 16), r1 = v[j].y - __uint_as_float(hi.x & 0xffff0000u), r2 = v[j].z - __uint_as_float(hi.y << 16), r3 = v[j].w - __uint_as_float(hi.y & 0xffff0000u);
                u32x2 lo; lo.x = pk2(r0, r1); lo.y = pk2(r2, r3);
                *(LAS u32x2*)(hhi + (c.wave * 4 + q) * HROW + 4 * lane + 256 * j) = hi; *(LAS u32x2*)(hlo + (c.wave * 4 + q) * HROW + 4 * lane + 256 * j) = lo; } }
        __syncthreads();
        { f32x4 acc = (f32x4){0.f, 0.f, 0.f, 0.f};
          const LAS bf16* ah = hhi + (mb * 16 + (lane & 15)) * HROW + 8 * (lane >> 4); const LAS bf16* al = hlo + (mb * 16 + (lane & 15)) * HROW + 8 * (lane >> 4);
          const bf16* bh = Whi + (size_t)(nb * 16 + (lane & 15)) * 1024 + 8 * (lane >> 4); const bf16* bl = Wlo + (size_t)(nb * 16 + (lane & 15)) * 1024 + 8 * (lane >> 4);
#pragma unroll 8
          for (int ks = 0; ks < 32; ++ks) { const bf16x8 a_h = *(const LAS bf16x8*)(ah + 32 * ks), a_l = *(const LAS bf16x8*)(al + 32 * ks), b_h = *(const bf16x8*)(bh + 32 * ks), b_l = *(const bf16x8*)(bl + 32 * ks);
              acc = __builtin_amdgcn_mfma_f32_16x16x32_bf16(a_h, b_h, acc, 0, 0, 0); acc = __builtin_amdgcn_mfma_f32_16x16x32_bf16(a_h, b_l, acc, 0, 0, 0); acc = __builtin_amdgcn_mfma_f32_16x16x32_bf16(a_l, b_h, acc, 0, 0, 0); }
#pragma unroll
          for (int i = 0; i < 4; ++i) lgs[(mb * 16 + 4 * (lane >> 4) + i) * 64 + nb * 16 + (lane & 15)] = acc[i]; }
        __syncthreads();
#pragma unroll
        for (int q = 0; q < 4; ++q) {
            const int r = tile * 32 + c.wave * 4 + q;
            const float s = sigmoidf_(lgs[(c.wave * 4 + q) * 64 + lane]), bs = s + rbias;
            float m1 = bs; m1 = fmaxf(m1, shx<1>(m1)); m1 = fmaxf(m1, shx<2>(m1)); m1 = fmaxf(m1, shx<4>(m1));
            const unsigned long long eq = __ballot(bs == m1); const unsigned gm = (unsigned)(eq >> (lane & 56)) & 0xffu; const int first = __ffs(gm) - 1;
            float m2 = ((lane & 7) == first) ? -1e30f : bs; m2 = fmaxf(m2, shx<1>(m2)); m2 = fmaxf(m2, shx<2>(m2)); m2 = fmaxf(m2, shx<4>(m2));
            const float gs = m1 + m2; const int g = lane >> 3; int rank = 0;
#pragma unroll
            for (int j = 0; j < 8; ++j) { const float o = rdl(gs, 8 * j); rank += (o > gs || (o == gs && j < g)) ? 1 : 0; }
            float cand = rank < 4 ? bs : -1e30f; int my_e = 0; float my_w = 0.f, wsum = 0.f;
#pragma unroll
            for (int k = 0; k < 8; ++k) { const float mm = wave_max(cand); const unsigned long long e2 = __ballot(cand == mm); const int idx = __ffsll((long long)e2) - 1; const float wk = rdl(s, idx);
                if (lane == idx) cand = -1e30f; if (lane == k) { my_e = idx; my_w = wk; } wsum += wk; }
            if (lane < 8) { const int lp = atomicAdd((int*)&hist[my_e], 1); TKEP[(size_t)r * 8 + lane] = my_e | (lp << 8); TKW[(size_t)r * 8 + lane] = my_w / wsum * 2.5f; }
        }
        __syncthreads();
        if (c.tid < 64) { const int n = hist[c.tid]; int base = 0; if (n > 0) base = atomicAdd(&CNT[((tile * 32) / rpc) * NE + c.tid], n); TB[tile * 64 + c.tid] = base; }
    }
    __syncthreads();
}
__device__ __forceinline__ void phase_route_fill(const Ctx& c, int l, int ntok) {
    const int* TKEP = (const int*)(c.ws + WS_RT + RT_TKEP); int* SLOT = (int*)(c.ws + WS_RT + RT_SLOT); const int* TB = (const int*)(c.ws + WS_TB);
    const int* CNT = (const int*)(c.ws + WS_CTL) + CW_CNT + l * NCH * NE; int* ROWL = (int*)(c.ws + WS_ROWL);
    LAS int* est = (LAS int*)c.lds;
    const int rpc = ntok / NCH;
    LAS int* cntl = est + 256;
    __syncthreads();
    if (c.tid < NCH * NE) cntl[c.tid] = (CNT[c.tid] + 255) & ~255;
    __syncthreads();
    if (c.tid < NCH) { int s = 0; for (int e = 0; e < NE; ++e) { est[c.tid * 65 + e] = s; s += cntl[c.tid * NE + e]; } est[c.tid * 65 + 64] = s; }
    __syncthreads();
    const size_t na = (size_t)ntok * 8;
    for (size_t a = (size_t)c.blk * NTHR + c.tid; a < na; a += (size_t)c.G * NTHR) { const int t = (int)(a >> 3), ch = t / rpc; const int ep = TKEP[a], e = ep & 255, lp = ep >> 8;
        const int slot = est[ch * 65 + e] + TB[(t >> 5) * 64 + e] + lp; SLOT[a] = slot; ROWL[(size_t)ch * RPCMAX + slot] = t; }
    for (int i = c.blk * NTHR + c.tid; i < NCH * NE * 256; i += c.G * NTHR) { const int ch = i >> 14, e = (i >> 8) & 63, j = i & 255; const int n = CNT[ch * NE + e]; const int pad = ((n + 255) & ~255) - n;
        if (j < pad) ROWL[(size_t)ch * RPCMAX + est[ch * 65 + e] + n + j] = ch * rpc; }
    __syncthreads();
}

__device__ __forceinline__ void moe_tile_table(const Ctx& c, int l, int ch, LAS int* tst) {
    const int* CNT = (const int*)(c.ws + WS_CTL) + CW_CNT + l * NCH * NE + ch * NE;
    LAS unsigned char* texp = (LAS unsigned char*)(tst + 80);
    LAS int* cntl = tst + 1024;
    __syncthreads();
    if (c.tid < NE) cntl[c.tid] = (CNT[c.tid] + 255) >> 8;
    __syncthreads();
    if (c.tid == 0) { int s = 0; for (int e = 0; e < NE; ++e) { tst[e] = s; s += cntl[e]; } tst[64] = s; }
    __syncthreads();
    if (c.tid < NE) { for (int t = tst[c.tid]; t < tst[c.tid + 1]; ++t) texp[t] = (unsigned char)c.tid; }
    __syncthreads();
}
__device__ __forceinline__ void phase_combine(const Ctx& c, KParams p, int l, int ch, int rpc) {
    const float* MOD = (const float*)(c.ws + WS_MOD) + (size_t)l * 33 * 6144 + 5120; const float* MODn = (const float*)(c.ws + WS_MOD) + (size_t)33 * 6144;
    const int* SLOT = (const int*)(c.ws + WS_RT + RT_SLOT); const float* TKW = (const float*)(c.ws + WS_RT + RT_TKW);
    const unsigned char* OB = (const unsigned char*)(c.ws + WS_OB); const bf16* OBS = (const bf16*)(c.ws + WS_OBS);
    float* xl = p->out; float* xc = (float*)(c.ws + WS_XC); unsigned char* H = c.ws + WS_H;
    const int gw = c.blk * NWAVES + c.wave, NGW = c.G * NWAVES, lane = c.lane;
    const int col0 = (lane >> 4) * 256 + ((lane >> 2) & 3) * 32 + (lane & 3) * 8;
    f32x4 gn[4];
#pragma unroll
    for (int q = 0; q < 4; ++q) gn[q] = *(const f32x4*)((l == 0 ? p->in[I_N1G] + DM : p->in[I_FG]) + col0 + 128 * (q >> 1) + 4 * (q & 1));
    int sl_n = 0; float w_n = 0.f;
    if (gw < rpc && lane < 8) { sl_n = SLOT[(size_t)(ch * rpc + gw) * 8 + lane]; w_n = TKW[(size_t)(ch * rpc + gw) * 8 + lane] * 0.0625f; }
    for (int i = gw; i < rpc; i += NGW) {
        const int t = ch * rpc + i; float* xr = t < NLAT ? xl + (size_t)t * DM : xc + (size_t)(t - NLAT) * DM; const int mr = mod_row(t); const float* g2 = MOD + (size_t)mr * 6144;
        const int sl = sl_n; const float w = w_n;
        u32x4 ob[8], os0, os1; f32x4 xv[4];
#pragma unroll
        for (int e = 0; e < 8; ++e) ob[e] = *(const u32x4*)(OB + (size_t)rdli(sl, e) * 1024 + lane * 16);
        os0 = *(const u32x4*)(OBS + (size_t)i * DM + col0); os1 = *(const u32x4*)(OBS + (size_t)i * DM + col0 + 128);
#pragma unroll
        for (int q = 0; q < 4; ++q) xv[q] = *(const f32x4*)(xr + col0 + 128 * (q >> 1) + 4 * (q & 1));
        if (i + NGW < rpc && lane < 8) { sl_n = SLOT[(size_t)(t + NGW) * 8 + lane]; w_n = TKW[(size_t)(t + NGW) * 8 + lane] * 0.0625f; }
        float a[16]; { float t8[8]; unpack8(os0, t8);
#pragma unroll
            for (int q = 0; q < 8; ++q) a[q] = t8[q];
            unpack8(os1, t8);
#pragma unroll
            for (int q = 0; q < 8; ++q) a[8 + q] = t8[q]; }
#pragma unroll
        for (int e = 0; e < 8; ++e) { const float wk = rdl(w, e);
#pragma unroll
            for (int q = 0; q < 4; ++q) { const f32x2 lo = __builtin_amdgcn_cvt_pk_f32_fp8((int)ob[e][q], false), hi = __builtin_amdgcn_cvt_pk_f32_fp8((int)ob[e][q], true);
                a[4 * q] = fmaf(wk, lo.x, a[4 * q]); a[4 * q + 1] = fmaf(wk, lo.y, a[4 * q + 1]); a[4 * q + 2] = fmaf(wk, hi.x, a[4 * q + 2]); a[4 * q + 3] = fmaf(wk, hi.y, a[4 * q + 3]); } }
        f32x4 xn[4]; float ss = 0.f;
#pragma unroll
        for (int q = 0; q < 4; ++q) { const int cc = col0 + 128 * (q >> 1) + 4 * (q & 1); const f32x4 gv = *(const f32x4*)(g2 + cc);
            xn[q] = xv[q] + gv * (f32x4){a[4 * q], a[4 * q + 1], a[4 * q + 2], a[4 * q + 3]}; ss += (xn[q].x * xn[q].x + xn[q].y * xn[q].y) + (xn[q].z * xn[q].z + xn[q].w * xn[q].w); }
        const float rstd = rsqrtf(wave_sum(ss) * (1.f / 1024.f) + EPS);
        if (l == 0) { const float* mn = MODn + (size_t)mr * 6144; unsigned char* hr = H + (size_t)t * DM;
#pragma unroll
            for (int q = 0; q < 4; ++q) { const int cc = col0 + 128 * (q >> 1) + 4 * (q & 1); *(f32x4*)(xr + cc) = xn[q];
                const f32x4 s0 = *(const f32x4*)(mn + cc), s1 = *(const f32x4*)(mn + 1024 + cc); const f32x4 hv = (xn[q] * rstd * gn[q] * (s1 + 1.0f) + s0) * 4.f;
                *(unsigned*)(hr + cc) = pk4_fp8(hv.x, hv.y, hv.z, hv.w); } }
        else {
#pragma unroll
            for (int q = 0; q < 4; ++q) { const int cc = col0 + 128 * (q >> 1) + 4 * (q & 1); *(f32x4*)(xr + cc) = xn[q] * rstd * gn[q]; } }
    }
}
constexpr int LDS_BYTES = 147456;
constexpr int LDS_TAB = 131072, LDS_XB = LDS_BYTES - 16;
enum { J_INPROJ = 0, J_S5G1, J_PW, J_Q, J_KV, J_S5G2, J_GLU, J_OUT, J_GU, J_GUS, J_DN, J_DNS };
enum { SK_DENSE = 0, SK_S5, SK_MOE };
enum { EK_INPROJ = 0, EK_S5X, EK_S5Y, EK_BIAS, EK_GLU, EK_Q, EK_KV, EK_RESID, EK_SWIGLU, EK_OB8, EK_BF16 };
struct JSched {
    int sk, G, c; pg8::DenseOrder d; const char* W; size_t wexp, wtile; const LAS unsigned char* texp; int ntile, npn;
    __device__ __forceinline__ bool next(int i, pg8::Unit& u) const {
        if (sk == SK_DENSE) return d.next(i, u);
        const int L = i * G + c;
        if (sk == SK_S5) { if (L >= 288) return false; u.pm = L; u.pn = 0; u.e = L / 18; u.B = W + (size_t)u.e * wexp; return true; }
        if (L >= ntile * npn) return false;
        const int T = npn == 2 ? (L >> 1) : (L >> 2), pn = L & (npn - 1); const int e = __builtin_amdgcn_readfirstlane((int)texp[T]);
        u.pm = T; u.pn = pn; u.e = e; u.B = W + (size_t)e * wexp + (size_t)pn * wtile; return true;
    }
};
struct JRows { const int* list; unsigned ldab;
    __device__ __forceinline__ unsigned off(const pg8::Unit& u, int r) const { const int row = u.pm * 256 + r; return (unsigned)(list ? list[row] : row) * ldab; } };
struct JEpi {
    int ek; void* p0; void* p1; void* p2; const void* q0; const void* q1; const void* q2; int i0;
    __device__ __forceinline__ void operator()(EPI_ARGS) const {
        switch (ek) {
        case EK_S5X:    EpiS5X{(bf16*)p0}(acc, u, wr, wc, fr, fq); break;
        case EK_S5Y:    EpiS5Y{(bf16*)p0}(acc, u, wr, wc, fr, fq); break;
        case EK_BIAS:   EpiBiasBf16{(unsigned char*)p0, i0, (const float*)q0}(acc, u, wr, wc, fr, fq); break;
        case EK_GLU:    EpiGluSig{(unsigned char*)p0, i0, (const float*)q0}(acc, u, wr, wc, fr, fq); break;
        case EK_Q:      EpiQ{(bf16*)p0, (const float*)q0}(acc, u, wr, wc, fr, fq); break;
        case EK_KV:     EpiKV{(bf16*)p0, (bf16*)p1, (const float*)q0}(acc, u, wr, wc, fr, fq); break;
        default:        EpiBf16{(bf16*)p0, i0}(acc, u, wr, wc, fr, fq); break;
        }
    }
};
struct JEpi8 {
    int ek; void* p0; int i0; const void* q0; void* p1; void* p2;
    __device__ __forceinline__ void operator()(EPI_ARGS) const {
        if (ek == EK_SWIGLU) EpiSwiglu{(unsigned char*)p0, i0, 1.0f / 256.0f}(acc, u, wr, wc, fr, fq);
        else if (ek == EK_OB8) EpiOB8{(unsigned char*)p0, 16.0f / 1024.0f}(acc, u, wr, wc, fr, fq);
        else if (ek == EK_INPROJ) EpiInProj{(bf16*)p0, (bf16*)p1, (bf16*)p2, 1.0f / 256.0f}(acc, u, wr, wc, fr, fq);
        else if (ek == EK_RESID) EpiDelta{(bf16*)p0, (const float*)q0, 1.0f / 1024.0f}(acc, u, wr, wc, fr, fq);
        else EpiBf16S{(bf16*)p0, i0, 1.0f / 1024.0f}(acc, u, wr, wc, fr, fq);
    }
};
__device__ __forceinline__ void gemm_job(KParams p, LAS unsigned char* lds, int job, int l, int ch) {
    unsigned char* ws = p->ws;
    const int G = gridDim.x, blk = blockIdx.x;
    const bool last = (l == 1); const int nrows = last ? NLAT : NTOK, rpc = nrows / NCH;
    unsigned char* sm = ws + WS_WSM + (size_t)l * WSM_L;
    const LAS int* tst = (const LAS int*)(lds + LDS_TAB);
    auto rot8 = [&](int units) { return ((units % G) + 7) & ~7; };
    auto rotc = [&](int rot) { return (blk + G - rot % G) % G; };
    const char* A = nullptr; int K = 256; bool fp8 = false; JSched S; JRows R; JEpi E;
    S.sk = SK_DENSE; S.G = G; S.c = blk; S.W = nullptr; S.wexp = 0; S.wtile = 0; S.texp = (const LAS unsigned char*)(tst + 80); S.ntile = 0; S.npn = 2; S.d.init(1, 1, G, blk, nullptr, 256);
    R.list = nullptr; R.ldab = 512u; E.ek = EK_BF16; E.p0 = E.p1 = E.p2 = nullptr; E.q0 = E.q1 = E.q2 = nullptr; E.i0 = 0;
    switch (job) {
    case J_INPROJ: A = (const char*)(ws + WS_H); K = 512; fp8 = true; R.ldab = 1024u; S.d.init(NTOK / 256, ZW / 256, G, blk, (const bf16*)(ws + WS_WIN) + (size_t)l * 2048 * 1024, 512);
        E.ek = EK_INPROJ; E.p0 = ws + WS_Z; E.p1 = ws + WS_UP; E.p2 = ws + WS_GVT; break;
    case J_S5G1: A = (const char*)(ws + WS_UP); K = 256; R.ldab = 1024u; S.sk = SK_S5; S.W = (const char*)(ws + WS_S5W) + (size_t)l * 16 * 256 * 256 * 2; S.wexp = (size_t)256 * 256 * 2; E.ek = EK_S5X; E.p0 = ws + WS_Y5; break;
    case J_PW: A = (const char*)(ws + WS_CV); K = 256; R.ldab = 512u; S.d.init(nrows / 256, 1, G, blk, (const bf16*)(sm + WSM_PW), 256); E.ek = EK_BIAS; E.p0 = ws + WS_MIX + 256; E.i0 = DM; E.q0 = p->in[I_CPB] + l * 256; break;
    case J_Q: A = (const char*)(ws + WS_Z) + ZCQ * 2; K = 256; R.ldab = (unsigned)ZW * 2u; S.d.init(NTOK / 256, 2, G, rotc(rot8(nrows / 256)), (const bf16*)(sm + WSM_UQ), 256);
        E.ek = EK_Q; E.p0 = ws + WS_H; E.q0 = ws + WS_RS; break;
    case J_KV: A = (const char*)(ws + WS_Z) + ZCKV * 2; K = 256; R.ldab = (unsigned)ZW * 2u; S.d.init(NTOK / 256, 2, G, rotc(rot8(nrows / 256) + rot8(NTOK / 256 * 2)), (const bf16*)(sm + WSM_UK), 256);
        E.ek = EK_KV; E.p0 = (bf16*)(ws + WS_H) + (size_t)NTOK * 384; E.p1 = (bf16*)(ws + WS_H) + (size_t)NTOK * 768; E.q0 = ws + WS_RS; break;
    case J_S5G2: A = (const char*)(ws + WS_UP); K = 512; R.ldab = 1024u; S.sk = SK_S5; S.W = (const char*)(ws + WS_S5W) + (size_t)32 * 256 * 256 * 2 + (size_t)l * 16 * 256 * 512 * 2; S.wexp = (size_t)256 * 512 * 2; E.ek = EK_S5Y; E.p0 = ws + WS_Y5; break;
    case J_GLU: A = (const char*)(ws + WS_Y5); K = 256; R.ldab = 512u; S.d.init(nrows / 256, 2, G, blk, (const bf16*)(sm + WSM_GLU), 256); E.ek = EK_GLU; E.p0 = ws + WS_MIX + 512; E.i0 = DM; E.q0 = p->in[I_S5GB] + l * 512; break;
    case J_OUT: A = (const char*)(ws + WS_MIX); K = 512; fp8 = true; R.ldab = 1024u; S.d.init(nrows / 256, 4, G, blk, (const bf16*)(ws + WS_WOUT) + (size_t)l * 1024 * 1024, 512);
        E.ek = EK_RESID; E.p0 = ws + WS_Z; E.q0 = (const float*)(ws + WS_MOD) + (size_t)l * 33 * 6144 + 2048; break;
    case J_GU: A = (const char*)(ws + WS_H8); K = 512; fp8 = true; R.list = (const int*)(ws + WS_ROWL) + (size_t)ch * RPCMAX; R.ldab = 1024u; S.sk = SK_MOE; S.ntile = __builtin_amdgcn_readfirstlane(tst[64]); S.npn = 2; S.W = (const char*)(ws + WS_WMOE) + (size_t)l * 48 * MiB; S.wexp = (size_t)512 * 1024; S.wtile = (size_t)256 * 1024;
        E.ek = EK_SWIGLU; E.p0 = ws + WS_HB; E.i0 = 256; break;
    case J_GUS: A = (const char*)(ws + WS_H8) + (size_t)ch * rpc * 1024; K = 512; fp8 = true; R.ldab = 1024u; S.d.init(rpc / 256, 2, G, rotc(rot8(__builtin_amdgcn_readfirstlane(tst[64]) * 2)), (const bf16*)((const unsigned char*)(ws + WS_WSH) + (size_t)l * (512 * 1024 + 1024 * 256) * 2), 512); E.ek = EK_SWIGLU; E.p0 = ws + WS_HBS; E.i0 = 256; break;
    case J_DN: A = (const char*)(ws + WS_HB); K = 128; fp8 = true; R.ldab = 256u; S.sk = SK_MOE; S.ntile = __builtin_amdgcn_readfirstlane(tst[64]); S.npn = 4; S.W = (const char*)(ws + WS_WMOE) + (size_t)l * 48 * MiB + (size_t)NE * 512 * 1024; S.wexp = (size_t)1024 * 256; S.wtile = (size_t)256 * 256;
        E.ek = EK_OB8; E.p0 = ws + WS_OB; break;
    default: A = (const char*)(ws + WS_HBS); K = 128; fp8 = true; R.ldab = 256u; S.d.init(rpc / 256, 4, G, rotc(rot8(__builtin_amdgcn_readfirstlane(tst[64]) * 4)), (const bf16*)((const unsigned char*)(ws + WS_WSH) + (size_t)l * (512 * 1024 + 1024 * 256) * 2 + 512 * 1024), 128); E.ek = EK_BF16; E.p0 = ws + WS_OBS; E.i0 = DM; break;
    }
    __builtin_amdgcn_s_waitcnt(0x0F70);
    if (fp8) pg8::gemm_phase<true>(lds, A, K, S, R, JEpi8{E.ek, E.p0, E.i0, E.q0, E.p1, E.p2});
    else pg8::gemm_phase<false>(lds, A, K, S, R, E);
}


__global__ void __launch_bounds__(NTHR, 2) fwd_kernel(Params pk) {
    extern __shared__ __attribute__((aligned(16))) unsigned char lds_raw[];
    LAS unsigned char* const lds0 = (LAS unsigned char*)lds_raw;
    if (threadIdx.x < 4) ((LAS unsigned*)(lds0 + LDS_XB))[threadIdx.x] = 0u;
    __syncthreads();
    (void)xcd_barrier_post((unsigned*)(pk.ws + WS_CTL) + CW_BAR, (volatile LAS unsigned*)(lds0 + LDS_XB));
    constexpr int NSTEP = 15 + 6 * NCH;
#ifndef PROBE_DUP
#define PROBE_DUP (-9)
#endif
#pragma unroll 1
    for (int it_ = -2; it_ < 2 * NSTEP + (PROBE_DUP >= 0 ? 2 : 0); ++it_) {
        int gs = it_; if (PROBE_DUP >= 0) { if (it_ > PROBE_DUP) gs -= 1; if (it_ > NSTEP + PROBE_DUP + 1) gs -= 1; }
        KParams p = fresh_params(); Ctx c; { int t_ = threadIdx.x; asm volatile("" : "+v"(t_)); c.lds = lds0; c.tid = t_; c.lane = t_ & 63; c.wave = __builtin_amdgcn_readfirstlane(t_ >> 6); c.blk = blockIdx.x; c.G = gridDim.x; c.ws = p->ws; }
        LAS int* tst = (LAS int*)(c.lds + LDS_TAB);
        int l = 0, s = gs, ch = 0, job = -1; bool seam = true;
        if (gs >= 0) { l = gs >= NSTEP ? 1 : 0; s = gs - l * NSTEP; if (s >= 15) { ch = (s - 15) / 6; s = 15 + (s - 15) % 6; } }
        const bool last = (l == 1); const int nrows = last ? NLAT : NTOK, rpc = nrows / NCH;
        switch (s) {
        case -2: prologue(c, p); break;
        case -1: prologue2(c, p); phase_norm1(c, p, 0); break;
        case 0: seam = false; break;
        case 1: job = J_INPROJ; break;
        case 2: phase_gla(c, p, l); phase_conv1(c, p, l, !last); phase_mla_prep(c, p); seam = false; break;
        case 3: job = J_S5G1; break;
        case 4: phase_gla_final(c, p, l, nrows); seam = false; break;
        case 5: job = J_PW; seam = false; break;
        case 6: job = J_Q; seam = false; break;
        case 7: job = J_KV; seam = false; break;
        case 8: phase_s5_carry(c, l); break;
        case 9: phase_attn(c, !last); seam = false; break;
        case 10: job = J_S5G2; break;
        case 11: job = J_GLU; break;
        case 12: job = J_OUT; break;
        case 13: phase_norm2_route(c, p, l, nrows); break;
        case 14: phase_route_fill(c, l, nrows); break;
        case 15: moe_tile_table(c, l, ch, tst); job = J_GU; seam = false; break;
        case 16: job = J_GUS; break;
        case 17: job = J_DN; seam = false; break;
        case 18: job = J_DNS; break;
        case 19: phase_combine(c, p, l, ch, rpc); break;
        default: seam = false; break;
        }
        if (job >= 0) gemm_job(p, c.lds, job, l, ch);
        if (seam && gs + 1 < 2 * NSTEP) { XcdBarrier b_; b_.bar = (unsigned*)(p->ws + WS_CTL) + CW_BAR; b_.x = xb_xcc_id(); b_.st = (volatile LAS unsigned*)(lds0 + LDS_XB); xcd_barrier(b_); }
    }
}

extern "C" void kernel_launch(void* const* d_in, const int* in_sizes, int n_in, void* d_out, int out_size, void* d_ws, size_t ws_size, hipStream_t stream) {
    static int grid = 0;
    if (grid == 0) {
        if (n_in != 42 || out_size != NLAT * DM || ws_size < WS_END) { fprintf(stderr, "kernel_launch: unexpected shapes (n_in %d out %d ws %zu)\n", n_in, out_size, ws_size); grid = -1; return; }
        int dev = 0, cus = 0;
        if (hipGetDevice(&dev) != hipSuccess || hipDeviceGetAttribute(&cus, hipDeviceAttributeMultiprocessorCount, dev) != hipSuccess) { grid = -1; return; }
        if (hipFuncSetAttribute((const void*)fwd_kernel, hipFuncAttributeMaxDynamicSharedMemorySize, LDS_BYTES) != hipSuccess) { fprintf(stderr, "kernel_launch: hipFuncSetAttribute failed\n"); grid = -1; return; }
        int per_cu = 0;
        if (hipOccupancyMaxActiveBlocksPerMultiprocessor(&per_cu, (const void*)fwd_kernel, NTHR, LDS_BYTES) != hipSuccess || per_cu < 1) fprintf(stderr, "kernel_launch: occupancy query reports %d\n", per_cu);
        (void)hipGetLastError();
        grid = cus;
    }
    if (grid < 0) return;
    (void)hipMemsetAsync((char*)d_ws + WS_CTL, 0, CTL_BYTES, stream);
    Params p{};
    for (int i = 0; i < 42; ++i) p.in[i] = (const float*)d_in[i];
    p.out = (float*)d_out; p.ws = (unsigned char*)d_ws; p.ph_lo = 0; p.ph_hi = 1 << 20;
    hipLaunchKernelGGL(fwd_kernel, dim3(grid), dim3(NTHR), LDS_BYTES, stream, p);
}
```

```cpp
#include <hip/hip_runtime.h>
#include <cstdio>
#include <cstdint>

#define LAS __attribute__((address_space(3)))
typedef unsigned short bf16;
typedef short bf16x8 __attribute__((ext_vector_type(8)));
typedef float f32x4 __attribute__((ext_vector_type(4)));
typedef float f32x2 __attribute__((ext_vector_type(2)));
typedef float f32x16 __attribute__((ext_vector_type(16)));
typedef unsigned u32x4 __attribute__((ext_vector_type(4)));
typedef unsigned u32x2 __attribute__((ext_vector_type(2)));
typedef int i32x4 __attribute__((ext_vector_type(4)));
typedef int i32x8 __attribute__((ext_vector_type(8)));

constexpr int NB = 32, SEQ = 2048, CTXL = 256, DM = 1024;
constexpr int NLAT = NB * SEQ, NCTX = NB * CTXL, NTOK = NLAT + NCTX;
constexpr int ZW = 2048;
constexpr int ZQ = 0, ZK = 128, ZV = 256, ZR = 512, ZCA = 768, ZCG = 1024, ZS5 = 1280, ZCQ = 1536, ZCKV = 1792, ZKR = 1920, ZAF = 1952, ZAB = 1968;
constexpr int NE = 64, TOPK = 8;
constexpr int NCH = 2;
constexpr int RPCMAX = (NTOK / NCH) * 8 + 64 * 256;
constexpr float EPS = 1e-6f;
constexpr int NWAVES = 8, NTHR = 512;

constexpr size_t MiB = (size_t)1 << 20;
constexpr size_t WS_CTL = 0, CTL_BYTES = 1 * MiB;
constexpr size_t WS_MOD = 1 * MiB;
constexpr size_t WS_TAB = 3 * MiB;
constexpr size_t WS_WSM = 5 * MiB;
constexpr size_t WS_WIN = 8 * MiB;
constexpr size_t WS_WOUT = 16 * MiB;
constexpr size_t WS_WSH = 20 * MiB;
constexpr size_t WS_TB = 23 * MiB;
constexpr size_t WS_RT = 24 * MiB;
constexpr size_t WS_ROWL = 32 * MiB;
constexpr size_t WS_RS = 35 * MiB;
constexpr size_t WS_WMOE = 36 * MiB;
constexpr size_t WS_XC = 132 * MiB;
constexpr size_t WS_H = 164 * MiB;
constexpr size_t WS_H8 = WS_H + 72 * MiB;
constexpr size_t WS_Z = 308 * MiB;
constexpr size_t WS_MIX = 596 * MiB;
constexpr size_t WS_T1 = 740 * MiB;
constexpr size_t WS_UP = 812 * MiB;
constexpr size_t WS_CV = 884 * MiB;
constexpr size_t WS_Y5 = 920 * MiB;
constexpr size_t WS_S5W = 956 * MiB;
constexpr size_t WS_S5P = 968 * MiB;
constexpr size_t WS_GVT = 969 * MiB;
constexpr size_t WS_END = 1005 * MiB;
constexpr size_t WS_HB = WS_Z;
constexpr size_t WS_HBS = WS_Z + 152 * MiB;
constexpr size_t WS_OBS = WS_Z + 170 * MiB;
constexpr size_t WS_OB = WS_MIX;
static_assert((size_t)RPCMAX * 512 <= 152 * MiB && WS_OBS + (size_t)(NTOK / NCH) * 2048 <= WS_MIX && WS_OB + (size_t)RPCMAX * 1024 <= WS_S5W, "MoE overlays");
constexpr int CW_BAR = 0;
constexpr int CW_CNT = 4096;
constexpr size_t WSM_L = 1 * MiB;
constexpr size_t WSM_PW = 0, WSM_GLU = 128 * 1024, WSM_UQ = 384 * 1024, WSM_UK = 640 * 1024, WSM_UV = 768 * 1024;
constexpr size_t TAB_ROPE = 0;
constexpr size_t TAB_S5 = 256 * 1024;
constexpr size_t TAB_RWT = 1536 * 1024;
constexpr size_t RT_TKEP = 0, RT_TKW = 2400000, RT_SLOT = 4800000;

__device__ __forceinline__ float bf2f(bf16 v) { return __uint_as_float(((unsigned)v) << 16); }
typedef __bf16 bf16x2_t __attribute__((ext_vector_type(2)));
__device__ __forceinline__ unsigned pk2(float lo, float hi) { const f32x2 v = {lo, hi}; return __builtin_bit_cast(unsigned, __builtin_convertvector(v, bf16x2_t)); }
__device__ __forceinline__ bf16 f2bf(float f) { return __builtin_bit_cast(unsigned short, (__bf16)f); }
template <int O> __device__ __forceinline__ float shx(float v) {
    return __int_as_float(__builtin_amdgcn_ds_swizzle(__float_as_int(v), (O << 10) | 0x1f)); }
__device__ __forceinline__ float rdl(float v, int l) { return __int_as_float(__builtin_amdgcn_readlane(__float_as_int(v), l)); }
__device__ __forceinline__ int rdli(int v, int l) { return __builtin_amdgcn_readlane(v, l); }
__device__ __forceinline__ float wave_sum(float v) {
    v += shx<1>(v); v += shx<2>(v); v += shx<4>(v); v += shx<8>(v); v += shx<16>(v);
    const auto r = __builtin_amdgcn_permlane32_swap(__float_as_uint(v), __float_as_uint(v), false, false);
    return __uint_as_float(r[0]) + __uint_as_float(r[1]);
}
__device__ __forceinline__ float wave_max(float v) {
    v = fmaxf(v, shx<1>(v)); v = fmaxf(v, shx<2>(v)); v = fmaxf(v, shx<4>(v)); v = fmaxf(v, shx<8>(v)); v = fmaxf(v, shx<16>(v));
    const auto r = __builtin_amdgcn_permlane32_swap(__float_as_uint(v), __float_as_uint(v), false, false);
    return fmaxf(__uint_as_float(r[0]), __uint_as_float(r[1]));
}
__device__ __forceinline__ float sigmoidf_(float x) { return 1.0f / (1.0f + __expf(-x)); }
__device__ __forceinline__ float siluf_(float x) { return x / (1.0f + __expf(-x)); }
__device__ __forceinline__ void unpack8(const u32x4 w, float (&v)[8]) {
    v[0] = __uint_as_float(w.x << 16); v[1] = __uint_as_float(w.x & 0xffff0000u);
    v[2] = __uint_as_float(w.y << 16); v[3] = __uint_as_float(w.y & 0xffff0000u);
    v[4] = __uint_as_float(w.z << 16); v[5] = __uint_as_float(w.z & 0xffff0000u);
    v[6] = __uint_as_float(w.w << 16); v[7] = __uint_as_float(w.w & 0xffff0000u);
}
__device__ __forceinline__ void lds_wait() { asm volatile("s_waitcnt lgkmcnt(0)" ::: "memory"); }

#define XB_TMO      128
#define XB_XCNT(j)  (256  + 64 * (j))
#define XB_XSUB(j)  (1280 + 64 * (j))
#define XB_XGEN(j)  (2304 + 64 * (j))
#define XB_TOP      3328
#define XB_TOPGEN   3392
#define XCD_BAR_WORDS 3456
#define XB_SPIN_CAP (1u << 22)
__device__ __forceinline__ unsigned xb_ld(unsigned* p)              { return __hip_atomic_load(p, __ATOMIC_RELAXED, __HIP_MEMORY_SCOPE_AGENT); }
__device__ __forceinline__ unsigned xb_add(unsigned* p, unsigned v) { return __hip_atomic_fetch_add(p, v, __ATOMIC_RELAXED, __HIP_MEMORY_SCOPE_AGENT); }
__device__ __forceinline__ unsigned xb_xcc_id() { return (unsigned)__builtin_amdgcn_s_getreg((3 << 11) | 20) & 0xFu; }
#define XB_SPIN(cond, bar) do { unsigned _sp = 0; while (cond) { __builtin_amdgcn_s_sleep(1); \
    if ((++_sp & 255u) == 0u) { if (xb_ld(&(bar)[XB_TMO])) break; if (_sp > XB_SPIN_CAP) { atomicAdd(&(bar)[XB_TMO], 1u); break; } } } } while (0)
struct XcdBarrier { unsigned* bar; unsigned x; volatile LAS unsigned* st; };
__device__ __forceinline__ XcdBarrier xcd_barrier_post(unsigned* bar, volatile LAS unsigned* st) {
    XcdBarrier b; b.bar = bar; b.x = xb_xcc_id(); b.st = st;
    if (threadIdx.x == 0) (void)xb_add(&bar[XB_XCNT(b.x)], 1u);
    return b;
}
__device__ __forceinline__ void xcd_barrier_complete(unsigned* bar, unsigned x, unsigned& nloc, unsigned& nx) {
    const unsigned G = gridDim.x * gridDim.y * gridDim.z;
    unsigned sum, cnt, mine, sp = 0u;
    for (;;) {
        sum = 0u; cnt = 0u; mine = 0u;
#pragma unroll
        for (unsigned j = 0; j < 16; ++j) { const unsigned c = xb_ld(&bar[XB_XCNT(j)]); sum += c; cnt += (c > 0u) ? 1u : 0u; mine = (j == x) ? c : mine; }
        if (sum == G) break;
        __builtin_amdgcn_s_sleep(1);
        if ((++sp & 255u) == 0u) { if (xb_ld(&bar[XB_TMO])) break; if (sp > XB_SPIN_CAP) { atomicAdd(&bar[XB_TMO], 1u); break; } }
    }
    nloc = mine > 0u ? mine : 1u; nx = cnt > 0u ? cnt : 1u;
}
__device__ __forceinline__ void xcd_barrier(const XcdBarrier& b) {
    asm volatile("s_waitcnt vmcnt(0)" ::: "memory");
    __syncthreads();
    if (threadIdx.x == 0) {
        unsigned* bar = b.bar;
        __builtin_amdgcn_s_waitcnt(0);
        unsigned nloc = b.st[0], nx = b.st[1];
        if (nloc == 0u) { xcd_barrier_complete(bar, b.x, nloc, nx); b.st[0] = nloc; b.st[1] = nx; }
        const unsigned old = xb_add(&bar[XB_XSUB(b.x)], 1u);
        const unsigned gen = old / nloc;
        if (old + 1u == (gen + 1u) * nloc) {
            __builtin_amdgcn_fence(__ATOMIC_RELEASE, "agent");
            asm volatile("s_waitcnt vmcnt(0)" ::: "memory");
            const unsigned og = xb_add(&bar[XB_TOP], 1u);
            const unsigned tg = og / nx;
            if (og + 1u == (tg + 1u) * nx) xb_add(&bar[XB_TOPGEN], 1u);
            else XB_SPIN(xb_ld(&bar[XB_TOPGEN]) == tg, bar);
            __builtin_amdgcn_fence(__ATOMIC_ACQUIRE, "agent");
            xb_add(&bar[XB_XGEN(b.x)], 1u);
            asm volatile("s_waitcnt vmcnt(0)" ::: "memory");
        } else {
            XB_SPIN(xb_ld(&bar[XB_XGEN(b.x)]) == gen, bar);
            __builtin_amdgcn_fence(__ATOMIC_ACQUIRE, "agent");
            asm volatile("s_waitcnt vmcnt(0)" ::: "memory");
        }
    }
    __syncthreads();
}

namespace pg8 {
constexpr int BM = 256, BK = 64, HALF = 128, HTB = HALF * BK * 2, STAGE_BYTES = 8 * HTB, NXCD = 8, WGM = 8;
__device__ __forceinline__ int lds_byte(int r, int c) { const int st = (r >> 4) * 2 + (c >> 5), rr = r & 15, cc = c & 31, ob = rr * 64 + cc * 2; return st * 1024 + (ob ^ (((ob >> 9) & 1) << 5)); }
__device__ __forceinline__ void stage_rc(int b, int& R, int& C) { const int st = b / 1024, sb = b % 1024, swz = sb ^ (((sb >> 9) & 1) << 5); R = (st >> 1) * 16 + swz / 64; C = (st & 1) * 32 + (swz % 64) / 2; }
__device__ __forceinline__ int perm32(int rho) { const int n = rho >> 4, i = rho & 15; return 8 * (i >> 2) + 4 * n + (i & 3); }

struct Unit { int pm, pn, e; const char* B; };

struct DenseOrder {
    int nM, nN, nwg, G, c; const char* Bt; size_t btile;
    __device__ __forceinline__ void init(int nM_, int nN_, int G_, int c_, const bf16* Bt_, int K) { nM = nM_; nN = nN_; nwg = nM * nN; G = G_; c = c_; Bt = (const char*)Bt_; btile = (size_t)256 * K * 2; }
    __device__ __forceinline__ bool next(int i, Unit& u) const {
        const long L = (long)i * G + c; if (L >= nwg) return false;
        int wgid = (int)L; { const int q = nwg / NXCD, r = nwg % NXCD, xcd = wgid % NXCD, off = wgid / NXCD; wgid = (xcd < r ? xcd * (q + 1) : r * (q + 1) + (xcd - r) * q) + off; }
        const int nig = WGM * nN, gid = wgid / nig, fm = gid * WGM, gsz = (nM - fm) < WGM ? (nM - fm) : WGM;
        u.pm = fm + ((wgid % nig) % gsz); u.pn = (wgid % nig) / gsz; u.e = 0; u.B = Bt + (size_t)u.pn * btile; return true;
    }
};
struct RowsDense { unsigned ldab; __device__ __forceinline__ unsigned off(const Unit& u, int r) const { return (unsigned)(u.pm * 256 + r) * ldab; } };
struct RowsGather { const int* list; unsigned ldab; __device__ __forceinline__ unsigned off(const Unit& u, int r) const { return (unsigned)list[u.pm * 256 + r] * ldab; } };

template <bool FP8, class Epi, class Sched, class Rows>
__device__ __forceinline__ void gemm_phase(LAS unsigned char* lds, const char* Abase, const int K, const Sched& S, const Rows& RW, const Epi& E) {
    int tid_ = threadIdx.x; asm volatile("" : "+v"(tid_));
    const int tid = tid_, wid = __builtin_amdgcn_readfirstlane(tid >> 6), lane = tid & 63, wr = wid >> 2, wc = wid & 3, fr = lane & 15, fq = lane >> 4;
    const int nt = K / BK;
    int sR[2]; unsigned sC[2], voffB[2];
#pragma unroll
    for (int i = 0; i < 2; ++i) { int R, C; stage_rc(tid * 16 + i * 8192, R, C); sR[i] = R; sC[i] = (unsigned)C * 2u; const int Rb = (R & ~31) + perm32(R & 31); voffB[i] = (unsigned)(Rb * K + C) * 2u; }
    const size_t kstep = (size_t)(BK * 2);
    const size_t hstepB = (size_t)HALF * K * 2;
    const unsigned ldsw = (unsigned)wid * 1024u;
    const int aoff = lds_byte(wr * 64 + fr, fq * 8), boff = lds_byte(wc * 32 + fr, fq * 8);
#define PG8_SA(b, h) (((b) * 2 + (h)) * HTB)
#define PG8_SB(b, h) ((4 + (b) * 2 + (h)) * HTB)
#define PG8_STAGE(bufoff, gbase, voff) do { const char* _gb = (const char*)(gbase); asm volatile("" : "+s"(_gb)); _Pragma("unroll") for (int _i = 0; _i < 2; ++_i) { unsigned _o = (voff)[_i]; asm volatile("" : "+v"(_o)); \
        __builtin_amdgcn_global_load_lds((const unsigned*)(_gb + _o), (LAS unsigned*)(lds + (bufoff) + ldsw + _i * 8192), 16, 0, 0); } } while (0)
#define PG8_LDA(dst, b, h) do { _Pragma("unroll") for (int m = 0; m < 4; ++m) dst[m] = PG8_CAT(*(const LAS i32x4*)(lds + PG8_SA(b, h) + aoff + m * 2048), *(const LAS i32x4*)(lds + PG8_SA(b, h) + aoff + m * 2048 + 1024)); } while (0)
#define PG8_LDB(dst, b, h) do { _Pragma("unroll") for (int n = 0; n < 2; ++n) dst[n] = PG8_CAT(*(const LAS i32x4*)(lds + PG8_SB(b, h) + boff + n * 2048), *(const LAS i32x4*)(lds + PG8_SB(b, h) + boff + n * 2048 + 1024)); } while (0)
#define PG8_CAT(x0, x1) __builtin_shufflevector((x0), (x1), 0, 1, 2, 3, 4, 5, 6, 7)
#define PG8_LO(x) __builtin_bit_cast(bf16x8, __builtin_shufflevector((x), (x), 0, 1, 2, 3))
#define PG8_HI(x) __builtin_bit_cast(bf16x8, __builtin_shufflevector((x), (x), 4, 5, 6, 7))
#define PG8_MMA(ai, bj, At, Bt) do { __builtin_amdgcn_s_setprio(1); \
        if (FP8) { _Pragma("unroll") for (int m = 0; m < 4; ++m) _Pragma("unroll") for (int n = 0; n < 2; ++n) \
            acc[ai][bj][m][n] = __builtin_amdgcn_mfma_scale_f32_16x16x128_f8f6f4(Bt[n], At[m], acc[ai][bj][m][n], 0, 0, 0, 0x7f7f7f7f, 0, 0x7f7f7f7f); } \
        else { _Pragma("unroll") for (int m = 0; m < 4; ++m) _Pragma("unroll") for (int n = 0; n < 2; ++n) { \
            acc[ai][bj][m][n] = __builtin_amdgcn_mfma_f32_16x16x32_bf16(PG8_LO(Bt[n]), PG8_LO(At[m]), acc[ai][bj][m][n], 0, 0, 0); \
            acc[ai][bj][m][n] = __builtin_amdgcn_mfma_f32_16x16x32_bf16(PG8_HI(Bt[n]), PG8_HI(At[m]), acc[ai][bj][m][n], 0, 0, 0); } } \
        __builtin_amdgcn_s_setprio(0); } while (0)
#define PG8_WAIT_V(n) asm volatile("s_waitcnt vmcnt(" #n ")" ::: "memory")
#define PG8_WAIT_L(n) asm volatile("s_waitcnt lgkmcnt(" #n ")" ::: "memory")
#define PG8_BAR __builtin_amdgcn_s_barrier()
#define PG8_SCHED __builtin_amdgcn_sched_barrier(0)
    Unit cur, nxt; int ui = 0;
    if (!S.next(0, cur)) return;
    f32x4 acc[2][2][4][2];
#pragma unroll
    for (int a = 0; a < 2; ++a)
#pragma unroll
        for (int b = 0; b < 2; ++b)
#pragma unroll
            for (int m = 0; m < 4; ++m)
#pragma unroll
                for (int n = 0; n < 2; ++n) acc[a][b][m][n] = (f32x4){0.f, 0.f, 0.f, 0.f};
    i32x8 At[4], B0[2], B1[2];
    unsigned oA0[2], oA1[2];
#pragma unroll
    for (int i = 0; i < 2; ++i) { oA0[i] = RW.off(cur, sR[i]) + sC[i]; oA1[i] = RW.off(cur, HALF + sR[i]) + sC[i]; }
    const char* cB = cur.B;
    PG8_STAGE(PG8_SB(0, 0), cB, voffB); PG8_STAGE(PG8_SB(0, 1), cB + hstepB, voffB); PG8_STAGE(PG8_SA(0, 0), Abase, oA0); PG8_STAGE(PG8_SA(0, 1), Abase, oA1);
    if (wr == 1) PG8_BAR;
    PG8_WAIT_V(2); PG8_BAR;
    PG8_STAGE(PG8_SB(1, 0), cB + kstep, voffB); PG8_STAGE(PG8_SA(1, 0), Abase + kstep, oA0); PG8_STAGE(PG8_SB(1, 1), cB + hstepB + kstep, voffB);
    PG8_WAIT_V(6); PG8_BAR;
    for (;;) {
        const bool has_next = S.next(ui + 1, nxt);
        unsigned gi0 = 0u, gi1 = 0u, gi2 = 0u, gi3 = 0u;
        if (has_next && RW.list) {
            int t2 = threadIdx.x; asm volatile("" : "+v"(t2)); int R0, C0, R1, C1; stage_rc(t2 * 16, R0, C0); stage_rc(t2 * 16 + 8192, R1, C1);
            const int* lb = RW.list + (size_t)nxt.pm * 256; const unsigned o0 = (unsigned)R0 * 4u, o1 = (unsigned)R1 * 4u, o2 = (unsigned)(HALF + R0) * 4u, o3 = (unsigned)(HALF + R1) * 4u;
            asm volatile("global_load_dword %0, %4, %8\n\tglobal_load_dword %1, %5, %8\n\tglobal_load_dword %2, %6, %8\n\tglobal_load_dword %3, %7, %8"
                         : "=&v"(gi0), "=&v"(gi1), "=&v"(gi2), "=&v"(gi3) : "v"(o0), "v"(o1), "v"(o2), "v"(o3), "s"(lb));
        }
#pragma unroll 1
        for (int t = 0; t < nt; t += 2) {
            const bool last = (t == nt - 2);
            const char* a1 = Abase + (size_t)(t + 1) * kstep;
            PG8_LDB(B0, 0, 0); PG8_LDB(B1, 0, 1); PG8_SCHED; PG8_LDA(At, 0, 0); PG8_STAGE(PG8_SA(1, 1), a1, oA1);
            PG8_WAIT_V(8); PG8_WAIT_L(0); PG8_BAR; PG8_MMA(0, 0, At, B0); PG8_MMA(0, 1, At, B1); PG8_BAR; PG8_SCHED;
            const char* a2; const char* b2;
            if (last) {
                if (has_next) {
                    int t2 = threadIdx.x; asm volatile("" : "+v"(t2));
#pragma unroll
                    for (int i = 0; i < 2; ++i) { int R, C; stage_rc(t2 * 16 + i * 8192, R, C);
                        if (RW.list) { asm volatile("" : "+v"(gi0), "+v"(gi1), "+v"(gi2), "+v"(gi3)); oA0[i] = (i ? gi1 : gi0) * RW.ldab + (unsigned)C * 2u; oA1[i] = (i ? gi3 : gi2) * RW.ldab + (unsigned)C * 2u; }
                        else { oA0[i] = (unsigned)(nxt.pm * 256 + R) * RW.ldab + (unsigned)C * 2u; oA1[i] = (unsigned)(nxt.pm * 256 + HALF + R) * RW.ldab + (unsigned)C * 2u; } }
                    cB = nxt.B;
                }
                a2 = Abase; b2 = cB;
            } else { a2 = Abase + (size_t)(t + 2) * kstep; b2 = cB + (size_t)(t + 2) * kstep; }
            const char* a3 = a2 + kstep; const char* b3 = b2 + kstep;
            PG8_LDA(At, 0, 1); PG8_STAGE(PG8_SB(0, 0), b2, voffB); PG8_STAGE(PG8_SB(0, 1), b2 + hstepB, voffB); PG8_STAGE(PG8_SA(0, 0), a2, oA0);
            PG8_WAIT_V(8); PG8_WAIT_L(0); PG8_BAR; PG8_MMA(1, 0, At, B0); PG8_MMA(1, 1, At, B1); PG8_BAR; PG8_SCHED;
            PG8_LDB(B0, 1, 0); PG8_LDB(B1, 1, 1); PG8_SCHED; PG8_LDA(At, 1, 0); PG8_STAGE(PG8_SA(0, 1), a2, oA1);
            PG8_WAIT_V(8); PG8_WAIT_L(0); PG8_BAR; PG8_MMA(0, 0, At, B0); PG8_MMA(0, 1, At, B1); PG8_BAR; PG8_SCHED;
            PG8_LDA(At, 1, 1); PG8_STAGE(PG8_SB(1, 0), b3, voffB); PG8_STAGE(PG8_SB(1, 1), b3 + hstepB, voffB); PG8_STAGE(PG8_SA(1, 0), a3, oA0);
            PG8_WAIT_V(8); PG8_WAIT_L(0); PG8_BAR; PG8_MMA(1, 0, At, B0); PG8_MMA(1, 1, At, B1); PG8_BAR; PG8_SCHED;
        }
        if (wr == 0) PG8_BAR;
        { Unit eu = cur; asm volatile("" : "+s"(eu.pm), "+s"(eu.pn)); int t3 = threadIdx.x; asm volatile("" : "+v"(t3)); E(acc, eu, wr, wc, t3 & 15, (t3 & 63) >> 4); }
        if (!has_next) break;
#pragma unroll
        for (int a = 0; a < 2; ++a)
#pragma unroll
            for (int b = 0; b < 2; ++b)
#pragma unroll
                for (int m = 0; m < 4; ++m)
#pragma unroll
                    for (int n = 0; n < 2; ++n) acc[a][b][m][n] = (f32x4){0.f, 0.f, 0.f, 0.f};
        cur = nxt; ++ui;
        if (wr == 1) PG8_BAR;
    }
    PG8_WAIT_V(0);
    PG8_BAR;
#undef PG8_SA
#undef PG8_SB
#undef PG8_STAGE
#undef PG8_LDA
#undef PG8_LDB
#undef PG8_MMA
#undef PG8_CAT
#undef PG8_LO
#undef PG8_HI
#undef PG8_WAIT_V
#undef PG8_WAIT_L
#undef PG8_BAR
#undef PG8_SCHED
}
}

struct Params { const float* in[42]; float* out; unsigned char* ws; int ph_lo, ph_hi; };
enum { I_X = 0, I_C, I_CTX, I_CCTX, I_ADAW, I_ADAB, I_N1G, I_N2G, I_WIN, I_WOUT, I_GLAW, I_GLAB, I_GLAG, I_CDW, I_CDB, I_CLG, I_CLB, I_CPW, I_CPB,
       I_S5LR, I_S5LI, I_S5DT, I_S5BR, I_S5BI, I_S5CR, I_S5CI, I_S5D, I_S5GW, I_S5GB, I_QNG, I_KVNG, I_WUQ, I_WUKV, I_RW, I_RB, I_MG, I_MU, I_MD, I_SG, I_SU, I_SD, I_FG };

typedef const __attribute__((address_space(4))) Params* KParams;
__device__ __forceinline__ KParams fresh_params() { KParams kp = (KParams)__builtin_amdgcn_kernarg_segment_ptr(); asm volatile("" : "+s"(kp)); return kp; }
struct Ctx {
    LAS unsigned char* lds;
    int tid, lane, wave, blk, G;
    unsigned char* ws;
};

__device__ __forceinline__ int mod_row(int r) { return r < NLAT ? (r >> 11) : 32; }

__device__ __forceinline__ unsigned pk4_fp8(float a, float b, float c2, float d) {
    int pk = __builtin_amdgcn_cvt_pk_fp8_f32(__builtin_amdgcn_fmed3f(a, -440.f, 440.f), __builtin_amdgcn_fmed3f(b, -440.f, 440.f), 0, false);
    pk = __builtin_amdgcn_cvt_pk_fp8_f32(__builtin_amdgcn_fmed3f(c2, -440.f, 440.f), __builtin_amdgcn_fmed3f(d, -440.f, 440.f), pk, true); return (unsigned)pk; }
template <bool F8 = false>
__device__ __forceinline__ void tr_item(const float* W, int ldw, int k0, int n0, bf16* dst, int ldk, const float* kscale, float sc, LAS float* scr, int lane) {
    float tv[32];
#pragma unroll
    for (int i = 0; i < 32; ++i) tv[i] = W[(size_t)(k0 + 2 * i + (lane >> 5)) * ldw + n0 + (lane & 31)];
#pragma unroll
    for (int i = 0; i < 32; ++i) { const int kk = 2 * i + (lane >> 5); float v = tv[i] * sc; if (kscale) v *= kscale[k0 + kk]; scr[kk * 33 + (lane & 31)] = v; }
    lds_wait();
    const int c = lane & 7;
#pragma unroll
    for (int j = 0; j < 4; ++j) { const int n = (lane >> 3) + 8 * j; const LAS float* s = scr + (8 * c) * 33 + n;
        if (F8) { u32x2 o; o.x = pk4_fp8(s[0 * 33], s[1 * 33], s[2 * 33], s[3 * 33]); o.y = pk4_fp8(s[4 * 33], s[5 * 33], s[6 * 33], s[7 * 33]); *(u32x2*)((unsigned char*)dst + (size_t)n * ldk + k0 + 8 * c) = o; }
        else { u32x4 o; o.x = pk2(s[0 * 33], s[1 * 33]); o.y = pk2(s[2 * 33], s[3 * 33]); o.z = pk2(s[4 * 33], s[5 * 33]); o.w = pk2(s[6 * 33], s[7 * 33]);
            *(u32x4*)(dst + (size_t)n * ldk + k0 + 8 * c) = o; } }
    lds_wait();
}
template <int KIND> __device__ __forceinline__ int tr_dst(int n0) {
    if (KIND == 0) return n0;
    if (KIND == 1) return n0 < 768 ? n0 : (n0 == 768 ? 1952 : n0 - 32);
    if (KIND == 2) { const int half = n0 >> 8, c = n0 & 255; return (c >> 7) * 256 + half * 128 + (c & 127); }
    if (KIND == 3) { const int head = n0 / 96, d0 = n0 % 96; return d0 < 64 ? head * 64 + d0 : 256 + head * 32; }
    if (KIND == 4) { const int head = n0 >> 7, d0 = n0 & 127; return d0 < 64 ? head * 64 + d0 : 256 + head * 64 + (d0 - 64); }
    if (KIND == 5) return (n0 >> 7) * 256 + (n0 & 127);
    if (KIND == 6) return (n0 >> 7) * 256 + 128 + (n0 & 127);
    return n0;
}
template <int KIND, bool F8 = false> __device__ __forceinline__ void tr_matrix(const Ctx& c, const float* W, int ldw, int K, int Nsrc, bf16* WT, int ldk, const float* kscale, float sc) {
    LAS float* scr = (LAS float*)(c.lds + c.wave * 8704);
    const int gw = c.blk * NWAVES + c.wave, NGW = c.G * NWAVES, ng = Nsrc / 32, items = (K / 64) * ng;
    for (int it = gw; it < items; it += NGW) { const int kb = it / ng, g = it % ng; tr_item<F8>(W, ldw, kb * 64, 32 * g, F8 ? (bf16*)((unsigned char*)WT + (size_t)tr_dst<KIND>(32 * g) * ldk) : WT + (size_t)tr_dst<KIND>(32 * g) * ldk, ldk, kscale, sc, scr, c.lane); }
}
__device__ __forceinline__ void zero_fill16(const Ctx& c, void* p, size_t bytes) {
    u32x4* q = (u32x4*)p; const size_t n = bytes / 16;
    for (size_t i = (size_t)c.blk * NTHR + c.tid; i < n; i += (size_t)c.G * NTHR) q[i] = (u32x4){0u, 0u, 0u, 0u};
}
__device__ __forceinline__ void sincos_r(float x, float& s, float& co) {
    const float n = rintf(x * 0.15915494309189535f);
    float r = fmaf(n, -6.28125f, x); r = fmaf(n, -1.9353071795864769e-3f, r);
    s = __sinf(r); co = __cosf(r);
}

__device__ __forceinline__ void prologue_moe_weights(const Ctx& c, KParams p, int l) {
    unsigned char* WGU8 = c.ws + WS_WMOE + (size_t)l * 48 * MiB;
    unsigned char* WD8 = WGU8 + (size_t)NE * 512 * 1024;
    LAS float* scr = (LAS float*)(c.lds + c.wave * 8704);
    const int gw = c.blk * NWAVES + c.wave, NGW = c.G * NWAVES;
    for (int it = gw; it < NE * 384; it += NGW) {
        const int e = it / 384, r = it % 384;
        if (r < 256) { const int up = r >> 7, q = r & 127, kb = q >> 3, g = q & 7;
            const float* W = p->in[up ? I_MU : I_MG] + ((size_t)l * NE + e) * 1024 * 256;
            const int nd = up ? tr_dst<6>(32 * g) : tr_dst<5>(32 * g);
            tr_item<true>(W, 256, kb * 64, 32 * g, (bf16*)(WGU8 + (size_t)e * 512 * 1024 + (size_t)nd * 1024), 1024, nullptr, 64.f, scr, c.lane);
        } else { const int q = r - 256, kb = q >> 5, g = q & 31;
            const float* W = p->in[I_MD] + ((size_t)l * NE + e) * 256 * 1024;
            tr_item<true>(W, 1024, kb * 64, 32 * g, (bf16*)(WD8 + (size_t)e * 1024 * 256 + (size_t)(32 * g) * 256), 256, nullptr, 64.f, scr, c.lane);
        }
    }
}

__device__ __forceinline__ void prologue(const Ctx& c, KParams p) {
    float* MOD = (float*)(c.ws + WS_MOD);
    {
        const int u = c.G - 1 - c.blk;
        if (u < 96) {
            LAS float* sc = (LAS float*)(c.lds + 72 * 1024);
            LAS float* part = (LAS float*)c.lds;
            const int l = u / 48, kq = c.tid >> 7, cj = c.tid & 127, col = (u % 48) * 128 + cj;
            const float* W = p->in[I_ADAW] + (size_t)l * 1024 * 6144;
            float acc[33];
#pragma unroll
            for (int b = 0; b < 33; ++b) acc[b] = 0.f;
            for (int j = 0; j < 4; ++j) {
                __syncthreads();
                for (int i = c.tid; i < 4 * 33 * 64; i += NTHR) { const int q = i / (33 * 64), r = i % (33 * 64), b = r >> 6, kk = r & 63, k = 256 * q + 64 * j + kk; const float v = b < 32 ? p->in[I_C][b * 1024 + k] : p->in[I_CCTX][k]; sc[i] = siluf_(v); }
                __syncthreads();
                const float* wp = W + (size_t)(256 * kq + 64 * j) * 6144 + col; const LAS float* sq = sc + kq * 33 * 64;
#pragma unroll 8
                for (int kk = 0; kk < 64; ++kk) { const float w = wp[(size_t)kk * 6144];
#pragma unroll
                    for (int b = 0; b < 33; ++b) acc[b] = fmaf(sq[b * 64 + kk], w, acc[b]); }
            }
#pragma unroll
            for (int b = 0; b < 33; ++b) part[(kq * 33 + b) * 128 + cj] = acc[b];
            __syncthreads();
            for (int i = c.tid; i < 33 * 128; i += NTHR) { const int b = i >> 7, cc = i & 127, gc = (u % 48) * 128 + cc;
                MOD[((size_t)l * 33 + b) * 6144 + gc] = (part[(0 * 33 + b) * 128 + cc] + part[(1 * 33 + b) * 128 + cc]) + (part[(2 * 33 + b) * 128 + cc] + part[(3 * 33 + b) * 128 + cc]) + p->in[I_ADAB][l * 6144 + gc]; }
            __syncthreads();
        }
    }
    {
        float* ROPE = (float*)(c.ws + WS_TAB + TAB_ROPE);
        for (int i = c.blk * NTHR + c.tid; i < 2048 * 16; i += c.G * NTHR) { const int t = i >> 4, ax = (i >> 3) & 1, f = i & 7;
            const float pos = (float)(ax == 0 ? (t >> 6) : (t & 63)); const float inv = __expf(-(float)f * (9.210340371976184f / 8.0f));
            float s, co; sincos_r(pos * inv, s, co); ROPE[i * 2] = co; ROPE[i * 2 + 1] = s; }
        bf16* RWT = (bf16*)(c.ws + WS_TAB + TAB_RWT);
        for (int i = c.blk * NTHR + c.tid; i < 2 * 64 * 1024; i += c.G * NTHR) { const int l = i >> 16, n = (i >> 10) & 63, k = i & 1023; const float wv = p->in[I_RW][((size_t)l * 1024 + k) * 64 + n];
            const bf16 hi = f2bf(wv); RWT[(size_t)(l * 2) * 65536 + n * 1024 + k] = hi; RWT[(size_t)(l * 2 + 1) * 65536 + n * 1024 + k] = f2bf(wv - bf2f(hi)); }
        float* S5T = (float*)(c.ws + WS_TAB + TAB_S5);
        for (int i = c.blk * NTHR + c.tid; i < 2 * 2 * 16 * 64; i += c.G * NTHR) {
            const int pp = i & 63, g = (i >> 6) & 15, ld = i >> 10;
            const float lr = p->in[I_S5LR][i], li = p->in[I_S5LI][i], dt = __expf(p->in[I_S5DT][ld * 16 + g]);
            const float mag = __expf(lr * dt); float s, co; sincos_r(li * dt, s, co);
            const float are = mag * co, aim = mag * s, den = lr * lr + li * li;
            const float fre = ((are - 1.f) * lr + aim * li) / den, fim = (aim * lr - (are - 1.f) * li) / den;
            float* T = S5T + (size_t)i * 66; T[0] = are; T[1] = aim;
            { float* PW = (float*)(c.ws + WS_S5P) + (size_t)i * 34; float pr = 1.f, pi = 0.f;
              for (int e = 0; e <= 16; ++e) { PW[2 * e] = pr; PW[2 * e + 1] = pi; const float nr = pr * are - pi * aim, ni = pr * aim + pi * are; pr = nr; pi = ni; } }
            for (int ch = 0; ch < 16; ++ch) { const float br = p->in[I_S5BR][(size_t)i * 16 + ch], bi = p->in[I_S5BI][(size_t)i * 16 + ch];
                T[2 + ch] = fre * br - fim * bi; T[18 + ch] = fre * bi + fim * br;
                T[34 + ch] = p->in[I_S5CR][((size_t)(ld * 16 + g) * 16 + ch) * 64 + pp]; T[50 + ch] = p->in[I_S5CI][((size_t)(ld * 16 + g) * 16 + ch) * 64 + pp]; }
        }
    }
    for (int l = 0; l < 2; ++l) {
        bf16* WIN = (bf16*)(c.ws + WS_WIN) + (size_t)l * 2048 * 1024;
        tr_matrix<1, true>(c, p->in[I_WIN] + (size_t)l * 1024 * 1984, 1984, 1024, 1984, WIN, 1024, nullptr, 64.f);
        zero_fill16(c, (unsigned char*)WIN + (size_t)1984 * 1024, (size_t)64 * 1024);
        tr_matrix<0, true>(c, p->in[I_WOUT] + (size_t)l * 1024 * 1024, 1024, 1024, 1024, (bf16*)(c.ws + WS_WOUT) + (size_t)l * 1024 * 1024, 1024, nullptr, 64.f);
        unsigned char* sm = c.ws + WS_WSM + (size_t)l * WSM_L;
        tr_matrix<0>(c, p->in[I_CPW] + (size_t)l * 256 * 256, 256, 256, 256, (bf16*)(sm + WSM_PW), 256, nullptr, 1.f);
        tr_matrix<2>(c, p->in[I_S5GW] + (size_t)l * 256 * 512, 512, 256, 512, (bf16*)(sm + WSM_GLU), 256, nullptr, 1.f);
        tr_matrix<3>(c, p->in[I_WUQ] + (size_t)l * 256 * 384, 384, 256, 384, (bf16*)(sm + WSM_UQ), 256, p->in[I_QNG] + l * 256, 0.14724445f  );
        zero_fill16(c, (bf16*)(sm + WSM_UQ) + (size_t)384 * 256, (size_t)128 * 256 * 2);
        zero_fill16(c, sm + WSM_UK, (size_t)512 * 256 * 2);
    }
    for (int l = 0; l < 2; ++l) {
        bf16* WSGU = (bf16*)(c.ws + WS_WSH) + (size_t)l * (512 * 1024 + 1024 * 256); bf16* WSD = WSGU + 512 * 1024;
        tr_matrix<5, true>(c, p->in[I_SG] + (size_t)l * 1024 * 256, 256, 1024, 256, WSGU, 1024, nullptr, 64.f);
        tr_matrix<6, true>(c, p->in[I_SU] + (size_t)l * 1024 * 256, 256, 1024, 256, WSGU, 1024, nullptr, 64.f);
        tr_matrix<0, true>(c, p->in[I_SD] + (size_t)l * 256 * 1024, 1024, 256, 1024, (bf16*)((unsigned char*)WSGU + 512 * 1024), 256, nullptr, 64.f);
    }
    prologue_moe_weights(c, p, 0);
    prologue_moe_weights(c, p, 1);
}
__device__ __forceinline__ void prologue_s5_weights(const Ctx& c, KParams p) {
    const float* S5T = (const float*)(c.ws + WS_TAB + TAB_S5); const float* S5P = (const float*)(c.ws + WS_S5P);
    LAS float* pw = (LAS float*)c.lds;
    LAS float* bb = pw + 2 * 17 * 64 * 2;
    LAS float* cc = bb + 2 * 64 * 16 * 2;
    LAS float* kt = cc + 2 * 16 * 64 * 2;
    for (int uu = c.blk; uu < 256; uu += c.G) {
        const int u = uu & 31, part = uu >> 5; const int l = u >> 4, g = u & 15;
        __syncthreads();
        for (int i = c.tid; i < 2 * 64; i += NTHR) { const int dir = i >> 6, pp = i & 63; const size_t row = (size_t)((l * 2 + dir) * 16 + g) * 64 + pp; const float* T = S5T + row * 66; const float* PW = S5P + row * 34;
            for (int e = 0; e <= 16; ++e) { pw[((dir * 17 + e) * 64 + pp) * 2] = PW[2 * e]; pw[((dir * 17 + e) * 64 + pp) * 2 + 1] = PW[2 * e + 1]; }
            for (int ch = 0; ch < 16; ++ch) { bb[((dir * 64 + pp) * 16 + ch) * 2] = T[2 + ch]; bb[((dir * 64 + pp) * 16 + ch) * 2 + 1] = T[18 + ch]; cc[((dir * 16 + ch) * 64 + pp) * 2] = T[34 + ch]; cc[((dir * 16 + ch) * 64 + pp) * 2 + 1] = T[50 + ch]; } }
        __syncthreads();
        for (int i = c.tid; i < 2 * 16 * 256; i += NTHR) { const int dir = i >> 12, tau = (i >> 8) & 15, c1 = (i >> 4) & 15, c0 = i & 15; float s = 0.f;
            for (int pp = 0; pp < 64; ++pp) { const float cr = cc[((dir * 16 + c1) * 64 + pp) * 2], ci = cc[((dir * 16 + c1) * 64 + pp) * 2 + 1], pr = pw[((dir * 17 + tau) * 64 + pp) * 2], pi = pw[((dir * 17 + tau) * 64 + pp) * 2 + 1];
                const float wr_ = cr * pr - ci * pi, wi_ = cr * pi + ci * pr; s += wr_ * bb[((dir * 64 + pp) * 16 + c0) * 2] - wi_ * bb[((dir * 64 + pp) * 16 + c0) * 2 + 1]; }
            kt[i] = s; }
        __syncthreads();
        bf16* B1 = (bf16*)(c.ws + WS_S5W) + (size_t)(l * 16 + g) * 256 * 256;
        bf16* B2 = (bf16*)(c.ws + WS_S5W) + (size_t)32 * 256 * 256 + (size_t)(l * 16 + g) * 256 * 512;
        const float* dsk = p->in[I_S5D] + l * 256 + g * 16;
        for (int i = part * 8192 + c.tid; i < (part + 1) * 8192; i += NTHR) { const int n = i >> 8, k = i & 255, dir = n >> 7, ri = (n >> 6) & 1, pp = n & 63, s = k >> 4, ch = k & 15, e = dir ? s : 15 - s;
            const float pr = pw[((dir * 17 + e) * 64 + pp) * 2], pi = pw[((dir * 17 + e) * 64 + pp) * 2 + 1], br = bb[((dir * 64 + pp) * 16 + ch) * 2], bi = bb[((dir * 64 + pp) * 16 + ch) * 2 + 1];
            B1[i] = f2bf(ri ? pr * bi + pi * br : pr * br - pi * bi); }
        for (int i = part * 16384 + c.tid; i < (part + 1) * 16384; i += NTHR) { const int n = i >> 9, k = i & 511, t = n >> 4, c1 = n & 15; float v;
            if (k < 256) { const int s = k >> 4, c0 = k & 15; v = 0.f; if (s <= t) v += kt[((0 * 16 + (t - s)) * 16 + c1) * 16 + c0]; if (s >= t) v += kt[((1 * 16 + (s - t)) * 16 + c1) * 16 + c0]; if (s == t && c0 == c1) v += dsk[c0]; }
            else { const int q = k - 256, dir = q >> 7, ri = (q >> 6) & 1, pp = q & 63, e = dir ? 16 - t : t + 1;
                const float cr = cc[((dir * 16 + c1) * 64 + pp) * 2], ci = cc[((dir * 16 + c1) * 64 + pp) * 2 + 1], pr = pw[((dir * 17 + e) * 64 + pp) * 2], pi = pw[((dir * 17 + e) * 64 + pp) * 2 + 1];
                v = ri ? -(cr * pi + ci * pr) : (cr * pr - ci * pi); }
            B2[i] = f2bf(v); }
    }
    __syncthreads();
}
__device__ __forceinline__ void prologue2(const Ctx& c, KParams p) {
    prologue_s5_weights(c, p);
    for (int l = 0; l < 2; ++l) { unsigned char* sm = c.ws + WS_WSM + (size_t)l * WSM_L;
        tr_matrix<4>(c, p->in[I_WUKV] + (size_t)l * 128 * 512, 512, 128, 512, (bf16*)(sm + WSM_UK), 256, p->in[I_KVNG] + l * 128, 1.f); }
}

__device__ __forceinline__ void norm_row(const float* xrow, const float* gain, const float* sh, const float* sc, bf16* orow, int lane, f32x4 (&v)[4]) {
    float ss = 0.f;
#pragma unroll
    for (int j = 0; j < 4; ++j) { v[j] = *(const f32x4*)(xrow + 4 * lane + 256 * j); ss += (v[j].x * v[j].x + v[j].y * v[j].y) + (v[j].z * v[j].z + v[j].w * v[j].w); }
    const float rstd = rsqrtf(wave_sum(ss) * (1.f / 1024.f) + EPS);
#pragma unroll
    for (int j = 0; j < 4; ++j) { const int cc = 4 * lane + 256 * j; const f32x4 g = *(const f32x4*)(gain + cc), s1 = *(const f32x4*)(sc + cc), s0 = *(const f32x4*)(sh + cc);
        v[j] = v[j] * rstd * g * (s1 + 1.0f) + s0;
        u32x2 o; o.x = pk2(v[j].x, v[j].y); o.y = pk2(v[j].z, v[j].w); *(u32x2*)(orow + cc) = o; }
}
__device__ __forceinline__ void norm_row_add(const float* xrow, const bf16* drow, float* xout, const float* gain, const float* sh, const float* sc, unsigned char* orow8, int lane, f32x4 (&v)[4]) {
    float ss = 0.f; u32x2 dl[4];
#pragma unroll
    for (int j = 0; j < 4; ++j) { v[j] = *(const f32x4*)(xrow + 4 * lane + 256 * j); dl[j] = *(const u32x2*)(drow + 4 * lane + 256 * j); }
#pragma unroll
    for (int j = 0; j < 4; ++j) { v[j] += (f32x4){__uint_as_float(dl[j].x << 16), __uint_as_float(dl[j].x & 0xffff0000u), __uint_as_float(dl[j].y << 16), __uint_as_float(dl[j].y & 0xffff0000u)};
        *(f32x4*)(xout + 4 * lane + 256 * j) = v[j]; ss += (v[j].x * v[j].x + v[j].y * v[j].y) + (v[j].z * v[j].z + v[j].w * v[j].w); }
    const float rstd = rsqrtf(wave_sum(ss) * (1.f / 1024.f) + EPS);
#pragma unroll
    for (int j = 0; j < 4; ++j) { const int cc = 4 * lane + 256 * j; const f32x4 g = *(const f32x4*)(gain + cc), s1 = *(const f32x4*)(sc + cc), s0 = *(const f32x4*)(sh + cc);
        v[j] = v[j] * rstd * g * (s1 + 1.0f) + s0;
        *(unsigned*)(orow8 + cc) = pk4_fp8(v[j].x * 4.f, v[j].y * 4.f, v[j].z * 4.f, v[j].w * 4.f); }
}
__device__ __forceinline__ void phase_norm1(const Ctx& c, KParams p, int l) {
    const float* MOD = (const float*)(c.ws + WS_MOD) + (size_t)l * 33 * 6144;
    const float* xl = l == 0 ? p->in[I_X] : p->out; const float* xc = l == 0 ? p->in[I_CTX] : (const float*)(c.ws + WS_XC);
    unsigned char* H = c.ws + WS_H; const float* gain = p->in[I_N1G] + l * DM;
    const int gw = c.blk * NWAVES + c.wave, NGW = c.G * NWAVES, lane = c.lane;
    for (int r0 = gw; r0 < NTOK; r0 += 2 * NGW) {
        f32x4 v[2][4]; float ss[2];
#pragma unroll
        for (int k = 0; k < 2; ++k) { const int r = r0 + k * NGW < NTOK ? r0 + k * NGW : r0; const float* xr = r < NLAT ? xl + (size_t)r * DM : xc + (size_t)(r - NLAT) * DM;
#pragma unroll
            for (int j = 0; j < 4; ++j) v[k][j] = *(const f32x4*)(xr + 4 * lane + 256 * j); }
#pragma unroll
        for (int k = 0; k < 2; ++k) { ss[k] = 0.f;
#pragma unroll
            for (int j = 0; j < 4; ++j) ss[k] += (v[k][j].x * v[k][j].x + v[k][j].y * v[k][j].y) + (v[k][j].z * v[k][j].z + v[k][j].w * v[k][j].w); }
#pragma unroll
        for (int k = 0; k < 2; ++k) { const int r = r0 + k * NGW; if (r < NTOK) { const float rstd = rsqrtf(wave_sum(ss[k]) * (1.f / 1024.f) + EPS); const float* m = MOD + (size_t)mod_row(r) * 6144; unsigned char* orow = H + (size_t)r * DM;
#pragma unroll
            for (int j = 0; j < 4; ++j) { const int cc = 4 * lane + 256 * j; const f32x4 g = *(const f32x4*)(gain + cc), s1 = *(const f32x4*)(m + 1024 + cc), s0 = *(const f32x4*)(m + cc);
                const f32x4 y = (v[k][j] * rstd * g * (s1 + 1.0f) + s0) * 4.f; *(unsigned*)(orow + cc) = pk4_fp8(y.x, y.y, y.z, y.w); } } }
    }
}

#define EPI_ARGS const f32x4 (&acc)[2][2][4][2], const pg8::Unit& u, int wr, int wc, int fr, int fq
#define EPI_ROWS for (int ai = 0; ai < 2; ++ai) _Pragma("unroll") for (int m = 0; m < 4; ++m)
struct EpiBf16 {
    bf16* O; int ldo;
    __device__ __forceinline__ void operator()(EPI_ARGS) const {
        const int r0 = u.pm * 256 + wr * 64 + fr, c0 = u.pn * 256 + wc * 32 + 8 * fq;
#pragma unroll
        EPI_ROWS { bf16* rp = O + (size_t)(r0 + ai * 128 + m * 16) * ldo + c0;
#pragma unroll
            for (int bj = 0; bj < 2; ++bj) { const f32x4 a = acc[ai][bj][m][0], b = acc[ai][bj][m][1]; u32x4 w; w.x = pk2(a.x, a.y); w.y = pk2(a.z, a.w); w.z = pk2(b.x, b.y); w.w = pk2(b.z, b.w); *(u32x4*)(rp + bj * 128) = w; } asm volatile("" ::: "memory"); }
    }
};
struct EpiInProj {
    bf16* O; bf16* UP; bf16* GVT; float sc;
    __device__ __forceinline__ void operator()(EPI_ARGS) const {
        const int r0 = u.pm * 256 + wr * 64 + fr, c0 = u.pn * 256 + wc * 32 + 8 * fq;
#pragma unroll
        EPI_ROWS { const int row = r0 + ai * 128 + m * 16; bf16* rp = O + (size_t)row * ZW + c0;
            const int crow = row < NLAT ? (row >> 11) * 144 + 16 + ((row & 2047) >> 4) : ((row - NLAT) >> 8) * 144 + (((row - NLAT) & 255) >> 4);
#pragma unroll
            for (int bj = 0; bj < 2; ++bj) { const f32x4 a = acc[ai][bj][m][0] * sc, b = acc[ai][bj][m][1] * sc; u32x4 w; w.x = pk2(a.x, a.y); w.y = pk2(a.z, a.w); w.z = pk2(b.x, b.y); w.w = pk2(b.z, b.w);
                if (u.pn != 1 && u.pn != 5) *(u32x4*)(rp + bj * 128) = w;
                if (u.pn == 5) { const int g = 8 * bj + 2 * wc + (fq >> 1); *(u32x4*)(UP + ((size_t)g * 4608 + crow) * 512 + fr * 16 + 8 * (fq & 1)) = w; }
                if (u.pn == 1) { const int col = 128 * bj + 32 * wc + 8 * fq, bb = row < NLAT ? (row >> 11) : ((row - NLAT) >> 8), kk = row < NLAT ? 256 + (row & 2047) : ((row - NLAT) & 255);
                    bf16* dst = GVT + ((size_t)(bb * 4 + (col >> 6)) * 64 + (col & 63)) * 2304 + (kk & ~15) + 8 * ((fr >> 2) & 1) + 4 * (fr >> 3) + (fr & 3);
#pragma unroll
                    for (int n = 0; n < 2; ++n)
#pragma unroll
                        for (int i = 0; i < 4; ++i) dst[(size_t)(4 * n + i) * 2304] = f2bf(acc[ai][bj][m][n][i] * sc); } }
            asm volatile("" ::: "memory"); }
    }
};
struct EpiS5X {
    bf16* XE;
    __device__ __forceinline__ void operator()(EPI_ARGS) const {
        const int r0 = u.pm * 256 + wr * 64 + fr, c0 = wc * 32 + 8 * fq;
#pragma unroll
        EPI_ROWS { bf16* rp = XE + (size_t)(r0 + ai * 128 + m * 16) * 256 + c0;
#pragma unroll
            for (int bj = 0; bj < 2; ++bj) { const f32x4 a = acc[ai][bj][m][0], b = acc[ai][bj][m][1]; u32x4 w; w.x = pk2(a.x, a.y); w.y = pk2(a.z, a.w); w.z = pk2(b.x, b.y); w.w = pk2(b.z, b.w); *(u32x4*)(rp + bj * 128) = w; }
            asm volatile("" ::: "memory"); }
    }
};
struct EpiS5Y {
    bf16* Y;
    __device__ __forceinline__ void operator()(EPI_ARGS) const {
        const int r0 = u.pm * 256 + wr * 64 + fr;
#pragma unroll
        EPI_ROWS { const int grow = r0 + ai * 128 + m * 16; const int g = grow / 4608, rem = grow - g * 4608, b = rem / 144, ci = rem - b * 144;
            const int tok0 = ci < 16 ? NLAT + b * CTXL + ci * 16 : b * SEQ + (ci - 16) * 16;
#pragma unroll
            for (int bj = 0; bj < 2; ++bj) { const int t = 8 * bj + 2 * wc + (fq >> 1); const f32x4 a = acc[ai][bj][m][0], bq = acc[ai][bj][m][1]; u32x4 w; w.x = pk2(a.x, a.y); w.y = pk2(a.z, a.w); w.z = pk2(bq.x, bq.y); w.w = pk2(bq.z, bq.w);
                *(u32x4*)(Y + (size_t)(tok0 + t) * 256 + g * 16 + 8 * (fq & 1)) = w; }
            asm volatile("" ::: "memory"); }
    }
};
struct EpiOB8 {
    unsigned char* OB; float sc;
    __device__ __forceinline__ void operator()(EPI_ARGS) const {
        const int r0 = u.pm * 256 + wr * 64 + fr;
#pragma unroll
        EPI_ROWS { unsigned char* rp = OB + (size_t)(r0 + ai * 128 + m * 16) * 1024 + u.pn * 256 + (wc * 4 + fq) * 16; u32x4 w;
#pragma unroll
            for (int bj = 0; bj < 2; ++bj)
#pragma unroll
                for (int n = 0; n < 2; ++n) { const f32x4 a = acc[ai][bj][m][n] * sc; int pk = 0;
                    pk = __builtin_amdgcn_cvt_pk_fp8_f32(__builtin_amdgcn_fmed3f(a.x, -440.f, 440.f), __builtin_amdgcn_fmed3f(a.y, -440.f, 440.f), pk, false);
                    pk = __builtin_amdgcn_cvt_pk_fp8_f32(__builtin_amdgcn_fmed3f(a.z, -440.f, 440.f), __builtin_amdgcn_fmed3f(a.w, -440.f, 440.f), pk, true); w[2 * bj + n] = (unsigned)pk; }
            *(u32x4*)rp = w; asm volatile("" ::: "memory"); }
    }
};
struct EpiBf16S {
    bf16* O; int ldo; float sc;
    __device__ __forceinline__ void operator()(EPI_ARGS) const {
        const int r0 = u.pm * 256 + wr * 64 + fr, c0 = u.pn * 256 + wc * 32 + 8 * fq;
#pragma unroll
        EPI_ROWS { bf16* rp = O + (size_t)(r0 + ai * 128 + m * 16) * ldo + c0;
#pragma unroll
            for (int bj = 0; bj < 2; ++bj) { const f32x4 a = acc[ai][bj][m][0] * sc, b = acc[ai][bj][m][1] * sc; u32x4 w; w.x = pk2(a.x, a.y); w.y = pk2(a.z, a.w); w.z = pk2(b.x, b.y); w.w = pk2(b.z, b.w); *(u32x4*)(rp + bj * 128) = w; }
            asm volatile("" ::: "memory"); }
    }
};
struct EpiBiasBf16 {
    unsigned char* O; int ldo; const float* bias;
    __device__ __forceinline__ void operator()(EPI_ARGS) const {
        const int r0 = u.pm * 256 + wr * 64 + fr, c0 = u.pn * 256 + wc * 32 + 8 * fq;
        f32x4 bv[2][2];
#pragma unroll
        for (int bj = 0; bj < 2; ++bj) { bv[bj][0] = *(const f32x4*)(bias + c0 + bj * 128); bv[bj][1] = *(const f32x4*)(bias + c0 + bj * 128 + 4); }
        __builtin_amdgcn_s_waitcnt(0x0F70);
#pragma unroll
        EPI_ROWS { unsigned char* rp = O + (size_t)(r0 + ai * 128 + m * 16) * ldo + c0;
#pragma unroll
            for (int bj = 0; bj < 2; ++bj) { const f32x4 a = (acc[ai][bj][m][0] + bv[bj][0]) * 16.f, b = (acc[ai][bj][m][1] + bv[bj][1]) * 16.f; u32x2 w; w.x = pk4_fp8(a.x, a.y, a.z, a.w); w.y = pk4_fp8(b.x, b.y, b.z, b.w); *(u32x2*)(rp + bj * 128) = w; } asm volatile("" ::: "memory"); }
    }
};
struct EpiGluSig {
    unsigned char* O; int ldo; const float* bias;
    __device__ __forceinline__ void operator()(EPI_ARGS) const {
        const int r0 = u.pm * 256 + wr * 64 + fr, c0 = u.pn * 128 + wc * 32 + 8 * fq;
        f32x4 b1[2], b2[2];
#pragma unroll
        for (int n = 0; n < 2; ++n) { b1[n] = *(const f32x4*)(bias + c0 + 4 * n); b2[n] = *(const f32x4*)(bias + 256 + c0 + 4 * n); }
        __builtin_amdgcn_s_waitcnt(0x0F70);
#pragma unroll
        EPI_ROWS { unsigned char* rp = O + (size_t)(r0 + ai * 128 + m * 16) * ldo + c0; float o[8];
#pragma unroll
            for (int n = 0; n < 2; ++n)
#pragma unroll
                for (int i = 0; i < 4; ++i) o[4 * n + i] = (acc[ai][0][m][n][i] + b1[n][i]) * (16.f * sigmoidf_(acc[ai][1][m][n][i] + b2[n][i]));
            u32x2 w; w.x = pk4_fp8(o[0], o[1], o[2], o[3]); w.y = pk4_fp8(o[4], o[5], o[6], o[7]); *(u32x2*)rp = w; asm volatile("" ::: "memory"); }
    }
};
struct EpiSwiglu {
    unsigned char* O; int ldo; float sc;
    __device__ __forceinline__ void operator()(EPI_ARGS) const {
        const int r0 = u.pm * 256 + wr * 64 + fr, c0 = u.pn * 128 + wc * 32 + 8 * fq;
#pragma unroll
        EPI_ROWS { unsigned char* rp = O + (size_t)(r0 + ai * 128 + m * 16) * ldo + c0; float o[8];
#pragma unroll
            for (int n = 0; n < 2; ++n)
#pragma unroll
                for (int i = 0; i < 4; ++i) o[4 * n + i] = siluf_(acc[ai][0][m][n][i] * sc) * (acc[ai][1][m][n][i] * (sc * 16.0f));
            u32x2 w; w.x = pk4_fp8(o[0], o[1], o[2], o[3]); w.y = pk4_fp8(o[4], o[5], o[6], o[7]); *(u32x2*)rp = w; asm volatile("" ::: "memory"); }
    }
};
struct EpiQ {
    bf16* Q; const float* RS;
    __device__ __forceinline__ void operator()(EPI_ARGS) const {
        const int r0 = u.pm * 256 + wr * 64 + fr; float rq[8];
#pragma unroll
        for (int g = 0; g < 8; ++g) rq[g] = RS[(size_t)(r0 + (g >> 2) * 128 + (g & 3) * 16) * 2];
        __builtin_amdgcn_s_waitcnt(0x0F70);
#pragma unroll
        EPI_ROWS { const int row = r0 + ai * 128 + m * 16; const float rs = rq[ai * 4 + m]; bf16* rp = Q + (size_t)row * 384;
            if (u.pn == 0) {
#pragma unroll
                for (int bj = 0; bj < 2; ++bj) { const int head = 2 * bj + (wc >> 1), d = 32 * (wc & 1) + 8 * fq; const f32x4 a = acc[ai][bj][m][0] * rs, b = acc[ai][bj][m][1] * rs;
                    u32x4 w; w.x = pk2(a.x, a.y); w.y = pk2(a.z, a.w); w.z = pk2(b.x, b.y); w.w = pk2(b.z, b.w); *(u32x4*)(rp + head * 96 + d) = w; }
            } else { const f32x4 a = acc[ai][0][m][0] * rs, b = acc[ai][0][m][1] * rs;
                u32x4 w; w.x = pk2(a.x, a.y); w.y = pk2(a.z, a.w); w.z = pk2(b.x, b.y); w.w = pk2(b.z, b.w); *(u32x4*)(rp + wc * 96 + 64 + 8 * fq) = w; }
            asm volatile("" ::: "memory"); }
    }
};
struct EpiKV {
    bf16* Kb; bf16* VT; const float* RS;
    __device__ __forceinline__ void operator()(EPI_ARGS) const {
        const int r0 = u.pm * 256 + wr * 64 + fr;
        const int p16 = 8 * ((fr >> 2) & 1) + 4 * (fr >> 3) + (fr & 3); float rkv[8];
#pragma unroll
        for (int g = 0; g < 8; ++g) rkv[g] = RS[(size_t)(r0 + (g >> 2) * 128 + (g & 3) * 16) * 2 + 1];
        __builtin_amdgcn_s_waitcnt(0x0F70);
#pragma unroll
        EPI_ROWS { const int row = r0 + ai * 128 + m * 16; const float rk = rkv[ai * 4 + m];
            if (u.pn == 0) {
#pragma unroll
                for (int bj = 0; bj < 2; ++bj) { const int head = 2 * bj + (wc >> 1), d = 32 * (wc & 1) + 8 * fq; const f32x4 a = acc[ai][bj][m][0] * rk, b = acc[ai][bj][m][1] * rk;
                    u32x4 w; w.x = pk2(a.x, a.y); w.y = pk2(a.z, a.w); w.z = pk2(b.x, b.y); w.w = pk2(b.z, b.w);
                    *(u32x4*)(Kb + (size_t)row * 384 + head * 96 + d) = w; }
            } else {
                const int bb = row < NLAT ? (row >> 11) : ((row - NLAT) >> 8); const int kk = row < NLAT ? (row & 2047) : 2048 + ((row - NLAT) & 255);
                const int pos = (kk & ~15) + p16;
#pragma unroll
                for (int bj = 0; bj < 2; ++bj) { const int head = 2 * bj + (wc >> 1), d = 32 * (wc & 1) + 8 * fq; bf16* dst = VT + ((size_t)((bb * 4 + head) * 64 + d)) * 2304 + pos;
#pragma unroll
                    for (int n = 0; n < 2; ++n)
#pragma unroll
                        for (int i = 0; i < 4; ++i) dst[(size_t)(4 * n + i) * 2304] = f2bf(acc[ai][bj][m][n][i] * rk); }
            }
            asm volatile("" ::: "memory"); }
    }
};
struct EpiDelta {
    bf16* D; const float* MODg; float sc;
    __device__ __forceinline__ void operator()(EPI_ARGS) const {
        const int rt = u.pm * 256; const float* g = MODg + (size_t)(rt < NLAT ? (rt >> 11) : 32) * 6144;
        const int r0 = rt + wr * 64 + fr, c0 = u.pn * 256 + wc * 32 + 8 * fq;
        f32x4 gv[2][2];
#pragma unroll
        for (int bj = 0; bj < 2; ++bj) { gv[bj][0] = *(const f32x4*)(g + c0 + bj * 128) * sc; gv[bj][1] = *(const f32x4*)(g + c0 + bj * 128 + 4) * sc; }
        __builtin_amdgcn_s_waitcnt(0x0F70);
#pragma unroll
        EPI_ROWS { bf16* rp = D + (size_t)(r0 + ai * 128 + m * 16) * DM + c0;
#pragma unroll
            for (int bj = 0; bj < 2; ++bj) { const f32x4 a = gv[bj][0] * acc[ai][bj][m][0], b = gv[bj][1] * acc[ai][bj][m][1]; u32x4 w; w.x = pk2(a.x, a.y); w.y = pk2(a.z, a.w); w.z = pk2(b.x, b.y); w.w = pk2(b.z, b.w); *(u32x4*)(rp + bj * 128) = w; }
            asm volatile("" ::: "memory"); }
    }
};

__device__ __forceinline__ int seq_row(int b, int dir, int pos) {
    if (pos < CTXL) return NLAT + b * CTXL + (dir ? CTXL - 1 - pos : pos);
    const int t = pos - CTXL; return b * SEQ + (dir ? SEQ - 1 - t : t);
}
__device__ __forceinline__ void phase_gla(const Ctx& c, KParams p, int l) {
    const bf16* Z = (const bf16*)(c.ws + WS_Z); const bf16* GVT = (const bf16*)(c.ws + WS_GVT); bf16* OG = (bf16*)(c.ws + WS_T1);
    const int w = c.wave, tid = c.tid;
    LAS float* wtab = (LAS float*)c.lds;
    LAS float* DD = (LAS float*)(c.lds + 4096);
    LAS unsigned char* RW = c.lds + 8192 + w * 13824;
    LAS float* LA = (LAS float*)RW;
    LAS unsigned char* KTT = RW + 9216;
    for (int u = c.blk; u < 256; u += c.G) {
        const int b = u >> 3, h = (u >> 1) & 3, dir = u & 1;
        __syncthreads();
        { const float* wa = p->in[I_GLAW] + ((size_t)(l * 2 + dir) * 16) * 128 + h * 32; wtab[tid] = wa[(tid >> 5) * 128 + (tid & 31)]; if (tid < 32) wtab[512 + tid] = p->in[I_GLAB][(l * 2 + dir) * 128 + h * 32 + tid]; }
        float Sst[4] = {0.f, 0.f, 0.f, 0.f};
        __syncthreads();
        for (int gi = 0; gi < 5; ++gi) {
            const int pc = gi * 8 + w; const bool active = pc < 36;
            int lane_ = c.lane; asm volatile("" : "+v"(lane_));
            const int r = lane_ & 31, hh = lane_ >> 5;
            const int p16 = 8 * ((r >> 2) & 1) + 4 * ((r & 15) >> 3) + (r & 3);
            const int pos0 = (r & 16) + p16, pos1 = 32 + pos0;
            bf16x8 qd[2][2]; f32x16 oacc[2][2]; int row0 = 0;
            if (active) {
                int kk0;
                if (dir == 0) { if (pc < 4) { row0 = NLAT + b * CTXL + pc * 64; kk0 = pc * 64; } else { row0 = b * SEQ + (pc - 4) * 64; kk0 = 256 + (pc - 4) * 64; } }
                else { if (pc < 4) { row0 = NLAT + b * CTXL + (3 - pc) * 64; kk0 = (3 - pc) * 64; } else { row0 = b * SEQ + (35 - pc) * 64; kk0 = 256 + (35 - pc) * 64; } }
#pragma unroll
                for (int ib = 0; ib < 2; ++ib) { const bf16* zr = Z + (size_t)(row0 + 32 * ib + r) * ZW; float al[16]; { const u32x4 a0 = *(const u32x4*)(zr + ZAF + dir * 16), a1 = *(const u32x4*)(zr + ZAF + dir * 16 + 8); float t8[8]; unpack8(a0, t8);
#pragma unroll
                        for (int j = 0; j < 8; ++j) al[j] = t8[j];
                        unpack8(a1, t8);
#pragma unroll
                        for (int j = 0; j < 8; ++j) al[8 + j] = t8[j]; }
#pragma unroll
                    for (int ks = 0; ks < 2; ++ks) { float za[8]; { const f32x4 b0 = *(const LAS f32x4*)(wtab + 512 + 16 * ks + 8 * hh), b1 = *(const LAS f32x4*)(wtab + 512 + 16 * ks + 8 * hh + 4);
                            za[0] = b0.x; za[1] = b0.y; za[2] = b0.z; za[3] = b0.w; za[4] = b1.x; za[5] = b1.y; za[6] = b1.z; za[7] = b1.w; }
#pragma unroll
                        for (int j = 0; j < 16; ++j) { const f32x4 w0 = *(const LAS f32x4*)(wtab + j * 32 + 16 * ks + 8 * hh), w1 = *(const LAS f32x4*)(wtab + j * 32 + 16 * ks + 8 * hh + 4);
                            za[0] = fmaf(al[j], w0.x, za[0]); za[1] = fmaf(al[j], w0.y, za[1]); za[2] = fmaf(al[j], w0.z, za[2]); za[3] = fmaf(al[j], w0.w, za[3]);
                            za[4] = fmaf(al[j], w1.x, za[4]); za[5] = fmaf(al[j], w1.y, za[5]); za[6] = fmaf(al[j], w1.z, za[6]); za[7] = fmaf(al[j], w1.w, za[7]); }
                        float la[8];
#pragma unroll
                        for (int e = 0; e < 8; ++e) la[e] = (fminf(za[e], 0.f) - __logf(1.f + __expf(-fabsf(za[e])))) * 0.0625f;
                        *(LAS f32x4*)(LA + (32 * ib + r) * 36 + 16 * ks + 8 * hh) = (f32x4){la[0], la[1], la[2], la[3]}; *(LAS f32x4*)(LA + (32 * ib + r) * 36 + 16 * ks + 8 * hh + 4) = (f32x4){la[4], la[5], la[6], la[7]}; } }
                lds_wait();
                u32x4 qraw[2][2], kraw[2][2];
#pragma unroll
                for (int ib = 0; ib < 2; ++ib) { const bf16* zr = Z + (size_t)(row0 + 32 * ib + r) * ZW;
#pragma unroll
                    for (int ks = 0; ks < 2; ++ks) { qraw[ib][ks] = *(const u32x4*)(zr + ZQ + h * 32 + 16 * ks + 8 * hh); kraw[ib][ks] = *(const u32x4*)(zr + ZK + h * 32 + 16 * ks + 8 * hh); } }
                { float bend; float v[32], s = 0.f;
#pragma unroll
                  for (int qq = 0; qq < 32; ++qq) { const int q = 32 * hh + qq, i = dir ? 63 - q : q; v[qq] = LA[i * 36 + r]; s += v[qq]; }
                  const auto sw = __builtin_amdgcn_permlane32_swap(__float_as_uint(s), __float_as_uint(s), false, false);
                  const float h0 = __uint_as_float(sw[0]), h1 = __uint_as_float(sw[1]); bend = h0 + h1;
                  float run = hh ? h0 : 0.f;
#pragma unroll
                  for (int qq = 0; qq < 32; ++qq) { const int q = 32 * hh + qq, i = dir ? 63 - q : q; run += v[qq]; LA[i * 36 + r] = run; }
                  if (hh == 0) DD[w * 32 + r] = __expf(bend); }
                lds_wait();
                bf16x8 vt[2][4];
#pragma unroll
                for (int db = 0; db < 2; ++db)
#pragma unroll
                    for (int s4 = 0; s4 < 4; ++s4) vt[db][s4] = *(const bf16x8*)(GVT + ((size_t)(b * 4 + h) * 64 + 32 * db + r) * 2304 + kk0 + 16 * s4 + 8 * hh);
                bf16x8 ki[2][2];
#pragma unroll
                for (int ib = 0; ib < 2; ++ib) {
#pragma unroll
                    for (int ks = 0; ks < 2; ++ks) { const int dk0 = 16 * ks + 8 * hh; float q8[8], k8[8], b8[8]; unpack8(qraw[ib][ks], q8); unpack8(kraw[ib][ks], k8);
                        { const f32x4 x0 = *(const LAS f32x4*)(LA + (32 * ib + r) * 36 + dk0), x1 = *(const LAS f32x4*)(LA + (32 * ib + r) * 36 + dk0 + 4); b8[0] = x0.x; b8[1] = x0.y; b8[2] = x0.z; b8[3] = x0.w; b8[4] = x1.x; b8[5] = x1.y; b8[6] = x1.z; b8[7] = x1.w; }
                        float qo[8], ko[8];
#pragma unroll
                        for (int e = 0; e < 8; ++e) { const float eb = __expf(b8[e]), ieb = 1.f / eb; qo[e] = q8[e] * 0.17677669529663687f * eb; ko[e] = k8[e] * ieb;
                            *(LAS bf16*)(KTT + ((dk0 + e) * 72 + (ib ? pos1 : pos0)) * 2) = f2bf(ko[e] * DD[w * 32 + dk0 + e]); }
                        u32x4 wq, wk; wq.x = pk2(qo[0], qo[1]); wq.y = pk2(qo[2], qo[3]); wq.z = pk2(qo[4], qo[5]); wq.w = pk2(qo[6], qo[7]); wk.x = pk2(ko[0], ko[1]); wk.y = pk2(ko[2], ko[3]); wk.z = pk2(ko[4], ko[5]); wk.w = pk2(ko[6], ko[7]);
                        qd[ib][ks] = __builtin_bit_cast(bf16x8, wq); ki[ib][ks] = __builtin_bit_cast(bf16x8, wk); } }
                f32x16 zero16;
#pragma unroll
                for (int i = 0; i < 16; ++i) zero16[i] = 0.f;
                f32x16 a00 = __builtin_amdgcn_mfma_f32_32x32x16_bf16(ki[0][0], qd[0][0], zero16, 0, 0, 0); a00 = __builtin_amdgcn_mfma_f32_32x32x16_bf16(ki[0][1], qd[0][1], a00, 0, 0, 0);
                f32x16 a11 = __builtin_amdgcn_mfma_f32_32x32x16_bf16(ki[1][0], qd[1][0], zero16, 0, 0, 0); a11 = __builtin_amdgcn_mfma_f32_32x32x16_bf16(ki[1][1], qd[1][1], a11, 0, 0, 0);
                f32x16 aof;
                if (dir == 0) { aof = __builtin_amdgcn_mfma_f32_32x32x16_bf16(ki[0][0], qd[1][0], zero16, 0, 0, 0); aof = __builtin_amdgcn_mfma_f32_32x32x16_bf16(ki[0][1], qd[1][1], aof, 0, 0, 0); }
                else { aof = __builtin_amdgcn_mfma_f32_32x32x16_bf16(ki[1][0], qd[0][0], zero16, 0, 0, 0); aof = __builtin_amdgcn_mfma_f32_32x32x16_bf16(ki[1][1], qd[0][1], aof, 0, 0, 0); }
#pragma unroll
                for (int i = 0; i < 16; ++i) { const int j = (i & 3) + 8 * (i >> 2) + 4 * hh; const bool keep = dir ? (j >= r) : (j <= r); a00[i] = keep ? a00[i] : 0.f; a11[i] = keep ? a11[i] : 0.f; }
#define GLA_P(X, s) ({ u32x4 w_; w_.x = pk2((X)[8 * (s)], (X)[8 * (s) + 1]); w_.y = pk2((X)[8 * (s) + 2], (X)[8 * (s) + 3]); w_.z = pk2((X)[8 * (s) + 4], (X)[8 * (s) + 5]); w_.w = pk2((X)[8 * (s) + 6], (X)[8 * (s) + 7]); __builtin_bit_cast(bf16x8, w_); })
                const bf16x8 p00a = GLA_P(a00, 0), p00b = GLA_P(a00, 1), p11a = GLA_P(a11, 0), p11b = GLA_P(a11, 1), pofa = GLA_P(aof, 0), pofb = GLA_P(aof, 1);
#pragma unroll
                for (int db = 0; db < 2; ++db) {
                    f32x16 o0 = __builtin_amdgcn_mfma_f32_32x32x16_bf16(vt[db][0], p00a, zero16, 0, 0, 0); o0 = __builtin_amdgcn_mfma_f32_32x32x16_bf16(vt[db][1], p00b, o0, 0, 0, 0);
                    f32x16 o1 = __builtin_amdgcn_mfma_f32_32x32x16_bf16(vt[db][2], p11a, zero16, 0, 0, 0); o1 = __builtin_amdgcn_mfma_f32_32x32x16_bf16(vt[db][3], p11b, o1, 0, 0, 0);
                    if (dir == 0) { o1 = __builtin_amdgcn_mfma_f32_32x32x16_bf16(vt[db][0], pofa, o1, 0, 0, 0); o1 = __builtin_amdgcn_mfma_f32_32x32x16_bf16(vt[db][1], pofb, o1, 0, 0, 0); }
                    else { o0 = __builtin_amdgcn_mfma_f32_32x32x16_bf16(vt[db][2], pofa, o0, 0, 0, 0); o0 = __builtin_amdgcn_mfma_f32_32x32x16_bf16(vt[db][3], pofb, o0, 0, 0, 0); }
                    oacc[db][0] = o0; oacc[db][1] = o1; }
#undef GLA_P
                lds_wait();
                bf16x8 kf[4];
#pragma unroll
                for (int s4 = 0; s4 < 4; ++s4) kf[s4] = *(const LAS bf16x8*)(KTT + (r * 72 + 16 * s4 + 8 * hh) * 2);
#pragma unroll
                for (int db = 0; db < 2; ++db) { f32x16 uu = __builtin_amdgcn_mfma_f32_32x32x16_bf16(vt[db][0], kf[0], zero16, 0, 0, 0);
#pragma unroll
                    for (int s4 = 1; s4 < 4; ++s4) uu = __builtin_amdgcn_mfma_f32_32x32x16_bf16(vt[db][s4], kf[s4], uu, 0, 0, 0);
#pragma unroll
                    for (int i = 0; i < 16; ++i) LA[(32 * db + (i & 3) + 8 * (i >> 2) + 4 * hh) * 32 + r] = uu[i]; }
            }
            __syncthreads();
            const int dv2 = tid >> 3, dk4 = (tid & 7) * 4;
            f32x4 ur[8], dr[8];
#pragma unroll
            for (int cc = 0; cc < 8; ++cc) { ur[cc] = *(const LAS f32x4*)((LAS float*)(c.lds + 8192 + cc * 13824) + dv2 * 32 + dk4); dr[cc] = *(const LAS f32x4*)(DD + cc * 32 + dk4); }
            __syncthreads();
#pragma unroll
            for (int cc = 0; cc < 8; ++cc) if (gi * 8 + cc < 36) { u32x2 sp; sp.x = pk2(Sst[0], Sst[1]); sp.y = pk2(Sst[2], Sst[3]); *(LAS u32x2*)(c.lds + 8192 + cc * 13824 + (dv2 * 40 + dk4) * 2) = sp;
                Sst[0] = fmaf(dr[cc].x, Sst[0], ur[cc].x); Sst[1] = fmaf(dr[cc].y, Sst[1], ur[cc].y); Sst[2] = fmaf(dr[cc].z, Sst[2], ur[cc].z); Sst[3] = fmaf(dr[cc].w, Sst[3], ur[cc].w); }
            __syncthreads();
            if (active) {
#pragma unroll
                for (int db = 0; db < 2; ++db) { const bf16x8 s0 = *(const LAS bf16x8*)(RW + ((32 * db + r) * 40 + 8 * hh) * 2), s1 = *(const LAS bf16x8*)(RW + ((32 * db + r) * 40 + 16 + 8 * hh) * 2);
#pragma unroll
                    for (int ib = 0; ib < 2; ++ib) { oacc[db][ib] = __builtin_amdgcn_mfma_f32_32x32x16_bf16(s0, qd[ib][0], oacc[db][ib], 0, 0, 0); oacc[db][ib] = __builtin_amdgcn_mfma_f32_32x32x16_bf16(s1, qd[ib][1], oacc[db][ib], 0, 0, 0); } }
#pragma unroll
                for (int ib = 0; ib < 2; ++ib) { bf16* orow = OG + ((size_t)dir * NTOK + row0 + 32 * ib + r) * 256 + h * 64 + 4 * hh;
#pragma unroll
                    for (int db = 0; db < 2; ++db)
#pragma unroll
                        for (int g4 = 0; g4 < 4; ++g4) { u32x2 wv; wv.x = pk2(oacc[db][ib][4 * g4], oacc[db][ib][4 * g4 + 1]); wv.y = pk2(oacc[db][ib][4 * g4 + 2], oacc[db][ib][4 * g4 + 3]); *(u32x2*)(orow + 32 * db + 8 * g4) = wv; } }
                lds_wait();
            }
        }
    }
    __syncthreads();
}
__device__ __forceinline__ void phase_gla_final(const Ctx& c, KParams p, int l, int nrows) {
    const bf16* Z = (const bf16*)(c.ws + WS_Z); const bf16* OG = (const bf16*)(c.ws + WS_T1); unsigned char* MIX = c.ws + WS_MIX;
    const int gw = c.blk * NWAVES + c.wave, NGW = c.G * NWAVES; const f32x4 g = *(const f32x4*)(p->in[I_GLAG] + l * 256 + 4 * c.lane);
    for (int r0 = gw; r0 < nrows; r0 += 4 * NGW) {
        u32x2 of[4], ob[4], rg[4];
#pragma unroll
        for (int k = 0; k < 4; ++k) { const int r = r0 + k * NGW; of[k] = ob[k] = rg[k] = (u32x2){0u, 0u};
            if (r < nrows) { of[k] = *(const u32x2*)(OG + (size_t)r * 256 + 4 * c.lane); ob[k] = *(const u32x2*)(OG + ((size_t)NTOK + r) * 256 + 4 * c.lane); rg[k] = *(const u32x2*)(Z + (size_t)r * ZW + ZR + 4 * c.lane); } }
#pragma unroll
        for (int k = 0; k < 4; ++k) { const int r = r0 + k * NGW;
            f32x4 o = (f32x4){__uint_as_float(of[k].x << 16) + __uint_as_float(ob[k].x << 16), __uint_as_float(of[k].x & 0xffff0000u) + __uint_as_float(ob[k].x & 0xffff0000u),
                              __uint_as_float(of[k].y << 16) + __uint_as_float(ob[k].y << 16), __uint_as_float(of[k].y & 0xffff0000u) + __uint_as_float(ob[k].y & 0xffff0000u)};
            float ss = (o.x * o.x + o.y * o.y) + (o.z * o.z + o.w * o.w);
            ss += shx<1>(ss); ss += shx<2>(ss); ss += shx<4>(ss); ss += shx<8>(ss);
            const float rstd = rsqrtf(ss * (1.f / 64.f) + EPS);
            const float g0 = __uint_as_float(rg[k].x << 16), g1 = __uint_as_float(rg[k].x & 0xffff0000u), g2 = __uint_as_float(rg[k].y << 16), g3 = __uint_as_float(rg[k].y & 0xffff0000u);
            const float r16 = rstd * 16.f; const unsigned w = pk4_fp8(o.x * r16 * g.x * siluf_(g0), o.y * r16 * g.y * siluf_(g1), o.z * r16 * g.z * siluf_(g2), o.w * r16 * g.w * siluf_(g3));
            if (r < nrows) *(unsigned*)(MIX + (size_t)r * DM + 4 * c.lane) = w; }
    }
}

__device__ __forceinline__ void phase_conv1(const Ctx& c, KParams p, int l, bool with_ctx) {
    const bf16* Z = (const bf16*)(c.ws + WS_Z); bf16* CV = (bf16*)(c.ws + WS_CV);
    constexpr int TT = 64, HR = TT + 30;
    LAS float* glu = (LAS float*)c.lds;
    f32x4 wj[31];
#pragma unroll
    for (int j = 0; j < 31; ++j) wj[j] = *(const f32x4*)(p->in[I_CDW] + ((size_t)l * 31 + j) * 256 + 4 * c.lane);
    const int ntiles = with_ctx ? 1024 + 128 : 1024;
    const f32x4 dwb = *(const f32x4*)(p->in[I_CDB] + l * 256 + 4 * c.lane), lg = *(const f32x4*)(p->in[I_CLG] + l * 256 + 4 * c.lane), lb = *(const f32x4*)(p->in[I_CLB] + l * 256 + 4 * c.lane);
    for (int tile = c.blk; tile < ntiles; tile += c.G) {
        int rowbase, t0, slen;
        if (tile < 1024) { const int b = tile >> 5; rowbase = b * SEQ; t0 = (tile & 31) * TT; slen = SEQ; } else { const int q = tile - 1024, b = q >> 2; rowbase = NLAT + b * CTXL; t0 = (q & 3) * TT; slen = CTXL; }
        __syncthreads();
        u32x2 ra[12], rg[12];
#pragma unroll
        for (int k = 0; k < 12; ++k) { const int idx = c.tid + k * NTHR, j = idx >> 6, c4 = (idx & 63) * 4, t = t0 - 15 + j; ra[k] = (u32x2){0u, 0u}; rg[k] = (u32x2){0u, 0u};
            if (idx < HR * 64 && t >= 0 && t < slen) { const bf16* zr = Z + (size_t)(rowbase + t) * ZW; ra[k] = *(const u32x2*)(zr + ZCA + c4); rg[k] = *(const u32x2*)(zr + ZCG + c4); } }
#pragma unroll
        for (int k = 0; k < 12; ++k) { const int idx = c.tid + k * NTHR, j = idx >> 6, c4 = (idx & 63) * 4; f32x4 v;
            v.x = __uint_as_float(ra[k].x << 16) * sigmoidf_(__uint_as_float(rg[k].x << 16)); v.y = __uint_as_float(ra[k].x & 0xffff0000u) * sigmoidf_(__uint_as_float(rg[k].x & 0xffff0000u));
            v.z = __uint_as_float(ra[k].y << 16) * sigmoidf_(__uint_as_float(rg[k].y << 16)); v.w = __uint_as_float(ra[k].y & 0xffff0000u) * sigmoidf_(__uint_as_float(rg[k].y & 0xffff0000u));
            if (idx < HR * 64) *(LAS f32x4*)(glu + j * 256 + c4) = v; }
        __syncthreads();
        f32x4 acc8[8];
#pragma unroll
        for (int q = 0; q < 8; ++q) acc8[q] = dwb;
#pragma unroll
        for (int r = 0; r < 38; ++r) { const f32x4 x = *(const LAS f32x4*)(glu + (c.wave * 8 + r) * 256 + 4 * c.lane);
#pragma unroll
            for (int q = 0; q < 8; ++q) if (r - q >= 0 && r - q < 31) acc8[q] += x * wj[r - q]; }
#pragma unroll
        for (int q = 0; q < 8; ++q) { const int i = c.wave * 8 + q; const f32x4 a = acc8[q];
            const float mu = wave_sum((a.x + a.y) + (a.z + a.w)) * (1.f / 256.f); const f32x4 dlt = a - mu;
            const float var = wave_sum((dlt.x * dlt.x + dlt.y * dlt.y) + (dlt.z * dlt.z + dlt.w * dlt.w)) * (1.f / 256.f); const float rstd = rsqrtf(var + EPS);
            const f32x4 y = dlt * rstd * lg + lb;
            u32x2 w; w.x = pk2(siluf_(y.x), siluf_(y.y)); w.y = pk2(siluf_(y.z), siluf_(y.w));
            *(u32x2*)(CV + (size_t)(rowbase + t0 + i) * 256 + 4 * c.lane) = w; }
    }
    __syncthreads();
}

__device__ __forceinline__ void phase_s5_carry(const Ctx& c, int l) {
    const bf16* XE = (const bf16*)(c.ws + WS_Y5); bf16* UP = (bf16*)(c.ws + WS_UP); const float* S5P = (const float*)(c.ws + WS_S5P);
    for (int i = c.blk * NTHR + c.tid; i < NB * 2 * 16 * 64; i += c.G * NTHR) {
        const int pp = i & 63, g = (i >> 6) & 15, dir = (i >> 10) & 1, b = i >> 11;
        const float* PW = S5P + ((size_t)((l * 2 + dir) * 16 + g) * 64 + pp) * 34 + 32; const float ar = PW[0], ai = PW[1];
        const size_t rbase = (size_t)g * 4608 + (size_t)b * 144; float xr = 0.f, xi = 0.f;
        float er[16], ei[16], fr_[16], fi_[16];
        auto chunk_of = [&](int s) { return dir == 0 ? s : (s < 16 ? 15 - s : 159 - s); };
#pragma unroll
        for (int q = 0; q < 16; ++q) { const bf16* xe = XE + (rbase + chunk_of(q)) * 256 + dir * 128 + pp; er[q] = bf2f(xe[0]); ei[q] = bf2f(xe[64]); }
#pragma unroll 1
        for (int s0 = 0; s0 < 144; s0 += 16) {
            if (s0 + 16 < 144) {
#pragma unroll
                for (int q = 0; q < 16; ++q) { const bf16* xe = XE + (rbase + chunk_of(s0 + 16 + q)) * 256 + dir * 128 + pp; fr_[q] = bf2f(xe[0]); fi_[q] = bf2f(xe[64]); } }
#pragma unroll
            for (int q = 0; q < 16; ++q) { bf16* up = UP + (rbase + chunk_of(s0 + q)) * 512 + 256 + dir * 128 + pp; up[0] = f2bf(xr); up[64] = f2bf(xi);
                const float nr = ar * xr - ai * xi + er[q], ni = ar * xi + ai * xr + ei[q]; xr = nr; xi = ni; }
            if (s0 + 16 < 144) {
#pragma unroll
                for (int q = 0; q < 16; ++q) { er[q] = fr_[q]; ei[q] = fi_[q]; } }
        }
    }
}

__device__ __forceinline__ void phase_mla_prep(const Ctx& c, KParams p) {
    const bf16* Z = (const bf16*)(c.ws + WS_Z); float* RS = (float*)(c.ws + WS_RS); bf16* Kb = (bf16*)(c.ws + WS_H) + (size_t)NTOK * 384; const float* ROPE = (const float*)(c.ws + WS_TAB + TAB_ROPE);
    const int gw = c.blk * NWAVES + c.wave, NGW = c.G * NWAVES, lane = c.lane, d = lane & 31;
    for (int r0 = gw; r0 < NTOK; r0 += 4 * NGW) {
        u32x2 q4[4]; unsigned k2[4]; bf16 xr[4]; f32x2 cs[4];
#pragma unroll
        for (int k = 0; k < 4; ++k) { const int r = r0 + k * NGW; q4[k] = (u32x2){0u, 0u}; k2[k] = 0u; xr[k] = 0; cs[k] = (f32x2){1.f, 0.f};
            if (r < NTOK) { const bf16* zr = Z + (size_t)r * ZW; q4[k] = *(const u32x2*)(zr + ZCQ + 4 * lane); k2[k] = *(const unsigned*)(zr + ZCKV + 2 * lane); xr[k] = zr[ZKR + d];
                if (r < NLAT) cs[k] = *(const f32x2*)(ROPE + (((r & 2047) * 2 + (d >> 4)) * 8 + (d & 7)) * 2); } }
#pragma unroll
        for (int k = 0; k < 4; ++k) { const int r = r0 + k * NGW;
            const float a0 = __uint_as_float(q4[k].x << 16), a1 = __uint_as_float(q4[k].x & 0xffff0000u), a2 = __uint_as_float(q4[k].y << 16), a3 = __uint_as_float(q4[k].y & 0xffff0000u);
            const float b0 = __uint_as_float(k2[k] << 16), b1 = __uint_as_float(k2[k] & 0xffff0000u);
            const float sq = wave_sum((a0 * a0 + a1 * a1) + (a2 * a2 + a3 * a3)), sk = wave_sum(b0 * b0 + b1 * b1);
            const float x = bf2f(xr[k]); const float px = shx<8>(x);
            const float o = (d & 8) ? fmaf(x, cs[k].x, px * cs[k].y) : fmaf(x, cs[k].x, -px * cs[k].y);
            if (r < NTOK) { if (lane == 0) { RS[(size_t)r * 2] = rsqrtf(sq * (1.f / 256.f) + EPS); RS[(size_t)r * 2 + 1] = rsqrtf(sk * (1.f / 128.f) + EPS); }
                const bf16 ob = f2bf(o); bf16* kr = Kb + (size_t)r * 384 + 64 + d; if (lane < 32) { kr[0] = ob; kr[96] = ob; kr[192] = ob; kr[288] = ob; } } }
    }
}
__device__ __forceinline__ void phase_attn(const Ctx& c, bool with_ctx) {
    const bf16* Qb = (const bf16*)(c.ws + WS_H); const bf16* Kb = Qb + (size_t)NTOK * 384; const bf16* VT = Kb + (size_t)NTOK * 384; unsigned char* MIX = c.ws + WS_MIX;
    constexpr int KROW = 208, VROW = 144, KBUF = 64 * KROW, VBUF = 64 * VROW;
    LAS unsigned char* Kt = c.lds; LAS unsigned char* Vt = c.lds + 2 * KBUF;
    const int lane = c.lane, ln = lane & 31, hh = lane >> 5, tid = c.tid;
    const int nunits = with_ctx ? 1152 : 1024;
    for (int L = c.blk; L < nunits; L += c.G) {
        int u = L;
        if (c.G == 256 && L < 1024) { const int r = L >> 8, x = L & 7, j = (L & 255) >> 3; u = ((r * 32 + x * 4 + (j >> 3)) << 3) | (j & 7); }
        int b, h, qrow0, kt0, nkt;
        if (u < 1024) { b = u >> 5; h = (u >> 3) & 3; qrow0 = b * SEQ + (u & 7) * 256; kt0 = 0; nkt = 36; } else { const int q = u - 1024; b = q >> 2; h = q & 3; qrow0 = NLAT + b * CTXL; kt0 = 32; nkt = 4; }
        const bf16* vtb = VT + (size_t)((b * 4 + h) * 64) * 2304;
        bf16x8 qf[6];
        { const bf16* qr = Qb + (size_t)(qrow0 + 32 * c.wave + ln) * 384 + h * 96 + 8 * hh;
#pragma unroll
          for (int ks = 0; ks < 6; ++ks) qf[ks] = *(const bf16x8*)(qr + 16 * ks); }
        if (u < 1024) {
            const float* ROPE = (const float*)(c.ws + WS_TAB + TAB_ROPE) + (size_t)((qrow0 + 32 * c.wave + ln) & 2047) * 32;
#pragma unroll
            for (int ax = 0; ax < 2; ++ax) { const u32x4 own = __builtin_bit_cast(u32x4, qf[4 + ax]); u32x4 oth, res;
#pragma unroll
                for (int i = 0; i < 4; ++i) { const auto sw = __builtin_amdgcn_permlane32_swap(own[i], own[i], false, false); oth[i] = hh ? sw[0] : sw[1]; }
#pragma unroll
                for (int i = 0; i < 4; ++i) { const f32x4 cs = *(const f32x4*)(ROPE + ax * 16 + 4 * i);
                    const float v0 = __uint_as_float(own[i] << 16), v1 = __uint_as_float(own[i] & 0xffff0000u), p0 = __uint_as_float(oth[i] << 16), p1 = __uint_as_float(oth[i] & 0xffff0000u);
                    const float sg = hh ? 1.f : -1.f; res[i] = pk2(fmaf(v0, cs.x, sg * p0 * cs.y), fmaf(v1, cs.z, sg * p1 * cs.w)); }
                qf[4 + ax] = __builtin_bit_cast(bf16x8, res); } }
        f32x16 oacc[2];
#pragma unroll
        for (int i = 0; i < 16; ++i) { oacc[0][i] = 0.f; oacc[1][i] = 0.f; }
        float mrun = 0.f, lsum = 0.f;
        const int k0key = tid / 12, k0pt = tid % 12, k1key = (512 + tid) / 12, k1pt = (512 + tid) % 12; const bool k1on = tid < 256;
        u32x4 sk0, sk1 = (u32x4){0u, 0u, 0u, 0u}, sv;
        auto key_row = [&](int kt, int j) -> int { const int kk = kt * 64 + j; return kk < 2048 ? b * SEQ + kk : NLAT + b * CTXL + (kk - 2048); };
#define ATT_LOAD(kt) do { sk0 = *(const u32x4*)(Kb + (size_t)key_row((kt), k0key) * 384 + h * 96 + k0pt * 8); if (k1on) sk1 = *(const u32x4*)(Kb + (size_t)key_row((kt), k1key) * 384 + h * 96 + k1pt * 8); \
        sv = *(const u32x4*)(vtb + (size_t)(tid >> 3) * 2304 + (kt) * 64 + (tid & 7) * 8); } while (0)
#define ATT_STORE(buf) do { *(LAS u32x4*)(Kt + (buf) * KBUF + k0key * KROW + k0pt * 16) = sk0; if (k1on) *(LAS u32x4*)(Kt + (buf) * KBUF + k1key * KROW + k1pt * 16) = sk1; \
        *(LAS u32x4*)(Vt + (buf) * VBUF + (tid >> 3) * VROW + (tid & 7) * 16) = sv; } while (0)
        __syncthreads();
        ATT_LOAD(kt0); ATT_STORE(0);
        __syncthreads();
        for (int it = 0; it < nkt; ++it) {
            const int cur = it & 1;
            if (it + 1 < nkt) ATT_LOAD(kt0 + it + 1);
            f32x16 sacc[2];
            const float nm = -mrun;
#pragma unroll
            for (int kb = 0; kb < 2; ++kb) {
#pragma unroll
                for (int i = 0; i < 16; ++i) sacc[kb][i] = nm;
#pragma unroll
                for (int ks = 0; ks < 6; ++ks) { const bf16x8 a = *(const LAS bf16x8*)(Kt + cur * KBUF + (32 * kb + ln) * KROW + ks * 32 + hh * 16);
                    sacc[kb] = __builtin_amdgcn_mfma_f32_32x32x16_bf16(a, qf[ks], sacc[kb], 0, 0, 0); } }
            float mx = fmaxf(fmaxf(sacc[0][0], sacc[0][1]), sacc[0][2]);
#pragma unroll
            for (int i = 3; i < 15; i += 2) mx = fmaxf(fmaxf(mx, sacc[0][i]), sacc[0][i + 1]);
            mx = fmaxf(mx, sacc[0][15]);
#pragma unroll
            for (int i = 0; i < 16; i += 2) mx = fmaxf(fmaxf(mx, sacc[1][i]), sacc[1][i + 1]);
            { const auto r = __builtin_amdgcn_permlane32_swap(__float_as_uint(mx), __float_as_uint(mx), false, false); mx = fmaxf(__uint_as_float(r[0]), __uint_as_float(r[1])); }
            if (it == 0 || __builtin_amdgcn_ballot_w64(mx > 8.0f) != 0ull) {
                const float up = it == 0 ? mx : fmaxf(mx, 0.f), alpha = __builtin_amdgcn_exp2f(-up); mrun += up; lsum *= alpha;
#pragma unroll
                for (int i = 0; i < 16; ++i) { oacc[0][i] *= alpha; oacc[1][i] *= alpha; sacc[0][i] -= up; sacc[1][i] -= up; }
            }
            float ps = 0.f;
#pragma unroll
            for (int kb = 0; kb < 2; ++kb)
#pragma unroll
                for (int i = 0; i < 16; ++i) { const float pv = __builtin_amdgcn_exp2f(sacc[kb][i]); sacc[kb][i] = pv; ps += pv; }
            lsum += ps;
            bf16x8 pb[4];
#pragma unroll
            for (int s4 = 0; s4 < 4; ++s4) { const int kb = s4 >> 1, o8 = 8 * (s4 & 1); u32x4 w;
                w.x = pk2(sacc[kb][o8 + 0], sacc[kb][o8 + 1]); w.y = pk2(sacc[kb][o8 + 2], sacc[kb][o8 + 3]); w.z = pk2(sacc[kb][o8 + 4], sacc[kb][o8 + 5]); w.w = pk2(sacc[kb][o8 + 6], sacc[kb][o8 + 7]);
                pb[s4] = __builtin_bit_cast(bf16x8, w); }
#pragma unroll
            for (int db = 0; db < 2; ++db)
#pragma unroll
                for (int s4 = 0; s4 < 4; ++s4) { const bf16x8 a = *(const LAS bf16x8*)(Vt + cur * VBUF + (32 * db + ln) * VROW + s4 * 32 + hh * 16);
                    oacc[db] = __builtin_amdgcn_mfma_f32_32x32x16_bf16(a, pb[s4], oacc[db], 0, 0, 0); }
            if (it + 1 < nkt) ATT_STORE(cur ^ 1);
            __syncthreads();
        }
#undef ATT_LOAD
#undef ATT_STORE
        { const auto r = __builtin_amdgcn_permlane32_swap(__float_as_uint(lsum), __float_as_uint(lsum), false, false); lsum = __uint_as_float(r[0]) + __uint_as_float(r[1]); }
        const float inv = 16.f / lsum;
        unsigned char* dst = MIX + (size_t)(qrow0 + 32 * c.wave + ln) * DM + 768 + h * 64 + 4 * hh;
#pragma unroll
        for (int db = 0; db < 2; ++db)
#pragma unroll
            for (int g4 = 0; g4 < 4; ++g4) *(unsigned*)(dst + 32 * db + 8 * g4) = pk4_fp8(oacc[db][4 * g4] * inv, oacc[db][4 * g4 + 1] * inv, oacc[db][4 * g4 + 2] * inv, oacc[db][4 * g4 + 3] * inv);
    }
    __syncthreads();
}

__device__ __forceinline__ void phase_norm2_route(const Ctx& c, KParams p, int l, int ntok) {
    const float* MOD = (const float*)(c.ws + WS_MOD) + (size_t)l * 33 * 6144;
    const float* xl = l == 0 ? p->in[I_X] : p->out; const float* xc = l == 0 ? p->in[I_CTX] : (const float*)(c.ws + WS_XC);
    bf16* H = (bf16*)(c.ws + WS_H);
    int* TKEP = (int*)(c.ws + WS_RT + RT_TKEP); float* TKW = (float*)(c.ws + WS_RT + RT_TKW); int* TB = (int*)(c.ws + WS_TB);
    int* CNT = (int*)(c.ws + WS_CTL) + CW_CNT + l * NCH * NE;
    constexpr int HROW = 1032;
    LAS bf16* hhi = (LAS bf16*)c.lds;
    LAS bf16* hlo = hhi + 32 * HROW;
    LAS float* lgs = (LAS float*)(c.lds + 132096);
    LAS int* hist = (LAS int*)(c.lds + 140288);
    const bf16* Whi = (const bf16*)(c.ws + WS_TAB + TAB_RWT) + (size_t)(l * 2) * 65536; const bf16* Wlo = Whi + 65536;
    const float rbias = p->in[I_RB][l * 64 + c.lane];
    const int ntiles = ntok / 32, rpc = ntok / NCH, lane = c.lane, mb = c.wave >> 2, nb = c.wave & 3;
    for (int tile = c.blk; tile < ntiles; tile += c.G) {
        __syncthreads();
        if (c.tid < 64) hist[c.tid] = 0;
        for (int q = 0; q < 4; ++q) { const int r = tile * 32 + c.wave * 4 + q; const float* xr = r < NLAT ? xl + (size_t)r * DM : xc + (size_t)(r - NLAT) * DM; const float* m = MOD + (size_t)mod_row(r) * 6144;
            float* xo = r < NLAT ? p->out + (size_t)r * DM : (float*)(c.ws + WS_XC) + (size_t)(r - NLAT) * DM;
            f32x4 v[4]; norm_row_add(xr, (const bf16*)(c.ws + WS_Z) + (size_t)r * DM, xo, p->in[I_N2G] + l * DM, m + 3072, m + 4096, c.ws + WS_H8 + (size_t)r * DM, lane, v);
#pragma unroll
            for (int j = 0; j < 4; ++j) { u32x2 hi; hi.x = pk2(v[j].x, v[j].y); hi.y = pk2(v[j].z, v[j].w);
                const float r0 = v[j].x - __uint_as_float(hi.x << 16), r1 = v[j].y - __uint_as_float(hi.x & 0xffff0000u), r2 = v[j].z - __uint_as_float(hi.y << 16), r3 = v[j].w - __uint_as_float(hi.y & 0xffff0000u);
                u32x2 lo; lo.x = pk2(r0, r1); lo.y = pk2(r2, r3);
                *(LAS u32x2*)(hhi + (c.wave * 4 + q) * HROW + 4 * lane + 256 * j) = hi; *(LAS u32x2*)(hlo + (c.wave * 4 + q) * HROW + 4 * lane + 256 * j) = lo; } }
        __syncthreads();
        { f32x4 acc = (f32x4){0.f, 0.f, 0.f, 0.f};
          const LAS bf16* ah = hhi + (mb * 16 + (lane & 15)) * HROW + 8 * (lane >> 4); const LAS bf16* al = hlo + (mb * 16 + (lane & 15)) * HROW + 8 * (lane >> 4);
          const bf16* bh = Whi + (size_t)(nb * 16 + (lane & 15)) * 1024 + 8 * (lane >> 4); const bf16* bl = Wlo + (size_t)(nb * 16 + (lane & 15)) * 1024 + 8 * (lane >> 4);
#pragma unroll 8
          for (int ks = 0; ks < 32; ++ks) { const bf16x8 a_h = *(const LAS bf16x8*)(ah + 32 * ks), a_l = *(const LAS bf16x8*)(al + 32 * ks), b_h = *(const bf16x8*)(bh + 32 * ks), b_l = *(const bf16x8*)(bl + 32 * ks);
              acc = __builtin_amdgcn_mfma_f32_16x16x32_bf16(a_h, b_h, acc, 0, 0, 0); acc = __builtin_amdgcn_mfma_f32_16x16x32_bf16(a_h, b_l, acc, 0, 0, 0); acc = __builtin_amdgcn_mfma_f32_16x16x32_bf16(a_l, b_h, acc, 0, 0, 0); }
#pragma unroll
          for (int i = 0; i < 4; ++i) lgs[(mb * 16 + 4 * (lane >> 4) + i) * 64 + nb * 16 + (lane & 15)] = acc[i]; }
        __syncthreads();
#pragma unroll
        for (int q = 0; q < 4; ++q) {
            const int r = tile * 32 + c.wave * 4 + q;
            const float s = sigmoidf_(lgs[(c.wave * 4 + q) * 64 + lane]), bs = s + rbias;
            float m1 = bs; m1 = fmaxf(m1, shx<1>(m1)); m1 = fmaxf(m1, shx<2>(m1)); m1 = fmaxf(m1, shx<4>(m1));
            const unsigned long long eq = __ballot(bs == m1); const unsigned gm = (unsigned)(eq >> (lane & 56)) & 0xffu; const int first = __ffs(gm) - 1;
            float m2 = ((lane & 7) == first) ? -1e30f : bs; m2 = fmaxf(m2, shx<1>(m2)); m2 = fmaxf(m2, shx<2>(m2)); m2 = fmaxf(m2, shx<4>(m2));
            const float gs = m1 + m2; const int g = lane >> 3; int rank = 0;
#pragma unroll
            for (int j = 0; j < 8; ++j) { const float o = rdl(gs, 8 * j); rank += (o > gs || (o == gs && j < g)) ? 1 : 0; }
            float cand = rank < 4 ? bs : -1e30f; int my_e = 0; float my_w = 0.f, wsum = 0.f;
#pragma unroll
            for (int k = 0; k < 8; ++k) { const float mm = wave_max(cand); const unsigned long long e2 = __ballot(cand == mm); const int idx = __ffsll((long long)e2) - 1; const float wk = rdl(s, idx);
                if (lane == idx) cand = -1e30f; if (lane == k) { my_e = idx; my_w = wk; } wsum += wk; }
            if (lane < 8) { const int lp = atomicAdd((int*)&hist[my_e], 1); TKEP[(size_t)r * 8 + lane] = my_e | (lp << 8); TKW[(size_t)r * 8 + lane] = my_w / wsum * 2.5f; }
        }
        __syncthreads();
        if (c.tid < 64) { const int n = hist[c.tid]; int base = 0; if (n > 0) base = atomicAdd(&CNT[((tile * 32) / rpc) * NE + c.tid], n); TB[tile * 64 + c.tid] = base; }
    }
    __syncthreads();
}
__device__ __forceinline__ void phase_route_fill(const Ctx& c, int l, int ntok) {
    const int* TKEP = (const int*)(c.ws + WS_RT + RT_TKEP); int* SLOT = (int*)(c.ws + WS_RT + RT_SLOT); const int* TB = (const int*)(c.ws + WS_TB);
    const int* CNT = (const int*)(c.ws + WS_CTL) + CW_CNT + l * NCH * NE; int* ROWL = (int*)(c.ws + WS_ROWL);
    LAS int* est = (LAS int*)c.lds;
    const int rpc = ntok / NCH;
    LAS int* cntl = est + 256;
    __syncthreads();
    if (c.tid < NCH * NE) cntl[c.tid] = (CNT[c.tid] + 255) & ~255;
    __syncthreads();
    if (c.tid < NCH) { int s = 0; for (int e = 0; e < NE; ++e) { est[c.tid * 65 + e] = s; s += cntl[c.tid * NE + e]; } est[c.tid * 65 + 64] = s; }
    __syncthreads();
    const size_t na = (size_t)ntok * 8;
    for (size_t a = (size_t)c.blk * NTHR + c.tid; a < na; a += (size_t)c.G * NTHR) { const int t = (int)(a >> 3), ch = t / rpc; const int ep = TKEP[a], e = ep & 255, lp = ep >> 8;
        const int slot = est[ch * 65 + e] + TB[(t >> 5) * 64 + e] + lp; SLOT[a] = slot; ROWL[(size_t)ch * RPCMAX + slot] = t; }
    for (int i = c.blk * NTHR + c.tid; i < NCH * NE * 256; i += c.G * NTHR) { const int ch = i >> 14, e = (i >> 8) & 63, j = i & 255; const int n = CNT[ch * NE + e]; const int pad = ((n + 255) & ~255) - n;
        if (j < pad) ROWL[(size_t)ch * RPCMAX + est[ch * 65 + e] + n + j] = ch * rpc; }
    __syncthreads();
}

__device__ __forceinline__ void moe_tile_table(const Ctx& c, int l, int ch, LAS int* tst) {
    const int* CNT = (const int*)(c.ws + WS_CTL) + CW_CNT + l * NCH * NE + ch * NE;
    LAS unsigned char* texp = (LAS unsigned char*)(tst + 80);
    LAS int* cntl = tst + 1024;
    __syncthreads();
    if (c.tid < NE) cntl[c.tid] = (CNT[c.tid] + 255) >> 8;
    __syncthreads();
    if (c.tid == 0) { int s = 0; for (int e = 0; e < NE; ++e) { tst[e] = s; s += cntl[e]; } tst[64] = s; }
    __syncthreads();
    if (c.tid < NE) { for (int t = tst[c.tid]; t < tst[c.tid + 1]; ++t) texp[t] = (unsigned char)c.tid; }
    __syncthreads();
}
__device__ __forceinline__ void phase_combine(const Ctx& c, KParams p, int l, int ch, int rpc) {
    const float* MOD = (const float*)(c.ws + WS_MOD) + (size_t)l * 33 * 6144 + 5120; const float* MODn = (const float*)(c.ws + WS_MOD) + (size_t)33 * 6144;
    const int* SLOT = (const int*)(c.ws + WS_RT + RT_SLOT); const float* TKW = (const float*)(c.ws + WS_RT + RT_TKW);
    const unsigned char* OB = (const unsigned char*)(c.ws + WS_OB); const bf16* OBS = (const bf16*)(c.ws + WS_OBS);
    float* xl = p->out; float* xc = (float*)(c.ws + WS_XC); unsigned char* H = c.ws + WS_H;
    const int gw = c.blk * NWAVES + c.wave, NGW = c.G * NWAVES, lane = c.lane;
    const int col0 = (lane >> 4) * 256 + ((lane >> 2) & 3) * 32 + (lane & 3) * 8;
    f32x4 gn[4];
#pragma unroll
    for (int q = 0; q < 4; ++q) gn[q] = *(const f32x4*)((l == 0 ? p->in[I_N1G] + DM : p->in[I_FG]) + col0 + 128 * (q >> 1) + 4 * (q & 1));
    int sl_n = 0; float w_n = 0.f;
    if (gw < rpc && lane < 8) { sl_n = SLOT[(size_t)(ch * rpc + gw) * 8 + lane]; w_n = TKW[(size_t)(ch * rpc + gw) * 8 + lane] * 0.0625f; }
    for (int i = gw; i < rpc; i += NGW) {
        const int t = ch * rpc + i; float* xr = t < NLAT ? xl + (size_t)t * DM : xc + (size_t)(t - NLAT) * DM; const int mr = mod_row(t); const float* g2 = MOD + (size_t)mr * 6144;
        const int sl = sl_n; const float w = w_n;
        u32x4 ob[8], os0, os1; f32x4 xv[4];
#pragma unroll
        for (int e = 0; e < 8; ++e) ob[e] = *(const u32x4*)(OB + (size_t)rdli(sl, e) * 1024 + lane * 16);
        os0 = *(const u32x4*)(OBS + (size_t)i * DM + col0); os1 = *(const u32x4*)(OBS + (size_t)i * DM + col0 + 128);
#pragma unroll
        for (int q = 0; q < 4; ++q) xv[q] = *(const f32x4*)(xr + col0 + 128 * (q >> 1) + 4 * (q & 1));
        if (i + NGW < rpc && lane < 8) { sl_n = SLOT[(size_t)(t + NGW) * 8 + lane]; w_n = TKW[(size_t)(t + NGW) * 8 + lane] * 0.0625f; }
        float a[16]; { float t8[8]; unpack8(os0, t8);
#pragma unroll
            for (int q = 0; q < 8; ++q) a[q] = t8[q];
            unpack8(os1, t8);
#pragma unroll
            for (int q = 0; q < 8; ++q) a[8 + q] = t8[q]; }
#pragma unroll
        for (int e = 0; e < 8; ++e) { const float wk = rdl(w, e);
#pragma unroll
            for (int q = 0; q < 4; ++q) { const f32x2 lo = __builtin_amdgcn_cvt_pk_f32_fp8((int)ob[e][q], false), hi = __builtin_amdgcn_cvt_pk_f32_fp8((int)ob[e][q], true);
                a[4 * q] = fmaf(wk, lo.x, a[4 * q]); a[4 * q + 1] = fmaf(wk, lo.y, a[4 * q + 1]); a[4 * q + 2] = fmaf(wk, hi.x, a[4 * q + 2]); a[4 * q + 3] = fmaf(wk, hi.y, a[4 * q + 3]); } }
        f32x4 xn[4]; float ss = 0.f;
#pragma unroll
        for (int q = 0; q < 4; ++q) { const int cc = col0 + 128 * (q >> 1) + 4 * (q & 1); const f32x4 gv = *(const f32x4*)(g2 + cc);
            xn[q] = xv[q] + gv * (f32x4){a[4 * q], a[4 * q + 1], a[4 * q + 2], a[4 * q + 3]}; ss += (xn[q].x * xn[q].x + xn[q].y * xn[q].y) + (xn[q].z * xn[q].z + xn[q].w * xn[q].w); }
        const float rstd = rsqrtf(wave_sum(ss) * (1.f / 1024.f) + EPS);
        if (l == 0) { const float* mn = MODn + (size_t)mr * 6144; unsigned char* hr = H + (size_t)t * DM;
#pragma unroll
            for (int q = 0; q < 4; ++q) { const int cc = col0 + 128 * (q >> 1) + 4 * (q & 1); *(f32x4*)(xr + cc) = xn[q];
                const f32x4 s0 = *(const f32x4*)(mn + cc), s1 = *(const f32x4*)(mn + 1024 + cc); const f32x4 hv = (xn[q] * rstd * gn[q] * (s1 + 1.0f) + s0) * 4.f;
                *(unsigned*)(hr + cc) = pk4_fp8(hv.x, hv.y, hv.z, hv.w); } }
        else {
#pragma unroll
            for (int q = 0; q < 4; ++q) { const int cc = col0 + 128 * (q >> 1) + 4 * (q & 1); *(f32x4*)(xr + cc) = xn[q] * rstd * gn[q]; } }
    }
}
constexpr int LDS_BYTES = 147456;
constexpr int LDS_TAB = 131072, LDS_XB = LDS_BYTES - 16;
enum { J_INPROJ = 0, J_S5G1, J_PW, J_Q, J_KV, J_S5G2, J_GLU, J_OUT, J_GU, J_GUS, J_DN, J_DNS };
enum { SK_DENSE = 0, SK_S5, SK_MOE };
enum { EK_INPROJ = 0, EK_S5X, EK_S5Y, EK_BIAS, EK_GLU, EK_Q, EK_KV, EK_RESID, EK_SWIGLU, EK_OB8, EK_BF16 };
struct JSched {
    int sk, G, c; pg8::DenseOrder d; const char* W; size_t wexp, wtile; const LAS unsigned char* texp; int ntile, npn;
    __device__ __forceinline__ bool next(int i, pg8::Unit& u) const {
        if (sk == SK_DENSE) return d.next(i, u);
        const int L = i * G + c;
        if (sk == SK_S5) { if (L >= 288) return false; u.pm = L; u.pn = 0; u.e = L / 18; u.B = W + (size_t)u.e * wexp; return true; }
        if (L >= ntile * npn) return false;
        const int T = npn == 2 ? (L >> 1) : (L >> 2), pn = L & (npn - 1); const int e = __builtin_amdgcn_readfirstlane((int)texp[T]);
        u.pm = T; u.pn = pn; u.e = e; u.B = W + (size_t)e * wexp + (size_t)pn * wtile; return true;
    }
};
struct JRows { const int* list; unsigned ldab;
    __device__ __forceinline__ unsigned off(const pg8::Unit& u, int r) const { const int row = u.pm * 256 + r; return (unsigned)(list ? list[row] : row) * ldab; } };
struct JEpi {
    int ek; void* p0; void* p1; void* p2; const void* q0; const void* q1; const void* q2; int i0;
    __device__ __forceinline__ void operator()(EPI_ARGS) const {
        switch (ek) {
        case EK_S5X:    EpiS5X{(bf16*)p0}(acc, u, wr, wc, fr, fq); break;
        case EK_S5Y:    EpiS5Y{(bf16*)p0}(acc, u, wr, wc, fr, fq); break;
        case EK_BIAS:   EpiBiasBf16{(unsigned char*)p0, i0, (const float*)q0}(acc, u, wr, wc, fr, fq); break;
        case EK_GLU:    EpiGluSig{(unsigned char*)p0, i0, (const float*)q0}(acc, u, wr, wc, fr, fq); break;
        case EK_Q:      EpiQ{(bf16*)p0, (const float*)q0}(acc, u, wr, wc, fr, fq); break;
        case EK_KV:     EpiKV{(bf16*)p0, (bf16*)p1, (const float*)q0}(acc, u, wr, wc, fr, fq); break;
        default:        EpiBf16{(bf16*)p0, i0}(acc, u, wr, wc, fr, fq); break;
        }
    }
};
struct JEpi8 {
    int ek; void* p0; int i0; const void* q0; void* p1; void* p2;
    __device__ __forceinline__ void operator()(EPI_ARGS) const {
        if (ek == EK_SWIGLU) EpiSwiglu{(unsigned char*)p0, i0, 1.0f / 256.0f}(acc, u, wr, wc, fr, fq);
        else if (ek == EK_OB8) EpiOB8{(unsigned char*)p0, 16.0f / 1024.0f}(acc, u, wr, wc, fr, fq);
        else if (ek == EK_INPROJ) EpiInProj{(bf16*)p0, (bf16*)p1, (bf16*)p2, 1.0f / 256.0f}(acc, u, wr, wc, fr, fq);
        else if (ek == EK_RESID) EpiDelta{(bf16*)p0, (const float*)q0, 1.0f / 1024.0f}(acc, u, wr, wc, fr, fq);
        else EpiBf16S{(bf16*)p0, i0, 1.0f / 1024.0f}(acc, u, wr, wc, fr, fq);
    }
};
__device__ __forceinline__ void gemm_job(KParams p, LAS unsigned char* lds, int job, int l, int ch) {
    unsigned char* ws = p->ws;
    const int G = gridDim.x, blk = blockIdx.x;
    const bool last = (l == 1); const int nrows = last ? NLAT : NTOK, rpc = nrows / NCH;
    unsigned char* sm = ws + WS_WSM + (size_t)l * WSM_L;
    const LAS int* tst = (const LAS int*)(lds + LDS_TAB);
    auto rot8 = [&](int units) { return ((units % G) + 7) & ~7; };
    auto rotc = [&](int rot) { return (blk + G - rot % G) % G; };
    const char* A = nullptr; int K = 256; bool fp8 = false; JSched S; JRows R; JEpi E;
    S.sk = SK_DENSE; S.G = G; S.c = blk; S.W = nullptr; S.wexp = 0; S.wtile = 0; S.texp = (const LAS unsigned char*)(tst + 80); S.ntile = 0; S.npn = 2; S.d.init(1, 1, G, blk, nullptr, 256);
    R.list = nullptr; R.ldab = 512u; E.ek = EK_BF16; E.p0 = E.p1 = E.p2 = nullptr; E.q0 = E.q1 = E.q2 = nullptr; E.i0 = 0;
    switch (job) {
    case J_INPROJ: A = (const char*)(ws + WS_H); K = 512; fp8 = true; R.ldab = 1024u; S.d.init(NTOK / 256, ZW / 256, G, blk, (const bf16*)(ws + WS_WIN) + (size_t)l * 2048 * 1024, 512);
        E.ek = EK_INPROJ; E.p0 = ws + WS_Z; E.p1 = ws + WS_UP; E.p2 = ws + WS_GVT; break;
    case J_S5G1: A = (const char*)(ws + WS_UP); K = 256; R.ldab = 1024u; S.sk = SK_S5; S.W = (const char*)(ws + WS_S5W) + (size_t)l * 16 * 256 * 256 * 2; S.wexp = (size_t)256 * 256 * 2; E.ek = EK_S5X; E.p0 = ws + WS_Y5; break;
    case J_PW: A = (const char*)(ws + WS_CV); K = 256; R.ldab = 512u; S.d.init(nrows / 256, 1, G, blk, (const bf16*)(sm + WSM_PW), 256); E.ek = EK_BIAS; E.p0 = ws + WS_MIX + 256; E.i0 = DM; E.q0 = p->in[I_CPB] + l * 256; break;
    case J_Q: A = (const char*)(ws + WS_Z) + ZCQ * 2; K = 256; R.ldab = (unsigned)ZW * 2u; S.d.init(NTOK / 256, 2, G, rotc(rot8(nrows / 256)), (const bf16*)(sm + WSM_UQ), 256);
        E.ek = EK_Q; E.p0 = ws + WS_H; E.q0 = ws + WS_RS; break;
    case J_KV: A = (const char*)(ws + WS_Z) + ZCKV * 2; K = 256; R.ldab = (unsigned)ZW * 2u; S.d.init(NTOK / 256, 2, G, rotc(rot8(nrows / 256) + rot8(NTOK / 256 * 2)), (const bf16*)(sm + WSM_UK), 256);
        E.ek = EK_KV; E.p0 = (bf16*)(ws + WS_H) + (size_t)NTOK * 384; E.p1 = (bf16*)(ws + WS_H) + (size_t)NTOK * 768; E.q0 = ws + WS_RS; break;
    case J_S5G2: A = (const char*)(ws + WS_UP); K = 512; R.ldab = 1024u; S.sk = SK_S5; S.W = (const char*)(ws + WS_S5W) + (size_t)32 * 256 * 256 * 2 + (size_t)l * 16 * 256 * 512 * 2; S.wexp = (size_t)256 * 512 * 2; E.ek = EK_S5Y; E.p0 = ws + WS_Y5; break;
    case J_GLU: A = (const char*)(ws + WS_Y5); K = 256; R.ldab = 512u; S.d.init(nrows / 256, 2, G, blk, (const bf16*)(sm + WSM_GLU), 256); E.ek = EK_GLU; E.p0 = ws + WS_MIX + 512; E.i0 = DM; E.q0 = p->in[I_S5GB] + l * 512; break;
    case J_OUT: A = (const char*)(ws + WS_MIX); K = 512; fp8 = true; R.ldab = 1024u; S.d.init(nrows / 256, 4, G, blk, (const bf16*)(ws + WS_WOUT) + (size_t)l * 1024 * 1024, 512);
        E.ek = EK_RESID; E.p0 = ws + WS_Z; E.q0 = (const float*)(ws + WS_MOD) + (size_t)l * 33 * 6144 + 2048; break;
    case J_GU: A = (const char*)(ws + WS_H8); K = 512; fp8 = true; R.list = (const int*)(ws + WS_ROWL) + (size_t)ch * RPCMAX; R.ldab = 1024u; S.sk = SK_MOE; S.ntile = __builtin_amdgcn_readfirstlane(tst[64]); S.npn = 2; S.W = (const char*)(ws + WS_WMOE) + (size_t)l * 48 * MiB; S.wexp = (size_t)512 * 1024; S.wtile = (size_t)256 * 1024;
        E.ek = EK_SWIGLU; E.p0 = ws + WS_HB; E.i0 = 256; break;
    case J_GUS: A = (const char*)(ws + WS_H8) + (size_t)ch * rpc * 1024; K = 512; fp8 = true; R.ldab = 1024u; S.d.init(rpc / 256, 2, G, rotc(rot8(__builtin_amdgcn_readfirstlane(tst[64]) * 2)), (const bf16*)((const unsigned char*)(ws + WS_WSH) + (size_t)l * (512 * 1024 + 1024 * 256) * 2), 512); E.ek = EK_SWIGLU; E.p0 = ws + WS_HBS; E.i0 = 256; break;
    case J_DN: A = (const char*)(ws + WS_HB); K = 128; fp8 = true; R.ldab = 256u; S.sk = SK_MOE; S.ntile = __builtin_amdgcn_readfirstlane(tst[64]); S.npn = 4; S.W = (const char*)(ws + WS_WMOE) + (size_t)l * 48 * MiB + (size_t)NE * 512 * 1024; S.wexp = (size_t)1024 * 256; S.wtile = (size_t)256 * 256;
        E.ek = EK_OB8; E.p0 = ws + WS_OB; break;
    default: A = (const char*)(ws + WS_HBS); K = 128; fp8 = true; R.ldab = 256u; S.d.init(rpc / 256, 4, G, rotc(rot8(__builtin_amdgcn_readfirstlane(tst[64]) * 4)), (const bf16*)((const unsigned char*)(ws + WS_WSH) + (size_t)l * (512 * 1024 + 1024 * 256) * 2 + 512 * 1024), 128); E.ek = EK_BF16; E.p0 = ws + WS_OBS; E.i0 = DM; break;
    }
    __builtin_amdgcn_s_waitcnt(0x0F70);
    if (fp8) pg8::gemm_phase<true>(lds, A, K, S, R, JEpi8{E.ek, E.p0, E.i0, E.q0, E.p1, E.p2});
    else pg8::gemm_phase<false>(lds, A, K, S, R, E);
}


__global__ void __launch_bounds__(NTHR, 2) fwd_kernel(Params pk) {
    extern __shared__ __attribute__((aligned(16))) unsigned char lds_raw[];
    LAS unsigned char* const lds0 = (LAS unsigned char*)lds_raw;
    if (threadIdx.x < 4) ((LAS unsigned*)(lds0 + LDS_XB))[threadIdx.x] = 0u;
    __syncthreads();
    (void)xcd_barrier_post((unsigned*)(pk.ws + WS_CTL) + CW_BAR, (volatile LAS unsigned*)(lds0 + LDS_XB));
    constexpr int NSTEP = 15 + 6 * NCH;
#ifndef PROBE_DUP
#define PROBE_DUP (-9)
#endif
#pragma unroll 1
    for (int it_ = -2; it_ < 2 * NSTEP + (PROBE_DUP >= 0 ? 2 : 0); ++it_) {
        int gs = it_; if (PROBE_DUP >= 0) { if (it_ > PROBE_DUP) gs -= 1; if (it_ > NSTEP + PROBE_DUP + 1) gs -= 1; }
        KParams p = fresh_params(); Ctx c; { int t_ = threadIdx.x; asm volatile("" : "+v"(t_)); c.lds = lds0; c.tid = t_; c.lane = t_ & 63; c.wave = __builtin_amdgcn_readfirstlane(t_ >> 6); c.blk = blockIdx.x; c.G = gridDim.x; c.ws = p->ws; }
        LAS int* tst = (LAS int*)(c.lds + LDS_TAB);
        int l = 0, s = gs, ch = 0, job = -1; bool seam = true;
        if (gs >= 0) { l = gs >= NSTEP ? 1 : 0; s = gs - l * NSTEP; if (s >= 15) { ch = (s - 15) / 6; s = 15 + (s - 15) % 6; } }
        const bool last = (l == 1); const int nrows = last ? NLAT : NTOK, rpc = nrows / NCH;
        switch (s) {
        case -2: prologue(c, p); break;
        case -1: prologue2(c, p); phase_norm1(c, p, 0); break;
        case 0: seam = false; break;
        case 1: job = J_INPROJ; break;
        case 2: phase_gla(c, p, l); phase_conv1(c, p, l, !last); phase_mla_prep(c, p); seam = false; break;
        case 3: job = J_S5G1; break;
        case 4: phase_gla_final(c, p, l, nrows); seam = false; break;
        case 5: job = J_PW; seam = false; break;
        case 6: job = J_Q; seam = false; break;
        case 7: job = J_KV; seam = false; break;
        case 8: phase_s5_carry(c, l); break;
        case 9: phase_attn(c, !last); seam = false; break;
        case 10: job = J_S5G2; break;
        case 11: job = J_GLU; break;
        case 12: job = J_OUT; break;
        case 13: phase_norm2_route(c, p, l, nrows); break;
        case 14: phase_route_fill(c, l, nrows); break;
        case 15: moe_tile_table(c, l, ch, tst); job = J_GU; seam = false; break;
        case 16: job = J_GUS; break;
        case 17: job = J_DN; seam = false; break;
        case 18: job = J_DNS; break;
        case 19: phase_combine(c, p, l, ch, rpc); break;
        default: seam = false; break;
        }
        if (job >= 0) gemm_job(p, c.lds, job, l, ch);
        if (seam && gs + 1 < 2 * NSTEP) { XcdBarrier b_; b_.bar = (unsigned*)(p->ws + WS_CTL) + CW_BAR; b_.x = xb_xcc_id(); b_.st = (volatile LAS unsigned*)(lds0 + LDS_XB); xcd_barrier(b_); }
    }
}

extern "C" void kernel_launch(void* const* d_in, const int* in_sizes, int n_in, void* d_out, int out_size, void* d_ws, size_t ws_size, hipStream_t stream) {
    static int grid = 0;
    if (grid == 0) {
        if (n_in != 42 || out_size != NLAT * DM || ws_size < WS_END) { fprintf(stderr, "kernel_launch: unexpected shapes (n_in %d out %d ws %zu)\n", n_in, out_size, ws_size); grid = -1; return; }
        int dev = 0, cus = 0;
        if (hipGetDevice(&dev) != hipSuccess || hipDeviceGetAttribute(&cus, hipDeviceAttributeMultiprocessorCount, dev) != hipSuccess) { grid = -1; return; }
        if (hipFuncSetAttribute((const void*)fwd_kernel, hipFuncAttributeMaxDynamicSharedMemorySize, LDS_BYTES) != hipSuccess) { fprintf(stderr, "kernel_launch: hipFuncSetAttribute failed\n"); grid = -1; return; }
        int per_cu = 0;
        if (hipOccupancyMaxActiveBlocksPerMultiprocessor(&per_cu, (const void*)fwd_kernel, NTHR, LDS_BYTES) != hipSuccess || per_cu < 1) fprintf(stderr, "kernel_launch: occupancy query reports %d\n", per_cu);
        (void)hipGetLastError();
        grid = cus;
    }
    if (grid < 0) return;
    (void)hipMemsetAsync((char*)d_ws + WS_CTL, 0, CTL_BYTES, stream);
    Params p{};
    for (int i = 0; i < 42; ++i) p.in[i] = (const float*)d_in[i];
    p.out = (float*)d_out; p.ws = (unsigned char*)d_ws; p.ph_lo = 0; p.ph_hi = 1 << 20;
    hipLaunchKernelGGL(fwd_kernel, dim3(grid), dim3(NTHR), LDS_BYTES, stream, p);
}
```
